# Optimizing an MI355X kernel written in HIP

```python
import jax, jax.numpy as jnp
from jax import lax
import numpy as np

D_MODEL = 1024
BATCH = 8
SEQ = 4096
DEPTH = 1

ATT_HEADS = 8
ATT_KV_HEADS = 2
ATT_HEAD_DIM = 64
IDX_HEADS = 8
IDX_HEAD_DIM = 64
TOPK_MAX = 256
Q_BLOCK = 128
DN_HEADS = 4
DN_HEAD_DIM = 128
DN_CONV = 4
DN_CHUNK = 64
PEER_HEADS = 8
PEER_N_KEYS = 128
PEER_N_EXPERTS = PEER_N_KEYS * PEER_N_KEYS
PEER_KEY_DIM = 256
PEER_TOPK = 16
PEER_TOKEN_BLOCK = 128
EPS = 1e-6

ATT_Q_W = ATT_HEADS * ATT_HEAD_DIM
ATT_KV_W = ATT_KV_HEADS * ATT_HEAD_DIM
IDX_Q_W = IDX_HEADS * IDX_HEAD_DIM
DN_W = DN_HEADS * DN_HEAD_DIM
IN_SPLITS = (ATT_Q_W, ATT_KV_W, ATT_KV_W,
             IDX_Q_W, IDX_HEAD_DIM, IDX_HEADS,
             DN_W, DN_W, DN_W, DN_W,
             DN_HEADS, DN_HEADS,
             D_MODEL, D_MODEL)
IN_WIDTH = sum(IN_SPLITS)

kernel_name = 'hybrid_dsa_gdn_peer_block'


def rms_norm(x, gain):
    xf = x.astype(jnp.float32)
    y = xf * lax.rsqrt(jnp.mean(xf * xf, axis=-1, keepdims=True) + EPS)
    return (y * gain.astype(jnp.float32)).astype(x.dtype)


def l2_norm(x):
    return x * lax.rsqrt(jnp.sum(x * x, axis=-1, keepdims=True) + EPS)


def causal_depthwise_conv(x, w):
    k_width, chans = w.shape
    return lax.conv_general_dilated(x, w[:, None, :], window_strides=(1,), padding=[(k_width - 1, 0)],
                                    dimension_numbers=('NWC', 'WIO', 'NWC'), feature_group_count=chans)


def dsa_attention(q, k, v, iq, ik, iw, k_sel):
    f32 = jnp.float32
    b, t = q.shape[:2]
    nb = t // Q_BLOCK
    grp = ATT_HEADS // ATT_KV_HEADS
    scale = ATT_HEAD_DIM ** -0.5
    key_pos = jnp.arange(t)
    ik32 = ik.astype(f32)

    def to_blocks(a):
        return jnp.moveaxis(a.reshape((b, nb, Q_BLOCK) + a.shape[2:]), 1, 0)

    def block(args):
        qb, iqb, iwb, start = args
        qpos = start + jnp.arange(Q_BLOCK)
        causal = key_pos[None, :] <= qpos[:, None]
        dots = jnp.einsum('bqhd,bsd->bqhs', iqb.astype(f32), ik32)
        score = jnp.einsum('bqh,bqhs->bqs', iwb.astype(f32), jax.nn.relu(dots))
        score = jnp.where(causal[None], score, -jnp.inf)
        _, sel = lax.top_k(score, k_sel)
        valid = sel <= qpos[None, :, None]
        k_g = jax.vmap(lambda kb, ib: kb[ib])(k, sel)
        v_g = jax.vmap(lambda vb, ib: vb[ib])(v, sel)
        qg = qb.reshape(b, Q_BLOCK, ATT_KV_HEADS, grp, ATT_HEAD_DIM).astype(f32)
        logits = jnp.einsum('bqhgd,bqkhd->bqhgk', qg, k_g.astype(f32)) * scale
        logits = jnp.where(valid[:, :, None, None, :], logits, -1e30)
        p = jax.nn.softmax(logits, axis=-1)
        o = jnp.einsum('bqhgk,bqkhd->bqhgd', p, v_g.astype(f32))
        return o.reshape(b, Q_BLOCK, ATT_Q_W).astype(qb.dtype)

    starts = jnp.arange(nb) * Q_BLOCK
    out = lax.map(block, (to_blocks(q), to_blocks(iq), to_blocks(iw), starts))
    return jnp.moveaxis(out, 0, 1).reshape(b, t, ATT_Q_W)


def gated_deltanet(q, k, v, g, beta):
    f32 = jnp.float32
    out_dtype = q.dtype
    b, t, h, d = q.shape
    c = DN_CHUNK
    n = t // c
    q = l2_norm(q.astype(f32)) * (d ** -0.5)
    k = l2_norm(k.astype(f32))
    v = v.astype(f32)

    def chunk(a):
        a = a.reshape((b, n, c, h) + a.shape[3:])
        return jnp.moveaxis(a, 3, 1)

    q, k, v = chunk(q), chunk(k), chunk(v)
    g = jnp.cumsum(chunk(g.astype(f32)), axis=-1)
    beta = chunk(beta.astype(f32))
    tri = jnp.tril(jnp.ones((c, c), bool))
    strict = jnp.tril(jnp.ones((c, c), bool), -1)
    decay = jnp.exp(jnp.where(tri, g[..., :, None] - g[..., None, :], -jnp.inf))
    k_beta = k * beta[..., None]
    a_mat = jnp.where(strict, jnp.einsum('bhnid,bhnjd->bhnij', k_beta, k) * decay, 0.0)
    rhs = jnp.concatenate([v * beta[..., None], k_beta * jnp.exp(g)[..., None]], axis=-1)
    sol = lax.linalg.triangular_solve(a_mat, rhs, left_side=True, lower=True, unit_diagonal=True)
    u, w = sol[..., :d], sol[..., d:]
    intra = jnp.where(tri, jnp.einsum('bhnid,bhnjd->bhnij', q, k) * decay, 0.0)

    def step(state, inp):
        q_i, k_i, u_i, w_i, g_i, att_i = inp
        v_new = u_i - jnp.einsum('bhcd,bhde->bhce', w_i, state)
        o = (jnp.einsum('bhcd,bhde->bhce', q_i * jnp.exp(g_i)[..., None], state)
             + jnp.einsum('bhij,bhje->bhie', att_i, v_new))
        g_last = g_i[..., -1]
        state = (state * jnp.exp(g_last)[..., None, None]
                 + jnp.einsum('bhcd,bhce->bhde', k_i * jnp.exp(g_last[..., None] - g_i)[..., None], v_new))
        return state, o

    xs = tuple(jnp.moveaxis(a, 2, 0) for a in (q, k, u, w, g, intra))
    state0 = jnp.zeros((b, h, d, d), f32)
    _, o = lax.scan(step, state0, xs)
    o = jnp.moveaxis(o, 0, 2).reshape(b, h, t, d).transpose(0, 2, 1, 3)
    return o.astype(out_dtype)


def peer(hn, w_query, sub_keys, u_tab, v_tab):
    f32 = jnp.float32
    b, t, dm = hn.shape
    ntok = b * t
    hf = hn.reshape(ntok, dm)
    q = (hf @ w_query).reshape(ntok, PEER_HEADS, 2, PEER_KEY_DIM // 2)
    s = jnp.einsum('nhpd,hpkd->nhpk', q.astype(f32), sub_keys.astype(f32))
    top_s, top_i = lax.top_k(s, PEER_TOPK)
    cand_s = (top_s[:, :, 0, :, None] + top_s[:, :, 1, None, :]).reshape(ntok, PEER_HEADS, -1)
    cand_i = (top_i[:, :, 0, :, None] * PEER_N_KEYS + top_i[:, :, 1, None, :]).reshape(ntok, PEER_HEADS, -1)
    best_s, pos = lax.top_k(cand_s, PEER_TOPK)
    expert = jnp.take_along_axis(cand_i, pos, axis=-1)
    gate = jax.nn.softmax(best_s, axis=-1)
    nblk = ntok // PEER_TOKEN_BLOCK

    def block(args):
        hb, eb, gb = args
        act = jax.nn.gelu(jnp.einsum('nhkd,nd->nhk', u_tab[eb], hb).astype(f32), approximate=False)
        coef = (gb * act).astype(hb.dtype)
        return jnp.einsum('nhk,nhkd->nd', coef, v_tab[eb])

    out = lax.map(block, (hf.reshape(nblk, PEER_TOKEN_BLOCK, dm),
                          expert.reshape(nblk, PEER_TOKEN_BLOCK, PEER_HEADS, PEER_TOPK),
                          gate.reshape(nblk, PEER_TOKEN_BLOCK, PEER_HEADS, PEER_TOPK)))
    return out.reshape(b, t, dm)


def setup_inputs(seed: int = 0) -> dict:
    key = jax.random.key(seed)
    ks = jax.random.split(key, 17)
    f32 = jnp.float32
    nl = DEPTH

    def nrm(k, shape, scale):
        return jax.random.normal(k, shape, f32) * scale

    return {
        'x': nrm(ks[0], (BATCH, SEQ, D_MODEL), 1.0),
        'norm1_gain': 1.0 + nrm(ks[1], (nl, D_MODEL), 0.01),
        'w_in': nrm(ks[2], (nl, D_MODEL, IN_WIDTH), D_MODEL ** -0.5),
        'q_norm_gain': 1.0 + nrm(ks[3], (nl, ATT_HEAD_DIM), 0.01),
        'k_norm_gain': 1.0 + nrm(ks[4], (nl, ATT_HEAD_DIM), 0.01),
        'dn_conv_w': nrm(ks[5], (nl, DN_CONV, 3 * DN_W), DN_CONV ** -0.5),
        'dn_a_log': jnp.log(jax.random.uniform(ks[6], (nl, DN_HEADS), f32, 1.0, 16.0)),
        'dn_dt_bias': nrm(ks[7], (nl, DN_HEADS), 0.1),
        'dn_out_norm_gain': 1.0 + nrm(ks[8], (nl, DN_HEAD_DIM), 0.01),
        'w_att_branch': nrm(ks[9], (nl, ATT_Q_W, D_MODEL), ATT_Q_W ** -0.5),
        'w_dn_branch': nrm(ks[10], (nl, DN_W, D_MODEL), DN_W ** -0.5),
        'w_o': nrm(ks[11], (nl, D_MODEL, D_MODEL), D_MODEL ** -0.5),
        'norm2_gain': 1.0 + nrm(ks[12], (nl, D_MODEL), 0.01),
        'peer_w_query': nrm(ks[13], (nl, D_MODEL, PEER_HEADS * PEER_KEY_DIM), D_MODEL ** -0.5),
        'peer_sub_keys': nrm(ks[14], (nl, PEER_HEADS, 2, PEER_N_KEYS, PEER_KEY_DIM // 2), (PEER_KEY_DIM // 2) ** -0.5),
        'peer_u': nrm(ks[15], (nl, PEER_N_EXPERTS, D_MODEL), D_MODEL ** -0.5),
        'peer_v': nrm(ks[16], (nl, PEER_N_EXPERTS, D_MODEL), PEER_HEADS ** -0.5),
    }


def reference(x, norm1_gain, w_in, q_norm_gain, k_norm_gain, dn_conv_w, dn_a_log, dn_dt_bias,
              dn_out_norm_gain, w_att_branch, w_dn_branch, w_o, norm2_gain, peer_w_query,
              peer_sub_keys, peer_u, peer_v):
    b, t, _ = x.shape
    k_sel = min(TOPK_MAX, t // 4)
    cuts = np.cumsum(IN_SPLITS)[:-1].tolist()
    for layer in range(DEPTH):
        h = rms_norm(x, norm1_gain[layer])
        proj = h @ w_in[layer]
        (aq, ak, av, iq, ik, iw, dq, dk, dv, dz, da, db, ga, gb) = jnp.split(proj, cuts, axis=-1)

        aq = rms_norm(aq.reshape(b, t, ATT_HEADS, ATT_HEAD_DIM), q_norm_gain[layer])
        ak = rms_norm(ak.reshape(b, t, ATT_KV_HEADS, ATT_HEAD_DIM), k_norm_gain[layer])
        av = av.reshape(b, t, ATT_KV_HEADS, ATT_HEAD_DIM)
        iq = iq.reshape(b, t, IDX_HEADS, IDX_HEAD_DIM)
        y_att = dsa_attention(aq, ak, av, iq, ik, iw, k_sel)

        qkv = jax.nn.silu(causal_depthwise_conv(jnp.concatenate([dq, dk, dv], axis=-1), dn_conv_w[layer]))
        dq, dk, dv = jnp.split(qkv, 3, axis=-1)
        shp = (b, t, DN_HEADS, DN_HEAD_DIM)
        decay = -jnp.exp(dn_a_log[layer].astype(jnp.float32)) * jax.nn.softplus(
            da.astype(jnp.float32) + dn_dt_bias[layer].astype(jnp.float32))
        beta = jax.nn.sigmoid(db.astype(jnp.float32))
        o_dn = gated_deltanet(dq.reshape(shp), dk.reshape(shp), dv.reshape(shp), decay, beta)
        y_dn = (rms_norm(o_dn, dn_out_norm_gain[layer]) * jax.nn.silu(dz.reshape(shp))).reshape(b, t, DN_W)

        merged = (jax.nn.sigmoid(ga) * (y_att @ w_att_branch[layer])
                  + jax.nn.sigmoid(gb) * (y_dn @ w_dn_branch[layer]))
        x = x + merged @ w_o[layer]

        h2 = rms_norm(x, norm2_gain[layer])
        x = x + peer(h2, peer_w_query[layer], peer_sub_keys[layer], peer_u[layer], peer_v[layer])
    return x
```

```cpp
#include <hip/hip_runtime.h>
#include <hip/hip_bf16.h>
#include <hip/hip_cooperative_groups.h>
#include <cstdio>
#include <cstdint>
namespace cg = cooperative_groups;

typedef unsigned short u16;
typedef unsigned int u32;
typedef unsigned char u8;
typedef short bf16x8 __attribute__((ext_vector_type(8)));
typedef float f32x4 __attribute__((ext_vector_type(4)));
typedef unsigned int u32x4 __attribute__((ext_vector_type(4)));
typedef unsigned int u32x2 __attribute__((ext_vector_type(2)));

constexpr int NTHREADS = 512;
constexpr int BATCH = 8, SEQ = 4096, DM = 1024, MTOK = BATCH * SEQ;
constexpr int LDP = 5440;
constexpr int NPADW = 5504;
constexpr int C_AQ = 0, C_AK = 512, C_AV = 640, C_IQ = 768, C_IK = 1280, C_DQ = 1344, C_DK = 1856, C_DV = 2368,
              C_DZ = 2880, C_GA = 3392, C_GB = 4416;
constexpr size_t MiB = 1ull << 20;
constexpr size_t OFF_WTIN = 1 * MiB, OFF_WTA = 12 * MiB, OFF_WTB = 13 * MiB, OFF_WTO = 14 * MiB, OFF_WTQ = 16 * MiB,
                 OFF_SKB = 20 * MiB, OFF_SMALL = 21 * MiB, OFF_H = 23 * MiB, OFF_ATT = 23 * MiB, OFF_GC = 39 * MiB,
                 OFF_MERGED = 23 * MiB, OFF_PROJ = 87 * MiB, OFF_SEL = 427 * MiB, OFF_YATT = 443 * MiB,
                 OFF_YDN = 475 * MiB;
constexpr size_t OFF_H2 = OFF_PROJ, OFF_QP = OFF_PROJ + 64 * MiB, OFF_TOPS = OFF_PROJ + 192 * MiB,
                 OFF_TOPI = OFF_PROJ + 224 * MiB, OFF_EXPERT = OFF_PROJ + 232 * MiB, OFF_GATE = OFF_PROJ + 248 * MiB;
constexpr size_t DO_U = 0, DO_W = 32 * MiB, DO_QN = 64 * MiB, DO_KNT = 96 * MiB;

constexpr int SMEM_BYTES = 147456;
constexpr float EPS = 1e-6f;

struct Params {
  const float* in[17];
  float* out;
  unsigned char* ws;
  int ph_lo, ph_hi;
};

__device__ __forceinline__ u16 f2bf(float f) {
  u32 u = __float_as_uint(f);
  u += 0x7fffu + ((u >> 16) & 1u);
  return (u16)(u >> 16);
}
__device__ __forceinline__ float bf2f(u16 h) { return __uint_as_float(((u32)h) << 16); }
__device__ __forceinline__ u32 pack2(float a, float b) { return (u32)f2bf(a) | ((u32)f2bf(b) << 16); }
__device__ __forceinline__ float bflo(u32 w) { return __uint_as_float(w << 16); }
__device__ __forceinline__ float bfhi(u32 w) { return __uint_as_float(w & 0xffff0000u); }
__device__ __forceinline__ float wave_sum(float v) {
#pragma unroll
  for (int o = 32; o > 0; o >>= 1) v += __shfl_xor(v, o);
  return v;
}
__device__ __forceinline__ float wave_max(float v) {
#pragma unroll
  for (int o = 32; o > 0; o >>= 1) v = fmaxf(v, __shfl_xor(v, o));
  return v;
}
#define WAVE_LDS_SYNC() asm volatile("s_waitcnt lgkmcnt(0)" ::: "memory")
__device__ __forceinline__ float sigmoidf_(float x) { return __builtin_amdgcn_rcpf(1.f + __expf(-x)); }
__device__ __forceinline__ int perm32(int k) {
  int blk = k & ~31, r = k & 31;
  int p = (r < 16) ? (8 * (r >> 2) + (r & 3)) : (8 * ((r - 16) >> 2) + 4 + (r & 3));
  return blk + p;
}

__device__ __forceinline__ int win_map(int n) {
  if (n < 1344) return n;
  if (n < 3392) return n + 8;
  if (n < 5440) return n + 16;
  if (n < 5448) return 1344 + (n - 5440);
  if (n < 5452) return 3400 + (n - 5448);
  if (n < 5456) return 3404 + (n - 5452);
  return -1;
}
__device__ void transpose_tile(const float* __restrict__ src, int Nsrc, u16* __restrict__ dst, int K, int k0, int n0,
                               bool mapped, float* tile  ) {
  const int tid = threadIdx.x;
  {
    const int tx = tid & 63, ty = tid >> 6;
    int n = n0 + tx;
    int sc = mapped ? win_map(n) : n;
#pragma unroll
    for (int i = 0; i < 8; ++i) {
      int k = ty + 8 * i;
      float v = (sc >= 0) ? src[(size_t)(k0 + k) * Nsrc + sc] : 0.f;
      tile[k * 65 + tx] = v;
    }
  }
  __syncthreads();
  {
    const int n = tid >> 3, kc = (tid & 7) * 8;
    u32 w[4];
#pragma unroll
    for (int j = 0; j < 4; ++j) w[j] = pack2(tile[(kc + 2 * j) * 65 + n], tile[(kc + 2 * j + 1) * 65 + n]);
    *(uint4*)(dst + (size_t)(n0 + n) * K + k0 + kc) = make_uint4(w[0], w[1], w[2], w[3]);
  }
  __syncthreads();
}

__device__ void rmsnorm_rows(const float* __restrict__ x, const float* __restrict__ gain, u16* __restrict__ out) {
  const int lane = threadIdx.x & 63, wave = threadIdx.x >> 6;
  float4 g[4];
#pragma unroll
  for (int i = 0; i < 4; ++i) g[i] = ((const float4*)gain)[lane + 64 * i];
  for (int row = blockIdx.x * 8 + wave; row < MTOK; row += gridDim.x * 8) {
    const float4* xr = (const float4*)(x + (size_t)row * DM);
    float4 v[4];
    float ss = 0.f;
#pragma unroll
    for (int i = 0; i < 4; ++i) {
      v[i] = xr[lane + 64 * i];
      ss += v[i].x * v[i].x + v[i].y * v[i].y + v[i].z * v[i].z + v[i].w * v[i].w;
    }
    ss = wave_sum(ss);
    float r = rsqrtf(ss * (1.f / DM) + EPS);
#pragma unroll
    for (int i = 0; i < 4; ++i) {
      uint2 o;
      o.x = pack2(v[i].x * r * g[i].x, v[i].y * r * g[i].y);
      o.y = pack2(v[i].z * r * g[i].z, v[i].w * r * g[i].w);
      *(uint2*)(out + (size_t)row * DM + 4 * (lane + 64 * i)) = o;
    }
  }
}

__device__ void phase0(const Params& p, unsigned char* smem) {
  float* tile = (float*)smem;
  unsigned char* ws = p.ws;
  const int n_in = 16 * 86, n_a = 8 * 16, n_b = 8 * 16, n_o = 16 * 16, n_q = 16 * 32;
  const int total = n_in + n_a + n_b + n_o + n_q;
  for (int t = blockIdx.x; t < total; t += gridDim.x) {
    int i = t;
    if (i < n_in) { transpose_tile(p.in[2], 5456, (u16*)(ws + OFF_WTIN), 1024, (i / 86) * 64, (i % 86) * 64, true, tile); continue; }
    i -= n_in;
    if (i < n_a) { transpose_tile(p.in[9], 1024, (u16*)(ws + OFF_WTA), 512, (i / 16) * 64, (i % 16) * 64, false, tile); continue; }
    i -= n_a;
    if (i < n_b) { transpose_tile(p.in[10], 1024, (u16*)(ws + OFF_WTB), 512, (i / 16) * 64, (i % 16) * 64, false, tile); continue; }
    i -= n_b;
    if (i < n_o) { transpose_tile(p.in[11], 1024, (u16*)(ws + OFF_WTO), 1024, (i / 16) * 64, (i % 16) * 64, false, tile); continue; }
    i -= n_o;
    transpose_tile(p.in[13], 2048, (u16*)(ws + OFF_WTQ), 1024, (i / 32) * 64, (i % 32) * 64, false, tile);
  }
  {
    const float* sk = p.in[14];
    u16* skb = (u16*)(ws + OFF_SKB);
    for (int i = blockIdx.x * NTHREADS + threadIdx.x; i < 16 * 128 * 128; i += gridDim.x * NTHREADS) skb[i] = f2bf(sk[i]);
  }
  rmsnorm_rows(p.in[0], p.in[1], (u16*)(ws + OFF_H));
}

constexpr int G_BM = 256, G_BN = 128, G_BK = 64;
constexpr int G_ABYTES = G_BM * 128, G_BBYTES = G_BN * 128, G_STAGE = G_ABYTES + G_BBYTES;

__device__ __forceinline__ void gemm_mainloop(const u16* __restrict__ A, int lda, const u16* __restrict__ Bt, int ldb, int K,
                                              int m0, int n0, unsigned char* smem, f32x4 (&acc)[4][4]) {
  const int tid = threadIdx.x, lane = tid & 63, wave = tid >> 6;
  const int wm = wave >> 1, wn = wave & 1;
#pragma unroll
  for (int i = 0; i < 4; ++i)
#pragma unroll
    for (int j = 0; j < 4; ++j) acc[i][j] = (f32x4){0.f, 0.f, 0.f, 0.f};
  const int kc = tid & 7;
  const int arow = tid >> 3;
  u32x4 ra[4], rb[2];
  const u16* ap = A + (size_t)(m0 + arow) * lda + kc * 8;
  const u16* bp = Bt + (size_t)(n0 + arow) * ldb + kc * 8;
  const int nk = K / G_BK;
#pragma unroll
  for (int i = 0; i < 4; ++i) ra[i] = *(const u32x4*)(ap + (size_t)(64 * i) * lda);
#pragma unroll
  for (int i = 0; i < 2; ++i) rb[i] = *(const u32x4*)(bp + (size_t)(64 * i) * ldb);
  __syncthreads();
  {
    unsigned char* sa = smem;
    unsigned char* sb = smem + G_ABYTES;
#pragma unroll
    for (int i = 0; i < 4; ++i) { int r = arow + 64 * i; *(u32x4*)(sa + r * 128 + ((kc ^ (r & 7)) << 4)) = ra[i]; }
#pragma unroll
    for (int i = 0; i < 2; ++i) { int r = arow + 64 * i; *(u32x4*)(sb + r * 128 + ((kc ^ (r & 7)) << 4)) = rb[i]; }
  }
  __syncthreads();
  const int fr = lane & 15, fg = lane >> 4;
  for (int kt = 0; kt < nk; ++kt) {
    if (kt + 1 < nk) {
      const u16* ap2 = ap + (size_t)(kt + 1) * G_BK;
      const u16* bp2 = bp + (size_t)(kt + 1) * G_BK;
#pragma unroll
      for (int i = 0; i < 4; ++i) ra[i] = *(const u32x4*)(ap2 + (size_t)(64 * i) * lda);
#pragma unroll
      for (int i = 0; i < 2; ++i) rb[i] = *(const u32x4*)(bp2 + (size_t)(64 * i) * ldb);
    }
    const unsigned char* sa = smem + (kt & 1) * G_STAGE;
    const unsigned char* sb = sa + G_ABYTES;
#pragma unroll
    for (int kk = 0; kk < 2; ++kk) {
      bf16x8 af[4], bfr[4];
#pragma unroll
      for (int i = 0; i < 4; ++i) {
        int r = wm * 64 + i * 16 + fr;
        af[i] = *(const bf16x8*)(sa + r * 128 + (((kk * 4 + fg) ^ (r & 7)) << 4));
      }
#pragma unroll
      for (int j = 0; j < 4; ++j) {
        int r = wn * 64 + j * 16 + fr;
        bfr[j] = *(const bf16x8*)(sb + r * 128 + (((kk * 4 + fg) ^ (r & 7)) << 4));
      }
#pragma unroll
      for (int i = 0; i < 4; ++i)
#pragma unroll
        for (int j = 0; j < 4; ++j) acc[i][j] = __builtin_amdgcn_mfma_f32_16x16x32_bf16(af[i], bfr[j], acc[i][j], 0, 0, 0);
    }
    if (kt + 1 < nk) {
      unsigned char* sa2 = smem + ((kt + 1) & 1) * G_STAGE;
      unsigned char* sb2 = sa2 + G_ABYTES;
#pragma unroll
      for (int i = 0; i < 4; ++i) { int r = arow + 64 * i; *(u32x4*)(sa2 + r * 128 + ((kc ^ (r & 7)) << 4)) = ra[i]; }
#pragma unroll
      for (int i = 0; i < 2; ++i) { int r = arow + 64 * i; *(u32x4*)(sb2 + r * 128 + ((kc ^ (r & 7)) << 4)) = rb[i]; }
    }
    __syncthreads();
  }
}

__device__ void phase1(const Params& p, unsigned char* smem) {
  const u16* H = (const u16*)(p.ws + OFF_H);
  const u16* WT = (const u16*)(p.ws + OFF_WTIN);
  u16* PROJ = (u16*)(p.ws + OFF_PROJ);
  float* SMALL = (float*)(p.ws + OFF_SMALL);
  const int lane = threadIdx.x & 63, wave = threadIdx.x >> 6;
  const int wm = wave >> 1, wn = wave & 1, fr = lane & 15, fg = lane >> 4;
  const int ntn = NPADW / G_BN;
  const int ntiles = (MTOK / G_BM) * ntn;
  for (int t = blockIdx.x; t < ntiles; t += gridDim.x) {
    const int m0 = (t / ntn) * G_BM, n0 = (t % ntn) * G_BN;
    f32x4 acc[4][4];
    gemm_mainloop(H, DM, WT, DM, DM, m0, n0, smem, acc);
    const int cbase = n0 + wn * 64;
    const u32 rb0 = (u32)(m0 + wm * 64 + 4 * fg) * LDP + (u32)(cbase + fr);
    const u32 sb0 = (u32)(m0 + wm * 64 + 4 * fg) * 16 + (u32)(cbase + fr - LDP);
    if (cbase < C_AV) {
      const float* gain = (cbase < C_AK) ? p.in[3] : p.in[4];
      const float extra = (cbase < C_AK) ? 0.125f : 1.0f;
      float gj[4];
#pragma unroll
      for (int j = 0; j < 4; ++j) gj[j] = gain[j * 16 + fr] * extra;
#pragma unroll
      for (int i = 0; i < 4; ++i) {
        float ss[4];
#pragma unroll
        for (int r = 0; r < 4; ++r) {
          float s = 0.f;
#pragma unroll
          for (int j = 0; j < 4; ++j) s += acc[i][j][r] * acc[i][j][r];
          s += __shfl_xor(s, 1); s += __shfl_xor(s, 2); s += __shfl_xor(s, 4); s += __shfl_xor(s, 8);
          ss[r] = rsqrtf(s * (1.f / 64.f) + EPS);
        }
#pragma unroll
        for (int j = 0; j < 4; ++j)
#pragma unroll
          for (int r = 0; r < 4; ++r) {
            PROJ[rb0 + (u32)((i * 16 + r) * LDP + j * 16)] = f2bf(acc[i][j][r] * ss[r] * gj[j]);
          }
      }
    } else {
#pragma unroll
      for (int i = 0; i < 4; ++i)
#pragma unroll
        for (int j = 0; j < 4; ++j) {
          int col = cbase + j * 16 + fr;
#pragma unroll
          for (int r = 0; r < 4; ++r) {
            if (col < LDP) PROJ[rb0 + (u32)((i * 16 + r) * LDP + j * 16)] = f2bf(acc[i][j][r]);
            else if (col < LDP + 16) SMALL[sb0 + (u32)((i * 16 + r) * 16 + j * 16)] = acc[i][j][r];
          }
        }
    }
  }
}

constexpr int IDX_RS = 8208;

__device__ __forceinline__ u32 f2key(float x) {
  _Float16 h = (_Float16)x;
  u32 b = (u32) * (u16*)&h;
  return (b & 0x8000u) ? ((~b) & 0xffffu) : (b | 0x8000u);
}
__device__ __forceinline__ int count_ge(const u32 (&kreg)[32], u32 mid) {
  int c = 0;
#pragma unroll
  for (int i = 0; i < 32; ++i) {
    c += ((kreg[i] & 0xffffu) >= mid) ? 1 : 0;
    c += ((kreg[i] >> 16) >= mid) ? 1 : 0;
  }
  return c;
}
__device__ __forceinline__ int wave_sum_i(int v) {
#pragma unroll
  for (int o = 32; o > 0; o >>= 1) v += __shfl_xor(v, o);
  return v;
}

__device__ void idx_item(const Params& p, unsigned char* smem, int b, int tq) {
  const u16* PROJ = (const u16*)(p.ws + OFF_PROJ);
  const float* SMALL = (const float*)(p.ws + OFF_SMALL);
  u16* SEL = (u16*)(p.ws + OFF_SEL);
  const int tid = threadIdx.x, lane = tid & 63, wave = tid >> 6;
  const int t0 = tq * 16;
  const size_t tokb = (size_t)b * SEQ;
  if (tq < 16) {
    for (int rr = 0; rr < 2; ++rr) {
      int row = 2 * wave + rr, t = t0 + row;
      u16* out = SEL + (tokb + t) * 256;
      for (int i = lane; i < 256; i += 64) out[i] = (i <= t) ? (u16)i : (u16)0xFFFF;
    }
    return;
  }
  const int q = lane & 15, g = lane >> 4;
  __syncthreads();
  {
    const u16* iqrow = PROJ + (tokb + t0 + q) * LDP + C_IQ;
    bf16x8 bq[8][2];
    float wq[8];
#pragma unroll
    for (int h = 0; h < 8; ++h) {
      bq[h][0] = *(const bf16x8*)(iqrow + h * 64 + g * 8);
      bq[h][1] = *(const bf16x8*)(iqrow + h * 64 + 32 + g * 8);
      wq[h] = SMALL[(tokb + t0 + q) * 16 + h];
    }
    const int nkb = tq + 1;
    for (int kb = wave; kb < nkb; kb += 8) {
      const int s0 = kb * 16;
      const u16* ikrow = PROJ + (tokb + s0 + q) * LDP + C_IK;
      bf16x8 a0 = *(const bf16x8*)(ikrow + g * 8);
      bf16x8 a1 = *(const bf16x8*)(ikrow + 32 + g * 8);
      f32x4 tot = {0.f, 0.f, 0.f, 0.f};
#pragma unroll
      for (int h = 0; h < 8; ++h) {
        f32x4 acc = {0.f, 0.f, 0.f, 0.f};
        acc = __builtin_amdgcn_mfma_f32_16x16x32_bf16(a0, bq[h][0], acc, 0, 0, 0);
        acc = __builtin_amdgcn_mfma_f32_16x16x32_bf16(a1, bq[h][1], acc, 0, 0, 0);
#pragma unroll
        for (int r = 0; r < 4; ++r) tot[r] += wq[h] * fmaxf(acc[r], 0.f);
      }
      u32 k[4];
#pragma unroll
      for (int r = 0; r < 4; ++r) {
        int s = s0 + 4 * g + r;
        k[r] = (s <= t0 + q) ? f2key(tot[r]) : 0u;
      }
      uint2 w2 = make_uint2(k[0] | (k[1] << 16), k[2] | (k[3] << 16));
      *(uint2*)(smem + q * IDX_RS + (s0 + 4 * g) * 2) = w2;
    }
    const int nk = t0 + 16, nk64 = (nk + 63) & ~63;
    for (int i = tid; i < 16 * (nk64 - nk); i += NTHREADS) {
      int row = i / (nk64 - nk), c = nk + i % (nk64 - nk);
      *(u16*)(smem + row * IDX_RS + c * 2) = 0;
    }
  }
  __syncthreads();
  const int nk64 = (t0 + 16 + 63) & ~63;
  for (int rr = 0; rr < 2; ++rr) {
    const int row = 2 * wave + rr, t = t0 + row;
    u16* out = SEL + (tokb + t) * 256;
    u32 kreg[32];
    if (lane * 64 < nk64) {
      const uint4* src = (const uint4*)(smem + row * IDX_RS + lane * 128);
#pragma unroll
      for (int i = 0; i < 8; ++i) {
        uint4 v = src[i];
        kreg[4 * i] = v.x; kreg[4 * i + 1] = v.y; kreg[4 * i + 2] = v.z; kreg[4 * i + 3] = v.w;
      }
    } else {
#pragma unroll
      for (int i = 0; i < 32; ++i) kreg[i] = 0u;
    }
    u32 lo = 1u, hi = 65535u;
    while (lo < hi) {
      u32 mid = (lo + hi + 1u) >> 1;
      int c = wave_sum_i(count_ge(kreg, mid));
      if (c >= 256) lo = mid; else hi = mid - 1u;
    }
    const u32 tau = lo;
    int gt = 0, eq = 0;
#pragma unroll
    for (int i = 0; i < 32; ++i) {
      u32 a = kreg[i] & 0xffffu, c2 = kreg[i] >> 16;
      gt += (a > tau) ? 1 : 0; gt += (c2 > tau) ? 1 : 0;
      eq += (a == tau) ? 1 : 0; eq += (c2 == tau) ? 1 : 0;
    }
    int packed = gt | (eq << 16);
    int incl = packed;
#pragma unroll
    for (int o = 1; o < 64; o <<= 1) {
      int v = __shfl_up(incl, o);
      if (lane >= o) incl += v;
    }
    const int excl = incl - packed;
    const int total = __shfl(incl, 63);
    const int need = 256 - (total & 0xffff);
    const int pg = excl & 0xffff, pe = excl >> 16;
    int pos = pg + min(pe, need);
    int eqseen = pe;
#pragma unroll
    for (int i = 0; i < 32; ++i) {
#pragma unroll
      for (int hh = 0; hh < 2; ++hh) {
        u32 kv = hh ? (kreg[i] >> 16) : (kreg[i] & 0xffffu);
        int idx = lane * 64 + 2 * i + hh;
        bool take = false;
        if (kv > tau) take = true;
        else if (kv == tau) { take = (eqseen < need); ++eqseen; }
        if (take) { out[pos] = (u16)idx; ++pos; }
      }
    }
  }
}

constexpr int DNP = 68;
__device__ void dn_local_item(const Params& p, unsigned char* smem, int item) {
  const int h = item & 3, n = (item >> 2) & 63, b = item >> 8;
  const u16* PROJ = (const u16*)(p.ws + OFF_PROJ);
  const float* SMALL = (const float*)(p.ws + OFF_SMALL);
  u16* Ug = (u16*)((unsigned char*)p.out + DO_U);
  u16* Wg = (u16*)((unsigned char*)p.out + DO_W);
  u16* QNg = (u16*)((unsigned char*)p.out + DO_QN);
  u16* KNTg = (u16*)((unsigned char*)p.out + DO_KNT);
  u16* ATTg = (u16*)(p.ws + OFF_ATT);
  float* GCg = (float*)(p.ws + OFF_GC);
  const float* convw = p.in[5];
  const int tid = threadIdx.x, lane = tid & 63;
  const int c0 = n * 64;
  const size_t tok0 = (size_t)b * SEQ + c0;
  float* Qt = (float*)smem;
  float* Kt = Qt + 128 * DNP;
  float* V = Kt + 128 * DNP;
  float* AmT = V + 64 * 128;
  float* gc = AmT + 64 * 64;
  float* beta = gc + 64;
  float* qs = beta + 64;
  float* ks = qs + 64;
  __syncthreads();
  {
    const int c = tid & 127, tg = tid >> 7;
#pragma unroll
    for (int arr = 0; arr < 3; ++arr) {
      const int colp = (arr == 0 ? C_DQ : (arr == 1 ? C_DK : C_DV)) + h * 128 + c;
      float w0 = convw[0 * 1536 + arr * 512 + h * 128 + c], w1 = convw[1 * 1536 + arr * 512 + h * 128 + c],
            w2 = convw[2 * 1536 + arr * 512 + h * 128 + c], w3 = convw[3 * 1536 + arr * 512 + h * 128 + c];
      float x0, x1, x2;
      {
        int i = tg * 16;
        x0 = (c0 + i - 3 >= 0) ? bf2f(PROJ[(tok0 + i - 3) * LDP + colp]) : 0.f;
        x1 = (c0 + i - 2 >= 0) ? bf2f(PROJ[(tok0 + i - 2) * LDP + colp]) : 0.f;
        x2 = (c0 + i - 1 >= 0) ? bf2f(PROJ[(tok0 + i - 1) * LDP + colp]) : 0.f;
      }
#pragma unroll 2
      for (int ii = 0; ii < 16; ++ii) {
        int i = tg * 16 + ii;
        float x3 = bf2f(PROJ[(tok0 + i) * LDP + colp]);
        float y = w0 * x0 + w1 * x1 + w2 * x2 + w3 * x3;
        float s = y / (1.f + __expf(-y));
        if (arr == 0) Qt[c * DNP + i] = s;
        else if (arr == 1) Kt[c * DNP + i] = s;
        else V[i * 128 + c] = s;
        x0 = x1; x1 = x2; x2 = x3;
      }
    }
  }
  if (tid < 64) {
    float da = SMALL[(tok0 + tid) * 16 + 8 + h], db = SMALL[(tok0 + tid) * 16 + 12 + h];
    float xx = da + p.in[7][h];
    float sp = fmaxf(xx, 0.f) + log1pf(__expf(-fabsf(xx)));
    float gr = -__expf(p.in[6][h]) * sp;
    float incl = gr;
#pragma unroll
    for (int o = 1; o < 64; o <<= 1) {
      float v = __shfl_up(incl, o);
      if (lane >= o) incl += v;
    }
    gc[tid] = incl;
    beta[tid] = sigmoidf_(db);
    GCg[(tok0 + tid) * 4 + h] = incl;
  }
  __syncthreads();
  {
    const int arr = tid >> 8, i = (tid & 255) >> 2, part = tid & 3;
    const float* src = arr ? Kt : Qt;
    float ss = 0.f;
#pragma unroll 4
    for (int c = part * 32; c < part * 32 + 32; ++c) { float v = src[c * DNP + i]; ss += v * v; }
    ss += __shfl_xor(ss, 1); ss += __shfl_xor(ss, 2);
    if (part == 0) {
      if (arr == 0) qs[i] = rsqrtf(ss + EPS) * 0.08838834764831845f;
      else ks[i] = rsqrtf(ss + EPS);
    }
  }
  __syncthreads();
#pragma unroll 2
  for (int e = tid; e < 128 * 64; e += NTHREADS) {
    int c = e >> 6, i = e & 63;
    Qt[c * DNP + i] *= qs[i];
    Kt[c * DNP + i] *= ks[i];
  }
  __syncthreads();
#pragma unroll 2
  for (int e = tid; e < 64 * 128; e += NTHREADS) {
    int i = e >> 7, d = e & 127;
    QNg[(tok0 + i) * 512 + h * 128 + perm32(d)] = f2bf(Qt[d * DNP + i]);
  }
#pragma unroll 2
  for (int e = tid; e < 128 * 64; e += NTHREADS) {
    int d = e >> 6, i = e & 63;
    KNTg[(size_t)item * 8192 + d * 64 + perm32(i)] = f2bf(Kt[d * DNP + i]);
  }
  {
    const int mat = tid >> 8, bi = (tid & 255) >> 4, bj = tid & 15;
    const int i0 = 4 * bi, j0 = 4 * bj;
    if (j0 <= i0 + 3) {
      const float* Aop = mat ? Qt : Kt;
      float acc[4][4];
#pragma unroll
      for (int x = 0; x < 4; ++x)
#pragma unroll
        for (int y = 0; y < 4; ++y) acc[x][y] = 0.f;
#pragma unroll 4
      for (int d = 0; d < 128; ++d) {
        float4 a4 = *(const float4*)(Aop + d * DNP + i0);
        float4 b4 = *(const float4*)(Kt + d * DNP + j0);
        float av[4] = {a4.x, a4.y, a4.z, a4.w}, bv[4] = {b4.x, b4.y, b4.z, b4.w};
#pragma unroll
        for (int x = 0; x < 4; ++x)
#pragma unroll
          for (int y = 0; y < 4; ++y) acc[x][y] += av[x] * bv[y];
      }
#pragma unroll
      for (int x = 0; x < 4; ++x)
#pragma unroll
        for (int y = 0; y < 4; ++y) {
          int i = i0 + x, j = j0 + y;
          float dec = __expf(gc[i] - gc[j]);
          if (mat == 0) AmT[j * 64 + i] = (i > j) ? beta[i] * acc[x][y] * dec : 0.f;
          else ATTg[(size_t)item * 4096 + i * 64 + perm32(j)] = f2bf((i >= j) ? acc[x][y] * dec : 0.f);
        }
    } else {
#pragma unroll
      for (int x = 0; x < 4; ++x)
#pragma unroll
        for (int y = 0; y < 4; ++y) {
          int i = i0 + x, j = j0 + y;
          if (mat == 0) AmT[j * 64 + i] = 0.f;
          else ATTg[(size_t)item * 4096 + i * 64 + perm32(j)] = 0;
        }
    }
  }
  __syncthreads();
  if (tid < 256) {
    const int c = tid;
    const bool isu = c < 128;
    const int cc = c & 127;
    const int pc = perm32(cc);
#pragma unroll 1
    for (int ib = 0; ib < 4; ++ib) {
      float sreg[16];
#pragma unroll
      for (int r = 0; r < 16; ++r) {
        int i = ib * 16 + r;
        sreg[r] = isu ? V[i * 128 + cc] * beta[i] : Kt[cc * DNP + i] * beta[i] * __expf(gc[i]);
      }
#pragma unroll 2
      for (int j = 0; j < ib * 16; ++j) {
        float xj = isu ? V[j * 128 + cc] : Kt[cc * DNP + j];
        const f32x4* ap = (const f32x4*)(AmT + j * 64 + ib * 16);
        f32x4 a0 = ap[0], a1 = ap[1], a2 = ap[2], a3 = ap[3];
        sreg[0] -= a0[0] * xj; sreg[1] -= a0[1] * xj; sreg[2] -= a0[2] * xj; sreg[3] -= a0[3] * xj;
        sreg[4] -= a1[0] * xj; sreg[5] -= a1[1] * xj; sreg[6] -= a1[2] * xj; sreg[7] -= a1[3] * xj;
        sreg[8] -= a2[0] * xj; sreg[9] -= a2[1] * xj; sreg[10] -= a2[2] * xj; sreg[11] -= a2[3] * xj;
        sreg[12] -= a3[0] * xj; sreg[13] -= a3[1] * xj; sreg[14] -= a3[2] * xj; sreg[15] -= a3[3] * xj;
      }
#pragma unroll
      for (int q = 0; q < 15; ++q) {
        const float* ar = AmT + (ib * 16 + q) * 64 + ib * 16;
#pragma unroll
        for (int r = q + 1; r < 16; ++r) sreg[r] -= ar[r] * sreg[q];
      }
#pragma unroll
      for (int r = 0; r < 16; ++r) {
        int i = ib * 16 + r;
        if (isu) { V[i * 128 + cc] = sreg[r]; Ug[(tok0 + i) * 512 + h * 128 + cc] = f2bf(sreg[r]); }
        else { Kt[cc * DNP + i] = sreg[r]; Wg[(tok0 + i) * 512 + h * 128 + pc] = f2bf(sreg[r]); }
      }
    }
  }
}

__device__ void phase2(const Params& p, unsigned char* smem) {
#ifndef NO_IDX
  for (int i = blockIdx.x; i < 2048; i += gridDim.x) idx_item(p, smem, i & 7, 255 - (i >> 3));
#endif
#ifndef NO_DNL
  for (int i = blockIdx.x; i < 2048; i += gridDim.x) dn_local_item(p, smem, i);
#endif
}

constexpr int SC_WP = 272, SC_KP = 144;
constexpr int SC_W = 0, SC_Q = 64 * SC_WP, SC_KT = 2 * 64 * SC_WP, SC_AT = SC_KT + 128 * SC_KP, SC_BUF = SC_AT + 64 * SC_KP;
constexpr int SC_SSQ = 2 * SC_BUF;
constexpr int SC_GC = SC_SSQ + 8 * 64 * 4;

__device__ void dn_scan_item(const Params& p, unsigned char* smem, int bh) {
  const int h = bh & 3, b = bh >> 2;
  const u16* Ug = (const u16*)((const unsigned char*)p.out + DO_U);
  const u16* Wg = (const u16*)((const unsigned char*)p.out + DO_W);
  const u16* QNg = (const u16*)((const unsigned char*)p.out + DO_QN);
  const u16* KNTg = (const u16*)((const unsigned char*)p.out + DO_KNT);
  const u16* ATTg = (const u16*)(p.ws + OFF_ATT);
  const float* GCg = (const float*)(p.ws + OFF_GC);
  const u16* PROJ = (const u16*)(p.ws + OFF_PROJ);
  u16* YDN = (u16*)(p.ws + OFF_YDN);
  const float* ogain = p.in[8];
  const int tid = threadIdx.x, lane = tid & 63, wave = tid >> 6;
  const int fr = lane & 15, fg = lane >> 4;
  const int ecol = wave * 16 + fr;
  const float gn = ogain[ecol];
  float* ssq = (float*)(smem + SC_SSQ);
  float* gcs = (float*)(smem + SC_GC);
  f32x4 S[8];
#pragma unroll
  for (int d = 0; d < 8; ++d) S[d] = (f32x4){0.f, 0.f, 0.f, 0.f};
  u32x4 st[7];
  float gcr = 0.f;
  auto load_step = [&](int n) {
    const size_t tok0 = (size_t)b * SEQ + n * 64;
    const int item = (b * 64 + n) * 4 + h;
#pragma unroll
    for (int k = 0; k < 7; ++k) {
      int c = tid + 512 * k;
      const u16* src;
      if (c < 1024) { int row = c >> 4, ch = c & 15; src = Wg + (tok0 + row) * 512 + h * 128 + ch * 8; }
      else if (c < 2048) { int cc = c - 1024; int row = cc >> 4, ch = cc & 15; src = QNg + (tok0 + row) * 512 + h * 128 + ch * 8; }
      else if (c < 3072) { int cc = c - 2048; src = KNTg + (size_t)item * 8192 + cc * 8; }
      else { int cc = c - 3072; src = ATTg + (size_t)item * 4096 + cc * 8; }
      st[k] = *(const u32x4*)src;
    }
    if (tid < 64) gcr = GCg[(tok0 + tid) * 4 + h];
  };
  auto store_step = [&](int buf) {
    unsigned char* base = smem + buf * SC_BUF;
#pragma unroll
    for (int k = 0; k < 7; ++k) {
      int c = tid + 512 * k;
      unsigned char* dst;
      if (c < 1024) { int row = c >> 4, ch = c & 15; dst = base + SC_W + row * SC_WP + ch * 16; }
      else if (c < 2048) { int cc = c - 1024; int row = cc >> 4, ch = cc & 15; dst = base + SC_Q + row * SC_WP + ch * 16; }
      else if (c < 3072) { int cc = c - 2048; int row = cc >> 3, ch = cc & 7; dst = base + SC_KT + row * SC_KP + ch * 16; }
      else { int cc = c - 3072; int row = cc >> 3, ch = cc & 7; dst = base + SC_AT + row * SC_KP + ch * 16; }
      *(u32x4*)dst = st[k];
    }
    if (tid < 64) gcs[buf * 64 + tid] = gcr;
  };
  __syncthreads();
  load_step(0);
  store_step(0);
  __syncthreads();
  for (int n = 0; n < 64; ++n) {
    const int buf = n & 1;
    const size_t tok0 = (size_t)b * SEQ + n * 64;
    if (n + 1 < 64) load_step(n + 1);
    const unsigned char* base = smem + buf * SC_BUF;
    const u32 ub0 = (u32)(tok0 + 4 * fg) * 512 + (u32)(h * 128 + ecol);
    float uval[4][4];
#pragma unroll
    for (int m = 0; m < 4; ++m)
#pragma unroll
      for (int r = 0; r < 4; ++r) uval[m][r] = bf2f(Ug[ub0 + (u32)((m * 16 + r) * 512)]);
    const float* gcb = gcs + buf * 64 + 4 * fg;
    const float glast = gcs[buf * 64 + 63];
    bf16x8 Sb[4];
#pragma unroll
    for (int kk = 0; kk < 4; ++kk) {
      union { u32 w[4]; bf16x8 v; } cv;
      cv.w[0] = pack2(S[2 * kk][0], S[2 * kk][1]); cv.w[1] = pack2(S[2 * kk][2], S[2 * kk][3]);
      cv.w[2] = pack2(S[2 * kk + 1][0], S[2 * kk + 1][1]); cv.w[3] = pack2(S[2 * kk + 1][2], S[2 * kk + 1][3]);
      Sb[kk] = cv.v;
    }
    f32x4 vnew[4], ov[4];
#pragma unroll
    for (int m = 0; m < 4; ++m) {
      f32x4 aw = {0.f, 0.f, 0.f, 0.f}, aq = {0.f, 0.f, 0.f, 0.f};
#pragma unroll
      for (int kk = 0; kk < 4; ++kk) {
        bf16x8 wf = *(const bf16x8*)(base + SC_W + (m * 16 + fr) * SC_WP + kk * 64 + fg * 16);
        bf16x8 qf = *(const bf16x8*)(base + SC_Q + (m * 16 + fr) * SC_WP + kk * 64 + fg * 16);
        aw = __builtin_amdgcn_mfma_f32_16x16x32_bf16(wf, Sb[kk], aw, 0, 0, 0);
        aq = __builtin_amdgcn_mfma_f32_16x16x32_bf16(qf, Sb[kk], aq, 0, 0, 0);
      }
      f32x4 g4 = *(const f32x4*)(gcb + m * 16);
#pragma unroll
      for (int r = 0; r < 4; ++r) { vnew[m][r] = uval[m][r] - aw[r]; ov[m][r] = aq[r] * __expf(g4[r]); }
    }
    bf16x8 vb[2], vsb[2];
#pragma unroll
    for (int k2 = 0; k2 < 2; ++k2) {
      union { u32 w[4]; bf16x8 v; } c1, c2;
      const int ma = 2 * k2, mb = 2 * k2 + 1;
      c1.w[0] = pack2(vnew[ma][0], vnew[ma][1]); c1.w[1] = pack2(vnew[ma][2], vnew[ma][3]);
      c1.w[2] = pack2(vnew[mb][0], vnew[mb][1]); c1.w[3] = pack2(vnew[mb][2], vnew[mb][3]);
      f32x4 ga4 = *(const f32x4*)(gcb + ma * 16), gb4 = *(const f32x4*)(gcb + mb * 16);
      float sa[4], sb2[4];
#pragma unroll
      for (int r = 0; r < 4; ++r) { sa[r] = vnew[ma][r] * __expf(glast - ga4[r]); sb2[r] = vnew[mb][r] * __expf(glast - gb4[r]); }
      c2.w[0] = pack2(sa[0], sa[1]); c2.w[1] = pack2(sa[2], sa[3]);
      c2.w[2] = pack2(sb2[0], sb2[1]); c2.w[3] = pack2(sb2[2], sb2[3]);
      vb[k2] = c1.v; vsb[k2] = c2.v;
    }
#pragma unroll
    for (int m = 0; m < 4; ++m) {
      f32x4 ao = ov[m];
#pragma unroll
      for (int k2 = 0; k2 < 2; ++k2) {
        bf16x8 af = *(const bf16x8*)(base + SC_AT + (m * 16 + fr) * SC_KP + k2 * 64 + fg * 16);
        ao = __builtin_amdgcn_mfma_f32_16x16x32_bf16(af, vb[k2], ao, 0, 0, 0);
      }
      ov[m] = ao;
#pragma unroll
      for (int r = 0; r < 4; ++r) {
        float sq = ao[r] * ao[r];
        sq += __shfl_xor(sq, 1); sq += __shfl_xor(sq, 2); sq += __shfl_xor(sq, 4); sq += __shfl_xor(sq, 8);
        if (fr == 0) ssq[wave * 64 + m * 16 + 4 * fg + r] = sq;
      }
    }
    const float egl = __expf(glast);
#pragma unroll
    for (int d = 0; d < 8; ++d) {
      f32x4 a = S[d] * egl;
#pragma unroll
      for (int k2 = 0; k2 < 2; ++k2) {
        bf16x8 kf = *(const bf16x8*)(base + SC_KT + (d * 16 + fr) * SC_KP + k2 * 64 + fg * 16);
        a = __builtin_amdgcn_mfma_f32_16x16x32_bf16(kf, vsb[k2], a, 0, 0, 0);
      }
      S[d] = a;
    }
    if (n + 1 < 64) store_step(buf ^ 1);
    __syncthreads();
    {
      const u32 zb0 = (u32)(tok0 + 4 * fg) * LDP + (u32)(C_DZ + h * 128 + ecol);
#pragma unroll
      for (int m = 0; m < 4; ++m)
#pragma unroll
        for (int r = 0; r < 4; ++r) {
          int tk = m * 16 + 4 * fg + r;
          float tot = 0.f;
#pragma unroll
          for (int w = 0; w < 8; ++w) tot += ssq[w * 64 + tk];
          float rstd = rsqrtf(tot * (1.f / 128.f) + EPS);
          float z = bf2f(PROJ[zb0 + (u32)((m * 16 + r) * LDP)]);
          float y = ov[m][r] * rstd * gn * z * sigmoidf_(z);
          YDN[ub0 + (u32)((m * 16 + r) * 512)] = f2bf(y);
        }
    }
    __syncthreads();
  }
}

constexpr int AT_WAVE_BYTES = 2048 + 8192 + 512;
__device__ void attn_query(const Params& p, unsigned char* wsm, int b, int t) {
  const u16* PROJ = (const u16*)(p.ws + OFF_PROJ);
  const u16* SEL = (const u16*)(p.ws + OFF_SEL);
  u16* YATT = (u16*)(p.ws + OFF_YATT);
  const int lane = threadIdx.x & 63;
  float* qs = (float*)wsm;
  float* P = (float*)(wsm + 2048);
  u16* sl = (u16*)(wsm + 2048 + 8192);
  const size_t tokb = (size_t)b * SEQ;
  const size_t tok = tokb + t;
  const int nsel = min(256, t + 1);
  {
    const u16* qrow = PROJ + tok * LDP + C_AQ;
    uint4 v = *(const uint4*)(qrow + lane * 8);
    float* d = qs + lane * 8;
    d[0] = bflo(v.x); d[1] = bfhi(v.x); d[2] = bflo(v.y); d[3] = bfhi(v.y);
    d[4] = bflo(v.z); d[5] = bfhi(v.z); d[6] = bflo(v.w); d[7] = bfhi(v.w);
    const u16* sr = SEL + tok * 256;
#pragma unroll
    for (int i = 0; i < 4; ++i) sl[lane + 64 * i] = sr[lane + 64 * i];
  }
  WAVE_LDS_SYNC();
#pragma unroll 1
  for (int i = 0; i < 4; ++i) {
    const int ki = lane + 64 * i;
    const bool valid = ki < nsel;
    const int s = valid ? (int)sl[ki] : 0;
    const u16* krow = PROJ + (tokb + s) * LDP + C_AK;
#pragma unroll 1
    for (int g = 0; g < 2; ++g) {
      float a0 = 0.f, a1 = 0.f, a2 = 0.f, a3 = 0.f;
#pragma unroll 2
      for (int c = 0; c < 8; ++c) {
        u32x4 kv = *(const u32x4*)(krow + g * 64 + c * 8);
        float kf[8] = {bflo(kv[0]), bfhi(kv[0]), bflo(kv[1]), bfhi(kv[1]), bflo(kv[2]), bfhi(kv[2]), bflo(kv[3]), bfhi(kv[3])};
#pragma unroll
        for (int e = 0; e < 8; e += 4) {
          f32x4 q0 = *(const f32x4*)(qs + (g * 4 + 0) * 64 + c * 8 + e);
          f32x4 q1 = *(const f32x4*)(qs + (g * 4 + 1) * 64 + c * 8 + e);
          f32x4 q2 = *(const f32x4*)(qs + (g * 4 + 2) * 64 + c * 8 + e);
          f32x4 q3 = *(const f32x4*)(qs + (g * 4 + 3) * 64 + c * 8 + e);
          a0 += q0[0] * kf[e] + q0[1] * kf[e + 1] + q0[2] * kf[e + 2] + q0[3] * kf[e + 3];
          a1 += q1[0] * kf[e] + q1[1] * kf[e + 1] + q1[2] * kf[e + 2] + q1[3] * kf[e + 3];
          a2 += q2[0] * kf[e] + q2[1] * kf[e + 1] + q2[2] * kf[e + 2] + q2[3] * kf[e + 3];
          a3 += q3[0] * kf[e] + q3[1] * kf[e + 1] + q3[2] * kf[e + 2] + q3[3] * kf[e + 3];
        }
      }
      f32x4 r4;
      r4[0] = valid ? a0 : -1e30f; r4[1] = valid ? a1 : -1e30f; r4[2] = valid ? a2 : -1e30f; r4[3] = valid ? a3 : -1e30f;
      *(f32x4*)(P + ki * 8 + g * 4) = r4;
    }
  }
  WAVE_LDS_SYNC();
  float lg[4][8];
#pragma unroll
  for (int i = 0; i < 4; ++i) {
    f32x4 x0 = *(const f32x4*)(P + (lane + 64 * i) * 8), x1 = *(const f32x4*)(P + (lane + 64 * i) * 8 + 4);
    lg[i][0] = x0[0]; lg[i][1] = x0[1]; lg[i][2] = x0[2]; lg[i][3] = x0[3];
    lg[i][4] = x1[0]; lg[i][5] = x1[1]; lg[i][6] = x1[2]; lg[i][7] = x1[3];
  }
#pragma unroll
  for (int hh = 0; hh < 8; ++hh) {
    float m = fmaxf(fmaxf(lg[0][hh], lg[1][hh]), fmaxf(lg[2][hh], lg[3][hh]));
    m = wave_max(m);
    float e[4], s = 0.f;
#pragma unroll
    for (int i = 0; i < 4; ++i) { e[i] = __expf(lg[i][hh] - m); s += e[i]; }
    s = wave_sum(s);
    float inv = 1.f / s;
#pragma unroll
    for (int i = 0; i < 4; ++i) lg[i][hh] = e[i] * inv;
  }
#pragma unroll
  for (int i = 0; i < 4; ++i) {
    float* d = P + (lane + 64 * i) * 8;
    *(f32x4*)d = (f32x4){lg[i][0], lg[i][1], lg[i][2], lg[i][3]};
    *(f32x4*)(d + 4) = (f32x4){lg[i][4], lg[i][5], lg[i][6], lg[i][7]};
  }
  WAVE_LDS_SYNC();
  const int g = lane >> 5, d2 = (lane & 31) * 2;
  float o[4][2];
#pragma unroll
  for (int hh = 0; hh < 4; ++hh) { o[hh][0] = 0.f; o[hh][1] = 0.f; }
  for (int k = 0; k < nsel; ++k) {
    const int s = (int)sl[k];
    u32 vv = *(const u32*)(PROJ + (tokb + s) * LDP + C_AV + g * 64 + d2);
    float v0 = bflo(vv), v1 = bfhi(vv);
    f32x4 pw = *(const f32x4*)(P + k * 8 + g * 4);
    o[0][0] += pw[0] * v0; o[0][1] += pw[0] * v1;
    o[1][0] += pw[1] * v0; o[1][1] += pw[1] * v1;
    o[2][0] += pw[2] * v0; o[2][1] += pw[2] * v1;
    o[3][0] += pw[3] * v0; o[3][1] += pw[3] * v1;
  }
#pragma unroll
  for (int hh = 0; hh < 4; ++hh)
    *(u32*)(YATT + tok * 512 + (g * 4 + hh) * 64 + d2) = pack2(o[hh][0], o[hh][1]);
  WAVE_LDS_SYNC();
}

__device__ void phase3(const Params& p, unsigned char* smem) {
  const int wave = threadIdx.x >> 6;
#ifndef NO_SCAN
  if (blockIdx.x < 32) {
    dn_scan_item(p, smem, blockIdx.x);
    return;
  }
#endif
#ifdef NO_ATTN
  return;
#endif
  const int G = gridDim.x;
  const int cls = blockIdx.x & 7;
  const int j = (blockIdx.x >> 3) - 4;
  const int ncls = ((G - 1 - cls) >> 3) + 1 - 4;
  if (ncls <= 0) return;
  unsigned char* wsm = smem + wave * AT_WAVE_BYTES;
  for (int it = j; it < SEQ / 8; it += ncls) {
    int t = it * 8 + wave;
    attn_query(p, wsm, cls, t);
  }
}

__device__ void phase4(const Params& p, unsigned char* smem) {
  const u16* YATT = (const u16*)(p.ws + OFF_YATT);
  const u16* YDN = (const u16*)(p.ws + OFF_YDN);
  const u16* WTA = (const u16*)(p.ws + OFF_WTA);
  const u16* WTB = (const u16*)(p.ws + OFF_WTB);
  const u16* PROJ = (const u16*)(p.ws + OFF_PROJ);
  u16* MG = (u16*)(p.ws + OFF_MERGED);
  const int lane = threadIdx.x & 63, wave = threadIdx.x >> 6;
  const int wm = wave >> 1, wn = wave & 1, fr = lane & 15, fg = lane >> 4;
  const int ntn = DM / G_BN, ntiles = (MTOK / G_BM) * ntn;
  for (int t = blockIdx.x; t < ntiles; t += gridDim.x) {
    const int m0 = (t / ntn) * G_BM, n0 = (t % ntn) * G_BN;
    f32x4 acc[4][4];
    u32 mg[4][4][2];
    const u32 pb0 = (u32)(m0 + wm * 64 + 4 * fg) * LDP + (u32)(n0 + wn * 64 + fr);
    const u32 ob0 = (u32)(m0 + wm * 64 + 4 * fg) * DM + (u32)(n0 + wn * 64 + fr);
    gemm_mainloop(YATT, 512, WTA, 512, 512, m0, n0, smem, acc);
#pragma unroll
    for (int i = 0; i < 4; ++i)
#pragma unroll
      for (int j = 0; j < 4; ++j) {
        float t4[4];
#pragma unroll
        for (int r = 0; r < 4; ++r) {
          float ga = bf2f(PROJ[pb0 + (u32)(C_GA + (i * 16 + r) * LDP + j * 16)]);
          t4[r] = sigmoidf_(ga) * acc[i][j][r];
        }
        mg[i][j][0] = pack2(t4[0], t4[1]); mg[i][j][1] = pack2(t4[2], t4[3]);
        asm volatile("" ::: "memory");
      }
    gemm_mainloop(YDN, 512, WTB, 512, 512, m0, n0, smem, acc);
#pragma unroll
    for (int i = 0; i < 4; ++i)
#pragma unroll
      for (int j = 0; j < 4; ++j)
#pragma unroll
        for (int r = 0; r < 4; ++r) {
          float gb = bf2f(PROJ[pb0 + (u32)(C_GB + (i * 16 + r) * LDP + j * 16)]);
          u32 w = mg[i][j][r >> 1];
          float m1 = (r & 1) ? bfhi(w) : bflo(w);
          MG[ob0 + (u32)((i * 16 + r) * DM + j * 16)] = f2bf(m1 + sigmoidf_(gb) * acc[i][j][r]);
          if (r == 3) asm volatile("" ::: "memory");
        }
  }
}

__device__ void phase5(const Params& p, unsigned char* smem) {
  const u16* MG = (const u16*)(p.ws + OFF_MERGED);
  const u16* WTO = (const u16*)(p.ws + OFF_WTO);
  const float* x = p.in[0];
  const int lane = threadIdx.x & 63, wave = threadIdx.x >> 6;
  const int wm = wave >> 1, wn = wave & 1, fr = lane & 15, fg = lane >> 4;
  const int ntn = DM / G_BN, ntiles = (MTOK / G_BM) * ntn;
  for (int t = blockIdx.x; t < ntiles; t += gridDim.x) {
    const int m0 = (t / ntn) * G_BM, n0 = (t % ntn) * G_BN;
    f32x4 acc[4][4];
    gemm_mainloop(MG, DM, WTO, DM, DM, m0, n0, smem, acc);
    const u32 ob0 = (u32)(m0 + wm * 64 + 4 * fg) * DM + (u32)(n0 + wn * 64 + fr);
    float* outp = p.out;
#pragma unroll
    for (int i = 0; i < 4; ++i)
#pragma unroll
      for (int j = 0; j < 4; ++j)
#pragma unroll
        for (int r = 0; r < 4; ++r) {
          u32 o = ob0 + (u32)((i * 16 + r) * DM + j * 16);
          outp[o] = x[o] + acc[i][j][r];
        }
  }
}

__device__ void phase6(const Params& p, unsigned char* smem) {
  const u16* H2 = (const u16*)(p.ws + OFF_H2);
  const u16* WTQ = (const u16*)(p.ws + OFF_WTQ);
  u16* QP = (u16*)(p.ws + OFF_QP);
  const int lane = threadIdx.x & 63, wave = threadIdx.x >> 6;
  const int wm = wave >> 1, wn = wave & 1, fr = lane & 15, fg = lane >> 4;
  const int ntn = 2048 / G_BN, ntiles = (MTOK / G_BM) * ntn;
  for (int t = blockIdx.x; t < ntiles; t += gridDim.x) {
    const int m0 = (t / ntn) * G_BM, n0 = (t % ntn) * G_BN;
    f32x4 acc[4][4];
    gemm_mainloop(H2, DM, WTQ, DM, DM, m0, n0, smem, acc);
    const u32 ob0 = (u32)(m0 + wm * 64 + 4 * fg) * 2048 + (u32)(n0 + wn * 64 + fr);
#pragma unroll
    for (int i = 0; i < 4; ++i)
#pragma unroll
      for (int j = 0; j < 4; ++j)
#pragma unroll
        for (int r = 0; r < 4; ++r) QP[ob0 + (u32)((i * 16 + r) * 2048 + j * 16)] = f2bf(acc[i][j][r]);
  }
}

__device__ __forceinline__ void top16_insert(float (&vals)[16], int (&idx)[16], float v, int i) {
  if (v > vals[15]) {
    vals[15] = v; idx[15] = i;
#pragma unroll
    for (int k = 15; k > 0; --k) {
      bool sw = vals[k] > vals[k - 1];
      float a = vals[k], bb = vals[k - 1];
      int ia = idx[k], ib = idx[k - 1];
      vals[k - 1] = sw ? a : bb; vals[k] = sw ? bb : a;
      idx[k - 1] = sw ? ia : ib; idx[k] = sw ? ib : ia;
    }
  }
}

constexpr int P7_LD = 132;
__device__ void phase7(const Params& p, unsigned char* smem) {
  const u16* QP = (const u16*)(p.ws + OFF_QP);
  const u16* SKB = (const u16*)(p.ws + OFF_SKB);
  float* TOPS = (float*)(p.ws + OFF_TOPS);
  u8* TOPI = (u8*)(p.ws + OFF_TOPI);
  const int tid = threadIdx.x, lane = tid & 63, wave = tid >> 6;
  const int wm = wave >> 1, wn = wave & 1, fr = lane & 15, fg = lane >> 4;
  const int ntiles = (MTOK / G_BM) * 16;
  float* tile = (float*)smem;
  for (int t = blockIdx.x; t < ntiles; t += gridDim.x) {
    const int m0 = (t >> 4) * G_BM, hp = t & 15;
    f32x4 acc[4][4];
    gemm_mainloop(QP + hp * 128, 2048, SKB + (size_t)hp * 128 * 128, 128, 128, m0, 0, smem, acc);
#pragma unroll
    for (int i = 0; i < 4; ++i)
#pragma unroll
      for (int j = 0; j < 4; ++j)
#pragma unroll
        for (int r = 0; r < 4; ++r) {
          int row = wm * 64 + i * 16 + 4 * fg + r, col = wn * 64 + j * 16 + fr;
          tile[row * P7_LD + col] = acc[i][j][r];
        }
    __syncthreads();
    if (tid < 256) {
      float vals[16]; int idx[16];
#pragma unroll
      for (int k = 0; k < 16; ++k) { vals[k] = -INFINITY; idx[k] = 0; }
      const float* rowp = tile + tid * P7_LD;
      for (int c = 0; c < 128; c += 4) {
        float4 v = *(const float4*)(rowp + c);
        top16_insert(vals, idx, v.x, c);
        top16_insert(vals, idx, v.y, c + 1);
        top16_insert(vals, idx, v.z, c + 2);
        top16_insert(vals, idx, v.w, c + 3);
      }
      size_t o = ((size_t)(m0 + tid) * 16 + hp) * 16;
#pragma unroll
      for (int k = 0; k < 16; k += 4) *(float4*)(TOPS + o + k) = make_float4(vals[k], vals[k + 1], vals[k + 2], vals[k + 3]);
#pragma unroll
      for (int k = 0; k < 16; k += 4)
        *(u32*)(TOPI + o + k) = (u32)idx[k] | ((u32)idx[k + 1] << 8) | ((u32)idx[k + 2] << 16) | ((u32)idx[k + 3] << 24);
    }
    __syncthreads();
  }
}

__device__ void phase7b(const Params& p) {
  const float* TOPS = (const float*)(p.ws + OFF_TOPS);
  const u8* TOPI = (const u8*)(p.ws + OFF_TOPI);
  int* EXPERT = (int*)(p.ws + OFF_EXPERT);
  float* GATE = (float*)(p.ws + OFF_GATE);
  for (int w = blockIdx.x * NTHREADS + threadIdx.x; w < MTOK * 8; w += gridDim.x * NTHREADS) {
    const size_t o = (size_t)w * 32;
    float sa[16], sb[16];
#pragma unroll
    for (int k = 0; k < 16; k += 4) {
      float4 v = *(const float4*)(TOPS + o + k); sa[k] = v.x; sa[k + 1] = v.y; sa[k + 2] = v.z; sa[k + 3] = v.w;
      float4 u = *(const float4*)(TOPS + o + 16 + k); sb[k] = u.x; sb[k + 1] = u.y; sb[k + 2] = u.z; sb[k + 3] = u.w;
    }
    float vals[16]; int idx[16];
#pragma unroll
    for (int k = 0; k < 16; ++k) { vals[k] = -INFINITY; idx[k] = 0; }
#pragma unroll
    for (int a = 0; a < 16; ++a)
#pragma unroll
      for (int bb = 0; bb < 16; ++bb)
        if ((a + 1) * (bb + 1) <= 16) top16_insert(vals, idx, sa[a] + sb[bb], a * 16 + bb);
    float m = vals[0], s = 0.f, e[16];
#pragma unroll
    for (int k = 0; k < 16; ++k) { e[k] = __expf(vals[k] - m); s += e[k]; }
    float inv = 1.f / s;
#pragma unroll
    for (int k = 0; k < 16; ++k) {
      int a = idx[k] >> 4, bb = idx[k] & 15;
      int ex = (int)TOPI[o + a] * 128 + (int)TOPI[o + 16 + bb];
      EXPERT[(size_t)w * 16 + k] = ex;
      GATE[(size_t)w * 16 + k] = e[k] * inv;
    }
  }
}

__device__ void phase8(const Params& p) {
  const u16* H2 = (const u16*)(p.ws + OFF_H2);
  const int* EXPERT = (const int*)(p.ws + OFF_EXPERT);
  const float* GATE = (const float*)(p.ws + OFF_GATE);
  const float* U = p.in[15];
  const float* V = p.in[16];
  const int lane = threadIdx.x & 63, wave = threadIdx.x >> 6;
  for (int tok = blockIdx.x * 8 + wave; tok < MTOK; tok += gridDim.x * 8) {
    float hv[16], ov[16];
#pragma unroll
    for (int i = 0; i < 4; ++i) {
      uint2 w = *(const uint2*)(H2 + (size_t)tok * DM + 4 * (lane + 64 * i));
      hv[4 * i] = bflo(w.x); hv[4 * i + 1] = bfhi(w.x); hv[4 * i + 2] = bflo(w.y); hv[4 * i + 3] = bfhi(w.y);
      ov[4 * i] = 0.f; ov[4 * i + 1] = 0.f; ov[4 * i + 2] = 0.f; ov[4 * i + 3] = 0.f;
    }
    const int e0 = EXPERT[(size_t)tok * 128 + lane], e1 = EXPERT[(size_t)tok * 128 + 64 + lane];
    const float g0 = GATE[(size_t)tok * 128 + lane], g1 = GATE[(size_t)tok * 128 + 64 + lane];
    for (int k = 0; k < 128; k += 2) {
      int ea = __shfl((k < 64) ? e0 : e1, k & 63), eb = __shfl((k < 64) ? e0 : e1, (k + 1) & 63);
      float ga = __shfl((k < 64) ? g0 : g1, k & 63), gb = __shfl((k < 64) ? g0 : g1, (k + 1) & 63);
      const float4* ua = (const float4*)(U + (size_t)ea * DM);
      const float4* ub = (const float4*)(U + (size_t)eb * DM);
      const float4* va = (const float4*)(V + (size_t)ea * DM);
      const float4* vb = (const float4*)(V + (size_t)eb * DM);
      float4 ra[4], rb[4], sa[4], sb[4];
#pragma unroll
      for (int i = 0; i < 4; ++i) { ra[i] = ua[lane + 64 * i]; rb[i] = ub[lane + 64 * i]; }
#pragma unroll
      for (int i = 0; i < 4; ++i) { sa[i] = va[lane + 64 * i]; sb[i] = vb[lane + 64 * i]; }
      float da = 0.f, db = 0.f;
#pragma unroll
      for (int i = 0; i < 4; ++i) {
        da += ra[i].x * hv[4 * i] + ra[i].y * hv[4 * i + 1] + ra[i].z * hv[4 * i + 2] + ra[i].w * hv[4 * i + 3];
        db += rb[i].x * hv[4 * i] + rb[i].y * hv[4 * i + 1] + rb[i].z * hv[4 * i + 2] + rb[i].w * hv[4 * i + 3];
      }
      da = wave_sum(da); db = wave_sum(db);
      float ca = ga * 0.5f * da * (1.f + erff(da * 0.70710678118654752f));
      float cb = gb * 0.5f * db * (1.f + erff(db * 0.70710678118654752f));
#pragma unroll
      for (int i = 0; i < 4; ++i) {
        ov[4 * i] += ca * sa[i].x + cb * sb[i].x; ov[4 * i + 1] += ca * sa[i].y + cb * sb[i].y;
        ov[4 * i + 2] += ca * sa[i].z + cb * sb[i].z; ov[4 * i + 3] += ca * sa[i].w + cb * sb[i].w;
      }
    }
#pragma unroll
    for (int i = 0; i < 4; ++i) {
      float4* op = (float4*)(p.out + (size_t)tok * DM) + lane + 64 * i;
      float4 x2 = *op;
      x2.x += ov[4 * i]; x2.y += ov[4 * i + 1]; x2.z += ov[4 * i + 2]; x2.w += ov[4 * i + 3];
      *op = x2;
    }
  }
}

__global__ void __launch_bounds__(NTHREADS, 2) mk_fwd(Params p) {
  cg::grid_group grid = cg::this_grid();
  __shared__ __attribute__((aligned(16))) unsigned char smem[SMEM_BYTES];
  const int lo = p.ph_lo, hi = p.ph_hi;
#define RUN(k, call) if (lo <= (k) && (k) < hi) { call; if ((k) + 1 < hi) grid.sync(); }
  RUN(0, phase0(p, smem))
  RUN(1, phase1(p, smem))
  RUN(2, phase2(p, smem))
  RUN(3, phase3(p, smem))
  RUN(4, phase4(p, smem))
  RUN(5, phase5(p, smem))
  RUN(6, rmsnorm_rows(p.out, p.in[12], (u16*)(p.ws + OFF_H2)))
  RUN(7, phase6(p, smem))
  RUN(8, phase7(p, smem))
  RUN(9, phase7b(p))
  RUN(10, phase8(p))
#undef RUN
}

extern "C" void kernel_launch(void* const* d_in, const int* in_sizes, int n_in,
                              void* d_out, int out_size, void* d_ws, size_t ws_size,
                              hipStream_t stream) {
  static int grid_blocks = 0;
  if (!grid_blocks) {
    int dev = 0, cus = 0, per_cu = 0;
    (void)hipGetDevice(&dev);
    (void)hipDeviceGetAttribute(&cus, hipDeviceAttributeMultiprocessorCount, dev);
    (void)hipOccupancyMaxActiveBlocksPerMultiprocessor(&per_cu, mk_fwd, NTHREADS, 0);
    if (per_cu < 1) per_cu = 1;
    if (per_cu > 1) per_cu = 1;
    grid_blocks = cus * per_cu;
    fprintf(stderr, "mk_fwd: cus=%d per_cu=%d grid=%d ws=%zu\n", cus, per_cu, grid_blocks, ws_size);
  }
  Params p{};
  for (int i = 0; i < 17 && i < n_in; ++i) p.in[i] = (const float*)d_in[i];
  p.out = (float*)d_out;
  p.ws = (unsigned char*)d_ws;
  p.ph_lo = 0; p.ph_hi = 11;
  void* args[] = {&p};
  hipError_t e = hipLaunchCooperativeKernel((void*)mk_fwd, dim3(grid_blocks), dim3(NTHREADS), args, 0, stream);
  if (e != hipSuccess) fprintf(stderr, "cooperative launch failed: %s (grid %d)\n", hipGetErrorString(e), grid_blocks);
}
```

```cpp
#include <hip/hip_runtime.h>
#include <hip/hip_bf16.h>
#include <hip/hip_cooperative_groups.h>
#include <cstdio>
#include <cstdint>
namespace cg = cooperative_groups;

typedef unsigned short u16;
typedef unsigned int u32;
typedef unsigned char u8;
typedef short bf16x8 __attribute__((ext_vector_type(8)));
typedef float f32x4 __attribute__((ext_vector_type(4)));
typedef unsigned int u32x4 __attribute__((ext_vector_type(4)));
typedef unsigned int u32x2 __attribute__((ext_vector_type(2)));

constexpr int NTHREADS = 512;
constexpr int BATCH = 8, SEQ = 4096, DM = 1024, MTOK = BATCH * SEQ;
constexpr int LDP = 5440;
constexpr int NPADW = 5504;
constexpr int C_AQ = 0, C_AK = 512, C_AV = 640, C_IQ = 768, C_IK = 1280, C_DQ = 1344, C_DK = 1856, C_DV = 2368,
              C_DZ = 2880, C_GA = 3392, C_GB = 4416;
constexpr size_t MiB = 1ull << 20;
constexpr size_t OFF_WTIN = 1 * MiB, OFF_WTA = 12 * MiB, OFF_WTB = 13 * MiB, OFF_WTO = 14 * MiB, OFF_WTQ = 16 * MiB,
                 OFF_SKB = 20 * MiB, OFF_SMALL = 21 * MiB, OFF_H = 23 * MiB, OFF_ATT = 23 * MiB, OFF_GC = 39 * MiB,
                 OFF_MERGED = 23 * MiB, OFF_PROJ = 87 * MiB, OFF_SEL = 427 * MiB, OFF_YATT = 443 * MiB,
                 OFF_YDN = 475 * MiB;
constexpr size_t OFF_H2 = OFF_PROJ, OFF_QP = OFF_PROJ + 64 * MiB, OFF_TOPS = OFF_PROJ + 192 * MiB,
                 OFF_TOPI = OFF_PROJ + 224 * MiB, OFF_EXPERT = OFF_PROJ + 232 * MiB, OFF_GATE = OFF_PROJ + 248 * MiB;
constexpr size_t OFF_UB = OFF_PROJ + 264 * MiB, OFF_VB = OFF_PROJ + 296 * MiB;
constexpr size_t DO_U = 0, DO_W = 32 * MiB, DO_QN = 64 * MiB, DO_KNT = 96 * MiB;

constexpr int SMEM_BYTES = 147456;
constexpr float EPS = 1e-6f;

struct Params {
  const float* in[17];
  float* out;
  unsigned char* ws;
  int ph_lo, ph_hi;
  int flags, pad;
};

__device__ __forceinline__ u16 f2bf(float f) {
  u32 u = __float_as_uint(f);
  u += 0x7fffu + ((u >> 16) & 1u);
  return (u16)(u >> 16);
}
__device__ __forceinline__ float bf2f(u16 h) { return __uint_as_float(((u32)h) << 16); }
__device__ __forceinline__ u32 pack2(float a, float b) { return (u32)f2bf(a) | ((u32)f2bf(b) << 16); }
__device__ __forceinline__ float bflo(u32 w) { return __uint_as_float(w << 16); }
__device__ __forceinline__ float bfhi(u32 w) { return __uint_as_float(w & 0xffff0000u); }
__device__ __forceinline__ float wave_sum(float v) {
#pragma unroll
  for (int o = 32; o > 0; o >>= 1) v += __shfl_xor(v, o);
  return v;
}
__device__ __forceinline__ float wave_max(float v) {
#pragma unroll
  for (int o = 32; o > 0; o >>= 1) v = fmaxf(v, __shfl_xor(v, o));
  return v;
}
typedef __bf16 bf16x2_t __attribute__((ext_vector_type(2)));
__device__ __forceinline__ float dot2bf(u32 a, u32 b, float acc) {
  return __builtin_amdgcn_fdot2_f32_bf16(__builtin_bit_cast(bf16x2_t, a), __builtin_bit_cast(bf16x2_t, b), acc, false);
}
#define DPPF(v, ctrl) __int_as_float(__builtin_amdgcn_update_dpp(0, __float_as_int(v), ctrl, 0xf, 0xf, true))
__device__ __forceinline__ float wave_sum_dpp(float v) {
  v += DPPF(v, 0xb1);
  v += DPPF(v, 0x4e);
  v += DPPF(v, 0x124);
  v += DPPF(v, 0x128);
  float r0 = __int_as_float(__builtin_amdgcn_readlane(__float_as_int(v), 0));
  float r1 = __int_as_float(__builtin_amdgcn_readlane(__float_as_int(v), 16));
  float r2 = __int_as_float(__builtin_amdgcn_readlane(__float_as_int(v), 32));
  float r3 = __int_as_float(__builtin_amdgcn_readlane(__float_as_int(v), 48));
  return (r0 + r1) + (r2 + r3);
}
#define WAVE_LDS_SYNC() asm volatile("s_waitcnt lgkmcnt(0)" ::: "memory")
__device__ __forceinline__ float sigmoidf_(float x) { return __builtin_amdgcn_rcpf(1.f + __expf(-x)); }
__device__ __forceinline__ int perm32(int k) {
  int blk = k & ~31, r = k & 31;
  int p = (r < 16) ? (8 * (r >> 2) + (r & 3)) : (8 * ((r - 16) >> 2) + 4 + (r & 3));
  return blk + p;
}

__device__ __forceinline__ int win_map(int n) {
  if (n < 1344) return n;
  if (n < 3392) return n + 8;
  if (n < 5440) return n + 16;
  if (n < 5448) return 1344 + (n - 5440);
  if (n < 5452) return 3400 + (n - 5448);
  if (n < 5456) return 3404 + (n - 5452);
  return -1;
}
__device__ void transpose_tile(const float* __restrict__ src, int Nsrc, u16* __restrict__ dst, int K, int k0, int n0,
                               bool mapped, float* tile  ) {
  const int tid = threadIdx.x;
  {
    const int tx = tid & 63, ty = tid >> 6;
    int n = n0 + tx;
    int sc = mapped ? win_map(n) : n;
#pragma unroll
    for (int i = 0; i < 8; ++i) {
      int k = ty + 8 * i;
      float v = (sc >= 0) ? src[(size_t)(k0 + k) * Nsrc + sc] : 0.f;
      tile[k * 65 + tx] = v;
    }
  }
  __syncthreads();
  {
    const int n = tid >> 3, kc = (tid & 7) * 8;
    u32 w[4];
#pragma unroll
    for (int j = 0; j < 4; ++j) w[j] = pack2(tile[(kc + 2 * j) * 65 + n], tile[(kc + 2 * j + 1) * 65 + n]);
    *(uint4*)(dst + (size_t)(n0 + n) * K + k0 + kc) = make_uint4(w[0], w[1], w[2], w[3]);
  }
  __syncthreads();
}

__device__ void rmsnorm_rows(const float* __restrict__ x, const float* __restrict__ gain, u16* __restrict__ out) {
  const int lane = threadIdx.x & 63, wave = threadIdx.x >> 6;
  float4 g[4];
#pragma unroll
  for (int i = 0; i < 4; ++i) g[i] = ((const float4*)gain)[lane + 64 * i];
  for (int row = blockIdx.x * 8 + wave; row < MTOK; row += gridDim.x * 8) {
    const float4* xr = (const float4*)(x + (size_t)row * DM);
    float4 v[4];
    float ss = 0.f;
#pragma unroll
    for (int i = 0; i < 4; ++i) {
      v[i] = xr[lane + 64 * i];
      ss += v[i].x * v[i].x + v[i].y * v[i].y + v[i].z * v[i].z + v[i].w * v[i].w;
    }
    ss = wave_sum(ss);
    float r = rsqrtf(ss * (1.f / DM) + EPS);
#pragma unroll
    for (int i = 0; i < 4; ++i) {
      uint2 o;
      o.x = pack2(v[i].x * r * g[i].x, v[i].y * r * g[i].y);
      o.y = pack2(v[i].z * r * g[i].z, v[i].w * r * g[i].w);
      *(uint2*)(out + (size_t)row * DM + 4 * (lane + 64 * i)) = o;
    }
  }
}

__device__ void phase0(const Params& p, unsigned char* smem) {
  float* tile = (float*)smem;
  unsigned char* ws = p.ws;
  const int n_in = 16 * 86, n_a = 8 * 16, n_b = 8 * 16, n_o = 16 * 16, n_q = 16 * 32;
  const int total = n_in + n_a + n_b + n_o + n_q;
  for (int t = blockIdx.x; t < total; t += gridDim.x) {
    int i = t;
    if (i < n_in) { transpose_tile(p.in[2], 5456, (u16*)(ws + OFF_WTIN), 1024, (i / 86) * 64, (i % 86) * 64, true, tile); continue; }
    i -= n_in;
    if (i < n_a) { transpose_tile(p.in[9], 1024, (u16*)(ws + OFF_WTA), 512, (i / 16) * 64, (i % 16) * 64, false, tile); continue; }
    i -= n_a;
    if (i < n_b) { transpose_tile(p.in[10], 1024, (u16*)(ws + OFF_WTB), 512, (i / 16) * 64, (i % 16) * 64, false, tile); continue; }
    i -= n_b;
    if (i < n_o) { transpose_tile(p.in[11], 1024, (u16*)(ws + OFF_WTO), 1024, (i / 16) * 64, (i % 16) * 64, false, tile); continue; }
    i -= n_o;
    transpose_tile(p.in[13], 2048, (u16*)(ws + OFF_WTQ), 1024, (i / 32) * 64, (i % 32) * 64, false, tile);
  }
  {
    const float* sk = p.in[14];
    u16* skb = (u16*)(ws + OFF_SKB);
    for (int i = blockIdx.x * NTHREADS + threadIdx.x; i < 16 * 128 * 128; i += gridDim.x * NTHREADS) skb[i] = f2bf(sk[i]);
  }
  rmsnorm_rows(p.in[0], p.in[1], (u16*)(ws + OFF_H));
}

constexpr int G_BM = 256, G_BN = 128, G_BK = 64;
constexpr int G_ABYTES = G_BM * 128, G_BBYTES = G_BN * 128, G_STAGE = G_ABYTES + G_BBYTES;

__device__ __forceinline__ void gemm_mainloop(const u16* __restrict__ A, int lda, const u16* __restrict__ Bt, int ldb, int K,
                                              int m0, int n0, unsigned char* smem, f32x4 (&acc)[4][4]) {
  const int tid = threadIdx.x, lane = tid & 63, wave = tid >> 6;
  const int wm = wave >> 1, wn = wave & 1;
#pragma unroll
  for (int i = 0; i < 4; ++i)
#pragma unroll
    for (int j = 0; j < 4; ++j) acc[i][j] = (f32x4){0.f, 0.f, 0.f, 0.f};
  const int kc = tid & 7;
  const int arow = tid >> 3;
  u32x4 ra[4], rb[2];
  const u16* ap = A + (size_t)(m0 + arow) * lda + kc * 8;
  const u16* bp = Bt + (size_t)(n0 + arow) * ldb + kc * 8;
  const int nk = K / G_BK;
#pragma unroll
  for (int i = 0; i < 4; ++i) ra[i] = *(const u32x4*)(ap + (size_t)(64 * i) * lda);
#pragma unroll
  for (int i = 0; i < 2; ++i) rb[i] = *(const u32x4*)(bp + (size_t)(64 * i) * ldb);
  __syncthreads();
  {
    unsigned char* sa = smem;
    unsigned char* sb = smem + G_ABYTES;
#pragma unroll
    for (int i = 0; i < 4; ++i) { int r = arow + 64 * i; *(u32x4*)(sa + r * 128 + ((kc ^ (r & 7)) << 4)) = ra[i]; }
#pragma unroll
    for (int i = 0; i < 2; ++i) { int r = arow + 64 * i; *(u32x4*)(sb + r * 128 + ((kc ^ (r & 7)) << 4)) = rb[i]; }
  }
  __syncthreads();
  const int fr = lane & 15, fg = lane >> 4;
  for (int kt = 0; kt < nk; ++kt) {
    if (kt + 1 < nk) {
      const u16* ap2 = ap + (size_t)(kt + 1) * G_BK;
      const u16* bp2 = bp + (size_t)(kt + 1) * G_BK;
#pragma unroll
      for (int i = 0; i < 4; ++i) ra[i] = *(const u32x4*)(ap2 + (size_t)(64 * i) * lda);
#pragma unroll
      for (int i = 0; i < 2; ++i) rb[i] = *(const u32x4*)(bp2 + (size_t)(64 * i) * ldb);
    }
    const unsigned char* sa = smem + (kt & 1) * G_STAGE;
    const unsigned char* sb = sa + G_ABYTES;
#pragma unroll
    for (int kk = 0; kk < 2; ++kk) {
      bf16x8 af[4], bfr[4];
#pragma unroll
      for (int i = 0; i < 4; ++i) {
        int r = wm * 64 + i * 16 + fr;
        af[i] = *(const bf16x8*)(sa + r * 128 + (((kk * 4 + fg) ^ (r & 7)) << 4));
      }
#pragma unroll
      for (int j = 0; j < 4; ++j) {
        int r = wn * 64 + j * 16 + fr;
        bfr[j] = *(const bf16x8*)(sb + r * 128 + (((kk * 4 + fg) ^ (r & 7)) << 4));
      }
#pragma unroll
      for (int i = 0; i < 4; ++i)
#pragma unroll
        for (int j = 0; j < 4; ++j) acc[i][j] = __builtin_amdgcn_mfma_f32_16x16x32_bf16(af[i], bfr[j], acc[i][j], 0, 0, 0);
    }
    if (kt + 1 < nk) {
      unsigned char* sa2 = smem + ((kt + 1) & 1) * G_STAGE;
      unsigned char* sb2 = sa2 + G_ABYTES;
#pragma unroll
      for (int i = 0; i < 4; ++i) { int r = arow + 64 * i; *(u32x4*)(sa2 + r * 128 + ((kc ^ (r & 7)) << 4)) = ra[i]; }
#pragma unroll
      for (int i = 0; i < 2; ++i) { int r = arow + 64 * i; *(u32x4*)(sb2 + r * 128 + ((kc ^ (r & 7)) << 4)) = rb[i]; }
    }
    __syncthreads();
  }
}

__device__ void phase1(const Params& p, unsigned char* smem) {
  const u16* H = (const u16*)(p.ws + OFF_H);
  const u16* WT = (const u16*)(p.ws + OFF_WTIN);
  u16* PROJ = (u16*)(p.ws + OFF_PROJ);
  float* SMALL = (float*)(p.ws + OFF_SMALL);
  const int lane = threadIdx.x & 63, wave = threadIdx.x >> 6;
  const int wm = wave >> 1, wn = wave & 1, fr = lane & 15, fg = lane >> 4;
  const int ntn = NPADW / G_BN;
  const int ntiles = (MTOK / G_BM) * ntn;
  for (int t = blockIdx.x; t < ntiles; t += gridDim.x) {
    const int m0 = (t / ntn) * G_BM, n0 = (t % ntn) * G_BN;
    f32x4 acc[4][4];
    gemm_mainloop(H, DM, WT, DM, DM, m0, n0, smem, acc);
    const int cbase = n0 + wn * 64;
    const u32 rb0 = (u32)(m0 + wm * 64 + 4 * fg) * LDP + (u32)(cbase + fr);
    const u32 sb0 = (u32)(m0 + wm * 64 + 4 * fg) * 16 + (u32)(cbase + fr - LDP);
    if (cbase < C_AV) {
      const float* gain = (cbase < C_AK) ? p.in[3] : p.in[4];
      const float extra = (cbase < C_AK) ? 0.125f : 1.0f;
      float gj[4];
#pragma unroll
      for (int j = 0; j < 4; ++j) gj[j] = gain[j * 16 + fr] * extra;
#pragma unroll
      for (int i = 0; i < 4; ++i) {
        float ss[4];
#pragma unroll
        for (int r = 0; r < 4; ++r) {
          float s = 0.f;
#pragma unroll
          for (int j = 0; j < 4; ++j) s += acc[i][j][r] * acc[i][j][r];
          s += __shfl_xor(s, 1); s += __shfl_xor(s, 2); s += __shfl_xor(s, 4); s += __shfl_xor(s, 8);
          ss[r] = rsqrtf(s * (1.f / 64.f) + EPS);
        }
#pragma unroll
        for (int j = 0; j < 4; ++j)
#pragma unroll
          for (int r = 0; r < 4; ++r) {
            PROJ[rb0 + (u32)((i * 16 + r) * LDP + j * 16)] = f2bf(acc[i][j][r] * ss[r] * gj[j]);
          }
      }
    } else {
#pragma unroll
      for (int i = 0; i < 4; ++i)
#pragma unroll
        for (int j = 0; j < 4; ++j) {
          int col = cbase + j * 16 + fr;
#pragma unroll
          for (int r = 0; r < 4; ++r) {
            if (col < LDP) PROJ[rb0 + (u32)((i * 16 + r) * LDP + j * 16)] = f2bf(acc[i][j][r]);
            else if (col < LDP + 16) SMALL[sb0 + (u32)((i * 16 + r) * 16 + j * 16)] = acc[i][j][r];
          }
        }
    }
  }
}

constexpr int IDX_RS = 8208;

__device__ __forceinline__ u32 f2key(float x) {
  _Float16 h = (_Float16)x;
  u32 b = (u32) * (u16*)&h;
  return (b & 0x8000u) ? ((~b) & 0xffffu) : (b | 0x8000u);
}
__device__ __forceinline__ int count_ge(const u32 (&kreg)[32], u32 mid) {
  int c = 0;
#pragma unroll
  for (int i = 0; i < 32; ++i) {
    c += ((kreg[i] & 0xffffu) >= mid) ? 1 : 0;
    c += ((kreg[i] >> 16) >= mid) ? 1 : 0;
  }
  return c;
}
__device__ __forceinline__ int wave_sum_i(int v) {
#pragma unroll
  for (int o = 32; o > 0; o >>= 1) v += __shfl_xor(v, o);
  return v;
}

__device__ void idx_item(const Params& p, unsigned char* smem, int b, int tq) {
  const u16* PROJ = (const u16*)(p.ws + OFF_PROJ);
  const float* SMALL = (const float*)(p.ws + OFF_SMALL);
  u16* SEL = (u16*)(p.ws + OFF_SEL);
  const int tid = threadIdx.x, lane = tid & 63, wave = tid >> 6;
  const int t0 = tq * 16;
  const size_t tokb = (size_t)b * SEQ;
  if (tq < 16) {
    for (int rr = 0; rr < 2; ++rr) {
      int row = 2 * wave + rr, t = t0 + row;
      u16* out = SEL + (tokb + t) * 256;
      for (int i = lane; i < 256; i += 64) out[i] = (i <= t) ? (u16)i : (u16)0xFFFF;
    }
    return;
  }
  const int q = lane & 15, g = lane >> 4;
  __syncthreads();
  {
    const u16* iqrow = PROJ + (tokb + t0 + q) * LDP + C_IQ;
    bf16x8 bq[8][2];
    float wq[8];
#pragma unroll
    for (int h = 0; h < 8; ++h) {
      bq[h][0] = *(const bf16x8*)(iqrow + h * 64 + g * 8);
      bq[h][1] = *(const bf16x8*)(iqrow + h * 64 + 32 + g * 8);
      wq[h] = SMALL[(tokb + t0 + q) * 16 + h];
    }
    const int nkb = tq + 1;
    for (int kb = wave; kb < nkb; kb += 8) {
      const int s0 = kb * 16;
      const u16* ikrow = PROJ + (tokb + s0 + q) * LDP + C_IK;
      bf16x8 a0 = *(const bf16x8*)(ikrow + g * 8);
      bf16x8 a1 = *(const bf16x8*)(ikrow + 32 + g * 8);
      f32x4 tot = {0.f, 0.f, 0.f, 0.f};
#pragma unroll
      for (int h = 0; h < 8; ++h) {
        f32x4 acc = {0.f, 0.f, 0.f, 0.f};
        acc = __builtin_amdgcn_mfma_f32_16x16x32_bf16(a0, bq[h][0], acc, 0, 0, 0);
        acc = __builtin_amdgcn_mfma_f32_16x16x32_bf16(a1, bq[h][1], acc, 0, 0, 0);
#pragma unroll
        for (int r = 0; r < 4; ++r) tot[r] += wq[h] * fmaxf(acc[r], 0.f);
      }
      u32 k[4];
#pragma unroll
      for (int r = 0; r < 4; ++r) {
        int s = s0 + 4 * g + r;
        k[r] = (s <= t0 + q) ? f2key(tot[r]) : 0u;
      }
      uint2 w2 = make_uint2(k[0] | (k[1] << 16), k[2] | (k[3] << 16));
      *(uint2*)(smem + q * IDX_RS + (s0 + 4 * g) * 2) = w2;
    }
    const int nk = t0 + 16, nk64 = (nk + 63) & ~63;
    for (int i = tid; i < 16 * (nk64 - nk); i += NTHREADS) {
      int row = i / (nk64 - nk), c = nk + i % (nk64 - nk);
      *(u16*)(smem + row * IDX_RS + c * 2) = 0;
    }
  }
  __syncthreads();
  const int nk64 = (t0 + 16 + 63) & ~63;
  for (int rr = 0; rr < 2; ++rr) {
    const int row = 2 * wave + rr, t = t0 + row;
    u16* out = SEL + (tokb + t) * 256;
    u32 kreg[32];
    if (lane * 64 < nk64) {
      const uint4* src = (const uint4*)(smem + row * IDX_RS + lane * 128);
#pragma unroll
      for (int i = 0; i < 8; ++i) {
        uint4 v = src[i];
        kreg[4 * i] = v.x; kreg[4 * i + 1] = v.y; kreg[4 * i + 2] = v.z; kreg[4 * i + 3] = v.w;
      }
    } else {
#pragma unroll
      for (int i = 0; i < 32; ++i) kreg[i] = 0u;
    }
    u32 lo = 1u, hi = 65535u;
    while (lo < hi) {
      u32 mid = (lo + hi + 1u) >> 1;
      int c = wave_sum_i(count_ge(kreg, mid));
      if (c >= 256) lo = mid; else hi = mid - 1u;
    }
    const u32 tau = lo;
    int gt = 0, eq = 0;
#pragma unroll
    for (int i = 0; i < 32; ++i) {
      u32 a = kreg[i] & 0xffffu, c2 = kreg[i] >> 16;
      gt += (a > tau) ? 1 : 0; gt += (c2 > tau) ? 1 : 0;
      eq += (a == tau) ? 1 : 0; eq += (c2 == tau) ? 1 : 0;
    }
    int packed = gt | (eq << 16);
    int incl = packed;
#pragma unroll
    for (int o = 1; o < 64; o <<= 1) {
      int v = __shfl_up(incl, o);
      if (lane >= o) incl += v;
    }
    const int excl = incl - packed;
    const int total = __shfl(incl, 63);
    const int need = 256 - (total & 0xffff);
    const int pg = excl & 0xffff, pe = excl >> 16;
    int pos = pg + min(pe, need);
    int eqseen = pe;
#pragma unroll
    for (int i = 0; i < 32; ++i) {
#pragma unroll
      for (int hh = 0; hh < 2; ++hh) {
        u32 kv = hh ? (kreg[i] >> 16) : (kreg[i] & 0xffffu);
        int idx = lane * 64 + 2 * i + hh;
        bool take = false;
        if (kv > tau) take = true;
        else if (kv == tau) { take = (eqseen < need); ++eqseen; }
        if (take) { out[pos] = (u16)idx; ++pos; }
      }
    }
  }
}

constexpr int DNP = 68;
__device__ void dn_local_item(const Params& p, unsigned char* smem, int item) {
  const int h = item & 3, n = (item >> 2) & 63, b = item >> 8;
  const u16* PROJ = (const u16*)(p.ws + OFF_PROJ);
  const float* SMALL = (const float*)(p.ws + OFF_SMALL);
  u16* Ug = (u16*)((unsigned char*)p.out + DO_U);
  u16* Wg = (u16*)((unsigned char*)p.out + DO_W);
  u16* QNg = (u16*)((unsigned char*)p.out + DO_QN);
  u16* KNTg = (u16*)((unsigned char*)p.out + DO_KNT);
  u16* ATTg = (u16*)(p.ws + OFF_ATT);
  float* GCg = (float*)(p.ws + OFF_GC);
  const float* convw = p.in[5];
  const int tid = threadIdx.x, lane = tid & 63;
  const int c0 = n * 64;
  const size_t tok0 = (size_t)b * SEQ + c0;
  float* Qt = (float*)smem;
  float* Kt = Qt + 128 * DNP;
  float* V = Kt + 128 * DNP;
  float* AmT = V + 64 * 128;
  float* gc = AmT + 64 * 64;
  float* beta = gc + 64;
  float* qs = beta + 64;
  float* ks = qs + 64;
  __syncthreads();
  {
    const int c = tid & 127, tg = tid >> 7;
#pragma unroll
    for (int arr = 0; arr < 3; ++arr) {
      const int colp = (arr == 0 ? C_DQ : (arr == 1 ? C_DK : C_DV)) + h * 128 + c;
      float w0 = convw[0 * 1536 + arr * 512 + h * 128 + c], w1 = convw[1 * 1536 + arr * 512 + h * 128 + c],
            w2 = convw[2 * 1536 + arr * 512 + h * 128 + c], w3 = convw[3 * 1536 + arr * 512 + h * 128 + c];
      float x0, x1, x2;
      {
        int i = tg * 16;
        x0 = (c0 + i - 3 >= 0) ? bf2f(PROJ[(tok0 + i - 3) * LDP + colp]) : 0.f;
        x1 = (c0 + i - 2 >= 0) ? bf2f(PROJ[(tok0 + i - 2) * LDP + colp]) : 0.f;
        x2 = (c0 + i - 1 >= 0) ? bf2f(PROJ[(tok0 + i - 1) * LDP + colp]) : 0.f;
      }
#pragma unroll 2
      for (int ii = 0; ii < 16; ++ii) {
        int i = tg * 16 + ii;
        float x3 = bf2f(PROJ[(tok0 + i) * LDP + colp]);
        float y = w0 * x0 + w1 * x1 + w2 * x2 + w3 * x3;
        float s = y / (1.f + __expf(-y));
        if (arr == 0) Qt[c * DNP + i] = s;
        else if (arr == 1) Kt[c * DNP + i] = s;
        else V[i * 128 + c] = s;
        x0 = x1; x1 = x2; x2 = x3;
      }
    }
  }
  if (tid < 64) {
    float da = SMALL[(tok0 + tid) * 16 + 8 + h], db = SMALL[(tok0 + tid) * 16 + 12 + h];
    float xx = da + p.in[7][h];
    float sp = fmaxf(xx, 0.f) + log1pf(__expf(-fabsf(xx)));
    float gr = -__expf(p.in[6][h]) * sp;
    float incl = gr;
#pragma unroll
    for (int o = 1; o < 64; o <<= 1) {
      float v = __shfl_up(incl, o);
      if (lane >= o) incl += v;
    }
    gc[tid] = incl;
    beta[tid] = sigmoidf_(db);
    GCg[(tok0 + tid) * 4 + h] = incl;
  }
  __syncthreads();
  {
    const int arr = tid >> 8, i = (tid & 255) >> 2, part = tid & 3;
    const float* src = arr ? Kt : Qt;
    float ss = 0.f;
#pragma unroll 4
    for (int c = part * 32; c < part * 32 + 32; ++c) { float v = src[c * DNP + i]; ss += v * v; }
    ss += __shfl_xor(ss, 1); ss += __shfl_xor(ss, 2);
    if (part == 0) {
      if (arr == 0) qs[i] = rsqrtf(ss + EPS) * 0.08838834764831845f;
      else ks[i] = rsqrtf(ss + EPS);
    }
  }
  __syncthreads();
#pragma unroll 2
  for (int e = tid; e < 128 * 64; e += NTHREADS) {
    int c = e >> 6, i = e & 63;
    Qt[c * DNP + i] *= qs[i];
    Kt[c * DNP + i] *= ks[i];
  }
  __syncthreads();
#pragma unroll 2
  for (int e = tid; e < 64 * 128; e += NTHREADS) {
    int i = e >> 7, d = e & 127;
    QNg[(tok0 + i) * 512 + h * 128 + perm32(d)] = f2bf(Qt[d * DNP + i]);
  }
#pragma unroll 2
  for (int e = tid; e < 128 * 64; e += NTHREADS) {
    int d = e >> 6, i = e & 63;
    KNTg[(size_t)item * 8192 + d * 64 + perm32(i)] = f2bf(Kt[d * DNP + i]);
  }
  {
    const int mat = tid >> 8, bi = (tid & 255) >> 4, bj = tid & 15;
    const int i0 = 4 * bi, j0 = 4 * bj;
    if (j0 <= i0 + 3) {
      const float* Aop = mat ? Qt : Kt;
      float acc[4][4];
#pragma unroll
      for (int x = 0; x < 4; ++x)
#pragma unroll
        for (int y = 0; y < 4; ++y) acc[x][y] = 0.f;
#pragma unroll 4
      for (int d = 0; d < 128; ++d) {
        float4 a4 = *(const float4*)(Aop + d * DNP + i0);
        float4 b4 = *(const float4*)(Kt + d * DNP + j0);
        float av[4] = {a4.x, a4.y, a4.z, a4.w}, bv[4] = {b4.x, b4.y, b4.z, b4.w};
#pragma unroll
        for (int x = 0; x < 4; ++x)
#pragma unroll
          for (int y = 0; y < 4; ++y) acc[x][y] += av[x] * bv[y];
      }
#pragma unroll
      for (int x = 0; x < 4; ++x)
#pragma unroll
        for (int y = 0; y < 4; ++y) {
          int i = i0 + x, j = j0 + y;
          float dec = __expf(gc[i] - gc[j]);
          if (mat == 0) AmT[j * 64 + i] = (i > j) ? beta[i] * acc[x][y] * dec : 0.f;
          else ATTg[(size_t)item * 4096 + i * 64 + perm32(j)] = f2bf((i >= j) ? acc[x][y] * dec : 0.f);
        }
    } else {
#pragma unroll
      for (int x = 0; x < 4; ++x)
#pragma unroll
        for (int y = 0; y < 4; ++y) {
          int i = i0 + x, j = j0 + y;
          if (mat == 0) AmT[j * 64 + i] = 0.f;
          else ATTg[(size_t)item * 4096 + i * 64 + perm32(j)] = 0;
        }
    }
  }
  __syncthreads();
  if (tid < 256) {
    const int c = tid;
    const bool isu = c < 128;
    const int cc = c & 127;
    const int pc = perm32(cc);
#pragma unroll 1
    for (int ib = 0; ib < 4; ++ib) {
      float sreg[16];
#pragma unroll
      for (int r = 0; r < 16; ++r) {
        int i = ib * 16 + r;
        sreg[r] = isu ? V[i * 128 + cc] * beta[i] : Kt[cc * DNP + i] * beta[i] * __expf(gc[i]);
      }
#pragma unroll 2
      for (int j = 0; j < ib * 16; ++j) {
        float xj = isu ? V[j * 128 + cc] : Kt[cc * DNP + j];
        const f32x4* ap = (const f32x4*)(AmT + j * 64 + ib * 16);
        f32x4 a0 = ap[0], a1 = ap[1], a2 = ap[2], a3 = ap[3];
        sreg[0] -= a0[0] * xj; sreg[1] -= a0[1] * xj; sreg[2] -= a0[2] * xj; sreg[3] -= a0[3] * xj;
        sreg[4] -= a1[0] * xj; sreg[5] -= a1[1] * xj; sreg[6] -= a1[2] * xj; sreg[7] -= a1[3] * xj;
        sreg[8] -= a2[0] * xj; sreg[9] -= a2[1] * xj; sreg[10] -= a2[2] * xj; sreg[11] -= a2[3] * xj;
        sreg[12] -= a3[0] * xj; sreg[13] -= a3[1] * xj; sreg[14] -= a3[2] * xj; sreg[15] -= a3[3] * xj;
      }
#pragma unroll
      for (int q = 0; q < 15; ++q) {
        const float* ar = AmT + (ib * 16 + q) * 64 + ib * 16;
#pragma unroll
        for (int r = q + 1; r < 16; ++r) sreg[r] -= ar[r] * sreg[q];
      }
#pragma unroll
      for (int r = 0; r < 16; ++r) {
        int i = ib * 16 + r;
        if (isu) { V[i * 128 + cc] = sreg[r]; Ug[(tok0 + i) * 512 + h * 128 + cc] = f2bf(sreg[r]); }
        else { Kt[cc * DNP + i] = sreg[r]; Wg[(tok0 + i) * 512 + h * 128 + pc] = f2bf(sreg[r]); }
      }
    }
  }
}

__device__ void phase2(const Params& p, unsigned char* smem) {
#ifndef NO_IDX
  for (int i = blockIdx.x; i < 2048; i += gridDim.x) idx_item(p, smem, i & 7, 255 - (i >> 3));
#endif
#ifndef NO_DNL
  if (!(p.flags & 1))
    for (int i = blockIdx.x; i < 2048; i += gridDim.x) dn_local_item(p, smem, i);
#endif
}

constexpr int SC_WP = 272, SC_KP = 144;
constexpr int SC_W = 0, SC_Q = 64 * SC_WP, SC_KT = 2 * 64 * SC_WP, SC_AT = SC_KT + 128 * SC_KP, SC_BUF = SC_AT + 64 * SC_KP;
constexpr int SC_SSQ = 2 * SC_BUF;
constexpr int SC_GC = SC_SSQ + 8 * 64 * 4;

__device__ void dn_scan_item(const Params& p, unsigned char* smem, int bh) {
  const int h = bh & 3, b = bh >> 2;
  const u16* Ug = (const u16*)((const unsigned char*)p.out + DO_U);
  const u16* Wg = (const u16*)((const unsigned char*)p.out + DO_W);
  const u16* QNg = (const u16*)((const unsigned char*)p.out + DO_QN);
  const u16* KNTg = (const u16*)((const unsigned char*)p.out + DO_KNT);
  const u16* ATTg = (const u16*)(p.ws + OFF_ATT);
  const float* GCg = (const float*)(p.ws + OFF_GC);
  const u16* PROJ = (const u16*)(p.ws + OFF_PROJ);
  u16* YDN = (u16*)(p.ws + OFF_YDN);
  const float* ogain = p.in[8];
  const int tid = threadIdx.x, lane = tid & 63, wave = tid >> 6;
  const int fr = lane & 15, fg = lane >> 4;
  const int ecol = wave * 16 + fr;
  const float gn = ogain[ecol];
  float* ssq = (float*)(smem + SC_SSQ);
  float* gcs = (float*)(smem + SC_GC);
  f32x4 S[8];
#pragma unroll
  for (int d = 0; d < 8; ++d) S[d] = (f32x4){0.f, 0.f, 0.f, 0.f};
  u32x4 st[7];
  float gcr = 0.f;
  auto load_step = [&](int n) {
    const size_t tok0 = (size_t)b * SEQ + n * 64;
    const int item = (b * 64 + n) * 4 + h;
#pragma unroll
    for (int k = 0; k < 7; ++k) {
      int c = tid + 512 * k;
      const u16* src;
      if (c < 1024) { int row = c >> 4, ch = c & 15; src = Wg + (tok0 + row) * 512 + h * 128 + ch * 8; }
      else if (c < 2048) { int cc = c - 1024; int row = cc >> 4, ch = cc & 15; src = QNg + (tok0 + row) * 512 + h * 128 + ch * 8; }
      else if (c < 3072) { int cc = c - 2048; src = KNTg + (size_t)item * 8192 + cc * 8; }
      else { int cc = c - 3072; src = ATTg + (size_t)item * 4096 + cc * 8; }
      st[k] = *(const u32x4*)src;
    }
    if (tid < 64) gcr = GCg[(tok0 + tid) * 4 + h];
  };
  auto store_step = [&](int buf) {
    unsigned char* base = smem + buf * SC_BUF;
#pragma unroll
    for (int k = 0; k < 7; ++k) {
      int c = tid + 512 * k;
      unsigned char* dst;
      if (c < 1024) { int row = c >> 4, ch = c & 15; dst = base + SC_W + row * SC_WP + ch * 16; }
      else if (c < 2048) { int cc = c - 1024; int row = cc >> 4, ch = cc & 15; dst = base + SC_Q + row * SC_WP + ch * 16; }
      else if (c < 3072) { int cc = c - 2048; int row = cc >> 3, ch = cc & 7; dst = base + SC_KT + row * SC_KP + ch * 16; }
      else { int cc = c - 3072; int row = cc >> 3, ch = cc & 7; dst = base + SC_AT + row * SC_KP + ch * 16; }
      *(u32x4*)dst = st[k];
    }
    if (tid < 64) gcs[buf * 64 + tid] = gcr;
  };
  __syncthreads();
  load_step(0);
  store_step(0);
  __syncthreads();
  for (int n = 0; n < 64; ++n) {
    const int buf = n & 1;
    const size_t tok0 = (size_t)b * SEQ + n * 64;
    if (n + 1 < 64) load_step(n + 1);
    const unsigned char* base = smem + buf * SC_BUF;
    const u32 ub0 = (u32)(tok0 + 4 * fg) * 512 + (u32)(h * 128 + ecol);
    float uval[4][4];
#pragma unroll
    for (int m = 0; m < 4; ++m)
#pragma unroll
      for (int r = 0; r < 4; ++r) uval[m][r] = bf2f(Ug[ub0 + (u32)((m * 16 + r) * 512)]);
    const float* gcb = gcs + buf * 64 + 4 * fg;
    const float glast = gcs[buf * 64 + 63];
    bf16x8 Sb[4];
#pragma unroll
    for (int kk = 0; kk < 4; ++kk) {
      union { u32 w[4]; bf16x8 v; } cv;
      cv.w[0] = pack2(S[2 * kk][0], S[2 * kk][1]); cv.w[1] = pack2(S[2 * kk][2], S[2 * kk][3]);
      cv.w[2] = pack2(S[2 * kk + 1][0], S[2 * kk + 1][1]); cv.w[3] = pack2(S[2 * kk + 1][2], S[2 * kk + 1][3]);
      Sb[kk] = cv.v;
    }
    f32x4 vnew[4], ov[4];
#pragma unroll
    for (int m = 0; m < 4; ++m) {
      f32x4 aw = {0.f, 0.f, 0.f, 0.f}, aq = {0.f, 0.f, 0.f, 0.f};
#pragma unroll
      for (int kk = 0; kk < 4; ++kk) {
        bf16x8 wf = *(const bf16x8*)(base + SC_W + (m * 16 + fr) * SC_WP + kk * 64 + fg * 16);
        bf16x8 qf = *(const bf16x8*)(base + SC_Q + (m * 16 + fr) * SC_WP + kk * 64 + fg * 16);
        aw = __builtin_amdgcn_mfma_f32_16x16x32_bf16(wf, Sb[kk], aw, 0, 0, 0);
        aq = __builtin_amdgcn_mfma_f32_16x16x32_bf16(qf, Sb[kk], aq, 0, 0, 0);
      }
      f32x4 g4 = *(const f32x4*)(gcb + m * 16);
#pragma unroll
      for (int r = 0; r < 4; ++r) { vnew[m][r] = uval[m][r] - aw[r]; ov[m][r] = aq[r] * __expf(g4[r]); }
    }
    bf16x8 vb[2], vsb[2];
#pragma unroll
    for (int k2 = 0; k2 < 2; ++k2) {
      union { u32 w[4]; bf16x8 v; } c1, c2;
      const int ma = 2 * k2, mb = 2 * k2 + 1;
      c1.w[0] = pack2(vnew[ma][0], vnew[ma][1]); c1.w[1] = pack2(vnew[ma][2], vnew[ma][3]);
      c1.w[2] = pack2(vnew[mb][0], vnew[mb][1]); c1.w[3] = pack2(vnew[mb][2], vnew[mb][3]);
      f32x4 ga4 = *(const f32x4*)(gcb + ma * 16), gb4 = *(const f32x4*)(gcb + mb * 16);
      float sa[4], sb2[4];
#pragma unroll
      for (int r = 0; r < 4; ++r) { sa[r] = vnew[ma][r] * __expf(glast - ga4[r]); sb2[r] = vnew[mb][r] * __expf(glast - gb4[r]); }
      c2.w[0] = pack2(sa[0], sa[1]); c2.w[1] = pack2(sa[2], sa[3]);
      c2.w[2] = pack2(sb2[0], sb2[1]); c2.w[3] = pack2(sb2[2], sb2[3]);
      vb[k2] = c1.v; vsb[k2] = c2.v;
    }
#pragma unroll
    for (int m = 0; m < 4; ++m) {
      f32x4 ao = ov[m];
#pragma unroll
      for (int k2 = 0; k2 < 2; ++k2) {
        bf16x8 af = *(const bf16x8*)(base + SC_AT + (m * 16 + fr) * SC_KP + k2 * 64 + fg * 16);
        ao = __builtin_amdgcn_mfma_f32_16x16x32_bf16(af, vb[k2], ao, 0, 0, 0);
      }
      ov[m] = ao;
#pragma unroll
      for (int r = 0; r < 4; ++r) {
        float sq = ao[r] * ao[r];
        sq += __shfl_xor(sq, 1); sq += __shfl_xor(sq, 2); sq += __shfl_xor(sq, 4); sq += __shfl_xor(sq, 8);
        if (fr == 0) ssq[wave * 64 + m * 16 + 4 * fg + r] = sq;
      }
    }
    const float egl = __expf(glast);
#pragma unroll
    for (int d = 0; d < 8; ++d) {
      f32x4 a = S[d] * egl;
#pragma unroll
      for (int k2 = 0; k2 < 2; ++k2) {
        bf16x8 kf = *(const bf16x8*)(base + SC_KT + (d * 16 + fr) * SC_KP + k2 * 64 + fg * 16);
        a = __builtin_amdgcn_mfma_f32_16x16x32_bf16(kf, vsb[k2], a, 0, 0, 0);
      }
      S[d] = a;
    }
    if (n + 1 < 64) store_step(buf ^ 1);
    __syncthreads();
    {
      const u32 zb0 = (u32)(tok0 + 4 * fg) * LDP + (u32)(C_DZ + h * 128 + ecol);
#pragma unroll
      for (int m = 0; m < 4; ++m)
#pragma unroll
        for (int r = 0; r < 4; ++r) {
          int tk = m * 16 + 4 * fg + r;
          float tot = 0.f;
#pragma unroll
          for (int w = 0; w < 8; ++w) tot += ssq[w * 64 + tk];
          float rstd = rsqrtf(tot * (1.f / 128.f) + EPS);
          float z = bf2f(PROJ[zb0 + (u32)((m * 16 + r) * LDP)]);
          float y = ov[m][r] * rstd * gn * z * sigmoidf_(z);
          YDN[ub0 + (u32)((m * 16 + r) * 512)] = f2bf(y);
        }
    }
    __syncthreads();
  }
}

constexpr int AT_WAVE_BYTES = 2048 + 8192 + 512;
__device__ void attn_query(const Params& p, unsigned char* wsm, int b, int t) {
  const u16* PROJ = (const u16*)(p.ws + OFF_PROJ);
  const u16* SEL = (const u16*)(p.ws + OFF_SEL);
  u16* YATT = (u16*)(p.ws + OFF_YATT);
  const int lane = threadIdx.x & 63;
  float* qs = (float*)wsm;
  float* P = (float*)(wsm + 2048);
  u16* sl = (u16*)(wsm + 2048 + 8192);
  const size_t tokb = (size_t)b * SEQ;
  const size_t tok = tokb + t;
  const int nsel = min(256, t + 1);
  {
    const u16* qrow = PROJ + tok * LDP + C_AQ;
    uint4 v = *(const uint4*)(qrow + lane * 8);
    float* d = qs + lane * 8;
    d[0] = bflo(v.x); d[1] = bfhi(v.x); d[2] = bflo(v.y); d[3] = bfhi(v.y);
    d[4] = bflo(v.z); d[5] = bfhi(v.z); d[6] = bflo(v.w); d[7] = bfhi(v.w);
    const u16* sr = SEL + tok * 256;
#pragma unroll
    for (int i = 0; i < 4; ++i) sl[lane + 64 * i] = sr[lane + 64 * i];
  }
  WAVE_LDS_SYNC();
#pragma unroll 1
  for (int i = 0; i < 4; ++i) {
    const int ki = lane + 64 * i;
    const bool valid = ki < nsel;
    const int s = valid ? (int)sl[ki] : 0;
    const u16* krow = PROJ + (tokb + s) * LDP + C_AK;
#pragma unroll 1
    for (int g = 0; g < 2; ++g) {
      float a0 = 0.f, a1 = 0.f, a2 = 0.f, a3 = 0.f;
#pragma unroll 2
      for (int c = 0; c < 8; ++c) {
        u32x4 kv = *(const u32x4*)(krow + g * 64 + c * 8);
        float kf[8] = {bflo(kv[0]), bfhi(kv[0]), bflo(kv[1]), bfhi(kv[1]), bflo(kv[2]), bfhi(kv[2]), bflo(kv[3]), bfhi(kv[3])};
#pragma unroll
        for (int e = 0; e < 8; e += 4) {
          f32x4 q0 = *(const f32x4*)(qs + (g * 4 + 0) * 64 + c * 8 + e);
          f32x4 q1 = *(const f32x4*)(qs + (g * 4 + 1) * 64 + c * 8 + e);
          f32x4 q2 = *(const f32x4*)(qs + (g * 4 + 2) * 64 + c * 8 + e);
          f32x4 q3 = *(const f32x4*)(qs + (g * 4 + 3) * 64 + c * 8 + e);
          a0 += q0[0] * kf[e] + q0[1] * kf[e + 1] + q0[2] * kf[e + 2] + q0[3] * kf[e + 3];
          a1 += q1[0] * kf[e] + q1[1] * kf[e + 1] + q1[2] * kf[e + 2] + q1[3] * kf[e + 3];
          a2 += q2[0] * kf[e] + q2[1] * kf[e + 1] + q2[2] * kf[e + 2] + q2[3] * kf[e + 3];
          a3 += q3[0] * kf[e] + q3[1] * kf[e + 1] + q3[2] * kf[e + 2] + q3[3] * kf[e + 3];
        }
      }
      f32x4 r4;
      r4[0] = valid ? a0 : -1e30f; r4[1] = valid ? a1 : -1e30f; r4[2] = valid ? a2 : -1e30f; r4[3] = valid ? a3 : -1e30f;
      *(f32x4*)(P + ki * 8 + g * 4) = r4;
    }
  }
  WAVE_LDS_SYNC();
  float lg[4][8];
#pragma unroll
  for (int i = 0; i < 4; ++i) {
    f32x4 x0 = *(const f32x4*)(P + (lane + 64 * i) * 8), x1 = *(const f32x4*)(P + (lane + 64 * i) * 8 + 4);
    lg[i][0] = x0[0]; lg[i][1] = x0[1]; lg[i][2] = x0[2]; lg[i][3] = x0[3];
    lg[i][4] = x1[0]; lg[i][5] = x1[1]; lg[i][6] = x1[2]; lg[i][7] = x1[3];
  }
#pragma unroll
  for (int hh = 0; hh < 8; ++hh) {
    float m = fmaxf(fmaxf(lg[0][hh], lg[1][hh]), fmaxf(lg[2][hh], lg[3][hh]));
    m = wave_max(m);
    float e[4], s = 0.f;
#pragma unroll
    for (int i = 0; i < 4; ++i) { e[i] = __expf(lg[i][hh] - m); s += e[i]; }
    s = wave_sum(s);
    float inv = 1.f / s;
#pragma unroll
    for (int i = 0; i < 4; ++i) lg[i][hh] = e[i] * inv;
  }
#pragma unroll
  for (int i = 0; i < 4; ++i) {
    float* d = P + (lane + 64 * i) * 8;
    *(f32x4*)d = (f32x4){lg[i][0], lg[i][1], lg[i][2], lg[i][3]};
    *(f32x4*)(d + 4) = (f32x4){lg[i][4], lg[i][5], lg[i][6], lg[i][7]};
  }
  WAVE_LDS_SYNC();
  const int g = lane >> 5, d2 = (lane & 31) * 2;
  float o[4][2];
#pragma unroll
  for (int hh = 0; hh < 4; ++hh) { o[hh][0] = 0.f; o[hh][1] = 0.f; }
  for (int k = 0; k < nsel; ++k) {
    const int s = (int)sl[k];
    u32 vv = *(const u32*)(PROJ + (tokb + s) * LDP + C_AV + g * 64 + d2);
    float v0 = bflo(vv), v1 = bfhi(vv);
    f32x4 pw = *(const f32x4*)(P + k * 8 + g * 4);
    o[0][0] += pw[0] * v0; o[0][1] += pw[0] * v1;
    o[1][0] += pw[1] * v0; o[1][1] += pw[1] * v1;
    o[2][0] += pw[2] * v0; o[2][1] += pw[2] * v1;
    o[3][0] += pw[3] * v0; o[3][1] += pw[3] * v1;
  }
#pragma unroll
  for (int hh = 0; hh < 4; ++hh)
    *(u32*)(YATT + tok * 512 + (g * 4 + hh) * 64 + d2) = pack2(o[hh][0], o[hh][1]);
  WAVE_LDS_SYNC();
}

__device__ void phase3(const Params& p, unsigned char* smem) {
  const int wave = threadIdx.x >> 6;
#ifndef NO_SCAN
  if (blockIdx.x < 32) {
    dn_scan_item(p, smem, blockIdx.x);
    return;
  }
#endif
#ifdef NO_ATTN
  return;
#endif
  const int G = gridDim.x;
  const int cls = blockIdx.x & 7;
  const int j = (blockIdx.x >> 3) - 4;
  const int ncls = ((G - 1 - cls) >> 3) + 1 - 4;
  if (ncls <= 0) return;
  unsigned char* wsm = smem + wave * AT_WAVE_BYTES;
  for (int it = j; it < SEQ / 8; it += ncls) {
    int t = it * 8 + wave;
    attn_query(p, wsm, cls, t);
  }
}

__device__ void phase4(const Params& p, unsigned char* smem) {
  const u16* YATT = (const u16*)(p.ws + OFF_YATT);
  const u16* YDN = (const u16*)(p.ws + OFF_YDN);
  const u16* WTA = (const u16*)(p.ws + OFF_WTA);
  const u16* WTB = (const u16*)(p.ws + OFF_WTB);
  const u16* PROJ = (const u16*)(p.ws + OFF_PROJ);
  u16* MG = (u16*)(p.ws + OFF_MERGED);
  const int lane = threadIdx.x & 63, wave = threadIdx.x >> 6;
  const int wm = wave >> 1, wn = wave & 1, fr = lane & 15, fg = lane >> 4;
  const int ntn = DM / G_BN, ntiles = (MTOK / G_BM) * ntn;
  for (int t = blockIdx.x; t < ntiles; t += gridDim.x) {
    const int m0 = (t / ntn) * G_BM, n0 = (t % ntn) * G_BN;
    f32x4 acc[4][4];
    u32 mg[4][4][2];
    const u32 pb0 = (u32)(m0 + wm * 64 + 4 * fg) * LDP + (u32)(n0 + wn * 64 + fr);
    const u32 ob0 = (u32)(m0 + wm * 64 + 4 * fg) * DM + (u32)(n0 + wn * 64 + fr);
    gemm_mainloop(YATT, 512, WTA, 512, 512, m0, n0, smem, acc);
#pragma unroll
    for (int i = 0; i < 4; ++i)
#pragma unroll
      for (int j = 0; j < 4; ++j) {
        float t4[4];
#pragma unroll
        for (int r = 0; r < 4; ++r) {
          float ga = bf2f(PROJ[pb0 + (u32)(C_GA + (i * 16 + r) * LDP + j * 16)]);
          t4[r] = sigmoidf_(ga) * acc[i][j][r];
        }
        mg[i][j][0] = pack2(t4[0], t4[1]); mg[i][j][1] = pack2(t4[2], t4[3]);
        asm volatile("" ::: "memory");
      }
    gemm_mainloop(YDN, 512, WTB, 512, 512, m0, n0, smem, acc);
#pragma unroll
    for (int i = 0; i < 4; ++i)
#pragma unroll
      for (int j = 0; j < 4; ++j)
#pragma unroll
        for (int r = 0; r < 4; ++r) {
          float gb = bf2f(PROJ[pb0 + (u32)(C_GB + (i * 16 + r) * LDP + j * 16)]);
          u32 w = mg[i][j][r >> 1];
          float m1 = (r & 1) ? bfhi(w) : bflo(w);
          MG[ob0 + (u32)((i * 16 + r) * DM + j * 16)] = f2bf(m1 + sigmoidf_(gb) * acc[i][j][r]);
          if (r == 3) asm volatile("" ::: "memory");
        }
  }
}

__device__ void phase5(const Params& p, unsigned char* smem) {
  const u16* MG = (const u16*)(p.ws + OFF_MERGED);
  const u16* WTO = (const u16*)(p.ws + OFF_WTO);
  const float* x = p.in[0];
  const int lane = threadIdx.x & 63, wave = threadIdx.x >> 6;
  const int wm = wave >> 1, wn = wave & 1, fr = lane & 15, fg = lane >> 4;
  const int ntn = DM / G_BN, ntiles = (MTOK / G_BM) * ntn;
  for (int t = blockIdx.x; t < ntiles; t += gridDim.x) {
    const int m0 = (t / ntn) * G_BM, n0 = (t % ntn) * G_BN;
    f32x4 acc[4][4];
    gemm_mainloop(MG, DM, WTO, DM, DM, m0, n0, smem, acc);
    const u32 ob0 = (u32)(m0 + wm * 64 + 4 * fg) * DM + (u32)(n0 + wn * 64 + fr);
    float* outp = p.out;
#pragma unroll
    for (int i = 0; i < 4; ++i)
#pragma unroll
      for (int j = 0; j < 4; ++j)
#pragma unroll
        for (int r = 0; r < 4; ++r) {
          u32 o = ob0 + (u32)((i * 16 + r) * DM + j * 16);
          outp[o] = x[o] + acc[i][j][r];
        }
  }
}

__device__ void phase6(const Params& p, unsigned char* smem) {
  const u16* H2 = (const u16*)(p.ws + OFF_H2);
  const u16* WTQ = (const u16*)(p.ws + OFF_WTQ);
  u16* QP = (u16*)(p.ws + OFF_QP);
  const int lane = threadIdx.x & 63, wave = threadIdx.x >> 6;
  const int wm = wave >> 1, wn = wave & 1, fr = lane & 15, fg = lane >> 4;
  const int ntn = 2048 / G_BN, ntiles = (MTOK / G_BM) * ntn;
  for (int t = blockIdx.x; t < ntiles; t += gridDim.x) {
    const int m0 = (t / ntn) * G_BM, n0 = (t % ntn) * G_BN;
    f32x4 acc[4][4];
    gemm_mainloop(H2, DM, WTQ, DM, DM, m0, n0, smem, acc);
    const u32 ob0 = (u32)(m0 + wm * 64 + 4 * fg) * 2048 + (u32)(n0 + wn * 64 + fr);
#pragma unroll
    for (int i = 0; i < 4; ++i)
#pragma unroll
      for (int j = 0; j < 4; ++j)
#pragma unroll
        for (int r = 0; r < 4; ++r) QP[ob0 + (u32)((i * 16 + r) * 2048 + j * 16)] = f2bf(acc[i][j][r]);
  }
}

__device__ __forceinline__ void top16_insert(float (&vals)[16], int (&idx)[16], float v, int i) {
  if (v > vals[15]) {
    vals[15] = v; idx[15] = i;
#pragma unroll
    for (int k = 15; k > 0; --k) {
      bool sw = vals[k] > vals[k - 1];
      float a = vals[k], bb = vals[k - 1];
      int ia = idx[k], ib = idx[k - 1];
      vals[k - 1] = sw ? a : bb; vals[k] = sw ? bb : a;
      idx[k - 1] = sw ? ia : ib; idx[k] = sw ? ib : ia;
    }
  }
}

constexpr int P7_LD = 132;
__device__ void phase7(const Params& p, unsigned char* smem) {
  const u16* QP = (const u16*)(p.ws + OFF_QP);
  const u16* SKB = (const u16*)(p.ws + OFF_SKB);
  float* TOPS = (float*)(p.ws + OFF_TOPS);
  u8* TOPI = (u8*)(p.ws + OFF_TOPI);
  const int tid = threadIdx.x, lane = tid & 63, wave = tid >> 6;
  const int wm = wave >> 1, wn = wave & 1, fr = lane & 15, fg = lane >> 4;
  const int ntiles = (MTOK / G_BM) * 16;
  float* tile = (float*)smem;
  for (int t = blockIdx.x; t < ntiles; t += gridDim.x) {
    const int m0 = (t >> 4) * G_BM, hp = t & 15;
    f32x4 acc[4][4];
    gemm_mainloop(QP + hp * 128, 2048, SKB + (size_t)hp * 128 * 128, 128, 128, m0, 0, smem, acc);
#pragma unroll
    for (int i = 0; i < 4; ++i)
#pragma unroll
      for (int j = 0; j < 4; ++j)
#pragma unroll
        for (int r = 0; r < 4; ++r) {
          int row = wm * 64 + i * 16 + 4 * fg + r, col = wn * 64 + j * 16 + fr;
          tile[row * P7_LD + col] = acc[i][j][r];
        }
    __syncthreads();
    if (tid < 256) {
      float vals[16]; int idx[16];
#pragma unroll
      for (int k = 0; k < 16; ++k) { vals[k] = -INFINITY; idx[k] = 0; }
      const float* rowp = tile + tid * P7_LD;
      for (int c = 0; c < 128; c += 4) {
        float4 v = *(const float4*)(rowp + c);
        top16_insert(vals, idx, v.x, c);
        top16_insert(vals, idx, v.y, c + 1);
        top16_insert(vals, idx, v.z, c + 2);
        top16_insert(vals, idx, v.w, c + 3);
      }
      size_t o = ((size_t)(m0 + tid) * 16 + hp) * 16;
#pragma unroll
      for (int k = 0; k < 16; k += 4) *(float4*)(TOPS + o + k) = make_float4(vals[k], vals[k + 1], vals[k + 2], vals[k + 3]);
#pragma unroll
      for (int k = 0; k < 16; k += 4)
        *(u32*)(TOPI + o + k) = (u32)idx[k] | ((u32)idx[k + 1] << 8) | ((u32)idx[k + 2] << 16) | ((u32)idx[k + 3] << 24);
    }
    __syncthreads();
  }
}

__device__ void phase7b(const Params& p) {
  const float* TOPS = (const float*)(p.ws + OFF_TOPS);
  const u8* TOPI = (const u8*)(p.ws + OFF_TOPI);
  int* EXPERT = (int*)(p.ws + OFF_EXPERT);
  float* GATE = (float*)(p.ws + OFF_GATE);
  for (int w = blockIdx.x * NTHREADS + threadIdx.x; w < MTOK * 8; w += gridDim.x * NTHREADS) {
    const size_t o = (size_t)w * 32;
    float sa[16], sb[16];
#pragma unroll
    for (int k = 0; k < 16; k += 4) {
      float4 v = *(const float4*)(TOPS + o + k); sa[k] = v.x; sa[k + 1] = v.y; sa[k + 2] = v.z; sa[k + 3] = v.w;
      float4 u = *(const float4*)(TOPS + o + 16 + k); sb[k] = u.x; sb[k + 1] = u.y; sb[k + 2] = u.z; sb[k + 3] = u.w;
    }
    float vals[16]; int idx[16];
#pragma unroll
    for (int k = 0; k < 16; ++k) { vals[k] = -INFINITY; idx[k] = 0; }
#pragma unroll
    for (int a = 0; a < 16; ++a)
#pragma unroll
      for (int bb = 0; bb < 16; ++bb)
        if ((a + 1) * (bb + 1) <= 16) top16_insert(vals, idx, sa[a] + sb[bb], a * 16 + bb);
    float m = vals[0], s = 0.f, e[16];
#pragma unroll
    for (int k = 0; k < 16; ++k) { e[k] = __expf(vals[k] - m); s += e[k]; }
    float inv = 1.f / s;
#pragma unroll
    for (int k = 0; k < 16; ++k) {
      int a = idx[k] >> 4, bb = idx[k] & 15;
      int ex = (int)TOPI[o + a] * 128 + (int)TOPI[o + 16 + bb];
      EXPERT[(size_t)w * 16 + k] = ex;
      GATE[(size_t)w * 16 + k] = e[k] * inv;
    }
  }
  {
    const f32x4* U4 = (const f32x4*)p.in[15];
    const f32x4* V4 = (const f32x4*)p.in[16];
    u32x4* UB = (u32x4*)(p.ws + OFF_UB);
    u32x4* VB = (u32x4*)(p.ws + OFF_VB);
    const int nchunk = 16384 * 1024 / 8;
    for (int i = blockIdx.x * NTHREADS + threadIdx.x; i < nchunk; i += gridDim.x * NTHREADS) {
      f32x4 a = U4[2 * i], b = U4[2 * i + 1];
      UB[i] = (u32x4){pack2(a[0], a[1]), pack2(a[2], a[3]), pack2(b[0], b[1]), pack2(b[2], b[3])};
      f32x4 c = V4[2 * i], d = V4[2 * i + 1];
      VB[i] = (u32x4){pack2(c[0], c[1]), pack2(c[2], c[3]), pack2(d[0], d[1]), pack2(d[2], d[3])};
    }
  }
}

__device__ void phase8(const Params& p) {
  const u16* H2 = (const u16*)(p.ws + OFF_H2);
  const int* EXPERT = (const int*)(p.ws + OFF_EXPERT);
  const float* GATE = (const float*)(p.ws + OFF_GATE);
  const u16* UB = (const u16*)(p.ws + OFF_UB);
  const u16* VB = (const u16*)(p.ws + OFF_VB);
  const int lane = threadIdx.x & 63, wave = threadIdx.x >> 6;
  for (int tok = blockIdx.x * 8 + wave; tok < MTOK; tok += gridDim.x * 8) {
    const u32x4 h0 = *(const u32x4*)(H2 + (size_t)tok * DM + 8 * lane);
    const u32x4 h1 = *(const u32x4*)(H2 + (size_t)tok * DM + 8 * (lane + 64));
    float ov[16];
#pragma unroll
    for (int i = 0; i < 16; ++i) ov[i] = 0.f;
    const int e0 = EXPERT[(size_t)tok * 128 + lane], e1 = EXPERT[(size_t)tok * 128 + 64 + lane];
    const float g0 = GATE[(size_t)tok * 128 + lane], g1 = GATE[(size_t)tok * 128 + 64 + lane];
#pragma unroll 1
    for (int half = 0; half < 2; ++half) {
      const int ev = half ? e1 : e0;
      const float gv = half ? g1 : g0;
#pragma unroll 1
      for (int k = 0; k < 64; k += 4) {
        u32x4 ua[4][2], va[4][2];
        float gg[4];
#pragma unroll
        for (int j = 0; j < 4; ++j) {
          const int e = __builtin_amdgcn_readlane(ev, k + j);
          gg[j] = __int_as_float(__builtin_amdgcn_readlane(__float_as_int(gv), k + j));
          const u16* ur = UB + (size_t)e * DM;
          const u16* vr = VB + (size_t)e * DM;
          ua[j][0] = *(const u32x4*)(ur + 8 * lane); ua[j][1] = *(const u32x4*)(ur + 8 * (lane + 64));
          va[j][0] = *(const u32x4*)(vr + 8 * lane); va[j][1] = *(const u32x4*)(vr + 8 * (lane + 64));
        }
#pragma unroll
        for (int j = 0; j < 4; ++j) {
          float d = 0.f;
#pragma unroll
          for (int c = 0; c < 4; ++c) { d = dot2bf(ua[j][0][c], h0[c], d); d = dot2bf(ua[j][1][c], h1[c], d); }
          d = wave_sum_dpp(d);
          const float cf = gg[j] * 0.5f * d * (1.f + erff(d * 0.70710678118654752f));
#pragma unroll
          for (int c = 0; c < 4; ++c) {
            ov[2 * c] += cf * bflo(va[j][0][c]); ov[2 * c + 1] += cf * bfhi(va[j][0][c]);
            ov[8 + 2 * c] += cf * bflo(va[j][1][c]); ov[8 + 2 * c + 1] += cf * bfhi(va[j][1][c]);
          }
        }
      }
    }
#pragma unroll
    for (int i = 0; i < 2; ++i) {
      f32x4* op = (f32x4*)(p.out + (size_t)tok * DM + 8 * (lane + 64 * i));
      f32x4 x0 = op[0], x1 = op[1];
      x0[0] += ov[8 * i + 0]; x0[1] += ov[8 * i + 1]; x0[2] += ov[8 * i + 2]; x0[3] += ov[8 * i + 3];
      x1[0] += ov[8 * i + 4]; x1[1] += ov[8 * i + 5]; x1[2] += ov[8 * i + 6]; x1[3] += ov[8 * i + 7];
      op[0] = x0; op[1] = x1;
    }
  }
}

__global__ void __launch_bounds__(NTHREADS, 2) mk_fwd(Params p) {
  cg::grid_group grid = cg::this_grid();
  __shared__ __attribute__((aligned(16))) unsigned char smem[SMEM_BYTES];
  const int lo = p.ph_lo, hi = p.ph_hi;
#define RUN(k, call) if (lo <= (k) && (k) < hi) { call; if ((k) + 1 < hi) grid.sync(); }
  RUN(0, phase0(p, smem))
  RUN(1, phase1(p, smem))
  RUN(2, phase2(p, smem))
  RUN(3, phase3(p, smem))
  RUN(4, phase4(p, smem))
  RUN(5, phase5(p, smem))
  RUN(6, rmsnorm_rows(p.out, p.in[12], (u16*)(p.ws + OFF_H2)))
  RUN(7, phase6(p, smem))
  RUN(8, phase7(p, smem))
  RUN(9, phase7b(p))
  RUN(10, phase8(p))
#undef RUN
}

extern "C" void kernel_launch(void* const* d_in, const int* in_sizes, int n_in,
                              void* d_out, int out_size, void* d_ws, size_t ws_size,
                              hipStream_t stream) {
  static int grid_blocks = 0;
  if (!grid_blocks) {
    int dev = 0, cus = 0, per_cu = 0;
    (void)hipGetDevice(&dev);
    (void)hipDeviceGetAttribute(&cus, hipDeviceAttributeMultiprocessorCount, dev);
    (void)hipOccupancyMaxActiveBlocksPerMultiprocessor(&per_cu, mk_fwd, NTHREADS, 0);
    if (per_cu < 1) per_cu = 1;
    if (per_cu > 1) per_cu = 1;
    grid_blocks = cus * per_cu;
    fprintf(stderr, "mk_fwd: cus=%d per_cu=%d grid=%d ws=%zu\n", cus, per_cu, grid_blocks, ws_size);
  }
  Params p{};
  for (int i = 0; i < 17 && i < n_in; ++i) p.in[i] = (const float*)d_in[i];
  p.out = (float*)d_out;
  p.ws = (unsigned char*)d_ws;
  p.ph_lo = 0; p.ph_hi = 11;
  void* args[] = {&p};
  hipError_t e = hipLaunchCooperativeKernel((void*)mk_fwd, dim3(grid_blocks), dim3(NTHREADS), args, 0, stream);
  if (e != hipSuccess) fprintf(stderr, "cooperative launch failed: %s (grid %d)\n", hipGetErrorString(e), grid_blocks);
#ifdef EXTRA_LO
  {
    Params p2 = p;
    p2.ph_lo = EXTRA_LO; p2.ph_hi = EXTRA_HI; p2.flags = 1;
    void* args2[] = {&p2};
    (void)hipLaunchCooperativeKernel((void*)mk_fwd, dim3(grid_blocks), dim3(NTHREADS), args2, 0, stream);
  }
#endif
}
```

```cpp
#include <hip/hip_runtime.h>
#include <hip/hip_bf16.h>
#include <hip/hip_cooperative_groups.h>
#include <cstdio>
#include <cstdint>
namespace cg = cooperative_groups;

typedef unsigned short u16;
typedef unsigned int u32;
typedef unsigned char u8;
typedef short bf16x8 __attribute__((ext_vector_type(8)));
typedef float f32x4 __attribute__((ext_vector_type(4)));
typedef unsigned int u32x4 __attribute__((ext_vector_type(4)));
typedef unsigned int u32x2 __attribute__((ext_vector_type(2)));

constexpr int NTHREADS = 512;
constexpr int BATCH = 8, SEQ = 4096, DM = 1024, MTOK = BATCH * SEQ;
constexpr int LDP = 5440;
constexpr int NPADW = 5504;
constexpr int C_AQ = 0, C_AK = 512, C_AV = 640, C_IQ = 768, C_IK = 1280, C_DQ = 1344, C_DK = 1856, C_DV = 2368,
              C_DZ = 2880, C_GA = 3392, C_GB = 4416;
constexpr size_t MiB = 1ull << 20;
constexpr size_t OFF_WTIN = 1 * MiB, OFF_WTA = 12 * MiB, OFF_WTB = 13 * MiB, OFF_WTO = 14 * MiB, OFF_WTQ = 16 * MiB,
                 OFF_SKB = 20 * MiB, OFF_SMALL = 21 * MiB, OFF_H = 23 * MiB, OFF_ATT = 23 * MiB, OFF_GC = 39 * MiB,
                 OFF_MERGED = 23 * MiB, OFF_PROJ = 87 * MiB, OFF_SEL = 427 * MiB, OFF_YATT = 443 * MiB,
                 OFF_YDN = 475 * MiB;
constexpr size_t OFF_H2 = OFF_PROJ, OFF_QP = OFF_PROJ + 64 * MiB, OFF_TOPS = OFF_PROJ + 192 * MiB,
                 OFF_TOPI = OFF_PROJ + 224 * MiB, OFF_EXPERT = OFF_PROJ + 232 * MiB, OFF_GATE = OFF_PROJ + 248 * MiB;
constexpr size_t OFF_UQ = OFF_PROJ + 264 * MiB, OFF_VQ = OFF_PROJ + 280 * MiB, OFF_US = OFF_PROJ + 296 * MiB, OFF_VS = OFF_PROJ + 297 * MiB;
constexpr size_t DO_U = 0, DO_W = 32 * MiB, DO_QN = 64 * MiB, DO_KNT = 96 * MiB;

constexpr int SMEM_BYTES = 147456;
constexpr float EPS = 1e-6f;

struct Params {
  const float* in[17];
  float* out;
  unsigned char* ws;
  int ph_lo, ph_hi;
  int flags, pad;
};

__device__ __forceinline__ u16 f2bf(float f) {
  u32 u = __float_as_uint(f);
  u += 0x7fffu + ((u >> 16) & 1u);
  return (u16)(u >> 16);
}
__device__ __forceinline__ float bf2f(u16 h) { return __uint_as_float(((u32)h) << 16); }
__device__ __forceinline__ u32 pack2(float a, float b) { return (u32)f2bf(a) | ((u32)f2bf(b) << 16); }
__device__ __forceinline__ float bflo(u32 w) { return __uint_as_float(w << 16); }
__device__ __forceinline__ float bfhi(u32 w) { return __uint_as_float(w & 0xffff0000u); }
__device__ __forceinline__ float wave_sum(float v) {
#pragma unroll
  for (int o = 32; o > 0; o >>= 1) v += __shfl_xor(v, o);
  return v;
}
__device__ __forceinline__ float wave_max(float v) {
#pragma unroll
  for (int o = 32; o > 0; o >>= 1) v = fmaxf(v, __shfl_xor(v, o));
  return v;
}
typedef __bf16 bf16x2_t __attribute__((ext_vector_type(2)));
__device__ __forceinline__ float dot2bf(u32 a, u32 b, float acc) {
  return __builtin_amdgcn_fdot2_f32_bf16(__builtin_bit_cast(bf16x2_t, a), __builtin_bit_cast(bf16x2_t, b), acc, false);
}
#define DPPF(v, ctrl) __int_as_float(__builtin_amdgcn_update_dpp(0, __float_as_int(v), ctrl, 0xf, 0xf, true))
__device__ __forceinline__ float wave_sum_dpp(float v) {
  v += DPPF(v, 0xb1);
  v += DPPF(v, 0x4e);
  v += DPPF(v, 0x124);
  v += DPPF(v, 0x128);
  float r0 = __int_as_float(__builtin_amdgcn_readlane(__float_as_int(v), 0));
  float r1 = __int_as_float(__builtin_amdgcn_readlane(__float_as_int(v), 16));
  float r2 = __int_as_float(__builtin_amdgcn_readlane(__float_as_int(v), 32));
  float r3 = __int_as_float(__builtin_amdgcn_readlane(__float_as_int(v), 48));
  return (r0 + r1) + (r2 + r3);
}
#define DPPI(v, ctrl) __builtin_amdgcn_update_dpp(0, (v), ctrl, 0xf, 0xf, true)
__device__ __forceinline__ int wave_sum_i_dpp(int v) {
  v += DPPI(v, 0xb1);
  v += DPPI(v, 0x4e);
  v += DPPI(v, 0x124);
  v += DPPI(v, 0x128);
  return (__builtin_amdgcn_readlane(v, 0) + __builtin_amdgcn_readlane(v, 16)) +
         (__builtin_amdgcn_readlane(v, 32) + __builtin_amdgcn_readlane(v, 48));
}
__device__ __forceinline__ float wave_max_dpp(float v) {
  v = fmaxf(v, DPPF(v, 0xb1));
  v = fmaxf(v, DPPF(v, 0x4e));
  v = fmaxf(v, DPPF(v, 0x124));
  v = fmaxf(v, DPPF(v, 0x128));
  float r0 = __int_as_float(__builtin_amdgcn_readlane(__float_as_int(v), 0));
  float r1 = __int_as_float(__builtin_amdgcn_readlane(__float_as_int(v), 16));
  float r2 = __int_as_float(__builtin_amdgcn_readlane(__float_as_int(v), 32));
  float r3 = __int_as_float(__builtin_amdgcn_readlane(__float_as_int(v), 48));
  return fmaxf(fmaxf(r0, r1), fmaxf(r2, r3));
}
#define WAVE_LDS_SYNC() asm volatile("s_waitcnt lgkmcnt(0)" ::: "memory")
__device__ __forceinline__ float sigmoidf_(float x) { return __builtin_amdgcn_rcpf(1.f + __expf(-x)); }
__device__ __forceinline__ int perm32(int k) {
  int blk = k & ~31, r = k & 31;
  int p = (r < 16) ? (8 * (r >> 2) + (r & 3)) : (8 * ((r - 16) >> 2) + 4 + (r & 3));
  return blk + p;
}

__device__ __forceinline__ int win_map(int n) {
  if (n < 1344) return n;
  if (n < 3392) return n + 8;
  if (n < 5440) return n + 16;
  if (n < 5448) return 1344 + (n - 5440);
  if (n < 5452) return 3400 + (n - 5448);
  if (n < 5456) return 3404 + (n - 5452);
  return -1;
}
__device__ void transpose_tile(const float* __restrict__ src, int Nsrc, u16* __restrict__ dst, int K, int k0, int n0,
                               bool mapped, float* tile  ) {
  const int tid = threadIdx.x;
  {
    const int tx = tid & 63, ty = tid >> 6;
    int n = n0 + tx;
    int sc = mapped ? win_map(n) : n;
#pragma unroll
    for (int i = 0; i < 8; ++i) {
      int k = ty + 8 * i;
      float v = (sc >= 0) ? src[(size_t)(k0 + k) * Nsrc + sc] : 0.f;
      tile[k * 65 + tx] = v;
    }
  }
  __syncthreads();
  {
    const int n = tid >> 3, kc = (tid & 7) * 8;
    u32 w[4];
#pragma unroll
    for (int j = 0; j < 4; ++j) w[j] = pack2(tile[(kc + 2 * j) * 65 + n], tile[(kc + 2 * j + 1) * 65 + n]);
    *(uint4*)(dst + (size_t)(n0 + n) * K + k0 + kc) = make_uint4(w[0], w[1], w[2], w[3]);
  }
  __syncthreads();
}

__device__ void rmsnorm_rows(const float* __restrict__ x, const float* __restrict__ gain, u16* __restrict__ out) {
  const int lane = threadIdx.x & 63, wave = threadIdx.x >> 6;
  float4 g[4];
#pragma unroll
  for (int i = 0; i < 4; ++i) g[i] = ((const float4*)gain)[lane + 64 * i];
  for (int row = blockIdx.x * 8 + wave; row < MTOK; row += gridDim.x * 8) {
    const float4* xr = (const float4*)(x + (size_t)row * DM);
    float4 v[4];
    float ss = 0.f;
#pragma unroll
    for (int i = 0; i < 4; ++i) {
      v[i] = xr[lane + 64 * i];
      ss += v[i].x * v[i].x + v[i].y * v[i].y + v[i].z * v[i].z + v[i].w * v[i].w;
    }
    ss = wave_sum(ss);
    float r = rsqrtf(ss * (1.f / DM) + EPS);
#pragma unroll
    for (int i = 0; i < 4; ++i) {
      uint2 o;
      o.x = pack2(v[i].x * r * g[i].x, v[i].y * r * g[i].y);
      o.y = pack2(v[i].z * r * g[i].z, v[i].w * r * g[i].w);
      *(uint2*)(out + (size_t)row * DM + 4 * (lane + 64 * i)) = o;
    }
  }
}

__device__ void phase0(const Params& p, unsigned char* smem) {
  float* tile = (float*)smem;
  unsigned char* ws = p.ws;
  const int n_in = 16 * 86, n_a = 8 * 16, n_b = 8 * 16, n_o = 16 * 16, n_q = 16 * 32;
  const int total = n_in + n_a + n_b + n_o + n_q;
  for (int t = blockIdx.x; t < total; t += gridDim.x) {
    int i = t;
    if (i < n_in) { transpose_tile(p.in[2], 5456, (u16*)(ws + OFF_WTIN), 1024, (i / 86) * 64, (i % 86) * 64, true, tile); continue; }
    i -= n_in;
    if (i < n_a) { transpose_tile(p.in[9], 1024, (u16*)(ws + OFF_WTA), 512, (i / 16) * 64, (i % 16) * 64, false, tile); continue; }
    i -= n_a;
    if (i < n_b) { transpose_tile(p.in[10], 1024, (u16*)(ws + OFF_WTB), 512, (i / 16) * 64, (i % 16) * 64, false, tile); continue; }
    i -= n_b;
    if (i < n_o) { transpose_tile(p.in[11], 1024, (u16*)(ws + OFF_WTO), 1024, (i / 16) * 64, (i % 16) * 64, false, tile); continue; }
    i -= n_o;
    transpose_tile(p.in[13], 2048, (u16*)(ws + OFF_WTQ), 1024, (i / 32) * 64, (i % 32) * 64, false, tile);
  }
  {
    const float* sk = p.in[14];
    u16* skb = (u16*)(ws + OFF_SKB);
    for (int i = blockIdx.x * NTHREADS + threadIdx.x; i < 16 * 128 * 128; i += gridDim.x * NTHREADS) skb[i] = f2bf(sk[i]);
  }
  rmsnorm_rows(p.in[0], p.in[1], (u16*)(ws + OFF_H));
}

constexpr int G_BM = 256, G_BN = 128, G_BK = 64;
constexpr int G_ABYTES = G_BM * 128, G_BBYTES = G_BN * 128, G_STAGE = G_ABYTES + G_BBYTES;

__device__ __forceinline__ void gemm_mainloop(const u16* __restrict__ A, int lda, const u16* __restrict__ Bt, int ldb, int K,
                                              int m0, int n0, unsigned char* smem, f32x4 (&acc)[4][4]) {
  const int tid = threadIdx.x, lane = tid & 63, wave = tid >> 6;
  const int wm = wave >> 1, wn = wave & 1;
#pragma unroll
  for (int i = 0; i < 4; ++i)
#pragma unroll
    for (int j = 0; j < 4; ++j) acc[i][j] = (f32x4){0.f, 0.f, 0.f, 0.f};
  const int kc = tid & 7;
  const int arow = tid >> 3;
  u32x4 ra[4], rb[2];
  const u16* ap = A + (size_t)(m0 + arow) * lda + kc * 8;
  const u16* bp = Bt + (size_t)(n0 + arow) * ldb + kc * 8;
  const int nk = K / G_BK;
#pragma unroll
  for (int i = 0; i < 4; ++i) ra[i] = *(const u32x4*)(ap + (size_t)(64 * i) * lda);
#pragma unroll
  for (int i = 0; i < 2; ++i) rb[i] = *(const u32x4*)(bp + (size_t)(64 * i) * ldb);
  __syncthreads();
  {
    unsigned char* sa = smem;
    unsigned char* sb = smem + G_ABYTES;
#pragma unroll
    for (int i = 0; i < 4; ++i) { int r = arow + 64 * i; *(u32x4*)(sa + r * 128 + ((kc ^ (r & 7)) << 4)) = ra[i]; }
#pragma unroll
    for (int i = 0; i < 2; ++i) { int r = arow + 64 * i; *(u32x4*)(sb + r * 128 + ((kc ^ (r & 7)) << 4)) = rb[i]; }
  }
  __syncthreads();
  const int fr = lane & 15, fg = lane >> 4;
  for (int kt = 0; kt < nk; ++kt) {
    if (kt + 1 < nk) {
      const u16* ap2 = ap + (size_t)(kt + 1) * G_BK;
      const u16* bp2 = bp + (size_t)(kt + 1) * G_BK;
#pragma unroll
      for (int i = 0; i < 4; ++i) ra[i] = *(const u32x4*)(ap2 + (size_t)(64 * i) * lda);
#pragma unroll
      for (int i = 0; i < 2; ++i) rb[i] = *(const u32x4*)(bp2 + (size_t)(64 * i) * ldb);
    }
    const unsigned char* sa = smem + (kt & 1) * G_STAGE;
    const unsigned char* sb = sa + G_ABYTES;
#pragma unroll
    for (int kk = 0; kk < 2; ++kk) {
      bf16x8 af[4], bfr[4];
#pragma unroll
      for (int i = 0; i < 4; ++i) {
        int r = wm * 64 + i * 16 + fr;
        af[i] = *(const bf16x8*)(sa + r * 128 + (((kk * 4 + fg) ^ (r & 7)) << 4));
      }
#pragma unroll
      for (int j = 0; j < 4; ++j) {
        int r = wn * 64 + j * 16 + fr;
        bfr[j] = *(const bf16x8*)(sb + r * 128 + (((kk * 4 + fg) ^ (r & 7)) << 4));
      }
#pragma unroll
      for (int i = 0; i < 4; ++i)
#pragma unroll
        for (int j = 0; j < 4; ++j) acc[i][j] = __builtin_amdgcn_mfma_f32_16x16x32_bf16(af[i], bfr[j], acc[i][j], 0, 0, 0);
    }
    if (kt + 1 < nk) {
      unsigned char* sa2 = smem + ((kt + 1) & 1) * G_STAGE;
      unsigned char* sb2 = sa2 + G_ABYTES;
#pragma unroll
      for (int i = 0; i < 4; ++i) { int r = arow + 64 * i; *(u32x4*)(sa2 + r * 128 + ((kc ^ (r & 7)) << 4)) = ra[i]; }
#pragma unroll
      for (int i = 0; i < 2; ++i) { int r = arow + 64 * i; *(u32x4*)(sb2 + r * 128 + ((kc ^ (r & 7)) << 4)) = rb[i]; }
    }
    __syncthreads();
  }
}

__device__ void phase1(const Params& p, unsigned char* smem) {
  const u16* H = (const u16*)(p.ws + OFF_H);
  const u16* WT = (const u16*)(p.ws + OFF_WTIN);
  u16* PROJ = (u16*)(p.ws + OFF_PROJ);
  float* SMALL = (float*)(p.ws + OFF_SMALL);
  const int lane = threadIdx.x & 63, wave = threadIdx.x >> 6;
  const int wm = wave >> 1, wn = wave & 1, fr = lane & 15, fg = lane >> 4;
  const int ntn = NPADW / G_BN;
  const int ntiles = (MTOK / G_BM) * ntn;
  for (int t = blockIdx.x; t < ntiles; t += gridDim.x) {
    const int m0 = (t / ntn) * G_BM, n0 = (t % ntn) * G_BN;
    f32x4 acc[4][4];
    gemm_mainloop(H, DM, WT, DM, DM, m0, n0, smem, acc);
    const int cbase = n0 + wn * 64;
    const u32 rb0 = (u32)(m0 + wm * 64 + 4 * fg) * LDP + (u32)(cbase + fr);
    const u32 sb0 = (u32)(m0 + wm * 64 + 4 * fg) * 16 + (u32)(cbase + fr - LDP);
    if (cbase < C_AV) {
      const float* gain = (cbase < C_AK) ? p.in[3] : p.in[4];
      const float extra = (cbase < C_AK) ? 0.125f : 1.0f;
      float gj[4];
#pragma unroll
      for (int j = 0; j < 4; ++j) gj[j] = gain[j * 16 + fr] * extra;
#pragma unroll
      for (int i = 0; i < 4; ++i) {
        float ss[4];
#pragma unroll
        for (int r = 0; r < 4; ++r) {
          float s = 0.f;
#pragma unroll
          for (int j = 0; j < 4; ++j) s += acc[i][j][r] * acc[i][j][r];
          s += __shfl_xor(s, 1); s += __shfl_xor(s, 2); s += __shfl_xor(s, 4); s += __shfl_xor(s, 8);
          ss[r] = rsqrtf(s * (1.f / 64.f) + EPS);
        }
#pragma unroll
        for (int j = 0; j < 4; ++j)
#pragma unroll
          for (int r = 0; r < 4; ++r) {
            PROJ[rb0 + (u32)((i * 16 + r) * LDP + j * 16)] = f2bf(acc[i][j][r] * ss[r] * gj[j]);
          }
      }
    } else {
#pragma unroll
      for (int i = 0; i < 4; ++i)
#pragma unroll
        for (int j = 0; j < 4; ++j) {
          int col = cbase + j * 16 + fr;
#pragma unroll
          for (int r = 0; r < 4; ++r) {
            if (col < LDP) PROJ[rb0 + (u32)((i * 16 + r) * LDP + j * 16)] = f2bf(acc[i][j][r]);
            else if (col < LDP + 16) SMALL[sb0 + (u32)((i * 16 + r) * 16 + j * 16)] = acc[i][j][r];
          }
        }
    }
  }
}

constexpr int IDX_RS = 8208;

__device__ __forceinline__ u32 f2key(float x) {
  _Float16 h = (_Float16)x;
  u32 b = (u32) * (u16*)&h;
  return (b & 0x8000u) ? ((~b) & 0xffffu) : (b | 0x8000u);
}
__device__ __forceinline__ int count_ge(const u32 (&kreg)[32], u32 mid) {
  int c = 0;
#pragma unroll
  for (int i = 0; i < 32; ++i) {
    c += ((kreg[i] & 0xffffu) >= mid) ? 1 : 0;
    c += ((kreg[i] >> 16) >= mid) ? 1 : 0;
  }
  return c;
}
__device__ __forceinline__ int wave_sum_i(int v) {
#pragma unroll
  for (int o = 32; o > 0; o >>= 1) v += __shfl_xor(v, o);
  return v;
}

__device__ void idx_item(const Params& p, unsigned char* smem, int b, int tq) {
  const u16* PROJ = (const u16*)(p.ws + OFF_PROJ);
  const float* SMALL = (const float*)(p.ws + OFF_SMALL);
  u16* SEL = (u16*)(p.ws + OFF_SEL);
  const int tid = threadIdx.x, lane = tid & 63, wave = tid >> 6;
  const int t0 = tq * 16;
  const size_t tokb = (size_t)b * SEQ;
  if (tq < 16) {
    for (int rr = 0; rr < 2; ++rr) {
      int row = 2 * wave + rr, t = t0 + row;
      u16* out = SEL + (tokb + t) * 256;
      for (int i = lane; i < 256; i += 64) out[i] = (i <= t) ? (u16)i : (u16)0xFFFF;
    }
    return;
  }
  const int q = lane & 15, g = lane >> 4;
  __syncthreads();
  {
    const u16* iqrow = PROJ + (tokb + t0 + q) * LDP + C_IQ;
    bf16x8 bq[8][2];
    float wq[8];
#pragma unroll
    for (int h = 0; h < 8; ++h) {
      bq[h][0] = *(const bf16x8*)(iqrow + h * 64 + g * 8);
      bq[h][1] = *(const bf16x8*)(iqrow + h * 64 + 32 + g * 8);
      wq[h] = SMALL[(tokb + t0 + q) * 16 + h];
    }
    const int nkb = tq + 1;
    for (int kb = wave; kb < nkb; kb += 8) {
      const int s0 = kb * 16;
      const u16* ikrow = PROJ + (tokb + s0 + q) * LDP + C_IK;
      bf16x8 a0 = *(const bf16x8*)(ikrow + g * 8);
      bf16x8 a1 = *(const bf16x8*)(ikrow + 32 + g * 8);
      f32x4 tot = {0.f, 0.f, 0.f, 0.f};
#pragma unroll
      for (int h = 0; h < 8; ++h) {
        f32x4 acc = {0.f, 0.f, 0.f, 0.f};
        acc = __builtin_amdgcn_mfma_f32_16x16x32_bf16(a0, bq[h][0], acc, 0, 0, 0);
        acc = __builtin_amdgcn_mfma_f32_16x16x32_bf16(a1, bq[h][1], acc, 0, 0, 0);
#pragma unroll
        for (int r = 0; r < 4; ++r) tot[r] += wq[h] * fmaxf(acc[r], 0.f);
      }
      u32 k[4];
#pragma unroll
      for (int r = 0; r < 4; ++r) {
        int s = s0 + 4 * g + r;
        k[r] = (s <= t0 + q) ? f2key(tot[r]) : 0u;
      }
      uint2 w2 = make_uint2(k[0] | (k[1] << 16), k[2] | (k[3] << 16));
      *(uint2*)(smem + q * IDX_RS + (s0 + 4 * g) * 2) = w2;
    }
    const int nk = t0 + 16, nk64 = (nk + 63) & ~63;
    for (int i = tid; i < 16 * (nk64 - nk); i += NTHREADS) {
      int row = i / (nk64 - nk), c = nk + i % (nk64 - nk);
      *(u16*)(smem + row * IDX_RS + c * 2) = 0;
    }
  }
  __syncthreads();
  const int nk64 = (t0 + 16 + 63) & ~63;
  for (int rr = 0; rr < 2; ++rr) {
    const int row = 2 * wave + rr, t = t0 + row;
    u16* out = SEL + (tokb + t) * 256;
    u32 kreg[32];
    if (lane * 64 < nk64) {
      const uint4* src = (const uint4*)(smem + row * IDX_RS + lane * 128);
#pragma unroll
      for (int i = 0; i < 8; ++i) {
        uint4 v = src[i];
        kreg[4 * i] = v.x; kreg[4 * i + 1] = v.y; kreg[4 * i + 2] = v.z; kreg[4 * i + 3] = v.w;
      }
    } else {
#pragma unroll
      for (int i = 0; i < 32; ++i) kreg[i] = 0u;
    }
    u32 lo = 1u, hi = 65535u;
    while (lo < hi) {
      u32 mid = (lo + hi + 1u) >> 1;
      int c = wave_sum_i(count_ge(kreg, mid));
      if (c >= 256) lo = mid; else hi = mid - 1u;
    }
    const u32 tau = lo;
    int gt = 0, eq = 0;
#pragma unroll
    for (int i = 0; i < 32; ++i) {
      u32 a = kreg[i] & 0xffffu, c2 = kreg[i] >> 16;
      gt += (a > tau) ? 1 : 0; gt += (c2 > tau) ? 1 : 0;
      eq += (a == tau) ? 1 : 0; eq += (c2 == tau) ? 1 : 0;
    }
    int packed = gt | (eq << 16);
    int incl = packed;
#pragma unroll
    for (int o = 1; o < 64; o <<= 1) {
      int v = __shfl_up(incl, o);
      if (lane >= o) incl += v;
    }
    const int excl = incl - packed;
    const int total = __shfl(incl, 63);
    const int need = 256 - (total & 0xffff);
    const int pg = excl & 0xffff, pe = excl >> 16;
    int pos = pg + min(pe, need);
    int eqseen = pe;
#pragma unroll
    for (int i = 0; i < 32; ++i) {
#pragma unroll
      for (int hh = 0; hh < 2; ++hh) {
        u32 kv = hh ? (kreg[i] >> 16) : (kreg[i] & 0xffffu);
        int idx = lane * 64 + 2 * i + hh;
        bool take = false;
        if (kv > tau) take = true;
        else if (kv == tau) { take = (eqseen < need); ++eqseen; }
        if (take) { out[pos] = (u16)idx; ++pos; }
      }
    }
  }
}

constexpr int DNP = 68;
__device__ void dn_local_item(const Params& p, unsigned char* smem, int item) {
  const int h = item & 3, n = (item >> 2) & 63, b = item >> 8;
  const u16* PROJ = (const u16*)(p.ws + OFF_PROJ);
  const float* SMALL = (const float*)(p.ws + OFF_SMALL);
  u16* Ug = (u16*)((unsigned char*)p.out + DO_U);
  u16* Wg = (u16*)((unsigned char*)p.out + DO_W);
  u16* QNg = (u16*)((unsigned char*)p.out + DO_QN);
  u16* KNTg = (u16*)((unsigned char*)p.out + DO_KNT);
  u16* ATTg = (u16*)(p.ws + OFF_ATT);
  float* GCg = (float*)(p.ws + OFF_GC);
  const float* convw = p.in[5];
  const int tid = threadIdx.x, lane = tid & 63;
  const int c0 = n * 64;
  const size_t tok0 = (size_t)b * SEQ + c0;
  float* Qt = (float*)smem;
  float* Kt = Qt + 128 * DNP;
  float* V = Kt + 128 * DNP;
  float* AmT = V + 64 * 128;
  float* gc = AmT + 64 * 64;
  float* beta = gc + 64;
  float* qs = beta + 64;
  float* ks = qs + 64;
  __syncthreads();
  {
    const int c = tid & 127, tg = tid >> 7;
#pragma unroll
    for (int arr = 0; arr < 3; ++arr) {
      const int colp = (arr == 0 ? C_DQ : (arr == 1 ? C_DK : C_DV)) + h * 128 + c;
      float w0 = convw[0 * 1536 + arr * 512 + h * 128 + c], w1 = convw[1 * 1536 + arr * 512 + h * 128 + c],
            w2 = convw[2 * 1536 + arr * 512 + h * 128 + c], w3 = convw[3 * 1536 + arr * 512 + h * 128 + c];
      float x0, x1, x2;
      {
        int i = tg * 16;
        x0 = (c0 + i - 3 >= 0) ? bf2f(PROJ[(tok0 + i - 3) * LDP + colp]) : 0.f;
        x1 = (c0 + i - 2 >= 0) ? bf2f(PROJ[(tok0 + i - 2) * LDP + colp]) : 0.f;
        x2 = (c0 + i - 1 >= 0) ? bf2f(PROJ[(tok0 + i - 1) * LDP + colp]) : 0.f;
      }
#pragma unroll 2
      for (int ii = 0; ii < 16; ++ii) {
        int i = tg * 16 + ii;
        float x3 = bf2f(PROJ[(tok0 + i) * LDP + colp]);
        float y = w0 * x0 + w1 * x1 + w2 * x2 + w3 * x3;
        float s = y / (1.f + __expf(-y));
        if (arr == 0) Qt[c * DNP + i] = s;
        else if (arr == 1) Kt[c * DNP + i] = s;
        else V[i * 128 + c] = s;
        x0 = x1; x1 = x2; x2 = x3;
      }
    }
  }
  if (tid < 64) {
    float da = SMALL[(tok0 + tid) * 16 + 8 + h], db = SMALL[(tok0 + tid) * 16 + 12 + h];
    float xx = da + p.in[7][h];
    float sp = fmaxf(xx, 0.f) + log1pf(__expf(-fabsf(xx)));
    float gr = -__expf(p.in[6][h]) * sp;
    float incl = gr;
#pragma unroll
    for (int o = 1; o < 64; o <<= 1) {
      float v = __shfl_up(incl, o);
      if (lane >= o) incl += v;
    }
    gc[tid] = incl;
    beta[tid] = sigmoidf_(db);
    GCg[(tok0 + tid) * 4 + h] = incl;
  }
  __syncthreads();
  {
    const int arr = tid >> 8, i = (tid & 255) >> 2, part = tid & 3;
    const float* src = arr ? Kt : Qt;
    float ss = 0.f;
#pragma unroll 4
    for (int c = part * 32; c < part * 32 + 32; ++c) { float v = src[c * DNP + i]; ss += v * v; }
    ss += __shfl_xor(ss, 1); ss += __shfl_xor(ss, 2);
    if (part == 0) {
      if (arr == 0) qs[i] = rsqrtf(ss + EPS) * 0.08838834764831845f;
      else ks[i] = rsqrtf(ss + EPS);
    }
  }
  __syncthreads();
#pragma unroll 2
  for (int e = tid; e < 128 * 64; e += NTHREADS) {
    int c = e >> 6, i = e & 63;
    Qt[c * DNP + i] *= qs[i];
    Kt[c * DNP + i] *= ks[i];
  }
  __syncthreads();
#pragma unroll 2
  for (int e = tid; e < 64 * 128; e += NTHREADS) {
    int i = e >> 7, d = e & 127;
    QNg[(tok0 + i) * 512 + h * 128 + perm32(d)] = f2bf(Qt[d * DNP + i]);
  }
#pragma unroll 2
  for (int e = tid; e < 128 * 64; e += NTHREADS) {
    int d = e >> 6, i = e & 63;
    KNTg[(size_t)item * 8192 + d * 64 + perm32(i)] = f2bf(Kt[d * DNP + i]);
  }
  {
    const int mat = tid >> 8, bi = (tid & 255) >> 4, bj = tid & 15;
    const int i0 = 4 * bi, j0 = 4 * bj;
    if (j0 <= i0 + 3) {
      const float* Aop = mat ? Qt : Kt;
      float acc[4][4];
#pragma unroll
      for (int x = 0; x < 4; ++x)
#pragma unroll
        for (int y = 0; y < 4; ++y) acc[x][y] = 0.f;
#pragma unroll 4
      for (int d = 0; d < 128; ++d) {
        float4 a4 = *(const float4*)(Aop + d * DNP + i0);
        float4 b4 = *(const float4*)(Kt + d * DNP + j0);
        float av[4] = {a4.x, a4.y, a4.z, a4.w}, bv[4] = {b4.x, b4.y, b4.z, b4.w};
#pragma unroll
        for (int x = 0; x < 4; ++x)
#pragma unroll
          for (int y = 0; y < 4; ++y) acc[x][y] += av[x] * bv[y];
      }
#pragma unroll
      for (int x = 0; x < 4; ++x)
#pragma unroll
        for (int y = 0; y < 4; ++y) {
          int i = i0 + x, j = j0 + y;
          float dec = __expf(gc[i] - gc[j]);
          if (mat == 0) AmT[j * 64 + i] = (i > j) ? beta[i] * acc[x][y] * dec : 0.f;
          else ATTg[(size_t)item * 4096 + i * 64 + perm32(j)] = f2bf((i >= j) ? acc[x][y] * dec : 0.f);
        }
    } else {
#pragma unroll
      for (int x = 0; x < 4; ++x)
#pragma unroll
        for (int y = 0; y < 4; ++y) {
          int i = i0 + x, j = j0 + y;
          if (mat == 0) AmT[j * 64 + i] = 0.f;
          else ATTg[(size_t)item * 4096 + i * 64 + perm32(j)] = 0;
        }
    }
  }
  __syncthreads();
  if (tid < 256) {
    const int c = tid;
    const bool isu = c < 128;
    const int cc = c & 127;
    const int pc = perm32(cc);
#pragma unroll 1
    for (int ib = 0; ib < 4; ++ib) {
      float sreg[16];
#pragma unroll
      for (int r = 0; r < 16; ++r) {
        int i = ib * 16 + r;
        sreg[r] = isu ? V[i * 128 + cc] * beta[i] : Kt[cc * DNP + i] * beta[i] * __expf(gc[i]);
      }
#pragma unroll 2
      for (int j = 0; j < ib * 16; ++j) {
        float xj = isu ? V[j * 128 + cc] : Kt[cc * DNP + j];
        const f32x4* ap = (const f32x4*)(AmT + j * 64 + ib * 16);
        f32x4 a0 = ap[0], a1 = ap[1], a2 = ap[2], a3 = ap[3];
        sreg[0] -= a0[0] * xj; sreg[1] -= a0[1] * xj; sreg[2] -= a0[2] * xj; sreg[3] -= a0[3] * xj;
        sreg[4] -= a1[0] * xj; sreg[5] -= a1[1] * xj; sreg[6] -= a1[2] * xj; sreg[7] -= a1[3] * xj;
        sreg[8] -= a2[0] * xj; sreg[9] -= a2[1] * xj; sreg[10] -= a2[2] * xj; sreg[11] -= a2[3] * xj;
        sreg[12] -= a3[0] * xj; sreg[13] -= a3[1] * xj; sreg[14] -= a3[2] * xj; sreg[15] -= a3[3] * xj;
      }
#pragma unroll
      for (int q = 0; q < 15; ++q) {
        const float* ar = AmT + (ib * 16 + q) * 64 + ib * 16;
#pragma unroll
        for (int r = q + 1; r < 16; ++r) sreg[r] -= ar[r] * sreg[q];
      }
#pragma unroll
      for (int r = 0; r < 16; ++r) {
        int i = ib * 16 + r;
        if (isu) { V[i * 128 + cc] = sreg[r]; Ug[(tok0 + i) * 512 + h * 128 + cc] = f2bf(sreg[r]); }
        else { Kt[cc * DNP + i] = sreg[r]; Wg[(tok0 + i) * 512 + h * 128 + pc] = f2bf(sreg[r]); }
      }
    }
  }
}

__device__ void phase2(const Params& p, unsigned char* smem) {
#ifndef NO_IDX
  for (int i = blockIdx.x; i < 2048; i += gridDim.x) idx_item(p, smem, i & 7, 255 - (i >> 3));
#endif
#ifndef NO_DNL
  if (!(p.flags & 1))
    for (int i = blockIdx.x; i < 2048; i += gridDim.x) dn_local_item(p, smem, i);
#endif
}

constexpr int SC_WP = 272, SC_KP = 144;
constexpr int SC_W = 0, SC_Q = 64 * SC_WP, SC_KT = 2 * 64 * SC_WP, SC_AT = SC_KT + 128 * SC_KP, SC_BUF = SC_AT + 64 * SC_KP;
constexpr int SC_SSQ = 2 * SC_BUF;
constexpr int SC_GC = SC_SSQ + 8 * 64 * 4;

__device__ void dn_scan_item(const Params& p, unsigned char* smem, int bh) {
  const int h = bh & 3, b = bh >> 2;
  const u16* Ug = (const u16*)((const unsigned char*)p.out + DO_U);
  const u16* Wg = (const u16*)((const unsigned char*)p.out + DO_W);
  const u16* QNg = (const u16*)((const unsigned char*)p.out + DO_QN);
  const u16* KNTg = (const u16*)((const unsigned char*)p.out + DO_KNT);
  const u16* ATTg = (const u16*)(p.ws + OFF_ATT);
  const float* GCg = (const float*)(p.ws + OFF_GC);
  const u16* PROJ = (const u16*)(p.ws + OFF_PROJ);
  u16* YDN = (u16*)(p.ws + OFF_YDN);
  const float* ogain = p.in[8];
  const int tid = threadIdx.x, lane = tid & 63, wave = tid >> 6;
  const int fr = lane & 15, fg = lane >> 4;
  const int ecol = wave * 16 + fr;
  const float gn = ogain[ecol];
  float* ssq = (float*)(smem + SC_SSQ);
  float* gcs = (float*)(smem + SC_GC);
  f32x4 S[8];
#pragma unroll
  for (int d = 0; d < 8; ++d) S[d] = (f32x4){0.f, 0.f, 0.f, 0.f};
  u32x4 st[7];
  float gcr = 0.f;
  auto load_step = [&](int n) {
    const size_t tok0 = (size_t)b * SEQ + n * 64;
    const int item = (b * 64 + n) * 4 + h;
#pragma unroll
    for (int k = 0; k < 7; ++k) {
      int c = tid + 512 * k;
      const u16* src;
      if (c < 1024) { int row = c >> 4, ch = c & 15; src = Wg + (tok0 + row) * 512 + h * 128 + ch * 8; }
      else if (c < 2048) { int cc = c - 1024; int row = cc >> 4, ch = cc & 15; src = QNg + (tok0 + row) * 512 + h * 128 + ch * 8; }
      else if (c < 3072) { int cc = c - 2048; src = KNTg + (size_t)item * 8192 + cc * 8; }
      else { int cc = c - 3072; src = ATTg + (size_t)item * 4096 + cc * 8; }
      st[k] = *(const u32x4*)src;
    }
    if (tid < 64) gcr = GCg[(tok0 + tid) * 4 + h];
  };
  auto store_step = [&](int buf) {
    unsigned char* base = smem + buf * SC_BUF;
#pragma unroll
    for (int k = 0; k < 7; ++k) {
      int c = tid + 512 * k;
      unsigned char* dst;
      if (c < 1024) { int row = c >> 4, ch = c & 15; dst = base + SC_W + row * SC_WP + ch * 16; }
      else if (c < 2048) { int cc = c - 1024; int row = cc >> 4, ch = cc & 15; dst = base + SC_Q + row * SC_WP + ch * 16; }
      else if (c < 3072) { int cc = c - 2048; int row = cc >> 3, ch = cc & 7; dst = base + SC_KT + row * SC_KP + ch * 16; }
      else { int cc = c - 3072; int row = cc >> 3, ch = cc & 7; dst = base + SC_AT + row * SC_KP + ch * 16; }
      *(u32x4*)dst = st[k];
    }
    if (tid < 64) gcs[buf * 64 + tid] = gcr;
  };
  __syncthreads();
  load_step(0);
  store_step(0);
  __syncthreads();
  for (int n = 0; n < 64; ++n) {
    const int buf = n & 1;
    const size_t tok0 = (size_t)b * SEQ + n * 64;
    if (n + 1 < 64) load_step(n + 1);
    const unsigned char* base = smem + buf * SC_BUF;
    const u32 ub0 = (u32)(tok0 + 4 * fg) * 512 + (u32)(h * 128 + ecol);
    float uval[4][4];
#pragma unroll
    for (int m = 0; m < 4; ++m)
#pragma unroll
      for (int r = 0; r < 4; ++r) uval[m][r] = bf2f(Ug[ub0 + (u32)((m * 16 + r) * 512)]);
    const float* gcb = gcs + buf * 64 + 4 * fg;
    const float glast = gcs[buf * 64 + 63];
    bf16x8 Sb[4];
#pragma unroll
    for (int kk = 0; kk < 4; ++kk) {
      union { u32 w[4]; bf16x8 v; } cv;
      cv.w[0] = pack2(S[2 * kk][0], S[2 * kk][1]); cv.w[1] = pack2(S[2 * kk][2], S[2 * kk][3]);
      cv.w[2] = pack2(S[2 * kk + 1][0], S[2 * kk + 1][1]); cv.w[3] = pack2(S[2 * kk + 1][2], S[2 * kk + 1][3]);
      Sb[kk] = cv.v;
    }
    f32x4 vnew[4], ov[4];
#pragma unroll
    for (int m = 0; m < 4; ++m) {
      f32x4 aw = {0.f, 0.f, 0.f, 0.f}, aq = {0.f, 0.f, 0.f, 0.f};
#pragma unroll
      for (int kk = 0; kk < 4; ++kk) {
        bf16x8 wf = *(const bf16x8*)(base + SC_W + (m * 16 + fr) * SC_WP + kk * 64 + fg * 16);
        bf16x8 qf = *(const bf16x8*)(base + SC_Q + (m * 16 + fr) * SC_WP + kk * 64 + fg * 16);
        aw = __builtin_amdgcn_mfma_f32_16x16x32_bf16(wf, Sb[kk], aw, 0, 0, 0);
        aq = __builtin_amdgcn_mfma_f32_16x16x32_bf16(qf, Sb[kk], aq, 0, 0, 0);
      }
      f32x4 g4 = *(const f32x4*)(gcb + m * 16);
#pragma unroll
      for (int r = 0; r < 4; ++r) { vnew[m][r] = uval[m][r] - aw[r]; ov[m][r] = aq[r] * __expf(g4[r]); }
    }
    bf16x8 vb[2], vsb[2];
#pragma unroll
    for (int k2 = 0; k2 < 2; ++k2) {
      union { u32 w[4]; bf16x8 v; } c1, c2;
      const int ma = 2 * k2, mb = 2 * k2 + 1;
      c1.w[0] = pack2(vnew[ma][0], vnew[ma][1]); c1.w[1] = pack2(vnew[ma][2], vnew[ma][3]);
      c1.w[2] = pack2(vnew[mb][0], vnew[mb][1]); c1.w[3] = pack2(vnew[mb][2], vnew[mb][3]);
      f32x4 ga4 = *(const f32x4*)(gcb + ma * 16), gb4 = *(const f32x4*)(gcb + mb * 16);
      float sa[4], sb2[4];
#pragma unroll
      for (int r = 0; r < 4; ++r) { sa[r] = vnew[ma][r] * __expf(glast - ga4[r]); sb2[r] = vnew[mb][r] * __expf(glast - gb4[r]); }
      c2.w[0] = pack2(sa[0], sa[1]); c2.w[1] = pack2(sa[2], sa[3]);
      c2.w[2] = pack2(sb2[0], sb2[1]); c2.w[3] = pack2(sb2[2], sb2[3]);
      vb[k2] = c1.v; vsb[k2] = c2.v;
    }
#pragma unroll
    for (int m = 0; m < 4; ++m) {
      f32x4 ao = ov[m];
#pragma unroll
      for (int k2 = 0; k2 < 2; ++k2) {
        bf16x8 af = *(const bf16x8*)(base + SC_AT + (m * 16 + fr) * SC_KP + k2 * 64 + fg * 16);
        ao = __builtin_amdgcn_mfma_f32_16x16x32_bf16(af, vb[k2], ao, 0, 0, 0);
      }
      ov[m] = ao;
#pragma unroll
      for (int r = 0; r < 4; ++r) {
        float sq = ao[r] * ao[r];
        sq += __shfl_xor(sq, 1); sq += __shfl_xor(sq, 2); sq += __shfl_xor(sq, 4); sq += __shfl_xor(sq, 8);
        if (fr == 0) ssq[wave * 64 + m * 16 + 4 * fg + r] = sq;
      }
    }
    const float egl = __expf(glast);
#pragma unroll
    for (int d = 0; d < 8; ++d) {
      f32x4 a = S[d] * egl;
#pragma unroll
      for (int k2 = 0; k2 < 2; ++k2) {
        bf16x8 kf = *(const bf16x8*)(base + SC_KT + (d * 16 + fr) * SC_KP + k2 * 64 + fg * 16);
        a = __builtin_amdgcn_mfma_f32_16x16x32_bf16(kf, vsb[k2], a, 0, 0, 0);
      }
      S[d] = a;
    }
    if (n + 1 < 64) store_step(buf ^ 1);
    __syncthreads();
    {
      const u32 zb0 = (u32)(tok0 + 4 * fg) * LDP + (u32)(C_DZ + h * 128 + ecol);
#pragma unroll
      for (int m = 0; m < 4; ++m)
#pragma unroll
        for (int r = 0; r < 4; ++r) {
          int tk = m * 16 + 4 * fg + r;
          float tot = 0.f;
#pragma unroll
          for (int w = 0; w < 8; ++w) tot += ssq[w * 64 + tk];
          float rstd = rsqrtf(tot * (1.f / 128.f) + EPS);
          float z = bf2f(PROJ[zb0 + (u32)((m * 16 + r) * LDP)]);
          float y = ov[m][r] * rstd * gn * z * sigmoidf_(z);
          YDN[ub0 + (u32)((m * 16 + r) * 512)] = f2bf(y);
        }
    }
    __syncthreads();
  }
}

constexpr int AT_WAVE_BYTES = 2048 + 8192 + 512;
__device__ void attn_query(const Params& p, unsigned char* wsm, int b, int t) {
  const u16* PROJ = (const u16*)(p.ws + OFF_PROJ);
  const u16* SEL = (const u16*)(p.ws + OFF_SEL);
  u16* YATT = (u16*)(p.ws + OFF_YATT);
  const int lane = threadIdx.x & 63;
  float* qs = (float*)wsm;
  float* P = (float*)(wsm + 2048);
  u16* sl = (u16*)(wsm + 2048 + 8192);
  const size_t tokb = (size_t)b * SEQ;
  const size_t tok = tokb + t;
  const int nsel = min(256, t + 1);
  {
    const u16* qrow = PROJ + tok * LDP + C_AQ;
    uint4 v = *(const uint4*)(qrow + lane * 8);
    float* d = qs + lane * 8;
    d[0] = bflo(v.x); d[1] = bfhi(v.x); d[2] = bflo(v.y); d[3] = bfhi(v.y);
    d[4] = bflo(v.z); d[5] = bfhi(v.z); d[6] = bflo(v.w); d[7] = bfhi(v.w);
    const u16* sr = SEL + tok * 256;
#pragma unroll
    for (int i = 0; i < 4; ++i) sl[lane + 64 * i] = sr[lane + 64 * i];
  }
  WAVE_LDS_SYNC();
#pragma unroll 1
  for (int i = 0; i < 4; ++i) {
    const int ki = lane + 64 * i;
    const bool valid = ki < nsel;
    const int s = valid ? (int)sl[ki] : 0;
    const u16* krow = PROJ + (tokb + s) * LDP + C_AK;
#pragma unroll 1
    for (int g = 0; g < 2; ++g) {
      float a0 = 0.f, a1 = 0.f, a2 = 0.f, a3 = 0.f;
#pragma unroll 2
      for (int c = 0; c < 8; ++c) {
        u32x4 kv = *(const u32x4*)(krow + g * 64 + c * 8);
        float kf[8] = {bflo(kv[0]), bfhi(kv[0]), bflo(kv[1]), bfhi(kv[1]), bflo(kv[2]), bfhi(kv[2]), bflo(kv[3]), bfhi(kv[3])};
#pragma unroll
        for (int e = 0; e < 8; e += 4) {
          f32x4 q0 = *(const f32x4*)(qs + (g * 4 + 0) * 64 + c * 8 + e);
          f32x4 q1 = *(const f32x4*)(qs + (g * 4 + 1) * 64 + c * 8 + e);
          f32x4 q2 = *(const f32x4*)(qs + (g * 4 + 2) * 64 + c * 8 + e);
          f32x4 q3 = *(const f32x4*)(qs + (g * 4 + 3) * 64 + c * 8 + e);
          a0 += q0[0] * kf[e] + q0[1] * kf[e + 1] + q0[2] * kf[e + 2] + q0[3] * kf[e + 3];
          a1 += q1[0] * kf[e] + q1[1] * kf[e + 1] + q1[2] * kf[e + 2] + q1[3] * kf[e + 3];
          a2 += q2[0] * kf[e] + q2[1] * kf[e + 1] + q2[2] * kf[e + 2] + q2[3] * kf[e + 3];
          a3 += q3[0] * kf[e] + q3[1] * kf[e + 1] + q3[2] * kf[e + 2] + q3[3] * kf[e + 3];
        }
      }
      f32x4 r4;
      r4[0] = valid ? a0 : -1e30f; r4[1] = valid ? a1 : -1e30f; r4[2] = valid ? a2 : -1e30f; r4[3] = valid ? a3 : -1e30f;
      *(f32x4*)(P + ki * 8 + g * 4) = r4;
    }
  }
  WAVE_LDS_SYNC();
  float lg[4][8];
#pragma unroll
  for (int i = 0; i < 4; ++i) {
    f32x4 x0 = *(const f32x4*)(P + (lane + 64 * i) * 8), x1 = *(const f32x4*)(P + (lane + 64 * i) * 8 + 4);
    lg[i][0] = x0[0]; lg[i][1] = x0[1]; lg[i][2] = x0[2]; lg[i][3] = x0[3];
    lg[i][4] = x1[0]; lg[i][5] = x1[1]; lg[i][6] = x1[2]; lg[i][7] = x1[3];
  }
#pragma unroll
  for (int hh = 0; hh < 8; ++hh) {
    float m = fmaxf(fmaxf(lg[0][hh], lg[1][hh]), fmaxf(lg[2][hh], lg[3][hh]));
    m = wave_max(m);
    float e[4], s = 0.f;
#pragma unroll
    for (int i = 0; i < 4; ++i) { e[i] = __expf(lg[i][hh] - m); s += e[i]; }
    s = wave_sum(s);
    float inv = 1.f / s;
#pragma unroll
    for (int i = 0; i < 4; ++i) lg[i][hh] = e[i] * inv;
  }
#pragma unroll
  for (int i = 0; i < 4; ++i) {
    float* d = P + (lane + 64 * i) * 8;
    *(f32x4*)d = (f32x4){lg[i][0], lg[i][1], lg[i][2], lg[i][3]};
    *(f32x4*)(d + 4) = (f32x4){lg[i][4], lg[i][5], lg[i][6], lg[i][7]};
  }
  WAVE_LDS_SYNC();
  const int g = lane >> 5, d2 = (lane & 31) * 2;
  float o[4][2];
#pragma unroll
  for (int hh = 0; hh < 4; ++hh) { o[hh][0] = 0.f; o[hh][1] = 0.f; }
  for (int k = 0; k < nsel; ++k) {
    const int s = (int)sl[k];
    u32 vv = *(const u32*)(PROJ + (tokb + s) * LDP + C_AV + g * 64 + d2);
    float v0 = bflo(vv), v1 = bfhi(vv);
    f32x4 pw = *(const f32x4*)(P + k * 8 + g * 4);
    o[0][0] += pw[0] * v0; o[0][1] += pw[0] * v1;
    o[1][0] += pw[1] * v0; o[1][1] += pw[1] * v1;
    o[2][0] += pw[2] * v0; o[2][1] += pw[2] * v1;
    o[3][0] += pw[3] * v0; o[3][1] += pw[3] * v1;
  }
#pragma unroll
  for (int hh = 0; hh < 4; ++hh)
    *(u32*)(YATT + tok * 512 + (g * 4 + hh) * 64 + d2) = pack2(o[hh][0], o[hh][1]);
  WAVE_LDS_SYNC();
}

__device__ void phase3(const Params& p, unsigned char* smem) {
  const int wave = threadIdx.x >> 6;
#ifndef NO_SCAN
  if (blockIdx.x < 32) {
    dn_scan_item(p, smem, blockIdx.x);
    return;
  }
#endif
#ifdef NO_ATTN
  return;
#endif
  const int G = gridDim.x;
  const int cls = blockIdx.x & 7;
  const int j = (blockIdx.x >> 3) - 4;
  const int ncls = ((G - 1 - cls) >> 3) + 1 - 4;
  if (ncls <= 0) return;
  unsigned char* wsm = smem + wave * AT_WAVE_BYTES;
  for (int it = j; it < SEQ / 8; it += ncls) {
    int t = it * 8 + wave;
    attn_query(p, wsm, cls, t);
  }
}

__device__ void phase4(const Params& p, unsigned char* smem) {
  const u16* YATT = (const u16*)(p.ws + OFF_YATT);
  const u16* YDN = (const u16*)(p.ws + OFF_YDN);
  const u16* WTA = (const u16*)(p.ws + OFF_WTA);
  const u16* WTB = (const u16*)(p.ws + OFF_WTB);
  const u16* PROJ = (const u16*)(p.ws + OFF_PROJ);
  u16* MG = (u16*)(p.ws + OFF_MERGED);
  const int lane = threadIdx.x & 63, wave = threadIdx.x >> 6;
  const int wm = wave >> 1, wn = wave & 1, fr = lane & 15, fg = lane >> 4;
  const int ntn = DM / G_BN, ntiles = (MTOK / G_BM) * ntn;
  for (int t = blockIdx.x; t < ntiles; t += gridDim.x) {
    const int m0 = (t / ntn) * G_BM, n0 = (t % ntn) * G_BN;
    f32x4 acc[4][4];
    u32 mg[4][4][2];
    const u32 pb0 = (u32)(m0 + wm * 64 + 4 * fg) * LDP + (u32)(n0 + wn * 64 + fr);
    const u32 ob0 = (u32)(m0 + wm * 64 + 4 * fg) * DM + (u32)(n0 + wn * 64 + fr);
    gemm_mainloop(YATT, 512, WTA, 512, 512, m0, n0, smem, acc);
#pragma unroll
    for (int i = 0; i < 4; ++i)
#pragma unroll
      for (int j = 0; j < 4; ++j) {
        float t4[4];
#pragma unroll
        for (int r = 0; r < 4; ++r) {
          float ga = bf2f(PROJ[pb0 + (u32)(C_GA + (i * 16 + r) * LDP + j * 16)]);
          t4[r] = sigmoidf_(ga) * acc[i][j][r];
        }
        mg[i][j][0] = pack2(t4[0], t4[1]); mg[i][j][1] = pack2(t4[2], t4[3]);
        asm volatile("" ::: "memory");
      }
    gemm_mainloop(YDN, 512, WTB, 512, 512, m0, n0, smem, acc);
#pragma unroll
    for (int i = 0; i < 4; ++i)
#pragma unroll
      for (int j = 0; j < 4; ++j)
#pragma unroll
        for (int r = 0; r < 4; ++r) {
          float gb = bf2f(PROJ[pb0 + (u32)(C_GB + (i * 16 + r) * LDP + j * 16)]);
          u32 w = mg[i][j][r >> 1];
          float m1 = (r & 1) ? bfhi(w) : bflo(w);
          MG[ob0 + (u32)((i * 16 + r) * DM + j * 16)] = f2bf(m1 + sigmoidf_(gb) * acc[i][j][r]);
          if (r == 3) asm volatile("" ::: "memory");
        }
  }
}

__device__ void phase5(const Params& p, unsigned char* smem) {
  const u16* MG = (const u16*)(p.ws + OFF_MERGED);
  const u16* WTO = (const u16*)(p.ws + OFF_WTO);
  const float* x = p.in[0];
  const int lane = threadIdx.x & 63, wave = threadIdx.x >> 6;
  const int wm = wave >> 1, wn = wave & 1, fr = lane & 15, fg = lane >> 4;
  const int ntn = DM / G_BN, ntiles = (MTOK / G_BM) * ntn;
  for (int t = blockIdx.x; t < ntiles; t += gridDim.x) {
    const int m0 = (t / ntn) * G_BM, n0 = (t % ntn) * G_BN;
    f32x4 acc[4][4];
    gemm_mainloop(MG, DM, WTO, DM, DM, m0, n0, smem, acc);
    const u32 ob0 = (u32)(m0 + wm * 64 + 4 * fg) * DM + (u32)(n0 + wn * 64 + fr);
    float* outp = p.out;
#pragma unroll
    for (int i = 0; i < 4; ++i)
#pragma unroll
      for (int j = 0; j < 4; ++j)
#pragma unroll
        for (int r = 0; r < 4; ++r) {
          u32 o = ob0 + (u32)((i * 16 + r) * DM + j * 16);
          outp[o] = x[o] + acc[i][j][r];
        }
  }
}

__device__ void phase6(const Params& p, unsigned char* smem) {
  const u16* H2 = (const u16*)(p.ws + OFF_H2);
  const u16* WTQ = (const u16*)(p.ws + OFF_WTQ);
  u16* QP = (u16*)(p.ws + OFF_QP);
  const int lane = threadIdx.x & 63, wave = threadIdx.x >> 6;
  const int wm = wave >> 1, wn = wave & 1, fr = lane & 15, fg = lane >> 4;
  const int ntn = 2048 / G_BN, ntiles = (MTOK / G_BM) * ntn;
  for (int t = blockIdx.x; t < ntiles; t += gridDim.x) {
    const int m0 = (t / ntn) * G_BM, n0 = (t % ntn) * G_BN;
    f32x4 acc[4][4];
    gemm_mainloop(H2, DM, WTQ, DM, DM, m0, n0, smem, acc);
    const u32 ob0 = (u32)(m0 + wm * 64 + 4 * fg) * 2048 + (u32)(n0 + wn * 64 + fr);
#pragma unroll
    for (int i = 0; i < 4; ++i)
#pragma unroll
      for (int j = 0; j < 4; ++j)
#pragma unroll
        for (int r = 0; r < 4; ++r) QP[ob0 + (u32)((i * 16 + r) * 2048 + j * 16)] = f2bf(acc[i][j][r]);
  }
}

__device__ __forceinline__ void top16_insert(float (&vals)[16], int (&idx)[16], float v, int i) {
  if (v > vals[15]) {
    vals[15] = v; idx[15] = i;
#pragma unroll
    for (int k = 15; k > 0; --k) {
      bool sw = vals[k] > vals[k - 1];
      float a = vals[k], bb = vals[k - 1];
      int ia = idx[k], ib = idx[k - 1];
      vals[k - 1] = sw ? a : bb; vals[k] = sw ? bb : a;
      idx[k - 1] = sw ? ia : ib; idx[k] = sw ? ib : ia;
    }
  }
}

constexpr int P7_LD = 132;
__device__ void phase7(const Params& p, unsigned char* smem) {
  const u16* QP = (const u16*)(p.ws + OFF_QP);
  const u16* SKB = (const u16*)(p.ws + OFF_SKB);
  float* TOPS = (float*)(p.ws + OFF_TOPS);
  u8* TOPI = (u8*)(p.ws + OFF_TOPI);
  const int tid = threadIdx.x, lane = tid & 63, wave = tid >> 6;
  const int wm = wave >> 1, wn = wave & 1, fr = lane & 15, fg = lane >> 4;
  const int ntiles = (MTOK / G_BM) * 16;
  float* tile = (float*)smem;
  for (int t = blockIdx.x; t < ntiles; t += gridDim.x) {
    const int m0 = (t >> 4) * G_BM, hp = t & 15;
    f32x4 acc[4][4];
    gemm_mainloop(QP + hp * 128, 2048, SKB + (size_t)hp * 128 * 128, 128, 128, m0, 0, smem, acc);
#pragma unroll
    for (int i = 0; i < 4; ++i)
#pragma unroll
      for (int j = 0; j < 4; ++j)
#pragma unroll
        for (int r = 0; r < 4; ++r) {
          int row = wm * 64 + i * 16 + 4 * fg + r, col = wn * 64 + j * 16 + fr;
          tile[row * P7_LD + col] = acc[i][j][r];
        }
    __syncthreads();
    if (tid < 256) {
      float vals[16]; int idx[16];
#pragma unroll
      for (int k = 0; k < 16; ++k) { vals[k] = -INFINITY; idx[k] = 0; }
      const float* rowp = tile + tid * P7_LD;
      for (int c = 0; c < 128; c += 4) {
        float4 v = *(const float4*)(rowp + c);
        top16_insert(vals, idx, v.x, c);
        top16_insert(vals, idx, v.y, c + 1);
        top16_insert(vals, idx, v.z, c + 2);
        top16_insert(vals, idx, v.w, c + 3);
      }
      size_t o = ((size_t)(m0 + tid) * 16 + hp) * 16;
#pragma unroll
      for (int k = 0; k < 16; k += 4) *(float4*)(TOPS + o + k) = make_float4(vals[k], vals[k + 1], vals[k + 2], vals[k + 3]);
#pragma unroll
      for (int k = 0; k < 16; k += 4)
        *(u32*)(TOPI + o + k) = (u32)idx[k] | ((u32)idx[k + 1] << 8) | ((u32)idx[k + 2] << 16) | ((u32)idx[k + 3] << 24);
    }
    __syncthreads();
  }
}

__device__ void phase7b(const Params& p) {
  const float* TOPS = (const float*)(p.ws + OFF_TOPS);
  const u8* TOPI = (const u8*)(p.ws + OFF_TOPI);
  int* EXPERT = (int*)(p.ws + OFF_EXPERT);
  float* GATE = (float*)(p.ws + OFF_GATE);
  for (int w = blockIdx.x * NTHREADS + threadIdx.x; w < MTOK * 8; w += gridDim.x * NTHREADS) {
    const size_t o = (size_t)w * 32;
    float sa[16], sb[16];
#pragma unroll
    for (int k = 0; k < 16; k += 4) {
      float4 v = *(const float4*)(TOPS + o + k); sa[k] = v.x; sa[k + 1] = v.y; sa[k + 2] = v.z; sa[k + 3] = v.w;
      float4 u = *(const float4*)(TOPS + o + 16 + k); sb[k] = u.x; sb[k + 1] = u.y; sb[k + 2] = u.z; sb[k + 3] = u.w;
    }
    float vals[16]; int idx[16];
#pragma unroll
    for (int k = 0; k < 16; ++k) { vals[k] = -INFINITY; idx[k] = 0; }
#pragma unroll
    for (int a = 0; a < 16; ++a)
#pragma unroll
      for (int bb = 0; bb < 16; ++bb)
        if ((a + 1) * (bb + 1) <= 16) top16_insert(vals, idx, sa[a] + sb[bb], a * 16 + bb);
    float m = vals[0], s = 0.f, e[16];
#pragma unroll
    for (int k = 0; k < 16; ++k) { e[k] = __expf(vals[k] - m); s += e[k]; }
    float inv = 1.f / s;
#pragma unroll
    for (int k = 0; k < 16; ++k) {
      int a = idx[k] >> 4, bb = idx[k] & 15;
      int ex = (int)TOPI[o + a] * 128 + (int)TOPI[o + 16 + bb];
      EXPERT[(size_t)w * 16 + k] = ex;
      GATE[(size_t)w * 16 + k] = e[k] * inv;
    }
  }
  {
    const int lane = threadIdx.x & 63, wave = threadIdx.x >> 6;
    for (int row = blockIdx.x * 8 + wave; row < 2 * 16384; row += gridDim.x * 8) {
      const int tbl = row >> 14, r = row & 16383;
      const f32x4* src = (const f32x4*)((tbl ? p.in[16] : p.in[15]) + (size_t)r * DM) + 4 * lane;
      f32x4 x[4];
      float amax = 0.f;
#pragma unroll
      for (int i = 0; i < 4; ++i) {
        x[i] = src[i];
        amax = fmaxf(amax, fmaxf(fmaxf(fabsf(x[i][0]), fabsf(x[i][1])), fmaxf(fabsf(x[i][2]), fabsf(x[i][3]))));
      }
      amax = wave_max_dpp(amax);
      const float inv = amax > 0.f ? 127.f / amax : 0.f;
      const int bias = tbl ? 128 : 0;
      u32x4 o;
#pragma unroll
      for (int i = 0; i < 4; ++i) {
        int q0 = (int)rintf(x[i][0] * inv) + bias, q1 = (int)rintf(x[i][1] * inv) + bias;
        int q2 = (int)rintf(x[i][2] * inv) + bias, q3 = (int)rintf(x[i][3] * inv) + bias;
        o[i] = (u32)(q0 & 0xff) | ((u32)(q1 & 0xff) << 8) | ((u32)(q2 & 0xff) << 16) | ((u32)(q3 & 0xff) << 24);
      }
      *(u32x4*)(p.ws + (tbl ? OFF_VQ : OFF_UQ) + (size_t)r * DM + 16 * lane) = o;
      if (lane == 0) ((float*)(p.ws + (tbl ? OFF_VS : OFF_US)))[r] = amax * (1.f / 127.f);
    }
  }
}

__device__ void phase8(const Params& p) {
  const u16* H2 = (const u16*)(p.ws + OFF_H2);
  const int* EXPERT = (const int*)(p.ws + OFF_EXPERT);
  const float* GATE = (const float*)(p.ws + OFF_GATE);
  const unsigned char* UQ = p.ws + OFF_UQ;
  const unsigned char* VQ = p.ws + OFF_VQ;
  const float* US = (const float*)(p.ws + OFF_US);
  const float* VS = (const float*)(p.ws + OFF_VS);
  const int lane = threadIdx.x & 63, wave = threadIdx.x >> 6;
  for (int tok = blockIdx.x * 8 + wave; tok < MTOK; tok += gridDim.x * 8) {
    u32 hq[4];
    float sh;
    {
      const u32x4 a = *(const u32x4*)(H2 + (size_t)tok * DM + 16 * lane);
      const u32x4 b = *(const u32x4*)(H2 + (size_t)tok * DM + 16 * lane + 8);
      float hv[16];
#pragma unroll
      for (int c = 0; c < 4; ++c) { hv[2 * c] = bflo(a[c]); hv[2 * c + 1] = bfhi(a[c]); hv[8 + 2 * c] = bflo(b[c]); hv[8 + 2 * c + 1] = bfhi(b[c]); }
      float amax = 0.f;
#pragma unroll
      for (int i = 0; i < 16; ++i) amax = fmaxf(amax, fabsf(hv[i]));
      amax = wave_max_dpp(amax);
      const float inv = amax > 0.f ? 127.f / amax : 0.f;
      sh = amax * (1.f / 127.f);
#pragma unroll
      for (int c = 0; c < 4; ++c) {
        int q0 = (int)rintf(hv[4 * c] * inv), q1 = (int)rintf(hv[4 * c + 1] * inv);
        int q2 = (int)rintf(hv[4 * c + 2] * inv), q3 = (int)rintf(hv[4 * c + 3] * inv);
        hq[c] = (u32)(q0 & 0xff) | ((u32)(q1 & 0xff) << 8) | ((u32)(q2 & 0xff) << 16) | ((u32)(q3 & 0xff) << 24);
      }
    }
    const int e0 = EXPERT[(size_t)tok * 128 + lane], e1 = EXPERT[(size_t)tok * 128 + 64 + lane];
    const float g0 = GATE[(size_t)tok * 128 + lane], g1 = GATE[(size_t)tok * 128 + 64 + lane];
    const float su0 = US[e0], su1 = US[e1], sv0 = VS[e0], sv1 = VS[e1];
    int dacc0 = 0, dacc1 = 0;
#pragma unroll 1
    for (int half = 0; half < 2; ++half) {
      const int ev = half ? e1 : e0;
      int dacc = 0;
#pragma unroll 1
      for (int k = 0; k < 64; k += 8) {
        u32x4 ua[8];
#pragma unroll
        for (int j = 0; j < 8; ++j) {
          const int e = __builtin_amdgcn_readlane(ev, k + j);
          ua[j] = *(const u32x4*)(UQ + (size_t)e * DM + 16 * lane);
        }
#pragma unroll
        for (int j = 0; j < 8; ++j) {
          int sdot = 0;
#pragma unroll
          for (int c = 0; c < 4; ++c) sdot = __builtin_amdgcn_sdot4((int)ua[j][c], (int)hq[c], sdot, false);
          sdot = wave_sum_i_dpp(sdot);
          dacc = (lane == k + j) ? sdot : dacc;
        }
      }
      if (half) dacc1 = dacc; else dacc0 = dacc;
    }
    const float d0 = (float)dacc0 * su0 * sh, d1 = (float)dacc1 * su1 * sh;
    const float cf0 = g0 * 0.5f * d0 * (1.f + erff(d0 * 0.70710678118654752f)) * sv0;
    const float cf1 = g1 * 0.5f * d1 * (1.f + erff(d1 * 0.70710678118654752f)) * sv1;
    const float csum = wave_sum_dpp(cf0 + cf1);
    float ov[16];
#pragma unroll
    for (int i = 0; i < 16; ++i) ov[i] = 0.f;
#pragma unroll 1
    for (int half = 0; half < 2; ++half) {
      const int ev = half ? e1 : e0;
      const float cv = half ? cf1 : cf0;
#pragma unroll 1
      for (int k = 0; k < 64; k += 8) {
        u32x4 va[8];
        float cc[8];
#pragma unroll
        for (int j = 0; j < 8; ++j) {
          const int e = __builtin_amdgcn_readlane(ev, k + j);
          cc[j] = __int_as_float(__builtin_amdgcn_readlane(__float_as_int(cv), k + j));
          va[j] = *(const u32x4*)(VQ + (size_t)e * DM + 16 * lane);
        }
#pragma unroll
        for (int j = 0; j < 8; ++j) {
#pragma unroll
          for (int c = 0; c < 4; ++c) {
            const u32 w = va[j][c];
            ov[4 * c + 0] += cc[j] * (float)(w & 0xffu);
            ov[4 * c + 1] += cc[j] * (float)((w >> 8) & 0xffu);
            ov[4 * c + 2] += cc[j] * (float)((w >> 16) & 0xffu);
            ov[4 * c + 3] += cc[j] * (float)(w >> 24);
          }
        }
      }
    }
    const float corr = 128.f * csum;
    f32x4* op = (f32x4*)(p.out + (size_t)tok * DM + 16 * lane);
#pragma unroll
    for (int c = 0; c < 4; ++c) {
      f32x4 x = op[c];
      x[0] += ov[4 * c] - corr; x[1] += ov[4 * c + 1] - corr; x[2] += ov[4 * c + 2] - corr; x[3] += ov[4 * c + 3] - corr;
      op[c] = x;
    }
  }
}

__global__ void __launch_bounds__(NTHREADS, 2) mk_fwd(Params p) {
  cg::grid_group grid = cg::this_grid();
  __shared__ __attribute__((aligned(16))) unsigned char smem[SMEM_BYTES];
  const int lo = p.ph_lo, hi = p.ph_hi;
#define RUN(k, call) if (lo <= (k) && (k) < hi) { call; if ((k) + 1 < hi) grid.sync(); }
  RUN(0, phase0(p, smem))
  RUN(1, phase1(p, smem))
  RUN(2, phase2(p, smem))
  RUN(3, phase3(p, smem))
  RUN(4, phase4(p, smem))
  RUN(5, phase5(p, smem))
  RUN(6, rmsnorm_rows(p.out, p.in[12], (u16*)(p.ws + OFF_H2)))
  RUN(7, phase6(p, smem))
  RUN(8, phase7(p, smem))
  RUN(9, phase7b(p))
  RUN(10, phase8(p))
#undef RUN
}

extern "C" void kernel_launch(void* const* d_in, const int* in_sizes, int n_in,
                              void* d_out, int out_size, void* d_ws, size_t ws_size,
                              hipStream_t stream) {
  static int grid_blocks = 0;
  if (!grid_blocks) {
    int dev = 0, cus = 0, per_cu = 0;
    (void)hipGetDevice(&dev);
    (void)hipDeviceGetAttribute(&cus, hipDeviceAttributeMultiprocessorCount, dev);
    (void)hipOccupancyMaxActiveBlocksPerMultiprocessor(&per_cu, mk_fwd, NTHREADS, 0);
    if (per_cu < 1) per_cu = 1;
    if (per_cu > 1) per_cu = 1;
    grid_blocks = cus * per_cu;
    fprintf(stderr, "mk_fwd: cus=%d per_cu=%d grid=%d ws=%zu\n", cus, per_cu, grid_blocks, ws_size);
  }
  Params p{};
  for (int i = 0; i < 17 && i < n_in; ++i) p.in[i] = (const float*)d_in[i];
  p.out = (float*)d_out;
  p.ws = (unsigned char*)d_ws;
  p.ph_lo = 0; p.ph_hi = 11;
  void* args[] = {&p};
  hipError_t e = hipLaunchCooperativeKernel((void*)mk_fwd, dim3(grid_blocks), dim3(NTHREADS), args, 0, stream);
  if (e != hipSuccess) fprintf(stderr, "cooperative launch failed: %s (grid %d)\n", hipGetErrorString(e), grid_blocks);
#ifdef EXTRA_LO
  {
    Params p2 = p;
    p2.ph_lo = EXTRA_LO; p2.ph_hi = EXTRA_HI; p2.flags = 1;
    void* args2[] = {&p2};
    (void)hipLaunchCooperativeKernel((void*)mk_fwd, dim3(grid_blocks), dim3(NTHREADS), args2, 0, stream);
  }
#endif
}
```

```cpp
#include <hip/hip_runtime.h>
#include <hip/hip_bf16.h>
#include <hip/hip_cooperative_groups.h>
#include <cstdio>
#include <cstdint>
namespace cg = cooperative_groups;

typedef unsigned short u16;
typedef unsigned int u32;
typedef unsigned char u8;
typedef short bf16x8 __attribute__((ext_vector_type(8)));
typedef float f32x4 __attribute__((ext_vector_type(4)));
typedef unsigned int u32x4 __attribute__((ext_vector_type(4)));
typedef unsigned int u32x2 __attribute__((ext_vector_type(2)));

constexpr int NTHREADS = 512;
constexpr int BATCH = 8, SEQ = 4096, DM = 1024, MTOK = BATCH * SEQ;
constexpr int LDP = 5440;
constexpr int NPADW = 5504;
constexpr int C_AQ = 0, C_AK = 512, C_AV = 640, C_IQ = 768, C_IK = 1280, C_DQ = 1344, C_DK = 1856, C_DV = 2368,
              C_DZ = 2880, C_GA = 3392, C_GB = 4416;
constexpr size_t MiB = 1ull << 20;
constexpr size_t OFF_WTIN = 1 * MiB, OFF_WTA = 12 * MiB, OFF_WTB = 13 * MiB, OFF_WTO = 14 * MiB, OFF_WTQ = 16 * MiB,
                 OFF_SKB = 20 * MiB, OFF_SMALL = 21 * MiB, OFF_H = 23 * MiB, OFF_ATT = 23 * MiB, OFF_GC = 39 * MiB,
                 OFF_MERGED = 23 * MiB, OFF_PROJ = 87 * MiB, OFF_SEL = 427 * MiB, OFF_YATT = 443 * MiB,
                 OFF_YDN = 475 * MiB;
constexpr size_t OFF_H2 = OFF_PROJ, OFF_QP = OFF_PROJ + 64 * MiB, OFF_TOPS = OFF_PROJ + 192 * MiB,
                 OFF_TOPI = OFF_PROJ + 224 * MiB, OFF_EXPERT = OFF_PROJ + 232 * MiB, OFF_GATE = OFF_PROJ + 248 * MiB;
constexpr size_t OFF_UQ = OFF_PROJ + 264 * MiB, OFF_VQ = OFF_PROJ + 280 * MiB, OFF_US = OFF_PROJ + 296 * MiB, OFF_VS = OFF_PROJ + 297 * MiB;
constexpr size_t DO_U = 0, DO_W = 32 * MiB, DO_QN = 64 * MiB, DO_KNT = 96 * MiB;

constexpr int SMEM_BYTES = 162816;
constexpr float EPS = 1e-6f;

struct Params {
  const float* in[17];
  float* out;
  unsigned char* ws;
  int ph_lo, ph_hi;
  int flags, pad;
};

typedef __bf16 bf16x2_t __attribute__((ext_vector_type(2)));
typedef float f32x2_t __attribute__((ext_vector_type(2)));
__device__ __forceinline__ u32 pack2(float a, float b) {
  f32x2_t f = {a, b};
  return __builtin_bit_cast(u32, __builtin_convertvector(f, bf16x2_t));
}
__device__ __forceinline__ u16 f2bf(float f) { return (u16)(pack2(f, f) & 0xffffu); }
__device__ __forceinline__ float bf2f(u16 h) { return __uint_as_float(((u32)h) << 16); }
__device__ __forceinline__ float bflo(u32 w) { return __uint_as_float(w << 16); }
__device__ __forceinline__ float bfhi(u32 w) { return __uint_as_float(w & 0xffff0000u); }
__device__ __forceinline__ float wave_sum(float v) {
#pragma unroll
  for (int o = 32; o > 0; o >>= 1) v += __shfl_xor(v, o);
  return v;
}
__device__ __forceinline__ float wave_max(float v) {
#pragma unroll
  for (int o = 32; o > 0; o >>= 1) v = fmaxf(v, __shfl_xor(v, o));
  return v;
}
__device__ __forceinline__ float dot2bf(u32 a, u32 b, float acc) {
  return __builtin_amdgcn_fdot2_f32_bf16(__builtin_bit_cast(bf16x2_t, a), __builtin_bit_cast(bf16x2_t, b), acc, false);
}
#define DPPF(v, ctrl) __int_as_float(__builtin_amdgcn_update_dpp(0, __float_as_int(v), ctrl, 0xf, 0xf, true))
__device__ __forceinline__ float wave_sum_dpp(float v) {
  v += DPPF(v, 0xb1);
  v += DPPF(v, 0x4e);
  v += DPPF(v, 0x124);
  v += DPPF(v, 0x128);
  float r0 = __int_as_float(__builtin_amdgcn_readlane(__float_as_int(v), 0));
  float r1 = __int_as_float(__builtin_amdgcn_readlane(__float_as_int(v), 16));
  float r2 = __int_as_float(__builtin_amdgcn_readlane(__float_as_int(v), 32));
  float r3 = __int_as_float(__builtin_amdgcn_readlane(__float_as_int(v), 48));
  return (r0 + r1) + (r2 + r3);
}
#define DPPI(v, ctrl) __builtin_amdgcn_update_dpp(0, (v), ctrl, 0xf, 0xf, true)
__device__ __forceinline__ int wave_sum_i_dpp(int v) {
  v += DPPI(v, 0xb1);
  v += DPPI(v, 0x4e);
  v += DPPI(v, 0x124);
  v += DPPI(v, 0x128);
  return (__builtin_amdgcn_readlane(v, 0) + __builtin_amdgcn_readlane(v, 16)) +
         (__builtin_amdgcn_readlane(v, 32) + __builtin_amdgcn_readlane(v, 48));
}
__device__ __forceinline__ float wave_max_dpp(float v) {
  v = fmaxf(v, DPPF(v, 0xb1));
  v = fmaxf(v, DPPF(v, 0x4e));
  v = fmaxf(v, DPPF(v, 0x124));
  v = fmaxf(v, DPPF(v, 0x128));
  float r0 = __int_as_float(__builtin_amdgcn_readlane(__float_as_int(v), 0));
  float r1 = __int_as_float(__builtin_amdgcn_readlane(__float_as_int(v), 16));
  float r2 = __int_as_float(__builtin_amdgcn_readlane(__float_as_int(v), 32));
  float r3 = __int_as_float(__builtin_amdgcn_readlane(__float_as_int(v), 48));
  return fmaxf(fmaxf(r0, r1), fmaxf(r2, r3));
}
#define WAVE_LDS_SYNC() asm volatile("s_waitcnt lgkmcnt(0)" ::: "memory")
__device__ __forceinline__ float sigmoidf_(float x) { return __builtin_amdgcn_rcpf(1.f + __expf(-x)); }
__device__ __forceinline__ int perm32(int k) {
  int blk = k & ~31, r = k & 31;
  int p = (r < 16) ? (8 * (r >> 2) + (r & 3)) : (8 * ((r - 16) >> 2) + 4 + (r & 3));
  return blk + p;
}

__device__ __forceinline__ int win_map(int n) {
  if (n < 1344) return n;
  if (n < 3392) return n + 8;
  if (n < 5440) return n + 16;
  if (n < 5448) return 1344 + (n - 5440);
  if (n < 5452) return 3400 + (n - 5448);
  if (n < 5456) return 3404 + (n - 5452);
  return -1;
}
__device__ void transpose_tile(const float* __restrict__ src, int Nsrc, u16* __restrict__ dst, int K, int k0, int n0,
                               bool mapped, float* tile  ) {
  const int tid = threadIdx.x;
  {
    const int tx = tid & 63, ty = tid >> 6;
    int n = n0 + tx;
    int sc = mapped ? win_map(n) : n;
#pragma unroll
    for (int i = 0; i < 8; ++i) {
      int k = ty + 8 * i;
      float v = (sc >= 0) ? src[(size_t)(k0 + k) * Nsrc + sc] : 0.f;
      tile[k * 65 + tx] = v;
    }
  }
  __syncthreads();
  {
    const int n = tid >> 3, kc = (tid & 7) * 8;
    u32 w[4];
#pragma unroll
    for (int j = 0; j < 4; ++j) w[j] = pack2(tile[(kc + 2 * j) * 65 + n], tile[(kc + 2 * j + 1) * 65 + n]);
    *(uint4*)(dst + (size_t)(n0 + n) * K + k0 + kc) = make_uint4(w[0], w[1], w[2], w[3]);
  }
  __syncthreads();
}

__device__ void rmsnorm_rows(const float* __restrict__ x, const float* __restrict__ gain, u16* __restrict__ out) {
  const int lane = threadIdx.x & 63, wave = threadIdx.x >> 6;
  float4 g[4];
#pragma unroll
  for (int i = 0; i < 4; ++i) g[i] = ((const float4*)gain)[lane + 64 * i];
  for (int row = blockIdx.x * 8 + wave; row < MTOK; row += gridDim.x * 8) {
    const float4* xr = (const float4*)(x + (size_t)row * DM);
    float4 v[4];
    float ss = 0.f;
#pragma unroll
    for (int i = 0; i < 4; ++i) {
      v[i] = xr[lane + 64 * i];
      ss += v[i].x * v[i].x + v[i].y * v[i].y + v[i].z * v[i].z + v[i].w * v[i].w;
    }
    ss = wave_sum(ss);
    float r = rsqrtf(ss * (1.f / DM) + EPS);
#pragma unroll
    for (int i = 0; i < 4; ++i) {
      uint2 o;
      o.x = pack2(v[i].x * r * g[i].x, v[i].y * r * g[i].y);
      o.y = pack2(v[i].z * r * g[i].z, v[i].w * r * g[i].w);
      *(uint2*)(out + (size_t)row * DM + 4 * (lane + 64 * i)) = o;
    }
  }
}

__device__ void phase0(const Params& p, unsigned char* smem) {
  float* tile = (float*)smem;
  unsigned char* ws = p.ws;
  const int n_in = 16 * 86, n_a = 8 * 16, n_b = 8 * 16, n_o = 16 * 16, n_q = 16 * 32;
  const int total = n_in + n_a + n_b + n_o + n_q;
  for (int t = blockIdx.x; t < total; t += gridDim.x) {
    int i = t;
    if (i < n_in) { transpose_tile(p.in[2], 5456, (u16*)(ws + OFF_WTIN), 1024, (i / 86) * 64, (i % 86) * 64, true, tile); continue; }
    i -= n_in;
    if (i < n_a) { transpose_tile(p.in[9], 1024, (u16*)(ws + OFF_WTA), 512, (i / 16) * 64, (i % 16) * 64, false, tile); continue; }
    i -= n_a;
    if (i < n_b) { transpose_tile(p.in[10], 1024, (u16*)(ws + OFF_WTB), 512, (i / 16) * 64, (i % 16) * 64, false, tile); continue; }
    i -= n_b;
    if (i < n_o) { transpose_tile(p.in[11], 1024, (u16*)(ws + OFF_WTO), 1024, (i / 16) * 64, (i % 16) * 64, false, tile); continue; }
    i -= n_o;
    transpose_tile(p.in[13], 2048, (u16*)(ws + OFF_WTQ), 1024, (i / 32) * 64, (i % 32) * 64, false, tile);
  }
  {
    const float* sk = p.in[14];
    u16* skb = (u16*)(ws + OFF_SKB);
    for (int i = blockIdx.x * NTHREADS + threadIdx.x; i < 16 * 128 * 128; i += gridDim.x * NTHREADS) skb[i] = f2bf(sk[i]);
  }
  rmsnorm_rows(p.in[0], p.in[1], (u16*)(ws + OFF_H));
}

constexpr int G_BM = 256, G_BN = 128, G_BK = 64;
constexpr int G_ABYTES = G_BM * 128, G_BBYTES = G_BN * 128, G_STAGE = G_ABYTES + G_BBYTES;

__device__ __forceinline__ void gemm_mainloop(const u16* __restrict__ A, int lda, const u16* __restrict__ Bt, int ldb, int K,
                                              int m0, int n0, unsigned char* smem, f32x4 (&acc)[4][4]) {
  const int tid = threadIdx.x, lane = tid & 63, wave = tid >> 6;
  const int wm = wave >> 1, wn = wave & 1;
#pragma unroll
  for (int i = 0; i < 4; ++i)
#pragma unroll
    for (int j = 0; j < 4; ++j) acc[i][j] = (f32x4){0.f, 0.f, 0.f, 0.f};
  const int kc = tid & 7;
  const int arow = tid >> 3;
  u32x4 ra[4], rb[2];
  const u16* ap = A + (size_t)(m0 + arow) * lda + kc * 8;
  const u16* bp = Bt + (size_t)(n0 + arow) * ldb + kc * 8;
  const int nk = K / G_BK;
  const int fr = lane & 15, fg = lane >> 4;
#define G_LOAD(kt_)                                                                       \
  {                                                                                       \
    const u16* ap2_ = ap + (size_t)(kt_) * G_BK;                                          \
    const u16* bp2_ = bp + (size_t)(kt_) * G_BK;                                          \
    _Pragma("unroll") for (int i = 0; i < 4; ++i) ra[i] = *(const u32x4*)(ap2_ + (size_t)(64 * i) * lda); \
    _Pragma("unroll") for (int i = 0; i < 2; ++i) rb[i] = *(const u32x4*)(bp2_ + (size_t)(64 * i) * ldb); \
  }
#define G_STORE(st_)                                                                      \
  {                                                                                       \
    unsigned char* sa_ = smem + (st_) * G_STAGE;                                          \
    unsigned char* sb_ = sa_ + G_ABYTES;                                                  \
    _Pragma("unroll") for (int i = 0; i < 4; ++i) { int r = arow + 64 * i; *(u32x4*)(sa_ + r * 128 + ((kc ^ (r & 7)) << 4)) = ra[i]; } \
    _Pragma("unroll") for (int i = 0; i < 2; ++i) { int r = arow + 64 * i; *(u32x4*)(sb_ + r * 128 + ((kc ^ (r & 7)) << 4)) = rb[i]; } \
  }
  G_LOAD(0)
  __syncthreads();
  G_STORE(0)
  if (nk > 1) G_LOAD(1)
  __syncthreads();
  for (int kt = 0; kt < nk; ++kt) {
    if (kt + 1 < nk) G_STORE((kt + 1) & 1)
    if (kt + 2 < nk) G_LOAD(kt + 2)
    __builtin_amdgcn_sched_barrier(0);
    const unsigned char* sa = smem + (kt & 1) * G_STAGE;
    const unsigned char* sb = sa + G_ABYTES;
#pragma unroll
    for (int kk = 0; kk < 2; ++kk) {
      bf16x8 af[4], bfr[4];
#pragma unroll
      for (int i = 0; i < 4; ++i) {
        int r = wm * 64 + i * 16 + fr;
        af[i] = *(const bf16x8*)(sa + r * 128 + (((kk * 4 + fg) ^ (r & 7)) << 4));
      }
#pragma unroll
      for (int j = 0; j < 4; ++j) {
        int r = wn * 64 + j * 16 + fr;
        bfr[j] = *(const bf16x8*)(sb + r * 128 + (((kk * 4 + fg) ^ (r & 7)) << 4));
      }
#pragma unroll
      for (int i = 0; i < 4; ++i)
#pragma unroll
        for (int j = 0; j < 4; ++j) acc[i][j] = __builtin_amdgcn_mfma_f32_16x16x32_bf16(af[i], bfr[j], acc[i][j], 0, 0, 0);
    }
    __syncthreads();
  }
#undef G_LOAD
#undef G_STORE
}

__device__ void phase1(const Params& p, unsigned char* smem) {
  const u16* H = (const u16*)(p.ws + OFF_H);
  const u16* WT = (const u16*)(p.ws + OFF_WTIN);
  u16* PROJ = (u16*)(p.ws + OFF_PROJ);
  float* SMALL = (float*)(p.ws + OFF_SMALL);
  const int lane = threadIdx.x & 63, wave = threadIdx.x >> 6;
  const int wm = wave >> 1, wn = wave & 1, fr = lane & 15, fg = lane >> 4;
  const int ntn = NPADW / G_BN;
  const int ntiles = (MTOK / G_BM) * ntn;
  for (int t = blockIdx.x; t < ntiles; t += gridDim.x) {
    const int m0 = (t / ntn) * G_BM, n0 = (t % ntn) * G_BN;
    f32x4 acc[4][4];
    gemm_mainloop(H, DM, WT, DM, DM, m0, n0, smem, acc);
    const int cbase = n0 + wn * 64;
    const u32 rb0 = (u32)(m0 + wm * 64 + 4 * fg) * LDP + (u32)(cbase + fr);
    const u32 sb0 = (u32)(m0 + wm * 64 + 4 * fg) * 16 + (u32)(cbase + fr - LDP);
    if (cbase < C_AV) {
      const float* gain = (cbase < C_AK) ? p.in[3] : p.in[4];
      const float extra = (cbase < C_AK) ? 0.125f : 1.0f;
      float gj[4];
#pragma unroll
      for (int j = 0; j < 4; ++j) gj[j] = gain[j * 16 + fr] * extra;
#pragma unroll
      for (int i = 0; i < 4; ++i) {
        float ss[4];
#pragma unroll
        for (int r = 0; r < 4; ++r) {
          float s = 0.f;
#pragma unroll
          for (int j = 0; j < 4; ++j) s += acc[i][j][r] * acc[i][j][r];
          s += __shfl_xor(s, 1); s += __shfl_xor(s, 2); s += __shfl_xor(s, 4); s += __shfl_xor(s, 8);
          ss[r] = rsqrtf(s * (1.f / 64.f) + EPS);
        }
#pragma unroll
        for (int j = 0; j < 4; ++j)
#pragma unroll
          for (int r = 0; r < 4; ++r) {
            PROJ[rb0 + (u32)((i * 16 + r) * LDP + j * 16)] = f2bf(acc[i][j][r] * ss[r] * gj[j]);
          }
      }
    } else {
#pragma unroll
      for (int i = 0; i < 4; ++i)
#pragma unroll
        for (int j = 0; j < 4; ++j) {
          int col = cbase + j * 16 + fr;
#pragma unroll
          for (int r = 0; r < 4; ++r) {
            if (col < LDP) PROJ[rb0 + (u32)((i * 16 + r) * LDP + j * 16)] = f2bf(acc[i][j][r]);
            else if (col < LDP + 16) SMALL[sb0 + (u32)((i * 16 + r) * 16 + j * 16)] = acc[i][j][r];
          }
        }
    }
  }
}

constexpr int IDX_RS = 8208;

__device__ __forceinline__ u32 f2key(float x) {
  _Float16 h = (_Float16)x;
  u32 b = (u32) * (u16*)&h;
  return (b & 0x8000u) ? ((~b) & 0xffffu) : (b | 0x8000u);
}
__device__ __forceinline__ int count_ge_wave(const u32 (&kreg)[32], u32 mid) {
  const u32 m1 = (mid - 1u) * 0x00010001u;
  const u32 one = 0x00010001u;
  u32 acc0 = 0u, acc1 = 0u;
#pragma unroll
  for (int i = 0; i < 32; i += 2) {
    u32 t0, t1;
    asm("v_pk_sub_u16 %0, %1, %2 clamp" : "=v"(t0) : "v"(kreg[i]), "s"(m1));
    asm("v_pk_sub_u16 %0, %1, %2 clamp" : "=v"(t1) : "v"(kreg[i + 1]), "s"(m1));
    asm("v_pk_min_u16 %0, %1, %2" : "=v"(t0) : "v"(t0), "s"(one));
    asm("v_pk_min_u16 %0, %1, %2" : "=v"(t1) : "v"(t1), "s"(one));
    asm("v_pk_add_u16 %0, %1, %2" : "=v"(acc0) : "v"(acc0), "v"(t0));
    asm("v_pk_add_u16 %0, %1, %2" : "=v"(acc1) : "v"(acc1), "v"(t1));
  }
  int c = (int)((acc0 & 0xffffu) + (acc0 >> 16) + (acc1 & 0xffffu) + (acc1 >> 16));
  return wave_sum_i_dpp(c);
}

__device__ void idx_item(const Params& p, unsigned char* smem, int b, int tq) {
  const u16* PROJ = (const u16*)(p.ws + OFF_PROJ);
  const float* SMALL = (const float*)(p.ws + OFF_SMALL);
  u16* SEL = (u16*)(p.ws + OFF_SEL);
  const int tid = threadIdx.x, lane = tid & 63, wave = tid >> 6;
  const int t0 = tq * 16;
  const size_t tokb = (size_t)b * SEQ;
  if (tq < 16) {
    for (int rr = 0; rr < 2; ++rr) {
      int row = 2 * wave + rr, t = t0 + row;
      u16* out = SEL + (tokb + t) * 256;
      for (int i = lane; i < 256; i += 64) out[i] = (i <= t) ? (u16)i : (u16)0xFFFF;
    }
    return;
  }
  const int q = lane & 15, g = lane >> 4;
  __syncthreads();
  {
    const u16* iqrow = PROJ + (tokb + t0 + q) * LDP + C_IQ;
    bf16x8 bq[8][2];
    float wq[8];
#pragma unroll
    for (int h = 0; h < 8; ++h) {
      bq[h][0] = *(const bf16x8*)(iqrow + h * 64 + g * 8);
      bq[h][1] = *(const bf16x8*)(iqrow + h * 64 + 32 + g * 8);
      wq[h] = SMALL[(tokb + t0 + q) * 16 + h];
    }
    const int nkb = tq + 1;
    const int niter = (nkb > wave) ? ((nkb - wave + 7) >> 3) : 0;
    const u16* ikbase = PROJ + (tokb + q) * LDP + C_IK + g * 8;
    bf16x8 ca[3][2];
#pragma unroll
    for (int j = 0; j < 3; ++j)
      if (j < niter) {
        const u16* ikrow = ikbase + (size_t)((wave + 8 * j) * 16) * LDP;
        ca[j][0] = *(const bf16x8*)(ikrow); ca[j][1] = *(const bf16x8*)(ikrow + 32);
      }
    for (int i0 = 0; i0 < ((p.flags & 8) ? 0 : niter); i0 += 3) {
#pragma unroll
      for (int j = 0; j < 3; ++j) {
        if (i0 + j < niter) {
          const int s0 = (wave + 8 * (i0 + j)) * 16;
          f32x4 tot = {0.f, 0.f, 0.f, 0.f};
#pragma unroll
          for (int h = 0; h < 8; ++h) {
            f32x4 acc = {0.f, 0.f, 0.f, 0.f};
            acc = __builtin_amdgcn_mfma_f32_16x16x32_bf16(ca[j][0], bq[h][0], acc, 0, 0, 0);
            acc = __builtin_amdgcn_mfma_f32_16x16x32_bf16(ca[j][1], bq[h][1], acc, 0, 0, 0);
#pragma unroll
            for (int r = 0; r < 4; ++r) tot[r] += wq[h] * fmaxf(acc[r], 0.f);
          }
          if (i0 + 3 + j < niter) {
            const u16* ikrow = ikbase + (size_t)((wave + 8 * (i0 + 3 + j)) * 16) * LDP;
            ca[j][0] = *(const bf16x8*)(ikrow); ca[j][1] = *(const bf16x8*)(ikrow + 32);
          }
          u32 k[4];
#pragma unroll
          for (int r = 0; r < 4; ++r) {
            int sidx = s0 + 4 * g + r;
            k[r] = (sidx <= t0 + q) ? f2key(tot[r]) : 0u;
          }
          u32x2 w2 = {k[0] | (k[1] << 16), k[2] | (k[3] << 16)};
          *(u32x2*)(smem + q * IDX_RS + (s0 + 4 * g) * 2) = w2;
        }
      }
    }
    const int nk = t0 + 16, nk64 = (nk + 63) & ~63;
    for (int i = tid; i < 16 * (nk64 - nk); i += NTHREADS) {
      int row = i / (nk64 - nk), c = nk + i % (nk64 - nk);
      *(u16*)(smem + row * IDX_RS + c * 2) = 0;
    }
  }
  __syncthreads();
  const int nk64 = (t0 + 16 + 63) & ~63;
  for (int rr = 0; rr < ((p.flags & 16) ? 0 : 2); ++rr) {
    const int row = 2 * wave + rr, t = t0 + row;
    u16* out = SEL + (tokb + t) * 256;
    u32 kreg[32];
    if (lane * 64 < nk64) {
      const uint4* src = (const uint4*)(smem + row * IDX_RS + lane * 128);
#pragma unroll
      for (int i = 0; i < 8; ++i) {
        uint4 v = src[i];
        kreg[4 * i] = v.x; kreg[4 * i + 1] = v.y; kreg[4 * i + 2] = v.z; kreg[4 * i + 3] = v.w;
      }
    } else {
#pragma unroll
      for (int i = 0; i < 32; ++i) kreg[i] = 0u;
    }
    WAVE_LDS_SYNC();
    u32 lo = 1u, hi = 65535u;
    while (lo < hi) {
      u32 mid = (lo + hi + 1u) >> 1;
      int c = count_ge_wave(kreg, mid);
      if (c >= 256) lo = mid; else hi = mid - 1u;
    }
    const u32 tau = lo;
    int gt = 0, eq = 0;
#pragma unroll
    for (int i = 0; i < 32; ++i) {
      u32 a = kreg[i] & 0xffffu, c2 = kreg[i] >> 16;
      gt += (a > tau) ? 1 : 0; gt += (c2 > tau) ? 1 : 0;
      eq += (a == tau) ? 1 : 0; eq += (c2 == tau) ? 1 : 0;
    }
    int packed = gt | (eq << 16);
    int incl = packed;
#pragma unroll
    for (int o = 1; o < 64; o <<= 1) {
      int v = __shfl_up(incl, o);
      if (lane >= o) incl += v;
    }
    const int excl = incl - packed;
    const int total = __shfl(incl, 63);
    const int need = 256 - (total & 0xffff);
    const int pg = excl & 0xffff, pe = excl >> 16;
    int pos = pg + min(pe, need);
    int eqseen = pe;
    u16* lrow = (u16*)(smem + row * IDX_RS);
#pragma unroll
    for (int i = 0; i < 32; ++i) {
#pragma unroll
      for (int hh = 0; hh < 2; ++hh) {
        u32 kv = hh ? (kreg[i] >> 16) : (kreg[i] & 0xffffu);
        int idx = lane * 64 + 2 * i + hh;
        bool take = false;
        if (kv > tau) take = true;
        else if (kv == tau) { take = (eqseen < need); ++eqseen; }
        if (take) { lrow[pos] = (u16)idx; ++pos; }
      }
    }
    WAVE_LDS_SYNC();
    *(u32x2*)(out + lane * 4) = *(const u32x2*)(lrow + lane * 4);
    WAVE_LDS_SYNC();
  }
}

constexpr int DNP = 68;
__device__ void dn_local_item(const Params& p, unsigned char* smem, int item) {
  const int h = item & 3, n = (item >> 2) & 63, b = item >> 8;
  const u16* PROJ = (const u16*)(p.ws + OFF_PROJ);
  const float* SMALL = (const float*)(p.ws + OFF_SMALL);
  u16* Ug = (u16*)((unsigned char*)p.out + DO_U);
  u16* Wg = (u16*)((unsigned char*)p.out + DO_W);
  u16* QNg = (u16*)((unsigned char*)p.out + DO_QN);
  u16* KNTg = (u16*)((unsigned char*)p.out + DO_KNT);
  u16* ATTg = (u16*)(p.ws + OFF_ATT);
  float* GCg = (float*)(p.ws + OFF_GC);
  const float* convw = p.in[5];
  const int tid = threadIdx.x, lane = tid & 63;
  const int c0 = n * 64;
  const size_t tok0 = (size_t)b * SEQ + c0;
  float* Qt = (float*)smem;
  float* Kt = Qt + 128 * DNP;
  float* V = Kt + 128 * DNP;
  float* AmT = V + 64 * 128;
  float* gc = AmT + 64 * 64;
  float* beta = gc + 64;
  float* qs = beta + 64;
  float* ks = qs + 64;
  __syncthreads();
  {
    const int c = tid & 127, tg = tid >> 7;
#pragma unroll
    for (int arr = 0; arr < 3; ++arr) {
      const int colp = (arr == 0 ? C_DQ : (arr == 1 ? C_DK : C_DV)) + h * 128 + c;
      float w0 = convw[0 * 1536 + arr * 512 + h * 128 + c], w1 = convw[1 * 1536 + arr * 512 + h * 128 + c],
            w2 = convw[2 * 1536 + arr * 512 + h * 128 + c], w3 = convw[3 * 1536 + arr * 512 + h * 128 + c];
      float x0, x1, x2;
      {
        int i = tg * 16;
        x0 = (c0 + i - 3 >= 0) ? bf2f(PROJ[(tok0 + i - 3) * LDP + colp]) : 0.f;
        x1 = (c0 + i - 2 >= 0) ? bf2f(PROJ[(tok0 + i - 2) * LDP + colp]) : 0.f;
        x2 = (c0 + i - 1 >= 0) ? bf2f(PROJ[(tok0 + i - 1) * LDP + colp]) : 0.f;
      }
#pragma unroll 2
      for (int ii = 0; ii < 16; ++ii) {
        int i = tg * 16 + ii;
        float x3 = bf2f(PROJ[(tok0 + i) * LDP + colp]);
        float y = w0 * x0 + w1 * x1 + w2 * x2 + w3 * x3;
        float s = y / (1.f + __expf(-y));
        if (arr == 0) Qt[c * DNP + i] = s;
        else if (arr == 1) Kt[c * DNP + i] = s;
        else V[i * 128 + c] = s;
        x0 = x1; x1 = x2; x2 = x3;
      }
    }
  }
  if (tid < 64) {
    float da = SMALL[(tok0 + tid) * 16 + 8 + h], db = SMALL[(tok0 + tid) * 16 + 12 + h];
    float xx = da + p.in[7][h];
    float sp = fmaxf(xx, 0.f) + log1pf(__expf(-fabsf(xx)));
    float gr = -__expf(p.in[6][h]) * sp;
    float incl = gr;
#pragma unroll
    for (int o = 1; o < 64; o <<= 1) {
      float v = __shfl_up(incl, o);
      if (lane >= o) incl += v;
    }
    gc[tid] = incl;
    beta[tid] = sigmoidf_(db);
    GCg[(tok0 + tid) * 4 + h] = incl;
  }
  __syncthreads();
  {
    const int arr = tid >> 8, i = (tid & 255) >> 2, part = tid & 3;
    const float* src = arr ? Kt : Qt;
    float ss = 0.f;
#pragma unroll 4
    for (int c = part * 32; c < part * 32 + 32; ++c) { float v = src[c * DNP + i]; ss += v * v; }
    ss += __shfl_xor(ss, 1); ss += __shfl_xor(ss, 2);
    if (part == 0) {
      if (arr == 0) qs[i] = rsqrtf(ss + EPS) * 0.08838834764831845f;
      else ks[i] = rsqrtf(ss + EPS);
    }
  }
  __syncthreads();
#pragma unroll 2
  for (int e = tid; e < 128 * 64; e += NTHREADS) {
    int c = e >> 6, i = e & 63;
    Qt[c * DNP + i] *= qs[i];
    Kt[c * DNP + i] *= ks[i];
  }
  __syncthreads();
#pragma unroll 2
  for (int e = tid; e < 64 * 128; e += NTHREADS) {
    int i = e >> 7, d = e & 127;
    QNg[(tok0 + i) * 512 + h * 128 + perm32(d)] = f2bf(Qt[d * DNP + i]);
  }
#pragma unroll 2
  for (int e = tid; e < 128 * 64; e += NTHREADS) {
    int d = e >> 6, i = e & 63;
    KNTg[(size_t)item * 8192 + d * 64 + perm32(i)] = f2bf(Kt[d * DNP + i]);
  }
  {
    const int mat = tid >> 8, bi = (tid & 255) >> 4, bj = tid & 15;
    const int i0 = 4 * bi, j0 = 4 * bj;
    if (j0 <= i0 + 3) {
      const float* Aop = mat ? Qt : Kt;
      float acc[4][4];
#pragma unroll
      for (int x = 0; x < 4; ++x)
#pragma unroll
        for (int y = 0; y < 4; ++y) acc[x][y] = 0.f;
#pragma unroll 4
      for (int d = 0; d < 128; ++d) {
        float4 a4 = *(const float4*)(Aop + d * DNP + i0);
        float4 b4 = *(const float4*)(Kt + d * DNP + j0);
        float av[4] = {a4.x, a4.y, a4.z, a4.w}, bv[4] = {b4.x, b4.y, b4.z, b4.w};
#pragma unroll
        for (int x = 0; x < 4; ++x)
#pragma unroll
          for (int y = 0; y < 4; ++y) acc[x][y] += av[x] * bv[y];
      }
#pragma unroll
      for (int x = 0; x < 4; ++x)
#pragma unroll
        for (int y = 0; y < 4; ++y) {
          int i = i0 + x, j = j0 + y;
          float dec = __expf(gc[i] - gc[j]);
          if (mat == 0) AmT[j * 64 + i] = (i > j) ? beta[i] * acc[x][y] * dec : 0.f;
          else ATTg[(size_t)item * 4096 + i * 64 + perm32(j)] = f2bf((i >= j) ? acc[x][y] * dec : 0.f);
        }
    } else {
#pragma unroll
      for (int x = 0; x < 4; ++x)
#pragma unroll
        for (int y = 0; y < 4; ++y) {
          int i = i0 + x, j = j0 + y;
          if (mat == 0) AmT[j * 64 + i] = 0.f;
          else ATTg[(size_t)item * 4096 + i * 64 + perm32(j)] = 0;
        }
    }
  }
  __syncthreads();
  if (tid < 256) {
    const int c = tid;
    const bool isu = c < 128;
    const int cc = c & 127;
    const int pc = perm32(cc);
#pragma unroll 1
    for (int ib = 0; ib < 4; ++ib) {
      float sreg[16];
#pragma unroll
      for (int r = 0; r < 16; ++r) {
        int i = ib * 16 + r;
        sreg[r] = isu ? V[i * 128 + cc] * beta[i] : Kt[cc * DNP + i] * beta[i] * __expf(gc[i]);
      }
#pragma unroll 2
      for (int j = 0; j < ib * 16; ++j) {
        float xj = isu ? V[j * 128 + cc] : Kt[cc * DNP + j];
        const f32x4* ap = (const f32x4*)(AmT + j * 64 + ib * 16);
        f32x4 a0 = ap[0], a1 = ap[1], a2 = ap[2], a3 = ap[3];
        sreg[0] -= a0[0] * xj; sreg[1] -= a0[1] * xj; sreg[2] -= a0[2] * xj; sreg[3] -= a0[3] * xj;
        sreg[4] -= a1[0] * xj; sreg[5] -= a1[1] * xj; sreg[6] -= a1[2] * xj; sreg[7] -= a1[3] * xj;
        sreg[8] -= a2[0] * xj; sreg[9] -= a2[1] * xj; sreg[10] -= a2[2] * xj; sreg[11] -= a2[3] * xj;
        sreg[12] -= a3[0] * xj; sreg[13] -= a3[1] * xj; sreg[14] -= a3[2] * xj; sreg[15] -= a3[3] * xj;
      }
#pragma unroll
      for (int q = 0; q < 15; ++q) {
        const float* ar = AmT + (ib * 16 + q) * 64 + ib * 16;
#pragma unroll
        for (int r = q + 1; r < 16; ++r) sreg[r] -= ar[r] * sreg[q];
      }
#pragma unroll
      for (int r = 0; r < 16; ++r) {
        int i = ib * 16 + r;
        if (isu) { V[i * 128 + cc] = sreg[r]; Ug[(tok0 + i) * 512 + h * 128 + cc] = f2bf(sreg[r]); }
        else { Kt[cc * DNP + i] = sreg[r]; Wg[(tok0 + i) * 512 + h * 128 + pc] = f2bf(sreg[r]); }
      }
    }
  }
}

__device__ void phase2(const Params& p, unsigned char* smem) {
#ifndef NO_IDX
  for (int i = blockIdx.x; i < 2048; i += gridDim.x) idx_item(p, smem, i & 7, 255 - (i >> 3));
#endif
#ifndef NO_DNL
  if (!(p.flags & 1))
    for (int i = blockIdx.x; i < 2048; i += gridDim.x) dn_local_item(p, smem, i);
#endif
}

constexpr int SC_WP = 272, SC_KP = 144;
constexpr int SC_W = 0, SC_Q = 64 * SC_WP, SC_KT = 2 * 64 * SC_WP, SC_AT = SC_KT + 128 * SC_KP, SC_BUF = SC_AT + 64 * SC_KP;
constexpr int SC_U = 2 * SC_BUF;
constexpr int SC_DZ = SC_U + 64 * SC_WP;
constexpr int SC_SSQ = SC_DZ + 64 * SC_WP;
constexpr int SC_GC = SC_SSQ + 8 * 64 * 4;
static_assert(SC_GC + 2 * 64 * 4 <= SMEM_BYTES, "scan LDS");

__device__ void dn_scan_item(const Params& p, unsigned char* smem, int bh) {
  const int h = bh & 3, b = bh >> 2;
  const u16* Ug = (const u16*)((const unsigned char*)p.out + DO_U);
  const u16* Wg = (const u16*)((const unsigned char*)p.out + DO_W);
  const u16* QNg = (const u16*)((const unsigned char*)p.out + DO_QN);
  const u16* KNTg = (const u16*)((const unsigned char*)p.out + DO_KNT);
  const u16* ATTg = (const u16*)(p.ws + OFF_ATT);
  const float* GCg = (const float*)(p.ws + OFF_GC);
  const u16* PROJ = (const u16*)(p.ws + OFF_PROJ);
  u16* YDN = (u16*)(p.ws + OFF_YDN);
  const float* ogain = p.in[8];
  const int tid = threadIdx.x, lane = tid & 63, wave = tid >> 6;
  const int fr = lane & 15, fg = lane >> 4;
  const int ecol = wave * 16 + fr;
  const float gn = ogain[ecol];
  float* ssq = (float*)(smem + SC_SSQ);
  float* gcs = (float*)(smem + SC_GC);
  f32x4 S[8];
#pragma unroll
  for (int d = 0; d < 8; ++d) S[d] = (f32x4){0.f, 0.f, 0.f, 0.f};
  u32x4 st[7], su[2], sd[2];
  float gcr = 0.f;
  const int r16 = tid >> 4, c16 = tid & 15;
  const int r8 = tid >> 3, c8 = tid & 7;
#define SCAN_LOAD(n_)                                                                                      \
  {                                                                                                        \
    const size_t tk0 = (size_t)b * SEQ + (size_t)(n_) * 64;                                                \
    const size_t it_ = (size_t)((b * 64 + (n_)) * 4 + h);                                                  \
    st[0] = *(const u32x4*)(Wg + (tk0 + r16) * 512 + h * 128 + c16 * 8);                                   \
    st[1] = *(const u32x4*)(Wg + (tk0 + r16 + 32) * 512 + h * 128 + c16 * 8);                              \
    st[2] = *(const u32x4*)(QNg + (tk0 + r16) * 512 + h * 128 + c16 * 8);                                  \
    st[3] = *(const u32x4*)(QNg + (tk0 + r16 + 32) * 512 + h * 128 + c16 * 8);                             \
    st[4] = *(const u32x4*)(KNTg + it_ * 8192 + (size_t)tid * 8);                                          \
    st[5] = *(const u32x4*)(KNTg + it_ * 8192 + (size_t)(tid + 512) * 8);                                  \
    st[6] = *(const u32x4*)(ATTg + it_ * 4096 + (size_t)tid * 8);                                          \
    su[0] = *(const u32x4*)(Ug + (tk0 + r16) * 512 + h * 128 + c16 * 8);                                   \
    su[1] = *(const u32x4*)(Ug + (tk0 + r16 + 32) * 512 + h * 128 + c16 * 8);                              \
    sd[0] = *(const u32x4*)(PROJ + (tk0 + r16) * LDP + C_DZ + h * 128 + c16 * 8);                          \
    sd[1] = *(const u32x4*)(PROJ + (tk0 + r16 + 32) * LDP + C_DZ + h * 128 + c16 * 8);                     \
    if (tid < 64) gcr = GCg[(tk0 + tid) * 4 + h];                                                          \
  }
#define SCAN_STORE_MAIN(buf_)                                                                              \
  {                                                                                                        \
    unsigned char* bs_ = smem + (buf_) * SC_BUF;                                                           \
    *(u32x4*)(bs_ + SC_W + r16 * SC_WP + c16 * 16) = st[0];                                                \
    *(u32x4*)(bs_ + SC_W + (r16 + 32) * SC_WP + c16 * 16) = st[1];                                         \
    *(u32x4*)(bs_ + SC_Q + r16 * SC_WP + c16 * 16) = st[2];                                                \
    *(u32x4*)(bs_ + SC_Q + (r16 + 32) * SC_WP + c16 * 16) = st[3];                                         \
    *(u32x4*)(bs_ + SC_KT + r8 * SC_KP + c8 * 16) = st[4];                                                 \
    *(u32x4*)(bs_ + SC_KT + (r8 + 64) * SC_KP + c8 * 16) = st[5];                                          \
    *(u32x4*)(bs_ + SC_AT + r8 * SC_KP + c8 * 16) = st[6];                                                 \
    if (tid < 64) gcs[(buf_) * 64 + tid] = gcr;                                                            \
  }
#define SCAN_STORE_U()                                                                                     \
  {                                                                                                        \
    *(u32x4*)(smem + SC_U + r16 * SC_WP + c16 * 16) = su[0];                                               \
    *(u32x4*)(smem + SC_U + (r16 + 32) * SC_WP + c16 * 16) = su[1];                                        \
  }
#define SCAN_STORE_DZ()                                                                                    \
  {                                                                                                        \
    *(u32x4*)(smem + SC_DZ + r16 * SC_WP + c16 * 16) = sd[0];                                              \
    *(u32x4*)(smem + SC_DZ + (r16 + 32) * SC_WP + c16 * 16) = sd[1];                                       \
  }
  __syncthreads();
  SCAN_LOAD(0)
  SCAN_STORE_MAIN(0)
  SCAN_STORE_U()
  __syncthreads();
  for (int n = 0; n < 64; ++n) {
    const int buf = n & 1;
    const size_t tok0 = (size_t)b * SEQ + n * 64;
    SCAN_STORE_DZ()
    if (n + 1 < 64) SCAN_LOAD(n + 1)
    const unsigned char* base = smem + buf * SC_BUF;
    const u32 ub0 = (u32)(tok0 + 4 * fg) * 512 + (u32)(h * 128 + ecol);
    const float* gcb = gcs + buf * 64 + 4 * fg;
    const float glast = gcs[buf * 64 + 63];
    bf16x8 Sb[4];
#pragma unroll
    for (int kk = 0; kk < 4; ++kk) {
      union { u32 w[4]; bf16x8 v; } cv;
      cv.w[0] = pack2(S[2 * kk][0], S[2 * kk][1]); cv.w[1] = pack2(S[2 * kk][2], S[2 * kk][3]);
      cv.w[2] = pack2(S[2 * kk + 1][0], S[2 * kk + 1][1]); cv.w[3] = pack2(S[2 * kk + 1][2], S[2 * kk + 1][3]);
      Sb[kk] = cv.v;
    }
    f32x4 vnew[4], ov[4];
#pragma unroll
    for (int m = 0; m < 4; ++m) {
      f32x4 aw = {0.f, 0.f, 0.f, 0.f}, aq = {0.f, 0.f, 0.f, 0.f};
#pragma unroll
      for (int kk = 0; kk < 4; ++kk) {
        bf16x8 wf = *(const bf16x8*)(base + SC_W + (m * 16 + fr) * SC_WP + kk * 64 + fg * 16);
        bf16x8 qf = *(const bf16x8*)(base + SC_Q + (m * 16 + fr) * SC_WP + kk * 64 + fg * 16);
        aw = __builtin_amdgcn_mfma_f32_16x16x32_bf16(wf, Sb[kk], aw, 0, 0, 0);
        aq = __builtin_amdgcn_mfma_f32_16x16x32_bf16(qf, Sb[kk], aq, 0, 0, 0);
      }
      f32x4 g4 = *(const f32x4*)(gcb + m * 16);
#pragma unroll
      for (int r = 0; r < 4; ++r) {
        float uv = bf2f(*(const u16*)(smem + SC_U + (m * 16 + 4 * fg + r) * SC_WP + ecol * 2));
        vnew[m][r] = uv - aw[r];
        ov[m][r] = aq[r] * __expf(g4[r]);
      }
    }
    bf16x8 vb[2], vsb[2];
#pragma unroll
    for (int k2 = 0; k2 < 2; ++k2) {
      union { u32 w[4]; bf16x8 v; } c1, c2;
      const int ma = 2 * k2, mb = 2 * k2 + 1;
      c1.w[0] = pack2(vnew[ma][0], vnew[ma][1]); c1.w[1] = pack2(vnew[ma][2], vnew[ma][3]);
      c1.w[2] = pack2(vnew[mb][0], vnew[mb][1]); c1.w[3] = pack2(vnew[mb][2], vnew[mb][3]);
      f32x4 ga4 = *(const f32x4*)(gcb + ma * 16), gb4 = *(const f32x4*)(gcb + mb * 16);
      float sa[4], sb2[4];
#pragma unroll
      for (int r = 0; r < 4; ++r) { sa[r] = vnew[ma][r] * __expf(glast - ga4[r]); sb2[r] = vnew[mb][r] * __expf(glast - gb4[r]); }
      c2.w[0] = pack2(sa[0], sa[1]); c2.w[1] = pack2(sa[2], sa[3]);
      c2.w[2] = pack2(sb2[0], sb2[1]); c2.w[3] = pack2(sb2[2], sb2[3]);
      vb[k2] = c1.v; vsb[k2] = c2.v;
    }
#pragma unroll
    for (int m = 0; m < 4; ++m) {
      f32x4 ao = ov[m];
#pragma unroll
      for (int k2 = 0; k2 < 2; ++k2) {
        bf16x8 af = *(const bf16x8*)(base + SC_AT + (m * 16 + fr) * SC_KP + k2 * 64 + fg * 16);
        ao = __builtin_amdgcn_mfma_f32_16x16x32_bf16(af, vb[k2], ao, 0, 0, 0);
      }
      ov[m] = ao;
#pragma unroll
      for (int r = 0; r < 4; ++r) {
        float sq = ao[r] * ao[r];
        sq += DPPF(sq, 0xb1); sq += DPPF(sq, 0x4e); sq += DPPF(sq, 0x141); sq += DPPF(sq, 0x140);
        if (fr == 0) ssq[(m * 16 + 4 * fg + r) * 8 + wave] = sq;
      }
    }
    const float egl = __expf(glast);
#pragma unroll
    for (int d = 0; d < 8; ++d) {
      f32x4 a = S[d] * egl;
#pragma unroll
      for (int k2 = 0; k2 < 2; ++k2) {
        bf16x8 kf = *(const bf16x8*)(base + SC_KT + (d * 16 + fr) * SC_KP + k2 * 64 + fg * 16);
        a = __builtin_amdgcn_mfma_f32_16x16x32_bf16(kf, vsb[k2], a, 0, 0, 0);
      }
      S[d] = a;
    }
    if (n + 1 < 64) SCAN_STORE_MAIN(buf ^ 1)
    __syncthreads();
    if (n + 1 < 64) SCAN_STORE_U()
#pragma unroll
    for (int m = 0; m < 4; ++m)
#pragma unroll
      for (int r = 0; r < 4; ++r) {
        int tk = m * 16 + 4 * fg + r;
        f32x4 q0 = *(const f32x4*)(ssq + tk * 8), q1 = *(const f32x4*)(ssq + tk * 8 + 4);
        float tot = ((q0[0] + q0[1]) + (q0[2] + q0[3])) + ((q1[0] + q1[1]) + (q1[2] + q1[3]));
        float rstd = rsqrtf(tot * (1.f / 128.f) + EPS);
        float z = bf2f(*(const u16*)(smem + SC_DZ + tk * SC_WP + ecol * 2));
        float y = ov[m][r] * rstd * gn * z * sigmoidf_(z);
        YDN[ub0 + (u32)((m * 16 + r) * 512)] = f2bf(y);
      }
    __syncthreads();
  }
#undef SCAN_LOAD
#undef SCAN_STORE_MAIN
#undef SCAN_STORE_U
#undef SCAN_STORE_DZ
}

constexpr int AT_WAVE_BYTES = 8192 + 512;
__device__ __forceinline__ float xor16_sum(float v) {
  auto r = __builtin_amdgcn_permlane16_swap(__float_as_uint(v), __float_as_uint(v), false, false);
  return __uint_as_float(r[0]) + __uint_as_float(r[1]);
}
__device__ __forceinline__ float xor32_sum(float v) {
  auto r = __builtin_amdgcn_permlane32_swap(__float_as_uint(v), __float_as_uint(v), false, false);
  return __uint_as_float(r[0]) + __uint_as_float(r[1]);
}
__device__ void attn_query(const Params& p, unsigned char* wsm, int b, int t) {
  const u16* PROJ = (const u16*)(p.ws + OFF_PROJ);
  const u16* SEL = (const u16*)(p.ws + OFF_SEL);
  u16* YATT = (u16*)(p.ws + OFF_YATT);
  const int lane = threadIdx.x & 63;
  const int fr = lane & 15, fg = lane >> 4;
  float* P = (float*)wsm;
  u16* sl = (u16*)(wsm + 8192);
  const size_t tokb = (size_t)b * SEQ;
  const size_t tok = tokb + t;
  const int nsel = min(256, t + 1);
  bf16x8 qb[2][2];
  {
    const bf16x8 z = {0, 0, 0, 0, 0, 0, 0, 0};
    const u16* qrow = PROJ + tok * LDP + C_AQ + (fr & 3) * 64 + fg * 8;
#pragma unroll
    for (int g = 0; g < 2; ++g)
#pragma unroll
      for (int kk = 0; kk < 2; ++kk) {
        bf16x8 v = *(const bf16x8*)(qrow + g * 256 + kk * 32);
        qb[g][kk] = (fr < 4) ? v : z;
      }
    const u16* sr = SEL + tok * 256;
#pragma unroll
    for (int i = 0; i < 4; ++i) sl[lane + 64 * i] = sr[lane + 64 * i];
  }
  WAVE_LDS_SYNC();
  const int ngrp = (nsel + 15) >> 4;
  const int nbq = (ngrp + 1) >> 1;
  bf16x8 kA[2][4], kB[2][4];
#define QK_LOAD(buf_, bi_)                                                                       \
  _Pragma("unroll") for (int j = 0; j < 2; ++j) {                                                \
    const int ki_ = min(((bi_) * 2 + j) * 16 + fr, 255);                                         \
    const int s_ = (int)sl[ki_] & 4095;                                                          \
    const u16* krow_ = PROJ + (tokb + s_) * LDP + C_AK + fg * 8;                                 \
    buf_[j][0] = *(const bf16x8*)(krow_); buf_[j][1] = *(const bf16x8*)(krow_ + 32);             \
    buf_[j][2] = *(const bf16x8*)(krow_ + 64); buf_[j][3] = *(const bf16x8*)(krow_ + 96);        \
  }
#define QK_COMPUTE(buf_, bi_)                                                                    \
  _Pragma("unroll") for (int j = 0; j < 2; ++j) {                                                \
    f32x4 c0_ = {0.f, 0.f, 0.f, 0.f}, c1_ = {0.f, 0.f, 0.f, 0.f};                                \
    c0_ = __builtin_amdgcn_mfma_f32_16x16x32_bf16(buf_[j][0], qb[0][0], c0_, 0, 0, 0);           \
    c0_ = __builtin_amdgcn_mfma_f32_16x16x32_bf16(buf_[j][1], qb[0][1], c0_, 0, 0, 0);           \
    c1_ = __builtin_amdgcn_mfma_f32_16x16x32_bf16(buf_[j][2], qb[1][0], c1_, 0, 0, 0);           \
    c1_ = __builtin_amdgcn_mfma_f32_16x16x32_bf16(buf_[j][3], qb[1][1], c1_, 0, 0, 0);           \
    if (fr < 4) {                                                                                \
      _Pragma("unroll") for (int r = 0; r < 4; ++r) {                                            \
        const int kk2_ = ((bi_) * 2 + j) * 16 + 4 * fg + r;                                      \
        if (kk2_ < 256) {                                                                        \
          const bool v_ = kk2_ < nsel;                                                           \
          P[kk2_ * 8 + fr] = v_ ? c0_[r] : -1e30f;                                               \
          P[kk2_ * 8 + 4 + fr] = v_ ? c1_[r] : -1e30f;                                           \
        }                                                                                        \
      }                                                                                          \
    }                                                                                            \
  }
  QK_LOAD(kA, 0)
  for (int bi = 0; bi < nbq; bi += 2) {
    if (bi + 1 < nbq) { QK_LOAD(kB, bi + 1) }
    QK_COMPUTE(kA, bi)
    if (bi + 2 < nbq) { QK_LOAD(kA, bi + 2) }
    if (bi + 1 < nbq) { QK_COMPUTE(kB, bi + 1) }
  }
#undef QK_LOAD
#undef QK_COMPUTE
  for (int ki = nbq * 32 + lane; ki < 256; ki += 64) {
    *(f32x4*)(P + ki * 8) = (f32x4){-1e30f, -1e30f, -1e30f, -1e30f};
    *(f32x4*)(P + ki * 8 + 4) = (f32x4){-1e30f, -1e30f, -1e30f, -1e30f};
  }
  WAVE_LDS_SYNC();
  {
    float lg[4][8];
#pragma unroll
    for (int i = 0; i < 4; ++i) {
      f32x4 x0 = *(const f32x4*)(P + (lane + 64 * i) * 8), x1 = *(const f32x4*)(P + (lane + 64 * i) * 8 + 4);
      lg[i][0] = x0[0]; lg[i][1] = x0[1]; lg[i][2] = x0[2]; lg[i][3] = x0[3];
      lg[i][4] = x1[0]; lg[i][5] = x1[1]; lg[i][6] = x1[2]; lg[i][7] = x1[3];
    }
#pragma unroll
    for (int hh = 0; hh < 8; ++hh) {
      float m = fmaxf(fmaxf(lg[0][hh], lg[1][hh]), fmaxf(lg[2][hh], lg[3][hh]));
      m = wave_max_dpp(m);
      float e[4], sum = 0.f;
#pragma unroll
      for (int i = 0; i < 4; ++i) { e[i] = __expf(lg[i][hh] - m); sum += e[i]; }
      sum = wave_sum_dpp(sum);
      const float inv = __builtin_amdgcn_rcpf(sum);
#pragma unroll
      for (int i = 0; i < 4; ++i) lg[i][hh] = e[i] * inv;
    }
#pragma unroll
    for (int i = 0; i < 4; ++i) {
      float* d = P + (lane + 64 * i) * 8;
      *(f32x4*)d = (f32x4){lg[i][0], lg[i][1], lg[i][2], lg[i][3]};
      *(f32x4*)(d + 4) = (f32x4){lg[i][4], lg[i][5], lg[i][6], lg[i][7]};
    }
  }
  WAVE_LDS_SYNC();
  const int ks = lane >> 3, c8 = lane & 7;
  const int ngrp8 = (nsel + 7) >> 3;
  const int nb = (ngrp8 + 7) >> 3;
  const int total = 2 * nb;
  u32x4 vA[8], vB[8];
  float o[4][8];
#define PV_LOAD(buf_, gb_)                                                                       \
  {                                                                                              \
    const int g_ = ((gb_) >= nb) ? 1 : 0;                                                        \
    const int bi_ = (gb_) - g_ * nb;                                                             \
    _Pragma("unroll") for (int j = 0; j < 8; ++j) {                                              \
      const int ki_ = min((bi_ * 8 + j) * 8 + ks, 255);                                          \
      const int s_ = (int)sl[ki_] & 4095;                                                        \
      buf_[j] = *(const u32x4*)(PROJ + (tokb + s_) * LDP + C_AV + g_ * 64 + c8 * 8);             \
    }                                                                                            \
  }
#define PV_COMPUTE(buf_, gb_)                                                                    \
  {                                                                                              \
    const int g_ = ((gb_) >= nb) ? 1 : 0;                                                        \
    const int bi_ = (gb_) - g_ * nb;                                                             \
    _Pragma("unroll") for (int j = 0; j < 8; ++j) {                                              \
      const int ki_ = (bi_ * 8 + j) * 8 + ks;                                                    \
      f32x4 p0_ = *(const f32x4*)(P + min(ki_, 255) * 8 + g_ * 4);                               \
      if (ki_ >= nsel) p0_ = (f32x4){0.f, 0.f, 0.f, 0.f};                                        \
      float f0_[8];                                                                              \
      _Pragma("unroll") for (int c = 0; c < 4; ++c) { f0_[2 * c] = bflo(buf_[j][c]); f0_[2 * c + 1] = bfhi(buf_[j][c]); } \
      _Pragma("unroll") for (int hh = 0; hh < 4; ++hh)                                           \
        _Pragma("unroll") for (int d = 0; d < 8; ++d) o[hh][d] += p0_[hh] * f0_[d];              \
    }                                                                                            \
    if (bi_ == nb - 1) {                                                                         \
      _Pragma("unroll") for (int hh = 0; hh < 4; ++hh) {                                         \
        u32 w_[4];                                                                               \
        _Pragma("unroll") for (int d = 0; d < 8; d += 2) {                                       \
          float x0 = o[hh][d], x1 = o[hh][d + 1];                                                \
          x0 += DPPF(x0, 0x128); x1 += DPPF(x1, 0x128);                                          \
          x0 = xor16_sum(x0); x1 = xor16_sum(x1);                                                \
          x0 = xor32_sum(x0); x1 = xor32_sum(x1);                                                \
          w_[d >> 1] = pack2(x0, x1);                                                            \
          o[hh][d] = 0.f; o[hh][d + 1] = 0.f;                                                    \
        }                                                                                        \
        if (lane < 8) *(u32x4*)(YATT + tok * 512 + (g_ * 4 + hh) * 64 + c8 * 8) = (u32x4){w_[0], w_[1], w_[2], w_[3]}; \
      }                                                                                          \
    }                                                                                            \
  }
#pragma unroll
  for (int hh = 0; hh < 4; ++hh)
#pragma unroll
    for (int d = 0; d < 8; ++d) o[hh][d] = 0.f;
  PV_LOAD(vA, 0)
  for (int gb = 0; gb < total; gb += 2) {
    PV_LOAD(vB, gb + 1)
    PV_COMPUTE(vA, gb)
    if (gb + 2 < total) PV_LOAD(vA, gb + 2)
    PV_COMPUTE(vB, gb + 1)
  }
#undef PV_LOAD
#undef PV_COMPUTE
  WAVE_LDS_SYNC();
}

__device__ void phase3(const Params& p, unsigned char* smem) {
  const int wave = threadIdx.x >> 6;
#ifndef NO_SCAN
  if (blockIdx.x < 32) {
    if (!(p.flags & 2)) dn_scan_item(p, smem, blockIdx.x);
    return;
  }
#endif
#ifdef NO_ATTN
  return;
#endif
  if (p.flags & 4) return;
  const int G = gridDim.x;
  const int cls = blockIdx.x & 7;
  const int j = (blockIdx.x >> 3) - 4;
  const int ncls = ((G - 1 - cls) >> 3) + 1 - 4;
  if (ncls <= 0) return;
  unsigned char* wsm = smem + wave * AT_WAVE_BYTES;
  for (int it = j; it < SEQ / 8; it += ncls) {
    int t = it * 8 + wave;
    attn_query(p, wsm, cls, t);
  }
}

__device__ void phase4(const Params& p, unsigned char* smem) {
  const u16* YATT = (const u16*)(p.ws + OFF_YATT);
  const u16* YDN = (const u16*)(p.ws + OFF_YDN);
  const u16* WTA = (const u16*)(p.ws + OFF_WTA);
  const u16* WTB = (const u16*)(p.ws + OFF_WTB);
  const u16* PROJ = (const u16*)(p.ws + OFF_PROJ);
  u16* MG = (u16*)(p.ws + OFF_MERGED);
  const int lane = threadIdx.x & 63, wave = threadIdx.x >> 6;
  const int wm = wave >> 1, wn = wave & 1, fr = lane & 15, fg = lane >> 4;
  const int ntn = DM / G_BN, ntiles = (MTOK / G_BM) * ntn;
  for (int t = blockIdx.x; t < ntiles; t += gridDim.x) {
    const int m0 = (t / ntn) * G_BM, n0 = (t % ntn) * G_BN;
    f32x4 acc[4][4];
    u32 mg[4][4][2];
    const u32 pb0 = (u32)(m0 + wm * 64 + 4 * fg) * LDP + (u32)(n0 + wn * 64 + fr);
    const u32 ob0 = (u32)(m0 + wm * 64 + 4 * fg) * DM + (u32)(n0 + wn * 64 + fr);
    gemm_mainloop(YATT, 512, WTA, 512, 512, m0, n0, smem, acc);
#pragma unroll
    for (int i = 0; i < 4; ++i)
#pragma unroll
      for (int j = 0; j < 4; ++j) {
        float t4[4];
#pragma unroll
        for (int r = 0; r < 4; ++r) {
          float ga = bf2f(PROJ[pb0 + (u32)(C_GA + (i * 16 + r) * LDP + j * 16)]);
          t4[r] = sigmoidf_(ga) * acc[i][j][r];
        }
        mg[i][j][0] = pack2(t4[0], t4[1]); mg[i][j][1] = pack2(t4[2], t4[3]);
        asm volatile("" ::: "memory");
      }
    gemm_mainloop(YDN, 512, WTB, 512, 512, m0, n0, smem, acc);
#pragma unroll
    for (int i = 0; i < 4; ++i)
#pragma unroll
      for (int j = 0; j < 4; ++j)
#pragma unroll
        for (int r = 0; r < 4; ++r) {
          float gb = bf2f(PROJ[pb0 + (u32)(C_GB + (i * 16 + r) * LDP + j * 16)]);
          u32 w = mg[i][j][r >> 1];
          float m1 = (r & 1) ? bfhi(w) : bflo(w);
          MG[ob0 + (u32)((i * 16 + r) * DM + j * 16)] = f2bf(m1 + sigmoidf_(gb) * acc[i][j][r]);
          if (r == 3) asm volatile("" ::: "memory");
        }
  }
}

__device__ void phase5(const Params& p, unsigned char* smem) {
  const u16* MG = (const u16*)(p.ws + OFF_MERGED);
  const u16* WTO = (const u16*)(p.ws + OFF_WTO);
  const float* x = p.in[0];
  const int lane = threadIdx.x & 63, wave = threadIdx.x >> 6;
  const int wm = wave >> 1, wn = wave & 1, fr = lane & 15, fg = lane >> 4;
  const int ntn = DM / G_BN, ntiles = (MTOK / G_BM) * ntn;
  for (int t = blockIdx.x; t < ntiles; t += gridDim.x) {
    const int m0 = (t / ntn) * G_BM, n0 = (t % ntn) * G_BN;
    f32x4 acc[4][4];
    gemm_mainloop(MG, DM, WTO, DM, DM, m0, n0, smem, acc);
    const u32 ob0 = (u32)(m0 + wm * 64 + 4 * fg) * DM + (u32)(n0 + wn * 64 + fr);
    float* outp = p.out;
#pragma unroll
    for (int i = 0; i < 4; ++i)
#pragma unroll
      for (int j = 0; j < 4; ++j)
#pragma unroll
        for (int r = 0; r < 4; ++r) {
          u32 o = ob0 + (u32)((i * 16 + r) * DM + j * 16);
          outp[o] = x[o] + acc[i][j][r];
        }
  }
}

__device__ void phase6(const Params& p, unsigned char* smem) {
  const u16* H2 = (const u16*)(p.ws + OFF_H2);
  const u16* WTQ = (const u16*)(p.ws + OFF_WTQ);
  u16* QP = (u16*)(p.ws + OFF_QP);
  const int lane = threadIdx.x & 63, wave = threadIdx.x >> 6;
  const int wm = wave >> 1, wn = wave & 1, fr = lane & 15, fg = lane >> 4;
  const int ntn = 2048 / G_BN, ntiles = (MTOK / G_BM) * ntn;
  for (int t = blockIdx.x; t < ntiles; t += gridDim.x) {
    const int m0 = (t / ntn) * G_BM, n0 = (t % ntn) * G_BN;
    f32x4 acc[4][4];
    gemm_mainloop(H2, DM, WTQ, DM, DM, m0, n0, smem, acc);
    const u32 ob0 = (u32)(m0 + wm * 64 + 4 * fg) * 2048 + (u32)(n0 + wn * 64 + fr);
#pragma unroll
    for (int i = 0; i < 4; ++i)
#pragma unroll
      for (int j = 0; j < 4; ++j)
#pragma unroll
        for (int r = 0; r < 4; ++r) QP[ob0 + (u32)((i * 16 + r) * 2048 + j * 16)] = f2bf(acc[i][j][r]);
  }
}

__device__ __forceinline__ void top16_insert(float (&vals)[16], int (&idx)[16], float v, int i) {
  if (v > vals[15]) {
    vals[15] = v; idx[15] = i;
#pragma unroll
    for (int k = 15; k > 0; --k) {
      bool sw = vals[k] > vals[k - 1];
      float a = vals[k], bb = vals[k - 1];
      int ia = idx[k], ib = idx[k - 1];
      vals[k - 1] = sw ? a : bb; vals[k] = sw ? bb : a;
      idx[k - 1] = sw ? ia : ib; idx[k] = sw ? ib : ia;
    }
  }
}

constexpr int P7_LD = 132;
__device__ void phase7(const Params& p, unsigned char* smem) {
  const u16* QP = (const u16*)(p.ws + OFF_QP);
  const u16* SKB = (const u16*)(p.ws + OFF_SKB);
  float* TOPS = (float*)(p.ws + OFF_TOPS);
  u8* TOPI = (u8*)(p.ws + OFF_TOPI);
  const int tid = threadIdx.x, lane = tid & 63, wave = tid >> 6;
  const int wm = wave >> 1, wn = wave & 1, fr = lane & 15, fg = lane >> 4;
  const int ntiles = (MTOK / G_BM) * 16;
  float* tile = (float*)smem;
  for (int t = blockIdx.x; t < ntiles; t += gridDim.x) {
    const int m0 = (t >> 4) * G_BM, hp = t & 15;
    f32x4 acc[4][4];
    gemm_mainloop(QP + hp * 128, 2048, SKB + (size_t)hp * 128 * 128, 128, 128, m0, 0, smem, acc);
#pragma unroll
    for (int i = 0; i < 4; ++i)
#pragma unroll
      for (int j = 0; j < 4; ++j)
#pragma unroll
        for (int r = 0; r < 4; ++r) {
          int row = wm * 64 + i * 16 + 4 * fg + r, col = wn * 64 + j * 16 + fr;
          tile[row * P7_LD + col] = acc[i][j][r];
        }
    __syncthreads();
    if (tid < 256) {
      float vals[16]; int idx[16];
#pragma unroll
      for (int k = 0; k < 16; ++k) { vals[k] = -INFINITY; idx[k] = 0; }
      const float* rowp = tile + tid * P7_LD;
      for (int c = 0; c < 128; c += 4) {
        float4 v = *(const float4*)(rowp + c);
        top16_insert(vals, idx, v.x, c);
        top16_insert(vals, idx, v.y, c + 1);
        top16_insert(vals, idx, v.z, c + 2);
        top16_insert(vals, idx, v.w, c + 3);
      }
      size_t o = ((size_t)(m0 + tid) * 16 + hp) * 16;
#pragma unroll
      for (int k = 0; k < 16; k += 4) *(float4*)(TOPS + o + k) = make_float4(vals[k], vals[k + 1], vals[k + 2], vals[k + 3]);
#pragma unroll
      for (int k = 0; k < 16; k += 4)
        *(u32*)(TOPI + o + k) = (u32)idx[k] | ((u32)idx[k + 1] << 8) | ((u32)idx[k + 2] << 16) | ((u32)idx[k + 3] << 24);
    }
    __syncthreads();
  }
}

__device__ void phase7b(const Params& p) {
  const float* TOPS = (const float*)(p.ws + OFF_TOPS);
  const u8* TOPI = (const u8*)(p.ws + OFF_TOPI);
  int* EXPERT = (int*)(p.ws + OFF_EXPERT);
  float* GATE = (float*)(p.ws + OFF_GATE);
  for (int w = blockIdx.x * NTHREADS + threadIdx.x; w < MTOK * 8; w += gridDim.x * NTHREADS) {
    const size_t o = (size_t)w * 32;
    float sa[16], sb[16];
#pragma unroll
    for (int k = 0; k < 16; k += 4) {
      float4 v = *(const float4*)(TOPS + o + k); sa[k] = v.x; sa[k + 1] = v.y; sa[k + 2] = v.z; sa[k + 3] = v.w;
      float4 u = *(const float4*)(TOPS + o + 16 + k); sb[k] = u.x; sb[k + 1] = u.y; sb[k + 2] = u.z; sb[k + 3] = u.w;
    }
    float vals[16]; int idx[16];
#pragma unroll
    for (int k = 0; k < 16; ++k) { vals[k] = -INFINITY; idx[k] = 0; }
#pragma unroll
    for (int a = 0; a < 16; ++a)
#pragma unroll
      for (int bb = 0; bb < 16; ++bb)
        if ((a + 1) * (bb + 1) <= 16) top16_insert(vals, idx, sa[a] + sb[bb], a * 16 + bb);
    float m = vals[0], s = 0.f, e[16];
#pragma unroll
    for (int k = 0; k < 16; ++k) { e[k] = __expf(vals[k] - m); s += e[k]; }
    float inv = 1.f / s;
#pragma unroll
    for (int k = 0; k < 16; ++k) {
      int a = idx[k] >> 4, bb = idx[k] & 15;
      int ex = (int)TOPI[o + a] * 128 + (int)TOPI[o + 16 + bb];
      EXPERT[(size_t)w * 16 + k] = ex;
      GATE[(size_t)w * 16 + k] = e[k] * inv;
    }
  }
  {
    const int lane = threadIdx.x & 63, wave = threadIdx.x >> 6;
    for (int row = blockIdx.x * 8 + wave; row < 2 * 16384; row += gridDim.x * 8) {
      const int tbl = row >> 14, r = row & 16383;
      const f32x4* src = (const f32x4*)((tbl ? p.in[16] : p.in[15]) + (size_t)r * DM) + 4 * lane;
      f32x4 x[4];
      float amax = 0.f;
#pragma unroll
      for (int i = 0; i < 4; ++i) {
        x[i] = src[i];
        amax = fmaxf(amax, fmaxf(fmaxf(fabsf(x[i][0]), fabsf(x[i][1])), fmaxf(fabsf(x[i][2]), fabsf(x[i][3]))));
      }
      amax = wave_max_dpp(amax);
      const float inv = amax > 0.f ? 127.f / amax : 0.f;
      const int bias = tbl ? 128 : 0;
      u32x4 o;
#pragma unroll
      for (int i = 0; i < 4; ++i) {
        int q0 = (int)rintf(x[i][0] * inv) + bias, q1 = (int)rintf(x[i][1] * inv) + bias;
        int q2 = (int)rintf(x[i][2] * inv) + bias, q3 = (int)rintf(x[i][3] * inv) + bias;
        o[i] = (u32)(q0 & 0xff) | ((u32)(q1 & 0xff) << 8) | ((u32)(q2 & 0xff) << 16) | ((u32)(q3 & 0xff) << 24);
      }
      *(u32x4*)(p.ws + (tbl ? OFF_VQ : OFF_UQ) + (size_t)r * DM + 16 * lane) = o;
      if (lane == 0) ((float*)(p.ws + (tbl ? OFF_VS : OFF_US)))[r] = amax * (1.f / 127.f);
    }
  }
}

__device__ void phase8(const Params& p) {
  const u16* H2 = (const u16*)(p.ws + OFF_H2);
  const int* EXPERT = (const int*)(p.ws + OFF_EXPERT);
  const float* GATE = (const float*)(p.ws + OFF_GATE);
  const unsigned char* UQ = p.ws + OFF_UQ;
  const unsigned char* VQ = p.ws + OFF_VQ;
  const float* US = (const float*)(p.ws + OFF_US);
  const float* VS = (const float*)(p.ws + OFF_VS);
  const int lane = threadIdx.x & 63, wave = threadIdx.x >> 6;
  for (int tok = blockIdx.x * 8 + wave; tok < MTOK; tok += gridDim.x * 8) {
    u32 hq[4];
    float sh;
    {
      const u32x4 a = *(const u32x4*)(H2 + (size_t)tok * DM + 16 * lane);
      const u32x4 b = *(const u32x4*)(H2 + (size_t)tok * DM + 16 * lane + 8);
      float hv[16];
#pragma unroll
      for (int c = 0; c < 4; ++c) { hv[2 * c] = bflo(a[c]); hv[2 * c + 1] = bfhi(a[c]); hv[8 + 2 * c] = bflo(b[c]); hv[8 + 2 * c + 1] = bfhi(b[c]); }
      float amax = 0.f;
#pragma unroll
      for (int i = 0; i < 16; ++i) amax = fmaxf(amax, fabsf(hv[i]));
      amax = wave_max_dpp(amax);
      const float inv = amax > 0.f ? 127.f / amax : 0.f;
      sh = amax * (1.f / 127.f);
#pragma unroll
      for (int c = 0; c < 4; ++c) {
        int q0 = (int)rintf(hv[4 * c] * inv), q1 = (int)rintf(hv[4 * c + 1] * inv);
        int q2 = (int)rintf(hv[4 * c + 2] * inv), q3 = (int)rintf(hv[4 * c + 3] * inv);
        hq[c] = (u32)(q0 & 0xff) | ((u32)(q1 & 0xff) << 8) | ((u32)(q2 & 0xff) << 16) | ((u32)(q3 & 0xff) << 24);
      }
    }
    const int e0 = EXPERT[(size_t)tok * 128 + lane], e1 = EXPERT[(size_t)tok * 128 + 64 + lane];
    const float g0 = GATE[(size_t)tok * 128 + lane], g1 = GATE[(size_t)tok * 128 + 64 + lane];
    const float su0 = US[e0], su1 = US[e1], sv0 = VS[e0], sv1 = VS[e1];
    int dacc0 = 0, dacc1 = 0;
#pragma unroll 1
    for (int half = 0; half < 2; ++half) {
      const int ev = half ? e1 : e0;
      int dacc = 0;
#pragma unroll 1
      for (int k = 0; k < 64; k += 16) {
        u32x4 ua[16];
#pragma unroll
        for (int j = 0; j < 16; ++j) {
          const int e = __builtin_amdgcn_readlane(ev, k + j);
          ua[j] = *(const u32x4*)(UQ + (size_t)e * DM + 16 * lane);
        }
#pragma unroll
        for (int j = 0; j < 16; ++j) {
          int sdot = 0;
#pragma unroll
          for (int c = 0; c < 4; ++c) sdot = __builtin_amdgcn_sdot4((int)ua[j][c], (int)hq[c], sdot, false);
          sdot = wave_sum_i_dpp(sdot);
          dacc = (lane == k + j) ? sdot : dacc;
        }
      }
      if (half) dacc1 = dacc; else dacc0 = dacc;
    }
    const float d0 = (float)dacc0 * su0 * sh, d1 = (float)dacc1 * su1 * sh;
    const float cf0 = g0 * 0.5f * d0 * (1.f + erff(d0 * 0.70710678118654752f)) * sv0;
    const float cf1 = g1 * 0.5f * d1 * (1.f + erff(d1 * 0.70710678118654752f)) * sv1;
    const float csum = wave_sum_dpp(cf0 + cf1);
    float ov[16];
#pragma unroll
    for (int i = 0; i < 16; ++i) ov[i] = 0.f;
#pragma unroll 1
    for (int half = 0; half < 2; ++half) {
      const int ev = half ? e1 : e0;
      const float cv = half ? cf1 : cf0;
#pragma unroll 1
      for (int k = 0; k < 64; k += 16) {
        u32x4 va[16];
        float cc[16];
#pragma unroll
        for (int j = 0; j < 16; ++j) {
          const int e = __builtin_amdgcn_readlane(ev, k + j);
          cc[j] = __int_as_float(__builtin_amdgcn_readlane(__float_as_int(cv), k + j));
          va[j] = *(const u32x4*)(VQ + (size_t)e * DM + 16 * lane);
        }
#pragma unroll
        for (int j = 0; j < 16; ++j) {
#pragma unroll
          for (int c = 0; c < 4; ++c) {
            const u32 w = va[j][c];
            ov[4 * c + 0] += cc[j] * (float)(w & 0xffu);
            ov[4 * c + 1] += cc[j] * (float)((w >> 8) & 0xffu);
            ov[4 * c + 2] += cc[j] * (float)((w >> 16) & 0xffu);
            ov[4 * c + 3] += cc[j] * (float)(w >> 24);
          }
        }
      }
    }
    const float corr = 128.f * csum;
    f32x4* op = (f32x4*)(p.out + (size_t)tok * DM + 16 * lane);
#pragma unroll
    for (int c = 0; c < 4; ++c) {
      f32x4 x = op[c];
      x[0] += ov[4 * c] - corr; x[1] += ov[4 * c + 1] - corr; x[2] += ov[4 * c + 2] - corr; x[3] += ov[4 * c + 3] - corr;
      op[c] = x;
    }
  }
}

__global__ void __launch_bounds__(NTHREADS, 2) mk_fwd(Params p) {
  cg::grid_group grid = cg::this_grid();
  __shared__ __attribute__((aligned(16))) unsigned char smem[SMEM_BYTES];
  const int lo = p.ph_lo, hi = p.ph_hi;
#define RUN(k, call) if (lo <= (k) && (k) < hi) { call; if ((k) + 1 < hi) grid.sync(); }
  RUN(0, phase0(p, smem))
  RUN(1, phase1(p, smem))
  RUN(2, phase2(p, smem))
  RUN(3, phase3(p, smem))
  RUN(4, phase4(p, smem))
  RUN(5, phase5(p, smem))
  RUN(6, rmsnorm_rows(p.out, p.in[12], (u16*)(p.ws + OFF_H2)))
  RUN(7, phase6(p, smem))
  RUN(8, phase7(p, smem))
  RUN(9, phase7b(p))
  RUN(10, phase8(p))
#undef RUN
}

extern "C" void kernel_launch(void* const* d_in, const int* in_sizes, int n_in,
                              void* d_out, int out_size, void* d_ws, size_t ws_size,
                              hipStream_t stream) {
  static int grid_blocks = 0;
  if (!grid_blocks) {
    int dev = 0, cus = 0, per_cu = 0;
    (void)hipGetDevice(&dev);
    (void)hipDeviceGetAttribute(&cus, hipDeviceAttributeMultiprocessorCount, dev);
    (void)hipOccupancyMaxActiveBlocksPerMultiprocessor(&per_cu, mk_fwd, NTHREADS, 0);
    if (per_cu < 1) per_cu = 1;
    if (per_cu > 1) per_cu = 1;
    grid_blocks = cus * per_cu;
    fprintf(stderr, "mk_fwd: cus=%d per_cu=%d grid=%d ws=%zu\n", cus, per_cu, grid_blocks, ws_size);
  }
  Params p{};
  for (int i = 0; i < 17 && i < n_in; ++i) p.in[i] = (const float*)d_in[i];
  p.out = (float*)d_out;
  p.ws = (unsigned char*)d_ws;
  p.ph_lo = 0; p.ph_hi = 11;
  void* args[] = {&p};
  hipError_t e = hipLaunchCooperativeKernel((void*)mk_fwd, dim3(grid_blocks), dim3(NTHREADS), args, 0, stream);
  if (e != hipSuccess) fprintf(stderr, "cooperative launch failed: %s (grid %d)\n", hipGetErrorString(e), grid_blocks);
#ifdef EXTRA_LO
  {
    Params p2 = p;
    p2.ph_lo = EXTRA_LO; p2.ph_hi = EXTRA_HI; p2.flags = EXTRA_FLAGS;
    void* args2[] = {&p2};
    (void)hipLaunchCooperativeKernel((void*)mk_fwd, dim3(grid_blocks), dim3(NTHREADS), args2, 0, stream);
  }
#endif
}
```

```cpp
#include <hip/hip_runtime.h>
#include <hip/hip_bf16.h>
#include <hip/hip_cooperative_groups.h>
#include <cstdio>
#include <cstdint>
namespace cg = cooperative_groups;

typedef unsigned short u16;
typedef unsigned int u32;
typedef unsigned char u8;
typedef short bf16x8 __attribute__((ext_vector_type(8)));
typedef float f32x4 __attribute__((ext_vector_type(4)));
typedef unsigned int u32x4 __attribute__((ext_vector_type(4)));
typedef unsigned int u32x2 __attribute__((ext_vector_type(2)));

constexpr int NTHREADS = 512;
constexpr int BATCH = 8, SEQ = 4096, DM = 1024, MTOK = BATCH * SEQ;
constexpr int LDP = 5120;
constexpr int NPADW = 5504;
constexpr int C_AQ = 0, C_IQ = 512, C_DQ = 1024, C_DK = 1536, C_DV = 2048, C_DZ = 2560, C_GA = 3072, C_GB = 4096;
constexpr int N_AK = 5120, N_AV = 5248, N_IK = 5376, N_SM = 5440;
constexpr size_t MiB = 1ull << 20;
constexpr size_t OFF_WTIN = 1 * MiB, OFF_WTA = 12 * MiB, OFF_WTB = 13 * MiB, OFF_WTO = 14 * MiB, OFF_WTQ = 16 * MiB,
                 OFF_SKB = 20 * MiB, OFF_SMALL = 21 * MiB, OFF_H = 23 * MiB, OFF_ATT = 23 * MiB, OFF_GC = 39 * MiB,
                 OFF_MERGED = 23 * MiB, OFF_PROJ = 87 * MiB, OFF_KVC = 407 * MiB, OFF_IKC = 423 * MiB, OFF_SEL = 427 * MiB, OFF_YATT = 443 * MiB,
                 OFF_YDN = 475 * MiB;
constexpr size_t OFF_H2 = OFF_PROJ, OFF_QP = OFF_PROJ + 64 * MiB, OFF_TOPS = OFF_PROJ + 192 * MiB,
                 OFF_TOPI = OFF_PROJ + 224 * MiB, OFF_EXPERT = OFF_PROJ + 232 * MiB, OFF_GATE = OFF_PROJ + 248 * MiB;
constexpr size_t OFF_UQ = OFF_PROJ + 264 * MiB, OFF_VQ = OFF_PROJ + 280 * MiB, OFF_US = OFF_PROJ + 296 * MiB, OFF_VS = OFF_PROJ + 297 * MiB;
constexpr size_t DO_U = 0, DO_W = 32 * MiB, DO_QN = 64 * MiB, DO_KNT = 96 * MiB;

constexpr int SMEM_BYTES = 162816;
constexpr float EPS = 1e-6f;

struct Params {
  const float* in[17];
  float* out;
  unsigned char* ws;
  int ph_lo, ph_hi;
  int flags, pad;
};

typedef __bf16 bf16x2_t __attribute__((ext_vector_type(2)));
typedef float f32x2_t __attribute__((ext_vector_type(2)));
__device__ __forceinline__ u32 pack2(float a, float b) {
  f32x2_t f = {a, b};
  return __builtin_bit_cast(u32, __builtin_convertvector(f, bf16x2_t));
}
__device__ __forceinline__ u16 f2bf(float f) { return (u16)(pack2(f, f) & 0xffffu); }
__device__ __forceinline__ float bf2f(u16 h) { return __uint_as_float(((u32)h) << 16); }
__device__ __forceinline__ float bflo(u32 w) { return __uint_as_float(w << 16); }
__device__ __forceinline__ float bfhi(u32 w) { return __uint_as_float(w & 0xffff0000u); }
__device__ __forceinline__ float wave_sum(float v) {
#pragma unroll
  for (int o = 32; o > 0; o >>= 1) v += __shfl_xor(v, o);
  return v;
}
__device__ __forceinline__ float wave_max(float v) {
#pragma unroll
  for (int o = 32; o > 0; o >>= 1) v = fmaxf(v, __shfl_xor(v, o));
  return v;
}
__device__ __forceinline__ float dot2bf(u32 a, u32 b, float acc) {
  return __builtin_amdgcn_fdot2_f32_bf16(__builtin_bit_cast(bf16x2_t, a), __builtin_bit_cast(bf16x2_t, b), acc, false);
}
#define DPPF(v, ctrl) __int_as_float(__builtin_amdgcn_update_dpp(0, __float_as_int(v), ctrl, 0xf, 0xf, true))
__device__ __forceinline__ float wave_sum_dpp(float v) {
  v += DPPF(v, 0xb1);
  v += DPPF(v, 0x4e);
  v += DPPF(v, 0x124);
  v += DPPF(v, 0x128);
  float r0 = __int_as_float(__builtin_amdgcn_readlane(__float_as_int(v), 0));
  float r1 = __int_as_float(__builtin_amdgcn_readlane(__float_as_int(v), 16));
  float r2 = __int_as_float(__builtin_amdgcn_readlane(__float_as_int(v), 32));
  float r3 = __int_as_float(__builtin_amdgcn_readlane(__float_as_int(v), 48));
  return (r0 + r1) + (r2 + r3);
}
__device__ __forceinline__ int opaque_tid() { int t = threadIdx.x; asm volatile("" : "+v"(t)); return t; }
#define TIDX opaque_tid()
#define DPPI(v, ctrl) __builtin_amdgcn_update_dpp(0, (v), ctrl, 0xf, 0xf, true)
__device__ __forceinline__ int wave_sum_i_dpp(int v) {
  v += DPPI(v, 0xb1);
  v += DPPI(v, 0x4e);
  v += DPPI(v, 0x124);
  v += DPPI(v, 0x128);
  return (__builtin_amdgcn_readlane(v, 0) + __builtin_amdgcn_readlane(v, 16)) +
         (__builtin_amdgcn_readlane(v, 32) + __builtin_amdgcn_readlane(v, 48));
}
__device__ __forceinline__ float wave_max_dpp(float v) {
  v = fmaxf(v, DPPF(v, 0xb1));
  v = fmaxf(v, DPPF(v, 0x4e));
  v = fmaxf(v, DPPF(v, 0x124));
  v = fmaxf(v, DPPF(v, 0x128));
  float r0 = __int_as_float(__builtin_amdgcn_readlane(__float_as_int(v), 0));
  float r1 = __int_as_float(__builtin_amdgcn_readlane(__float_as_int(v), 16));
  float r2 = __int_as_float(__builtin_amdgcn_readlane(__float_as_int(v), 32));
  float r3 = __int_as_float(__builtin_amdgcn_readlane(__float_as_int(v), 48));
  return fmaxf(fmaxf(r0, r1), fmaxf(r2, r3));
}
#define WAVE_LDS_SYNC() asm volatile("s_waitcnt lgkmcnt(0)" ::: "memory")
__device__ __forceinline__ float sigmoidf_(float x) { return __builtin_amdgcn_rcpf(1.f + __expf(-x)); }
__device__ __forceinline__ int perm32(int k) {
  int blk = k & ~31, r = k & 31;
  int p = (r < 16) ? (8 * (r >> 2) + (r & 3)) : (8 * ((r - 16) >> 2) + 4 + (r & 3));
  return blk + p;
}

__device__ __forceinline__ int win_map(int n) {
  if (n < 512) return n;
  if (n < 1024) return 768 + (n - 512);
  if (n < 3072) return 1352 + (n - 1024);
  if (n < 5120) return 3408 + (n - 3072);
  if (n < 5248) return 512 + (n - 5120);
  if (n < 5376) return 640 + (n - 5248);
  if (n < 5440) return 1280 + (n - 5376);
  if (n < 5448) return 1344 + (n - 5440);
  if (n < 5452) return 3400 + (n - 5448);
  if (n < 5456) return 3404 + (n - 5452);
  return -1;
}
__device__ __forceinline__ void transpose_tile(const float* __restrict__ src, int Nsrc, u16* __restrict__ dst, int K, int k0, int n0,
                               bool mapped, float* tile  ) {
  const int tid = TIDX;
  {
    const int tx = tid & 63, ty = tid >> 6;
    int n = n0 + tx;
    int sc = mapped ? win_map(n) : n;
#pragma unroll
    for (int i = 0; i < 8; ++i) {
      int k = ty + 8 * i;
      float v = (sc >= 0) ? src[(size_t)(k0 + k) * Nsrc + sc] : 0.f;
      tile[k * 65 + tx] = v;
    }
  }
  __syncthreads();
  {
    const int n = tid >> 3, kc = (tid & 7) * 8;
    u32 w[4];
#pragma unroll
    for (int j = 0; j < 4; ++j) w[j] = pack2(tile[(kc + 2 * j) * 65 + n], tile[(kc + 2 * j + 1) * 65 + n]);
    *(uint4*)(dst + (size_t)(n0 + n) * K + k0 + kc) = make_uint4(w[0], w[1], w[2], w[3]);
  }
  __syncthreads();
}

__device__ __forceinline__ void rmsnorm_rows(const float* __restrict__ x, const float* __restrict__ gain, u16* __restrict__ out) {
  const int lane = TIDX & 63, wave = TIDX >> 6;
  float4 g[4];
#pragma unroll
  for (int i = 0; i < 4; ++i) g[i] = ((const float4*)gain)[lane + 64 * i];
  for (int row = blockIdx.x * 8 + wave; row < MTOK; row += gridDim.x * 8) {
    const float4* xr = (const float4*)(x + (size_t)row * DM);
    float4 v[4];
    float ss = 0.f;
#pragma unroll
    for (int i = 0; i < 4; ++i) {
      v[i] = xr[lane + 64 * i];
      ss += v[i].x * v[i].x + v[i].y * v[i].y + v[i].z * v[i].z + v[i].w * v[i].w;
    }
    ss = wave_sum(ss);
    float r = rsqrtf(ss * (1.f / DM) + EPS);
#pragma unroll
    for (int i = 0; i < 4; ++i) {
      uint2 o;
      o.x = pack2(v[i].x * r * g[i].x, v[i].y * r * g[i].y);
      o.y = pack2(v[i].z * r * g[i].z, v[i].w * r * g[i].w);
      *(uint2*)(out + (size_t)row * DM + 4 * (lane + 64 * i)) = o;
    }
  }
}

__device__ __forceinline__ void phase0(const Params& p, unsigned char* smem) {
  float* tile = (float*)smem;
  unsigned char* ws = p.ws;
  const int n_in = 16 * 86, n_a = 8 * 16, n_b = 8 * 16, n_o = 16 * 16, n_q = 16 * 32;
  const int total = n_in + n_a + n_b + n_o + n_q;
  for (int t = blockIdx.x; t < total; t += gridDim.x) {
    int i = t;
    if (i < n_in) { transpose_tile(p.in[2], 5456, (u16*)(ws + OFF_WTIN), 1024, (i / 86) * 64, (i % 86) * 64, true, tile); continue; }
    i -= n_in;
    if (i < n_a) { transpose_tile(p.in[9], 1024, (u16*)(ws + OFF_WTA), 512, (i / 16) * 64, (i % 16) * 64, false, tile); continue; }
    i -= n_a;
    if (i < n_b) { transpose_tile(p.in[10], 1024, (u16*)(ws + OFF_WTB), 512, (i / 16) * 64, (i % 16) * 64, false, tile); continue; }
    i -= n_b;
    if (i < n_o) { transpose_tile(p.in[11], 1024, (u16*)(ws + OFF_WTO), 1024, (i / 16) * 64, (i % 16) * 64, false, tile); continue; }
    i -= n_o;
    transpose_tile(p.in[13], 2048, (u16*)(ws + OFF_WTQ), 1024, (i / 32) * 64, (i % 32) * 64, false, tile);
  }
  {
    const float* sk = p.in[14];
    u16* skb = (u16*)(ws + OFF_SKB);
    for (int i = blockIdx.x * NTHREADS + TIDX; i < 16 * 128 * 128; i += gridDim.x * NTHREADS) skb[i] = f2bf(sk[i]);
  }
  rmsnorm_rows(p.in[0], p.in[1], (u16*)(ws + OFF_H));
}

constexpr int G_BM = 256, G_BN = 128, G_BK = 64;
constexpr int G_ABYTES = G_BM * 128, G_BBYTES = G_BN * 128, G_STAGE = G_ABYTES + G_BBYTES;

__device__ __forceinline__ void gemm_mainloop(const u16* __restrict__ A, int lda, const u16* __restrict__ Bt, int ldb, int K,
                                              int m0, int n0, unsigned char* smem, f32x4 (&acc)[4][4]) {
  const int tid = TIDX, lane = tid & 63, wave = tid >> 6;
  const int wm = wave >> 1, wn = wave & 1;
#pragma unroll
  for (int i = 0; i < 4; ++i)
#pragma unroll
    for (int j = 0; j < 4; ++j) acc[i][j] = (f32x4){0.f, 0.f, 0.f, 0.f};
  const int kc = tid & 7;
  const int arow = tid >> 3;
  u32x4 ra[4], rb[2];
  const u16* ap = A + (size_t)(m0 + arow) * lda + kc * 8;
  const u16* bp = Bt + (size_t)(n0 + arow) * ldb + kc * 8;
  const int nk = K / G_BK;
  const int fr = lane & 15, fg = lane >> 4;
#define G_LOAD(kt_)                                                                       \
  {                                                                                       \
    const u16* ap2_ = ap + (size_t)(kt_) * G_BK;                                          \
    const u16* bp2_ = bp + (size_t)(kt_) * G_BK;                                          \
    _Pragma("unroll") for (int i = 0; i < 4; ++i) ra[i] = *(const u32x4*)(ap2_ + (size_t)(64 * i) * lda); \
    _Pragma("unroll") for (int i = 0; i < 2; ++i) rb[i] = *(const u32x4*)(bp2_ + (size_t)(64 * i) * ldb); \
  }
#define G_STORE(st_)                                                                      \
  {                                                                                       \
    unsigned char* sa_ = smem + (st_) * G_STAGE;                                          \
    unsigned char* sb_ = sa_ + G_ABYTES;                                                  \
    _Pragma("unroll") for (int i = 0; i < 4; ++i) { int r = arow + 64 * i; *(u32x4*)(sa_ + r * 128 + ((kc ^ (r & 7)) << 4)) = ra[i]; } \
    _Pragma("unroll") for (int i = 0; i < 2; ++i) { int r = arow + 64 * i; *(u32x4*)(sb_ + r * 128 + ((kc ^ (r & 7)) << 4)) = rb[i]; } \
  }
  G_LOAD(0)
  __syncthreads();
  G_STORE(0)
  if (nk > 1) G_LOAD(1)
  __syncthreads();
  for (int kt = 0; kt < nk; ++kt) {
    if (kt + 1 < nk) G_STORE((kt + 1) & 1)
    if (kt + 2 < nk) G_LOAD(kt + 2)
    __builtin_amdgcn_sched_barrier(0);
    const unsigned char* sa = smem + (kt & 1) * G_STAGE;
    const unsigned char* sb = sa + G_ABYTES;
#pragma unroll
    for (int kk = 0; kk < 2; ++kk) {
      bf16x8 af[4], bfr[4];
#pragma unroll
      for (int i = 0; i < 4; ++i) {
        int r = wm * 64 + i * 16 + fr;
        af[i] = *(const bf16x8*)(sa + r * 128 + (((kk * 4 + fg) ^ (r & 7)) << 4));
      }
#pragma unroll
      for (int j = 0; j < 4; ++j) {
        int r = wn * 64 + j * 16 + fr;
        bfr[j] = *(const bf16x8*)(sb + r * 128 + (((kk * 4 + fg) ^ (r & 7)) << 4));
      }
#pragma unroll
      for (int i = 0; i < 4; ++i)
#pragma unroll
        for (int j = 0; j < 4; ++j) acc[i][j] = __builtin_amdgcn_mfma_f32_16x16x32_bf16(af[i], bfr[j], acc[i][j], 0, 0, 0);
    }
    __syncthreads();
  }
#undef G_LOAD
#undef G_STORE
}

__device__ __forceinline__ void phase1(const Params& p, unsigned char* smem) {
  const u16* H = (const u16*)(p.ws + OFF_H);
  const u16* WT = (const u16*)(p.ws + OFF_WTIN);
  u16* PROJ = (u16*)(p.ws + OFF_PROJ);
  u16* KVC = (u16*)(p.ws + OFF_KVC);
  u16* IKC = (u16*)(p.ws + OFF_IKC);
  float* SMALL = (float*)(p.ws + OFF_SMALL);
  const int lane = TIDX & 63, wave = TIDX >> 6;
  const int wm = wave >> 1, wn = wave & 1, fr = lane & 15, fg = lane >> 4;
  const int ntn = NPADW / G_BN;
  const int ntiles = (MTOK / G_BM) * ntn;
  for (int t = blockIdx.x; t < ntiles; t += gridDim.x) {
    const int m0 = (t / ntn) * G_BM, n0 = (t % ntn) * G_BN;
    f32x4 acc[4][4];
    gemm_mainloop(H, DM, WT, DM, DM, m0, n0, smem, acc);
    const int cbase = n0 + wn * 64;
    const bool isq = cbase < C_IQ, isk = (cbase >= N_AK && cbase < N_AV);
    if (isq || isk) {
      const float* gain = isq ? p.in[3] : p.in[4];
      const float extra = isq ? 0.125f : 1.0f;
      u16* dst = isq ? PROJ : KVC;
      const u32 ob = isq ? ((u32)(m0 + wm * 64 + 4 * fg) * LDP + (u32)(cbase + fr))
                         : ((u32)(m0 + wm * 64 + 4 * fg) * 256 + (u32)(cbase - N_AK + fr));
      const u32 ld = isq ? (u32)LDP : 256u;
      float gj[4];
#pragma unroll
      for (int j = 0; j < 4; ++j) gj[j] = gain[j * 16 + fr] * extra;
#pragma unroll
      for (int i = 0; i < 4; ++i) {
        float ss[4];
#pragma unroll
        for (int r = 0; r < 4; ++r) {
          float sq = 0.f;
#pragma unroll
          for (int j = 0; j < 4; ++j) sq += acc[i][j][r] * acc[i][j][r];
          sq += DPPF(sq, 0xb1); sq += DPPF(sq, 0x4e); sq += DPPF(sq, 0x141); sq += DPPF(sq, 0x140);
          ss[r] = rsqrtf(sq * (1.f / 64.f) + EPS);
        }
#pragma unroll
        for (int j = 0; j < 4; ++j)
#pragma unroll
          for (int r = 0; r < 4; ++r) dst[ob + (u32)(i * 16 + r) * ld + (u32)(j * 16)] = f2bf(acc[i][j][r] * ss[r] * gj[j]);
      }
    } else if (cbase < LDP) {
      const u32 rb0 = (u32)(m0 + wm * 64 + 4 * fg) * LDP + (u32)(cbase + fr);
#pragma unroll
      for (int i = 0; i < 4; ++i)
#pragma unroll
        for (int j = 0; j < 4; ++j)
#pragma unroll
          for (int r = 0; r < 4; ++r) PROJ[rb0 + (u32)((i * 16 + r) * LDP + j * 16)] = f2bf(acc[i][j][r]);
    } else if (cbase < N_IK) {
      const u32 vb0 = (u32)(m0 + wm * 64 + 4 * fg) * 256 + (u32)(cbase - N_AV + 128 + fr);
#pragma unroll
      for (int i = 0; i < 4; ++i)
#pragma unroll
        for (int j = 0; j < 4; ++j)
#pragma unroll
          for (int r = 0; r < 4; ++r) KVC[vb0 + (u32)((i * 16 + r) * 256 + j * 16)] = f2bf(acc[i][j][r]);
    } else if (cbase < N_SM) {
      const u32 ib0 = (u32)(m0 + wm * 64 + 4 * fg) * 64 + (u32)fr;
#pragma unroll
      for (int i = 0; i < 4; ++i)
#pragma unroll
        for (int j = 0; j < 4; ++j)
#pragma unroll
          for (int r = 0; r < 4; ++r) IKC[ib0 + (u32)((i * 16 + r) * 64 + j * 16)] = f2bf(acc[i][j][r]);
    } else {
      const u32 sb0 = (u32)(m0 + wm * 64 + 4 * fg) * 16 + (u32)fr;
#pragma unroll
      for (int i = 0; i < 4; ++i)
#pragma unroll
        for (int r = 0; r < 4; ++r) SMALL[sb0 + (u32)((i * 16 + r) * 16)] = acc[i][0][r];
    }
  }
}

constexpr int IDX_RS = 8208;

__device__ __forceinline__ u32 f2key(float x) {
  _Float16 h = (_Float16)x;
  u32 b = (u32) * (u16*)&h;
  return (b & 0x8000u) ? ((~b) & 0xffffu) : (b | 0x8000u);
}
__device__ __forceinline__ int count_ge_wave(const u32 (&kreg)[32], u32 mid) {
  const u32 m1 = (mid - 1u) * 0x00010001u;
  const u32 one = 0x00010001u;
  u32 acc0 = 0u, acc1 = 0u;
#pragma unroll
  for (int i = 0; i < 32; i += 2) {
    u32 t0, t1;
    asm("v_pk_sub_u16 %0, %1, %2 clamp" : "=v"(t0) : "v"(kreg[i]), "s"(m1));
    asm("v_pk_sub_u16 %0, %1, %2 clamp" : "=v"(t1) : "v"(kreg[i + 1]), "s"(m1));
    asm("v_pk_min_u16 %0, %1, %2" : "=v"(t0) : "v"(t0), "s"(one));
    asm("v_pk_min_u16 %0, %1, %2" : "=v"(t1) : "v"(t1), "s"(one));
    asm("v_pk_add_u16 %0, %1, %2" : "=v"(acc0) : "v"(acc0), "v"(t0));
    asm("v_pk_add_u16 %0, %1, %2" : "=v"(acc1) : "v"(acc1), "v"(t1));
  }
  int c = (int)((acc0 & 0xffffu) + (acc0 >> 16) + (acc1 & 0xffffu) + (acc1 >> 16));
  return wave_sum_i_dpp(c);
}

__device__ __forceinline__ void idx_item(const Params& p, unsigned char* smem, int b, int tq) {
  const u16* PROJ = (const u16*)(p.ws + OFF_PROJ);
  const float* SMALL = (const float*)(p.ws + OFF_SMALL);
  u16* SEL = (u16*)(p.ws + OFF_SEL);
  const int tid = TIDX, lane = tid & 63, wave = tid >> 6;
  const int t0 = tq * 16;
  const size_t tokb = (size_t)b * SEQ;
  if (tq < 16) {
    for (int rr = 0; rr < 2; ++rr) {
      int row = 2 * wave + rr, t = t0 + row;
      u16* out = SEL + (tokb + t) * 256;
      for (int i = lane; i < 256; i += 64) out[i] = (i <= t) ? (u16)i : (u16)0xFFFF;
    }
    return;
  }
  const int q = lane & 15, g = lane >> 4;
  __syncthreads();
  {
    const u16* iqrow = PROJ + (tokb + t0 + q) * LDP + C_IQ;
    bf16x8 bq[8][2];
    float wq[8];
#pragma unroll
    for (int h = 0; h < 8; ++h) {
      bq[h][0] = *(const bf16x8*)(iqrow + h * 64 + g * 8);
      bq[h][1] = *(const bf16x8*)(iqrow + h * 64 + 32 + g * 8);
      wq[h] = SMALL[(tokb + t0 + q) * 16 + h];
    }
    const int nkb = tq + 1;
    const int niter = (nkb > wave) ? ((nkb - wave + 7) >> 3) : 0;
    const u16* ikbase = (const u16*)(p.ws + OFF_IKC) + (tokb + q) * 64 + g * 8;
    bf16x8 ca[3][2];
#pragma unroll
    for (int j = 0; j < 3; ++j)
      if (j < niter) {
        const u16* ikrow = ikbase + (size_t)((wave + 8 * j) * 16) * 64;
        ca[j][0] = *(const bf16x8*)(ikrow); ca[j][1] = *(const bf16x8*)(ikrow + 32);
      }
    for (int i0 = 0; i0 < ((p.flags & 8) ? 0 : niter); i0 += 3) {
#pragma unroll
      for (int j = 0; j < 3; ++j) {
        if (i0 + j < niter) {
          const int s0 = (wave + 8 * (i0 + j)) * 16;
          f32x4 tot = {0.f, 0.f, 0.f, 0.f};
#pragma unroll
          for (int h = 0; h < 8; ++h) {
            f32x4 acc = {0.f, 0.f, 0.f, 0.f};
            acc = __builtin_amdgcn_mfma_f32_16x16x32_bf16(ca[j][0], bq[h][0], acc, 0, 0, 0);
            acc = __builtin_amdgcn_mfma_f32_16x16x32_bf16(ca[j][1], bq[h][1], acc, 0, 0, 0);
#pragma unroll
            for (int r = 0; r < 4; ++r) tot[r] += wq[h] * fmaxf(acc[r], 0.f);
          }
          if (i0 + 3 + j < niter) {
            const u16* ikrow = ikbase + (size_t)((wave + 8 * (i0 + 3 + j)) * 16) * 64;
            ca[j][0] = *(const bf16x8*)(ikrow); ca[j][1] = *(const bf16x8*)(ikrow + 32);
          }
          u32 k[4];
#pragma unroll
          for (int r = 0; r < 4; ++r) {
            int sidx = s0 + 4 * g + r;
            k[r] = (sidx <= t0 + q) ? f2key(tot[r]) : 0u;
          }
          u32x2 w2 = {k[0] | (k[1] << 16), k[2] | (k[3] << 16)};
          *(u32x2*)(smem + q * IDX_RS + (s0 + 4 * g) * 2) = w2;
        }
        __builtin_amdgcn_sched_barrier(0);
      }
    }
    const int nk = t0 + 16, nk64 = (nk + 63) & ~63;
    for (int i = tid; i < 16 * (nk64 - nk); i += NTHREADS) {
      int row = i / (nk64 - nk), c = nk + i % (nk64 - nk);
      *(u16*)(smem + row * IDX_RS + c * 2) = 0;
    }
  }
  __syncthreads();
  const int nk64 = (t0 + 16 + 63) & ~63;
  for (int rr = 0; rr < ((p.flags & 16) ? 0 : 2); ++rr) {
    const int row = 2 * wave + rr, t = t0 + row;
    u16* out = SEL + (tokb + t) * 256;
    u32 kreg[32];
    if (lane * 64 < nk64) {
      const uint4* src = (const uint4*)(smem + row * IDX_RS + lane * 128);
#pragma unroll
      for (int i = 0; i < 8; ++i) {
        uint4 v = src[i];
        kreg[4 * i] = v.x; kreg[4 * i + 1] = v.y; kreg[4 * i + 2] = v.z; kreg[4 * i + 3] = v.w;
      }
    } else {
#pragma unroll
      for (int i = 0; i < 32; ++i) kreg[i] = 0u;
    }
    WAVE_LDS_SYNC();
    u32 lo = 1u, hi = 65535u;
    while (lo < hi) {
      u32 mid = (lo + hi + 1u) >> 1;
      int c = count_ge_wave(kreg, mid);
      if (c >= 256) lo = mid; else hi = mid - 1u;
    }
    const u32 tau = lo;
    int gt = 0, eq = 0;
#pragma unroll
    for (int i = 0; i < 32; ++i) {
      u32 a = kreg[i] & 0xffffu, c2 = kreg[i] >> 16;
      gt += (a > tau) ? 1 : 0; gt += (c2 > tau) ? 1 : 0;
      eq += (a == tau) ? 1 : 0; eq += (c2 == tau) ? 1 : 0;
    }
    int packed = gt | (eq << 16);
    int incl = packed;
#pragma unroll
    for (int o = 1; o < 64; o <<= 1) {
      int v = __shfl_up(incl, o);
      if (lane >= o) incl += v;
    }
    const int excl = incl - packed;
    const int total = __shfl(incl, 63);
    const int need = 256 - (total & 0xffff);
    const int pg = excl & 0xffff, pe = excl >> 16;
    int pos = pg + min(pe, need);
    int eqseen = pe;
    u16* lrow = (u16*)(smem + row * IDX_RS);
#pragma unroll
    for (int i = 0; i < 32; ++i) {
#pragma unroll
      for (int hh = 0; hh < 2; ++hh) {
        u32 kv = hh ? (kreg[i] >> 16) : (kreg[i] & 0xffffu);
        int idx = lane * 64 + 2 * i + hh;
        bool take = false;
        if (kv > tau) take = true;
        else if (kv == tau) { take = (eqseen < need); ++eqseen; }
        if (take) { lrow[pos] = (u16)idx; ++pos; }
      }
    }
    WAVE_LDS_SYNC();
    *(u32x2*)(out + lane * 4) = *(const u32x2*)(lrow + lane * 4);
    WAVE_LDS_SYNC();
  }
}

constexpr int DNP = 68;
constexpr int DL_KT = 0;
constexpr int DL_V = DL_KT + 128 * DNP * 4;
constexpr int DL_QB = DL_V + 64 * 128 * 4;
constexpr int DL_KB = DL_QB + 64 * 272;
constexpr int DL_SM = DL_KB + 64 * 272;
constexpr int DL_RAW = DL_SM + 2048;
static_assert(DL_RAW + 3 * 67 * 272 <= SMEM_BYTES, "dn_local LDS");
__device__ __forceinline__ void dn_local_item(const Params& p, unsigned char* smem, int item) {
  const int h = item & 3, n = (item >> 2) & 63, b = item >> 8;
  const u16* PROJ = (const u16*)(p.ws + OFF_PROJ);
  const float* SMALL = (const float*)(p.ws + OFF_SMALL);
  u16* Ug = (u16*)((unsigned char*)p.out + DO_U);
  u16* Wg = (u16*)((unsigned char*)p.out + DO_W);
  u16* QNg = (u16*)((unsigned char*)p.out + DO_QN);
  u16* KNTg = (u16*)((unsigned char*)p.out + DO_KNT);
  u16* ATTg = (u16*)(p.ws + OFF_ATT);
  float* GCg = (float*)(p.ws + OFF_GC);
  const float* convw = p.in[5];
  const int tid = TIDX, lane = tid & 63, wave = tid >> 6;
  const int c0 = n * 64;
  const size_t tok0 = (size_t)b * SEQ + c0;
  float* Kt = (float*)(smem + DL_KT);
  float* V = (float*)(smem + DL_V);
  unsigned char* Qb = smem + DL_QB;
  unsigned char* Kb = smem + DL_KB;
  float* gc = (float*)(smem + DL_SM);
  float* beta = gc + 64;
  float* ssp = beta + 64;
  unsigned char* RAW = smem + DL_RAW;
  float* AmT = (float*)(smem + DL_RAW);
  __syncthreads();
  {
    u32x4 rg[7];
#pragma unroll
    for (int k = 0; k < 7; ++k) {
      const int ci = tid + 512 * k;
      rg[k] = (u32x4){0u, 0u, 0u, 0u};
      if (ci < 3216) {
        const int arr = ci / 1072, rem = ci - arr * 1072, row = rem >> 4, ch = rem & 15;
        const int trel = c0 - 3 + row;
        if (trel >= 0)
          rg[k] = *(const u32x4*)(PROJ + ((size_t)b * SEQ + trel) * LDP + (C_DQ + arr * 512) + h * 128 + ch * 8);
      }
    }
#pragma unroll
    for (int k = 0; k < 7; ++k) {
      const int ci = tid + 512 * k;
      if (ci < 3216) {
        const int arr = ci / 1072, rem = ci - arr * 1072, row = rem >> 4, ch = rem & 15;
        *(u32x4*)(RAW + (arr * 67 + row) * 272 + ch * 16) = rg[k];
      }
    }
  }
  if (tid < 64) {
    float da = SMALL[(tok0 + tid) * 16 + 8 + h], db = SMALL[(tok0 + tid) * 16 + 12 + h];
    float xx = da + p.in[7][h];
    float sp = fmaxf(xx, 0.f) + log1pf(__expf(-fabsf(xx)));
    float gr = -__expf(p.in[6][h]) * sp;
    float incl = gr;
#pragma unroll
    for (int o = 1; o < 64; o <<= 1) {
      float v = __shfl_up(incl, o);
      if (lane >= o) incl += v;
    }
    gc[tid] = incl;
    beta[tid] = sigmoidf_(db);
    GCg[(tok0 + tid) * 4 + h] = incl;
  }
  __syncthreads();
  {
    const int c = tid & 127, tg = tid >> 7;
    float qv[16], kv[16];
#pragma unroll
    for (int arr = 0; arr < 3; ++arr) {
      const float w0 = convw[0 * 1536 + arr * 512 + h * 128 + c], w1 = convw[1 * 1536 + arr * 512 + h * 128 + c],
                  w2 = convw[2 * 1536 + arr * 512 + h * 128 + c], w3 = convw[3 * 1536 + arr * 512 + h * 128 + c];
      const unsigned char* rp = RAW + (arr * 67 + tg * 16) * 272 + c * 2;
      float x0 = bf2f(*(const u16*)(rp)), x1 = bf2f(*(const u16*)(rp + 272)), x2 = bf2f(*(const u16*)(rp + 2 * 272));
#pragma unroll
      for (int ii = 0; ii < 16; ++ii) {
        const float x3 = bf2f(*(const u16*)(rp + (ii + 3) * 272));
        const float y = w0 * x0 + w1 * x1 + w2 * x2 + w3 * x3;
        const float sv = y * sigmoidf_(y);
        if (arr == 0) qv[ii] = sv;
        else if (arr == 1) kv[ii] = sv;
        else V[(tg * 16 + ii) * 128 + c] = sv;
        x0 = x1; x1 = x2; x2 = x3;
      }
    }
#pragma unroll
    for (int ii = 0; ii < 16; ++ii) {
      const float sq = wave_sum_dpp(qv[ii] * qv[ii]);
      const float sk = wave_sum_dpp(kv[ii] * kv[ii]);
      if (lane == 0) {
        ssp[((tg * 16 + ii) * 2) + (wave & 1)] = sq;
        ssp[128 + ((tg * 16 + ii) * 2) + (wave & 1)] = sk;
      }
    }
    __syncthreads();
#pragma unroll
    for (int ii = 0; ii < 16; ++ii) {
      const int i = tg * 16 + ii;
      const float qsc = rsqrtf(ssp[i * 2] + ssp[i * 2 + 1] + EPS) * 0.08838834764831845f;
      const float ksc = rsqrtf(ssp[128 + i * 2] + ssp[128 + i * 2 + 1] + EPS);
      const float qn = qv[ii] * qsc, kn = kv[ii] * ksc;
      *(u16*)(Qb + i * 272 + c * 2) = f2bf(qn);
      *(u16*)(Kb + i * 272 + c * 2) = f2bf(kn);
      Kt[c * DNP + i] = kn;
    }
  }
  __syncthreads();
#pragma unroll
  for (int k = 0; k < 4; ++k) {
    const int gi = tid + 512 * k;
    {
      const int i = gi >> 5, d4 = (gi & 31) * 4;
      const u32x2 v = *(const u32x2*)(Qb + i * 272 + d4 * 2);
      *(u32x2*)(QNg + (tok0 + i) * 512 + h * 128 + perm32(d4)) = v;
    }
    {
      const int d = gi >> 4, t4 = (gi & 15) * 4;
      const f32x4 v = *(const f32x4*)(Kt + d * DNP + t4);
      u32x2 o = {pack2(v[0], v[1]), pack2(v[2], v[3])};
      *(u32x2*)(KNTg + (size_t)item * 8192 + d * 64 + perm32(t4)) = o;
    }
  }
  {
    const int mat = wave >> 2, it = wave & 3;
    const int fr = lane & 15, fg = lane >> 4;
    const unsigned char* Ab = mat ? Qb : Kb;
    bf16x8 af[4];
#pragma unroll
    for (int kk = 0; kk < 4; ++kk) af[kk] = *(const bf16x8*)(Ab + (it * 16 + fr) * 272 + kk * 64 + fg * 16);
    f32x4 gi4 = *(const f32x4*)(gc + it * 16 + 4 * fg);
    f32x4 bi4 = *(const f32x4*)(beta + it * 16 + 4 * fg);
#pragma unroll
    for (int jt = 0; jt < 4; ++jt) {
      f32x4 acc = {0.f, 0.f, 0.f, 0.f};
      if (jt <= it) {
#pragma unroll
        for (int kk = 0; kk < 4; ++kk) {
          bf16x8 bfg = *(const bf16x8*)(Kb + (jt * 16 + fr) * 272 + kk * 64 + fg * 16);
          acc = __builtin_amdgcn_mfma_f32_16x16x32_bf16(af[kk], bfg, acc, 0, 0, 0);
        }
      }
      const int j = jt * 16 + fr;
      const float gj = gc[j];
#pragma unroll
      for (int r = 0; r < 4; ++r) {
        const int i = it * 16 + 4 * fg + r;
        const float dec = __expf(fminf(gi4[r] - gj, 0.f));
        if (mat == 0) { if (jt <= it) AmT[j * 64 + i] = (i > j) ? bi4[r] * acc[r] * dec : 0.f; }
        else ATTg[(size_t)item * 4096 + i * 64 + perm32(j)] = f2bf((i >= j) ? acc[r] * dec : 0.f);
      }
    }
  }
  __syncthreads();
  if (tid < 256) {
    const int c = tid;
    const bool isu = c < 128;
    const int cc = c & 127;
    const int pc = perm32(cc);
#pragma unroll 1
    for (int ib = 0; ib < 4; ++ib) {
      float sreg[16];
#pragma unroll
      for (int r = 0; r < 16; ++r) {
        int i = ib * 16 + r;
        sreg[r] = isu ? V[i * 128 + cc] * beta[i] : Kt[cc * DNP + i] * beta[i] * __expf(gc[i]);
      }
#pragma unroll 1
      for (int j = 0; j < ib * 16; ++j) {
        float xj = isu ? V[j * 128 + cc] : Kt[cc * DNP + j];
        const f32x4* ap = (const f32x4*)(AmT + j * 64 + ib * 16);
        f32x4 a0 = ap[0], a1 = ap[1], a2 = ap[2], a3 = ap[3];
        sreg[0] -= a0[0] * xj; sreg[1] -= a0[1] * xj; sreg[2] -= a0[2] * xj; sreg[3] -= a0[3] * xj;
        sreg[4] -= a1[0] * xj; sreg[5] -= a1[1] * xj; sreg[6] -= a1[2] * xj; sreg[7] -= a1[3] * xj;
        sreg[8] -= a2[0] * xj; sreg[9] -= a2[1] * xj; sreg[10] -= a2[2] * xj; sreg[11] -= a2[3] * xj;
        sreg[12] -= a3[0] * xj; sreg[13] -= a3[1] * xj; sreg[14] -= a3[2] * xj; sreg[15] -= a3[3] * xj;
      }
#pragma unroll
      for (int q = 0; q < 15; ++q) {
        const float* ar = AmT + (ib * 16 + q) * 64 + ib * 16;
#pragma unroll
        for (int r = q + 1; r < 16; ++r) sreg[r] -= ar[r] * sreg[q];
      }
#pragma unroll
      for (int r = 0; r < 16; ++r) {
        int i = ib * 16 + r;
        if (isu) { V[i * 128 + cc] = sreg[r]; Ug[(tok0 + i) * 512 + h * 128 + cc] = f2bf(sreg[r]); }
        else { Kt[cc * DNP + i] = sreg[r]; Wg[(tok0 + i) * 512 + h * 128 + pc] = f2bf(sreg[r]); }
      }
    }
  }
}

__device__ __forceinline__ void phase2(const Params& p, unsigned char* smem) {
#ifndef NO_IDX
  for (int i = blockIdx.x; i < 2048; i += gridDim.x) idx_item(p, smem, i & 7, 255 - (i >> 3));
#endif
#ifndef NO_DNL
  if (!(p.flags & 1))
    for (int i = blockIdx.x; i < 2048; i += gridDim.x) dn_local_item(p, smem, i);
#endif
}

constexpr int SC_WP = 272, SC_KP = 144;
constexpr int SC_W = 0, SC_Q = 64 * SC_WP, SC_KT = 2 * 64 * SC_WP, SC_AT = SC_KT + 128 * SC_KP, SC_U = SC_AT + 64 * SC_KP,
              SC_BUF = SC_U + 64 * SC_WP;
constexpr int SC_GC = 2 * SC_BUF;
static_assert(SC_GC + 2 * 64 * 4 <= SMEM_BYTES, "scan LDS");

__device__ __forceinline__ void dn_scan_item(const Params& p, unsigned char* smem, int bh) {
  const int h = bh & 3, b = bh >> 2;
  const u16* Ug = (const u16*)((const unsigned char*)p.out + DO_U);
  const u16* Wg = (const u16*)((const unsigned char*)p.out + DO_W);
  const u16* QNg = (const u16*)((const unsigned char*)p.out + DO_QN);
  const u16* KNTg = (const u16*)((const unsigned char*)p.out + DO_KNT);
  const u16* ATTg = (const u16*)(p.ws + OFF_ATT);
  const float* GCg = (const float*)(p.ws + OFF_GC);
  const u16* PROJ = (const u16*)(p.ws + OFF_PROJ);
  u16* YDN = (u16*)(p.ws + OFF_YDN);
  const float* ogain = p.in[8];
  const int tid = TIDX, lane = tid & 63, wave = tid >> 6;
  const int fr = lane & 15, fg = lane >> 4;
  const int ecol = wave * 16 + fr;
  float* gcs = (float*)(smem + SC_GC);
  f32x4 S[8];
#pragma unroll
  for (int d = 0; d < 8; ++d) S[d] = (f32x4){0.f, 0.f, 0.f, 0.f};
  u32x4 st[9];
  float gcr = 0.f;
  const int r16 = tid >> 4, c16 = tid & 15;
  const int r8 = tid >> 3, c8 = tid & 7;
#define SCAN_LOAD(n_)                                                                                      \
  {                                                                                                        \
    const size_t tk0 = (size_t)b * SEQ + (size_t)(n_) * 64;                                                \
    const size_t it_ = (size_t)((b * 64 + (n_)) * 4 + h);                                                  \
    st[0] = *(const u32x4*)(Wg + (tk0 + r16) * 512 + h * 128 + c16 * 8);                                   \
    st[1] = *(const u32x4*)(Wg + (tk0 + r16 + 32) * 512 + h * 128 + c16 * 8);                              \
    st[2] = *(const u32x4*)(QNg + (tk0 + r16) * 512 + h * 128 + c16 * 8);                                  \
    st[3] = *(const u32x4*)(QNg + (tk0 + r16 + 32) * 512 + h * 128 + c16 * 8);                             \
    st[4] = *(const u32x4*)(KNTg + it_ * 8192 + (size_t)tid * 8);                                          \
    st[5] = *(const u32x4*)(KNTg + it_ * 8192 + (size_t)(tid + 512) * 8);                                  \
    st[6] = *(const u32x4*)(ATTg + it_ * 4096 + (size_t)tid * 8);                                          \
    st[7] = *(const u32x4*)(Ug + (tk0 + r16) * 512 + h * 128 + c16 * 8);                                   \
    st[8] = *(const u32x4*)(Ug + (tk0 + r16 + 32) * 512 + h * 128 + c16 * 8);                              \
    if (tid < 64) gcr = GCg[(tk0 + tid) * 4 + h];                                                          \
  }
#define SCAN_STORE(buf_)                                                                                   \
  {                                                                                                        \
    unsigned char* bs_ = smem + (buf_) * SC_BUF;                                                           \
    *(u32x4*)(bs_ + SC_W + r16 * SC_WP + c16 * 16) = st[0];                                                \
    *(u32x4*)(bs_ + SC_W + (r16 + 32) * SC_WP + c16 * 16) = st[1];                                         \
    *(u32x4*)(bs_ + SC_Q + r16 * SC_WP + c16 * 16) = st[2];                                                \
    *(u32x4*)(bs_ + SC_Q + (r16 + 32) * SC_WP + c16 * 16) = st[3];                                         \
    *(u32x4*)(bs_ + SC_KT + r8 * SC_KP + c8 * 16) = st[4];                                                 \
    *(u32x4*)(bs_ + SC_KT + (r8 + 64) * SC_KP + c8 * 16) = st[5];                                          \
    *(u32x4*)(bs_ + SC_AT + r8 * SC_KP + c8 * 16) = st[6];                                                 \
    *(u32x4*)(bs_ + SC_U + r16 * SC_WP + c16 * 16) = st[7];                                                \
    *(u32x4*)(bs_ + SC_U + (r16 + 32) * SC_WP + c16 * 16) = st[8];                                         \
    if (tid < 64) gcs[(buf_) * 64 + tid] = gcr;                                                            \
  }
  __syncthreads();
  SCAN_LOAD(0)
  SCAN_STORE(0)
  if (1 < 64) SCAN_LOAD(1)
  __syncthreads();
  for (int n = 0; n < 64; ++n) {
    const int buf = n & 1;
    const size_t tok0 = (size_t)b * SEQ + n * 64;
    if (n + 1 < 64) SCAN_STORE(buf ^ 1)
    if (n + 2 < 64) SCAN_LOAD(n + 2)
    __builtin_amdgcn_sched_barrier(0);
    const unsigned char* base = smem + buf * SC_BUF;
    const u32 ub0 = (u32)(tok0 + 4 * fg) * 512 + (u32)(h * 128 + ecol);
    const float* gcb = gcs + buf * 64 + 4 * fg;
    const float glast = gcs[buf * 64 + 63];
    bf16x8 Sb[4];
#pragma unroll
    for (int kk = 0; kk < 4; ++kk) {
      union { u32 w[4]; bf16x8 v; } cv;
      cv.w[0] = pack2(S[2 * kk][0], S[2 * kk][1]); cv.w[1] = pack2(S[2 * kk][2], S[2 * kk][3]);
      cv.w[2] = pack2(S[2 * kk + 1][0], S[2 * kk + 1][1]); cv.w[3] = pack2(S[2 * kk + 1][2], S[2 * kk + 1][3]);
      Sb[kk] = cv.v;
    }
    f32x4 vnew[4], ov[4];
#pragma unroll
    for (int m = 0; m < 4; ++m) {
      f32x4 aw = {0.f, 0.f, 0.f, 0.f}, aq = {0.f, 0.f, 0.f, 0.f};
#pragma unroll
      for (int kk = 0; kk < 4; ++kk) {
        bf16x8 wf = *(const bf16x8*)(base + SC_W + (m * 16 + fr) * SC_WP + kk * 64 + fg * 16);
        bf16x8 qf = *(const bf16x8*)(base + SC_Q + (m * 16 + fr) * SC_WP + kk * 64 + fg * 16);
        aw = __builtin_amdgcn_mfma_f32_16x16x32_bf16(wf, Sb[kk], aw, 0, 0, 0);
        aq = __builtin_amdgcn_mfma_f32_16x16x32_bf16(qf, Sb[kk], aq, 0, 0, 0);
      }
      f32x4 g4 = *(const f32x4*)(gcb + m * 16);
#pragma unroll
      for (int r = 0; r < 4; ++r) {
        float uv = bf2f(*(const u16*)(base + SC_U + (m * 16 + 4 * fg + r) * SC_WP + ecol * 2));
        vnew[m][r] = uv - aw[r];
        ov[m][r] = aq[r] * __expf(g4[r]);
      }
    }
    bf16x8 vb[2], vsb[2];
#pragma unroll
    for (int k2 = 0; k2 < 2; ++k2) {
      union { u32 w[4]; bf16x8 v; } c1, c2;
      const int ma = 2 * k2, mb = 2 * k2 + 1;
      c1.w[0] = pack2(vnew[ma][0], vnew[ma][1]); c1.w[1] = pack2(vnew[ma][2], vnew[ma][3]);
      c1.w[2] = pack2(vnew[mb][0], vnew[mb][1]); c1.w[3] = pack2(vnew[mb][2], vnew[mb][3]);
      f32x4 ga4 = *(const f32x4*)(gcb + ma * 16), gb4 = *(const f32x4*)(gcb + mb * 16);
      float sa[4], sb2[4];
#pragma unroll
      for (int r = 0; r < 4; ++r) { sa[r] = vnew[ma][r] * __expf(glast - ga4[r]); sb2[r] = vnew[mb][r] * __expf(glast - gb4[r]); }
      c2.w[0] = pack2(sa[0], sa[1]); c2.w[1] = pack2(sa[2], sa[3]);
      c2.w[2] = pack2(sb2[0], sb2[1]); c2.w[3] = pack2(sb2[2], sb2[3]);
      vb[k2] = c1.v; vsb[k2] = c2.v;
    }
    const float egl = __expf(glast);
#pragma unroll
    for (int d = 0; d < 8; ++d) {
      f32x4 a = S[d] * egl;
#pragma unroll
      for (int k2 = 0; k2 < 2; ++k2) {
        bf16x8 kf = *(const bf16x8*)(base + SC_KT + (d * 16 + fr) * SC_KP + k2 * 64 + fg * 16);
        a = __builtin_amdgcn_mfma_f32_16x16x32_bf16(kf, vsb[k2], a, 0, 0, 0);
      }
      S[d] = a;
    }
#pragma unroll
    for (int m = 0; m < 4; ++m) {
      f32x4 ao = ov[m];
#pragma unroll
      for (int k2 = 0; k2 < 2; ++k2) {
        bf16x8 af = *(const bf16x8*)(base + SC_AT + (m * 16 + fr) * SC_KP + k2 * 64 + fg * 16);
        ao = __builtin_amdgcn_mfma_f32_16x16x32_bf16(af, vb[k2], ao, 0, 0, 0);
      }
#pragma unroll
      for (int r = 0; r < 4; ++r) YDN[ub0 + (u32)((m * 16 + r) * 512)] = f2bf(ao[r]);
    }
    __syncthreads();
  }
#undef SCAN_LOAD
#undef SCAN_STORE
  asm volatile("s_waitcnt vmcnt(0)" ::: "memory");
  __syncthreads();
  {
    const int sub = lane >> 4, l16 = lane & 15;
    float gn8[8];
#pragma unroll
    for (int e = 0; e < 8; ++e) gn8[e] = ogain[l16 * 8 + e];
    for (int t = wave * 4 + sub; t < SEQ; t += 32) {
      const size_t tok = (size_t)b * SEQ + t;
      u16* yp = YDN + tok * 512 + h * 128 + l16 * 8;
      const u32x4 ov4 = *(const u32x4*)yp;
      const u32x4 zv4 = *(const u32x4*)(PROJ + tok * LDP + C_DZ + h * 128 + l16 * 8);
      float o8[8], z8[8];
#pragma unroll
      for (int c = 0; c < 4; ++c) { o8[2 * c] = bflo(ov4[c]); o8[2 * c + 1] = bfhi(ov4[c]); z8[2 * c] = bflo(zv4[c]); z8[2 * c + 1] = bfhi(zv4[c]); }
      float sq = 0.f;
#pragma unroll
      for (int e = 0; e < 8; ++e) sq += o8[e] * o8[e];
      sq += DPPF(sq, 0xb1); sq += DPPF(sq, 0x4e); sq += DPPF(sq, 0x141); sq += DPPF(sq, 0x140);
      const float rstd = rsqrtf(sq * (1.f / 128.f) + EPS);
      u32 w[4];
#pragma unroll
      for (int c = 0; c < 4; ++c) {
        const float y0 = o8[2 * c] * rstd * gn8[2 * c] * z8[2 * c] * sigmoidf_(z8[2 * c]);
        const float y1 = o8[2 * c + 1] * rstd * gn8[2 * c + 1] * z8[2 * c + 1] * sigmoidf_(z8[2 * c + 1]);
        w[c] = pack2(y0, y1);
      }
      *(u32x4*)yp = (u32x4){w[0], w[1], w[2], w[3]};
    }
  }
}

constexpr int AT_WAVE_BYTES = 8192 + 512 + 8192;
__device__ __forceinline__ float xor16_sum(float v) {
  auto r = __builtin_amdgcn_permlane16_swap(__float_as_uint(v), __float_as_uint(v), false, false);
  return __uint_as_float(r[0]) + __uint_as_float(r[1]);
}
__device__ __forceinline__ float xor32_sum(float v) {
  auto r = __builtin_amdgcn_permlane32_swap(__float_as_uint(v), __float_as_uint(v), false, false);
  return __uint_as_float(r[0]) + __uint_as_float(r[1]);
}
__device__ __forceinline__ void attn_query(const Params& p, unsigned char* wsm, int b, int t) {
  const u16* PROJ = (const u16*)(p.ws + OFF_PROJ);
  const u16* SEL = (const u16*)(p.ws + OFF_SEL);
  const u16* KVC = (const u16*)(p.ws + OFF_KVC);
  u16* YATT = (u16*)(p.ws + OFF_YATT);
  const int lane = TIDX & 63;
  const int fr = lane & 15, fg = lane >> 4;
  float* P = (float*)wsm;
  u16* sl = (u16*)(wsm + 8192);
  const size_t tokb = (size_t)b * SEQ;
  const size_t tok = tokb + t;
  const int nsel = min(256, t + 1);
  bf16x8 qb[2][2];
  {
    const bf16x8 z = {0, 0, 0, 0, 0, 0, 0, 0};
    const u16* qrow = PROJ + tok * LDP + C_AQ + (fr & 3) * 64 + fg * 8;
#pragma unroll
    for (int g = 0; g < 2; ++g)
#pragma unroll
      for (int kk = 0; kk < 2; ++kk) {
        bf16x8 v = *(const bf16x8*)(qrow + g * 256 + kk * 32);
        qb[g][kk] = (fr < 4) ? v : z;
      }
    const u16* sr = SEL + tok * 256;
#pragma unroll
    for (int i = 0; i < 4; ++i) sl[lane + 64 * i] = sr[lane + 64 * i];
  }
  WAVE_LDS_SYNC();
  const int ngrp = (nsel + 15) >> 4;
  const int nbq = (ngrp + 1) >> 1;
  unsigned char* KST = wsm + 8192 + 512;
  const int kq = lane >> 3, kch = lane & 7;
  u32x4 kA[2][4], kB[2][4];
#define QK_LOAD(buf_, bi_)                                                                       \
  _Pragma("unroll") for (int j = 0; j < 2; ++j)                                                  \
    _Pragma("unroll") for (int hf = 0; hf < 2; ++hf) {                                           \
      const int ki_ = min(((bi_) * 2 + j) * 16 + hf * 8 + kq, 255);                              \
      const int s_ = (int)sl[ki_] & 4095;                                                        \
      const u16* krow_ = KVC + (tokb + s_) * 256 + kch * 8;                                      \
      buf_[j][hf * 2] = *(const u32x4*)(krow_); buf_[j][hf * 2 + 1] = *(const u32x4*)(krow_ + 64); \
    }
#define QK_COMPUTE(buf_, bi_)                                                                    \
  {                                                                                              \
    _Pragma("unroll") for (int j = 0; j < 2; ++j)                                                \
      _Pragma("unroll") for (int hf = 0; hf < 2; ++hf) {                                         \
        const int row_ = hf * 8 + kq;                                                            \
        _Pragma("unroll") for (int g = 0; g < 2; ++g)                                            \
          *(u32x4*)(KST + j * 4096 + (row_ * 2 + g) * 128 + ((kch ^ (row_ & 7)) << 4)) = buf_[j][hf * 2 + g]; \
      }                                                                                          \
    WAVE_LDS_SYNC();                                                                             \
    _Pragma("unroll") for (int j = 0; j < 2; ++j) {                                              \
      const unsigned char* kr_ = KST + j * 4096 + fr * 256;                                      \
      const bf16x8 a00_ = *(const bf16x8*)(kr_ + (((0 + fg) ^ (fr & 7)) << 4));                  \
      const bf16x8 a01_ = *(const bf16x8*)(kr_ + (((4 + fg) ^ (fr & 7)) << 4));                  \
      const bf16x8 a10_ = *(const bf16x8*)(kr_ + 128 + (((0 + fg) ^ (fr & 7)) << 4));            \
      const bf16x8 a11_ = *(const bf16x8*)(kr_ + 128 + (((4 + fg) ^ (fr & 7)) << 4));            \
      f32x4 c0_ = {0.f, 0.f, 0.f, 0.f}, c1_ = {0.f, 0.f, 0.f, 0.f};                              \
      c0_ = __builtin_amdgcn_mfma_f32_16x16x32_bf16(a00_, qb[0][0], c0_, 0, 0, 0);               \
      c0_ = __builtin_amdgcn_mfma_f32_16x16x32_bf16(a01_, qb[0][1], c0_, 0, 0, 0);               \
      c1_ = __builtin_amdgcn_mfma_f32_16x16x32_bf16(a10_, qb[1][0], c1_, 0, 0, 0);               \
      c1_ = __builtin_amdgcn_mfma_f32_16x16x32_bf16(a11_, qb[1][1], c1_, 0, 0, 0);               \
      if (fr < 4) {                                                                              \
        _Pragma("unroll") for (int r = 0; r < 4; ++r) {                                          \
          const int kk2_ = ((bi_) * 2 + j) * 16 + 4 * fg + r;                                    \
          if (kk2_ < 256) {                                                                      \
            const bool v_ = kk2_ < nsel;                                                         \
            P[kk2_ * 8 + fr] = v_ ? c0_[r] : -1e30f;                                             \
            P[kk2_ * 8 + 4 + fr] = v_ ? c1_[r] : -1e30f;                                         \
          }                                                                                      \
        }                                                                                        \
      }                                                                                          \
    }                                                                                            \
    WAVE_LDS_SYNC();                                                                             \
  }
  QK_LOAD(kA, 0)
  for (int bi = 0; bi < nbq; bi += 2) {
    if (bi + 1 < nbq) { QK_LOAD(kB, bi + 1) }
    QK_COMPUTE(kA, bi)
    if (bi + 2 < nbq) { QK_LOAD(kA, bi + 2) }
    if (bi + 1 < nbq) { QK_COMPUTE(kB, bi + 1) }
  }
#undef QK_LOAD
#undef QK_COMPUTE
  for (int ki = nbq * 32 + lane; ki < 256; ki += 64) {
    *(f32x4*)(P + ki * 8) = (f32x4){-1e30f, -1e30f, -1e30f, -1e30f};
    *(f32x4*)(P + ki * 8 + 4) = (f32x4){-1e30f, -1e30f, -1e30f, -1e30f};
  }
  WAVE_LDS_SYNC();
  {
    float lg[4][8];
#pragma unroll
    for (int i = 0; i < 4; ++i) {
      f32x4 x0 = *(const f32x4*)(P + (lane + 64 * i) * 8), x1 = *(const f32x4*)(P + (lane + 64 * i) * 8 + 4);
      lg[i][0] = x0[0]; lg[i][1] = x0[1]; lg[i][2] = x0[2]; lg[i][3] = x0[3];
      lg[i][4] = x1[0]; lg[i][5] = x1[1]; lg[i][6] = x1[2]; lg[i][7] = x1[3];
    }
#pragma unroll
    for (int hh = 0; hh < 8; ++hh) {
      float m = fmaxf(fmaxf(lg[0][hh], lg[1][hh]), fmaxf(lg[2][hh], lg[3][hh]));
      m = wave_max_dpp(m);
      float e[4], sum = 0.f;
#pragma unroll
      for (int i = 0; i < 4; ++i) { e[i] = __expf(lg[i][hh] - m); sum += e[i]; }
      sum = wave_sum_dpp(sum);
      const float inv = __builtin_amdgcn_rcpf(sum);
#pragma unroll
      for (int i = 0; i < 4; ++i) lg[i][hh] = e[i] * inv;
    }
#pragma unroll
    for (int i = 0; i < 4; ++i) {
      float* d = P + (lane + 64 * i) * 8;
      *(f32x4*)d = (f32x4){lg[i][0], lg[i][1], lg[i][2], lg[i][3]};
      *(f32x4*)(d + 4) = (f32x4){lg[i][4], lg[i][5], lg[i][6], lg[i][7]};
    }
  }
  WAVE_LDS_SYNC();
  const int ks = lane >> 3, c8 = lane & 7;
  const int ngrp8 = (nsel + 7) >> 3;
  const int total = (ngrp8 + 3) >> 2;
  u32x4 vA[4][2], vB[4][2];
  f32x2_t o2[2][4][4];
#define PV_LOAD(buf_, bi_)                                                                       \
  _Pragma("unroll") for (int j = 0; j < 4; ++j) {                                                \
    const int ki_ = min(((bi_) * 4 + j) * 8 + ks, 255);                                          \
    const int s_ = (int)sl[ki_] & 4095;                                                          \
    const u16* vrow_ = KVC + (tokb + s_) * 256 + 128 + c8 * 8;                                   \
    buf_[j][0] = *(const u32x4*)(vrow_); buf_[j][1] = *(const u32x4*)(vrow_ + 64);               \
  }
#define PV_COMPUTE(buf_, bi_)                                                                    \
  _Pragma("unroll") for (int j = 0; j < 4; ++j) {                                                \
    const int ki_ = ((bi_) * 4 + j) * 8 + ks;                                                    \
    f32x4 p0_ = *(const f32x4*)(P + min(ki_, 255) * 8), p1_ = *(const f32x4*)(P + min(ki_, 255) * 8 + 4); \
    if (ki_ >= nsel) { p0_ = (f32x4){0.f, 0.f, 0.f, 0.f}; p1_ = p0_; }                           \
    _Pragma("unroll") for (int c = 0; c < 4; ++c) {                                              \
      const f32x2_t f0_ = {bflo(buf_[j][0][c]), bfhi(buf_[j][0][c])};                            \
      const f32x2_t f1_ = {bflo(buf_[j][1][c]), bfhi(buf_[j][1][c])};                            \
      _Pragma("unroll") for (int hh = 0; hh < 4; ++hh) {                                         \
        const f32x2_t pa_ = {p0_[hh], p0_[hh]}, pb_ = {p1_[hh], p1_[hh]};                        \
        o2[0][hh][c] = __builtin_elementwise_fma(pa_, f0_, o2[0][hh][c]);                        \
        o2[1][hh][c] = __builtin_elementwise_fma(pb_, f1_, o2[1][hh][c]);                        \
      }                                                                                          \
    }                                                                                            \
  }
#pragma unroll
  for (int g = 0; g < 2; ++g)
#pragma unroll
    for (int hh = 0; hh < 4; ++hh)
#pragma unroll
      for (int c = 0; c < 4; ++c) o2[g][hh][c] = (f32x2_t){0.f, 0.f};
  PV_LOAD(vA, 0)
  for (int bi = 0; bi < total; bi += 2) {
    if (bi + 1 < total) { PV_LOAD(vB, bi + 1) }
    PV_COMPUTE(vA, bi)
    if (bi + 2 < total) { PV_LOAD(vA, bi + 2) }
    if (bi + 1 < total) { PV_COMPUTE(vB, bi + 1) }
  }
#undef PV_LOAD
#undef PV_COMPUTE
#pragma unroll
  for (int g = 0; g < 2; ++g)
#pragma unroll
    for (int hh = 0; hh < 4; ++hh) {
      u32 w_[4];
#pragma unroll
      for (int c = 0; c < 4; ++c) {
        float x0 = o2[g][hh][c][0], x1 = o2[g][hh][c][1];
        x0 += DPPF(x0, 0x128); x1 += DPPF(x1, 0x128);
        x0 = xor16_sum(x0); x1 = xor16_sum(x1);
        x0 = xor32_sum(x0); x1 = xor32_sum(x1);
        w_[c] = pack2(x0, x1);
      }
      if (lane < 8) *(u32x4*)(YATT + tok * 512 + (g * 4 + hh) * 64 + c8 * 8) = (u32x4){w_[0], w_[1], w_[2], w_[3]};
    }
  WAVE_LDS_SYNC();
}

__device__ __forceinline__ void phase3(const Params& p, unsigned char* smem) {
  const int wave = TIDX >> 6;
#ifndef NO_SCAN
  if (blockIdx.x < 32) {
    if (!(p.flags & 2)) dn_scan_item(p, smem, blockIdx.x);
    __syncthreads();
  }
#endif
#ifdef NO_ATTN
  return;
#endif
  if (p.flags & 4) return;
  unsigned* qctr = (unsigned*)(p.ws + 1024);
  const unsigned xcc = (unsigned)__builtin_amdgcn_s_getreg((3 << 11) | 20) & 7u;
  unsigned char* wsm = smem + wave * AT_WAVE_BYTES;
  for (unsigned db = 0; db < 8; ++db) {
    const int bb = (int)((xcc + db) & 7u);
    for (;;) {
      unsigned qi = 0;
      if ((TIDX & 63) == 0) qi = __hip_atomic_fetch_add(qctr + bb * 16, 1u, __ATOMIC_RELAXED, __HIP_MEMORY_SCOPE_AGENT);
      qi = (unsigned)__builtin_amdgcn_readfirstlane((int)qi);
      if (qi >= (unsigned)SEQ) break;
      attn_query(p, wsm, bb, SEQ - 1 - (int)qi);
    }
  }
}

__device__ __forceinline__ void phase4(const Params& p, unsigned char* smem) {
  const u16* YATT = (const u16*)(p.ws + OFF_YATT);
  const u16* YDN = (const u16*)(p.ws + OFF_YDN);
  const u16* WTA = (const u16*)(p.ws + OFF_WTA);
  const u16* WTB = (const u16*)(p.ws + OFF_WTB);
  const u16* PROJ = (const u16*)(p.ws + OFF_PROJ);
  u16* MG = (u16*)(p.ws + OFF_MERGED);
  const int lane = TIDX & 63, wave = TIDX >> 6;
  const int wm = wave >> 1, wn = wave & 1, fr = lane & 15, fg = lane >> 4;
  const int ntn = DM / G_BN, ntiles = (MTOK / G_BM) * ntn;
  for (int t = blockIdx.x; t < ntiles; t += gridDim.x) {
    const int m0 = (t / ntn) * G_BM, n0 = (t % ntn) * G_BN;
    f32x4 acc[4][4];
    u32 mg[4][4][2];
    const u32 pb0 = (u32)(m0 + wm * 64 + 4 * fg) * LDP + (u32)(n0 + wn * 64 + fr);
    const u32 ob0 = (u32)(m0 + wm * 64 + 4 * fg) * DM + (u32)(n0 + wn * 64 + fr);
    gemm_mainloop(YATT, 512, WTA, 512, 512, m0, n0, smem, acc);
#pragma unroll
    for (int i = 0; i < 4; ++i)
#pragma unroll
      for (int j = 0; j < 4; ++j) {
        float t4[4];
#pragma unroll
        for (int r = 0; r < 4; ++r) {
          float ga = bf2f(PROJ[pb0 + (u32)(C_GA + (i * 16 + r) * LDP + j * 16)]);
          t4[r] = sigmoidf_(ga) * acc[i][j][r];
        }
        mg[i][j][0] = pack2(t4[0], t4[1]); mg[i][j][1] = pack2(t4[2], t4[3]);
        asm volatile("" ::: "memory");
      }
    gemm_mainloop(YDN, 512, WTB, 512, 512, m0, n0, smem, acc);
#pragma unroll
    for (int i = 0; i < 4; ++i)
#pragma unroll
      for (int j = 0; j < 4; ++j)
#pragma unroll
        for (int r = 0; r < 4; ++r) {
          float gb = bf2f(PROJ[pb0 + (u32)(C_GB + (i * 16 + r) * LDP + j * 16)]);
          u32 w = mg[i][j][r >> 1];
          float m1 = (r & 1) ? bfhi(w) : bflo(w);
          MG[ob0 + (u32)((i * 16 + r) * DM + j * 16)] = f2bf(m1 + sigmoidf_(gb) * acc[i][j][r]);
          if (r == 3) asm volatile("" ::: "memory");
        }
  }
}

__device__ __forceinline__ void phase5(const Params& p, unsigned char* smem) {
  const u16* MG = (const u16*)(p.ws + OFF_MERGED);
  const u16* WTO = (const u16*)(p.ws + OFF_WTO);
  const float* x = p.in[0];
  const int lane = TIDX & 63, wave = TIDX >> 6;
  const int wm = wave >> 1, wn = wave & 1, fr = lane & 15, fg = lane >> 4;
  const int ntn = DM / G_BN, ntiles = (MTOK / G_BM) * ntn;
  for (int t = blockIdx.x; t < ntiles; t += gridDim.x) {
    const int m0 = (t / ntn) * G_BM, n0 = (t % ntn) * G_BN;
    f32x4 acc[4][4];
    gemm_mainloop(MG, DM, WTO, DM, DM, m0, n0, smem, acc);
    const u32 ob0 = (u32)(m0 + wm * 64 + 4 * fg) * DM + (u32)(n0 + wn * 64 + fr);
    float* outp = p.out;
#pragma unroll
    for (int i = 0; i < 4; ++i)
#pragma unroll
      for (int j = 0; j < 4; ++j)
#pragma unroll
        for (int r = 0; r < 4; ++r) {
          u32 o = ob0 + (u32)((i * 16 + r) * DM + j * 16);
          outp[o] = x[o] + acc[i][j][r];
        }
  }
}

__device__ __forceinline__ void phase6(const Params& p, unsigned char* smem) {
  const u16* H2 = (const u16*)(p.ws + OFF_H2);
  const u16* WTQ = (const u16*)(p.ws + OFF_WTQ);
  u16* QP = (u16*)(p.ws + OFF_QP);
  const int lane = TIDX & 63, wave = TIDX >> 6;
  const int wm = wave >> 1, wn = wave & 1, fr = lane & 15, fg = lane >> 4;
  const int ntn = 2048 / G_BN, ntiles = (MTOK / G_BM) * ntn;
  for (int t = blockIdx.x; t < ntiles; t += gridDim.x) {
    const int m0 = (t / ntn) * G_BM, n0 = (t % ntn) * G_BN;
    f32x4 acc[4][4];
    gemm_mainloop(H2, DM, WTQ, DM, DM, m0, n0, smem, acc);
    const u32 ob0 = (u32)(m0 + wm * 64 + 4 * fg) * 2048 + (u32)(n0 + wn * 64 + fr);
#pragma unroll
    for (int i = 0; i < 4; ++i)
#pragma unroll
      for (int j = 0; j < 4; ++j)
#pragma unroll
        for (int r = 0; r < 4; ++r) QP[ob0 + (u32)((i * 16 + r) * 2048 + j * 16)] = f2bf(acc[i][j][r]);
  }
}

__device__ __forceinline__ int mono_key(float v) { int b = __float_as_int(v); return b ^ ((b >> 31) & 0x7fffffff); }
__device__ __forceinline__ float unmono_key(int k) { return __int_as_float(k ^ ((k >> 31) & 0x7fffffff)); }
__device__ __forceinline__ void chain16(int (&k)[16], int x) {
#pragma unroll
  for (int j = 0; j < 16; ++j) { int hi = max(k[j], x); x = min(k[j], x); k[j] = hi; }
}

constexpr int P7_LD = 132;
__device__ __forceinline__ void phase7(const Params& p, unsigned char* smem) {
  const u16* QP = (const u16*)(p.ws + OFF_QP);
  const u16* SKB = (const u16*)(p.ws + OFF_SKB);
  float* TOPS = (float*)(p.ws + OFF_TOPS);
  u8* TOPI = (u8*)(p.ws + OFF_TOPI);
  const int tid = TIDX, lane = tid & 63, wave = tid >> 6;
  const int wm = wave >> 1, wn = wave & 1, fr = lane & 15, fg = lane >> 4;
  const int ntiles = (MTOK / G_BM) * 16;
  float* tile = (float*)smem;
  for (int t = blockIdx.x; t < ntiles; t += gridDim.x) {
    const int m0 = (t >> 4) * G_BM, hp = t & 15;
    f32x4 acc[4][4];
    gemm_mainloop(QP + hp * 128, 2048, SKB + (size_t)hp * 128 * 128, 128, 128, m0, 0, smem, acc);
#pragma unroll
    for (int i = 0; i < 4; ++i)
#pragma unroll
      for (int j = 0; j < 4; ++j)
#pragma unroll
        for (int r = 0; r < 4; ++r) {
          int row = wm * 64 + i * 16 + 4 * fg + r, col = wn * 64 + j * 16 + fr;
          tile[row * P7_LD + col] = acc[i][j][r];
        }
    __syncthreads();
    {
      const int row = tid >> 1, half = tid & 1;
      int k[16];
#pragma unroll
      for (int j = 0; j < 16; ++j) k[j] = (int)0x80000000;
      const float* rowp = tile + row * P7_LD + half * 64;
#pragma unroll 4
      for (int c = 0; c < 64; c += 4) {
        f32x4 v = *(const f32x4*)(rowp + c);
        const int ib = 127 - (half * 64 + c);
        chain16(k, (mono_key(v[0]) & ~127) | ib);
        chain16(k, (mono_key(v[1]) & ~127) | (ib - 1));
        chain16(k, (mono_key(v[2]) & ~127) | (ib - 2));
        chain16(k, (mono_key(v[3]) & ~127) | (ib - 3));
      }
#pragma unroll
      for (int j = 0; j < 16; ++j) {
        const int other = DPPI(k[j], 0xb1);
        if (half == 0) chain16(k, other);
      }
      if (half == 0) {
        size_t o = ((size_t)(m0 + row) * 16 + hp) * 16;
        float vals[16]; int idx[16];
#pragma unroll
        for (int j = 0; j < 16; ++j) { idx[j] = 127 - (k[j] & 127); vals[j] = tile[row * P7_LD + idx[j]]; }
#pragma unroll
        for (int j = 0; j < 16; j += 4) *(f32x4*)(TOPS + o + j) = (f32x4){vals[j], vals[j + 1], vals[j + 2], vals[j + 3]};
#pragma unroll
        for (int j = 0; j < 16; j += 4)
          *(u32*)(TOPI + o + j) = (u32)idx[j] | ((u32)idx[j + 1] << 8) | ((u32)idx[j + 2] << 16) | ((u32)idx[j + 3] << 24);
      }
    }
    __syncthreads();
  }
}

__device__ __forceinline__ void phase7b(const Params& p) {
  const float* TOPS = (const float*)(p.ws + OFF_TOPS);
  const u8* TOPI = (const u8*)(p.ws + OFF_TOPI);
  int* EXPERT = (int*)(p.ws + OFF_EXPERT);
  float* GATE = (float*)(p.ws + OFF_GATE);
  for (int w = blockIdx.x * NTHREADS + TIDX; w < MTOK * 8; w += gridDim.x * NTHREADS) {
    const size_t o = (size_t)w * 32;
    float sa[16], sb[16];
#pragma unroll
    for (int k = 0; k < 16; k += 4) {
      float4 v = *(const float4*)(TOPS + o + k); sa[k] = v.x; sa[k + 1] = v.y; sa[k + 2] = v.z; sa[k + 3] = v.w;
      float4 u = *(const float4*)(TOPS + o + 16 + k); sb[k] = u.x; sb[k + 1] = u.y; sb[k + 2] = u.z; sb[k + 3] = u.w;
    }
    int kk[16];
#pragma unroll
    for (int k = 0; k < 16; ++k) kk[k] = (int)0x80000000;
#pragma unroll
    for (int a = 0; a < 16; ++a)
#pragma unroll
      for (int bb = 0; bb < 16; ++bb)
        if ((a + 1) * (bb + 1) <= 16) chain16(kk, (mono_key(sa[a] + sb[bb]) & ~255) | (255 - (a * 16 + bb)));
    float vals[16];
#pragma unroll
    for (int k = 0; k < 16; ++k) vals[k] = unmono_key(kk[k] & ~255);
    float m = vals[0], s = 0.f, e[16];
#pragma unroll
    for (int k = 0; k < 16; ++k) { e[k] = __expf(vals[k] - m); s += e[k]; }
    float inv = 1.f / s;
#pragma unroll
    for (int k = 0; k < 16; ++k) {
      const int ci = 255 - (kk[k] & 255);
      int a = ci >> 4, bb = ci & 15;
      int ex = (int)TOPI[o + a] * 128 + (int)TOPI[o + 16 + bb];
      EXPERT[(size_t)w * 16 + k] = ex;
      GATE[(size_t)w * 16 + k] = e[k] * inv;
    }
  }
  {
    const int lane = TIDX & 63, wave = TIDX >> 6;
    for (int row = blockIdx.x * 8 + wave; row < 2 * 16384; row += gridDim.x * 8) {
      const int tbl = row >> 14, r = row & 16383;
      const f32x4* src = (const f32x4*)((tbl ? p.in[16] : p.in[15]) + (size_t)r * DM) + 4 * lane;
      f32x4 x[4];
      float amax = 0.f;
#pragma unroll
      for (int i = 0; i < 4; ++i) {
        x[i] = src[i];
        amax = fmaxf(amax, fmaxf(fmaxf(fabsf(x[i][0]), fabsf(x[i][1])), fmaxf(fabsf(x[i][2]), fabsf(x[i][3]))));
      }
      amax = wave_max_dpp(amax);
      const float inv = amax > 0.f ? 127.f / amax : 0.f;
      const int bias = tbl ? 128 : 0;
      u32x4 o;
#pragma unroll
      for (int i = 0; i < 4; ++i) {
        int q0 = (int)rintf(x[i][0] * inv) + bias, q1 = (int)rintf(x[i][1] * inv) + bias;
        int q2 = (int)rintf(x[i][2] * inv) + bias, q3 = (int)rintf(x[i][3] * inv) + bias;
        o[i] = (u32)(q0 & 0xff) | ((u32)(q1 & 0xff) << 8) | ((u32)(q2 & 0xff) << 16) | ((u32)(q3 & 0xff) << 24);
      }
      *(u32x4*)(p.ws + (tbl ? OFF_VQ : OFF_UQ) + (size_t)r * DM + 16 * lane) = o;
      if (lane == 0) ((float*)(p.ws + (tbl ? OFF_VS : OFF_US)))[r] = amax * (1.f / 127.f);
    }
  }
}

__device__ __forceinline__ void phase8(const Params& p) {
  const u16* H2 = (const u16*)(p.ws + OFF_H2);
  const int* EXPERT = (const int*)(p.ws + OFF_EXPERT);
  const float* GATE = (const float*)(p.ws + OFF_GATE);
  const unsigned char* UQ = p.ws + OFF_UQ;
  const unsigned char* VQ = p.ws + OFF_VQ;
  const float* US = (const float*)(p.ws + OFF_US);
  const float* VS = (const float*)(p.ws + OFF_VS);
  const int lane = TIDX & 63, wave = TIDX >> 6;
  for (int tok = blockIdx.x * 8 + wave; tok < MTOK; tok += gridDim.x * 8) {
    u32 hq[4];
    float sh;
    {
      const u32x4 a = *(const u32x4*)(H2 + (size_t)tok * DM + 16 * lane);
      const u32x4 b = *(const u32x4*)(H2 + (size_t)tok * DM + 16 * lane + 8);
      float hv[16];
#pragma unroll
      for (int c = 0; c < 4; ++c) { hv[2 * c] = bflo(a[c]); hv[2 * c + 1] = bfhi(a[c]); hv[8 + 2 * c] = bflo(b[c]); hv[8 + 2 * c + 1] = bfhi(b[c]); }
      float amax = 0.f;
#pragma unroll
      for (int i = 0; i < 16; ++i) amax = fmaxf(amax, fabsf(hv[i]));
      amax = wave_max_dpp(amax);
      const float inv = amax > 0.f ? 127.f / amax : 0.f;
      sh = amax * (1.f / 127.f);
#pragma unroll
      for (int c = 0; c < 4; ++c) {
        int q0 = (int)rintf(hv[4 * c] * inv), q1 = (int)rintf(hv[4 * c + 1] * inv);
        int q2 = (int)rintf(hv[4 * c + 2] * inv), q3 = (int)rintf(hv[4 * c + 3] * inv);
        hq[c] = (u32)(q0 & 0xff) | ((u32)(q1 & 0xff) << 8) | ((u32)(q2 & 0xff) << 16) | ((u32)(q3 & 0xff) << 24);
      }
    }
    const int e0 = EXPERT[(size_t)tok * 128 + lane], e1 = EXPERT[(size_t)tok * 128 + 64 + lane];
    const float g0 = GATE[(size_t)tok * 128 + lane], g1 = GATE[(size_t)tok * 128 + 64 + lane];
    const float su0 = US[e0], su1 = US[e1], sv0 = VS[e0], sv1 = VS[e1];
    int dacc0 = 0, dacc1 = 0;
#pragma unroll 1
    for (int half = 0; half < 2; ++half) {
      const int ev = half ? e1 : e0;
      int dacc = 0;
#pragma unroll 1
      for (int k = 0; k < 64; k += 16) {
        u32x4 ua[16];
#pragma unroll
        for (int j = 0; j < 16; ++j) {
          const int e = __builtin_amdgcn_readlane(ev, k + j);
          ua[j] = *(const u32x4*)(UQ + (size_t)e * DM + 16 * lane);
        }
#pragma unroll
        for (int j = 0; j < 16; ++j) {
          int sdot = 0;
#pragma unroll
          for (int c = 0; c < 4; ++c) sdot = __builtin_amdgcn_sdot4((int)ua[j][c], (int)hq[c], sdot, false);
          sdot = wave_sum_i_dpp(sdot);
          dacc = (lane == k + j) ? sdot : dacc;
        }
      }
      if (half) dacc1 = dacc; else dacc0 = dacc;
    }
    const float d0 = (float)dacc0 * su0 * sh, d1 = (float)dacc1 * su1 * sh;
    const float cf0 = g0 * 0.5f * d0 * (1.f + erff(d0 * 0.70710678118654752f)) * sv0;
    const float cf1 = g1 * 0.5f * d1 * (1.f + erff(d1 * 0.70710678118654752f)) * sv1;
    const float csum = wave_sum_dpp(cf0 + cf1);
    f32x2_t ov2[8];
#pragma unroll
    for (int i = 0; i < 8; ++i) ov2[i] = (f32x2_t){0.f, 0.f};
#pragma unroll 1
    for (int half = 0; half < 2; ++half) {
      const int ev = half ? e1 : e0;
      const float cv = half ? cf1 : cf0;
#pragma unroll 1
      for (int k = 0; k < 64; k += 16) {
        u32x4 va[16];
        float cc[16];
#pragma unroll
        for (int j = 0; j < 16; ++j) {
          const int e = __builtin_amdgcn_readlane(ev, k + j);
          cc[j] = __int_as_float(__builtin_amdgcn_readlane(__float_as_int(cv), k + j));
          va[j] = *(const u32x4*)(VQ + (size_t)e * DM + 16 * lane);
        }
#pragma unroll
        for (int j = 0; j < 16; ++j) {
#pragma unroll
          for (int c = 0; c < 4; ++c) {
            const u32 w = va[j][c];
            const f32x2_t cc2 = {cc[j], cc[j]};
            const f32x2_t fa = {(float)(w & 0xffu), (float)((w >> 8) & 0xffu)};
            const f32x2_t fb = {(float)((w >> 16) & 0xffu), (float)(w >> 24)};
            ov2[2 * c] = __builtin_elementwise_fma(cc2, fa, ov2[2 * c]);
            ov2[2 * c + 1] = __builtin_elementwise_fma(cc2, fb, ov2[2 * c + 1]);
          }
        }
      }
    }
    const float corr = 128.f * csum;
    f32x4* op = (f32x4*)(p.out + (size_t)tok * DM + 16 * lane);
#pragma unroll
    for (int c = 0; c < 4; ++c) {
      f32x4 x = op[c];
      x[0] += ov2[2 * c][0] - corr; x[1] += ov2[2 * c][1] - corr; x[2] += ov2[2 * c + 1][0] - corr; x[3] += ov2[2 * c + 1][1] - corr;
      if (!(p.flags & 32) || x[0] == 1.2345678e30f) op[c] = x;
    }
  }
}

__device__ __forceinline__ void grid_barrier(unsigned* ctr, unsigned target) {
  asm volatile("s_waitcnt vmcnt(0)" ::: "memory");
  __syncthreads();
  if (TIDX == 0) {
    __builtin_amdgcn_fence(__ATOMIC_RELEASE, "agent");
    asm volatile("s_waitcnt vmcnt(0)" ::: "memory");
    __hip_atomic_fetch_add(ctr, 1u, __ATOMIC_RELAXED, __HIP_MEMORY_SCOPE_AGENT);
    while (__hip_atomic_load(ctr, __ATOMIC_RELAXED, __HIP_MEMORY_SCOPE_AGENT) < target) __builtin_amdgcn_s_sleep(2);
    __builtin_amdgcn_fence(__ATOMIC_ACQUIRE, "agent");
    asm volatile("s_waitcnt vmcnt(0)" ::: "memory");
  }
  __syncthreads();
}

__global__ void __launch_bounds__(NTHREADS, 2) mk_fwd(Params p) {
  cg::grid_group grid = cg::this_grid();
  __shared__ __attribute__((aligned(16))) unsigned char smem[SMEM_BYTES];
  const int lo = p.ph_lo, hi = p.ph_hi;
#define RUN(k, call) if (lo <= (k) && (k) < hi) { call; if ((k) + 1 < hi) { if ((k) == lo) grid.sync(); else grid_barrier((unsigned*)p.ws, (unsigned)((k) - lo) * gridDim.x); } }
  RUN(0, phase0(p, smem))
  RUN(1, phase1(p, smem))
  RUN(2, phase2(p, smem))
  RUN(3, phase3(p, smem))
  RUN(4, phase4(p, smem))
  RUN(5, phase5(p, smem))
  RUN(6, rmsnorm_rows(p.out, p.in[12], (u16*)(p.ws + OFF_H2)))
  RUN(7, phase6(p, smem))
  RUN(8, phase7(p, smem))
  RUN(9, phase7b(p))
  RUN(10, phase8(p))
#undef RUN
}

extern "C" void kernel_launch(void* const* d_in, const int* in_sizes, int n_in,
                              void* d_out, int out_size, void* d_ws, size_t ws_size,
                              hipStream_t stream) {
  static int grid_blocks = 0;
  if (!grid_blocks) {
    int dev = 0, cus = 0, per_cu = 0;
    (void)hipGetDevice(&dev);
    (void)hipDeviceGetAttribute(&cus, hipDeviceAttributeMultiprocessorCount, dev);
    (void)hipOccupancyMaxActiveBlocksPerMultiprocessor(&per_cu, mk_fwd, NTHREADS, 0);
    if (per_cu < 1) per_cu = 1;
    if (per_cu > 1) per_cu = 1;
    grid_blocks = cus * per_cu;
    fprintf(stderr, "mk_fwd: cus=%d per_cu=%d grid=%d ws=%zu\n", cus, per_cu, grid_blocks, ws_size);
  }
  Params p{};
  for (int i = 0; i < 17 && i < n_in; ++i) p.in[i] = (const float*)d_in[i];
  p.out = (float*)d_out;
  p.ws = (unsigned char*)d_ws;
  p.ph_lo = 0; p.ph_hi = 11;
  (void)hipMemsetAsync(d_ws, 0, 4096, stream);
  void* args[] = {&p};
  hipError_t e = hipLaunchCooperativeKernel((void*)mk_fwd, dim3(grid_blocks), dim3(NTHREADS), args, 0, stream);
  if (e != hipSuccess) fprintf(stderr, "cooperative launch failed: %s (grid %d)\n", hipGetErrorString(e), grid_blocks);
#ifdef EXTRA_LO
  {
    Params p2 = p;
    p2.ph_lo = EXTRA_LO; p2.ph_hi = EXTRA_HI; p2.flags = EXTRA_FLAGS;
    void* args2[] = {&p2};
    (void)hipLaunchCooperativeKernel((void*)mk_fwd, dim3(grid_blocks), dim3(NTHREADS), args2, 0, stream);
  }
#endif
}
```

```cpp
#include <hip/hip_runtime.h>
#include <hip/hip_bf16.h>
#include <hip/hip_cooperative_groups.h>
#include <cstdio>
#include <cstdint>
namespace cg = cooperative_groups;

typedef unsigned short u16;
typedef unsigned int u32;
typedef unsigned char u8;
typedef short bf16x8 __attribute__((ext_vector_type(8)));
typedef float f32x4 __attribute__((ext_vector_type(4)));
typedef unsigned int u32x4 __attribute__((ext_vector_type(4)));
typedef unsigned int u32x2 __attribute__((ext_vector_type(2)));

constexpr int NTHREADS = 512;
constexpr int BATCH = 8, SEQ = 4096, DM = 1024, MTOK = BATCH * SEQ;
constexpr int LDP = 5120;
constexpr int NPADW = 5632;
constexpr int C_AQ = 0, C_IQ = 512, C_DQ = 1024, C_DK = 1536, C_DV = 2048, C_DZ = 2560, C_GA = 3072, C_GB = 4096;
constexpr int N_AK = 5120, N_AV = 5248, N_IK = 5376, N_SM = 5440;
constexpr size_t MiB = 1ull << 20;
constexpr size_t OFF_WTIN = 1 * MiB, OFF_WTA = 12 * MiB, OFF_WTB = 13 * MiB, OFF_WTO = 14 * MiB, OFF_WTQ = 16 * MiB,
                 OFF_SKB = 20 * MiB, OFF_SMALL = 21 * MiB, OFF_H = 23 * MiB, OFF_ATT = 23 * MiB, OFF_GC = 39 * MiB,
                 OFF_MERGED = 23 * MiB, OFF_PROJ = 87 * MiB, OFF_KVC = 407 * MiB, OFF_IKC = 423 * MiB, OFF_SEL = 427 * MiB, OFF_YATT = 443 * MiB,
                 OFF_YDN = 475 * MiB;
constexpr size_t OFF_H2 = OFF_PROJ, OFF_QP = OFF_PROJ + 64 * MiB, OFF_TOPS = OFF_PROJ + 192 * MiB,
                 OFF_TOPI = OFF_PROJ + 224 * MiB, OFF_EXPERT = OFF_PROJ + 232 * MiB, OFF_GATE = OFF_PROJ + 248 * MiB;
constexpr size_t OFF_UQ = OFF_PROJ + 264 * MiB, OFF_VQ = OFF_PROJ + 280 * MiB, OFF_US = OFF_PROJ + 296 * MiB, OFF_VS = OFF_PROJ + 297 * MiB;
constexpr size_t DO_U = 0, DO_W = 32 * MiB, DO_QN = 64 * MiB, DO_KNT = 96 * MiB;

constexpr int SMEM_BYTES = 162816;
constexpr float EPS = 1e-6f;

struct Params {
  const float* in[17];
  float* out;
  unsigned char* ws;
  int ph_lo, ph_hi;
  int flags, pad;
};

typedef __bf16 bf16x2_t __attribute__((ext_vector_type(2)));
typedef float f32x2_t __attribute__((ext_vector_type(2)));
__device__ __forceinline__ u32 pack2(float a, float b) {
  f32x2_t f = {a, b};
  return __builtin_bit_cast(u32, __builtin_convertvector(f, bf16x2_t));
}
__device__ __forceinline__ u16 f2bf(float f) { return (u16)(pack2(f, f) & 0xffffu); }
__device__ __forceinline__ float bf2f(u16 h) { return __uint_as_float(((u32)h) << 16); }
__device__ __forceinline__ float bflo(u32 w) { return __uint_as_float(w << 16); }
__device__ __forceinline__ float bfhi(u32 w) { return __uint_as_float(w & 0xffff0000u); }
__device__ __forceinline__ float wave_sum(float v) {
#pragma unroll
  for (int o = 32; o > 0; o >>= 1) v += __shfl_xor(v, o);
  return v;
}
__device__ __forceinline__ float wave_max(float v) {
#pragma unroll
  for (int o = 32; o > 0; o >>= 1) v = fmaxf(v, __shfl_xor(v, o));
  return v;
}
__device__ __forceinline__ float dot2bf(u32 a, u32 b, float acc) {
  return __builtin_amdgcn_fdot2_f32_bf16(__builtin_bit_cast(bf16x2_t, a), __builtin_bit_cast(bf16x2_t, b), acc, false);
}
#define DPPF(v, ctrl) __int_as_float(__builtin_amdgcn_update_dpp(0, __float_as_int(v), ctrl, 0xf, 0xf, true))
__device__ __forceinline__ float wave_sum_dpp(float v) {
  v += DPPF(v, 0xb1);
  v += DPPF(v, 0x4e);
  v += DPPF(v, 0x124);
  v += DPPF(v, 0x128);
  float r0 = __int_as_float(__builtin_amdgcn_readlane(__float_as_int(v), 0));
  float r1 = __int_as_float(__builtin_amdgcn_readlane(__float_as_int(v), 16));
  float r2 = __int_as_float(__builtin_amdgcn_readlane(__float_as_int(v), 32));
  float r3 = __int_as_float(__builtin_amdgcn_readlane(__float_as_int(v), 48));
  return (r0 + r1) + (r2 + r3);
}
__device__ __forceinline__ int opaque_tid() { int t = threadIdx.x; asm volatile("" : "+v"(t)); return t; }
#define TIDX opaque_tid()
#define DPPI(v, ctrl) __builtin_amdgcn_update_dpp(0, (v), ctrl, 0xf, 0xf, true)
__device__ __forceinline__ int wave_sum_i_dpp(int v) {
  v += DPPI(v, 0xb1);
  v += DPPI(v, 0x4e);
  v += DPPI(v, 0x124);
  v += DPPI(v, 0x128);
  return (__builtin_amdgcn_readlane(v, 0) + __builtin_amdgcn_readlane(v, 16)) +
         (__builtin_amdgcn_readlane(v, 32) + __builtin_amdgcn_readlane(v, 48));
}
__device__ __forceinline__ float wave_max_dpp(float v) {
  v = fmaxf(v, DPPF(v, 0xb1));
  v = fmaxf(v, DPPF(v, 0x4e));
  v = fmaxf(v, DPPF(v, 0x124));
  v = fmaxf(v, DPPF(v, 0x128));
  float r0 = __int_as_float(__builtin_amdgcn_readlane(__float_as_int(v), 0));
  float r1 = __int_as_float(__builtin_amdgcn_readlane(__float_as_int(v), 16));
  float r2 = __int_as_float(__builtin_amdgcn_readlane(__float_as_int(v), 32));
  float r3 = __int_as_float(__builtin_amdgcn_readlane(__float_as_int(v), 48));
  return fmaxf(fmaxf(r0, r1), fmaxf(r2, r3));
}
#define WAVE_LDS_SYNC() asm volatile("s_waitcnt lgkmcnt(0)" ::: "memory")
__device__ __forceinline__ float sigmoidf_(float x) { return __builtin_amdgcn_rcpf(1.f + __expf(-x)); }
__device__ __forceinline__ int perm32(int k) {
  int blk = k & ~31, r = k & 31;
  int p = (r < 16) ? (8 * (r >> 2) + (r & 3)) : (8 * ((r - 16) >> 2) + 4 + (r & 3));
  return blk + p;
}

__device__ __forceinline__ int win_map(int n) {
  if (n < 512) return n;
  if (n < 1024) return 768 + (n - 512);
  if (n < 3072) return 1352 + (n - 1024);
  if (n < 5120) return 3408 + (n - 3072);
  if (n < 5248) return 512 + (n - 5120);
  if (n < 5376) return 640 + (n - 5248);
  if (n < 5440) return 1280 + (n - 5376);
  if (n < 5448) return 1344 + (n - 5440);
  if (n < 5452) return 3400 + (n - 5448);
  if (n < 5456) return 3404 + (n - 5452);
  return -1;
}
__device__ __forceinline__ void transpose_tile(const float* __restrict__ src, int Nsrc, u16* __restrict__ dst, int K, int k0, int n0,
                               bool mapped, float* tile  ) {
  const int tid = TIDX;
  {
    const int tx = tid & 63, ty = tid >> 6;
    int n = n0 + tx;
    int sc = mapped ? win_map(n) : n;
#pragma unroll
    for (int i = 0; i < 8; ++i) {
      int k = ty + 8 * i;
      float v = (sc >= 0) ? src[(size_t)(k0 + k) * Nsrc + sc] : 0.f;
      tile[k * 65 + tx] = v;
    }
  }
  __syncthreads();
  {
    const int n = tid >> 3, kc = (tid & 7) * 8;
    u32 w[4];
#pragma unroll
    for (int j = 0; j < 4; ++j) w[j] = pack2(tile[(kc + 2 * j) * 65 + n], tile[(kc + 2 * j + 1) * 65 + n]);
    *(uint4*)(dst + (size_t)(n0 + n) * K + k0 + kc) = make_uint4(w[0], w[1], w[2], w[3]);
  }
  __syncthreads();
}

__device__ __forceinline__ void rmsnorm_rows(const float* __restrict__ x, const float* __restrict__ gain, u16* __restrict__ out) {
  const int lane = TIDX & 63, wave = TIDX >> 6;
  float4 g[4];
#pragma unroll
  for (int i = 0; i < 4; ++i) g[i] = ((const float4*)gain)[lane + 64 * i];
  for (int row = blockIdx.x * 8 + wave; row < MTOK; row += gridDim.x * 8) {
    const float4* xr = (const float4*)(x + (size_t)row * DM);
    float4 v[4];
    float ss = 0.f;
#pragma unroll
    for (int i = 0; i < 4; ++i) {
      v[i] = xr[lane + 64 * i];
      ss += v[i].x * v[i].x + v[i].y * v[i].y + v[i].z * v[i].z + v[i].w * v[i].w;
    }
    ss = wave_sum(ss);
    float r = rsqrtf(ss * (1.f / DM) + EPS);
#pragma unroll
    for (int i = 0; i < 4; ++i) {
      uint2 o;
      o.x = pack2(v[i].x * r * g[i].x, v[i].y * r * g[i].y);
      o.y = pack2(v[i].z * r * g[i].z, v[i].w * r * g[i].w);
      *(uint2*)(out + (size_t)row * DM + 4 * (lane + 64 * i)) = o;
    }
  }
}

__device__ __forceinline__ void phase0(const Params& p, unsigned char* smem) {
  float* tile = (float*)smem;
  unsigned char* ws = p.ws;
  const int n_in = 16 * 88, n_a = 8 * 16, n_b = 8 * 16, n_o = 16 * 16, n_q = 16 * 32;
  const int total = n_in + n_a + n_b + n_o + n_q;
  for (int t = blockIdx.x; t < total; t += gridDim.x) {
    int i = t;
    if (i < n_in) { transpose_tile(p.in[2], 5456, (u16*)(ws + OFF_WTIN), 1024, (i / 88) * 64, (i % 88) * 64, true, tile); continue; }
    i -= n_in;
    if (i < n_a) { transpose_tile(p.in[9], 1024, (u16*)(ws + OFF_WTA), 512, (i / 16) * 64, (i % 16) * 64, false, tile); continue; }
    i -= n_a;
    if (i < n_b) { transpose_tile(p.in[10], 1024, (u16*)(ws + OFF_WTB), 512, (i / 16) * 64, (i % 16) * 64, false, tile); continue; }
    i -= n_b;
    if (i < n_o) { transpose_tile(p.in[11], 1024, (u16*)(ws + OFF_WTO), 1024, (i / 16) * 64, (i % 16) * 64, false, tile); continue; }
    i -= n_o;
    transpose_tile(p.in[13], 2048, (u16*)(ws + OFF_WTQ), 1024, (i / 32) * 64, (i % 32) * 64, false, tile);
  }
  {
    const float* sk = p.in[14];
    u16* skb = (u16*)(ws + OFF_SKB);
    for (int i = blockIdx.x * NTHREADS + TIDX; i < 16 * 128 * 128; i += gridDim.x * NTHREADS) skb[i] = f2bf(sk[i]);
  }
  rmsnorm_rows(p.in[0], p.in[1], (u16*)(ws + OFF_H));
}

constexpr int G_BM = 256, G_BN = 128, G_BK = 64;
constexpr int G_ABYTES = G_BM * 128;

template <int MI>
__device__ __forceinline__ void gemm_mainloop_t(const u16* __restrict__ A, int lda, const u16* __restrict__ Bt, int ldb, int K,
                                                int m0, int n0, unsigned char* smem, f32x4 (&acc)[MI][4]) {
  constexpr int BN = (MI == 4) ? 128 : 256;
  constexpr int NRB = BN / 64;
  constexpr int STAGE = G_ABYTES + BN * 128;
  const int tid = TIDX, lane = tid & 63, wave = tid >> 6;
  const int wm = (MI == 4) ? (wave >> 1) : (wave >> 2), wn = (MI == 4) ? (wave & 1) : (wave & 3);
#pragma unroll
  for (int i = 0; i < MI; ++i)
#pragma unroll
    for (int j = 0; j < 4; ++j) acc[i][j] = (f32x4){0.f, 0.f, 0.f, 0.f};
  const int kc = tid & 7;
  const int arow = tid >> 3;
  u32x4 ra[4], rb[NRB];
  const u16* ap = A + (size_t)(m0 + arow) * lda + kc * 8;
  const u16* bp = Bt + (size_t)(n0 + arow) * ldb + kc * 8;
  const int nk = K / G_BK;
  const int fr = lane & 15, fg = lane >> 4;
#define G_LOAD(kt_)                                                                       \
  {                                                                                       \
    const u16* ap2_ = ap + (size_t)(kt_) * G_BK;                                          \
    const u16* bp2_ = bp + (size_t)(kt_) * G_BK;                                          \
    _Pragma("unroll") for (int i = 0; i < 4; ++i) ra[i] = *(const u32x4*)(ap2_ + (size_t)(64 * i) * lda); \
    _Pragma("unroll") for (int i = 0; i < NRB; ++i) rb[i] = *(const u32x4*)(bp2_ + (size_t)(64 * i) * ldb); \
  }
#define G_STORE(st_)                                                                      \
  {                                                                                       \
    unsigned char* sa_ = smem + (st_) * STAGE;                                            \
    unsigned char* sb_ = sa_ + G_ABYTES;                                                  \
    _Pragma("unroll") for (int i = 0; i < 4; ++i) { int r = arow + 64 * i; *(u32x4*)(sa_ + r * 128 + ((kc ^ (r & 7)) << 4)) = ra[i]; } \
    _Pragma("unroll") for (int i = 0; i < NRB; ++i) { int r = arow + 64 * i; *(u32x4*)(sb_ + r * 128 + ((kc ^ (r & 7)) << 4)) = rb[i]; } \
  }
  G_LOAD(0)
  __syncthreads();
  G_STORE(0)
  if (nk > 1) G_LOAD(1)
  __syncthreads();
  for (int kt = 0; kt < nk; ++kt) {
    if (kt + 1 < nk) G_STORE((kt + 1) & 1)
    if (kt + 2 < nk) G_LOAD(kt + 2)
    __builtin_amdgcn_sched_barrier(0);
    const unsigned char* sa = smem + (kt & 1) * STAGE;
    const unsigned char* sb = sa + G_ABYTES;
#pragma unroll
    for (int kk = 0; kk < 2; ++kk) {
      bf16x8 bfr[4];
#pragma unroll
      for (int j = 0; j < 4; ++j) {
        int r = wn * 64 + j * 16 + fr;
        bfr[j] = *(const bf16x8*)(sb + r * 128 + (((kk * 4 + fg) ^ (r & 7)) << 4));
      }
#pragma unroll
      for (int ih = 0; ih < MI; ih += 4) {
        bf16x8 af[4];
#pragma unroll
        for (int i = 0; i < 4; ++i) {
          int r = wm * (MI * 16) + (ih + i) * 16 + fr;
          af[i] = *(const bf16x8*)(sa + r * 128 + (((kk * 4 + fg) ^ (r & 7)) << 4));
        }
#pragma unroll
        for (int i = 0; i < 4; ++i)
#pragma unroll
          for (int j = 0; j < 4; ++j) acc[ih + i][j] = __builtin_amdgcn_mfma_f32_16x16x32_bf16(af[i], bfr[j], acc[ih + i][j], 0, 0, 0);
        if (MI == 8 && ih == 0) __builtin_amdgcn_sched_barrier(0);
      }
    }
    __syncthreads();
  }
#undef G_LOAD
#undef G_STORE
}
__device__ __forceinline__ void gemm_mainloop(const u16* __restrict__ A, int lda, const u16* __restrict__ Bt, int ldb, int K,
                                              int m0, int n0, unsigned char* smem, f32x4 (&acc)[4][4]) {
  gemm_mainloop_t<4>(A, lda, Bt, ldb, K, m0, n0, smem, acc);
}

template <int LD, bool NORM>
__device__ __forceinline__ void ep_store(u16* __restrict__ dst, u32 ob, const f32x4 (&acc)[8][4], const float* __restrict__ gain,
                                         float extra, int fr) {
  float gj[4] = {1.f, 1.f, 1.f, 1.f};
  if (NORM) {
#pragma unroll
    for (int j = 0; j < 4; ++j) gj[j] = gain[j * 16 + fr] * extra;
  }
#pragma unroll
  for (int i = 0; i < 8; ++i) {
#pragma unroll
    for (int r = 0; r < 4; ++r) {
      float rs = 1.f;
      if (NORM) {
        float sq = 0.f;
#pragma unroll
        for (int j = 0; j < 4; ++j) sq += acc[i][j][r] * acc[i][j][r];
        sq += DPPF(sq, 0xb1); sq += DPPF(sq, 0x4e); sq += DPPF(sq, 0x141); sq += DPPF(sq, 0x140);
        rs = rsqrtf(sq * (1.f / 64.f) + EPS);
      }
#pragma unroll
      for (int j = 0; j < 4; ++j) dst[ob + (u32)((i * 16 + r) * LD + j * 16)] = f2bf(NORM ? acc[i][j][r] * rs * gj[j] : acc[i][j][r]);
    }
    __builtin_amdgcn_sched_barrier(0);
  }
}

__device__ __forceinline__ void phase1(const Params& p, unsigned char* smem) {
  const u16* H = (const u16*)(p.ws + OFF_H);
  const u16* WT = (const u16*)(p.ws + OFF_WTIN);
  u16* PROJ = (u16*)(p.ws + OFF_PROJ);
  u16* KVC = (u16*)(p.ws + OFF_KVC);
  u16* IKC = (u16*)(p.ws + OFF_IKC);
  float* SMALL = (float*)(p.ws + OFF_SMALL);
  const int lane = TIDX & 63, wave = TIDX >> 6;
  const int wm = wave >> 2, wn = wave & 3, fr = lane & 15, fg = lane >> 4;
  const int ntn = NPADW / 256;
  const int ntiles = (MTOK / G_BM) * ntn;
  for (int t = blockIdx.x; t < ntiles; t += gridDim.x) {
    const int m0 = (t / ntn) * G_BM, n0 = (t % ntn) * 256;
    f32x4 acc[8][4];
    gemm_mainloop_t<8>(H, DM, WT, DM, DM, m0, n0, smem, acc);
    const int cbase = n0 + wn * 64;
    const u32 rbase = (u32)(m0 + wm * 128 + 4 * fg);
    if (cbase < C_IQ) {
      ep_store<LDP, true>(PROJ, rbase * LDP + (u32)(cbase + fr), acc, p.in[3], 0.125f, fr);
    } else if (cbase < LDP) {
      ep_store<LDP, false>(PROJ, rbase * LDP + (u32)(cbase + fr), acc, nullptr, 1.f, fr);
    } else if (cbase < N_AV) {
      ep_store<256, true>(KVC, rbase * 256 + (u32)(cbase - N_AK + fr), acc, p.in[4], 1.f, fr);
    } else if (cbase < N_IK) {
      ep_store<256, false>(KVC, rbase * 256 + (u32)(cbase - N_AV + 128 + fr), acc, nullptr, 1.f, fr);
    } else if (cbase < N_SM) {
      ep_store<64, false>(IKC, rbase * 64 + (u32)fr, acc, nullptr, 1.f, fr);
    } else if (cbase == N_SM) {
      const u32 sb0 = rbase * 16 + (u32)fr;
#pragma unroll
      for (int i = 0; i < 8; ++i)
#pragma unroll
        for (int r = 0; r < 4; ++r) SMALL[sb0 + (u32)((i * 16 + r) * 16)] = acc[i][0][r];
    }
  }
}

constexpr int IDX_RS = 8208;

__device__ __forceinline__ u32 f2key(float x) {
  _Float16 h = (_Float16)x;
  u32 b = (u32) * (u16*)&h;
  return (b & 0x8000u) ? ((~b) & 0xffffu) : (b | 0x8000u);
}
__device__ __forceinline__ int count_ge_wave(const u32 (&kreg)[32], u32 mid) {
  const u32 m1 = (mid - 1u) * 0x00010001u;
  const u32 one = 0x00010001u;
  u32 acc0 = 0u, acc1 = 0u;
#pragma unroll
  for (int i = 0; i < 32; i += 2) {
    u32 t0, t1;
    asm("v_pk_sub_u16 %0, %1, %2 clamp" : "=v"(t0) : "v"(kreg[i]), "s"(m1));
    asm("v_pk_sub_u16 %0, %1, %2 clamp" : "=v"(t1) : "v"(kreg[i + 1]), "s"(m1));
    asm("v_pk_min_u16 %0, %1, %2" : "=v"(t0) : "v"(t0), "s"(one));
    asm("v_pk_min_u16 %0, %1, %2" : "=v"(t1) : "v"(t1), "s"(one));
    asm("v_pk_add_u16 %0, %1, %2" : "=v"(acc0) : "v"(acc0), "v"(t0));
    asm("v_pk_add_u16 %0, %1, %2" : "=v"(acc1) : "v"(acc1), "v"(t1));
  }
  int c = (int)((acc0 & 0xffffu) + (acc0 >> 16) + (acc1 & 0xffffu) + (acc1 >> 16));
  return wave_sum_i_dpp(c);
}

__device__ __forceinline__ void idx_item(const Params& p, unsigned char* smem, int b, int tq) {
  const u16* PROJ = (const u16*)(p.ws + OFF_PROJ);
  const float* SMALL = (const float*)(p.ws + OFF_SMALL);
  u16* SEL = (u16*)(p.ws + OFF_SEL);
  const int tid = TIDX, lane = tid & 63, wave = tid >> 6;
  const int t0 = tq * 16;
  const size_t tokb = (size_t)b * SEQ;
  if (tq < 16) {
    for (int rr = 0; rr < 2; ++rr) {
      int row = 2 * wave + rr, t = t0 + row;
      u16* out = SEL + (tokb + t) * 256;
      for (int i = lane; i < 256; i += 64) out[i] = (i <= t) ? (u16)i : (u16)0xFFFF;
    }
    return;
  }
  const int q = lane & 15, g = lane >> 4;
  __syncthreads();
  {
    const u16* iqrow = PROJ + (tokb + t0 + q) * LDP + C_IQ;
    bf16x8 bq[8][2];
    float wq[8];
#pragma unroll
    for (int h = 0; h < 8; ++h) {
      bq[h][0] = *(const bf16x8*)(iqrow + h * 64 + g * 8);
      bq[h][1] = *(const bf16x8*)(iqrow + h * 64 + 32 + g * 8);
      wq[h] = SMALL[(tokb + t0 + q) * 16 + h];
    }
    const int nkb = tq + 1;
    const int niter = (nkb > wave) ? ((nkb - wave + 7) >> 3) : 0;
    const u16* ikbase = (const u16*)(p.ws + OFF_IKC) + (tokb + q) * 64 + g * 8;
    bf16x8 ca[3][2];
#pragma unroll
    for (int j = 0; j < 3; ++j)
      if (j < niter) {
        const u16* ikrow = ikbase + (size_t)((wave + 8 * j) * 16) * 64;
        ca[j][0] = *(const bf16x8*)(ikrow); ca[j][1] = *(const bf16x8*)(ikrow + 32);
      }
    for (int i0 = 0; i0 < ((p.flags & 8) ? 0 : niter); i0 += 3) {
#pragma unroll
      for (int j = 0; j < 3; ++j) {
        if (i0 + j < niter) {
          const int s0 = (wave + 8 * (i0 + j)) * 16;
          f32x4 tot = {0.f, 0.f, 0.f, 0.f};
#pragma unroll
          for (int h = 0; h < 8; ++h) {
            f32x4 acc = {0.f, 0.f, 0.f, 0.f};
            acc = __builtin_amdgcn_mfma_f32_16x16x32_bf16(ca[j][0], bq[h][0], acc, 0, 0, 0);
            acc = __builtin_amdgcn_mfma_f32_16x16x32_bf16(ca[j][1], bq[h][1], acc, 0, 0, 0);
#pragma unroll
            for (int r = 0; r < 4; ++r) tot[r] += wq[h] * fmaxf(acc[r], 0.f);
          }
          if (i0 + 3 + j < niter) {
            const u16* ikrow = ikbase + (size_t)((wave + 8 * (i0 + 3 + j)) * 16) * 64;
            ca[j][0] = *(const bf16x8*)(ikrow); ca[j][1] = *(const bf16x8*)(ikrow + 32);
          }
          u32 k[4];
#pragma unroll
          for (int r = 0; r < 4; ++r) {
            int sidx = s0 + 4 * g + r;
            k[r] = (sidx <= t0 + q) ? f2key(tot[r]) : 0u;
          }
          u32x2 w2 = {k[0] | (k[1] << 16), k[2] | (k[3] << 16)};
          *(u32x2*)(smem + q * IDX_RS + (s0 + 4 * g) * 2) = w2;
        }
        __builtin_amdgcn_sched_barrier(0);
      }
    }
    const int nk = t0 + 16, nk64 = (nk + 63) & ~63;
    for (int i = tid; i < 16 * (nk64 - nk); i += NTHREADS) {
      int row = i / (nk64 - nk), c = nk + i % (nk64 - nk);
      *(u16*)(smem + row * IDX_RS + c * 2) = 0;
    }
  }
  __syncthreads();
  const int nk64 = (t0 + 16 + 63) & ~63;
  for (int rr = 0; rr < ((p.flags & 16) ? 0 : 2); ++rr) {
    const int row = 2 * wave + rr, t = t0 + row;
    u16* out = SEL + (tokb + t) * 256;
    u32 kreg[32];
    if (lane * 64 < nk64) {
      const uint4* src = (const uint4*)(smem + row * IDX_RS + lane * 128);
#pragma unroll
      for (int i = 0; i < 8; ++i) {
        uint4 v = src[i];
        kreg[4 * i] = v.x; kreg[4 * i + 1] = v.y; kreg[4 * i + 2] = v.z; kreg[4 * i + 3] = v.w;
      }
    } else {
#pragma unroll
      for (int i = 0; i < 32; ++i) kreg[i] = 0u;
    }
    WAVE_LDS_SYNC();
    u32 lo = 1u, hi = 65535u;
    while (lo < hi) {
      u32 mid = (lo + hi + 1u) >> 1;
      int c = count_ge_wave(kreg, mid);
      if (c >= 256) lo = mid; else hi = mid - 1u;
    }
    const u32 tau = lo;
    int gt = 0, eq = 0;
#pragma unroll
    for (int i = 0; i < 32; ++i) {
      u32 a = kreg[i] & 0xffffu, c2 = kreg[i] >> 16;
      gt += (a > tau) ? 1 : 0; gt += (c2 > tau) ? 1 : 0;
      eq += (a == tau) ? 1 : 0; eq += (c2 == tau) ? 1 : 0;
    }
    int packed = gt | (eq << 16);
    int incl = packed;
#pragma unroll
    for (int o = 1; o < 64; o <<= 1) {
      int v = __shfl_up(incl, o);
      if (lane >= o) incl += v;
    }
    const int excl = incl - packed;
    const int total = __shfl(incl, 63);
    const int need = 256 - (total & 0xffff);
    const int pg = excl & 0xffff, pe = excl >> 16;
    int pos = pg + min(pe, need);
    int eqseen = pe;
    u16* lrow = (u16*)(smem + row * IDX_RS);
#pragma unroll
    for (int i = 0; i < 32; ++i) {
#pragma unroll
      for (int hh = 0; hh < 2; ++hh) {
        u32 kv = hh ? (kreg[i] >> 16) : (kreg[i] & 0xffffu);
        int idx = lane * 64 + 2 * i + hh;
        bool take = false;
        if (kv > tau) take = true;
        else if (kv == tau) { take = (eqseen < need); ++eqseen; }
        if (take) { lrow[pos] = (u16)idx; ++pos; }
      }
    }
    WAVE_LDS_SYNC();
    *(u32x2*)(out + lane * 4) = *(const u32x2*)(lrow + lane * 4);
    WAVE_LDS_SYNC();
  }
}

constexpr int DNP = 68;
constexpr int DL_KT = 0;
constexpr int DL_V = DL_KT + 128 * DNP * 4;
constexpr int DL_QB = DL_V + 64 * 128 * 4;
constexpr int DL_KB = DL_QB + 64 * 272;
constexpr int DL_SM = DL_KB + 64 * 272;
constexpr int DL_RAW = DL_SM + 2048;
static_assert(DL_RAW + 3 * 67 * 272 <= SMEM_BYTES, "dn_local LDS");
__device__ __forceinline__ void dn_local_item(const Params& p, unsigned char* smem, int item) {
  const int h = item & 3, n = (item >> 2) & 63, b = item >> 8;
  const u16* PROJ = (const u16*)(p.ws + OFF_PROJ);
  const float* SMALL = (const float*)(p.ws + OFF_SMALL);
  u16* Ug = (u16*)((unsigned char*)p.out + DO_U);
  u16* Wg = (u16*)((unsigned char*)p.out + DO_W);
  u16* QNg = (u16*)((unsigned char*)p.out + DO_QN);
  u16* KNTg = (u16*)((unsigned char*)p.out + DO_KNT);
  u16* ATTg = (u16*)(p.ws + OFF_ATT);
  float* GCg = (float*)(p.ws + OFF_GC);
  const float* convw = p.in[5];
  const int tid = TIDX, lane = tid & 63, wave = tid >> 6;
  const int c0 = n * 64;
  const size_t tok0 = (size_t)b * SEQ + c0;
  float* Kt = (float*)(smem + DL_KT);
  float* V = (float*)(smem + DL_V);
  unsigned char* Qb = smem + DL_QB;
  unsigned char* Kb = smem + DL_KB;
  float* gc = (float*)(smem + DL_SM);
  float* beta = gc + 64;
  float* ssp = beta + 64;
  unsigned char* RAW = smem + DL_RAW;
  float* AmT = (float*)(smem + DL_RAW);
  __syncthreads();
  {
    u32x4 rg[7];
#pragma unroll
    for (int k = 0; k < 7; ++k) {
      const int ci = tid + 512 * k;
      rg[k] = (u32x4){0u, 0u, 0u, 0u};
      if (ci < 3216) {
        const int arr = ci / 1072, rem = ci - arr * 1072, row = rem >> 4, ch = rem & 15;
        const int trel = c0 - 3 + row;
        if (trel >= 0)
          rg[k] = *(const u32x4*)(PROJ + ((size_t)b * SEQ + trel) * LDP + (C_DQ + arr * 512) + h * 128 + ch * 8);
      }
    }
#pragma unroll
    for (int k = 0; k < 7; ++k) {
      const int ci = tid + 512 * k;
      if (ci < 3216) {
        const int arr = ci / 1072, rem = ci - arr * 1072, row = rem >> 4, ch = rem & 15;
        *(u32x4*)(RAW + (arr * 67 + row) * 272 + ch * 16) = rg[k];
      }
    }
  }
  if (tid < 64) {
    float da = SMALL[(tok0 + tid) * 16 + 8 + h], db = SMALL[(tok0 + tid) * 16 + 12 + h];
    float xx = da + p.in[7][h];
    float sp = fmaxf(xx, 0.f) + log1pf(__expf(-fabsf(xx)));
    float gr = -__expf(p.in[6][h]) * sp;
    float incl = gr;
#pragma unroll
    for (int o = 1; o < 64; o <<= 1) {
      float v = __shfl_up(incl, o);
      if (lane >= o) incl += v;
    }
    gc[tid] = incl;
    beta[tid] = sigmoidf_(db);
    GCg[(tok0 + tid) * 4 + h] = incl;
  }
  __syncthreads();
  {
    const int c = tid & 127, tg = tid >> 7;
    float qv[16], kv[16];
#pragma unroll
    for (int arr = 0; arr < 3; ++arr) {
      const float w0 = convw[0 * 1536 + arr * 512 + h * 128 + c], w1 = convw[1 * 1536 + arr * 512 + h * 128 + c],
                  w2 = convw[2 * 1536 + arr * 512 + h * 128 + c], w3 = convw[3 * 1536 + arr * 512 + h * 128 + c];
      const unsigned char* rp = RAW + (arr * 67 + tg * 16) * 272 + c * 2;
      float x0 = bf2f(*(const u16*)(rp)), x1 = bf2f(*(const u16*)(rp + 272)), x2 = bf2f(*(const u16*)(rp + 2 * 272));
#pragma unroll
      for (int ii = 0; ii < 16; ++ii) {
        const float x3 = bf2f(*(const u16*)(rp + (ii + 3) * 272));
        const float y = w0 * x0 + w1 * x1 + w2 * x2 + w3 * x3;
        const float sv = y * sigmoidf_(y);
        if (arr == 0) qv[ii] = sv;
        else if (arr == 1) kv[ii] = sv;
        else V[(tg * 16 + ii) * 128 + c] = sv;
        x0 = x1; x1 = x2; x2 = x3;
      }
    }
#pragma unroll
    for (int ii = 0; ii < 16; ++ii) {
      const float sq = wave_sum_dpp(qv[ii] * qv[ii]);
      const float sk = wave_sum_dpp(kv[ii] * kv[ii]);
      if (lane == 0) {
        ssp[((tg * 16 + ii) * 2) + (wave & 1)] = sq;
        ssp[128 + ((tg * 16 + ii) * 2) + (wave & 1)] = sk;
      }
    }
    __syncthreads();
#pragma unroll
    for (int ii = 0; ii < 16; ++ii) {
      const int i = tg * 16 + ii;
      const float qsc = rsqrtf(ssp[i * 2] + ssp[i * 2 + 1] + EPS) * 0.08838834764831845f;
      const float ksc = rsqrtf(ssp[128 + i * 2] + ssp[128 + i * 2 + 1] + EPS);
      const float qn = qv[ii] * qsc, kn = kv[ii] * ksc;
      *(u16*)(Qb + i * 272 + c * 2) = f2bf(qn);
      *(u16*)(Kb + i * 272 + c * 2) = f2bf(kn);
      Kt[c * DNP + i] = kn;
    }
  }
  __syncthreads();
#pragma unroll
  for (int k = 0; k < 4; ++k) {
    const int gi = tid + 512 * k;
    {
      const int i = gi >> 5, d4 = (gi & 31) * 4;
      const u32x2 v = *(const u32x2*)(Qb + i * 272 + d4 * 2);
      *(u32x2*)(QNg + (tok0 + i) * 512 + h * 128 + perm32(d4)) = v;
    }
    {
      const int d = gi >> 4, t4 = (gi & 15) * 4;
      const f32x4 v = *(const f32x4*)(Kt + d * DNP + t4);
      u32x2 o = {pack2(v[0], v[1]), pack2(v[2], v[3])};
      *(u32x2*)(KNTg + (size_t)item * 8192 + d * 64 + perm32(t4)) = o;
    }
  }
  {
    const int mat = wave >> 2, it = wave & 3;
    const int fr = lane & 15, fg = lane >> 4;
    const unsigned char* Ab = mat ? Qb : Kb;
    bf16x8 af[4];
#pragma unroll
    for (int kk = 0; kk < 4; ++kk) af[kk] = *(const bf16x8*)(Ab + (it * 16 + fr) * 272 + kk * 64 + fg * 16);
    f32x4 gi4 = *(const f32x4*)(gc + it * 16 + 4 * fg);
    f32x4 bi4 = *(const f32x4*)(beta + it * 16 + 4 * fg);
#pragma unroll
    for (int jt = 0; jt < 4; ++jt) {
      f32x4 acc = {0.f, 0.f, 0.f, 0.f};
      if (jt <= it) {
#pragma unroll
        for (int kk = 0; kk < 4; ++kk) {
          bf16x8 bfg = *(const bf16x8*)(Kb + (jt * 16 + fr) * 272 + kk * 64 + fg * 16);
          acc = __builtin_amdgcn_mfma_f32_16x16x32_bf16(af[kk], bfg, acc, 0, 0, 0);
        }
      }
      const int j = jt * 16 + fr;
      const float gj = gc[j];
#pragma unroll
      for (int r = 0; r < 4; ++r) {
        const int i = it * 16 + 4 * fg + r;
        const float dec = __expf(fminf(gi4[r] - gj, 0.f));
        if (mat == 0) { if (jt <= it) AmT[j * 64 + i] = (i > j) ? bi4[r] * acc[r] * dec : 0.f; }
        else ATTg[(size_t)item * 4096 + i * 64 + perm32(j)] = f2bf((i >= j) ? acc[r] * dec : 0.f);
      }
    }
  }
  __syncthreads();
  if (tid < 256) {
    const int c = tid;
    const bool isu = c < 128;
    const int cc = c & 127;
    const int pc = perm32(cc);
#pragma unroll 1
    for (int ib = 0; ib < 4; ++ib) {
      float sreg[16];
#pragma unroll
      for (int r = 0; r < 16; ++r) {
        int i = ib * 16 + r;
        sreg[r] = isu ? V[i * 128 + cc] * beta[i] : Kt[cc * DNP + i] * beta[i] * __expf(gc[i]);
      }
#pragma unroll 1
      for (int j = 0; j < ib * 16; ++j) {
        float xj = isu ? V[j * 128 + cc] : Kt[cc * DNP + j];
        const f32x4* ap = (const f32x4*)(AmT + j * 64 + ib * 16);
        f32x4 a0 = ap[0], a1 = ap[1], a2 = ap[2], a3 = ap[3];
        sreg[0] -= a0[0] * xj; sreg[1] -= a0[1] * xj; sreg[2] -= a0[2] * xj; sreg[3] -= a0[3] * xj;
        sreg[4] -= a1[0] * xj; sreg[5] -= a1[1] * xj; sreg[6] -= a1[2] * xj; sreg[7] -= a1[3] * xj;
        sreg[8] -= a2[0] * xj; sreg[9] -= a2[1] * xj; sreg[10] -= a2[2] * xj; sreg[11] -= a2[3] * xj;
        sreg[12] -= a3[0] * xj; sreg[13] -= a3[1] * xj; sreg[14] -= a3[2] * xj; sreg[15] -= a3[3] * xj;
      }
#pragma unroll
      for (int q = 0; q < 15; ++q) {
        const float* ar = AmT + (ib * 16 + q) * 64 + ib * 16;
#pragma unroll
        for (int r = q + 1; r < 16; ++r) sreg[r] -= ar[r] * sreg[q];
      }
#pragma unroll
      for (int r = 0; r < 16; ++r) {
        int i = ib * 16 + r;
        if (isu) { V[i * 128 + cc] = sreg[r]; Ug[(tok0 + i) * 512 + h * 128 + cc] = f2bf(sreg[r]); }
        else { Kt[cc * DNP + i] = sreg[r]; Wg[(tok0 + i) * 512 + h * 128 + pc] = f2bf(sreg[r]); }
      }
    }
  }
}

__device__ __forceinline__ void phase2(const Params& p, unsigned char* smem) {
#ifndef NO_IDX
  for (int i = blockIdx.x; i < 2048; i += gridDim.x) idx_item(p, smem, i & 7, 255 - (i >> 3));
#endif
#ifndef NO_DNL
  if (!(p.flags & 1))
    for (int i = blockIdx.x; i < 2048; i += gridDim.x) dn_local_item(p, smem, i);
#endif
}

constexpr int SC_WP = 272, SC_KP = 144;
constexpr int SC_W = 0, SC_Q = 64 * SC_WP, SC_KT = 2 * 64 * SC_WP, SC_AT = SC_KT + 128 * SC_KP, SC_U = SC_AT + 64 * SC_KP,
              SC_BUF = SC_U + 64 * SC_WP;
constexpr int SC_GC = 2 * SC_BUF;
static_assert(SC_GC + 2 * 64 * 4 <= SMEM_BYTES, "scan LDS");

__device__ __forceinline__ void dn_scan_item(const Params& p, unsigned char* smem, int bh) {
  const int h = bh & 3, b = bh >> 2;
  const u16* Ug = (const u16*)((const unsigned char*)p.out + DO_U);
  const u16* Wg = (const u16*)((const unsigned char*)p.out + DO_W);
  const u16* QNg = (const u16*)((const unsigned char*)p.out + DO_QN);
  const u16* KNTg = (const u16*)((const unsigned char*)p.out + DO_KNT);
  const u16* ATTg = (const u16*)(p.ws + OFF_ATT);
  const float* GCg = (const float*)(p.ws + OFF_GC);
  const u16* PROJ = (const u16*)(p.ws + OFF_PROJ);
  u16* YDN = (u16*)(p.ws + OFF_YDN);
  const float* ogain = p.in[8];
  const int tid = TIDX, lane = tid & 63, wave = tid >> 6;
  const int fr = lane & 15, fg = lane >> 4;
  const int ecol = wave * 16 + fr;
  float* gcs = (float*)(smem + SC_GC);
  f32x4 S[8];
#pragma unroll
  for (int d = 0; d < 8; ++d) S[d] = (f32x4){0.f, 0.f, 0.f, 0.f};
  u32x4 st[9];
  float gcr = 0.f;
  const int r16 = tid >> 4, c16 = tid & 15;
  const int r8 = tid >> 3, c8 = tid & 7;
#define SCAN_LOAD(n_)                                                                                      \
  {                                                                                                        \
    const size_t tk0 = (size_t)b * SEQ + (size_t)(n_) * 64;                                                \
    const size_t it_ = (size_t)((b * 64 + (n_)) * 4 + h);                                                  \
    st[0] = *(const u32x4*)(Wg + (tk0 + r16) * 512 + h * 128 + c16 * 8);                                   \
    st[1] = *(const u32x4*)(Wg + (tk0 + r16 + 32) * 512 + h * 128 + c16 * 8);                              \
    st[2] = *(const u32x4*)(QNg + (tk0 + r16) * 512 + h * 128 + c16 * 8);                                  \
    st[3] = *(const u32x4*)(QNg + (tk0 + r16 + 32) * 512 + h * 128 + c16 * 8);                             \
    st[4] = *(const u32x4*)(KNTg + it_ * 8192 + (size_t)tid * 8);                                          \
    st[5] = *(const u32x4*)(KNTg + it_ * 8192 + (size_t)(tid + 512) * 8);                                  \
    st[6] = *(const u32x4*)(ATTg + it_ * 4096 + (size_t)tid * 8);                                          \
    st[7] = *(const u32x4*)(Ug + (tk0 + r16) * 512 + h * 128 + c16 * 8);                                   \
    st[8] = *(const u32x4*)(Ug + (tk0 + r16 + 32) * 512 + h * 128 + c16 * 8);                              \
    if (tid < 64) gcr = GCg[(tk0 + tid) * 4 + h];                                                          \
  }
#define SCAN_STORE(buf_)                                                                                   \
  {                                                                                                        \
    unsigned char* bs_ = smem + (buf_) * SC_BUF;                                                           \
    *(u32x4*)(bs_ + SC_W + r16 * SC_WP + c16 * 16) = st[0];                                                \
    *(u32x4*)(bs_ + SC_W + (r16 + 32) * SC_WP + c16 * 16) = st[1];                                         \
    *(u32x4*)(bs_ + SC_Q + r16 * SC_WP + c16 * 16) = st[2];                                                \
    *(u32x4*)(bs_ + SC_Q + (r16 + 32) * SC_WP + c16 * 16) = st[3];                                         \
    *(u32x4*)(bs_ + SC_KT + r8 * SC_KP + c8 * 16) = st[4];                                                 \
    *(u32x4*)(bs_ + SC_KT + (r8 + 64) * SC_KP + c8 * 16) = st[5];                                          \
    *(u32x4*)(bs_ + SC_AT + r8 * SC_KP + c8 * 16) = st[6];                                                 \
    *(u32x4*)(bs_ + SC_U + r16 * SC_WP + c16 * 16) = st[7];                                                \
    *(u32x4*)(bs_ + SC_U + (r16 + 32) * SC_WP + c16 * 16) = st[8];                                         \
    if (tid < 64) gcs[(buf_) * 64 + tid] = gcr;                                                            \
  }
  __syncthreads();
  SCAN_LOAD(0)
  SCAN_STORE(0)
  if (1 < 64) SCAN_LOAD(1)
  __syncthreads();
  for (int n = 0; n < 64; ++n) {
    const int buf = n & 1;
    const size_t tok0 = (size_t)b * SEQ + n * 64;
    if (n + 1 < 64) SCAN_STORE(buf ^ 1)
    if (n + 2 < 64) SCAN_LOAD(n + 2)
    __builtin_amdgcn_sched_barrier(0);
    const unsigned char* base = smem + buf * SC_BUF;
    const u32 ub0 = (u32)(tok0 + 4 * fg) * 512 + (u32)(h * 128 + ecol);
    const float* gcb = gcs + buf * 64 + 4 * fg;
    const float glast = gcs[buf * 64 + 63];
    bf16x8 Sb[4];
#pragma unroll
    for (int kk = 0; kk < 4; ++kk) {
      union { u32 w[4]; bf16x8 v; } cv;
      cv.w[0] = pack2(S[2 * kk][0], S[2 * kk][1]); cv.w[1] = pack2(S[2 * kk][2], S[2 * kk][3]);
      cv.w[2] = pack2(S[2 * kk + 1][0], S[2 * kk + 1][1]); cv.w[3] = pack2(S[2 * kk + 1][2], S[2 * kk + 1][3]);
      Sb[kk] = cv.v;
    }
    f32x4 vnew[4], ov[4];
#pragma unroll
    for (int m = 0; m < 4; ++m) {
      f32x4 aw = {0.f, 0.f, 0.f, 0.f}, aq = {0.f, 0.f, 0.f, 0.f};
#pragma unroll
      for (int kk = 0; kk < 4; ++kk) {
        bf16x8 wf = *(const bf16x8*)(base + SC_W + (m * 16 + fr) * SC_WP + kk * 64 + fg * 16);
        bf16x8 qf = *(const bf16x8*)(base + SC_Q + (m * 16 + fr) * SC_WP + kk * 64 + fg * 16);
        aw = __builtin_amdgcn_mfma_f32_16x16x32_bf16(wf, Sb[kk], aw, 0, 0, 0);
        aq = __builtin_amdgcn_mfma_f32_16x16x32_bf16(qf, Sb[kk], aq, 0, 0, 0);
      }
      f32x4 g4 = *(const f32x4*)(gcb + m * 16);
#pragma unroll
      for (int r = 0; r < 4; ++r) {
        float uv = bf2f(*(const u16*)(base + SC_U + (m * 16 + 4 * fg + r) * SC_WP + ecol * 2));
        vnew[m][r] = uv - aw[r];
        ov[m][r] = aq[r] * __expf(g4[r]);
      }
    }
    bf16x8 vb[2], vsb[2];
#pragma unroll
    for (int k2 = 0; k2 < 2; ++k2) {
      union { u32 w[4]; bf16x8 v; } c1, c2;
      const int ma = 2 * k2, mb = 2 * k2 + 1;
      c1.w[0] = pack2(vnew[ma][0], vnew[ma][1]); c1.w[1] = pack2(vnew[ma][2], vnew[ma][3]);
      c1.w[2] = pack2(vnew[mb][0], vnew[mb][1]); c1.w[3] = pack2(vnew[mb][2], vnew[mb][3]);
      f32x4 ga4 = *(const f32x4*)(gcb + ma * 16), gb4 = *(const f32x4*)(gcb + mb * 16);
      float sa[4], sb2[4];
#pragma unroll
      for (int r = 0; r < 4; ++r) { sa[r] = vnew[ma][r] * __expf(glast - ga4[r]); sb2[r] = vnew[mb][r] * __expf(glast - gb4[r]); }
      c2.w[0] = pack2(sa[0], sa[1]); c2.w[1] = pack2(sa[2], sa[3]);
      c2.w[2] = pack2(sb2[0], sb2[1]); c2.w[3] = pack2(sb2[2], sb2[3]);
      vb[k2] = c1.v; vsb[k2] = c2.v;
    }
    const float egl = __expf(glast);
#pragma unroll
    for (int d = 0; d < 8; ++d) {
      f32x4 a = S[d] * egl;
#pragma unroll
      for (int k2 = 0; k2 < 2; ++k2) {
        bf16x8 kf = *(const bf16x8*)(base + SC_KT + (d * 16 + fr) * SC_KP + k2 * 64 + fg * 16);
        a = __builtin_amdgcn_mfma_f32_16x16x32_bf16(kf, vsb[k2], a, 0, 0, 0);
      }
      S[d] = a;
    }
#pragma unroll
    for (int m = 0; m < 4; ++m) {
      f32x4 ao = ov[m];
#pragma unroll
      for (int k2 = 0; k2 < 2; ++k2) {
        bf16x8 af = *(const bf16x8*)(base + SC_AT + (m * 16 + fr) * SC_KP + k2 * 64 + fg * 16);
        ao = __builtin_amdgcn_mfma_f32_16x16x32_bf16(af, vb[k2], ao, 0, 0, 0);
      }
#pragma unroll
      for (int r = 0; r < 4; ++r) YDN[ub0 + (u32)((m * 16 + r) * 512)] = f2bf(ao[r]);
    }
    __syncthreads();
  }
#undef SCAN_LOAD
#undef SCAN_STORE
  asm volatile("s_waitcnt vmcnt(0)" ::: "memory");
  __syncthreads();
  {
    const int sub = lane >> 4, l16 = lane & 15;
    float gn8[8];
#pragma unroll
    for (int e = 0; e < 8; ++e) gn8[e] = ogain[l16 * 8 + e];
    for (int t = wave * 4 + sub; t < SEQ; t += 32) {
      const size_t tok = (size_t)b * SEQ + t;
      u16* yp = YDN + tok * 512 + h * 128 + l16 * 8;
      const u32x4 ov4 = *(const u32x4*)yp;
      const u32x4 zv4 = *(const u32x4*)(PROJ + tok * LDP + C_DZ + h * 128 + l16 * 8);
      float o8[8], z8[8];
#pragma unroll
      for (int c = 0; c < 4; ++c) { o8[2 * c] = bflo(ov4[c]); o8[2 * c + 1] = bfhi(ov4[c]); z8[2 * c] = bflo(zv4[c]); z8[2 * c + 1] = bfhi(zv4[c]); }
      float sq = 0.f;
#pragma unroll
      for (int e = 0; e < 8; ++e) sq += o8[e] * o8[e];
      sq += DPPF(sq, 0xb1); sq += DPPF(sq, 0x4e); sq += DPPF(sq, 0x141); sq += DPPF(sq, 0x140);
      const float rstd = rsqrtf(sq * (1.f / 128.f) + EPS);
      u32 w[4];
#pragma unroll
      for (int c = 0; c < 4; ++c) {
        const float y0 = o8[2 * c] * rstd * gn8[2 * c] * z8[2 * c] * sigmoidf_(z8[2 * c]);
        const float y1 = o8[2 * c + 1] * rstd * gn8[2 * c + 1] * z8[2 * c + 1] * sigmoidf_(z8[2 * c + 1]);
        w[c] = pack2(y0, y1);
      }
      *(u32x4*)yp = (u32x4){w[0], w[1], w[2], w[3]};
    }
  }
}

constexpr int AT_WAVE_BYTES = 8192 + 512 + 8192;
__device__ __forceinline__ float xor16_sum(float v) {
  auto r = __builtin_amdgcn_permlane16_swap(__float_as_uint(v), __float_as_uint(v), false, false);
  return __uint_as_float(r[0]) + __uint_as_float(r[1]);
}
__device__ __forceinline__ float xor32_sum(float v) {
  auto r = __builtin_amdgcn_permlane32_swap(__float_as_uint(v), __float_as_uint(v), false, false);
  return __uint_as_float(r[0]) + __uint_as_float(r[1]);
}
__device__ __forceinline__ void attn_query(const Params& p, unsigned char* wsm, int b, int t) {
  const u16* PROJ = (const u16*)(p.ws + OFF_PROJ);
  const u16* SEL = (const u16*)(p.ws + OFF_SEL);
  const u16* KVC = (const u16*)(p.ws + OFF_KVC);
  u16* YATT = (u16*)(p.ws + OFF_YATT);
  const int lane = TIDX & 63;
  const int fr = lane & 15, fg = lane >> 4;
  float* P = (float*)wsm;
  u16* sl = (u16*)(wsm + 8192);
  const size_t tokb = (size_t)b * SEQ;
  const size_t tok = tokb + t;
  const int nsel = min(256, t + 1);
  bf16x8 qb[2][2];
  {
    const bf16x8 z = {0, 0, 0, 0, 0, 0, 0, 0};
    const u16* qrow = PROJ + tok * LDP + C_AQ + (fr & 3) * 64 + fg * 8;
#pragma unroll
    for (int g = 0; g < 2; ++g)
#pragma unroll
      for (int kk = 0; kk < 2; ++kk) {
        bf16x8 v = *(const bf16x8*)(qrow + g * 256 + kk * 32);
        qb[g][kk] = (fr < 4) ? v : z;
      }
    const u16* sr = SEL + tok * 256;
#pragma unroll
    for (int i = 0; i < 4; ++i) sl[lane + 64 * i] = sr[lane + 64 * i];
  }
  WAVE_LDS_SYNC();
  const int ngrp = (nsel + 15) >> 4;
  const int nbq = (ngrp + 1) >> 1;
  unsigned char* KST = wsm + 8192 + 512;
  const int kq = lane >> 3, kch = lane & 7;
  u32x4 kA[2][4], kB[2][4];
#define QK_LOAD(buf_, bi_)                                                                       \
  _Pragma("unroll") for (int j = 0; j < 2; ++j)                                                  \
    _Pragma("unroll") for (int hf = 0; hf < 2; ++hf) {                                           \
      const int ki_ = min(((bi_) * 2 + j) * 16 + hf * 8 + kq, 255);                              \
      const int s_ = (int)sl[ki_] & 4095;                                                        \
      const u16* krow_ = KVC + (tokb + s_) * 256 + kch * 8;                                      \
      buf_[j][hf * 2] = *(const u32x4*)(krow_); buf_[j][hf * 2 + 1] = *(const u32x4*)(krow_ + 64); \
    }
#define QK_COMPUTE(buf_, bi_)                                                                    \
  {                                                                                              \
    _Pragma("unroll") for (int j = 0; j < 2; ++j)                                                \
      _Pragma("unroll") for (int hf = 0; hf < 2; ++hf) {                                         \
        const int row_ = hf * 8 + kq;                                                            \
        _Pragma("unroll") for (int g = 0; g < 2; ++g)                                            \
          *(u32x4*)(KST + j * 4096 + (row_ * 2 + g) * 128 + ((kch ^ (row_ & 7)) << 4)) = buf_[j][hf * 2 + g]; \
      }                                                                                          \
    WAVE_LDS_SYNC();                                                                             \
    _Pragma("unroll") for (int j = 0; j < 2; ++j) {                                              \
      const unsigned char* kr_ = KST + j * 4096 + fr * 256;                                      \
      const bf16x8 a00_ = *(const bf16x8*)(kr_ + (((0 + fg) ^ (fr & 7)) << 4));                  \
      const bf16x8 a01_ = *(const bf16x8*)(kr_ + (((4 + fg) ^ (fr & 7)) << 4));                  \
      const bf16x8 a10_ = *(const bf16x8*)(kr_ + 128 + (((0 + fg) ^ (fr & 7)) << 4));            \
      const bf16x8 a11_ = *(const bf16x8*)(kr_ + 128 + (((4 + fg) ^ (fr & 7)) << 4));            \
      f32x4 c0_ = {0.f, 0.f, 0.f, 0.f}, c1_ = {0.f, 0.f, 0.f, 0.f};                              \
      c0_ = __builtin_amdgcn_mfma_f32_16x16x32_bf16(a00_, qb[0][0], c0_, 0, 0, 0);               \
      c0_ = __builtin_amdgcn_mfma_f32_16x16x32_bf16(a01_, qb[0][1], c0_, 0, 0, 0);               \
      c1_ = __builtin_amdgcn_mfma_f32_16x16x32_bf16(a10_, qb[1][0], c1_, 0, 0, 0);               \
      c1_ = __builtin_amdgcn_mfma_f32_16x16x32_bf16(a11_, qb[1][1], c1_, 0, 0, 0);               \
      if (fr < 4) {                                                                              \
        _Pragma("unroll") for (int r = 0; r < 4; ++r) {                                          \
          const int kk2_ = ((bi_) * 2 + j) * 16 + 4 * fg + r;                                    \
          if (kk2_ < 256) {                                                                      \
            const bool v_ = kk2_ < nsel;                                                         \
            P[kk2_ * 8 + fr] = v_ ? c0_[r] : -1e30f;                                             \
            P[kk2_ * 8 + 4 + fr] = v_ ? c1_[r] : -1e30f;                                         \
          }                                                                                      \
        }                                                                                        \
      }                                                                                          \
    }                                                                                            \
    WAVE_LDS_SYNC();                                                                             \
  }
  QK_LOAD(kA, 0)
  for (int bi = 0; bi < nbq; bi += 2) {
    if (bi + 1 < nbq) { QK_LOAD(kB, bi + 1) }
    QK_COMPUTE(kA, bi)
    if (bi + 2 < nbq) { QK_LOAD(kA, bi + 2) }
    if (bi + 1 < nbq) { QK_COMPUTE(kB, bi + 1) }
  }
#undef QK_LOAD
#undef QK_COMPUTE
  for (int ki = nbq * 32 + lane; ki < 256; ki += 64) {
    *(f32x4*)(P + ki * 8) = (f32x4){-1e30f, -1e30f, -1e30f, -1e30f};
    *(f32x4*)(P + ki * 8 + 4) = (f32x4){-1e30f, -1e30f, -1e30f, -1e30f};
  }
  WAVE_LDS_SYNC();
  {
    float lg[4][8];
#pragma unroll
    for (int i = 0; i < 4; ++i) {
      f32x4 x0 = *(const f32x4*)(P + (lane + 64 * i) * 8), x1 = *(const f32x4*)(P + (lane + 64 * i) * 8 + 4);
      lg[i][0] = x0[0]; lg[i][1] = x0[1]; lg[i][2] = x0[2]; lg[i][3] = x0[3];
      lg[i][4] = x1[0]; lg[i][5] = x1[1]; lg[i][6] = x1[2]; lg[i][7] = x1[3];
    }
#pragma unroll
    for (int hh = 0; hh < 8; ++hh) {
      float m = fmaxf(fmaxf(lg[0][hh], lg[1][hh]), fmaxf(lg[2][hh], lg[3][hh]));
      m = wave_max_dpp(m);
      float e[4], sum = 0.f;
#pragma unroll
      for (int i = 0; i < 4; ++i) { e[i] = __expf(lg[i][hh] - m); sum += e[i]; }
      sum = wave_sum_dpp(sum);
      const float inv = __builtin_amdgcn_rcpf(sum);
#pragma unroll
      for (int i = 0; i < 4; ++i) lg[i][hh] = e[i] * inv;
    }
#pragma unroll
    for (int i = 0; i < 4; ++i) {
      float* d = P + (lane + 64 * i) * 8;
      *(f32x4*)d = (f32x4){lg[i][0], lg[i][1], lg[i][2], lg[i][3]};
      *(f32x4*)(d + 4) = (f32x4){lg[i][4], lg[i][5], lg[i][6], lg[i][7]};
    }
  }
  WAVE_LDS_SYNC();
  const int ks = lane >> 3, c8 = lane & 7;
  const int ngrp8 = (nsel + 7) >> 3;
  const int total = (ngrp8 + 3) >> 2;
  u32x4 vA[4][2], vB[4][2];
  f32x2_t o2[2][4][4];
#define PV_LOAD(buf_, bi_)                                                                       \
  _Pragma("unroll") for (int j = 0; j < 4; ++j) {                                                \
    const int ki_ = min(((bi_) * 4 + j) * 8 + ks, 255);                                          \
    const int s_ = (int)sl[ki_] & 4095;                                                          \
    const u16* vrow_ = KVC + (tokb + s_) * 256 + 128 + c8 * 8;                                   \
    buf_[j][0] = *(const u32x4*)(vrow_); buf_[j][1] = *(const u32x4*)(vrow_ + 64);               \
  }
#define PV_COMPUTE(buf_, bi_)                                                                    \
  _Pragma("unroll") for (int j = 0; j < 4; ++j) {                                                \
    const int ki_ = ((bi_) * 4 + j) * 8 + ks;                                                    \
    f32x4 p0_ = *(const f32x4*)(P + min(ki_, 255) * 8), p1_ = *(const f32x4*)(P + min(ki_, 255) * 8 + 4); \
    if (ki_ >= nsel) { p0_ = (f32x4){0.f, 0.f, 0.f, 0.f}; p1_ = p0_; }                           \
    _Pragma("unroll") for (int c = 0; c < 4; ++c) {                                              \
      const f32x2_t f0_ = {bflo(buf_[j][0][c]), bfhi(buf_[j][0][c])};                            \
      const f32x2_t f1_ = {bflo(buf_[j][1][c]), bfhi(buf_[j][1][c])};                            \
      _Pragma("unroll") for (int hh = 0; hh < 4; ++hh) {                                         \
        const f32x2_t pa_ = {p0_[hh], p0_[hh]}, pb_ = {p1_[hh], p1_[hh]};                        \
        o2[0][hh][c] = __builtin_elementwise_fma(pa_, f0_, o2[0][hh][c]);                        \
        o2[1][hh][c] = __builtin_elementwise_fma(pb_, f1_, o2[1][hh][c]);                        \
      }                                                                                          \
    }                                                                                            \
  }
#pragma unroll
  for (int g = 0; g < 2; ++g)
#pragma unroll
    for (int hh = 0; hh < 4; ++hh)
#pragma unroll
      for (int c = 0; c < 4; ++c) o2[g][hh][c] = (f32x2_t){0.f, 0.f};
  PV_LOAD(vA, 0)
  for (int bi = 0; bi < total; bi += 2) {
    if (bi + 1 < total) { PV_LOAD(vB, bi + 1) }
    PV_COMPUTE(vA, bi)
    if (bi + 2 < total) { PV_LOAD(vA, bi + 2) }
    if (bi + 1 < total) { PV_COMPUTE(vB, bi + 1) }
  }
#undef PV_LOAD
#undef PV_COMPUTE
#pragma unroll
  for (int g = 0; g < 2; ++g)
#pragma unroll
    for (int hh = 0; hh < 4; ++hh) {
      u32 w_[4];
#pragma unroll
      for (int c = 0; c < 4; ++c) {
        float x0 = o2[g][hh][c][0], x1 = o2[g][hh][c][1];
        x0 += DPPF(x0, 0x128); x1 += DPPF(x1, 0x128);
        x0 = xor16_sum(x0); x1 = xor16_sum(x1);
        x0 = xor32_sum(x0); x1 = xor32_sum(x1);
        w_[c] = pack2(x0, x1);
      }
      if (lane < 8) *(u32x4*)(YATT + tok * 512 + (g * 4 + hh) * 64 + c8 * 8) = (u32x4){w_[0], w_[1], w_[2], w_[3]};
    }
  WAVE_LDS_SYNC();
}

__device__ __forceinline__ void phase3(const Params& p, unsigned char* smem) {
  const int wave = TIDX >> 6;
#ifndef NO_SCAN
  if (blockIdx.x < 32) {
    if (!(p.flags & 2)) dn_scan_item(p, smem, blockIdx.x);
    __syncthreads();
  }
#endif
#ifdef NO_ATTN
  return;
#endif
  if (p.flags & 4) return;
  unsigned* qctr = (unsigned*)(p.ws + 1024);
  const unsigned xcc = (unsigned)__builtin_amdgcn_s_getreg((3 << 11) | 20) & 7u;
  unsigned char* wsm = smem + wave * AT_WAVE_BYTES;
  for (unsigned db = 0; db < 8; ++db) {
    const int bb = (int)((xcc + db) & 7u);
    for (;;) {
      unsigned qi = 0;
      if ((TIDX & 63) == 0) qi = __hip_atomic_fetch_add(qctr + bb * 16, 1u, __ATOMIC_RELAXED, __HIP_MEMORY_SCOPE_AGENT);
      qi = (unsigned)__builtin_amdgcn_readfirstlane((int)qi);
      if (qi >= (unsigned)SEQ) break;
      attn_query(p, wsm, bb, SEQ - 1 - (int)qi);
    }
  }
}

__device__ __forceinline__ void phase4(const Params& p, unsigned char* smem) {
  const u16* YATT = (const u16*)(p.ws + OFF_YATT);
  const u16* YDN = (const u16*)(p.ws + OFF_YDN);
  const u16* WTA = (const u16*)(p.ws + OFF_WTA);
  const u16* WTB = (const u16*)(p.ws + OFF_WTB);
  const u16* PROJ = (const u16*)(p.ws + OFF_PROJ);
  u16* MG = (u16*)(p.ws + OFF_MERGED);
  const int lane = TIDX & 63, wave = TIDX >> 6;
  const int wm = wave >> 1, wn = wave & 1, fr = lane & 15, fg = lane >> 4;
  const int ntn = DM / G_BN, ntiles = (MTOK / G_BM) * ntn;
  for (int t = blockIdx.x; t < ntiles; t += gridDim.x) {
    const int m0 = (t / ntn) * G_BM, n0 = (t % ntn) * G_BN;
    f32x4 acc[4][4];
    u32 mg[4][4][2];
    const u32 pb0 = (u32)(m0 + wm * 64 + 4 * fg) * LDP + (u32)(n0 + wn * 64 + fr);
    const u32 ob0 = (u32)(m0 + wm * 64 + 4 * fg) * DM + (u32)(n0 + wn * 64 + fr);
    gemm_mainloop(YATT, 512, WTA, 512, 512, m0, n0, smem, acc);
#pragma unroll
    for (int i = 0; i < 4; ++i)
#pragma unroll
      for (int j = 0; j < 4; ++j) {
        float t4[4];
#pragma unroll
        for (int r = 0; r < 4; ++r) {
          float ga = bf2f(PROJ[pb0 + (u32)(C_GA + (i * 16 + r) * LDP + j * 16)]);
          t4[r] = sigmoidf_(ga) * acc[i][j][r];
        }
        mg[i][j][0] = pack2(t4[0], t4[1]); mg[i][j][1] = pack2(t4[2], t4[3]);
        asm volatile("" ::: "memory");
      }
    gemm_mainloop(YDN, 512, WTB, 512, 512, m0, n0, smem, acc);
#pragma unroll
    for (int i = 0; i < 4; ++i)
#pragma unroll
      for (int j = 0; j < 4; ++j)
#pragma unroll
        for (int r = 0; r < 4; ++r) {
          float gb = bf2f(PROJ[pb0 + (u32)(C_GB + (i * 16 + r) * LDP + j * 16)]);
          u32 w = mg[i][j][r >> 1];
          float m1 = (r & 1) ? bfhi(w) : bflo(w);
          MG[ob0 + (u32)((i * 16 + r) * DM + j * 16)] = f2bf(m1 + sigmoidf_(gb) * acc[i][j][r]);
          if (r == 3) asm volatile("" ::: "memory");
        }
  }
}

__device__ __forceinline__ void phase5(const Params& p, unsigned char* smem) {
  const u16* MG = (const u16*)(p.ws + OFF_MERGED);
  const u16* WTO = (const u16*)(p.ws + OFF_WTO);
  const float* x = p.in[0];
  const int lane = TIDX & 63, wave = TIDX >> 6;
  const int wm = wave >> 2, wn = wave & 3, fr = lane & 15, fg = lane >> 4;
  const int ntn = DM / 256, ntiles = (MTOK / G_BM) * ntn;
  for (int t = blockIdx.x; t < ntiles; t += gridDim.x) {
    const int m0 = (t / ntn) * G_BM, n0 = (t % ntn) * 256;
    f32x4 acc[8][4];
    gemm_mainloop_t<8>(MG, DM, WTO, DM, DM, m0, n0, smem, acc);
    const u32 ob0 = (u32)(m0 + wm * 128 + 4 * fg) * DM + (u32)(n0 + wn * 64 + fr);
    float* outp = p.out;
#pragma unroll
    for (int i = 0; i < 8; ++i) {
#pragma unroll
      for (int j = 0; j < 4; ++j)
#pragma unroll
        for (int r = 0; r < 4; ++r) {
          u32 o = ob0 + (u32)((i * 16 + r) * DM + j * 16);
          outp[o] = x[o] + acc[i][j][r];
        }
      __builtin_amdgcn_sched_barrier(0);
    }
  }
}

__device__ __forceinline__ void phase6(const Params& p, unsigned char* smem) {
  const u16* H2 = (const u16*)(p.ws + OFF_H2);
  const u16* WTQ = (const u16*)(p.ws + OFF_WTQ);
  u16* QP = (u16*)(p.ws + OFF_QP);
  const int lane = TIDX & 63, wave = TIDX >> 6;
  const int wm = wave >> 2, wn = wave & 3, fr = lane & 15, fg = lane >> 4;
  const int ntn = 2048 / 256, ntiles = (MTOK / G_BM) * ntn;
  for (int t = blockIdx.x; t < ntiles; t += gridDim.x) {
    const int m0 = (t / ntn) * G_BM, n0 = (t % ntn) * 256;
    f32x4 acc[8][4];
    gemm_mainloop_t<8>(H2, DM, WTQ, DM, DM, m0, n0, smem, acc);
    const u32 ob0 = (u32)(m0 + wm * 128 + 4 * fg) * 2048 + (u32)(n0 + wn * 64 + fr);
#pragma unroll
    for (int i = 0; i < 8; ++i)
#pragma unroll
      for (int j = 0; j < 4; ++j)
#pragma unroll
        for (int r = 0; r < 4; ++r) QP[ob0 + (u32)((i * 16 + r) * 2048 + j * 16)] = f2bf(acc[i][j][r]);
  }
}

__device__ __forceinline__ int mono_key(float v) { int b = __float_as_int(v); return b ^ ((b >> 31) & 0x7fffffff); }
__device__ __forceinline__ float unmono_key(int k) { return __int_as_float(k ^ ((k >> 31) & 0x7fffffff)); }
__device__ __forceinline__ void chain16(int (&k)[16], int x) {
#pragma unroll
  for (int j = 0; j < 16; ++j) { int hi = max(k[j], x); x = min(k[j], x); k[j] = hi; }
}

constexpr int P7_LD = 132;
__device__ __forceinline__ void phase7(const Params& p, unsigned char* smem) {
  const u16* QP = (const u16*)(p.ws + OFF_QP);
  const u16* SKB = (const u16*)(p.ws + OFF_SKB);
  float* TOPS = (float*)(p.ws + OFF_TOPS);
  u8* TOPI = (u8*)(p.ws + OFF_TOPI);
  const int tid = TIDX, lane = tid & 63, wave = tid >> 6;
  const int wm = wave >> 1, wn = wave & 1, fr = lane & 15, fg = lane >> 4;
  const int ntiles = (MTOK / G_BM) * 16;
  float* tile = (float*)smem;
  for (int t = blockIdx.x; t < ntiles; t += gridDim.x) {
    const int m0 = (t >> 4) * G_BM, hp = t & 15;
    f32x4 acc[4][4];
    gemm_mainloop(QP + hp * 128, 2048, SKB + (size_t)hp * 128 * 128, 128, 128, m0, 0, smem, acc);
#pragma unroll
    for (int i = 0; i < 4; ++i)
#pragma unroll
      for (int j = 0; j < 4; ++j)
#pragma unroll
        for (int r = 0; r < 4; ++r) {
          int row = wm * 64 + i * 16 + 4 * fg + r, col = wn * 64 + j * 16 + fr;
          tile[row * P7_LD + col] = acc[i][j][r];
        }
    __syncthreads();
    {
      const int row = tid >> 1, half = tid & 1;
      int k[16];
#pragma unroll
      for (int j = 0; j < 16; ++j) k[j] = (int)0x80000000;
      const float* rowp = tile + row * P7_LD + half * 64;
#pragma unroll 4
      for (int c = 0; c < 64; c += 4) {
        f32x4 v = *(const f32x4*)(rowp + c);
        const int ib = 127 - (half * 64 + c);
        chain16(k, (mono_key(v[0]) & ~127) | ib);
        chain16(k, (mono_key(v[1]) & ~127) | (ib - 1));
        chain16(k, (mono_key(v[2]) & ~127) | (ib - 2));
        chain16(k, (mono_key(v[3]) & ~127) | (ib - 3));
      }
#pragma unroll
      for (int j = 0; j < 16; ++j) {
        const int other = DPPI(k[j], 0xb1);
        if (half == 0) chain16(k, other);
      }
      if (half == 0) {
        size_t o = ((size_t)(m0 + row) * 16 + hp) * 16;
        float vals[16]; int idx[16];
#pragma unroll
        for (int j = 0; j < 16; ++j) { idx[j] = 127 - (k[j] & 127); vals[j] = tile[row * P7_LD + idx[j]]; }
#pragma unroll
        for (int j = 0; j < 16; j += 4) *(f32x4*)(TOPS + o + j) = (f32x4){vals[j], vals[j + 1], vals[j + 2], vals[j + 3]};
#pragma unroll
        for (int j = 0; j < 16; j += 4)
          *(u32*)(TOPI + o + j) = (u32)idx[j] | ((u32)idx[j + 1] << 8) | ((u32)idx[j + 2] << 16) | ((u32)idx[j + 3] << 24);
      }
    }
    __syncthreads();
  }
}

__device__ __forceinline__ void phase7b(const Params& p) {
  const float* TOPS = (const float*)(p.ws + OFF_TOPS);
  const u8* TOPI = (const u8*)(p.ws + OFF_TOPI);
  int* EXPERT = (int*)(p.ws + OFF_EXPERT);
  float* GATE = (float*)(p.ws + OFF_GATE);
  for (int w = blockIdx.x * NTHREADS + TIDX; w < MTOK * 8; w += gridDim.x * NTHREADS) {
    const size_t o = (size_t)w * 32;
    float sa[16], sb[16];
#pragma unroll
    for (int k = 0; k < 16; k += 4) {
      float4 v = *(const float4*)(TOPS + o + k); sa[k] = v.x; sa[k + 1] = v.y; sa[k + 2] = v.z; sa[k + 3] = v.w;
      float4 u = *(const float4*)(TOPS + o + 16 + k); sb[k] = u.x; sb[k + 1] = u.y; sb[k + 2] = u.z; sb[k + 3] = u.w;
    }
    int kk[16];
#pragma unroll
    for (int k = 0; k < 16; ++k) kk[k] = (int)0x80000000;
#pragma unroll
    for (int a = 0; a < 16; ++a)
#pragma unroll
      for (int bb = 0; bb < 16; ++bb)
        if ((a + 1) * (bb + 1) <= 16) chain16(kk, (mono_key(sa[a] + sb[bb]) & ~255) | (255 - (a * 16 + bb)));
    float vals[16];
#pragma unroll
    for (int k = 0; k < 16; ++k) vals[k] = unmono_key(kk[k] & ~255);
    float m = vals[0], s = 0.f, e[16];
#pragma unroll
    for (int k = 0; k < 16; ++k) { e[k] = __expf(vals[k] - m); s += e[k]; }
    float inv = 1.f / s;
#pragma unroll
    for (int k = 0; k < 16; ++k) {
      const int ci = 255 - (kk[k] & 255);
      int a = ci >> 4, bb = ci & 15;
      int ex = (int)TOPI[o + a] * 128 + (int)TOPI[o + 16 + bb];
      EXPERT[(size_t)w * 16 + k] = ex;
      GATE[(size_t)w * 16 + k] = e[k] * inv;
    }
  }
  {
    const int lane = TIDX & 63, wave = TIDX >> 6;
    for (int row = blockIdx.x * 8 + wave; row < 2 * 16384; row += gridDim.x * 8) {
      const int tbl = row >> 14, r = row & 16383;
      const f32x4* src = (const f32x4*)((tbl ? p.in[16] : p.in[15]) + (size_t)r * DM) + 4 * lane;
      f32x4 x[4];
      float amax = 0.f;
#pragma unroll
      for (int i = 0; i < 4; ++i) {
        x[i] = src[i];
        amax = fmaxf(amax, fmaxf(fmaxf(fabsf(x[i][0]), fabsf(x[i][1])), fmaxf(fabsf(x[i][2]), fabsf(x[i][3]))));
      }
      amax = wave_max_dpp(amax);
      const float inv = amax > 0.f ? 127.f / amax : 0.f;
      const int bias = tbl ? 128 : 0;
      u32x4 o;
#pragma unroll
      for (int i = 0; i < 4; ++i) {
        int q0 = (int)rintf(x[i][0] * inv) + bias, q1 = (int)rintf(x[i][1] * inv) + bias;
        int q2 = (int)rintf(x[i][2] * inv) + bias, q3 = (int)rintf(x[i][3] * inv) + bias;
        o[i] = (u32)(q0 & 0xff) | ((u32)(q1 & 0xff) << 8) | ((u32)(q2 & 0xff) << 16) | ((u32)(q3 & 0xff) << 24);
      }
      *(u32x4*)(p.ws + (tbl ? OFF_VQ : OFF_UQ) + (size_t)r * DM + 16 * lane) = o;
      if (lane == 0) ((float*)(p.ws + (tbl ? OFF_VS : OFF_US)))[r] = amax * (1.f / 127.f);
    }
  }
}

__device__ __forceinline__ void phase8(const Params& p) {
  const u16* H2 = (const u16*)(p.ws + OFF_H2);
  const int* EXPERT = (const int*)(p.ws + OFF_EXPERT);
  const float* GATE = (const float*)(p.ws + OFF_GATE);
  const unsigned char* UQ = p.ws + OFF_UQ;
  const unsigned char* VQ = p.ws + OFF_VQ;
  const float* US = (const float*)(p.ws + OFF_US);
  const float* VS = (const float*)(p.ws + OFF_VS);
  const int lane = TIDX & 63, wave = TIDX >> 6;
  for (int tok = blockIdx.x * 8 + wave; tok < MTOK; tok += gridDim.x * 8) {
    u32 hq[4];
    float sh;
    {
      const u32x4 a = *(const u32x4*)(H2 + (size_t)tok * DM + 16 * lane);
      const u32x4 b = *(const u32x4*)(H2 + (size_t)tok * DM + 16 * lane + 8);
      float hv[16];
#pragma unroll
      for (int c = 0; c < 4; ++c) { hv[2 * c] = bflo(a[c]); hv[2 * c + 1] = bfhi(a[c]); hv[8 + 2 * c] = bflo(b[c]); hv[8 + 2 * c + 1] = bfhi(b[c]); }
      float amax = 0.f;
#pragma unroll
      for (int i = 0; i < 16; ++i) amax = fmaxf(amax, fabsf(hv[i]));
      amax = wave_max_dpp(amax);
      const float inv = amax > 0.f ? 127.f / amax : 0.f;
      sh = amax * (1.f / 127.f);
#pragma unroll
      for (int c = 0; c < 4; ++c) {
        int q0 = (int)rintf(hv[4 * c] * inv), q1 = (int)rintf(hv[4 * c + 1] * inv);
        int q2 = (int)rintf(hv[4 * c + 2] * inv), q3 = (int)rintf(hv[4 * c + 3] * inv);
        hq[c] = (u32)(q0 & 0xff) | ((u32)(q1 & 0xff) << 8) | ((u32)(q2 & 0xff) << 16) | ((u32)(q3 & 0xff) << 24);
      }
    }
    const int e0 = EXPERT[(size_t)tok * 128 + lane], e1 = EXPERT[(size_t)tok * 128 + 64 + lane];
    const float g0 = GATE[(size_t)tok * 128 + lane], g1 = GATE[(size_t)tok * 128 + 64 + lane];
    const float su0 = US[e0], su1 = US[e1], sv0 = VS[e0], sv1 = VS[e1];
    int dacc0 = 0, dacc1 = 0;
#pragma unroll 1
    for (int half = 0; half < 2; ++half) {
      const int ev = half ? e1 : e0;
      int dacc = 0;
#pragma unroll 1
      for (int k = 0; k < 64; k += 16) {
        u32x4 ua[16];
#pragma unroll
        for (int j = 0; j < 16; ++j) {
          const int e = __builtin_amdgcn_readlane(ev, k + j);
          ua[j] = *(const u32x4*)(UQ + (size_t)e * DM + 16 * lane);
        }
#pragma unroll
        for (int j = 0; j < 16; ++j) {
          int sdot = 0;
#pragma unroll
          for (int c = 0; c < 4; ++c) sdot = __builtin_amdgcn_sdot4((int)ua[j][c], (int)hq[c], sdot, false);
          sdot = wave_sum_i_dpp(sdot);
          dacc = (lane == k + j) ? sdot : dacc;
        }
      }
      if (half) dacc1 = dacc; else dacc0 = dacc;
    }
    const float d0 = (float)dacc0 * su0 * sh, d1 = (float)dacc1 * su1 * sh;
    const float cf0 = g0 * 0.5f * d0 * (1.f + erff(d0 * 0.70710678118654752f)) * sv0;
    const float cf1 = g1 * 0.5f * d1 * (1.f + erff(d1 * 0.70710678118654752f)) * sv1;
    const float csum = wave_sum_dpp(cf0 + cf1);
    f32x2_t ov2[8];
#pragma unroll
    for (int i = 0; i < 8; ++i) ov2[i] = (f32x2_t){0.f, 0.f};
#pragma unroll 1
    for (int half = 0; half < 2; ++half) {
      const int ev = half ? e1 : e0;
      const float cv = half ? cf1 : cf0;
#pragma unroll 1
      for (int k = 0; k < 64; k += 16) {
        u32x4 va[16];
        float cc[16];
#pragma unroll
        for (int j = 0; j < 16; ++j) {
          const int e = __builtin_amdgcn_readlane(ev, k + j);
          cc[j] = __int_as_float(__builtin_amdgcn_readlane(__float_as_int(cv), k + j));
          va[j] = *(const u32x4*)(VQ + (size_t)e * DM + 16 * lane);
        }
#pragma unroll
        for (int j = 0; j < 16; ++j) {
#pragma unroll
          for (int c = 0; c < 4; ++c) {
            const u32 w = va[j][c];
            const f32x2_t cc2 = {cc[j], cc[j]};
            const f32x2_t fa = {(float)(w & 0xffu), (float)((w >> 8) & 0xffu)};
            const f32x2_t fb = {(float)((w >> 16) & 0xffu), (float)(w >> 24)};
            ov2[2 * c] = __builtin_elementwise_fma(cc2, fa, ov2[2 * c]);
            ov2[2 * c + 1] = __builtin_elementwise_fma(cc2, fb, ov2[2 * c + 1]);
          }
        }
      }
    }
    const float corr = 128.f * csum;
    f32x4* op = (f32x4*)(p.out + (size_t)tok * DM + 16 * lane);
#pragma unroll
    for (int c = 0; c < 4; ++c) {
      f32x4 x = op[c];
      x[0] += ov2[2 * c][0] - corr; x[1] += ov2[2 * c][1] - corr; x[2] += ov2[2 * c + 1][0] - corr; x[3] += ov2[2 * c + 1][1] - corr;
      if (!(p.flags & 32) || x[0] == 1.2345678e30f) op[c] = x;
    }
  }
}

__device__ __forceinline__ void grid_barrier(unsigned* ctr, unsigned target) {
  asm volatile("s_waitcnt vmcnt(0)" ::: "memory");
  __syncthreads();
  if (TIDX == 0) {
    __builtin_amdgcn_fence(__ATOMIC_RELEASE, "agent");
    asm volatile("s_waitcnt vmcnt(0)" ::: "memory");
    __hip_atomic_fetch_add(ctr, 1u, __ATOMIC_RELAXED, __HIP_MEMORY_SCOPE_AGENT);
    while (__hip_atomic_load(ctr, __ATOMIC_RELAXED, __HIP_MEMORY_SCOPE_AGENT) < target) __builtin_amdgcn_s_sleep(2);
    __builtin_amdgcn_fence(__ATOMIC_ACQUIRE, "agent");
    asm volatile("s_waitcnt vmcnt(0)" ::: "memory");
  }
  __syncthreads();
}

__global__ void __launch_bounds__(NTHREADS, 2) mk_fwd(Params p) {
  cg::grid_group grid = cg::this_grid();
  __shared__ __attribute__((aligned(16))) unsigned char smem[SMEM_BYTES];
  const int lo = p.ph_lo, hi = p.ph_hi;
#define RUN(k, call) if (lo <= (k) && (k) < hi) { call; if ((k) + 1 < hi) { if ((k) == lo) grid.sync(); else grid_barrier((unsigned*)p.ws, (unsigned)((k) - lo) * gridDim.x); } }
  RUN(0, phase0(p, smem))
  RUN(1, phase1(p, smem))
  RUN(2, phase2(p, smem))
  RUN(3, phase3(p, smem))
  RUN(4, phase4(p, smem))
  RUN(5, phase5(p, smem))
  RUN(6, rmsnorm_rows(p.out, p.in[12], (u16*)(p.ws + OFF_H2)))
  RUN(7, phase6(p, smem))
  RUN(8, phase7(p, smem))
  RUN(9, phase7b(p))
  RUN(10, phase8(p))
#undef RUN
}

extern "C" void kernel_launch(void* const* d_in, const int* in_sizes, int n_in,
                              void* d_out, int out_size, void* d_ws, size_t ws_size,
                              hipStream_t stream) {
  static int grid_blocks = 0;
  if (!grid_blocks) {
    int dev = 0, cus = 0, per_cu = 0;
    (void)hipGetDevice(&dev);
    (void)hipDeviceGetAttribute(&cus, hipDeviceAttributeMultiprocessorCount, dev);
    (void)hipOccupancyMaxActiveBlocksPerMultiprocessor(&per_cu, mk_fwd, NTHREADS, 0);
    if (per_cu < 1) per_cu = 1;
    if (per_cu > 1) per_cu = 1;
    grid_blocks = cus * per_cu;
    fprintf(stderr, "mk_fwd: cus=%d per_cu=%d grid=%d ws=%zu\n", cus, per_cu, grid_blocks, ws_size);
  }
  Params p{};
  for (int i = 0; i < 17 && i < n_in; ++i) p.in[i] = (const float*)d_in[i];
  p.out = (float*)d_out;
  p.ws = (unsigned char*)d_ws;
  p.ph_lo = 0; p.ph_hi = 11;
  (void)hipMemsetAsync(d_ws, 0, 4096, stream);
  void* args[] = {&p};
  hipError_t e = hipLaunchCooperativeKernel((void*)mk_fwd, dim3(grid_blocks), dim3(NTHREADS), args, 0, stream);
  if (e != hipSuccess) fprintf(stderr, "cooperative launch failed: %s (grid %d)\n", hipGetErrorString(e), grid_blocks);
#ifdef EXTRA_LO
  {
    Params p2 = p;
    p2.ph_lo = EXTRA_LO; p2.ph_hi = EXTRA_HI; p2.flags = EXTRA_FLAGS;
    void* args2[] = {&p2};
    (void)hipLaunchCooperativeKernel((void*)mk_fwd, dim3(grid_blocks), dim3(NTHREADS), args2, 0, stream);
  }
#endif
}
```

```cpp
#include <hip/hip_runtime.h>
#include <hip/hip_bf16.h>
#include <hip/hip_cooperative_groups.h>
#include <cstdio>
#include <cstdint>
namespace cg = cooperative_groups;

typedef unsigned short u16;
typedef unsigned int u32;
typedef unsigned char u8;
typedef short bf16x8 __attribute__((ext_vector_type(8)));
typedef float f32x4 __attribute__((ext_vector_type(4)));
typedef unsigned int u32x4 __attribute__((ext_vector_type(4)));
typedef unsigned int u32x2 __attribute__((ext_vector_type(2)));

constexpr int NTHREADS = 512;
constexpr int BATCH = 8, SEQ = 4096, DM = 1024, MTOK = BATCH * SEQ;
constexpr int LDP = 5120;
constexpr int NPADW = 5632;
constexpr int C_AQ = 0, C_IQ = 512, C_DQ = 1024, C_DK = 1536, C_DV = 2048, C_DZ = 2560, C_GA = 3072, C_GB = 4096;
constexpr int N_AK = 5120, N_AV = 5248, N_IK = 5376, N_SM = 5440;
constexpr size_t MiB = 1ull << 20;
constexpr size_t OFF_WTIN = 1 * MiB, OFF_WTA = 12 * MiB, OFF_WTB = 13 * MiB, OFF_WTO = 14 * MiB, OFF_WTQ = 16 * MiB,
                 OFF_SKB = 20 * MiB, OFF_SMALL = 21 * MiB, OFF_H = 23 * MiB, OFF_ATT = 23 * MiB, OFF_GC = 39 * MiB,
                 OFF_MERGED = 23 * MiB, OFF_PROJ = 87 * MiB, OFF_KVC = 407 * MiB, OFF_IKC = 423 * MiB, OFF_SEL = 427 * MiB, OFF_YATT = 443 * MiB,
                 OFF_YDN = 475 * MiB;
constexpr size_t OFF_H2 = OFF_PROJ, OFF_QP = OFF_PROJ + 64 * MiB, OFF_TOPS = OFF_PROJ + 192 * MiB,
                 OFF_TOPI = OFF_PROJ + 224 * MiB, OFF_EXPERT = OFF_PROJ + 232 * MiB, OFF_GATE = OFF_PROJ + 248 * MiB;
constexpr size_t OFF_UQ = OFF_PROJ + 264 * MiB, OFF_VQ = OFF_PROJ + 280 * MiB, OFF_US = OFF_PROJ + 296 * MiB, OFF_VS = OFF_PROJ + 297 * MiB;
constexpr size_t DO_U = 0, DO_W = 32 * MiB, DO_QN = 64 * MiB, DO_KNT = 96 * MiB;

constexpr int SMEM_BYTES = 162816;
constexpr float EPS = 1e-6f;

struct Params {
  const float* in[17];
  float* out;
  unsigned char* ws;
  int ph_lo, ph_hi;
  int flags, pad;
};

typedef __bf16 bf16x2_t __attribute__((ext_vector_type(2)));
typedef float f32x2_t __attribute__((ext_vector_type(2)));
__device__ __forceinline__ u32 pack2(float a, float b) {
  f32x2_t f = {a, b};
  return __builtin_bit_cast(u32, __builtin_convertvector(f, bf16x2_t));
}
__device__ __forceinline__ u16 f2bf(float f) { return (u16)(pack2(f, f) & 0xffffu); }
__device__ __forceinline__ float bf2f(u16 h) { return __uint_as_float(((u32)h) << 16); }
__device__ __forceinline__ float bflo(u32 w) { return __uint_as_float(w << 16); }
__device__ __forceinline__ float bfhi(u32 w) { return __uint_as_float(w & 0xffff0000u); }
__device__ __forceinline__ float wave_sum(float v) {
#pragma unroll
  for (int o = 32; o > 0; o >>= 1) v += __shfl_xor(v, o);
  return v;
}
__device__ __forceinline__ float wave_max(float v) {
#pragma unroll
  for (int o = 32; o > 0; o >>= 1) v = fmaxf(v, __shfl_xor(v, o));
  return v;
}
__device__ __forceinline__ float dot2bf(u32 a, u32 b, float acc) {
  return __builtin_amdgcn_fdot2_f32_bf16(__builtin_bit_cast(bf16x2_t, a), __builtin_bit_cast(bf16x2_t, b), acc, false);
}
#define DPPF(v, ctrl) __int_as_float(__builtin_amdgcn_update_dpp(0, __float_as_int(v), ctrl, 0xf, 0xf, true))
__device__ __forceinline__ float wave_sum_dpp(float v) {
  v += DPPF(v, 0xb1);
  v += DPPF(v, 0x4e);
  v += DPPF(v, 0x124);
  v += DPPF(v, 0x128);
  float r0 = __int_as_float(__builtin_amdgcn_readlane(__float_as_int(v), 0));
  float r1 = __int_as_float(__builtin_amdgcn_readlane(__float_as_int(v), 16));
  float r2 = __int_as_float(__builtin_amdgcn_readlane(__float_as_int(v), 32));
  float r3 = __int_as_float(__builtin_amdgcn_readlane(__float_as_int(v), 48));
  return (r0 + r1) + (r2 + r3);
}
__device__ __forceinline__ int opaque_tid() { int t = threadIdx.x; asm volatile("" : "+v"(t)); return t; }
#define TIDX opaque_tid()
#define DPPI(v, ctrl) __builtin_amdgcn_update_dpp(0, (v), ctrl, 0xf, 0xf, true)
__device__ __forceinline__ int wave_sum_i_dpp(int v) {
  v += DPPI(v, 0xb1);
  v += DPPI(v, 0x4e);
  v += DPPI(v, 0x124);
  v += DPPI(v, 0x128);
  return (__builtin_amdgcn_readlane(v, 0) + __builtin_amdgcn_readlane(v, 16)) +
         (__builtin_amdgcn_readlane(v, 32) + __builtin_amdgcn_readlane(v, 48));
}
__device__ __forceinline__ float wave_max_dpp(float v) {
  v = fmaxf(v, DPPF(v, 0xb1));
  v = fmaxf(v, DPPF(v, 0x4e));
  v = fmaxf(v, DPPF(v, 0x124));
  v = fmaxf(v, DPPF(v, 0x128));
  float r0 = __int_as_float(__builtin_amdgcn_readlane(__float_as_int(v), 0));
  float r1 = __int_as_float(__builtin_amdgcn_readlane(__float_as_int(v), 16));
  float r2 = __int_as_float(__builtin_amdgcn_readlane(__float_as_int(v), 32));
  float r3 = __int_as_float(__builtin_amdgcn_readlane(__float_as_int(v), 48));
  return fmaxf(fmaxf(r0, r1), fmaxf(r2, r3));
}
#define WAVE_LDS_SYNC() asm volatile("s_waitcnt lgkmcnt(0)" ::: "memory")
__device__ __forceinline__ float sigmoidf_(float x) { return __builtin_amdgcn_rcpf(1.f + __expf(-x)); }
__device__ __forceinline__ int perm32(int k) {
  int blk = k & ~31, r = k & 31;
  int p = (r < 16) ? (8 * (r >> 2) + (r & 3)) : (8 * ((r - 16) >> 2) + 4 + (r & 3));
  return blk + p;
}

__device__ __forceinline__ int g8_logical_col(int t) { return ((t & 127) >> 5) * 64 + (t >> 7) * 32 + (t & 31); }
__device__ __forceinline__ int win_map(int n) {
  if (n < 512) return n;
  if (n < 1024) return 768 + (n - 512);
  if (n < 3072) return 1352 + (n - 1024);
  if (n < 5120) return 3408 + (n - 3072);
  if (n < 5248) return 512 + (n - 5120);
  if (n < 5376) return 640 + (n - 5248);
  if (n < 5440) return 1280 + (n - 5376);
  if (n < 5448) return 1344 + (n - 5440);
  if (n < 5452) return 3400 + (n - 5448);
  if (n < 5456) return 3404 + (n - 5452);
  return -1;
}
__device__ __forceinline__ void transpose_tile(const float* __restrict__ src, int Nsrc, u16* __restrict__ dst, int K, int k0, int n0,
                               bool mapped, bool perm8, float* tile  ) {
  const int tid = TIDX;
  {
    const int tx = tid & 63, ty = tid >> 6;
    int n = n0 + tx;
    if (perm8) n = (n & ~255) + g8_logical_col(n & 255);
    int sc = mapped ? win_map(n) : n;
#pragma unroll
    for (int i = 0; i < 8; ++i) {
      int k = ty + 8 * i;
      float v = (sc >= 0) ? src[(size_t)(k0 + k) * Nsrc + sc] : 0.f;
      tile[k * 65 + tx] = v;
    }
  }
  __syncthreads();
  {
    const int n = tid >> 3, kc = (tid & 7) * 8;
    u32 w[4];
#pragma unroll
    for (int j = 0; j < 4; ++j) w[j] = pack2(tile[(kc + 2 * j) * 65 + n], tile[(kc + 2 * j + 1) * 65 + n]);
    *(uint4*)(dst + (size_t)(n0 + n) * K + k0 + kc) = make_uint4(w[0], w[1], w[2], w[3]);
  }
  __syncthreads();
}

__device__ __forceinline__ void rmsnorm_rows(const float* __restrict__ x, const float* __restrict__ gain, u16* __restrict__ out) {
  const int lane = TIDX & 63, wave = TIDX >> 6;
  float4 g[4];
#pragma unroll
  for (int i = 0; i < 4; ++i) g[i] = ((const float4*)gain)[lane + 64 * i];
  for (int row = blockIdx.x * 8 + wave; row < MTOK; row += gridDim.x * 8) {
    const float4* xr = (const float4*)(x + (size_t)row * DM);
    float4 v[4];
    float ss = 0.f;
#pragma unroll
    for (int i = 0; i < 4; ++i) {
      v[i] = xr[lane + 64 * i];
      ss += v[i].x * v[i].x + v[i].y * v[i].y + v[i].z * v[i].z + v[i].w * v[i].w;
    }
    ss = wave_sum(ss);
    float r = rsqrtf(ss * (1.f / DM) + EPS);
#pragma unroll
    for (int i = 0; i < 4; ++i) {
      uint2 o;
      o.x = pack2(v[i].x * r * g[i].x, v[i].y * r * g[i].y);
      o.y = pack2(v[i].z * r * g[i].z, v[i].w * r * g[i].w);
      *(uint2*)(out + (size_t)row * DM + 4 * (lane + 64 * i)) = o;
    }
  }
}

__device__ __forceinline__ void phase0(const Params& p, unsigned char* smem) {
  float* tile = (float*)smem;
  unsigned char* ws = p.ws;
  const int n_in = 16 * 88, n_a = 8 * 16, n_b = 8 * 16, n_o = 16 * 16, n_q = 16 * 32;
  const int total = n_in + n_a + n_b + n_o + n_q;
  for (int t = blockIdx.x; t < total; t += gridDim.x) {
    int i = t;
    if (i < n_in) { transpose_tile(p.in[2], 5456, (u16*)(ws + OFF_WTIN), 1024, (i / 88) * 64, (i % 88) * 64, true, true, tile); continue; }
    i -= n_in;
    if (i < n_a) { transpose_tile(p.in[9], 1024, (u16*)(ws + OFF_WTA), 512, (i / 16) * 64, (i % 16) * 64, false, false, tile); continue; }
    i -= n_a;
    if (i < n_b) { transpose_tile(p.in[10], 1024, (u16*)(ws + OFF_WTB), 512, (i / 16) * 64, (i % 16) * 64, false, false, tile); continue; }
    i -= n_b;
    if (i < n_o) { transpose_tile(p.in[11], 1024, (u16*)(ws + OFF_WTO), 1024, (i / 16) * 64, (i % 16) * 64, false, true, tile); continue; }
    i -= n_o;
    transpose_tile(p.in[13], 2048, (u16*)(ws + OFF_WTQ), 1024, (i / 32) * 64, (i % 32) * 64, false, true, tile);
  }
  {
    const float* sk = p.in[14];
    u16* skb = (u16*)(ws + OFF_SKB);
    for (int i = blockIdx.x * NTHREADS + TIDX; i < 16 * 128 * 128; i += gridDim.x * NTHREADS) skb[i] = f2bf(sk[i]);
  }
  rmsnorm_rows(p.in[0], p.in[1], (u16*)(ws + OFF_H));
}

constexpr int G_BM = 256, G_BN = 128, G_BK = 64;
constexpr int G_ABYTES = G_BM * 128;

template <int MI>
__device__ __forceinline__ void gemm_mainloop_t(const u16* __restrict__ A, int lda, const u16* __restrict__ Bt, int ldb, int K,
                                                int m0, int n0, unsigned char* smem, f32x4 (&acc)[MI][4]) {
  constexpr int BN = (MI == 4) ? 128 : 256;
  constexpr int NRB = BN / 64;
  constexpr int STAGE = G_ABYTES + BN * 128;
  const int tid = TIDX, lane = tid & 63, wave = tid >> 6;
  const int wm = (MI == 4) ? (wave >> 1) : (wave >> 2), wn = (MI == 4) ? (wave & 1) : (wave & 3);
#pragma unroll
  for (int i = 0; i < MI; ++i)
#pragma unroll
    for (int j = 0; j < 4; ++j) acc[i][j] = (f32x4){0.f, 0.f, 0.f, 0.f};
  const int kc = tid & 7;
  const int arow = tid >> 3;
  u32x4 ra[4], rb[NRB];
  const u16* ap = A + (size_t)(m0 + arow) * lda + kc * 8;
  const u16* bp = Bt + (size_t)(n0 + arow) * ldb + kc * 8;
  const int nk = K / G_BK;
  const int fr = lane & 15, fg = lane >> 4;
#define G_LOAD(kt_)                                                                       \
  {                                                                                       \
    const u16* ap2_ = ap + (size_t)(kt_) * G_BK;                                          \
    const u16* bp2_ = bp + (size_t)(kt_) * G_BK;                                          \
    _Pragma("unroll") for (int i = 0; i < 4; ++i) ra[i] = *(const u32x4*)(ap2_ + (size_t)(64 * i) * lda); \
    _Pragma("unroll") for (int i = 0; i < NRB; ++i) rb[i] = *(const u32x4*)(bp2_ + (size_t)(64 * i) * ldb); \
  }
#define G_STORE(st_)                                                                      \
  {                                                                                       \
    unsigned char* sa_ = smem + (st_) * STAGE;                                            \
    unsigned char* sb_ = sa_ + G_ABYTES;                                                  \
    _Pragma("unroll") for (int i = 0; i < 4; ++i) { int r = arow + 64 * i; *(u32x4*)(sa_ + r * 128 + ((kc ^ (r & 7)) << 4)) = ra[i]; } \
    _Pragma("unroll") for (int i = 0; i < NRB; ++i) { int r = arow + 64 * i; *(u32x4*)(sb_ + r * 128 + ((kc ^ (r & 7)) << 4)) = rb[i]; } \
  }
  G_LOAD(0)
  __syncthreads();
  G_STORE(0)
  if (nk > 1) G_LOAD(1)
  __syncthreads();
  for (int kt = 0; kt < nk; ++kt) {
    if (kt + 1 < nk) G_STORE((kt + 1) & 1)
    if (kt + 2 < nk) G_LOAD(kt + 2)
    __builtin_amdgcn_sched_barrier(0);
    const unsigned char* sa = smem + (kt & 1) * STAGE;
    const unsigned char* sb = sa + G_ABYTES;
#pragma unroll
    for (int kk = 0; kk < 2; ++kk) {
      bf16x8 bfr[4];
#pragma unroll
      for (int j = 0; j < 4; ++j) {
        int r = wn * 64 + j * 16 + fr;
        bfr[j] = *(const bf16x8*)(sb + r * 128 + (((kk * 4 + fg) ^ (r & 7)) << 4));
      }
#pragma unroll
      for (int ih = 0; ih < MI; ih += 4) {
        bf16x8 af[4];
#pragma unroll
        for (int i = 0; i < 4; ++i) {
          int r = wm * (MI * 16) + (ih + i) * 16 + fr;
          af[i] = *(const bf16x8*)(sa + r * 128 + (((kk * 4 + fg) ^ (r & 7)) << 4));
        }
#pragma unroll
        for (int i = 0; i < 4; ++i)
#pragma unroll
          for (int j = 0; j < 4; ++j) acc[ih + i][j] = __builtin_amdgcn_mfma_f32_16x16x32_bf16(af[i], bfr[j], acc[ih + i][j], 0, 0, 0);
        if (MI == 8 && ih == 0) __builtin_amdgcn_sched_barrier(0);
      }
    }
    __syncthreads();
  }
#undef G_LOAD
#undef G_STORE
}
__device__ __forceinline__ void gemm_mainloop(const u16* __restrict__ A, int lda, const u16* __restrict__ Bt, int ldb, int K,
                                              int m0, int n0, unsigned char* smem, f32x4 (&acc)[4][4]) {
  gemm_mainloop_t<4>(A, lda, Bt, ldb, K, m0, n0, smem, acc);
}

__device__ __forceinline__ int g8_lds_byte(int r, int c) {
  int st = (r >> 4) * 2 + (c >> 5), rr = r & 15, cc = c & 31, ob = rr * 64 + cc * 2;
  return st * 1024 + (ob ^ (((ob >> 9) & 1) << 5));
}
__device__ __forceinline__ void g8_stage_rc(int b, int& R, int& C) {
  int st = b / 1024, sb = b % 1024, swz = sb ^ (((sb >> 9) & 1) << 5);
  R = (st >> 1) * 16 + swz / 64; C = (st & 1) * 32 + (swz % 64) / 2;
}
typedef __attribute__((address_space(3))) unsigned int lds_u32;
__device__ __forceinline__ void gemm8_tile(const u16* __restrict__ A, const u16* __restrict__ Bt, int K, int brow, int bcol,
                                           unsigned char* smem, f32x4 (&acc)[2][2][4][2]) {
  constexpr int HTB = 16384;
  const int tid = TIDX;
  const int wid = tid >> 6, lane = tid & 63, wr = wid >> 2, wc = wid & 3, fr = lane & 15, fq = lane >> 4;
#define SA(b, h) (smem + ((b) * 2 + (h)) * HTB)
#define SB(b, h) (smem + (4 + (b) * 2 + (h)) * HTB)
#define STAGE(P, BASE, br, kt) do { const long _g = (long)(br) * K + (long)(kt) * 64; \
    _Pragma("unroll") for (int _i = 0; _i < 2; ++_i) { int _b = tid * 16 + _i * 8192; int _r, _c; g8_stage_rc(_b, _r, _c); \
      __builtin_amdgcn_global_load_lds((const unsigned int*)(BASE + _g + (long)_r * K + _c), \
        (lds_u32*)((P) + _b), 16, 0, 0); } } while (0)
#define LDA(dst, b, h) _Pragma("unroll") for (int m = 0; m < 4; ++m) _Pragma("unroll") for (int k = 0; k < 2; ++k) \
    dst[m][k] = *(const bf16x8*)(SA(b, h) + g8_lds_byte(wr * 64 + m * 16 + fr, k * 32 + fq * 8))
#define LDB(dst, b, h) _Pragma("unroll") for (int n = 0; n < 2; ++n) _Pragma("unroll") for (int k = 0; k < 2; ++k) \
    dst[n][k] = *(const bf16x8*)(SB(b, h) + g8_lds_byte(wc * 32 + n * 16 + fr, k * 32 + fq * 8))
#define MMA(ai, bj, At_, Bt_) do { __builtin_amdgcn_s_setprio(1); \
    _Pragma("unroll") for (int m = 0; m < 4; ++m) _Pragma("unroll") for (int n = 0; n < 2; ++n) _Pragma("unroll") for (int k = 0; k < 2; ++k) \
      acc[ai][bj][m][n] = __builtin_amdgcn_mfma_f32_16x16x32_bf16(At_[m][k], Bt_[n][k], acc[ai][bj][m][n], 0, 0, 0); \
    __builtin_amdgcn_s_setprio(0); } while (0)
#define WAIT_V(n) asm volatile("s_waitcnt vmcnt(" #n ")" ::: "memory")
#define WAIT_L(n) asm volatile("s_waitcnt lgkmcnt(" #n ")" ::: "memory")
#define BAR __builtin_amdgcn_s_barrier()
#define SCHED __builtin_amdgcn_sched_barrier(0)
#pragma unroll
  for (int a = 0; a < 2; ++a)
#pragma unroll
    for (int b2 = 0; b2 < 2; ++b2)
#pragma unroll
      for (int m = 0; m < 4; ++m)
#pragma unroll
        for (int n = 0; n < 2; ++n) acc[a][b2][m][n] = (f32x4){0.f, 0.f, 0.f, 0.f};
  bf16x8 At[4][2], B0[2][2], B1[2][2];
  const int nt = K / 64;
  constexpr int HALF = 128;
  __syncthreads();
  STAGE(SB(0, 0), Bt, bcol, 0); STAGE(SA(0, 0), A, brow, 0);
  STAGE(SB(0, 1), Bt, bcol + HALF, 0); STAGE(SA(0, 1), A, brow + HALF, 0);
  if (wr == 1) BAR;
  WAIT_V(4); BAR;
  STAGE(SB(1, 0), Bt, bcol, 1); STAGE(SA(1, 0), A, brow, 1); STAGE(SB(1, 1), Bt, bcol + HALF, 1);
  WAIT_V(6); BAR;
  for (int t = 0; t < nt - 2; t += 2) {
    LDB(B0, 0, 0); SCHED; LDA(At, 0, 0); STAGE(SA(1, 1), A, brow + HALF, t + 1);
    WAIT_L(8); BAR; WAIT_L(0); MMA(0, 0, At, B0); BAR; SCHED;
    LDB(B1, 0, 1); STAGE(SB(0, 0), Bt, bcol, t + 2);
    BAR; WAIT_L(0); MMA(0, 1, At, B1); BAR;
    LDA(At, 0, 1); STAGE(SA(0, 0), A, brow, t + 2);
    BAR; WAIT_L(0); MMA(1, 0, At, B0); BAR; SCHED;
    STAGE(SB(0, 1), Bt, bcol + HALF, t + 2);
    WAIT_V(6); BAR; MMA(1, 1, At, B1); BAR;
    LDB(B0, 1, 0); SCHED; LDA(At, 1, 0); STAGE(SA(0, 1), A, brow + HALF, t + 2);
    WAIT_L(8); BAR; WAIT_L(0); MMA(0, 0, At, B0); BAR; SCHED;
    LDB(B1, 1, 1); STAGE(SB(1, 0), Bt, bcol, t + 3);
    BAR; WAIT_L(0); MMA(0, 1, At, B1); BAR;
    LDA(At, 1, 1); STAGE(SA(1, 0), A, brow, t + 3);
    BAR; WAIT_L(0); MMA(1, 0, At, B0); BAR; SCHED;
    STAGE(SB(1, 1), Bt, bcol + HALF, t + 3);
    WAIT_V(6); BAR; MMA(1, 1, At, B1); BAR;
  }
  { LDB(B0, 0, 0); LDA(At, 0, 0); STAGE(SA(1, 1), A, brow + HALF, nt - 1);
    BAR; WAIT_L(0); MMA(0, 0, At, B0); BAR;
    LDB(B1, 0, 1); BAR; WAIT_L(0); MMA(0, 1, At, B1); BAR;
    LDA(At, 0, 1); WAIT_V(4); BAR; WAIT_L(0); MMA(1, 0, At, B0); MMA(1, 1, At, B1); BAR; }
  { LDB(B0, 1, 0); LDA(At, 1, 0); WAIT_V(2); BAR; WAIT_L(0); MMA(0, 0, At, B0); BAR;
    LDB(B1, 1, 1); WAIT_V(0); BAR; WAIT_L(0); MMA(0, 1, At, B1); BAR;
    LDA(At, 1, 1); BAR; WAIT_L(0); MMA(1, 0, At, B0); MMA(1, 1, At, B1); BAR; }
  if (wr == 0) BAR;
#undef SA
#undef SB
#undef STAGE
#undef LDA
#undef LDB
#undef MMA
#undef WAIT_V
#undef WAIT_L
#undef BAR
#undef SCHED
}

template <int LD, bool NORM>
__device__ __forceinline__ void ep_store(u16* __restrict__ dst, u32 ob, const f32x4 (&acc)[2][2][4][2], const float* __restrict__ gain,
                                         float extra, unsigned char* smem, int wave, int lane_in) {
  int lane = lane_in;
  asm volatile("" : "+v"(lane));
  const int fr = lane & 15, fq = lane >> 4;
  unsigned char* reg = smem + wave * 16384;
  float gj[4] = {1.f, 1.f, 1.f, 1.f};
  if (NORM) {
#pragma unroll
    for (int j = 0; j < 4; ++j) gj[j] = gain[j * 16 + fr] * extra;
  }
  const int lrot = (fr >> 3) + 2 * fq;
  unsigned char* wbase = reg + (4 * fq) * 128 + (fr & 7) * 2;
#pragma unroll
  for (int ai = 0; ai < 2; ++ai)
#pragma unroll
    for (int m = 0; m < 4; ++m) {
#pragma unroll
      for (int r = 0; r < 4; ++r) {
        float rs = 1.f;
        if (NORM) {
          float sq = 0.f;
#pragma unroll
          for (int bj = 0; bj < 2; ++bj)
#pragma unroll
            for (int n = 0; n < 2; ++n) sq += acc[ai][bj][m][n][r] * acc[ai][bj][m][n][r];
          sq += DPPF(sq, 0xb1); sq += DPPF(sq, 0x4e); sq += DPPF(sq, 0x141); sq += DPPF(sq, 0x140);
          rs = rsqrtf(sq * (1.f / 64.f) + EPS);
        }
#pragma unroll
        for (int bj = 0; bj < 2; ++bj)
#pragma unroll
          for (int n = 0; n < 2; ++n) {
            const float v = acc[ai][bj][m][n][r];
            const int ch = ((bj * 2 + n) * 2 + lrot) & 7;
            *(u16*)(wbase + (ai * 64 + m * 16 + r) * 128 + (ch << 4)) = f2bf(NORM ? v * rs * gj[bj * 2 + n] : v);
          }
      }
      __builtin_amdgcn_sched_barrier(0);
    }
  WAVE_LDS_SYNC();
  const int c16 = lane & 7, r8 = lane >> 3;
#pragma unroll
  for (int it = 0; it < 16; ++it) {
    const int rw = it * 8 + r8;
    const u32x4 v = *(const u32x4*)(reg + rw * 128 + (((c16 + 2 * ((rw >> 2) & 3)) & 7) << 4));
    const int grow = (it >> 3) * 128 + (it & 7) * 8 + r8;
    *(u32x4*)(dst + ob + (u32)(grow * LD + c16 * 8)) = v;
    if ((it & 3) == 3) __builtin_amdgcn_sched_barrier(0);
  }
}

__device__ __forceinline__ void phase1(const Params& p, unsigned char* smem) {
  const u16* H = (const u16*)(p.ws + OFF_H);
  const u16* WT = (const u16*)(p.ws + OFF_WTIN);
  u16* PROJ = (u16*)(p.ws + OFF_PROJ);
  u16* KVC = (u16*)(p.ws + OFF_KVC);
  u16* IKC = (u16*)(p.ws + OFF_IKC);
  float* SMALL = (float*)(p.ws + OFF_SMALL);
  const int lane = TIDX & 63, wave = TIDX >> 6;
  const int wr = wave >> 2, wc = wave & 3, fr = lane & 15, fq = lane >> 4;
  const int ntn = NPADW / 256;
  const int ntiles = (MTOK / 256) * ntn;
  for (int t = blockIdx.x; t < ntiles; t += gridDim.x) {
    const int m0 = (t / ntn) * 256, n0 = (t % ntn) * 256;
    f32x4 acc[2][2][4][2];
    gemm8_tile(H, WT, DM, m0, n0, smem, acc);
    const int cbase = n0 + wc * 64;
    const u32 rbase = (u32)(m0 + wr * 64);
    if (cbase < C_IQ) {
      ep_store<LDP, true>(PROJ, rbase * LDP + (u32)cbase, acc, p.in[3], 0.125f, smem, wave, lane);
    } else if (cbase < LDP) {
      ep_store<LDP, false>(PROJ, rbase * LDP + (u32)cbase, acc, nullptr, 1.f, smem, wave, lane);
    } else if (cbase < N_AV) {
      ep_store<256, true>(KVC, rbase * 256 + (u32)(cbase - N_AK), acc, p.in[4], 1.f, smem, wave, lane);
    } else if (cbase < N_IK) {
      ep_store<256, false>(KVC, rbase * 256 + (u32)(cbase - N_AV + 128), acc, nullptr, 1.f, smem, wave, lane);
    } else if (cbase < N_SM) {
      ep_store<64, false>(IKC, rbase * 64, acc, nullptr, 1.f, smem, wave, lane);
    } else if (cbase == N_SM) {
      const u32 sb0 = (rbase + 4 * fq) * 16 + (u32)fr;
#pragma unroll
      for (int ai = 0; ai < 2; ++ai)
#pragma unroll
        for (int m = 0; m < 4; ++m)
#pragma unroll
          for (int r = 0; r < 4; ++r) SMALL[sb0 + (u32)((ai * 128 + m * 16 + r) * 16)] = acc[ai][0][m][0][r];
    }
  }
}

constexpr int IDX_RS = 8208;

__device__ __forceinline__ u32 f2key(float x) {
  _Float16 h = (_Float16)x;
  u32 b = (u32) * (u16*)&h;
  return (b & 0x8000u) ? ((~b) & 0xffffu) : (b | 0x8000u);
}
__device__ __forceinline__ int count_ge_wave(const u32 (&kreg)[32], u32 mid) {
  const u32 m1 = (mid - 1u) * 0x00010001u;
  const u32 one = 0x00010001u;
  u32 acc0 = 0u, acc1 = 0u;
#pragma unroll
  for (int i = 0; i < 32; i += 2) {
    u32 t0, t1;
    asm("v_pk_sub_u16 %0, %1, %2 clamp" : "=v"(t0) : "v"(kreg[i]), "s"(m1));
    asm("v_pk_sub_u16 %0, %1, %2 clamp" : "=v"(t1) : "v"(kreg[i + 1]), "s"(m1));
    asm("v_pk_min_u16 %0, %1, %2" : "=v"(t0) : "v"(t0), "s"(one));
    asm("v_pk_min_u16 %0, %1, %2" : "=v"(t1) : "v"(t1), "s"(one));
    asm("v_pk_add_u16 %0, %1, %2" : "=v"(acc0) : "v"(acc0), "v"(t0));
    asm("v_pk_add_u16 %0, %1, %2" : "=v"(acc1) : "v"(acc1), "v"(t1));
  }
  int c = (int)((acc0 & 0xffffu) + (acc0 >> 16) + (acc1 & 0xffffu) + (acc1 >> 16));
  return wave_sum_i_dpp(c);
}

__device__ __forceinline__ void idx_item(const Params& p, unsigned char* smem, int b, int tq) {
  const u16* PROJ = (const u16*)(p.ws + OFF_PROJ);
  const float* SMALL = (const float*)(p.ws + OFF_SMALL);
  u16* SEL = (u16*)(p.ws + OFF_SEL);
  const int tid = TIDX, lane = tid & 63, wave = tid >> 6;
  const int t0 = tq * 16;
  const size_t tokb = (size_t)b * SEQ;
  if (tq < 16) {
    for (int rr = 0; rr < 2; ++rr) {
      int row = 2 * wave + rr, t = t0 + row;
      u16* out = SEL + (tokb + t) * 256;
      for (int i = lane; i < 256; i += 64) out[i] = (i <= t) ? (u16)i : (u16)0xFFFF;
    }
    return;
  }
  const int q = lane & 15, g = lane >> 4;
  __syncthreads();
  {
    const u16* iqrow = PROJ + (tokb + t0 + q) * LDP + C_IQ;
    bf16x8 bq[8][2];
    float wq[8];
#pragma unroll
    for (int h = 0; h < 8; ++h) {
      bq[h][0] = *(const bf16x8*)(iqrow + h * 64 + g * 8);
      bq[h][1] = *(const bf16x8*)(iqrow + h * 64 + 32 + g * 8);
      wq[h] = SMALL[(tokb + t0 + q) * 16 + h];
    }
    const int nkb = tq + 1;
    const int niter = (nkb > wave) ? ((nkb - wave + 7) >> 3) : 0;
    const u16* ikbase = (const u16*)(p.ws + OFF_IKC) + (tokb + q) * 64 + g * 8;
    bf16x8 ca[3][2];
#pragma unroll
    for (int j = 0; j < 3; ++j)
      if (j < niter) {
        const u16* ikrow = ikbase + (size_t)((wave + 8 * j) * 16) * 64;
        ca[j][0] = *(const bf16x8*)(ikrow); ca[j][1] = *(const bf16x8*)(ikrow + 32);
      }
    for (int i0 = 0; i0 < ((p.flags & 8) ? 0 : niter); i0 += 3) {
#pragma unroll
      for (int j = 0; j < 3; ++j) {
        if (i0 + j < niter) {
          const int s0 = (wave + 8 * (i0 + j)) * 16;
          f32x4 tot = {0.f, 0.f, 0.f, 0.f};
#pragma unroll
          for (int h = 0; h < 8; ++h) {
            f32x4 acc = {0.f, 0.f, 0.f, 0.f};
            acc = __builtin_amdgcn_mfma_f32_16x16x32_bf16(ca[j][0], bq[h][0], acc, 0, 0, 0);
            acc = __builtin_amdgcn_mfma_f32_16x16x32_bf16(ca[j][1], bq[h][1], acc, 0, 0, 0);
#pragma unroll
            for (int r = 0; r < 4; ++r) tot[r] += wq[h] * fmaxf(acc[r], 0.f);
          }
          if (i0 + 3 + j < niter) {
            const u16* ikrow = ikbase + (size_t)((wave + 8 * (i0 + 3 + j)) * 16) * 64;
            ca[j][0] = *(const bf16x8*)(ikrow); ca[j][1] = *(const bf16x8*)(ikrow + 32);
          }
          u32 k[4];
#pragma unroll
          for (int r = 0; r < 4; ++r) {
            int sidx = s0 + 4 * g + r;
            k[r] = (sidx <= t0 + q) ? f2key(tot[r]) : 0u;
          }
          u32x2 w2 = {k[0] | (k[1] << 16), k[2] | (k[3] << 16)};
          *(u32x2*)(smem + q * IDX_RS + (s0 + 4 * g) * 2) = w2;
        }
        __builtin_amdgcn_sched_barrier(0);
      }
    }
    const int nk = t0 + 16, nk64 = (nk + 63) & ~63;
    for (int i = tid; i < 16 * (nk64 - nk); i += NTHREADS) {
      int row = i / (nk64 - nk), c = nk + i % (nk64 - nk);
      *(u16*)(smem + row * IDX_RS + c * 2) = 0;
    }
  }
  __syncthreads();
  const int nk64 = (t0 + 16 + 63) & ~63;
  for (int rr = 0; rr < ((p.flags & 16) ? 0 : 2); ++rr) {
    const int row = 2 * wave + rr, t = t0 + row;
    u16* out = SEL + (tokb + t) * 256;
    u32 kreg[32];
    if (lane * 64 < nk64) {
      const uint4* src = (const uint4*)(smem + row * IDX_RS + lane * 128);
#pragma unroll
      for (int i = 0; i < 8; ++i) {
        uint4 v = src[i];
        kreg[4 * i] = v.x; kreg[4 * i + 1] = v.y; kreg[4 * i + 2] = v.z; kreg[4 * i + 3] = v.w;
      }
    } else {
#pragma unroll
      for (int i = 0; i < 32; ++i) kreg[i] = 0u;
    }
    WAVE_LDS_SYNC();
    u32 lo = 1u, hi = 65535u;
    while (lo < hi) {
      u32 mid = (lo + hi + 1u) >> 1;
      int c = count_ge_wave(kreg, mid);
      if (c >= 256) lo = mid; else hi = mid - 1u;
    }
    const u32 tau = lo;
    int gt = 0, eq = 0;
#pragma unroll
    for (int i = 0; i < 32; ++i) {
      u32 a = kreg[i] & 0xffffu, c2 = kreg[i] >> 16;
      gt += (a > tau) ? 1 : 0; gt += (c2 > tau) ? 1 : 0;
      eq += (a == tau) ? 1 : 0; eq += (c2 == tau) ? 1 : 0;
    }
    int packed = gt | (eq << 16);
    int incl = packed;
#pragma unroll
    for (int o = 1; o < 64; o <<= 1) {
      int v = __shfl_up(incl, o);
      if (lane >= o) incl += v;
    }
    const int excl = incl - packed;
    const int total = __shfl(incl, 63);
    const int need = 256 - (total & 0xffff);
    const int pg = excl & 0xffff, pe = excl >> 16;
    int pos = pg + min(pe, need);
    int eqseen = pe;
    u16* lrow = (u16*)(smem + row * IDX_RS);
#pragma unroll
    for (int i = 0; i < 32; ++i) {
#pragma unroll
      for (int hh = 0; hh < 2; ++hh) {
        u32 kv = hh ? (kreg[i] >> 16) : (kreg[i] & 0xffffu);
        int idx = lane * 64 + 2 * i + hh;
        bool take = false;
        if (kv > tau) take = true;
        else if (kv == tau) { take = (eqseen < need); ++eqseen; }
        if (take) { lrow[pos] = (u16)idx; ++pos; }
      }
    }
    WAVE_LDS_SYNC();
    *(u32x2*)(out + lane * 4) = *(const u32x2*)(lrow + lane * 4);
    WAVE_LDS_SYNC();
  }
}

constexpr int DNP = 68;
constexpr int DL_KT = 0;
constexpr int DL_V = DL_KT + 128 * DNP * 4;
constexpr int DL_QB = DL_V + 64 * 128 * 4;
constexpr int DL_KB = DL_QB + 64 * 272;
constexpr int DL_SM = DL_KB + 64 * 272;
constexpr int DL_RAW = DL_SM + 2048;
static_assert(DL_RAW + 3 * 67 * 272 <= SMEM_BYTES, "dn_local LDS");
__device__ __forceinline__ void dn_local_item(const Params& p, unsigned char* smem, int item) {
  const int h = item & 3, n = (item >> 2) & 63, b = item >> 8;
  const u16* PROJ = (const u16*)(p.ws + OFF_PROJ);
  const float* SMALL = (const float*)(p.ws + OFF_SMALL);
  u16* Ug = (u16*)((unsigned char*)p.out + DO_U);
  u16* Wg = (u16*)((unsigned char*)p.out + DO_W);
  u16* QNg = (u16*)((unsigned char*)p.out + DO_QN);
  u16* KNTg = (u16*)((unsigned char*)p.out + DO_KNT);
  u16* ATTg = (u16*)(p.ws + OFF_ATT);
  float* GCg = (float*)(p.ws + OFF_GC);
  const float* convw = p.in[5];
  const int tid = TIDX, lane = tid & 63, wave = tid >> 6;
  const int c0 = n * 64;
  const size_t tok0 = (size_t)b * SEQ + c0;
  float* Kt = (float*)(smem + DL_KT);
  float* V = (float*)(smem + DL_V);
  unsigned char* Qb = smem + DL_QB;
  unsigned char* Kb = smem + DL_KB;
  float* gc = (float*)(smem + DL_SM);
  float* beta = gc + 64;
  float* ssp = beta + 64;
  unsigned char* RAW = smem + DL_RAW;
  float* AmT = (float*)(smem + DL_RAW);
  __syncthreads();
  {
    u32x4 rg[7];
#pragma unroll
    for (int k = 0; k < 7; ++k) {
      const int ci = tid + 512 * k;
      rg[k] = (u32x4){0u, 0u, 0u, 0u};
      if (ci < 3216) {
        const int arr = ci / 1072, rem = ci - arr * 1072, row = rem >> 4, ch = rem & 15;
        const int trel = c0 - 3 + row;
        if (trel >= 0)
          rg[k] = *(const u32x4*)(PROJ + ((size_t)b * SEQ + trel) * LDP + (C_DQ + arr * 512) + h * 128 + ch * 8);
      }
    }
#pragma unroll
    for (int k = 0; k < 7; ++k) {
      const int ci = tid + 512 * k;
      if (ci < 3216) {
        const int arr = ci / 1072, rem = ci - arr * 1072, row = rem >> 4, ch = rem & 15;
        *(u32x4*)(RAW + (arr * 67 + row) * 272 + ch * 16) = rg[k];
      }
    }
  }
  if (tid < 64) {
    float da = SMALL[(tok0 + tid) * 16 + 8 + h], db = SMALL[(tok0 + tid) * 16 + 12 + h];
    float xx = da + p.in[7][h];
    float sp = fmaxf(xx, 0.f) + log1pf(__expf(-fabsf(xx)));
    float gr = -__expf(p.in[6][h]) * sp;
    float incl = gr;
#pragma unroll
    for (int o = 1; o < 64; o <<= 1) {
      float v = __shfl_up(incl, o);
      if (lane >= o) incl += v;
    }
    gc[tid] = incl;
    beta[tid] = sigmoidf_(db);
    GCg[(tok0 + tid) * 4 + h] = incl;
  }
  __syncthreads();
  {
    const int c = tid & 127, tg = tid >> 7;
    float qv[16], kv[16];
#pragma unroll
    for (int arr = 0; arr < 3; ++arr) {
      const float w0 = convw[0 * 1536 + arr * 512 + h * 128 + c], w1 = convw[1 * 1536 + arr * 512 + h * 128 + c],
                  w2 = convw[2 * 1536 + arr * 512 + h * 128 + c], w3 = convw[3 * 1536 + arr * 512 + h * 128 + c];
      const unsigned char* rp = RAW + (arr * 67 + tg * 16) * 272 + c * 2;
      float x0 = bf2f(*(const u16*)(rp)), x1 = bf2f(*(const u16*)(rp + 272)), x2 = bf2f(*(const u16*)(rp + 2 * 272));
#pragma unroll
      for (int ii = 0; ii < 16; ++ii) {
        const float x3 = bf2f(*(const u16*)(rp + (ii + 3) * 272));
        const float y = w0 * x0 + w1 * x1 + w2 * x2 + w3 * x3;
        const float sv = y * sigmoidf_(y);
        if (arr == 0) qv[ii] = sv;
        else if (arr == 1) kv[ii] = sv;
        else V[(tg * 16 + ii) * 128 + c] = sv;
        x0 = x1; x1 = x2; x2 = x3;
      }
    }
#pragma unroll
    for (int ii = 0; ii < 16; ++ii) {
      const float sq = wave_sum_dpp(qv[ii] * qv[ii]);
      const float sk = wave_sum_dpp(kv[ii] * kv[ii]);
      if (lane == 0) {
        ssp[((tg * 16 + ii) * 2) + (wave & 1)] = sq;
        ssp[128 + ((tg * 16 + ii) * 2) + (wave & 1)] = sk;
      }
    }
    __syncthreads();
#pragma unroll
    for (int ii = 0; ii < 16; ++ii) {
      const int i = tg * 16 + ii;
      const float qsc = rsqrtf(ssp[i * 2] + ssp[i * 2 + 1] + EPS) * 0.08838834764831845f;
      const float ksc = rsqrtf(ssp[128 + i * 2] + ssp[128 + i * 2 + 1] + EPS);
      const float qn = qv[ii] * qsc, kn = kv[ii] * ksc;
      *(u16*)(Qb + i * 272 + c * 2) = f2bf(qn);
      *(u16*)(Kb + i * 272 + c * 2) = f2bf(kn);
      Kt[c * DNP + i] = kn;
    }
  }
  __syncthreads();
#pragma unroll
  for (int k = 0; k < 4; ++k) {
    const int gi = tid + 512 * k;
    {
      const int i = gi >> 5, d4 = (gi & 31) * 4;
      const u32x2 v = *(const u32x2*)(Qb + i * 272 + d4 * 2);
      *(u32x2*)(QNg + (tok0 + i) * 512 + h * 128 + perm32(d4)) = v;
    }
    {
      const int d = gi >> 4, t4 = (gi & 15) * 4;
      const f32x4 v = *(const f32x4*)(Kt + d * DNP + t4);
      u32x2 o = {pack2(v[0], v[1]), pack2(v[2], v[3])};
      *(u32x2*)(KNTg + (size_t)item * 8192 + d * 64 + perm32(t4)) = o;
    }
  }
  {
    const int mat = wave >> 2, it = wave & 3;
    const int fr = lane & 15, fg = lane >> 4;
    const unsigned char* Ab = mat ? Qb : Kb;
    bf16x8 af[4];
#pragma unroll
    for (int kk = 0; kk < 4; ++kk) af[kk] = *(const bf16x8*)(Ab + (it * 16 + fr) * 272 + kk * 64 + fg * 16);
    f32x4 gi4 = *(const f32x4*)(gc + it * 16 + 4 * fg);
    f32x4 bi4 = *(const f32x4*)(beta + it * 16 + 4 * fg);
#pragma unroll
    for (int jt = 0; jt < 4; ++jt) {
      f32x4 acc = {0.f, 0.f, 0.f, 0.f};
      if (jt <= it) {
#pragma unroll
        for (int kk = 0; kk < 4; ++kk) {
          bf16x8 bfg = *(const bf16x8*)(Kb + (jt * 16 + fr) * 272 + kk * 64 + fg * 16);
          acc = __builtin_amdgcn_mfma_f32_16x16x32_bf16(af[kk], bfg, acc, 0, 0, 0);
        }
      }
      const int j = jt * 16 + fr;
      const float gj = gc[j];
#pragma unroll
      for (int r = 0; r < 4; ++r) {
        const int i = it * 16 + 4 * fg + r;
        const float dec = __expf(fminf(gi4[r] - gj, 0.f));
        if (mat == 0) { if (jt <= it) AmT[j * 64 + i] = (i > j) ? bi4[r] * acc[r] * dec : 0.f; }
        else ATTg[(size_t)item * 4096 + i * 64 + perm32(j)] = f2bf((i >= j) ? acc[r] * dec : 0.f);
      }
    }
  }
  __syncthreads();
  if (tid < 256) {
    const int c = tid;
    const bool isu = c < 128;
    const int cc = c & 127;
    const int pc = perm32(cc);
#pragma unroll 1
    for (int ib = 0; ib < 4; ++ib) {
      float sreg[16];
#pragma unroll
      for (int r = 0; r < 16; ++r) {
        int i = ib * 16 + r;
        sreg[r] = isu ? V[i * 128 + cc] * beta[i] : Kt[cc * DNP + i] * beta[i] * __expf(gc[i]);
      }
#pragma unroll 1
      for (int j = 0; j < ib * 16; ++j) {
        float xj = isu ? V[j * 128 + cc] : Kt[cc * DNP + j];
        const f32x4* ap = (const f32x4*)(AmT + j * 64 + ib * 16);
        f32x4 a0 = ap[0], a1 = ap[1], a2 = ap[2], a3 = ap[3];
        sreg[0] -= a0[0] * xj; sreg[1] -= a0[1] * xj; sreg[2] -= a0[2] * xj; sreg[3] -= a0[3] * xj;
        sreg[4] -= a1[0] * xj; sreg[5] -= a1[1] * xj; sreg[6] -= a1[2] * xj; sreg[7] -= a1[3] * xj;
        sreg[8] -= a2[0] * xj; sreg[9] -= a2[1] * xj; sreg[10] -= a2[2] * xj; sreg[11] -= a2[3] * xj;
        sreg[12] -= a3[0] * xj; sreg[13] -= a3[1] * xj; sreg[14] -= a3[2] * xj; sreg[15] -= a3[3] * xj;
      }
#pragma unroll
      for (int q = 0; q < 15; ++q) {
        const float* ar = AmT + (ib * 16 + q) * 64 + ib * 16;
#pragma unroll
        for (int r = q + 1; r < 16; ++r) sreg[r] -= ar[r] * sreg[q];
      }
#pragma unroll
      for (int r = 0; r < 16; ++r) {
        int i = ib * 16 + r;
        if (isu) { V[i * 128 + cc] = sreg[r]; Ug[(tok0 + i) * 512 + h * 128 + cc] = f2bf(sreg[r]); }
        else { Kt[cc * DNP + i] = sreg[r]; Wg[(tok0 + i) * 512 + h * 128 + pc] = f2bf(sreg[r]); }
      }
    }
  }
}

__device__ __forceinline__ void phase2(const Params& p, unsigned char* smem) {
#ifndef NO_IDX
  for (int i = blockIdx.x; i < 2048; i += gridDim.x) idx_item(p, smem, i & 7, 255 - (i >> 3));
#endif
#ifndef NO_DNL
  if (!(p.flags & 1))
    for (int i = blockIdx.x; i < 2048; i += gridDim.x) dn_local_item(p, smem, i);
#endif
}

constexpr int SC_WP = 272, SC_KP = 144;
constexpr int SC_W = 0, SC_Q = 64 * SC_WP, SC_KT = 2 * 64 * SC_WP, SC_AT = SC_KT + 128 * SC_KP, SC_U = SC_AT + 64 * SC_KP,
              SC_BUF = SC_U + 64 * SC_WP;
constexpr int SC_GC = 2 * SC_BUF;
static_assert(SC_GC + 2 * 64 * 4 <= SMEM_BYTES, "scan LDS");

__device__ __forceinline__ void dn_scan_item(const Params& p, unsigned char* smem, int bh) {
  const int h = bh & 3, b = bh >> 2;
  const u16* Ug = (const u16*)((const unsigned char*)p.out + DO_U);
  const u16* Wg = (const u16*)((const unsigned char*)p.out + DO_W);
  const u16* QNg = (const u16*)((const unsigned char*)p.out + DO_QN);
  const u16* KNTg = (const u16*)((const unsigned char*)p.out + DO_KNT);
  const u16* ATTg = (const u16*)(p.ws + OFF_ATT);
  const float* GCg = (const float*)(p.ws + OFF_GC);
  const u16* PROJ = (const u16*)(p.ws + OFF_PROJ);
  u16* YDN = (u16*)(p.ws + OFF_YDN);
  const float* ogain = p.in[8];
  const int tid = TIDX, lane = tid & 63, wave = tid >> 6;
  const int fr = lane & 15, fg = lane >> 4;
  const int ecol = wave * 16 + fr;
  float* gcs = (float*)(smem + SC_GC);
  f32x4 S[8];
#pragma unroll
  for (int d = 0; d < 8; ++d) S[d] = (f32x4){0.f, 0.f, 0.f, 0.f};
  u32x4 st[9];
  float gcr = 0.f;
  const int r16 = tid >> 4, c16 = tid & 15;
  const int r8 = tid >> 3, c8 = tid & 7;
#define SCAN_LOAD(n_)                                                                                      \
  {                                                                                                        \
    const size_t tk0 = (size_t)b * SEQ + (size_t)(n_) * 64;                                                \
    const size_t it_ = (size_t)((b * 64 + (n_)) * 4 + h);                                                  \
    st[0] = *(const u32x4*)(Wg + (tk0 + r16) * 512 + h * 128 + c16 * 8);                                   \
    st[1] = *(const u32x4*)(Wg + (tk0 + r16 + 32) * 512 + h * 128 + c16 * 8);                              \
    st[2] = *(const u32x4*)(QNg + (tk0 + r16) * 512 + h * 128 + c16 * 8);                                  \
    st[3] = *(const u32x4*)(QNg + (tk0 + r16 + 32) * 512 + h * 128 + c16 * 8);                             \
    st[4] = *(const u32x4*)(KNTg + it_ * 8192 + (size_t)tid * 8);                                          \
    st[5] = *(const u32x4*)(KNTg + it_ * 8192 + (size_t)(tid + 512) * 8);                                  \
    st[6] = *(const u32x4*)(ATTg + it_ * 4096 + (size_t)tid * 8);                                          \
    st[7] = *(const u32x4*)(Ug + (tk0 + r16) * 512 + h * 128 + c16 * 8);                                   \
    st[8] = *(const u32x4*)(Ug + (tk0 + r16 + 32) * 512 + h * 128 + c16 * 8);                              \
    if (tid < 64) gcr = GCg[(tk0 + tid) * 4 + h];                                                          \
  }
#define SCAN_STORE(buf_)                                                                                   \
  {                                                                                                        \
    unsigned char* bs_ = smem + (buf_) * SC_BUF;                                                           \
    *(u32x4*)(bs_ + SC_W + r16 * SC_WP + c16 * 16) = st[0];                                                \
    *(u32x4*)(bs_ + SC_W + (r16 + 32) * SC_WP + c16 * 16) = st[1];                                         \
    *(u32x4*)(bs_ + SC_Q + r16 * SC_WP + c16 * 16) = st[2];                                                \
    *(u32x4*)(bs_ + SC_Q + (r16 + 32) * SC_WP + c16 * 16) = st[3];                                         \
    *(u32x4*)(bs_ + SC_KT + r8 * SC_KP + c8 * 16) = st[4];                                                 \
    *(u32x4*)(bs_ + SC_KT + (r8 + 64) * SC_KP + c8 * 16) = st[5];                                          \
    *(u32x4*)(bs_ + SC_AT + r8 * SC_KP + c8 * 16) = st[6];                                                 \
    *(u32x4*)(bs_ + SC_U + r16 * SC_WP + c16 * 16) = st[7];                                                \
    *(u32x4*)(bs_ + SC_U + (r16 + 32) * SC_WP + c16 * 16) = st[8];                                         \
    if (tid < 64) gcs[(buf_) * 64 + tid] = gcr;                                                            \
  }
  __syncthreads();
  SCAN_LOAD(0)
  SCAN_STORE(0)
  if (1 < 64) SCAN_LOAD(1)
  __syncthreads();
  for (int n = 0; n < 64; ++n) {
    const int buf = n & 1;
    const size_t tok0 = (size_t)b * SEQ + n * 64;
    if (n + 1 < 64) SCAN_STORE(buf ^ 1)
    if (n + 2 < 64) SCAN_LOAD(n + 2)
    __builtin_amdgcn_sched_barrier(0);
    const unsigned char* base = smem + buf * SC_BUF;
    const u32 ub0 = (u32)(tok0 + 4 * fg) * 512 + (u32)(h * 128 + ecol);
    const float* gcb = gcs + buf * 64 + 4 * fg;
    const float glast = gcs[buf * 64 + 63];
    bf16x8 Sb[4];
#pragma unroll
    for (int kk = 0; kk < 4; ++kk) {
      union { u32 w[4]; bf16x8 v; } cv;
      cv.w[0] = pack2(S[2 * kk][0], S[2 * kk][1]); cv.w[1] = pack2(S[2 * kk][2], S[2 * kk][3]);
      cv.w[2] = pack2(S[2 * kk + 1][0], S[2 * kk + 1][1]); cv.w[3] = pack2(S[2 * kk + 1][2], S[2 * kk + 1][3]);
      Sb[kk] = cv.v;
    }
    f32x4 vnew[4], ov[4];
#pragma unroll
    for (int m = 0; m < 4; ++m) {
      f32x4 aw = {0.f, 0.f, 0.f, 0.f}, aq = {0.f, 0.f, 0.f, 0.f};
#pragma unroll
      for (int kk = 0; kk < 4; ++kk) {
        bf16x8 wf = *(const bf16x8*)(base + SC_W + (m * 16 + fr) * SC_WP + kk * 64 + fg * 16);
        bf16x8 qf = *(const bf16x8*)(base + SC_Q + (m * 16 + fr) * SC_WP + kk * 64 + fg * 16);
        aw = __builtin_amdgcn_mfma_f32_16x16x32_bf16(wf, Sb[kk], aw, 0, 0, 0);
        aq = __builtin_amdgcn_mfma_f32_16x16x32_bf16(qf, Sb[kk], aq, 0, 0, 0);
      }
      f32x4 g4 = *(const f32x4*)(gcb + m * 16);
#pragma unroll
      for (int r = 0; r < 4; ++r) {
        float uv = bf2f(*(const u16*)(base + SC_U + (m * 16 + 4 * fg + r) * SC_WP + ecol * 2));
        vnew[m][r] = uv - aw[r];
        ov[m][r] = aq[r] * __expf(g4[r]);
      }
    }
    bf16x8 vb[2], vsb[2];
#pragma unroll
    for (int k2 = 0; k2 < 2; ++k2) {
      union { u32 w[4]; bf16x8 v; } c1, c2;
      const int ma = 2 * k2, mb = 2 * k2 + 1;
      c1.w[0] = pack2(vnew[ma][0], vnew[ma][1]); c1.w[1] = pack2(vnew[ma][2], vnew[ma][3]);
      c1.w[2] = pack2(vnew[mb][0], vnew[mb][1]); c1.w[3] = pack2(vnew[mb][2], vnew[mb][3]);
      f32x4 ga4 = *(const f32x4*)(gcb + ma * 16), gb4 = *(const f32x4*)(gcb + mb * 16);
      float sa[4], sb2[4];
#pragma unroll
      for (int r = 0; r < 4; ++r) { sa[r] = vnew[ma][r] * __expf(glast - ga4[r]); sb2[r] = vnew[mb][r] * __expf(glast - gb4[r]); }
      c2.w[0] = pack2(sa[0], sa[1]); c2.w[1] = pack2(sa[2], sa[3]);
      c2.w[2] = pack2(sb2[0], sb2[1]); c2.w[3] = pack2(sb2[2], sb2[3]);
      vb[k2] = c1.v; vsb[k2] = c2.v;
    }
    const float egl = __expf(glast);
#pragma unroll
    for (int d = 0; d < 8; ++d) {
      f32x4 a = S[d] * egl;
#pragma unroll
      for (int k2 = 0; k2 < 2; ++k2) {
        bf16x8 kf = *(const bf16x8*)(base + SC_KT + (d * 16 + fr) * SC_KP + k2 * 64 + fg * 16);
        a = __builtin_amdgcn_mfma_f32_16x16x32_bf16(kf, vsb[k2], a, 0, 0, 0);
      }
      S[d] = a;
    }
#pragma unroll
    for (int m = 0; m < 4; ++m) {
      f32x4 ao = ov[m];
#pragma unroll
      for (int k2 = 0; k2 < 2; ++k2) {
        bf16x8 af = *(const bf16x8*)(base + SC_AT + (m * 16 + fr) * SC_KP + k2 * 64 + fg * 16);
        ao = __builtin_amdgcn_mfma_f32_16x16x32_bf16(af, vb[k2], ao, 0, 0, 0);
      }
#pragma unroll
      for (int r = 0; r < 4; ++r) YDN[ub0 + (u32)((m * 16 + r) * 512)] = f2bf(ao[r]);
    }
    __syncthreads();
  }
#undef SCAN_LOAD
#undef SCAN_STORE
  asm volatile("s_waitcnt vmcnt(0)" ::: "memory");
  __syncthreads();
  {
    const int sub = lane >> 4, l16 = lane & 15;
    float gn8[8];
#pragma unroll
    for (int e = 0; e < 8; ++e) gn8[e] = ogain[l16 * 8 + e];
    for (int t = wave * 4 + sub; t < SEQ; t += 32) {
      const size_t tok = (size_t)b * SEQ + t;
      u16* yp = YDN + tok * 512 + h * 128 + l16 * 8;
      const u32x4 ov4 = *(const u32x4*)yp;
      const u32x4 zv4 = *(const u32x4*)(PROJ + tok * LDP + C_DZ + h * 128 + l16 * 8);
      float o8[8], z8[8];
#pragma unroll
      for (int c = 0; c < 4; ++c) { o8[2 * c] = bflo(ov4[c]); o8[2 * c + 1] = bfhi(ov4[c]); z8[2 * c] = bflo(zv4[c]); z8[2 * c + 1] = bfhi(zv4[c]); }
      float sq = 0.f;
#pragma unroll
      for (int e = 0; e < 8; ++e) sq += o8[e] * o8[e];
      sq += DPPF(sq, 0xb1); sq += DPPF(sq, 0x4e); sq += DPPF(sq, 0x141); sq += DPPF(sq, 0x140);
      const float rstd = rsqrtf(sq * (1.f / 128.f) + EPS);
      u32 w[4];
#pragma unroll
      for (int c = 0; c < 4; ++c) {
        const float y0 = o8[2 * c] * rstd * gn8[2 * c] * z8[2 * c] * sigmoidf_(z8[2 * c]);
        const float y1 = o8[2 * c + 1] * rstd * gn8[2 * c + 1] * z8[2 * c + 1] * sigmoidf_(z8[2 * c + 1]);
        w[c] = pack2(y0, y1);
      }
      *(u32x4*)yp = (u32x4){w[0], w[1], w[2], w[3]};
    }
  }
}

constexpr int AT_WAVE_BYTES = 8192 + 512 + 8192;
__device__ __forceinline__ float xor16_sum(float v) {
  auto r = __builtin_amdgcn_permlane16_swap(__float_as_uint(v), __float_as_uint(v), false, false);
  return __uint_as_float(r[0]) + __uint_as_float(r[1]);
}
__device__ __forceinline__ float xor32_sum(float v) {
  auto r = __builtin_amdgcn_permlane32_swap(__float_as_uint(v), __float_as_uint(v), false, false);
  return __uint_as_float(r[0]) + __uint_as_float(r[1]);
}
__device__ __forceinline__ void attn_query(const Params& p, unsigned char* wsm, int b, int t) {
  const u16* PROJ = (const u16*)(p.ws + OFF_PROJ);
  const u16* SEL = (const u16*)(p.ws + OFF_SEL);
  const u16* KVC = (const u16*)(p.ws + OFF_KVC);
  u16* YATT = (u16*)(p.ws + OFF_YATT);
  const int lane = TIDX & 63;
  const int fr = lane & 15, fg = lane >> 4;
  float* P = (float*)wsm;
  u16* sl = (u16*)(wsm + 8192);
  const size_t tokb = (size_t)b * SEQ;
  const size_t tok = tokb + t;
  const int nsel = min(256, t + 1);
  bf16x8 qb[2][2];
  {
    const bf16x8 z = {0, 0, 0, 0, 0, 0, 0, 0};
    const u16* qrow = PROJ + tok * LDP + C_AQ + (fr & 3) * 64 + fg * 8;
#pragma unroll
    for (int g = 0; g < 2; ++g)
#pragma unroll
      for (int kk = 0; kk < 2; ++kk) {
        bf16x8 v = *(const bf16x8*)(qrow + g * 256 + kk * 32);
        qb[g][kk] = (fr < 4) ? v : z;
      }
    const u16* sr = SEL + tok * 256;
#pragma unroll
    for (int i = 0; i < 4; ++i) sl[lane + 64 * i] = sr[lane + 64 * i];
  }
  WAVE_LDS_SYNC();
  const int ngrp = (nsel + 15) >> 4;
  const int nbq = (ngrp + 1) >> 1;
  unsigned char* KST = wsm + 8192 + 512;
  const int kq = lane >> 3, kch = lane & 7;
  u32x4 kA[2][4], kB[2][4];
#define QK_LOAD(buf_, bi_)                                                                       \
  _Pragma("unroll") for (int j = 0; j < 2; ++j)                                                  \
    _Pragma("unroll") for (int hf = 0; hf < 2; ++hf) {                                           \
      const int ki_ = min(((bi_) * 2 + j) * 16 + hf * 8 + kq, 255);                              \
      const int s_ = (int)sl[ki_] & 4095;                                                        \
      const u16* krow_ = KVC + (tokb + s_) * 256 + kch * 8;                                      \
      buf_[j][hf * 2] = *(const u32x4*)(krow_); buf_[j][hf * 2 + 1] = *(const u32x4*)(krow_ + 64); \
    }
#define QK_COMPUTE(buf_, bi_)                                                                    \
  {                                                                                              \
    _Pragma("unroll") for (int j = 0; j < 2; ++j)                                                \
      _Pragma("unroll") for (int hf = 0; hf < 2; ++hf) {                                         \
        const int row_ = hf * 8 + kq;                                                            \
        _Pragma("unroll") for (int g = 0; g < 2; ++g)                                            \
          *(u32x4*)(KST + j * 4096 + (row_ * 2 + g) * 128 + ((kch ^ (row_ & 7)) << 4)) = buf_[j][hf * 2 + g]; \
      }                                                                                          \
    WAVE_LDS_SYNC();                                                                             \
    _Pragma("unroll") for (int j = 0; j < 2; ++j) {                                              \
      const unsigned char* kr_ = KST + j * 4096 + fr * 256;                                      \
      const bf16x8 a00_ = *(const bf16x8*)(kr_ + (((0 + fg) ^ (fr & 7)) << 4));                  \
      const bf16x8 a01_ = *(const bf16x8*)(kr_ + (((4 + fg) ^ (fr & 7)) << 4));                  \
      const bf16x8 a10_ = *(const bf16x8*)(kr_ + 128 + (((0 + fg) ^ (fr & 7)) << 4));            \
      const bf16x8 a11_ = *(const bf16x8*)(kr_ + 128 + (((4 + fg) ^ (fr & 7)) << 4));            \
      f32x4 c0_ = {0.f, 0.f, 0.f, 0.f}, c1_ = {0.f, 0.f, 0.f, 0.f};                              \
      c0_ = __builtin_amdgcn_mfma_f32_16x16x32_bf16(a00_, qb[0][0], c0_, 0, 0, 0);               \
      c0_ = __builtin_amdgcn_mfma_f32_16x16x32_bf16(a01_, qb[0][1], c0_, 0, 0, 0);               \
      c1_ = __builtin_amdgcn_mfma_f32_16x16x32_bf16(a10_, qb[1][0], c1_, 0, 0, 0);               \
      c1_ = __builtin_amdgcn_mfma_f32_16x16x32_bf16(a11_, qb[1][1], c1_, 0, 0, 0);               \
      if (fr < 4) {                                                                              \
        _Pragma("unroll") for (int r = 0; r < 4; ++r) {                                          \
          const int kk2_ = ((bi_) * 2 + j) * 16 + 4 * fg + r;                                    \
          if (kk2_ < 256) {                                                                      \
            const bool v_ = kk2_ < nsel;                                                         \
            P[kk2_ * 8 + fr] = v_ ? c0_[r] : -1e30f;                                             \
            P[kk2_ * 8 + 4 + fr] = v_ ? c1_[r] : -1e30f;                                         \
          }                                                                                      \
        }                                                                                        \
      }                                                                                          \
    }                                                                                            \
    WAVE_LDS_SYNC();                                                                             \
  }
  QK_LOAD(kA, 0)
  for (int bi = 0; bi < nbq; bi += 2) {
    if (bi + 1 < nbq) { QK_LOAD(kB, bi + 1) }
    QK_COMPUTE(kA, bi)
    if (bi + 2 < nbq) { QK_LOAD(kA, bi + 2) }
    if (bi + 1 < nbq) { QK_COMPUTE(kB, bi + 1) }
  }
#undef QK_LOAD
#undef QK_COMPUTE
  for (int ki = nbq * 32 + lane; ki < 256; ki += 64) {
    *(f32x4*)(P + ki * 8) = (f32x4){-1e30f, -1e30f, -1e30f, -1e30f};
    *(f32x4*)(P + ki * 8 + 4) = (f32x4){-1e30f, -1e30f, -1e30f, -1e30f};
  }
  WAVE_LDS_SYNC();
  {
    float lg[4][8];
#pragma unroll
    for (int i = 0; i < 4; ++i) {
      f32x4 x0 = *(const f32x4*)(P + (lane + 64 * i) * 8), x1 = *(const f32x4*)(P + (lane + 64 * i) * 8 + 4);
      lg[i][0] = x0[0]; lg[i][1] = x0[1]; lg[i][2] = x0[2]; lg[i][3] = x0[3];
      lg[i][4] = x1[0]; lg[i][5] = x1[1]; lg[i][6] = x1[2]; lg[i][7] = x1[3];
    }
#pragma unroll
    for (int hh = 0; hh < 8; ++hh) {
      float m = fmaxf(fmaxf(lg[0][hh], lg[1][hh]), fmaxf(lg[2][hh], lg[3][hh]));
      m = wave_max_dpp(m);
      float e[4], sum = 0.f;
#pragma unroll
      for (int i = 0; i < 4; ++i) { e[i] = __expf(lg[i][hh] - m); sum += e[i]; }
      sum = wave_sum_dpp(sum);
      const float inv = __builtin_amdgcn_rcpf(sum);
#pragma unroll
      for (int i = 0; i < 4; ++i) lg[i][hh] = e[i] * inv;
    }
#pragma unroll
    for (int i = 0; i < 4; ++i) {
      float* d = P + (lane + 64 * i) * 8;
      *(f32x4*)d = (f32x4){lg[i][0], lg[i][1], lg[i][2], lg[i][3]};
      *(f32x4*)(d + 4) = (f32x4){lg[i][4], lg[i][5], lg[i][6], lg[i][7]};
    }
  }
  WAVE_LDS_SYNC();
  const int ks = lane >> 3, c8 = lane & 7;
  const int ngrp8 = (nsel + 7) >> 3;
  const int total = (ngrp8 + 3) >> 2;
  u32x4 vA[4][2], vB[4][2];
  f32x2_t o2[2][4][4];
#define PV_LOAD(buf_, bi_)                                                                       \
  _Pragma("unroll") for (int j = 0; j < 4; ++j) {                                                \
    const int ki_ = min(((bi_) * 4 + j) * 8 + ks, 255);                                          \
    const int s_ = (int)sl[ki_] & 4095;                                                          \
    const u16* vrow_ = KVC + (tokb + s_) * 256 + 128 + c8 * 8;                                   \
    buf_[j][0] = *(const u32x4*)(vrow_); buf_[j][1] = *(const u32x4*)(vrow_ + 64);               \
  }
#define PV_COMPUTE(buf_, bi_)                                                                    \
  _Pragma("unroll") for (int j = 0; j < 4; ++j) {                                                \
    const int ki_ = ((bi_) * 4 + j) * 8 + ks;                                                    \
    f32x4 p0_ = *(const f32x4*)(P + min(ki_, 255) * 8), p1_ = *(const f32x4*)(P + min(ki_, 255) * 8 + 4); \
    if (ki_ >= nsel) { p0_ = (f32x4){0.f, 0.f, 0.f, 0.f}; p1_ = p0_; }                           \
    _Pragma("unroll") for (int c = 0; c < 4; ++c) {                                              \
      const f32x2_t f0_ = {bflo(buf_[j][0][c]), bfhi(buf_[j][0][c])};                            \
      const f32x2_t f1_ = {bflo(buf_[j][1][c]), bfhi(buf_[j][1][c])};                            \
      _Pragma("unroll") for (int hh = 0; hh < 4; ++hh) {                                         \
        const f32x2_t pa_ = {p0_[hh], p0_[hh]}, pb_ = {p1_[hh], p1_[hh]};                        \
        o2[0][hh][c] = __builtin_elementwise_fma(pa_, f0_, o2[0][hh][c]);                        \
        o2[1][hh][c] = __builtin_elementwise_fma(pb_, f1_, o2[1][hh][c]);                        \
      }                                                                                          \
    }                                                                                            \
  }
#pragma unroll
  for (int g = 0; g < 2; ++g)
#pragma unroll
    for (int hh = 0; hh < 4; ++hh)
#pragma unroll
      for (int c = 0; c < 4; ++c) o2[g][hh][c] = (f32x2_t){0.f, 0.f};
  PV_LOAD(vA, 0)
  for (int bi = 0; bi < total; bi += 2) {
    if (bi + 1 < total) { PV_LOAD(vB, bi + 1) }
    PV_COMPUTE(vA, bi)
    if (bi + 2 < total) { PV_LOAD(vA, bi + 2) }
    if (bi + 1 < total) { PV_COMPUTE(vB, bi + 1) }
  }
#undef PV_LOAD
#undef PV_COMPUTE
#pragma unroll
  for (int g = 0; g < 2; ++g)
#pragma unroll
    for (int hh = 0; hh < 4; ++hh) {
      u32 w_[4];
#pragma unroll
      for (int c = 0; c < 4; ++c) {
        float x0 = o2[g][hh][c][0], x1 = o2[g][hh][c][1];
        x0 += DPPF(x0, 0x128); x1 += DPPF(x1, 0x128);
        x0 = xor16_sum(x0); x1 = xor16_sum(x1);
        x0 = xor32_sum(x0); x1 = xor32_sum(x1);
        w_[c] = pack2(x0, x1);
      }
      if (lane < 8) *(u32x4*)(YATT + tok * 512 + (g * 4 + hh) * 64 + c8 * 8) = (u32x4){w_[0], w_[1], w_[2], w_[3]};
    }
  WAVE_LDS_SYNC();
}

__device__ __forceinline__ void phase3(const Params& p, unsigned char* smem) {
  const int wave = TIDX >> 6;
#ifndef NO_SCAN
  if (blockIdx.x < 32) {
    if (!(p.flags & 2)) dn_scan_item(p, smem, blockIdx.x);
    __syncthreads();
  }
#endif
#ifdef NO_ATTN
  return;
#endif
  if (p.flags & 4) return;
  unsigned* qctr = (unsigned*)(p.ws + 1024);
  const unsigned xcc = (unsigned)__builtin_amdgcn_s_getreg((3 << 11) | 20) & 7u;
  unsigned char* wsm = smem + wave * AT_WAVE_BYTES;
  for (unsigned db = 0; db < 8; ++db) {
    const int bb = (int)((xcc + db) & 7u);
    for (;;) {
      unsigned qi = 0;
      if ((TIDX & 63) == 0) qi = __hip_atomic_fetch_add(qctr + bb * 16, 1u, __ATOMIC_RELAXED, __HIP_MEMORY_SCOPE_AGENT);
      qi = (unsigned)__builtin_amdgcn_readfirstlane((int)qi);
      if (qi >= (unsigned)SEQ) break;
      attn_query(p, wsm, bb, SEQ - 1 - (int)qi);
    }
  }
}

__device__ __forceinline__ void phase4(const Params& p, unsigned char* smem) {
  const u16* YATT = (const u16*)(p.ws + OFF_YATT);
  const u16* YDN = (const u16*)(p.ws + OFF_YDN);
  const u16* WTA = (const u16*)(p.ws + OFF_WTA);
  const u16* WTB = (const u16*)(p.ws + OFF_WTB);
  const u16* PROJ = (const u16*)(p.ws + OFF_PROJ);
  u16* MG = (u16*)(p.ws + OFF_MERGED);
  const int lane = TIDX & 63, wave = TIDX >> 6;
  const int wm = wave >> 1, wn = wave & 1, fr = lane & 15, fg = lane >> 4;
  const int ntn = DM / G_BN, ntiles = (MTOK / G_BM) * ntn;
  for (int t = blockIdx.x; t < ntiles; t += gridDim.x) {
    const int m0 = (t / ntn) * G_BM, n0 = (t % ntn) * G_BN;
    f32x4 acc[4][4];
    u32 mg[4][4][2];
    const u32 pb0 = (u32)(m0 + wm * 64 + 4 * fg) * LDP + (u32)(n0 + wn * 64 + fr);
    const u32 ob0 = (u32)(m0 + wm * 64 + 4 * fg) * DM + (u32)(n0 + wn * 64 + fr);
    gemm_mainloop(YATT, 512, WTA, 512, 512, m0, n0, smem, acc);
#pragma unroll
    for (int i = 0; i < 4; ++i)
#pragma unroll
      for (int j = 0; j < 4; ++j) {
        float t4[4];
#pragma unroll
        for (int r = 0; r < 4; ++r) {
          float ga = bf2f(PROJ[pb0 + (u32)(C_GA + (i * 16 + r) * LDP + j * 16)]);
          t4[r] = sigmoidf_(ga) * acc[i][j][r];
        }
        mg[i][j][0] = pack2(t4[0], t4[1]); mg[i][j][1] = pack2(t4[2], t4[3]);
        asm volatile("" ::: "memory");
      }
    gemm_mainloop(YDN, 512, WTB, 512, 512, m0, n0, smem, acc);
#pragma unroll
    for (int i = 0; i < 4; ++i)
#pragma unroll
      for (int j = 0; j < 4; ++j)
#pragma unroll
        for (int r = 0; r < 4; ++r) {
          float gb = bf2f(PROJ[pb0 + (u32)(C_GB + (i * 16 + r) * LDP + j * 16)]);
          u32 w = mg[i][j][r >> 1];
          float m1 = (r & 1) ? bfhi(w) : bflo(w);
          MG[ob0 + (u32)((i * 16 + r) * DM + j * 16)] = f2bf(m1 + sigmoidf_(gb) * acc[i][j][r]);
          if (r == 3) asm volatile("" ::: "memory");
        }
  }
}

__device__ __forceinline__ void phase5(const Params& p, unsigned char* smem) {
  const u16* MG = (const u16*)(p.ws + OFF_MERGED);
  const u16* WTO = (const u16*)(p.ws + OFF_WTO);
  const float* x = p.in[0];
  const int lane = TIDX & 63, wave = TIDX >> 6;
  const int wr = wave >> 2, wc = wave & 3, fr = lane & 15, fq = lane >> 4;
  const int ntn = DM / 256, ntiles = (MTOK / 256) * ntn;
  for (int t = blockIdx.x; t < ntiles; t += gridDim.x) {
    const int m0 = (t / ntn) * 256, n0 = (t % ntn) * 256;
    f32x4 acc[2][2][4][2];
    gemm8_tile(MG, WTO, DM, m0, n0, smem, acc);
    const u32 ob0 = (u32)(m0 + wr * 64 + 4 * fq) * DM + (u32)(n0 + wc * 64 + fr);
    float* outp = p.out;
#pragma unroll
    for (int ai = 0; ai < 2; ++ai)
#pragma unroll
      for (int m = 0; m < 4; ++m) {
#pragma unroll
        for (int bj = 0; bj < 2; ++bj)
#pragma unroll
          for (int n = 0; n < 2; ++n)
#pragma unroll
            for (int j = 0; j < 4; ++j) {
              u32 o = ob0 + (u32)((ai * 128 + m * 16 + j) * DM + (bj * 2 + n) * 16);
              outp[o] = x[o] + acc[ai][bj][m][n][j];
            }
        __builtin_amdgcn_sched_barrier(0);
      }
  }
}

__device__ __forceinline__ void phase6(const Params& p, unsigned char* smem) {
  const u16* H2 = (const u16*)(p.ws + OFF_H2);
  const u16* WTQ = (const u16*)(p.ws + OFF_WTQ);
  u16* QP = (u16*)(p.ws + OFF_QP);
  const int lane = TIDX & 63, wave = TIDX >> 6;
  const int wr = wave >> 2, wc = wave & 3, fr = lane & 15, fq = lane >> 4;
  const int ntn = 2048 / 256, ntiles = (MTOK / 256) * ntn;
  for (int t = blockIdx.x; t < ntiles; t += gridDim.x) {
    const int m0 = (t / ntn) * 256, n0 = (t % ntn) * 256;
    f32x4 acc[2][2][4][2];
    gemm8_tile(H2, WTQ, DM, m0, n0, smem, acc);
    ep_store<2048, false>(QP, (u32)(m0 + wr * 64) * 2048 + (u32)(n0 + wc * 64), acc, nullptr, 1.f, smem, wave, lane);
  }
}

__device__ __forceinline__ int mono_key(float v) { int b = __float_as_int(v); return b ^ ((b >> 31) & 0x7fffffff); }
__device__ __forceinline__ float unmono_key(int k) { return __int_as_float(k ^ ((k >> 31) & 0x7fffffff)); }
__device__ __forceinline__ void chain16(int (&k)[16], int x) {
#pragma unroll
  for (int j = 0; j < 16; ++j) { int hi = max(k[j], x); x = min(k[j], x); k[j] = hi; }
}

constexpr int P7_LD = 132;
__device__ __forceinline__ void phase7(const Params& p, unsigned char* smem) {
  const u16* QP = (const u16*)(p.ws + OFF_QP);
  const u16* SKB = (const u16*)(p.ws + OFF_SKB);
  float* TOPS = (float*)(p.ws + OFF_TOPS);
  u8* TOPI = (u8*)(p.ws + OFF_TOPI);
  const int tid = TIDX, lane = tid & 63, wave = tid >> 6;
  const int wm = wave >> 1, wn = wave & 1, fr = lane & 15, fg = lane >> 4;
  const int ntiles = (MTOK / G_BM) * 16;
  float* tile = (float*)smem;
  for (int t = blockIdx.x; t < ntiles; t += gridDim.x) {
    const int m0 = (t >> 4) * G_BM, hp = t & 15;
    f32x4 acc[4][4];
    gemm_mainloop(QP + hp * 128, 2048, SKB + (size_t)hp * 128 * 128, 128, 128, m0, 0, smem, acc);
#pragma unroll
    for (int i = 0; i < 4; ++i)
#pragma unroll
      for (int j = 0; j < 4; ++j)
#pragma unroll
        for (int r = 0; r < 4; ++r) {
          int row = wm * 64 + i * 16 + 4 * fg + r, col = wn * 64 + j * 16 + fr;
          tile[row * P7_LD + col] = acc[i][j][r];
        }
    __syncthreads();
    {
      const int row = tid >> 1, half = tid & 1;
      int k[16];
#pragma unroll
      for (int j = 0; j < 16; ++j) k[j] = (int)0x80000000;
      const float* rowp = tile + row * P7_LD + half * 64;
#pragma unroll 4
      for (int c = 0; c < 64; c += 4) {
        f32x4 v = *(const f32x4*)(rowp + c);
        const int ib = 127 - (half * 64 + c);
        chain16(k, (mono_key(v[0]) & ~127) | ib);
        chain16(k, (mono_key(v[1]) & ~127) | (ib - 1));
        chain16(k, (mono_key(v[2]) & ~127) | (ib - 2));
        chain16(k, (mono_key(v[3]) & ~127) | (ib - 3));
      }
#pragma unroll
      for (int j = 0; j < 16; ++j) {
        const int other = DPPI(k[j], 0xb1);
        if (half == 0) chain16(k, other);
      }
      if (half == 0) {
        size_t o = ((size_t)(m0 + row) * 16 + hp) * 16;
        float vals[16]; int idx[16];
#pragma unroll
        for (int j = 0; j < 16; ++j) { idx[j] = 127 - (k[j] & 127); vals[j] = tile[row * P7_LD + idx[j]]; }
#pragma unroll
        for (int j = 0; j < 16; j += 4) *(f32x4*)(TOPS + o + j) = (f32x4){vals[j], vals[j + 1], vals[j + 2], vals[j + 3]};
#pragma unroll
        for (int j = 0; j < 16; j += 4)
          *(u32*)(TOPI + o + j) = (u32)idx[j] | ((u32)idx[j + 1] << 8) | ((u32)idx[j + 2] << 16) | ((u32)idx[j + 3] << 24);
      }
    }
    __syncthreads();
  }
}

__device__ __forceinline__ void phase7b(const Params& p) {
  const float* TOPS = (const float*)(p.ws + OFF_TOPS);
  const u8* TOPI = (const u8*)(p.ws + OFF_TOPI);
  int* EXPERT = (int*)(p.ws + OFF_EXPERT);
  float* GATE = (float*)(p.ws + OFF_GATE);
  for (int w = blockIdx.x * NTHREADS + TIDX; w < MTOK * 8; w += gridDim.x * NTHREADS) {
    const size_t o = (size_t)w * 32;
    float sa[16], sb[16];
#pragma unroll
    for (int k = 0; k < 16; k += 4) {
      float4 v = *(const float4*)(TOPS + o + k); sa[k] = v.x; sa[k + 1] = v.y; sa[k + 2] = v.z; sa[k + 3] = v.w;
      float4 u = *(const float4*)(TOPS + o + 16 + k); sb[k] = u.x; sb[k + 1] = u.y; sb[k + 2] = u.z; sb[k + 3] = u.w;
    }
    int kk[16];
#pragma unroll
    for (int k = 0; k < 16; ++k) kk[k] = (int)0x80000000;
#pragma unroll
    for (int a = 0; a < 16; ++a)
#pragma unroll
      for (int bb = 0; bb < 16; ++bb)
        if ((a + 1) * (bb + 1) <= 16) chain16(kk, (mono_key(sa[a] + sb[bb]) & ~255) | (255 - (a * 16 + bb)));
    float vals[16];
#pragma unroll
    for (int k = 0; k < 16; ++k) vals[k] = unmono_key(kk[k] & ~255);
    float m = vals[0], s = 0.f, e[16];
#pragma unroll
    for (int k = 0; k < 16; ++k) { e[k] = __expf(vals[k] - m); s += e[k]; }
    float inv = 1.f / s;
#pragma unroll
    for (int k = 0; k < 16; ++k) {
      const int ci = 255 - (kk[k] & 255);
      int a = ci >> 4, bb = ci & 15;
      int ex = (int)TOPI[o + a] * 128 + (int)TOPI[o + 16 + bb];
      EXPERT[(size_t)w * 16 + k] = ex;
      GATE[(size_t)w * 16 + k] = e[k] * inv;
    }
  }
  {
    const int lane = TIDX & 63, wave = TIDX >> 6;
    for (int row = blockIdx.x * 8 + wave; row < 2 * 16384; row += gridDim.x * 8) {
      const int tbl = row >> 14, r = row & 16383;
      const f32x4* src = (const f32x4*)((tbl ? p.in[16] : p.in[15]) + (size_t)r * DM) + 4 * lane;
      f32x4 x[4];
      float amax = 0.f;
#pragma unroll
      for (int i = 0; i < 4; ++i) {
        x[i] = src[i];
        amax = fmaxf(amax, fmaxf(fmaxf(fabsf(x[i][0]), fabsf(x[i][1])), fmaxf(fabsf(x[i][2]), fabsf(x[i][3]))));
      }
      amax = wave_max_dpp(amax);
      const float inv = amax > 0.f ? 127.f / amax : 0.f;
      const int bias = tbl ? 128 : 0;
      u32x4 o;
#pragma unroll
      for (int i = 0; i < 4; ++i) {
        int q0 = (int)rintf(x[i][0] * inv) + bias, q1 = (int)rintf(x[i][1] * inv) + bias;
        int q2 = (int)rintf(x[i][2] * inv) + bias, q3 = (int)rintf(x[i][3] * inv) + bias;
        o[i] = (u32)(q0 & 0xff) | ((u32)(q1 & 0xff) << 8) | ((u32)(q2 & 0xff) << 16) | ((u32)(q3 & 0xff) << 24);
      }
      *(u32x4*)(p.ws + (tbl ? OFF_VQ : OFF_UQ) + (size_t)r * DM + 16 * lane) = o;
      if (lane == 0) ((float*)(p.ws + (tbl ? OFF_VS : OFF_US)))[r] = amax * (1.f / 127.f);
    }
  }
}

__device__ __forceinline__ void phase8(const Params& p) {
  const u16* H2 = (const u16*)(p.ws + OFF_H2);
  const int* EXPERT = (const int*)(p.ws + OFF_EXPERT);
  const float* GATE = (const float*)(p.ws + OFF_GATE);
  const unsigned char* UQ = p.ws + OFF_UQ;
  const unsigned char* VQ = p.ws + OFF_VQ;
  const float* US = (const float*)(p.ws + OFF_US);
  const float* VS = (const float*)(p.ws + OFF_VS);
  const int lane = TIDX & 63, wave = TIDX >> 6;
  for (int tok = blockIdx.x * 8 + wave; tok < MTOK; tok += gridDim.x * 8) {
    u32 hq[4];
    float sh;
    {
      const u32x4 a = *(const u32x4*)(H2 + (size_t)tok * DM + 16 * lane);
      const u32x4 b = *(const u32x4*)(H2 + (size_t)tok * DM + 16 * lane + 8);
      float hv[16];
#pragma unroll
      for (int c = 0; c < 4; ++c) { hv[2 * c] = bflo(a[c]); hv[2 * c + 1] = bfhi(a[c]); hv[8 + 2 * c] = bflo(b[c]); hv[8 + 2 * c + 1] = bfhi(b[c]); }
      float amax = 0.f;
#pragma unroll
      for (int i = 0; i < 16; ++i) amax = fmaxf(amax, fabsf(hv[i]));
      amax = wave_max_dpp(amax);
      const float inv = amax > 0.f ? 127.f / amax : 0.f;
      sh = amax * (1.f / 127.f);
#pragma unroll
      for (int c = 0; c < 4; ++c) {
        int q0 = (int)rintf(hv[4 * c] * inv), q1 = (int)rintf(hv[4 * c + 1] * inv);
        int q2 = (int)rintf(hv[4 * c + 2] * inv), q3 = (int)rintf(hv[4 * c + 3] * inv);
        hq[c] = (u32)(q0 & 0xff) | ((u32)(q1 & 0xff) << 8) | ((u32)(q2 & 0xff) << 16) | ((u32)(q3 & 0xff) << 24);
      }
    }
    const int e0 = EXPERT[(size_t)tok * 128 + lane], e1 = EXPERT[(size_t)tok * 128 + 64 + lane];
    const float g0 = GATE[(size_t)tok * 128 + lane], g1 = GATE[(size_t)tok * 128 + 64 + lane];
    const float su0 = US[e0], su1 = US[e1], sv0 = VS[e0], sv1 = VS[e1];
    int dacc0 = 0, dacc1 = 0;
#pragma unroll 1
    for (int half = 0; half < 2; ++half) {
      const int ev = half ? e1 : e0;
      int dacc = 0;
#pragma unroll 1
      for (int k = 0; k < 64; k += 16) {
        u32x4 ua[16];
#pragma unroll
        for (int j = 0; j < 16; ++j) {
          const int e = __builtin_amdgcn_readlane(ev, k + j);
          ua[j] = *(const u32x4*)(UQ + (size_t)e * DM + 16 * lane);
        }
#pragma unroll
        for (int j = 0; j < 16; ++j) {
          int sdot = 0;
#pragma unroll
          for (int c = 0; c < 4; ++c) sdot = __builtin_amdgcn_sdot4((int)ua[j][c], (int)hq[c], sdot, false);
          sdot = wave_sum_i_dpp(sdot);
          dacc = (lane == k + j) ? sdot : dacc;
        }
      }
      if (half) dacc1 = dacc; else dacc0 = dacc;
    }
    const float d0 = (float)dacc0 * su0 * sh, d1 = (float)dacc1 * su1 * sh;
    const float cf0 = g0 * 0.5f * d0 * (1.f + erff(d0 * 0.70710678118654752f)) * sv0;
    const float cf1 = g1 * 0.5f * d1 * (1.f + erff(d1 * 0.70710678118654752f)) * sv1;
    const float csum = wave_sum_dpp(cf0 + cf1);
    f32x2_t ov2[8];
#pragma unroll
    for (int i = 0; i < 8; ++i) ov2[i] = (f32x2_t){0.f, 0.f};
#pragma unroll 1
    for (int half = 0; half < 2; ++half) {
      const int ev = half ? e1 : e0;
      const float cv = half ? cf1 : cf0;
#pragma unroll 1
      for (int k = 0; k < 64; k += 16) {
        u32x4 va[16];
        float cc[16];
#pragma unroll
        for (int j = 0; j < 16; ++j) {
          const int e = __builtin_amdgcn_readlane(ev, k + j);
          cc[j] = __int_as_float(__builtin_amdgcn_readlane(__float_as_int(cv), k + j));
          va[j] = *(const u32x4*)(VQ + (size_t)e * DM + 16 * lane);
        }
#pragma unroll
        for (int j = 0; j < 16; ++j) {
#pragma unroll
          for (int c = 0; c < 4; ++c) {
            const u32 w = va[j][c];
            const f32x2_t cc2 = {cc[j], cc[j]};
            const f32x2_t fa = {(float)(w & 0xffu), (float)((w >> 8) & 0xffu)};
            const f32x2_t fb = {(float)((w >> 16) & 0xffu), (float)(w >> 24)};
            ov2[2 * c] = __builtin_elementwise_fma(cc2, fa, ov2[2 * c]);
            ov2[2 * c + 1] = __builtin_elementwise_fma(cc2, fb, ov2[2 * c + 1]);
          }
        }
      }
    }
    const float corr = 128.f * csum;
    f32x4* op = (f32x4*)(p.out + (size_t)tok * DM + 16 * lane);
#pragma unroll
    for (int c = 0; c < 4; ++c) {
      f32x4 x = op[c];
      x[0] += ov2[2 * c][0] - corr; x[1] += ov2[2 * c][1] - corr; x[2] += ov2[2 * c + 1][0] - corr; x[3] += ov2[2 * c + 1][1] - corr;
      if (!(p.flags & 32) || x[0] == 1.2345678e30f) op[c] = x;
    }
  }
}

__device__ __forceinline__ void grid_barrier(unsigned* ctr, unsigned target) {
  asm volatile("s_waitcnt vmcnt(0)" ::: "memory");
  __syncthreads();
  if (TIDX == 0) {
    __builtin_amdgcn_fence(__ATOMIC_RELEASE, "agent");
    asm volatile("s_waitcnt vmcnt(0)" ::: "memory");
    __hip_atomic_fetch_add(ctr, 1u, __ATOMIC_RELAXED, __HIP_MEMORY_SCOPE_AGENT);
    while (__hip_atomic_load(ctr, __ATOMIC_RELAXED, __HIP_MEMORY_SCOPE_AGENT) < target) __builtin_amdgcn_s_sleep(2);
    __builtin_amdgcn_fence(__ATOMIC_ACQUIRE, "agent");
    asm volatile("s_waitcnt vmcnt(0)" ::: "memory");
  }
  __syncthreads();
}

__global__ void __launch_bounds__(NTHREADS, 2) mk_fwd(Params p) {
  cg::grid_group grid = cg::this_grid();
  __shared__ __attribute__((aligned(16))) unsigned char smem[SMEM_BYTES];
  const int lo = p.ph_lo, hi = p.ph_hi;
#define RUN(k, call) if (lo <= (k) && (k) < hi) { call; if ((k) + 1 < hi) { if ((k) == lo) grid.sync(); else grid_barrier((unsigned*)p.ws, (unsigned)((k) - lo) * gridDim.x); } }
  RUN(0, phase0(p, smem))
  RUN(1, phase1(p, smem))
  RUN(2, phase2(p, smem))
  RUN(3, phase3(p, smem))
  RUN(4, phase4(p, smem))
  RUN(5, phase5(p, smem))
  RUN(6, rmsnorm_rows(p.out, p.in[12], (u16*)(p.ws + OFF_H2)))
  RUN(7, phase6(p, smem))
  RUN(8, phase7(p, smem))
  RUN(9, phase7b(p))
  RUN(10, phase8(p))
#undef RUN
}

extern "C" void kernel_launch(void* const* d_in, const int* in_sizes, int n_in,
                              void* d_out, int out_size, void* d_ws, size_t ws_size,
                              hipStream_t stream) {
  static int grid_blocks = 0;
  if (!grid_blocks) {
    int dev = 0, cus = 0, per_cu = 0;
    (void)hipGetDevice(&dev);
    (void)hipDeviceGetAttribute(&cus, hipDeviceAttributeMultiprocessorCount, dev);
    (void)hipOccupancyMaxActiveBlocksPerMultiprocessor(&per_cu, mk_fwd, NTHREADS, 0);
    if (per_cu < 1) per_cu = 1;
    if (per_cu > 1) per_cu = 1;
    grid_blocks = cus * per_cu;
    fprintf(stderr, "mk_fwd: cus=%d per_cu=%d grid=%d ws=%zu\n", cus, per_cu, grid_blocks, ws_size);
  }
  Params p{};
  for (int i = 0; i < 17 && i < n_in; ++i) p.in[i] = (const float*)d_in[i];
  p.out = (float*)d_out;
  p.ws = (unsigned char*)d_ws;
  p.ph_lo = 0; p.ph_hi = 11;
  (void)hipMemsetAsync(d_ws, 0, 4096, stream);
  void* args[] = {&p};
  hipError_t e = hipLaunchCooperativeKernel((void*)mk_fwd, dim3(grid_blocks), dim3(NTHREADS), args, 0, stream);
  if (e != hipSuccess) fprintf(stderr, "cooperative launch failed: %s (grid %d)\n", hipGetErrorString(e), grid_blocks);
#ifdef EXTRA_LO
  {
    Params p2 = p;
    p2.ph_lo = EXTRA_LO; p2.ph_hi = EXTRA_HI; p2.flags = EXTRA_FLAGS;
    void* args2[] = {&p2};
    (void)hipLaunchCooperativeKernel((void*)mk_fwd, dim3(grid_blocks), dim3(NTHREADS), args2, 0, stream);
  }
#endif
}
```

```cpp
#include <hip/hip_runtime.h>
#include <hip/hip_bf16.h>
#include <hip/hip_cooperative_groups.h>
#include <cstdio>
#include <cstdint>
namespace cg = cooperative_groups;

typedef unsigned short u16;
typedef unsigned int u32;
typedef unsigned char u8;
typedef short bf16x8 __attribute__((ext_vector_type(8)));
typedef float f32x4 __attribute__((ext_vector_type(4)));
typedef unsigned int u32x4 __attribute__((ext_vector_type(4)));
typedef unsigned int u32x2 __attribute__((ext_vector_type(2)));

constexpr int NTHREADS = 512;
constexpr int BATCH = 8, SEQ = 4096, DM = 1024, MTOK = BATCH * SEQ;
constexpr int LDP = 5120;
constexpr int NPADW = 5632;
constexpr int C_AQ = 0, C_IQ = 512, C_DQ = 1024, C_DK = 1536, C_DV = 2048, C_DZ = 2560, C_GA = 3072, C_GB = 4096;
constexpr int N_AK = 5120, N_AV = 5248, N_IK = 5376, N_SM = 5440;
constexpr size_t MiB = 1ull << 20;
constexpr size_t OFF_WTIN = 1 * MiB, OFF_WTA = 12 * MiB, OFF_WTB = 13 * MiB, OFF_WTO = 14 * MiB, OFF_WTQ = 16 * MiB,
                 OFF_SKB = 20 * MiB, OFF_SMALL = 21 * MiB, OFF_H = 23 * MiB, OFF_ATT = 23 * MiB, OFF_GC = 39 * MiB,
                 OFF_MERGED = 23 * MiB, OFF_PROJ = 87 * MiB, OFF_KVC = 407 * MiB, OFF_IKC = 423 * MiB, OFF_SEL = 427 * MiB, OFF_YATT = 443 * MiB,
                 OFF_YDN = 475 * MiB;
constexpr size_t OFF_H2 = OFF_PROJ, OFF_QP = OFF_PROJ + 64 * MiB, OFF_TOPS = OFF_PROJ + 192 * MiB,
                 OFF_TOPI = OFF_PROJ + 224 * MiB, OFF_EXPERT = OFF_PROJ + 232 * MiB, OFF_GATE = OFF_PROJ + 248 * MiB;
constexpr size_t OFF_UQ = OFF_PROJ + 264 * MiB, OFF_VQ = OFF_PROJ + 280 * MiB, OFF_US = OFF_PROJ + 296 * MiB, OFF_VS = OFF_PROJ + 297 * MiB;
constexpr size_t OFF_H2Q = 23 * MiB, OFF_HS = 55 * MiB, OFF_PD = OFF_PROJ + 64 * MiB;
constexpr size_t DO_U = 0, DO_W = 32 * MiB, DO_QN = 64 * MiB, DO_KNT = 96 * MiB;

constexpr int SMEM_BYTES = 162816;
constexpr float EPS = 1e-6f;

struct Params {
  const float* in[17];
  float* out;
  unsigned char* ws;
  int ph_lo, ph_hi;
  int flags, pad;
};

typedef __bf16 bf16x2_t __attribute__((ext_vector_type(2)));
typedef float f32x2_t __attribute__((ext_vector_type(2)));
__device__ __forceinline__ u32 pack2(float a, float b) {
  f32x2_t f = {a, b};
  return __builtin_bit_cast(u32, __builtin_convertvector(f, bf16x2_t));
}
__device__ __forceinline__ u16 f2bf(float f) { return (u16)(pack2(f, f) & 0xffffu); }
__device__ __forceinline__ float bf2f(u16 h) { return __uint_as_float(((u32)h) << 16); }
__device__ __forceinline__ float bflo(u32 w) { return __uint_as_float(w << 16); }
__device__ __forceinline__ float bfhi(u32 w) { return __uint_as_float(w & 0xffff0000u); }
__device__ __forceinline__ float wave_sum(float v) {
#pragma unroll
  for (int o = 32; o > 0; o >>= 1) v += __shfl_xor(v, o);
  return v;
}
__device__ __forceinline__ float wave_max(float v) {
#pragma unroll
  for (int o = 32; o > 0; o >>= 1) v = fmaxf(v, __shfl_xor(v, o));
  return v;
}
__device__ __forceinline__ float dot2bf(u32 a, u32 b, float acc) {
  return __builtin_amdgcn_fdot2_f32_bf16(__builtin_bit_cast(bf16x2_t, a), __builtin_bit_cast(bf16x2_t, b), acc, false);
}
#define DPPF(v, ctrl) __int_as_float(__builtin_amdgcn_update_dpp(0, __float_as_int(v), ctrl, 0xf, 0xf, true))
__device__ __forceinline__ float wave_sum_dpp(float v) {
  v += DPPF(v, 0xb1);
  v += DPPF(v, 0x4e);
  v += DPPF(v, 0x124);
  v += DPPF(v, 0x128);
  float r0 = __int_as_float(__builtin_amdgcn_readlane(__float_as_int(v), 0));
  float r1 = __int_as_float(__builtin_amdgcn_readlane(__float_as_int(v), 16));
  float r2 = __int_as_float(__builtin_amdgcn_readlane(__float_as_int(v), 32));
  float r3 = __int_as_float(__builtin_amdgcn_readlane(__float_as_int(v), 48));
  return (r0 + r1) + (r2 + r3);
}
__device__ __forceinline__ int opaque_tid() { int t = threadIdx.x; asm volatile("" : "+v"(t)); return t; }
#define TIDX opaque_tid()
#define DPPI(v, ctrl) __builtin_amdgcn_update_dpp(0, (v), ctrl, 0xf, 0xf, true)
__device__ __forceinline__ int wave_sum_i_dpp(int v) {
  v += DPPI(v, 0xb1);
  v += DPPI(v, 0x4e);
  v += DPPI(v, 0x124);
  v += DPPI(v, 0x128);
  return (__builtin_amdgcn_readlane(v, 0) + __builtin_amdgcn_readlane(v, 16)) +
         (__builtin_amdgcn_readlane(v, 32) + __builtin_amdgcn_readlane(v, 48));
}
__device__ __forceinline__ float wave_max_dpp(float v) {
  v = fmaxf(v, DPPF(v, 0xb1));
  v = fmaxf(v, DPPF(v, 0x4e));
  v = fmaxf(v, DPPF(v, 0x124));
  v = fmaxf(v, DPPF(v, 0x128));
  float r0 = __int_as_float(__builtin_amdgcn_readlane(__float_as_int(v), 0));
  float r1 = __int_as_float(__builtin_amdgcn_readlane(__float_as_int(v), 16));
  float r2 = __int_as_float(__builtin_amdgcn_readlane(__float_as_int(v), 32));
  float r3 = __int_as_float(__builtin_amdgcn_readlane(__float_as_int(v), 48));
  return fmaxf(fmaxf(r0, r1), fmaxf(r2, r3));
}
#define WAVE_LDS_SYNC() asm volatile("s_waitcnt lgkmcnt(0)" ::: "memory")
__device__ __forceinline__ float sigmoidf_(float x) { return __builtin_amdgcn_rcpf(1.f + __expf(-x)); }
__device__ __forceinline__ int perm32(int k) {
  int blk = k & ~31, r = k & 31;
  int p = (r < 16) ? (8 * (r >> 2) + (r & 3)) : (8 * ((r - 16) >> 2) + 4 + (r & 3));
  return blk + p;
}

__device__ __forceinline__ int g8_logical_col(int t) { return ((t & 127) >> 5) * 64 + (t >> 7) * 32 + (t & 31); }
__device__ __forceinline__ int win_map(int n) {
  if (n < 512) return n;
  if (n < 1024) return 768 + (n - 512);
  if (n < 3072) return 1352 + (n - 1024);
  if (n < 5120) return 3408 + (n - 3072);
  if (n < 5248) return 512 + (n - 5120);
  if (n < 5376) return 640 + (n - 5248);
  if (n < 5440) return 1280 + (n - 5376);
  if (n < 5448) return 1344 + (n - 5440);
  if (n < 5452) return 3400 + (n - 5448);
  if (n < 5456) return 3404 + (n - 5452);
  return -1;
}
__device__ __forceinline__ void transpose_tile(const float* __restrict__ src, int Nsrc, u16* __restrict__ dst, int K, int k0, int n0,
                               bool mapped, bool perm8, float* tile  ) {
  const int tid = TIDX;
  {
    const int tx = tid & 63, ty = tid >> 6;
    int n = n0 + tx;
    if (perm8) n = (n & ~255) + g8_logical_col(n & 255);
    int sc = mapped ? win_map(n) : n;
#pragma unroll
    for (int i = 0; i < 8; ++i) {
      int k = ty + 8 * i;
      float v = (sc >= 0) ? src[(size_t)(k0 + k) * Nsrc + sc] : 0.f;
      tile[k * 65 + tx] = v;
    }
  }
  __syncthreads();
  {
    const int n = tid >> 3, kc = (tid & 7) * 8;
    u32 w[4];
#pragma unroll
    for (int j = 0; j < 4; ++j) w[j] = pack2(tile[(kc + 2 * j) * 65 + n], tile[(kc + 2 * j + 1) * 65 + n]);
    *(uint4*)(dst + (size_t)(n0 + n) * K + k0 + kc) = make_uint4(w[0], w[1], w[2], w[3]);
  }
  __syncthreads();
}

template <bool Q8>
__device__ __forceinline__ void rmsnorm_rows(const float* __restrict__ x, const float* __restrict__ gain, u16* __restrict__ out,
                                             unsigned char* __restrict__ q8, float* __restrict__ qs) {
  const int lane = TIDX & 63, wave = TIDX >> 6;
  float4 g[4];
#pragma unroll
  for (int i = 0; i < 4; ++i) g[i] = ((const float4*)gain)[lane + 64 * i];
  for (int row = blockIdx.x * 8 + wave; row < MTOK; row += gridDim.x * 8) {
    const float4* xr = (const float4*)(x + (size_t)row * DM);
    float4 v[4];
    float ss = 0.f;
#pragma unroll
    for (int i = 0; i < 4; ++i) {
      v[i] = xr[lane + 64 * i];
      ss += v[i].x * v[i].x + v[i].y * v[i].y + v[i].z * v[i].z + v[i].w * v[i].w;
    }
    ss = wave_sum_dpp(ss);
    float r = rsqrtf(ss * (1.f / DM) + EPS);
    float amax = 0.f;
#pragma unroll
    for (int i = 0; i < 4; ++i) {
      v[i].x *= r * g[i].x; v[i].y *= r * g[i].y; v[i].z *= r * g[i].z; v[i].w *= r * g[i].w;
      uint2 o;
      o.x = pack2(v[i].x, v[i].y);
      o.y = pack2(v[i].z, v[i].w);
      *(uint2*)(out + (size_t)row * DM + 4 * (lane + 64 * i)) = o;
      if (Q8) amax = fmaxf(amax, fmaxf(fmaxf(fabsf(v[i].x), fabsf(v[i].y)), fmaxf(fabsf(v[i].z), fabsf(v[i].w))));
    }
    if (Q8) {
      amax = wave_max_dpp(amax);
      const float inv = amax > 0.f ? 127.f / amax : 0.f;
#pragma unroll
      for (int i = 0; i < 4; ++i) {
        const int q0 = (int)rintf(v[i].x * inv), q1 = (int)rintf(v[i].y * inv), q2 = (int)rintf(v[i].z * inv), q3 = (int)rintf(v[i].w * inv);
        *(u32*)(q8 + (size_t)row * DM + 4 * (lane + 64 * i)) =
            (u32)(q0 & 0xff) | ((u32)(q1 & 0xff) << 8) | ((u32)(q2 & 0xff) << 16) | ((u32)(q3 & 0xff) << 24);
      }
      if (lane == 0) qs[row] = amax * (1.f / 127.f);
    }
  }
}

__device__ __forceinline__ void phase0(const Params& p, unsigned char* smem) {
  float* tile = (float*)smem;
  unsigned char* ws = p.ws;
  const int n_in = 16 * 88, n_a = 8 * 16, n_b = 8 * 16, n_o = 16 * 16, n_q = 16 * 32;
  const int total = n_in + n_a + n_b + n_o + n_q;
  for (int t = blockIdx.x; t < total; t += gridDim.x) {
    int i = t;
    if (i < n_in) { transpose_tile(p.in[2], 5456, (u16*)(ws + OFF_WTIN), 1024, (i / 88) * 64, (i % 88) * 64, true, true, tile); continue; }
    i -= n_in;
    if (i < n_a) { transpose_tile(p.in[9], 1024, (u16*)(ws + OFF_WTA), 512, (i / 16) * 64, (i % 16) * 64, false, false, tile); continue; }
    i -= n_a;
    if (i < n_b) { transpose_tile(p.in[10], 1024, (u16*)(ws + OFF_WTB), 512, (i / 16) * 64, (i % 16) * 64, false, false, tile); continue; }
    i -= n_b;
    if (i < n_o) { transpose_tile(p.in[11], 1024, (u16*)(ws + OFF_WTO), 1024, (i / 16) * 64, (i % 16) * 64, false, true, tile); continue; }
    i -= n_o;
    transpose_tile(p.in[13], 2048, (u16*)(ws + OFF_WTQ), 1024, (i / 32) * 64, (i % 32) * 64, false, true, tile);
  }
  {
    const float* sk = p.in[14];
    u16* skb = (u16*)(ws + OFF_SKB);
    for (int i = blockIdx.x * NTHREADS + TIDX; i < 16 * 128 * 128; i += gridDim.x * NTHREADS) skb[i] = f2bf(sk[i]);
  }
  rmsnorm_rows<false>(p.in[0], p.in[1], (u16*)(ws + OFF_H), nullptr, nullptr);
}

constexpr int G_BM = 256, G_BN = 128, G_BK = 64;
constexpr int G_ABYTES = G_BM * 128;

template <int MI>
__device__ __forceinline__ void gemm_mainloop_t(const u16* __restrict__ A, int lda, const u16* __restrict__ Bt, int ldb, int K,
                                                int m0, int n0, unsigned char* smem, f32x4 (&acc)[MI][4]) {
  constexpr int BN = (MI == 4) ? 128 : 256;
  constexpr int NRB = BN / 64;
  constexpr int STAGE = G_ABYTES + BN * 128;
  const int tid = TIDX, lane = tid & 63, wave = tid >> 6;
  const int wm = (MI == 4) ? (wave >> 1) : (wave >> 2), wn = (MI == 4) ? (wave & 1) : (wave & 3);
#pragma unroll
  for (int i = 0; i < MI; ++i)
#pragma unroll
    for (int j = 0; j < 4; ++j) acc[i][j] = (f32x4){0.f, 0.f, 0.f, 0.f};
  const int kc = tid & 7;
  const int arow = tid >> 3;
  u32x4 ra[4], rb[NRB];
  const u16* ap = A + (size_t)(m0 + arow) * lda + kc * 8;
  const u16* bp = Bt + (size_t)(n0 + arow) * ldb + kc * 8;
  const int nk = K / G_BK;
  const int fr = lane & 15, fg = lane >> 4;
#define G_LOAD(kt_)                                                                       \
  {                                                                                       \
    const u16* ap2_ = ap + (size_t)(kt_) * G_BK;                                          \
    const u16* bp2_ = bp + (size_t)(kt_) * G_BK;                                          \
    _Pragma("unroll") for (int i = 0; i < 4; ++i) ra[i] = *(const u32x4*)(ap2_ + (size_t)(64 * i) * lda); \
    _Pragma("unroll") for (int i = 0; i < NRB; ++i) rb[i] = *(const u32x4*)(bp2_ + (size_t)(64 * i) * ldb); \
  }
#define G_STORE(st_)                                                                      \
  {                                                                                       \
    unsigned char* sa_ = smem + (st_) * STAGE;                                            \
    unsigned char* sb_ = sa_ + G_ABYTES;                                                  \
    _Pragma("unroll") for (int i = 0; i < 4; ++i) { int r = arow + 64 * i; *(u32x4*)(sa_ + r * 128 + ((kc ^ (r & 7)) << 4)) = ra[i]; } \
    _Pragma("unroll") for (int i = 0; i < NRB; ++i) { int r = arow + 64 * i; *(u32x4*)(sb_ + r * 128 + ((kc ^ (r & 7)) << 4)) = rb[i]; } \
  }
  G_LOAD(0)
  __syncthreads();
  G_STORE(0)
  if (nk > 1) G_LOAD(1)
  __syncthreads();
  for (int kt = 0; kt < nk; ++kt) {
    if (kt + 1 < nk) G_STORE((kt + 1) & 1)
    if (kt + 2 < nk) G_LOAD(kt + 2)
    __builtin_amdgcn_sched_barrier(0);
    const unsigned char* sa = smem + (kt & 1) * STAGE;
    const unsigned char* sb = sa + G_ABYTES;
#pragma unroll
    for (int kk = 0; kk < 2; ++kk) {
      bf16x8 bfr[4];
#pragma unroll
      for (int j = 0; j < 4; ++j) {
        int r = wn * 64 + j * 16 + fr;
        bfr[j] = *(const bf16x8*)(sb + r * 128 + (((kk * 4 + fg) ^ (r & 7)) << 4));
      }
#pragma unroll
      for (int ih = 0; ih < MI; ih += 4) {
        bf16x8 af[4];
#pragma unroll
        for (int i = 0; i < 4; ++i) {
          int r = wm * (MI * 16) + (ih + i) * 16 + fr;
          af[i] = *(const bf16x8*)(sa + r * 128 + (((kk * 4 + fg) ^ (r & 7)) << 4));
        }
#pragma unroll
        for (int i = 0; i < 4; ++i)
#pragma unroll
          for (int j = 0; j < 4; ++j) acc[ih + i][j] = __builtin_amdgcn_mfma_f32_16x16x32_bf16(af[i], bfr[j], acc[ih + i][j], 0, 0, 0);
        if (MI == 8 && ih == 0) __builtin_amdgcn_sched_barrier(0);
      }
    }
    __syncthreads();
  }
#undef G_LOAD
#undef G_STORE
}
__device__ __forceinline__ void gemm_mainloop(const u16* __restrict__ A, int lda, const u16* __restrict__ Bt, int ldb, int K,
                                              int m0, int n0, unsigned char* smem, f32x4 (&acc)[4][4]) {
  gemm_mainloop_t<4>(A, lda, Bt, ldb, K, m0, n0, smem, acc);
}

__device__ __forceinline__ int g8_lds_byte(int r, int c) {
  int st = (r >> 4) * 2 + (c >> 5), rr = r & 15, cc = c & 31, ob = rr * 64 + cc * 2;
  return st * 1024 + (ob ^ (((ob >> 9) & 1) << 5));
}
__device__ __forceinline__ void g8_stage_rc(int b, int& R, int& C) {
  int st = b / 1024, sb = b % 1024, swz = sb ^ (((sb >> 9) & 1) << 5);
  R = (st >> 1) * 16 + swz / 64; C = (st & 1) * 32 + (swz % 64) / 2;
}
typedef __attribute__((address_space(3))) unsigned int lds_u32;
__device__ __forceinline__ void gemm8_tile(const u16* __restrict__ A, const u16* __restrict__ Bt, int K, int brow, int bcol,
                                           unsigned char* smem, f32x4 (&acc)[2][2][4][2]) {
  constexpr int HTB = 16384;
  const int tid = TIDX;
  const int wid = tid >> 6, lane = tid & 63, wr = wid >> 2, wc = wid & 3, fr = lane & 15, fq = lane >> 4;
#define SA(b, h) (smem + ((b) * 2 + (h)) * HTB)
#define SB(b, h) (smem + (4 + (b) * 2 + (h)) * HTB)
#define STAGE(P, BASE, br, kt) do { const long _g = (long)(br) * K + (long)(kt) * 64; \
    _Pragma("unroll") for (int _i = 0; _i < 2; ++_i) { int _b = tid * 16 + _i * 8192; int _r, _c; g8_stage_rc(_b, _r, _c); \
      __builtin_amdgcn_global_load_lds((const unsigned int*)(BASE + _g + (long)_r * K + _c), \
        (lds_u32*)((P) + _b), 16, 0, 0); } } while (0)
#define LDA(dst, b, h) _Pragma("unroll") for (int m = 0; m < 4; ++m) _Pragma("unroll") for (int k = 0; k < 2; ++k) \
    dst[m][k] = *(const bf16x8*)(SA(b, h) + g8_lds_byte(wr * 64 + m * 16 + fr, k * 32 + fq * 8))
#define LDB(dst, b, h) _Pragma("unroll") for (int n = 0; n < 2; ++n) _Pragma("unroll") for (int k = 0; k < 2; ++k) \
    dst[n][k] = *(const bf16x8*)(SB(b, h) + g8_lds_byte(wc * 32 + n * 16 + fr, k * 32 + fq * 8))
#define MMA(ai, bj, At_, Bt_) do { __builtin_amdgcn_s_setprio(1); \
    _Pragma("unroll") for (int m = 0; m < 4; ++m) _Pragma("unroll") for (int n = 0; n < 2; ++n) _Pragma("unroll") for (int k = 0; k < 2; ++k) \
      acc[ai][bj][m][n] = __builtin_amdgcn_mfma_f32_16x16x32_bf16(At_[m][k], Bt_[n][k], acc[ai][bj][m][n], 0, 0, 0); \
    __builtin_amdgcn_s_setprio(0); } while (0)
#define WAIT_V(n) asm volatile("s_waitcnt vmcnt(" #n ")" ::: "memory")
#define WAIT_L(n) asm volatile("s_waitcnt lgkmcnt(" #n ")" ::: "memory")
#define BAR __builtin_amdgcn_s_barrier()
#define SCHED __builtin_amdgcn_sched_barrier(0)
#pragma unroll
  for (int a = 0; a < 2; ++a)
#pragma unroll
    for (int b2 = 0; b2 < 2; ++b2)
#pragma unroll
      for (int m = 0; m < 4; ++m)
#pragma unroll
        for (int n = 0; n < 2; ++n) acc[a][b2][m][n] = (f32x4){0.f, 0.f, 0.f, 0.f};
  bf16x8 At[4][2], B0[2][2], B1[2][2];
  const int nt = K / 64;
  constexpr int HALF = 128;
  __syncthreads();
  STAGE(SB(0, 0), Bt, bcol, 0); STAGE(SA(0, 0), A, brow, 0);
  STAGE(SB(0, 1), Bt, bcol + HALF, 0); STAGE(SA(0, 1), A, brow + HALF, 0);
  if (wr == 1) BAR;
  WAIT_V(4); BAR;
  STAGE(SB(1, 0), Bt, bcol, 1); STAGE(SA(1, 0), A, brow, 1); STAGE(SB(1, 1), Bt, bcol + HALF, 1);
  WAIT_V(6); BAR;
  for (int t = 0; t < nt - 2; t += 2) {
    LDB(B0, 0, 0); SCHED; LDA(At, 0, 0); STAGE(SA(1, 1), A, brow + HALF, t + 1);
    WAIT_L(8); BAR; WAIT_L(0); MMA(0, 0, At, B0); BAR; SCHED;
    LDB(B1, 0, 1); STAGE(SB(0, 0), Bt, bcol, t + 2);
    BAR; WAIT_L(0); MMA(0, 1, At, B1); BAR;
    LDA(At, 0, 1); STAGE(SA(0, 0), A, brow, t + 2);
    BAR; WAIT_L(0); MMA(1, 0, At, B0); BAR; SCHED;
    STAGE(SB(0, 1), Bt, bcol + HALF, t + 2);
    WAIT_V(6); BAR; MMA(1, 1, At, B1); BAR;
    LDB(B0, 1, 0); SCHED; LDA(At, 1, 0); STAGE(SA(0, 1), A, brow + HALF, t + 2);
    WAIT_L(8); BAR; WAIT_L(0); MMA(0, 0, At, B0); BAR; SCHED;
    LDB(B1, 1, 1); STAGE(SB(1, 0), Bt, bcol, t + 3);
    BAR; WAIT_L(0); MMA(0, 1, At, B1); BAR;
    LDA(At, 1, 1); STAGE(SA(1, 0), A, brow, t + 3);
    BAR; WAIT_L(0); MMA(1, 0, At, B0); BAR; SCHED;
    STAGE(SB(1, 1), Bt, bcol + HALF, t + 3);
    WAIT_V(6); BAR; MMA(1, 1, At, B1); BAR;
  }
  { LDB(B0, 0, 0); LDA(At, 0, 0); STAGE(SA(1, 1), A, brow + HALF, nt - 1);
    BAR; WAIT_L(0); MMA(0, 0, At, B0); BAR;
    LDB(B1, 0, 1); BAR; WAIT_L(0); MMA(0, 1, At, B1); BAR;
    LDA(At, 0, 1); WAIT_V(4); BAR; WAIT_L(0); MMA(1, 0, At, B0); MMA(1, 1, At, B1); BAR; }
  { LDB(B0, 1, 0); LDA(At, 1, 0); WAIT_V(2); BAR; WAIT_L(0); MMA(0, 0, At, B0); BAR;
    LDB(B1, 1, 1); WAIT_V(0); BAR; WAIT_L(0); MMA(0, 1, At, B1); BAR;
    LDA(At, 1, 1); BAR; WAIT_L(0); MMA(1, 0, At, B0); MMA(1, 1, At, B1); BAR; }
  if (wr == 0) BAR;
#undef SA
#undef SB
#undef STAGE
#undef LDA
#undef LDB
#undef MMA
#undef WAIT_V
#undef WAIT_L
#undef BAR
#undef SCHED
}

template <int LD, bool NORM>
__device__ __forceinline__ void ep_store(u16* __restrict__ dst, u32 ob, const f32x4 (&acc)[2][2][4][2], const float* __restrict__ gain,
                                         float extra, unsigned char* smem, int wave, int lane_in) {
  int lane = lane_in;
  asm volatile("" : "+v"(lane));
  const int fr = lane & 15, fq = lane >> 4;
  unsigned char* reg = smem + wave * 16384;
  float gj[4] = {1.f, 1.f, 1.f, 1.f};
  if (NORM) {
#pragma unroll
    for (int j = 0; j < 4; ++j) gj[j] = gain[j * 16 + fr] * extra;
  }
  const int lrot = (fr >> 3) + 2 * fq;
  unsigned char* wbase = reg + (4 * fq) * 128 + (fr & 7) * 2;
#pragma unroll
  for (int ai = 0; ai < 2; ++ai)
#pragma unroll
    for (int m = 0; m < 4; ++m) {
#pragma unroll
      for (int r = 0; r < 4; ++r) {
        float rs = 1.f;
        if (NORM) {
          float sq = 0.f;
#pragma unroll
          for (int bj = 0; bj < 2; ++bj)
#pragma unroll
            for (int n = 0; n < 2; ++n) sq += acc[ai][bj][m][n][r] * acc[ai][bj][m][n][r];
          sq += DPPF(sq, 0xb1); sq += DPPF(sq, 0x4e); sq += DPPF(sq, 0x141); sq += DPPF(sq, 0x140);
          rs = rsqrtf(sq * (1.f / 64.f) + EPS);
        }
#pragma unroll
        for (int bj = 0; bj < 2; ++bj)
#pragma unroll
          for (int n = 0; n < 2; ++n) {
            const float v = acc[ai][bj][m][n][r];
            const int ch = ((bj * 2 + n) * 2 + lrot) & 7;
            *(u16*)(wbase + (ai * 64 + m * 16 + r) * 128 + (ch << 4)) = f2bf(NORM ? v * rs * gj[bj * 2 + n] : v);
          }
      }
      __builtin_amdgcn_sched_barrier(0);
    }
  WAVE_LDS_SYNC();
  const int c16 = lane & 7, r8 = lane >> 3;
#pragma unroll
  for (int it = 0; it < 16; ++it) {
    const int rw = it * 8 + r8;
    const u32x4 v = *(const u32x4*)(reg + rw * 128 + (((c16 + 2 * ((rw >> 2) & 3)) & 7) << 4));
    const int grow = (it >> 3) * 128 + (it & 7) * 8 + r8;
    *(u32x4*)(dst + ob + (u32)(grow * LD + c16 * 8)) = v;
    if ((it & 3) == 3) __builtin_amdgcn_sched_barrier(0);
  }
}

__device__ __forceinline__ void phase1(const Params& p, unsigned char* smem) {
  const u16* H = (const u16*)(p.ws + OFF_H);
  const u16* WT = (const u16*)(p.ws + OFF_WTIN);
  u16* PROJ = (u16*)(p.ws + OFF_PROJ);
  u16* KVC = (u16*)(p.ws + OFF_KVC);
  u16* IKC = (u16*)(p.ws + OFF_IKC);
  float* SMALL = (float*)(p.ws + OFF_SMALL);
  const int lane = TIDX & 63, wave = TIDX >> 6;
  const int wr = wave >> 2, wc = wave & 3, fr = lane & 15, fq = lane >> 4;
  const int ntn = NPADW / 256;
  const int ntiles = (MTOK / 256) * ntn;
  for (int t = blockIdx.x; t < ntiles; t += gridDim.x) {
    const int m0 = (t / ntn) * 256, n0 = (t % ntn) * 256;
    f32x4 acc[2][2][4][2];
    gemm8_tile(H, WT, DM, m0, n0, smem, acc);
    const int cbase = n0 + wc * 64;
    const u32 rbase = (u32)(m0 + wr * 64);
    if (cbase < C_IQ) {
      ep_store<LDP, true>(PROJ, rbase * LDP + (u32)cbase, acc, p.in[3], 0.125f, smem, wave, lane);
    } else if (cbase < LDP) {
      ep_store<LDP, false>(PROJ, rbase * LDP + (u32)cbase, acc, nullptr, 1.f, smem, wave, lane);
    } else if (cbase < N_AV) {
      ep_store<256, true>(KVC, rbase * 256 + (u32)(cbase - N_AK), acc, p.in[4], 1.f, smem, wave, lane);
    } else if (cbase < N_IK) {
      ep_store<256, false>(KVC, rbase * 256 + (u32)(cbase - N_AV + 128), acc, nullptr, 1.f, smem, wave, lane);
    } else if (cbase < N_SM) {
      ep_store<64, false>(IKC, rbase * 64, acc, nullptr, 1.f, smem, wave, lane);
    } else if (cbase == N_SM) {
      const u32 sb0 = (rbase + 4 * fq) * 16 + (u32)fr;
#pragma unroll
      for (int ai = 0; ai < 2; ++ai)
#pragma unroll
        for (int m = 0; m < 4; ++m)
#pragma unroll
          for (int r = 0; r < 4; ++r) SMALL[sb0 + (u32)((ai * 128 + m * 16 + r) * 16)] = acc[ai][0][m][0][r];
    }
  }
}

constexpr int IDX_RS = 8208;

__device__ __forceinline__ u32 f2key(float x) {
  _Float16 h = (_Float16)x;
  u32 b = (u32) * (u16*)&h;
  return (b & 0x8000u) ? ((~b) & 0xffffu) : (b | 0x8000u);
}
__device__ __forceinline__ int count_ge_wave(const u32 (&kreg)[32], u32 mid) {
  const u32 m1 = (mid - 1u) * 0x00010001u;
  const u32 one = 0x00010001u;
  u32 acc0 = 0u, acc1 = 0u;
#pragma unroll
  for (int i = 0; i < 32; i += 2) {
    u32 t0, t1;
    asm("v_pk_sub_u16 %0, %1, %2 clamp" : "=v"(t0) : "v"(kreg[i]), "s"(m1));
    asm("v_pk_sub_u16 %0, %1, %2 clamp" : "=v"(t1) : "v"(kreg[i + 1]), "s"(m1));
    asm("v_pk_min_u16 %0, %1, %2" : "=v"(t0) : "v"(t0), "s"(one));
    asm("v_pk_min_u16 %0, %1, %2" : "=v"(t1) : "v"(t1), "s"(one));
    asm("v_pk_add_u16 %0, %1, %2" : "=v"(acc0) : "v"(acc0), "v"(t0));
    asm("v_pk_add_u16 %0, %1, %2" : "=v"(acc1) : "v"(acc1), "v"(t1));
  }
  int c = (int)((acc0 & 0xffffu) + (acc0 >> 16) + (acc1 & 0xffffu) + (acc1 >> 16));
  return wave_sum_i_dpp(c);
}

__device__ __forceinline__ void idx_item(const Params& p, unsigned char* smem, int b, int tq) {
  const u16* PROJ = (const u16*)(p.ws + OFF_PROJ);
  const float* SMALL = (const float*)(p.ws + OFF_SMALL);
  u16* SEL = (u16*)(p.ws + OFF_SEL);
  const int tid = TIDX, lane = tid & 63, wave = tid >> 6;
  const int t0 = tq * 16;
  const size_t tokb = (size_t)b * SEQ;
  if (tq < 16) {
    for (int rr = 0; rr < 2; ++rr) {
      int row = 2 * wave + rr, t = t0 + row;
      u16* out = SEL + (tokb + t) * 256;
      for (int i = lane; i < 256; i += 64) out[i] = (i <= t) ? (u16)i : (u16)0xFFFF;
    }
    return;
  }
  const int q = lane & 15, g = lane >> 4;
  __syncthreads();
  {
    const u16* iqrow = PROJ + (tokb + t0 + q) * LDP + C_IQ;
    bf16x8 bq[8][2];
    float wq[8];
#pragma unroll
    for (int h = 0; h < 8; ++h) {
      bq[h][0] = *(const bf16x8*)(iqrow + h * 64 + g * 8);
      bq[h][1] = *(const bf16x8*)(iqrow + h * 64 + 32 + g * 8);
      wq[h] = SMALL[(tokb + t0 + q) * 16 + h];
    }
    const int nkb = tq + 1;
    const int niter = (nkb > wave) ? ((nkb - wave + 7) >> 3) : 0;
    const u16* ikbase = (const u16*)(p.ws + OFF_IKC) + (tokb + q) * 64 + g * 8;
    bf16x8 ca[3][2];
#pragma unroll
    for (int j = 0; j < 3; ++j)
      if (j < niter) {
        const u16* ikrow = ikbase + (size_t)((wave + 8 * j) * 16) * 64;
        ca[j][0] = *(const bf16x8*)(ikrow); ca[j][1] = *(const bf16x8*)(ikrow + 32);
      }
    for (int i0 = 0; i0 < ((p.flags & 8) ? 0 : niter); i0 += 3) {
#pragma unroll
      for (int j = 0; j < 3; ++j) {
        if (i0 + j < niter) {
          const int s0 = (wave + 8 * (i0 + j)) * 16;
          f32x4 tot = {0.f, 0.f, 0.f, 0.f};
#pragma unroll
          for (int h = 0; h < 8; ++h) {
            f32x4 acc = {0.f, 0.f, 0.f, 0.f};
            acc = __builtin_amdgcn_mfma_f32_16x16x32_bf16(ca[j][0], bq[h][0], acc, 0, 0, 0);
            acc = __builtin_amdgcn_mfma_f32_16x16x32_bf16(ca[j][1], bq[h][1], acc, 0, 0, 0);
#pragma unroll
            for (int r = 0; r < 4; ++r) tot[r] += wq[h] * fmaxf(acc[r], 0.f);
          }
          if (i0 + 3 + j < niter) {
            const u16* ikrow = ikbase + (size_t)((wave + 8 * (i0 + 3 + j)) * 16) * 64;
            ca[j][0] = *(const bf16x8*)(ikrow); ca[j][1] = *(const bf16x8*)(ikrow + 32);
          }
          u32 k[4];
#pragma unroll
          for (int r = 0; r < 4; ++r) {
            int sidx = s0 + 4 * g + r;
            k[r] = (sidx <= t0 + q) ? f2key(tot[r]) : 0u;
          }
          u32x2 w2 = {k[0] | (k[1] << 16), k[2] | (k[3] << 16)};
          *(u32x2*)(smem + q * IDX_RS + (s0 + 4 * g) * 2) = w2;
        }
        __builtin_amdgcn_sched_barrier(0);
      }
    }
    const int nk = t0 + 16, nk64 = (nk + 63) & ~63;
    for (int i = tid; i < 16 * (nk64 - nk); i += NTHREADS) {
      int row = i / (nk64 - nk), c = nk + i % (nk64 - nk);
      *(u16*)(smem + row * IDX_RS + c * 2) = 0;
    }
  }
  __syncthreads();
  const int nk64 = (t0 + 16 + 63) & ~63;
  for (int rr = 0; rr < ((p.flags & 16) ? 0 : 2); ++rr) {
    const int row = 2 * wave + rr, t = t0 + row;
    u16* out = SEL + (tokb + t) * 256;
    u32 kreg[32];
    if (lane * 64 < nk64) {
      const uint4* src = (const uint4*)(smem + row * IDX_RS + lane * 128);
#pragma unroll
      for (int i = 0; i < 8; ++i) {
        uint4 v = src[i];
        kreg[4 * i] = v.x; kreg[4 * i + 1] = v.y; kreg[4 * i + 2] = v.z; kreg[4 * i + 3] = v.w;
      }
    } else {
#pragma unroll
      for (int i = 0; i < 32; ++i) kreg[i] = 0u;
    }
    WAVE_LDS_SYNC();
    u32 lo = 1u, hi = 65535u;
    while (lo < hi) {
      u32 mid = (lo + hi + 1u) >> 1;
      int c = count_ge_wave(kreg, mid);
      if (c >= 256) lo = mid; else hi = mid - 1u;
    }
    const u32 tau = lo;
    int gt = 0, eq = 0;
#pragma unroll
    for (int i = 0; i < 32; ++i) {
      u32 a = kreg[i] & 0xffffu, c2 = kreg[i] >> 16;
      gt += (a > tau) ? 1 : 0; gt += (c2 > tau) ? 1 : 0;
      eq += (a == tau) ? 1 : 0; eq += (c2 == tau) ? 1 : 0;
    }
    int packed = gt | (eq << 16);
    int incl = packed;
#pragma unroll
    for (int o = 1; o < 64; o <<= 1) {
      int v = __shfl_up(incl, o);
      if (lane >= o) incl += v;
    }
    const int excl = incl - packed;
    const int total = __shfl(incl, 63);
    const int need = 256 - (total & 0xffff);
    const int pg = excl & 0xffff, pe = excl >> 16;
    int pos = pg + min(pe, need);
    int eqseen = pe;
    u16* lrow = (u16*)(smem + row * IDX_RS);
#pragma unroll
    for (int i = 0; i < 32; ++i) {
#pragma unroll
      for (int hh = 0; hh < 2; ++hh) {
        u32 kv = hh ? (kreg[i] >> 16) : (kreg[i] & 0xffffu);
        int idx = lane * 64 + 2 * i + hh;
        bool take = false;
        if (kv > tau) take = true;
        else if (kv == tau) { take = (eqseen < need); ++eqseen; }
        if (take) { lrow[pos] = (u16)idx; ++pos; }
      }
    }
    WAVE_LDS_SYNC();
    *(u32x2*)(out + lane * 4) = *(const u32x2*)(lrow + lane * 4);
    WAVE_LDS_SYNC();
  }
}

constexpr int DNP = 68;
constexpr int DL_KT = 0;
constexpr int DL_V = DL_KT + 128 * DNP * 4;
constexpr int DL_QB = DL_V + 64 * 128 * 4;
constexpr int DL_KB = DL_QB + 64 * 272;
constexpr int DL_SM = DL_KB + 64 * 272;
constexpr int DL_RAW = DL_SM + 2048;
static_assert(DL_RAW + 3 * 67 * 272 <= SMEM_BYTES, "dn_local LDS");
__device__ __forceinline__ void dn_local_item(const Params& p, unsigned char* smem, int item) {
  const int h = item & 3, n = (item >> 2) & 63, b = item >> 8;
  const u16* PROJ = (const u16*)(p.ws + OFF_PROJ);
  const float* SMALL = (const float*)(p.ws + OFF_SMALL);
  u16* Ug = (u16*)((unsigned char*)p.out + DO_U);
  u16* Wg = (u16*)((unsigned char*)p.out + DO_W);
  u16* QNg = (u16*)((unsigned char*)p.out + DO_QN);
  u16* KNTg = (u16*)((unsigned char*)p.out + DO_KNT);
  u16* ATTg = (u16*)(p.ws + OFF_ATT);
  float* GCg = (float*)(p.ws + OFF_GC);
  const float* convw = p.in[5];
  const int tid = TIDX, lane = tid & 63, wave = tid >> 6;
  const int c0 = n * 64;
  const size_t tok0 = (size_t)b * SEQ + c0;
  float* Kt = (float*)(smem + DL_KT);
  float* V = (float*)(smem + DL_V);
  unsigned char* Qb = smem + DL_QB;
  unsigned char* Kb = smem + DL_KB;
  float* gc = (float*)(smem + DL_SM);
  float* beta = gc + 64;
  float* ssp = beta + 64;
  unsigned char* RAW = smem + DL_RAW;
  float* AmT = (float*)(smem + DL_RAW);
  __syncthreads();
  {
    u32x4 rg[7];
#pragma unroll
    for (int k = 0; k < 7; ++k) {
      const int ci = tid + 512 * k;
      rg[k] = (u32x4){0u, 0u, 0u, 0u};
      if (ci < 3216) {
        const int arr = ci / 1072, rem = ci - arr * 1072, row = rem >> 4, ch = rem & 15;
        const int trel = c0 - 3 + row;
        if (trel >= 0)
          rg[k] = *(const u32x4*)(PROJ + ((size_t)b * SEQ + trel) * LDP + (C_DQ + arr * 512) + h * 128 + ch * 8);
      }
    }
#pragma unroll
    for (int k = 0; k < 7; ++k) {
      const int ci = tid + 512 * k;
      if (ci < 3216) {
        const int arr = ci / 1072, rem = ci - arr * 1072, row = rem >> 4, ch = rem & 15;
        *(u32x4*)(RAW + (arr * 67 + row) * 272 + ch * 16) = rg[k];
      }
    }
  }
  if (tid < 64) {
    float da = SMALL[(tok0 + tid) * 16 + 8 + h], db = SMALL[(tok0 + tid) * 16 + 12 + h];
    float xx = da + p.in[7][h];
    float sp = fmaxf(xx, 0.f) + log1pf(__expf(-fabsf(xx)));
    float gr = -__expf(p.in[6][h]) * sp;
    float incl = gr;
#pragma unroll
    for (int o = 1; o < 64; o <<= 1) {
      float v = __shfl_up(incl, o);
      if (lane >= o) incl += v;
    }
    gc[tid] = incl;
    beta[tid] = sigmoidf_(db);
    GCg[(tok0 + tid) * 4 + h] = incl;
  }
  __syncthreads();
  {
    const int c = tid & 127, tg = tid >> 7;
    float qv[16], kv[16];
#pragma unroll
    for (int arr = 0; arr < 3; ++arr) {
      const float w0 = convw[0 * 1536 + arr * 512 + h * 128 + c], w1 = convw[1 * 1536 + arr * 512 + h * 128 + c],
                  w2 = convw[2 * 1536 + arr * 512 + h * 128 + c], w3 = convw[3 * 1536 + arr * 512 + h * 128 + c];
      const unsigned char* rp = RAW + (arr * 67 + tg * 16) * 272 + c * 2;
      float x0 = bf2f(*(const u16*)(rp)), x1 = bf2f(*(const u16*)(rp + 272)), x2 = bf2f(*(const u16*)(rp + 2 * 272));
#pragma unroll
      for (int ii = 0; ii < 16; ++ii) {
        const float x3 = bf2f(*(const u16*)(rp + (ii + 3) * 272));
        const float y = w0 * x0 + w1 * x1 + w2 * x2 + w3 * x3;
        const float sv = y * sigmoidf_(y);
        if (arr == 0) qv[ii] = sv;
        else if (arr == 1) kv[ii] = sv;
        else V[(tg * 16 + ii) * 128 + c] = sv;
        x0 = x1; x1 = x2; x2 = x3;
      }
    }
#pragma unroll
    for (int ii = 0; ii < 16; ++ii) {
      const float sq = wave_sum_dpp(qv[ii] * qv[ii]);
      const float sk = wave_sum_dpp(kv[ii] * kv[ii]);
      if (lane == 0) {
        ssp[((tg * 16 + ii) * 2) + (wave & 1)] = sq;
        ssp[128 + ((tg * 16 + ii) * 2) + (wave & 1)] = sk;
      }
    }
    __syncthreads();
#pragma unroll
    for (int ii = 0; ii < 16; ++ii) {
      const int i = tg * 16 + ii;
      const float qsc = rsqrtf(ssp[i * 2] + ssp[i * 2 + 1] + EPS) * 0.08838834764831845f;
      const float ksc = rsqrtf(ssp[128 + i * 2] + ssp[128 + i * 2 + 1] + EPS);
      const float qn = qv[ii] * qsc, kn = kv[ii] * ksc;
      *(u16*)(Qb + i * 272 + c * 2) = f2bf(qn);
      *(u16*)(Kb + i * 272 + c * 2) = f2bf(kn);
      Kt[c * DNP + i] = kn;
    }
  }
  __syncthreads();
#pragma unroll
  for (int k = 0; k < 4; ++k) {
    const int gi = tid + 512 * k;
    {
      const int i = gi >> 5, d4 = (gi & 31) * 4;
      const u32x2 v = *(const u32x2*)(Qb + i * 272 + d4 * 2);
      *(u32x2*)(QNg + (tok0 + i) * 512 + h * 128 + perm32(d4)) = v;
    }
    {
      const int d = gi >> 4, t4 = (gi & 15) * 4;
      const f32x4 v = *(const f32x4*)(Kt + d * DNP + t4);
      u32x2 o = {pack2(v[0], v[1]), pack2(v[2], v[3])};
      *(u32x2*)(KNTg + (size_t)item * 8192 + d * 64 + perm32(t4)) = o;
    }
  }
  {
    const int mat = wave >> 2, it = wave & 3;
    const int fr = lane & 15, fg = lane >> 4;
    const unsigned char* Ab = mat ? Qb : Kb;
    bf16x8 af[4];
#pragma unroll
    for (int kk = 0; kk < 4; ++kk) af[kk] = *(const bf16x8*)(Ab + (it * 16 + fr) * 272 + kk * 64 + fg * 16);
    f32x4 gi4 = *(const f32x4*)(gc + it * 16 + 4 * fg);
    f32x4 bi4 = *(const f32x4*)(beta + it * 16 + 4 * fg);
#pragma unroll
    for (int jt = 0; jt < 4; ++jt) {
      f32x4 acc = {0.f, 0.f, 0.f, 0.f};
      if (jt <= it) {
#pragma unroll
        for (int kk = 0; kk < 4; ++kk) {
          bf16x8 bfg = *(const bf16x8*)(Kb + (jt * 16 + fr) * 272 + kk * 64 + fg * 16);
          acc = __builtin_amdgcn_mfma_f32_16x16x32_bf16(af[kk], bfg, acc, 0, 0, 0);
        }
      }
      const int j = jt * 16 + fr;
      const float gj = gc[j];
#pragma unroll
      for (int r = 0; r < 4; ++r) {
        const int i = it * 16 + 4 * fg + r;
        const float dec = __expf(fminf(gi4[r] - gj, 0.f));
        if (mat == 0) { if (jt <= it) AmT[j * 64 + i] = (i > j) ? bi4[r] * acc[r] * dec : 0.f; }
        else ATTg[(size_t)item * 4096 + i * 64 + perm32(j)] = f2bf((i >= j) ? acc[r] * dec : 0.f);
      }
    }
  }
  __syncthreads();
  if (tid < 256) {
    const int c = tid;
    const bool isu = c < 128;
    const int cc = c & 127;
    const int pc = perm32(cc);
#pragma unroll 1
    for (int ib = 0; ib < 4; ++ib) {
      float sreg[16];
#pragma unroll
      for (int r = 0; r < 16; ++r) {
        int i = ib * 16 + r;
        sreg[r] = isu ? V[i * 128 + cc] * beta[i] : Kt[cc * DNP + i] * beta[i] * __expf(gc[i]);
      }
#pragma unroll 1
      for (int j = 0; j < ib * 16; ++j) {
        float xj = isu ? V[j * 128 + cc] : Kt[cc * DNP + j];
        const f32x4* ap = (const f32x4*)(AmT + j * 64 + ib * 16);
        f32x4 a0 = ap[0], a1 = ap[1], a2 = ap[2], a3 = ap[3];
        sreg[0] -= a0[0] * xj; sreg[1] -= a0[1] * xj; sreg[2] -= a0[2] * xj; sreg[3] -= a0[3] * xj;
        sreg[4] -= a1[0] * xj; sreg[5] -= a1[1] * xj; sreg[6] -= a1[2] * xj; sreg[7] -= a1[3] * xj;
        sreg[8] -= a2[0] * xj; sreg[9] -= a2[1] * xj; sreg[10] -= a2[2] * xj; sreg[11] -= a2[3] * xj;
        sreg[12] -= a3[0] * xj; sreg[13] -= a3[1] * xj; sreg[14] -= a3[2] * xj; sreg[15] -= a3[3] * xj;
      }
#pragma unroll
      for (int q = 0; q < 15; ++q) {
        const float* ar = AmT + (ib * 16 + q) * 64 + ib * 16;
#pragma unroll
        for (int r = q + 1; r < 16; ++r) sreg[r] -= ar[r] * sreg[q];
      }
#pragma unroll
      for (int r = 0; r < 16; ++r) {
        int i = ib * 16 + r;
        if (isu) { V[i * 128 + cc] = sreg[r]; Ug[(tok0 + i) * 512 + h * 128 + cc] = f2bf(sreg[r]); }
        else { Kt[cc * DNP + i] = sreg[r]; Wg[(tok0 + i) * 512 + h * 128 + pc] = f2bf(sreg[r]); }
      }
    }
  }
}

__device__ __forceinline__ void phase2(const Params& p, unsigned char* smem) {
#ifndef NO_IDX
  for (int i = blockIdx.x; i < 2048; i += gridDim.x) idx_item(p, smem, i & 7, 255 - (i >> 3));
#endif
#ifndef NO_DNL
  if (!(p.flags & 1))
    for (int i = blockIdx.x; i < 2048; i += gridDim.x) dn_local_item(p, smem, i);
#endif
}

constexpr int SC_WP = 272, SC_KP = 144;
constexpr int SC_W = 0, SC_Q = 64 * SC_WP, SC_KT = 2 * 64 * SC_WP, SC_AT = SC_KT + 128 * SC_KP, SC_U = SC_AT + 64 * SC_KP,
              SC_BUF = SC_U + 64 * SC_WP;
constexpr int SC_GC = 2 * SC_BUF;
static_assert(SC_GC + 2 * 64 * 4 <= SMEM_BYTES, "scan LDS");

__device__ __forceinline__ void dn_scan_item(const Params& p, unsigned char* smem, int bh) {
  const int h = bh & 3, b = bh >> 2;
  const u16* Ug = (const u16*)((const unsigned char*)p.out + DO_U);
  const u16* Wg = (const u16*)((const unsigned char*)p.out + DO_W);
  const u16* QNg = (const u16*)((const unsigned char*)p.out + DO_QN);
  const u16* KNTg = (const u16*)((const unsigned char*)p.out + DO_KNT);
  const u16* ATTg = (const u16*)(p.ws + OFF_ATT);
  const float* GCg = (const float*)(p.ws + OFF_GC);
  const u16* PROJ = (const u16*)(p.ws + OFF_PROJ);
  u16* YDN = (u16*)(p.ws + OFF_YDN);
  const float* ogain = p.in[8];
  const int tid = TIDX, lane = tid & 63, wave = tid >> 6;
  const int fr = lane & 15, fg = lane >> 4;
  const int ecol = wave * 16 + fr;
  float* gcs = (float*)(smem + SC_GC);
  f32x4 S[8];
#pragma unroll
  for (int d = 0; d < 8; ++d) S[d] = (f32x4){0.f, 0.f, 0.f, 0.f};
  u32x4 st[9];
  float gcr = 0.f;
  const int r16 = tid >> 4, c16 = tid & 15;
  const int r8 = tid >> 3, c8 = tid & 7;
#define SCAN_LOAD(n_)                                                                                      \
  {                                                                                                        \
    const size_t tk0 = (size_t)b * SEQ + (size_t)(n_) * 64;                                                \
    const size_t it_ = (size_t)((b * 64 + (n_)) * 4 + h);                                                  \
    st[0] = *(const u32x4*)(Wg + (tk0 + r16) * 512 + h * 128 + c16 * 8);                                   \
    st[1] = *(const u32x4*)(Wg + (tk0 + r16 + 32) * 512 + h * 128 + c16 * 8);                              \
    st[2] = *(const u32x4*)(QNg + (tk0 + r16) * 512 + h * 128 + c16 * 8);                                  \
    st[3] = *(const u32x4*)(QNg + (tk0 + r16 + 32) * 512 + h * 128 + c16 * 8);                             \
    st[4] = *(const u32x4*)(KNTg + it_ * 8192 + (size_t)tid * 8);                                          \
    st[5] = *(const u32x4*)(KNTg + it_ * 8192 + (size_t)(tid + 512) * 8);                                  \
    st[6] = *(const u32x4*)(ATTg + it_ * 4096 + (size_t)tid * 8);                                          \
    st[7] = *(const u32x4*)(Ug + (tk0 + r16) * 512 + h * 128 + c16 * 8);                                   \
    st[8] = *(const u32x4*)(Ug + (tk0 + r16 + 32) * 512 + h * 128 + c16 * 8);                              \
    if (tid < 64) gcr = GCg[(tk0 + tid) * 4 + h];                                                          \
  }
#define SCAN_STORE(buf_)                                                                                   \
  {                                                                                                        \
    unsigned char* bs_ = smem + (buf_) * SC_BUF;                                                           \
    *(u32x4*)(bs_ + SC_W + r16 * SC_WP + c16 * 16) = st[0];                                                \
    *(u32x4*)(bs_ + SC_W + (r16 + 32) * SC_WP + c16 * 16) = st[1];                                         \
    *(u32x4*)(bs_ + SC_Q + r16 * SC_WP + c16 * 16) = st[2];                                                \
    *(u32x4*)(bs_ + SC_Q + (r16 + 32) * SC_WP + c16 * 16) = st[3];                                         \
    *(u32x4*)(bs_ + SC_KT + r8 * SC_KP + c8 * 16) = st[4];                                                 \
    *(u32x4*)(bs_ + SC_KT + (r8 + 64) * SC_KP + c8 * 16) = st[5];                                          \
    *(u32x4*)(bs_ + SC_AT + r8 * SC_KP + c8 * 16) = st[6];                                                 \
    *(u32x4*)(bs_ + SC_U + r16 * SC_WP + c16 * 16) = st[7];                                                \
    *(u32x4*)(bs_ + SC_U + (r16 + 32) * SC_WP + c16 * 16) = st[8];                                         \
    if (tid < 64) gcs[(buf_) * 64 + tid] = gcr;                                                            \
  }
  __syncthreads();
  SCAN_LOAD(0)
  SCAN_STORE(0)
  if (1 < 64) SCAN_LOAD(1)
  __syncthreads();
  for (int n = 0; n < 64; ++n) {
    const int buf = n & 1;
    const size_t tok0 = (size_t)b * SEQ + n * 64;
    if (n + 1 < 64) SCAN_STORE(buf ^ 1)
    if (n + 2 < 64) SCAN_LOAD(n + 2)
    __builtin_amdgcn_sched_barrier(0);
    const unsigned char* base = smem + buf * SC_BUF;
    const u32 ub0 = (u32)(tok0 + 4 * fg) * 512 + (u32)(h * 128 + ecol);
    const float* gcb = gcs + buf * 64 + 4 * fg;
    const float glast = gcs[buf * 64 + 63];
    bf16x8 Sb[4];
#pragma unroll
    for (int kk = 0; kk < 4; ++kk) {
      union { u32 w[4]; bf16x8 v; } cv;
      cv.w[0] = pack2(S[2 * kk][0], S[2 * kk][1]); cv.w[1] = pack2(S[2 * kk][2], S[2 * kk][3]);
      cv.w[2] = pack2(S[2 * kk + 1][0], S[2 * kk + 1][1]); cv.w[3] = pack2(S[2 * kk + 1][2], S[2 * kk + 1][3]);
      Sb[kk] = cv.v;
    }
    f32x4 vnew[4], ov[4];
#pragma unroll
    for (int m = 0; m < 4; ++m) {
      f32x4 aw = {0.f, 0.f, 0.f, 0.f}, aq = {0.f, 0.f, 0.f, 0.f};
#pragma unroll
      for (int kk = 0; kk < 4; ++kk) {
        bf16x8 wf = *(const bf16x8*)(base + SC_W + (m * 16 + fr) * SC_WP + kk * 64 + fg * 16);
        bf16x8 qf = *(const bf16x8*)(base + SC_Q + (m * 16 + fr) * SC_WP + kk * 64 + fg * 16);
        aw = __builtin_amdgcn_mfma_f32_16x16x32_bf16(wf, Sb[kk], aw, 0, 0, 0);
        aq = __builtin_amdgcn_mfma_f32_16x16x32_bf16(qf, Sb[kk], aq, 0, 0, 0);
      }
      f32x4 g4 = *(const f32x4*)(gcb + m * 16);
#pragma unroll
      for (int r = 0; r < 4; ++r) {
        float uv = bf2f(*(const u16*)(base + SC_U + (m * 16 + 4 * fg + r) * SC_WP + ecol * 2));
        vnew[m][r] = uv - aw[r];
        ov[m][r] = aq[r] * __expf(g4[r]);
      }
    }
    bf16x8 vb[2], vsb[2];
#pragma unroll
    for (int k2 = 0; k2 < 2; ++k2) {
      union { u32 w[4]; bf16x8 v; } c1, c2;
      const int ma = 2 * k2, mb = 2 * k2 + 1;
      c1.w[0] = pack2(vnew[ma][0], vnew[ma][1]); c1.w[1] = pack2(vnew[ma][2], vnew[ma][3]);
      c1.w[2] = pack2(vnew[mb][0], vnew[mb][1]); c1.w[3] = pack2(vnew[mb][2], vnew[mb][3]);
      f32x4 ga4 = *(const f32x4*)(gcb + ma * 16), gb4 = *(const f32x4*)(gcb + mb * 16);
      float sa[4], sb2[4];
#pragma unroll
      for (int r = 0; r < 4; ++r) { sa[r] = vnew[ma][r] * __expf(glast - ga4[r]); sb2[r] = vnew[mb][r] * __expf(glast - gb4[r]); }
      c2.w[0] = pack2(sa[0], sa[1]); c2.w[1] = pack2(sa[2], sa[3]);
      c2.w[2] = pack2(sb2[0], sb2[1]); c2.w[3] = pack2(sb2[2], sb2[3]);
      vb[k2] = c1.v; vsb[k2] = c2.v;
    }
    const float egl = __expf(glast);
#pragma unroll
    for (int d = 0; d < 8; ++d) {
      f32x4 a = S[d] * egl;
#pragma unroll
      for (int k2 = 0; k2 < 2; ++k2) {
        bf16x8 kf = *(const bf16x8*)(base + SC_KT + (d * 16 + fr) * SC_KP + k2 * 64 + fg * 16);
        a = __builtin_amdgcn_mfma_f32_16x16x32_bf16(kf, vsb[k2], a, 0, 0, 0);
      }
      S[d] = a;
    }
#pragma unroll
    for (int m = 0; m < 4; ++m) {
      f32x4 ao = ov[m];
#pragma unroll
      for (int k2 = 0; k2 < 2; ++k2) {
        bf16x8 af = *(const bf16x8*)(base + SC_AT + (m * 16 + fr) * SC_KP + k2 * 64 + fg * 16);
        ao = __builtin_amdgcn_mfma_f32_16x16x32_bf16(af, vb[k2], ao, 0, 0, 0);
      }
#pragma unroll
      for (int r = 0; r < 4; ++r) YDN[ub0 + (u32)((m * 16 + r) * 512)] = f2bf(ao[r]);
    }
    __syncthreads();
  }
#undef SCAN_LOAD
#undef SCAN_STORE
  asm volatile("s_waitcnt vmcnt(0)" ::: "memory");
  __syncthreads();
  {
    const int sub = lane >> 4, l16 = lane & 15;
    float gn8[8];
#pragma unroll
    for (int e = 0; e < 8; ++e) gn8[e] = ogain[l16 * 8 + e];
    for (int t = wave * 4 + sub; t < SEQ; t += 32) {
      const size_t tok = (size_t)b * SEQ + t;
      u16* yp = YDN + tok * 512 + h * 128 + l16 * 8;
      const u32x4 ov4 = *(const u32x4*)yp;
      const u32x4 zv4 = *(const u32x4*)(PROJ + tok * LDP + C_DZ + h * 128 + l16 * 8);
      float o8[8], z8[8];
#pragma unroll
      for (int c = 0; c < 4; ++c) { o8[2 * c] = bflo(ov4[c]); o8[2 * c + 1] = bfhi(ov4[c]); z8[2 * c] = bflo(zv4[c]); z8[2 * c + 1] = bfhi(zv4[c]); }
      float sq = 0.f;
#pragma unroll
      for (int e = 0; e < 8; ++e) sq += o8[e] * o8[e];
      sq += DPPF(sq, 0xb1); sq += DPPF(sq, 0x4e); sq += DPPF(sq, 0x141); sq += DPPF(sq, 0x140);
      const float rstd = rsqrtf(sq * (1.f / 128.f) + EPS);
      u32 w[4];
#pragma unroll
      for (int c = 0; c < 4; ++c) {
        const float y0 = o8[2 * c] * rstd * gn8[2 * c] * z8[2 * c] * sigmoidf_(z8[2 * c]);
        const float y1 = o8[2 * c + 1] * rstd * gn8[2 * c + 1] * z8[2 * c + 1] * sigmoidf_(z8[2 * c + 1]);
        w[c] = pack2(y0, y1);
      }
      *(u32x4*)yp = (u32x4){w[0], w[1], w[2], w[3]};
    }
  }
}

constexpr int AT_WAVE_BYTES = 8192 + 512 + 8192;
__device__ __forceinline__ float xor16_sum(float v) {
  auto r = __builtin_amdgcn_permlane16_swap(__float_as_uint(v), __float_as_uint(v), false, false);
  return __uint_as_float(r[0]) + __uint_as_float(r[1]);
}
__device__ __forceinline__ float xor32_sum(float v) {
  auto r = __builtin_amdgcn_permlane32_swap(__float_as_uint(v), __float_as_uint(v), false, false);
  return __uint_as_float(r[0]) + __uint_as_float(r[1]);
}
__device__ __forceinline__ void attn_query(const Params& p, unsigned char* wsm, int b, int t) {
  const u16* PROJ = (const u16*)(p.ws + OFF_PROJ);
  const u16* SEL = (const u16*)(p.ws + OFF_SEL);
  const u16* KVC = (const u16*)(p.ws + OFF_KVC);
  u16* YATT = (u16*)(p.ws + OFF_YATT);
  const int lane = TIDX & 63;
  const int fr = lane & 15, fg = lane >> 4;
  float* P = (float*)wsm;
  u16* sl = (u16*)(wsm + 8192);
  const size_t tokb = (size_t)b * SEQ;
  const size_t tok = tokb + t;
  const int nsel = min(256, t + 1);
  bf16x8 qb[2][2];
  {
    const bf16x8 z = {0, 0, 0, 0, 0, 0, 0, 0};
    const u16* qrow = PROJ + tok * LDP + C_AQ + (fr & 3) * 64 + fg * 8;
#pragma unroll
    for (int g = 0; g < 2; ++g)
#pragma unroll
      for (int kk = 0; kk < 2; ++kk) {
        bf16x8 v = *(const bf16x8*)(qrow + g * 256 + kk * 32);
        qb[g][kk] = (fr < 4) ? v : z;
      }
    const u16* sr = SEL + tok * 256;
#pragma unroll
    for (int i = 0; i < 4; ++i) sl[lane + 64 * i] = sr[lane + 64 * i];
  }
  WAVE_LDS_SYNC();
  const int ngrp = (nsel + 15) >> 4;
  const int nbq = (ngrp + 1) >> 1;
  unsigned char* KST = wsm + 8192 + 512;
  const int kq = lane >> 3, kch = lane & 7;
  u32x4 kA[2][4], kB[2][4];
#define QK_LOAD(buf_, bi_)                                                                       \
  _Pragma("unroll") for (int j = 0; j < 2; ++j)                                                  \
    _Pragma("unroll") for (int hf = 0; hf < 2; ++hf) {                                           \
      const int ki_ = min(((bi_) * 2 + j) * 16 + hf * 8 + kq, 255);                              \
      const int s_ = (int)sl[ki_] & 4095;                                                        \
      const u16* krow_ = KVC + (tokb + s_) * 256 + kch * 8;                                      \
      buf_[j][hf * 2] = *(const u32x4*)(krow_); buf_[j][hf * 2 + 1] = *(const u32x4*)(krow_ + 64); \
    }
#define QK_COMPUTE(buf_, bi_)                                                                    \
  {                                                                                              \
    _Pragma("unroll") for (int j = 0; j < 2; ++j)                                                \
      _Pragma("unroll") for (int hf = 0; hf < 2; ++hf) {                                         \
        const int row_ = hf * 8 + kq;                                                            \
        _Pragma("unroll") for (int g = 0; g < 2; ++g)                                            \
          *(u32x4*)(KST + j * 4096 + (row_ * 2 + g) * 128 + ((kch ^ (row_ & 7)) << 4)) = buf_[j][hf * 2 + g]; \
      }                                                                                          \
    WAVE_LDS_SYNC();                                                                             \
    _Pragma("unroll") for (int j = 0; j < 2; ++j) {                                              \
      const unsigned char* kr_ = KST + j * 4096 + fr * 256;                                      \
      const bf16x8 a00_ = *(const bf16x8*)(kr_ + (((0 + fg) ^ (fr & 7)) << 4));                  \
      const bf16x8 a01_ = *(const bf16x8*)(kr_ + (((4 + fg) ^ (fr & 7)) << 4));                  \
      const bf16x8 a10_ = *(const bf16x8*)(kr_ + 128 + (((0 + fg) ^ (fr & 7)) << 4));            \
      const bf16x8 a11_ = *(const bf16x8*)(kr_ + 128 + (((4 + fg) ^ (fr & 7)) << 4));            \
      f32x4 c0_ = {0.f, 0.f, 0.f, 0.f}, c1_ = {0.f, 0.f, 0.f, 0.f};                              \
      c0_ = __builtin_amdgcn_mfma_f32_16x16x32_bf16(a00_, qb[0][0], c0_, 0, 0, 0);               \
      c0_ = __builtin_amdgcn_mfma_f32_16x16x32_bf16(a01_, qb[0][1], c0_, 0, 0, 0);               \
      c1_ = __builtin_amdgcn_mfma_f32_16x16x32_bf16(a10_, qb[1][0], c1_, 0, 0, 0);               \
      c1_ = __builtin_amdgcn_mfma_f32_16x16x32_bf16(a11_, qb[1][1], c1_, 0, 0, 0);               \
      if (fr < 4) {                                                                              \
        _Pragma("unroll") for (int r = 0; r < 4; ++r) {                                          \
          const int kk2_ = ((bi_) * 2 + j) * 16 + 4 * fg + r;                                    \
          if (kk2_ < 256) {                                                                      \
            const bool v_ = kk2_ < nsel;                                                         \
            P[kk2_ * 8 + fr] = v_ ? c0_[r] : -1e30f;                                             \
            P[kk2_ * 8 + 4 + fr] = v_ ? c1_[r] : -1e30f;                                         \
          }                                                                                      \
        }                                                                                        \
      }                                                                                          \
    }                                                                                            \
    WAVE_LDS_SYNC();                                                                             \
  }
  QK_LOAD(kA, 0)
  for (int bi = 0; bi < nbq; bi += 2) {
    if (bi + 1 < nbq) { QK_LOAD(kB, bi + 1) }
    QK_COMPUTE(kA, bi)
    if (bi + 2 < nbq) { QK_LOAD(kA, bi + 2) }
    if (bi + 1 < nbq) { QK_COMPUTE(kB, bi + 1) }
  }
#undef QK_LOAD
#undef QK_COMPUTE
  for (int ki = nbq * 32 + lane; ki < 256; ki += 64) {
    *(f32x4*)(P + ki * 8) = (f32x4){-1e30f, -1e30f, -1e30f, -1e30f};
    *(f32x4*)(P + ki * 8 + 4) = (f32x4){-1e30f, -1e30f, -1e30f, -1e30f};
  }
  WAVE_LDS_SYNC();
  float inv8[8];
  {
    float lg[4][8];
#pragma unroll
    for (int i = 0; i < 4; ++i) {
      f32x4 x0 = *(const f32x4*)(P + (lane + 64 * i) * 8), x1 = *(const f32x4*)(P + (lane + 64 * i) * 8 + 4);
      lg[i][0] = x0[0]; lg[i][1] = x0[1]; lg[i][2] = x0[2]; lg[i][3] = x0[3];
      lg[i][4] = x1[0]; lg[i][5] = x1[1]; lg[i][6] = x1[2]; lg[i][7] = x1[3];
    }
    WAVE_LDS_SYNC();
    u16* PT = (u16*)P;
#pragma unroll
    for (int hh = 0; hh < 8; ++hh) {
      float m = fmaxf(fmaxf(lg[0][hh], lg[1][hh]), fmaxf(lg[2][hh], lg[3][hh]));
      m = wave_max_dpp(m);
      float e[4], sum = 0.f;
#pragma unroll
      for (int i = 0; i < 4; ++i) { e[i] = __expf(lg[i][hh] - m); sum += e[i]; }
      sum = wave_sum_dpp(sum);
      inv8[hh] = __builtin_amdgcn_rcpf(sum);
#pragma unroll
      for (int i = 0; i < 4; ++i) PT[hh * 256 + lane + 64 * i] = f2bf(e[i]);
    }
  }
  WAVE_LDS_SYNC();
  {
    typedef short s16x4 __attribute__((ext_vector_type(4)));
    typedef __attribute__((address_space(3))) s16x4 lds_s16x4;
    const u16* PT = (const u16*)P;
    unsigned char* VST = wsm + 8192 + 512;
    const int vkey = lane >> 4, vch = lane & 15;
    const int tq = (lane & 15) >> 2, tp = lane & 3;
    f32x4 oacc[2][4];
#pragma unroll
    for (int g = 0; g < 2; ++g)
#pragma unroll
      for (int c = 0; c < 4; ++c) oacc[g][c] = (f32x4){0.f, 0.f, 0.f, 0.f};
    const int nks = (nsel + 31) >> 5;
    u32x4 vA[8], vB[8];
#define PV_LOAD(buf_, ks_)                                                                       \
  _Pragma("unroll") for (int i = 0; i < 8; ++i) {                                                \
    const int ki_ = min((ks_) * 32 + i * 4 + vkey, 255);                                         \
    const int s_ = (int)sl[ki_] & 4095;                                                          \
    buf_[i] = *(const u32x4*)(KVC + (tokb + s_) * 256 + 128 + vch * 8);                          \
  }
#define PV_COMPUTE(buf_, ks_)                                                                    \
  {                                                                                              \
    _Pragma("unroll") for (int i = 0; i < 8; ++i) {                                              \
      const int key_ = i * 4 + vkey;                                                             \
      *(u32x4*)(VST + key_ * 256 + ((vch ^ (key_ & 15)) << 4)) = buf_[i];                        \
    }                                                                                            \
    WAVE_LDS_SYNC();                                                                             \
    const bf16x8 z8_ = {0, 0, 0, 0, 0, 0, 0, 0};                                                 \
    bf16x8 pa_[2];                                                                               \
    _Pragma("unroll") for (int g = 0; g < 2; ++g) {                                              \
      const bf16x8 t_ = *(const bf16x8*)(PT + (g * 4 + (fr & 3)) * 256 + (ks_) * 32 + 8 * fg);  \
      pa_[g] = (fr < 4) ? t_ : z8_;                                                              \
    }                                                                                            \
    const int r1_ = 8 * fg + tq, r2_ = r1_ + 4;                                                  \
    _Pragma("unroll") for (int g = 0; g < 2; ++g)                                                \
      _Pragma("unroll") for (int c = 0; c < 4; ++c) {                                            \
        const int ch_ = g * 8 + 2 * c + (tp >> 1);                                               \
        const s16x4 lo_ = __builtin_amdgcn_ds_read_tr16_b64_v4i16((lds_s16x4*)(VST + r1_ * 256 + ((ch_ ^ (r1_ & 15)) << 4) + 8 * (tp & 1))); \
        const s16x4 hi_ = __builtin_amdgcn_ds_read_tr16_b64_v4i16((lds_s16x4*)(VST + r2_ * 256 + ((ch_ ^ (r2_ & 15)) << 4) + 8 * (tp & 1))); \
        const bf16x8 vb_ = {lo_[0], lo_[1], lo_[2], lo_[3], hi_[0], hi_[1], hi_[2], hi_[3]};     \
        oacc[g][c] = __builtin_amdgcn_mfma_f32_16x16x32_bf16(pa_[g], vb_, oacc[g][c], 0, 0, 0);  \
      }                                                                                          \
    WAVE_LDS_SYNC();                                                                             \
  }
    PV_LOAD(vA, 0)
    for (int ks = 0; ks < nks; ks += 2) {
      if (ks + 1 < nks) { PV_LOAD(vB, ks + 1) }
      PV_COMPUTE(vA, ks)
      if (ks + 2 < nks) { PV_LOAD(vA, ks + 2) }
      if (ks + 1 < nks) { PV_COMPUTE(vB, ks + 1) }
    }
#undef PV_LOAD
#undef PV_COMPUTE
    if (lane < 16) {
#pragma unroll
      for (int g = 0; g < 2; ++g)
#pragma unroll
        for (int c = 0; c < 4; ++c)
#pragma unroll
          for (int r = 0; r < 4; ++r)
            YATT[tok * 512 + (g * 4 + r) * 64 + 16 * c + fr] = f2bf(oacc[g][c][r] * inv8[g * 4 + r]);
    }
  }
  WAVE_LDS_SYNC();
}

__device__ __forceinline__ void phase3(const Params& p, unsigned char* smem) {
  const int wave = TIDX >> 6;
#ifndef NO_SCAN
  if (blockIdx.x < 32) {
    if (!(p.flags & 2)) dn_scan_item(p, smem, blockIdx.x);
    __syncthreads();
  }
#endif
#ifdef NO_ATTN
  return;
#endif
  if (p.flags & 4) return;
  unsigned* qctr = (unsigned*)(p.ws + 1024);
  const unsigned xcc = (unsigned)__builtin_amdgcn_s_getreg((3 << 11) | 20) & 7u;
  unsigned char* wsm = smem + wave * AT_WAVE_BYTES;
  for (unsigned db = 0; db < 8; ++db) {
    const int bb = (int)((xcc + db) & 7u);
    for (;;) {
      unsigned qi = 0;
      if ((TIDX & 63) == 0) qi = __hip_atomic_fetch_add(qctr + bb * 16, 1u, __ATOMIC_RELAXED, __HIP_MEMORY_SCOPE_AGENT);
      qi = (unsigned)__builtin_amdgcn_readfirstlane((int)qi);
      if (qi >= (unsigned)SEQ) break;
      attn_query(p, wsm, bb, SEQ - 1 - (int)qi);
    }
  }
}

__device__ __forceinline__ void phase4(const Params& p, unsigned char* smem) {
  const u16* YATT = (const u16*)(p.ws + OFF_YATT);
  const u16* YDN = (const u16*)(p.ws + OFF_YDN);
  const u16* WTA = (const u16*)(p.ws + OFF_WTA);
  const u16* WTB = (const u16*)(p.ws + OFF_WTB);
  const u16* PROJ = (const u16*)(p.ws + OFF_PROJ);
  u16* MG = (u16*)(p.ws + OFF_MERGED);
  const int lane = TIDX & 63, wave = TIDX >> 6;
  const int wm = wave >> 1, wn = wave & 1, fr = lane & 15, fg = lane >> 4;
  const int ntn = DM / G_BN, ntiles = (MTOK / G_BM) * ntn;
  for (int t = blockIdx.x; t < ntiles; t += gridDim.x) {
    const int m0 = (t / ntn) * G_BM, n0 = (t % ntn) * G_BN;
    f32x4 acc[4][4];
    u32 mg[4][4][2];
    const u32 pb0 = (u32)(m0 + wm * 64 + 4 * fg) * LDP + (u32)(n0 + wn * 64 + fr);
    const u32 ob0 = (u32)(m0 + wm * 64 + 4 * fg) * DM + (u32)(n0 + wn * 64 + fr);
    gemm_mainloop(YATT, 512, WTA, 512, 512, m0, n0, smem, acc);
#pragma unroll
    for (int i = 0; i < 4; ++i)
#pragma unroll
      for (int j = 0; j < 4; ++j) {
        float t4[4];
#pragma unroll
        for (int r = 0; r < 4; ++r) {
          float ga = bf2f(PROJ[pb0 + (u32)(C_GA + (i * 16 + r) * LDP + j * 16)]);
          t4[r] = sigmoidf_(ga) * acc[i][j][r];
        }
        mg[i][j][0] = pack2(t4[0], t4[1]); mg[i][j][1] = pack2(t4[2], t4[3]);
        asm volatile("" ::: "memory");
      }
    gemm_mainloop(YDN, 512, WTB, 512, 512, m0, n0, smem, acc);
#pragma unroll
    for (int i = 0; i < 4; ++i)
#pragma unroll
      for (int j = 0; j < 4; ++j)
#pragma unroll
        for (int r = 0; r < 4; ++r) {
          float gb = bf2f(PROJ[pb0 + (u32)(C_GB + (i * 16 + r) * LDP + j * 16)]);
          u32 w = mg[i][j][r >> 1];
          float m1 = (r & 1) ? bfhi(w) : bflo(w);
          MG[ob0 + (u32)((i * 16 + r) * DM + j * 16)] = f2bf(m1 + sigmoidf_(gb) * acc[i][j][r]);
          if (r == 3) asm volatile("" ::: "memory");
        }
  }
}

__device__ __forceinline__ void phase5(const Params& p, unsigned char* smem) {
  const u16* MG = (const u16*)(p.ws + OFF_MERGED);
  const u16* WTO = (const u16*)(p.ws + OFF_WTO);
  const float* x = p.in[0];
  const int lane = TIDX & 63, wave = TIDX >> 6;
  const int wr = wave >> 2, wc = wave & 3, fr = lane & 15, fq = lane >> 4;
  const int ntn = DM / 256, ntiles = (MTOK / 256) * ntn;
  for (int t = blockIdx.x; t < ntiles; t += gridDim.x) {
    const int m0 = (t / ntn) * 256, n0 = (t % ntn) * 256;
    f32x4 acc[2][2][4][2];
    gemm8_tile(MG, WTO, DM, m0, n0, smem, acc);
    const u32 ob0 = (u32)(m0 + wr * 64 + 4 * fq) * DM + (u32)(n0 + wc * 64 + fr);
    float* outp = p.out;
#pragma unroll
    for (int ai = 0; ai < 2; ++ai)
#pragma unroll
      for (int m = 0; m < 4; ++m) {
#pragma unroll
        for (int bj = 0; bj < 2; ++bj)
#pragma unroll
          for (int n = 0; n < 2; ++n)
#pragma unroll
            for (int j = 0; j < 4; ++j) {
              u32 o = ob0 + (u32)((ai * 128 + m * 16 + j) * DM + (bj * 2 + n) * 16);
              outp[o] = x[o] + acc[ai][bj][m][n][j];
            }
        __builtin_amdgcn_sched_barrier(0);
      }
  }
}

__device__ __forceinline__ void phase6(const Params& p, unsigned char* smem) {
  const u16* H2 = (const u16*)(p.ws + OFF_H2);
  const u16* WTQ = (const u16*)(p.ws + OFF_WTQ);
  u16* QP = (u16*)(p.ws + OFF_QP);
  const int lane = TIDX & 63, wave = TIDX >> 6;
  const int wr = wave >> 2, wc = wave & 3, fr = lane & 15, fq = lane >> 4;
  const int ntn = 2048 / 256, ntiles = (MTOK / 256) * ntn;
  for (int t = blockIdx.x; t < ntiles; t += gridDim.x) {
    const int m0 = (t / ntn) * 256, n0 = (t % ntn) * 256;
    f32x4 acc[2][2][4][2];
    gemm8_tile(H2, WTQ, DM, m0, n0, smem, acc);
    ep_store<2048, false>(QP, (u32)(m0 + wr * 64) * 2048 + (u32)(n0 + wc * 64), acc, nullptr, 1.f, smem, wave, lane);
  }
}

__device__ __forceinline__ int mono_key(float v) { int b = __float_as_int(v); return b ^ ((b >> 31) & 0x7fffffff); }
__device__ __forceinline__ float unmono_key(int k) { return __int_as_float(k ^ ((k >> 31) & 0x7fffffff)); }
__device__ __forceinline__ void chain16(int (&k)[16], int x) {
#pragma unroll
  for (int j = 0; j < 16; ++j) { int hi = max(k[j], x); x = min(k[j], x); k[j] = hi; }
}

constexpr int P7_LD = 132;
__device__ __forceinline__ void phase7(const Params& p, unsigned char* smem) {
  const u16* QP = (const u16*)(p.ws + OFF_QP);
  const u16* SKB = (const u16*)(p.ws + OFF_SKB);
  float* TOPS = (float*)(p.ws + OFF_TOPS);
  u8* TOPI = (u8*)(p.ws + OFF_TOPI);
  const int tid = TIDX, lane = tid & 63, wave = tid >> 6;
  const int wm = wave >> 1, wn = wave & 1, fr = lane & 15, fg = lane >> 4;
  const int ntiles = (MTOK / G_BM) * 16;
  float* tile = (float*)smem;
  for (int t = blockIdx.x; t < ntiles; t += gridDim.x) {
    const int m0 = (t >> 4) * G_BM, hp = t & 15;
    f32x4 acc[4][4];
    gemm_mainloop(QP + hp * 128, 2048, SKB + (size_t)hp * 128 * 128, 128, 128, m0, 0, smem, acc);
#pragma unroll
    for (int i = 0; i < 4; ++i)
#pragma unroll
      for (int j = 0; j < 4; ++j)
#pragma unroll
        for (int r = 0; r < 4; ++r) {
          int row = wm * 64 + i * 16 + 4 * fg + r, col = wn * 64 + j * 16 + fr;
          tile[row * P7_LD + col] = acc[i][j][r];
        }
    __syncthreads();
    {
      const int row = tid >> 1, half = tid & 1;
      int k[16];
#pragma unroll
      for (int j = 0; j < 16; ++j) k[j] = (int)0x80000000;
      const float* rowp = tile + row * P7_LD + half * 64;
#pragma unroll 4
      for (int c = 0; c < 64; c += 4) {
        f32x4 v = *(const f32x4*)(rowp + c);
        const int ib = 127 - (half * 64 + c);
        chain16(k, (mono_key(v[0]) & ~127) | ib);
        chain16(k, (mono_key(v[1]) & ~127) | (ib - 1));
        chain16(k, (mono_key(v[2]) & ~127) | (ib - 2));
        chain16(k, (mono_key(v[3]) & ~127) | (ib - 3));
      }
#pragma unroll
      for (int j = 0; j < 16; ++j) {
        const int other = DPPI(k[j], 0xb1);
        if (half == 0) chain16(k, other);
      }
      if (half == 0) {
        size_t o = ((size_t)(m0 + row) * 16 + hp) * 16;
        float vals[16]; int idx[16];
#pragma unroll
        for (int j = 0; j < 16; ++j) { idx[j] = 127 - (k[j] & 127); vals[j] = tile[row * P7_LD + idx[j]]; }
#pragma unroll
        for (int j = 0; j < 16; j += 4) *(f32x4*)(TOPS + o + j) = (f32x4){vals[j], vals[j + 1], vals[j + 2], vals[j + 3]};
#pragma unroll
        for (int j = 0; j < 16; j += 4)
          *(u32*)(TOPI + o + j) = (u32)idx[j] | ((u32)idx[j + 1] << 8) | ((u32)idx[j + 2] << 16) | ((u32)idx[j + 3] << 24);
      }
    }
    __syncthreads();
  }
}

__device__ __forceinline__ void phase7b(const Params& p) {
  const float* TOPS = (const float*)(p.ws + OFF_TOPS);
  const u8* TOPI = (const u8*)(p.ws + OFF_TOPI);
  int* EXPERT = (int*)(p.ws + OFF_EXPERT);
  float* GATE = (float*)(p.ws + OFF_GATE);
  for (int w = blockIdx.x * NTHREADS + TIDX; w < MTOK * 8; w += gridDim.x * NTHREADS) {
    const size_t o = (size_t)w * 32;
    float sa[16], sb[16];
#pragma unroll
    for (int k = 0; k < 16; k += 4) {
      float4 v = *(const float4*)(TOPS + o + k); sa[k] = v.x; sa[k + 1] = v.y; sa[k + 2] = v.z; sa[k + 3] = v.w;
      float4 u = *(const float4*)(TOPS + o + 16 + k); sb[k] = u.x; sb[k + 1] = u.y; sb[k + 2] = u.z; sb[k + 3] = u.w;
    }
    int kk[16];
#pragma unroll
    for (int k = 0; k < 16; ++k) kk[k] = (int)0x80000000;
#pragma unroll
    for (int a = 0; a < 16; ++a)
#pragma unroll
      for (int bb = 0; bb < 16; ++bb)
        if ((a + 1) * (bb + 1) <= 16) chain16(kk, (mono_key(sa[a] + sb[bb]) & ~255) | (255 - (a * 16 + bb)));
    float vals[16];
#pragma unroll
    for (int k = 0; k < 16; ++k) vals[k] = unmono_key(kk[k] & ~255);
    float m = vals[0], s = 0.f, e[16];
#pragma unroll
    for (int k = 0; k < 16; ++k) { e[k] = __expf(vals[k] - m); s += e[k]; }
    float inv = 1.f / s;
#pragma unroll
    for (int k = 0; k < 16; ++k) {
      const int ci = 255 - (kk[k] & 255);
      int a = ci >> 4, bb = ci & 15;
      int ex = (int)TOPI[o + a] * 128 + (int)TOPI[o + 16 + bb];
      EXPERT[(size_t)w * 16 + k] = ex;
      GATE[(size_t)w * 16 + k] = e[k] * inv;
    }
  }
  {
    const int lane = TIDX & 63, wave = TIDX >> 6;
    for (int row = blockIdx.x * 8 + wave; row < 2 * 16384; row += gridDim.x * 8) {
      const int tbl = row >> 14, r = row & 16383;
      const f32x4* src = (const f32x4*)((tbl ? p.in[16] : p.in[15]) + (size_t)r * DM) + 4 * lane;
      f32x4 x[4];
      float amax = 0.f;
#pragma unroll
      for (int i = 0; i < 4; ++i) {
        x[i] = src[i];
        amax = fmaxf(amax, fmaxf(fmaxf(fabsf(x[i][0]), fabsf(x[i][1])), fmaxf(fabsf(x[i][2]), fabsf(x[i][3]))));
      }
      amax = wave_max_dpp(amax);
      const float inv = amax > 0.f ? 127.f / amax : 0.f;
      const int bias = tbl ? 128 : 0;
      u32x4 o;
#pragma unroll
      for (int i = 0; i < 4; ++i) {
        int q0 = (int)rintf(x[i][0] * inv) + bias, q1 = (int)rintf(x[i][1] * inv) + bias;
        int q2 = (int)rintf(x[i][2] * inv) + bias, q3 = (int)rintf(x[i][3] * inv) + bias;
        o[i] = (u32)(q0 & 0xff) | ((u32)(q1 & 0xff) << 8) | ((u32)(q2 & 0xff) << 16) | ((u32)(q3 & 0xff) << 24);
      }
      *(u32x4*)(p.ws + (tbl ? OFF_VQ : OFF_UQ) + ((size_t)(lane >> 3) * 16384 + r) * 128 + (lane & 7) * 16) = o;
      if (lane == 0) ((float*)(p.ws + (tbl ? OFF_VS : OFF_US)))[r] = amax * (1.f / 127.f);
    }
  }
}

__device__ __forceinline__ void phase8a(const Params& p) {
  const int* EXPERT = (const int*)(p.ws + OFF_EXPERT);
  const unsigned char* UQS = p.ws + OFF_UQ;
  const unsigned char* H2Q = p.ws + OFF_H2Q;
  int* PD = (int*)(p.ws + OFF_PD);
  unsigned* ctr = (unsigned*)(p.ws + 2048 + ((p.flags & 128) ? 4096 : 0));
  const unsigned xcc = (unsigned)__builtin_amdgcn_s_getreg((3 << 11) | 20) & 7u;
  const int lane = TIDX & 63, g8 = lane >> 3, l8 = lane & 7;
  for (unsigned db = 0; db < 8; ++db) {
    const int x = (int)((xcc + db) & 7u);
    for (;;) {
      unsigned ci = 0;
      if (lane == 0) ci = __hip_atomic_fetch_add(ctr + x * 16, 1u, __ATOMIC_RELAXED, __HIP_MEMORY_SCOPE_AGENT);
      ci = (unsigned)__builtin_amdgcn_readfirstlane((int)ci);
      if (ci >= (unsigned)(MTOK / 16)) break;
#pragma unroll 1
      for (int tt = 0; tt < 16; ++tt) {
        const int tok = (int)ci * 16 + tt;
        const int e0 = EXPERT[(size_t)tok * 128 + lane], e1 = EXPERT[(size_t)tok * 128 + 64 + lane];
        const u32x4 hq = *(const u32x4*)(H2Q + (size_t)tok * DM + x * 128 + l8 * 16);
        u32x4 ua[16];
#pragma unroll
        for (int i = 0; i < 16; ++i) {
          const int k = i * 8 + g8;
          const int ek = __shfl(i < 8 ? e0 : e1, k & 63);
          ua[i] = *(const u32x4*)(UQS + ((size_t)(x * 16384 + ek)) * 128 + l8 * 16);
        }
        int keep0 = 0, keep1 = 0;
#pragma unroll
        for (int i = 0; i < 16; ++i) {
          int sd = 0;
#pragma unroll
          for (int c = 0; c < 4; ++c) sd = __builtin_amdgcn_sdot4((int)ua[i][c], (int)hq[c], sd, false);
          sd += DPPI(sd, 0xb1); sd += DPPI(sd, 0x4e); sd += DPPI(sd, 0x141);
          if (i < 8) keep0 = (l8 == (i & 7)) ? sd : keep0; else keep1 = (l8 == (i & 7)) ? sd : keep1;
        }
        int* pd = PD + ((size_t)x * MTOK + tok) * 128 + l8 * 8 + g8;
        pd[0] = keep0; pd[64] = keep1;
      }
    }
  }
}

__device__ __forceinline__ void phase8b(const Params& p) {
  const int* EXPERT = (const int*)(p.ws + OFF_EXPERT);
  const float* GATE = (const float*)(p.ws + OFF_GATE);
  const unsigned char* VQS = p.ws + OFF_VQ;
  const float* US = (const float*)(p.ws + OFF_US);
  const float* VS = (const float*)(p.ws + OFF_VS);
  const float* HS = (const float*)(p.ws + OFF_HS);
  const int* PD = (const int*)(p.ws + OFF_PD);
  unsigned* ctr = (unsigned*)(p.ws + 3072 + ((p.flags & 128) ? 4096 : 0));
  const unsigned xcc = (unsigned)__builtin_amdgcn_s_getreg((3 << 11) | 20) & 7u;
  const int lane = TIDX & 63, g8 = lane >> 3, l8 = lane & 7;
  for (unsigned db = 0; db < 8; ++db) {
    const int x = (int)((xcc + db) & 7u);
    for (;;) {
      unsigned ci = 0;
      if (lane == 0) ci = __hip_atomic_fetch_add(ctr + x * 16, 1u, __ATOMIC_RELAXED, __HIP_MEMORY_SCOPE_AGENT);
      ci = (unsigned)__builtin_amdgcn_readfirstlane((int)ci);
      if (ci >= (unsigned)(MTOK / 16)) break;
#pragma unroll 1
      for (int tt = 0; tt < 16; ++tt) {
        const int tok = (int)ci * 16 + tt;
        const int e0 = EXPERT[(size_t)tok * 128 + lane], e1 = EXPERT[(size_t)tok * 128 + 64 + lane];
        const float g0 = GATE[(size_t)tok * 128 + lane], g1 = GATE[(size_t)tok * 128 + 64 + lane];
        int s0 = 0, s1 = 0;
#pragma unroll
        for (int xx = 0; xx < 8; ++xx) {
          s0 += PD[((size_t)xx * MTOK + tok) * 128 + lane];
          s1 += PD[((size_t)xx * MTOK + tok) * 128 + 64 + lane];
        }
        const float hs = HS[tok];
        const float d0 = (float)s0 * US[e0] * hs, d1 = (float)s1 * US[e1] * hs;
        const float cf0 = g0 * 0.5f * d0 * (1.f + erff(d0 * 0.70710678118654752f)) * VS[e0];
        const float cf1 = g1 * 0.5f * d1 * (1.f + erff(d1 * 0.70710678118654752f)) * VS[e1];
        const float csum = wave_sum_dpp(cf0 + cf1);
        u32x4 va[16];
        float ck[16];
#pragma unroll
        for (int i = 0; i < 16; ++i) {
          const int k = i * 8 + g8;
          const int ek = __shfl(i < 8 ? e0 : e1, k & 63);
          ck[i] = __shfl(i < 8 ? cf0 : cf1, k & 63);
          va[i] = *(const u32x4*)(VQS + ((size_t)(x * 16384 + ek)) * 128 + l8 * 16);
        }
        f32x2_t ov2[8];
#pragma unroll
        for (int c = 0; c < 8; ++c) ov2[c] = (f32x2_t){0.f, 0.f};
#pragma unroll
        for (int i = 0; i < 16; ++i) {
          const f32x2_t cc2 = {ck[i], ck[i]};
#pragma unroll
          for (int c = 0; c < 4; ++c) {
            const u32 w = va[i][c];
            const f32x2_t fa = {(float)(w & 0xffu), (float)((w >> 8) & 0xffu)};
            const f32x2_t fb = {(float)((w >> 16) & 0xffu), (float)(w >> 24)};
            ov2[2 * c] = __builtin_elementwise_fma(cc2, fa, ov2[2 * c]);
            ov2[2 * c + 1] = __builtin_elementwise_fma(cc2, fb, ov2[2 * c + 1]);
          }
        }
        float tot[16];
#pragma unroll
        for (int c = 0; c < 8; ++c) {
          float a0 = ov2[c][0], a1 = ov2[c][1];
          a0 += DPPF(a0, 0x128); a1 += DPPF(a1, 0x128);
          a0 = xor16_sum(a0); a1 = xor16_sum(a1);
          a0 = xor32_sum(a0); a1 = xor32_sum(a1);
          tot[2 * c] = a0; tot[2 * c + 1] = a1;
        }
        const float corr = 128.f * csum;
        if (lane < 8 && !(p.flags & 32)) {
          f32x4* op = (f32x4*)(p.out + (size_t)tok * DM + x * 128 + l8 * 16);
#pragma unroll
          for (int c = 0; c < 4; ++c) {
            f32x4 xv = op[c];
            xv[0] += tot[4 * c] - corr; xv[1] += tot[4 * c + 1] - corr; xv[2] += tot[4 * c + 2] - corr; xv[3] += tot[4 * c + 3] - corr;
            op[c] = xv;
          }
        }
      }
    }
  }
}

__device__ __forceinline__ void grid_barrier(unsigned* ctr, unsigned target) {
  asm volatile("s_waitcnt vmcnt(0)" ::: "memory");
  __syncthreads();
  if (TIDX == 0) {
    __builtin_amdgcn_fence(__ATOMIC_RELEASE, "agent");
    asm volatile("s_waitcnt vmcnt(0)" ::: "memory");
    __hip_atomic_fetch_add(ctr, 1u, __ATOMIC_RELAXED, __HIP_MEMORY_SCOPE_AGENT);
    while (__hip_atomic_load(ctr, __ATOMIC_RELAXED, __HIP_MEMORY_SCOPE_AGENT) < target) __builtin_amdgcn_s_sleep(2);
    __builtin_amdgcn_fence(__ATOMIC_ACQUIRE, "agent");
    asm volatile("s_waitcnt vmcnt(0)" ::: "memory");
  }
  __syncthreads();
}

__global__ void __launch_bounds__(NTHREADS, 2) mk_fwd(Params p) {
  cg::grid_group grid = cg::this_grid();
  __shared__ __attribute__((aligned(16))) unsigned char smem[SMEM_BYTES];
  const int lo = p.ph_lo, hi = p.ph_hi;
#define RUN(k, call) if (lo <= (k) && (k) < hi) { call; if ((k) + 1 < hi) { if ((k) == lo) grid.sync(); else grid_barrier((unsigned*)p.ws, (unsigned)((k) - lo) * gridDim.x); } }
  RUN(0, phase0(p, smem))
  RUN(1, phase1(p, smem))
  RUN(2, phase2(p, smem))
  RUN(3, phase3(p, smem))
  RUN(4, phase4(p, smem))
  RUN(5, phase5(p, smem))
  RUN(6, rmsnorm_rows<true>(p.out, p.in[12], (u16*)(p.ws + OFF_H2), p.ws + OFF_H2Q, (float*)(p.ws + OFF_HS)))
  RUN(7, phase6(p, smem))
  RUN(8, phase7(p, smem))
  RUN(9, phase7b(p))
  RUN(10, phase8a(p))
  RUN(11, phase8b(p))
#undef RUN
}

extern "C" void kernel_launch(void* const* d_in, const int* in_sizes, int n_in,
                              void* d_out, int out_size, void* d_ws, size_t ws_size,
                              hipStream_t stream) {
  static int grid_blocks = 0;
  if (!grid_blocks) {
    int dev = 0, cus = 0, per_cu = 0;
    (void)hipGetDevice(&dev);
    (void)hipDeviceGetAttribute(&cus, hipDeviceAttributeMultiprocessorCount, dev);
    (void)hipOccupancyMaxActiveBlocksPerMultiprocessor(&per_cu, mk_fwd, NTHREADS, 0);
    if (per_cu < 1) per_cu = 1;
    if (per_cu > 1) per_cu = 1;
    grid_blocks = cus * per_cu;
    fprintf(stderr, "mk_fwd: cus=%d per_cu=%d grid=%d ws=%zu\n", cus, per_cu, grid_blocks, ws_size);
  }
  Params p{};
  for (int i = 0; i < 17 && i < n_in; ++i) p.in[i] = (const float*)d_in[i];
  p.out = (float*)d_out;
  p.ws = (unsigned char*)d_ws;
  p.ph_lo = 0; p.ph_hi = 12;
  (void)hipMemsetAsync(d_ws, 0, 8192, stream);
  void* args[] = {&p};
  hipError_t e = hipLaunchCooperativeKernel((void*)mk_fwd, dim3(grid_blocks), dim3(NTHREADS), args, 0, stream);
  if (e != hipSuccess) fprintf(stderr, "cooperative launch failed: %s (grid %d)\n", hipGetErrorString(e), grid_blocks);
#ifdef EXTRA_LO
  {
    Params p2 = p;
    p2.ph_lo = EXTRA_LO; p2.ph_hi = EXTRA_HI; p2.flags = EXTRA_FLAGS;
    void* args2[] = {&p2};
    (void)hipLaunchCooperativeKernel((void*)mk_fwd, dim3(grid_blocks), dim3(NTHREADS), args2, 0, stream);
  }
#endif
}
```

```cpp
#include <hip/hip_runtime.h>
#include <hip/hip_bf16.h>
#include <hip/hip_cooperative_groups.h>
#include <cstdio>
#include <cstdint>
namespace cg = cooperative_groups;

typedef unsigned short u16;
typedef unsigned int u32;
typedef unsigned char u8;
typedef short bf16x8 __attribute__((ext_vector_type(8)));
typedef float f32x4 __attribute__((ext_vector_type(4)));
typedef unsigned int u32x4 __attribute__((ext_vector_type(4)));
typedef unsigned int u32x2 __attribute__((ext_vector_type(2)));

constexpr int NTHREADS = 512;
constexpr int BATCH = 8, SEQ = 4096, DM = 1024, MTOK = BATCH * SEQ;
constexpr int LDP = 5120;
constexpr int NPADW = 5632;
constexpr int C_AQ = 0, C_IQ = 512, C_DQ = 1024, C_DK = 1536, C_DV = 2048, C_DZ = 2560, C_GA = 3072, C_GB = 4096;
constexpr int N_AK = 5120, N_AV = 5248, N_IK = 5376, N_SM = 5440;
constexpr size_t MiB = 1ull << 20;
constexpr size_t OFF_WTIN = 1 * MiB, OFF_WTA = 12 * MiB, OFF_WTB = 13 * MiB, OFF_WTO = 14 * MiB, OFF_WTQ = 16 * MiB,
                 OFF_SKB = 20 * MiB, OFF_SMALL = 21 * MiB, OFF_H = 23 * MiB, OFF_ATT = 23 * MiB, OFF_GC = 39 * MiB,
                 OFF_MERGED = 23 * MiB, OFF_PROJ = 87 * MiB, OFF_KVC = 407 * MiB, OFF_IKC = 423 * MiB, OFF_SEL = 427 * MiB, OFF_YATT = 443 * MiB,
                 OFF_YDN = 475 * MiB;
constexpr size_t OFF_H2 = OFF_PROJ, OFF_QP = OFF_PROJ + 64 * MiB, OFF_TOPS = OFF_PROJ + 192 * MiB,
                 OFF_TOPI = OFF_PROJ + 224 * MiB, OFF_EXPERT = OFF_PROJ + 232 * MiB, OFF_GATE = OFF_PROJ + 248 * MiB;
constexpr size_t OFF_UQ = OFF_PROJ + 264 * MiB, OFF_VQ = OFF_PROJ + 280 * MiB, OFF_US = OFF_PROJ + 296 * MiB, OFF_VS = OFF_PROJ + 297 * MiB;
constexpr size_t OFF_CQ8 = 56 * MiB, OFF_QSC = 64 * MiB;
constexpr size_t OFF_H2Q = 23 * MiB, OFF_HS = 55 * MiB, OFF_PD = OFF_PROJ + 64 * MiB;
constexpr size_t DO_U = 0, DO_W = 32 * MiB, DO_QN = 64 * MiB, DO_KNT = 96 * MiB;

constexpr int SMEM_BYTES = 162816;
constexpr float EPS = 1e-6f;

struct Params {
  const float* in[17];
  float* out;
  unsigned char* ws;
  int ph_lo, ph_hi;
  int flags, pad;
};

typedef __bf16 bf16x2_t __attribute__((ext_vector_type(2)));
typedef float f32x2_t __attribute__((ext_vector_type(2)));
__device__ __forceinline__ u32 pack2(float a, float b) {
  f32x2_t f = {a, b};
  return __builtin_bit_cast(u32, __builtin_convertvector(f, bf16x2_t));
}
__device__ __forceinline__ u16 f2bf(float f) { return (u16)(pack2(f, f) & 0xffffu); }
__device__ __forceinline__ float bf2f(u16 h) { return __uint_as_float(((u32)h) << 16); }
__device__ __forceinline__ float bflo(u32 w) { return __uint_as_float(w << 16); }
__device__ __forceinline__ float bfhi(u32 w) { return __uint_as_float(w & 0xffff0000u); }
__device__ __forceinline__ float wave_sum(float v) {
#pragma unroll
  for (int o = 32; o > 0; o >>= 1) v += __shfl_xor(v, o);
  return v;
}
__device__ __forceinline__ float wave_max(float v) {
#pragma unroll
  for (int o = 32; o > 0; o >>= 1) v = fmaxf(v, __shfl_xor(v, o));
  return v;
}
__device__ __forceinline__ float dot2bf(u32 a, u32 b, float acc) {
  return __builtin_amdgcn_fdot2_f32_bf16(__builtin_bit_cast(bf16x2_t, a), __builtin_bit_cast(bf16x2_t, b), acc, false);
}
#define DPPF(v, ctrl) __int_as_float(__builtin_amdgcn_update_dpp(0, __float_as_int(v), ctrl, 0xf, 0xf, true))
__device__ __forceinline__ float wave_sum_dpp(float v) {
  v += DPPF(v, 0xb1);
  v += DPPF(v, 0x4e);
  v += DPPF(v, 0x124);
  v += DPPF(v, 0x128);
  float r0 = __int_as_float(__builtin_amdgcn_readlane(__float_as_int(v), 0));
  float r1 = __int_as_float(__builtin_amdgcn_readlane(__float_as_int(v), 16));
  float r2 = __int_as_float(__builtin_amdgcn_readlane(__float_as_int(v), 32));
  float r3 = __int_as_float(__builtin_amdgcn_readlane(__float_as_int(v), 48));
  return (r0 + r1) + (r2 + r3);
}
__device__ __forceinline__ int opaque_tid() { int t = threadIdx.x; asm volatile("" : "+v"(t)); return t; }
#define TIDX opaque_tid()
#define DPPI(v, ctrl) __builtin_amdgcn_update_dpp(0, (v), ctrl, 0xf, 0xf, true)
__device__ __forceinline__ int wave_sum_i_dpp(int v) {
  v += DPPI(v, 0xb1);
  v += DPPI(v, 0x4e);
  v += DPPI(v, 0x124);
  v += DPPI(v, 0x128);
  return (__builtin_amdgcn_readlane(v, 0) + __builtin_amdgcn_readlane(v, 16)) +
         (__builtin_amdgcn_readlane(v, 32) + __builtin_amdgcn_readlane(v, 48));
}
__device__ __forceinline__ float wave_max_dpp(float v) {
  v = fmaxf(v, DPPF(v, 0xb1));
  v = fmaxf(v, DPPF(v, 0x4e));
  v = fmaxf(v, DPPF(v, 0x124));
  v = fmaxf(v, DPPF(v, 0x128));
  float r0 = __int_as_float(__builtin_amdgcn_readlane(__float_as_int(v), 0));
  float r1 = __int_as_float(__builtin_amdgcn_readlane(__float_as_int(v), 16));
  float r2 = __int_as_float(__builtin_amdgcn_readlane(__float_as_int(v), 32));
  float r3 = __int_as_float(__builtin_amdgcn_readlane(__float_as_int(v), 48));
  return fmaxf(fmaxf(r0, r1), fmaxf(r2, r3));
}
#define WAVE_LDS_SYNC() asm volatile("s_waitcnt lgkmcnt(0)" ::: "memory")
__device__ __forceinline__ float sigmoidf_(float x) { return __builtin_amdgcn_rcpf(1.f + __expf(-x)); }
__device__ __forceinline__ int perm32(int k) {
  int blk = k & ~31, r = k & 31;
  int p = (r < 16) ? (8 * (r >> 2) + (r & 3)) : (8 * ((r - 16) >> 2) + 4 + (r & 3));
  return blk + p;
}

__device__ __forceinline__ int g8_logical_col(int t) { return ((t & 127) >> 5) * 64 + (t >> 7) * 32 + (t & 31); }
__device__ __forceinline__ int win_map(int n) {
  if (n < 512) return n;
  if (n < 1024) return 768 + (n - 512);
  if (n < 3072) return 1352 + (n - 1024);
  if (n < 5120) return 3408 + (n - 3072);
  if (n < 5248) return 512 + (n - 5120);
  if (n < 5376) return 640 + (n - 5248);
  if (n < 5440) return 1280 + (n - 5376);
  if (n < 5448) return 1344 + (n - 5440);
  if (n < 5452) return 3400 + (n - 5448);
  if (n < 5456) return 3404 + (n - 5452);
  return -1;
}
__device__ __forceinline__ void transpose_tile(const float* __restrict__ src, int Nsrc, u16* __restrict__ dst, int K, int k0, int n0,
                               bool mapped, bool perm8, float* tile  ) {
  const int tid = TIDX;
  {
    const int tx = tid & 63, ty = tid >> 6;
    int n = n0 + tx;
    if (perm8) n = (n & ~255) + g8_logical_col(n & 255);
    int sc = mapped ? win_map(n) : n;
#pragma unroll
    for (int i = 0; i < 8; ++i) {
      int k = ty + 8 * i;
      float v = (sc >= 0) ? src[(size_t)(k0 + k) * Nsrc + sc] : 0.f;
      tile[k * 65 + tx] = v;
    }
  }
  __syncthreads();
  {
    const int n = tid >> 3, kc = (tid & 7) * 8;
    u32 w[4];
#pragma unroll
    for (int j = 0; j < 4; ++j) w[j] = pack2(tile[(kc + 2 * j) * 65 + n], tile[(kc + 2 * j + 1) * 65 + n]);
    *(uint4*)(dst + (size_t)(n0 + n) * K + k0 + kc) = make_uint4(w[0], w[1], w[2], w[3]);
  }
  __syncthreads();
}

template <bool Q8>
__device__ __forceinline__ void rmsnorm_rows(const float* __restrict__ x, const float* __restrict__ gain, u16* __restrict__ out,
                                             unsigned char* __restrict__ q8, float* __restrict__ qs) {
  const int lane = TIDX & 63, wave = TIDX >> 6;
  float4 g[4];
#pragma unroll
  for (int i = 0; i < 4; ++i) g[i] = ((const float4*)gain)[lane + 64 * i];
  for (int row = blockIdx.x * 8 + wave; row < MTOK; row += gridDim.x * 8) {
    const float4* xr = (const float4*)(x + (size_t)row * DM);
    float4 v[4];
    float ss = 0.f;
#pragma unroll
    for (int i = 0; i < 4; ++i) {
      v[i] = xr[lane + 64 * i];
      ss += v[i].x * v[i].x + v[i].y * v[i].y + v[i].z * v[i].z + v[i].w * v[i].w;
    }
    ss = wave_sum_dpp(ss);
    float r = rsqrtf(ss * (1.f / DM) + EPS);
    float amax = 0.f;
#pragma unroll
    for (int i = 0; i < 4; ++i) {
      v[i].x *= r * g[i].x; v[i].y *= r * g[i].y; v[i].z *= r * g[i].z; v[i].w *= r * g[i].w;
      uint2 o;
      o.x = pack2(v[i].x, v[i].y);
      o.y = pack2(v[i].z, v[i].w);
      *(uint2*)(out + (size_t)row * DM + 4 * (lane + 64 * i)) = o;
      if (Q8) amax = fmaxf(amax, fmaxf(fmaxf(fabsf(v[i].x), fabsf(v[i].y)), fmaxf(fabsf(v[i].z), fabsf(v[i].w))));
    }
    if (Q8) {
      amax = wave_max_dpp(amax);
      const float inv = amax > 0.f ? 127.f / amax : 0.f;
#pragma unroll
      for (int i = 0; i < 4; ++i) {
        const int q0 = (int)rintf(v[i].x * inv), q1 = (int)rintf(v[i].y * inv), q2 = (int)rintf(v[i].z * inv), q3 = (int)rintf(v[i].w * inv);
        *(u32*)(q8 + (size_t)row * DM + 4 * (lane + 64 * i)) =
            (u32)(q0 & 0xff) | ((u32)(q1 & 0xff) << 8) | ((u32)(q2 & 0xff) << 16) | ((u32)(q3 & 0xff) << 24);
      }
      if (lane == 0) qs[row] = amax * (1.f / 127.f);
    }
  }
}

__device__ __forceinline__ void phase0(const Params& p, unsigned char* smem) {
  float* tile = (float*)smem;
  unsigned char* ws = p.ws;
  const int n_in = 16 * 88, n_a = 8 * 16, n_b = 8 * 16, n_o = 16 * 16, n_q = 16 * 32;
  const int total = n_in + n_a + n_b + n_o + n_q;
  for (int t = blockIdx.x; t < total; t += gridDim.x) {
    int i = t;
    if (i < n_in) { transpose_tile(p.in[2], 5456, (u16*)(ws + OFF_WTIN), 1024, (i / 88) * 64, (i % 88) * 64, true, true, tile); continue; }
    i -= n_in;
    if (i < n_a) { transpose_tile(p.in[9], 1024, (u16*)(ws + OFF_WTA), 512, (i / 16) * 64, (i % 16) * 64, false, true, tile); continue; }
    i -= n_a;
    if (i < n_b) { transpose_tile(p.in[10], 1024, (u16*)(ws + OFF_WTB), 512, (i / 16) * 64, (i % 16) * 64, false, true, tile); continue; }
    i -= n_b;
    if (i < n_o) { transpose_tile(p.in[11], 1024, (u16*)(ws + OFF_WTO), 1024, (i / 16) * 64, (i % 16) * 64, false, true, tile); continue; }
    i -= n_o;
    transpose_tile(p.in[13], 2048, (u16*)(ws + OFF_WTQ), 1024, (i / 32) * 64, (i % 32) * 64, false, true, tile);
  }
  {
    const float* sk = p.in[14];
    u16* skb = (u16*)(ws + OFF_SKB);
    for (int i = blockIdx.x * NTHREADS + TIDX; i < 16 * 128 * 128; i += gridDim.x * NTHREADS) skb[i] = f2bf(sk[i]);
  }
  rmsnorm_rows<false>(p.in[0], p.in[1], (u16*)(ws + OFF_H), nullptr, nullptr);
}

constexpr int G_BM = 256, G_BN = 128, G_BK = 64;
constexpr int G_ABYTES = G_BM * 128;

template <int MI>
__device__ __forceinline__ void gemm_mainloop_t(const u16* __restrict__ A, int lda, const u16* __restrict__ Bt, int ldb, int K,
                                                int m0, int n0, unsigned char* smem, f32x4 (&acc)[MI][4]) {
  constexpr int BN = (MI == 4) ? 128 : 256;
  constexpr int NRB = BN / 64;
  constexpr int STAGE = G_ABYTES + BN * 128;
  const int tid = TIDX, lane = tid & 63, wave = tid >> 6;
  const int wm = (MI == 4) ? (wave >> 1) : (wave >> 2), wn = (MI == 4) ? (wave & 1) : (wave & 3);
#pragma unroll
  for (int i = 0; i < MI; ++i)
#pragma unroll
    for (int j = 0; j < 4; ++j) acc[i][j] = (f32x4){0.f, 0.f, 0.f, 0.f};
  const int kc = tid & 7;
  const int arow = tid >> 3;
  u32x4 ra[4], rb[NRB];
  const u16* ap = A + (size_t)(m0 + arow) * lda + kc * 8;
  const u16* bp = Bt + (size_t)(n0 + arow) * ldb + kc * 8;
  const int nk = K / G_BK;
  const int fr = lane & 15, fg = lane >> 4;
#define G_LOAD(kt_)                                                                       \
  {                                                                                       \
    const u16* ap2_ = ap + (size_t)(kt_) * G_BK;                                          \
    const u16* bp2_ = bp + (size_t)(kt_) * G_BK;                                          \
    _Pragma("unroll") for (int i = 0; i < 4; ++i) ra[i] = *(const u32x4*)(ap2_ + (size_t)(64 * i) * lda); \
    _Pragma("unroll") for (int i = 0; i < NRB; ++i) rb[i] = *(const u32x4*)(bp2_ + (size_t)(64 * i) * ldb); \
  }
#define G_STORE(st_)                                                                      \
  {                                                                                       \
    unsigned char* sa_ = smem + (st_) * STAGE;                                            \
    unsigned char* sb_ = sa_ + G_ABYTES;                                                  \
    _Pragma("unroll") for (int i = 0; i < 4; ++i) { int r = arow + 64 * i; *(u32x4*)(sa_ + r * 128 + ((kc ^ (r & 7)) << 4)) = ra[i]; } \
    _Pragma("unroll") for (int i = 0; i < NRB; ++i) { int r = arow + 64 * i; *(u32x4*)(sb_ + r * 128 + ((kc ^ (r & 7)) << 4)) = rb[i]; } \
  }
  G_LOAD(0)
  __syncthreads();
  G_STORE(0)
  if (nk > 1) G_LOAD(1)
  __syncthreads();
  for (int kt = 0; kt < nk; ++kt) {
    if (kt + 1 < nk) G_STORE((kt + 1) & 1)
    if (kt + 2 < nk) G_LOAD(kt + 2)
    __builtin_amdgcn_sched_barrier(0);
    const unsigned char* sa = smem + (kt & 1) * STAGE;
    const unsigned char* sb = sa + G_ABYTES;
#pragma unroll
    for (int kk = 0; kk < 2; ++kk) {
      bf16x8 bfr[4];
#pragma unroll
      for (int j = 0; j < 4; ++j) {
        int r = wn * 64 + j * 16 + fr;
        bfr[j] = *(const bf16x8*)(sb + r * 128 + (((kk * 4 + fg) ^ (r & 7)) << 4));
      }
#pragma unroll
      for (int ih = 0; ih < MI; ih += 4) {
        bf16x8 af[4];
#pragma unroll
        for (int i = 0; i < 4; ++i) {
          int r = wm * (MI * 16) + (ih + i) * 16 + fr;
          af[i] = *(const bf16x8*)(sa + r * 128 + (((kk * 4 + fg) ^ (r & 7)) << 4));
        }
#pragma unroll
        for (int i = 0; i < 4; ++i)
#pragma unroll
          for (int j = 0; j < 4; ++j) acc[ih + i][j] = __builtin_amdgcn_mfma_f32_16x16x32_bf16(af[i], bfr[j], acc[ih + i][j], 0, 0, 0);
        if (MI == 8 && ih == 0) __builtin_amdgcn_sched_barrier(0);
      }
    }
    __syncthreads();
  }
#undef G_LOAD
#undef G_STORE
}
__device__ __forceinline__ void gemm_mainloop(const u16* __restrict__ A, int lda, const u16* __restrict__ Bt, int ldb, int K,
                                              int m0, int n0, unsigned char* smem, f32x4 (&acc)[4][4]) {
  gemm_mainloop_t<4>(A, lda, Bt, ldb, K, m0, n0, smem, acc);
}

__device__ __forceinline__ int g8_lds_byte(int r, int c) {
  int st = (r >> 4) * 2 + (c >> 5), rr = r & 15, cc = c & 31, ob = rr * 64 + cc * 2;
  return st * 1024 + (ob ^ (((ob >> 9) & 1) << 5));
}
__device__ __forceinline__ void g8_stage_rc(int b, int& R, int& C) {
  int st = b / 1024, sb = b % 1024, swz = sb ^ (((sb >> 9) & 1) << 5);
  R = (st >> 1) * 16 + swz / 64; C = (st & 1) * 32 + (swz % 64) / 2;
}
typedef __attribute__((address_space(3))) unsigned int lds_u32;
__device__ __forceinline__ void gemm8_tile(const u16* __restrict__ A, const u16* __restrict__ Bt, int K, int brow, int bcol,
                                           unsigned char* smem, f32x4 (&acc)[2][2][4][2]) {
  constexpr int HTB = 16384;
  const int tid = TIDX;
  const int wid = tid >> 6, lane = tid & 63, wr = wid >> 2, wc = wid & 3, fr = lane & 15, fq = lane >> 4;
#define SA(b, h) (smem + ((b) * 2 + (h)) * HTB)
#define SB(b, h) (smem + (4 + (b) * 2 + (h)) * HTB)
#define STAGE(P, BASE, br, kt) do { const long _g = (long)(br) * K + (long)(kt) * 64; \
    _Pragma("unroll") for (int _i = 0; _i < 2; ++_i) { int _b = tid * 16 + _i * 8192; int _r, _c; g8_stage_rc(_b, _r, _c); \
      __builtin_amdgcn_global_load_lds((const unsigned int*)(BASE + _g + (long)_r * K + _c), \
        (lds_u32*)((P) + _b), 16, 0, 0); } } while (0)
#define LDA(dst, b, h) _Pragma("unroll") for (int m = 0; m < 4; ++m) _Pragma("unroll") for (int k = 0; k < 2; ++k) \
    dst[m][k] = *(const bf16x8*)(SA(b, h) + g8_lds_byte(wr * 64 + m * 16 + fr, k * 32 + fq * 8))
#define LDB(dst, b, h) _Pragma("unroll") for (int n = 0; n < 2; ++n) _Pragma("unroll") for (int k = 0; k < 2; ++k) \
    dst[n][k] = *(const bf16x8*)(SB(b, h) + g8_lds_byte(wc * 32 + n * 16 + fr, k * 32 + fq * 8))
#define MMA(ai, bj, At_, Bt_) do { __builtin_amdgcn_s_setprio(1); \
    _Pragma("unroll") for (int m = 0; m < 4; ++m) _Pragma("unroll") for (int n = 0; n < 2; ++n) _Pragma("unroll") for (int k = 0; k < 2; ++k) \
      acc[ai][bj][m][n] = __builtin_amdgcn_mfma_f32_16x16x32_bf16(At_[m][k], Bt_[n][k], acc[ai][bj][m][n], 0, 0, 0); \
    __builtin_amdgcn_s_setprio(0); } while (0)
#define WAIT_V(n) asm volatile("s_waitcnt vmcnt(" #n ")" ::: "memory")
#define WAIT_L(n) asm volatile("s_waitcnt lgkmcnt(" #n ")" ::: "memory")
#define BAR __builtin_amdgcn_s_barrier()
#define SCHED __builtin_amdgcn_sched_barrier(0)
#pragma unroll
  for (int a = 0; a < 2; ++a)
#pragma unroll
    for (int b2 = 0; b2 < 2; ++b2)
#pragma unroll
      for (int m = 0; m < 4; ++m)
#pragma unroll
        for (int n = 0; n < 2; ++n) acc[a][b2][m][n] = (f32x4){0.f, 0.f, 0.f, 0.f};
  bf16x8 At[4][2], B0[2][2], B1[2][2];
  const int nt = K / 64;
  constexpr int HALF = 128;
  __syncthreads();
  STAGE(SB(0, 0), Bt, bcol, 0); STAGE(SA(0, 0), A, brow, 0);
  STAGE(SB(0, 1), Bt, bcol + HALF, 0); STAGE(SA(0, 1), A, brow + HALF, 0);
  if (wr == 1) BAR;
  WAIT_V(4); BAR;
  STAGE(SB(1, 0), Bt, bcol, 1); STAGE(SA(1, 0), A, brow, 1); STAGE(SB(1, 1), Bt, bcol + HALF, 1);
  WAIT_V(6); BAR;
  for (int t = 0; t < nt - 2; t += 2) {
    LDB(B0, 0, 0); SCHED; LDA(At, 0, 0); STAGE(SA(1, 1), A, brow + HALF, t + 1);
    WAIT_L(8); BAR; WAIT_L(0); MMA(0, 0, At, B0); BAR; SCHED;
    LDB(B1, 0, 1); STAGE(SB(0, 0), Bt, bcol, t + 2);
    BAR; WAIT_L(0); MMA(0, 1, At, B1); BAR;
    LDA(At, 0, 1); STAGE(SA(0, 0), A, brow, t + 2);
    BAR; WAIT_L(0); MMA(1, 0, At, B0); BAR; SCHED;
    STAGE(SB(0, 1), Bt, bcol + HALF, t + 2);
    WAIT_V(6); BAR; MMA(1, 1, At, B1); BAR;
    LDB(B0, 1, 0); SCHED; LDA(At, 1, 0); STAGE(SA(0, 1), A, brow + HALF, t + 2);
    WAIT_L(8); BAR; WAIT_L(0); MMA(0, 0, At, B0); BAR; SCHED;
    LDB(B1, 1, 1); STAGE(SB(1, 0), Bt, bcol, t + 3);
    BAR; WAIT_L(0); MMA(0, 1, At, B1); BAR;
    LDA(At, 1, 1); STAGE(SA(1, 0), A, brow, t + 3);
    BAR; WAIT_L(0); MMA(1, 0, At, B0); BAR; SCHED;
    STAGE(SB(1, 1), Bt, bcol + HALF, t + 3);
    WAIT_V(6); BAR; MMA(1, 1, At, B1); BAR;
  }
  { LDB(B0, 0, 0); LDA(At, 0, 0); STAGE(SA(1, 1), A, brow + HALF, nt - 1);
    BAR; WAIT_L(0); MMA(0, 0, At, B0); BAR;
    LDB(B1, 0, 1); BAR; WAIT_L(0); MMA(0, 1, At, B1); BAR;
    LDA(At, 0, 1); WAIT_V(4); BAR; WAIT_L(0); MMA(1, 0, At, B0); MMA(1, 1, At, B1); BAR; }
  { LDB(B0, 1, 0); LDA(At, 1, 0); WAIT_V(2); BAR; WAIT_L(0); MMA(0, 0, At, B0); BAR;
    LDB(B1, 1, 1); WAIT_V(0); BAR; WAIT_L(0); MMA(0, 1, At, B1); BAR;
    LDA(At, 1, 1); BAR; WAIT_L(0); MMA(1, 0, At, B0); MMA(1, 1, At, B1); BAR; }
  if (wr == 0) BAR;
#undef SA
#undef SB
#undef STAGE
#undef LDA
#undef LDB
#undef MMA
#undef WAIT_V
#undef WAIT_L
#undef BAR
#undef SCHED
}

template <int LD, bool NORM>
__device__ __forceinline__ void ep_store(u16* __restrict__ dst, u32 ob, const f32x4 (&acc)[2][2][4][2], const float* __restrict__ gain,
                                         float extra, unsigned char* smem, int wave, int lane_in) {
  int lane = lane_in;
  asm volatile("" : "+v"(lane));
  const int fr = lane & 15, fq = lane >> 4;
  unsigned char* reg = smem + wave * 16384;
  float gj[4] = {1.f, 1.f, 1.f, 1.f};
  if (NORM) {
#pragma unroll
    for (int j = 0; j < 4; ++j) gj[j] = gain[j * 16 + fr] * extra;
  }
  const int lrot = (fr >> 3) + 2 * fq;
  unsigned char* wbase = reg + (4 * fq) * 128 + (fr & 7) * 2;
#pragma unroll
  for (int ai = 0; ai < 2; ++ai)
#pragma unroll
    for (int m = 0; m < 4; ++m) {
#pragma unroll
      for (int r = 0; r < 4; ++r) {
        float rs = 1.f;
        if (NORM) {
          float sq = 0.f;
#pragma unroll
          for (int bj = 0; bj < 2; ++bj)
#pragma unroll
            for (int n = 0; n < 2; ++n) sq += acc[ai][bj][m][n][r] * acc[ai][bj][m][n][r];
          sq += DPPF(sq, 0xb1); sq += DPPF(sq, 0x4e); sq += DPPF(sq, 0x141); sq += DPPF(sq, 0x140);
          rs = rsqrtf(sq * (1.f / 64.f) + EPS);
        }
#pragma unroll
        for (int bj = 0; bj < 2; ++bj)
#pragma unroll
          for (int n = 0; n < 2; ++n) {
            const float v = acc[ai][bj][m][n][r];
            const int ch = ((bj * 2 + n) * 2 + lrot) & 7;
            *(u16*)(wbase + (ai * 64 + m * 16 + r) * 128 + (ch << 4)) = f2bf(NORM ? v * rs * gj[bj * 2 + n] : v);
          }
      }
      __builtin_amdgcn_sched_barrier(0);
    }
  WAVE_LDS_SYNC();
  const int c16 = lane & 7, r8 = lane >> 3;
#pragma unroll
  for (int it = 0; it < 16; ++it) {
    const int rw = it * 8 + r8;
    const u32x4 v = *(const u32x4*)(reg + rw * 128 + (((c16 + 2 * ((rw >> 2) & 3)) & 7) << 4));
    const int grow = (it >> 3) * 128 + (it & 7) * 8 + r8;
    *(u32x4*)(dst + ob + (u32)(grow * LD + c16 * 8)) = v;
    if ((it & 3) == 3) __builtin_amdgcn_sched_barrier(0);
  }
}

__device__ __forceinline__ void phase1(const Params& p, unsigned char* smem) {
  const u16* H = (const u16*)(p.ws + OFF_H);
  const u16* WT = (const u16*)(p.ws + OFF_WTIN);
  u16* PROJ = (u16*)(p.ws + OFF_PROJ);
  u16* KVC = (u16*)(p.ws + OFF_KVC);
  u16* IKC = (u16*)(p.ws + OFF_IKC);
  float* SMALL = (float*)(p.ws + OFF_SMALL);
  const int lane = TIDX & 63, wave = TIDX >> 6;
  const int wr = wave >> 2, wc = wave & 3, fr = lane & 15, fq = lane >> 4;
  const int ntn = NPADW / 256;
  const int ntiles = (MTOK / 256) * ntn;
  for (int t = blockIdx.x; t < ntiles; t += gridDim.x) {
    const int m0 = (t / ntn) * 256, n0 = (t % ntn) * 256;
    f32x4 acc[2][2][4][2];
    gemm8_tile(H, WT, DM, m0, n0, smem, acc);
    const int cbase = n0 + wc * 64;
    const u32 rbase = (u32)(m0 + wr * 64);
    if (cbase < C_IQ) {
      ep_store<LDP, true>(PROJ, rbase * LDP + (u32)cbase, acc, p.in[3], 0.125f, smem, wave, lane);
    } else if (cbase < LDP) {
      ep_store<LDP, false>(PROJ, rbase * LDP + (u32)cbase, acc, nullptr, 1.f, smem, wave, lane);
    } else if (cbase < N_AV) {
      ep_store<256, true>(KVC, rbase * 256 + (u32)(cbase - N_AK), acc, p.in[4], 1.f, smem, wave, lane);
    } else if (cbase < N_IK) {
      ep_store<256, false>(KVC, rbase * 256 + (u32)(cbase - N_AV + 128), acc, nullptr, 1.f, smem, wave, lane);
    } else if (cbase < N_SM) {
      ep_store<64, false>(IKC, rbase * 64, acc, nullptr, 1.f, smem, wave, lane);
    } else if (cbase == N_SM) {
      const u32 sb0 = (rbase + 4 * fq) * 16 + (u32)fr;
#pragma unroll
      for (int ai = 0; ai < 2; ++ai)
#pragma unroll
        for (int m = 0; m < 4; ++m)
#pragma unroll
          for (int r = 0; r < 4; ++r) SMALL[sb0 + (u32)((ai * 128 + m * 16 + r) * 16)] = acc[ai][0][m][0][r];
    }
  }
}

constexpr int IDX_RS = 8208;

__device__ __forceinline__ u32 f2key(float x) {
  _Float16 h = (_Float16)x;
  u32 b = (u32) * (u16*)&h;
  return (b & 0x8000u) ? ((~b) & 0xffffu) : (b | 0x8000u);
}
__device__ __forceinline__ int count_ge_wave(const u32 (&kreg)[32], u32 mid) {
  const u32 m1 = (mid - 1u) * 0x00010001u;
  const u32 one = 0x00010001u;
  u32 acc0 = 0u, acc1 = 0u;
#pragma unroll
  for (int i = 0; i < 32; i += 2) {
    u32 t0, t1;
    asm("v_pk_sub_u16 %0, %1, %2 clamp" : "=v"(t0) : "v"(kreg[i]), "s"(m1));
    asm("v_pk_sub_u16 %0, %1, %2 clamp" : "=v"(t1) : "v"(kreg[i + 1]), "s"(m1));
    asm("v_pk_min_u16 %0, %1, %2" : "=v"(t0) : "v"(t0), "s"(one));
    asm("v_pk_min_u16 %0, %1, %2" : "=v"(t1) : "v"(t1), "s"(one));
    asm("v_pk_add_u16 %0, %1, %2" : "=v"(acc0) : "v"(acc0), "v"(t0));
    asm("v_pk_add_u16 %0, %1, %2" : "=v"(acc1) : "v"(acc1), "v"(t1));
  }
  int c = (int)((acc0 & 0xffffu) + (acc0 >> 16) + (acc1 & 0xffffu) + (acc1 >> 16));
  return wave_sum_i_dpp(c);
}

__device__ __forceinline__ void idx_item(const Params& p, unsigned char* smem, int b, int tq) {
  const u16* PROJ = (const u16*)(p.ws + OFF_PROJ);
  const float* SMALL = (const float*)(p.ws + OFF_SMALL);
  u16* SEL = (u16*)(p.ws + OFF_SEL);
  const int tid = TIDX, lane = tid & 63, wave = tid >> 6;
  const int t0 = tq * 16;
  const size_t tokb = (size_t)b * SEQ;
  if (tq < 16) {
    for (int rr = 0; rr < 2; ++rr) {
      int row = 2 * wave + rr, t = t0 + row;
      u16* out = SEL + (tokb + t) * 256;
      for (int i = lane; i < 256; i += 64) out[i] = (i <= t) ? (u16)i : (u16)0xFFFF;
    }
    return;
  }
  const int q = lane & 15, g = lane >> 4;
  __syncthreads();
  {
    const u16* iqrow = PROJ + (tokb + t0 + q) * LDP + C_IQ;
    bf16x8 bq[8][2];
    float wq[8];
#pragma unroll
    for (int h = 0; h < 8; ++h) {
      bq[h][0] = *(const bf16x8*)(iqrow + h * 64 + g * 8);
      bq[h][1] = *(const bf16x8*)(iqrow + h * 64 + 32 + g * 8);
      wq[h] = SMALL[(tokb + t0 + q) * 16 + h];
    }
    const int nkb = tq + 1;
    const int niter = (nkb > wave) ? ((nkb - wave + 7) >> 3) : 0;
    const u16* ikbase = (const u16*)(p.ws + OFF_IKC) + (tokb + q) * 64 + g * 8;
    bf16x8 ca[3][2];
#pragma unroll
    for (int j = 0; j < 3; ++j)
      if (j < niter) {
        const u16* ikrow = ikbase + (size_t)((wave + 8 * j) * 16) * 64;
        ca[j][0] = *(const bf16x8*)(ikrow); ca[j][1] = *(const bf16x8*)(ikrow + 32);
      }
    for (int i0 = 0; i0 < ((p.flags & 8) ? 0 : niter); i0 += 3) {
#pragma unroll
      for (int j = 0; j < 3; ++j) {
        if (i0 + j < niter) {
          const int s0 = (wave + 8 * (i0 + j)) * 16;
          f32x4 tot = {0.f, 0.f, 0.f, 0.f};
#pragma unroll
          for (int h = 0; h < 8; ++h) {
            f32x4 acc = {0.f, 0.f, 0.f, 0.f};
            acc = __builtin_amdgcn_mfma_f32_16x16x32_bf16(ca[j][0], bq[h][0], acc, 0, 0, 0);
            acc = __builtin_amdgcn_mfma_f32_16x16x32_bf16(ca[j][1], bq[h][1], acc, 0, 0, 0);
#pragma unroll
            for (int r = 0; r < 4; ++r) tot[r] += wq[h] * fmaxf(acc[r], 0.f);
          }
          if (i0 + 3 + j < niter) {
            const u16* ikrow = ikbase + (size_t)((wave + 8 * (i0 + 3 + j)) * 16) * 64;
            ca[j][0] = *(const bf16x8*)(ikrow); ca[j][1] = *(const bf16x8*)(ikrow + 32);
          }
          u32 k[4];
#pragma unroll
          for (int r = 0; r < 4; ++r) {
            int sidx = s0 + 4 * g + r;
            k[r] = (sidx <= t0 + q) ? f2key(tot[r]) : 0u;
          }
          u32x2 w2 = {k[0] | (k[1] << 16), k[2] | (k[3] << 16)};
          *(u32x2*)(smem + q * IDX_RS + (s0 + 4 * g) * 2) = w2;
        }
        __builtin_amdgcn_sched_barrier(0);
      }
    }
    const int nk = t0 + 16, nk64 = (nk + 63) & ~63;
    for (int i = tid; i < 16 * (nk64 - nk); i += NTHREADS) {
      int row = i / (nk64 - nk), c = nk + i % (nk64 - nk);
      *(u16*)(smem + row * IDX_RS + c * 2) = 0;
    }
  }
  __syncthreads();
  const int nk64 = (t0 + 16 + 63) & ~63;
  for (int rr = 0; rr < ((p.flags & 16) ? 0 : 2); ++rr) {
    const int row = 2 * wave + rr, t = t0 + row;
    u16* out = SEL + (tokb + t) * 256;
    u32 kreg[32];
    if (lane * 64 < nk64) {
      const uint4* src = (const uint4*)(smem + row * IDX_RS + lane * 128);
#pragma unroll
      for (int i = 0; i < 8; ++i) {
        uint4 v = src[i];
        kreg[4 * i] = v.x; kreg[4 * i + 1] = v.y; kreg[4 * i + 2] = v.z; kreg[4 * i + 3] = v.w;
      }
    } else {
#pragma unroll
      for (int i = 0; i < 32; ++i) kreg[i] = 0u;
    }
    WAVE_LDS_SYNC();
    u32 lo = 1u, hi = 65535u;
    while (lo < hi) {
      u32 mid = (lo + hi + 1u) >> 1;
      int c = count_ge_wave(kreg, mid);
      if (c >= 256) lo = mid; else hi = mid - 1u;
    }
    const u32 tau = lo;
    int gt = 0, eq = 0;
#pragma unroll
    for (int i = 0; i < 32; ++i) {
      u32 a = kreg[i] & 0xffffu, c2 = kreg[i] >> 16;
      gt += (a > tau) ? 1 : 0; gt += (c2 > tau) ? 1 : 0;
      eq += (a == tau) ? 1 : 0; eq += (c2 == tau) ? 1 : 0;
    }
    int packed = gt | (eq << 16);
    int incl = packed;
#pragma unroll
    for (int o = 1; o < 64; o <<= 1) {
      int v = __shfl_up(incl, o);
      if (lane >= o) incl += v;
    }
    const int excl = incl - packed;
    const int total = __shfl(incl, 63);
    const int need = 256 - (total & 0xffff);
    const int pg = excl & 0xffff, pe = excl >> 16;
    int pos = pg + min(pe, need);
    int eqseen = pe;
    u16* lrow = (u16*)(smem + row * IDX_RS);
#pragma unroll
    for (int i = 0; i < 32; ++i) {
#pragma unroll
      for (int hh = 0; hh < 2; ++hh) {
        u32 kv = hh ? (kreg[i] >> 16) : (kreg[i] & 0xffffu);
        int idx = lane * 64 + 2 * i + hh;
        bool take = false;
        if (kv > tau) take = true;
        else if (kv == tau) { take = (eqseen < need); ++eqseen; }
        if (take) { lrow[pos] = (u16)idx; ++pos; }
      }
    }
    WAVE_LDS_SYNC();
    *(u32x2*)(out + lane * 4) = *(const u32x2*)(lrow + lane * 4);
    WAVE_LDS_SYNC();
  }
}

constexpr int DNP = 68;
constexpr int DL_KT = 0;
constexpr int DL_V = DL_KT + 128 * DNP * 4;
constexpr int DL_QB = DL_V + 64 * 128 * 4;
constexpr int DL_KB = DL_QB + 64 * 272;
constexpr int DL_SM = DL_KB + 64 * 272;
constexpr int DL_RAW = DL_SM + 2048;
static_assert(DL_RAW + 3 * 67 * 272 <= SMEM_BYTES, "dn_local LDS");
__device__ __forceinline__ void dn_local_item(const Params& p, unsigned char* smem, int item) {
  const int h = item & 3, n = (item >> 2) & 63, b = item >> 8;
  const u16* PROJ = (const u16*)(p.ws + OFF_PROJ);
  const float* SMALL = (const float*)(p.ws + OFF_SMALL);
  u16* Ug = (u16*)((unsigned char*)p.out + DO_U);
  u16* Wg = (u16*)((unsigned char*)p.out + DO_W);
  u16* QNg = (u16*)((unsigned char*)p.out + DO_QN);
  u16* KNTg = (u16*)((unsigned char*)p.out + DO_KNT);
  u16* ATTg = (u16*)(p.ws + OFF_ATT);
  float* GCg = (float*)(p.ws + OFF_GC);
  const float* convw = p.in[5];
  const int tid = TIDX, lane = tid & 63, wave = tid >> 6;
  const int c0 = n * 64;
  const size_t tok0 = (size_t)b * SEQ + c0;
  float* Kt = (float*)(smem + DL_KT);
  float* V = (float*)(smem + DL_V);
  unsigned char* Qb = smem + DL_QB;
  unsigned char* Kb = smem + DL_KB;
  float* gc = (float*)(smem + DL_SM);
  float* beta = gc + 64;
  float* ssp = beta + 64;
  unsigned char* RAW = smem + DL_RAW;
  float* AmT = (float*)(smem + DL_RAW);
  __syncthreads();
  {
    u32x4 rg[7];
#pragma unroll
    for (int k = 0; k < 7; ++k) {
      const int ci = tid + 512 * k;
      rg[k] = (u32x4){0u, 0u, 0u, 0u};
      if (ci < 3216) {
        const int arr = ci / 1072, rem = ci - arr * 1072, row = rem >> 4, ch = rem & 15;
        const int trel = c0 - 3 + row;
        if (trel >= 0)
          rg[k] = *(const u32x4*)(PROJ + ((size_t)b * SEQ + trel) * LDP + (C_DQ + arr * 512) + h * 128 + ch * 8);
      }
    }
#pragma unroll
    for (int k = 0; k < 7; ++k) {
      const int ci = tid + 512 * k;
      if (ci < 3216) {
        const int arr = ci / 1072, rem = ci - arr * 1072, row = rem >> 4, ch = rem & 15;
        *(u32x4*)(RAW + (arr * 67 + row) * 272 + ch * 16) = rg[k];
      }
    }
  }
  if (tid < 64) {
    float da = SMALL[(tok0 + tid) * 16 + 8 + h], db = SMALL[(tok0 + tid) * 16 + 12 + h];
    float xx = da + p.in[7][h];
    float sp = fmaxf(xx, 0.f) + log1pf(__expf(-fabsf(xx)));
    float gr = -__expf(p.in[6][h]) * sp;
    float incl = gr;
#pragma unroll
    for (int o = 1; o < 64; o <<= 1) {
      float v = __shfl_up(incl, o);
      if (lane >= o) incl += v;
    }
    gc[tid] = incl;
    beta[tid] = sigmoidf_(db);
    GCg[(tok0 + tid) * 4 + h] = incl;
  }
  __syncthreads();
  {
    const int c = tid & 127, tg = tid >> 7;
    float qv[16], kv[16];
#pragma unroll
    for (int arr = 0; arr < 3; ++arr) {
      const float w0 = convw[0 * 1536 + arr * 512 + h * 128 + c], w1 = convw[1 * 1536 + arr * 512 + h * 128 + c],
                  w2 = convw[2 * 1536 + arr * 512 + h * 128 + c], w3 = convw[3 * 1536 + arr * 512 + h * 128 + c];
      const unsigned char* rp = RAW + (arr * 67 + tg * 16) * 272 + c * 2;
      float x0 = bf2f(*(const u16*)(rp)), x1 = bf2f(*(const u16*)(rp + 272)), x2 = bf2f(*(const u16*)(rp + 2 * 272));
#pragma unroll
      for (int ii = 0; ii < 16; ++ii) {
        const float x3 = bf2f(*(const u16*)(rp + (ii + 3) * 272));
        const float y = w0 * x0 + w1 * x1 + w2 * x2 + w3 * x3;
        const float sv = y * sigmoidf_(y);
        if (arr == 0) qv[ii] = sv;
        else if (arr == 1) kv[ii] = sv;
        else V[(tg * 16 + ii) * 128 + c] = sv;
        x0 = x1; x1 = x2; x2 = x3;
      }
    }
#pragma unroll
    for (int ii = 0; ii < 16; ++ii) {
      const float sq = wave_sum_dpp(qv[ii] * qv[ii]);
      const float sk = wave_sum_dpp(kv[ii] * kv[ii]);
      if (lane == 0) {
        ssp[((tg * 16 + ii) * 2) + (wave & 1)] = sq;
        ssp[128 + ((tg * 16 + ii) * 2) + (wave & 1)] = sk;
      }
    }
    __syncthreads();
#pragma unroll
    for (int ii = 0; ii < 16; ++ii) {
      const int i = tg * 16 + ii;
      const float qsc = rsqrtf(ssp[i * 2] + ssp[i * 2 + 1] + EPS) * 0.08838834764831845f;
      const float ksc = rsqrtf(ssp[128 + i * 2] + ssp[128 + i * 2 + 1] + EPS);
      const float qn = qv[ii] * qsc, kn = kv[ii] * ksc;
      *(u16*)(Qb + i * 272 + c * 2) = f2bf(qn);
      *(u16*)(Kb + i * 272 + c * 2) = f2bf(kn);
      Kt[c * DNP + i] = kn;
    }
  }
  __syncthreads();
#pragma unroll
  for (int k = 0; k < 4; ++k) {
    const int gi = tid + 512 * k;
    {
      const int i = gi >> 5, d4 = (gi & 31) * 4;
      const u32x2 v = *(const u32x2*)(Qb + i * 272 + d4 * 2);
      *(u32x2*)(QNg + (tok0 + i) * 512 + h * 128 + perm32(d4)) = v;
    }
    {
      const int d = gi >> 4, t4 = (gi & 15) * 4;
      const f32x4 v = *(const f32x4*)(Kt + d * DNP + t4);
      u32x2 o = {pack2(v[0], v[1]), pack2(v[2], v[3])};
      *(u32x2*)(KNTg + (size_t)item * 8192 + d * 64 + perm32(t4)) = o;
    }
  }
  {
    const int mat = wave >> 2, it = wave & 3;
    const int fr = lane & 15, fg = lane >> 4;
    const unsigned char* Ab = mat ? Qb : Kb;
    bf16x8 af[4];
#pragma unroll
    for (int kk = 0; kk < 4; ++kk) af[kk] = *(const bf16x8*)(Ab + (it * 16 + fr) * 272 + kk * 64 + fg * 16);
    f32x4 gi4 = *(const f32x4*)(gc + it * 16 + 4 * fg);
    f32x4 bi4 = *(const f32x4*)(beta + it * 16 + 4 * fg);
#pragma unroll
    for (int jt = 0; jt < 4; ++jt) {
      f32x4 acc = {0.f, 0.f, 0.f, 0.f};
      if (jt <= it) {
#pragma unroll
        for (int kk = 0; kk < 4; ++kk) {
          bf16x8 bfg = *(const bf16x8*)(Kb + (jt * 16 + fr) * 272 + kk * 64 + fg * 16);
          acc = __builtin_amdgcn_mfma_f32_16x16x32_bf16(af[kk], bfg, acc, 0, 0, 0);
        }
      }
      const int j = jt * 16 + fr;
      const float gj = gc[j];
#pragma unroll
      for (int r = 0; r < 4; ++r) {
        const int i = it * 16 + 4 * fg + r;
        const float dec = __expf(fminf(gi4[r] - gj, 0.f));
        if (mat == 0) { if (jt <= it) AmT[j * 64 + i] = (i > j) ? bi4[r] * acc[r] * dec : 0.f; }
        else ATTg[(size_t)item * 4096 + i * 64 + perm32(j)] = f2bf((i >= j) ? acc[r] * dec : 0.f);
      }
    }
  }
  __syncthreads();
  if (tid < 256) {
    const int c = tid;
    const bool isu = c < 128;
    const int cc = c & 127;
    const int pc = perm32(cc);
#pragma unroll 1
    for (int ib = 0; ib < 4; ++ib) {
      float sreg[16];
#pragma unroll
      for (int r = 0; r < 16; ++r) {
        int i = ib * 16 + r;
        sreg[r] = isu ? V[i * 128 + cc] * beta[i] : Kt[cc * DNP + i] * beta[i] * __expf(gc[i]);
      }
#pragma unroll 1
      for (int j = 0; j < ib * 16; ++j) {
        float xj = isu ? V[j * 128 + cc] : Kt[cc * DNP + j];
        const f32x4* ap = (const f32x4*)(AmT + j * 64 + ib * 16);
        f32x4 a0 = ap[0], a1 = ap[1], a2 = ap[2], a3 = ap[3];
        sreg[0] -= a0[0] * xj; sreg[1] -= a0[1] * xj; sreg[2] -= a0[2] * xj; sreg[3] -= a0[3] * xj;
        sreg[4] -= a1[0] * xj; sreg[5] -= a1[1] * xj; sreg[6] -= a1[2] * xj; sreg[7] -= a1[3] * xj;
        sreg[8] -= a2[0] * xj; sreg[9] -= a2[1] * xj; sreg[10] -= a2[2] * xj; sreg[11] -= a2[3] * xj;
        sreg[12] -= a3[0] * xj; sreg[13] -= a3[1] * xj; sreg[14] -= a3[2] * xj; sreg[15] -= a3[3] * xj;
      }
#pragma unroll
      for (int q = 0; q < 15; ++q) {
        const float* ar = AmT + (ib * 16 + q) * 64 + ib * 16;
#pragma unroll
        for (int r = q + 1; r < 16; ++r) sreg[r] -= ar[r] * sreg[q];
      }
#pragma unroll
      for (int r = 0; r < 16; ++r) {
        int i = ib * 16 + r;
        if (isu) { V[i * 128 + cc] = sreg[r]; Ug[(tok0 + i) * 512 + h * 128 + cc] = f2bf(sreg[r]); }
        else { Kt[cc * DNP + i] = sreg[r]; Wg[(tok0 + i) * 512 + h * 128 + pc] = f2bf(sreg[r]); }
      }
    }
  }
}

__device__ __forceinline__ void phase2(const Params& p, unsigned char* smem) {
#ifndef NO_IDX
  for (int i = blockIdx.x; i < 2048; i += gridDim.x) idx_item(p, smem, i & 7, 255 - (i >> 3));
#endif
#ifndef NO_DNL
  if (!(p.flags & 1))
    for (int i = blockIdx.x; i < 2048; i += gridDim.x) dn_local_item(p, smem, i);
#endif
}

constexpr int SC_WP = 272, SC_KP = 144;
constexpr int SC_W = 0, SC_Q = 64 * SC_WP, SC_KT = 2 * 64 * SC_WP, SC_AT = SC_KT + 128 * SC_KP, SC_U = SC_AT + 64 * SC_KP,
              SC_BUF = SC_U + 64 * SC_WP;
constexpr int SC_GC = 2 * SC_BUF;
static_assert(SC_GC + 2 * 64 * 4 <= SMEM_BYTES, "scan LDS");

__device__ __forceinline__ void dn_scan_item(const Params& p, unsigned char* smem, int bh) {
  const int h = bh & 3, b = bh >> 2;
  const u16* Ug = (const u16*)((const unsigned char*)p.out + DO_U);
  const u16* Wg = (const u16*)((const unsigned char*)p.out + DO_W);
  const u16* QNg = (const u16*)((const unsigned char*)p.out + DO_QN);
  const u16* KNTg = (const u16*)((const unsigned char*)p.out + DO_KNT);
  const u16* ATTg = (const u16*)(p.ws + OFF_ATT);
  const float* GCg = (const float*)(p.ws + OFF_GC);
  const u16* PROJ = (const u16*)(p.ws + OFF_PROJ);
  u16* YDN = (u16*)(p.ws + OFF_YDN);
  const float* ogain = p.in[8];
  const int tid = TIDX, lane = tid & 63, wave = tid >> 6;
  const int fr = lane & 15, fg = lane >> 4;
  const int ecol = wave * 16 + fr;
  float* gcs = (float*)(smem + SC_GC);
  f32x4 S[8];
#pragma unroll
  for (int d = 0; d < 8; ++d) S[d] = (f32x4){0.f, 0.f, 0.f, 0.f};
  u32x4 st[9];
  float gcr = 0.f;
  const int r16 = tid >> 4, c16 = tid & 15;
  const int r8 = tid >> 3, c8 = tid & 7;
#define SCAN_LOAD(n_)                                                                                      \
  {                                                                                                        \
    const size_t tk0 = (size_t)b * SEQ + (size_t)(n_) * 64;                                                \
    const size_t it_ = (size_t)((b * 64 + (n_)) * 4 + h);                                                  \
    st[0] = *(const u32x4*)(Wg + (tk0 + r16) * 512 + h * 128 + c16 * 8);                                   \
    st[1] = *(const u32x4*)(Wg + (tk0 + r16 + 32) * 512 + h * 128 + c16 * 8);                              \
    st[2] = *(const u32x4*)(QNg + (tk0 + r16) * 512 + h * 128 + c16 * 8);                                  \
    st[3] = *(const u32x4*)(QNg + (tk0 + r16 + 32) * 512 + h * 128 + c16 * 8);                             \
    st[4] = *(const u32x4*)(KNTg + it_ * 8192 + (size_t)tid * 8);                                          \
    st[5] = *(const u32x4*)(KNTg + it_ * 8192 + (size_t)(tid + 512) * 8);                                  \
    st[6] = *(const u32x4*)(ATTg + it_ * 4096 + (size_t)tid * 8);                                          \
    st[7] = *(const u32x4*)(Ug + (tk0 + r16) * 512 + h * 128 + c16 * 8);                                   \
    st[8] = *(const u32x4*)(Ug + (tk0 + r16 + 32) * 512 + h * 128 + c16 * 8);                              \
    if (tid < 64) gcr = GCg[(tk0 + tid) * 4 + h];                                                          \
  }
#define SCAN_STORE(buf_)                                                                                   \
  {                                                                                                        \
    unsigned char* bs_ = smem + (buf_) * SC_BUF;                                                           \
    *(u32x4*)(bs_ + SC_W + r16 * SC_WP + c16 * 16) = st[0];                                                \
    *(u32x4*)(bs_ + SC_W + (r16 + 32) * SC_WP + c16 * 16) = st[1];                                         \
    *(u32x4*)(bs_ + SC_Q + r16 * SC_WP + c16 * 16) = st[2];                                                \
    *(u32x4*)(bs_ + SC_Q + (r16 + 32) * SC_WP + c16 * 16) = st[3];                                         \
    *(u32x4*)(bs_ + SC_KT + r8 * SC_KP + c8 * 16) = st[4];                                                 \
    *(u32x4*)(bs_ + SC_KT + (r8 + 64) * SC_KP + c8 * 16) = st[5];                                          \
    *(u32x4*)(bs_ + SC_AT + r8 * SC_KP + c8 * 16) = st[6];                                                 \
    *(u32x4*)(bs_ + SC_U + r16 * SC_WP + c16 * 16) = st[7];                                                \
    *(u32x4*)(bs_ + SC_U + (r16 + 32) * SC_WP + c16 * 16) = st[8];                                         \
    if (tid < 64) gcs[(buf_) * 64 + tid] = gcr;                                                            \
  }
  __syncthreads();
  SCAN_LOAD(0)
  SCAN_STORE(0)
  if (1 < 64) SCAN_LOAD(1)
  __syncthreads();
  for (int n = 0; n < 64; ++n) {
    const int buf = n & 1;
    const size_t tok0 = (size_t)b * SEQ + n * 64;
    if (n + 1 < 64) SCAN_STORE(buf ^ 1)
    if (n + 2 < 64) SCAN_LOAD(n + 2)
    __builtin_amdgcn_sched_barrier(0);
    const unsigned char* base = smem + buf * SC_BUF;
    const u32 ub0 = (u32)(tok0 + 4 * fg) * 512 + (u32)(h * 128 + ecol);
    const float* gcb = gcs + buf * 64 + 4 * fg;
    const float glast = gcs[buf * 64 + 63];
    bf16x8 Sb[4];
#pragma unroll
    for (int kk = 0; kk < 4; ++kk) {
      union { u32 w[4]; bf16x8 v; } cv;
      cv.w[0] = pack2(S[2 * kk][0], S[2 * kk][1]); cv.w[1] = pack2(S[2 * kk][2], S[2 * kk][3]);
      cv.w[2] = pack2(S[2 * kk + 1][0], S[2 * kk + 1][1]); cv.w[3] = pack2(S[2 * kk + 1][2], S[2 * kk + 1][3]);
      Sb[kk] = cv.v;
    }
    f32x4 vnew[4], ov[4];
#pragma unroll
    for (int m = 0; m < 4; ++m) {
      f32x4 aw = {0.f, 0.f, 0.f, 0.f}, aq = {0.f, 0.f, 0.f, 0.f};
#pragma unroll
      for (int kk = 0; kk < 4; ++kk) {
        bf16x8 wf = *(const bf16x8*)(base + SC_W + (m * 16 + fr) * SC_WP + kk * 64 + fg * 16);
        bf16x8 qf = *(const bf16x8*)(base + SC_Q + (m * 16 + fr) * SC_WP + kk * 64 + fg * 16);
        aw = __builtin_amdgcn_mfma_f32_16x16x32_bf16(wf, Sb[kk], aw, 0, 0, 0);
        aq = __builtin_amdgcn_mfma_f32_16x16x32_bf16(qf, Sb[kk], aq, 0, 0, 0);
      }
      f32x4 g4 = *(const f32x4*)(gcb + m * 16);
#pragma unroll
      for (int r = 0; r < 4; ++r) {
        float uv = bf2f(*(const u16*)(base + SC_U + (m * 16 + 4 * fg + r) * SC_WP + ecol * 2));
        vnew[m][r] = uv - aw[r];
        ov[m][r] = aq[r] * __expf(g4[r]);
      }
    }
    bf16x8 vb[2], vsb[2];
#pragma unroll
    for (int k2 = 0; k2 < 2; ++k2) {
      union { u32 w[4]; bf16x8 v; } c1, c2;
      const int ma = 2 * k2, mb = 2 * k2 + 1;
      c1.w[0] = pack2(vnew[ma][0], vnew[ma][1]); c1.w[1] = pack2(vnew[ma][2], vnew[ma][3]);
      c1.w[2] = pack2(vnew[mb][0], vnew[mb][1]); c1.w[3] = pack2(vnew[mb][2], vnew[mb][3]);
      f32x4 ga4 = *(const f32x4*)(gcb + ma * 16), gb4 = *(const f32x4*)(gcb + mb * 16);
      float sa[4], sb2[4];
#pragma unroll
      for (int r = 0; r < 4; ++r) { sa[r] = vnew[ma][r] * __expf(glast - ga4[r]); sb2[r] = vnew[mb][r] * __expf(glast - gb4[r]); }
      c2.w[0] = pack2(sa[0], sa[1]); c2.w[1] = pack2(sa[2], sa[3]);
      c2.w[2] = pack2(sb2[0], sb2[1]); c2.w[3] = pack2(sb2[2], sb2[3]);
      vb[k2] = c1.v; vsb[k2] = c2.v;
    }
    const float egl = __expf(glast);
#pragma unroll
    for (int d = 0; d < 8; ++d) {
      f32x4 a = S[d] * egl;
#pragma unroll
      for (int k2 = 0; k2 < 2; ++k2) {
        bf16x8 kf = *(const bf16x8*)(base + SC_KT + (d * 16 + fr) * SC_KP + k2 * 64 + fg * 16);
        a = __builtin_amdgcn_mfma_f32_16x16x32_bf16(kf, vsb[k2], a, 0, 0, 0);
      }
      S[d] = a;
    }
#pragma unroll
    for (int m = 0; m < 4; ++m) {
      f32x4 ao = ov[m];
#pragma unroll
      for (int k2 = 0; k2 < 2; ++k2) {
        bf16x8 af = *(const bf16x8*)(base + SC_AT + (m * 16 + fr) * SC_KP + k2 * 64 + fg * 16);
        ao = __builtin_amdgcn_mfma_f32_16x16x32_bf16(af, vb[k2], ao, 0, 0, 0);
      }
#pragma unroll
      for (int r = 0; r < 4; ++r) YDN[ub0 + (u32)((m * 16 + r) * 512)] = f2bf(ao[r]);
    }
    __syncthreads();
  }
#undef SCAN_LOAD
#undef SCAN_STORE
  asm volatile("s_waitcnt vmcnt(0)" ::: "memory");
  __syncthreads();
  {
    const int sub = lane >> 4, l16 = lane & 15;
    float gn8[8];
#pragma unroll
    for (int e = 0; e < 8; ++e) gn8[e] = ogain[l16 * 8 + e];
    for (int t = wave * 4 + sub; t < SEQ; t += 32) {
      const size_t tok = (size_t)b * SEQ + t;
      u16* yp = YDN + tok * 512 + h * 128 + l16 * 8;
      const u32x4 ov4 = *(const u32x4*)yp;
      const u32x4 zv4 = *(const u32x4*)(PROJ + tok * LDP + C_DZ + h * 128 + l16 * 8);
      float o8[8], z8[8];
#pragma unroll
      for (int c = 0; c < 4; ++c) { o8[2 * c] = bflo(ov4[c]); o8[2 * c + 1] = bfhi(ov4[c]); z8[2 * c] = bflo(zv4[c]); z8[2 * c + 1] = bfhi(zv4[c]); }
      float sq = 0.f;
#pragma unroll
      for (int e = 0; e < 8; ++e) sq += o8[e] * o8[e];
      sq += DPPF(sq, 0xb1); sq += DPPF(sq, 0x4e); sq += DPPF(sq, 0x141); sq += DPPF(sq, 0x140);
      const float rstd = rsqrtf(sq * (1.f / 128.f) + EPS);
      u32 w[4];
#pragma unroll
      for (int c = 0; c < 4; ++c) {
        const float y0 = o8[2 * c] * rstd * gn8[2 * c] * z8[2 * c] * sigmoidf_(z8[2 * c]);
        const float y1 = o8[2 * c + 1] * rstd * gn8[2 * c + 1] * z8[2 * c + 1] * sigmoidf_(z8[2 * c + 1]);
        w[c] = pack2(y0, y1);
      }
      *(u32x4*)yp = (u32x4){w[0], w[1], w[2], w[3]};
    }
  }
}

constexpr int AT_WAVE_BYTES = 8192 + 512 + 8192;
__device__ __forceinline__ float xor16_sum(float v) {
  auto r = __builtin_amdgcn_permlane16_swap(__float_as_uint(v), __float_as_uint(v), false, false);
  return __uint_as_float(r[0]) + __uint_as_float(r[1]);
}
__device__ __forceinline__ float xor32_sum(float v) {
  auto r = __builtin_amdgcn_permlane32_swap(__float_as_uint(v), __float_as_uint(v), false, false);
  return __uint_as_float(r[0]) + __uint_as_float(r[1]);
}
__device__ __forceinline__ void attn_query(const Params& p, unsigned char* wsm, int b, int t) {
  const u16* PROJ = (const u16*)(p.ws + OFF_PROJ);
  const u16* SEL = (const u16*)(p.ws + OFF_SEL);
  const u16* KVC = (const u16*)(p.ws + OFF_KVC);
  u16* YATT = (u16*)(p.ws + OFF_YATT);
  const int lane = TIDX & 63;
  const int fr = lane & 15, fg = lane >> 4;
  float* P = (float*)wsm;
  u16* sl = (u16*)(wsm + 8192);
  const size_t tokb = (size_t)b * SEQ;
  const size_t tok = tokb + t;
  const int nsel = min(256, t + 1);
  bf16x8 qb[2][2];
  {
    const bf16x8 z = {0, 0, 0, 0, 0, 0, 0, 0};
    const u16* qrow = PROJ + tok * LDP + C_AQ + (fr & 3) * 64 + fg * 8;
#pragma unroll
    for (int g = 0; g < 2; ++g)
#pragma unroll
      for (int kk = 0; kk < 2; ++kk) {
        bf16x8 v = *(const bf16x8*)(qrow + g * 256 + kk * 32);
        qb[g][kk] = (fr < 4) ? v : z;
      }
    const u16* sr = SEL + tok * 256;
#pragma unroll
    for (int i = 0; i < 4; ++i) sl[lane + 64 * i] = sr[lane + 64 * i];
  }
  WAVE_LDS_SYNC();
  const int ngrp = (nsel + 15) >> 4;
  const int nbq = (ngrp + 1) >> 1;
  unsigned char* KST = wsm + 8192 + 512;
  const int kq = lane >> 3, kch = lane & 7;
  u32x4 kA[2][4], kB[2][4];
#define QK_LOAD(buf_, bi_)                                                                       \
  _Pragma("unroll") for (int j = 0; j < 2; ++j)                                                  \
    _Pragma("unroll") for (int hf = 0; hf < 2; ++hf) {                                           \
      const int ki_ = min(((bi_) * 2 + j) * 16 + hf * 8 + kq, 255);                              \
      const int s_ = (int)sl[ki_] & 4095;                                                        \
      const u16* krow_ = KVC + (tokb + s_) * 256 + kch * 8;                                      \
      buf_[j][hf * 2] = *(const u32x4*)(krow_); buf_[j][hf * 2 + 1] = *(const u32x4*)(krow_ + 64); \
    }
#define QK_COMPUTE(buf_, bi_)                                                                    \
  {                                                                                              \
    _Pragma("unroll") for (int j = 0; j < 2; ++j)                                                \
      _Pragma("unroll") for (int hf = 0; hf < 2; ++hf) {                                         \
        const int row_ = hf * 8 + kq;                                                            \
        _Pragma("unroll") for (int g = 0; g < 2; ++g)                                            \
          *(u32x4*)(KST + j * 4096 + (row_ * 2 + g) * 128 + ((kch ^ (row_ & 7)) << 4)) = buf_[j][hf * 2 + g]; \
      }                                                                                          \
    WAVE_LDS_SYNC();                                                                             \
    _Pragma("unroll") for (int j = 0; j < 2; ++j) {                                              \
      const unsigned char* kr_ = KST + j * 4096 + fr * 256;                                      \
      const bf16x8 a00_ = *(const bf16x8*)(kr_ + (((0 + fg) ^ (fr & 7)) << 4));                  \
      const bf16x8 a01_ = *(const bf16x8*)(kr_ + (((4 + fg) ^ (fr & 7)) << 4));                  \
      const bf16x8 a10_ = *(const bf16x8*)(kr_ + 128 + (((0 + fg) ^ (fr & 7)) << 4));            \
      const bf16x8 a11_ = *(const bf16x8*)(kr_ + 128 + (((4 + fg) ^ (fr & 7)) << 4));            \
      f32x4 c0_ = {0.f, 0.f, 0.f, 0.f}, c1_ = {0.f, 0.f, 0.f, 0.f};                              \
      c0_ = __builtin_amdgcn_mfma_f32_16x16x32_bf16(a00_, qb[0][0], c0_, 0, 0, 0);               \
      c0_ = __builtin_amdgcn_mfma_f32_16x16x32_bf16(a01_, qb[0][1], c0_, 0, 0, 0);               \
      c1_ = __builtin_amdgcn_mfma_f32_16x16x32_bf16(a10_, qb[1][0], c1_, 0, 0, 0);               \
      c1_ = __builtin_amdgcn_mfma_f32_16x16x32_bf16(a11_, qb[1][1], c1_, 0, 0, 0);               \
      if (fr < 4) {                                                                              \
        _Pragma("unroll") for (int r = 0; r < 4; ++r) {                                          \
          const int kk2_ = ((bi_) * 2 + j) * 16 + 4 * fg + r;                                    \
          if (kk2_ < 256) {                                                                      \
            const bool v_ = kk2_ < nsel;                                                         \
            P[kk2_ * 8 + fr] = v_ ? c0_[r] : -1e30f;                                             \
            P[kk2_ * 8 + 4 + fr] = v_ ? c1_[r] : -1e30f;                                         \
          }                                                                                      \
        }                                                                                        \
      }                                                                                          \
    }                                                                                            \
    WAVE_LDS_SYNC();                                                                             \
  }
  QK_LOAD(kA, 0)
  for (int bi = 0; bi < nbq; bi += 2) {
    if (bi + 1 < nbq) { QK_LOAD(kB, bi + 1) }
    QK_COMPUTE(kA, bi)
    if (bi + 2 < nbq) { QK_LOAD(kA, bi + 2) }
    if (bi + 1 < nbq) { QK_COMPUTE(kB, bi + 1) }
  }
#undef QK_LOAD
#undef QK_COMPUTE
  for (int ki = nbq * 32 + lane; ki < 256; ki += 64) {
    *(f32x4*)(P + ki * 8) = (f32x4){-1e30f, -1e30f, -1e30f, -1e30f};
    *(f32x4*)(P + ki * 8 + 4) = (f32x4){-1e30f, -1e30f, -1e30f, -1e30f};
  }
  WAVE_LDS_SYNC();
  float inv8[8];
  {
    float lg[4][8];
#pragma unroll
    for (int i = 0; i < 4; ++i) {
      f32x4 x0 = *(const f32x4*)(P + (lane + 64 * i) * 8), x1 = *(const f32x4*)(P + (lane + 64 * i) * 8 + 4);
      lg[i][0] = x0[0]; lg[i][1] = x0[1]; lg[i][2] = x0[2]; lg[i][3] = x0[3];
      lg[i][4] = x1[0]; lg[i][5] = x1[1]; lg[i][6] = x1[2]; lg[i][7] = x1[3];
    }
    WAVE_LDS_SYNC();
    u16* PT = (u16*)P;
#pragma unroll
    for (int hh = 0; hh < 8; ++hh) {
      float m = fmaxf(fmaxf(lg[0][hh], lg[1][hh]), fmaxf(lg[2][hh], lg[3][hh]));
      m = wave_max_dpp(m);
      float e[4], sum = 0.f;
#pragma unroll
      for (int i = 0; i < 4; ++i) { e[i] = __expf(lg[i][hh] - m); sum += e[i]; }
      sum = wave_sum_dpp(sum);
      inv8[hh] = __builtin_amdgcn_rcpf(sum);
#pragma unroll
      for (int i = 0; i < 4; ++i) PT[hh * 256 + lane + 64 * i] = f2bf(e[i]);
    }
  }
  WAVE_LDS_SYNC();
  {
    typedef short s16x4 __attribute__((ext_vector_type(4)));
    typedef __attribute__((address_space(3))) s16x4 lds_s16x4;
    const u16* PT = (const u16*)P;
    unsigned char* VST = wsm + 8192 + 512;
    const int vkey = lane >> 4, vch = lane & 15;
    const int tq = (lane & 15) >> 2, tp = lane & 3;
    f32x4 oacc[2][4];
#pragma unroll
    for (int g = 0; g < 2; ++g)
#pragma unroll
      for (int c = 0; c < 4; ++c) oacc[g][c] = (f32x4){0.f, 0.f, 0.f, 0.f};
    const int nks = (nsel + 31) >> 5;
    u32x4 vA[8], vB[8];
#define PV_LOAD(buf_, ks_)                                                                       \
  _Pragma("unroll") for (int i = 0; i < 8; ++i) {                                                \
    const int ki_ = min((ks_) * 32 + i * 4 + vkey, 255);                                         \
    const int s_ = (int)sl[ki_] & 4095;                                                          \
    buf_[i] = *(const u32x4*)(KVC + (tokb + s_) * 256 + 128 + vch * 8);                          \
  }
#define PV_COMPUTE(buf_, ks_)                                                                    \
  {                                                                                              \
    _Pragma("unroll") for (int i = 0; i < 8; ++i) {                                              \
      const int key_ = i * 4 + vkey;                                                             \
      *(u32x4*)(VST + key_ * 256 + ((vch ^ (key_ & 15)) << 4)) = buf_[i];                        \
    }                                                                                            \
    WAVE_LDS_SYNC();                                                                             \
    const bf16x8 z8_ = {0, 0, 0, 0, 0, 0, 0, 0};                                                 \
    bf16x8 pa_[2];                                                                               \
    _Pragma("unroll") for (int g = 0; g < 2; ++g) {                                              \
      const bf16x8 t_ = *(const bf16x8*)(PT + (g * 4 + (fr & 3)) * 256 + (ks_) * 32 + 8 * fg);  \
      pa_[g] = (fr < 4) ? t_ : z8_;                                                              \
    }                                                                                            \
    const int r1_ = 8 * fg + tq, r2_ = r1_ + 4;                                                  \
    _Pragma("unroll") for (int g = 0; g < 2; ++g)                                                \
      _Pragma("unroll") for (int c = 0; c < 4; ++c) {                                            \
        const int ch_ = g * 8 + 2 * c + (tp >> 1);                                               \
        const s16x4 lo_ = __builtin_amdgcn_ds_read_tr16_b64_v4i16((lds_s16x4*)(VST + r1_ * 256 + ((ch_ ^ (r1_ & 15)) << 4) + 8 * (tp & 1))); \
        const s16x4 hi_ = __builtin_amdgcn_ds_read_tr16_b64_v4i16((lds_s16x4*)(VST + r2_ * 256 + ((ch_ ^ (r2_ & 15)) << 4) + 8 * (tp & 1))); \
        const bf16x8 vb_ = {lo_[0], lo_[1], lo_[2], lo_[3], hi_[0], hi_[1], hi_[2], hi_[3]};     \
        oacc[g][c] = __builtin_amdgcn_mfma_f32_16x16x32_bf16(pa_[g], vb_, oacc[g][c], 0, 0, 0);  \
      }                                                                                          \
    WAVE_LDS_SYNC();                                                                             \
  }
    PV_LOAD(vA, 0)
    for (int ks = 0; ks < nks; ks += 2) {
      if (ks + 1 < nks) { PV_LOAD(vB, ks + 1) }
      PV_COMPUTE(vA, ks)
      if (ks + 2 < nks) { PV_LOAD(vA, ks + 2) }
      if (ks + 1 < nks) { PV_COMPUTE(vB, ks + 1) }
    }
#undef PV_LOAD
#undef PV_COMPUTE
    if (lane < 16) {
#pragma unroll
      for (int g = 0; g < 2; ++g)
#pragma unroll
        for (int c = 0; c < 4; ++c)
#pragma unroll
          for (int r = 0; r < 4; ++r)
            YATT[tok * 512 + (g * 4 + r) * 64 + 16 * c + fr] = f2bf(oacc[g][c][r] * inv8[g * 4 + r]);
    }
  }
  WAVE_LDS_SYNC();
}

__device__ __forceinline__ void phase3(const Params& p, unsigned char* smem) {
  const int wave = TIDX >> 6;
#ifndef NO_SCAN
  if (blockIdx.x < 32) {
    if (!(p.flags & 2)) dn_scan_item(p, smem, blockIdx.x);
    __syncthreads();
  }
#endif
#ifdef NO_ATTN
  return;
#endif
  if (p.flags & 4) return;
  unsigned* qctr = (unsigned*)(p.ws + 1024 + ((p.flags & 128) ? 4096 : 0));
  const unsigned xcc = (unsigned)__builtin_amdgcn_s_getreg((3 << 11) | 20) & 7u;
  unsigned char* wsm = smem + wave * AT_WAVE_BYTES;
  for (unsigned db = 0; db < 8; ++db) {
    const int bb = (int)((xcc + db) & 7u);
    for (;;) {
      unsigned qi = 0;
      if ((TIDX & 63) == 0) qi = __hip_atomic_fetch_add(qctr + bb * 16, 1u, __ATOMIC_RELAXED, __HIP_MEMORY_SCOPE_AGENT);
      qi = (unsigned)__builtin_amdgcn_readfirstlane((int)qi);
      if (qi >= (unsigned)SEQ) break;
      attn_query(p, wsm, bb, SEQ - 1 - (int)qi);
    }
  }
}

__device__ __forceinline__ void hblk_load(unsigned char* reg, const u16* __restrict__ src, u32 ob, u32 ld, int lane) {
  const int c16 = lane & 7, r8 = lane >> 3;
#pragma unroll
  for (int it = 0; it < 8; ++it) {
    const int rl = it * 8 + r8;
    const u32x4 v = *(const u32x4*)(src + ob + (u32)rl * ld + (u32)(c16 * 8));
    *(u32x4*)(reg + rl * 128 + (((c16 + 2 * ((rl >> 2) & 3)) & 7) << 4)) = v;
    if ((it & 3) == 3) __builtin_amdgcn_sched_barrier(0);
  }
}
__device__ __forceinline__ void hblk_store(const unsigned char* reg, u16* __restrict__ dst, u32 ob, u32 ld, int lane) {
  const int c16 = lane & 7, r8 = lane >> 3;
#pragma unroll
  for (int it = 0; it < 8; ++it) {
    const int rl = it * 8 + r8;
    const u32x4 v = *(const u32x4*)(reg + rl * 128 + (((c16 + 2 * ((rl >> 2) & 3)) & 7) << 4));
    *(u32x4*)(dst + ob + (u32)rl * ld + (u32)(c16 * 8)) = v;
  }
}
__device__ __forceinline__ void phase4(const Params& p, unsigned char* smem) {
  const u16* YATT = (const u16*)(p.ws + OFF_YATT);
  const u16* YDN = (const u16*)(p.ws + OFF_YDN);
  const u16* WTA = (const u16*)(p.ws + OFF_WTA);
  const u16* WTB = (const u16*)(p.ws + OFF_WTB);
  const u16* PROJ = (const u16*)(p.ws + OFF_PROJ);
  u16* MG = (u16*)(p.ws + OFF_MERGED);
  const int ntn = DM / 256, ntiles = (MTOK / 256) * ntn;
  for (int t = blockIdx.x; t < ntiles; t += gridDim.x) {
    const int m0 = (t / ntn) * 256, n0 = (t % ntn) * 256;
    f32x4 acc[2][2][4][2];
#pragma unroll
    for (int pass = 0; pass < 2; ++pass) {
      gemm8_tile(pass ? YDN : YATT, pass ? WTB : WTA, 512, m0, n0, smem, acc);
      int lane = TIDX & 63;
      asm volatile("" : "+v"(lane));
      const int wave = TIDX >> 6, wr = wave >> 2, wc = wave & 3, fr = lane & 15, fq = lane >> 4;
      unsigned char* regG = smem + wave * 16384;
      unsigned char* regT = regG + 8192;
      const int lrot = (fr >> 3) + 2 * fq;
      int off4[4];
#pragma unroll
      for (int jj = 0; jj < 4; ++jj) off4[jj] = (4 * fq) * 128 + (fr & 7) * 2 + (((jj * 2 + lrot) & 7) << 4);
#pragma unroll
      for (int ai = 0; ai < 2; ++ai) {
        const u32 gb0 = (u32)(m0 + ai * 128 + wr * 64) * LDP + (u32)(n0 + wc * 64) + (u32)(pass ? C_GB : C_GA);
        const u32 ob0 = (u32)(m0 + ai * 128 + wr * 64) * DM + (u32)(n0 + wc * 64);
        hblk_load(regG, PROJ, gb0, LDP, lane);
        if (pass == 1) hblk_load(regT, MG, ob0, DM, lane);
        WAVE_LDS_SYNC();
#pragma unroll
        for (int m = 0; m < 4; ++m)
#pragma unroll
          for (int r = 0; r < 4; ++r)
#pragma unroll
            for (int bj = 0; bj < 2; ++bj)
#pragma unroll
              for (int n = 0; n < 2; ++n) {
                const int o = off4[bj * 2 + n] + (m * 16 + r) * 128;
                float v = sigmoidf_(bf2f(*(const u16*)(regG + o))) * acc[ai][bj][m][n][r];
                if (pass == 1) v += bf2f(*(const u16*)(regT + o));
                *(u16*)(regT + o) = f2bf(v);
              }
        WAVE_LDS_SYNC();
        hblk_store(regT, MG, ob0, DM, lane);
        WAVE_LDS_SYNC();
      }
      asm volatile("s_waitcnt vmcnt(0)" ::: "memory");
    }
  }
}

__device__ __forceinline__ void phase5(const Params& p, unsigned char* smem) {
  const u16* MG = (const u16*)(p.ws + OFF_MERGED);
  const u16* WTO = (const u16*)(p.ws + OFF_WTO);
  const float* x = p.in[0];
  const int lane = TIDX & 63, wave = TIDX >> 6;
  const int wr = wave >> 2, wc = wave & 3, fr = lane & 15, fq = lane >> 4;
  const int ntn = DM / 256, ntiles = (MTOK / 256) * ntn;
  for (int t = blockIdx.x; t < ntiles; t += gridDim.x) {
    const int m0 = (t / ntn) * 256, n0 = (t % ntn) * 256;
    f32x4 acc[2][2][4][2];
    gemm8_tile(MG, WTO, DM, m0, n0, smem, acc);
    const u32 ob0 = (u32)(m0 + wr * 64 + 4 * fq) * DM + (u32)(n0 + wc * 64 + fr);
    float* outp = p.out;
#pragma unroll
    for (int ai = 0; ai < 2; ++ai)
#pragma unroll
      for (int m = 0; m < 4; ++m) {
#pragma unroll
        for (int bj = 0; bj < 2; ++bj)
#pragma unroll
          for (int n = 0; n < 2; ++n)
#pragma unroll
            for (int j = 0; j < 4; ++j) {
              u32 o = ob0 + (u32)((ai * 128 + m * 16 + j) * DM + (bj * 2 + n) * 16);
              outp[o] = x[o] + acc[ai][bj][m][n][j];
            }
        __builtin_amdgcn_sched_barrier(0);
      }
  }
}

__device__ __forceinline__ void phase6(const Params& p, unsigned char* smem) {
  const u16* H2 = (const u16*)(p.ws + OFF_H2);
  const u16* WTQ = (const u16*)(p.ws + OFF_WTQ);
  u16* QP = (u16*)(p.ws + OFF_QP);
  const int lane = TIDX & 63, wave = TIDX >> 6;
  const int wr = wave >> 2, wc = wave & 3, fr = lane & 15, fq = lane >> 4;
  const int ntn = 2048 / 256, ntiles = (MTOK / 256) * ntn;
  for (int t = blockIdx.x; t < ntiles; t += gridDim.x) {
    const int m0 = (t / ntn) * 256, n0 = (t % ntn) * 256;
    f32x4 acc[2][2][4][2];
    gemm8_tile(H2, WTQ, DM, m0, n0, smem, acc);
    ep_store<2048, false>(QP, (u32)(m0 + wr * 64) * 2048 + (u32)(n0 + wc * 64), acc, nullptr, 1.f, smem, wave, lane);
  }
}

__device__ __forceinline__ int mono_key(float v) { int b = __float_as_int(v); return b ^ ((b >> 31) & 0x7fffffff); }
__device__ __forceinline__ float unmono_key(int k) { return __int_as_float(k ^ ((k >> 31) & 0x7fffffff)); }
__device__ __forceinline__ void chain16(int (&k)[16], int x) {
#pragma unroll
  for (int j = 0; j < 16; ++j) { int hi = max(k[j], x); x = min(k[j], x); k[j] = hi; }
}

constexpr int P7_LD = 132;
__device__ __forceinline__ void phase7(const Params& p, unsigned char* smem) {
  const u16* QP = (const u16*)(p.ws + OFF_QP);
  const u16* SKB = (const u16*)(p.ws + OFF_SKB);
  float* TOPS = (float*)(p.ws + OFF_TOPS);
  u8* TOPI = (u8*)(p.ws + OFF_TOPI);
  const int tid = TIDX, lane = tid & 63, wave = tid >> 6;
  const int wm = wave >> 1, wn = wave & 1, fr = lane & 15, fg = lane >> 4;
  const int ntiles = (MTOK / G_BM) * 16;
  float* tile = (float*)smem;
  for (int t = blockIdx.x; t < ntiles; t += gridDim.x) {
    const int m0 = (t >> 4) * G_BM, hp = t & 15;
    f32x4 acc[4][4];
    gemm_mainloop(QP + hp * 128, 2048, SKB + (size_t)hp * 128 * 128, 128, 128, m0, 0, smem, acc);
#pragma unroll
    for (int i = 0; i < 4; ++i)
#pragma unroll
      for (int j = 0; j < 4; ++j)
#pragma unroll
        for (int r = 0; r < 4; ++r) {
          int row = wm * 64 + i * 16 + 4 * fg + r, col = wn * 64 + j * 16 + fr;
          tile[row * P7_LD + col] = acc[i][j][r];
        }
    __syncthreads();
    {
      const int row = tid >> 1, half = tid & 1;
      int k[16];
#pragma unroll
      for (int j = 0; j < 16; ++j) k[j] = (int)0x80000000;
      const float* rowp = tile + row * P7_LD + half * 64;
#pragma unroll 4
      for (int c = 0; c < 64; c += 4) {
        f32x4 v = *(const f32x4*)(rowp + c);
        const int ib = 127 - (half * 64 + c);
        chain16(k, (mono_key(v[0]) & ~127) | ib);
        chain16(k, (mono_key(v[1]) & ~127) | (ib - 1));
        chain16(k, (mono_key(v[2]) & ~127) | (ib - 2));
        chain16(k, (mono_key(v[3]) & ~127) | (ib - 3));
      }
#pragma unroll
      for (int j = 0; j < 16; ++j) {
        const int other = DPPI(k[j], 0xb1);
        if (half == 0) chain16(k, other);
      }
      if (half == 0) {
        size_t o = ((size_t)(m0 + row) * 16 + hp) * 16;
        float vals[16]; int idx[16];
#pragma unroll
        for (int j = 0; j < 16; ++j) { idx[j] = 127 - (k[j] & 127); vals[j] = tile[row * P7_LD + idx[j]]; }
#pragma unroll
        for (int j = 0; j < 16; j += 4) *(f32x4*)(TOPS + o + j) = (f32x4){vals[j], vals[j + 1], vals[j + 2], vals[j + 3]};
#pragma unroll
        for (int j = 0; j < 16; j += 4)
          *(u32*)(TOPI + o + j) = (u32)idx[j] | ((u32)idx[j + 1] << 8) | ((u32)idx[j + 2] << 16) | ((u32)idx[j + 3] << 24);
      }
    }
    __syncthreads();
  }
}

__device__ __forceinline__ void phase7b(const Params& p) {
  const float* TOPS = (const float*)(p.ws + OFF_TOPS);
  const u8* TOPI = (const u8*)(p.ws + OFF_TOPI);
  int* EXPERT = (int*)(p.ws + OFF_EXPERT);
  float* GATE = (float*)(p.ws + OFF_GATE);
  for (int w = blockIdx.x * NTHREADS + TIDX; w < MTOK * 8; w += gridDim.x * NTHREADS) {
    const size_t o = (size_t)w * 32;
    float sa[16], sb[16];
#pragma unroll
    for (int k = 0; k < 16; k += 4) {
      float4 v = *(const float4*)(TOPS + o + k); sa[k] = v.x; sa[k + 1] = v.y; sa[k + 2] = v.z; sa[k + 3] = v.w;
      float4 u = *(const float4*)(TOPS + o + 16 + k); sb[k] = u.x; sb[k + 1] = u.y; sb[k + 2] = u.z; sb[k + 3] = u.w;
    }
    int kk[16];
#pragma unroll
    for (int k = 0; k < 16; ++k) kk[k] = (int)0x80000000;
#pragma unroll
    for (int a = 0; a < 16; ++a)
#pragma unroll
      for (int bb = 0; bb < 16; ++bb)
        if ((a + 1) * (bb + 1) <= 16) chain16(kk, (mono_key(sa[a] + sb[bb]) & ~255) | (255 - (a * 16 + bb)));
    float vals[16];
#pragma unroll
    for (int k = 0; k < 16; ++k) vals[k] = unmono_key(kk[k] & ~255);
    float m = vals[0], s = 0.f, e[16];
#pragma unroll
    for (int k = 0; k < 16; ++k) { e[k] = __expf(vals[k] - m); s += e[k]; }
    float inv = 1.f / s;
#pragma unroll
    for (int k = 0; k < 16; ++k) {
      const int ci = 255 - (kk[k] & 255);
      int a = ci >> 4, bb = ci & 15;
      int ex = (int)TOPI[o + a] * 128 + (int)TOPI[o + 16 + bb];
      EXPERT[(size_t)w * 16 + k] = ex;
      GATE[(size_t)w * 16 + k] = e[k] * inv;
    }
  }
  {
    const int lane = TIDX & 63, wave = TIDX >> 6;
    for (int row = blockIdx.x * 8 + wave; row < 2 * 16384; row += gridDim.x * 8) {
      const int tbl = row >> 14, r = row & 16383;
      const f32x4* src = (const f32x4*)((tbl ? p.in[16] : p.in[15]) + (size_t)r * DM) + 4 * lane;
      f32x4 x[4];
      float amax = 0.f;
#pragma unroll
      for (int i = 0; i < 4; ++i) {
        x[i] = src[i];
        amax = fmaxf(amax, fmaxf(fmaxf(fabsf(x[i][0]), fabsf(x[i][1])), fmaxf(fabsf(x[i][2]), fabsf(x[i][3]))));
      }
      amax = wave_max_dpp(amax);
      const float inv = amax > 0.f ? 127.f / amax : 0.f;
      const int bias = 0;
      u32x4 o;
#pragma unroll
      for (int i = 0; i < 4; ++i) {
        int q0 = (int)rintf(x[i][0] * inv) + bias, q1 = (int)rintf(x[i][1] * inv) + bias;
        int q2 = (int)rintf(x[i][2] * inv) + bias, q3 = (int)rintf(x[i][3] * inv) + bias;
        o[i] = (u32)(q0 & 0xff) | ((u32)(q1 & 0xff) << 8) | ((u32)(q2 & 0xff) << 16) | ((u32)(q3 & 0xff) << 24);
      }
      *(u32x4*)(p.ws + (tbl ? OFF_VQ : OFF_UQ) + ((size_t)(lane >> 3) * 16384 + r) * 128 + (lane & 7) * 16) = o;
      if (lane == 0) ((float*)(p.ws + (tbl ? OFF_VS : OFF_US)))[r] = amax * (1.f / 127.f);
    }
  }
}

__device__ __forceinline__ void phase8a(const Params& p) {
  const int* EXPERT = (const int*)(p.ws + OFF_EXPERT);
  const unsigned char* UQS = p.ws + OFF_UQ;
  const unsigned char* H2Q = p.ws + OFF_H2Q;
  int* PD = (int*)(p.ws + OFF_PD);
  unsigned* ctr = (unsigned*)(p.ws + 2048 + ((p.flags & 128) ? 4096 : 0));
  const unsigned xcc = (unsigned)__builtin_amdgcn_s_getreg((3 << 11) | 20) & 7u;
  const int lane = TIDX & 63, g8 = lane >> 3, l8 = lane & 7;
  for (unsigned db = 0; db < 8; ++db) {
    const int x = (int)((xcc + db) & 7u);
    for (;;) {
      unsigned ci = 0;
      if (lane == 0) ci = __hip_atomic_fetch_add(ctr + x * 16, 1u, __ATOMIC_RELAXED, __HIP_MEMORY_SCOPE_AGENT);
      ci = (unsigned)__builtin_amdgcn_readfirstlane((int)ci);
      if (ci >= (unsigned)(MTOK / 16)) break;
#pragma unroll 1
      for (int tt = 0; tt < 16; ++tt) {
        const int tok = (int)ci * 16 + tt;
        const int e0 = EXPERT[(size_t)tok * 128 + lane], e1 = EXPERT[(size_t)tok * 128 + 64 + lane];
        const u32x4 hq = *(const u32x4*)(H2Q + (size_t)tok * DM + x * 128 + l8 * 16);
        u32x4 ua[16];
#pragma unroll
        for (int i = 0; i < 16; ++i) {
          const int k = i * 8 + g8;
          const int ek = __shfl(i < 8 ? e0 : e1, k & 63);
          ua[i] = *(const u32x4*)(UQS + ((size_t)(x * 16384 + ek)) * 128 + l8 * 16);
        }
        int keep0 = 0, keep1 = 0;
#pragma unroll
        for (int i = 0; i < 16; ++i) {
          int sd = 0;
#pragma unroll
          for (int c = 0; c < 4; ++c) sd = __builtin_amdgcn_sdot4((int)ua[i][c], (int)hq[c], sd, false);
          sd += DPPI(sd, 0xb1); sd += DPPI(sd, 0x4e); sd += DPPI(sd, 0x141);
          if (i < 8) keep0 = (l8 == (i & 7)) ? sd : keep0; else keep1 = (l8 == (i & 7)) ? sd : keep1;
        }
        int* pd = PD + ((size_t)x * MTOK + tok) * 128 + l8 * 8 + g8;
        pd[0] = keep0; pd[64] = keep1;
      }
    }
  }
}

__device__ __forceinline__ void phase8c(const Params& p) {
  const int* EXPERT = (const int*)(p.ws + OFF_EXPERT);
  const float* GATE = (const float*)(p.ws + OFF_GATE);
  const float* US = (const float*)(p.ws + OFF_US);
  const float* VS = (const float*)(p.ws + OFF_VS);
  const float* HS = (const float*)(p.ws + OFF_HS);
  const int* PD = (const int*)(p.ws + OFF_PD);
  unsigned char* CQ8 = p.ws + OFF_CQ8;
  float* QSC = (float*)(p.ws + OFF_QSC);
  const int lane = TIDX & 63, wave = TIDX >> 6;
  for (int tok = blockIdx.x * 8 + wave; tok < MTOK; tok += gridDim.x * 8) {
    const int e0 = EXPERT[(size_t)tok * 128 + lane], e1 = EXPERT[(size_t)tok * 128 + 64 + lane];
    const float g0 = GATE[(size_t)tok * 128 + lane], g1 = GATE[(size_t)tok * 128 + 64 + lane];
    int s0 = 0, s1 = 0;
#pragma unroll
    for (int xx = 0; xx < 8; ++xx) {
      s0 += PD[((size_t)xx * MTOK + tok) * 128 + lane];
      s1 += PD[((size_t)xx * MTOK + tok) * 128 + 64 + lane];
    }
    const float hs = HS[tok];
    const float d0 = (float)s0 * US[e0] * hs, d1 = (float)s1 * US[e1] * hs;
    const float cf0 = g0 * 0.5f * d0 * (1.f + erff(d0 * 0.70710678118654752f)) * VS[e0];
    const float cf1 = g1 * 0.5f * d1 * (1.f + erff(d1 * 0.70710678118654752f)) * VS[e1];
    const float cmax = wave_max_dpp(fmaxf(fabsf(cf0), fabsf(cf1)));
    const float qinv = cmax > 0.f ? 32639.f / cmax : 0.f;
    const int c0 = (int)rintf(cf0 * qinv), c1 = (int)rintf(cf1 * qinv);
    const int h0 = (c0 + 128) >> 8, h1 = (c1 + 128) >> 8;
    unsigned char* cq = CQ8 + (size_t)tok * 256;
    cq[lane] = (unsigned char)(h0 & 0xff); cq[64 + lane] = (unsigned char)(h1 & 0xff);
    cq[128 + lane] = (unsigned char)((c0 - 256 * h0) & 0xff); cq[192 + lane] = (unsigned char)((c1 - 256 * h1) & 0xff);
    if (lane == 0) QSC[tok] = cmax * (1.f / 32639.f);
  }
}

#ifndef TR8_VARIANT
#define TR8_VARIANT 0
#endif
__device__ __forceinline__ void phase8b(const Params& p, unsigned char* smem) {
  typedef int i32x4 __attribute__((ext_vector_type(4)));
  typedef int i32x2 __attribute__((ext_vector_type(2)));
  typedef __attribute__((address_space(3))) i32x2 lds_i32x2;
  const int* EXPERT = (const int*)(p.ws + OFF_EXPERT);
  const unsigned char* VQS = p.ws + OFF_VQ;
  const unsigned char* CQ8 = p.ws + OFF_CQ8;
  const float* QSC = (const float*)(p.ws + OFF_QSC);
  unsigned* ctr = (unsigned*)(p.ws + 3072 + ((p.flags & 128) ? 4096 : 0));
  const unsigned xcc = (unsigned)__builtin_amdgcn_s_getreg((3 << 11) | 20) & 7u;
  const int lane = TIDX & 63, wave = TIDX >> 6, g8 = lane >> 3, l8 = lane & 7;
  const int fr = lane & 15, fg = lane >> 4;
  unsigned char* VST = smem + wave * 16384;
#if TR8_VARIANT == 0
  const int trow = (lane & 15) >> 1, thalf = lane & 1;
#else
  const int trow = lane & 7, thalf = (lane & 15) >> 3;
#endif
  __syncthreads();
  for (unsigned db = 0; db < 8; ++db) {
    const int x = (int)((xcc + db) & 7u);
    for (;;) {
      unsigned ci = 0;
      if (lane == 0) ci = __hip_atomic_fetch_add(ctr + x * 16, 1u, __ATOMIC_RELAXED, __HIP_MEMORY_SCOPE_AGENT);
      ci = (unsigned)__builtin_amdgcn_readfirstlane((int)ci);
      if (ci >= (unsigned)(MTOK / 16)) break;
#pragma unroll 1
      for (int tt = 0; tt < 16; ++tt) {
        const int tok = (int)ci * 16 + tt;
        const int e0 = EXPERT[(size_t)tok * 128 + lane], e1 = EXPERT[(size_t)tok * 128 + 64 + lane];
        u32x4 va[16];
#pragma unroll
        for (int i = 0; i < 16; ++i) {
          const int k = i * 8 + g8;
          const int ek = __shfl(i < 8 ? e0 : e1, k & 63);
          va[i] = *(const u32x4*)(VQS + ((size_t)(x * 16384 + ek)) * 128 + l8 * 16);
        }
        i32x4 af[2];
#pragma unroll
        for (int sx = 0; sx < 2; ++sx) {
          af[sx] = *(const i32x4*)(CQ8 + (size_t)tok * 256 + (fr & 1) * 128 + sx * 64 + fg * 16);
          if (fr >= 2) af[sx] = (i32x4){0, 0, 0, 0};
        }
        const float qsc = QSC[tok];
#pragma unroll
        for (int i = 0; i < 16; ++i) {
          const int k = i * 8 + g8;
          *(u32x4*)(VST + k * 128 + ((l8 ^ g8) << 4)) = va[i];
        }
        WAVE_LDS_SYNC();
        i32x4 acc[8];
#pragma unroll
        for (int c = 0; c < 8; ++c) acc[c] = (i32x4){0, 0, 0, 0};
#pragma unroll
        for (int sx = 0; sx < 2; ++sx) {
          const int r1 = sx * 64 + fg * 16 + trow, r2 = r1 + 8;
#pragma unroll
          for (int c = 0; c < 8; ++c) {
            const i32x2 lo = __builtin_amdgcn_ds_read_tr8_b64_v2i32((lds_i32x2*)(VST + r1 * 128 + ((c ^ (r1 & 7)) << 4) + 8 * thalf));
            const i32x2 hi = __builtin_amdgcn_ds_read_tr8_b64_v2i32((lds_i32x2*)(VST + r2 * 128 + ((c ^ (r2 & 7)) << 4) + 8 * thalf));
            const i32x4 bf = {lo[0], lo[1], hi[0], hi[1]};
            acc[c] = __builtin_amdgcn_mfma_i32_16x16x64_i8(af[sx], bf, acc[c], 0, 0, 0);
          }
        }
        WAVE_LDS_SYNC();
        if (lane < 16 && !(p.flags & 32)) {
          float* op = p.out + (size_t)tok * DM + x * 128 + fr;
#pragma unroll
          for (int c = 0; c < 8; ++c) op[16 * c] += ((float)acc[c][0] * 256.f + (float)acc[c][1]) * qsc;
        }
      }
    }
  }
}

__device__ __forceinline__ void grid_barrier(unsigned* ctr, unsigned target) {
  asm volatile("s_waitcnt vmcnt(0)" ::: "memory");
  __syncthreads();
  if (TIDX == 0) {
    __builtin_amdgcn_fence(__ATOMIC_RELEASE, "agent");
    asm volatile("s_waitcnt vmcnt(0)" ::: "memory");
    __hip_atomic_fetch_add(ctr, 1u, __ATOMIC_RELAXED, __HIP_MEMORY_SCOPE_AGENT);
    while (__hip_atomic_load(ctr, __ATOMIC_RELAXED, __HIP_MEMORY_SCOPE_AGENT) < target) __builtin_amdgcn_s_sleep(2);
    __builtin_amdgcn_fence(__ATOMIC_ACQUIRE, "agent");
    asm volatile("s_waitcnt vmcnt(0)" ::: "memory");
  }
  __syncthreads();
}

__global__ void __launch_bounds__(NTHREADS, 2) mk_fwd(Params p) {
  cg::grid_group grid = cg::this_grid();
  __shared__ __attribute__((aligned(16))) unsigned char smem[SMEM_BYTES];
  const int lo = p.ph_lo, hi = p.ph_hi;
#define RUN(k, call) if (lo <= (k) && (k) < hi) { call; if ((k) + 1 < hi) { if ((k) == lo) grid.sync(); else grid_barrier((unsigned*)p.ws, (unsigned)((k) - lo) * gridDim.x); } }
  RUN(0, phase0(p, smem))
  RUN(1, phase1(p, smem))
  RUN(2, phase2(p, smem))
  RUN(3, phase3(p, smem))
  RUN(4, phase4(p, smem))
  RUN(5, phase5(p, smem))
  RUN(6, rmsnorm_rows<true>(p.out, p.in[12], (u16*)(p.ws + OFF_H2), p.ws + OFF_H2Q, (float*)(p.ws + OFF_HS)))
  RUN(7, phase6(p, smem))
  RUN(8, phase7(p, smem))
  RUN(9, phase7b(p))
  RUN(10, phase8a(p))
  RUN(11, phase8c(p))
  RUN(12, phase8b(p, smem))
#undef RUN
}

extern "C" void kernel_launch(void* const* d_in, const int* in_sizes, int n_in,
                              void* d_out, int out_size, void* d_ws, size_t ws_size,
                              hipStream_t stream) {
  static int grid_blocks = 0;
  if (!grid_blocks) {
    int dev = 0, cus = 0, per_cu = 0;
    (void)hipGetDevice(&dev);
    (void)hipDeviceGetAttribute(&cus, hipDeviceAttributeMultiprocessorCount, dev);
    (void)hipOccupancyMaxActiveBlocksPerMultiprocessor(&per_cu, mk_fwd, NTHREADS, 0);
    if (per_cu < 1) per_cu = 1;
    if (per_cu > 1) per_cu = 1;
    grid_blocks = cus * per_cu;
    fprintf(stderr, "mk_fwd: cus=%d per_cu=%d grid=%d ws=%zu\n", cus, per_cu, grid_blocks, ws_size);
  }
  Params p{};
  for (int i = 0; i < 17 && i < n_in; ++i) p.in[i] = (const float*)d_in[i];
  p.out = (float*)d_out;
  p.ws = (unsigned char*)d_ws;
  p.ph_lo = 0; p.ph_hi = 13;
  (void)hipMemsetAsync(d_ws, 0, 8192, stream);
  void* args[] = {&p};
  hipError_t e = hipLaunchCooperativeKernel((void*)mk_fwd, dim3(grid_blocks), dim3(NTHREADS), args, 0, stream);
  if (e != hipSuccess) fprintf(stderr, "cooperative launch failed: %s (grid %d)\n", hipGetErrorString(e), grid_blocks);
#ifdef EXTRA_LO
  {
    Params p2 = p;
    p2.ph_lo = EXTRA_LO; p2.ph_hi = EXTRA_HI; p2.flags = EXTRA_FLAGS;
    void* args2[] = {&p2};
    (void)hipLaunchCooperativeKernel((void*)mk_fwd, dim3(grid_blocks), dim3(NTHREADS), args2, 0, stream);
  }
#endif
}
```

```cpp
#include <hip/hip_runtime.h>
#include <hip/hip_bf16.h>
#include <hip/hip_cooperative_groups.h>
#include <cstdio>
#include <cstdint>
namespace cg = cooperative_groups;

typedef unsigned short u16;
typedef unsigned int u32;
typedef unsigned char u8;
typedef short bf16x8 __attribute__((ext_vector_type(8)));
typedef float f32x4 __attribute__((ext_vector_type(4)));
typedef unsigned int u32x4 __attribute__((ext_vector_type(4)));
typedef unsigned int u32x2 __attribute__((ext_vector_type(2)));

constexpr int NTHREADS = 512;
constexpr int BATCH = 8, SEQ = 4096, DM = 1024, MTOK = BATCH * SEQ;
constexpr int LDP = 5120;
constexpr int NPADW = 5632;
constexpr int C_AQ = 0, C_IQ = 512, C_DQ = 1024, C_DK = 1536, C_DV = 2048, C_DZ = 2560, C_GA = 3072, C_GB = 4096;
constexpr int N_AK = 5120, N_AV = 5248, N_IK = 5376, N_SM = 5440;
constexpr size_t MiB = 1ull << 20;
constexpr size_t OFF_WTIN = 1 * MiB, OFF_WTA = 12 * MiB, OFF_WTB = 13 * MiB, OFF_WTO = 14 * MiB, OFF_WTQ = 16 * MiB,
                 OFF_SKB = 20 * MiB, OFF_SMALL = 21 * MiB, OFF_H = 23 * MiB, OFF_ATT = 23 * MiB, OFF_GC = 39 * MiB,
                 OFF_MERGED = 23 * MiB, OFF_PROJ = 87 * MiB, OFF_KVC = 407 * MiB, OFF_IKC = 423 * MiB, OFF_SEL = 427 * MiB, OFF_YATT = 443 * MiB,
                 OFF_YDN = 475 * MiB;
constexpr size_t OFF_H2 = OFF_PROJ, OFF_QP = OFF_PROJ + 64 * MiB, OFF_TOPS = OFF_PROJ + 192 * MiB,
                 OFF_TOPI = OFF_PROJ + 224 * MiB, OFF_EXPERT = OFF_PROJ + 232 * MiB, OFF_GATE = OFF_PROJ + 248 * MiB;
constexpr size_t OFF_UQ = OFF_PROJ + 264 * MiB, OFF_VQ = OFF_PROJ + 280 * MiB, OFF_US = OFF_PROJ + 296 * MiB, OFF_VS = OFF_PROJ + 297 * MiB;
constexpr size_t OFF_CQ8 = 56 * MiB, OFF_QSC = 64 * MiB;
constexpr size_t OFF_H2Q = 23 * MiB, OFF_HS = 55 * MiB, OFF_PD = OFF_PROJ + 64 * MiB;
constexpr size_t DO_U = 0, DO_W = 32 * MiB, DO_QN = 64 * MiB, DO_KNT = 96 * MiB;

constexpr int SMEM_BYTES = 162816;
constexpr float EPS = 1e-6f;

struct Params {
  const float* in[17];
  float* out;
  unsigned char* ws;
  int ph_lo, ph_hi;
  int flags, pad;
};

typedef __bf16 bf16x2_t __attribute__((ext_vector_type(2)));
typedef float f32x2_t __attribute__((ext_vector_type(2)));
__device__ __forceinline__ u32 pack2(float a, float b) {
  f32x2_t f = {a, b};
  return __builtin_bit_cast(u32, __builtin_convertvector(f, bf16x2_t));
}
__device__ __forceinline__ u16 f2bf(float f) { return (u16)(pack2(f, f) & 0xffffu); }
__device__ __forceinline__ float bf2f(u16 h) { return __uint_as_float(((u32)h) << 16); }
__device__ __forceinline__ float bflo(u32 w) { return __uint_as_float(w << 16); }
__device__ __forceinline__ float bfhi(u32 w) { return __uint_as_float(w & 0xffff0000u); }
__device__ __forceinline__ float wave_sum(float v) {
#pragma unroll
  for (int o = 32; o > 0; o >>= 1) v += __shfl_xor(v, o);
  return v;
}
__device__ __forceinline__ float wave_max(float v) {
#pragma unroll
  for (int o = 32; o > 0; o >>= 1) v = fmaxf(v, __shfl_xor(v, o));
  return v;
}
__device__ __forceinline__ float dot2bf(u32 a, u32 b, float acc) {
  return __builtin_amdgcn_fdot2_f32_bf16(__builtin_bit_cast(bf16x2_t, a), __builtin_bit_cast(bf16x2_t, b), acc, false);
}
#define DPPF(v, ctrl) __int_as_float(__builtin_amdgcn_update_dpp(0, __float_as_int(v), ctrl, 0xf, 0xf, true))
__device__ __forceinline__ float wave_sum_dpp(float v) {
  v += DPPF(v, 0xb1);
  v += DPPF(v, 0x4e);
  v += DPPF(v, 0x124);
  v += DPPF(v, 0x128);
  float r0 = __int_as_float(__builtin_amdgcn_readlane(__float_as_int(v), 0));
  float r1 = __int_as_float(__builtin_amdgcn_readlane(__float_as_int(v), 16));
  float r2 = __int_as_float(__builtin_amdgcn_readlane(__float_as_int(v), 32));
  float r3 = __int_as_float(__builtin_amdgcn_readlane(__float_as_int(v), 48));
  return (r0 + r1) + (r2 + r3);
}
__device__ __forceinline__ int opaque_tid() { int t = threadIdx.x; asm volatile("" : "+v"(t)); return t; }
#define TIDX opaque_tid()
#define DPPI(v, ctrl) __builtin_amdgcn_update_dpp(0, (v), ctrl, 0xf, 0xf, true)
__device__ __forceinline__ int wave_sum_i_dpp(int v) {
  v += DPPI(v, 0xb1);
  v += DPPI(v, 0x4e);
  v += DPPI(v, 0x124);
  v += DPPI(v, 0x128);
  return (__builtin_amdgcn_readlane(v, 0) + __builtin_amdgcn_readlane(v, 16)) +
         (__builtin_amdgcn_readlane(v, 32) + __builtin_amdgcn_readlane(v, 48));
}
__device__ __forceinline__ float wave_max_dpp(float v) {
  v = fmaxf(v, DPPF(v, 0xb1));
  v = fmaxf(v, DPPF(v, 0x4e));
  v = fmaxf(v, DPPF(v, 0x124));
  v = fmaxf(v, DPPF(v, 0x128));
  float r0 = __int_as_float(__builtin_amdgcn_readlane(__float_as_int(v), 0));
  float r1 = __int_as_float(__builtin_amdgcn_readlane(__float_as_int(v), 16));
  float r2 = __int_as_float(__builtin_amdgcn_readlane(__float_as_int(v), 32));
  float r3 = __int_as_float(__builtin_amdgcn_readlane(__float_as_int(v), 48));
  return fmaxf(fmaxf(r0, r1), fmaxf(r2, r3));
}
#define WAVE_LDS_SYNC() asm volatile("s_waitcnt lgkmcnt(0)" ::: "memory")
__device__ __forceinline__ float sigmoidf_(float x) { return __builtin_amdgcn_rcpf(1.f + __expf(-x)); }
__device__ __forceinline__ int perm32(int k) {
  int blk = k & ~31, r = k & 31;
  int p = (r < 16) ? (8 * (r >> 2) + (r & 3)) : (8 * ((r - 16) >> 2) + 4 + (r & 3));
  return blk + p;
}

__device__ __forceinline__ int g8_logical_col(int t) { return ((t & 127) >> 5) * 64 + (t >> 7) * 32 + (t & 31); }
__device__ __forceinline__ int win_map(int n) {
  if (n < 512) return n;
  if (n < 1024) return 768 + (n - 512);
  if (n < 3072) return 1352 + (n - 1024);
  if (n < 5120) return 3408 + (n - 3072);
  if (n < 5248) return 512 + (n - 5120);
  if (n < 5376) return 640 + (n - 5248);
  if (n < 5440) return 1280 + (n - 5376);
  if (n < 5448) return 1344 + (n - 5440);
  if (n < 5452) return 3400 + (n - 5448);
  if (n < 5456) return 3404 + (n - 5452);
  return -1;
}
__device__ __forceinline__ void transpose_tile(const float* __restrict__ src, int Nsrc, u16* __restrict__ dst, int K, int k0, int n0,
                               bool mapped, bool perm8, float* tile  ) {
  const int tid = TIDX;
  {
    const int tx = tid & 63, ty = tid >> 6;
    int n = n0 + tx;
    if (perm8) n = (n & ~255) + g8_logical_col(n & 255);
    int sc = mapped ? win_map(n) : n;
#pragma unroll
    for (int i = 0; i < 8; ++i) {
      int k = ty + 8 * i;
      float v = (sc >= 0) ? src[(size_t)(k0 + k) * Nsrc + sc] : 0.f;
      tile[k * 65 + tx] = v;
    }
  }
  __syncthreads();
  {
    const int n = tid >> 3, kc = (tid & 7) * 8;
    u32 w[4];
#pragma unroll
    for (int j = 0; j < 4; ++j) w[j] = pack2(tile[(kc + 2 * j) * 65 + n], tile[(kc + 2 * j + 1) * 65 + n]);
    *(uint4*)(dst + (size_t)(n0 + n) * K + k0 + kc) = make_uint4(w[0], w[1], w[2], w[3]);
  }
  __syncthreads();
}

template <bool Q8>
__device__ __forceinline__ void rmsnorm_rows(const float* __restrict__ x, const float* __restrict__ gain, u16* __restrict__ out,
                                             unsigned char* __restrict__ q8, float* __restrict__ qs) {
  const int lane = TIDX & 63, wave = TIDX >> 6;
  float4 g[4];
#pragma unroll
  for (int i = 0; i < 4; ++i) g[i] = ((const float4*)gain)[lane + 64 * i];
  for (int row = blockIdx.x * 8 + wave; row < MTOK; row += gridDim.x * 8) {
    const float4* xr = (const float4*)(x + (size_t)row * DM);
    float4 v[4];
    float ss = 0.f;
#pragma unroll
    for (int i = 0; i < 4; ++i) {
      v[i] = xr[lane + 64 * i];
      ss += v[i].x * v[i].x + v[i].y * v[i].y + v[i].z * v[i].z + v[i].w * v[i].w;
    }
    ss = wave_sum_dpp(ss);
    float r = rsqrtf(ss * (1.f / DM) + EPS);
    float amax = 0.f;
#pragma unroll
    for (int i = 0; i < 4; ++i) {
      v[i].x *= r * g[i].x; v[i].y *= r * g[i].y; v[i].z *= r * g[i].z; v[i].w *= r * g[i].w;
      uint2 o;
      o.x = pack2(v[i].x, v[i].y);
      o.y = pack2(v[i].z, v[i].w);
      *(uint2*)(out + (size_t)row * DM + 4 * (lane + 64 * i)) = o;
      if (Q8) amax = fmaxf(amax, fmaxf(fmaxf(fabsf(v[i].x), fabsf(v[i].y)), fmaxf(fabsf(v[i].z), fabsf(v[i].w))));
    }
    if (Q8) {
      amax = wave_max_dpp(amax);
      const float inv = amax > 0.f ? 127.f / amax : 0.f;
#pragma unroll
      for (int i = 0; i < 4; ++i) {
        const int q0 = (int)rintf(v[i].x * inv), q1 = (int)rintf(v[i].y * inv), q2 = (int)rintf(v[i].z * inv), q3 = (int)rintf(v[i].w * inv);
        *(u32*)(q8 + (size_t)row * DM + 4 * (lane + 64 * i)) =
            (u32)(q0 & 0xff) | ((u32)(q1 & 0xff) << 8) | ((u32)(q2 & 0xff) << 16) | ((u32)(q3 & 0xff) << 24);
      }
      if (lane == 0) qs[row] = amax * (1.f / 127.f);
    }
  }
}

__device__ __forceinline__ void phase0(const Params& p, unsigned char* smem) {
  float* tile = (float*)smem;
  unsigned char* ws = p.ws;
  const int n_in = 16 * 88, n_a = 8 * 16, n_b = 8 * 16, n_o = 16 * 16, n_q = 16 * 32;
  const int total = n_in + n_a + n_b + n_o + n_q;
  for (int t = blockIdx.x; t < total; t += gridDim.x) {
    int i = t;
    if (i < n_in) { transpose_tile(p.in[2], 5456, (u16*)(ws + OFF_WTIN), 1024, (i / 88) * 64, (i % 88) * 64, true, true, tile); continue; }
    i -= n_in;
    if (i < n_a) { transpose_tile(p.in[9], 1024, (u16*)(ws + OFF_WTA), 512, (i / 16) * 64, (i % 16) * 64, false, true, tile); continue; }
    i -= n_a;
    if (i < n_b) { transpose_tile(p.in[10], 1024, (u16*)(ws + OFF_WTB), 512, (i / 16) * 64, (i % 16) * 64, false, true, tile); continue; }
    i -= n_b;
    if (i < n_o) { transpose_tile(p.in[11], 1024, (u16*)(ws + OFF_WTO), 1024, (i / 16) * 64, (i % 16) * 64, false, true, tile); continue; }
    i -= n_o;
    transpose_tile(p.in[13], 2048, (u16*)(ws + OFF_WTQ), 1024, (i / 32) * 64, (i % 32) * 64, false, true, tile);
  }
  {
    const float* sk = p.in[14];
    u16* skb = (u16*)(ws + OFF_SKB);
    for (int i = blockIdx.x * NTHREADS + TIDX; i < 16 * 128 * 128; i += gridDim.x * NTHREADS) skb[i] = f2bf(sk[i]);
  }
  rmsnorm_rows<false>(p.in[0], p.in[1], (u16*)(ws + OFF_H), nullptr, nullptr);
}

constexpr int G_BM = 256, G_BN = 128, G_BK = 64;
constexpr int G_ABYTES = G_BM * 128;

template <int MI>
__device__ __forceinline__ void gemm_mainloop_t(const u16* __restrict__ A, int lda, const u16* __restrict__ Bt, int ldb, int K,
                                                int m0, int n0, unsigned char* smem, f32x4 (&acc)[MI][4]) {
  constexpr int BN = (MI == 4) ? 128 : 256;
  constexpr int NRB = BN / 64;
  constexpr int STAGE = G_ABYTES + BN * 128;
  const int tid = TIDX, lane = tid & 63, wave = tid >> 6;
  const int wm = (MI == 4) ? (wave >> 1) : (wave >> 2), wn = (MI == 4) ? (wave & 1) : (wave & 3);
#pragma unroll
  for (int i = 0; i < MI; ++i)
#pragma unroll
    for (int j = 0; j < 4; ++j) acc[i][j] = (f32x4){0.f, 0.f, 0.f, 0.f};
  const int kc = tid & 7;
  const int arow = tid >> 3;
  u32x4 ra[4], rb[NRB];
  const u16* ap = A + (size_t)(m0 + arow) * lda + kc * 8;
  const u16* bp = Bt + (size_t)(n0 + arow) * ldb + kc * 8;
  const int nk = K / G_BK;
  const int fr = lane & 15, fg = lane >> 4;
#define G_LOAD(kt_)                                                                       \
  {                                                                                       \
    const u16* ap2_ = ap + (size_t)(kt_) * G_BK;                                          \
    const u16* bp2_ = bp + (size_t)(kt_) * G_BK;                                          \
    _Pragma("unroll") for (int i = 0; i < 4; ++i) ra[i] = *(const u32x4*)(ap2_ + (size_t)(64 * i) * lda); \
    _Pragma("unroll") for (int i = 0; i < NRB; ++i) rb[i] = *(const u32x4*)(bp2_ + (size_t)(64 * i) * ldb); \
  }
#define G_STORE(st_)                                                                      \
  {                                                                                       \
    unsigned char* sa_ = smem + (st_) * STAGE;                                            \
    unsigned char* sb_ = sa_ + G_ABYTES;                                                  \
    _Pragma("unroll") for (int i = 0; i < 4; ++i) { int r = arow + 64 * i; *(u32x4*)(sa_ + r * 128 + ((kc ^ (r & 7)) << 4)) = ra[i]; } \
    _Pragma("unroll") for (int i = 0; i < NRB; ++i) { int r = arow + 64 * i; *(u32x4*)(sb_ + r * 128 + ((kc ^ (r & 7)) << 4)) = rb[i]; } \
  }
  G_LOAD(0)
  __syncthreads();
  G_STORE(0)
  if (nk > 1) G_LOAD(1)
  __syncthreads();
  for (int kt = 0; kt < nk; ++kt) {
    if (kt + 1 < nk) G_STORE((kt + 1) & 1)
    if (kt + 2 < nk) G_LOAD(kt + 2)
    __builtin_amdgcn_sched_barrier(0);
    const unsigned char* sa = smem + (kt & 1) * STAGE;
    const unsigned char* sb = sa + G_ABYTES;
#pragma unroll
    for (int kk = 0; kk < 2; ++kk) {
      bf16x8 bfr[4];
#pragma unroll
      for (int j = 0; j < 4; ++j) {
        int r = wn * 64 + j * 16 + fr;
        bfr[j] = *(const bf16x8*)(sb + r * 128 + (((kk * 4 + fg) ^ (r & 7)) << 4));
      }
#pragma unroll
      for (int ih = 0; ih < MI; ih += 4) {
        bf16x8 af[4];
#pragma unroll
        for (int i = 0; i < 4; ++i) {
          int r = wm * (MI * 16) + (ih + i) * 16 + fr;
          af[i] = *(const bf16x8*)(sa + r * 128 + (((kk * 4 + fg) ^ (r & 7)) << 4));
        }
#pragma unroll
        for (int i = 0; i < 4; ++i)
#pragma unroll
          for (int j = 0; j < 4; ++j) acc[ih + i][j] = __builtin_amdgcn_mfma_f32_16x16x32_bf16(af[i], bfr[j], acc[ih + i][j], 0, 0, 0);
        if (MI == 8 && ih == 0) __builtin_amdgcn_sched_barrier(0);
      }
    }
    __syncthreads();
  }
#undef G_LOAD
#undef G_STORE
}
__device__ __forceinline__ void gemm_mainloop(const u16* __restrict__ A, int lda, const u16* __restrict__ Bt, int ldb, int K,
                                              int m0, int n0, unsigned char* smem, f32x4 (&acc)[4][4]) {
  gemm_mainloop_t<4>(A, lda, Bt, ldb, K, m0, n0, smem, acc);
}

__device__ __forceinline__ int g8_lds_byte(int r, int c) {
  int st = (r >> 4) * 2 + (c >> 5), rr = r & 15, cc = c & 31, ob = rr * 64 + cc * 2;
  return st * 1024 + (ob ^ (((ob >> 9) & 1) << 5));
}
__device__ __forceinline__ void g8_stage_rc(int b, int& R, int& C) {
  int st = b / 1024, sb = b % 1024, swz = sb ^ (((sb >> 9) & 1) << 5);
  R = (st >> 1) * 16 + swz / 64; C = (st & 1) * 32 + (swz % 64) / 2;
}
typedef __attribute__((address_space(3))) unsigned int lds_u32;
__device__ __forceinline__ void gemm8_tile(const u16* __restrict__ A, const u16* __restrict__ Bt, int K, int brow, int bcol,
                                           unsigned char* smem, f32x4 (&acc)[2][2][4][2]) {
  constexpr int HTB = 16384;
  const int tid = TIDX;
  const int wid = tid >> 6, lane = tid & 63, wr = wid >> 2, wc = wid & 3, fr = lane & 15, fq = lane >> 4;
#define SA(b, h) (smem + ((b) * 2 + (h)) * HTB)
#define SB(b, h) (smem + (4 + (b) * 2 + (h)) * HTB)
#define STAGE(P, BASE, br, kt) do { const long _g = (long)(br) * K + (long)(kt) * 64; \
    _Pragma("unroll") for (int _i = 0; _i < 2; ++_i) { int _b = tid * 16 + _i * 8192; int _r, _c; g8_stage_rc(_b, _r, _c); \
      __builtin_amdgcn_global_load_lds((const unsigned int*)(BASE + _g + (long)_r * K + _c), \
        (lds_u32*)((P) + _b), 16, 0, 0); } } while (0)
#define LDA(dst, b, h) _Pragma("unroll") for (int m = 0; m < 4; ++m) _Pragma("unroll") for (int k = 0; k < 2; ++k) \
    dst[m][k] = *(const bf16x8*)(SA(b, h) + g8_lds_byte(wr * 64 + m * 16 + fr, k * 32 + fq * 8))
#define LDB(dst, b, h) _Pragma("unroll") for (int n = 0; n < 2; ++n) _Pragma("unroll") for (int k = 0; k < 2; ++k) \
    dst[n][k] = *(const bf16x8*)(SB(b, h) + g8_lds_byte(wc * 32 + n * 16 + fr, k * 32 + fq * 8))
#define MMA(ai, bj, At_, Bt_) do { __builtin_amdgcn_s_setprio(1); \
    _Pragma("unroll") for (int m = 0; m < 4; ++m) _Pragma("unroll") for (int n = 0; n < 2; ++n) _Pragma("unroll") for (int k = 0; k < 2; ++k) \
      acc[ai][bj][m][n] = __builtin_amdgcn_mfma_f32_16x16x32_bf16(At_[m][k], Bt_[n][k], acc[ai][bj][m][n], 0, 0, 0); \
    __builtin_amdgcn_s_setprio(0); } while (0)
#define WAIT_V(n) asm volatile("s_waitcnt vmcnt(" #n ")" ::: "memory")
#define WAIT_L(n) asm volatile("s_waitcnt lgkmcnt(" #n ")" ::: "memory")
#define BAR __builtin_amdgcn_s_barrier()
#define SCHED __builtin_amdgcn_sched_barrier(0)
#pragma unroll
  for (int a = 0; a < 2; ++a)
#pragma unroll
    for (int b2 = 0; b2 < 2; ++b2)
#pragma unroll
      for (int m = 0; m < 4; ++m)
#pragma unroll
        for (int n = 0; n < 2; ++n) acc[a][b2][m][n] = (f32x4){0.f, 0.f, 0.f, 0.f};
  bf16x8 At[4][2], B0[2][2], B1[2][2];
  const int nt = K / 64;
  constexpr int HALF = 128;
  __syncthreads();
  STAGE(SB(0, 0), Bt, bcol, 0); STAGE(SA(0, 0), A, brow, 0);
  STAGE(SB(0, 1), Bt, bcol + HALF, 0); STAGE(SA(0, 1), A, brow + HALF, 0);
  if (wr == 1) BAR;
  WAIT_V(4); BAR;
  STAGE(SB(1, 0), Bt, bcol, 1); STAGE(SA(1, 0), A, brow, 1); STAGE(SB(1, 1), Bt, bcol + HALF, 1);
  WAIT_V(6); BAR;
  for (int t = 0; t < nt - 2; t += 2) {
    LDB(B0, 0, 0); SCHED; LDA(At, 0, 0); STAGE(SA(1, 1), A, brow + HALF, t + 1);
    WAIT_L(8); BAR; WAIT_L(0); MMA(0, 0, At, B0); BAR; SCHED;
    LDB(B1, 0, 1); STAGE(SB(0, 0), Bt, bcol, t + 2);
    BAR; WAIT_L(0); MMA(0, 1, At, B1); BAR;
    LDA(At, 0, 1); STAGE(SA(0, 0), A, brow, t + 2);
    BAR; WAIT_L(0); MMA(1, 0, At, B0); BAR; SCHED;
    STAGE(SB(0, 1), Bt, bcol + HALF, t + 2);
    WAIT_V(6); BAR; MMA(1, 1, At, B1); BAR;
    LDB(B0, 1, 0); SCHED; LDA(At, 1, 0); STAGE(SA(0, 1), A, brow + HALF, t + 2);
    WAIT_L(8); BAR; WAIT_L(0); MMA(0, 0, At, B0); BAR; SCHED;
    LDB(B1, 1, 1); STAGE(SB(1, 0), Bt, bcol, t + 3);
    BAR; WAIT_L(0); MMA(0, 1, At, B1); BAR;
    LDA(At, 1, 1); STAGE(SA(1, 0), A, brow, t + 3);
    BAR; WAIT_L(0); MMA(1, 0, At, B0); BAR; SCHED;
    STAGE(SB(1, 1), Bt, bcol + HALF, t + 3);
    WAIT_V(6); BAR; MMA(1, 1, At, B1); BAR;
  }
  { LDB(B0, 0, 0); LDA(At, 0, 0); STAGE(SA(1, 1), A, brow + HALF, nt - 1);
    BAR; WAIT_L(0); MMA(0, 0, At, B0); BAR;
    LDB(B1, 0, 1); BAR; WAIT_L(0); MMA(0, 1, At, B1); BAR;
    LDA(At, 0, 1); WAIT_V(4); BAR; WAIT_L(0); MMA(1, 0, At, B0); MMA(1, 1, At, B1); BAR; }
  { LDB(B0, 1, 0); LDA(At, 1, 0); WAIT_V(2); BAR; WAIT_L(0); MMA(0, 0, At, B0); BAR;
    LDB(B1, 1, 1); WAIT_V(0); BAR; WAIT_L(0); MMA(0, 1, At, B1); BAR;
    LDA(At, 1, 1); BAR; WAIT_L(0); MMA(1, 0, At, B0); MMA(1, 1, At, B1); BAR; }
  if (wr == 0) BAR;
#undef SA
#undef SB
#undef STAGE
#undef LDA
#undef LDB
#undef MMA
#undef WAIT_V
#undef WAIT_L
#undef BAR
#undef SCHED
}

template <int LD, bool NORM>
__device__ __forceinline__ void ep_store(u16* __restrict__ dst, u32 ob, const f32x4 (&acc)[2][2][4][2], const float* __restrict__ gain,
                                         float extra, unsigned char* smem, int wave, int lane_in) {
  int lane = lane_in;
  asm volatile("" : "+v"(lane));
  const int fr = lane & 15, fq = lane >> 4;
  unsigned char* reg = smem + wave * 16384;
  float gj[4] = {1.f, 1.f, 1.f, 1.f};
  if (NORM) {
#pragma unroll
    for (int j = 0; j < 4; ++j) gj[j] = gain[j * 16 + fr] * extra;
  }
  const int lrot = (fr >> 3) + 2 * fq;
  unsigned char* wbase = reg + (4 * fq) * 128 + (fr & 7) * 2;
#pragma unroll
  for (int ai = 0; ai < 2; ++ai)
#pragma unroll
    for (int m = 0; m < 4; ++m) {
#pragma unroll
      for (int r = 0; r < 4; ++r) {
        float rs = 1.f;
        if (NORM) {
          float sq = 0.f;
#pragma unroll
          for (int bj = 0; bj < 2; ++bj)
#pragma unroll
            for (int n = 0; n < 2; ++n) sq += acc[ai][bj][m][n][r] * acc[ai][bj][m][n][r];
          sq += DPPF(sq, 0xb1); sq += DPPF(sq, 0x4e); sq += DPPF(sq, 0x141); sq += DPPF(sq, 0x140);
          rs = rsqrtf(sq * (1.f / 64.f) + EPS);
        }
#pragma unroll
        for (int bj = 0; bj < 2; ++bj)
#pragma unroll
          for (int n = 0; n < 2; ++n) {
            const float v = acc[ai][bj][m][n][r];
            const int ch = ((bj * 2 + n) * 2 + lrot) & 7;
            *(u16*)(wbase + (ai * 64 + m * 16 + r) * 128 + (ch << 4)) = f2bf(NORM ? v * rs * gj[bj * 2 + n] : v);
          }
      }
      __builtin_amdgcn_sched_barrier(0);
    }
  WAVE_LDS_SYNC();
  const int c16 = lane & 7, r8 = lane >> 3;
#pragma unroll
  for (int it = 0; it < 16; ++it) {
    const int rw = it * 8 + r8;
    const u32x4 v = *(const u32x4*)(reg + rw * 128 + (((c16 + 2 * ((rw >> 2) & 3)) & 7) << 4));
    const int grow = (it >> 3) * 128 + (it & 7) * 8 + r8;
    *(u32x4*)(dst + ob + (u32)(grow * LD + c16 * 8)) = v;
    if ((it & 3) == 3) __builtin_amdgcn_sched_barrier(0);
  }
}

__device__ __forceinline__ void phase1(const Params& p, unsigned char* smem) {
  const u16* H = (const u16*)(p.ws + OFF_H);
  const u16* WT = (const u16*)(p.ws + OFF_WTIN);
  u16* PROJ = (u16*)(p.ws + OFF_PROJ);
  u16* KVC = (u16*)(p.ws + OFF_KVC);
  u16* IKC = (u16*)(p.ws + OFF_IKC);
  float* SMALL = (float*)(p.ws + OFF_SMALL);
  const int lane = TIDX & 63, wave = TIDX >> 6;
  const int wr = wave >> 2, wc = wave & 3, fr = lane & 15, fq = lane >> 4;
  const int ntn = NPADW / 256;
  const int ntiles = (MTOK / 256) * ntn;
  for (int t = blockIdx.x; t < ntiles; t += gridDim.x) {
    const int m0 = (t / ntn) * 256, n0 = (t % ntn) * 256;
    f32x4 acc[2][2][4][2];
    gemm8_tile(H, WT, DM, m0, n0, smem, acc);
    const int cbase = n0 + wc * 64;
    const u32 rbase = (u32)(m0 + wr * 64);
    if (cbase < C_IQ) {
      ep_store<LDP, true>(PROJ, rbase * LDP + (u32)cbase, acc, p.in[3], 0.125f, smem, wave, lane);
    } else if (cbase < LDP) {
      ep_store<LDP, false>(PROJ, rbase * LDP + (u32)cbase, acc, nullptr, 1.f, smem, wave, lane);
    } else if (cbase < N_AV) {
      ep_store<256, true>(KVC, rbase * 256 + (u32)(cbase - N_AK), acc, p.in[4], 1.f, smem, wave, lane);
    } else if (cbase < N_IK) {
      ep_store<256, false>(KVC, rbase * 256 + (u32)(cbase - N_AV + 128), acc, nullptr, 1.f, smem, wave, lane);
    } else if (cbase < N_SM) {
      ep_store<64, false>(IKC, rbase * 64, acc, nullptr, 1.f, smem, wave, lane);
    } else if (cbase == N_SM) {
      const u32 sb0 = (rbase + 4 * fq) * 16 + (u32)fr;
#pragma unroll
      for (int ai = 0; ai < 2; ++ai)
#pragma unroll
        for (int m = 0; m < 4; ++m)
#pragma unroll
          for (int r = 0; r < 4; ++r) SMALL[sb0 + (u32)((ai * 128 + m * 16 + r) * 16)] = acc[ai][0][m][0][r];
    }
  }
}

constexpr int IDX_RS = 8208;

__device__ __forceinline__ u32 f2key(float x) {
  _Float16 h = (_Float16)x;
  u32 b = (u32) * (u16*)&h;
  return (b & 0x8000u) ? ((~b) & 0xffffu) : (b | 0x8000u);
}
__device__ __forceinline__ int count_ge_wave(const u32 (&kreg)[32], u32 mid) {
  const u32 m1 = (mid - 1u) * 0x00010001u;
  const u32 one = 0x00010001u;
  u32 acc0 = 0u, acc1 = 0u;
#pragma unroll
  for (int i = 0; i < 32; i += 2) {
    u32 t0, t1;
    asm("v_pk_sub_u16 %0, %1, %2 clamp" : "=v"(t0) : "v"(kreg[i]), "s"(m1));
    asm("v_pk_sub_u16 %0, %1, %2 clamp" : "=v"(t1) : "v"(kreg[i + 1]), "s"(m1));
    asm("v_pk_min_u16 %0, %1, %2" : "=v"(t0) : "v"(t0), "s"(one));
    asm("v_pk_min_u16 %0, %1, %2" : "=v"(t1) : "v"(t1), "s"(one));
    asm("v_pk_add_u16 %0, %1, %2" : "=v"(acc0) : "v"(acc0), "v"(t0));
    asm("v_pk_add_u16 %0, %1, %2" : "=v"(acc1) : "v"(acc1), "v"(t1));
  }
  int c = (int)((acc0 & 0xffffu) + (acc0 >> 16) + (acc1 & 0xffffu) + (acc1 >> 16));
  return wave_sum_i_dpp(c);
}

__device__ __forceinline__ void idx_item(const Params& p, unsigned char* smem, int b, int tq) {
  const u16* PROJ = (const u16*)(p.ws + OFF_PROJ);
  const float* SMALL = (const float*)(p.ws + OFF_SMALL);
  u16* SEL = (u16*)(p.ws + OFF_SEL);
  const int tid = TIDX, lane = tid & 63, wave = tid >> 6;
  const int t0 = tq * 16;
  const size_t tokb = (size_t)b * SEQ;
  if (tq < 16) {
    for (int rr = 0; rr < 2; ++rr) {
      int row = 2 * wave + rr, t = t0 + row;
      u16* out = SEL + (tokb + t) * 256;
      for (int i = lane; i < 256; i += 64) out[i] = (i <= t) ? (u16)i : (u16)0xFFFF;
    }
    return;
  }
  const int q = lane & 15, g = lane >> 4;
  __syncthreads();
  {
    const u16* iqrow = PROJ + (tokb + t0 + q) * LDP + C_IQ;
    bf16x8 bq[8][2];
    float wq[8];
#pragma unroll
    for (int h = 0; h < 8; ++h) {
      bq[h][0] = *(const bf16x8*)(iqrow + h * 64 + g * 8);
      bq[h][1] = *(const bf16x8*)(iqrow + h * 64 + 32 + g * 8);
      wq[h] = SMALL[(tokb + t0 + q) * 16 + h];
    }
    const int nkb = tq + 1;
    const int niter = (nkb > wave) ? ((nkb - wave + 7) >> 3) : 0;
    const u16* ikbase = (const u16*)(p.ws + OFF_IKC) + (tokb + q) * 64 + g * 8;
    bf16x8 ca[3][2];
#pragma unroll
    for (int j = 0; j < 3; ++j)
      if (j < niter) {
        const u16* ikrow = ikbase + (size_t)((wave + 8 * j) * 16) * 64;
        ca[j][0] = *(const bf16x8*)(ikrow); ca[j][1] = *(const bf16x8*)(ikrow + 32);
      }
    for (int i0 = 0; i0 < ((p.flags & 8) ? 0 : niter); i0 += 3) {
#pragma unroll
      for (int j = 0; j < 3; ++j) {
        if (i0 + j < niter) {
          const int s0 = (wave + 8 * (i0 + j)) * 16;
          f32x4 tot = {0.f, 0.f, 0.f, 0.f};
#pragma unroll
          for (int h = 0; h < 8; ++h) {
            f32x4 acc = {0.f, 0.f, 0.f, 0.f};
            acc = __builtin_amdgcn_mfma_f32_16x16x32_bf16(ca[j][0], bq[h][0], acc, 0, 0, 0);
            acc = __builtin_amdgcn_mfma_f32_16x16x32_bf16(ca[j][1], bq[h][1], acc, 0, 0, 0);
#pragma unroll
            for (int r = 0; r < 4; ++r) tot[r] += wq[h] * fmaxf(acc[r], 0.f);
          }
          if (i0 + 3 + j < niter) {
            const u16* ikrow = ikbase + (size_t)((wave + 8 * (i0 + 3 + j)) * 16) * 64;
            ca[j][0] = *(const bf16x8*)(ikrow); ca[j][1] = *(const bf16x8*)(ikrow + 32);
          }
          u32 k[4];
#pragma unroll
          for (int r = 0; r < 4; ++r) {
            int sidx = s0 + 4 * g + r;
            k[r] = (sidx <= t0 + q) ? f2key(tot[r]) : 0u;
          }
          u32x2 w2 = {k[0] | (k[1] << 16), k[2] | (k[3] << 16)};
          *(u32x2*)(smem + q * IDX_RS + (s0 + 4 * g) * 2) = w2;
        }
        __builtin_amdgcn_sched_barrier(0);
      }
    }
    const int nk = t0 + 16, nk64 = (nk + 63) & ~63;
    for (int i = tid; i < 16 * (nk64 - nk); i += NTHREADS) {
      int row = i / (nk64 - nk), c = nk + i % (nk64 - nk);
      *(u16*)(smem + row * IDX_RS + c * 2) = 0;
    }
  }
  __syncthreads();
  const int nk64 = (t0 + 16 + 63) & ~63;
  for (int rr = 0; rr < ((p.flags & 16) ? 0 : 2); ++rr) {
    const int row = 2 * wave + rr, t = t0 + row;
    u16* out = SEL + (tokb + t) * 256;
    u32 kreg[32];
    if (lane * 64 < nk64) {
      const uint4* src = (const uint4*)(smem + row * IDX_RS + lane * 128);
#pragma unroll
      for (int i = 0; i < 8; ++i) {
        uint4 v = src[i];
        kreg[4 * i] = v.x; kreg[4 * i + 1] = v.y; kreg[4 * i + 2] = v.z; kreg[4 * i + 3] = v.w;
      }
    } else {
#pragma unroll
      for (int i = 0; i < 32; ++i) kreg[i] = 0u;
    }
    WAVE_LDS_SYNC();
    u32 lo = 1u, hi = 65535u;
    while (lo < hi) {
      u32 mid = (lo + hi + 1u) >> 1;
      int c = count_ge_wave(kreg, mid);
      if (c >= 256) lo = mid; else hi = mid - 1u;
    }
    const u32 tau = lo;
    int gt = 0, eq = 0;
#pragma unroll
    for (int i = 0; i < 32; ++i) {
      u32 a = kreg[i] & 0xffffu, c2 = kreg[i] >> 16;
      gt += (a > tau) ? 1 : 0; gt += (c2 > tau) ? 1 : 0;
      eq += (a == tau) ? 1 : 0; eq += (c2 == tau) ? 1 : 0;
    }
    int packed = gt | (eq << 16);
    int incl = packed;
#pragma unroll
    for (int o = 1; o < 64; o <<= 1) {
      int v = __shfl_up(incl, o);
      if (lane >= o) incl += v;
    }
    const int excl = incl - packed;
    const int total = __shfl(incl, 63);
    const int need = 256 - (total & 0xffff);
    const int pg = excl & 0xffff, pe = excl >> 16;
    int pos = pg + min(pe, need);
    int eqseen = pe;
    u16* lrow = (u16*)(smem + row * IDX_RS);
#pragma unroll
    for (int i = 0; i < 32; ++i) {
#pragma unroll
      for (int hh = 0; hh < 2; ++hh) {
        u32 kv = hh ? (kreg[i] >> 16) : (kreg[i] & 0xffffu);
        int idx = lane * 64 + 2 * i + hh;
        bool take = false;
        if (kv > tau) take = true;
        else if (kv == tau) { take = (eqseen < need); ++eqseen; }
        if (take) { lrow[pos] = (u16)idx; ++pos; }
      }
    }
    WAVE_LDS_SYNC();
    *(u32x2*)(out + lane * 4) = *(const u32x2*)(lrow + lane * 4);
    WAVE_LDS_SYNC();
  }
}

constexpr int DNP = 68;
constexpr int DL_KT = 0;
constexpr int DL_V = DL_KT + 128 * DNP * 4;
constexpr int DL_QB = DL_V + 64 * 128 * 4;
constexpr int DL_KB = DL_QB + 64 * 272;
constexpr int DL_SM = DL_KB + 64 * 272;
constexpr int DL_RAW = DL_SM + 2048;
static_assert(DL_RAW + 3 * 67 * 272 <= SMEM_BYTES, "dn_local LDS");
__device__ __forceinline__ void dn_local_item(const Params& p, unsigned char* smem, int item) {
  const int h = item & 3, n = (item >> 2) & 63, b = item >> 8;
  const u16* PROJ = (const u16*)(p.ws + OFF_PROJ);
  const float* SMALL = (const float*)(p.ws + OFF_SMALL);
  u16* Ug = (u16*)((unsigned char*)p.out + DO_U);
  u16* Wg = (u16*)((unsigned char*)p.out + DO_W);
  u16* QNg = (u16*)((unsigned char*)p.out + DO_QN);
  u16* KNTg = (u16*)((unsigned char*)p.out + DO_KNT);
  u16* ATTg = (u16*)(p.ws + OFF_ATT);
  float* GCg = (float*)(p.ws + OFF_GC);
  const float* convw = p.in[5];
  const int tid = TIDX, lane = tid & 63, wave = tid >> 6;
  const int c0 = n * 64;
  const size_t tok0 = (size_t)b * SEQ + c0;
  float* Kt = (float*)(smem + DL_KT);
  float* V = (float*)(smem + DL_V);
  unsigned char* Qb = smem + DL_QB;
  unsigned char* Kb = smem + DL_KB;
  float* gc = (float*)(smem + DL_SM);
  float* beta = gc + 64;
  float* ssp = beta + 64;
  unsigned char* RAW = smem + DL_RAW;
  float* AmT = (float*)(smem + DL_RAW);
  __syncthreads();
  {
    u32x4 rg[7];
#pragma unroll
    for (int k = 0; k < 7; ++k) {
      const int ci = tid + 512 * k;
      rg[k] = (u32x4){0u, 0u, 0u, 0u};
      if (ci < 3216) {
        const int arr = ci / 1072, rem = ci - arr * 1072, row = rem >> 4, ch = rem & 15;
        const int trel = c0 - 3 + row;
        if (trel >= 0)
          rg[k] = *(const u32x4*)(PROJ + ((size_t)b * SEQ + trel) * LDP + (C_DQ + arr * 512) + h * 128 + ch * 8);
      }
    }
#pragma unroll
    for (int k = 0; k < 7; ++k) {
      const int ci = tid + 512 * k;
      if (ci < 3216) {
        const int arr = ci / 1072, rem = ci - arr * 1072, row = rem >> 4, ch = rem & 15;
        *(u32x4*)(RAW + (arr * 67 + row) * 272 + ch * 16) = rg[k];
      }
    }
  }
  if (tid < 64) {
    float da = SMALL[(tok0 + tid) * 16 + 8 + h], db = SMALL[(tok0 + tid) * 16 + 12 + h];
    float xx = da + p.in[7][h];
    float sp = fmaxf(xx, 0.f) + log1pf(__expf(-fabsf(xx)));
    float gr = -__expf(p.in[6][h]) * sp;
    float incl = gr;
#pragma unroll
    for (int o = 1; o < 64; o <<= 1) {
      float v = __shfl_up(incl, o);
      if (lane >= o) incl += v;
    }
    gc[tid] = incl;
    beta[tid] = sigmoidf_(db);
    GCg[(tok0 + tid) * 4 + h] = incl;
  }
  __syncthreads();
  {
    const int c = tid & 127, tg = tid >> 7;
    float qv[16], kv[16];
#pragma unroll
    for (int arr = 0; arr < 3; ++arr) {
      const float w0 = convw[0 * 1536 + arr * 512 + h * 128 + c], w1 = convw[1 * 1536 + arr * 512 + h * 128 + c],
                  w2 = convw[2 * 1536 + arr * 512 + h * 128 + c], w3 = convw[3 * 1536 + arr * 512 + h * 128 + c];
      const unsigned char* rp = RAW + (arr * 67 + tg * 16) * 272 + c * 2;
      float x0 = bf2f(*(const u16*)(rp)), x1 = bf2f(*(const u16*)(rp + 272)), x2 = bf2f(*(const u16*)(rp + 2 * 272));
#pragma unroll
      for (int ii = 0; ii < 16; ++ii) {
        const float x3 = bf2f(*(const u16*)(rp + (ii + 3) * 272));
        const float y = w0 * x0 + w1 * x1 + w2 * x2 + w3 * x3;
        const float sv = y * sigmoidf_(y);
        if (arr == 0) qv[ii] = sv;
        else if (arr == 1) kv[ii] = sv;
        else V[(tg * 16 + ii) * 128 + c] = sv;
        x0 = x1; x1 = x2; x2 = x3;
      }
    }
#pragma unroll
    for (int ii = 0; ii < 16; ++ii) {
      const float sq = wave_sum_dpp(qv[ii] * qv[ii]);
      const float sk = wave_sum_dpp(kv[ii] * kv[ii]);
      if (lane == 0) {
        ssp[((tg * 16 + ii) * 2) + (wave & 1)] = sq;
        ssp[128 + ((tg * 16 + ii) * 2) + (wave & 1)] = sk;
      }
    }
    __syncthreads();
#pragma unroll
    for (int ii = 0; ii < 16; ++ii) {
      const int i = tg * 16 + ii;
      const float qsc = rsqrtf(ssp[i * 2] + ssp[i * 2 + 1] + EPS) * 0.08838834764831845f;
      const float ksc = rsqrtf(ssp[128 + i * 2] + ssp[128 + i * 2 + 1] + EPS);
      const float qn = qv[ii] * qsc, kn = kv[ii] * ksc;
      *(u16*)(Qb + i * 272 + c * 2) = f2bf(qn);
      *(u16*)(Kb + i * 272 + c * 2) = f2bf(kn);
      Kt[c * DNP + i] = kn;
    }
  }
  __syncthreads();
#pragma unroll
  for (int k = 0; k < 4; ++k) {
    const int gi = tid + 512 * k;
    {
      const int i = gi >> 5, d4 = (gi & 31) * 4;
      const u32x2 v = *(const u32x2*)(Qb + i * 272 + d4 * 2);
      *(u32x2*)(QNg + (tok0 + i) * 512 + h * 128 + perm32(d4)) = v;
    }
    {
      const int d = gi >> 4, t4 = (gi & 15) * 4;
      const f32x4 v = *(const f32x4*)(Kt + d * DNP + t4);
      u32x2 o = {pack2(v[0], v[1]), pack2(v[2], v[3])};
      *(u32x2*)(KNTg + (size_t)item * 8192 + d * 64 + perm32(t4)) = o;
    }
  }
  {
    const int mat = wave >> 2, it = wave & 3;
    const int fr = lane & 15, fg = lane >> 4;
    const unsigned char* Ab = mat ? Qb : Kb;
    bf16x8 af[4];
#pragma unroll
    for (int kk = 0; kk < 4; ++kk) af[kk] = *(const bf16x8*)(Ab + (it * 16 + fr) * 272 + kk * 64 + fg * 16);
    f32x4 gi4 = *(const f32x4*)(gc + it * 16 + 4 * fg);
    f32x4 bi4 = *(const f32x4*)(beta + it * 16 + 4 * fg);
#pragma unroll
    for (int jt = 0; jt < 4; ++jt) {
      f32x4 acc = {0.f, 0.f, 0.f, 0.f};
      if (jt <= it) {
#pragma unroll
        for (int kk = 0; kk < 4; ++kk) {
          bf16x8 bfg = *(const bf16x8*)(Kb + (jt * 16 + fr) * 272 + kk * 64 + fg * 16);
          acc = __builtin_amdgcn_mfma_f32_16x16x32_bf16(af[kk], bfg, acc, 0, 0, 0);
        }
      }
      const int j = jt * 16 + fr;
      const float gj = gc[j];
#pragma unroll
      for (int r = 0; r < 4; ++r) {
        const int i = it * 16 + 4 * fg + r;
        const float dec = __expf(fminf(gi4[r] - gj, 0.f));
        if (mat == 0) { if (jt <= it) AmT[j * 64 + i] = (i > j) ? bi4[r] * acc[r] * dec : 0.f; }
        else ATTg[(size_t)item * 4096 + i * 64 + perm32(j)] = f2bf((i >= j) ? acc[r] * dec : 0.f);
      }
    }
  }
  __syncthreads();
  if (tid < 256) {
    const int c = tid;
    const bool isu = c < 128;
    const int cc = c & 127;
    const int pc = perm32(cc);
#pragma unroll 1
    for (int ib = 0; ib < 4; ++ib) {
      float sreg[16];
#pragma unroll
      for (int r = 0; r < 16; ++r) {
        int i = ib * 16 + r;
        sreg[r] = isu ? V[i * 128 + cc] * beta[i] : Kt[cc * DNP + i] * beta[i] * __expf(gc[i]);
      }
#pragma unroll 1
      for (int j = 0; j < ib * 16; ++j) {
        float xj = isu ? V[j * 128 + cc] : Kt[cc * DNP + j];
        const f32x4* ap = (const f32x4*)(AmT + j * 64 + ib * 16);
        f32x4 a0 = ap[0], a1 = ap[1], a2 = ap[2], a3 = ap[3];
        sreg[0] -= a0[0] * xj; sreg[1] -= a0[1] * xj; sreg[2] -= a0[2] * xj; sreg[3] -= a0[3] * xj;
        sreg[4] -= a1[0] * xj; sreg[5] -= a1[1] * xj; sreg[6] -= a1[2] * xj; sreg[7] -= a1[3] * xj;
        sreg[8] -= a2[0] * xj; sreg[9] -= a2[1] * xj; sreg[10] -= a2[2] * xj; sreg[11] -= a2[3] * xj;
        sreg[12] -= a3[0] * xj; sreg[13] -= a3[1] * xj; sreg[14] -= a3[2] * xj; sreg[15] -= a3[3] * xj;
      }
#pragma unroll
      for (int q = 0; q < 15; ++q) {
        const float* ar = AmT + (ib * 16 + q) * 64 + ib * 16;
#pragma unroll
        for (int r = q + 1; r < 16; ++r) sreg[r] -= ar[r] * sreg[q];
      }
#pragma unroll
      for (int r = 0; r < 16; ++r) {
        int i = ib * 16 + r;
        if (isu) { V[i * 128 + cc] = sreg[r]; Ug[(tok0 + i) * 512 + h * 128 + cc] = f2bf(sreg[r]); }
        else { Kt[cc * DNP + i] = sreg[r]; Wg[(tok0 + i) * 512 + h * 128 + pc] = f2bf(sreg[r]); }
      }
    }
  }
}

__device__ __forceinline__ void phase2(const Params& p, unsigned char* smem) {
#ifndef NO_IDX
  for (int i = blockIdx.x; i < 2048; i += gridDim.x) idx_item(p, smem, i & 7, 255 - (i >> 3));
#endif
#ifndef NO_DNL
  if (!(p.flags & 1))
    for (int i = blockIdx.x; i < 2048; i += gridDim.x) dn_local_item(p, smem, i);
#endif
}

constexpr int SC_WP = 272, SC_KP = 144;
constexpr int SC_W = 0, SC_Q = 64 * SC_WP, SC_KT = 2 * 64 * SC_WP, SC_AT = SC_KT + 128 * SC_KP, SC_U = SC_AT + 64 * SC_KP,
              SC_BUF = SC_U + 64 * SC_WP;
constexpr int SC_GC = 2 * SC_BUF;
static_assert(SC_GC + 2 * 64 * 4 <= SMEM_BYTES, "scan LDS");

__device__ __forceinline__ void dn_scan_item(const Params& p, unsigned char* smem, int bh) {
  const int h = bh & 3, b = bh >> 2;
  const u16* Ug = (const u16*)((const unsigned char*)p.out + DO_U);
  const u16* Wg = (const u16*)((const unsigned char*)p.out + DO_W);
  const u16* QNg = (const u16*)((const unsigned char*)p.out + DO_QN);
  const u16* KNTg = (const u16*)((const unsigned char*)p.out + DO_KNT);
  const u16* ATTg = (const u16*)(p.ws + OFF_ATT);
  const float* GCg = (const float*)(p.ws + OFF_GC);
  const u16* PROJ = (const u16*)(p.ws + OFF_PROJ);
  u16* YDN = (u16*)(p.ws + OFF_YDN);
  const float* ogain = p.in[8];
  const int tid = TIDX, lane = tid & 63, wave = tid >> 6;
  const int fr = lane & 15, fg = lane >> 4;
  const int ecol = wave * 16 + fr;
  float* gcs = (float*)(smem + SC_GC);
  f32x4 S[8];
#pragma unroll
  for (int d = 0; d < 8; ++d) S[d] = (f32x4){0.f, 0.f, 0.f, 0.f};
  u32x4 st[9];
  float gcr = 0.f;
  const int r16 = tid >> 4, c16 = tid & 15;
  const int r8 = tid >> 3, c8 = tid & 7;
#define SCAN_LOAD(n_)                                                                                      \
  {                                                                                                        \
    const size_t tk0 = (size_t)b * SEQ + (size_t)(n_) * 64;                                                \
    const size_t it_ = (size_t)((b * 64 + (n_)) * 4 + h);                                                  \
    st[0] = *(const u32x4*)(Wg + (tk0 + r16) * 512 + h * 128 + c16 * 8);                                   \
    st[1] = *(const u32x4*)(Wg + (tk0 + r16 + 32) * 512 + h * 128 + c16 * 8);                              \
    st[2] = *(const u32x4*)(QNg + (tk0 + r16) * 512 + h * 128 + c16 * 8);                                  \
    st[3] = *(const u32x4*)(QNg + (tk0 + r16 + 32) * 512 + h * 128 + c16 * 8);                             \
    st[4] = *(const u32x4*)(KNTg + it_ * 8192 + (size_t)tid * 8);                                          \
    st[5] = *(const u32x4*)(KNTg + it_ * 8192 + (size_t)(tid + 512) * 8);                                  \
    st[6] = *(const u32x4*)(ATTg + it_ * 4096 + (size_t)tid * 8);                                          \
    st[7] = *(const u32x4*)(Ug + (tk0 + r16) * 512 + h * 128 + c16 * 8);                                   \
    st[8] = *(const u32x4*)(Ug + (tk0 + r16 + 32) * 512 + h * 128 + c16 * 8);                              \
    if (tid < 64) gcr = GCg[(tk0 + tid) * 4 + h];                                                          \
  }
#define SCAN_STORE(buf_)                                                                                   \
  {                                                                                                        \
    unsigned char* bs_ = smem + (buf_) * SC_BUF;                                                           \
    *(u32x4*)(bs_ + SC_W + r16 * SC_WP + c16 * 16) = st[0];                                                \
    *(u32x4*)(bs_ + SC_W + (r16 + 32) * SC_WP + c16 * 16) = st[1];                                         \
    *(u32x4*)(bs_ + SC_Q + r16 * SC_WP + c16 * 16) = st[2];                                                \
    *(u32x4*)(bs_ + SC_Q + (r16 + 32) * SC_WP + c16 * 16) = st[3];                                         \
    *(u32x4*)(bs_ + SC_KT + r8 * SC_KP + c8 * 16) = st[4];                                                 \
    *(u32x4*)(bs_ + SC_KT + (r8 + 64) * SC_KP + c8 * 16) = st[5];                                          \
    *(u32x4*)(bs_ + SC_AT + r8 * SC_KP + c8 * 16) = st[6];                                                 \
    *(u32x4*)(bs_ + SC_U + r16 * SC_WP + c16 * 16) = st[7];                                                \
    *(u32x4*)(bs_ + SC_U + (r16 + 32) * SC_WP + c16 * 16) = st[8];                                         \
    if (tid < 64) gcs[(buf_) * 64 + tid] = gcr;                                                            \
  }
  __syncthreads();
  SCAN_LOAD(0)
  SCAN_STORE(0)
  if (1 < 64) SCAN_LOAD(1)
  __syncthreads();
  for (int n = 0; n < 64; ++n) {
    const int buf = n & 1;
    const size_t tok0 = (size_t)b * SEQ + n * 64;
    if (n + 1 < 64) SCAN_STORE(buf ^ 1)
    if (n + 2 < 64) SCAN_LOAD(n + 2)
    __builtin_amdgcn_sched_barrier(0);
    const unsigned char* base = smem + buf * SC_BUF;
    const u32 ub0 = (u32)(tok0 + 4 * fg) * 512 + (u32)(h * 128 + ecol);
    const float* gcb = gcs + buf * 64 + 4 * fg;
    const float glast = gcs[buf * 64 + 63];
    bf16x8 Sb[4];
#pragma unroll
    for (int kk = 0; kk < 4; ++kk) {
      union { u32 w[4]; bf16x8 v; } cv;
      cv.w[0] = pack2(S[2 * kk][0], S[2 * kk][1]); cv.w[1] = pack2(S[2 * kk][2], S[2 * kk][3]);
      cv.w[2] = pack2(S[2 * kk + 1][0], S[2 * kk + 1][1]); cv.w[3] = pack2(S[2 * kk + 1][2], S[2 * kk + 1][3]);
      Sb[kk] = cv.v;
    }
    f32x4 vnew[4], ov[4];
#pragma unroll
    for (int m = 0; m < 4; ++m) {
      f32x4 aw = {0.f, 0.f, 0.f, 0.f}, aq = {0.f, 0.f, 0.f, 0.f};
#pragma unroll
      for (int kk = 0; kk < 4; ++kk) {
        bf16x8 wf = *(const bf16x8*)(base + SC_W + (m * 16 + fr) * SC_WP + kk * 64 + fg * 16);
        bf16x8 qf = *(const bf16x8*)(base + SC_Q + (m * 16 + fr) * SC_WP + kk * 64 + fg * 16);
        aw = __builtin_amdgcn_mfma_f32_16x16x32_bf16(wf, Sb[kk], aw, 0, 0, 0);
        aq = __builtin_amdgcn_mfma_f32_16x16x32_bf16(qf, Sb[kk], aq, 0, 0, 0);
      }
      f32x4 g4 = *(const f32x4*)(gcb + m * 16);
#pragma unroll
      for (int r = 0; r < 4; ++r) {
        float uv = bf2f(*(const u16*)(base + SC_U + (m * 16 + 4 * fg + r) * SC_WP + ecol * 2));
        vnew[m][r] = uv - aw[r];
        ov[m][r] = aq[r] * __expf(g4[r]);
      }
    }
    bf16x8 vb[2], vsb[2];
#pragma unroll
    for (int k2 = 0; k2 < 2; ++k2) {
      union { u32 w[4]; bf16x8 v; } c1, c2;
      const int ma = 2 * k2, mb = 2 * k2 + 1;
      c1.w[0] = pack2(vnew[ma][0], vnew[ma][1]); c1.w[1] = pack2(vnew[ma][2], vnew[ma][3]);
      c1.w[2] = pack2(vnew[mb][0], vnew[mb][1]); c1.w[3] = pack2(vnew[mb][2], vnew[mb][3]);
      f32x4 ga4 = *(const f32x4*)(gcb + ma * 16), gb4 = *(const f32x4*)(gcb + mb * 16);
      float sa[4], sb2[4];
#pragma unroll
      for (int r = 0; r < 4; ++r) { sa[r] = vnew[ma][r] * __expf(glast - ga4[r]); sb2[r] = vnew[mb][r] * __expf(glast - gb4[r]); }
      c2.w[0] = pack2(sa[0], sa[1]); c2.w[1] = pack2(sa[2], sa[3]);
      c2.w[2] = pack2(sb2[0], sb2[1]); c2.w[3] = pack2(sb2[2], sb2[3]);
      vb[k2] = c1.v; vsb[k2] = c2.v;
    }
    const float egl = __expf(glast);
#pragma unroll
    for (int d = 0; d < 8; ++d) {
      f32x4 a = S[d] * egl;
#pragma unroll
      for (int k2 = 0; k2 < 2; ++k2) {
        bf16x8 kf = *(const bf16x8*)(base + SC_KT + (d * 16 + fr) * SC_KP + k2 * 64 + fg * 16);
        a = __builtin_amdgcn_mfma_f32_16x16x32_bf16(kf, vsb[k2], a, 0, 0, 0);
      }
      S[d] = a;
    }
#pragma unroll
    for (int m = 0; m < 4; ++m) {
      f32x4 ao = ov[m];
#pragma unroll
      for (int k2 = 0; k2 < 2; ++k2) {
        bf16x8 af = *(const bf16x8*)(base + SC_AT + (m * 16 + fr) * SC_KP + k2 * 64 + fg * 16);
        ao = __builtin_amdgcn_mfma_f32_16x16x32_bf16(af, vb[k2], ao, 0, 0, 0);
      }
#pragma unroll
      for (int r = 0; r < 4; ++r) YDN[ub0 + (u32)((m * 16 + r) * 512)] = f2bf(ao[r]);
    }
    __syncthreads();
  }
#undef SCAN_LOAD
#undef SCAN_STORE
  asm volatile("s_waitcnt vmcnt(0)" ::: "memory");
  __syncthreads();
  {
    const int sub = lane >> 4, l16 = lane & 15;
    float gn8[8];
#pragma unroll
    for (int e = 0; e < 8; ++e) gn8[e] = ogain[l16 * 8 + e];
    for (int t = wave * 4 + sub; t < SEQ; t += 32) {
      const size_t tok = (size_t)b * SEQ + t;
      u16* yp = YDN + tok * 512 + h * 128 + l16 * 8;
      const u32x4 ov4 = *(const u32x4*)yp;
      const u32x4 zv4 = *(const u32x4*)(PROJ + tok * LDP + C_DZ + h * 128 + l16 * 8);
      float o8[8], z8[8];
#pragma unroll
      for (int c = 0; c < 4; ++c) { o8[2 * c] = bflo(ov4[c]); o8[2 * c + 1] = bfhi(ov4[c]); z8[2 * c] = bflo(zv4[c]); z8[2 * c + 1] = bfhi(zv4[c]); }
      float sq = 0.f;
#pragma unroll
      for (int e = 0; e < 8; ++e) sq += o8[e] * o8[e];
      sq += DPPF(sq, 0xb1); sq += DPPF(sq, 0x4e); sq += DPPF(sq, 0x141); sq += DPPF(sq, 0x140);
      const float rstd = rsqrtf(sq * (1.f / 128.f) + EPS);
      u32 w[4];
#pragma unroll
      for (int c = 0; c < 4; ++c) {
        const float y0 = o8[2 * c] * rstd * gn8[2 * c] * z8[2 * c] * sigmoidf_(z8[2 * c]);
        const float y1 = o8[2 * c + 1] * rstd * gn8[2 * c + 1] * z8[2 * c + 1] * sigmoidf_(z8[2 * c + 1]);
        w[c] = pack2(y0, y1);
      }
      *(u32x4*)yp = (u32x4){w[0], w[1], w[2], w[3]};
    }
  }
}

constexpr int AT_WAVE_BYTES = 8192 + 512 + 8192;
__device__ __forceinline__ float xor16_sum(float v) {
  auto r = __builtin_amdgcn_permlane16_swap(__float_as_uint(v), __float_as_uint(v), false, false);
  return __uint_as_float(r[0]) + __uint_as_float(r[1]);
}
__device__ __forceinline__ float xor32_sum(float v) {
  auto r = __builtin_amdgcn_permlane32_swap(__float_as_uint(v), __float_as_uint(v), false, false);
  return __uint_as_float(r[0]) + __uint_as_float(r[1]);
}
__device__ __forceinline__ void attn_query(const Params& p, unsigned char* wsm, int b, int t) {
  const u16* PROJ = (const u16*)(p.ws + OFF_PROJ);
  const u16* SEL = (const u16*)(p.ws + OFF_SEL);
  const u16* KVC = (const u16*)(p.ws + OFF_KVC);
  u16* YATT = (u16*)(p.ws + OFF_YATT);
  const int lane = TIDX & 63;
  const int fr = lane & 15, fg = lane >> 4;
  float* P = (float*)wsm;
  u16* sl = (u16*)(wsm + 8192);
  const size_t tokb = (size_t)b * SEQ;
  const size_t tok = tokb + t;
  const int nsel = min(256, t + 1);
  bf16x8 qb[2][2];
  {
    const bf16x8 z = {0, 0, 0, 0, 0, 0, 0, 0};
    const u16* qrow = PROJ + tok * LDP + C_AQ + (fr & 3) * 64 + fg * 8;
#pragma unroll
    for (int g = 0; g < 2; ++g)
#pragma unroll
      for (int kk = 0; kk < 2; ++kk) {
        bf16x8 v = *(const bf16x8*)(qrow + g * 256 + kk * 32);
        qb[g][kk] = (fr < 4) ? v : z;
      }
    const u16* sr = SEL + tok * 256;
#pragma unroll
    for (int i = 0; i < 4; ++i) sl[lane + 64 * i] = sr[lane + 64 * i];
  }
  WAVE_LDS_SYNC();
  const int ngrp = (nsel + 15) >> 4;
  const int nbq = (ngrp + 1) >> 1;
  unsigned char* KST = wsm + 8192 + 512;
  const int kq = lane >> 3, kch = lane & 7;
  u32x4 kA[2][4], kB[2][4];
#define QK_LOAD(buf_, bi_)                                                                       \
  _Pragma("unroll") for (int j = 0; j < 2; ++j)                                                  \
    _Pragma("unroll") for (int hf = 0; hf < 2; ++hf) {                                           \
      const int ki_ = min(((bi_) * 2 + j) * 16 + hf * 8 + kq, 255);                              \
      const int s_ = (int)sl[ki_] & 4095;                                                        \
      const u16* krow_ = KVC + (tokb + s_) * 256 + kch * 8;                                      \
      buf_[j][hf * 2] = *(const u32x4*)(krow_); buf_[j][hf * 2 + 1] = *(const u32x4*)(krow_ + 64); \
    }
#define QK_COMPUTE(buf_, bi_)                                                                    \
  {                                                                                              \
    _Pragma("unroll") for (int j = 0; j < 2; ++j)                                                \
      _Pragma("unroll") for (int hf = 0; hf < 2; ++hf) {                                         \
        const int row_ = hf * 8 + kq;                                                            \
        _Pragma("unroll") for (int g = 0; g < 2; ++g)                                            \
          *(u32x4*)(KST + j * 4096 + (row_ * 2 + g) * 128 + ((kch ^ (row_ & 7)) << 4)) = buf_[j][hf * 2 + g]; \
      }                                                                                          \
    WAVE_LDS_SYNC();                                                                             \
    _Pragma("unroll") for (int j = 0; j < 2; ++j) {                                              \
      const unsigned char* kr_ = KST + j * 4096 + fr * 256;                                      \
      const bf16x8 a00_ = *(const bf16x8*)(kr_ + (((0 + fg) ^ (fr & 7)) << 4));                  \
      const bf16x8 a01_ = *(const bf16x8*)(kr_ + (((4 + fg) ^ (fr & 7)) << 4));                  \
      const bf16x8 a10_ = *(const bf16x8*)(kr_ + 128 + (((0 + fg) ^ (fr & 7)) << 4));            \
      const bf16x8 a11_ = *(const bf16x8*)(kr_ + 128 + (((4 + fg) ^ (fr & 7)) << 4));            \
      f32x4 c0_ = {0.f, 0.f, 0.f, 0.f}, c1_ = {0.f, 0.f, 0.f, 0.f};                              \
      c0_ = __builtin_amdgcn_mfma_f32_16x16x32_bf16(a00_, qb[0][0], c0_, 0, 0, 0);               \
      c0_ = __builtin_amdgcn_mfma_f32_16x16x32_bf16(a01_, qb[0][1], c0_, 0, 0, 0);               \
      c1_ = __builtin_amdgcn_mfma_f32_16x16x32_bf16(a10_, qb[1][0], c1_, 0, 0, 0);               \
      c1_ = __builtin_amdgcn_mfma_f32_16x16x32_bf16(a11_, qb[1][1], c1_, 0, 0, 0);               \
      if (fr < 4) {                                                                              \
        _Pragma("unroll") for (int r = 0; r < 4; ++r) {                                          \
          const int kk2_ = ((bi_) * 2 + j) * 16 + 4 * fg + r;                                    \
          if (kk2_ < 256) {                                                                      \
            const bool v_ = kk2_ < nsel;                                                         \
            P[kk2_ * 8 + fr] = v_ ? c0_[r] : -1e30f;                                             \
            P[kk2_ * 8 + 4 + fr] = v_ ? c1_[r] : -1e30f;                                         \
          }                                                                                      \
        }                                                                                        \
      }                                                                                          \
    }                                                                                            \
    WAVE_LDS_SYNC();                                                                             \
  }
  QK_LOAD(kA, 0)
  for (int bi = 0; bi < nbq; bi += 2) {
    if (bi + 1 < nbq) { QK_LOAD(kB, bi + 1) }
    QK_COMPUTE(kA, bi)
    if (bi + 2 < nbq) { QK_LOAD(kA, bi + 2) }
    if (bi + 1 < nbq) { QK_COMPUTE(kB, bi + 1) }
  }
#undef QK_LOAD
#undef QK_COMPUTE
  for (int ki = nbq * 32 + lane; ki < 256; ki += 64) {
    *(f32x4*)(P + ki * 8) = (f32x4){-1e30f, -1e30f, -1e30f, -1e30f};
    *(f32x4*)(P + ki * 8 + 4) = (f32x4){-1e30f, -1e30f, -1e30f, -1e30f};
  }
  WAVE_LDS_SYNC();
  float inv8[8];
  {
    float lg[4][8];
#pragma unroll
    for (int i = 0; i < 4; ++i) {
      f32x4 x0 = *(const f32x4*)(P + (lane + 64 * i) * 8), x1 = *(const f32x4*)(P + (lane + 64 * i) * 8 + 4);
      lg[i][0] = x0[0]; lg[i][1] = x0[1]; lg[i][2] = x0[2]; lg[i][3] = x0[3];
      lg[i][4] = x1[0]; lg[i][5] = x1[1]; lg[i][6] = x1[2]; lg[i][7] = x1[3];
    }
    WAVE_LDS_SYNC();
    u16* PT = (u16*)P;
#pragma unroll
    for (int hh = 0; hh < 8; ++hh) {
      float m = fmaxf(fmaxf(lg[0][hh], lg[1][hh]), fmaxf(lg[2][hh], lg[3][hh]));
      m = wave_max_dpp(m);
      float e[4], sum = 0.f;
#pragma unroll
      for (int i = 0; i < 4; ++i) { e[i] = __expf(lg[i][hh] - m); sum += e[i]; }
      sum = wave_sum_dpp(sum);
      inv8[hh] = __builtin_amdgcn_rcpf(sum);
#pragma unroll
      for (int i = 0; i < 4; ++i) PT[hh * 256 + lane + 64 * i] = f2bf(e[i]);
    }
  }
  WAVE_LDS_SYNC();
  {
    typedef short s16x4 __attribute__((ext_vector_type(4)));
    typedef __attribute__((address_space(3))) s16x4 lds_s16x4;
    const u16* PT = (const u16*)P;
    unsigned char* VST = wsm + 8192 + 512;
    const int vkey = lane >> 4, vch = lane & 15;
    const int tq = (lane & 15) >> 2, tp = lane & 3;
    f32x4 oacc[2][4];
#pragma unroll
    for (int g = 0; g < 2; ++g)
#pragma unroll
      for (int c = 0; c < 4; ++c) oacc[g][c] = (f32x4){0.f, 0.f, 0.f, 0.f};
    const int nks = (nsel + 31) >> 5;
    u32x4 vA[8], vB[8];
#define PV_LOAD(buf_, ks_)                                                                       \
  _Pragma("unroll") for (int i = 0; i < 8; ++i) {                                                \
    const int ki_ = min((ks_) * 32 + i * 4 + vkey, 255);                                         \
    const int s_ = (int)sl[ki_] & 4095;                                                          \
    buf_[i] = *(const u32x4*)(KVC + (tokb + s_) * 256 + 128 + vch * 8);                          \
  }
#define PV_COMPUTE(buf_, ks_)                                                                    \
  {                                                                                              \
    _Pragma("unroll") for (int i = 0; i < 8; ++i) {                                              \
      const int key_ = i * 4 + vkey;                                                             \
      *(u32x4*)(VST + key_ * 256 + ((vch ^ (key_ & 15)) << 4)) = buf_[i];                        \
    }                                                                                            \
    WAVE_LDS_SYNC();                                                                             \
    const bf16x8 z8_ = {0, 0, 0, 0, 0, 0, 0, 0};                                                 \
    bf16x8 pa_[2];                                                                               \
    _Pragma("unroll") for (int g = 0; g < 2; ++g) {                                              \
      const bf16x8 t_ = *(const bf16x8*)(PT + (g * 4 + (fr & 3)) * 256 + (ks_) * 32 + 8 * fg);  \
      pa_[g] = (fr < 4) ? t_ : z8_;                                                              \
    }                                                                                            \
    const int r1_ = 8 * fg + tq, r2_ = r1_ + 4;                                                  \
    _Pragma("unroll") for (int g = 0; g < 2; ++g)                                                \
      _Pragma("unroll") for (int c = 0; c < 4; ++c) {                                            \
        const int ch_ = g * 8 + 2 * c + (tp >> 1);                                               \
        const s16x4 lo_ = __builtin_amdgcn_ds_read_tr16_b64_v4i16((lds_s16x4*)(VST + r1_ * 256 + ((ch_ ^ (r1_ & 15)) << 4) + 8 * (tp & 1))); \
        const s16x4 hi_ = __builtin_amdgcn_ds_read_tr16_b64_v4i16((lds_s16x4*)(VST + r2_ * 256 + ((ch_ ^ (r2_ & 15)) << 4) + 8 * (tp & 1))); \
        const bf16x8 vb_ = {lo_[0], lo_[1], lo_[2], lo_[3], hi_[0], hi_[1], hi_[2], hi_[3]};     \
        oacc[g][c] = __builtin_amdgcn_mfma_f32_16x16x32_bf16(pa_[g], vb_, oacc[g][c], 0, 0, 0);  \
      }                                                                                          \
    WAVE_LDS_SYNC();                                                                             \
  }
    PV_LOAD(vA, 0)
    for (int ks = 0; ks < nks; ks += 2) {
      if (ks + 1 < nks) { PV_LOAD(vB, ks + 1) }
      PV_COMPUTE(vA, ks)
      if (ks + 2 < nks) { PV_LOAD(vA, ks + 2) }
      if (ks + 1 < nks) { PV_COMPUTE(vB, ks + 1) }
    }
#undef PV_LOAD
#undef PV_COMPUTE
    if (lane < 16) {
#pragma unroll
      for (int g = 0; g < 2; ++g)
#pragma unroll
        for (int c = 0; c < 4; ++c)
#pragma unroll
          for (int r = 0; r < 4; ++r)
            YATT[tok * 512 + (g * 4 + r) * 64 + 16 * c + fr] = f2bf(oacc[g][c][r] * inv8[g * 4 + r]);
    }
  }
  WAVE_LDS_SYNC();
}

__device__ __forceinline__ void phase3(const Params& p, unsigned char* smem) {
  const int wave = TIDX >> 6;
#ifndef NO_SCAN
  if (blockIdx.x < 32) {
    if (!(p.flags & 2)) dn_scan_item(p, smem, blockIdx.x);
    __syncthreads();
  }
#endif
#ifdef NO_ATTN
  return;
#endif
  if (p.flags & 4) return;
  unsigned* qctr = (unsigned*)(p.ws + 1024 + ((p.flags & 128) ? 4096 : 0));
  const unsigned xcc = (unsigned)__builtin_amdgcn_s_getreg((3 << 11) | 20) & 7u;
  unsigned char* wsm = smem + wave * AT_WAVE_BYTES;
  for (unsigned db = 0; db < 8; ++db) {
    const int bb = (int)((xcc + db) & 7u);
    for (;;) {
      unsigned qi = 0;
      if ((TIDX & 63) == 0) qi = __hip_atomic_fetch_add(qctr + bb * 16, 1u, __ATOMIC_RELAXED, __HIP_MEMORY_SCOPE_AGENT);
      qi = (unsigned)__builtin_amdgcn_readfirstlane((int)qi);
      if (qi >= (unsigned)SEQ) break;
      attn_query(p, wsm, bb, SEQ - 1 - (int)qi);
    }
  }
}

__device__ __forceinline__ void hblk_load(unsigned char* reg, const u16* __restrict__ src, u32 ob, u32 ld, int lane) {
  const int c16 = lane & 7, r8 = lane >> 3;
#pragma unroll
  for (int it = 0; it < 8; ++it) {
    const int rl = it * 8 + r8;
    const u32x4 v = *(const u32x4*)(src + ob + (u32)rl * ld + (u32)(c16 * 8));
    *(u32x4*)(reg + rl * 128 + (((c16 + 2 * ((rl >> 2) & 3)) & 7) << 4)) = v;
    if ((it & 3) == 3) __builtin_amdgcn_sched_barrier(0);
  }
}
__device__ __forceinline__ void hblk_store(const unsigned char* reg, u16* __restrict__ dst, u32 ob, u32 ld, int lane) {
  const int c16 = lane & 7, r8 = lane >> 3;
#pragma unroll
  for (int it = 0; it < 8; ++it) {
    const int rl = it * 8 + r8;
    const u32x4 v = *(const u32x4*)(reg + rl * 128 + (((c16 + 2 * ((rl >> 2) & 3)) & 7) << 4));
    *(u32x4*)(dst + ob + (u32)rl * ld + (u32)(c16 * 8)) = v;
  }
}
__device__ __forceinline__ void phase4(const Params& p, unsigned char* smem) {
  const u16* YATT = (const u16*)(p.ws + OFF_YATT);
  const u16* YDN = (const u16*)(p.ws + OFF_YDN);
  const u16* WTA = (const u16*)(p.ws + OFF_WTA);
  const u16* WTB = (const u16*)(p.ws + OFF_WTB);
  const u16* PROJ = (const u16*)(p.ws + OFF_PROJ);
  u16* MG = (u16*)(p.ws + OFF_MERGED);
  const int ntn = DM / 256, ntiles = (MTOK / 256) * ntn;
  for (int t = blockIdx.x; t < ntiles; t += gridDim.x) {
    const int m0 = (t / ntn) * 256, n0 = (t % ntn) * 256;
    f32x4 acc[2][2][4][2];
#pragma unroll
    for (int pass = 0; pass < 2; ++pass) {
      gemm8_tile(pass ? YDN : YATT, pass ? WTB : WTA, 512, m0, n0, smem, acc);
      int lane = TIDX & 63;
      asm volatile("" : "+v"(lane));
      const int wave = TIDX >> 6, wr = wave >> 2, wc = wave & 3, fr = lane & 15, fq = lane >> 4;
      unsigned char* regG = smem + wave * 16384;
      unsigned char* regT = regG + 8192;
      const int lrot = (fr >> 3) + 2 * fq;
      int off4[4];
#pragma unroll
      for (int jj = 0; jj < 4; ++jj) off4[jj] = (4 * fq) * 128 + (fr & 7) * 2 + (((jj * 2 + lrot) & 7) << 4);
#pragma unroll
      for (int ai = 0; ai < 2; ++ai) {
        const u32 gb0 = (u32)(m0 + ai * 128 + wr * 64) * LDP + (u32)(n0 + wc * 64) + (u32)(pass ? C_GB : C_GA);
        const u32 ob0 = (u32)(m0 + ai * 128 + wr * 64) * DM + (u32)(n0 + wc * 64);
        hblk_load(regG, PROJ, gb0, LDP, lane);
        if (pass == 1) hblk_load(regT, MG, ob0, DM, lane);
        WAVE_LDS_SYNC();
#pragma unroll
        for (int m = 0; m < 4; ++m)
#pragma unroll
          for (int r = 0; r < 4; ++r)
#pragma unroll
            for (int bj = 0; bj < 2; ++bj)
#pragma unroll
              for (int n = 0; n < 2; ++n) {
                const int o = off4[bj * 2 + n] + (m * 16 + r) * 128;
                float v = sigmoidf_(bf2f(*(const u16*)(regG + o))) * acc[ai][bj][m][n][r];
                if (pass == 1) v += bf2f(*(const u16*)(regT + o));
                *(u16*)(regT + o) = f2bf(v);
              }
        WAVE_LDS_SYNC();
        hblk_store(regT, MG, ob0, DM, lane);
        WAVE_LDS_SYNC();
      }
      asm volatile("s_waitcnt vmcnt(0)" ::: "memory");
    }
  }
}

__device__ __forceinline__ void phase5(const Params& p, unsigned char* smem) {
  const u16* MG = (const u16*)(p.ws + OFF_MERGED);
  const u16* WTO = (const u16*)(p.ws + OFF_WTO);
  const float* x = p.in[0];
  const int lane = TIDX & 63, wave = TIDX >> 6;
  const int wr = wave >> 2, wc = wave & 3, fr = lane & 15, fq = lane >> 4;
  const int ntn = DM / 256, ntiles = (MTOK / 256) * ntn;
  for (int t = blockIdx.x; t < ntiles; t += gridDim.x) {
    const int m0 = (t / ntn) * 256, n0 = (t % ntn) * 256;
    f32x4 acc[2][2][4][2];
    gemm8_tile(MG, WTO, DM, m0, n0, smem, acc);
    const u32 ob0 = (u32)(m0 + wr * 64 + 4 * fq) * DM + (u32)(n0 + wc * 64 + fr);
    float* outp = p.out;
#pragma unroll
    for (int ai = 0; ai < 2; ++ai)
#pragma unroll
      for (int m = 0; m < 4; ++m) {
#pragma unroll
        for (int bj = 0; bj < 2; ++bj)
#pragma unroll
          for (int n = 0; n < 2; ++n)
#pragma unroll
            for (int j = 0; j < 4; ++j) {
              u32 o = ob0 + (u32)((ai * 128 + m * 16 + j) * DM + (bj * 2 + n) * 16);
              outp[o] = x[o] + acc[ai][bj][m][n][j];
            }
        __builtin_amdgcn_sched_barrier(0);
      }
  }
}

__device__ __forceinline__ void phase6(const Params& p, unsigned char* smem) {
  const u16* H2 = (const u16*)(p.ws + OFF_H2);
  const u16* WTQ = (const u16*)(p.ws + OFF_WTQ);
  u16* QP = (u16*)(p.ws + OFF_QP);
  const int lane = TIDX & 63, wave = TIDX >> 6;
  const int wr = wave >> 2, wc = wave & 3, fr = lane & 15, fq = lane >> 4;
  const int ntn = 2048 / 256, ntiles = (MTOK / 256) * ntn;
  for (int t = blockIdx.x; t < ntiles; t += gridDim.x) {
    const int m0 = (t / ntn) * 256, n0 = (t % ntn) * 256;
    f32x4 acc[2][2][4][2];
    gemm8_tile(H2, WTQ, DM, m0, n0, smem, acc);
    ep_store<2048, false>(QP, (u32)(m0 + wr * 64) * 2048 + (u32)(n0 + wc * 64), acc, nullptr, 1.f, smem, wave, lane);
  }
}

__device__ __forceinline__ int mono_key(float v) { int b = __float_as_int(v); return b ^ ((b >> 31) & 0x7fffffff); }
__device__ __forceinline__ float unmono_key(int k) { return __int_as_float(k ^ ((k >> 31) & 0x7fffffff)); }
__device__ __forceinline__ void chain16(int (&k)[16], int x) {
#pragma unroll
  for (int j = 0; j < 16; ++j) { int hi = max(k[j], x); x = min(k[j], x); k[j] = hi; }
}

#define CE_DESC(a, b) { const int hi_ = max(a, b), lo_ = min(a, b); a = hi_; b = lo_; }
__device__ __forceinline__ void sort16_desc(int (&k)[16]) {
#pragma unroll
  for (int size = 2; size <= 16; size <<= 1) {
#pragma unroll
    for (int stride = size >> 1; stride > 0; stride >>= 1) {
#pragma unroll
      for (int i = 0; i < 16; ++i) {
        const int l = i ^ stride;
        if (l > i) {
          if ((i & size) == 0) CE_DESC(k[i], k[l]) else CE_DESC(k[l], k[i])
        }
      }
    }
  }
}
__device__ __forceinline__ void merge_top16(int (&a)[16], const int (&b)[16]) {
#pragma unroll
  for (int i = 0; i < 16; ++i) a[i] = max(a[i], b[15 - i]);
#pragma unroll
  for (int stride = 8; stride > 0; stride >>= 1) {
#pragma unroll
    for (int i = 0; i < 16; ++i) {
      const int l = i ^ stride;
      if (l > i) CE_DESC(a[i], a[l])
    }
  }
}

constexpr int P7_LD = 132;
__device__ __forceinline__ void phase7(const Params& p, unsigned char* smem) {
  const u16* QP = (const u16*)(p.ws + OFF_QP);
  const u16* SKB = (const u16*)(p.ws + OFF_SKB);
  float* TOPS = (float*)(p.ws + OFF_TOPS);
  u8* TOPI = (u8*)(p.ws + OFF_TOPI);
  const int tid = TIDX, lane = tid & 63, wave = tid >> 6;
  const int wm = wave >> 1, wn = wave & 1, fr = lane & 15, fg = lane >> 4;
  const int ntiles = (MTOK / G_BM) * 16;
  float* tile = (float*)smem;
  for (int t = blockIdx.x; t < ntiles; t += gridDim.x) {
    const int m0 = (t >> 4) * G_BM, hp = t & 15;
    f32x4 acc[4][4];
    gemm_mainloop(QP + hp * 128, 2048, SKB + (size_t)hp * 128 * 128, 128, 128, m0, 0, smem, acc);
#pragma unroll
    for (int i = 0; i < 4; ++i)
#pragma unroll
      for (int j = 0; j < 4; ++j)
#pragma unroll
        for (int r = 0; r < 4; ++r) {
          int row = wm * 64 + i * 16 + 4 * fg + r, col = wn * 64 + j * 16 + fr;
          tile[row * P7_LD + col] = acc[i][j][r];
        }
    __syncthreads();
    {
      const int row = tid >> 1, half = tid & 1;
      int k[16];
      const float* rowp = tile + row * P7_LD + half * 64;
#pragma unroll
      for (int grp = 0; grp < 4; ++grp) {
        int gk[16];
#pragma unroll
        for (int c = 0; c < 16; c += 4) {
          f32x4 v = *(const f32x4*)(rowp + grp * 16 + c);
          const int ib = 127 - (half * 64 + grp * 16 + c);
          gk[c] = (mono_key(v[0]) & ~127) | ib;
          gk[c + 1] = (mono_key(v[1]) & ~127) | (ib - 1);
          gk[c + 2] = (mono_key(v[2]) & ~127) | (ib - 2);
          gk[c + 3] = (mono_key(v[3]) & ~127) | (ib - 3);
        }
        sort16_desc(gk);
        if (grp == 0) {
#pragma unroll
          for (int j = 0; j < 16; ++j) k[j] = gk[j];
        } else merge_top16(k, gk);
      }
      {
        int other[16];
#pragma unroll
        for (int j = 0; j < 16; ++j) other[j] = DPPI(k[j], 0xb1);
        merge_top16(k, other);
      }
      if (half == 0) {
        size_t o = ((size_t)(m0 + row) * 16 + hp) * 16;
        float vals[16]; int idx[16];
#pragma unroll
        for (int j = 0; j < 16; ++j) { idx[j] = 127 - (k[j] & 127); vals[j] = tile[row * P7_LD + idx[j]]; }
#pragma unroll
        for (int j = 0; j < 16; j += 4) *(f32x4*)(TOPS + o + j) = (f32x4){vals[j], vals[j + 1], vals[j + 2], vals[j + 3]};
#pragma unroll
        for (int j = 0; j < 16; j += 4)
          *(u32*)(TOPI + o + j) = (u32)idx[j] | ((u32)idx[j + 1] << 8) | ((u32)idx[j + 2] << 16) | ((u32)idx[j + 3] << 24);
      }
    }
    __syncthreads();
  }
}

__device__ __forceinline__ void phase7b(const Params& p) {
  const float* TOPS = (const float*)(p.ws + OFF_TOPS);
  const u8* TOPI = (const u8*)(p.ws + OFF_TOPI);
  int* EXPERT = (int*)(p.ws + OFF_EXPERT);
  float* GATE = (float*)(p.ws + OFF_GATE);
  for (int w = blockIdx.x * NTHREADS + TIDX; w < MTOK * 8; w += gridDim.x * NTHREADS) {
    const size_t o = (size_t)w * 32;
    float sa[16], sb[16];
#pragma unroll
    for (int k = 0; k < 16; k += 4) {
      float4 v = *(const float4*)(TOPS + o + k); sa[k] = v.x; sa[k + 1] = v.y; sa[k + 2] = v.z; sa[k + 3] = v.w;
      float4 u = *(const float4*)(TOPS + o + 16 + k); sb[k] = u.x; sb[k + 1] = u.y; sb[k + 2] = u.z; sb[k + 3] = u.w;
    }
    int cand[64];
#pragma unroll
    for (int k = 0; k < 64; ++k) cand[k] = (int)0x80000000;
    {
      int cnt = 0;
#pragma unroll
      for (int a = 0; a < 16; ++a)
#pragma unroll
        for (int bb = 0; bb < 16; ++bb)
          if ((a + 1) * (bb + 1) <= 16) { cand[cnt] = (mono_key(sa[a] + sb[bb]) & ~255) | (255 - (a * 16 + bb)); ++cnt; }
    }
    int kk[16];
#pragma unroll
    for (int grp = 0; grp < 4; ++grp) {
      int gk[16];
#pragma unroll
      for (int j = 0; j < 16; ++j) gk[j] = cand[grp * 16 + j];
      sort16_desc(gk);
      if (grp == 0) {
#pragma unroll
        for (int j = 0; j < 16; ++j) kk[j] = gk[j];
      } else merge_top16(kk, gk);
    }
    float vals[16];
#pragma unroll
    for (int k = 0; k < 16; ++k) vals[k] = unmono_key(kk[k] & ~255);
    float m = vals[0], s = 0.f, e[16];
#pragma unroll
    for (int k = 0; k < 16; ++k) { e[k] = __expf(vals[k] - m); s += e[k]; }
    float inv = 1.f / s;
#pragma unroll
    for (int k = 0; k < 16; ++k) {
      const int ci = 255 - (kk[k] & 255);
      int a = ci >> 4, bb = ci & 15;
      int ex = (int)TOPI[o + a] * 128 + (int)TOPI[o + 16 + bb];
      EXPERT[(size_t)w * 16 + k] = ex;
      GATE[(size_t)w * 16 + k] = e[k] * inv;
    }
  }
  {
    const int lane = TIDX & 63, wave = TIDX >> 6;
    for (int row = blockIdx.x * 8 + wave; row < 2 * 16384; row += gridDim.x * 8) {
      const int tbl = row >> 14, r = row & 16383;
      const f32x4* src = (const f32x4*)((tbl ? p.in[16] : p.in[15]) + (size_t)r * DM) + 4 * lane;
      f32x4 x[4];
      float amax = 0.f;
#pragma unroll
      for (int i = 0; i < 4; ++i) {
        x[i] = src[i];
        amax = fmaxf(amax, fmaxf(fmaxf(fabsf(x[i][0]), fabsf(x[i][1])), fmaxf(fabsf(x[i][2]), fabsf(x[i][3]))));
      }
      amax = wave_max_dpp(amax);
      const float inv = amax > 0.f ? 127.f / amax : 0.f;
      const int bias = 0;
      u32x4 o;
#pragma unroll
      for (int i = 0; i < 4; ++i) {
        int q0 = (int)rintf(x[i][0] * inv) + bias, q1 = (int)rintf(x[i][1] * inv) + bias;
        int q2 = (int)rintf(x[i][2] * inv) + bias, q3 = (int)rintf(x[i][3] * inv) + bias;
        o[i] = (u32)(q0 & 0xff) | ((u32)(q1 & 0xff) << 8) | ((u32)(q2 & 0xff) << 16) | ((u32)(q3 & 0xff) << 24);
      }
      *(u32x4*)(p.ws + (tbl ? OFF_VQ : OFF_UQ) + ((size_t)(lane >> 3) * 16384 + r) * 128 + (lane & 7) * 16) = o;
      if (lane == 0) ((float*)(p.ws + (tbl ? OFF_VS : OFF_US)))[r] = amax * (1.f / 127.f);
    }
  }
}

__device__ __forceinline__ void phase8a(const Params& p) {
  const int* EXPERT = (const int*)(p.ws + OFF_EXPERT);
  const unsigned char* UQS = p.ws + OFF_UQ;
  const unsigned char* H2Q = p.ws + OFF_H2Q;
  int* PD = (int*)(p.ws + OFF_PD);
  unsigned* ctr = (unsigned*)(p.ws + 2048 + ((p.flags & 128) ? 4096 : 0));
  const unsigned xcc = (unsigned)__builtin_amdgcn_s_getreg((3 << 11) | 20) & 7u;
  const int lane = TIDX & 63, g8 = lane >> 3, l8 = lane & 7;
  for (unsigned db = 0; db < 8; ++db) {
    const int x = (int)((xcc + db) & 7u);
    for (;;) {
      unsigned ci = 0;
      if (lane == 0) ci = __hip_atomic_fetch_add(ctr + x * 16, 1u, __ATOMIC_RELAXED, __HIP_MEMORY_SCOPE_AGENT);
      ci = (unsigned)__builtin_amdgcn_readfirstlane((int)ci);
      if (ci >= (unsigned)(MTOK / 16)) break;
#pragma unroll 1
      for (int tt = 0; tt < 16; ++tt) {
        const int tok = (int)ci * 16 + tt;
        const int e0 = EXPERT[(size_t)tok * 128 + lane], e1 = EXPERT[(size_t)tok * 128 + 64 + lane];
        const u32x4 hq = *(const u32x4*)(H2Q + (size_t)tok * DM + x * 128 + l8 * 16);
        u32x4 ua[16];
#pragma unroll
        for (int i = 0; i < 16; ++i) {
          const int k = i * 8 + g8;
          const int ek = __shfl(i < 8 ? e0 : e1, k & 63);
          ua[i] = *(const u32x4*)(UQS + ((size_t)(x * 16384 + ek)) * 128 + l8 * 16);
        }
        int keep0 = 0, keep1 = 0;
#pragma unroll
        for (int i = 0; i < 16; ++i) {
          int sd = 0;
#pragma unroll
          for (int c = 0; c < 4; ++c) sd = __builtin_amdgcn_sdot4((int)ua[i][c], (int)hq[c], sd, false);
          sd += DPPI(sd, 0xb1); sd += DPPI(sd, 0x4e); sd += DPPI(sd, 0x141);
          if (i < 8) keep0 = (l8 == (i & 7)) ? sd : keep0; else keep1 = (l8 == (i & 7)) ? sd : keep1;
        }
        int* pd = PD + ((size_t)x * MTOK + tok) * 128 + l8 * 8 + g8;
        pd[0] = keep0; pd[64] = keep1;
      }
    }
  }
}

__device__ __forceinline__ void phase8c(const Params& p) {
  const int* EXPERT = (const int*)(p.ws + OFF_EXPERT);
  const float* GATE = (const float*)(p.ws + OFF_GATE);
  const float* US = (const float*)(p.ws + OFF_US);
  const float* VS = (const float*)(p.ws + OFF_VS);
  const float* HS = (const float*)(p.ws + OFF_HS);
  const int* PD = (const int*)(p.ws + OFF_PD);
  unsigned char* CQ8 = p.ws + OFF_CQ8;
  float* QSC = (float*)(p.ws + OFF_QSC);
  const int lane = TIDX & 63, wave = TIDX >> 6;
  for (int tok = blockIdx.x * 8 + wave; tok < MTOK; tok += gridDim.x * 8) {
    const int e0 = EXPERT[(size_t)tok * 128 + lane], e1 = EXPERT[(size_t)tok * 128 + 64 + lane];
    const float g0 = GATE[(size_t)tok * 128 + lane], g1 = GATE[(size_t)tok * 128 + 64 + lane];
    int s0 = 0, s1 = 0;
#pragma unroll
    for (int xx = 0; xx < 8; ++xx) {
      s0 += PD[((size_t)xx * MTOK + tok) * 128 + lane];
      s1 += PD[((size_t)xx * MTOK + tok) * 128 + 64 + lane];
    }
    const float hs = HS[tok];
    const float d0 = (float)s0 * US[e0] * hs, d1 = (float)s1 * US[e1] * hs;
    const float cf0 = g0 * 0.5f * d0 * (1.f + erff(d0 * 0.70710678118654752f)) * VS[e0];
    const float cf1 = g1 * 0.5f * d1 * (1.f + erff(d1 * 0.70710678118654752f)) * VS[e1];
    const float cmax = wave_max_dpp(fmaxf(fabsf(cf0), fabsf(cf1)));
    const float qinv = cmax > 0.f ? 32639.f / cmax : 0.f;
    const int c0 = (int)rintf(cf0 * qinv), c1 = (int)rintf(cf1 * qinv);
    const int h0 = (c0 + 128) >> 8, h1 = (c1 + 128) >> 8;
    unsigned char* cq = CQ8 + (size_t)tok * 256;
    cq[lane] = (unsigned char)(h0 & 0xff); cq[64 + lane] = (unsigned char)(h1 & 0xff);
    cq[128 + lane] = (unsigned char)((c0 - 256 * h0) & 0xff); cq[192 + lane] = (unsigned char)((c1 - 256 * h1) & 0xff);
    if (lane == 0) QSC[tok] = cmax * (1.f / 32639.f);
  }
}

#ifndef TR8_VARIANT
#define TR8_VARIANT 0
#endif
__device__ __forceinline__ void phase8b(const Params& p, unsigned char* smem) {
  typedef int i32x4 __attribute__((ext_vector_type(4)));
  typedef int i32x2 __attribute__((ext_vector_type(2)));
  typedef __attribute__((address_space(3))) i32x2 lds_i32x2;
  const int* EXPERT = (const int*)(p.ws + OFF_EXPERT);
  const unsigned char* VQS = p.ws + OFF_VQ;
  const unsigned char* CQ8 = p.ws + OFF_CQ8;
  const float* QSC = (const float*)(p.ws + OFF_QSC);
  unsigned* ctr = (unsigned*)(p.ws + 3072 + ((p.flags & 128) ? 4096 : 0));
  const unsigned xcc = (unsigned)__builtin_amdgcn_s_getreg((3 << 11) | 20) & 7u;
  const int lane = TIDX & 63, wave = TIDX >> 6, g8 = lane >> 3, l8 = lane & 7;
  const int fr = lane & 15, fg = lane >> 4;
  unsigned char* VST = smem + wave * 16384;
#if TR8_VARIANT == 0
  const int trow = (lane & 15) >> 1, thalf = lane & 1;
#else
  const int trow = lane & 7, thalf = (lane & 15) >> 3;
#endif
  __syncthreads();
  for (unsigned db = 0; db < 8; ++db) {
    const int x = (int)((xcc + db) & 7u);
    for (;;) {
      unsigned ci = 0;
      if (lane == 0) ci = __hip_atomic_fetch_add(ctr + x * 16, 1u, __ATOMIC_RELAXED, __HIP_MEMORY_SCOPE_AGENT);
      ci = (unsigned)__builtin_amdgcn_readfirstlane((int)ci);
      if (ci >= (unsigned)(MTOK / 16)) break;
#pragma unroll 1
      for (int tt = 0; tt < 16; ++tt) {
        const int tok = (int)ci * 16 + tt;
        const int e0 = EXPERT[(size_t)tok * 128 + lane], e1 = EXPERT[(size_t)tok * 128 + 64 + lane];
        u32x4 va[16];
#pragma unroll
        for (int i = 0; i < 16; ++i) {
          const int k = i * 8 + g8;
          const int ek = __shfl(i < 8 ? e0 : e1, k & 63);
          va[i] = *(const u32x4*)(VQS + ((size_t)(x * 16384 + ek)) * 128 + l8 * 16);
        }
        i32x4 af[2];
#pragma unroll
        for (int sx = 0; sx < 2; ++sx) {
          af[sx] = *(const i32x4*)(CQ8 + (size_t)tok * 256 + (fr & 1) * 128 + sx * 64 + fg * 16);
          if (fr >= 2) af[sx] = (i32x4){0, 0, 0, 0};
        }
        const float qsc = QSC[tok];
#pragma unroll
        for (int i = 0; i < 16; ++i) {
          const int k = i * 8 + g8;
          *(u32x4*)(VST + k * 128 + ((l8 ^ g8) << 4)) = va[i];
        }
        WAVE_LDS_SYNC();
        i32x4 acc[8];
#pragma unroll
        for (int c = 0; c < 8; ++c) acc[c] = (i32x4){0, 0, 0, 0};
#pragma unroll
        for (int sx = 0; sx < 2; ++sx) {
          const int r1 = sx * 64 + fg * 16 + trow, r2 = r1 + 8;
#pragma unroll
          for (int c = 0; c < 8; ++c) {
            const i32x2 lo = __builtin_amdgcn_ds_read_tr8_b64_v2i32((lds_i32x2*)(VST + r1 * 128 + ((c ^ (r1 & 7)) << 4) + 8 * thalf));
            const i32x2 hi = __builtin_amdgcn_ds_read_tr8_b64_v2i32((lds_i32x2*)(VST + r2 * 128 + ((c ^ (r2 & 7)) << 4) + 8 * thalf));
            const i32x4 bf = {lo[0], lo[1], hi[0], hi[1]};
            acc[c] = __builtin_amdgcn_mfma_i32_16x16x64_i8(af[sx], bf, acc[c], 0, 0, 0);
          }
        }
        WAVE_LDS_SYNC();
        if (lane < 16 && !(p.flags & 32)) {
          float* op = p.out + (size_t)tok * DM + x * 128 + fr;
#pragma unroll
          for (int c = 0; c < 8; ++c) op[16 * c] += ((float)acc[c][0] * 256.f + (float)acc[c][1]) * qsc;
        }
      }
    }
  }
}

__device__ __forceinline__ void grid_barrier(unsigned* ctr, unsigned target) {
  asm volatile("s_waitcnt vmcnt(0)" ::: "memory");
  __syncthreads();
  if (TIDX == 0) {
    __builtin_amdgcn_fence(__ATOMIC_RELEASE, "agent");
    asm volatile("s_waitcnt vmcnt(0)" ::: "memory");
    __hip_atomic_fetch_add(ctr, 1u, __ATOMIC_RELAXED, __HIP_MEMORY_SCOPE_AGENT);
    while (__hip_atomic_load(ctr, __ATOMIC_RELAXED, __HIP_MEMORY_SCOPE_AGENT) < target) __builtin_amdgcn_s_sleep(2);
    __builtin_amdgcn_fence(__ATOMIC_ACQUIRE, "agent");
    asm volatile("s_waitcnt vmcnt(0)" ::: "memory");
  }
  __syncthreads();
}

__global__ void __launch_bounds__(NTHREADS, 2) mk_fwd(Params p) {
  cg::grid_group grid = cg::this_grid();
  __shared__ __attribute__((aligned(16))) unsigned char smem[SMEM_BYTES];
  const int lo = p.ph_lo, hi = p.ph_hi;
#define RUN(k, call) if (lo <= (k) && (k) < hi) { call; if ((k) + 1 < hi) { if ((k) == lo) grid.sync(); else grid_barrier((unsigned*)p.ws, (unsigned)((k) - lo) * gridDim.x); } }
  RUN(0, phase0(p, smem))
  RUN(1, phase1(p, smem))
  RUN(2, phase2(p, smem))
  RUN(3, phase3(p, smem))
  RUN(4, phase4(p, smem))
  RUN(5, phase5(p, smem))
  RUN(6, rmsnorm_rows<true>(p.out, p.in[12], (u16*)(p.ws + OFF_H2), p.ws + OFF_H2Q, (float*)(p.ws + OFF_HS)))
  RUN(7, phase6(p, smem))
  RUN(8, phase7(p, smem))
  RUN(9, phase7b(p))
  RUN(10, phase8a(p))
  RUN(11, phase8c(p))
  RUN(12, phase8b(p, smem))
#undef RUN
}

extern "C" void kernel_launch(void* const* d_in, const int* in_sizes, int n_in,
                              void* d_out, int out_size, void* d_ws, size_t ws_size,
                              hipStream_t stream) {
  static int grid_blocks = 0;
  if (!grid_blocks) {
    int dev = 0, cus = 0, per_cu = 0;
    (void)hipGetDevice(&dev);
    (void)hipDeviceGetAttribute(&cus, hipDeviceAttributeMultiprocessorCount, dev);
    (void)hipOccupancyMaxActiveBlocksPerMultiprocessor(&per_cu, mk_fwd, NTHREADS, 0);
    if (per_cu < 1) per_cu = 1;
    if (per_cu > 1) per_cu = 1;
    grid_blocks = cus * per_cu;
    fprintf(stderr, "mk_fwd: cus=%d per_cu=%d grid=%d ws=%zu\n", cus, per_cu, grid_blocks, ws_size);
  }
  Params p{};
  for (int i = 0; i < 17 && i < n_in; ++i) p.in[i] = (const float*)d_in[i];
  p.out = (float*)d_out;
  p.ws = (unsigned char*)d_ws;
  p.ph_lo = 0; p.ph_hi = 13;
  (void)hipMemsetAsync(d_ws, 0, 8192, stream);
  void* args[] = {&p};
  hipError_t e = hipLaunchCooperativeKernel((void*)mk_fwd, dim3(grid_blocks), dim3(NTHREADS), args, 0, stream);
  if (e != hipSuccess) fprintf(stderr, "cooperative launch failed: %s (grid %d)\n", hipGetErrorString(e), grid_blocks);
#ifdef EXTRA_LO
  {
    Params p2 = p;
    p2.ph_lo = EXTRA_LO; p2.ph_hi = EXTRA_HI; p2.flags = EXTRA_FLAGS;
    void* args2[] = {&p2};
    (void)hipLaunchCooperativeKernel((void*)mk_fwd, dim3(grid_blocks), dim3(NTHREADS), args2, 0, stream);
  }
#endif
}
```

```cpp
#include <hip/hip_runtime.h>
#include <hip/hip_bf16.h>
#include <hip/hip_cooperative_groups.h>
#include <cstdio>
#include <cstdint>
namespace cg = cooperative_groups;

typedef unsigned short u16;
typedef unsigned int u32;
typedef unsigned char u8;
typedef short bf16x8 __attribute__((ext_vector_type(8)));
typedef float f32x4 __attribute__((ext_vector_type(4)));
typedef unsigned int u32x4 __attribute__((ext_vector_type(4)));
typedef unsigned int u32x2 __attribute__((ext_vector_type(2)));

constexpr int NTHREADS = 512;
constexpr int BATCH = 8, SEQ = 4096, DM = 1024, MTOK = BATCH * SEQ;
constexpr int LDP = 5120;
constexpr int NPADW = 5632;
constexpr int C_AQ = 0, C_IQ = 512, C_DQ = 1024, C_DK = 1536, C_DV = 2048, C_DZ = 2560, C_GA = 3072, C_GB = 4096;
constexpr int N_AK = 5120, N_AV = 5248, N_IK = 5376, N_SM = 5440;
constexpr size_t MiB = 1ull << 20;
constexpr size_t OFF_WTIN = 1 * MiB, OFF_WTA = 12 * MiB, OFF_WTB = 13 * MiB, OFF_WTO = 14 * MiB, OFF_WTQ = 16 * MiB,
                 OFF_SKB = 20 * MiB, OFF_SMALL = 21 * MiB, OFF_H = 23 * MiB, OFF_ATT = 23 * MiB, OFF_GC = 39 * MiB,
                 OFF_MERGED = 23 * MiB, OFF_PROJ = 87 * MiB, OFF_KVC = 407 * MiB, OFF_IKC = 423 * MiB, OFF_SEL = 427 * MiB, OFF_YATT = 443 * MiB,
                 OFF_YDN = 475 * MiB;
constexpr size_t OFF_H2 = OFF_PROJ, OFF_QP = OFF_PROJ + 64 * MiB, OFF_TOPS = OFF_PROJ + 192 * MiB,
                 OFF_TOPI = OFF_PROJ + 224 * MiB, OFF_EXPERT = OFF_PROJ + 232 * MiB, OFF_GATE = OFF_PROJ + 248 * MiB;
constexpr size_t OFF_UQ = OFF_PROJ + 264 * MiB, OFF_VQ = OFF_PROJ + 280 * MiB, OFF_US = OFF_PROJ + 296 * MiB, OFF_VS = OFF_PROJ + 297 * MiB;
constexpr size_t OFF_CQ8 = 56 * MiB, OFF_QSC = 64 * MiB;
constexpr size_t OFF_H2Q = 23 * MiB, OFF_HS = 55 * MiB, OFF_PD = OFF_PROJ + 64 * MiB;
constexpr size_t DO_U = 0, DO_W = 32 * MiB, DO_QN = 64 * MiB, DO_KNT = 96 * MiB;

constexpr int SMEM_BYTES = 162816;
constexpr float EPS = 1e-6f;

struct Params {
  const float* in[17];
  float* out;
  unsigned char* ws;
  int ph_lo, ph_hi;
  int flags, pad;
};

typedef __bf16 bf16x2_t __attribute__((ext_vector_type(2)));
typedef float f32x2_t __attribute__((ext_vector_type(2)));
__device__ __forceinline__ u32 pack2(float a, float b) {
  f32x2_t f = {a, b};
  return __builtin_bit_cast(u32, __builtin_convertvector(f, bf16x2_t));
}
__device__ __forceinline__ u16 f2bf(float f) { return (u16)(pack2(f, f) & 0xffffu); }
__device__ __forceinline__ float bf2f(u16 h) { return __uint_as_float(((u32)h) << 16); }
__device__ __forceinline__ float bflo(u32 w) { return __uint_as_float(w << 16); }
__device__ __forceinline__ float bfhi(u32 w) { return __uint_as_float(w & 0xffff0000u); }
__device__ __forceinline__ float wave_sum(float v) {
#pragma unroll
  for (int o = 32; o > 0; o >>= 1) v += __shfl_xor(v, o);
  return v;
}
__device__ __forceinline__ float wave_max(float v) {
#pragma unroll
  for (int o = 32; o > 0; o >>= 1) v = fmaxf(v, __shfl_xor(v, o));
  return v;
}
__device__ __forceinline__ float dot2bf(u32 a, u32 b, float acc) {
  return __builtin_amdgcn_fdot2_f32_bf16(__builtin_bit_cast(bf16x2_t, a), __builtin_bit_cast(bf16x2_t, b), acc, false);
}
#define DPPF(v, ctrl) __int_as_float(__builtin_amdgcn_update_dpp(0, __float_as_int(v), ctrl, 0xf, 0xf, true))
__device__ __forceinline__ float wave_sum_dpp(float v) {
  v += DPPF(v, 0xb1);
  v += DPPF(v, 0x4e);
  v += DPPF(v, 0x124);
  v += DPPF(v, 0x128);
  float r0 = __int_as_float(__builtin_amdgcn_readlane(__float_as_int(v), 0));
  float r1 = __int_as_float(__builtin_amdgcn_readlane(__float_as_int(v), 16));
  float r2 = __int_as_float(__builtin_amdgcn_readlane(__float_as_int(v), 32));
  float r3 = __int_as_float(__builtin_amdgcn_readlane(__float_as_int(v), 48));
  return (r0 + r1) + (r2 + r3);
}
__device__ __forceinline__ int opaque_tid() { int t = threadIdx.x; asm volatile("" : "+v"(t)); return t; }
#define TIDX opaque_tid()
#define DPPI(v, ctrl) __builtin_amdgcn_update_dpp(0, (v), ctrl, 0xf, 0xf, true)
__device__ __forceinline__ int wave_sum_i_dpp(int v) {
  v += DPPI(v, 0xb1);
  v += DPPI(v, 0x4e);
  v += DPPI(v, 0x124);
  v += DPPI(v, 0x128);
  return (__builtin_amdgcn_readlane(v, 0) + __builtin_amdgcn_readlane(v, 16)) +
         (__builtin_amdgcn_readlane(v, 32) + __builtin_amdgcn_readlane(v, 48));
}
__device__ __forceinline__ float wave_max_dpp(float v) {
  v = fmaxf(v, DPPF(v, 0xb1));
  v = fmaxf(v, DPPF(v, 0x4e));
  v = fmaxf(v, DPPF(v, 0x124));
  v = fmaxf(v, DPPF(v, 0x128));
  float r0 = __int_as_float(__builtin_amdgcn_readlane(__float_as_int(v), 0));
  float r1 = __int_as_float(__builtin_amdgcn_readlane(__float_as_int(v), 16));
  float r2 = __int_as_float(__builtin_amdgcn_readlane(__float_as_int(v), 32));
  float r3 = __int_as_float(__builtin_amdgcn_readlane(__float_as_int(v), 48));
  return fmaxf(fmaxf(r0, r1), fmaxf(r2, r3));
}
#define WAVE_LDS_SYNC() asm volatile("s_waitcnt lgkmcnt(0)" ::: "memory")
__device__ __forceinline__ float sigmoidf_(float x) { return __builtin_amdgcn_rcpf(1.f + __expf(-x)); }
__device__ __forceinline__ int perm32(int k) {
  int blk = k & ~31, r = k & 31;
  int p = (r < 16) ? (8 * (r >> 2) + (r & 3)) : (8 * ((r - 16) >> 2) + 4 + (r & 3));
  return blk + p;
}

__device__ __forceinline__ int g8_logical_col(int t) { return ((t & 127) >> 5) * 64 + (t >> 7) * 32 + (t & 31); }
__device__ __forceinline__ int win_map(int n) {
  if (n < 512) return n;
  if (n < 1024) return 768 + (n - 512);
  if (n < 3072) return 1352 + (n - 1024);
  if (n < 5120) return 3408 + (n - 3072);
  if (n < 5248) return 512 + (n - 5120);
  if (n < 5376) return 640 + (n - 5248);
  if (n < 5440) return 1280 + (n - 5376);
  if (n < 5448) return 1344 + (n - 5440);
  if (n < 5452) return 3400 + (n - 5448);
  if (n < 5456) return 3404 + (n - 5452);
  return -1;
}
__device__ __forceinline__ void transpose_tile(const float* __restrict__ src, int Nsrc, u16* __restrict__ dst, int K, int k0, int n0,
                               bool mapped, bool perm8, float* tile  ) {
  const int tid = TIDX;
  {
    const int tx = tid & 63, ty = tid >> 6;
    int n = n0 + tx;
    if (perm8) n = (n & ~255) + g8_logical_col(n & 255);
    int sc = mapped ? win_map(n) : n;
#pragma unroll
    for (int i = 0; i < 8; ++i) {
      int k = ty + 8 * i;
      float v = (sc >= 0) ? src[(size_t)(k0 + k) * Nsrc + sc] : 0.f;
      tile[k * 65 + tx] = v;
    }
  }
  __syncthreads();
  {
    const int n = tid >> 3, kc = (tid & 7) * 8;
    u32 w[4];
#pragma unroll
    for (int j = 0; j < 4; ++j) w[j] = pack2(tile[(kc + 2 * j) * 65 + n], tile[(kc + 2 * j + 1) * 65 + n]);
    *(uint4*)(dst + (size_t)(n0 + n) * K + k0 + kc) = make_uint4(w[0], w[1], w[2], w[3]);
  }
  __syncthreads();
}

template <bool Q8>
__device__ __forceinline__ void rmsnorm_rows(const float* __restrict__ x, const float* __restrict__ gain, u16* __restrict__ out,
                                             unsigned char* __restrict__ q8, float* __restrict__ qs) {
  const int lane = TIDX & 63, wave = TIDX >> 6;
  float4 g[4];
#pragma unroll
  for (int i = 0; i < 4; ++i) g[i] = ((const float4*)gain)[lane + 64 * i];
  for (int row = blockIdx.x * 8 + wave; row < MTOK; row += gridDim.x * 8) {
    const float4* xr = (const float4*)(x + (size_t)row * DM);
    float4 v[4];
    float ss = 0.f;
#pragma unroll
    for (int i = 0; i < 4; ++i) {
      v[i] = xr[lane + 64 * i];
      ss += v[i].x * v[i].x + v[i].y * v[i].y + v[i].z * v[i].z + v[i].w * v[i].w;
    }
    ss = wave_sum_dpp(ss);
    float r = rsqrtf(ss * (1.f / DM) + EPS);
    float amax = 0.f;
#pragma unroll
    for (int i = 0; i < 4; ++i) {
      v[i].x *= r * g[i].x; v[i].y *= r * g[i].y; v[i].z *= r * g[i].z; v[i].w *= r * g[i].w;
      uint2 o;
      o.x = pack2(v[i].x, v[i].y);
      o.y = pack2(v[i].z, v[i].w);
      *(uint2*)(out + (size_t)row * DM + 4 * (lane + 64 * i)) = o;
      if (Q8) amax = fmaxf(amax, fmaxf(fmaxf(fabsf(v[i].x), fabsf(v[i].y)), fmaxf(fabsf(v[i].z), fabsf(v[i].w))));
    }
    if (Q8) {
      amax = wave_max_dpp(amax);
      const float inv = amax > 0.f ? 127.f / amax : 0.f;
#pragma unroll
      for (int i = 0; i < 4; ++i) {
        const int q0 = (int)rintf(v[i].x * inv), q1 = (int)rintf(v[i].y * inv), q2 = (int)rintf(v[i].z * inv), q3 = (int)rintf(v[i].w * inv);
        *(u32*)(q8 + (size_t)row * DM + 4 * (lane + 64 * i)) =
            (u32)(q0 & 0xff) | ((u32)(q1 & 0xff) << 8) | ((u32)(q2 & 0xff) << 16) | ((u32)(q3 & 0xff) << 24);
      }
      if (lane == 0) qs[row] = amax * (1.f / 127.f);
    }
  }
}

__device__ __forceinline__ void phase0(const Params& p, unsigned char* smem) {
  float* tile = (float*)smem;
  unsigned char* ws = p.ws;
  const int n_in = 16 * 88, n_a = 8 * 16, n_b = 8 * 16, n_o = 16 * 16, n_q = 16 * 32;
  const int total = n_in + n_a + n_b + n_o + n_q;
  for (int t = blockIdx.x; t < total; t += gridDim.x) {
    int i = t;
    if (i < n_in) { transpose_tile(p.in[2], 5456, (u16*)(ws + OFF_WTIN), 1024, (i / 88) * 64, (i % 88) * 64, true, true, tile); continue; }
    i -= n_in;
    if (i < n_a) { transpose_tile(p.in[9], 1024, (u16*)(ws + OFF_WTA), 512, (i / 16) * 64, (i % 16) * 64, false, true, tile); continue; }
    i -= n_a;
    if (i < n_b) { transpose_tile(p.in[10], 1024, (u16*)(ws + OFF_WTB), 512, (i / 16) * 64, (i % 16) * 64, false, true, tile); continue; }
    i -= n_b;
    if (i < n_o) { transpose_tile(p.in[11], 1024, (u16*)(ws + OFF_WTO), 1024, (i / 16) * 64, (i % 16) * 64, false, true, tile); continue; }
    i -= n_o;
    transpose_tile(p.in[13], 2048, (u16*)(ws + OFF_WTQ), 1024, (i / 32) * 64, (i % 32) * 64, false, true, tile);
  }
  {
    const float* sk = p.in[14];
    u16* skb = (u16*)(ws + OFF_SKB);
    for (int i = blockIdx.x * NTHREADS + TIDX; i < 16 * 128 * 128; i += gridDim.x * NTHREADS) skb[i] = f2bf(sk[i]);
  }
  rmsnorm_rows<false>(p.in[0], p.in[1], (u16*)(ws + OFF_H), nullptr, nullptr);
}

constexpr int G_BM = 256, G_BN = 128, G_BK = 64;
constexpr int G_ABYTES = G_BM * 128;

template <int MI>
__device__ __forceinline__ void gemm_mainloop_t(const u16* __restrict__ A, int lda, const u16* __restrict__ Bt, int ldb, int K,
                                                int m0, int n0, unsigned char* smem, f32x4 (&acc)[MI][4]) {
  constexpr int BN = (MI == 4) ? 128 : 256;
  constexpr int NRB = BN / 64;
  constexpr int STAGE = G_ABYTES + BN * 128;
  const int tid = TIDX, lane = tid & 63, wave = tid >> 6;
  const int wm = (MI == 4) ? (wave >> 1) : (wave >> 2), wn = (MI == 4) ? (wave & 1) : (wave & 3);
#pragma unroll
  for (int i = 0; i < MI; ++i)
#pragma unroll
    for (int j = 0; j < 4; ++j) acc[i][j] = (f32x4){0.f, 0.f, 0.f, 0.f};
  const int kc = tid & 7;
  const int arow = tid >> 3;
  u32x4 ra[4], rb[NRB];
  const u16* ap = A + (size_t)(m0 + arow) * lda + kc * 8;
  const u16* bp = Bt + (size_t)(n0 + arow) * ldb + kc * 8;
  const int nk = K / G_BK;
  const int fr = lane & 15, fg = lane >> 4;
#define G_LOAD(kt_)                                                                       \
  {                                                                                       \
    const u16* ap2_ = ap + (size_t)(kt_) * G_BK;                                          \
    const u16* bp2_ = bp + (size_t)(kt_) * G_BK;                                          \
    _Pragma("unroll") for (int i = 0; i < 4; ++i) ra[i] = *(const u32x4*)(ap2_ + (size_t)(64 * i) * lda); \
    _Pragma("unroll") for (int i = 0; i < NRB; ++i) rb[i] = *(const u32x4*)(bp2_ + (size_t)(64 * i) * ldb); \
  }
#define G_STORE(st_)                                                                      \
  {                                                                                       \
    unsigned char* sa_ = smem + (st_) * STAGE;                                            \
    unsigned char* sb_ = sa_ + G_ABYTES;                                                  \
    _Pragma("unroll") for (int i = 0; i < 4; ++i) { int r = arow + 64 * i; *(u32x4*)(sa_ + r * 128 + ((kc ^ (r & 7)) << 4)) = ra[i]; } \
    _Pragma("unroll") for (int i = 0; i < NRB; ++i) { int r = arow + 64 * i; *(u32x4*)(sb_ + r * 128 + ((kc ^ (r & 7)) << 4)) = rb[i]; } \
  }
  G_LOAD(0)
  __syncthreads();
  G_STORE(0)
  if (nk > 1) G_LOAD(1)
  __syncthreads();
  for (int kt = 0; kt < nk; ++kt) {
    if (kt + 1 < nk) G_STORE((kt + 1) & 1)
    if (kt + 2 < nk) G_LOAD(kt + 2)
    __builtin_amdgcn_sched_barrier(0);
    const unsigned char* sa = smem + (kt & 1) * STAGE;
    const unsigned char* sb = sa + G_ABYTES;
#pragma unroll
    for (int kk = 0; kk < 2; ++kk) {
      bf16x8 bfr[4];
#pragma unroll
      for (int j = 0; j < 4; ++j) {
        int r = wn * 64 + j * 16 + fr;
        bfr[j] = *(const bf16x8*)(sb + r * 128 + (((kk * 4 + fg) ^ (r & 7)) << 4));
      }
#pragma unroll
      for (int ih = 0; ih < MI; ih += 4) {
        bf16x8 af[4];
#pragma unroll
        for (int i = 0; i < 4; ++i) {
          int r = wm * (MI * 16) + (ih + i) * 16 + fr;
          af[i] = *(const bf16x8*)(sa + r * 128 + (((kk * 4 + fg) ^ (r & 7)) << 4));
        }
#pragma unroll
        for (int i = 0; i < 4; ++i)
#pragma unroll
          for (int j = 0; j < 4; ++j) acc[ih + i][j] = __builtin_amdgcn_mfma_f32_16x16x32_bf16(af[i], bfr[j], acc[ih + i][j], 0, 0, 0);
        if (MI == 8 && ih == 0) __builtin_amdgcn_sched_barrier(0);
      }
    }
    __syncthreads();
  }
#undef G_LOAD
#undef G_STORE
}
__device__ __forceinline__ void gemm_mainloop(const u16* __restrict__ A, int lda, const u16* __restrict__ Bt, int ldb, int K,
                                              int m0, int n0, unsigned char* smem, f32x4 (&acc)[4][4]) {
  gemm_mainloop_t<4>(A, lda, Bt, ldb, K, m0, n0, smem, acc);
}

__device__ __forceinline__ int g8_lds_byte(int r, int c) {
  int st = (r >> 4) * 2 + (c >> 5), rr = r & 15, cc = c & 31, ob = rr * 64 + cc * 2;
  return st * 1024 + (ob ^ (((ob >> 9) & 1) << 5));
}
__device__ __forceinline__ void g8_stage_rc(int b, int& R, int& C) {
  int st = b / 1024, sb = b % 1024, swz = sb ^ (((sb >> 9) & 1) << 5);
  R = (st >> 1) * 16 + swz / 64; C = (st & 1) * 32 + (swz % 64) / 2;
}
typedef __attribute__((address_space(3))) unsigned int lds_u32;
__device__ __forceinline__ void gemm8_tile(const u16* __restrict__ A, const u16* __restrict__ Bt, int K, int brow, int bcol,
                                           unsigned char* smem, f32x4 (&acc)[2][2][4][2]) {
  constexpr int HTB = 16384;
  const int tid = TIDX;
  const int wid = tid >> 6, lane = tid & 63, wr = wid >> 2, wc = wid & 3, fr = lane & 15, fq = lane >> 4;
#define SA(b, h) (smem + ((b) * 2 + (h)) * HTB)
#define SB(b, h) (smem + (4 + (b) * 2 + (h)) * HTB)
#define STAGE(P, BASE, br, kt) do { const long _g = (long)(br) * K + (long)(kt) * 64; \
    _Pragma("unroll") for (int _i = 0; _i < 2; ++_i) { int _b = tid * 16 + _i * 8192; int _r, _c; g8_stage_rc(_b, _r, _c); \
      __builtin_amdgcn_global_load_lds((const unsigned int*)(BASE + _g + (long)_r * K + _c), \
        (lds_u32*)((P) + _b), 16, 0, 0); } } while (0)
#define LDA(dst, b, h) _Pragma("unroll") for (int m = 0; m < 4; ++m) _Pragma("unroll") for (int k = 0; k < 2; ++k) \
    dst[m][k] = *(const bf16x8*)(SA(b, h) + g8_lds_byte(wr * 64 + m * 16 + fr, k * 32 + fq * 8))
#define LDB(dst, b, h) _Pragma("unroll") for (int n = 0; n < 2; ++n) _Pragma("unroll") for (int k = 0; k < 2; ++k) \
    dst[n][k] = *(const bf16x8*)(SB(b, h) + g8_lds_byte(wc * 32 + n * 16 + fr, k * 32 + fq * 8))
#define MMA(ai, bj, At_, Bt_) do { __builtin_amdgcn_s_setprio(1); \
    _Pragma("unroll") for (int m = 0; m < 4; ++m) _Pragma("unroll") for (int n = 0; n < 2; ++n) _Pragma("unroll") for (int k = 0; k < 2; ++k) \
      acc[ai][bj][m][n] = __builtin_amdgcn_mfma_f32_16x16x32_bf16(At_[m][k], Bt_[n][k], acc[ai][bj][m][n], 0, 0, 0); \
    __builtin_amdgcn_s_setprio(0); } while (0)
#define WAIT_V(n) asm volatile("s_waitcnt vmcnt(" #n ")" ::: "memory")
#define WAIT_L(n) asm volatile("s_waitcnt lgkmcnt(" #n ")" ::: "memory")
#define BAR __builtin_amdgcn_s_barrier()
#define SCHED __builtin_amdgcn_sched_barrier(0)
#pragma unroll
  for (int a = 0; a < 2; ++a)
#pragma unroll
    for (int b2 = 0; b2 < 2; ++b2)
#pragma unroll
      for (int m = 0; m < 4; ++m)
#pragma unroll
        for (int n = 0; n < 2; ++n) acc[a][b2][m][n] = (f32x4){0.f, 0.f, 0.f, 0.f};
  bf16x8 At[4][2], B0[2][2], B1[2][2];
  const int nt = K / 64;
  constexpr int HALF = 128;
  __syncthreads();
  STAGE(SB(0, 0), Bt, bcol, 0); STAGE(SA(0, 0), A, brow, 0);
  STAGE(SB(0, 1), Bt, bcol + HALF, 0); STAGE(SA(0, 1), A, brow + HALF, 0);
  if (wr == 1) BAR;
  WAIT_V(4); BAR;
  STAGE(SB(1, 0), Bt, bcol, 1); STAGE(SA(1, 0), A, brow, 1); STAGE(SB(1, 1), Bt, bcol + HALF, 1);
  WAIT_V(6); BAR;
  for (int t = 0; t < nt - 2; t += 2) {
    LDB(B0, 0, 0); SCHED; LDA(At, 0, 0); STAGE(SA(1, 1), A, brow + HALF, t + 1);
    WAIT_L(8); BAR; WAIT_L(0); MMA(0, 0, At, B0); BAR; SCHED;
    LDB(B1, 0, 1); STAGE(SB(0, 0), Bt, bcol, t + 2);
    BAR; WAIT_L(0); MMA(0, 1, At, B1); BAR;
    LDA(At, 0, 1); STAGE(SA(0, 0), A, brow, t + 2);
    BAR; WAIT_L(0); MMA(1, 0, At, B0); BAR; SCHED;
    STAGE(SB(0, 1), Bt, bcol + HALF, t + 2);
    WAIT_V(6); BAR; MMA(1, 1, At, B1); BAR;
    LDB(B0, 1, 0); SCHED; LDA(At, 1, 0); STAGE(SA(0, 1), A, brow + HALF, t + 2);
    WAIT_L(8); BAR; WAIT_L(0); MMA(0, 0, At, B0); BAR; SCHED;
    LDB(B1, 1, 1); STAGE(SB(1, 0), Bt, bcol, t + 3);
    BAR; WAIT_L(0); MMA(0, 1, At, B1); BAR;
    LDA(At, 1, 1); STAGE(SA(1, 0), A, brow, t + 3);
    BAR; WAIT_L(0); MMA(1, 0, At, B0); BAR; SCHED;
    STAGE(SB(1, 1), Bt, bcol + HALF, t + 3);
    WAIT_V(6); BAR; MMA(1, 1, At, B1); BAR;
  }
  { LDB(B0, 0, 0); LDA(At, 0, 0); STAGE(SA(1, 1), A, brow + HALF, nt - 1);
    BAR; WAIT_L(0); MMA(0, 0, At, B0); BAR;
    LDB(B1, 0, 1); BAR; WAIT_L(0); MMA(0, 1, At, B1); BAR;
    LDA(At, 0, 1); WAIT_V(4); BAR; WAIT_L(0); MMA(1, 0, At, B0); MMA(1, 1, At, B1); BAR; }
  { LDB(B0, 1, 0); LDA(At, 1, 0); WAIT_V(2); BAR; WAIT_L(0); MMA(0, 0, At, B0); BAR;
    LDB(B1, 1, 1); WAIT_V(0); BAR; WAIT_L(0); MMA(0, 1, At, B1); BAR;
    LDA(At, 1, 1); BAR; WAIT_L(0); MMA(1, 0, At, B0); MMA(1, 1, At, B1); BAR; }
  if (wr == 0) BAR;
#undef SA
#undef SB
#undef STAGE
#undef LDA
#undef LDB
#undef MMA
#undef WAIT_V
#undef WAIT_L
#undef BAR
#undef SCHED
}

template <int LD, bool NORM>
__device__ __forceinline__ void ep_store(u16* __restrict__ dst, u32 ob, const f32x4 (&acc)[2][2][4][2], const float* __restrict__ gain,
                                         float extra, unsigned char* smem, int wave, int lane_in) {
  int lane = lane_in;
  asm volatile("" : "+v"(lane));
  const int fr = lane & 15, fq = lane >> 4;
  unsigned char* reg = smem + wave * 16384;
  float gj[4] = {1.f, 1.f, 1.f, 1.f};
  if (NORM) {
#pragma unroll
    for (int j = 0; j < 4; ++j) gj[j] = gain[j * 16 + fr] * extra;
  }
  const int lrot = (fr >> 3) + 2 * fq;
  unsigned char* wbase = reg + (4 * fq) * 128 + (fr & 7) * 2;
#pragma unroll
  for (int ai = 0; ai < 2; ++ai)
#pragma unroll
    for (int m = 0; m < 4; ++m) {
#pragma unroll
      for (int r = 0; r < 4; ++r) {
        float rs = 1.f;
        if (NORM) {
          float sq = 0.f;
#pragma unroll
          for (int bj = 0; bj < 2; ++bj)
#pragma unroll
            for (int n = 0; n < 2; ++n) sq += acc[ai][bj][m][n][r] * acc[ai][bj][m][n][r];
          sq += DPPF(sq, 0xb1); sq += DPPF(sq, 0x4e); sq += DPPF(sq, 0x141); sq += DPPF(sq, 0x140);
          rs = rsqrtf(sq * (1.f / 64.f) + EPS);
        }
#pragma unroll
        for (int bj = 0; bj < 2; ++bj)
#pragma unroll
          for (int n = 0; n < 2; ++n) {
            const float v = acc[ai][bj][m][n][r];
            const int ch = ((bj * 2 + n) * 2 + lrot) & 7;
            *(u16*)(wbase + (ai * 64 + m * 16 + r) * 128 + (ch << 4)) = f2bf(NORM ? v * rs * gj[bj * 2 + n] : v);
          }
      }
      __builtin_amdgcn_sched_barrier(0);
    }
  WAVE_LDS_SYNC();
  const int c16 = lane & 7, r8 = lane >> 3;
#pragma unroll
  for (int it = 0; it < 16; ++it) {
    const int rw = it * 8 + r8;
    const u32x4 v = *(const u32x4*)(reg + rw * 128 + (((c16 + 2 * ((rw >> 2) & 3)) & 7) << 4));
    const int grow = (it >> 3) * 128 + (it & 7) * 8 + r8;
    *(u32x4*)(dst + ob + (u32)(grow * LD + c16 * 8)) = v;
    if ((it & 3) == 3) __builtin_amdgcn_sched_barrier(0);
  }
}

template <bool NORM>
__device__ __forceinline__ void ep_store8(unsigned char* __restrict__ dst, u32 ob, const f32x4 (&acc)[2][2][4][2],
                                          const float* __restrict__ gain, unsigned char* smem, int wave, int lane_in) {
  int lane = lane_in;
  asm volatile("" : "+v"(lane));
  const int fr = lane & 15, fq = lane >> 4;
  unsigned char* reg = smem + wave * 16384;
  float gj[4] = {1.f, 1.f, 1.f, 1.f};
  if (NORM) {
#pragma unroll
    for (int j = 0; j < 4; ++j) gj[j] = gain[j * 16 + fr];
  }
#pragma unroll
  for (int ai = 0; ai < 2; ++ai)
#pragma unroll
    for (int m = 0; m < 4; ++m) {
#pragma unroll
      for (int r = 0; r < 4; ++r) {
        float rs = 1.f;
        if (NORM) {
          float sq = 0.f;
#pragma unroll
          for (int bj = 0; bj < 2; ++bj)
#pragma unroll
            for (int n = 0; n < 2; ++n) sq += acc[ai][bj][m][n][r] * acc[ai][bj][m][n][r];
          sq += DPPF(sq, 0xb1); sq += DPPF(sq, 0x4e); sq += DPPF(sq, 0x141); sq += DPPF(sq, 0x140);
          rs = rsqrtf(sq * (1.f / 64.f) + EPS);
        }
        const int rw = ai * 64 + m * 16 + 4 * fq + r;
#pragma unroll
        for (int bj = 0; bj < 2; ++bj)
#pragma unroll
          for (int n = 0; n < 2; ++n) {
            const float v = NORM ? acc[ai][bj][m][n][r] * rs * gj[bj * 2 + n] : acc[ai][bj][m][n][r];
            reg[rw * 64 + ((((bj * 2 + n) + (rw >> 2)) & 3) << 4) + fr] =
                (unsigned char)(__builtin_amdgcn_cvt_pk_fp8_f32(v, v, 0, false) & 0xff);
          }
      }
      __builtin_amdgcn_sched_barrier(0);
    }
  WAVE_LDS_SYNC();
  const int c4 = lane & 3, r16 = lane >> 2;
#pragma unroll
  for (int it = 0; it < 8; ++it) {
    const int rw = it * 16 + r16;
    const u32x4 v = *(const u32x4*)(reg + rw * 64 + (((c4 + (rw >> 2)) & 3) << 4));
    const int grow = (rw >> 6) * 128 + (rw & 63);
    *(u32x4*)(dst + ob + (u32)(grow * 256 + c4 * 16)) = v;
  }
}

__device__ __forceinline__ void phase1(const Params& p, unsigned char* smem) {
  const u16* H = (const u16*)(p.ws + OFF_H);
  const u16* WT = (const u16*)(p.ws + OFF_WTIN);
  u16* PROJ = (u16*)(p.ws + OFF_PROJ);
  u16* KVC = (u16*)(p.ws + OFF_KVC);
  u16* IKC = (u16*)(p.ws + OFF_IKC);
  float* SMALL = (float*)(p.ws + OFF_SMALL);
  const int lane = TIDX & 63, wave = TIDX >> 6;
  const int wr = wave >> 2, wc = wave & 3, fr = lane & 15, fq = lane >> 4;
  const int ntn = NPADW / 256;
  const int ntiles = (MTOK / 256) * ntn;
  for (int t = blockIdx.x; t < ntiles; t += gridDim.x) {
    const int m0 = (t / ntn) * 256, n0 = (t % ntn) * 256;
    f32x4 acc[2][2][4][2];
    gemm8_tile(H, WT, DM, m0, n0, smem, acc);
    const int cbase = n0 + wc * 64;
    const u32 rbase = (u32)(m0 + wr * 64);
    if (cbase < C_IQ) {
      ep_store<LDP, true>(PROJ, rbase * LDP + (u32)cbase, acc, p.in[3], 0.125f, smem, wave, lane);
    } else if (cbase < LDP) {
      ep_store<LDP, false>(PROJ, rbase * LDP + (u32)cbase, acc, nullptr, 1.f, smem, wave, lane);
    } else if (cbase < N_AV) {
      ep_store8<true>(p.ws + OFF_KVC, rbase * 256 + (u32)(cbase - N_AK), acc, p.in[4], smem, wave, lane);
    } else if (cbase < N_IK) {
      ep_store8<false>(p.ws + OFF_KVC, rbase * 256 + (u32)(cbase - N_AV + 128), acc, nullptr, smem, wave, lane);
    } else if (cbase < N_SM) {
      ep_store<64, false>(IKC, rbase * 64, acc, nullptr, 1.f, smem, wave, lane);
    } else if (cbase == N_SM) {
      const u32 sb0 = (rbase + 4 * fq) * 16 + (u32)fr;
#pragma unroll
      for (int ai = 0; ai < 2; ++ai)
#pragma unroll
        for (int m = 0; m < 4; ++m)
#pragma unroll
          for (int r = 0; r < 4; ++r) SMALL[sb0 + (u32)((ai * 128 + m * 16 + r) * 16)] = acc[ai][0][m][0][r];
    }
  }
}

constexpr int IDX_RS = 8208;

__device__ __forceinline__ u32 f2key(float x) {
  _Float16 h = (_Float16)x;
  u32 b = (u32) * (u16*)&h;
  return (b & 0x8000u) ? ((~b) & 0xffffu) : (b | 0x8000u);
}
__device__ __forceinline__ int count_ge_wave(const u32 (&kreg)[32], u32 mid) {
  const u32 m1 = (mid - 1u) * 0x00010001u;
  const u32 one = 0x00010001u;
  u32 acc0 = 0u, acc1 = 0u;
#pragma unroll
  for (int i = 0; i < 32; i += 2) {
    u32 t0, t1;
    asm("v_pk_sub_u16 %0, %1, %2 clamp" : "=v"(t0) : "v"(kreg[i]), "s"(m1));
    asm("v_pk_sub_u16 %0, %1, %2 clamp" : "=v"(t1) : "v"(kreg[i + 1]), "s"(m1));
    asm("v_pk_min_u16 %0, %1, %2" : "=v"(t0) : "v"(t0), "s"(one));
    asm("v_pk_min_u16 %0, %1, %2" : "=v"(t1) : "v"(t1), "s"(one));
    asm("v_pk_add_u16 %0, %1, %2" : "=v"(acc0) : "v"(acc0), "v"(t0));
    asm("v_pk_add_u16 %0, %1, %2" : "=v"(acc1) : "v"(acc1), "v"(t1));
  }
  int c = (int)((acc0 & 0xffffu) + (acc0 >> 16) + (acc1 & 0xffffu) + (acc1 >> 16));
  return wave_sum_i_dpp(c);
}

__device__ __forceinline__ void idx_item(const Params& p, unsigned char* smem, int b, int tq) {
  const u16* PROJ = (const u16*)(p.ws + OFF_PROJ);
  const float* SMALL = (const float*)(p.ws + OFF_SMALL);
  u16* SEL = (u16*)(p.ws + OFF_SEL);
  const int tid = TIDX, lane = tid & 63, wave = tid >> 6;
  const int t0 = tq * 16;
  const size_t tokb = (size_t)b * SEQ;
  if (tq < 16) {
    for (int rr = 0; rr < 2; ++rr) {
      int row = 2 * wave + rr, t = t0 + row;
      u16* out = SEL + (tokb + t) * 256;
      for (int i = lane; i < 256; i += 64) out[i] = (i <= t) ? (u16)i : (u16)0xFFFF;
    }
    return;
  }
  const int q = lane & 15, g = lane >> 4;
  __syncthreads();
  {
    const u16* iqrow = PROJ + (tokb + t0 + q) * LDP + C_IQ;
    bf16x8 bq[8][2];
    float wq[8];
#pragma unroll
    for (int h = 0; h < 8; ++h) {
      bq[h][0] = *(const bf16x8*)(iqrow + h * 64 + g * 8);
      bq[h][1] = *(const bf16x8*)(iqrow + h * 64 + 32 + g * 8);
      wq[h] = SMALL[(tokb + t0 + q) * 16 + h];
    }
    const int nkb = tq + 1;
    const int niter = (nkb > wave) ? ((nkb - wave + 7) >> 3) : 0;
    const u16* ikbase = (const u16*)(p.ws + OFF_IKC) + (tokb + q) * 64 + g * 8;
    bf16x8 ca[3][2];
#pragma unroll
    for (int j = 0; j < 3; ++j)
      if (j < niter) {
        const u16* ikrow = ikbase + (size_t)((wave + 8 * j) * 16) * 64;
        ca[j][0] = *(const bf16x8*)(ikrow); ca[j][1] = *(const bf16x8*)(ikrow + 32);
      }
    for (int i0 = 0; i0 < ((p.flags & 8) ? 0 : niter); i0 += 3) {
#pragma unroll
      for (int j = 0; j < 3; ++j) {
        if (i0 + j < niter) {
          const int s0 = (wave + 8 * (i0 + j)) * 16;
          f32x4 tot = {0.f, 0.f, 0.f, 0.f};
#pragma unroll
          for (int h = 0; h < 8; ++h) {
            f32x4 acc = {0.f, 0.f, 0.f, 0.f};
            acc = __builtin_amdgcn_mfma_f32_16x16x32_bf16(ca[j][0], bq[h][0], acc, 0, 0, 0);
            acc = __builtin_amdgcn_mfma_f32_16x16x32_bf16(ca[j][1], bq[h][1], acc, 0, 0, 0);
#pragma unroll
            for (int r = 0; r < 4; ++r) tot[r] += wq[h] * fmaxf(acc[r], 0.f);
          }
          if (i0 + 3 + j < niter) {
            const u16* ikrow = ikbase + (size_t)((wave + 8 * (i0 + 3 + j)) * 16) * 64;
            ca[j][0] = *(const bf16x8*)(ikrow); ca[j][1] = *(const bf16x8*)(ikrow + 32);
          }
          u32 k[4];
#pragma unroll
          for (int r = 0; r < 4; ++r) {
            int sidx = s0 + 4 * g + r;
            k[r] = (sidx <= t0 + q) ? f2key(tot[r]) : 0u;
          }
          u32x2 w2 = {k[0] | (k[1] << 16), k[2] | (k[3] << 16)};
          *(u32x2*)(smem + q * IDX_RS + (s0 + 4 * g) * 2) = w2;
        }
        __builtin_amdgcn_sched_barrier(0);
      }
    }
    const int nk = t0 + 16, nk64 = (nk + 63) & ~63;
    for (int i = tid; i < 16 * (nk64 - nk); i += NTHREADS) {
      int row = i / (nk64 - nk), c = nk + i % (nk64 - nk);
      *(u16*)(smem + row * IDX_RS + c * 2) = 0;
    }
  }
  __syncthreads();
  const int nk64 = (t0 + 16 + 63) & ~63;
  for (int rr = 0; rr < ((p.flags & 16) ? 0 : 2); ++rr) {
    const int row = 2 * wave + rr, t = t0 + row;
    u16* out = SEL + (tokb + t) * 256;
    u32 kreg[32];
    if (lane * 64 < nk64) {
      const uint4* src = (const uint4*)(smem + row * IDX_RS + lane * 128);
#pragma unroll
      for (int i = 0; i < 8; ++i) {
        uint4 v = src[i];
        kreg[4 * i] = v.x; kreg[4 * i + 1] = v.y; kreg[4 * i + 2] = v.z; kreg[4 * i + 3] = v.w;
      }
    } else {
#pragma unroll
      for (int i = 0; i < 32; ++i) kreg[i] = 0u;
    }
    WAVE_LDS_SYNC();
    u32 lo = 1u, hi = 65535u;
    while (lo < hi) {
      u32 mid = (lo + hi + 1u) >> 1;
      int c = count_ge_wave(kreg, mid);
      if (c >= 256) lo = mid; else hi = mid - 1u;
    }
    const u32 tau = lo;
    int gt = 0, eq = 0;
#pragma unroll
    for (int i = 0; i < 32; ++i) {
      u32 a = kreg[i] & 0xffffu, c2 = kreg[i] >> 16;
      gt += (a > tau) ? 1 : 0; gt += (c2 > tau) ? 1 : 0;
      eq += (a == tau) ? 1 : 0; eq += (c2 == tau) ? 1 : 0;
    }
    int packed = gt | (eq << 16);
    int incl = packed;
#pragma unroll
    for (int o = 1; o < 64; o <<= 1) {
      int v = __shfl_up(incl, o);
      if (lane >= o) incl += v;
    }
    const int excl = incl - packed;
    const int total = __shfl(incl, 63);
    const int need = 256 - (total & 0xffff);
    const int pg = excl & 0xffff, pe = excl >> 16;
    int pos = pg + min(pe, need);
    int eqseen = pe;
    u16* lrow = (u16*)(smem + row * IDX_RS);
#pragma unroll
    for (int i = 0; i < 32; ++i) {
#pragma unroll
      for (int hh = 0; hh < 2; ++hh) {
        u32 kv = hh ? (kreg[i] >> 16) : (kreg[i] & 0xffffu);
        int idx = lane * 64 + 2 * i + hh;
        bool take = false;
        if (kv > tau) take = true;
        else if (kv == tau) { take = (eqseen < need); ++eqseen; }
        if (take) { lrow[pos] = (u16)idx; ++pos; }
      }
    }
    WAVE_LDS_SYNC();
    *(u32x2*)(out + lane * 4) = *(const u32x2*)(lrow + lane * 4);
    WAVE_LDS_SYNC();
  }
}

constexpr int DNP = 68;
constexpr int DL_KT = 0;
constexpr int DL_V = DL_KT + 128 * DNP * 4;
constexpr int DL_QB = DL_V + 64 * 128 * 4;
constexpr int DL_KB = DL_QB + 64 * 272;
constexpr int DL_SM = DL_KB + 64 * 272;
constexpr int DL_RAW = DL_SM + 2048;
static_assert(DL_RAW + 3 * 67 * 272 <= SMEM_BYTES && 16384 + 64 * 144 + 2048 <= 3 * 67 * 272, "dn_local LDS");
__device__ __forceinline__ void dn_local_item(const Params& p, unsigned char* smem, int item) {
  const int h = item & 3, n = (item >> 2) & 63, b = item >> 8;
  const u16* PROJ = (const u16*)(p.ws + OFF_PROJ);
  const float* SMALL = (const float*)(p.ws + OFF_SMALL);
  u16* Ug = (u16*)((unsigned char*)p.out + DO_U);
  u16* Wg = (u16*)((unsigned char*)p.out + DO_W);
  u16* QNg = (u16*)((unsigned char*)p.out + DO_QN);
  u16* KNTg = (u16*)((unsigned char*)p.out + DO_KNT);
  u16* ATTg = (u16*)(p.ws + OFF_ATT);
  float* GCg = (float*)(p.ws + OFF_GC);
  const float* convw = p.in[5];
  const int tid = TIDX, lane = tid & 63, wave = tid >> 6;
  const int c0 = n * 64;
  const size_t tok0 = (size_t)b * SEQ + c0;
  float* Kt = (float*)(smem + DL_KT);
  float* V = (float*)(smem + DL_V);
  unsigned char* Qb = smem + DL_QB;
  unsigned char* Kb = smem + DL_KB;
  float* gc = (float*)(smem + DL_SM);
  float* beta = gc + 64;
  float* ssp = beta + 64;
  unsigned char* RAW = smem + DL_RAW;
  float* AmT = (float*)(smem + DL_RAW);
  __syncthreads();
  {
    u32x4 rg[7];
#pragma unroll
    for (int k = 0; k < 7; ++k) {
      const int ci = tid + 512 * k;
      rg[k] = (u32x4){0u, 0u, 0u, 0u};
      if (ci < 3216) {
        const int arr = ci / 1072, rem = ci - arr * 1072, row = rem >> 4, ch = rem & 15;
        const int trel = c0 - 3 + row;
        if (trel >= 0)
          rg[k] = *(const u32x4*)(PROJ + ((size_t)b * SEQ + trel) * LDP + (C_DQ + arr * 512) + h * 128 + ch * 8);
      }
    }
#pragma unroll
    for (int k = 0; k < 7; ++k) {
      const int ci = tid + 512 * k;
      if (ci < 3216) {
        const int arr = ci / 1072, rem = ci - arr * 1072, row = rem >> 4, ch = rem & 15;
        *(u32x4*)(RAW + (arr * 67 + row) * 272 + ch * 16) = rg[k];
      }
    }
  }
  if (tid < 64) {
    float da = SMALL[(tok0 + tid) * 16 + 8 + h], db = SMALL[(tok0 + tid) * 16 + 12 + h];
    float xx = da + p.in[7][h];
    float sp = fmaxf(xx, 0.f) + log1pf(__expf(-fabsf(xx)));
    float gr = -__expf(p.in[6][h]) * sp;
    float incl = gr;
#pragma unroll
    for (int o = 1; o < 64; o <<= 1) {
      float v = __shfl_up(incl, o);
      if (lane >= o) incl += v;
    }
    gc[tid] = incl;
    beta[tid] = sigmoidf_(db);
    GCg[(tok0 + tid) * 4 + h] = incl;
  }
  __syncthreads();
  {
    const int c = tid & 127, tg = tid >> 7;
    float qv[16], kv[16];
#pragma unroll
    for (int arr = 0; arr < 3; ++arr) {
      const float w0 = convw[0 * 1536 + arr * 512 + h * 128 + c], w1 = convw[1 * 1536 + arr * 512 + h * 128 + c],
                  w2 = convw[2 * 1536 + arr * 512 + h * 128 + c], w3 = convw[3 * 1536 + arr * 512 + h * 128 + c];
      const unsigned char* rp = RAW + (arr * 67 + tg * 16) * 272 + c * 2;
      float x0 = bf2f(*(const u16*)(rp)), x1 = bf2f(*(const u16*)(rp + 272)), x2 = bf2f(*(const u16*)(rp + 2 * 272));
#pragma unroll
      for (int ii = 0; ii < 16; ++ii) {
        const float x3 = bf2f(*(const u16*)(rp + (ii + 3) * 272));
        const float y = w0 * x0 + w1 * x1 + w2 * x2 + w3 * x3;
        const float sv = y * sigmoidf_(y);
        if (arr == 0) qv[ii] = sv;
        else if (arr == 1) kv[ii] = sv;
        else V[(tg * 16 + ii) * 128 + c] = sv;
        x0 = x1; x1 = x2; x2 = x3;
      }
    }
#pragma unroll
    for (int ii = 0; ii < 16; ++ii) {
      const float sq = wave_sum_dpp(qv[ii] * qv[ii]);
      const float sk = wave_sum_dpp(kv[ii] * kv[ii]);
      if (lane == 0) {
        ssp[((tg * 16 + ii) * 2) + (wave & 1)] = sq;
        ssp[128 + ((tg * 16 + ii) * 2) + (wave & 1)] = sk;
      }
    }
    __syncthreads();
#pragma unroll
    for (int ii = 0; ii < 16; ++ii) {
      const int i = tg * 16 + ii;
      const float qsc = rsqrtf(ssp[i * 2] + ssp[i * 2 + 1] + EPS) * 0.08838834764831845f;
      const float ksc = rsqrtf(ssp[128 + i * 2] + ssp[128 + i * 2 + 1] + EPS);
      const float qn = qv[ii] * qsc, kn = kv[ii] * ksc;
      *(u16*)(Qb + i * 272 + c * 2) = f2bf(qn);
      *(u16*)(Kb + i * 272 + c * 2) = f2bf(kn);
      Kt[c * DNP + i] = kn;
    }
  }
  __syncthreads();
#pragma unroll
  for (int k = 0; k < 4; ++k) {
    const int gi = tid + 512 * k;
    {
      const int i = gi >> 5, d4 = (gi & 31) * 4;
      const u32x2 v = *(const u32x2*)(Qb + i * 272 + d4 * 2);
      *(u32x2*)(QNg + (tok0 + i) * 512 + h * 128 + perm32(d4)) = v;
    }
    {
      const int d = gi >> 4, t4 = (gi & 15) * 4;
      const f32x4 v = *(const f32x4*)(Kt + d * DNP + t4);
      u32x2 o = {pack2(v[0], v[1]), pack2(v[2], v[3])};
      *(u32x2*)(KNTg + (size_t)item * 8192 + d * 64 + perm32(t4)) = o;
    }
  }
  {
    const int mat = wave >> 2, it = wave & 3;
    const int fr = lane & 15, fg = lane >> 4;
    const unsigned char* Ab = mat ? Qb : Kb;
    bf16x8 af[4];
#pragma unroll
    for (int kk = 0; kk < 4; ++kk) af[kk] = *(const bf16x8*)(Ab + (it * 16 + fr) * 272 + kk * 64 + fg * 16);
    f32x4 gi4 = *(const f32x4*)(gc + it * 16 + 4 * fg);
    f32x4 bi4 = *(const f32x4*)(beta + it * 16 + 4 * fg);
#pragma unroll
    for (int jt = 0; jt < 4; ++jt) {
      f32x4 acc = {0.f, 0.f, 0.f, 0.f};
      if (jt <= it) {
#pragma unroll
        for (int kk = 0; kk < 4; ++kk) {
          bf16x8 bfg = *(const bf16x8*)(Kb + (jt * 16 + fr) * 272 + kk * 64 + fg * 16);
          acc = __builtin_amdgcn_mfma_f32_16x16x32_bf16(af[kk], bfg, acc, 0, 0, 0);
        }
      }
      const int j = jt * 16 + fr;
      const float gj = gc[j];
#pragma unroll
      for (int r = 0; r < 4; ++r) {
        const int i = it * 16 + 4 * fg + r;
        const float dec = __expf(fminf(gi4[r] - gj, 0.f));
        if (mat == 0) { if (jt <= it) AmT[j * 64 + i] = (i > j) ? bi4[r] * acc[r] * dec : 0.f; }
        else ATTg[(size_t)item * 4096 + i * 64 + perm32(j)] = f2bf((i >= j) ? acc[r] * dec : 0.f);
      }
    }
  }
  __syncthreads();
  u16* nA = (u16*)(smem + DL_RAW + 16384);
  u16* Nb = (u16*)(smem + DL_RAW + 16384 + 64 * 144);
  {
#pragma unroll
    for (int k = 0; k < 8; ++k) {
      const int e = tid + 512 * k;
      const int i = e >> 6, j = e & 63;
      const float v = ((j >> 4) < (i >> 4)) ? -AmT[j * 64 + i] : 0.f;
      nA[i * 72 + j] = f2bf(v);
    }
    if (tid < 64) {
      const int bb = tid >> 4, j = tid & 15;
      float nn[16];
#pragma unroll
      for (int i = 0; i < 16; ++i) {
        float sacc = 0.f;
#pragma unroll
        for (int k = 0; k < i; ++k) sacc += AmT[(bb * 16 + k) * 64 + bb * 16 + i] * nn[k];
        nn[i] = (i == j) ? 1.f : ((i > j) ? -sacc : 0.f);
      }
#pragma unroll
      for (int i = 0; i < 16; ++i) Nb[bb * 256 + i * 16 + j] = f2bf(nn[i]);
    }
  }
  __syncthreads();
  {
    const int fr = lane & 15, fg = lane >> 4;
    f32x4 X[2][4];
#pragma unroll
    for (int ct2 = 0; ct2 < 2; ++ct2) {
      const int c = (wave * 2 + ct2) * 16 + fr;
      const bool isu = c < 128;
      const int cc = c & 127;
#pragma unroll
      for (int bb = 0; bb < 4; ++bb) {
        f32x4 acc;
#pragma unroll
        for (int r = 0; r < 4; ++r) {
          const int i = bb * 16 + 4 * fg + r;
          acc[r] = isu ? V[i * 128 + cc] * beta[i] : Kt[cc * DNP + i] * beta[i] * __expf(gc[i]);
        }
        if (bb >= 1) {
          union { u32 w[4]; bf16x8 v; } af, bf;
          const u32x2 a0 = *(const u32x2*)(nA + (bb * 16 + fr) * 72 + 4 * fg);
          af.w[0] = a0[0]; af.w[1] = a0[1];
          bf.w[0] = pack2(X[ct2][0][0], X[ct2][0][1]); bf.w[1] = pack2(X[ct2][0][2], X[ct2][0][3]);
          if (bb >= 2) {
            const u32x2 a1 = *(const u32x2*)(nA + (bb * 16 + fr) * 72 + 16 + 4 * fg);
            af.w[2] = a1[0]; af.w[3] = a1[1];
            bf.w[2] = pack2(X[ct2][1][0], X[ct2][1][1]); bf.w[3] = pack2(X[ct2][1][2], X[ct2][1][3]);
          } else { af.w[2] = 0u; af.w[3] = 0u; bf.w[2] = 0u; bf.w[3] = 0u; }
          acc = __builtin_amdgcn_mfma_f32_16x16x32_bf16(af.v, bf.v, acc, 0, 0, 0);
          if (bb == 3) {
            const u32x2 a2 = *(const u32x2*)(nA + (bb * 16 + fr) * 72 + 32 + 4 * fg);
            af.w[0] = a2[0]; af.w[1] = a2[1]; af.w[2] = 0u; af.w[3] = 0u;
            bf.w[0] = pack2(X[ct2][2][0], X[ct2][2][1]); bf.w[1] = pack2(X[ct2][2][2], X[ct2][2][3]); bf.w[2] = 0u; bf.w[3] = 0u;
            acc = __builtin_amdgcn_mfma_f32_16x16x32_bf16(af.v, bf.v, acc, 0, 0, 0);
          }
        }
        {
          union { u32 w[4]; bf16x8 v; } af, bf;
          const u32x2 d0 = *(const u32x2*)(Nb + bb * 256 + fr * 16 + 4 * fg);
          af.w[0] = d0[0]; af.w[1] = d0[1]; af.w[2] = 0u; af.w[3] = 0u;
          bf.w[0] = pack2(acc[0], acc[1]); bf.w[1] = pack2(acc[2], acc[3]); bf.w[2] = 0u; bf.w[3] = 0u;
          const f32x4 z4 = {0.f, 0.f, 0.f, 0.f};
          X[ct2][bb] = __builtin_amdgcn_mfma_f32_16x16x32_bf16(af.v, bf.v, z4, 0, 0, 0);
        }
#pragma unroll
        for (int r = 0; r < 4; ++r) {
          const int i = bb * 16 + 4 * fg + r;
          if (isu) Ug[(tok0 + i) * 512 + h * 128 + cc] = f2bf(X[ct2][bb][r]);
          else Wg[(tok0 + i) * 512 + h * 128 + perm32(cc)] = f2bf(X[ct2][bb][r]);
        }
      }
    }
  }
}

__device__ __forceinline__ void phase2(const Params& p, unsigned char* smem) {
#ifndef NO_IDX
  for (int i = blockIdx.x; i < 2048; i += gridDim.x) idx_item(p, smem, i & 7, 255 - (i >> 3));
#endif
#ifndef NO_DNL
  if (!(p.flags & 1))
    for (int i = blockIdx.x; i < 2048; i += gridDim.x) dn_local_item(p, smem, i);
#endif
}

constexpr int SC_WP = 272, SC_KP = 144;
constexpr int SC_W = 0, SC_Q = 64 * SC_WP, SC_KT = 2 * 64 * SC_WP, SC_AT = SC_KT + 128 * SC_KP, SC_U = SC_AT + 64 * SC_KP,
              SC_BUF = SC_U + 64 * SC_WP;
constexpr int SC_GC = 2 * SC_BUF;
static_assert(SC_GC + 2 * 64 * 4 <= SMEM_BYTES, "scan LDS");

__device__ __forceinline__ void dn_scan_item(const Params& p, unsigned char* smem, int bh) {
  const int h = bh & 3, b = bh >> 2;
  const u16* Ug = (const u16*)((const unsigned char*)p.out + DO_U);
  const u16* Wg = (const u16*)((const unsigned char*)p.out + DO_W);
  const u16* QNg = (const u16*)((const unsigned char*)p.out + DO_QN);
  const u16* KNTg = (const u16*)((const unsigned char*)p.out + DO_KNT);
  const u16* ATTg = (const u16*)(p.ws + OFF_ATT);
  const float* GCg = (const float*)(p.ws + OFF_GC);
  const u16* PROJ = (const u16*)(p.ws + OFF_PROJ);
  u16* YDN = (u16*)(p.ws + OFF_YDN);
  const float* ogain = p.in[8];
  const int tid = TIDX, lane = tid & 63, wave = tid >> 6;
  const int fr = lane & 15, fg = lane >> 4;
  const int ecol = wave * 16 + fr;
  float* gcs = (float*)(smem + SC_GC);
  f32x4 S[8];
#pragma unroll
  for (int d = 0; d < 8; ++d) S[d] = (f32x4){0.f, 0.f, 0.f, 0.f};
  u32x4 st[9];
  float gcr = 0.f;
  const int r16 = tid >> 4, c16 = tid & 15;
  const int r8 = tid >> 3, c8 = tid & 7;
#define SCAN_LOAD(n_)                                                                                      \
  {                                                                                                        \
    const size_t tk0 = (size_t)b * SEQ + (size_t)(n_) * 64;                                                \
    const size_t it_ = (size_t)((b * 64 + (n_)) * 4 + h);                                                  \
    st[0] = *(const u32x4*)(Wg + (tk0 + r16) * 512 + h * 128 + c16 * 8);                                   \
    st[1] = *(const u32x4*)(Wg + (tk0 + r16 + 32) * 512 + h * 128 + c16 * 8);                              \
    st[2] = *(const u32x4*)(QNg + (tk0 + r16) * 512 + h * 128 + c16 * 8);                                  \
    st[3] = *(const u32x4*)(QNg + (tk0 + r16 + 32) * 512 + h * 128 + c16 * 8);                             \
    st[4] = *(const u32x4*)(KNTg + it_ * 8192 + (size_t)tid * 8);                                          \
    st[5] = *(const u32x4*)(KNTg + it_ * 8192 + (size_t)(tid + 512) * 8);                                  \
    st[6] = *(const u32x4*)(ATTg + it_ * 4096 + (size_t)tid * 8);                                          \
    st[7] = *(const u32x4*)(Ug + (tk0 + r16) * 512 + h * 128 + c16 * 8);                                   \
    st[8] = *(const u32x4*)(Ug + (tk0 + r16 + 32) * 512 + h * 128 + c16 * 8);                              \
    if (tid < 64) gcr = GCg[(tk0 + tid) * 4 + h];                                                          \
  }
#define SCAN_STORE(buf_)                                                                                   \
  {                                                                                                        \
    unsigned char* bs_ = smem + (buf_) * SC_BUF;                                                           \
    *(u32x4*)(bs_ + SC_W + r16 * SC_WP + c16 * 16) = st[0];                                                \
    *(u32x4*)(bs_ + SC_W + (r16 + 32) * SC_WP + c16 * 16) = st[1];                                         \
    *(u32x4*)(bs_ + SC_Q + r16 * SC_WP + c16 * 16) = st[2];                                                \
    *(u32x4*)(bs_ + SC_Q + (r16 + 32) * SC_WP + c16 * 16) = st[3];                                         \
    *(u32x4*)(bs_ + SC_KT + r8 * SC_KP + c8 * 16) = st[4];                                                 \
    *(u32x4*)(bs_ + SC_KT + (r8 + 64) * SC_KP + c8 * 16) = st[5];                                          \
    *(u32x4*)(bs_ + SC_AT + r8 * SC_KP + c8 * 16) = st[6];                                                 \
    *(u32x4*)(bs_ + SC_U + r16 * SC_WP + c16 * 16) = st[7];                                                \
    *(u32x4*)(bs_ + SC_U + (r16 + 32) * SC_WP + c16 * 16) = st[8];                                         \
    if (tid < 64) gcs[(buf_) * 64 + tid] = gcr;                                                            \
  }
  __syncthreads();
  SCAN_LOAD(0)
  SCAN_STORE(0)
  if (1 < 64) SCAN_LOAD(1)
  __syncthreads();
  for (int n = 0; n < 64; ++n) {
    const int buf = n & 1;
    const size_t tok0 = (size_t)b * SEQ + n * 64;
    if (n + 1 < 64) SCAN_STORE(buf ^ 1)
    if (n + 2 < 64) SCAN_LOAD(n + 2)
    __builtin_amdgcn_sched_barrier(0);
    const unsigned char* base = smem + buf * SC_BUF;
    const u32 ub0 = (u32)(tok0 + 4 * fg) * 512 + (u32)(h * 128 + ecol);
    const float* gcb = gcs + buf * 64 + 4 * fg;
    const float glast = gcs[buf * 64 + 63];
    bf16x8 Sb[4];
#pragma unroll
    for (int kk = 0; kk < 4; ++kk) {
      union { u32 w[4]; bf16x8 v; } cv;
      cv.w[0] = pack2(S[2 * kk][0], S[2 * kk][1]); cv.w[1] = pack2(S[2 * kk][2], S[2 * kk][3]);
      cv.w[2] = pack2(S[2 * kk + 1][0], S[2 * kk + 1][1]); cv.w[3] = pack2(S[2 * kk + 1][2], S[2 * kk + 1][3]);
      Sb[kk] = cv.v;
    }
    f32x4 vnew[4], ov[4];
#pragma unroll
    for (int m = 0; m < 4; ++m) {
      f32x4 aw = {0.f, 0.f, 0.f, 0.f}, aq = {0.f, 0.f, 0.f, 0.f};
#pragma unroll
      for (int kk = 0; kk < 4; ++kk) {
        bf16x8 wf = *(const bf16x8*)(base + SC_W + (m * 16 + fr) * SC_WP + kk * 64 + fg * 16);
        bf16x8 qf = *(const bf16x8*)(base + SC_Q + (m * 16 + fr) * SC_WP + kk * 64 + fg * 16);
        aw = __builtin_amdgcn_mfma_f32_16x16x32_bf16(wf, Sb[kk], aw, 0, 0, 0);
        aq = __builtin_amdgcn_mfma_f32_16x16x32_bf16(qf, Sb[kk], aq, 0, 0, 0);
      }
      f32x4 g4 = *(const f32x4*)(gcb + m * 16);
#pragma unroll
      for (int r = 0; r < 4; ++r) {
        float uv = bf2f(*(const u16*)(base + SC_U + (m * 16 + 4 * fg + r) * SC_WP + ecol * 2));
        vnew[m][r] = uv - aw[r];
        ov[m][r] = aq[r] * __expf(g4[r]);
      }
    }
    bf16x8 vb[2], vsb[2];
#pragma unroll
    for (int k2 = 0; k2 < 2; ++k2) {
      union { u32 w[4]; bf16x8 v; } c1, c2;
      const int ma = 2 * k2, mb = 2 * k2 + 1;
      c1.w[0] = pack2(vnew[ma][0], vnew[ma][1]); c1.w[1] = pack2(vnew[ma][2], vnew[ma][3]);
      c1.w[2] = pack2(vnew[mb][0], vnew[mb][1]); c1.w[3] = pack2(vnew[mb][2], vnew[mb][3]);
      f32x4 ga4 = *(const f32x4*)(gcb + ma * 16), gb4 = *(const f32x4*)(gcb + mb * 16);
      float sa[4], sb2[4];
#pragma unroll
      for (int r = 0; r < 4; ++r) { sa[r] = vnew[ma][r] * __expf(glast - ga4[r]); sb2[r] = vnew[mb][r] * __expf(glast - gb4[r]); }
      c2.w[0] = pack2(sa[0], sa[1]); c2.w[1] = pack2(sa[2], sa[3]);
      c2.w[2] = pack2(sb2[0], sb2[1]); c2.w[3] = pack2(sb2[2], sb2[3]);
      vb[k2] = c1.v; vsb[k2] = c2.v;
    }
    const float egl = __expf(glast);
#pragma unroll
    for (int d = 0; d < 8; ++d) {
      f32x4 a = S[d] * egl;
#pragma unroll
      for (int k2 = 0; k2 < 2; ++k2) {
        bf16x8 kf = *(const bf16x8*)(base + SC_KT + (d * 16 + fr) * SC_KP + k2 * 64 + fg * 16);
        a = __builtin_amdgcn_mfma_f32_16x16x32_bf16(kf, vsb[k2], a, 0, 0, 0);
      }
      S[d] = a;
    }
#pragma unroll
    for (int m = 0; m < 4; ++m) {
      f32x4 ao = ov[m];
#pragma unroll
      for (int k2 = 0; k2 < 2; ++k2) {
        bf16x8 af = *(const bf16x8*)(base + SC_AT + (m * 16 + fr) * SC_KP + k2 * 64 + fg * 16);
        ao = __builtin_amdgcn_mfma_f32_16x16x32_bf16(af, vb[k2], ao, 0, 0, 0);
      }
#pragma unroll
      for (int r = 0; r < 4; ++r) YDN[ub0 + (u32)((m * 16 + r) * 512)] = f2bf(ao[r]);
    }
    __syncthreads();
  }
#undef SCAN_LOAD
#undef SCAN_STORE
  asm volatile("s_waitcnt vmcnt(0)" ::: "memory");
  __syncthreads();
  {
    const int sub = lane >> 4, l16 = lane & 15;
    float gn8[8];
#pragma unroll
    for (int e = 0; e < 8; ++e) gn8[e] = ogain[l16 * 8 + e];
    for (int t = wave * 4 + sub; t < SEQ; t += 32) {
      const size_t tok = (size_t)b * SEQ + t;
      u16* yp = YDN + tok * 512 + h * 128 + l16 * 8;
      const u32x4 ov4 = *(const u32x4*)yp;
      const u32x4 zv4 = *(const u32x4*)(PROJ + tok * LDP + C_DZ + h * 128 + l16 * 8);
      float o8[8], z8[8];
#pragma unroll
      for (int c = 0; c < 4; ++c) { o8[2 * c] = bflo(ov4[c]); o8[2 * c + 1] = bfhi(ov4[c]); z8[2 * c] = bflo(zv4[c]); z8[2 * c + 1] = bfhi(zv4[c]); }
      float sq = 0.f;
#pragma unroll
      for (int e = 0; e < 8; ++e) sq += o8[e] * o8[e];
      sq += DPPF(sq, 0xb1); sq += DPPF(sq, 0x4e); sq += DPPF(sq, 0x141); sq += DPPF(sq, 0x140);
      const float rstd = rsqrtf(sq * (1.f / 128.f) + EPS);
      u32 w[4];
#pragma unroll
      for (int c = 0; c < 4; ++c) {
        const float y0 = o8[2 * c] * rstd * gn8[2 * c] * z8[2 * c] * sigmoidf_(z8[2 * c]);
        const float y1 = o8[2 * c + 1] * rstd * gn8[2 * c + 1] * z8[2 * c + 1] * sigmoidf_(z8[2 * c + 1]);
        w[c] = pack2(y0, y1);
      }
      *(u32x4*)yp = (u32x4){w[0], w[1], w[2], w[3]};
    }
  }
}

constexpr int AT_WAVE_BYTES = 8192 + 512 + 8192;
__device__ __forceinline__ float xor16_sum(float v) {
  auto r = __builtin_amdgcn_permlane16_swap(__float_as_uint(v), __float_as_uint(v), false, false);
  return __uint_as_float(r[0]) + __uint_as_float(r[1]);
}
__device__ __forceinline__ float xor32_sum(float v) {
  auto r = __builtin_amdgcn_permlane32_swap(__float_as_uint(v), __float_as_uint(v), false, false);
  return __uint_as_float(r[0]) + __uint_as_float(r[1]);
}
__device__ __forceinline__ u32 fp8x4(float a, float b, float c, float d) {
  int w = __builtin_amdgcn_cvt_pk_fp8_f32(a, b, 0, false);
  w = __builtin_amdgcn_cvt_pk_fp8_f32(c, d, w, true);
  return (u32)w;
}
__device__ __forceinline__ void attn_query(const Params& p, unsigned char* wsm, int b, int t) {
  typedef long i64;
  typedef int i32x2 __attribute__((ext_vector_type(2)));
  typedef __attribute__((address_space(3))) i32x2 lds_i32x2;
  const u16* PROJ = (const u16*)(p.ws + OFF_PROJ);
  const u16* SEL = (const u16*)(p.ws + OFF_SEL);
  const unsigned char* KVC8 = p.ws + OFF_KVC;
  u16* YATT = (u16*)(p.ws + OFF_YATT);
  const int lane = TIDX & 63;
  const int fr = lane & 15, fg = lane >> 4;
  float* P = (float*)wsm;
  u16* sl = (u16*)(wsm + 8192);
  const size_t tokb = (size_t)b * SEQ;
  const size_t tok = tokb + t;
  const int nsel = min(256, t + 1);
  i64 qb[2][2];
  {
    const u16* qrow = PROJ + tok * LDP + C_AQ + (fr & 3) * 64 + fg * 8;
#pragma unroll
    for (int g = 0; g < 2; ++g)
#pragma unroll
      for (int kk = 0; kk < 2; ++kk) {
        const u32x4 v = *(const u32x4*)(qrow + g * 256 + kk * 32);
        const u32 lo = fp8x4(bflo(v[0]) * 16.f, bfhi(v[0]) * 16.f, bflo(v[1]) * 16.f, bfhi(v[1]) * 16.f);
        const u32 hi = fp8x4(bflo(v[2]) * 16.f, bfhi(v[2]) * 16.f, bflo(v[3]) * 16.f, bfhi(v[3]) * 16.f);
        const i64 w = (i64)(((unsigned long long)hi << 32) | (unsigned long long)lo);
        qb[g][kk] = (fr < 4) ? w : (i64)0;
      }
    const u16* sr = SEL + tok * 256;
#pragma unroll
    for (int i = 0; i < 4; ++i) sl[lane + 64 * i] = sr[lane + 64 * i];
  }
  WAVE_LDS_SYNC();
  const int ngrp = (nsel + 15) >> 4;
  const int nbq = (ngrp + 1) >> 1;
  unsigned char* KST = wsm + 8192 + 512;
  const int kq = lane >> 3, kch = lane & 7;
  u32x4 kA[2][2], kB[2][2];
#define QK_LOAD(buf_, bi_)                                                                       \
  _Pragma("unroll") for (int j = 0; j < 2; ++j)                                                  \
    _Pragma("unroll") for (int hf = 0; hf < 2; ++hf) {                                           \
      const int ki_ = min(((bi_) * 2 + j) * 16 + hf * 8 + kq, 255);                              \
      const int s_ = (int)sl[ki_] & 4095;                                                        \
      buf_[j][hf] = *(const u32x4*)(KVC8 + (tokb + s_) * 256 + kch * 16);                        \
    }
#define QK_COMPUTE(buf_, bi_)                                                                    \
  {                                                                                              \
    _Pragma("unroll") for (int j = 0; j < 2; ++j)                                                \
      _Pragma("unroll") for (int hf = 0; hf < 2; ++hf) {                                         \
        const int row_ = hf * 8 + kq;                                                            \
        *(u32x4*)(KST + j * 2048 + row_ * 128 + ((kch ^ (row_ & 7)) << 4)) = buf_[j][hf];        \
      }                                                                                          \
    WAVE_LDS_SYNC();                                                                             \
    _Pragma("unroll") for (int j = 0; j < 2; ++j) {                                              \
      const unsigned char* kr_ = KST + j * 2048 + fr * 128 + 8 * (fg & 1);                       \
      const int sw_ = fr & 7, ch_ = fg >> 1;                                                     \
      const i64 a00_ = *(const i64*)(kr_ + (((0 + ch_) ^ sw_) << 4));                            \
      const i64 a01_ = *(const i64*)(kr_ + (((2 + ch_) ^ sw_) << 4));                            \
      const i64 a10_ = *(const i64*)(kr_ + (((4 + ch_) ^ sw_) << 4));                            \
      const i64 a11_ = *(const i64*)(kr_ + (((6 + ch_) ^ sw_) << 4));                            \
      f32x4 c0_ = {0.f, 0.f, 0.f, 0.f}, c1_ = {0.f, 0.f, 0.f, 0.f};                              \
      c0_ = __builtin_amdgcn_mfma_f32_16x16x32_fp8_fp8(a00_, qb[0][0], c0_, 0, 0, 0);            \
      c0_ = __builtin_amdgcn_mfma_f32_16x16x32_fp8_fp8(a01_, qb[0][1], c0_, 0, 0, 0);            \
      c1_ = __builtin_amdgcn_mfma_f32_16x16x32_fp8_fp8(a10_, qb[1][0], c1_, 0, 0, 0);            \
      c1_ = __builtin_amdgcn_mfma_f32_16x16x32_fp8_fp8(a11_, qb[1][1], c1_, 0, 0, 0);            \
      if (fr < 4) {                                                                              \
        _Pragma("unroll") for (int r = 0; r < 4; ++r) {                                          \
          const int kk2_ = ((bi_) * 2 + j) * 16 + 4 * fg + r;                                    \
          if (kk2_ < 256) {                                                                      \
            const bool v_ = kk2_ < nsel;                                                         \
            P[kk2_ * 8 + fr] = v_ ? c0_[r] * 0.0625f : -1e30f;                                   \
            P[kk2_ * 8 + 4 + fr] = v_ ? c1_[r] * 0.0625f : -1e30f;                               \
          }                                                                                      \
        }                                                                                        \
      }                                                                                          \
    }                                                                                            \
    WAVE_LDS_SYNC();                                                                             \
  }
  QK_LOAD(kA, 0)
  for (int bi = 0; bi < nbq; bi += 2) {
    if (bi + 1 < nbq) { QK_LOAD(kB, bi + 1) }
    QK_COMPUTE(kA, bi)
    if (bi + 2 < nbq) { QK_LOAD(kA, bi + 2) }
    if (bi + 1 < nbq) { QK_COMPUTE(kB, bi + 1) }
  }
#undef QK_LOAD
#undef QK_COMPUTE
  for (int ki = nbq * 32 + lane; ki < 256; ki += 64) {
    *(f32x4*)(P + ki * 8) = (f32x4){-1e30f, -1e30f, -1e30f, -1e30f};
    *(f32x4*)(P + ki * 8 + 4) = (f32x4){-1e30f, -1e30f, -1e30f, -1e30f};
  }
  WAVE_LDS_SYNC();
  float inv8[8];
  {
    float lg[4][8];
#pragma unroll
    for (int i = 0; i < 4; ++i) {
      f32x4 x0 = *(const f32x4*)(P + (lane + 64 * i) * 8), x1 = *(const f32x4*)(P + (lane + 64 * i) * 8 + 4);
      lg[i][0] = x0[0]; lg[i][1] = x0[1]; lg[i][2] = x0[2]; lg[i][3] = x0[3];
      lg[i][4] = x1[0]; lg[i][5] = x1[1]; lg[i][6] = x1[2]; lg[i][7] = x1[3];
    }
    WAVE_LDS_SYNC();
    unsigned char* PT8 = (unsigned char*)P;
#pragma unroll
    for (int hh = 0; hh < 8; ++hh) {
      float m = fmaxf(fmaxf(lg[0][hh], lg[1][hh]), fmaxf(lg[2][hh], lg[3][hh]));
      m = wave_max_dpp(m);
      float e[4], sum = 0.f;
#pragma unroll
      for (int i = 0; i < 4; ++i) { e[i] = __expf(lg[i][hh] - m); sum += e[i]; }
      sum = wave_sum_dpp(sum);
      inv8[hh] = __builtin_amdgcn_rcpf(sum) * (1.f / 256.f);
      const u32 w = fp8x4(e[0] * 256.f, e[1] * 256.f, e[2] * 256.f, e[3] * 256.f);
#pragma unroll
      for (int i = 0; i < 4; ++i) PT8[hh * 256 + lane + 64 * i] = (unsigned char)((w >> (8 * i)) & 0xffu);
    }
  }
  WAVE_LDS_SYNC();
  {
    const unsigned char* PT8 = (const unsigned char*)P;
    unsigned char* VST = wsm + 8192 + 512;
    const int trow = (lane & 15) >> 1, thalf = lane & 1;
    f32x4 oacc[2][4];
#pragma unroll
    for (int g = 0; g < 2; ++g)
#pragma unroll
      for (int c = 0; c < 4; ++c) oacc[g][c] = (f32x4){0.f, 0.f, 0.f, 0.f};
    const int nks = (nsel + 31) >> 5;
    u32x4 vA[4], vB[4];
#define PV_LOAD(buf_, ks_)                                                                       \
  _Pragma("unroll") for (int i = 0; i < 4; ++i) {                                                \
    const int ki_ = min((ks_) * 32 + i * 8 + kq, 255);                                           \
    const int s_ = (int)sl[ki_] & 4095;                                                          \
    buf_[i] = *(const u32x4*)(KVC8 + (tokb + s_) * 256 + 128 + kch * 16);                        \
  }
#define PV_COMPUTE(buf_, ks_)                                                                    \
  {                                                                                              \
    _Pragma("unroll") for (int i = 0; i < 4; ++i) {                                              \
      const int key_ = i * 8 + kq;                                                               \
      *(u32x4*)(VST + key_ * 128 + ((kch ^ (key_ & 7)) << 4)) = buf_[i];                         \
    }                                                                                            \
    WAVE_LDS_SYNC();                                                                             \
    i64 pa_[2];                                                                                  \
    _Pragma("unroll") for (int g = 0; g < 2; ++g) {                                              \
      const i64 t_ = *(const i64*)(PT8 + (g * 4 + (fr & 3)) * 256 + (ks_) * 32 + 8 * fg);        \
      pa_[g] = (fr < 4) ? t_ : (i64)0;                                                           \
    }                                                                                            \
    const int r1_ = 8 * fg + trow;                                                               \
    _Pragma("unroll") for (int g = 0; g < 2; ++g)                                                \
      _Pragma("unroll") for (int c = 0; c < 4; ++c) {                                            \
        const i32x2 tv_ = __builtin_amdgcn_ds_read_tr8_b64_v2i32((lds_i32x2*)(VST + r1_ * 128 + (((g * 4 + c) ^ (r1_ & 7)) << 4) + 8 * thalf)); \
        const i64 vb_ = (i64)(((unsigned long long)(u32)tv_[1] << 32) | (unsigned long long)(u32)tv_[0]); \
        oacc[g][c] = __builtin_amdgcn_mfma_f32_16x16x32_fp8_fp8(pa_[g], vb_, oacc[g][c], 0, 0, 0); \
      }                                                                                          \
    WAVE_LDS_SYNC();                                                                             \
  }
    PV_LOAD(vA, 0)
    for (int ks = 0; ks < nks; ks += 2) {
      if (ks + 1 < nks) { PV_LOAD(vB, ks + 1) }
      PV_COMPUTE(vA, ks)
      if (ks + 2 < nks) { PV_LOAD(vA, ks + 2) }
      if (ks + 1 < nks) { PV_COMPUTE(vB, ks + 1) }
    }
#undef PV_LOAD
#undef PV_COMPUTE
    if (lane < 16) {
#pragma unroll
      for (int g = 0; g < 2; ++g)
#pragma unroll
        for (int c = 0; c < 4; ++c)
#pragma unroll
          for (int r = 0; r < 4; ++r)
            YATT[tok * 512 + (g * 4 + r) * 64 + 16 * c + fr] = f2bf(oacc[g][c][r] * inv8[g * 4 + r]);
    }
  }
  WAVE_LDS_SYNC();
}

__device__ __forceinline__ void phase3(const Params& p, unsigned char* smem) {
  const int wave = TIDX >> 6;
#ifndef NO_SCAN
  if (blockIdx.x < 32) {
    if (!(p.flags & 2)) dn_scan_item(p, smem, blockIdx.x);
    __syncthreads();
  }
#endif
#ifdef NO_ATTN
  return;
#endif
  if (p.flags & 4) return;
  unsigned* qctr = (unsigned*)(p.ws + 1024 + ((p.flags & 128) ? 4096 : 0));
  const unsigned xcc = (unsigned)__builtin_amdgcn_s_getreg((3 << 11) | 20) & 7u;
  unsigned char* wsm = smem + wave * AT_WAVE_BYTES;
  for (unsigned db = 0; db < 8; ++db) {
    const int bb = (int)((xcc + db) & 7u);
    for (;;) {
      unsigned qi = 0;
      if ((TIDX & 63) == 0) qi = __hip_atomic_fetch_add(qctr + bb * 16, 1u, __ATOMIC_RELAXED, __HIP_MEMORY_SCOPE_AGENT);
      qi = (unsigned)__builtin_amdgcn_readfirstlane((int)qi);
      if (qi >= (unsigned)SEQ) break;
      attn_query(p, wsm, bb, SEQ - 1 - (int)qi);
    }
  }
}

__device__ __forceinline__ void hblk_load(unsigned char* reg, const u16* __restrict__ src, u32 ob, u32 ld, int lane) {
  const int c16 = lane & 7, r8 = lane >> 3;
#pragma unroll
  for (int it = 0; it < 8; ++it) {
    const int rl = it * 8 + r8;
    const u32x4 v = *(const u32x4*)(src + ob + (u32)rl * ld + (u32)(c16 * 8));
    *(u32x4*)(reg + rl * 128 + (((c16 + 2 * ((rl >> 2) & 3)) & 7) << 4)) = v;
    if ((it & 3) == 3) __builtin_amdgcn_sched_barrier(0);
  }
}
__device__ __forceinline__ void hblk_store(const unsigned char* reg, u16* __restrict__ dst, u32 ob, u32 ld, int lane) {
  const int c16 = lane & 7, r8 = lane >> 3;
#pragma unroll
  for (int it = 0; it < 8; ++it) {
    const int rl = it * 8 + r8;
    const u32x4 v = *(const u32x4*)(reg + rl * 128 + (((c16 + 2 * ((rl >> 2) & 3)) & 7) << 4));
    *(u32x4*)(dst + ob + (u32)rl * ld + (u32)(c16 * 8)) = v;
  }
}
__device__ __forceinline__ void phase4(const Params& p, unsigned char* smem) {
  const u16* YATT = (const u16*)(p.ws + OFF_YATT);
  const u16* YDN = (const u16*)(p.ws + OFF_YDN);
  const u16* WTA = (const u16*)(p.ws + OFF_WTA);
  const u16* WTB = (const u16*)(p.ws + OFF_WTB);
  const u16* PROJ = (const u16*)(p.ws + OFF_PROJ);
  u16* MG = (u16*)(p.ws + OFF_MERGED);
  const int ntn = DM / 256, ntiles = (MTOK / 256) * ntn;
  for (int t = blockIdx.x; t < ntiles; t += gridDim.x) {
    const int m0 = (t / ntn) * 256, n0 = (t % ntn) * 256;
    f32x4 acc[2][2][4][2];
#pragma unroll
    for (int pass = 0; pass < 2; ++pass) {
      gemm8_tile(pass ? YDN : YATT, pass ? WTB : WTA, 512, m0, n0, smem, acc);
      int lane = TIDX & 63;
      asm volatile("" : "+v"(lane));
      const int wave = TIDX >> 6, wr = wave >> 2, wc = wave & 3, fr = lane & 15, fq = lane >> 4;
      unsigned char* regG = smem + wave * 16384;
      unsigned char* regT = regG + 8192;
      const int lrot = (fr >> 3) + 2 * fq;
      int off4[4];
#pragma unroll
      for (int jj = 0; jj < 4; ++jj) off4[jj] = (4 * fq) * 128 + (fr & 7) * 2 + (((jj * 2 + lrot) & 7) << 4);
#pragma unroll
      for (int ai = 0; ai < 2; ++ai) {
        const u32 gb0 = (u32)(m0 + ai * 128 + wr * 64) * LDP + (u32)(n0 + wc * 64) + (u32)(pass ? C_GB : C_GA);
        const u32 ob0 = (u32)(m0 + ai * 128 + wr * 64) * DM + (u32)(n0 + wc * 64);
        hblk_load(regG, PROJ, gb0, LDP, lane);
        if (pass == 1) hblk_load(regT, MG, ob0, DM, lane);
        WAVE_LDS_SYNC();
#pragma unroll
        for (int m = 0; m < 4; ++m)
#pragma unroll
          for (int r = 0; r < 4; ++r)
#pragma unroll
            for (int bj = 0; bj < 2; ++bj)
#pragma unroll
              for (int n = 0; n < 2; ++n) {
                const int o = off4[bj * 2 + n] + (m * 16 + r) * 128;
                float v = sigmoidf_(bf2f(*(const u16*)(regG + o))) * acc[ai][bj][m][n][r];
                if (pass == 1) v += bf2f(*(const u16*)(regT + o));
                *(u16*)(regT + o) = f2bf(v);
              }
        WAVE_LDS_SYNC();
        hblk_store(regT, MG, ob0, DM, lane);
        WAVE_LDS_SYNC();
      }
      asm volatile("s_waitcnt vmcnt(0)" ::: "memory");
    }
  }
}

__device__ __forceinline__ void phase5(const Params& p, unsigned char* smem) {
  const u16* MG = (const u16*)(p.ws + OFF_MERGED);
  const u16* WTO = (const u16*)(p.ws + OFF_WTO);
  const float* x = p.in[0];
  const int lane = TIDX & 63, wave = TIDX >> 6;
  const int wr = wave >> 2, wc = wave & 3, fr = lane & 15, fq = lane >> 4;
  const int ntn = DM / 256, ntiles = (MTOK / 256) * ntn;
  for (int t = blockIdx.x; t < ntiles; t += gridDim.x) {
    const int m0 = (t / ntn) * 256, n0 = (t % ntn) * 256;
    f32x4 acc[2][2][4][2];
    gemm8_tile(MG, WTO, DM, m0, n0, smem, acc);
    const u32 ob0 = (u32)(m0 + wr * 64 + 4 * fq) * DM + (u32)(n0 + wc * 64 + fr);
    float* outp = p.out;
#pragma unroll
    for (int ai = 0; ai < 2; ++ai)
#pragma unroll
      for (int m = 0; m < 4; ++m) {
#pragma unroll
        for (int bj = 0; bj < 2; ++bj)
#pragma unroll
          for (int n = 0; n < 2; ++n)
#pragma unroll
            for (int j = 0; j < 4; ++j) {
              u32 o = ob0 + (u32)((ai * 128 + m * 16 + j) * DM + (bj * 2 + n) * 16);
              outp[o] = x[o] + acc[ai][bj][m][n][j];
            }
        __builtin_amdgcn_sched_barrier(0);
      }
  }
}

__device__ __forceinline__ void phase6(const Params& p, unsigned char* smem) {
  const u16* H2 = (const u16*)(p.ws + OFF_H2);
  const u16* WTQ = (const u16*)(p.ws + OFF_WTQ);
  u16* QP = (u16*)(p.ws + OFF_QP);
  const int lane = TIDX & 63, wave = TIDX >> 6;
  const int wr = wave >> 2, wc = wave & 3, fr = lane & 15, fq = lane >> 4;
  const int ntn = 2048 / 256, ntiles = (MTOK / 256) * ntn;
  for (int t = blockIdx.x; t < ntiles; t += gridDim.x) {
    const int m0 = (t / ntn) * 256, n0 = (t % ntn) * 256;
    f32x4 acc[2][2][4][2];
    gemm8_tile(H2, WTQ, DM, m0, n0, smem, acc);
    ep_store<2048, false>(QP, (u32)(m0 + wr * 64) * 2048 + (u32)(n0 + wc * 64), acc, nullptr, 1.f, smem, wave, lane);
  }
}

__device__ __forceinline__ int mono_key(float v) { int b = __float_as_int(v); return b ^ ((b >> 31) & 0x7fffffff); }
__device__ __forceinline__ float unmono_key(int k) { return __int_as_float(k ^ ((k >> 31) & 0x7fffffff)); }
__device__ __forceinline__ void chain16(int (&k)[16], int x) {
#pragma unroll
  for (int j = 0; j < 16; ++j) { int hi = max(k[j], x); x = min(k[j], x); k[j] = hi; }
}

#define CE_DESC(a, b) { const int hi_ = max(a, b), lo_ = min(a, b); a = hi_; b = lo_; }
__device__ __forceinline__ void sort16_desc(int (&k)[16]) {
#pragma unroll
  for (int size = 2; size <= 16; size <<= 1) {
#pragma unroll
    for (int stride = size >> 1; stride > 0; stride >>= 1) {
#pragma unroll
      for (int i = 0; i < 16; ++i) {
        const int l = i ^ stride;
        if (l > i) {
          if ((i & size) == 0) CE_DESC(k[i], k[l]) else CE_DESC(k[l], k[i])
        }
      }
    }
  }
}
__device__ __forceinline__ void merge_top16(int (&a)[16], const int (&b)[16]) {
#pragma unroll
  for (int i = 0; i < 16; ++i) a[i] = max(a[i], b[15 - i]);
#pragma unroll
  for (int stride = 8; stride > 0; stride >>= 1) {
#pragma unroll
    for (int i = 0; i < 16; ++i) {
      const int l = i ^ stride;
      if (l > i) CE_DESC(a[i], a[l])
    }
  }
}

constexpr int P7_LD = 132;
__device__ __forceinline__ void phase7(const Params& p, unsigned char* smem) {
  const u16* QP = (const u16*)(p.ws + OFF_QP);
  const u16* SKB = (const u16*)(p.ws + OFF_SKB);
  float* TOPS = (float*)(p.ws + OFF_TOPS);
  u8* TOPI = (u8*)(p.ws + OFF_TOPI);
  const int tid = TIDX, lane = tid & 63, wave = tid >> 6;
  const int wm = wave >> 1, wn = wave & 1, fr = lane & 15, fg = lane >> 4;
  const int ntiles = (MTOK / G_BM) * 16;
  float* tile = (float*)smem;
  for (int t = blockIdx.x; t < ntiles; t += gridDim.x) {
    const int m0 = (t >> 4) * G_BM, hp = t & 15;
    f32x4 acc[4][4];
    gemm_mainloop(QP + hp * 128, 2048, SKB + (size_t)hp * 128 * 128, 128, 128, m0, 0, smem, acc);
#pragma unroll
    for (int i = 0; i < 4; ++i)
#pragma unroll
      for (int j = 0; j < 4; ++j)
#pragma unroll
        for (int r = 0; r < 4; ++r) {
          int row = wm * 64 + i * 16 + 4 * fg + r, col = wn * 64 + j * 16 + fr;
          tile[row * P7_LD + col] = acc[i][j][r];
        }
    __syncthreads();
    {
      const int row = tid >> 1, half = tid & 1;
      int k[16];
      const float* rowp = tile + row * P7_LD + half * 64;
#pragma unroll
      for (int grp = 0; grp < 4; ++grp) {
        int gk[16];
#pragma unroll
        for (int c = 0; c < 16; c += 4) {
          f32x4 v = *(const f32x4*)(rowp + grp * 16 + c);
          const int ib = 127 - (half * 64 + grp * 16 + c);
          gk[c] = (mono_key(v[0]) & ~127) | ib;
          gk[c + 1] = (mono_key(v[1]) & ~127) | (ib - 1);
          gk[c + 2] = (mono_key(v[2]) & ~127) | (ib - 2);
          gk[c + 3] = (mono_key(v[3]) & ~127) | (ib - 3);
        }
        sort16_desc(gk);
        if (grp == 0) {
#pragma unroll
          for (int j = 0; j < 16; ++j) k[j] = gk[j];
        } else merge_top16(k, gk);
      }
      {
        int other[16];
#pragma unroll
        for (int j = 0; j < 16; ++j) other[j] = DPPI(k[j], 0xb1);
        merge_top16(k, other);
      }
      if (half == 0) {
        size_t o = ((size_t)(m0 + row) * 16 + hp) * 16;
        float vals[16]; int idx[16];
#pragma unroll
        for (int j = 0; j < 16; ++j) { idx[j] = 127 - (k[j] & 127); vals[j] = tile[row * P7_LD + idx[j]]; }
#pragma unroll
        for (int j = 0; j < 16; j += 4) *(f32x4*)(TOPS + o + j) = (f32x4){vals[j], vals[j + 1], vals[j + 2], vals[j + 3]};
#pragma unroll
        for (int j = 0; j < 16; j += 4)
          *(u32*)(TOPI + o + j) = (u32)idx[j] | ((u32)idx[j + 1] << 8) | ((u32)idx[j + 2] << 16) | ((u32)idx[j + 3] << 24);
      }
    }
    __syncthreads();
  }
}

__device__ __forceinline__ void phase7b(const Params& p) {
  const float* TOPS = (const float*)(p.ws + OFF_TOPS);
  const u8* TOPI = (const u8*)(p.ws + OFF_TOPI);
  int* EXPERT = (int*)(p.ws + OFF_EXPERT);
  float* GATE = (float*)(p.ws + OFF_GATE);
  for (int w = blockIdx.x * NTHREADS + TIDX; w < MTOK * 8; w += gridDim.x * NTHREADS) {
    const size_t o = (size_t)w * 32;
    float sa[16], sb[16];
#pragma unroll
    for (int k = 0; k < 16; k += 4) {
      float4 v = *(const float4*)(TOPS + o + k); sa[k] = v.x; sa[k + 1] = v.y; sa[k + 2] = v.z; sa[k + 3] = v.w;
      float4 u = *(const float4*)(TOPS + o + 16 + k); sb[k] = u.x; sb[k + 1] = u.y; sb[k + 2] = u.z; sb[k + 3] = u.w;
    }
    int cand[64];
#pragma unroll
    for (int k = 0; k < 64; ++k) cand[k] = (int)0x80000000;
    {
      int cnt = 0;
#pragma unroll
      for (int a = 0; a < 16; ++a)
#pragma unroll
        for (int bb = 0; bb < 16; ++bb)
          if ((a + 1) * (bb + 1) <= 16) { cand[cnt] = (mono_key(sa[a] + sb[bb]) & ~255) | (255 - (a * 16 + bb)); ++cnt; }
    }
    int kk[16];
#pragma unroll
    for (int grp = 0; grp < 4; ++grp) {
      int gk[16];
#pragma unroll
      for (int j = 0; j < 16; ++j) gk[j] = cand[grp * 16 + j];
      sort16_desc(gk);
      if (grp == 0) {
#pragma unroll
        for (int j = 0; j < 16; ++j) kk[j] = gk[j];
      } else merge_top16(kk, gk);
    }
    float vals[16];
#pragma unroll
    for (int k = 0; k < 16; ++k) vals[k] = unmono_key(kk[k] & ~255);
    float m = vals[0], s = 0.f, e[16];
#pragma unroll
    for (int k = 0; k < 16; ++k) { e[k] = __expf(vals[k] - m); s += e[k]; }
    float inv = 1.f / s;
#pragma unroll
    for (int k = 0; k < 16; ++k) {
      const int ci = 255 - (kk[k] & 255);
      int a = ci >> 4, bb = ci & 15;
      int ex = (int)TOPI[o + a] * 128 + (int)TOPI[o + 16 + bb];
      EXPERT[(size_t)w * 16 + k] = ex;
      GATE[(size_t)w * 16 + k] = e[k] * inv;
    }
  }
  {
    const int lane = TIDX & 63, wave = TIDX >> 6;
    for (int row = blockIdx.x * 8 + wave; row < 2 * 16384; row += gridDim.x * 8) {
      const int tbl = row >> 14, r = row & 16383;
      const f32x4* src = (const f32x4*)((tbl ? p.in[16] : p.in[15]) + (size_t)r * DM) + 4 * lane;
      f32x4 x[4];
      float amax = 0.f;
#pragma unroll
      for (int i = 0; i < 4; ++i) {
        x[i] = src[i];
        amax = fmaxf(amax, fmaxf(fmaxf(fabsf(x[i][0]), fabsf(x[i][1])), fmaxf(fabsf(x[i][2]), fabsf(x[i][3]))));
      }
      amax = wave_max_dpp(amax);
      const float inv = amax > 0.f ? 127.f / amax : 0.f;
      const int bias = 0;
      u32x4 o;
#pragma unroll
      for (int i = 0; i < 4; ++i) {
        int q0 = (int)rintf(x[i][0] * inv) + bias, q1 = (int)rintf(x[i][1] * inv) + bias;
        int q2 = (int)rintf(x[i][2] * inv) + bias, q3 = (int)rintf(x[i][3] * inv) + bias;
        o[i] = (u32)(q0 & 0xff) | ((u32)(q1 & 0xff) << 8) | ((u32)(q2 & 0xff) << 16) | ((u32)(q3 & 0xff) << 24);
      }
      *(u32x4*)(p.ws + (tbl ? OFF_VQ : OFF_UQ) + ((size_t)(lane >> 3) * 16384 + r) * 128 + (lane & 7) * 16) = o;
      if (lane == 0) ((float*)(p.ws + (tbl ? OFF_VS : OFF_US)))[r] = amax * (1.f / 127.f);
    }
  }
}

__device__ __forceinline__ void phase8a(const Params& p) {
  const int* EXPERT = (const int*)(p.ws + OFF_EXPERT);
  const unsigned char* UQS = p.ws + OFF_UQ;
  const unsigned char* H2Q = p.ws + OFF_H2Q;
  int* PD = (int*)(p.ws + OFF_PD);
  unsigned* ctr = (unsigned*)(p.ws + 2048 + ((p.flags & 128) ? 4096 : 0));
  const unsigned xcc = (unsigned)__builtin_amdgcn_s_getreg((3 << 11) | 20) & 7u;
  const int lane = TIDX & 63, g8 = lane >> 3, l8 = lane & 7;
  for (unsigned db = 0; db < 8; ++db) {
    const int x = (int)((xcc + db) & 7u);
    for (;;) {
      unsigned ci = 0;
      if (lane == 0) ci = __hip_atomic_fetch_add(ctr + x * 16, 1u, __ATOMIC_RELAXED, __HIP_MEMORY_SCOPE_AGENT);
      ci = (unsigned)__builtin_amdgcn_readfirstlane((int)ci);
      if (ci >= (unsigned)(MTOK / 16)) break;
#pragma unroll 1
      for (int tt = 0; tt < 16; ++tt) {
        const int tok = (int)ci * 16 + tt;
        const int e0 = EXPERT[(size_t)tok * 128 + lane], e1 = EXPERT[(size_t)tok * 128 + 64 + lane];
        const u32x4 hq = *(const u32x4*)(H2Q + (size_t)tok * DM + x * 128 + l8 * 16);
        u32x4 ua[16];
#pragma unroll
        for (int i = 0; i < 16; ++i) {
          const int k = i * 8 + g8;
          const int ek = __shfl(i < 8 ? e0 : e1, k & 63);
          ua[i] = *(const u32x4*)(UQS + ((size_t)(x * 16384 + ek)) * 128 + l8 * 16);
        }
        int keep0 = 0, keep1 = 0;
#pragma unroll
        for (int i = 0; i < 16; ++i) {
          int sd = 0;
#pragma unroll
          for (int c = 0; c < 4; ++c) sd = __builtin_amdgcn_sdot4((int)ua[i][c], (int)hq[c], sd, false);
          sd += DPPI(sd, 0xb1); sd += DPPI(sd, 0x4e); sd += DPPI(sd, 0x141);
          if (i < 8) keep0 = (l8 == (i & 7)) ? sd : keep0; else keep1 = (l8 == (i & 7)) ? sd : keep1;
        }
        int* pd = PD + ((size_t)x * MTOK + tok) * 128 + l8 * 8 + g8;
        pd[0] = keep0; pd[64] = keep1;
      }
    }
  }
}

__device__ __forceinline__ void phase8c(const Params& p) {
  const int* EXPERT = (const int*)(p.ws + OFF_EXPERT);
  const float* GATE = (const float*)(p.ws + OFF_GATE);
  const float* US = (const float*)(p.ws + OFF_US);
  const float* VS = (const float*)(p.ws + OFF_VS);
  const float* HS = (const float*)(p.ws + OFF_HS);
  const int* PD = (const int*)(p.ws + OFF_PD);
  unsigned char* CQ8 = p.ws + OFF_CQ8;
  float* QSC = (float*)(p.ws + OFF_QSC);
  const int lane = TIDX & 63, wave = TIDX >> 6;
  for (int tok = blockIdx.x * 8 + wave; tok < MTOK; tok += gridDim.x * 8) {
    const int e0 = EXPERT[(size_t)tok * 128 + lane], e1 = EXPERT[(size_t)tok * 128 + 64 + lane];
    const float g0 = GATE[(size_t)tok * 128 + lane], g1 = GATE[(size_t)tok * 128 + 64 + lane];
    int s0 = 0, s1 = 0;
#pragma unroll
    for (int xx = 0; xx < 8; ++xx) {
      s0 += PD[((size_t)xx * MTOK + tok) * 128 + lane];
      s1 += PD[((size_t)xx * MTOK + tok) * 128 + 64 + lane];
    }
    const float hs = HS[tok];
    const float d0 = (float)s0 * US[e0] * hs, d1 = (float)s1 * US[e1] * hs;
    const float cf0 = g0 * 0.5f * d0 * (1.f + erff(d0 * 0.70710678118654752f)) * VS[e0];
    const float cf1 = g1 * 0.5f * d1 * (1.f + erff(d1 * 0.70710678118654752f)) * VS[e1];
    const float cmax = wave_max_dpp(fmaxf(fabsf(cf0), fabsf(cf1)));
    const float qinv = cmax > 0.f ? 32639.f / cmax : 0.f;
    const int c0 = (int)rintf(cf0 * qinv), c1 = (int)rintf(cf1 * qinv);
    const int h0 = (c0 + 128) >> 8, h1 = (c1 + 128) >> 8;
    unsigned char* cq = CQ8 + (size_t)tok * 256;
    cq[lane] = (unsigned char)(h0 & 0xff); cq[64 + lane] = (unsigned char)(h1 & 0xff);
    cq[128 + lane] = (unsigned char)((c0 - 256 * h0) & 0xff); cq[192 + lane] = (unsigned char)((c1 - 256 * h1) & 0xff);
    if (lane == 0) QSC[tok] = cmax * (1.f / 32639.f);
  }
}

#ifndef TR8_VARIANT
#define TR8_VARIANT 0
#endif
__device__ __forceinline__ void phase8b(const Params& p, unsigned char* smem) {
  typedef int i32x4 __attribute__((ext_vector_type(4)));
  typedef int i32x2 __attribute__((ext_vector_type(2)));
  typedef __attribute__((address_space(3))) i32x2 lds_i32x2;
  const int* EXPERT = (const int*)(p.ws + OFF_EXPERT);
  const unsigned char* VQS = p.ws + OFF_VQ;
  const unsigned char* CQ8 = p.ws + OFF_CQ8;
  const float* QSC = (const float*)(p.ws + OFF_QSC);
  unsigned* ctr = (unsigned*)(p.ws + 3072 + ((p.flags & 128) ? 4096 : 0));
  const unsigned xcc = (unsigned)__builtin_amdgcn_s_getreg((3 << 11) | 20) & 7u;
  const int lane = TIDX & 63, wave = TIDX >> 6, g8 = lane >> 3, l8 = lane & 7;
  const int fr = lane & 15, fg = lane >> 4;
  unsigned char* VST = smem + wave * 16384;
#if TR8_VARIANT == 0
  const int trow = (lane & 15) >> 1, thalf = lane & 1;
#else
  const int trow = lane & 7, thalf = (lane & 15) >> 3;
#endif
  __syncthreads();
  for (unsigned db = 0; db < 8; ++db) {
    const int x = (int)((xcc + db) & 7u);
    for (;;) {
      unsigned ci = 0;
      if (lane == 0) ci = __hip_atomic_fetch_add(ctr + x * 16, 1u, __ATOMIC_RELAXED, __HIP_MEMORY_SCOPE_AGENT);
      ci = (unsigned)__builtin_amdgcn_readfirstlane((int)ci);
      if (ci >= (unsigned)(MTOK / 16)) break;
#pragma unroll 1
      for (int tt = 0; tt < 16; ++tt) {
        const int tok = (int)ci * 16 + tt;
        const int e0 = EXPERT[(size_t)tok * 128 + lane], e1 = EXPERT[(size_t)tok * 128 + 64 + lane];
        u32x4 va[16];
#pragma unroll
        for (int i = 0; i < 16; ++i) {
          const int k = i * 8 + g8;
          const int ek = __shfl(i < 8 ? e0 : e1, k & 63);
          va[i] = *(const u32x4*)(VQS + ((size_t)(x * 16384 + ek)) * 128 + l8 * 16);
        }
        i32x4 af[2];
#pragma unroll
        for (int sx = 0; sx < 2; ++sx) {
          af[sx] = *(const i32x4*)(CQ8 + (size_t)tok * 256 + (fr & 1) * 128 + sx * 64 + fg * 16);
          if (fr >= 2) af[sx] = (i32x4){0, 0, 0, 0};
        }
        const float qsc = QSC[tok];
#pragma unroll
        for (int i = 0; i < 16; ++i) {
          const int k = i * 8 + g8;
          *(u32x4*)(VST + k * 128 + ((l8 ^ g8) << 4)) = va[i];
        }
        WAVE_LDS_SYNC();
        i32x4 acc[8];
#pragma unroll
        for (int c = 0; c < 8; ++c) acc[c] = (i32x4){0, 0, 0, 0};
#pragma unroll
        for (int sx = 0; sx < 2; ++sx) {
          const int r1 = sx * 64 + fg * 16 + trow, r2 = r1 + 8;
#pragma unroll
          for (int c = 0; c < 8; ++c) {
            const i32x2 lo = __builtin_amdgcn_ds_read_tr8_b64_v2i32((lds_i32x2*)(VST + r1 * 128 + ((c ^ (r1 & 7)) << 4) + 8 * thalf));
            const i32x2 hi = __builtin_amdgcn_ds_read_tr8_b64_v2i32((lds_i32x2*)(VST + r2 * 128 + ((c ^ (r2 & 7)) << 4) + 8 * thalf));
            const i32x4 bf = {lo[0], lo[1], hi[0], hi[1]};
            acc[c] = __builtin_amdgcn_mfma_i32_16x16x64_i8(af[sx], bf, acc[c], 0, 0, 0);
          }
        }
        WAVE_LDS_SYNC();
        if (lane < 16 && !(p.flags & 32)) {
          float* op = p.out + (size_t)tok * DM + x * 128 + fr;
#pragma unroll
          for (int c = 0; c < 8; ++c) op[16 * c] += ((float)acc[c][0] * 256.f + (float)acc[c][1]) * qsc;
        }
      }
    }
  }
}

__device__ __forceinline__ void grid_barrier(unsigned* ctr, unsigned target) {
  asm volatile("s_waitcnt vmcnt(0)" ::: "memory");
  __syncthreads();
  if (TIDX == 0) {
    __builtin_amdgcn_fence(__ATOMIC_RELEASE, "agent");
    asm volatile("s_waitcnt vmcnt(0)" ::: "memory");
    __hip_atomic_fetch_add(ctr, 1u, __ATOMIC_RELAXED, __HIP_MEMORY_SCOPE_AGENT);
    while (__hip_atomic_load(ctr, __ATOMIC_RELAXED, __HIP_MEMORY_SCOPE_AGENT) < target) __builtin_amdgcn_s_sleep(2);
    __builtin_amdgcn_fence(__ATOMIC_ACQUIRE, "agent");
    asm volatile("s_waitcnt vmcnt(0)" ::: "memory");
  }
  __syncthreads();
}

__global__ void __launch_bounds__(NTHREADS, 2) mk_fwd(Params p) {
  cg::grid_group grid = cg::this_grid();
  __shared__ __attribute__((aligned(16))) unsigned char smem[SMEM_BYTES];
  const int lo = p.ph_lo, hi = p.ph_hi;
#define RUN(k, call) if (lo <= (k) && (k) < hi) { call; if ((k) + 1 < hi) { if ((k) == lo) grid.sync(); else grid_barrier((unsigned*)p.ws, (unsigned)((k) - lo) * gridDim.x); } }
  RUN(0, phase0(p, smem))
  RUN(1, phase1(p, smem))
  RUN(2, phase2(p, smem))
  RUN(3, phase3(p, smem))
  RUN(4, phase4(p, smem))
  RUN(5, phase5(p, smem))
  RUN(6, rmsnorm_rows<true>(p.out, p.in[12], (u16*)(p.ws + OFF_H2), p.ws + OFF_H2Q, (float*)(p.ws + OFF_HS)))
  RUN(7, phase6(p, smem))
  RUN(8, phase7(p, smem))
  RUN(9, phase7b(p))
  RUN(10, phase8a(p))
  RUN(11, phase8c(p))
  RUN(12, phase8b(p, smem))
#undef RUN
}

extern "C" void kernel_launch(void* const* d_in, const int* in_sizes, int n_in,
                              void* d_out, int out_size, void* d_ws, size_t ws_size,
                              hipStream_t stream) {
  static int grid_blocks = 0;
  if (!grid_blocks) {
    int dev = 0, cus = 0, per_cu = 0;
    (void)hipGetDevice(&dev);
    (void)hipDeviceGetAttribute(&cus, hipDeviceAttributeMultiprocessorCount, dev);
    (void)hipOccupancyMaxActiveBlocksPerMultiprocessor(&per_cu, mk_fwd, NTHREADS, 0);
    if (per_cu < 1) per_cu = 1;
    if (per_cu > 1) per_cu = 1;
    grid_blocks = cus * per_cu;
    fprintf(stderr, "mk_fwd: cus=%d per_cu=%d grid=%d ws=%zu\n", cus, per_cu, grid_blocks, ws_size);
  }
  Params p{};
  for (int i = 0; i < 17 && i < n_in; ++i) p.in[i] = (const float*)d_in[i];
  p.out = (float*)d_out;
  p.ws = (unsigned char*)d_ws;
  p.ph_lo = 0; p.ph_hi = 13;
  (void)hipMemsetAsync(d_ws, 0, 8192, stream);
  void* args[] = {&p};
  hipError_t e = hipLaunchCooperativeKernel((void*)mk_fwd, dim3(grid_blocks), dim3(NTHREADS), args, 0, stream);
  if (e != hipSuccess) fprintf(stderr, "cooperative launch failed: %s (grid %d)\n", hipGetErrorString(e), grid_blocks);
#ifdef EXTRA_LO
  {
    Params p2 = p;
    p2.ph_lo = EXTRA_LO; p2.ph_hi = EXTRA_HI; p2.flags = EXTRA_FLAGS;
    void* args2[] = {&p2};
    (void)hipLaunchCooperativeKernel((void*)mk_fwd, dim3(grid_blocks), dim3(NTHREADS), args2, 0, stream);
  }
#endif
}
```

```cpp
#include <hip/hip_runtime.h>
#include <hip/hip_bf16.h>
#include <hip/hip_cooperative_groups.h>
#include <cstdio>
#include <cstdint>
namespace cg = cooperative_groups;

typedef unsigned short u16;
typedef unsigned int u32;
typedef unsigned char u8;
typedef short bf16x8 __attribute__((ext_vector_type(8)));
typedef float f32x4 __attribute__((ext_vector_type(4)));
typedef unsigned int u32x4 __attribute__((ext_vector_type(4)));
typedef unsigned int u32x2 __attribute__((ext_vector_type(2)));

constexpr int NTHREADS = 512;
constexpr int BATCH = 8, SEQ = 4096, DM = 1024, MTOK = BATCH * SEQ;
constexpr int LDP = 5120;
constexpr int NPADW = 5632;
constexpr int C_AQ = 0, C_IQ = 512, C_DQ = 1024, C_DK = 1536, C_DV = 2048, C_DZ = 2560, C_GA = 3072, C_GB = 4096;
constexpr int N_AK = 5120, N_AV = 5248, N_IK = 5376, N_SM = 5440;
constexpr size_t MiB = 1ull << 20;
constexpr size_t OFF_WTIN = 1 * MiB, OFF_WTA = 12 * MiB, OFF_WTB = 13 * MiB, OFF_WTO = 14 * MiB, OFF_WTQ = 16 * MiB,
                 OFF_SKB = 20 * MiB, OFF_SMALL = 21 * MiB, OFF_H = 23 * MiB, OFF_ATT = 23 * MiB, OFF_GC = 39 * MiB,
                 OFF_MERGED = 23 * MiB, OFF_PROJ = 87 * MiB, OFF_KVC = 407 * MiB, OFF_IKC = 423 * MiB, OFF_SEL = 427 * MiB, OFF_YATT = 443 * MiB,
                 OFF_YDN = 475 * MiB;
constexpr size_t OFF_H2 = OFF_PROJ, OFF_QP = OFF_PROJ + 64 * MiB, OFF_TOPS = OFF_PROJ + 192 * MiB,
                 OFF_TOPI = OFF_PROJ + 224 * MiB, OFF_EXPERT = OFF_PROJ + 232 * MiB, OFF_GATE = OFF_PROJ + 248 * MiB;
constexpr size_t OFF_UQ = OFF_PROJ + 264 * MiB, OFF_VQ = OFF_PROJ + 280 * MiB, OFF_US = OFF_PROJ + 296 * MiB, OFF_VS = OFF_PROJ + 297 * MiB;
constexpr size_t OFF_CQ8 = 56 * MiB, OFF_QSC = 64 * MiB;
constexpr size_t OFF_H2Q = 23 * MiB, OFF_HS = 55 * MiB, OFF_PD = OFF_PROJ + 64 * MiB;
constexpr size_t DO_U = 0, DO_W = 32 * MiB, DO_QN = 64 * MiB, DO_KNT = 96 * MiB;

constexpr int SMEM_BYTES = 162816;
constexpr float EPS = 1e-6f;

struct Params {
  const float* in[17];
  float* out;
  unsigned char* ws;
  int ph_lo, ph_hi;
  int flags, pad;
};

typedef __bf16 bf16x2_t __attribute__((ext_vector_type(2)));
typedef float f32x2_t __attribute__((ext_vector_type(2)));
__device__ __forceinline__ u32 pack2(float a, float b) {
  f32x2_t f = {a, b};
  return __builtin_bit_cast(u32, __builtin_convertvector(f, bf16x2_t));
}
__device__ __forceinline__ u16 f2bf(float f) { return (u16)(pack2(f, f) & 0xffffu); }
__device__ __forceinline__ float bf2f(u16 h) { return __uint_as_float(((u32)h) << 16); }
__device__ __forceinline__ float bflo(u32 w) { return __uint_as_float(w << 16); }
__device__ __forceinline__ float bfhi(u32 w) { return __uint_as_float(w & 0xffff0000u); }
__device__ __forceinline__ float wave_sum(float v) {
#pragma unroll
  for (int o = 32; o > 0; o >>= 1) v += __shfl_xor(v, o);
  return v;
}
__device__ __forceinline__ float wave_max(float v) {
#pragma unroll
  for (int o = 32; o > 0; o >>= 1) v = fmaxf(v, __shfl_xor(v, o));
  return v;
}
__device__ __forceinline__ float dot2bf(u32 a, u32 b, float acc) {
  return __builtin_amdgcn_fdot2_f32_bf16(__builtin_bit_cast(bf16x2_t, a), __builtin_bit_cast(bf16x2_t, b), acc, false);
}
#define DPPF(v, ctrl) __int_as_float(__builtin_amdgcn_update_dpp(0, __float_as_int(v), ctrl, 0xf, 0xf, true))
__device__ __forceinline__ float wave_sum_dpp(float v) {
  v += DPPF(v, 0xb1);
  v += DPPF(v, 0x4e);
  v += DPPF(v, 0x124);
  v += DPPF(v, 0x128);
  float r0 = __int_as_float(__builtin_amdgcn_readlane(__float_as_int(v), 0));
  float r1 = __int_as_float(__builtin_amdgcn_readlane(__float_as_int(v), 16));
  float r2 = __int_as_float(__builtin_amdgcn_readlane(__float_as_int(v), 32));
  float r3 = __int_as_float(__builtin_amdgcn_readlane(__float_as_int(v), 48));
  return (r0 + r1) + (r2 + r3);
}
__device__ __forceinline__ int opaque_tid() { int t = threadIdx.x; asm volatile("" : "+v"(t)); return t; }
#define TIDX opaque_tid()
#define DPPI(v, ctrl) __builtin_amdgcn_update_dpp(0, (v), ctrl, 0xf, 0xf, true)
__device__ __forceinline__ int wave_sum_i_dpp(int v) {
  v += DPPI(v, 0xb1);
  v += DPPI(v, 0x4e);
  v += DPPI(v, 0x124);
  v += DPPI(v, 0x128);
  return (__builtin_amdgcn_readlane(v, 0) + __builtin_amdgcn_readlane(v, 16)) +
         (__builtin_amdgcn_readlane(v, 32) + __builtin_amdgcn_readlane(v, 48));
}
__device__ __forceinline__ float wave_max_dpp(float v) {
  v = fmaxf(v, DPPF(v, 0xb1));
  v = fmaxf(v, DPPF(v, 0x4e));
  v = fmaxf(v, DPPF(v, 0x124));
  v = fmaxf(v, DPPF(v, 0x128));
  float r0 = __int_as_float(__builtin_amdgcn_readlane(__float_as_int(v), 0));
  float r1 = __int_as_float(__builtin_amdgcn_readlane(__float_as_int(v), 16));
  float r2 = __int_as_float(__builtin_amdgcn_readlane(__float_as_int(v), 32));
  float r3 = __int_as_float(__builtin_amdgcn_readlane(__float_as_int(v), 48));
  return fmaxf(fmaxf(r0, r1), fmaxf(r2, r3));
}
#define WAVE_LDS_SYNC() asm volatile("s_waitcnt lgkmcnt(0)" ::: "memory")
__device__ __forceinline__ float sigmoidf_(float x) { return __builtin_amdgcn_rcpf(1.f + __expf(-x)); }
__device__ __forceinline__ int perm32(int k) {
  int blk = k & ~31, r = k & 31;
  int p = (r < 16) ? (8 * (r >> 2) + (r & 3)) : (8 * ((r - 16) >> 2) + 4 + (r & 3));
  return blk + p;
}

__device__ __forceinline__ int g8_logical_col(int t) { return ((t & 127) >> 5) * 64 + (t >> 7) * 32 + (t & 31); }
__device__ __forceinline__ int win_map(int n) {
  if (n < 512) return n;
  if (n < 1024) return 768 + (n - 512);
  if (n < 3072) return 1352 + (n - 1024);
  if (n < 5120) return 3408 + (n - 3072);
  if (n < 5248) return 512 + (n - 5120);
  if (n < 5376) return 640 + (n - 5248);
  if (n < 5440) return 1280 + (n - 5376);
  if (n < 5448) return 1344 + (n - 5440);
  if (n < 5452) return 3400 + (n - 5448);
  if (n < 5456) return 3404 + (n - 5452);
  return -1;
}
__device__ __forceinline__ void transpose_tile(const float* __restrict__ src, int Nsrc, u16* __restrict__ dst, int K, int k0, int n0,
                               bool mapped, bool perm8, float* tile  ) {
  const int tid = TIDX;
  {
    const int tx = tid & 63, ty = tid >> 6;
    int n = n0 + tx;
    if (perm8) n = (n & ~255) + g8_logical_col(n & 255);
    int sc = mapped ? win_map(n) : n;
#pragma unroll
    for (int i = 0; i < 8; ++i) {
      int k = ty + 8 * i;
      float v = (sc >= 0) ? src[(size_t)(k0 + k) * Nsrc + sc] : 0.f;
      tile[k * 65 + tx] = v;
    }
  }
  __syncthreads();
  {
    const int n = tid >> 3, kc = (tid & 7) * 8;
    u32 w[4];
#pragma unroll
    for (int j = 0; j < 4; ++j) w[j] = pack2(tile[(kc + 2 * j) * 65 + n], tile[(kc + 2 * j + 1) * 65 + n]);
    *(uint4*)(dst + (size_t)(n0 + n) * K + k0 + kc) = make_uint4(w[0], w[1], w[2], w[3]);
  }
  __syncthreads();
}

template <bool Q8>
__device__ __forceinline__ void rmsnorm_rows(const float* __restrict__ x, const float* __restrict__ gain, u16* __restrict__ out,
                                             unsigned char* __restrict__ q8, float* __restrict__ qs) {
  const int lane = TIDX & 63, wave = TIDX >> 6;
  float4 g[4];
#pragma unroll
  for (int i = 0; i < 4; ++i) g[i] = ((const float4*)gain)[lane + 64 * i];
  for (int row = blockIdx.x * 8 + wave; row < MTOK; row += gridDim.x * 8) {
    const float4* xr = (const float4*)(x + (size_t)row * DM);
    float4 v[4];
    float ss = 0.f;
#pragma unroll
    for (int i = 0; i < 4; ++i) {
      v[i] = xr[lane + 64 * i];
      ss += v[i].x * v[i].x + v[i].y * v[i].y + v[i].z * v[i].z + v[i].w * v[i].w;
    }
    ss = wave_sum_dpp(ss);
    float r = rsqrtf(ss * (1.f / DM) + EPS);
    float amax = 0.f;
#pragma unroll
    for (int i = 0; i < 4; ++i) {
      v[i].x *= r * g[i].x; v[i].y *= r * g[i].y; v[i].z *= r * g[i].z; v[i].w *= r * g[i].w;
      uint2 o;
      o.x = pack2(v[i].x, v[i].y);
      o.y = pack2(v[i].z, v[i].w);
      *(uint2*)(out + (size_t)row * DM + 4 * (lane + 64 * i)) = o;
      if (Q8) amax = fmaxf(amax, fmaxf(fmaxf(fabsf(v[i].x), fabsf(v[i].y)), fmaxf(fabsf(v[i].z), fabsf(v[i].w))));
    }
    if (Q8) {
      amax = wave_max_dpp(amax);
      const float inv = amax > 0.f ? 127.f / amax : 0.f;
#pragma unroll
      for (int i = 0; i < 4; ++i) {
        const int q0 = (int)rintf(v[i].x * inv), q1 = (int)rintf(v[i].y * inv), q2 = (int)rintf(v[i].z * inv), q3 = (int)rintf(v[i].w * inv);
        *(u32*)(q8 + (size_t)row * DM + 4 * (lane + 64 * i)) =
            (u32)(q0 & 0xff) | ((u32)(q1 & 0xff) << 8) | ((u32)(q2 & 0xff) << 16) | ((u32)(q3 & 0xff) << 24);
      }
      if (lane == 0) qs[row] = amax * (1.f / 127.f);
    }
  }
}

__device__ __forceinline__ void phase0(const Params& p, unsigned char* smem) {
  float* tile = (float*)smem;
  unsigned char* ws = p.ws;
  const int n_in = 16 * 88, n_a = 8 * 16, n_b = 8 * 16, n_o = 16 * 16, n_q = 16 * 32;
  const int total = n_in + n_a + n_b + n_o + n_q;
  for (int t = blockIdx.x; t < total; t += gridDim.x) {
    int i = t;
    if (i < n_in) { transpose_tile(p.in[2], 5456, (u16*)(ws + OFF_WTIN), 1024, (i / 88) * 64, (i % 88) * 64, true, true, tile); continue; }
    i -= n_in;
    if (i < n_a) { transpose_tile(p.in[9], 1024, (u16*)(ws + OFF_WTA), 512, (i / 16) * 64, (i % 16) * 64, false, true, tile); continue; }
    i -= n_a;
    if (i < n_b) { transpose_tile(p.in[10], 1024, (u16*)(ws + OFF_WTB), 512, (i / 16) * 64, (i % 16) * 64, false, true, tile); continue; }
    i -= n_b;
    if (i < n_o) { transpose_tile(p.in[11], 1024, (u16*)(ws + OFF_WTO), 1024, (i / 16) * 64, (i % 16) * 64, false, true, tile); continue; }
    i -= n_o;
    transpose_tile(p.in[13], 2048, (u16*)(ws + OFF_WTQ), 1024, (i / 32) * 64, (i % 32) * 64, false, true, tile);
  }
  {
    const float* sk = p.in[14];
    u16* skb = (u16*)(ws + OFF_SKB);
    for (int i = blockIdx.x * NTHREADS + TIDX; i < 16 * 128 * 128; i += gridDim.x * NTHREADS) skb[i] = f2bf(sk[i]);
  }
  rmsnorm_rows<false>(p.in[0], p.in[1], (u16*)(ws + OFF_H), nullptr, nullptr);
}

constexpr int G_BM = 256, G_BN = 128, G_BK = 64;
constexpr int G_ABYTES = G_BM * 128;

template <int MI>
__device__ __forceinline__ void gemm_mainloop_t(const u16* __restrict__ A, int lda, const u16* __restrict__ Bt, int ldb, int K,
                                                int m0, int n0, unsigned char* smem, f32x4 (&acc)[MI][4]) {
  constexpr int BN = (MI == 4) ? 128 : 256;
  constexpr int NRB = BN / 64;
  constexpr int STAGE = G_ABYTES + BN * 128;
  const int tid = TIDX, lane = tid & 63, wave = tid >> 6;
  const int wm = (MI == 4) ? (wave >> 1) : (wave >> 2), wn = (MI == 4) ? (wave & 1) : (wave & 3);
#pragma unroll
  for (int i = 0; i < MI; ++i)
#pragma unroll
    for (int j = 0; j < 4; ++j) acc[i][j] = (f32x4){0.f, 0.f, 0.f, 0.f};
  const int kc = tid & 7;
  const int arow = tid >> 3;
  u32x4 ra[4], rb[NRB];
  const u16* ap = A + (size_t)(m0 + arow) * lda + kc * 8;
  const u16* bp = Bt + (size_t)(n0 + arow) * ldb + kc * 8;
  const int nk = K / G_BK;
  const int fr = lane & 15, fg = lane >> 4;
#define G_LOAD(kt_)                                                                       \
  {                                                                                       \
    const u16* ap2_ = ap + (size_t)(kt_) * G_BK;                                          \
    const u16* bp2_ = bp + (size_t)(kt_) * G_BK;                                          \
    _Pragma("unroll") for (int i = 0; i < 4; ++i) ra[i] = *(const u32x4*)(ap2_ + (size_t)(64 * i) * lda); \
    _Pragma("unroll") for (int i = 0; i < NRB; ++i) rb[i] = *(const u32x4*)(bp2_ + (size_t)(64 * i) * ldb); \
  }
#define G_STORE(st_)                                                                      \
  {                                                                                       \
    unsigned char* sa_ = smem + (st_) * STAGE;                                            \
    unsigned char* sb_ = sa_ + G_ABYTES;                                                  \
    _Pragma("unroll") for (int i = 0; i < 4; ++i) { int r = arow + 64 * i; *(u32x4*)(sa_ + r * 128 + ((kc ^ (r & 7)) << 4)) = ra[i]; } \
    _Pragma("unroll") for (int i = 0; i < NRB; ++i) { int r = arow + 64 * i; *(u32x4*)(sb_ + r * 128 + ((kc ^ (r & 7)) << 4)) = rb[i]; } \
  }
  G_LOAD(0)
  __syncthreads();
  G_STORE(0)
  if (nk > 1) G_LOAD(1)
  __syncthreads();
  for (int kt = 0; kt < nk; ++kt) {
    if (kt + 1 < nk) G_STORE((kt + 1) & 1)
    if (kt + 2 < nk) G_LOAD(kt + 2)
    __builtin_amdgcn_sched_barrier(0);
    const unsigned char* sa = smem + (kt & 1) * STAGE;
    const unsigned char* sb = sa + G_ABYTES;
#pragma unroll
    for (int kk = 0; kk < 2; ++kk) {
      bf16x8 bfr[4];
#pragma unroll
      for (int j = 0; j < 4; ++j) {
        int r = wn * 64 + j * 16 + fr;
        bfr[j] = *(const bf16x8*)(sb + r * 128 + (((kk * 4 + fg) ^ (r & 7)) << 4));
      }
#pragma unroll
      for (int ih = 0; ih < MI; ih += 4) {
        bf16x8 af[4];
#pragma unroll
        for (int i = 0; i < 4; ++i) {
          int r = wm * (MI * 16) + (ih + i) * 16 + fr;
          af[i] = *(const bf16x8*)(sa + r * 128 + (((kk * 4 + fg) ^ (r & 7)) << 4));
        }
#pragma unroll
        for (int i = 0; i < 4; ++i)
#pragma unroll
          for (int j = 0; j < 4; ++j) acc[ih + i][j] = __builtin_amdgcn_mfma_f32_16x16x32_bf16(af[i], bfr[j], acc[ih + i][j], 0, 0, 0);
        if (MI == 8 && ih == 0) __builtin_amdgcn_sched_barrier(0);
      }
    }
    __syncthreads();
  }
#undef G_LOAD
#undef G_STORE
}
__device__ __forceinline__ void gemm_mainloop(const u16* __restrict__ A, int lda, const u16* __restrict__ Bt, int ldb, int K,
                                              int m0, int n0, unsigned char* smem, f32x4 (&acc)[4][4]) {
  gemm_mainloop_t<4>(A, lda, Bt, ldb, K, m0, n0, smem, acc);
}

__device__ __forceinline__ int g8_lds_byte(int r, int c) {
  int st = (r >> 4) * 2 + (c >> 5), rr = r & 15, cc = c & 31, ob = rr * 64 + cc * 2;
  return st * 1024 + (ob ^ (((ob >> 9) & 1) << 5));
}
__device__ __forceinline__ void g8_stage_rc(int b, int& R, int& C) {
  int st = b / 1024, sb = b % 1024, swz = sb ^ (((sb >> 9) & 1) << 5);
  R = (st >> 1) * 16 + swz / 64; C = (st & 1) * 32 + (swz % 64) / 2;
}
typedef __attribute__((address_space(3))) unsigned int lds_u32;
__device__ __forceinline__ void gemm8_tile(const u16* __restrict__ A, const u16* __restrict__ Bt, int K, int brow, int bcol,
                                           unsigned char* smem, f32x4 (&acc)[2][2][4][2]) {
  constexpr int HTB = 16384;
  const int tid = TIDX;
  const int wid = tid >> 6, lane = tid & 63, wr = wid >> 2, wc = wid & 3, fr = lane & 15, fq = lane >> 4;
#define SA(b, h) (smem + ((b) * 2 + (h)) * HTB)
#define SB(b, h) (smem + (4 + (b) * 2 + (h)) * HTB)
#define STAGE(P, BASE, br, kt) do { const long _g = (long)(br) * K + (long)(kt) * 64; \
    _Pragma("unroll") for (int _i = 0; _i < 2; ++_i) { int _b = tid * 16 + _i * 8192; int _r, _c; g8_stage_rc(_b, _r, _c); \
      __builtin_amdgcn_global_load_lds((const unsigned int*)(BASE + _g + (long)_r * K + _c), \
        (lds_u32*)((P) + _b), 16, 0, 0); } } while (0)
#define LDA(dst, b, h) _Pragma("unroll") for (int m = 0; m < 4; ++m) _Pragma("unroll") for (int k = 0; k < 2; ++k) \
    dst[m][k] = *(const bf16x8*)(SA(b, h) + g8_lds_byte(wr * 64 + m * 16 + fr, k * 32 + fq * 8))
#define LDB(dst, b, h) _Pragma("unroll") for (int n = 0; n < 2; ++n) _Pragma("unroll") for (int k = 0; k < 2; ++k) \
    dst[n][k] = *(const bf16x8*)(SB(b, h) + g8_lds_byte(wc * 32 + n * 16 + fr, k * 32 + fq * 8))
#define MMA(ai, bj, At_, Bt_) do { __builtin_amdgcn_s_setprio(1); \
    _Pragma("unroll") for (int m = 0; m < 4; ++m) _Pragma("unroll") for (int n = 0; n < 2; ++n) _Pragma("unroll") for (int k = 0; k < 2; ++k) \
      acc[ai][bj][m][n] = __builtin_amdgcn_mfma_f32_16x16x32_bf16(At_[m][k], Bt_[n][k], acc[ai][bj][m][n], 0, 0, 0); \
    __builtin_amdgcn_s_setprio(0); } while (0)
#define WAIT_V(n) asm volatile("s_waitcnt vmcnt(" #n ")" ::: "memory")
#define WAIT_L(n) asm volatile("s_waitcnt lgkmcnt(" #n ")" ::: "memory")
#define BAR __builtin_amdgcn_s_barrier()
#define SCHED __builtin_amdgcn_sched_barrier(0)
#pragma unroll
  for (int a = 0; a < 2; ++a)
#pragma unroll
    for (int b2 = 0; b2 < 2; ++b2)
#pragma unroll
      for (int m = 0; m < 4; ++m)
#pragma unroll
        for (int n = 0; n < 2; ++n) acc[a][b2][m][n] = (f32x4){0.f, 0.f, 0.f, 0.f};
  bf16x8 At[4][2], B0[2][2], B1[2][2];
  const int nt = K / 64;
  constexpr int HALF = 128;
  __syncthreads();
  STAGE(SB(0, 0), Bt, bcol, 0); STAGE(SA(0, 0), A, brow, 0);
  STAGE(SB(0, 1), Bt, bcol + HALF, 0); STAGE(SA(0, 1), A, brow + HALF, 0);
  if (wr == 1) BAR;
  WAIT_V(4); BAR;
  STAGE(SB(1, 0), Bt, bcol, 1); STAGE(SA(1, 0), A, brow, 1); STAGE(SB(1, 1), Bt, bcol + HALF, 1);
  WAIT_V(6); BAR;
  for (int t = 0; t < nt - 2; t += 2) {
    LDB(B0, 0, 0); SCHED; LDA(At, 0, 0); STAGE(SA(1, 1), A, brow + HALF, t + 1);
    WAIT_L(8); BAR; WAIT_L(0); MMA(0, 0, At, B0); BAR; SCHED;
    LDB(B1, 0, 1); STAGE(SB(0, 0), Bt, bcol, t + 2);
    BAR; WAIT_L(0); MMA(0, 1, At, B1); BAR;
    LDA(At, 0, 1); STAGE(SA(0, 0), A, brow, t + 2);
    BAR; WAIT_L(0); MMA(1, 0, At, B0); BAR; SCHED;
    STAGE(SB(0, 1), Bt, bcol + HALF, t + 2);
    WAIT_V(6); BAR; MMA(1, 1, At, B1); BAR;
    LDB(B0, 1, 0); SCHED; LDA(At, 1, 0); STAGE(SA(0, 1), A, brow + HALF, t + 2);
    WAIT_L(8); BAR; WAIT_L(0); MMA(0, 0, At, B0); BAR; SCHED;
    LDB(B1, 1, 1); STAGE(SB(1, 0), Bt, bcol, t + 3);
    BAR; WAIT_L(0); MMA(0, 1, At, B1); BAR;
    LDA(At, 1, 1); STAGE(SA(1, 0), A, brow, t + 3);
    BAR; WAIT_L(0); MMA(1, 0, At, B0); BAR; SCHED;
    STAGE(SB(1, 1), Bt, bcol + HALF, t + 3);
    WAIT_V(6); BAR; MMA(1, 1, At, B1); BAR;
  }
  { LDB(B0, 0, 0); LDA(At, 0, 0); STAGE(SA(1, 1), A, brow + HALF, nt - 1);
    BAR; WAIT_L(0); MMA(0, 0, At, B0); BAR;
    LDB(B1, 0, 1); BAR; WAIT_L(0); MMA(0, 1, At, B1); BAR;
    LDA(At, 0, 1); WAIT_V(4); BAR; WAIT_L(0); MMA(1, 0, At, B0); MMA(1, 1, At, B1); BAR; }
  { LDB(B0, 1, 0); LDA(At, 1, 0); WAIT_V(2); BAR; WAIT_L(0); MMA(0, 0, At, B0); BAR;
    LDB(B1, 1, 1); WAIT_V(0); BAR; WAIT_L(0); MMA(0, 1, At, B1); BAR;
    LDA(At, 1, 1); BAR; WAIT_L(0); MMA(1, 0, At, B0); MMA(1, 1, At, B1); BAR; }
  if (wr == 0) BAR;
#undef SA
#undef SB
#undef STAGE
#undef LDA
#undef LDB
#undef MMA
#undef WAIT_V
#undef WAIT_L
#undef BAR
#undef SCHED
}

template <int LD, bool NORM>
__device__ __forceinline__ void ep_store(u16* __restrict__ dst, u32 ob, const f32x4 (&acc)[2][2][4][2], const float* __restrict__ gain,
                                         float extra, unsigned char* smem, int wave, int lane_in) {
  int lane = lane_in;
  asm volatile("" : "+v"(lane));
  const int fr = lane & 15, fq = lane >> 4;
  unsigned char* reg = smem + wave * 16384;
  float gj[4] = {1.f, 1.f, 1.f, 1.f};
  if (NORM) {
#pragma unroll
    for (int j = 0; j < 4; ++j) gj[j] = gain[j * 16 + fr] * extra;
  }
  const int lrot = (fr >> 3) + 2 * fq;
  unsigned char* wbase = reg + (4 * fq) * 128 + (fr & 7) * 2;
#pragma unroll
  for (int ai = 0; ai < 2; ++ai)
#pragma unroll
    for (int m = 0; m < 4; ++m) {
#pragma unroll
      for (int r = 0; r < 4; ++r) {
        float rs = 1.f;
        if (NORM) {
          float sq = 0.f;
#pragma unroll
          for (int bj = 0; bj < 2; ++bj)
#pragma unroll
            for (int n = 0; n < 2; ++n) sq += acc[ai][bj][m][n][r] * acc[ai][bj][m][n][r];
          sq += DPPF(sq, 0xb1); sq += DPPF(sq, 0x4e); sq += DPPF(sq, 0x141); sq += DPPF(sq, 0x140);
          rs = rsqrtf(sq * (1.f / 64.f) + EPS);
        }
#pragma unroll
        for (int bj = 0; bj < 2; ++bj)
#pragma unroll
          for (int n = 0; n < 2; ++n) {
            const float v = acc[ai][bj][m][n][r];
            const int ch = ((bj * 2 + n) * 2 + lrot) & 7;
            *(u16*)(wbase + (ai * 64 + m * 16 + r) * 128 + (ch << 4)) = f2bf(NORM ? v * rs * gj[bj * 2 + n] : v);
          }
      }
      __builtin_amdgcn_sched_barrier(0);
    }
  WAVE_LDS_SYNC();
  const int c16 = lane & 7, r8 = lane >> 3;
#pragma unroll
  for (int it = 0; it < 16; ++it) {
    const int rw = it * 8 + r8;
    const u32x4 v = *(const u32x4*)(reg + rw * 128 + (((c16 + 2 * ((rw >> 2) & 3)) & 7) << 4));
    const int grow = (it >> 3) * 128 + (it & 7) * 8 + r8;
    *(u32x4*)(dst + ob + (u32)(grow * LD + c16 * 8)) = v;
    if ((it & 3) == 3) __builtin_amdgcn_sched_barrier(0);
  }
}

template <bool NORM>
__device__ __forceinline__ void ep_store8(unsigned char* __restrict__ dst, u32 ob, const f32x4 (&acc)[2][2][4][2],
                                          const float* __restrict__ gain, unsigned char* smem, int wave, int lane_in) {
  int lane = lane_in;
  asm volatile("" : "+v"(lane));
  const int fr = lane & 15, fq = lane >> 4;
  unsigned char* reg = smem + wave * 16384;
  float gj[4] = {1.f, 1.f, 1.f, 1.f};
  if (NORM) {
#pragma unroll
    for (int j = 0; j < 4; ++j) gj[j] = gain[j * 16 + fr];
  }
#pragma unroll
  for (int ai = 0; ai < 2; ++ai)
#pragma unroll
    for (int m = 0; m < 4; ++m) {
#pragma unroll
      for (int r = 0; r < 4; ++r) {
        float rs = 1.f;
        if (NORM) {
          float sq = 0.f;
#pragma unroll
          for (int bj = 0; bj < 2; ++bj)
#pragma unroll
            for (int n = 0; n < 2; ++n) sq += acc[ai][bj][m][n][r] * acc[ai][bj][m][n][r];
          sq += DPPF(sq, 0xb1); sq += DPPF(sq, 0x4e); sq += DPPF(sq, 0x141); sq += DPPF(sq, 0x140);
          rs = rsqrtf(sq * (1.f / 64.f) + EPS);
        }
        const int rw = ai * 64 + m * 16 + 4 * fq + r;
#pragma unroll
        for (int bj = 0; bj < 2; ++bj)
#pragma unroll
          for (int n = 0; n < 2; ++n) {
            const float v = NORM ? acc[ai][bj][m][n][r] * rs * gj[bj * 2 + n] : acc[ai][bj][m][n][r];
            reg[rw * 64 + ((((bj * 2 + n) + (rw >> 2)) & 3) << 4) + fr] =
                (unsigned char)(__builtin_amdgcn_cvt_pk_fp8_f32(v, v, 0, false) & 0xff);
          }
      }
      __builtin_amdgcn_sched_barrier(0);
    }
  WAVE_LDS_SYNC();
  const int c4 = lane & 3, r16 = lane >> 2;
#pragma unroll
  for (int it = 0; it < 8; ++it) {
    const int rw = it * 16 + r16;
    const u32x4 v = *(const u32x4*)(reg + rw * 64 + (((c4 + (rw >> 2)) & 3) << 4));
    const int grow = (rw >> 6) * 128 + (rw & 63);
    *(u32x4*)(dst + ob + (u32)(grow * 256 + c4 * 16)) = v;
  }
}

__device__ __forceinline__ void phase1(const Params& p, unsigned char* smem) {
  const u16* H = (const u16*)(p.ws + OFF_H);
  const u16* WT = (const u16*)(p.ws + OFF_WTIN);
  u16* PROJ = (u16*)(p.ws + OFF_PROJ);
  u16* KVC = (u16*)(p.ws + OFF_KVC);
  u16* IKC = (u16*)(p.ws + OFF_IKC);
  float* SMALL = (float*)(p.ws + OFF_SMALL);
  const int lane = TIDX & 63, wave = TIDX >> 6;
  const int wr = wave >> 2, wc = wave & 3, fr = lane & 15, fq = lane >> 4;
  const int ntn = NPADW / 256;
  const int ntiles = (MTOK / 256) * ntn;
  for (int t = blockIdx.x; t < ntiles; t += gridDim.x) {
    const int m0 = (t / ntn) * 256, n0 = (t % ntn) * 256;
    f32x4 acc[2][2][4][2];
    gemm8_tile(H, WT, DM, m0, n0, smem, acc);
    const int cbase = n0 + wc * 64;
    const u32 rbase = (u32)(m0 + wr * 64);
    if (cbase < C_IQ) {
      ep_store<LDP, true>(PROJ, rbase * LDP + (u32)cbase, acc, p.in[3], 0.125f, smem, wave, lane);
    } else if (cbase < LDP) {
      ep_store<LDP, false>(PROJ, rbase * LDP + (u32)cbase, acc, nullptr, 1.f, smem, wave, lane);
    } else if (cbase < N_AV) {
      ep_store8<true>(p.ws + OFF_KVC, rbase * 256 + (u32)(cbase - N_AK), acc, p.in[4], smem, wave, lane);
    } else if (cbase < N_IK) {
      ep_store8<false>(p.ws + OFF_KVC, rbase * 256 + (u32)(cbase - N_AV + 128), acc, nullptr, smem, wave, lane);
    } else if (cbase < N_SM) {
      ep_store<64, false>(IKC, rbase * 64, acc, nullptr, 1.f, smem, wave, lane);
    } else if (cbase == N_SM) {
      const u32 sb0 = (rbase + 4 * fq) * 16 + (u32)fr;
#pragma unroll
      for (int ai = 0; ai < 2; ++ai)
#pragma unroll
        for (int m = 0; m < 4; ++m)
#pragma unroll
          for (int r = 0; r < 4; ++r) SMALL[sb0 + (u32)((ai * 128 + m * 16 + r) * 16)] = acc[ai][0][m][0][r];
    }
  }
}

constexpr int IDX_RS = 8208;

__device__ __forceinline__ u32 f2key(float x) {
  _Float16 h = (_Float16)x;
  u32 b = (u32) * (u16*)&h;
  return (b & 0x8000u) ? ((~b) & 0xffffu) : (b | 0x8000u);
}
__device__ __forceinline__ int count_ge_wave(const u32 (&kreg)[32], u32 mid, int ndw) {
  const u32 m1 = (mid - 1u) * 0x00010001u;
  const u32 one = 0x00010001u;
  u32 acc0 = 0u, acc1 = 0u;
#pragma unroll
  for (int c4 = 0; c4 < 8; ++c4) {
    if (c4 * 4 < ndw) {
#pragma unroll
      for (int i = c4 * 4; i < c4 * 4 + 4; i += 2) {
        u32 t0, t1;
        asm("v_pk_sub_u16 %0, %1, %2 clamp" : "=v"(t0) : "v"(kreg[i]), "s"(m1));
        asm("v_pk_sub_u16 %0, %1, %2 clamp" : "=v"(t1) : "v"(kreg[i + 1]), "s"(m1));
        asm("v_pk_min_u16 %0, %1, %2" : "=v"(t0) : "v"(t0), "s"(one));
        asm("v_pk_min_u16 %0, %1, %2" : "=v"(t1) : "v"(t1), "s"(one));
        asm("v_pk_add_u16 %0, %1, %2" : "=v"(acc0) : "v"(acc0), "v"(t0));
        asm("v_pk_add_u16 %0, %1, %2" : "=v"(acc1) : "v"(acc1), "v"(t1));
      }
    }
  }
  int c = (int)((acc0 & 0xffffu) + (acc0 >> 16) + (acc1 & 0xffffu) + (acc1 >> 16));
  return wave_sum_i_dpp(c);
}

__device__ __forceinline__ void idx_item(const Params& p, unsigned char* smem, int b, int tq) {
  const u16* PROJ = (const u16*)(p.ws + OFF_PROJ);
  const float* SMALL = (const float*)(p.ws + OFF_SMALL);
  u16* SEL = (u16*)(p.ws + OFF_SEL);
  const int tid = TIDX, lane = tid & 63, wave = tid >> 6;
  const int t0 = tq * 16;
  const size_t tokb = (size_t)b * SEQ;
  if (tq < 16) {
    for (int rr = 0; rr < 2; ++rr) {
      int row = 2 * wave + rr, t = t0 + row;
      u16* out = SEL + (tokb + t) * 256;
      for (int i = lane; i < 256; i += 64) out[i] = (i <= t) ? (u16)i : (u16)0xFFFF;
    }
    return;
  }
  const int q = lane & 15, g = lane >> 4;
  __syncthreads();
  {
    const u16* iqrow = PROJ + (tokb + t0 + q) * LDP + C_IQ;
    bf16x8 bq[8][2];
    float wq[8];
#pragma unroll
    for (int h = 0; h < 8; ++h) {
      bq[h][0] = *(const bf16x8*)(iqrow + h * 64 + g * 8);
      bq[h][1] = *(const bf16x8*)(iqrow + h * 64 + 32 + g * 8);
      wq[h] = SMALL[(tokb + t0 + q) * 16 + h];
    }
    const int nkb = tq + 1;
    const int niter = (nkb > wave) ? ((nkb - wave + 7) >> 3) : 0;
    const u16* ikbase = (const u16*)(p.ws + OFF_IKC) + (tokb + q) * 64 + g * 8;
    bf16x8 ca[3][2];
#pragma unroll
    for (int j = 0; j < 3; ++j)
      if (j < niter) {
        const u16* ikrow = ikbase + (size_t)((wave + 8 * j) * 16) * 64;
        ca[j][0] = *(const bf16x8*)(ikrow); ca[j][1] = *(const bf16x8*)(ikrow + 32);
      }
    for (int i0 = 0; i0 < ((p.flags & 8) ? 0 : niter); i0 += 3) {
#pragma unroll
      for (int j = 0; j < 3; ++j) {
        if (i0 + j < niter) {
          const int s0 = (wave + 8 * (i0 + j)) * 16;
          f32x4 tot = {0.f, 0.f, 0.f, 0.f};
#pragma unroll
          for (int h = 0; h < 8; ++h) {
            f32x4 acc = {0.f, 0.f, 0.f, 0.f};
            acc = __builtin_amdgcn_mfma_f32_16x16x32_bf16(ca[j][0], bq[h][0], acc, 0, 0, 0);
            acc = __builtin_amdgcn_mfma_f32_16x16x32_bf16(ca[j][1], bq[h][1], acc, 0, 0, 0);
#pragma unroll
            for (int r = 0; r < 4; ++r) tot[r] += wq[h] * fmaxf(acc[r], 0.f);
          }
          if (i0 + 3 + j < niter) {
            const u16* ikrow = ikbase + (size_t)((wave + 8 * (i0 + 3 + j)) * 16) * 64;
            ca[j][0] = *(const bf16x8*)(ikrow); ca[j][1] = *(const bf16x8*)(ikrow + 32);
          }
          u32 k[4];
#pragma unroll
          for (int r = 0; r < 4; ++r) {
            int sidx = s0 + 4 * g + r;
            k[r] = (sidx <= t0 + q) ? f2key(tot[r]) : 0u;
          }
          u32x2 w2 = {k[0] | (k[1] << 16), k[2] | (k[3] << 16)};
          *(u32x2*)(smem + q * IDX_RS + (s0 + 4 * g) * 2) = w2;
        }
        __builtin_amdgcn_sched_barrier(0);
      }
    }
    const int nk = t0 + 16, nk64 = (nk + 511) & ~511;
    for (int i = tid; i < 16 * (nk64 - nk); i += NTHREADS) {
      int row = i / (nk64 - nk), c = nk + i % (nk64 - nk);
      *(u16*)(smem + row * IDX_RS + c * 2) = 0;
    }
  }
  __syncthreads();
  const int ndw = ((t0 + 16 + 511) >> 9) << 2;
  for (int rr = 0; rr < ((p.flags & 16) ? 0 : 2); ++rr) {
    const int row = 2 * wave + rr, t = t0 + row;
    u16* out = SEL + (tokb + t) * 256;
    u32 kreg[32];
    {
      const u32* src = (const u32*)(smem + row * IDX_RS) + lane;
#pragma unroll
      for (int c4 = 0; c4 < 8; ++c4)
        if (c4 * 4 < ndw) {
#pragma unroll
          for (int i = c4 * 4; i < c4 * 4 + 4; ++i) kreg[i] = src[i * 64];
        }
    }
    WAVE_LDS_SYNC();
    u32 lo = 1u, hi = 65535u;
    while (lo < hi) {
      u32 mid = (lo + hi + 1u) >> 1;
      int c = count_ge_wave(kreg, mid, ndw);
      if (c >= 256) lo = mid; else hi = mid - 1u;
    }
    const u32 tau = lo;
    int gt = 0, eq = 0;
#pragma unroll
    for (int c4 = 0; c4 < 8; ++c4)
      if (c4 * 4 < ndw) {
#pragma unroll
        for (int i = c4 * 4; i < c4 * 4 + 4; ++i) {
          u32 a = kreg[i] & 0xffffu, c2 = kreg[i] >> 16;
          gt += (a > tau) ? 1 : 0; gt += (c2 > tau) ? 1 : 0;
          eq += (a == tau) ? 1 : 0; eq += (c2 == tau) ? 1 : 0;
        }
      }
    int packed = gt | (eq << 16);
    int incl = packed;
#pragma unroll
    for (int o = 1; o < 64; o <<= 1) {
      int v = __shfl_up(incl, o);
      if (lane >= o) incl += v;
    }
    const int excl = incl - packed;
    const int total = __shfl(incl, 63);
    const int need = 256 - (total & 0xffff);
    const int pg = excl & 0xffff, pe = excl >> 16;
    int pos = pg + min(pe, need);
    int eqseen = pe;
    u16* lrow = (u16*)(smem + row * IDX_RS);
#pragma unroll
    for (int c4 = 0; c4 < 8; ++c4)
      if (c4 * 4 < ndw) {
#pragma unroll
        for (int i = c4 * 4; i < c4 * 4 + 4; ++i) {
#pragma unroll
          for (int hh = 0; hh < 2; ++hh) {
            u32 kv = hh ? (kreg[i] >> 16) : (kreg[i] & 0xffffu);
            int idx = 128 * i + 2 * lane + hh;
            bool take = false;
            if (kv > tau) take = true;
            else if (kv == tau) { take = (eqseen < need); ++eqseen; }
            if (take) { lrow[pos] = (u16)idx; ++pos; }
          }
        }
      }
    WAVE_LDS_SYNC();
    *(u32x2*)(out + lane * 4) = *(const u32x2*)(lrow + lane * 4);
    WAVE_LDS_SYNC();
  }
}

constexpr int DNP = 68;
constexpr int DL_KT = 0;
constexpr int DL_V = DL_KT + 128 * DNP * 4;
constexpr int DL_QB = DL_V + 64 * 128 * 4;
constexpr int DL_KB = DL_QB + 64 * 272;
constexpr int DL_SM = DL_KB + 64 * 272;
constexpr int DL_RAW = DL_SM + 2048;
static_assert(DL_RAW + 3 * 67 * 272 <= SMEM_BYTES && 16384 + 64 * 144 + 2048 <= 3 * 67 * 272, "dn_local LDS");
__device__ __forceinline__ void dn_local_item(const Params& p, unsigned char* smem, int item) {
  const int h = item & 3, n = (item >> 2) & 63, b = item >> 8;
  const u16* PROJ = (const u16*)(p.ws + OFF_PROJ);
  const float* SMALL = (const float*)(p.ws + OFF_SMALL);
  u16* Ug = (u16*)((unsigned char*)p.out + DO_U);
  u16* Wg = (u16*)((unsigned char*)p.out + DO_W);
  u16* QNg = (u16*)((unsigned char*)p.out + DO_QN);
  u16* KNTg = (u16*)((unsigned char*)p.out + DO_KNT);
  u16* ATTg = (u16*)(p.ws + OFF_ATT);
  float* GCg = (float*)(p.ws + OFF_GC);
  const float* convw = p.in[5];
  const int tid = TIDX, lane = tid & 63, wave = tid >> 6;
  const int c0 = n * 64;
  const size_t tok0 = (size_t)b * SEQ + c0;
  float* Kt = (float*)(smem + DL_KT);
  float* V = (float*)(smem + DL_V);
  unsigned char* Qb = smem + DL_QB;
  unsigned char* Kb = smem + DL_KB;
  float* gc = (float*)(smem + DL_SM);
  float* beta = gc + 64;
  float* ssp = beta + 64;
  unsigned char* RAW = smem + DL_RAW;
  float* AmT = (float*)(smem + DL_RAW);
  __syncthreads();
  {
    u32x4 rg[7];
#pragma unroll
    for (int k = 0; k < 7; ++k) {
      const int ci = tid + 512 * k;
      rg[k] = (u32x4){0u, 0u, 0u, 0u};
      if (ci < 3216) {
        const int arr = ci / 1072, rem = ci - arr * 1072, row = rem >> 4, ch = rem & 15;
        const int trel = c0 - 3 + row;
        if (trel >= 0)
          rg[k] = *(const u32x4*)(PROJ + ((size_t)b * SEQ + trel) * LDP + (C_DQ + arr * 512) + h * 128 + ch * 8);
      }
    }
#pragma unroll
    for (int k = 0; k < 7; ++k) {
      const int ci = tid + 512 * k;
      if (ci < 3216) {
        const int arr = ci / 1072, rem = ci - arr * 1072, row = rem >> 4, ch = rem & 15;
        *(u32x4*)(RAW + (arr * 67 + row) * 272 + ch * 16) = rg[k];
      }
    }
  }
  if (tid < 64) {
    float da = SMALL[(tok0 + tid) * 16 + 8 + h], db = SMALL[(tok0 + tid) * 16 + 12 + h];
    float xx = da + p.in[7][h];
    float sp = fmaxf(xx, 0.f) + log1pf(__expf(-fabsf(xx)));
    float gr = -__expf(p.in[6][h]) * sp;
    float incl = gr;
#pragma unroll
    for (int o = 1; o < 64; o <<= 1) {
      float v = __shfl_up(incl, o);
      if (lane >= o) incl += v;
    }
    gc[tid] = incl;
    beta[tid] = sigmoidf_(db);
    GCg[(tok0 + tid) * 4 + h] = incl;
  }
  __syncthreads();
  {
    const int c = tid & 127, tg = tid >> 7;
    float qv[16], kv[16];
#pragma unroll
    for (int arr = 0; arr < 3; ++arr) {
      const float w0 = convw[0 * 1536 + arr * 512 + h * 128 + c], w1 = convw[1 * 1536 + arr * 512 + h * 128 + c],
                  w2 = convw[2 * 1536 + arr * 512 + h * 128 + c], w3 = convw[3 * 1536 + arr * 512 + h * 128 + c];
      const unsigned char* rp = RAW + (arr * 67 + tg * 16) * 272 + c * 2;
      float x0 = bf2f(*(const u16*)(rp)), x1 = bf2f(*(const u16*)(rp + 272)), x2 = bf2f(*(const u16*)(rp + 2 * 272));
#pragma unroll
      for (int ii = 0; ii < 16; ++ii) {
        const float x3 = bf2f(*(const u16*)(rp + (ii + 3) * 272));
        const float y = w0 * x0 + w1 * x1 + w2 * x2 + w3 * x3;
        const float sv = y * sigmoidf_(y);
        if (arr == 0) qv[ii] = sv;
        else if (arr == 1) kv[ii] = sv;
        else V[(tg * 16 + ii) * 128 + c] = sv;
        x0 = x1; x1 = x2; x2 = x3;
      }
    }
#pragma unroll
    for (int ii = 0; ii < 16; ++ii) {
      const float sq = wave_sum_dpp(qv[ii] * qv[ii]);
      const float sk = wave_sum_dpp(kv[ii] * kv[ii]);
      if (lane == 0) {
        ssp[((tg * 16 + ii) * 2) + (wave & 1)] = sq;
        ssp[128 + ((tg * 16 + ii) * 2) + (wave & 1)] = sk;
      }
    }
    __syncthreads();
#pragma unroll
    for (int ii = 0; ii < 16; ++ii) {
      const int i = tg * 16 + ii;
      const float qsc = rsqrtf(ssp[i * 2] + ssp[i * 2 + 1] + EPS) * 0.08838834764831845f;
      const float ksc = rsqrtf(ssp[128 + i * 2] + ssp[128 + i * 2 + 1] + EPS);
      const float qn = qv[ii] * qsc, kn = kv[ii] * ksc;
      *(u16*)(Qb + i * 272 + c * 2) = f2bf(qn);
      *(u16*)(Kb + i * 272 + c * 2) = f2bf(kn);
      Kt[c * DNP + i] = kn;
    }
  }
  __syncthreads();
#pragma unroll
  for (int k = 0; k < 4; ++k) {
    const int gi = tid + 512 * k;
    {
      const int i = gi >> 5, d4 = (gi & 31) * 4;
      const u32x2 v = *(const u32x2*)(Qb + i * 272 + d4 * 2);
      *(u32x2*)(QNg + (tok0 + i) * 512 + h * 128 + perm32(d4)) = v;
    }
    {
      const int d = gi >> 4, t4 = (gi & 15) * 4;
      const f32x4 v = *(const f32x4*)(Kt + d * DNP + t4);
      u32x2 o = {pack2(v[0], v[1]), pack2(v[2], v[3])};
      *(u32x2*)(KNTg + (size_t)item * 8192 + d * 64 + perm32(t4)) = o;
    }
  }
  {
    const int mat = wave >> 2, it = wave & 3;
    const int fr = lane & 15, fg = lane >> 4;
    const unsigned char* Ab = mat ? Qb : Kb;
    bf16x8 af[4];
#pragma unroll
    for (int kk = 0; kk < 4; ++kk) af[kk] = *(const bf16x8*)(Ab + (it * 16 + fr) * 272 + kk * 64 + fg * 16);
    f32x4 gi4 = *(const f32x4*)(gc + it * 16 + 4 * fg);
    f32x4 bi4 = *(const f32x4*)(beta + it * 16 + 4 * fg);
#pragma unroll
    for (int jt = 0; jt < 4; ++jt) {
      f32x4 acc = {0.f, 0.f, 0.f, 0.f};
      if (jt <= it) {
#pragma unroll
        for (int kk = 0; kk < 4; ++kk) {
          bf16x8 bfg = *(const bf16x8*)(Kb + (jt * 16 + fr) * 272 + kk * 64 + fg * 16);
          acc = __builtin_amdgcn_mfma_f32_16x16x32_bf16(af[kk], bfg, acc, 0, 0, 0);
        }
      }
      const int j = jt * 16 + fr;
      const float gj = gc[j];
#pragma unroll
      for (int r = 0; r < 4; ++r) {
        const int i = it * 16 + 4 * fg + r;
        const float dec = __expf(fminf(gi4[r] - gj, 0.f));
        if (mat == 0) { if (jt <= it) AmT[j * 64 + i] = (i > j) ? bi4[r] * acc[r] * dec : 0.f; }
        else ATTg[(size_t)item * 4096 + i * 64 + perm32(j)] = f2bf((i >= j) ? acc[r] * dec : 0.f);
      }
    }
  }
  __syncthreads();
  u16* nA = (u16*)(smem + DL_RAW + 16384);
  u16* Nb = (u16*)(smem + DL_RAW + 16384 + 64 * 144);
  {
#pragma unroll
    for (int k = 0; k < 8; ++k) {
      const int e = tid + 512 * k;
      const int i = e >> 6, j = e & 63;
      const float v = ((j >> 4) < (i >> 4)) ? -AmT[j * 64 + i] : 0.f;
      nA[i * 72 + j] = f2bf(v);
    }
    if (tid < 64) {
      const int bb = tid >> 4, j = tid & 15;
      float nn[16];
#pragma unroll
      for (int i = 0; i < 16; ++i) {
        float sacc = 0.f;
#pragma unroll
        for (int k = 0; k < i; ++k) sacc += AmT[(bb * 16 + k) * 64 + bb * 16 + i] * nn[k];
        nn[i] = (i == j) ? 1.f : ((i > j) ? -sacc : 0.f);
      }
#pragma unroll
      for (int i = 0; i < 16; ++i) Nb[bb * 256 + i * 16 + j] = f2bf(nn[i]);
    }
  }
  __syncthreads();
  {
    const int fr = lane & 15, fg = lane >> 4;
    f32x4 X[2][4];
#pragma unroll
    for (int ct2 = 0; ct2 < 2; ++ct2) {
      const int c = (wave * 2 + ct2) * 16 + fr;
      const bool isu = c < 128;
      const int cc = c & 127;
#pragma unroll
      for (int bb = 0; bb < 4; ++bb) {
        f32x4 acc;
#pragma unroll
        for (int r = 0; r < 4; ++r) {
          const int i = bb * 16 + 4 * fg + r;
          acc[r] = isu ? V[i * 128 + cc] * beta[i] : Kt[cc * DNP + i] * beta[i] * __expf(gc[i]);
        }
        if (bb >= 1) {
          union { u32 w[4]; bf16x8 v; } af, bf;
          const u32x2 a0 = *(const u32x2*)(nA + (bb * 16 + fr) * 72 + 4 * fg);
          af.w[0] = a0[0]; af.w[1] = a0[1];
          bf.w[0] = pack2(X[ct2][0][0], X[ct2][0][1]); bf.w[1] = pack2(X[ct2][0][2], X[ct2][0][3]);
          if (bb >= 2) {
            const u32x2 a1 = *(const u32x2*)(nA + (bb * 16 + fr) * 72 + 16 + 4 * fg);
            af.w[2] = a1[0]; af.w[3] = a1[1];
            bf.w[2] = pack2(X[ct2][1][0], X[ct2][1][1]); bf.w[3] = pack2(X[ct2][1][2], X[ct2][1][3]);
          } else { af.w[2] = 0u; af.w[3] = 0u; bf.w[2] = 0u; bf.w[3] = 0u; }
          acc = __builtin_amdgcn_mfma_f32_16x16x32_bf16(af.v, bf.v, acc, 0, 0, 0);
          if (bb == 3) {
            const u32x2 a2 = *(const u32x2*)(nA + (bb * 16 + fr) * 72 + 32 + 4 * fg);
            af.w[0] = a2[0]; af.w[1] = a2[1]; af.w[2] = 0u; af.w[3] = 0u;
            bf.w[0] = pack2(X[ct2][2][0], X[ct2][2][1]); bf.w[1] = pack2(X[ct2][2][2], X[ct2][2][3]); bf.w[2] = 0u; bf.w[3] = 0u;
            acc = __builtin_amdgcn_mfma_f32_16x16x32_bf16(af.v, bf.v, acc, 0, 0, 0);
          }
        }
        {
          union { u32 w[4]; bf16x8 v; } af, bf;
          const u32x2 d0 = *(const u32x2*)(Nb + bb * 256 + fr * 16 + 4 * fg);
          af.w[0] = d0[0]; af.w[1] = d0[1]; af.w[2] = 0u; af.w[3] = 0u;
          bf.w[0] = pack2(acc[0], acc[1]); bf.w[1] = pack2(acc[2], acc[3]); bf.w[2] = 0u; bf.w[3] = 0u;
          const f32x4 z4 = {0.f, 0.f, 0.f, 0.f};
          X[ct2][bb] = __builtin_amdgcn_mfma_f32_16x16x32_bf16(af.v, bf.v, z4, 0, 0, 0);
        }
#pragma unroll
        for (int r = 0; r < 4; ++r) {
          const int i = bb * 16 + 4 * fg + r;
          if (isu) Ug[(tok0 + i) * 512 + h * 128 + cc] = f2bf(X[ct2][bb][r]);
          else Wg[(tok0 + i) * 512 + h * 128 + perm32(cc)] = f2bf(X[ct2][bb][r]);
        }
      }
    }
  }
}

__device__ __forceinline__ void phase2(const Params& p, unsigned char* smem) {
#ifndef NO_IDX
  for (int i = blockIdx.x; i < 2048; i += gridDim.x) idx_item(p, smem, i & 7, 255 - (i >> 3));
#endif
#ifndef NO_DNL
  if (!(p.flags & 1))
    for (int i = blockIdx.x; i < 2048; i += gridDim.x) dn_local_item(p, smem, i);
#endif
}

constexpr int SC_WP = 272, SC_KP = 144;
constexpr int SC_W = 0, SC_Q = 64 * SC_WP, SC_KT = 2 * 64 * SC_WP, SC_AT = SC_KT + 128 * SC_KP, SC_U = SC_AT + 64 * SC_KP,
              SC_BUF = SC_U + 64 * SC_WP;
constexpr int SC_GC = 2 * SC_BUF;
static_assert(SC_GC + 2 * 64 * 4 <= SMEM_BYTES, "scan LDS");

__device__ __forceinline__ void dn_scan_item(const Params& p, unsigned char* smem, int bh) {
  const int h = bh & 3, b = bh >> 2;
  const u16* Ug = (const u16*)((const unsigned char*)p.out + DO_U);
  const u16* Wg = (const u16*)((const unsigned char*)p.out + DO_W);
  const u16* QNg = (const u16*)((const unsigned char*)p.out + DO_QN);
  const u16* KNTg = (const u16*)((const unsigned char*)p.out + DO_KNT);
  const u16* ATTg = (const u16*)(p.ws + OFF_ATT);
  const float* GCg = (const float*)(p.ws + OFF_GC);
  const u16* PROJ = (const u16*)(p.ws + OFF_PROJ);
  u16* YDN = (u16*)(p.ws + OFF_YDN);
  const float* ogain = p.in[8];
  const int tid = TIDX, lane = tid & 63, wave = tid >> 6;
  const int fr = lane & 15, fg = lane >> 4;
  const int ecol = wave * 16 + fr;
  float* gcs = (float*)(smem + SC_GC);
  f32x4 S[8];
#pragma unroll
  for (int d = 0; d < 8; ++d) S[d] = (f32x4){0.f, 0.f, 0.f, 0.f};
  u32x4 st[9];
  float gcr = 0.f;
  const int r16 = tid >> 4, c16 = tid & 15;
  const int r8 = tid >> 3, c8 = tid & 7;
#define SCAN_LOAD(n_)                                                                                      \
  {                                                                                                        \
    const size_t tk0 = (size_t)b * SEQ + (size_t)(n_) * 64;                                                \
    const size_t it_ = (size_t)((b * 64 + (n_)) * 4 + h);                                                  \
    st[0] = *(const u32x4*)(Wg + (tk0 + r16) * 512 + h * 128 + c16 * 8);                                   \
    st[1] = *(const u32x4*)(Wg + (tk0 + r16 + 32) * 512 + h * 128 + c16 * 8);                              \
    st[2] = *(const u32x4*)(QNg + (tk0 + r16) * 512 + h * 128 + c16 * 8);                                  \
    st[3] = *(const u32x4*)(QNg + (tk0 + r16 + 32) * 512 + h * 128 + c16 * 8);                             \
    st[4] = *(const u32x4*)(KNTg + it_ * 8192 + (size_t)tid * 8);                                          \
    st[5] = *(const u32x4*)(KNTg + it_ * 8192 + (size_t)(tid + 512) * 8);                                  \
    st[6] = *(const u32x4*)(ATTg + it_ * 4096 + (size_t)tid * 8);                                          \
    st[7] = *(const u32x4*)(Ug + (tk0 + r16) * 512 + h * 128 + c16 * 8);                                   \
    st[8] = *(const u32x4*)(Ug + (tk0 + r16 + 32) * 512 + h * 128 + c16 * 8);                              \
    if (tid < 64) gcr = GCg[(tk0 + tid) * 4 + h];                                                          \
  }
#define SCAN_STORE(buf_)                                                                                   \
  {                                                                                                        \
    unsigned char* bs_ = smem + (buf_) * SC_BUF;                                                           \
    *(u32x4*)(bs_ + SC_W + r16 * SC_WP + c16 * 16) = st[0];                                                \
    *(u32x4*)(bs_ + SC_W + (r16 + 32) * SC_WP + c16 * 16) = st[1];                                         \
    *(u32x4*)(bs_ + SC_Q + r16 * SC_WP + c16 * 16) = st[2];                                                \
    *(u32x4*)(bs_ + SC_Q + (r16 + 32) * SC_WP + c16 * 16) = st[3];                                         \
    *(u32x4*)(bs_ + SC_KT + r8 * SC_KP + c8 * 16) = st[4];                                                 \
    *(u32x4*)(bs_ + SC_KT + (r8 + 64) * SC_KP + c8 * 16) = st[5];                                          \
    *(u32x4*)(bs_ + SC_AT + r8 * SC_KP + c8 * 16) = st[6];                                                 \
    *(u32x4*)(bs_ + SC_U + r16 * SC_WP + c16 * 16) = st[7];                                                \
    *(u32x4*)(bs_ + SC_U + (r16 + 32) * SC_WP + c16 * 16) = st[8];                                         \
    if (tid < 64) gcs[(buf_) * 64 + tid] = gcr;                                                            \
  }
  __syncthreads();
  SCAN_LOAD(0)
  SCAN_STORE(0)
  if (1 < 64) SCAN_LOAD(1)
  __syncthreads();
  for (int n = 0; n < 64; ++n) {
    const int buf = n & 1;
    const size_t tok0 = (size_t)b * SEQ + n * 64;
    if (n + 1 < 64) SCAN_STORE(buf ^ 1)
    if (n + 2 < 64) SCAN_LOAD(n + 2)
    __builtin_amdgcn_sched_barrier(0);
    const unsigned char* base = smem + buf * SC_BUF;
    const u32 ub0 = (u32)(tok0 + 4 * fg) * 512 + (u32)(h * 128 + ecol);
    const float* gcb = gcs + buf * 64 + 4 * fg;
    const float glast = gcs[buf * 64 + 63];
    bf16x8 Sb[4];
#pragma unroll
    for (int kk = 0; kk < 4; ++kk) {
      union { u32 w[4]; bf16x8 v; } cv;
      cv.w[0] = pack2(S[2 * kk][0], S[2 * kk][1]); cv.w[1] = pack2(S[2 * kk][2], S[2 * kk][3]);
      cv.w[2] = pack2(S[2 * kk + 1][0], S[2 * kk + 1][1]); cv.w[3] = pack2(S[2 * kk + 1][2], S[2 * kk + 1][3]);
      Sb[kk] = cv.v;
    }
    f32x4 vnew[4], ov[4];
#pragma unroll
    for (int m = 0; m < 4; ++m) {
      f32x4 aw = {0.f, 0.f, 0.f, 0.f}, aq = {0.f, 0.f, 0.f, 0.f};
#pragma unroll
      for (int kk = 0; kk < 4; ++kk) {
        bf16x8 wf = *(const bf16x8*)(base + SC_W + (m * 16 + fr) * SC_WP + kk * 64 + fg * 16);
        bf16x8 qf = *(const bf16x8*)(base + SC_Q + (m * 16 + fr) * SC_WP + kk * 64 + fg * 16);
        aw = __builtin_amdgcn_mfma_f32_16x16x32_bf16(wf, Sb[kk], aw, 0, 0, 0);
        aq = __builtin_amdgcn_mfma_f32_16x16x32_bf16(qf, Sb[kk], aq, 0, 0, 0);
      }
      f32x4 g4 = *(const f32x4*)(gcb + m * 16);
#pragma unroll
      for (int r = 0; r < 4; ++r) {
        float uv = bf2f(*(const u16*)(base + SC_U + (m * 16 + 4 * fg + r) * SC_WP + ecol * 2));
        vnew[m][r] = uv - aw[r];
        ov[m][r] = aq[r] * __expf(g4[r]);
      }
    }
    bf16x8 vb[2], vsb[2];
#pragma unroll
    for (int k2 = 0; k2 < 2; ++k2) {
      union { u32 w[4]; bf16x8 v; } c1, c2;
      const int ma = 2 * k2, mb = 2 * k2 + 1;
      c1.w[0] = pack2(vnew[ma][0], vnew[ma][1]); c1.w[1] = pack2(vnew[ma][2], vnew[ma][3]);
      c1.w[2] = pack2(vnew[mb][0], vnew[mb][1]); c1.w[3] = pack2(vnew[mb][2], vnew[mb][3]);
      f32x4 ga4 = *(const f32x4*)(gcb + ma * 16), gb4 = *(const f32x4*)(gcb + mb * 16);
      float sa[4], sb2[4];
#pragma unroll
      for (int r = 0; r < 4; ++r) { sa[r] = vnew[ma][r] * __expf(glast - ga4[r]); sb2[r] = vnew[mb][r] * __expf(glast - gb4[r]); }
      c2.w[0] = pack2(sa[0], sa[1]); c2.w[1] = pack2(sa[2], sa[3]);
      c2.w[2] = pack2(sb2[0], sb2[1]); c2.w[3] = pack2(sb2[2], sb2[3]);
      vb[k2] = c1.v; vsb[k2] = c2.v;
    }
    const float egl = __expf(glast);
#pragma unroll
    for (int d = 0; d < 8; ++d) {
      f32x4 a = S[d] * egl;
#pragma unroll
      for (int k2 = 0; k2 < 2; ++k2) {
        bf16x8 kf = *(const bf16x8*)(base + SC_KT + (d * 16 + fr) * SC_KP + k2 * 64 + fg * 16);
        a = __builtin_amdgcn_mfma_f32_16x16x32_bf16(kf, vsb[k2], a, 0, 0, 0);
      }
      S[d] = a;
    }
#pragma unroll
    for (int m = 0; m < 4; ++m) {
      f32x4 ao = ov[m];
#pragma unroll
      for (int k2 = 0; k2 < 2; ++k2) {
        bf16x8 af = *(const bf16x8*)(base + SC_AT + (m * 16 + fr) * SC_KP + k2 * 64 + fg * 16);
        ao = __builtin_amdgcn_mfma_f32_16x16x32_bf16(af, vb[k2], ao, 0, 0, 0);
      }
#pragma unroll
      for (int r = 0; r < 4; ++r) YDN[ub0 + (u32)((m * 16 + r) * 512)] = f2bf(ao[r]);
    }
    __syncthreads();
  }
#undef SCAN_LOAD
#undef SCAN_STORE
  asm volatile("s_waitcnt vmcnt(0)" ::: "memory");
  __syncthreads();
  {
    const int sub = lane >> 4, l16 = lane & 15;
    float gn8[8];
#pragma unroll
    for (int e = 0; e < 8; ++e) gn8[e] = ogain[l16 * 8 + e];
    for (int t = wave * 4 + sub; t < SEQ; t += 32) {
      const size_t tok = (size_t)b * SEQ + t;
      u16* yp = YDN + tok * 512 + h * 128 + l16 * 8;
      const u32x4 ov4 = *(const u32x4*)yp;
      const u32x4 zv4 = *(const u32x4*)(PROJ + tok * LDP + C_DZ + h * 128 + l16 * 8);
      float o8[8], z8[8];
#pragma unroll
      for (int c = 0; c < 4; ++c) { o8[2 * c] = bflo(ov4[c]); o8[2 * c + 1] = bfhi(ov4[c]); z8[2 * c] = bflo(zv4[c]); z8[2 * c + 1] = bfhi(zv4[c]); }
      float sq = 0.f;
#pragma unroll
      for (int e = 0; e < 8; ++e) sq += o8[e] * o8[e];
      sq += DPPF(sq, 0xb1); sq += DPPF(sq, 0x4e); sq += DPPF(sq, 0x141); sq += DPPF(sq, 0x140);
      const float rstd = rsqrtf(sq * (1.f / 128.f) + EPS);
      u32 w[4];
#pragma unroll
      for (int c = 0; c < 4; ++c) {
        const float y0 = o8[2 * c] * rstd * gn8[2 * c] * z8[2 * c] * sigmoidf_(z8[2 * c]);
        const float y1 = o8[2 * c + 1] * rstd * gn8[2 * c + 1] * z8[2 * c + 1] * sigmoidf_(z8[2 * c + 1]);
        w[c] = pack2(y0, y1);
      }
      *(u32x4*)yp = (u32x4){w[0], w[1], w[2], w[3]};
    }
  }
}

constexpr int AT_WAVE_BYTES = 8192 + 512 + 8192;
__device__ __forceinline__ float xor16_sum(float v) {
  auto r = __builtin_amdgcn_permlane16_swap(__float_as_uint(v), __float_as_uint(v), false, false);
  return __uint_as_float(r[0]) + __uint_as_float(r[1]);
}
__device__ __forceinline__ float xor32_sum(float v) {
  auto r = __builtin_amdgcn_permlane32_swap(__float_as_uint(v), __float_as_uint(v), false, false);
  return __uint_as_float(r[0]) + __uint_as_float(r[1]);
}
__device__ __forceinline__ u32 fp8x4(float a, float b, float c, float d) {
  int w = __builtin_amdgcn_cvt_pk_fp8_f32(a, b, 0, false);
  w = __builtin_amdgcn_cvt_pk_fp8_f32(c, d, w, true);
  return (u32)w;
}
__device__ __forceinline__ void attn_query(const Params& p, unsigned char* wsm, int b, int t) {
  typedef long i64;
  typedef int i32x2 __attribute__((ext_vector_type(2)));
  typedef __attribute__((address_space(3))) i32x2 lds_i32x2;
  const u16* PROJ = (const u16*)(p.ws + OFF_PROJ);
  const u16* SEL = (const u16*)(p.ws + OFF_SEL);
  const unsigned char* KVC8 = p.ws + OFF_KVC;
  u16* YATT = (u16*)(p.ws + OFF_YATT);
  const int lane = TIDX & 63;
  const int fr = lane & 15, fg = lane >> 4;
  float* P = (float*)wsm;
  u16* sl = (u16*)(wsm + 8192);
  const size_t tokb = (size_t)b * SEQ;
  const size_t tok = tokb + t;
  const int nsel = min(256, t + 1);
  i64 qb[2][2];
  {
    const u16* qrow = PROJ + tok * LDP + C_AQ + (fr & 3) * 64 + fg * 8;
#pragma unroll
    for (int g = 0; g < 2; ++g)
#pragma unroll
      for (int kk = 0; kk < 2; ++kk) {
        const u32x4 v = *(const u32x4*)(qrow + g * 256 + kk * 32);
        const u32 lo = fp8x4(bflo(v[0]) * 16.f, bfhi(v[0]) * 16.f, bflo(v[1]) * 16.f, bfhi(v[1]) * 16.f);
        const u32 hi = fp8x4(bflo(v[2]) * 16.f, bfhi(v[2]) * 16.f, bflo(v[3]) * 16.f, bfhi(v[3]) * 16.f);
        const i64 w = (i64)(((unsigned long long)hi << 32) | (unsigned long long)lo);
        qb[g][kk] = (fr < 4) ? w : (i64)0;
      }
    const u16* sr = SEL + tok * 256;
#pragma unroll
    for (int i = 0; i < 4; ++i) sl[lane + 64 * i] = sr[lane + 64 * i];
  }
  WAVE_LDS_SYNC();
  const int ngrp = (nsel + 15) >> 4;
  const int nbq = (ngrp + 1) >> 1;
  unsigned char* KST = wsm + 8192 + 512;
  const int kq = lane >> 3, kch = lane & 7;
  u32x4 kA[2][2], kB[2][2];
#define QK_LOAD(buf_, bi_)                                                                       \
  _Pragma("unroll") for (int j = 0; j < 2; ++j)                                                  \
    _Pragma("unroll") for (int hf = 0; hf < 2; ++hf) {                                           \
      const int ki_ = min(((bi_) * 2 + j) * 16 + hf * 8 + kq, 255);                              \
      const int s_ = (int)sl[ki_] & 4095;                                                        \
      buf_[j][hf] = *(const u32x4*)(KVC8 + (tokb + s_) * 256 + kch * 16);                        \
    }
#define QK_COMPUTE(buf_, bi_)                                                                    \
  {                                                                                              \
    _Pragma("unroll") for (int j = 0; j < 2; ++j)                                                \
      _Pragma("unroll") for (int hf = 0; hf < 2; ++hf) {                                         \
        const int row_ = hf * 8 + kq;                                                            \
        *(u32x4*)(KST + j * 2048 + row_ * 128 + ((kch ^ (row_ & 7)) << 4)) = buf_[j][hf];        \
      }                                                                                          \
    WAVE_LDS_SYNC();                                                                             \
    _Pragma("unroll") for (int j = 0; j < 2; ++j) {                                              \
      const unsigned char* kr_ = KST + j * 2048 + fr * 128 + 8 * (fg & 1);                       \
      const int sw_ = fr & 7, ch_ = fg >> 1;                                                     \
      const i64 a00_ = *(const i64*)(kr_ + (((0 + ch_) ^ sw_) << 4));                            \
      const i64 a01_ = *(const i64*)(kr_ + (((2 + ch_) ^ sw_) << 4));                            \
      const i64 a10_ = *(const i64*)(kr_ + (((4 + ch_) ^ sw_) << 4));                            \
      const i64 a11_ = *(const i64*)(kr_ + (((6 + ch_) ^ sw_) << 4));                            \
      f32x4 c0_ = {0.f, 0.f, 0.f, 0.f}, c1_ = {0.f, 0.f, 0.f, 0.f};                              \
      c0_ = __builtin_amdgcn_mfma_f32_16x16x32_fp8_fp8(a00_, qb[0][0], c0_, 0, 0, 0);            \
      c0_ = __builtin_amdgcn_mfma_f32_16x16x32_fp8_fp8(a01_, qb[0][1], c0_, 0, 0, 0);            \
      c1_ = __builtin_amdgcn_mfma_f32_16x16x32_fp8_fp8(a10_, qb[1][0], c1_, 0, 0, 0);            \
      c1_ = __builtin_amdgcn_mfma_f32_16x16x32_fp8_fp8(a11_, qb[1][1], c1_, 0, 0, 0);            \
      if (fr < 4) {                                                                              \
        _Pragma("unroll") for (int r = 0; r < 4; ++r) {                                          \
          const int kk2_ = ((bi_) * 2 + j) * 16 + 4 * fg + r;                                    \
          if (kk2_ < 256) {                                                                      \
            const bool v_ = kk2_ < nsel;                                                         \
            P[kk2_ * 8 + fr] = v_ ? c0_[r] * 0.0625f : -1e30f;                                   \
            P[kk2_ * 8 + 4 + fr] = v_ ? c1_[r] * 0.0625f : -1e30f;                               \
          }                                                                                      \
        }                                                                                        \
      }                                                                                          \
    }                                                                                            \
    WAVE_LDS_SYNC();                                                                             \
  }
  QK_LOAD(kA, 0)
  for (int bi = 0; bi < nbq; bi += 2) {
    if (bi + 1 < nbq) { QK_LOAD(kB, bi + 1) }
    QK_COMPUTE(kA, bi)
    if (bi + 2 < nbq) { QK_LOAD(kA, bi + 2) }
    if (bi + 1 < nbq) { QK_COMPUTE(kB, bi + 1) }
  }
#undef QK_LOAD
#undef QK_COMPUTE
  for (int ki = nbq * 32 + lane; ki < 256; ki += 64) {
    *(f32x4*)(P + ki * 8) = (f32x4){-1e30f, -1e30f, -1e30f, -1e30f};
    *(f32x4*)(P + ki * 8 + 4) = (f32x4){-1e30f, -1e30f, -1e30f, -1e30f};
  }
  WAVE_LDS_SYNC();
  float inv8[8];
  {
    float lg[4][8];
#pragma unroll
    for (int i = 0; i < 4; ++i) {
      f32x4 x0 = *(const f32x4*)(P + (lane + 64 * i) * 8), x1 = *(const f32x4*)(P + (lane + 64 * i) * 8 + 4);
      lg[i][0] = x0[0]; lg[i][1] = x0[1]; lg[i][2] = x0[2]; lg[i][3] = x0[3];
      lg[i][4] = x1[0]; lg[i][5] = x1[1]; lg[i][6] = x1[2]; lg[i][7] = x1[3];
    }
    WAVE_LDS_SYNC();
    unsigned char* PT8 = (unsigned char*)P;
#pragma unroll
    for (int hh = 0; hh < 8; ++hh) {
      float m = fmaxf(fmaxf(lg[0][hh], lg[1][hh]), fmaxf(lg[2][hh], lg[3][hh]));
      m = wave_max_dpp(m);
      float e[4], sum = 0.f;
#pragma unroll
      for (int i = 0; i < 4; ++i) { e[i] = __expf(lg[i][hh] - m); sum += e[i]; }
      sum = wave_sum_dpp(sum);
      inv8[hh] = __builtin_amdgcn_rcpf(sum) * (1.f / 256.f);
      const u32 w = fp8x4(e[0] * 256.f, e[1] * 256.f, e[2] * 256.f, e[3] * 256.f);
#pragma unroll
      for (int i = 0; i < 4; ++i) PT8[hh * 256 + lane + 64 * i] = (unsigned char)((w >> (8 * i)) & 0xffu);
    }
  }
  WAVE_LDS_SYNC();
  {
    const unsigned char* PT8 = (const unsigned char*)P;
    unsigned char* VST = wsm + 8192 + 512;
    const int trow = (lane & 15) >> 1, thalf = lane & 1;
    f32x4 oacc[2][4];
#pragma unroll
    for (int g = 0; g < 2; ++g)
#pragma unroll
      for (int c = 0; c < 4; ++c) oacc[g][c] = (f32x4){0.f, 0.f, 0.f, 0.f};
    const int nks = (nsel + 31) >> 5;
    u32x4 vA[4], vB[4];
#define PV_LOAD(buf_, ks_)                                                                       \
  _Pragma("unroll") for (int i = 0; i < 4; ++i) {                                                \
    const int ki_ = min((ks_) * 32 + i * 8 + kq, 255);                                           \
    const int s_ = (int)sl[ki_] & 4095;                                                          \
    buf_[i] = *(const u32x4*)(KVC8 + (tokb + s_) * 256 + 128 + kch * 16);                        \
  }
#define PV_COMPUTE(buf_, ks_)                                                                    \
  {                                                                                              \
    _Pragma("unroll") for (int i = 0; i < 4; ++i) {                                              \
      const int key_ = i * 8 + kq;                                                               \
      *(u32x4*)(VST + key_ * 128 + ((kch ^ (key_ & 7)) << 4)) = buf_[i];                         \
    }                                                                                            \
    WAVE_LDS_SYNC();                                                                             \
    i64 pa_[2];                                                                                  \
    _Pragma("unroll") for (int g = 0; g < 2; ++g) {                                              \
      const i64 t_ = *(const i64*)(PT8 + (g * 4 + (fr & 3)) * 256 + (ks_) * 32 + 8 * fg);        \
      pa_[g] = (fr < 4) ? t_ : (i64)0;                                                           \
    }                                                                                            \
    const int r1_ = 8 * fg + trow;                                                               \
    _Pragma("unroll") for (int g = 0; g < 2; ++g)                                                \
      _Pragma("unroll") for (int c = 0; c < 4; ++c) {                                            \
        const i32x2 tv_ = __builtin_amdgcn_ds_read_tr8_b64_v2i32((lds_i32x2*)(VST + r1_ * 128 + (((g * 4 + c) ^ (r1_ & 7)) << 4) + 8 * thalf)); \
        const i64 vb_ = (i64)(((unsigned long long)(u32)tv_[1] << 32) | (unsigned long long)(u32)tv_[0]); \
        oacc[g][c] = __builtin_amdgcn_mfma_f32_16x16x32_fp8_fp8(pa_[g], vb_, oacc[g][c], 0, 0, 0); \
      }                                                                                          \
    WAVE_LDS_SYNC();                                                                             \
  }
    PV_LOAD(vA, 0)
    for (int ks = 0; ks < nks; ks += 2) {
      if (ks + 1 < nks) { PV_LOAD(vB, ks + 1) }
      PV_COMPUTE(vA, ks)
      if (ks + 2 < nks) { PV_LOAD(vA, ks + 2) }
      if (ks + 1 < nks) { PV_COMPUTE(vB, ks + 1) }
    }
#undef PV_LOAD
#undef PV_COMPUTE
    if (lane < 16) {
#pragma unroll
      for (int g = 0; g < 2; ++g)
#pragma unroll
        for (int c = 0; c < 4; ++c)
#pragma unroll
          for (int r = 0; r < 4; ++r)
            YATT[tok * 512 + (g * 4 + r) * 64 + 16 * c + fr] = f2bf(oacc[g][c][r] * inv8[g * 4 + r]);
    }
  }
  WAVE_LDS_SYNC();
}

__device__ __forceinline__ void phase3(const Params& p, unsigned char* smem) {
  const int wave = TIDX >> 6;
#ifndef NO_SCAN
  if (blockIdx.x < 32) {
    if (!(p.flags & 2)) dn_scan_item(p, smem, blockIdx.x);
    __syncthreads();
  }
#endif
#ifdef NO_ATTN
  return;
#endif
  if (p.flags & 4) return;
  unsigned* qctr = (unsigned*)(p.ws + 1024 + ((p.flags & 128) ? 4096 : 0));
  const unsigned xcc = (unsigned)__builtin_amdgcn_s_getreg((3 << 11) | 20) & 7u;
  unsigned char* wsm = smem + wave * AT_WAVE_BYTES;
  for (unsigned db = 0; db < 8; ++db) {
    const int bb = (int)((xcc + db) & 7u);
    for (;;) {
      unsigned qi = 0;
      if ((TIDX & 63) == 0) qi = __hip_atomic_fetch_add(qctr + bb * 16, 1u, __ATOMIC_RELAXED, __HIP_MEMORY_SCOPE_AGENT);
      qi = (unsigned)__builtin_amdgcn_readfirstlane((int)qi);
      if (qi >= (unsigned)SEQ) break;
      attn_query(p, wsm, bb, SEQ - 1 - (int)qi);
    }
  }
}

__device__ __forceinline__ void hblk_load(unsigned char* reg, const u16* __restrict__ src, u32 ob, u32 ld, int lane) {
  const int c16 = lane & 7, r8 = lane >> 3;
#pragma unroll
  for (int it = 0; it < 8; ++it) {
    const int rl = it * 8 + r8;
    const u32x4 v = *(const u32x4*)(src + ob + (u32)rl * ld + (u32)(c16 * 8));
    *(u32x4*)(reg + rl * 128 + (((c16 + 2 * ((rl >> 2) & 3)) & 7) << 4)) = v;
    if ((it & 3) == 3) __builtin_amdgcn_sched_barrier(0);
  }
}
__device__ __forceinline__ void hblk_store(const unsigned char* reg, u16* __restrict__ dst, u32 ob, u32 ld, int lane) {
  const int c16 = lane & 7, r8 = lane >> 3;
#pragma unroll
  for (int it = 0; it < 8; ++it) {
    const int rl = it * 8 + r8;
    const u32x4 v = *(const u32x4*)(reg + rl * 128 + (((c16 + 2 * ((rl >> 2) & 3)) & 7) << 4));
    *(u32x4*)(dst + ob + (u32)rl * ld + (u32)(c16 * 8)) = v;
  }
}
__device__ __forceinline__ void phase4(const Params& p, unsigned char* smem) {
  const u16* YATT = (const u16*)(p.ws + OFF_YATT);
  const u16* YDN = (const u16*)(p.ws + OFF_YDN);
  const u16* WTA = (const u16*)(p.ws + OFF_WTA);
  const u16* WTB = (const u16*)(p.ws + OFF_WTB);
  const u16* PROJ = (const u16*)(p.ws + OFF_PROJ);
  u16* MG = (u16*)(p.ws + OFF_MERGED);
  const int ntn = DM / 256, ntiles = (MTOK / 256) * ntn;
  for (int t = blockIdx.x; t < ntiles; t += gridDim.x) {
    const int m0 = (t / ntn) * 256, n0 = (t % ntn) * 256;
    f32x4 acc[2][2][4][2];
#pragma unroll
    for (int pass = 0; pass < 2; ++pass) {
      gemm8_tile(pass ? YDN : YATT, pass ? WTB : WTA, 512, m0, n0, smem, acc);
      int lane = TIDX & 63;
      asm volatile("" : "+v"(lane));
      const int wave = TIDX >> 6, wr = wave >> 2, wc = wave & 3, fr = lane & 15, fq = lane >> 4;
      unsigned char* regG = smem + wave * 16384;
      unsigned char* regT = regG + 8192;
      const int lrot = (fr >> 3) + 2 * fq;
      int off4[4];
#pragma unroll
      for (int jj = 0; jj < 4; ++jj) off4[jj] = (4 * fq) * 128 + (fr & 7) * 2 + (((jj * 2 + lrot) & 7) << 4);
#pragma unroll
      for (int ai = 0; ai < 2; ++ai) {
        const u32 gb0 = (u32)(m0 + ai * 128 + wr * 64) * LDP + (u32)(n0 + wc * 64) + (u32)(pass ? C_GB : C_GA);
        const u32 ob0 = (u32)(m0 + ai * 128 + wr * 64) * DM + (u32)(n0 + wc * 64);
        hblk_load(regG, PROJ, gb0, LDP, lane);
        if (pass == 1) hblk_load(regT, MG, ob0, DM, lane);
        WAVE_LDS_SYNC();
#pragma unroll
        for (int m = 0; m < 4; ++m)
#pragma unroll
          for (int r = 0; r < 4; ++r)
#pragma unroll
            for (int bj = 0; bj < 2; ++bj)
#pragma unroll
              for (int n = 0; n < 2; ++n) {
                const int o = off4[bj * 2 + n] + (m * 16 + r) * 128;
                float v = sigmoidf_(bf2f(*(const u16*)(regG + o))) * acc[ai][bj][m][n][r];
                if (pass == 1) v += bf2f(*(const u16*)(regT + o));
                *(u16*)(regT + o) = f2bf(v);
              }
        WAVE_LDS_SYNC();
        hblk_store(regT, MG, ob0, DM, lane);
        WAVE_LDS_SYNC();
      }
      asm volatile("s_waitcnt vmcnt(0)" ::: "memory");
    }
  }
}

__device__ __forceinline__ void phase5(const Params& p, unsigned char* smem) {
  const u16* MG = (const u16*)(p.ws + OFF_MERGED);
  const u16* WTO = (const u16*)(p.ws + OFF_WTO);
  const float* x = p.in[0];
  const int lane = TIDX & 63, wave = TIDX >> 6;
  const int wr = wave >> 2, wc = wave & 3, fr = lane & 15, fq = lane >> 4;
  const int ntn = DM / 256, ntiles = (MTOK / 256) * ntn;
  for (int t = blockIdx.x; t < ntiles; t += gridDim.x) {
    const int m0 = (t / ntn) * 256, n0 = (t % ntn) * 256;
    f32x4 acc[2][2][4][2];
    gemm8_tile(MG, WTO, DM, m0, n0, smem, acc);
    const u32 ob0 = (u32)(m0 + wr * 64 + 4 * fq) * DM + (u32)(n0 + wc * 64 + fr);
    float* outp = p.out;
#pragma unroll
    for (int ai = 0; ai < 2; ++ai)
#pragma unroll
      for (int m = 0; m < 4; ++m) {
#pragma unroll
        for (int bj = 0; bj < 2; ++bj)
#pragma unroll
          for (int n = 0; n < 2; ++n)
#pragma unroll
            for (int j = 0; j < 4; ++j) {
              u32 o = ob0 + (u32)((ai * 128 + m * 16 + j) * DM + (bj * 2 + n) * 16);
              outp[o] = x[o] + acc[ai][bj][m][n][j];
            }
        __builtin_amdgcn_sched_barrier(0);
      }
  }
}

__device__ __forceinline__ void phase6(const Params& p, unsigned char* smem) {
  const u16* H2 = (const u16*)(p.ws + OFF_H2);
  const u16* WTQ = (const u16*)(p.ws + OFF_WTQ);
  u16* QP = (u16*)(p.ws + OFF_QP);
  const int lane = TIDX & 63, wave = TIDX >> 6;
  const int wr = wave >> 2, wc = wave & 3, fr = lane & 15, fq = lane >> 4;
  const int ntn = 2048 / 256, ntiles = (MTOK / 256) * ntn;
  for (int t = blockIdx.x; t < ntiles; t += gridDim.x) {
    const int m0 = (t / ntn) * 256, n0 = (t % ntn) * 256;
    f32x4 acc[2][2][4][2];
    gemm8_tile(H2, WTQ, DM, m0, n0, smem, acc);
    ep_store<2048, false>(QP, (u32)(m0 + wr * 64) * 2048 + (u32)(n0 + wc * 64), acc, nullptr, 1.f, smem, wave, lane);
  }
}

__device__ __forceinline__ int mono_key(float v) { int b = __float_as_int(v); return b ^ ((b >> 31) & 0x7fffffff); }
__device__ __forceinline__ float unmono_key(int k) { return __int_as_float(k ^ ((k >> 31) & 0x7fffffff)); }
__device__ __forceinline__ void chain16(int (&k)[16], int x) {
#pragma unroll
  for (int j = 0; j < 16; ++j) { int hi = max(k[j], x); x = min(k[j], x); k[j] = hi; }
}

#define CE_DESC(a, b) { const int hi_ = max(a, b), lo_ = min(a, b); a = hi_; b = lo_; }
__device__ __forceinline__ void sort16_desc(int (&k)[16]) {
#pragma unroll
  for (int size = 2; size <= 16; size <<= 1) {
#pragma unroll
    for (int stride = size >> 1; stride > 0; stride >>= 1) {
#pragma unroll
      for (int i = 0; i < 16; ++i) {
        const int l = i ^ stride;
        if (l > i) {
          if ((i & size) == 0) CE_DESC(k[i], k[l]) else CE_DESC(k[l], k[i])
        }
      }
    }
  }
}
__device__ __forceinline__ void merge_top16(int (&a)[16], const int (&b)[16]) {
#pragma unroll
  for (int i = 0; i < 16; ++i) a[i] = max(a[i], b[15 - i]);
#pragma unroll
  for (int stride = 8; stride > 0; stride >>= 1) {
#pragma unroll
    for (int i = 0; i < 16; ++i) {
      const int l = i ^ stride;
      if (l > i) CE_DESC(a[i], a[l])
    }
  }
}

constexpr int P7_LD = 132;
__device__ __forceinline__ void phase7(const Params& p, unsigned char* smem) {
  const u16* QP = (const u16*)(p.ws + OFF_QP);
  const u16* SKB = (const u16*)(p.ws + OFF_SKB);
  float* TOPS = (float*)(p.ws + OFF_TOPS);
  u8* TOPI = (u8*)(p.ws + OFF_TOPI);
  const int tid = TIDX, lane = tid & 63, wave = tid >> 6;
  const int wm = wave >> 1, wn = wave & 1, fr = lane & 15, fg = lane >> 4;
  const int ntiles = (MTOK / G_BM) * 16;
  float* tile = (float*)smem;
  for (int t = blockIdx.x; t < ntiles; t += gridDim.x) {
    const int m0 = (t >> 4) * G_BM, hp = t & 15;
    f32x4 acc[4][4];
    gemm_mainloop(QP + hp * 128, 2048, SKB + (size_t)hp * 128 * 128, 128, 128, m0, 0, smem, acc);
#pragma unroll
    for (int i = 0; i < 4; ++i)
#pragma unroll
      for (int j = 0; j < 4; ++j)
#pragma unroll
        for (int r = 0; r < 4; ++r) {
          int row = wm * 64 + i * 16 + 4 * fg + r, col = wn * 64 + j * 16 + fr;
          tile[row * P7_LD + col] = acc[i][j][r];
        }
    __syncthreads();
    {
      const int row = tid >> 1, half = tid & 1;
      int k[16];
      const float* rowp = tile + row * P7_LD + half * 64;
#pragma unroll
      for (int grp = 0; grp < 4; ++grp) {
        int gk[16];
#pragma unroll
        for (int c = 0; c < 16; c += 4) {
          f32x4 v = *(const f32x4*)(rowp + grp * 16 + c);
          const int ib = 127 - (half * 64 + grp * 16 + c);
          gk[c] = (mono_key(v[0]) & ~127) | ib;
          gk[c + 1] = (mono_key(v[1]) & ~127) | (ib - 1);
          gk[c + 2] = (mono_key(v[2]) & ~127) | (ib - 2);
          gk[c + 3] = (mono_key(v[3]) & ~127) | (ib - 3);
        }
        sort16_desc(gk);
        if (grp == 0) {
#pragma unroll
          for (int j = 0; j < 16; ++j) k[j] = gk[j];
        } else merge_top16(k, gk);
      }
      {
        int other[16];
#pragma unroll
        for (int j = 0; j < 16; ++j) other[j] = DPPI(k[j], 0xb1);
        merge_top16(k, other);
      }
      if (half == 0) {
        size_t o = ((size_t)(m0 + row) * 16 + hp) * 16;
        float vals[16]; int idx[16];
#pragma unroll
        for (int j = 0; j < 16; ++j) { idx[j] = 127 - (k[j] & 127); vals[j] = tile[row * P7_LD + idx[j]]; }
#pragma unroll
        for (int j = 0; j < 16; j += 4) *(f32x4*)(TOPS + o + j) = (f32x4){vals[j], vals[j + 1], vals[j + 2], vals[j + 3]};
#pragma unroll
        for (int j = 0; j < 16; j += 4)
          *(u32*)(TOPI + o + j) = (u32)idx[j] | ((u32)idx[j + 1] << 8) | ((u32)idx[j + 2] << 16) | ((u32)idx[j + 3] << 24);
      }
    }
    __syncthreads();
  }
}

__device__ __forceinline__ void phase7b(const Params& p) {
  const float* TOPS = (const float*)(p.ws + OFF_TOPS);
  const u8* TOPI = (const u8*)(p.ws + OFF_TOPI);
  int* EXPERT = (int*)(p.ws + OFF_EXPERT);
  float* GATE = (float*)(p.ws + OFF_GATE);
  for (int w = blockIdx.x * NTHREADS + TIDX; w < MTOK * 8; w += gridDim.x * NTHREADS) {
    const size_t o = (size_t)w * 32;
    float sa[16], sb[16];
#pragma unroll
    for (int k = 0; k < 16; k += 4) {
      float4 v = *(const float4*)(TOPS + o + k); sa[k] = v.x; sa[k + 1] = v.y; sa[k + 2] = v.z; sa[k + 3] = v.w;
      float4 u = *(const float4*)(TOPS + o + 16 + k); sb[k] = u.x; sb[k + 1] = u.y; sb[k + 2] = u.z; sb[k + 3] = u.w;
    }
    int cand[64];
#pragma unroll
    for (int k = 0; k < 64; ++k) cand[k] = (int)0x80000000;
    {
      int cnt = 0;
#pragma unroll
      for (int a = 0; a < 16; ++a)
#pragma unroll
        for (int bb = 0; bb < 16; ++bb)
          if ((a + 1) * (bb + 1) <= 16) { cand[cnt] = (mono_key(sa[a] + sb[bb]) & ~255) | (255 - (a * 16 + bb)); ++cnt; }
    }
    int kk[16];
#pragma unroll
    for (int grp = 0; grp < 4; ++grp) {
      int gk[16];
#pragma unroll
      for (int j = 0; j < 16; ++j) gk[j] = cand[grp * 16 + j];
      sort16_desc(gk);
      if (grp == 0) {
#pragma unroll
        for (int j = 0; j < 16; ++j) kk[j] = gk[j];
      } else merge_top16(kk, gk);
    }
    float vals[16];
#pragma unroll
    for (int k = 0; k < 16; ++k) vals[k] = unmono_key(kk[k] & ~255);
    float m = vals[0], s = 0.f, e[16];
#pragma unroll
    for (int k = 0; k < 16; ++k) { e[k] = __expf(vals[k] - m); s += e[k]; }
    float inv = 1.f / s;
#pragma unroll
    for (int k = 0; k < 16; ++k) {
      const int ci = 255 - (kk[k] & 255);
      int a = ci >> 4, bb = ci & 15;
      int ex = (int)TOPI[o + a] * 128 + (int)TOPI[o + 16 + bb];
      EXPERT[(size_t)w * 16 + k] = ex;
      GATE[(size_t)w * 16 + k] = e[k] * inv;
    }
  }
  {
    const int lane = TIDX & 63, wave = TIDX >> 6;
    for (int row = blockIdx.x * 8 + wave; row < 2 * 16384; row += gridDim.x * 8) {
      const int tbl = row >> 14, r = row & 16383;
      const f32x4* src = (const f32x4*)((tbl ? p.in[16] : p.in[15]) + (size_t)r * DM) + 4 * lane;
      f32x4 x[4];
      float amax = 0.f;
#pragma unroll
      for (int i = 0; i < 4; ++i) {
        x[i] = src[i];
        amax = fmaxf(amax, fmaxf(fmaxf(fabsf(x[i][0]), fabsf(x[i][1])), fmaxf(fabsf(x[i][2]), fabsf(x[i][3]))));
      }
      amax = wave_max_dpp(amax);
      const float inv = amax > 0.f ? 127.f / amax : 0.f;
      const int bias = 0;
      u32x4 o;
#pragma unroll
      for (int i = 0; i < 4; ++i) {
        int q0 = (int)rintf(x[i][0] * inv) + bias, q1 = (int)rintf(x[i][1] * inv) + bias;
        int q2 = (int)rintf(x[i][2] * inv) + bias, q3 = (int)rintf(x[i][3] * inv) + bias;
        o[i] = (u32)(q0 & 0xff) | ((u32)(q1 & 0xff) << 8) | ((u32)(q2 & 0xff) << 16) | ((u32)(q3 & 0xff) << 24);
      }
      *(u32x4*)(p.ws + (tbl ? OFF_VQ : OFF_UQ) + ((size_t)(lane >> 3) * 16384 + r) * 128 + (lane & 7) * 16) = o;
      if (lane == 0) ((float*)(p.ws + (tbl ? OFF_VS : OFF_US)))[r] = amax * (1.f / 127.f);
    }
  }
}

__device__ __forceinline__ void phase8a(const Params& p) {
  const int* EXPERT = (const int*)(p.ws + OFF_EXPERT);
  const unsigned char* UQS = p.ws + OFF_UQ;
  const unsigned char* H2Q = p.ws + OFF_H2Q;
  int* PD = (int*)(p.ws + OFF_PD);
  unsigned* ctr = (unsigned*)(p.ws + 2048 + ((p.flags & 128) ? 4096 : 0));
  const unsigned xcc = (unsigned)__builtin_amdgcn_s_getreg((3 << 11) | 20) & 7u;
  const int lane = TIDX & 63, g8 = lane >> 3, l8 = lane & 7;
  for (unsigned db = 0; db < 8; ++db) {
    const int x = (int)((xcc + db) & 7u);
    for (;;) {
      unsigned ci = 0;
      if (lane == 0) ci = __hip_atomic_fetch_add(ctr + x * 16, 1u, __ATOMIC_RELAXED, __HIP_MEMORY_SCOPE_AGENT);
      ci = (unsigned)__builtin_amdgcn_readfirstlane((int)ci);
      if (ci >= (unsigned)(MTOK / 16)) break;
#pragma unroll 1
      for (int tt = 0; tt < 16; ++tt) {
        const int tok = (int)ci * 16 + tt;
        const int e0 = EXPERT[(size_t)tok * 128 + lane], e1 = EXPERT[(size_t)tok * 128 + 64 + lane];
        const u32x4 hq = *(const u32x4*)(H2Q + (size_t)tok * DM + x * 128 + l8 * 16);
        u32x4 ua[16];
#pragma unroll
        for (int i = 0; i < 16; ++i) {
          const int k = i * 8 + g8;
          const int ek = __shfl(i < 8 ? e0 : e1, k & 63);
          ua[i] = *(const u32x4*)(UQS + ((size_t)(x * 16384 + ek)) * 128 + l8 * 16);
        }
        int keep0 = 0, keep1 = 0;
#pragma unroll
        for (int i = 0; i < 16; ++i) {
          int sd = 0;
#pragma unroll
          for (int c = 0; c < 4; ++c) sd = __builtin_amdgcn_sdot4((int)ua[i][c], (int)hq[c], sd, false);
          sd += DPPI(sd, 0xb1); sd += DPPI(sd, 0x4e); sd += DPPI(sd, 0x141);
          if (i < 8) keep0 = (l8 == (i & 7)) ? sd : keep0; else keep1 = (l8 == (i & 7)) ? sd : keep1;
        }
        int* pd = PD + ((size_t)x * MTOK + tok) * 128 + l8 * 8 + g8;
        pd[0] = keep0; pd[64] = keep1;
      }
    }
  }
}

__device__ __forceinline__ void phase8c(const Params& p) {
  const int* EXPERT = (const int*)(p.ws + OFF_EXPERT);
  const float* GATE = (const float*)(p.ws + OFF_GATE);
  const float* US = (const float*)(p.ws + OFF_US);
  const float* VS = (const float*)(p.ws + OFF_VS);
  const float* HS = (const float*)(p.ws + OFF_HS);
  const int* PD = (const int*)(p.ws + OFF_PD);
  unsigned char* CQ8 = p.ws + OFF_CQ8;
  float* QSC = (float*)(p.ws + OFF_QSC);
  const int lane = TIDX & 63, wave = TIDX >> 6;
  for (int tok = blockIdx.x * 8 + wave; tok < MTOK; tok += gridDim.x * 8) {
    const int e0 = EXPERT[(size_t)tok * 128 + lane], e1 = EXPERT[(size_t)tok * 128 + 64 + lane];
    const float g0 = GATE[(size_t)tok * 128 + lane], g1 = GATE[(size_t)tok * 128 + 64 + lane];
    int s0 = 0, s1 = 0;
#pragma unroll
    for (int xx = 0; xx < 8; ++xx) {
      s0 += PD[((size_t)xx * MTOK + tok) * 128 + lane];
      s1 += PD[((size_t)xx * MTOK + tok) * 128 + 64 + lane];
    }
    const float hs = HS[tok];
    const float d0 = (float)s0 * US[e0] * hs, d1 = (float)s1 * US[e1] * hs;
    const float cf0 = g0 * 0.5f * d0 * (1.f + erff(d0 * 0.70710678118654752f)) * VS[e0];
    const float cf1 = g1 * 0.5f * d1 * (1.f + erff(d1 * 0.70710678118654752f)) * VS[e1];
    const float cmax = wave_max_dpp(fmaxf(fabsf(cf0), fabsf(cf1)));
    const float qinv = cmax > 0.f ? 32639.f / cmax : 0.f;
    const int c0 = (int)rintf(cf0 * qinv), c1 = (int)rintf(cf1 * qinv);
    const int h0 = (c0 + 128) >> 8, h1 = (c1 + 128) >> 8;
    unsigned char* cq = CQ8 + (size_t)tok * 256;
    cq[lane] = (unsigned char)(h0 & 0xff); cq[64 + lane] = (unsigned char)(h1 & 0xff);
    cq[128 + lane] = (unsigned char)((c0 - 256 * h0) & 0xff); cq[192 + lane] = (unsigned char)((c1 - 256 * h1) & 0xff);
    if (lane == 0) QSC[tok] = cmax * (1.f / 32639.f);
  }
}

#ifndef TR8_VARIANT
#define TR8_VARIANT 0
#endif
__device__ __forceinline__ void phase8b(const Params& p, unsigned char* smem) {
  typedef int i32x4 __attribute__((ext_vector_type(4)));
  typedef int i32x2 __attribute__((ext_vector_type(2)));
  typedef __attribute__((address_space(3))) i32x2 lds_i32x2;
  const int* EXPERT = (const int*)(p.ws + OFF_EXPERT);
  const unsigned char* VQS = p.ws + OFF_VQ;
  const unsigned char* CQ8 = p.ws + OFF_CQ8;
  const float* QSC = (const float*)(p.ws + OFF_QSC);
  unsigned* ctr = (unsigned*)(p.ws + 3072 + ((p.flags & 128) ? 4096 : 0));
  const unsigned xcc = (unsigned)__builtin_amdgcn_s_getreg((3 << 11) | 20) & 7u;
  const int lane = TIDX & 63, wave = TIDX >> 6, g8 = lane >> 3, l8 = lane & 7;
  const int fr = lane & 15, fg = lane >> 4;
  unsigned char* VST = smem + wave * 16384;
#if TR8_VARIANT == 0
  const int trow = (lane & 15) >> 1, thalf = lane & 1;
#else
  const int trow = lane & 7, thalf = (lane & 15) >> 3;
#endif
  __syncthreads();
  for (unsigned db = 0; db < 8; ++db) {
    const int x = (int)((xcc + db) & 7u);
    for (;;) {
      unsigned ci = 0;
      if (lane == 0) ci = __hip_atomic_fetch_add(ctr + x * 16, 1u, __ATOMIC_RELAXED, __HIP_MEMORY_SCOPE_AGENT);
      ci = (unsigned)__builtin_amdgcn_readfirstlane((int)ci);
      if (ci >= (unsigned)(MTOK / 16)) break;
#pragma unroll 1
      for (int tt = 0; tt < 16; ++tt) {
        const int tok = (int)ci * 16 + tt;
        const int e0 = EXPERT[(size_t)tok * 128 + lane], e1 = EXPERT[(size_t)tok * 128 + 64 + lane];
        u32x4 va[16];
#pragma unroll
        for (int i = 0; i < 16; ++i) {
          const int k = i * 8 + g8;
          const int ek = __shfl(i < 8 ? e0 : e1, k & 63);
          va[i] = *(const u32x4*)(VQS + ((size_t)(x * 16384 + ek)) * 128 + l8 * 16);
        }
        i32x4 af[2];
#pragma unroll
        for (int sx = 0; sx < 2; ++sx) {
          af[sx] = *(const i32x4*)(CQ8 + (size_t)tok * 256 + (fr & 1) * 128 + sx * 64 + fg * 16);
          if (fr >= 2) af[sx] = (i32x4){0, 0, 0, 0};
        }
        const float qsc = QSC[tok];
#pragma unroll
        for (int i = 0; i < 16; ++i) {
          const int k = i * 8 + g8;
          *(u32x4*)(VST + k * 128 + ((l8 ^ g8) << 4)) = va[i];
        }
        WAVE_LDS_SYNC();
        i32x4 acc[8];
#pragma unroll
        for (int c = 0; c < 8; ++c) acc[c] = (i32x4){0, 0, 0, 0};
#pragma unroll
        for (int sx = 0; sx < 2; ++sx) {
          const int r1 = sx * 64 + fg * 16 + trow, r2 = r1 + 8;
#pragma unroll
          for (int c = 0; c < 8; ++c) {
            const i32x2 lo = __builtin_amdgcn_ds_read_tr8_b64_v2i32((lds_i32x2*)(VST + r1 * 128 + ((c ^ (r1 & 7)) << 4) + 8 * thalf));
            const i32x2 hi = __builtin_amdgcn_ds_read_tr8_b64_v2i32((lds_i32x2*)(VST + r2 * 128 + ((c ^ (r2 & 7)) << 4) + 8 * thalf));
            const i32x4 bf = {lo[0], lo[1], hi[0], hi[1]};
            acc[c] = __builtin_amdgcn_mfma_i32_16x16x64_i8(af[sx], bf, acc[c], 0, 0, 0);
          }
        }
        WAVE_LDS_SYNC();
        if (lane < 16 && !(p.flags & 32)) {
          float* op = p.out + (size_t)tok * DM + x * 128 + fr;
#pragma unroll
          for (int c = 0; c < 8; ++c) op[16 * c] += ((float)acc[c][0] * 256.f + (float)acc[c][1]) * qsc;
        }
      }
    }
  }
}

__device__ __forceinline__ void grid_barrier(unsigned* ctr, unsigned target) {
  asm volatile("s_waitcnt vmcnt(0)" ::: "memory");
  __syncthreads();
  if (TIDX == 0) {
    __builtin_amdgcn_fence(__ATOMIC_RELEASE, "agent");
    asm volatile("s_waitcnt vmcnt(0)" ::: "memory");
    __hip_atomic_fetch_add(ctr, 1u, __ATOMIC_RELAXED, __HIP_MEMORY_SCOPE_AGENT);
    while (__hip_atomic_load(ctr, __ATOMIC_RELAXED, __HIP_MEMORY_SCOPE_AGENT) < target) __builtin_amdgcn_s_sleep(2);
    __builtin_amdgcn_fence(__ATOMIC_ACQUIRE, "agent");
    asm volatile("s_waitcnt vmcnt(0)" ::: "memory");
  }
  __syncthreads();
}

__global__ void __launch_bounds__(NTHREADS, 2) mk_fwd(Params p) {
  cg::grid_group grid = cg::this_grid();
  __shared__ __attribute__((aligned(16))) unsigned char smem[SMEM_BYTES];
  const int lo = p.ph_lo, hi = p.ph_hi;
#define RUN(k, call) if (lo <= (k) && (k) < hi) { call; if ((k) + 1 < hi) { if ((k) == lo) grid.sync(); else grid_barrier((unsigned*)p.ws, (unsigned)((k) - lo) * gridDim.x); } }
  RUN(0, phase0(p, smem))
  RUN(1, phase1(p, smem))
  RUN(2, phase2(p, smem))
  RUN(3, phase3(p, smem))
  RUN(4, phase4(p, smem))
  RUN(5, phase5(p, smem))
  RUN(6, rmsnorm_rows<true>(p.out, p.in[12], (u16*)(p.ws + OFF_H2), p.ws + OFF_H2Q, (float*)(p.ws + OFF_HS)))
  RUN(7, phase6(p, smem))
  RUN(8, phase7(p, smem))
  RUN(9, phase7b(p))
  RUN(10, phase8a(p))
  RUN(11, phase8c(p))
  RUN(12, phase8b(p, smem))
#undef RUN
}

extern "C" void kernel_launch(void* const* d_in, const int* in_sizes, int n_in,
                              void* d_out, int out_size, void* d_ws, size_t ws_size,
                              hipStream_t stream) {
  static int grid_blocks = 0;
  if (!grid_blocks) {
    int dev = 0, cus = 0, per_cu = 0;
    (void)hipGetDevice(&dev);
    (void)hipDeviceGetAttribute(&cus, hipDeviceAttributeMultiprocessorCount, dev);
    (void)hipOccupancyMaxActiveBlocksPerMultiprocessor(&per_cu, mk_fwd, NTHREADS, 0);
    if (per_cu < 1) per_cu = 1;
    if (per_cu > 1) per_cu = 1;
    grid_blocks = cus * per_cu;
    fprintf(stderr, "mk_fwd: cus=%d per_cu=%d grid=%d ws=%zu\n", cus, per_cu, grid_blocks, ws_size);
  }
  Params p{};
  for (int i = 0; i < 17 && i < n_in; ++i) p.in[i] = (const float*)d_in[i];
  p.out = (float*)d_out;
  p.ws = (unsigned char*)d_ws;
  p.ph_lo = 0; p.ph_hi = 13;
  (void)hipMemsetAsync(d_ws, 0, 8192, stream);
  void* args[] = {&p};
  hipError_t e = hipLaunchCooperativeKernel((void*)mk_fwd, dim3(grid_blocks), dim3(NTHREADS), args, 0, stream);
  if (e != hipSuccess) fprintf(stderr, "cooperative launch failed: %s (grid %d)\n", hipGetErrorString(e), grid_blocks);
#ifdef EXTRA_LO
  {
    Params p2 = p;
    p2.ph_lo = EXTRA_LO; p2.ph_hi = EXTRA_HI; p2.flags = EXTRA_FLAGS;
    void* args2[] = {&p2};
    (void)hipLaunchCooperativeKernel((void*)mk_fwd, dim3(grid_blocks), dim3(NTHREADS), args2, 0, stream);
  }
#endif
}
```

```cpp
#include <hip/hip_runtime.h>
#include <hip/hip_bf16.h>
#include <hip/hip_cooperative_groups.h>
#include <cstdio>
#include <cstdint>
namespace cg = cooperative_groups;

typedef unsigned short u16;
typedef unsigned int u32;
typedef unsigned char u8;
typedef short bf16x8 __attribute__((ext_vector_type(8)));
typedef float f32x4 __attribute__((ext_vector_type(4)));
typedef unsigned int u32x4 __attribute__((ext_vector_type(4)));
typedef unsigned int u32x2 __attribute__((ext_vector_type(2)));

constexpr int NTHREADS = 512;
constexpr int BATCH = 8, SEQ = 4096, DM = 1024, MTOK = BATCH * SEQ;
constexpr int LDP = 5120;
constexpr int NPADW = 5632;
constexpr int C_AQ = 0, C_IQ = 512, C_DQ = 1024, C_DK = 1536, C_DV = 2048, C_DZ = 2560, C_GA = 3072, C_GB = 4096;
constexpr int N_AK = 5120, N_AV = 5248, N_IK = 5376, N_SM = 5440;
constexpr size_t MiB = 1ull << 20;
constexpr size_t OFF_WTIN = 1 * MiB, OFF_WTA = 12 * MiB, OFF_WTB = 13 * MiB, OFF_WTO = 14 * MiB, OFF_WTQ = 16 * MiB,
                 OFF_SKB = 20 * MiB, OFF_SMALL = 21 * MiB, OFF_H = 23 * MiB, OFF_ATT = 23 * MiB, OFF_GC = 39 * MiB,
                 OFF_MERGED = 23 * MiB, OFF_PROJ = 87 * MiB, OFF_KVC = 407 * MiB, OFF_IKC = 423 * MiB, OFF_SEL = 427 * MiB, OFF_YATT = 443 * MiB,
                 OFF_YDN = 475 * MiB;
constexpr size_t OFF_H2 = OFF_PROJ, OFF_QP = OFF_PROJ + 64 * MiB, OFF_TOPS = OFF_PROJ + 192 * MiB,
                 OFF_TOPI = OFF_PROJ + 224 * MiB, OFF_EXPERT = OFF_PROJ + 232 * MiB, OFF_GATE = OFF_PROJ + 248 * MiB;
constexpr size_t OFF_UQ = OFF_PROJ + 264 * MiB, OFF_VQ = OFF_PROJ + 280 * MiB, OFF_US = OFF_PROJ + 296 * MiB, OFF_VS = OFF_PROJ + 297 * MiB;
constexpr size_t OFF_CQ8 = 56 * MiB, OFF_QSC = 64 * MiB;
constexpr size_t OFF_H2Q = 23 * MiB, OFF_HS = 55 * MiB, OFF_PD = OFF_PROJ + 64 * MiB;
constexpr size_t DO_U = 0, DO_W = 32 * MiB, DO_QN = 64 * MiB, DO_KNT = 96 * MiB;

constexpr int SMEM_BYTES = 162816;
constexpr float EPS = 1e-6f;

struct Params {
  const float* in[17];
  float* out;
  unsigned char* ws;
  int ph_lo, ph_hi;
  int flags, pad;
};

typedef __bf16 bf16x2_t __attribute__((ext_vector_type(2)));
typedef float f32x2_t __attribute__((ext_vector_type(2)));
__device__ __forceinline__ u32 pack2(float a, float b) {
  f32x2_t f = {a, b};
  return __builtin_bit_cast(u32, __builtin_convertvector(f, bf16x2_t));
}
__device__ __forceinline__ u16 f2bf(float f) { return (u16)(pack2(f, f) & 0xffffu); }
__device__ __forceinline__ float bf2f(u16 h) { return __uint_as_float(((u32)h) << 16); }
__device__ __forceinline__ float bflo(u32 w) { return __uint_as_float(w << 16); }
__device__ __forceinline__ float bfhi(u32 w) { return __uint_as_float(w & 0xffff0000u); }
__device__ __forceinline__ float wave_sum(float v) {
#pragma unroll
  for (int o = 32; o > 0; o >>= 1) v += __shfl_xor(v, o);
  return v;
}
__device__ __forceinline__ float wave_max(float v) {
#pragma unroll
  for (int o = 32; o > 0; o >>= 1) v = fmaxf(v, __shfl_xor(v, o));
  return v;
}
__device__ __forceinline__ float dot2bf(u32 a, u32 b, float acc) {
  return __builtin_amdgcn_fdot2_f32_bf16(__builtin_bit_cast(bf16x2_t, a), __builtin_bit_cast(bf16x2_t, b), acc, false);
}
#define DPPF(v, ctrl) __int_as_float(__builtin_amdgcn_update_dpp(0, __float_as_int(v), ctrl, 0xf, 0xf, true))
__device__ __forceinline__ float wave_sum_dpp(float v) {
  v += DPPF(v, 0xb1);
  v += DPPF(v, 0x4e);
  v += DPPF(v, 0x124);
  v += DPPF(v, 0x128);
  float r0 = __int_as_float(__builtin_amdgcn_readlane(__float_as_int(v), 0));
  float r1 = __int_as_float(__builtin_amdgcn_readlane(__float_as_int(v), 16));
  float r2 = __int_as_float(__builtin_amdgcn_readlane(__float_as_int(v), 32));
  float r3 = __int_as_float(__builtin_amdgcn_readlane(__float_as_int(v), 48));
  return (r0 + r1) + (r2 + r3);
}
__device__ __forceinline__ int opaque_tid() { int t = threadIdx.x; asm volatile("" : "+v"(t)); return t; }
#define TIDX opaque_tid()
#define DPPI(v, ctrl) __builtin_amdgcn_update_dpp(0, (v), ctrl, 0xf, 0xf, true)
__device__ __forceinline__ int wave_sum_i_dpp(int v) {
  v += DPPI(v, 0xb1);
  v += DPPI(v, 0x4e);
  v += DPPI(v, 0x124);
  v += DPPI(v, 0x128);
  return (__builtin_amdgcn_readlane(v, 0) + __builtin_amdgcn_readlane(v, 16)) +
         (__builtin_amdgcn_readlane(v, 32) + __builtin_amdgcn_readlane(v, 48));
}
__device__ __forceinline__ float wave_max_dpp(float v) {
  v = fmaxf(v, DPPF(v, 0xb1));
  v = fmaxf(v, DPPF(v, 0x4e));
  v = fmaxf(v, DPPF(v, 0x124));
  v = fmaxf(v, DPPF(v, 0x128));
  float r0 = __int_as_float(__builtin_amdgcn_readlane(__float_as_int(v), 0));
  float r1 = __int_as_float(__builtin_amdgcn_readlane(__float_as_int(v), 16));
  float r2 = __int_as_float(__builtin_amdgcn_readlane(__float_as_int(v), 32));
  float r3 = __int_as_float(__builtin_amdgcn_readlane(__float_as_int(v), 48));
  return fmaxf(fmaxf(r0, r1), fmaxf(r2, r3));
}
#define WAVE_LDS_SYNC() asm volatile("s_waitcnt lgkmcnt(0)" ::: "memory")
__device__ __forceinline__ float sigmoidf_(float x) { return __builtin_amdgcn_rcpf(1.f + __expf(-x)); }
__device__ __forceinline__ int perm32(int k) {
  int blk = k & ~31, r = k & 31;
  int p = (r < 16) ? (8 * (r >> 2) + (r & 3)) : (8 * ((r - 16) >> 2) + 4 + (r & 3));
  return blk + p;
}

__device__ __forceinline__ u32 fp8x4(float a, float b, float c, float d) {
  int w = __builtin_amdgcn_cvt_pk_fp8_f32(a, b, 0, false);
  w = __builtin_amdgcn_cvt_pk_fp8_f32(c, d, w, true);
  return (u32)w;
}
__device__ __forceinline__ int g8_logical_col(int t) { return ((t & 127) >> 5) * 64 + (t >> 7) * 32 + (t & 31); }
__device__ __forceinline__ int win_map(int n) {
  if (n < 512) return n;
  if (n < 1024) return 768 + (n - 512);
  if (n < 3072) return 1352 + (n - 1024);
  if (n < 5120) return 3408 + (n - 3072);
  if (n < 5248) return 512 + (n - 5120);
  if (n < 5376) return 640 + (n - 5248);
  if (n < 5440) return 1280 + (n - 5376);
  if (n < 5448) return 1344 + (n - 5440);
  if (n < 5452) return 3400 + (n - 5448);
  if (n < 5456) return 3404 + (n - 5452);
  return -1;
}
__device__ __forceinline__ void transpose_tile(const float* __restrict__ src, int Nsrc, u16* __restrict__ dst, int K, int k0, int n0,
                               bool mapped, bool perm8, float* tile  , float f8scale = 0.f) {
  const int tid = TIDX;
  {
    const int tx = tid & 63, ty = tid >> 6;
    int n = n0 + tx;
    if (perm8) n = (n & ~255) + g8_logical_col(n & 255);
    int sc = mapped ? win_map(n) : n;
#pragma unroll
    for (int i = 0; i < 8; ++i) {
      int k = ty + 8 * i;
      float v = (sc >= 0) ? src[(size_t)(k0 + k) * Nsrc + sc] : 0.f;
      tile[k * 65 + tx] = v;
    }
  }
  __syncthreads();
  {
    const int n = tid >> 3, kc = (tid & 7) * 8;
    if (f8scale != 0.f) {
      u32 w[2];
#pragma unroll
      for (int j = 0; j < 2; ++j)
        w[j] = fp8x4(tile[(kc + 4 * j) * 65 + n] * f8scale, tile[(kc + 4 * j + 1) * 65 + n] * f8scale,
                     tile[(kc + 4 * j + 2) * 65 + n] * f8scale, tile[(kc + 4 * j + 3) * 65 + n] * f8scale);
      *(uint2*)((unsigned char*)dst + (size_t)(n0 + n) * K + k0 + kc) = make_uint2(w[0], w[1]);
    } else {
    u32 w[4];
#pragma unroll
    for (int j = 0; j < 4; ++j) w[j] = pack2(tile[(kc + 2 * j) * 65 + n], tile[(kc + 2 * j + 1) * 65 + n]);
    *(uint4*)(dst + (size_t)(n0 + n) * K + k0 + kc) = make_uint4(w[0], w[1], w[2], w[3]);
    }
  }
  __syncthreads();
}

template <bool Q8, bool F8OUT = false>
__device__ __forceinline__ void rmsnorm_rows(const float* __restrict__ x, const float* __restrict__ gain, u16* __restrict__ out,
                                             unsigned char* __restrict__ q8, float* __restrict__ qs) {
  const int lane = TIDX & 63, wave = TIDX >> 6;
  float4 g[4];
#pragma unroll
  for (int i = 0; i < 4; ++i) g[i] = ((const float4*)gain)[lane + 64 * i];
  for (int row = blockIdx.x * 8 + wave; row < MTOK; row += gridDim.x * 8) {
    const float4* xr = (const float4*)(x + (size_t)row * DM);
    float4 v[4];
    float ss = 0.f;
#pragma unroll
    for (int i = 0; i < 4; ++i) {
      v[i] = xr[lane + 64 * i];
      ss += v[i].x * v[i].x + v[i].y * v[i].y + v[i].z * v[i].z + v[i].w * v[i].w;
    }
    ss = wave_sum_dpp(ss);
    float r = rsqrtf(ss * (1.f / DM) + EPS);
    float amax = 0.f;
#pragma unroll
    for (int i = 0; i < 4; ++i) {
      v[i].x *= r * g[i].x; v[i].y *= r * g[i].y; v[i].z *= r * g[i].z; v[i].w *= r * g[i].w;
      if (F8OUT) {
        *(u32*)((unsigned char*)out + (size_t)row * DM + 4 * (lane + 64 * i)) = fp8x4(2.f * v[i].x, 2.f * v[i].y, 2.f * v[i].z, 2.f * v[i].w);
      } else {
        uint2 o;
        o.x = pack2(v[i].x, v[i].y);
        o.y = pack2(v[i].z, v[i].w);
        *(uint2*)(out + (size_t)row * DM + 4 * (lane + 64 * i)) = o;
      }
      if (Q8) amax = fmaxf(amax, fmaxf(fmaxf(fabsf(v[i].x), fabsf(v[i].y)), fmaxf(fabsf(v[i].z), fabsf(v[i].w))));
    }
    if (Q8) {
      amax = wave_max_dpp(amax);
      const float inv = amax > 0.f ? 127.f / amax : 0.f;
#pragma unroll
      for (int i = 0; i < 4; ++i) {
        const int q0 = (int)rintf(v[i].x * inv), q1 = (int)rintf(v[i].y * inv), q2 = (int)rintf(v[i].z * inv), q3 = (int)rintf(v[i].w * inv);
        *(u32*)(q8 + (size_t)row * DM + 4 * (lane + 64 * i)) =
            (u32)(q0 & 0xff) | ((u32)(q1 & 0xff) << 8) | ((u32)(q2 & 0xff) << 16) | ((u32)(q3 & 0xff) << 24);
      }
      if (lane == 0) qs[row] = amax * (1.f / 127.f);
    }
  }
}

__device__ __forceinline__ void phase0(const Params& p, unsigned char* smem) {
  float* tile = (float*)smem;
  unsigned char* ws = p.ws;
  const int n_in = 16 * 88, n_a = 8 * 16, n_b = 8 * 16, n_o = 16 * 16, n_q = 16 * 32;
  const int total = n_in + n_a + n_b + n_o + n_q;
  for (int t = blockIdx.x; t < total; t += gridDim.x) {
    int i = t;
    if (i < n_in) { transpose_tile(p.in[2], 5456, (u16*)(ws + OFF_WTIN), 1024, (i / 88) * 64, (i % 88) * 64, true, true, tile, 32.f); continue; }
    i -= n_in;
    if (i < n_a) { transpose_tile(p.in[9], 1024, (u16*)(ws + OFF_WTA), 512, (i / 16) * 64, (i % 16) * 64, false, true, tile); continue; }
    i -= n_a;
    if (i < n_b) { transpose_tile(p.in[10], 1024, (u16*)(ws + OFF_WTB), 512, (i / 16) * 64, (i % 16) * 64, false, true, tile); continue; }
    i -= n_b;
    if (i < n_o) { transpose_tile(p.in[11], 1024, (u16*)(ws + OFF_WTO), 1024, (i / 16) * 64, (i % 16) * 64, false, true, tile); continue; }
    i -= n_o;
    transpose_tile(p.in[13], 2048, (u16*)(ws + OFF_WTQ), 1024, (i / 32) * 64, (i % 32) * 64, false, true, tile);
  }
  {
    const float* sk = p.in[14];
    u16* skb = (u16*)(ws + OFF_SKB);
    for (int i = blockIdx.x * NTHREADS + TIDX; i < 16 * 128 * 128; i += gridDim.x * NTHREADS) skb[i] = f2bf(sk[i]);
  }
  rmsnorm_rows<false, true>(p.in[0], p.in[1], (u16*)(ws + OFF_H), nullptr, nullptr);
}

constexpr int G_BM = 256, G_BN = 128, G_BK = 64;
constexpr int G_ABYTES = G_BM * 128;

template <int MI>
__device__ __forceinline__ void gemm_mainloop_t(const u16* __restrict__ A, int lda, const u16* __restrict__ Bt, int ldb, int K,
                                                int m0, int n0, unsigned char* smem, f32x4 (&acc)[MI][4]) {
  constexpr int BN = (MI == 4) ? 128 : 256;
  constexpr int NRB = BN / 64;
  constexpr int STAGE = G_ABYTES + BN * 128;
  const int tid = TIDX, lane = tid & 63, wave = tid >> 6;
  const int wm = (MI == 4) ? (wave >> 1) : (wave >> 2), wn = (MI == 4) ? (wave & 1) : (wave & 3);
#pragma unroll
  for (int i = 0; i < MI; ++i)
#pragma unroll
    for (int j = 0; j < 4; ++j) acc[i][j] = (f32x4){0.f, 0.f, 0.f, 0.f};
  const int kc = tid & 7;
  const int arow = tid >> 3;
  u32x4 ra[4], rb[NRB];
  const u16* ap = A + (size_t)(m0 + arow) * lda + kc * 8;
  const u16* bp = Bt + (size_t)(n0 + arow) * ldb + kc * 8;
  const int nk = K / G_BK;
  const int fr = lane & 15, fg = lane >> 4;
#define G_LOAD(kt_)                                                                       \
  {                                                                                       \
    const u16* ap2_ = ap + (size_t)(kt_) * G_BK;                                          \
    const u16* bp2_ = bp + (size_t)(kt_) * G_BK;                                          \
    _Pragma("unroll") for (int i = 0; i < 4; ++i) ra[i] = *(const u32x4*)(ap2_ + (size_t)(64 * i) * lda); \
    _Pragma("unroll") for (int i = 0; i < NRB; ++i) rb[i] = *(const u32x4*)(bp2_ + (size_t)(64 * i) * ldb); \
  }
#define G_STORE(st_)                                                                      \
  {                                                                                       \
    unsigned char* sa_ = smem + (st_) * STAGE;                                            \
    unsigned char* sb_ = sa_ + G_ABYTES;                                                  \
    _Pragma("unroll") for (int i = 0; i < 4; ++i) { int r = arow + 64 * i; *(u32x4*)(sa_ + r * 128 + ((kc ^ (r & 7)) << 4)) = ra[i]; } \
    _Pragma("unroll") for (int i = 0; i < NRB; ++i) { int r = arow + 64 * i; *(u32x4*)(sb_ + r * 128 + ((kc ^ (r & 7)) << 4)) = rb[i]; } \
  }
  G_LOAD(0)
  __syncthreads();
  G_STORE(0)
  if (nk > 1) G_LOAD(1)
  __syncthreads();
  for (int kt = 0; kt < nk; ++kt) {
    if (kt + 1 < nk) G_STORE((kt + 1) & 1)
    if (kt + 2 < nk) G_LOAD(kt + 2)
    __builtin_amdgcn_sched_barrier(0);
    const unsigned char* sa = smem + (kt & 1) * STAGE;
    const unsigned char* sb = sa + G_ABYTES;
#pragma unroll
    for (int kk = 0; kk < 2; ++kk) {
      bf16x8 bfr[4];
#pragma unroll
      for (int j = 0; j < 4; ++j) {
        int r = wn * 64 + j * 16 + fr;
        bfr[j] = *(const bf16x8*)(sb + r * 128 + (((kk * 4 + fg) ^ (r & 7)) << 4));
      }
#pragma unroll
      for (int ih = 0; ih < MI; ih += 4) {
        bf16x8 af[4];
#pragma unroll
        for (int i = 0; i < 4; ++i) {
          int r = wm * (MI * 16) + (ih + i) * 16 + fr;
          af[i] = *(const bf16x8*)(sa + r * 128 + (((kk * 4 + fg) ^ (r & 7)) << 4));
        }
#pragma unroll
        for (int i = 0; i < 4; ++i)
#pragma unroll
          for (int j = 0; j < 4; ++j) acc[ih + i][j] = __builtin_amdgcn_mfma_f32_16x16x32_bf16(af[i], bfr[j], acc[ih + i][j], 0, 0, 0);
        if (MI == 8 && ih == 0) __builtin_amdgcn_sched_barrier(0);
      }
    }
    __syncthreads();
  }
#undef G_LOAD
#undef G_STORE
}
__device__ __forceinline__ void gemm_mainloop(const u16* __restrict__ A, int lda, const u16* __restrict__ Bt, int ldb, int K,
                                              int m0, int n0, unsigned char* smem, f32x4 (&acc)[4][4]) {
  gemm_mainloop_t<4>(A, lda, Bt, ldb, K, m0, n0, smem, acc);
}

__device__ __forceinline__ int g8_lds_byte(int r, int c) {
  int st = (r >> 4) * 2 + (c >> 5), rr = r & 15, cc = c & 31, ob = rr * 64 + cc * 2;
  return st * 1024 + (ob ^ (((ob >> 9) & 1) << 5));
}
__device__ __forceinline__ void g8_stage_rc(int b, int& R, int& C) {
  int st = b / 1024, sb = b % 1024, swz = sb ^ (((sb >> 9) & 1) << 5);
  R = (st >> 1) * 16 + swz / 64; C = (st & 1) * 32 + (swz % 64) / 2;
}
typedef __attribute__((address_space(3))) unsigned int lds_u32;
template <int F8 = 0, int SC = 127>
__device__ __forceinline__ void gemm8_tile(const u16* __restrict__ A, const u16* __restrict__ Bt, int K, int brow, int bcol,
                                           unsigned char* smem, f32x4 (&acc)[2][2][4][2]) {
  typedef int i32x8_ __attribute__((ext_vector_type(8)));
  typedef int i32x4_ __attribute__((ext_vector_type(4)));
  constexpr int HTB = 16384;
  const int tid = TIDX;
  const int wid = tid >> 6, lane = tid & 63, wr = wid >> 2, wc = wid & 3, fr = lane & 15, fq = lane >> 4;
#define SA(b, h) (smem + ((b) * 2 + (h)) * HTB)
#define SB(b, h) (smem + (4 + (b) * 2 + (h)) * HTB)
  u32 soff0;
  { int _r, _c; g8_stage_rc(tid * 16, _r, _c); soff0 = (u32)(_r * K + _c) * 2u; }
  const int wbase = __builtin_amdgcn_readfirstlane(wid) * 1024;
#define STAGE(P, BASE, br, kt) do { \
    unsigned long long _uv0 = (unsigned long long)(BASE) + (unsigned long long)(((long)(br) * K + (long)(kt) * 64) * 2); \
    unsigned long long _uv1 = _uv0 + (unsigned long long)(64 * K * 2); \
    asm volatile("" : "+s"(_uv0), "+s"(_uv1)); \
    __builtin_amdgcn_global_load_lds((const unsigned int*)((const unsigned char*)_uv0 + soff0), (lds_u32*)((P) + wbase), 16, 0, 0); \
    __builtin_amdgcn_global_load_lds((const unsigned int*)((const unsigned char*)_uv1 + soff0), (lds_u32*)((P) + wbase + 8192), 16, 0, 0); } while (0)
#define LDA(dst, b, h) _Pragma("unroll") for (int m = 0; m < 4; ++m) _Pragma("unroll") for (int k = 0; k < 2; ++k) \
    dst[m][k] = *(const bf16x8*)(SA(b, h) + g8_lds_byte(wr * 64 + m * 16 + fr, k * 32 + fq * 8))
#define LDB(dst, b, h) _Pragma("unroll") for (int n = 0; n < 2; ++n) _Pragma("unroll") for (int k = 0; k < 2; ++k) \
    dst[n][k] = *(const bf16x8*)(SB(b, h) + g8_lds_byte(wc * 32 + n * 16 + fr, k * 32 + fq * 8))
#define MMA(ai, bj, At_, Bt_) do { __builtin_amdgcn_s_setprio(1); \
    if (F8) { \
      _Pragma("unroll") for (int m = 0; m < 4; ++m) _Pragma("unroll") for (int n = 0; n < 2; ++n) \
        acc[ai][bj][m][n] = __builtin_amdgcn_mfma_scale_f32_16x16x128_f8f6f4( \
            __builtin_shufflevector((i32x4_)At_[m][0], (i32x4_)At_[m][1], 0, 1, 2, 3, 4, 5, 6, 7), \
            __builtin_shufflevector((i32x4_)Bt_[n][0], (i32x4_)Bt_[n][1], 0, 1, 2, 3, 4, 5, 6, 7), \
            acc[ai][bj][m][n], 0, 0, 0, SC * 0x01010101, 0, SC * 0x01010101); \
    } else { \
    _Pragma("unroll") for (int m = 0; m < 4; ++m) _Pragma("unroll") for (int n = 0; n < 2; ++n) _Pragma("unroll") for (int k = 0; k < 2; ++k) \
      acc[ai][bj][m][n] = __builtin_amdgcn_mfma_f32_16x16x32_bf16(At_[m][k], Bt_[n][k], acc[ai][bj][m][n], 0, 0, 0); \
    } \
    __builtin_amdgcn_s_setprio(0); } while (0)
#define WAIT_V(n) asm volatile("s_waitcnt vmcnt(" #n ")" ::: "memory")
#define WAIT_L(n) asm volatile("s_waitcnt lgkmcnt(" #n ")" ::: "memory")
#define BAR __builtin_amdgcn_s_barrier()
#define SCHED __builtin_amdgcn_sched_barrier(0)
#pragma unroll
  for (int a = 0; a < 2; ++a)
#pragma unroll
    for (int b2 = 0; b2 < 2; ++b2)
#pragma unroll
      for (int m = 0; m < 4; ++m)
#pragma unroll
        for (int n = 0; n < 2; ++n) acc[a][b2][m][n] = (f32x4){0.f, 0.f, 0.f, 0.f};
  bf16x8 At[4][2], B0[2][2], B1[2][2];
  const int nt = K / 64;
  constexpr int HALF = 128;
  __syncthreads();
  STAGE(SB(0, 0), Bt, bcol, 0); STAGE(SA(0, 0), A, brow, 0);
  STAGE(SB(0, 1), Bt, bcol + HALF, 0); STAGE(SA(0, 1), A, brow + HALF, 0);
  if (wr == 1) BAR;
  WAIT_V(4); BAR;
  STAGE(SB(1, 0), Bt, bcol, 1); STAGE(SA(1, 0), A, brow, 1); STAGE(SB(1, 1), Bt, bcol + HALF, 1);
  WAIT_V(6); BAR;
#pragma unroll 1
  for (int t = 0; t < nt - 2; t += 2) {
    LDB(B0, 0, 0); SCHED; LDA(At, 0, 0); STAGE(SA(1, 1), A, brow + HALF, t + 1);
    WAIT_L(8); BAR; WAIT_L(0); MMA(0, 0, At, B0); BAR; SCHED;
    LDB(B1, 0, 1); STAGE(SB(0, 0), Bt, bcol, t + 2);
    BAR; WAIT_L(0); MMA(0, 1, At, B1); BAR;
    LDA(At, 0, 1); STAGE(SA(0, 0), A, brow, t + 2);
    BAR; WAIT_L(0); MMA(1, 0, At, B0); BAR; SCHED;
    STAGE(SB(0, 1), Bt, bcol + HALF, t + 2);
    WAIT_V(6); BAR; MMA(1, 1, At, B1); BAR;
    LDB(B0, 1, 0); SCHED; LDA(At, 1, 0); STAGE(SA(0, 1), A, brow + HALF, t + 2);
    WAIT_L(8); BAR; WAIT_L(0); MMA(0, 0, At, B0); BAR; SCHED;
    LDB(B1, 1, 1); STAGE(SB(1, 0), Bt, bcol, t + 3);
    BAR; WAIT_L(0); MMA(0, 1, At, B1); BAR;
    LDA(At, 1, 1); STAGE(SA(1, 0), A, brow, t + 3);
    BAR; WAIT_L(0); MMA(1, 0, At, B0); BAR; SCHED;
    STAGE(SB(1, 1), Bt, bcol + HALF, t + 3);
    WAIT_V(6); BAR; MMA(1, 1, At, B1); BAR;
  }
  { LDB(B0, 0, 0); LDA(At, 0, 0); STAGE(SA(1, 1), A, brow + HALF, nt - 1);
    BAR; WAIT_L(0); MMA(0, 0, At, B0); BAR; SCHED;
    LDB(B1, 0, 1); BAR; WAIT_L(0); MMA(0, 1, At, B1); BAR; SCHED;
    LDA(At, 0, 1); WAIT_V(4); BAR; WAIT_L(0); MMA(1, 0, At, B0); MMA(1, 1, At, B1); BAR; SCHED; }
  { LDB(B0, 1, 0); LDA(At, 1, 0); WAIT_V(2); BAR; WAIT_L(0); MMA(0, 0, At, B0); BAR; SCHED;
    LDB(B1, 1, 1); WAIT_V(0); BAR; WAIT_L(0); MMA(0, 1, At, B1); BAR; SCHED;
    LDA(At, 1, 1); BAR; WAIT_L(0); MMA(1, 0, At, B0); MMA(1, 1, At, B1); BAR; SCHED; }
#pragma unroll
  for (int a = 0; a < 2; ++a)
#pragma unroll
    for (int b2 = 0; b2 < 2; ++b2)
      asm volatile("" : "+v"(acc[a][b2][0][0]), "+v"(acc[a][b2][0][1]), "+v"(acc[a][b2][1][0]), "+v"(acc[a][b2][1][1]),
                        "+v"(acc[a][b2][2][0]), "+v"(acc[a][b2][2][1]), "+v"(acc[a][b2][3][0]), "+v"(acc[a][b2][3][1]));
  if (wr == 0) BAR;
#undef SA
#undef SB
#undef STAGE
#undef LDA
#undef LDB
#undef MMA
#undef WAIT_V
#undef WAIT_L
#undef BAR
#undef SCHED
}

template <int LD, bool NORM>
__device__ __forceinline__ void ep_store(u16* __restrict__ dst, u32 ob, const f32x4 (&acc)[2][2][4][2], const float* __restrict__ gain,
                                         float extra, unsigned char* smem, int wave, int lane_in) {
  int lane = lane_in;
  asm volatile("" : "+v"(lane));
  const int fr = lane & 15, fq = lane >> 4;
  unsigned char* reg = smem + wave * 16384;
  float gj[4] = {1.f, 1.f, 1.f, 1.f};
  if (NORM) {
#pragma unroll
    for (int j = 0; j < 4; ++j) gj[j] = gain[j * 16 + fr] * extra;
  }
  const int lrot = (fr >> 3) + 2 * fq;
  unsigned char* wbase = reg + (4 * fq) * 128 + (fr & 7) * 2;
#pragma unroll
  for (int ai = 0; ai < 2; ++ai)
#pragma unroll
    for (int m = 0; m < 4; ++m) {
#pragma unroll
      for (int r = 0; r < 4; ++r) {
        float rs = 1.f;
        if (NORM) {
          float sq = 0.f;
#pragma unroll
          for (int bj = 0; bj < 2; ++bj)
#pragma unroll
            for (int n = 0; n < 2; ++n) sq += acc[ai][bj][m][n][r] * acc[ai][bj][m][n][r];
          sq += DPPF(sq, 0xb1); sq += DPPF(sq, 0x4e); sq += DPPF(sq, 0x141); sq += DPPF(sq, 0x140);
          rs = rsqrtf(sq * (1.f / 64.f) + EPS);
        }
#pragma unroll
        for (int bj = 0; bj < 2; ++bj)
#pragma unroll
          for (int n = 0; n < 2; ++n) {
            const float v = acc[ai][bj][m][n][r];
            const int ch = ((bj * 2 + n) * 2 + lrot) & 7;
            *(u16*)(wbase + (ai * 64 + m * 16 + r) * 128 + (ch << 4)) = f2bf(NORM ? v * rs * gj[bj * 2 + n] : v);
          }
      }
      __builtin_amdgcn_sched_barrier(0);
    }
  WAVE_LDS_SYNC();
  const int c16 = lane & 7, r8 = lane >> 3;
#pragma unroll
  for (int it = 0; it < 16; ++it) {
    const int rw = it * 8 + r8;
    const u32x4 v = *(const u32x4*)(reg + rw * 128 + (((c16 + 2 * ((rw >> 2) & 3)) & 7) << 4));
    const int grow = (it >> 3) * 128 + (it & 7) * 8 + r8;
    *(u32x4*)(dst + ob + (u32)(grow * LD + c16 * 8)) = v;
    if ((it & 3) == 3) __builtin_amdgcn_sched_barrier(0);
  }
}

template <bool NORM>
__device__ __forceinline__ void ep_store8(unsigned char* __restrict__ dst, u32 ob, const f32x4 (&acc)[2][2][4][2],
                                          const float* __restrict__ gain, unsigned char* smem, int wave, int lane_in) {
  int lane = lane_in;
  asm volatile("" : "+v"(lane));
  const int fr = lane & 15, fq = lane >> 4;
  unsigned char* reg = smem + wave * 16384;
  float gj[4] = {1.f, 1.f, 1.f, 1.f};
  if (NORM) {
#pragma unroll
    for (int j = 0; j < 4; ++j) gj[j] = gain[j * 16 + fr];
  }
#pragma unroll
  for (int ai = 0; ai < 2; ++ai)
#pragma unroll
    for (int m = 0; m < 4; ++m) {
#pragma unroll
      for (int r = 0; r < 4; ++r) {
        float rs = 1.f;
        if (NORM) {
          float sq = 0.f;
#pragma unroll
          for (int bj = 0; bj < 2; ++bj)
#pragma unroll
            for (int n = 0; n < 2; ++n) sq += acc[ai][bj][m][n][r] * acc[ai][bj][m][n][r];
          sq += DPPF(sq, 0xb1); sq += DPPF(sq, 0x4e); sq += DPPF(sq, 0x141); sq += DPPF(sq, 0x140);
          rs = rsqrtf(sq * (1.f / 64.f) + EPS);
        }
        const int rw = ai * 64 + m * 16 + 4 * fq + r;
#pragma unroll
        for (int bj = 0; bj < 2; ++bj)
#pragma unroll
          for (int n = 0; n < 2; ++n) {
            const float v = NORM ? acc[ai][bj][m][n][r] * rs * gj[bj * 2 + n] : acc[ai][bj][m][n][r];
            reg[rw * 64 + ((((bj * 2 + n) + (rw >> 2)) & 3) << 4) + fr] =
                (unsigned char)(__builtin_amdgcn_cvt_pk_fp8_f32(v, v, 0, false) & 0xff);
          }
      }
      __builtin_amdgcn_sched_barrier(0);
    }
  WAVE_LDS_SYNC();
  const int c4 = lane & 3, r16 = lane >> 2;
#pragma unroll
  for (int it = 0; it < 8; ++it) {
    const int rw = it * 16 + r16;
    const u32x4 v = *(const u32x4*)(reg + rw * 64 + (((c4 + (rw >> 2)) & 3) << 4));
    const int grow = (rw >> 6) * 128 + (rw & 63);
    *(u32x4*)(dst + ob + (u32)(grow * 256 + c4 * 16)) = v;
  }
}

__device__ __forceinline__ void phase1(const Params& p, unsigned char* smem) {
  const u16* H = (const u16*)(p.ws + OFF_H);
  const u16* WT = (const u16*)(p.ws + OFF_WTIN);
  u16* PROJ = (u16*)(p.ws + OFF_PROJ);
  u16* KVC = (u16*)(p.ws + OFF_KVC);
  u16* IKC = (u16*)(p.ws + OFF_IKC);
  float* SMALL = (float*)(p.ws + OFF_SMALL);
  const int ntn = NPADW / 256;
  const int ntiles = (MTOK / 256) * ntn;
  for (int t = blockIdx.x; t < ntiles; t += gridDim.x) {
    const int m0 = (t / ntn) * 256, n0 = (t % ntn) * 256;
    f32x4 acc[2][2][4][2];
    gemm8_tile<1, 124>(H, WT, DM / 2, m0, n0, smem, acc);
    const int tid_e = TIDX, lane = tid_e & 63, wave = tid_e >> 6;
    const int wr = wave >> 2, wc = wave & 3, fr = lane & 15, fq = lane >> 4;
    const int cbase = n0 + wc * 64;
    const u32 rbase = (u32)(m0 + wr * 64);
    if (cbase < C_IQ) {
      ep_store<LDP, true>(PROJ, rbase * LDP + (u32)cbase, acc, p.in[3], 0.125f, smem, wave, lane);
    } else if (cbase < LDP) {
      ep_store<LDP, false>(PROJ, rbase * LDP + (u32)cbase, acc, nullptr, 1.f, smem, wave, lane);
    } else if (cbase < N_AV) {
      ep_store8<true>(p.ws + OFF_KVC, rbase * 256 + (u32)(cbase - N_AK), acc, p.in[4], smem, wave, lane);
    } else if (cbase < N_IK) {
      ep_store8<false>(p.ws + OFF_KVC, rbase * 256 + (u32)(cbase - N_AV + 128), acc, nullptr, smem, wave, lane);
    } else if (cbase < N_SM) {
      ep_store<64, false>(IKC, rbase * 64, acc, nullptr, 1.f, smem, wave, lane);
    } else if (cbase == N_SM) {
      const u32 sb0 = (rbase + 4 * fq) * 16 + (u32)fr;
#pragma unroll
      for (int ai = 0; ai < 2; ++ai)
#pragma unroll
        for (int m = 0; m < 4; ++m)
#pragma unroll
          for (int r = 0; r < 4; ++r) SMALL[sb0 + (u32)((ai * 128 + m * 16 + r) * 16)] = acc[ai][0][m][0][r];
    }
  }
}

constexpr int IDX_RS = 8208;

__device__ __forceinline__ u32 f2key(float x) {
  _Float16 h = (_Float16)x;
  u32 b = (u32) * (u16*)&h;
  return (b & 0x8000u) ? ((~b) & 0xffffu) : (b | 0x8000u);
}
__device__ __forceinline__ int count_ge_wave(const u32 (&kreg)[32], u32 mid, int ndw) {
  const u32 m1 = (mid - 1u) * 0x00010001u;
  const u32 one = 0x00010001u;
  u32 acc0 = 0u, acc1 = 0u;
#pragma unroll
  for (int c4 = 0; c4 < 8; ++c4) {
    if (c4 * 4 < ndw) {
#pragma unroll
      for (int i = c4 * 4; i < c4 * 4 + 4; i += 2) {
        u32 t0, t1;
        asm("v_pk_sub_u16 %0, %1, %2 clamp" : "=v"(t0) : "v"(kreg[i]), "s"(m1));
        asm("v_pk_sub_u16 %0, %1, %2 clamp" : "=v"(t1) : "v"(kreg[i + 1]), "s"(m1));
        asm("v_pk_min_u16 %0, %1, %2" : "=v"(t0) : "v"(t0), "s"(one));
        asm("v_pk_min_u16 %0, %1, %2" : "=v"(t1) : "v"(t1), "s"(one));
        asm("v_pk_add_u16 %0, %1, %2" : "=v"(acc0) : "v"(acc0), "v"(t0));
        asm("v_pk_add_u16 %0, %1, %2" : "=v"(acc1) : "v"(acc1), "v"(t1));
      }
    }
  }
  int c = (int)((acc0 & 0xffffu) + (acc0 >> 16) + (acc1 & 0xffffu) + (acc1 >> 16));
  return wave_sum_i_dpp(c);
}

__device__ __forceinline__ void idx_item(const Params& p, unsigned char* smem, int b, int tq) {
  const u16* PROJ = (const u16*)(p.ws + OFF_PROJ);
  const float* SMALL = (const float*)(p.ws + OFF_SMALL);
  u16* SEL = (u16*)(p.ws + OFF_SEL);
  const int tid = TIDX, lane = tid & 63, wave = tid >> 6;
  const int t0 = tq * 16;
  const size_t tokb = (size_t)b * SEQ;
  if (tq < 16) {
    for (int rr = 0; rr < 2; ++rr) {
      int row = 2 * wave + rr, t = t0 + row;
      u16* out = SEL + (tokb + t) * 256;
      for (int i = lane; i < 256; i += 64) out[i] = (i <= t) ? (u16)i : (u16)0xFFFF;
    }
    return;
  }
  const int q = lane & 15, g = lane >> 4;
  __syncthreads();
  {
    const u16* iqrow = PROJ + (tokb + t0 + q) * LDP + C_IQ;
    bf16x8 bq[8][2];
    float wq[8];
#pragma unroll
    for (int h = 0; h < 8; ++h) {
      bq[h][0] = *(const bf16x8*)(iqrow + h * 64 + g * 8);
      bq[h][1] = *(const bf16x8*)(iqrow + h * 64 + 32 + g * 8);
      wq[h] = SMALL[(tokb + t0 + q) * 16 + h];
    }
    const int nkb = tq + 1;
    const int niter = (nkb > wave) ? ((nkb - wave + 7) >> 3) : 0;
    const u16* ikbase = (const u16*)(p.ws + OFF_IKC) + (tokb + q) * 64 + g * 8;
    bf16x8 ca[3][2];
#pragma unroll
    for (int j = 0; j < 3; ++j)
      if (j < niter) {
        const u16* ikrow = ikbase + (size_t)((wave + 8 * j) * 16) * 64;
        ca[j][0] = *(const bf16x8*)(ikrow); ca[j][1] = *(const bf16x8*)(ikrow + 32);
      }
    for (int i0 = 0; i0 < ((p.flags & 8) ? 0 : niter); i0 += 3) {
#pragma unroll
      for (int j = 0; j < 3; ++j) {
        if (i0 + j < niter) {
          const int s0 = (wave + 8 * (i0 + j)) * 16;
          f32x4 tot = {0.f, 0.f, 0.f, 0.f};
#pragma unroll
          for (int h = 0; h < 8; ++h) {
            f32x4 acc = {0.f, 0.f, 0.f, 0.f};
            acc = __builtin_amdgcn_mfma_f32_16x16x32_bf16(ca[j][0], bq[h][0], acc, 0, 0, 0);
            acc = __builtin_amdgcn_mfma_f32_16x16x32_bf16(ca[j][1], bq[h][1], acc, 0, 0, 0);
#pragma unroll
            for (int r = 0; r < 4; ++r) tot[r] += wq[h] * fmaxf(acc[r], 0.f);
          }
          if (i0 + 3 + j < niter) {
            const u16* ikrow = ikbase + (size_t)((wave + 8 * (i0 + 3 + j)) * 16) * 64;
            ca[j][0] = *(const bf16x8*)(ikrow); ca[j][1] = *(const bf16x8*)(ikrow + 32);
          }
          u32 k[4];
#pragma unroll
          for (int r = 0; r < 4; ++r) {
            int sidx = s0 + 4 * g + r;
            k[r] = (sidx <= t0 + q) ? f2key(tot[r]) : 0u;
          }
          u32x2 w2 = {k[0] | (k[1] << 16), k[2] | (k[3] << 16)};
          *(u32x2*)(smem + q * IDX_RS + (s0 + 4 * g) * 2) = w2;
        }
        __builtin_amdgcn_sched_barrier(0);
      }
    }
    const int nk = t0 + 16, nk64 = (nk + 511) & ~511;
    for (int i = tid; i < 16 * (nk64 - nk); i += NTHREADS) {
      int row = i / (nk64 - nk), c = nk + i % (nk64 - nk);
      *(u16*)(smem + row * IDX_RS + c * 2) = 0;
    }
  }
  __syncthreads();
  const int ndw = ((t0 + 16 + 511) >> 9) << 2;
  for (int rr = 0; rr < ((p.flags & 16) ? 0 : 2); ++rr) {
    const int row = 2 * wave + rr, t = t0 + row;
    u16* out = SEL + (tokb + t) * 256;
    u32 kreg[32];
    {
      const u32* src = (const u32*)(smem + row * IDX_RS) + lane;
#pragma unroll
      for (int c4 = 0; c4 < 8; ++c4)
        if (c4 * 4 < ndw) {
#pragma unroll
          for (int i = c4 * 4; i < c4 * 4 + 4; ++i) kreg[i] = src[i * 64];
        }
    }
    WAVE_LDS_SYNC();
    u32 lo = 1u, hi = 65535u;
    while (lo < hi) {
      u32 mid = (lo + hi + 1u) >> 1;
      int c = count_ge_wave(kreg, mid, ndw);
      if (c >= 256) lo = mid; else hi = mid - 1u;
    }
    const u32 tau = lo;
    int gt = 0, eq = 0;
#pragma unroll
    for (int c4 = 0; c4 < 8; ++c4)
      if (c4 * 4 < ndw) {
#pragma unroll
        for (int i = c4 * 4; i < c4 * 4 + 4; ++i) {
          u32 a = kreg[i] & 0xffffu, c2 = kreg[i] >> 16;
          gt += (a > tau) ? 1 : 0; gt += (c2 > tau) ? 1 : 0;
          eq += (a == tau) ? 1 : 0; eq += (c2 == tau) ? 1 : 0;
        }
      }
    int packed = gt | (eq << 16);
    int incl = packed;
#pragma unroll
    for (int o = 1; o < 64; o <<= 1) {
      int v = __shfl_up(incl, o);
      if (lane >= o) incl += v;
    }
    const int excl = incl - packed;
    const int total = __shfl(incl, 63);
    const int need = 256 - (total & 0xffff);
    const int pg = excl & 0xffff, pe = excl >> 16;
    int pos = pg + min(pe, need);
    int eqseen = pe;
    u16* lrow = (u16*)(smem + row * IDX_RS);
#pragma unroll
    for (int c4 = 0; c4 < 8; ++c4)
      if (c4 * 4 < ndw) {
#pragma unroll
        for (int i = c4 * 4; i < c4 * 4 + 4; ++i) {
#pragma unroll
          for (int hh = 0; hh < 2; ++hh) {
            u32 kv = hh ? (kreg[i] >> 16) : (kreg[i] & 0xffffu);
            int idx = 128 * i + 2 * lane + hh;
            bool take = false;
            if (kv > tau) take = true;
            else if (kv == tau) { take = (eqseen < need); ++eqseen; }
            if (take) { lrow[pos] = (u16)idx; ++pos; }
          }
        }
      }
    WAVE_LDS_SYNC();
    *(u32x2*)(out + lane * 4) = *(const u32x2*)(lrow + lane * 4);
    WAVE_LDS_SYNC();
  }
}

constexpr int DNP = 68;
constexpr int DL_KT = 0;
constexpr int DL_V = DL_KT + 128 * DNP * 4;
constexpr int DL_QB = DL_V + 64 * 128 * 4;
constexpr int DL_KB = DL_QB + 64 * 272;
constexpr int DL_SM = DL_KB + 64 * 272;
constexpr int DL_RAW = DL_SM + 2048;
static_assert(DL_RAW + 3 * 67 * 272 <= SMEM_BYTES && 16384 + 64 * 144 + 2048 <= 3 * 67 * 272, "dn_local LDS");
__device__ __forceinline__ void dn_local_item(const Params& p, unsigned char* smem, int item) {
  const int h = item & 3, n = (item >> 2) & 63, b = item >> 8;
  const u16* PROJ = (const u16*)(p.ws + OFF_PROJ);
  const float* SMALL = (const float*)(p.ws + OFF_SMALL);
  u16* Ug = (u16*)((unsigned char*)p.out + DO_U);
  u16* Wg = (u16*)((unsigned char*)p.out + DO_W);
  u16* QNg = (u16*)((unsigned char*)p.out + DO_QN);
  u16* KNTg = (u16*)((unsigned char*)p.out + DO_KNT);
  u16* ATTg = (u16*)(p.ws + OFF_ATT);
  float* GCg = (float*)(p.ws + OFF_GC);
  const float* convw = p.in[5];
  const int tid = TIDX, lane = tid & 63, wave = tid >> 6;
  const int c0 = n * 64;
  const size_t tok0 = (size_t)b * SEQ + c0;
  float* Kt = (float*)(smem + DL_KT);
  float* V = (float*)(smem + DL_V);
  unsigned char* Qb = smem + DL_QB;
  unsigned char* Kb = smem + DL_KB;
  float* gc = (float*)(smem + DL_SM);
  float* beta = gc + 64;
  float* ssp = beta + 64;
  unsigned char* RAW = smem + DL_RAW;
  float* AmT = (float*)(smem + DL_RAW);
  __syncthreads();
  {
    u32x4 rg[7];
#pragma unroll
    for (int k = 0; k < 7; ++k) {
      const int ci = tid + 512 * k;
      rg[k] = (u32x4){0u, 0u, 0u, 0u};
      if (ci < 3216) {
        const int arr = ci / 1072, rem = ci - arr * 1072, row = rem >> 4, ch = rem & 15;
        const int trel = c0 - 3 + row;
        if (trel >= 0)
          rg[k] = *(const u32x4*)(PROJ + ((size_t)b * SEQ + trel) * LDP + (C_DQ + arr * 512) + h * 128 + ch * 8);
      }
    }
#pragma unroll
    for (int k = 0; k < 7; ++k) {
      const int ci = tid + 512 * k;
      if (ci < 3216) {
        const int arr = ci / 1072, rem = ci - arr * 1072, row = rem >> 4, ch = rem & 15;
        *(u32x4*)(RAW + (arr * 67 + row) * 272 + ch * 16) = rg[k];
      }
    }
  }
  if (tid < 64) {
    float da = SMALL[(tok0 + tid) * 16 + 8 + h], db = SMALL[(tok0 + tid) * 16 + 12 + h];
    float xx = da + p.in[7][h];
    float sp = fmaxf(xx, 0.f) + log1pf(__expf(-fabsf(xx)));
    float gr = -__expf(p.in[6][h]) * sp;
    float incl = gr;
#pragma unroll
    for (int o = 1; o < 64; o <<= 1) {
      float v = __shfl_up(incl, o);
      if (lane >= o) incl += v;
    }
    gc[tid] = incl;
    beta[tid] = sigmoidf_(db);
    GCg[(tok0 + tid) * 4 + h] = incl;
  }
  __syncthreads();
  {
    const int c = tid & 127, tg = tid >> 7;
    float qv[16], kv[16];
#pragma unroll
    for (int arr = 0; arr < 3; ++arr) {
      const float w0 = convw[0 * 1536 + arr * 512 + h * 128 + c], w1 = convw[1 * 1536 + arr * 512 + h * 128 + c],
                  w2 = convw[2 * 1536 + arr * 512 + h * 128 + c], w3 = convw[3 * 1536 + arr * 512 + h * 128 + c];
      const unsigned char* rp = RAW + (arr * 67 + tg * 16) * 272 + c * 2;
      float x0 = bf2f(*(const u16*)(rp)), x1 = bf2f(*(const u16*)(rp + 272)), x2 = bf2f(*(const u16*)(rp + 2 * 272));
#pragma unroll
      for (int ii = 0; ii < 16; ++ii) {
        const float x3 = bf2f(*(const u16*)(rp + (ii + 3) * 272));
        const float y = w0 * x0 + w1 * x1 + w2 * x2 + w3 * x3;
        const float sv = y * sigmoidf_(y);
        if (arr == 0) qv[ii] = sv;
        else if (arr == 1) kv[ii] = sv;
        else V[(tg * 16 + ii) * 128 + c] = sv;
        x0 = x1; x1 = x2; x2 = x3;
      }
    }
#pragma unroll
    for (int ii = 0; ii < 16; ++ii) {
      const float sq = wave_sum_dpp(qv[ii] * qv[ii]);
      const float sk = wave_sum_dpp(kv[ii] * kv[ii]);
      if (lane == 0) {
        ssp[((tg * 16 + ii) * 2) + (wave & 1)] = sq;
        ssp[128 + ((tg * 16 + ii) * 2) + (wave & 1)] = sk;
      }
    }
    __syncthreads();
#pragma unroll
    for (int ii = 0; ii < 16; ++ii) {
      const int i = tg * 16 + ii;
      const float qsc = rsqrtf(ssp[i * 2] + ssp[i * 2 + 1] + EPS) * 0.08838834764831845f;
      const float ksc = rsqrtf(ssp[128 + i * 2] + ssp[128 + i * 2 + 1] + EPS);
      const float qn = qv[ii] * qsc, kn = kv[ii] * ksc;
      *(u16*)(Qb + i * 272 + c * 2) = f2bf(qn);
      *(u16*)(Kb + i * 272 + c * 2) = f2bf(kn);
      Kt[c * DNP + i] = kn;
    }
  }
  __syncthreads();
#pragma unroll
  for (int k = 0; k < 4; ++k) {
    const int gi = tid + 512 * k;
    {
      const int i = gi >> 5, d4 = (gi & 31) * 4;
      const u32x2 v = *(const u32x2*)(Qb + i * 272 + d4 * 2);
      *(u32x2*)(QNg + (tok0 + i) * 512 + h * 128 + perm32(d4)) = v;
    }
    {
      const int d = gi >> 4, t4 = (gi & 15) * 4;
      const f32x4 v = *(const f32x4*)(Kt + d * DNP + t4);
      u32x2 o = {pack2(v[0], v[1]), pack2(v[2], v[3])};
      *(u32x2*)(KNTg + (size_t)item * 8192 + d * 64 + perm32(t4)) = o;
    }
  }
  {
    const int mat = wave >> 2, it = wave & 3;
    const int fr = lane & 15, fg = lane >> 4;
    const unsigned char* Ab = mat ? Qb : Kb;
    bf16x8 af[4];
#pragma unroll
    for (int kk = 0; kk < 4; ++kk) af[kk] = *(const bf16x8*)(Ab + (it * 16 + fr) * 272 + kk * 64 + fg * 16);
    f32x4 gi4 = *(const f32x4*)(gc + it * 16 + 4 * fg);
    f32x4 bi4 = *(const f32x4*)(beta + it * 16 + 4 * fg);
#pragma unroll
    for (int jt = 0; jt < 4; ++jt) {
      f32x4 acc = {0.f, 0.f, 0.f, 0.f};
      if (jt <= it) {
#pragma unroll
        for (int kk = 0; kk < 4; ++kk) {
          bf16x8 bfg = *(const bf16x8*)(Kb + (jt * 16 + fr) * 272 + kk * 64 + fg * 16);
          acc = __builtin_amdgcn_mfma_f32_16x16x32_bf16(af[kk], bfg, acc, 0, 0, 0);
        }
      }
      const int j = jt * 16 + fr;
      const float gj = gc[j];
#pragma unroll
      for (int r = 0; r < 4; ++r) {
        const int i = it * 16 + 4 * fg + r;
        const float dec = __expf(fminf(gi4[r] - gj, 0.f));
        if (mat == 0) { if (jt <= it) AmT[j * 64 + i] = (i > j) ? bi4[r] * acc[r] * dec : 0.f; }
        else ATTg[(size_t)item * 4096 + i * 64 + perm32(j)] = f2bf((i >= j) ? acc[r] * dec : 0.f);
      }
    }
  }
  __syncthreads();
  u16* nA = (u16*)(smem + DL_RAW + 16384);
  u16* Nb = (u16*)(smem + DL_RAW + 16384 + 64 * 144);
  {
#pragma unroll
    for (int k = 0; k < 8; ++k) {
      const int e = tid + 512 * k;
      const int i = e >> 6, j = e & 63;
      const float v = ((j >> 4) < (i >> 4)) ? -AmT[j * 64 + i] : 0.f;
      nA[i * 72 + j] = f2bf(v);
    }
    if (tid < 64) {
      const int bb = tid >> 4, j = tid & 15;
      float nn[16];
#pragma unroll
      for (int i = 0; i < 16; ++i) {
        float sacc = 0.f;
#pragma unroll
        for (int k = 0; k < i; ++k) sacc += AmT[(bb * 16 + k) * 64 + bb * 16 + i] * nn[k];
        nn[i] = (i == j) ? 1.f : ((i > j) ? -sacc : 0.f);
      }
#pragma unroll
      for (int i = 0; i < 16; ++i) Nb[bb * 256 + i * 16 + j] = f2bf(nn[i]);
    }
  }
  __syncthreads();
  {
    const int fr = lane & 15, fg = lane >> 4;
    f32x4 X[2][4];
#pragma unroll
    for (int ct2 = 0; ct2 < 2; ++ct2) {
      const int c = (wave * 2 + ct2) * 16 + fr;
      const bool isu = c < 128;
      const int cc = c & 127;
#pragma unroll
      for (int bb = 0; bb < 4; ++bb) {
        f32x4 acc;
#pragma unroll
        for (int r = 0; r < 4; ++r) {
          const int i = bb * 16 + 4 * fg + r;
          acc[r] = isu ? V[i * 128 + cc] * beta[i] : Kt[cc * DNP + i] * beta[i] * __expf(gc[i]);
        }
        if (bb >= 1) {
          union { u32 w[4]; bf16x8 v; } af, bf;
          const u32x2 a0 = *(const u32x2*)(nA + (bb * 16 + fr) * 72 + 4 * fg);
          af.w[0] = a0[0]; af.w[1] = a0[1];
          bf.w[0] = pack2(X[ct2][0][0], X[ct2][0][1]); bf.w[1] = pack2(X[ct2][0][2], X[ct2][0][3]);
          if (bb >= 2) {
            const u32x2 a1 = *(const u32x2*)(nA + (bb * 16 + fr) * 72 + 16 + 4 * fg);
            af.w[2] = a1[0]; af.w[3] = a1[1];
            bf.w[2] = pack2(X[ct2][1][0], X[ct2][1][1]); bf.w[3] = pack2(X[ct2][1][2], X[ct2][1][3]);
          } else { af.w[2] = 0u; af.w[3] = 0u; bf.w[2] = 0u; bf.w[3] = 0u; }
          acc = __builtin_amdgcn_mfma_f32_16x16x32_bf16(af.v, bf.v, acc, 0, 0, 0);
          if (bb == 3) {
            const u32x2 a2 = *(const u32x2*)(nA + (bb * 16 + fr) * 72 + 32 + 4 * fg);
            af.w[0] = a2[0]; af.w[1] = a2[1]; af.w[2] = 0u; af.w[3] = 0u;
            bf.w[0] = pack2(X[ct2][2][0], X[ct2][2][1]); bf.w[1] = pack2(X[ct2][2][2], X[ct2][2][3]); bf.w[2] = 0u; bf.w[3] = 0u;
            acc = __builtin_amdgcn_mfma_f32_16x16x32_bf16(af.v, bf.v, acc, 0, 0, 0);
          }
        }
        {
          union { u32 w[4]; bf16x8 v; } af, bf;
          const u32x2 d0 = *(const u32x2*)(Nb + bb * 256 + fr * 16 + 4 * fg);
          af.w[0] = d0[0]; af.w[1] = d0[1]; af.w[2] = 0u; af.w[3] = 0u;
          bf.w[0] = pack2(acc[0], acc[1]); bf.w[1] = pack2(acc[2], acc[3]); bf.w[2] = 0u; bf.w[3] = 0u;
          const f32x4 z4 = {0.f, 0.f, 0.f, 0.f};
          X[ct2][bb] = __builtin_amdgcn_mfma_f32_16x16x32_bf16(af.v, bf.v, z4, 0, 0, 0);
        }
#pragma unroll
        for (int r = 0; r < 4; ++r) {
          const int i = bb * 16 + 4 * fg + r;
          if (isu) Ug[(tok0 + i) * 512 + h * 128 + cc] = f2bf(X[ct2][bb][r]);
          else Wg[(tok0 + i) * 512 + h * 128 + perm32(cc)] = f2bf(X[ct2][bb][r]);
        }
      }
    }
  }
}

__device__ __forceinline__ void phase2(const Params& p, unsigned char* smem) {
#ifndef NO_IDX
  for (int i = blockIdx.x; i < 2048; i += gridDim.x) idx_item(p, smem, i & 7, 255 - (i >> 3));
#endif
#ifndef NO_DNL
  if (!(p.flags & 1))
    for (int i = blockIdx.x; i < 2048; i += gridDim.x) dn_local_item(p, smem, i);
#endif
}

constexpr int SC_WP = 272, SC_KP = 144;
constexpr int SC_W = 0, SC_Q = 64 * SC_WP, SC_KT = 2 * 64 * SC_WP, SC_AT = SC_KT + 128 * SC_KP, SC_U = SC_AT + 64 * SC_KP,
              SC_BUF = SC_U + 64 * SC_WP;
constexpr int SC_GC = 2 * SC_BUF;
static_assert(SC_GC + 2 * 64 * 4 <= SMEM_BYTES, "scan LDS");

__device__ __forceinline__ void dn_scan_item(const Params& p, unsigned char* smem, int bh) {
  const int h = bh & 3, b = bh >> 2;
  const u16* Ug = (const u16*)((const unsigned char*)p.out + DO_U);
  const u16* Wg = (const u16*)((const unsigned char*)p.out + DO_W);
  const u16* QNg = (const u16*)((const unsigned char*)p.out + DO_QN);
  const u16* KNTg = (const u16*)((const unsigned char*)p.out + DO_KNT);
  const u16* ATTg = (const u16*)(p.ws + OFF_ATT);
  const float* GCg = (const float*)(p.ws + OFF_GC);
  const u16* PROJ = (const u16*)(p.ws + OFF_PROJ);
  u16* YDN = (u16*)(p.ws + OFF_YDN);
  const float* ogain = p.in[8];
  const int tid = TIDX, lane = tid & 63, wave = tid >> 6;
  const int fr = lane & 15, fg = lane >> 4;
  const int ecol = wave * 16 + fr;
  float* gcs = (float*)(smem + SC_GC);
  f32x4 S[8];
#pragma unroll
  for (int d = 0; d < 8; ++d) S[d] = (f32x4){0.f, 0.f, 0.f, 0.f};
  u32x4 st[9];
  float gcr = 0.f;
  const int r16 = tid >> 4, c16 = tid & 15;
  const int r8 = tid >> 3, c8 = tid & 7;
#define SCAN_LOAD(n_)                                                                                      \
  {                                                                                                        \
    const size_t tk0 = (size_t)b * SEQ + (size_t)(n_) * 64;                                                \
    const size_t it_ = (size_t)((b * 64 + (n_)) * 4 + h);                                                  \
    st[0] = *(const u32x4*)(Wg + (tk0 + r16) * 512 + h * 128 + c16 * 8);                                   \
    st[1] = *(const u32x4*)(Wg + (tk0 + r16 + 32) * 512 + h * 128 + c16 * 8);                              \
    st[2] = *(const u32x4*)(QNg + (tk0 + r16) * 512 + h * 128 + c16 * 8);                                  \
    st[3] = *(const u32x4*)(QNg + (tk0 + r16 + 32) * 512 + h * 128 + c16 * 8);                             \
    st[4] = *(const u32x4*)(KNTg + it_ * 8192 + (size_t)tid * 8);                                          \
    st[5] = *(const u32x4*)(KNTg + it_ * 8192 + (size_t)(tid + 512) * 8);                                  \
    st[6] = *(const u32x4*)(ATTg + it_ * 4096 + (size_t)tid * 8);                                          \
    st[7] = *(const u32x4*)(Ug + (tk0 + r16) * 512 + h * 128 + c16 * 8);                                   \
    st[8] = *(const u32x4*)(Ug + (tk0 + r16 + 32) * 512 + h * 128 + c16 * 8);                              \
    if (tid < 64) gcr = GCg[(tk0 + tid) * 4 + h];                                                          \
  }
#define SCAN_STORE(buf_)                                                                                   \
  {                                                                                                        \
    unsigned char* bs_ = smem + (buf_) * SC_BUF;                                                           \
    *(u32x4*)(bs_ + SC_W + r16 * SC_WP + c16 * 16) = st[0];                                                \
    *(u32x4*)(bs_ + SC_W + (r16 + 32) * SC_WP + c16 * 16) = st[1];                                         \
    *(u32x4*)(bs_ + SC_Q + r16 * SC_WP + c16 * 16) = st[2];                                                \
    *(u32x4*)(bs_ + SC_Q + (r16 + 32) * SC_WP + c16 * 16) = st[3];                                         \
    *(u32x4*)(bs_ + SC_KT + r8 * SC_KP + c8 * 16) = st[4];                                                 \
    *(u32x4*)(bs_ + SC_KT + (r8 + 64) * SC_KP + c8 * 16) = st[5];                                          \
    *(u32x4*)(bs_ + SC_AT + r8 * SC_KP + c8 * 16) = st[6];                                                 \
    *(u32x4*)(bs_ + SC_U + r16 * SC_WP + c16 * 16) = st[7];                                                \
    *(u32x4*)(bs_ + SC_U + (r16 + 32) * SC_WP + c16 * 16) = st[8];                                         \
    if (tid < 64) gcs[(buf_) * 64 + tid] = gcr;                                                            \
  }
  __syncthreads();
  SCAN_LOAD(0)
  SCAN_STORE(0)
  if (1 < 64) SCAN_LOAD(1)
  __syncthreads();
  for (int n = 0; n < 64; ++n) {
    const int buf = n & 1;
    const size_t tok0 = (size_t)b * SEQ + n * 64;
    if (n + 1 < 64) SCAN_STORE(buf ^ 1)
    if (n + 2 < 64) SCAN_LOAD(n + 2)
    __builtin_amdgcn_sched_barrier(0);
    const unsigned char* base = smem + buf * SC_BUF;
    const u32 ub0 = (u32)(tok0 + 4 * fg) * 512 + (u32)(h * 128 + ecol);
    const float* gcb = gcs + buf * 64 + 4 * fg;
    const float glast = gcs[buf * 64 + 63];
    bf16x8 Sb[4];
#pragma unroll
    for (int kk = 0; kk < 4; ++kk) {
      union { u32 w[4]; bf16x8 v; } cv;
      cv.w[0] = pack2(S[2 * kk][0], S[2 * kk][1]); cv.w[1] = pack2(S[2 * kk][2], S[2 * kk][3]);
      cv.w[2] = pack2(S[2 * kk + 1][0], S[2 * kk + 1][1]); cv.w[3] = pack2(S[2 * kk + 1][2], S[2 * kk + 1][3]);
      Sb[kk] = cv.v;
    }
    f32x4 vnew[4], ov[4];
#pragma unroll
    for (int m = 0; m < 4; ++m) {
      f32x4 aw = {0.f, 0.f, 0.f, 0.f}, aq = {0.f, 0.f, 0.f, 0.f};
#pragma unroll
      for (int kk = 0; kk < 4; ++kk) {
        bf16x8 wf = *(const bf16x8*)(base + SC_W + (m * 16 + fr) * SC_WP + kk * 64 + fg * 16);
        bf16x8 qf = *(const bf16x8*)(base + SC_Q + (m * 16 + fr) * SC_WP + kk * 64 + fg * 16);
        aw = __builtin_amdgcn_mfma_f32_16x16x32_bf16(wf, Sb[kk], aw, 0, 0, 0);
        aq = __builtin_amdgcn_mfma_f32_16x16x32_bf16(qf, Sb[kk], aq, 0, 0, 0);
      }
      f32x4 g4 = *(const f32x4*)(gcb + m * 16);
#pragma unroll
      for (int r = 0; r < 4; ++r) {
        float uv = bf2f(*(const u16*)(base + SC_U + (m * 16 + 4 * fg + r) * SC_WP + ecol * 2));
        vnew[m][r] = uv - aw[r];
        ov[m][r] = aq[r] * __expf(g4[r]);
      }
    }
    bf16x8 vb[2], vsb[2];
#pragma unroll
    for (int k2 = 0; k2 < 2; ++k2) {
      union { u32 w[4]; bf16x8 v; } c1, c2;
      const int ma = 2 * k2, mb = 2 * k2 + 1;
      c1.w[0] = pack2(vnew[ma][0], vnew[ma][1]); c1.w[1] = pack2(vnew[ma][2], vnew[ma][3]);
      c1.w[2] = pack2(vnew[mb][0], vnew[mb][1]); c1.w[3] = pack2(vnew[mb][2], vnew[mb][3]);
      f32x4 ga4 = *(const f32x4*)(gcb + ma * 16), gb4 = *(const f32x4*)(gcb + mb * 16);
      float sa[4], sb2[4];
#pragma unroll
      for (int r = 0; r < 4; ++r) { sa[r] = vnew[ma][r] * __expf(glast - ga4[r]); sb2[r] = vnew[mb][r] * __expf(glast - gb4[r]); }
      c2.w[0] = pack2(sa[0], sa[1]); c2.w[1] = pack2(sa[2], sa[3]);
      c2.w[2] = pack2(sb2[0], sb2[1]); c2.w[3] = pack2(sb2[2], sb2[3]);
      vb[k2] = c1.v; vsb[k2] = c2.v;
    }
    const float egl = __expf(glast);
#pragma unroll
    for (int d = 0; d < 8; ++d) {
      f32x4 a = S[d] * egl;
#pragma unroll
      for (int k2 = 0; k2 < 2; ++k2) {
        bf16x8 kf = *(const bf16x8*)(base + SC_KT + (d * 16 + fr) * SC_KP + k2 * 64 + fg * 16);
        a = __builtin_amdgcn_mfma_f32_16x16x32_bf16(kf, vsb[k2], a, 0, 0, 0);
      }
      S[d] = a;
    }
#pragma unroll
    for (int m = 0; m < 4; ++m) {
      f32x4 ao = ov[m];
#pragma unroll
      for (int k2 = 0; k2 < 2; ++k2) {
        bf16x8 af = *(const bf16x8*)(base + SC_AT + (m * 16 + fr) * SC_KP + k2 * 64 + fg * 16);
        ao = __builtin_amdgcn_mfma_f32_16x16x32_bf16(af, vb[k2], ao, 0, 0, 0);
      }
#pragma unroll
      for (int r = 0; r < 4; ++r) YDN[ub0 + (u32)((m * 16 + r) * 512)] = f2bf(ao[r]);
    }
    __syncthreads();
  }
#undef SCAN_LOAD
#undef SCAN_STORE
  asm volatile("s_waitcnt vmcnt(0)" ::: "memory");
  __syncthreads();
  {
    const int sub = lane >> 4, l16 = lane & 15;
    float gn8[8];
#pragma unroll
    for (int e = 0; e < 8; ++e) gn8[e] = ogain[l16 * 8 + e];
    for (int t = wave * 4 + sub; t < SEQ; t += 32) {
      const size_t tok = (size_t)b * SEQ + t;
      u16* yp = YDN + tok * 512 + h * 128 + l16 * 8;
      const u32x4 ov4 = *(const u32x4*)yp;
      const u32x4 zv4 = *(const u32x4*)(PROJ + tok * LDP + C_DZ + h * 128 + l16 * 8);
      float o8[8], z8[8];
#pragma unroll
      for (int c = 0; c < 4; ++c) { o8[2 * c] = bflo(ov4[c]); o8[2 * c + 1] = bfhi(ov4[c]); z8[2 * c] = bflo(zv4[c]); z8[2 * c + 1] = bfhi(zv4[c]); }
      float sq = 0.f;
#pragma unroll
      for (int e = 0; e < 8; ++e) sq += o8[e] * o8[e];
      sq += DPPF(sq, 0xb1); sq += DPPF(sq, 0x4e); sq += DPPF(sq, 0x141); sq += DPPF(sq, 0x140);
      const float rstd = rsqrtf(sq * (1.f / 128.f) + EPS);
      u32 w[4];
#pragma unroll
      for (int c = 0; c < 4; ++c) {
        const float y0 = o8[2 * c] * rstd * gn8[2 * c] * z8[2 * c] * sigmoidf_(z8[2 * c]);
        const float y1 = o8[2 * c + 1] * rstd * gn8[2 * c + 1] * z8[2 * c + 1] * sigmoidf_(z8[2 * c + 1]);
        w[c] = pack2(y0, y1);
      }
      *(u32x4*)yp = (u32x4){w[0], w[1], w[2], w[3]};
    }
  }
}

constexpr int AT_WAVE_BYTES = 8192 + 512 + 8192;
__device__ __forceinline__ float xor16_sum(float v) {
  auto r = __builtin_amdgcn_permlane16_swap(__float_as_uint(v), __float_as_uint(v), false, false);
  return __uint_as_float(r[0]) + __uint_as_float(r[1]);
}
__device__ __forceinline__ float xor32_sum(float v) {
  auto r = __builtin_amdgcn_permlane32_swap(__float_as_uint(v), __float_as_uint(v), false, false);
  return __uint_as_float(r[0]) + __uint_as_float(r[1]);
}
__device__ __forceinline__ void attn_query(const Params& p, unsigned char* wsm, int b, int t) {
  typedef long i64;
  typedef int i32x2 __attribute__((ext_vector_type(2)));
  typedef __attribute__((address_space(3))) i32x2 lds_i32x2;
  const u16* PROJ = (const u16*)(p.ws + OFF_PROJ);
  const u16* SEL = (const u16*)(p.ws + OFF_SEL);
  const unsigned char* KVC8 = p.ws + OFF_KVC;
  u16* YATT = (u16*)(p.ws + OFF_YATT);
  const int lane = TIDX & 63;
  const int fr = lane & 15, fg = lane >> 4;
  float* P = (float*)wsm;
  u16* sl = (u16*)(wsm + 8192);
  const size_t tokb = (size_t)b * SEQ;
  const size_t tok = tokb + t;
  const int nsel = min(256, t + 1);
  i64 qb[2][2];
  {
    const u16* qrow = PROJ + tok * LDP + C_AQ + (fr & 3) * 64 + fg * 8;
#pragma unroll
    for (int g = 0; g < 2; ++g)
#pragma unroll
      for (int kk = 0; kk < 2; ++kk) {
        const u32x4 v = *(const u32x4*)(qrow + g * 256 + kk * 32);
        const u32 lo = fp8x4(bflo(v[0]) * 16.f, bfhi(v[0]) * 16.f, bflo(v[1]) * 16.f, bfhi(v[1]) * 16.f);
        const u32 hi = fp8x4(bflo(v[2]) * 16.f, bfhi(v[2]) * 16.f, bflo(v[3]) * 16.f, bfhi(v[3]) * 16.f);
        const i64 w = (i64)(((unsigned long long)hi << 32) | (unsigned long long)lo);
        qb[g][kk] = (fr < 4) ? w : (i64)0;
      }
    const u16* sr = SEL + tok * 256;
#pragma unroll
    for (int i = 0; i < 4; ++i) sl[lane + 64 * i] = sr[lane + 64 * i];
  }
  WAVE_LDS_SYNC();
  const int ngrp = (nsel + 15) >> 4;
  const int nbq = (ngrp + 1) >> 1;
  unsigned char* KST = wsm + 8192 + 512;
  const int kq = lane >> 3, kch = lane & 7;
  u32x4 kA[2][2], kB[2][2];
#define QK_LOAD(buf_, bi_)                                                                       \
  _Pragma("unroll") for (int j = 0; j < 2; ++j)                                                  \
    _Pragma("unroll") for (int hf = 0; hf < 2; ++hf) {                                           \
      const int ki_ = min(((bi_) * 2 + j) * 16 + hf * 8 + kq, 255);                              \
      const int s_ = (int)sl[ki_] & 4095;                                                        \
      buf_[j][hf] = *(const u32x4*)(KVC8 + (tokb + s_) * 256 + kch * 16);                        \
    }
#define QK_COMPUTE(buf_, bi_)                                                                    \
  {                                                                                              \
    _Pragma("unroll") for (int j = 0; j < 2; ++j)                                                \
      _Pragma("unroll") for (int hf = 0; hf < 2; ++hf) {                                         \
        const int row_ = hf * 8 + kq;                                                            \
        *(u32x4*)(KST + j * 2048 + row_ * 128 + ((kch ^ (row_ & 7)) << 4)) = buf_[j][hf];        \
      }                                                                                          \
    WAVE_LDS_SYNC();                                                                             \
    _Pragma("unroll") for (int j = 0; j < 2; ++j) {                                              \
      const unsigned char* kr_ = KST + j * 2048 + fr * 128 + 8 * (fg & 1);                       \
      const int sw_ = fr & 7, ch_ = fg >> 1;                                                     \
      const i64 a00_ = *(const i64*)(kr_ + (((0 + ch_) ^ sw_) << 4));                            \
      const i64 a01_ = *(const i64*)(kr_ + (((2 + ch_) ^ sw_) << 4));                            \
      const i64 a10_ = *(const i64*)(kr_ + (((4 + ch_) ^ sw_) << 4));                            \
      const i64 a11_ = *(const i64*)(kr_ + (((6 + ch_) ^ sw_) << 4));                            \
      f32x4 c0_ = {0.f, 0.f, 0.f, 0.f}, c1_ = {0.f, 0.f, 0.f, 0.f};                              \
      c0_ = __builtin_amdgcn_mfma_f32_16x16x32_fp8_fp8(a00_, qb[0][0], c0_, 0, 0, 0);            \
      c0_ = __builtin_amdgcn_mfma_f32_16x16x32_fp8_fp8(a01_, qb[0][1], c0_, 0, 0, 0);            \
      c1_ = __builtin_amdgcn_mfma_f32_16x16x32_fp8_fp8(a10_, qb[1][0], c1_, 0, 0, 0);            \
      c1_ = __builtin_amdgcn_mfma_f32_16x16x32_fp8_fp8(a11_, qb[1][1], c1_, 0, 0, 0);            \
      if (fr < 4) {                                                                              \
        _Pragma("unroll") for (int r = 0; r < 4; ++r) {                                          \
          const int kk2_ = ((bi_) * 2 + j) * 16 + 4 * fg + r;                                    \
          if (kk2_ < 256) {                                                                      \
            const bool v_ = kk2_ < nsel;                                                         \
            P[kk2_ * 8 + fr] = v_ ? c0_[r] * 0.0625f : -1e30f;                                   \
            P[kk2_ * 8 + 4 + fr] = v_ ? c1_[r] * 0.0625f : -1e30f;                               \
          }                                                                                      \
        }                                                                                        \
      }                                                                                          \
    }                                                                                            \
    WAVE_LDS_SYNC();                                                                             \
  }
  QK_LOAD(kA, 0)
  for (int bi = 0; bi < nbq; bi += 2) {
    if (bi + 1 < nbq) { QK_LOAD(kB, bi + 1) }
    QK_COMPUTE(kA, bi)
    if (bi + 2 < nbq) { QK_LOAD(kA, bi + 2) }
    if (bi + 1 < nbq) { QK_COMPUTE(kB, bi + 1) }
  }
#undef QK_LOAD
#undef QK_COMPUTE
  for (int ki = nbq * 32 + lane; ki < 256; ki += 64) {
    *(f32x4*)(P + ki * 8) = (f32x4){-1e30f, -1e30f, -1e30f, -1e30f};
    *(f32x4*)(P + ki * 8 + 4) = (f32x4){-1e30f, -1e30f, -1e30f, -1e30f};
  }
  WAVE_LDS_SYNC();
  float inv8[8];
  {
    float lg[4][8];
#pragma unroll
    for (int i = 0; i < 4; ++i) {
      f32x4 x0 = *(const f32x4*)(P + (lane + 64 * i) * 8), x1 = *(const f32x4*)(P + (lane + 64 * i) * 8 + 4);
      lg[i][0] = x0[0]; lg[i][1] = x0[1]; lg[i][2] = x0[2]; lg[i][3] = x0[3];
      lg[i][4] = x1[0]; lg[i][5] = x1[1]; lg[i][6] = x1[2]; lg[i][7] = x1[3];
    }
    WAVE_LDS_SYNC();
    unsigned char* PT8 = (unsigned char*)P;
#pragma unroll
    for (int hh = 0; hh < 8; ++hh) {
      float m = fmaxf(fmaxf(lg[0][hh], lg[1][hh]), fmaxf(lg[2][hh], lg[3][hh]));
      m = wave_max_dpp(m);
      float e[4], sum = 0.f;
#pragma unroll
      for (int i = 0; i < 4; ++i) { e[i] = __expf(lg[i][hh] - m); sum += e[i]; }
      sum = wave_sum_dpp(sum);
      inv8[hh] = __builtin_amdgcn_rcpf(sum) * (1.f / 256.f);
      const u32 w = fp8x4(e[0] * 256.f, e[1] * 256.f, e[2] * 256.f, e[3] * 256.f);
#pragma unroll
      for (int i = 0; i < 4; ++i) PT8[hh * 256 + lane + 64 * i] = (unsigned char)((w >> (8 * i)) & 0xffu);
    }
  }
  WAVE_LDS_SYNC();
  {
    const unsigned char* PT8 = (const unsigned char*)P;
    unsigned char* VST = wsm + 8192 + 512;
    const int trow = (lane & 15) >> 1, thalf = lane & 1;
    f32x4 oacc[2][4];
#pragma unroll
    for (int g = 0; g < 2; ++g)
#pragma unroll
      for (int c = 0; c < 4; ++c) oacc[g][c] = (f32x4){0.f, 0.f, 0.f, 0.f};
    const int nks = (nsel + 31) >> 5;
    u32x4 vA[4], vB[4];
#define PV_LOAD(buf_, ks_)                                                                       \
  _Pragma("unroll") for (int i = 0; i < 4; ++i) {                                                \
    const int ki_ = min((ks_) * 32 + i * 8 + kq, 255);                                           \
    const int s_ = (int)sl[ki_] & 4095;                                                          \
    buf_[i] = *(const u32x4*)(KVC8 + (tokb + s_) * 256 + 128 + kch * 16);                        \
  }
#define PV_COMPUTE(buf_, ks_)                                                                    \
  {                                                                                              \
    _Pragma("unroll") for (int i = 0; i < 4; ++i) {                                              \
      const int key_ = i * 8 + kq;                                                               \
      *(u32x4*)(VST + key_ * 128 + ((kch ^ (key_ & 7)) << 4)) = buf_[i];                         \
    }                                                                                            \
    WAVE_LDS_SYNC();                                                                             \
    i64 pa_[2];                                                                                  \
    _Pragma("unroll") for (int g = 0; g < 2; ++g) {                                              \
      const i64 t_ = *(const i64*)(PT8 + (g * 4 + (fr & 3)) * 256 + (ks_) * 32 + 8 * fg);        \
      pa_[g] = (fr < 4) ? t_ : (i64)0;                                                           \
    }                                                                                            \
    const int r1_ = 8 * fg + trow;                                                               \
    _Pragma("unroll") for (int g = 0; g < 2; ++g)                                                \
      _Pragma("unroll") for (int c = 0; c < 4; ++c) {                                            \
        const i32x2 tv_ = __builtin_amdgcn_ds_read_tr8_b64_v2i32((lds_i32x2*)(VST + r1_ * 128 + (((g * 4 + c) ^ (r1_ & 7)) << 4) + 8 * thalf)); \
        const i64 vb_ = (i64)(((unsigned long long)(u32)tv_[1] << 32) | (unsigned long long)(u32)tv_[0]); \
        oacc[g][c] = __builtin_amdgcn_mfma_f32_16x16x32_fp8_fp8(pa_[g], vb_, oacc[g][c], 0, 0, 0); \
      }                                                                                          \
    WAVE_LDS_SYNC();                                                                             \
  }
    PV_LOAD(vA, 0)
    for (int ks = 0; ks < nks; ks += 2) {
      if (ks + 1 < nks) { PV_LOAD(vB, ks + 1) }
      PV_COMPUTE(vA, ks)
      if (ks + 2 < nks) { PV_LOAD(vA, ks + 2) }
      if (ks + 1 < nks) { PV_COMPUTE(vB, ks + 1) }
    }
#undef PV_LOAD
#undef PV_COMPUTE
    if (lane < 16) {
#pragma unroll
      for (int g = 0; g < 2; ++g)
#pragma unroll
        for (int c = 0; c < 4; ++c)
#pragma unroll
          for (int r = 0; r < 4; ++r)
            YATT[tok * 512 + (g * 4 + r) * 64 + 16 * c + fr] = f2bf(oacc[g][c][r] * inv8[g * 4 + r]);
    }
  }
  WAVE_LDS_SYNC();
}

__device__ __forceinline__ void phase3(const Params& p, unsigned char* smem) {
  const int wave = TIDX >> 6;
#ifndef NO_SCAN
  if (blockIdx.x < 32) {
    if (!(p.flags & 2)) dn_scan_item(p, smem, blockIdx.x);
    __syncthreads();
  }
#endif
#ifdef NO_ATTN
  return;
#endif
  if (p.flags & 4) return;
  unsigned* qctr = (unsigned*)(p.ws + 1024 + ((p.flags & 128) ? 4096 : 0));
  const unsigned xcc = (unsigned)__builtin_amdgcn_s_getreg((3 << 11) | 20) & 7u;
  unsigned char* wsm = smem + wave * AT_WAVE_BYTES;
  for (unsigned db = 0; db < 8; ++db) {
    const int bb = (int)((xcc + db) & 7u);
    for (;;) {
      unsigned qi = 0;
      if ((TIDX & 63) == 0) qi = __hip_atomic_fetch_add(qctr + bb * 16, 1u, __ATOMIC_RELAXED, __HIP_MEMORY_SCOPE_AGENT);
      qi = (unsigned)__builtin_amdgcn_readfirstlane((int)qi);
      if (qi >= (unsigned)SEQ) break;
      attn_query(p, wsm, bb, SEQ - 1 - (int)qi);
    }
  }
}

__device__ __forceinline__ void hblk_load(unsigned char* reg, const u16* __restrict__ src, u32 ob, u32 ld, int lane) {
  const int c16 = lane & 7, r8 = lane >> 3;
#pragma unroll
  for (int it = 0; it < 8; ++it) {
    const int rl = it * 8 + r8;
    const u32x4 v = *(const u32x4*)(src + ob + (u32)rl * ld + (u32)(c16 * 8));
    *(u32x4*)(reg + rl * 128 + (((c16 + 2 * ((rl >> 2) & 3)) & 7) << 4)) = v;
    if ((it & 3) == 3) __builtin_amdgcn_sched_barrier(0);
  }
}
__device__ __forceinline__ void hblk_store(const unsigned char* reg, u16* __restrict__ dst, u32 ob, u32 ld, int lane) {
  const int c16 = lane & 7, r8 = lane >> 3;
#pragma unroll
  for (int it = 0; it < 8; ++it) {
    const int rl = it * 8 + r8;
    const u32x4 v = *(const u32x4*)(reg + rl * 128 + (((c16 + 2 * ((rl >> 2) & 3)) & 7) << 4));
    *(u32x4*)(dst + ob + (u32)rl * ld + (u32)(c16 * 8)) = v;
  }
}
__device__ __forceinline__ void phase4(const Params& p, unsigned char* smem) {
  const u16* YATT = (const u16*)(p.ws + OFF_YATT);
  const u16* YDN = (const u16*)(p.ws + OFF_YDN);
  const u16* WTA = (const u16*)(p.ws + OFF_WTA);
  const u16* WTB = (const u16*)(p.ws + OFF_WTB);
  const u16* PROJ = (const u16*)(p.ws + OFF_PROJ);
  u16* MG = (u16*)(p.ws + OFF_MERGED);
  const int ntn = DM / 256, ntiles = (MTOK / 256) * ntn;
  for (int t = blockIdx.x; t < ntiles; t += gridDim.x) {
    const int m0 = (t / ntn) * 256, n0 = (t % ntn) * 256;
    f32x4 acc[2][2][4][2];
#pragma unroll
    for (int pass = 0; pass < 2; ++pass) {
      gemm8_tile(pass ? YDN : YATT, pass ? WTB : WTA, 512, m0, n0, smem, acc);
      int lane = TIDX & 63;
      asm volatile("" : "+v"(lane));
      const int wave = TIDX >> 6, wr = wave >> 2, wc = wave & 3, fr = lane & 15, fq = lane >> 4;
      unsigned char* regG = smem + wave * 16384;
      unsigned char* regT = regG + 8192;
      const int lrot = (fr >> 3) + 2 * fq;
      int off4[4];
#pragma unroll
      for (int jj = 0; jj < 4; ++jj) off4[jj] = (4 * fq) * 128 + (fr & 7) * 2 + (((jj * 2 + lrot) & 7) << 4);
#pragma unroll
      for (int ai = 0; ai < 2; ++ai) {
        const u32 gb0 = (u32)(m0 + ai * 128 + wr * 64) * LDP + (u32)(n0 + wc * 64) + (u32)(pass ? C_GB : C_GA);
        const u32 ob0 = (u32)(m0 + ai * 128 + wr * 64) * DM + (u32)(n0 + wc * 64);
        hblk_load(regG, PROJ, gb0, LDP, lane);
        if (pass == 1) hblk_load(regT, MG, ob0, DM, lane);
        WAVE_LDS_SYNC();
#pragma unroll
        for (int m = 0; m < 4; ++m)
#pragma unroll
          for (int r = 0; r < 4; ++r)
#pragma unroll
            for (int bj = 0; bj < 2; ++bj)
#pragma unroll
              for (int n = 0; n < 2; ++n) {
                const int o = off4[bj * 2 + n] + (m * 16 + r) * 128;
                float v = sigmoidf_(bf2f(*(const u16*)(regG + o))) * acc[ai][bj][m][n][r];
                if (pass == 1) v += bf2f(*(const u16*)(regT + o));
                *(u16*)(regT + o) = f2bf(v);
              }
        WAVE_LDS_SYNC();
        hblk_store(regT, MG, ob0, DM, lane);
        WAVE_LDS_SYNC();
      }
      asm volatile("s_waitcnt vmcnt(0)" ::: "memory");
    }
  }
}

__device__ __forceinline__ void phase5(const Params& p, unsigned char* smem) {
  const u16* MG = (const u16*)(p.ws + OFF_MERGED);
  const u16* WTO = (const u16*)(p.ws + OFF_WTO);
  const float* x = p.in[0];
  const int lane = TIDX & 63, wave = TIDX >> 6;
  const int wr = wave >> 2, wc = wave & 3, fr = lane & 15, fq = lane >> 4;
  const int ntn = DM / 256, ntiles = (MTOK / 256) * ntn;
  for (int t = blockIdx.x; t < ntiles; t += gridDim.x) {
    const int m0 = (t / ntn) * 256, n0 = (t % ntn) * 256;
    f32x4 acc[2][2][4][2];
    gemm8_tile(MG, WTO, DM, m0, n0, smem, acc);
    const u32 ob0 = (u32)(m0 + wr * 64 + 4 * fq) * DM + (u32)(n0 + wc * 64 + fr);
    float* outp = p.out;
#pragma unroll
    for (int ai = 0; ai < 2; ++ai)
#pragma unroll
      for (int m = 0; m < 4; ++m) {
#pragma unroll
        for (int bj = 0; bj < 2; ++bj)
#pragma unroll
          for (int n = 0; n < 2; ++n)
#pragma unroll
            for (int j = 0; j < 4; ++j) {
              u32 o = ob0 + (u32)((ai * 128 + m * 16 + j) * DM + (bj * 2 + n) * 16);
              outp[o] = x[o] + acc[ai][bj][m][n][j];
            }
        __builtin_amdgcn_sched_barrier(0);
      }
  }
}

__device__ __forceinline__ void phase6(const Params& p, unsigned char* smem) {
  const u16* H2 = (const u16*)(p.ws + OFF_H2);
  const u16* WTQ = (const u16*)(p.ws + OFF_WTQ);
  u16* QP = (u16*)(p.ws + OFF_QP);
  const int lane = TIDX & 63, wave = TIDX >> 6;
  const int wr = wave >> 2, wc = wave & 3, fr = lane & 15, fq = lane >> 4;
  const int ntn = 2048 / 256, ntiles = (MTOK / 256) * ntn;
  for (int t = blockIdx.x; t < ntiles; t += gridDim.x) {
    const int m0 = (t / ntn) * 256, n0 = (t % ntn) * 256;
    f32x4 acc[2][2][4][2];
    gemm8_tile(H2, WTQ, DM, m0, n0, smem, acc);
    ep_store<2048, false>(QP, (u32)(m0 + wr * 64) * 2048 + (u32)(n0 + wc * 64), acc, nullptr, 1.f, smem, wave, lane);
  }
}

__device__ __forceinline__ int mono_key(float v) { int b = __float_as_int(v); return b ^ ((b >> 31) & 0x7fffffff); }
__device__ __forceinline__ float unmono_key(int k) { return __int_as_float(k ^ ((k >> 31) & 0x7fffffff)); }
__device__ __forceinline__ void chain16(int (&k)[16], int x) {
#pragma unroll
  for (int j = 0; j < 16; ++j) { int hi = max(k[j], x); x = min(k[j], x); k[j] = hi; }
}

#define CE_DESC(a, b) { const int hi_ = max(a, b), lo_ = min(a, b); a = hi_; b = lo_; }
__device__ __forceinline__ void sort16_desc(int (&k)[16]) {
#pragma unroll
  for (int size = 2; size <= 16; size <<= 1) {
#pragma unroll
    for (int stride = size >> 1; stride > 0; stride >>= 1) {
#pragma unroll
      for (int i = 0; i < 16; ++i) {
        const int l = i ^ stride;
        if (l > i) {
          if ((i & size) == 0) CE_DESC(k[i], k[l]) else CE_DESC(k[l], k[i])
        }
      }
    }
  }
}
__device__ __forceinline__ void merge_top16(int (&a)[16], const int (&b)[16]) {
#pragma unroll
  for (int i = 0; i < 16; ++i) a[i] = max(a[i], b[15 - i]);
#pragma unroll
  for (int stride = 8; stride > 0; stride >>= 1) {
#pragma unroll
    for (int i = 0; i < 16; ++i) {
      const int l = i ^ stride;
      if (l > i) CE_DESC(a[i], a[l])
    }
  }
}

constexpr int P7_LD = 132;
__device__ __forceinline__ void phase7(const Params& p, unsigned char* smem) {
  const u16* QP = (const u16*)(p.ws + OFF_QP);
  const u16* SKB = (const u16*)(p.ws + OFF_SKB);
  float* TOPS = (float*)(p.ws + OFF_TOPS);
  u8* TOPI = (u8*)(p.ws + OFF_TOPI);
  const int tid = TIDX, lane = tid & 63, wave = tid >> 6;
  const int wm = wave >> 1, wn = wave & 1, fr = lane & 15, fg = lane >> 4;
  const int ntiles = (MTOK / G_BM) * 16;
  float* tile = (float*)smem;
  for (int t = blockIdx.x; t < ntiles; t += gridDim.x) {
    const int m0 = (t >> 4) * G_BM, hp = t & 15;
    f32x4 acc[4][4];
    gemm_mainloop(QP + hp * 128, 2048, SKB + (size_t)hp * 128 * 128, 128, 128, m0, 0, smem, acc);
#pragma unroll
    for (int i = 0; i < 4; ++i)
#pragma unroll
      for (int j = 0; j < 4; ++j)
#pragma unroll
        for (int r = 0; r < 4; ++r) {
          int row = wm * 64 + i * 16 + 4 * fg + r, col = wn * 64 + j * 16 + fr;
          tile[row * P7_LD + col] = acc[i][j][r];
        }
    __syncthreads();
    {
      const int row = tid >> 1, half = tid & 1;
      int k[16];
      const float* rowp = tile + row * P7_LD + half * 64;
#pragma unroll
      for (int grp = 0; grp < 4; ++grp) {
        int gk[16];
#pragma unroll
        for (int c = 0; c < 16; c += 4) {
          f32x4 v = *(const f32x4*)(rowp + grp * 16 + c);
          const int ib = 127 - (half * 64 + grp * 16 + c);
          gk[c] = (mono_key(v[0]) & ~127) | ib;
          gk[c + 1] = (mono_key(v[1]) & ~127) | (ib - 1);
          gk[c + 2] = (mono_key(v[2]) & ~127) | (ib - 2);
          gk[c + 3] = (mono_key(v[3]) & ~127) | (ib - 3);
        }
        sort16_desc(gk);
        if (grp == 0) {
#pragma unroll
          for (int j = 0; j < 16; ++j) k[j] = gk[j];
        } else merge_top16(k, gk);
      }
      {
        int other[16];
#pragma unroll
        for (int j = 0; j < 16; ++j) other[j] = DPPI(k[j], 0xb1);
        merge_top16(k, other);
      }
      if (half == 0) {
        size_t o = ((size_t)(m0 + row) * 16 + hp) * 16;
        float vals[16]; int idx[16];
#pragma unroll
        for (int j = 0; j < 16; ++j) { idx[j] = 127 - (k[j] & 127); vals[j] = tile[row * P7_LD + idx[j]]; }
#pragma unroll
        for (int j = 0; j < 16; j += 4) *(f32x4*)(TOPS + o + j) = (f32x4){vals[j], vals[j + 1], vals[j + 2], vals[j + 3]};
#pragma unroll
        for (int j = 0; j < 16; j += 4)
          *(u32*)(TOPI + o + j) = (u32)idx[j] | ((u32)idx[j + 1] << 8) | ((u32)idx[j + 2] << 16) | ((u32)idx[j + 3] << 24);
      }
    }
    __syncthreads();
  }
}

__device__ __forceinline__ void phase7b(const Params& p) {
  const float* TOPS = (const float*)(p.ws + OFF_TOPS);
  const u8* TOPI = (const u8*)(p.ws + OFF_TOPI);
  int* EXPERT = (int*)(p.ws + OFF_EXPERT);
  float* GATE = (float*)(p.ws + OFF_GATE);
  for (int w = blockIdx.x * NTHREADS + TIDX; w < MTOK * 8; w += gridDim.x * NTHREADS) {
    const size_t o = (size_t)w * 32;
    float sa[16], sb[16];
#pragma unroll
    for (int k = 0; k < 16; k += 4) {
      float4 v = *(const float4*)(TOPS + o + k); sa[k] = v.x; sa[k + 1] = v.y; sa[k + 2] = v.z; sa[k + 3] = v.w;
      float4 u = *(const float4*)(TOPS + o + 16 + k); sb[k] = u.x; sb[k + 1] = u.y; sb[k + 2] = u.z; sb[k + 3] = u.w;
    }
    int cand[64];
#pragma unroll
    for (int k = 0; k < 64; ++k) cand[k] = (int)0x80000000;
    {
      int cnt = 0;
#pragma unroll
      for (int a = 0; a < 16; ++a)
#pragma unroll
        for (int bb = 0; bb < 16; ++bb)
          if ((a + 1) * (bb + 1) <= 16) { cand[cnt] = (mono_key(sa[a] + sb[bb]) & ~255) | (255 - (a * 16 + bb)); ++cnt; }
    }
    int kk[16];
#pragma unroll
    for (int grp = 0; grp < 4; ++grp) {
      int gk[16];
#pragma unroll
      for (int j = 0; j < 16; ++j) gk[j] = cand[grp * 16 + j];
      sort16_desc(gk);
      if (grp == 0) {
#pragma unroll
        for (int j = 0; j < 16; ++j) kk[j] = gk[j];
      } else merge_top16(kk, gk);
    }
    float vals[16];
#pragma unroll
    for (int k = 0; k < 16; ++k) vals[k] = unmono_key(kk[k] & ~255);
    float m = vals[0], s = 0.f, e[16];
#pragma unroll
    for (int k = 0; k < 16; ++k) { e[k] = __expf(vals[k] - m); s += e[k]; }
    float inv = 1.f / s;
#pragma unroll
    for (int k = 0; k < 16; ++k) {
      const int ci = 255 - (kk[k] & 255);
      int a = ci >> 4, bb = ci & 15;
      int ex = (int)TOPI[o + a] * 128 + (int)TOPI[o + 16 + bb];
      EXPERT[(size_t)w * 16 + k] = ex;
      GATE[(size_t)w * 16 + k] = e[k] * inv;
    }
  }
  {
    const int lane = TIDX & 63, wave = TIDX >> 6;
    for (int row = blockIdx.x * 8 + wave; row < 2 * 16384; row += gridDim.x * 8) {
      const int tbl = row >> 14, r = row & 16383;
      const f32x4* src = (const f32x4*)((tbl ? p.in[16] : p.in[15]) + (size_t)r * DM) + 4 * lane;
      f32x4 x[4];
      float amax = 0.f;
#pragma unroll
      for (int i = 0; i < 4; ++i) {
        x[i] = src[i];
        amax = fmaxf(amax, fmaxf(fmaxf(fabsf(x[i][0]), fabsf(x[i][1])), fmaxf(fabsf(x[i][2]), fabsf(x[i][3]))));
      }
      amax = wave_max_dpp(amax);
      const float inv = amax > 0.f ? 127.f / amax : 0.f;
      const int bias = 0;
      u32x4 o;
#pragma unroll
      for (int i = 0; i < 4; ++i) {
        int q0 = (int)rintf(x[i][0] * inv) + bias, q1 = (int)rintf(x[i][1] * inv) + bias;
        int q2 = (int)rintf(x[i][2] * inv) + bias, q3 = (int)rintf(x[i][3] * inv) + bias;
        o[i] = (u32)(q0 & 0xff) | ((u32)(q1 & 0xff) << 8) | ((u32)(q2 & 0xff) << 16) | ((u32)(q3 & 0xff) << 24);
      }
      *(u32x4*)(p.ws + (tbl ? OFF_VQ : OFF_UQ) + ((size_t)(lane >> 3) * 16384 + r) * 128 + (lane & 7) * 16) = o;
      if (lane == 0) ((float*)(p.ws + (tbl ? OFF_VS : OFF_US)))[r] = amax * (1.f / 127.f);
    }
  }
}

__device__ __forceinline__ void phase8a(const Params& p) {
  const int* EXPERT = (const int*)(p.ws + OFF_EXPERT);
  const unsigned char* UQS = p.ws + OFF_UQ;
  const unsigned char* H2Q = p.ws + OFF_H2Q;
  int* PD = (int*)(p.ws + OFF_PD);
  unsigned* ctr = (unsigned*)(p.ws + 2048 + ((p.flags & 128) ? 4096 : 0));
  const unsigned xcc = (unsigned)__builtin_amdgcn_s_getreg((3 << 11) | 20) & 7u;
  const int lane = TIDX & 63, g8 = lane >> 3, l8 = lane & 7;
  for (unsigned db = 0; db < 8; ++db) {
    const int x = (int)((xcc + db) & 7u);
    for (;;) {
      unsigned ci = 0;
      if (lane == 0) ci = __hip_atomic_fetch_add(ctr + x * 16, 1u, __ATOMIC_RELAXED, __HIP_MEMORY_SCOPE_AGENT);
      ci = (unsigned)__builtin_amdgcn_readfirstlane((int)ci);
      if (ci >= (unsigned)(MTOK / 16)) break;
#pragma unroll 1
      for (int tt = 0; tt < 16; ++tt) {
        const int tok = (int)ci * 16 + tt;
        const int e0 = EXPERT[(size_t)tok * 128 + lane], e1 = EXPERT[(size_t)tok * 128 + 64 + lane];
        const u32x4 hq = *(const u32x4*)(H2Q + (size_t)tok * DM + x * 128 + l8 * 16);
        u32x4 ua[16];
#pragma unroll
        for (int i = 0; i < 16; ++i) {
          const int k = i * 8 + g8;
          const int ek = __shfl(i < 8 ? e0 : e1, k & 63);
          ua[i] = *(const u32x4*)(UQS + ((size_t)(x * 16384 + ek)) * 128 + l8 * 16);
        }
        int keep0 = 0, keep1 = 0;
#pragma unroll
        for (int i = 0; i < 16; ++i) {
          int sd = 0;
#pragma unroll
          for (int c = 0; c < 4; ++c) sd = __builtin_amdgcn_sdot4((int)ua[i][c], (int)hq[c], sd, false);
          sd += DPPI(sd, 0xb1); sd += DPPI(sd, 0x4e); sd += DPPI(sd, 0x141);
          if (i < 8) keep0 = (l8 == (i & 7)) ? sd : keep0; else keep1 = (l8 == (i & 7)) ? sd : keep1;
        }
        int* pd = PD + ((size_t)x * MTOK + tok) * 128 + l8 * 8 + g8;
        pd[0] = keep0; pd[64] = keep1;
      }
    }
  }
}

__device__ __forceinline__ void phase8c(const Params& p) {
  const int* EXPERT = (const int*)(p.ws + OFF_EXPERT);
  const float* GATE = (const float*)(p.ws + OFF_GATE);
  const float* US = (const float*)(p.ws + OFF_US);
  const float* VS = (const float*)(p.ws + OFF_VS);
  const float* HS = (const float*)(p.ws + OFF_HS);
  const int* PD = (const int*)(p.ws + OFF_PD);
  unsigned char* CQ8 = p.ws + OFF_CQ8;
  float* QSC = (float*)(p.ws + OFF_QSC);
  const int lane = TIDX & 63, wave = TIDX >> 6;
  for (int tok = blockIdx.x * 8 + wave; tok < MTOK; tok += gridDim.x * 8) {
    const int e0 = EXPERT[(size_t)tok * 128 + lane], e1 = EXPERT[(size_t)tok * 128 + 64 + lane];
    const float g0 = GATE[(size_t)tok * 128 + lane], g1 = GATE[(size_t)tok * 128 + 64 + lane];
    int s0 = 0, s1 = 0;
#pragma unroll
    for (int xx = 0; xx < 8; ++xx) {
      s0 += PD[((size_t)xx * MTOK + tok) * 128 + lane];
      s1 += PD[((size_t)xx * MTOK + tok) * 128 + 64 + lane];
    }
    const float hs = HS[tok];
    const float d0 = (float)s0 * US[e0] * hs, d1 = (float)s1 * US[e1] * hs;
    const float cf0 = g0 * 0.5f * d0 * (1.f + erff(d0 * 0.70710678118654752f)) * VS[e0];
    const float cf1 = g1 * 0.5f * d1 * (1.f + erff(d1 * 0.70710678118654752f)) * VS[e1];
    const float cmax = wave_max_dpp(fmaxf(fabsf(cf0), fabsf(cf1)));
    const float qinv = cmax > 0.f ? 32639.f / cmax : 0.f;
    const int c0 = (int)rintf(cf0 * qinv), c1 = (int)rintf(cf1 * qinv);
    const int h0 = (c0 + 128) >> 8, h1 = (c1 + 128) >> 8;
    unsigned char* cq = CQ8 + (size_t)tok * 256;
    cq[lane] = (unsigned char)(h0 & 0xff); cq[64 + lane] = (unsigned char)(h1 & 0xff);
    cq[128 + lane] = (unsigned char)((c0 - 256 * h0) & 0xff); cq[192 + lane] = (unsigned char)((c1 - 256 * h1) & 0xff);
    if (lane == 0) QSC[tok] = cmax * (1.f / 32639.f);
  }
}

#ifndef TR8_VARIANT
#define TR8_VARIANT 0
#endif
__device__ __forceinline__ void phase8b(const Params& p, unsigned char* smem) {
  typedef int i32x4 __attribute__((ext_vector_type(4)));
  typedef int i32x2 __attribute__((ext_vector_type(2)));
  typedef __attribute__((address_space(3))) i32x2 lds_i32x2;
  const int* EXPERT = (const int*)(p.ws + OFF_EXPERT);
  const unsigned char* VQS = p.ws + OFF_VQ;
  const unsigned char* CQ8 = p.ws + OFF_CQ8;
  const float* QSC = (const float*)(p.ws + OFF_QSC);
  unsigned* ctr = (unsigned*)(p.ws + 3072 + ((p.flags & 128) ? 4096 : 0));
  const unsigned xcc = (unsigned)__builtin_amdgcn_s_getreg((3 << 11) | 20) & 7u;
  const int lane = TIDX & 63, wave = TIDX >> 6, g8 = lane >> 3, l8 = lane & 7;
  const int fr = lane & 15, fg = lane >> 4;
  unsigned char* VST = smem + wave * 16384;
#if TR8_VARIANT == 0
  const int trow = (lane & 15) >> 1, thalf = lane & 1;
#else
  const int trow = lane & 7, thalf = (lane & 15) >> 3;
#endif
  __syncthreads();
  for (unsigned db = 0; db < 8; ++db) {
    const int x = (int)((xcc + db) & 7u);
    for (;;) {
      unsigned ci = 0;
      if (lane == 0) ci = __hip_atomic_fetch_add(ctr + x * 16, 1u, __ATOMIC_RELAXED, __HIP_MEMORY_SCOPE_AGENT);
      ci = (unsigned)__builtin_amdgcn_readfirstlane((int)ci);
      if (ci >= (unsigned)(MTOK / 16)) break;
#pragma unroll 1
      for (int tt = 0; tt < 16; ++tt) {
        const int tok = (int)ci * 16 + tt;
        const int e0 = EXPERT[(size_t)tok * 128 + lane], e1 = EXPERT[(size_t)tok * 128 + 64 + lane];
        u32x4 va[16];
#pragma unroll
        for (int i = 0; i < 16; ++i) {
          const int k = i * 8 + g8;
          const int ek = __shfl(i < 8 ? e0 : e1, k & 63);
          va[i] = *(const u32x4*)(VQS + ((size_t)(x * 16384 + ek)) * 128 + l8 * 16);
        }
        i32x4 af[2];
#pragma unroll
        for (int sx = 0; sx < 2; ++sx) {
          af[sx] = *(const i32x4*)(CQ8 + (size_t)tok * 256 + (fr & 1) * 128 + sx * 64 + fg * 16);
          if (fr >= 2) af[sx] = (i32x4){0, 0, 0, 0};
        }
        const float qsc = QSC[tok];
#pragma unroll
        for (int i = 0; i < 16; ++i) {
          const int k = i * 8 + g8;
          *(u32x4*)(VST + k * 128 + ((l8 ^ g8) << 4)) = va[i];
        }
        WAVE_LDS_SYNC();
        i32x4 acc[8];
#pragma unroll
        for (int c = 0; c < 8; ++c) acc[c] = (i32x4){0, 0, 0, 0};
#pragma unroll
        for (int sx = 0; sx < 2; ++sx) {
          const int r1 = sx * 64 + fg * 16 + trow, r2 = r1 + 8;
#pragma unroll
          for (int c = 0; c < 8; ++c) {
            const i32x2 lo = __builtin_amdgcn_ds_read_tr8_b64_v2i32((lds_i32x2*)(VST + r1 * 128 + ((c ^ (r1 & 7)) << 4) + 8 * thalf));
            const i32x2 hi = __builtin_amdgcn_ds_read_tr8_b64_v2i32((lds_i32x2*)(VST + r2 * 128 + ((c ^ (r2 & 7)) << 4) + 8 * thalf));
            const i32x4 bf = {lo[0], lo[1], hi[0], hi[1]};
            acc[c] = __builtin_amdgcn_mfma_i32_16x16x64_i8(af[sx], bf, acc[c], 0, 0, 0);
          }
        }
        WAVE_LDS_SYNC();
        if (lane < 16 && !(p.flags & 32)) {
          float* op = p.out + (size_t)tok * DM + x * 128 + fr;
#pragma unroll
          for (int c = 0; c < 8; ++c) op[16 * c] += ((float)acc[c][0] * 256.f + (float)acc[c][1]) * qsc;
        }
      }
    }
  }
}

__device__ __forceinline__ void grid_barrier(unsigned* ctr, unsigned target) {
  asm volatile("s_waitcnt vmcnt(0)" ::: "memory");
  __syncthreads();
  if (TIDX == 0) {
    __builtin_amdgcn_fence(__ATOMIC_RELEASE, "agent");
    asm volatile("s_waitcnt vmcnt(0)" ::: "memory");
    __hip_atomic_fetch_add(ctr, 1u, __ATOMIC_RELAXED, __HIP_MEMORY_SCOPE_AGENT);
    while (__hip_atomic_load(ctr, __ATOMIC_RELAXED, __HIP_MEMORY_SCOPE_AGENT) < target) __builtin_amdgcn_s_sleep(2);
    __builtin_amdgcn_fence(__ATOMIC_ACQUIRE, "agent");
    asm volatile("s_waitcnt vmcnt(0)" ::: "memory");
  }
  __syncthreads();
}

__global__ void __launch_bounds__(NTHREADS, 2) mk_fwd(Params p) {
  cg::grid_group grid = cg::this_grid();
  __shared__ __attribute__((aligned(16))) unsigned char smem[SMEM_BYTES];
  const int lo = p.ph_lo, hi = p.ph_hi;
#define RUN(k, call) if (lo <= (k) && (k) < hi) { call; if ((k) + 1 < hi) { if ((k) == 0) grid.sync(); else grid_barrier((unsigned*)p.ws, (unsigned)(lo == 0 ? (k) : (k) - lo + 1) * gridDim.x); } }
  RUN(0, phase0(p, smem))
  RUN(1, phase1(p, smem))
  RUN(2, phase2(p, smem))
  RUN(3, phase3(p, smem))
  RUN(4, phase4(p, smem))
  RUN(5, phase5(p, smem))
  RUN(6, rmsnorm_rows<true>(p.out, p.in[12], (u16*)(p.ws + OFF_H2), p.ws + OFF_H2Q, (float*)(p.ws + OFF_HS)))
  RUN(7, phase6(p, smem))
  RUN(8, phase7(p, smem))
  RUN(9, phase7b(p))
  RUN(10, phase8a(p))
  RUN(11, phase8c(p))
  RUN(12, phase8b(p, smem))
#undef RUN
}

extern "C" void kernel_launch(void* const* d_in, const int* in_sizes, int n_in,
                              void* d_out, int out_size, void* d_ws, size_t ws_size,
                              hipStream_t stream) {
  static int grid_blocks = 0;
  if (!grid_blocks) {
    int dev = 0, cus = 0, per_cu = 0;
    (void)hipGetDevice(&dev);
    (void)hipDeviceGetAttribute(&cus, hipDeviceAttributeMultiprocessorCount, dev);
    (void)hipOccupancyMaxActiveBlocksPerMultiprocessor(&per_cu, mk_fwd, NTHREADS, 0);
    if (per_cu < 1) per_cu = 1;
    if (per_cu > 1) per_cu = 1;
    grid_blocks = cus * per_cu;
    fprintf(stderr, "mk_fwd: cus=%d per_cu=%d grid=%d ws=%zu\n", cus, per_cu, grid_blocks, ws_size);
  }
  Params p{};
  for (int i = 0; i < 17 && i < n_in; ++i) p.in[i] = (const float*)d_in[i];
  p.out = (float*)d_out;
  p.ws = (unsigned char*)d_ws;
  p.ph_lo = 0; p.ph_hi = 13;
  (void)hipMemsetAsync(d_ws, 0, 8192, stream);
  void* args[] = {&p};
  hipError_t e = hipLaunchCooperativeKernel((void*)mk_fwd, dim3(grid_blocks), dim3(NTHREADS), args, 0, stream);
  if (e != hipSuccess) fprintf(stderr, "cooperative launch failed: %s (grid %d)\n", hipGetErrorString(e), grid_blocks);
#ifdef EXTRA_LO
  {
    Params p2 = p;
    p2.ph_lo = EXTRA_LO; p2.ph_hi = EXTRA_HI; p2.flags = EXTRA_FLAGS;
    void* args2[] = {&p2};
    (void)hipLaunchCooperativeKernel((void*)mk_fwd, dim3(grid_blocks), dim3(NTHREADS), args2, 0, stream);
  }
#endif
}
```

```cpp
#include <hip/hip_runtime.h>
#include <hip/hip_bf16.h>
#include <hip/hip_cooperative_groups.h>
#include <cstdio>
#include <cstdint>
namespace cg = cooperative_groups;

typedef unsigned short u16;
typedef unsigned int u32;
typedef unsigned char u8;
typedef short bf16x8 __attribute__((ext_vector_type(8)));
typedef float f32x4 __attribute__((ext_vector_type(4)));
typedef unsigned int u32x4 __attribute__((ext_vector_type(4)));
typedef unsigned int u32x2 __attribute__((ext_vector_type(2)));

constexpr int NTHREADS = 512;
constexpr int BATCH = 8, SEQ = 4096, DM = 1024, MTOK = BATCH * SEQ;
constexpr int LDP = 5120;
constexpr int NPADW = 5632;
constexpr int C_AQ = 0, C_IQ = 512, C_DQ = 1024, C_DK = 1536, C_DV = 2048, C_DZ = 2560, C_GA = 3072, C_GB = 4096;
constexpr int N_AK = 5120, N_AV = 5248, N_IK = 5376, N_SM = 5440;
constexpr size_t MiB = 1ull << 20;
constexpr size_t OFF_WTIN = 1 * MiB, OFF_WTA = 12 * MiB, OFF_WTB = 13 * MiB, OFF_WTO = 14 * MiB, OFF_WTQ = 16 * MiB,
                 OFF_SKB = 20 * MiB, OFF_SMALL = 21 * MiB, OFF_H = 23 * MiB, OFF_ATT = 23 * MiB, OFF_GC = 39 * MiB,
                 OFF_MERGED = 23 * MiB, OFF_PROJ = 87 * MiB, OFF_KVC = 407 * MiB, OFF_IKC = 423 * MiB, OFF_SEL = 427 * MiB, OFF_YATT = 443 * MiB,
                 OFF_YDN = 475 * MiB;
constexpr size_t OFF_H2 = OFF_PROJ, OFF_QP = OFF_PROJ + 64 * MiB, OFF_TOPS = OFF_PROJ + 192 * MiB,
                 OFF_TOPI = OFF_PROJ + 224 * MiB, OFF_EXPERT = OFF_PROJ + 232 * MiB, OFF_GATE = OFF_PROJ + 248 * MiB;
constexpr size_t OFF_UQ = OFF_PROJ + 264 * MiB, OFF_VQ = OFF_PROJ + 280 * MiB, OFF_US = OFF_PROJ + 296 * MiB, OFF_VS = OFF_PROJ + 297 * MiB;
constexpr size_t OFF_CQ8 = 56 * MiB, OFF_QSC = 64 * MiB;
constexpr size_t OFF_H2Q = 23 * MiB, OFF_HS = 55 * MiB, OFF_PD = OFF_PROJ + 64 * MiB;
constexpr size_t DO_U = 0, DO_W = 32 * MiB, DO_QN = 64 * MiB, DO_KNT = 96 * MiB;

constexpr int SMEM_BYTES = 162816;
constexpr float EPS = 1e-6f;

struct Params {
  const float* in[17];
  float* out;
  unsigned char* ws;
  int ph_lo, ph_hi;
  int flags, pad;
};

typedef __bf16 bf16x2_t __attribute__((ext_vector_type(2)));
typedef float f32x2_t __attribute__((ext_vector_type(2)));
__device__ __forceinline__ u32 pack2(float a, float b) {
  f32x2_t f = {a, b};
  return __builtin_bit_cast(u32, __builtin_convertvector(f, bf16x2_t));
}
__device__ __forceinline__ u16 f2bf(float f) { return (u16)(pack2(f, f) & 0xffffu); }
__device__ __forceinline__ float bf2f(u16 h) { return __uint_as_float(((u32)h) << 16); }
__device__ __forceinline__ float bflo(u32 w) { return __uint_as_float(w << 16); }
__device__ __forceinline__ float bfhi(u32 w) { return __uint_as_float(w & 0xffff0000u); }
__device__ __forceinline__ float wave_sum(float v) {
#pragma unroll
  for (int o = 32; o > 0; o >>= 1) v += __shfl_xor(v, o);
  return v;
}
__device__ __forceinline__ float wave_max(float v) {
#pragma unroll
  for (int o = 32; o > 0; o >>= 1) v = fmaxf(v, __shfl_xor(v, o));
  return v;
}
__device__ __forceinline__ float dot2bf(u32 a, u32 b, float acc) {
  return __builtin_amdgcn_fdot2_f32_bf16(__builtin_bit_cast(bf16x2_t, a), __builtin_bit_cast(bf16x2_t, b), acc, false);
}
#define DPPF(v, ctrl) __int_as_float(__builtin_amdgcn_update_dpp(0, __float_as_int(v), ctrl, 0xf, 0xf, true))
__device__ __forceinline__ float wave_sum_dpp(float v) {
  v += DPPF(v, 0xb1);
  v += DPPF(v, 0x4e);
  v += DPPF(v, 0x124);
  v += DPPF(v, 0x128);
  float r0 = __int_as_float(__builtin_amdgcn_readlane(__float_as_int(v), 0));
  float r1 = __int_as_float(__builtin_amdgcn_readlane(__float_as_int(v), 16));
  float r2 = __int_as_float(__builtin_amdgcn_readlane(__float_as_int(v), 32));
  float r3 = __int_as_float(__builtin_amdgcn_readlane(__float_as_int(v), 48));
  return (r0 + r1) + (r2 + r3);
}
__device__ __forceinline__ int opaque_tid() { int t = threadIdx.x; asm volatile("" : "+v"(t)); return t; }
#define TIDX opaque_tid()
#define DPPI(v, ctrl) __builtin_amdgcn_update_dpp(0, (v), ctrl, 0xf, 0xf, true)
__device__ __forceinline__ int wave_sum_i_dpp(int v) {
  v += DPPI(v, 0xb1);
  v += DPPI(v, 0x4e);
  v += DPPI(v, 0x124);
  v += DPPI(v, 0x128);
  return (__builtin_amdgcn_readlane(v, 0) + __builtin_amdgcn_readlane(v, 16)) +
         (__builtin_amdgcn_readlane(v, 32) + __builtin_amdgcn_readlane(v, 48));
}
__device__ __forceinline__ float wave_max_dpp(float v) {
  v = fmaxf(v, DPPF(v, 0xb1));
  v = fmaxf(v, DPPF(v, 0x4e));
  v = fmaxf(v, DPPF(v, 0x124));
  v = fmaxf(v, DPPF(v, 0x128));
  float r0 = __int_as_float(__builtin_amdgcn_readlane(__float_as_int(v), 0));
  float r1 = __int_as_float(__builtin_amdgcn_readlane(__float_as_int(v), 16));
  float r2 = __int_as_float(__builtin_amdgcn_readlane(__float_as_int(v), 32));
  float r3 = __int_as_float(__builtin_amdgcn_readlane(__float_as_int(v), 48));
  return fmaxf(fmaxf(r0, r1), fmaxf(r2, r3));
}
#define WAVE_LDS_SYNC() asm volatile("s_waitcnt lgkmcnt(0)" ::: "memory")
__device__ __forceinline__ float sigmoidf_(float x) { return __builtin_amdgcn_rcpf(1.f + __expf(-x)); }
__device__ __forceinline__ int perm32(int k) {
  int blk = k & ~31, r = k & 31;
  int p = (r < 16) ? (8 * (r >> 2) + (r & 3)) : (8 * ((r - 16) >> 2) + 4 + (r & 3));
  return blk + p;
}

__device__ __forceinline__ u32 fp8x4(float a, float b, float c, float d) {
  int w = __builtin_amdgcn_cvt_pk_fp8_f32(a, b, 0, false);
  w = __builtin_amdgcn_cvt_pk_fp8_f32(c, d, w, true);
  return (u32)w;
}
__device__ __forceinline__ int g8_logical_col(int t) { return ((t & 127) >> 5) * 64 + (t >> 7) * 32 + (t & 31); }
__device__ __forceinline__ int win_map(int n) {
  if (n < 512) return n;
  if (n < 1024) return 768 + (n - 512);
  if (n < 3072) return 1352 + (n - 1024);
  if (n < 5120) return 3408 + (n - 3072);
  if (n < 5248) return 512 + (n - 5120);
  if (n < 5376) return 640 + (n - 5248);
  if (n < 5440) return 1280 + (n - 5376);
  if (n < 5448) return 1344 + (n - 5440);
  if (n < 5452) return 3400 + (n - 5448);
  if (n < 5456) return 3404 + (n - 5452);
  return -1;
}
__device__ __forceinline__ void transpose_tile(const float* __restrict__ src, int Nsrc, u16* __restrict__ dst, int K, int k0, int n0,
                               bool mapped, bool perm8, float* tile  , float f8scale = 0.f) {
  const int tid = TIDX;
  {
    const int tx = tid & 63, ty = tid >> 6;
    int n = n0 + tx;
    if (perm8) n = (n & ~255) + g8_logical_col(n & 255);
    int sc = mapped ? win_map(n) : n;
#pragma unroll
    for (int i = 0; i < 8; ++i) {
      int k = ty + 8 * i;
      float v = (sc >= 0) ? src[(size_t)(k0 + k) * Nsrc + sc] : 0.f;
      tile[k * 65 + tx] = v;
    }
  }
  __syncthreads();
  {
    const int n = tid >> 3, kc = (tid & 7) * 8;
    if (f8scale != 0.f) {
      u32 w[2];
#pragma unroll
      for (int j = 0; j < 2; ++j)
        w[j] = fp8x4(tile[(kc + 4 * j) * 65 + n] * f8scale, tile[(kc + 4 * j + 1) * 65 + n] * f8scale,
                     tile[(kc + 4 * j + 2) * 65 + n] * f8scale, tile[(kc + 4 * j + 3) * 65 + n] * f8scale);
      *(uint2*)((unsigned char*)dst + (size_t)(n0 + n) * K + k0 + kc) = make_uint2(w[0], w[1]);
    } else {
    u32 w[4];
#pragma unroll
    for (int j = 0; j < 4; ++j) w[j] = pack2(tile[(kc + 2 * j) * 65 + n], tile[(kc + 2 * j + 1) * 65 + n]);
    *(uint4*)(dst + (size_t)(n0 + n) * K + k0 + kc) = make_uint4(w[0], w[1], w[2], w[3]);
    }
  }
  __syncthreads();
}

template <bool Q8, bool F8OUT = false>
__device__ __forceinline__ void rmsnorm_rows(const float* __restrict__ x, const float* __restrict__ gain, u16* __restrict__ out,
                                             unsigned char* __restrict__ q8, float* __restrict__ qs) {
  const int lane = TIDX & 63, wave = TIDX >> 6;
  float4 g[4];
#pragma unroll
  for (int i = 0; i < 4; ++i) g[i] = ((const float4*)gain)[lane + 64 * i];
  for (int row = blockIdx.x * 8 + wave; row < MTOK; row += gridDim.x * 8) {
    const float4* xr = (const float4*)(x + (size_t)row * DM);
    float4 v[4];
    float ss = 0.f;
#pragma unroll
    for (int i = 0; i < 4; ++i) {
      v[i] = xr[lane + 64 * i];
      ss += v[i].x * v[i].x + v[i].y * v[i].y + v[i].z * v[i].z + v[i].w * v[i].w;
    }
    ss = wave_sum_dpp(ss);
    float r = rsqrtf(ss * (1.f / DM) + EPS);
    float amax = 0.f;
#pragma unroll
    for (int i = 0; i < 4; ++i) {
      v[i].x *= r * g[i].x; v[i].y *= r * g[i].y; v[i].z *= r * g[i].z; v[i].w *= r * g[i].w;
      if (F8OUT) {
        *(u32*)((unsigned char*)out + (size_t)row * DM + 4 * (lane + 64 * i)) = fp8x4(2.f * v[i].x, 2.f * v[i].y, 2.f * v[i].z, 2.f * v[i].w);
      } else {
        uint2 o;
        o.x = pack2(v[i].x, v[i].y);
        o.y = pack2(v[i].z, v[i].w);
        *(uint2*)(out + (size_t)row * DM + 4 * (lane + 64 * i)) = o;
      }
      if (Q8) amax = fmaxf(amax, fmaxf(fmaxf(fabsf(v[i].x), fabsf(v[i].y)), fmaxf(fabsf(v[i].z), fabsf(v[i].w))));
    }
    if (Q8) {
      amax = wave_max_dpp(amax);
      const float inv = amax > 0.f ? 127.f / amax : 0.f;
#pragma unroll
      for (int i = 0; i < 4; ++i) {
        const int q0 = (int)rintf(v[i].x * inv), q1 = (int)rintf(v[i].y * inv), q2 = (int)rintf(v[i].z * inv), q3 = (int)rintf(v[i].w * inv);
        *(u32*)(q8 + (size_t)row * DM + 4 * (lane + 64 * i)) =
            (u32)(q0 & 0xff) | ((u32)(q1 & 0xff) << 8) | ((u32)(q2 & 0xff) << 16) | ((u32)(q3 & 0xff) << 24);
      }
      if (lane == 0) qs[row] = amax * (1.f / 127.f);
    }
  }
}

__device__ __forceinline__ void phase0(const Params& p, unsigned char* smem) {
  float* tile = (float*)smem;
  unsigned char* ws = p.ws;
  const int n_in = 16 * 88, n_a = 8 * 16, n_b = 8 * 16, n_o = 16 * 16, n_q = 16 * 32;
  const int total = n_in + n_a + n_b + n_o + n_q;
  for (int t = blockIdx.x; t < total; t += gridDim.x) {
    int i = t;
    if (i < n_in) { transpose_tile(p.in[2], 5456, (u16*)(ws + OFF_WTIN), 1024, (i / 88) * 64, (i % 88) * 64, true, true, tile, 32.f); continue; }
    i -= n_in;
    if (i < n_a) { transpose_tile(p.in[9], 1024, (u16*)(ws + OFF_WTA), 512, (i / 16) * 64, (i % 16) * 64, false, true, tile); continue; }
    i -= n_a;
    if (i < n_b) { transpose_tile(p.in[10], 1024, (u16*)(ws + OFF_WTB), 512, (i / 16) * 64, (i % 16) * 64, false, true, tile); continue; }
    i -= n_b;
    if (i < n_o) { transpose_tile(p.in[11], 1024, (u16*)(ws + OFF_WTO), 1024, (i / 16) * 64, (i % 16) * 64, false, true, tile); continue; }
    i -= n_o;
    transpose_tile(p.in[13], 2048, (u16*)(ws + OFF_WTQ), 1024, (i / 32) * 64, (i % 32) * 64, false, true, tile);
  }
  {
    const float* sk = p.in[14];
    u16* skb = (u16*)(ws + OFF_SKB);
    for (int i = blockIdx.x * NTHREADS + TIDX; i < 16 * 128 * 128; i += gridDim.x * NTHREADS) skb[i] = f2bf(sk[i]);
  }
  rmsnorm_rows<false, true>(p.in[0], p.in[1], (u16*)(ws + OFF_H), nullptr, nullptr);
}

constexpr int G_BM = 256, G_BN = 128, G_BK = 64;
constexpr int G_ABYTES = G_BM * 128;

template <int MI>
__device__ __forceinline__ void gemm_mainloop_t(const u16* __restrict__ A, int lda, const u16* __restrict__ Bt, int ldb, int K,
                                                int m0, int n0, unsigned char* smem, f32x4 (&acc)[MI][4]) {
  constexpr int BN = (MI == 4) ? 128 : 256;
  constexpr int NRB = BN / 64;
  constexpr int STAGE = G_ABYTES + BN * 128;
  const int tid = TIDX, lane = tid & 63, wave = tid >> 6;
  const int wm = (MI == 4) ? (wave >> 1) : (wave >> 2), wn = (MI == 4) ? (wave & 1) : (wave & 3);
#pragma unroll
  for (int i = 0; i < MI; ++i)
#pragma unroll
    for (int j = 0; j < 4; ++j) acc[i][j] = (f32x4){0.f, 0.f, 0.f, 0.f};
  const int kc = tid & 7;
  const int arow = tid >> 3;
  u32x4 ra[4], rb[NRB];
  const u16* ap = A + (size_t)(m0 + arow) * lda + kc * 8;
  const u16* bp = Bt + (size_t)(n0 + arow) * ldb + kc * 8;
  const int nk = K / G_BK;
  const int fr = lane & 15, fg = lane >> 4;
#define G_LOAD(kt_)                                                                       \
  {                                                                                       \
    const u16* ap2_ = ap + (size_t)(kt_) * G_BK;                                          \
    const u16* bp2_ = bp + (size_t)(kt_) * G_BK;                                          \
    _Pragma("unroll") for (int i = 0; i < 4; ++i) ra[i] = *(const u32x4*)(ap2_ + (size_t)(64 * i) * lda); \
    _Pragma("unroll") for (int i = 0; i < NRB; ++i) rb[i] = *(const u32x4*)(bp2_ + (size_t)(64 * i) * ldb); \
  }
#define G_STORE(st_)                                                                      \
  {                                                                                       \
    unsigned char* sa_ = smem + (st_) * STAGE;                                            \
    unsigned char* sb_ = sa_ + G_ABYTES;                                                  \
    _Pragma("unroll") for (int i = 0; i < 4; ++i) { int r = arow + 64 * i; *(u32x4*)(sa_ + r * 128 + ((kc ^ (r & 7)) << 4)) = ra[i]; } \
    _Pragma("unroll") for (int i = 0; i < NRB; ++i) { int r = arow + 64 * i; *(u32x4*)(sb_ + r * 128 + ((kc ^ (r & 7)) << 4)) = rb[i]; } \
  }
  G_LOAD(0)
  __syncthreads();
  G_STORE(0)
  if (nk > 1) G_LOAD(1)
  __syncthreads();
  for (int kt = 0; kt < nk; ++kt) {
    if (kt + 1 < nk) G_STORE((kt + 1) & 1)
    if (kt + 2 < nk) G_LOAD(kt + 2)
    __builtin_amdgcn_sched_barrier(0);
    const unsigned char* sa = smem + (kt & 1) * STAGE;
    const unsigned char* sb = sa + G_ABYTES;
#pragma unroll
    for (int kk = 0; kk < 2; ++kk) {
      bf16x8 bfr[4];
#pragma unroll
      for (int j = 0; j < 4; ++j) {
        int r = wn * 64 + j * 16 + fr;
        bfr[j] = *(const bf16x8*)(sb + r * 128 + (((kk * 4 + fg) ^ (r & 7)) << 4));
      }
#pragma unroll
      for (int ih = 0; ih < MI; ih += 4) {
        bf16x8 af[4];
#pragma unroll
        for (int i = 0; i < 4; ++i) {
          int r = wm * (MI * 16) + (ih + i) * 16 + fr;
          af[i] = *(const bf16x8*)(sa + r * 128 + (((kk * 4 + fg) ^ (r & 7)) << 4));
        }
#pragma unroll
        for (int i = 0; i < 4; ++i)
#pragma unroll
          for (int j = 0; j < 4; ++j) acc[ih + i][j] = __builtin_amdgcn_mfma_f32_16x16x32_bf16(af[i], bfr[j], acc[ih + i][j], 0, 0, 0);
        if (MI == 8 && ih == 0) __builtin_amdgcn_sched_barrier(0);
      }
    }
    __syncthreads();
  }
#undef G_LOAD
#undef G_STORE
}
__device__ __forceinline__ void gemm_mainloop(const u16* __restrict__ A, int lda, const u16* __restrict__ Bt, int ldb, int K,
                                              int m0, int n0, unsigned char* smem, f32x4 (&acc)[4][4]) {
  gemm_mainloop_t<4>(A, lda, Bt, ldb, K, m0, n0, smem, acc);
}

__device__ __forceinline__ int g8_lds_byte(int r, int c) {
  int st = (r >> 4) * 2 + (c >> 5), rr = r & 15, cc = c & 31, ob = rr * 64 + cc * 2;
  return st * 1024 + (ob ^ (((ob >> 9) & 1) << 5));
}
__device__ __forceinline__ void g8_stage_rc(int b, int& R, int& C) {
  int st = b / 1024, sb = b % 1024, swz = sb ^ (((sb >> 9) & 1) << 5);
  R = (st >> 1) * 16 + swz / 64; C = (st & 1) * 32 + (swz % 64) / 2;
}
typedef __attribute__((address_space(3))) unsigned int lds_u32;
template <int F8 = 0, int SC = 127>
__device__ __forceinline__ void gemm8_tile(const u16* __restrict__ A, const u16* __restrict__ Bt, int K, int brow, int bcol,
                                           unsigned char* smem, f32x4 (&acc)[2][2][4][2]) {
  typedef int i32x8_ __attribute__((ext_vector_type(8)));
  typedef int i32x4_ __attribute__((ext_vector_type(4)));
  constexpr int HTB = 16384;
  const int tid = TIDX;
  const int wid = tid >> 6, lane = tid & 63, wr = wid >> 2, wc = wid & 3, fr = lane & 15, fq = lane >> 4;
#define SA(b, h) (smem + ((b) * 2 + (h)) * HTB)
#define SB(b, h) (smem + (4 + (b) * 2 + (h)) * HTB)
  u32 soff0;
  { int _r, _c; g8_stage_rc(tid * 16, _r, _c); soff0 = (u32)(_r * K + _c) * 2u; }
  const int wbase = __builtin_amdgcn_readfirstlane(wid) * 1024;
#define STAGE(P, BASE, br, kt) do { \
    unsigned long long _uv0 = (unsigned long long)(BASE) + (unsigned long long)(((long)(br) * K + (long)(kt) * 64) * 2); \
    unsigned long long _uv1 = _uv0 + (unsigned long long)(64 * K * 2); \
    asm volatile("" : "+s"(_uv0), "+s"(_uv1)); \
    __builtin_amdgcn_global_load_lds((const unsigned int*)((const unsigned char*)_uv0 + soff0), (lds_u32*)((P) + wbase), 16, 0, 0); \
    __builtin_amdgcn_global_load_lds((const unsigned int*)((const unsigned char*)_uv1 + soff0), (lds_u32*)((P) + wbase + 8192), 16, 0, 0); } while (0)
#define LDA(dst, b, h) _Pragma("unroll") for (int m = 0; m < 4; ++m) _Pragma("unroll") for (int k = 0; k < 2; ++k) \
    dst[m][k] = *(const bf16x8*)(SA(b, h) + g8_lds_byte(wr * 64 + m * 16 + fr, k * 32 + fq * 8))
#define LDB(dst, b, h) _Pragma("unroll") for (int n = 0; n < 2; ++n) _Pragma("unroll") for (int k = 0; k < 2; ++k) \
    dst[n][k] = *(const bf16x8*)(SB(b, h) + g8_lds_byte(wc * 32 + n * 16 + fr, k * 32 + fq * 8))
#define MMA(ai, bj, At_, Bt_) do { __builtin_amdgcn_s_setprio(1); \
    if (F8) { \
      _Pragma("unroll") for (int m = 0; m < 4; ++m) _Pragma("unroll") for (int n = 0; n < 2; ++n) \
        acc[ai][bj][m][n] = __builtin_amdgcn_mfma_scale_f32_16x16x128_f8f6f4( \
            __builtin_shufflevector((i32x4_)At_[m][0], (i32x4_)At_[m][1], 0, 1, 2, 3, 4, 5, 6, 7), \
            __builtin_shufflevector((i32x4_)Bt_[n][0], (i32x4_)Bt_[n][1], 0, 1, 2, 3, 4, 5, 6, 7), \
            acc[ai][bj][m][n], 0, 0, 0, SC * 0x01010101, 0, SC * 0x01010101); \
    } else { \
    _Pragma("unroll") for (int m = 0; m < 4; ++m) _Pragma("unroll") for (int n = 0; n < 2; ++n) _Pragma("unroll") for (int k = 0; k < 2; ++k) \
      acc[ai][bj][m][n] = __builtin_amdgcn_mfma_f32_16x16x32_bf16(At_[m][k], Bt_[n][k], acc[ai][bj][m][n], 0, 0, 0); \
    } \
    __builtin_amdgcn_s_setprio(0); } while (0)
#define WAIT_V(n) asm volatile("s_waitcnt vmcnt(" #n ")" ::: "memory")
#define WAIT_L(n) asm volatile("s_waitcnt lgkmcnt(" #n ")" ::: "memory")
#define BAR __builtin_amdgcn_s_barrier()
#define SCHED __builtin_amdgcn_sched_barrier(0)
#pragma unroll
  for (int a = 0; a < 2; ++a)
#pragma unroll
    for (int b2 = 0; b2 < 2; ++b2)
#pragma unroll
      for (int m = 0; m < 4; ++m)
#pragma unroll
        for (int n = 0; n < 2; ++n) acc[a][b2][m][n] = (f32x4){0.f, 0.f, 0.f, 0.f};
  bf16x8 At[4][2], B0[2][2], B1[2][2];
  const int nt = K / 64;
  constexpr int HALF = 128;
  __syncthreads();
  STAGE(SB(0, 0), Bt, bcol, 0); STAGE(SA(0, 0), A, brow, 0);
  STAGE(SB(0, 1), Bt, bcol + HALF, 0); STAGE(SA(0, 1), A, brow + HALF, 0);
  if (wr == 1) BAR;
  WAIT_V(4); BAR;
  STAGE(SB(1, 0), Bt, bcol, 1); STAGE(SA(1, 0), A, brow, 1); STAGE(SB(1, 1), Bt, bcol + HALF, 1);
  WAIT_V(6); BAR;
#pragma unroll 1
  for (int t = 0; t < nt - 2; t += 2) {
    LDB(B0, 0, 0); SCHED; LDA(At, 0, 0); STAGE(SA(1, 1), A, brow + HALF, t + 1);
    WAIT_L(8); BAR; WAIT_L(0); MMA(0, 0, At, B0); BAR; SCHED;
    LDB(B1, 0, 1); STAGE(SB(0, 0), Bt, bcol, t + 2);
    BAR; WAIT_L(0); MMA(0, 1, At, B1); BAR;
    LDA(At, 0, 1); STAGE(SA(0, 0), A, brow, t + 2);
    BAR; WAIT_L(0); MMA(1, 0, At, B0); BAR; SCHED;
    STAGE(SB(0, 1), Bt, bcol + HALF, t + 2);
    WAIT_V(6); BAR; MMA(1, 1, At, B1); BAR;
    LDB(B0, 1, 0); SCHED; LDA(At, 1, 0); STAGE(SA(0, 1), A, brow + HALF, t + 2);
    WAIT_L(8); BAR; WAIT_L(0); MMA(0, 0, At, B0); BAR; SCHED;
    LDB(B1, 1, 1); STAGE(SB(1, 0), Bt, bcol, t + 3);
    BAR; WAIT_L(0); MMA(0, 1, At, B1); BAR;
    LDA(At, 1, 1); STAGE(SA(1, 0), A, brow, t + 3);
    BAR; WAIT_L(0); MMA(1, 0, At, B0); BAR; SCHED;
    STAGE(SB(1, 1), Bt, bcol + HALF, t + 3);
    WAIT_V(6); BAR; MMA(1, 1, At, B1); BAR;
  }
  { LDB(B0, 0, 0); LDA(At, 0, 0); STAGE(SA(1, 1), A, brow + HALF, nt - 1);
    BAR; WAIT_L(0); MMA(0, 0, At, B0); BAR; SCHED;
    LDB(B1, 0, 1); BAR; WAIT_L(0); MMA(0, 1, At, B1); BAR; SCHED;
    LDA(At, 0, 1); WAIT_V(4); BAR; WAIT_L(0); MMA(1, 0, At, B0); MMA(1, 1, At, B1); BAR; SCHED; }
  { LDB(B0, 1, 0); LDA(At, 1, 0); WAIT_V(2); BAR; WAIT_L(0); MMA(0, 0, At, B0); BAR; SCHED;
    LDB(B1, 1, 1); WAIT_V(0); BAR; WAIT_L(0); MMA(0, 1, At, B1); BAR; SCHED;
    LDA(At, 1, 1); BAR; WAIT_L(0); MMA(1, 0, At, B0); MMA(1, 1, At, B1); BAR; SCHED; }
#pragma unroll
  for (int a = 0; a < 2; ++a)
#pragma unroll
    for (int b2 = 0; b2 < 2; ++b2)
      asm volatile("" : "+v"(acc[a][b2][0][0]), "+v"(acc[a][b2][0][1]), "+v"(acc[a][b2][1][0]), "+v"(acc[a][b2][1][1]),
                        "+v"(acc[a][b2][2][0]), "+v"(acc[a][b2][2][1]), "+v"(acc[a][b2][3][0]), "+v"(acc[a][b2][3][1]));
  if (wr == 0) BAR;
#undef SA
#undef SB
#undef STAGE
#undef LDA
#undef LDB
#undef MMA
#undef WAIT_V
#undef WAIT_L
#undef BAR
#undef SCHED
}

template <int LD, bool NORM>
__device__ __forceinline__ void ep_store(u16* __restrict__ dst, u32 ob, const f32x4 (&acc)[2][2][4][2], const float* __restrict__ gain,
                                         float extra, unsigned char* smem, int wave, int lane_in) {
  int lane = lane_in;
  asm volatile("" : "+v"(lane));
  const int fr = lane & 15, fq = lane >> 4;
  unsigned char* reg = smem + wave * 16384;
  float gj[4] = {1.f, 1.f, 1.f, 1.f};
  if (NORM) {
#pragma unroll
    for (int j = 0; j < 4; ++j) gj[j] = gain[j * 16 + fr] * extra;
  }
  const int lrot = (fr >> 3) + 2 * fq;
  unsigned char* wbase = reg + (4 * fq) * 128 + (fr & 7) * 2;
#pragma unroll
  for (int ai = 0; ai < 2; ++ai)
#pragma unroll
    for (int m = 0; m < 4; ++m) {
#pragma unroll
      for (int r = 0; r < 4; ++r) {
        float rs = 1.f;
        if (NORM) {
          float sq = 0.f;
#pragma unroll
          for (int bj = 0; bj < 2; ++bj)
#pragma unroll
            for (int n = 0; n < 2; ++n) sq += acc[ai][bj][m][n][r] * acc[ai][bj][m][n][r];
          sq += DPPF(sq, 0xb1); sq += DPPF(sq, 0x4e); sq += DPPF(sq, 0x141); sq += DPPF(sq, 0x140);
          rs = rsqrtf(sq * (1.f / 64.f) + EPS);
        }
#pragma unroll
        for (int bj = 0; bj < 2; ++bj)
#pragma unroll
          for (int n = 0; n < 2; ++n) {
            const float v = acc[ai][bj][m][n][r];
            const int ch = ((bj * 2 + n) * 2 + lrot) & 7;
            *(u16*)(wbase + (ai * 64 + m * 16 + r) * 128 + (ch << 4)) = f2bf(NORM ? v * rs * gj[bj * 2 + n] : v);
          }
      }
      __builtin_amdgcn_sched_barrier(0);
    }
  WAVE_LDS_SYNC();
  const int c16 = lane & 7, r8 = lane >> 3;
#pragma unroll
  for (int it = 0; it < 16; ++it) {
    const int rw = it * 8 + r8;
    const u32x4 v = *(const u32x4*)(reg + rw * 128 + (((c16 + 2 * ((rw >> 2) & 3)) & 7) << 4));
    const int grow = (it >> 3) * 128 + (it & 7) * 8 + r8;
    *(u32x4*)(dst + ob + (u32)(grow * LD + c16 * 8)) = v;
    if ((it & 3) == 3) __builtin_amdgcn_sched_barrier(0);
  }
}

template <bool NORM>
__device__ __forceinline__ void ep_store8(unsigned char* __restrict__ dst, u32 ob, const f32x4 (&acc)[2][2][4][2],
                                          const float* __restrict__ gain, unsigned char* smem, int wave, int lane_in) {
  int lane = lane_in;
  asm volatile("" : "+v"(lane));
  const int fr = lane & 15, fq = lane >> 4;
  unsigned char* reg = smem + wave * 16384;
  float gj[4] = {1.f, 1.f, 1.f, 1.f};
  if (NORM) {
#pragma unroll
    for (int j = 0; j < 4; ++j) gj[j] = gain[j * 16 + fr];
  }
#pragma unroll
  for (int ai = 0; ai < 2; ++ai)
#pragma unroll
    for (int m = 0; m < 4; ++m) {
#pragma unroll
      for (int r = 0; r < 4; ++r) {
        float rs = 1.f;
        if (NORM) {
          float sq = 0.f;
#pragma unroll
          for (int bj = 0; bj < 2; ++bj)
#pragma unroll
            for (int n = 0; n < 2; ++n) sq += acc[ai][bj][m][n][r] * acc[ai][bj][m][n][r];
          sq += DPPF(sq, 0xb1); sq += DPPF(sq, 0x4e); sq += DPPF(sq, 0x141); sq += DPPF(sq, 0x140);
          rs = rsqrtf(sq * (1.f / 64.f) + EPS);
        }
        const int rw = ai * 64 + m * 16 + 4 * fq + r;
#pragma unroll
        for (int bj = 0; bj < 2; ++bj)
#pragma unroll
          for (int n = 0; n < 2; ++n) {
            const float v = NORM ? acc[ai][bj][m][n][r] * rs * gj[bj * 2 + n] : acc[ai][bj][m][n][r];
            reg[rw * 64 + ((((bj * 2 + n) + (rw >> 2)) & 3) << 4) + fr] =
                (unsigned char)(__builtin_amdgcn_cvt_pk_fp8_f32(v, v, 0, false) & 0xff);
          }
      }
      __builtin_amdgcn_sched_barrier(0);
    }
  WAVE_LDS_SYNC();
  const int c4 = lane & 3, r16 = lane >> 2;
#pragma unroll
  for (int it = 0; it < 8; ++it) {
    const int rw = it * 16 + r16;
    const u32x4 v = *(const u32x4*)(reg + rw * 64 + (((c4 + (rw >> 2)) & 3) << 4));
    const int grow = (rw >> 6) * 128 + (rw & 63);
    *(u32x4*)(dst + ob + (u32)(grow * 256 + c4 * 16)) = v;
  }
}

__device__ __forceinline__ void phase1(const Params& p, unsigned char* smem) {
  const u16* H = (const u16*)(p.ws + OFF_H);
  const u16* WT = (const u16*)(p.ws + OFF_WTIN);
  u16* PROJ = (u16*)(p.ws + OFF_PROJ);
  u16* KVC = (u16*)(p.ws + OFF_KVC);
  u16* IKC = (u16*)(p.ws + OFF_IKC);
  float* SMALL = (float*)(p.ws + OFF_SMALL);
  const int ntn = NPADW / 256;
  const int ntiles = (MTOK / 256) * ntn;
  for (int t = blockIdx.x; t < ntiles; t += gridDim.x) {
    const int m0 = (t / ntn) * 256, n0 = (t % ntn) * 256;
    f32x4 acc[2][2][4][2];
    gemm8_tile<1, 124>(H, WT, DM / 2, m0, n0, smem, acc);
    const int tid_e = TIDX, lane = tid_e & 63, wave = tid_e >> 6;
    const int wr = wave >> 2, wc = wave & 3, fr = lane & 15, fq = lane >> 4;
    const int cbase = n0 + wc * 64;
    const u32 rbase = (u32)(m0 + wr * 64);
    if (cbase < C_IQ) {
      ep_store<LDP, true>(PROJ, rbase * LDP + (u32)cbase, acc, p.in[3], 0.125f, smem, wave, lane);
    } else if (cbase < LDP) {
      ep_store<LDP, false>(PROJ, rbase * LDP + (u32)cbase, acc, nullptr, 1.f, smem, wave, lane);
    } else if (cbase < N_AV) {
      ep_store8<true>(p.ws + OFF_KVC, rbase * 256 + (u32)(cbase - N_AK), acc, p.in[4], smem, wave, lane);
    } else if (cbase < N_IK) {
      ep_store8<false>(p.ws + OFF_KVC, rbase * 256 + (u32)(cbase - N_AV + 128), acc, nullptr, smem, wave, lane);
    } else if (cbase < N_SM) {
      ep_store<64, false>(IKC, rbase * 64, acc, nullptr, 1.f, smem, wave, lane);
    } else if (cbase == N_SM) {
      const u32 sb0 = (rbase + 4 * fq) * 16 + (u32)fr;
#pragma unroll
      for (int ai = 0; ai < 2; ++ai)
#pragma unroll
        for (int m = 0; m < 4; ++m)
#pragma unroll
          for (int r = 0; r < 4; ++r) SMALL[sb0 + (u32)((ai * 128 + m * 16 + r) * 16)] = acc[ai][0][m][0][r];
    }
  }
}

constexpr int IDX_RS = 8208;

__device__ __forceinline__ u32 f2key(float x) {
  _Float16 h = (_Float16)x;
  u32 b = (u32) * (u16*)&h;
  return (b & 0x8000u) ? ((~b) & 0xffffu) : (b | 0x8000u);
}
__device__ __forceinline__ int count_ge_wave(const u32 (&kreg)[32], u32 mid, int ndw) {
  const u32 m1 = (mid - 1u) * 0x00010001u;
  const u32 one = 0x00010001u;
  u32 acc0 = 0u, acc1 = 0u;
#pragma unroll
  for (int c4 = 0; c4 < 8; ++c4) {
    if (c4 * 4 < ndw) {
#pragma unroll
      for (int i = c4 * 4; i < c4 * 4 + 4; i += 2) {
        u32 t0, t1;
        asm("v_pk_sub_u16 %0, %1, %2 clamp" : "=v"(t0) : "v"(kreg[i]), "s"(m1));
        asm("v_pk_sub_u16 %0, %1, %2 clamp" : "=v"(t1) : "v"(kreg[i + 1]), "s"(m1));
        asm("v_pk_min_u16 %0, %1, %2" : "=v"(t0) : "v"(t0), "s"(one));
        asm("v_pk_min_u16 %0, %1, %2" : "=v"(t1) : "v"(t1), "s"(one));
        asm("v_pk_add_u16 %0, %1, %2" : "=v"(acc0) : "v"(acc0), "v"(t0));
        asm("v_pk_add_u16 %0, %1, %2" : "=v"(acc1) : "v"(acc1), "v"(t1));
      }
    }
  }
  int c = (int)((acc0 & 0xffffu) + (acc0 >> 16) + (acc1 & 0xffffu) + (acc1 >> 16));
  return wave_sum_i_dpp(c);
}

__device__ __forceinline__ void idx_item(const Params& p, unsigned char* smem, int b, int tq) {
  const u16* PROJ = (const u16*)(p.ws + OFF_PROJ);
  const float* SMALL = (const float*)(p.ws + OFF_SMALL);
  u16* SEL = (u16*)(p.ws + OFF_SEL);
  const int tid = TIDX, lane = tid & 63, wave = tid >> 6;
  const int t0 = tq * 16;
  const size_t tokb = (size_t)b * SEQ;
  if (tq < 16) {
    for (int rr = 0; rr < 2; ++rr) {
      int row = 2 * wave + rr, t = t0 + row;
      u16* out = SEL + (tokb + t) * 256;
      for (int i = lane; i < 256; i += 64) out[i] = (i <= t) ? (u16)i : (u16)0xFFFF;
    }
    return;
  }
  const int q = lane & 15, g = lane >> 4;
  __syncthreads();
  {
    const u16* iqrow = PROJ + (tokb + t0 + q) * LDP + C_IQ;
    bf16x8 bq[8][2];
    float wq[8];
#pragma unroll
    for (int h = 0; h < 8; ++h) {
      bq[h][0] = *(const bf16x8*)(iqrow + h * 64 + g * 8);
      bq[h][1] = *(const bf16x8*)(iqrow + h * 64 + 32 + g * 8);
      wq[h] = SMALL[(tokb + t0 + q) * 16 + h];
    }
    const int nkb = tq + 1;
    const int niter = (nkb > wave) ? ((nkb - wave + 7) >> 3) : 0;
    const u16* ikbase = (const u16*)(p.ws + OFF_IKC) + (tokb + q) * 64 + g * 8;
    bf16x8 ca[3][2];
#pragma unroll
    for (int j = 0; j < 3; ++j)
      if (j < niter) {
        const u16* ikrow = ikbase + (size_t)((wave + 8 * j) * 16) * 64;
        ca[j][0] = *(const bf16x8*)(ikrow); ca[j][1] = *(const bf16x8*)(ikrow + 32);
      }
    for (int i0 = 0; i0 < ((p.flags & 8) ? 0 : niter); i0 += 3) {
#pragma unroll
      for (int j = 0; j < 3; ++j) {
        if (i0 + j < niter) {
          const int s0 = (wave + 8 * (i0 + j)) * 16;
          f32x4 tot = {0.f, 0.f, 0.f, 0.f};
#pragma unroll
          for (int h = 0; h < 8; ++h) {
            f32x4 acc = {0.f, 0.f, 0.f, 0.f};
            acc = __builtin_amdgcn_mfma_f32_16x16x32_bf16(ca[j][0], bq[h][0], acc, 0, 0, 0);
            acc = __builtin_amdgcn_mfma_f32_16x16x32_bf16(ca[j][1], bq[h][1], acc, 0, 0, 0);
#pragma unroll
            for (int r = 0; r < 4; ++r) tot[r] += wq[h] * fmaxf(acc[r], 0.f);
          }
          if (i0 + 3 + j < niter) {
            const u16* ikrow = ikbase + (size_t)((wave + 8 * (i0 + 3 + j)) * 16) * 64;
            ca[j][0] = *(const bf16x8*)(ikrow); ca[j][1] = *(const bf16x8*)(ikrow + 32);
          }
          u32 k[4];
#pragma unroll
          for (int r = 0; r < 4; ++r) {
            int sidx = s0 + 4 * g + r;
            k[r] = (sidx <= t0 + q) ? f2key(tot[r]) : 0u;
          }
          u32x2 w2 = {k[0] | (k[1] << 16), k[2] | (k[3] << 16)};
          *(u32x2*)(smem + q * IDX_RS + (s0 + 4 * g) * 2) = w2;
        }
        __builtin_amdgcn_sched_barrier(0);
      }
    }
    const int nk = t0 + 16, nk64 = (nk + 511) & ~511;
    for (int i = tid; i < 16 * (nk64 - nk); i += NTHREADS) {
      int row = i / (nk64 - nk), c = nk + i % (nk64 - nk);
      *(u16*)(smem + row * IDX_RS + c * 2) = 0;
    }
  }
  __syncthreads();
  const int ndw = ((t0 + 16 + 511) >> 9) << 2;
  for (int rr = 0; rr < ((p.flags & 16) ? 0 : 2); ++rr) {
    const int row = 2 * wave + rr, t = t0 + row;
    u16* out = SEL + (tokb + t) * 256;
    u32 kreg[32];
    {
      const u32* src = (const u32*)(smem + row * IDX_RS) + lane;
#pragma unroll
      for (int c4 = 0; c4 < 8; ++c4)
        if (c4 * 4 < ndw) {
#pragma unroll
          for (int i = c4 * 4; i < c4 * 4 + 4; ++i) kreg[i] = src[i * 64];
        }
    }
    WAVE_LDS_SYNC();
    u32 lo = 1u, hi = 65535u;
    while (lo < hi) {
      u32 mid = (lo + hi + 1u) >> 1;
      int c = count_ge_wave(kreg, mid, ndw);
      if (c >= 256) lo = mid; else hi = mid - 1u;
    }
    const u32 tau = lo;
    int gt = 0, eq = 0;
#pragma unroll
    for (int c4 = 0; c4 < 8; ++c4)
      if (c4 * 4 < ndw) {
#pragma unroll
        for (int i = c4 * 4; i < c4 * 4 + 4; ++i) {
          u32 a = kreg[i] & 0xffffu, c2 = kreg[i] >> 16;
          gt += (a > tau) ? 1 : 0; gt += (c2 > tau) ? 1 : 0;
          eq += (a == tau) ? 1 : 0; eq += (c2 == tau) ? 1 : 0;
        }
      }
    int packed = gt | (eq << 16);
    int incl = packed;
#pragma unroll
    for (int o = 1; o < 64; o <<= 1) {
      int v = __shfl_up(incl, o);
      if (lane >= o) incl += v;
    }
    const int excl = incl - packed;
    const int total = __shfl(incl, 63);
    const int need = 256 - (total & 0xffff);
    const int pg = excl & 0xffff, pe = excl >> 16;
    int pos = pg + min(pe, need);
    int eqseen = pe;
    u16* lrow = (u16*)(smem + row * IDX_RS);
#pragma unroll
    for (int c4 = 0; c4 < 8; ++c4)
      if (c4 * 4 < ndw) {
#pragma unroll
        for (int i = c4 * 4; i < c4 * 4 + 4; ++i) {
#pragma unroll
          for (int hh = 0; hh < 2; ++hh) {
            u32 kv = hh ? (kreg[i] >> 16) : (kreg[i] & 0xffffu);
            int idx = 128 * i + 2 * lane + hh;
            bool take = false;
            if (kv > tau) take = true;
            else if (kv == tau) { take = (eqseen < need); ++eqseen; }
            if (take) { lrow[pos] = (u16)idx; ++pos; }
          }
        }
      }
    WAVE_LDS_SYNC();
    *(u32x2*)(out + lane * 4) = *(const u32x2*)(lrow + lane * 4);
    WAVE_LDS_SYNC();
  }
}

constexpr int DNP = 68;
constexpr int DL_KT = 0;
constexpr int DL_V = DL_KT + 128 * DNP * 4;
constexpr int DL_QB = DL_V + 64 * 128 * 4;
constexpr int DL_KB = DL_QB + 64 * 272;
constexpr int DL_SM = DL_KB + 64 * 272;
constexpr int DL_RAW = DL_SM + 2048;
static_assert(DL_RAW + 3 * 67 * 272 <= SMEM_BYTES && 16384 + 64 * 144 + 2048 <= 3 * 67 * 272, "dn_local LDS");
__device__ __forceinline__ void dn_local_item(const Params& p, unsigned char* smem, int item) {
  const int h = item & 3, n = (item >> 2) & 63, b = item >> 8;
  const u16* PROJ = (const u16*)(p.ws + OFF_PROJ);
  const float* SMALL = (const float*)(p.ws + OFF_SMALL);
  u16* Ug = (u16*)((unsigned char*)p.out + DO_U);
  u16* Wg = (u16*)((unsigned char*)p.out + DO_W);
  u16* QNg = (u16*)((unsigned char*)p.out + DO_QN);
  u16* KNTg = (u16*)((unsigned char*)p.out + DO_KNT);
  u16* ATTg = (u16*)(p.ws + OFF_ATT);
  float* GCg = (float*)(p.ws + OFF_GC);
  const float* convw = p.in[5];
  const int tid = TIDX, lane = tid & 63, wave = tid >> 6;
  const int c0 = n * 64;
  const size_t tok0 = (size_t)b * SEQ + c0;
  float* Kt = (float*)(smem + DL_KT);
  float* V = (float*)(smem + DL_V);
  unsigned char* Qb = smem + DL_QB;
  unsigned char* Kb = smem + DL_KB;
  float* gc = (float*)(smem + DL_SM);
  float* beta = gc + 64;
  float* ssp = beta + 64;
  unsigned char* RAW = smem + DL_RAW;
  float* AmT = (float*)(smem + DL_RAW);
  __syncthreads();
  {
    u32x4 rg[7];
#pragma unroll
    for (int k = 0; k < 7; ++k) {
      const int ci = tid + 512 * k;
      rg[k] = (u32x4){0u, 0u, 0u, 0u};
      if (ci < 3216) {
        const int arr = ci / 1072, rem = ci - arr * 1072, row = rem >> 4, ch = rem & 15;
        const int trel = c0 - 3 + row;
        if (trel >= 0)
          rg[k] = *(const u32x4*)(PROJ + ((size_t)b * SEQ + trel) * LDP + (C_DQ + arr * 512) + h * 128 + ch * 8);
      }
    }
#pragma unroll
    for (int k = 0; k < 7; ++k) {
      const int ci = tid + 512 * k;
      if (ci < 3216) {
        const int arr = ci / 1072, rem = ci - arr * 1072, row = rem >> 4, ch = rem & 15;
        *(u32x4*)(RAW + (arr * 67 + row) * 272 + ch * 16) = rg[k];
      }
    }
  }
  if (tid < 64) {
    float da = SMALL[(tok0 + tid) * 16 + 8 + h], db = SMALL[(tok0 + tid) * 16 + 12 + h];
    float xx = da + p.in[7][h];
    float sp = fmaxf(xx, 0.f) + log1pf(__expf(-fabsf(xx)));
    float gr = -__expf(p.in[6][h]) * sp;
    float incl = gr;
#pragma unroll
    for (int o = 1; o < 64; o <<= 1) {
      float v = __shfl_up(incl, o);
      if (lane >= o) incl += v;
    }
    gc[tid] = incl;
    beta[tid] = sigmoidf_(db);
    GCg[(tok0 + tid) * 4 + h] = incl;
  }
  __syncthreads();
  {
    const int c = tid & 127, tg = tid >> 7;
    float qv[16], kv[16];
#pragma unroll
    for (int arr = 0; arr < 3; ++arr) {
      const float w0 = convw[0 * 1536 + arr * 512 + h * 128 + c], w1 = convw[1 * 1536 + arr * 512 + h * 128 + c],
                  w2 = convw[2 * 1536 + arr * 512 + h * 128 + c], w3 = convw[3 * 1536 + arr * 512 + h * 128 + c];
      const unsigned char* rp = RAW + (arr * 67 + tg * 16) * 272 + c * 2;
      float x0 = bf2f(*(const u16*)(rp)), x1 = bf2f(*(const u16*)(rp + 272)), x2 = bf2f(*(const u16*)(rp + 2 * 272));
#pragma unroll
      for (int ii = 0; ii < 16; ++ii) {
        const float x3 = bf2f(*(const u16*)(rp + (ii + 3) * 272));
        const float y = w0 * x0 + w1 * x1 + w2 * x2 + w3 * x3;
        const float sv = y * sigmoidf_(y);
        if (arr == 0) qv[ii] = sv;
        else if (arr == 1) kv[ii] = sv;
        else V[(tg * 16 + ii) * 128 + c] = sv;
        x0 = x1; x1 = x2; x2 = x3;
      }
    }
#pragma unroll
    for (int ii = 0; ii < 16; ++ii) {
      const float sq = wave_sum_dpp(qv[ii] * qv[ii]);
      const float sk = wave_sum_dpp(kv[ii] * kv[ii]);
      if (lane == 0) {
        ssp[((tg * 16 + ii) * 2) + (wave & 1)] = sq;
        ssp[128 + ((tg * 16 + ii) * 2) + (wave & 1)] = sk;
      }
    }
    __syncthreads();
#pragma unroll
    for (int ii = 0; ii < 16; ++ii) {
      const int i = tg * 16 + ii;
      const float qsc = rsqrtf(ssp[i * 2] + ssp[i * 2 + 1] + EPS) * 0.08838834764831845f;
      const float ksc = rsqrtf(ssp[128 + i * 2] + ssp[128 + i * 2 + 1] + EPS);
      const float qn = qv[ii] * qsc, kn = kv[ii] * ksc;
      *(u16*)(Qb + i * 272 + c * 2) = f2bf(qn);
      *(u16*)(Kb + i * 272 + c * 2) = f2bf(kn);
      Kt[c * DNP + i] = kn;
    }
  }
  __syncthreads();
#pragma unroll
  for (int k = 0; k < 4; ++k) {
    const int gi = tid + 512 * k;
    {
      const int i = gi >> 5, d4 = (gi & 31) * 4;
      const u32x2 v = *(const u32x2*)(Qb + i * 272 + d4 * 2);
      *(u32x2*)(QNg + (tok0 + i) * 512 + h * 128 + perm32(d4)) = v;
    }
    {
      const int d = gi >> 4, t4 = (gi & 15) * 4;
      const f32x4 v = *(const f32x4*)(Kt + d * DNP + t4);
      u32x2 o = {pack2(v[0], v[1]), pack2(v[2], v[3])};
      *(u32x2*)(KNTg + (size_t)item * 8192 + d * 64 + perm32(t4)) = o;
    }
  }
  {
    const int mat = wave >> 2, it = wave & 3;
    const int fr = lane & 15, fg = lane >> 4;
    const unsigned char* Ab = mat ? Qb : Kb;
    bf16x8 af[4];
#pragma unroll
    for (int kk = 0; kk < 4; ++kk) af[kk] = *(const bf16x8*)(Ab + (it * 16 + fr) * 272 + kk * 64 + fg * 16);
    f32x4 gi4 = *(const f32x4*)(gc + it * 16 + 4 * fg);
    f32x4 bi4 = *(const f32x4*)(beta + it * 16 + 4 * fg);
#pragma unroll
    for (int jt = 0; jt < 4; ++jt) {
      f32x4 acc = {0.f, 0.f, 0.f, 0.f};
      if (jt <= it) {
#pragma unroll
        for (int kk = 0; kk < 4; ++kk) {
          bf16x8 bfg = *(const bf16x8*)(Kb + (jt * 16 + fr) * 272 + kk * 64 + fg * 16);
          acc = __builtin_amdgcn_mfma_f32_16x16x32_bf16(af[kk], bfg, acc, 0, 0, 0);
        }
      }
      const int j = jt * 16 + fr;
      const float gj = gc[j];
#pragma unroll
      for (int r = 0; r < 4; ++r) {
        const int i = it * 16 + 4 * fg + r;
        const float dec = __expf(fminf(gi4[r] - gj, 0.f));
        if (mat == 0) { if (jt <= it) AmT[j * 64 + i] = (i > j) ? bi4[r] * acc[r] * dec : 0.f; }
        else ATTg[(size_t)item * 4096 + i * 64 + perm32(j)] = f2bf((i >= j) ? acc[r] * dec : 0.f);
      }
    }
  }
  __syncthreads();
  u16* nA = (u16*)(smem + DL_RAW + 16384);
  u16* Nb = (u16*)(smem + DL_RAW + 16384 + 64 * 144);
  {
#pragma unroll
    for (int k = 0; k < 8; ++k) {
      const int e = tid + 512 * k;
      const int i = e >> 6, j = e & 63;
      const float v = ((j >> 4) < (i >> 4)) ? -AmT[j * 64 + i] : 0.f;
      nA[i * 72 + j] = f2bf(v);
    }
    if (tid < 64) {
      const int bb = tid >> 4, j = tid & 15;
      float nn[16];
#pragma unroll
      for (int i = 0; i < 16; ++i) {
        float sacc = 0.f;
#pragma unroll
        for (int k = 0; k < i; ++k) sacc += AmT[(bb * 16 + k) * 64 + bb * 16 + i] * nn[k];
        nn[i] = (i == j) ? 1.f : ((i > j) ? -sacc : 0.f);
      }
#pragma unroll
      for (int i = 0; i < 16; ++i) Nb[bb * 256 + i * 16 + j] = f2bf(nn[i]);
    }
  }
  __syncthreads();
  {
    const int fr = lane & 15, fg = lane >> 4;
    f32x4 X[2][4];
#pragma unroll
    for (int ct2 = 0; ct2 < 2; ++ct2) {
      const int c = (wave * 2 + ct2) * 16 + fr;
      const bool isu = c < 128;
      const int cc = c & 127;
#pragma unroll
      for (int bb = 0; bb < 4; ++bb) {
        f32x4 acc;
#pragma unroll
        for (int r = 0; r < 4; ++r) {
          const int i = bb * 16 + 4 * fg + r;
          acc[r] = isu ? V[i * 128 + cc] * beta[i] : Kt[cc * DNP + i] * beta[i] * __expf(gc[i]);
        }
        if (bb >= 1) {
          union { u32 w[4]; bf16x8 v; } af, bf;
          const u32x2 a0 = *(const u32x2*)(nA + (bb * 16 + fr) * 72 + 4 * fg);
          af.w[0] = a0[0]; af.w[1] = a0[1];
          bf.w[0] = pack2(X[ct2][0][0], X[ct2][0][1]); bf.w[1] = pack2(X[ct2][0][2], X[ct2][0][3]);
          if (bb >= 2) {
            const u32x2 a1 = *(const u32x2*)(nA + (bb * 16 + fr) * 72 + 16 + 4 * fg);
            af.w[2] = a1[0]; af.w[3] = a1[1];
            bf.w[2] = pack2(X[ct2][1][0], X[ct2][1][1]); bf.w[3] = pack2(X[ct2][1][2], X[ct2][1][3]);
          } else { af.w[2] = 0u; af.w[3] = 0u; bf.w[2] = 0u; bf.w[3] = 0u; }
          acc = __builtin_amdgcn_mfma_f32_16x16x32_bf16(af.v, bf.v, acc, 0, 0, 0);
          if (bb == 3) {
            const u32x2 a2 = *(const u32x2*)(nA + (bb * 16 + fr) * 72 + 32 + 4 * fg);
            af.w[0] = a2[0]; af.w[1] = a2[1]; af.w[2] = 0u; af.w[3] = 0u;
            bf.w[0] = pack2(X[ct2][2][0], X[ct2][2][1]); bf.w[1] = pack2(X[ct2][2][2], X[ct2][2][3]); bf.w[2] = 0u; bf.w[3] = 0u;
            acc = __builtin_amdgcn_mfma_f32_16x16x32_bf16(af.v, bf.v, acc, 0, 0, 0);
          }
        }
        {
          union { u32 w[4]; bf16x8 v; } af, bf;
          const u32x2 d0 = *(const u32x2*)(Nb + bb * 256 + fr * 16 + 4 * fg);
          af.w[0] = d0[0]; af.w[1] = d0[1]; af.w[2] = 0u; af.w[3] = 0u;
          bf.w[0] = pack2(acc[0], acc[1]); bf.w[1] = pack2(acc[2], acc[3]); bf.w[2] = 0u; bf.w[3] = 0u;
          const f32x4 z4 = {0.f, 0.f, 0.f, 0.f};
          X[ct2][bb] = __builtin_amdgcn_mfma_f32_16x16x32_bf16(af.v, bf.v, z4, 0, 0, 0);
        }
#pragma unroll
        for (int r = 0; r < 4; ++r) {
          const int i = bb * 16 + 4 * fg + r;
          if (isu) Ug[(tok0 + i) * 512 + h * 128 + cc] = f2bf(X[ct2][bb][r]);
          else Wg[(tok0 + i) * 512 + h * 128 + perm32(cc)] = f2bf(X[ct2][bb][r]);
        }
      }
    }
  }
}

__device__ __forceinline__ void phase2(const Params& p, unsigned char* smem) {
#ifndef NO_IDX
  for (int i = blockIdx.x; i < 2048; i += gridDim.x) {
    const int k = i >> 8, j = i & 255, r = j >> 3;
    idx_item(p, smem, j & 7, 255 - 32 * k - ((k & 1) ? 31 - r : r));
  }
#endif
#ifndef NO_DNL
  if (!(p.flags & 1))
    for (int i = blockIdx.x; i < 2048; i += gridDim.x) dn_local_item(p, smem, i);
#endif
}

constexpr int SC_WP = 272, SC_KP = 144;
constexpr int SC_W = 0, SC_Q = 64 * SC_WP, SC_KT = 2 * 64 * SC_WP, SC_AT = SC_KT + 128 * SC_KP, SC_U = SC_AT + 64 * SC_KP,
              SC_BUF = SC_U + 64 * SC_WP;
constexpr int SC_GC = 2 * SC_BUF;
static_assert(SC_GC + 2 * 64 * 4 <= SMEM_BYTES, "scan LDS");

__device__ __forceinline__ void dn_scan_item(const Params& p, unsigned char* smem, int bh) {
  const int h = bh & 3, b = bh >> 2;
  const u16* Ug = (const u16*)((const unsigned char*)p.out + DO_U);
  const u16* Wg = (const u16*)((const unsigned char*)p.out + DO_W);
  const u16* QNg = (const u16*)((const unsigned char*)p.out + DO_QN);
  const u16* KNTg = (const u16*)((const unsigned char*)p.out + DO_KNT);
  const u16* ATTg = (const u16*)(p.ws + OFF_ATT);
  const float* GCg = (const float*)(p.ws + OFF_GC);
  const u16* PROJ = (const u16*)(p.ws + OFF_PROJ);
  u16* YDN = (u16*)(p.ws + OFF_YDN);
  const float* ogain = p.in[8];
  const int tid = TIDX, lane = tid & 63, wave = tid >> 6;
  const int fr = lane & 15, fg = lane >> 4;
  const int ecol = wave * 16 + fr;
  float* gcs = (float*)(smem + SC_GC);
  f32x4 S[8];
#pragma unroll
  for (int d = 0; d < 8; ++d) S[d] = (f32x4){0.f, 0.f, 0.f, 0.f};
  u32x4 st[9];
  float gcr = 0.f;
  const int r16 = tid >> 4, c16 = tid & 15;
  const int r8 = tid >> 3, c8 = tid & 7;
#define SCAN_LOAD(n_)                                                                                      \
  {                                                                                                        \
    const size_t tk0 = (size_t)b * SEQ + (size_t)(n_) * 64;                                                \
    const size_t it_ = (size_t)((b * 64 + (n_)) * 4 + h);                                                  \
    st[0] = *(const u32x4*)(Wg + (tk0 + r16) * 512 + h * 128 + c16 * 8);                                   \
    st[1] = *(const u32x4*)(Wg + (tk0 + r16 + 32) * 512 + h * 128 + c16 * 8);                              \
    st[2] = *(const u32x4*)(QNg + (tk0 + r16) * 512 + h * 128 + c16 * 8);                                  \
    st[3] = *(const u32x4*)(QNg + (tk0 + r16 + 32) * 512 + h * 128 + c16 * 8);                             \
    st[4] = *(const u32x4*)(KNTg + it_ * 8192 + (size_t)tid * 8);                                          \
    st[5] = *(const u32x4*)(KNTg + it_ * 8192 + (size_t)(tid + 512) * 8);                                  \
    st[6] = *(const u32x4*)(ATTg + it_ * 4096 + (size_t)tid * 8);                                          \
    st[7] = *(const u32x4*)(Ug + (tk0 + r16) * 512 + h * 128 + c16 * 8);                                   \
    st[8] = *(const u32x4*)(Ug + (tk0 + r16 + 32) * 512 + h * 128 + c16 * 8);                              \
    if (tid < 64) gcr = GCg[(tk0 + tid) * 4 + h];                                                          \
  }
#define SCAN_STORE(buf_)                                                                                   \
  {                                                                                                        \
    unsigned char* bs_ = smem + (buf_) * SC_BUF;                                                           \
    *(u32x4*)(bs_ + SC_W + r16 * SC_WP + c16 * 16) = st[0];                                                \
    *(u32x4*)(bs_ + SC_W + (r16 + 32) * SC_WP + c16 * 16) = st[1];                                         \
    *(u32x4*)(bs_ + SC_Q + r16 * SC_WP + c16 * 16) = st[2];                                                \
    *(u32x4*)(bs_ + SC_Q + (r16 + 32) * SC_WP + c16 * 16) = st[3];                                         \
    *(u32x4*)(bs_ + SC_KT + r8 * SC_KP + c8 * 16) = st[4];                                                 \
    *(u32x4*)(bs_ + SC_KT + (r8 + 64) * SC_KP + c8 * 16) = st[5];                                          \
    *(u32x4*)(bs_ + SC_AT + r8 * SC_KP + c8 * 16) = st[6];                                                 \
    *(u32x4*)(bs_ + SC_U + r16 * SC_WP + c16 * 16) = st[7];                                                \
    *(u32x4*)(bs_ + SC_U + (r16 + 32) * SC_WP + c16 * 16) = st[8];                                         \
    if (tid < 64) gcs[(buf_) * 64 + tid] = gcr;                                                            \
  }
  __syncthreads();
  SCAN_LOAD(0)
  SCAN_STORE(0)
  if (1 < 64) SCAN_LOAD(1)
  __syncthreads();
  for (int n = 0; n < 64; ++n) {
    const int buf = n & 1;
    const size_t tok0 = (size_t)b * SEQ + n * 64;
    if (n + 1 < 64) SCAN_STORE(buf ^ 1)
    if (n + 2 < 64) SCAN_LOAD(n + 2)
    __builtin_amdgcn_sched_barrier(0);
    const unsigned char* base = smem + buf * SC_BUF;
    const u32 ub0 = (u32)(tok0 + 4 * fg) * 512 + (u32)(h * 128 + ecol);
    const float* gcb = gcs + buf * 64 + 4 * fg;
    const float glast = gcs[buf * 64 + 63];
    bf16x8 Sb[4];
#pragma unroll
    for (int kk = 0; kk < 4; ++kk) {
      union { u32 w[4]; bf16x8 v; } cv;
      cv.w[0] = pack2(S[2 * kk][0], S[2 * kk][1]); cv.w[1] = pack2(S[2 * kk][2], S[2 * kk][3]);
      cv.w[2] = pack2(S[2 * kk + 1][0], S[2 * kk + 1][1]); cv.w[3] = pack2(S[2 * kk + 1][2], S[2 * kk + 1][3]);
      Sb[kk] = cv.v;
    }
    f32x4 vnew[4], ov[4];
#pragma unroll
    for (int m = 0; m < 4; ++m) {
      f32x4 aw = {0.f, 0.f, 0.f, 0.f}, aq = {0.f, 0.f, 0.f, 0.f};
#pragma unroll
      for (int kk = 0; kk < 4; ++kk) {
        bf16x8 wf = *(const bf16x8*)(base + SC_W + (m * 16 + fr) * SC_WP + kk * 64 + fg * 16);
        bf16x8 qf = *(const bf16x8*)(base + SC_Q + (m * 16 + fr) * SC_WP + kk * 64 + fg * 16);
        aw = __builtin_amdgcn_mfma_f32_16x16x32_bf16(wf, Sb[kk], aw, 0, 0, 0);
        aq = __builtin_amdgcn_mfma_f32_16x16x32_bf16(qf, Sb[kk], aq, 0, 0, 0);
      }
      f32x4 g4 = *(const f32x4*)(gcb + m * 16);
#pragma unroll
      for (int r = 0; r < 4; ++r) {
        float uv = bf2f(*(const u16*)(base + SC_U + (m * 16 + 4 * fg + r) * SC_WP + ecol * 2));
        vnew[m][r] = uv - aw[r];
        ov[m][r] = aq[r] * __expf(g4[r]);
      }
    }
    bf16x8 vb[2], vsb[2];
#pragma unroll
    for (int k2 = 0; k2 < 2; ++k2) {
      union { u32 w[4]; bf16x8 v; } c1, c2;
      const int ma = 2 * k2, mb = 2 * k2 + 1;
      c1.w[0] = pack2(vnew[ma][0], vnew[ma][1]); c1.w[1] = pack2(vnew[ma][2], vnew[ma][3]);
      c1.w[2] = pack2(vnew[mb][0], vnew[mb][1]); c1.w[3] = pack2(vnew[mb][2], vnew[mb][3]);
      f32x4 ga4 = *(const f32x4*)(gcb + ma * 16), gb4 = *(const f32x4*)(gcb + mb * 16);
      float sa[4], sb2[4];
#pragma unroll
      for (int r = 0; r < 4; ++r) { sa[r] = vnew[ma][r] * __expf(glast - ga4[r]); sb2[r] = vnew[mb][r] * __expf(glast - gb4[r]); }
      c2.w[0] = pack2(sa[0], sa[1]); c2.w[1] = pack2(sa[2], sa[3]);
      c2.w[2] = pack2(sb2[0], sb2[1]); c2.w[3] = pack2(sb2[2], sb2[3]);
      vb[k2] = c1.v; vsb[k2] = c2.v;
    }
    const float egl = __expf(glast);
#pragma unroll
    for (int d = 0; d < 8; ++d) {
      f32x4 a = S[d] * egl;
#pragma unroll
      for (int k2 = 0; k2 < 2; ++k2) {
        bf16x8 kf = *(const bf16x8*)(base + SC_KT + (d * 16 + fr) * SC_KP + k2 * 64 + fg * 16);
        a = __builtin_amdgcn_mfma_f32_16x16x32_bf16(kf, vsb[k2], a, 0, 0, 0);
      }
      S[d] = a;
    }
#pragma unroll
    for (int m = 0; m < 4; ++m) {
      f32x4 ao = ov[m];
#pragma unroll
      for (int k2 = 0; k2 < 2; ++k2) {
        bf16x8 af = *(const bf16x8*)(base + SC_AT + (m * 16 + fr) * SC_KP + k2 * 64 + fg * 16);
        ao = __builtin_amdgcn_mfma_f32_16x16x32_bf16(af, vb[k2], ao, 0, 0, 0);
      }
#pragma unroll
      for (int r = 0; r < 4; ++r) YDN[ub0 + (u32)((m * 16 + r) * 512)] = f2bf(ao[r]);
    }
    __syncthreads();
  }
#undef SCAN_LOAD
#undef SCAN_STORE
  asm volatile("s_waitcnt vmcnt(0)" ::: "memory");
  __syncthreads();
  {
    const int sub = lane >> 4, l16 = lane & 15;
    float gn8[8];
#pragma unroll
    for (int e = 0; e < 8; ++e) gn8[e] = ogain[l16 * 8 + e];
    for (int t = wave * 4 + sub; t < SEQ; t += 32) {
      const size_t tok = (size_t)b * SEQ + t;
      u16* yp = YDN + tok * 512 + h * 128 + l16 * 8;
      const u32x4 ov4 = *(const u32x4*)yp;
      const u32x4 zv4 = *(const u32x4*)(PROJ + tok * LDP + C_DZ + h * 128 + l16 * 8);
      float o8[8], z8[8];
#pragma unroll
      for (int c = 0; c < 4; ++c) { o8[2 * c] = bflo(ov4[c]); o8[2 * c + 1] = bfhi(ov4[c]); z8[2 * c] = bflo(zv4[c]); z8[2 * c + 1] = bfhi(zv4[c]); }
      float sq = 0.f;
#pragma unroll
      for (int e = 0; e < 8; ++e) sq += o8[e] * o8[e];
      sq += DPPF(sq, 0xb1); sq += DPPF(sq, 0x4e); sq += DPPF(sq, 0x141); sq += DPPF(sq, 0x140);
      const float rstd = rsqrtf(sq * (1.f / 128.f) + EPS);
      u32 w[4];
#pragma unroll
      for (int c = 0; c < 4; ++c) {
        const float y0 = o8[2 * c] * rstd * gn8[2 * c] * z8[2 * c] * sigmoidf_(z8[2 * c]);
        const float y1 = o8[2 * c + 1] * rstd * gn8[2 * c + 1] * z8[2 * c + 1] * sigmoidf_(z8[2 * c + 1]);
        w[c] = pack2(y0, y1);
      }
      *(u32x4*)yp = (u32x4){w[0], w[1], w[2], w[3]};
    }
  }
}

constexpr int AT_WAVE_BYTES = 8192 + 512 + 8192;
__device__ __forceinline__ float xor16_sum(float v) {
  auto r = __builtin_amdgcn_permlane16_swap(__float_as_uint(v), __float_as_uint(v), false, false);
  return __uint_as_float(r[0]) + __uint_as_float(r[1]);
}
__device__ __forceinline__ float xor32_sum(float v) {
  auto r = __builtin_amdgcn_permlane32_swap(__float_as_uint(v), __float_as_uint(v), false, false);
  return __uint_as_float(r[0]) + __uint_as_float(r[1]);
}
__device__ __forceinline__ void attn_query(const Params& p, unsigned char* wsm, int b, int t) {
  typedef long i64;
  typedef int i32x2 __attribute__((ext_vector_type(2)));
  typedef __attribute__((address_space(3))) i32x2 lds_i32x2;
  const u16* PROJ = (const u16*)(p.ws + OFF_PROJ);
  const u16* SEL = (const u16*)(p.ws + OFF_SEL);
  const unsigned char* KVC8 = p.ws + OFF_KVC;
  u16* YATT = (u16*)(p.ws + OFF_YATT);
  const int lane = TIDX & 63;
  const int fr = lane & 15, fg = lane >> 4;
  float* P = (float*)wsm;
  u16* sl = (u16*)(wsm + 8192);
  const size_t tokb = (size_t)b * SEQ;
  const size_t tok = tokb + t;
  const int nsel = min(256, t + 1);
  i64 qb[2][2];
  {
    const u16* qrow = PROJ + tok * LDP + C_AQ + (fr & 3) * 64 + fg * 8;
#pragma unroll
    for (int g = 0; g < 2; ++g)
#pragma unroll
      for (int kk = 0; kk < 2; ++kk) {
        const u32x4 v = *(const u32x4*)(qrow + g * 256 + kk * 32);
        const u32 lo = fp8x4(bflo(v[0]) * 16.f, bfhi(v[0]) * 16.f, bflo(v[1]) * 16.f, bfhi(v[1]) * 16.f);
        const u32 hi = fp8x4(bflo(v[2]) * 16.f, bfhi(v[2]) * 16.f, bflo(v[3]) * 16.f, bfhi(v[3]) * 16.f);
        const i64 w = (i64)(((unsigned long long)hi << 32) | (unsigned long long)lo);
        qb[g][kk] = (fr < 4) ? w : (i64)0;
      }
    const u16* sr = SEL + tok * 256;
#pragma unroll
    for (int i = 0; i < 4; ++i) sl[lane + 64 * i] = sr[lane + 64 * i];
  }
  WAVE_LDS_SYNC();
  const int ngrp = (nsel + 15) >> 4;
  const int nbq = (ngrp + 1) >> 1;
  unsigned char* KST = wsm + 8192 + 512;
  const int kq = lane >> 3, kch = lane & 7;
  u32x4 kA[2][2], kB[2][2];
#define QK_LOAD(buf_, bi_)                                                                       \
  _Pragma("unroll") for (int j = 0; j < 2; ++j)                                                  \
    _Pragma("unroll") for (int hf = 0; hf < 2; ++hf) {                                           \
      const int ki_ = min(((bi_) * 2 + j) * 16 + hf * 8 + kq, 255);                              \
      const int s_ = (int)sl[ki_] & 4095;                                                        \
      buf_[j][hf] = *(const u32x4*)(KVC8 + (tokb + s_) * 256 + kch * 16);                        \
    }
#define QK_COMPUTE(buf_, bi_)                                                                    \
  {                                                                                              \
    _Pragma("unroll") for (int j = 0; j < 2; ++j)                                                \
      _Pragma("unroll") for (int hf = 0; hf < 2; ++hf) {                                         \
        const int row_ = hf * 8 + kq;                                                            \
        *(u32x4*)(KST + j * 2048 + row_ * 128 + ((kch ^ (row_ & 7)) << 4)) = buf_[j][hf];        \
      }                                                                                          \
    WAVE_LDS_SYNC();                                                                             \
    _Pragma("unroll") for (int j = 0; j < 2; ++j) {                                              \
      const unsigned char* kr_ = KST + j * 2048 + fr * 128 + 8 * (fg & 1);                       \
      const int sw_ = fr & 7, ch_ = fg >> 1;                                                     \
      const i64 a00_ = *(const i64*)(kr_ + (((0 + ch_) ^ sw_) << 4));                            \
      const i64 a01_ = *(const i64*)(kr_ + (((2 + ch_) ^ sw_) << 4));                            \
      const i64 a10_ = *(const i64*)(kr_ + (((4 + ch_) ^ sw_) << 4));                            \
      const i64 a11_ = *(const i64*)(kr_ + (((6 + ch_) ^ sw_) << 4));                            \
      f32x4 c0_ = {0.f, 0.f, 0.f, 0.f}, c1_ = {0.f, 0.f, 0.f, 0.f};                              \
      c0_ = __builtin_amdgcn_mfma_f32_16x16x32_fp8_fp8(a00_, qb[0][0], c0_, 0, 0, 0);            \
      c0_ = __builtin_amdgcn_mfma_f32_16x16x32_fp8_fp8(a01_, qb[0][1], c0_, 0, 0, 0);            \
      c1_ = __builtin_amdgcn_mfma_f32_16x16x32_fp8_fp8(a10_, qb[1][0], c1_, 0, 0, 0);            \
      c1_ = __builtin_amdgcn_mfma_f32_16x16x32_fp8_fp8(a11_, qb[1][1], c1_, 0, 0, 0);            \
      if (fr < 4) {                                                                              \
        _Pragma("unroll") for (int r = 0; r < 4; ++r) {                                          \
          const int kk2_ = ((bi_) * 2 + j) * 16 + 4 * fg + r;                                    \
          if (kk2_ < 256) {                                                                      \
            const bool v_ = kk2_ < nsel;                                                         \
            P[kk2_ * 8 + fr] = v_ ? c0_[r] * 0.0625f : -1e30f;                                   \
            P[kk2_ * 8 + 4 + fr] = v_ ? c1_[r] * 0.0625f : -1e30f;                               \
          }                                                                                      \
        }                                                                                        \
      }                                                                                          \
    }                                                                                            \
    WAVE_LDS_SYNC();                                                                             \
  }
  QK_LOAD(kA, 0)
  for (int bi = 0; bi < nbq; bi += 2) {
    if (bi + 1 < nbq) { QK_LOAD(kB, bi + 1) }
    QK_COMPUTE(kA, bi)
    if (bi + 2 < nbq) { QK_LOAD(kA, bi + 2) }
    if (bi + 1 < nbq) { QK_COMPUTE(kB, bi + 1) }
  }
#undef QK_LOAD
#undef QK_COMPUTE
  for (int ki = nbq * 32 + lane; ki < 256; ki += 64) {
    *(f32x4*)(P + ki * 8) = (f32x4){-1e30f, -1e30f, -1e30f, -1e30f};
    *(f32x4*)(P + ki * 8 + 4) = (f32x4){-1e30f, -1e30f, -1e30f, -1e30f};
  }
  WAVE_LDS_SYNC();
  float inv8[8];
  {
    float lg[4][8];
#pragma unroll
    for (int i = 0; i < 4; ++i) {
      f32x4 x0 = *(const f32x4*)(P + (lane + 64 * i) * 8), x1 = *(const f32x4*)(P + (lane + 64 * i) * 8 + 4);
      lg[i][0] = x0[0]; lg[i][1] = x0[1]; lg[i][2] = x0[2]; lg[i][3] = x0[3];
      lg[i][4] = x1[0]; lg[i][5] = x1[1]; lg[i][6] = x1[2]; lg[i][7] = x1[3];
    }
    WAVE_LDS_SYNC();
    unsigned char* PT8 = (unsigned char*)P;
#pragma unroll
    for (int hh = 0; hh < 8; ++hh) {
      float m = fmaxf(fmaxf(lg[0][hh], lg[1][hh]), fmaxf(lg[2][hh], lg[3][hh]));
      m = wave_max_dpp(m);
      float e[4], sum = 0.f;
#pragma unroll
      for (int i = 0; i < 4; ++i) { e[i] = __expf(lg[i][hh] - m); sum += e[i]; }
      sum = wave_sum_dpp(sum);
      inv8[hh] = __builtin_amdgcn_rcpf(sum) * (1.f / 256.f);
      const u32 w = fp8x4(e[0] * 256.f, e[1] * 256.f, e[2] * 256.f, e[3] * 256.f);
#pragma unroll
      for (int i = 0; i < 4; ++i) PT8[hh * 256 + lane + 64 * i] = (unsigned char)((w >> (8 * i)) & 0xffu);
    }
  }
  WAVE_LDS_SYNC();
  {
    const unsigned char* PT8 = (const unsigned char*)P;
    unsigned char* VST = wsm + 8192 + 512;
    const int trow = (lane & 15) >> 1, thalf = lane & 1;
    f32x4 oacc[2][4];
#pragma unroll
    for (int g = 0; g < 2; ++g)
#pragma unroll
      for (int c = 0; c < 4; ++c) oacc[g][c] = (f32x4){0.f, 0.f, 0.f, 0.f};
    const int nks = (nsel + 31) >> 5;
    u32x4 vA[4], vB[4];
#define PV_LOAD(buf_, ks_)                                                                       \
  _Pragma("unroll") for (int i = 0; i < 4; ++i) {                                                \
    const int ki_ = min((ks_) * 32 + i * 8 + kq, 255);                                           \
    const int s_ = (int)sl[ki_] & 4095;                                                          \
    buf_[i] = *(const u32x4*)(KVC8 + (tokb + s_) * 256 + 128 + kch * 16);                        \
  }
#define PV_COMPUTE(buf_, ks_)                                                                    \
  {                                                                                              \
    _Pragma("unroll") for (int i = 0; i < 4; ++i) {                                              \
      const int key_ = i * 8 + kq;                                                               \
      *(u32x4*)(VST + key_ * 128 + ((kch ^ (key_ & 7)) << 4)) = buf_[i];                         \
    }                                                                                            \
    WAVE_LDS_SYNC();                                                                             \
    i64 pa_[2];                                                                                  \
    _Pragma("unroll") for (int g = 0; g < 2; ++g) {                                              \
      const i64 t_ = *(const i64*)(PT8 + (g * 4 + (fr & 3)) * 256 + (ks_) * 32 + 8 * fg);        \
      pa_[g] = (fr < 4) ? t_ : (i64)0;                                                           \
    }                                                                                            \
    const int r1_ = 8 * fg + trow;                                                               \
    _Pragma("unroll") for (int g = 0; g < 2; ++g)                                                \
      _Pragma("unroll") for (int c = 0; c < 4; ++c) {                                            \
        const i32x2 tv_ = __builtin_amdgcn_ds_read_tr8_b64_v2i32((lds_i32x2*)(VST + r1_ * 128 + (((g * 4 + c) ^ (r1_ & 7)) << 4) + 8 * thalf)); \
        const i64 vb_ = (i64)(((unsigned long long)(u32)tv_[1] << 32) | (unsigned long long)(u32)tv_[0]); \
        oacc[g][c] = __builtin_amdgcn_mfma_f32_16x16x32_fp8_fp8(pa_[g], vb_, oacc[g][c], 0, 0, 0); \
      }                                                                                          \
    WAVE_LDS_SYNC();                                                                             \
  }
    PV_LOAD(vA, 0)
    for (int ks = 0; ks < nks; ks += 2) {
      if (ks + 1 < nks) { PV_LOAD(vB, ks + 1) }
      PV_COMPUTE(vA, ks)
      if (ks + 2 < nks) { PV_LOAD(vA, ks + 2) }
      if (ks + 1 < nks) { PV_COMPUTE(vB, ks + 1) }
    }
#undef PV_LOAD
#undef PV_COMPUTE
    if (lane < 16) {
#pragma unroll
      for (int g = 0; g < 2; ++g)
#pragma unroll
        for (int c = 0; c < 4; ++c)
#pragma unroll
          for (int r = 0; r < 4; ++r)
            YATT[tok * 512 + (g * 4 + r) * 64 + 16 * c + fr] = f2bf(oacc[g][c][r] * inv8[g * 4 + r]);
    }
  }
  WAVE_LDS_SYNC();
}

__device__ __forceinline__ void phase3(const Params& p, unsigned char* smem) {
  const int wave = TIDX >> 6;
#ifndef NO_SCAN
  if (blockIdx.x < 32) {
    if (!(p.flags & 2)) dn_scan_item(p, smem, blockIdx.x);
    __syncthreads();
  }
#endif
#ifdef NO_ATTN
  return;
#endif
  if (p.flags & 4) return;
  unsigned* qctr = (unsigned*)(p.ws + 1024 + ((p.flags & 128) ? 4096 : 0));
  const unsigned xcc = (unsigned)__builtin_amdgcn_s_getreg((3 << 11) | 20) & 7u;
  unsigned char* wsm = smem + wave * AT_WAVE_BYTES;
  for (unsigned db = 0; db < 8; ++db) {
    const int bb = (int)((xcc + db) & 7u);
    for (;;) {
      unsigned qi = 0;
      if ((TIDX & 63) == 0) qi = __hip_atomic_fetch_add(qctr + bb * 16, 1u, __ATOMIC_RELAXED, __HIP_MEMORY_SCOPE_AGENT);
      qi = (unsigned)__builtin_amdgcn_readfirstlane((int)qi);
      if (qi >= (unsigned)SEQ) break;
      attn_query(p, wsm, bb, SEQ - 1 - (int)qi);
    }
  }
}

__device__ __forceinline__ void hblk_load(unsigned char* reg, const u16* __restrict__ src, u32 ob, u32 ld, int lane) {
  const int c16 = lane & 7, r8 = lane >> 3;
#pragma unroll
  for (int it = 0; it < 8; ++it) {
    const int rl = it * 8 + r8;
    const u32x4 v = *(const u32x4*)(src + ob + (u32)rl * ld + (u32)(c16 * 8));
    *(u32x4*)(reg + rl * 128 + (((c16 + 2 * ((rl >> 2) & 3)) & 7) << 4)) = v;
    if ((it & 3) == 3) __builtin_amdgcn_sched_barrier(0);
  }
}
__device__ __forceinline__ void hblk_store(const unsigned char* reg, u16* __restrict__ dst, u32 ob, u32 ld, int lane) {
  const int c16 = lane & 7, r8 = lane >> 3;
#pragma unroll
  for (int it = 0; it < 8; ++it) {
    const int rl = it * 8 + r8;
    const u32x4 v = *(const u32x4*)(reg + rl * 128 + (((c16 + 2 * ((rl >> 2) & 3)) & 7) << 4));
    *(u32x4*)(dst + ob + (u32)rl * ld + (u32)(c16 * 8)) = v;
  }
}
__device__ __forceinline__ void phase4(const Params& p, unsigned char* smem) {
  const u16* YATT = (const u16*)(p.ws + OFF_YATT);
  const u16* YDN = (const u16*)(p.ws + OFF_YDN);
  const u16* WTA = (const u16*)(p.ws + OFF_WTA);
  const u16* WTB = (const u16*)(p.ws + OFF_WTB);
  const u16* PROJ = (const u16*)(p.ws + OFF_PROJ);
  u16* MG = (u16*)(p.ws + OFF_MERGED);
  const int ntn = DM / 256, ntiles = (MTOK / 256) * ntn;
  for (int t = blockIdx.x; t < ntiles; t += gridDim.x) {
    const int m0 = (t / ntn) * 256, n0 = (t % ntn) * 256;
    f32x4 acc[2][2][4][2];
#pragma unroll
    for (int pass = 0; pass < 2; ++pass) {
      gemm8_tile(pass ? YDN : YATT, pass ? WTB : WTA, 512, m0, n0, smem, acc);
      int lane = TIDX & 63;
      asm volatile("" : "+v"(lane));
      const int wave = TIDX >> 6, wr = wave >> 2, wc = wave & 3, fr = lane & 15, fq = lane >> 4;
      unsigned char* regG = smem + wave * 16384;
      unsigned char* regT = regG + 8192;
      const int lrot = (fr >> 3) + 2 * fq;
      int off4[4];
#pragma unroll
      for (int jj = 0; jj < 4; ++jj) off4[jj] = (4 * fq) * 128 + (fr & 7) * 2 + (((jj * 2 + lrot) & 7) << 4);
#pragma unroll
      for (int ai = 0; ai < 2; ++ai) {
        const u32 gb0 = (u32)(m0 + ai * 128 + wr * 64) * LDP + (u32)(n0 + wc * 64) + (u32)(pass ? C_GB : C_GA);
        const u32 ob0 = (u32)(m0 + ai * 128 + wr * 64) * DM + (u32)(n0 + wc * 64);
        hblk_load(regG, PROJ, gb0, LDP, lane);
        if (pass == 1) hblk_load(regT, MG, ob0, DM, lane);
        WAVE_LDS_SYNC();
#pragma unroll
        for (int m = 0; m < 4; ++m)
#pragma unroll
          for (int r = 0; r < 4; ++r)
#pragma unroll
            for (int bj = 0; bj < 2; ++bj)
#pragma unroll
              for (int n = 0; n < 2; ++n) {
                const int o = off4[bj * 2 + n] + (m * 16 + r) * 128;
                float v = sigmoidf_(bf2f(*(const u16*)(regG + o))) * acc[ai][bj][m][n][r];
                if (pass == 1) v += bf2f(*(const u16*)(regT + o));
                *(u16*)(regT + o) = f2bf(v);
              }
        WAVE_LDS_SYNC();
        hblk_store(regT, MG, ob0, DM, lane);
        WAVE_LDS_SYNC();
      }
      asm volatile("s_waitcnt vmcnt(0)" ::: "memory");
    }
  }
}

__device__ __forceinline__ void phase5(const Params& p, unsigned char* smem) {
  const u16* MG = (const u16*)(p.ws + OFF_MERGED);
  const u16* WTO = (const u16*)(p.ws + OFF_WTO);
  const float* x = p.in[0];
  const int lane = TIDX & 63, wave = TIDX >> 6;
  const int wr = wave >> 2, wc = wave & 3, fr = lane & 15, fq = lane >> 4;
  const int ntn = DM / 256, ntiles = (MTOK / 256) * ntn;
  for (int t = blockIdx.x; t < ntiles; t += gridDim.x) {
    const int m0 = (t / ntn) * 256, n0 = (t % ntn) * 256;
    f32x4 acc[2][2][4][2];
    gemm8_tile(MG, WTO, DM, m0, n0, smem, acc);
    const u32 ob0 = (u32)(m0 + wr * 64 + 4 * fq) * DM + (u32)(n0 + wc * 64 + fr);
    float* outp = p.out;
#pragma unroll
    for (int ai = 0; ai < 2; ++ai)
#pragma unroll
      for (int m = 0; m < 4; ++m) {
#pragma unroll
        for (int bj = 0; bj < 2; ++bj)
#pragma unroll
          for (int n = 0; n < 2; ++n)
#pragma unroll
            for (int j = 0; j < 4; ++j) {
              u32 o = ob0 + (u32)((ai * 128 + m * 16 + j) * DM + (bj * 2 + n) * 16);
              outp[o] = x[o] + acc[ai][bj][m][n][j];
            }
        __builtin_amdgcn_sched_barrier(0);
      }
  }
}

__device__ __forceinline__ void phase6(const Params& p, unsigned char* smem) {
  const u16* H2 = (const u16*)(p.ws + OFF_H2);
  const u16* WTQ = (const u16*)(p.ws + OFF_WTQ);
  u16* QP = (u16*)(p.ws + OFF_QP);
  const int lane = TIDX & 63, wave = TIDX >> 6;
  const int wr = wave >> 2, wc = wave & 3, fr = lane & 15, fq = lane >> 4;
  const int ntn = 2048 / 256, ntiles = (MTOK / 256) * ntn;
  for (int t = blockIdx.x; t < ntiles; t += gridDim.x) {
    const int m0 = (t / ntn) * 256, n0 = (t % ntn) * 256;
    f32x4 acc[2][2][4][2];
    gemm8_tile(H2, WTQ, DM, m0, n0, smem, acc);
    ep_store<2048, false>(QP, (u32)(m0 + wr * 64) * 2048 + (u32)(n0 + wc * 64), acc, nullptr, 1.f, smem, wave, lane);
  }
}

__device__ __forceinline__ int mono_key(float v) { int b = __float_as_int(v); return b ^ ((b >> 31) & 0x7fffffff); }
__device__ __forceinline__ float unmono_key(int k) { return __int_as_float(k ^ ((k >> 31) & 0x7fffffff)); }
__device__ __forceinline__ void chain16(int (&k)[16], int x) {
#pragma unroll
  for (int j = 0; j < 16; ++j) { int hi = max(k[j], x); x = min(k[j], x); k[j] = hi; }
}

#define CE_DESC(a, b) { const int hi_ = max(a, b), lo_ = min(a, b); a = hi_; b = lo_; }
__device__ __forceinline__ void sort16_desc(int (&k)[16]) {
#pragma unroll
  for (int size = 2; size <= 16; size <<= 1) {
#pragma unroll
    for (int stride = size >> 1; stride > 0; stride >>= 1) {
#pragma unroll
      for (int i = 0; i < 16; ++i) {
        const int l = i ^ stride;
        if (l > i) {
          if ((i & size) == 0) CE_DESC(k[i], k[l]) else CE_DESC(k[l], k[i])
        }
      }
    }
  }
}
__device__ __forceinline__ void merge_top16(int (&a)[16], const int (&b)[16]) {
#pragma unroll
  for (int i = 0; i < 16; ++i) a[i] = max(a[i], b[15 - i]);
#pragma unroll
  for (int stride = 8; stride > 0; stride >>= 1) {
#pragma unroll
    for (int i = 0; i < 16; ++i) {
      const int l = i ^ stride;
      if (l > i) CE_DESC(a[i], a[l])
    }
  }
}

constexpr int P7_LD = 132;
__device__ __forceinline__ void phase7(const Params& p, unsigned char* smem) {
  const u16* QP = (const u16*)(p.ws + OFF_QP);
  const u16* SKB = (const u16*)(p.ws + OFF_SKB);
  float* TOPS = (float*)(p.ws + OFF_TOPS);
  u8* TOPI = (u8*)(p.ws + OFF_TOPI);
  const int tid = TIDX, lane = tid & 63, wave = tid >> 6;
  const int wm = wave >> 1, wn = wave & 1, fr = lane & 15, fg = lane >> 4;
  const int ntiles = (MTOK / G_BM) * 16;
  float* tile = (float*)smem;
  for (int t = blockIdx.x; t < ntiles; t += gridDim.x) {
    const int m0 = (t >> 4) * G_BM, hp = t & 15;
    f32x4 acc[4][4];
    gemm_mainloop(QP + hp * 128, 2048, SKB + (size_t)hp * 128 * 128, 128, 128, m0, 0, smem, acc);
#pragma unroll
    for (int i = 0; i < 4; ++i)
#pragma unroll
      for (int j = 0; j < 4; ++j)
#pragma unroll
        for (int r = 0; r < 4; ++r) {
          int row = wm * 64 + i * 16 + 4 * fg + r, col = wn * 64 + j * 16 + fr;
          tile[row * P7_LD + col] = acc[i][j][r];
        }
    __syncthreads();
    {
      const int row = tid >> 1, half = tid & 1;
      int k[16];
      const float* rowp = tile + row * P7_LD + half * 64;
#pragma unroll
      for (int grp = 0; grp < 4; ++grp) {
        int gk[16];
#pragma unroll
        for (int c = 0; c < 16; c += 4) {
          f32x4 v = *(const f32x4*)(rowp + grp * 16 + c);
          const int ib = 127 - (half * 64 + grp * 16 + c);
          gk[c] = (mono_key(v[0]) & ~127) | ib;
          gk[c + 1] = (mono_key(v[1]) & ~127) | (ib - 1);
          gk[c + 2] = (mono_key(v[2]) & ~127) | (ib - 2);
          gk[c + 3] = (mono_key(v[3]) & ~127) | (ib - 3);
        }
        sort16_desc(gk);
        if (grp == 0) {
#pragma unroll
          for (int j = 0; j < 16; ++j) k[j] = gk[j];
        } else merge_top16(k, gk);
      }
      {
        int other[16];
#pragma unroll
        for (int j = 0; j < 16; ++j) other[j] = DPPI(k[j], 0xb1);
        merge_top16(k, other);
      }
      if (half == 0) {
        size_t o = ((size_t)(m0 + row) * 16 + hp) * 16;
        float vals[16]; int idx[16];
#pragma unroll
        for (int j = 0; j < 16; ++j) { idx[j] = 127 - (k[j] & 127); vals[j] = tile[row * P7_LD + idx[j]]; }
#pragma unroll
        for (int j = 0; j < 16; j += 4) *(f32x4*)(TOPS + o + j) = (f32x4){vals[j], vals[j + 1], vals[j + 2], vals[j + 3]};
#pragma unroll
        for (int j = 0; j < 16; j += 4)
          *(u32*)(TOPI + o + j) = (u32)idx[j] | ((u32)idx[j + 1] << 8) | ((u32)idx[j + 2] << 16) | ((u32)idx[j + 3] << 24);
      }
    }
    __syncthreads();
  }
}

__device__ __forceinline__ void phase7b(const Params& p) {
  const float* TOPS = (const float*)(p.ws + OFF_TOPS);
  const u8* TOPI = (const u8*)(p.ws + OFF_TOPI);
  int* EXPERT = (int*)(p.ws + OFF_EXPERT);
  float* GATE = (float*)(p.ws + OFF_GATE);
  for (int w = blockIdx.x * NTHREADS + TIDX; w < MTOK * 8; w += gridDim.x * NTHREADS) {
    const size_t o = (size_t)w * 32;
    float sa[16], sb[16];
#pragma unroll
    for (int k = 0; k < 16; k += 4) {
      float4 v = *(const float4*)(TOPS + o + k); sa[k] = v.x; sa[k + 1] = v.y; sa[k + 2] = v.z; sa[k + 3] = v.w;
      float4 u = *(const float4*)(TOPS + o + 16 + k); sb[k] = u.x; sb[k + 1] = u.y; sb[k + 2] = u.z; sb[k + 3] = u.w;
    }
    int cand[64];
#pragma unroll
    for (int k = 0; k < 64; ++k) cand[k] = (int)0x80000000;
    {
      int cnt = 0;
#pragma unroll
      for (int a = 0; a < 16; ++a)
#pragma unroll
        for (int bb = 0; bb < 16; ++bb)
          if ((a + 1) * (bb + 1) <= 16) { cand[cnt] = (mono_key(sa[a] + sb[bb]) & ~255) | (255 - (a * 16 + bb)); ++cnt; }
    }
    int kk[16];
#pragma unroll
    for (int grp = 0; grp < 4; ++grp) {
      int gk[16];
#pragma unroll
      for (int j = 0; j < 16; ++j) gk[j] = cand[grp * 16 + j];
      sort16_desc(gk);
      if (grp == 0) {
#pragma unroll
        for (int j = 0; j < 16; ++j) kk[j] = gk[j];
      } else merge_top16(kk, gk);
    }
    float vals[16];
#pragma unroll
    for (int k = 0; k < 16; ++k) vals[k] = unmono_key(kk[k] & ~255);
    float m = vals[0], s = 0.f, e[16];
#pragma unroll
    for (int k = 0; k < 16; ++k) { e[k] = __expf(vals[k] - m); s += e[k]; }
    float inv = 1.f / s;
#pragma unroll
    for (int k = 0; k < 16; ++k) {
      const int ci = 255 - (kk[k] & 255);
      int a = ci >> 4, bb = ci & 15;
      int ex = (int)TOPI[o + a] * 128 + (int)TOPI[o + 16 + bb];
      EXPERT[(size_t)w * 16 + k] = ex;
      GATE[(size_t)w * 16 + k] = e[k] * inv;
    }
  }
  {
    const int lane = TIDX & 63, wave = TIDX >> 6;
    for (int row = blockIdx.x * 8 + wave; row < 2 * 16384; row += gridDim.x * 8) {
      const int tbl = row >> 14, r = row & 16383;
      const f32x4* src = (const f32x4*)((tbl ? p.in[16] : p.in[15]) + (size_t)r * DM) + 4 * lane;
      f32x4 x[4];
      float amax = 0.f;
#pragma unroll
      for (int i = 0; i < 4; ++i) {
        x[i] = src[i];
        amax = fmaxf(amax, fmaxf(fmaxf(fabsf(x[i][0]), fabsf(x[i][1])), fmaxf(fabsf(x[i][2]), fabsf(x[i][3]))));
      }
      amax = wave_max_dpp(amax);
      const float inv = amax > 0.f ? 127.f / amax : 0.f;
      const int bias = 0;
      u32x4 o;
#pragma unroll
      for (int i = 0; i < 4; ++i) {
        int q0 = (int)rintf(x[i][0] * inv) + bias, q1 = (int)rintf(x[i][1] * inv) + bias;
        int q2 = (int)rintf(x[i][2] * inv) + bias, q3 = (int)rintf(x[i][3] * inv) + bias;
        o[i] = (u32)(q0 & 0xff) | ((u32)(q1 & 0xff) << 8) | ((u32)(q2 & 0xff) << 16) | ((u32)(q3 & 0xff) << 24);
      }
      *(u32x4*)(p.ws + (tbl ? OFF_VQ : OFF_UQ) + ((size_t)(lane >> 3) * 16384 + r) * 128 + (lane & 7) * 16) = o;
      if (lane == 0) ((float*)(p.ws + (tbl ? OFF_VS : OFF_US)))[r] = amax * (1.f / 127.f);
    }
  }
}

__device__ __forceinline__ void phase8a(const Params& p) {
  const int* EXPERT = (const int*)(p.ws + OFF_EXPERT);
  const unsigned char* UQS = p.ws + OFF_UQ;
  const unsigned char* H2Q = p.ws + OFF_H2Q;
  int* PD = (int*)(p.ws + OFF_PD);
  unsigned* ctr = (unsigned*)(p.ws + 2048 + ((p.flags & 128) ? 4096 : 0));
  const unsigned xcc = (unsigned)__builtin_amdgcn_s_getreg((3 << 11) | 20) & 7u;
  const int lane = TIDX & 63, g8 = lane >> 3, l8 = lane & 7;
  for (unsigned db = 0; db < 8; ++db) {
    const int x = (int)((xcc + db) & 7u);
    for (;;) {
      unsigned ci = 0;
      if (lane == 0) ci = __hip_atomic_fetch_add(ctr + x * 16, 1u, __ATOMIC_RELAXED, __HIP_MEMORY_SCOPE_AGENT);
      ci = (unsigned)__builtin_amdgcn_readfirstlane((int)ci);
      if (ci >= (unsigned)(MTOK / 16)) break;
#pragma unroll 1
      for (int tt = 0; tt < 16; ++tt) {
        const int tok = (int)ci * 16 + tt;
        const int e0 = EXPERT[(size_t)tok * 128 + lane], e1 = EXPERT[(size_t)tok * 128 + 64 + lane];
        const u32x4 hq = *(const u32x4*)(H2Q + (size_t)tok * DM + x * 128 + l8 * 16);
        u32x4 ua[16];
#pragma unroll
        for (int i = 0; i < 16; ++i) {
          const int k = i * 8 + g8;
          const int ek = __shfl(i < 8 ? e0 : e1, k & 63);
          ua[i] = *(const u32x4*)(UQS + ((size_t)(x * 16384 + ek)) * 128 + l8 * 16);
        }
        int keep0 = 0, keep1 = 0;
#pragma unroll
        for (int i = 0; i < 16; ++i) {
          int sd = 0;
#pragma unroll
          for (int c = 0; c < 4; ++c) sd = __builtin_amdgcn_sdot4((int)ua[i][c], (int)hq[c], sd, false);
          sd += DPPI(sd, 0xb1); sd += DPPI(sd, 0x4e); sd += DPPI(sd, 0x141);
          if (i < 8) keep0 = (l8 == (i & 7)) ? sd : keep0; else keep1 = (l8 == (i & 7)) ? sd : keep1;
        }
        int* pd = PD + ((size_t)x * MTOK + tok) * 128 + l8 * 8 + g8;
        pd[0] = keep0; pd[64] = keep1;
      }
    }
  }
}

__device__ __forceinline__ void phase8c(const Params& p) {
  const int* EXPERT = (const int*)(p.ws + OFF_EXPERT);
  const float* GATE = (const float*)(p.ws + OFF_GATE);
  const float* US = (const float*)(p.ws + OFF_US);
  const float* VS = (const float*)(p.ws + OFF_VS);
  const float* HS = (const float*)(p.ws + OFF_HS);
  const int* PD = (const int*)(p.ws + OFF_PD);
  unsigned char* CQ8 = p.ws + OFF_CQ8;
  float* QSC = (float*)(p.ws + OFF_QSC);
  const int lane = TIDX & 63, wave = TIDX >> 6;
  for (int tok = blockIdx.x * 8 + wave; tok < MTOK; tok += gridDim.x * 8) {
    const int e0 = EXPERT[(size_t)tok * 128 + lane], e1 = EXPERT[(size_t)tok * 128 + 64 + lane];
    const float g0 = GATE[(size_t)tok * 128 + lane], g1 = GATE[(size_t)tok * 128 + 64 + lane];
    int s0 = 0, s1 = 0;
#pragma unroll
    for (int xx = 0; xx < 8; ++xx) {
      s0 += PD[((size_t)xx * MTOK + tok) * 128 + lane];
      s1 += PD[((size_t)xx * MTOK + tok) * 128 + 64 + lane];
    }
    const float hs = HS[tok];
    const float d0 = (float)s0 * US[e0] * hs, d1 = (float)s1 * US[e1] * hs;
    const float cf0 = g0 * 0.5f * d0 * (1.f + erff(d0 * 0.70710678118654752f)) * VS[e0];
    const float cf1 = g1 * 0.5f * d1 * (1.f + erff(d1 * 0.70710678118654752f)) * VS[e1];
    const float cmax = wave_max_dpp(fmaxf(fabsf(cf0), fabsf(cf1)));
    const float qinv = cmax > 0.f ? 32639.f / cmax : 0.f;
    const int c0 = (int)rintf(cf0 * qinv), c1 = (int)rintf(cf1 * qinv);
    const int h0 = (c0 + 128) >> 8, h1 = (c1 + 128) >> 8;
    unsigned char* cq = CQ8 + (size_t)tok * 256;
    cq[lane] = (unsigned char)(h0 & 0xff); cq[64 + lane] = (unsigned char)(h1 & 0xff);
    cq[128 + lane] = (unsigned char)((c0 - 256 * h0) & 0xff); cq[192 + lane] = (unsigned char)((c1 - 256 * h1) & 0xff);
    if (lane == 0) QSC[tok] = cmax * (1.f / 32639.f);
  }
}

#ifndef TR8_VARIANT
#define TR8_VARIANT 0
#endif
__device__ __forceinline__ void phase8b(const Params& p, unsigned char* smem) {
  typedef int i32x4 __attribute__((ext_vector_type(4)));
  typedef int i32x2 __attribute__((ext_vector_type(2)));
  typedef __attribute__((address_space(3))) i32x2 lds_i32x2;
  const int* EXPERT = (const int*)(p.ws + OFF_EXPERT);
  const unsigned char* VQS = p.ws + OFF_VQ;
  const unsigned char* CQ8 = p.ws + OFF_CQ8;
  const float* QSC = (const float*)(p.ws + OFF_QSC);
  unsigned* ctr = (unsigned*)(p.ws + 3072 + ((p.flags & 128) ? 4096 : 0));
  const unsigned xcc = (unsigned)__builtin_amdgcn_s_getreg((3 << 11) | 20) & 7u;
  const int lane = TIDX & 63, wave = TIDX >> 6, g8 = lane >> 3, l8 = lane & 7;
  const int fr = lane & 15, fg = lane >> 4;
  unsigned char* VST = smem + wave * 16384;
#if TR8_VARIANT == 0
  const int trow = (lane & 15) >> 1, thalf = lane & 1;
#else
  const int trow = lane & 7, thalf = (lane & 15) >> 3;
#endif
  __syncthreads();
  for (unsigned db = 0; db < 8; ++db) {
    const int x = (int)((xcc + db) & 7u);
    for (;;) {
      unsigned ci = 0;
      if (lane == 0) ci = __hip_atomic_fetch_add(ctr + x * 16, 1u, __ATOMIC_RELAXED, __HIP_MEMORY_SCOPE_AGENT);
      ci = (unsigned)__builtin_amdgcn_readfirstlane((int)ci);
      if (ci >= (unsigned)(MTOK / 16)) break;
#pragma unroll 1
      for (int tt = 0; tt < 16; ++tt) {
        const int tok = (int)ci * 16 + tt;
        const int e0 = EXPERT[(size_t)tok * 128 + lane], e1 = EXPERT[(size_t)tok * 128 + 64 + lane];
        u32x4 va[16];
#pragma unroll
        for (int i = 0; i < 16; ++i) {
          const int k = i * 8 + g8;
          const int ek = __shfl(i < 8 ? e0 : e1, k & 63);
          va[i] = *(const u32x4*)(VQS + ((size_t)(x * 16384 + ek)) * 128 + l8 * 16);
        }
        i32x4 af[2];
#pragma unroll
        for (int sx = 0; sx < 2; ++sx) {
          af[sx] = *(const i32x4*)(CQ8 + (size_t)tok * 256 + (fr & 1) * 128 + sx * 64 + fg * 16);
          if (fr >= 2) af[sx] = (i32x4){0, 0, 0, 0};
        }
        const float qsc = QSC[tok];
#pragma unroll
        for (int i = 0; i < 16; ++i) {
          const int k = i * 8 + g8;
          *(u32x4*)(VST + k * 128 + ((l8 ^ g8) << 4)) = va[i];
        }
        WAVE_LDS_SYNC();
        i32x4 acc[8];
#pragma unroll
        for (int c = 0; c < 8; ++c) acc[c] = (i32x4){0, 0, 0, 0};
#pragma unroll
        for (int sx = 0; sx < 2; ++sx) {
          const int r1 = sx * 64 + fg * 16 + trow, r2 = r1 + 8;
#pragma unroll
          for (int c = 0; c < 8; ++c) {
            const i32x2 lo = __builtin_amdgcn_ds_read_tr8_b64_v2i32((lds_i32x2*)(VST + r1 * 128 + ((c ^ (r1 & 7)) << 4) + 8 * thalf));
            const i32x2 hi = __builtin_amdgcn_ds_read_tr8_b64_v2i32((lds_i32x2*)(VST + r2 * 128 + ((c ^ (r2 & 7)) << 4) + 8 * thalf));
            const i32x4 bf = {lo[0], lo[1], hi[0], hi[1]};
            acc[c] = __builtin_amdgcn_mfma_i32_16x16x64_i8(af[sx], bf, acc[c], 0, 0, 0);
          }
        }
        WAVE_LDS_SYNC();
        if (lane < 16 && !(p.flags & 32)) {
          float* op = p.out + (size_t)tok * DM + x * 128 + fr;
#pragma unroll
          for (int c = 0; c < 8; ++c) op[16 * c] += ((float)acc[c][0] * 256.f + (float)acc[c][1]) * qsc;
        }
      }
    }
  }
}

__device__ __forceinline__ void grid_barrier(unsigned* ctr, unsigned target) {
  asm volatile("s_waitcnt vmcnt(0)" ::: "memory");
  __syncthreads();
  if (TIDX == 0) {
    __builtin_amdgcn_fence(__ATOMIC_RELEASE, "agent");
    asm volatile("s_waitcnt vmcnt(0)" ::: "memory");
    __hip_atomic_fetch_add(ctr, 1u, __ATOMIC_RELAXED, __HIP_MEMORY_SCOPE_AGENT);
    while (__hip_atomic_load(ctr, __ATOMIC_RELAXED, __HIP_MEMORY_SCOPE_AGENT) < target) __builtin_amdgcn_s_sleep(2);
    __builtin_amdgcn_fence(__ATOMIC_ACQUIRE, "agent");
    asm volatile("s_waitcnt vmcnt(0)" ::: "memory");
  }
  __syncthreads();
}

__global__ void __launch_bounds__(NTHREADS, 2) mk_fwd(Params p) {
  cg::grid_group grid = cg::this_grid();
  __shared__ __attribute__((aligned(16))) unsigned char smem[SMEM_BYTES];
  const int lo = p.ph_lo, hi = p.ph_hi;
#define RUN(k, call) if (lo <= (k) && (k) < hi) { call; if ((k) + 1 < hi) { if ((k) == 0) grid.sync(); else grid_barrier((unsigned*)p.ws, (unsigned)(lo == 0 ? (k) : (k) - lo + 1) * gridDim.x); } }
  RUN(0, phase0(p, smem))
  RUN(1, phase1(p, smem))
  RUN(2, phase2(p, smem))
  RUN(3, phase3(p, smem))
  RUN(4, phase4(p, smem))
  RUN(5, phase5(p, smem))
  RUN(6, rmsnorm_rows<true>(p.out, p.in[12], (u16*)(p.ws + OFF_H2), p.ws + OFF_H2Q, (float*)(p.ws + OFF_HS)))
  RUN(7, phase6(p, smem))
  RUN(8, phase7(p, smem))
  RUN(9, phase7b(p))
  RUN(10, phase8a(p))
  RUN(11, phase8c(p))
  RUN(12, phase8b(p, smem))
#undef RUN
}

extern "C" void kernel_launch(void* const* d_in, const int* in_sizes, int n_in,
                              void* d_out, int out_size, void* d_ws, size_t ws_size,
                              hipStream_t stream) {
  static int grid_blocks = 0;
  if (!grid_blocks) {
    int dev = 0, cus = 0, per_cu = 0;
    (void)hipGetDevice(&dev);
    (void)hipDeviceGetAttribute(&cus, hipDeviceAttributeMultiprocessorCount, dev);
    (void)hipOccupancyMaxActiveBlocksPerMultiprocessor(&per_cu, mk_fwd, NTHREADS, 0);
    if (per_cu < 1) per_cu = 1;
    if (per_cu > 1) per_cu = 1;
    grid_blocks = cus * per_cu;
    fprintf(stderr, "mk_fwd: cus=%d per_cu=%d grid=%d ws=%zu\n", cus, per_cu, grid_blocks, ws_size);
  }
  Params p{};
  for (int i = 0; i < 17 && i < n_in; ++i) p.in[i] = (const float*)d_in[i];
  p.out = (float*)d_out;
  p.ws = (unsigned char*)d_ws;
  p.ph_lo = 0; p.ph_hi = 13;
  (void)hipMemsetAsync(d_ws, 0, 8192, stream);
  void* args[] = {&p};
  hipError_t e = hipLaunchCooperativeKernel((void*)mk_fwd, dim3(grid_blocks), dim3(NTHREADS), args, 0, stream);
  if (e != hipSuccess) fprintf(stderr, "cooperative launch failed: %s (grid %d)\n", hipGetErrorString(e), grid_blocks);
#ifdef EXTRA_LO
  {
    Params p2 = p;
    p2.ph_lo = EXTRA_LO; p2.ph_hi = EXTRA_HI; p2.flags = EXTRA_FLAGS;
    void* args2[] = {&p2};
    (void)hipLaunchCooperativeKernel((void*)mk_fwd, dim3(grid_blocks), dim3(NTHREADS), args2, 0, stream);
  }
#endif
}
```

```cpp
#include <hip/hip_runtime.h>
#include <hip/hip_bf16.h>
#include <hip/hip_cooperative_groups.h>
#include <cstdio>
#include <cstdint>
namespace cg = cooperative_groups;

typedef unsigned short u16;
typedef unsigned int u32;
typedef unsigned char u8;
typedef short bf16x8 __attribute__((ext_vector_type(8)));
typedef float f32x4 __attribute__((ext_vector_type(4)));
typedef unsigned int u32x4 __attribute__((ext_vector_type(4)));
typedef unsigned int u32x2 __attribute__((ext_vector_type(2)));

constexpr int NTHREADS = 512;
constexpr int BATCH = 8, SEQ = 4096, DM = 1024, MTOK = BATCH * SEQ;
constexpr int LDP = 5120;
constexpr int NPADW = 5632;
constexpr int C_AQ = 0, C_IQ = 512, C_DQ = 1024, C_DK = 1536, C_DV = 2048, C_DZ = 2560, C_GA = 3072, C_GB = 4096;
constexpr int N_AK = 5120, N_AV = 5248, N_IK = 5376, N_SM = 5440;
constexpr size_t MiB = 1ull << 20;
constexpr size_t OFF_WTIN = 1 * MiB, OFF_WTA = 12 * MiB, OFF_WTB = 13 * MiB, OFF_WTO = 14 * MiB, OFF_WTQ = 16 * MiB,
                 OFF_SKB = 20 * MiB, OFF_SMALL = 21 * MiB, OFF_H = 23 * MiB, OFF_ATT = 23 * MiB, OFF_GC = 39 * MiB,
                 OFF_MERGED = 23 * MiB, OFF_PROJ = 87 * MiB, OFF_KVC = 407 * MiB, OFF_IKC = 423 * MiB, OFF_SEL = 427 * MiB, OFF_YATT = 443 * MiB,
                 OFF_YDN = 475 * MiB;
constexpr size_t OFF_H2 = OFF_PROJ, OFF_QP = OFF_PROJ + 64 * MiB, OFF_TOPS = OFF_PROJ + 192 * MiB,
                 OFF_TOPI = OFF_PROJ + 224 * MiB, OFF_EXPERT = OFF_PROJ + 232 * MiB, OFF_GATE = OFF_PROJ + 248 * MiB;
constexpr size_t OFF_UQ = OFF_PROJ + 264 * MiB, OFF_VQ = OFF_PROJ + 280 * MiB, OFF_US = OFF_PROJ + 296 * MiB, OFF_VS = OFF_PROJ + 297 * MiB;
constexpr size_t OFF_CQ8 = 56 * MiB, OFF_QSC = 64 * MiB;
constexpr size_t OFF_H2Q = 23 * MiB, OFF_HS = 55 * MiB, OFF_PD = OFF_PROJ + 64 * MiB;
constexpr size_t DO_U = 0, DO_W = 32 * MiB, DO_QN = 64 * MiB, DO_KNT = 96 * MiB;

constexpr int SMEM_BYTES = 162816;
constexpr float EPS = 1e-6f;

struct Params {
  const float* in[17];
  float* out;
  unsigned char* ws;
  int ph_lo, ph_hi;
  int flags, pad;
};

typedef __bf16 bf16x2_t __attribute__((ext_vector_type(2)));
typedef float f32x2_t __attribute__((ext_vector_type(2)));
__device__ __forceinline__ u32 pack2(float a, float b) {
  f32x2_t f = {a, b};
  return __builtin_bit_cast(u32, __builtin_convertvector(f, bf16x2_t));
}
__device__ __forceinline__ u16 f2bf(float f) { return (u16)(pack2(f, f) & 0xffffu); }
__device__ __forceinline__ float bf2f(u16 h) { return __uint_as_float(((u32)h) << 16); }
__device__ __forceinline__ float bflo(u32 w) { return __uint_as_float(w << 16); }
__device__ __forceinline__ float bfhi(u32 w) { return __uint_as_float(w & 0xffff0000u); }
__device__ __forceinline__ float wave_sum(float v) {
#pragma unroll
  for (int o = 32; o > 0; o >>= 1) v += __shfl_xor(v, o);
  return v;
}
__device__ __forceinline__ float wave_max(float v) {
#pragma unroll
  for (int o = 32; o > 0; o >>= 1) v = fmaxf(v, __shfl_xor(v, o));
  return v;
}
__device__ __forceinline__ float dot2bf(u32 a, u32 b, float acc) {
  return __builtin_amdgcn_fdot2_f32_bf16(__builtin_bit_cast(bf16x2_t, a), __builtin_bit_cast(bf16x2_t, b), acc, false);
}
#define DPPF(v, ctrl) __int_as_float(__builtin_amdgcn_update_dpp(0, __float_as_int(v), ctrl, 0xf, 0xf, true))
__device__ __forceinline__ float wave_sum_dpp(float v) {
  v += DPPF(v, 0xb1);
  v += DPPF(v, 0x4e);
  v += DPPF(v, 0x124);
  v += DPPF(v, 0x128);
  float r0 = __int_as_float(__builtin_amdgcn_readlane(__float_as_int(v), 0));
  float r1 = __int_as_float(__builtin_amdgcn_readlane(__float_as_int(v), 16));
  float r2 = __int_as_float(__builtin_amdgcn_readlane(__float_as_int(v), 32));
  float r3 = __int_as_float(__builtin_amdgcn_readlane(__float_as_int(v), 48));
  return (r0 + r1) + (r2 + r3);
}
__device__ __forceinline__ int opaque_tid() { int t = threadIdx.x; asm volatile("" : "+v"(t)); return t; }
#define TIDX opaque_tid()
#define DPPI(v, ctrl) __builtin_amdgcn_update_dpp(0, (v), ctrl, 0xf, 0xf, true)
__device__ __forceinline__ int wave_sum_i_dpp(int v) {
  v += DPPI(v, 0xb1);
  v += DPPI(v, 0x4e);
  v += DPPI(v, 0x124);
  v += DPPI(v, 0x128);
  return (__builtin_amdgcn_readlane(v, 0) + __builtin_amdgcn_readlane(v, 16)) +
         (__builtin_amdgcn_readlane(v, 32) + __builtin_amdgcn_readlane(v, 48));
}
__device__ __forceinline__ float wave_max_dpp(float v) {
  v = fmaxf(v, DPPF(v, 0xb1));
  v = fmaxf(v, DPPF(v, 0x4e));
  v = fmaxf(v, DPPF(v, 0x124));
  v = fmaxf(v, DPPF(v, 0x128));
  float r0 = __int_as_float(__builtin_amdgcn_readlane(__float_as_int(v), 0));
  float r1 = __int_as_float(__builtin_amdgcn_readlane(__float_as_int(v), 16));
  float r2 = __int_as_float(__builtin_amdgcn_readlane(__float_as_int(v), 32));
  float r3 = __int_as_float(__builtin_amdgcn_readlane(__float_as_int(v), 48));
  return fmaxf(fmaxf(r0, r1), fmaxf(r2, r3));
}
#define WAVE_LDS_SYNC() asm volatile("s_waitcnt lgkmcnt(0)" ::: "memory")
__device__ __forceinline__ float sigmoidf_(float x) { return __builtin_amdgcn_rcpf(1.f + __expf(-x)); }
__device__ __forceinline__ int perm32(int k) {
  int blk = k & ~31, r = k & 31;
  int p = (r < 16) ? (8 * (r >> 2) + (r & 3)) : (8 * ((r - 16) >> 2) + 4 + (r & 3));
  return blk + p;
}

__device__ __forceinline__ u32 fp8x4(float a, float b, float c, float d) {
  int w = __builtin_amdgcn_cvt_pk_fp8_f32(a, b, 0, false);
  w = __builtin_amdgcn_cvt_pk_fp8_f32(c, d, w, true);
  return (u32)w;
}
__device__ __forceinline__ int g8_logical_col(int t) { return ((t & 127) >> 5) * 64 + (t >> 7) * 32 + (t & 31); }
__device__ __forceinline__ int win_map(int n) {
  if (n < 512) return n;
  if (n < 1024) return 768 + (n - 512);
  if (n < 3072) return 1352 + (n - 1024);
  if (n < 5120) return 3408 + (n - 3072);
  if (n < 5248) return 512 + (n - 5120);
  if (n < 5376) return 640 + (n - 5248);
  if (n < 5440) return 1280 + (n - 5376);
  if (n < 5448) return 1344 + (n - 5440);
  if (n < 5452) return 3400 + (n - 5448);
  if (n < 5456) return 3404 + (n - 5452);
  return -1;
}
__device__ __forceinline__ void transpose_tile(const float* __restrict__ src, int Nsrc, u16* __restrict__ dst, int K, int k0, int n0,
                               bool mapped, bool perm8, float* tile  , float f8scale = 0.f) {
  const int tid = TIDX;
  {
    const int tx = tid & 63, ty = tid >> 6;
    int n = n0 + tx;
    if (perm8) n = (n & ~255) + g8_logical_col(n & 255);
    int sc = mapped ? win_map(n) : n;
#pragma unroll
    for (int i = 0; i < 8; ++i) {
      int k = ty + 8 * i;
      float v = (sc >= 0) ? src[(size_t)(k0 + k) * Nsrc + sc] : 0.f;
      tile[k * 65 + tx] = v;
    }
  }
  __syncthreads();
  {
    const int n = tid >> 3, kc = (tid & 7) * 8;
    if (f8scale != 0.f) {
      u32 w[2];
#pragma unroll
      for (int j = 0; j < 2; ++j)
        w[j] = fp8x4(tile[(kc + 4 * j) * 65 + n] * f8scale, tile[(kc + 4 * j + 1) * 65 + n] * f8scale,
                     tile[(kc + 4 * j + 2) * 65 + n] * f8scale, tile[(kc + 4 * j + 3) * 65 + n] * f8scale);
      *(uint2*)((unsigned char*)dst + (size_t)(n0 + n) * K + k0 + kc) = make_uint2(w[0], w[1]);
    } else {
    u32 w[4];
#pragma unroll
    for (int j = 0; j < 4; ++j) w[j] = pack2(tile[(kc + 2 * j) * 65 + n], tile[(kc + 2 * j + 1) * 65 + n]);
    *(uint4*)(dst + (size_t)(n0 + n) * K + k0 + kc) = make_uint4(w[0], w[1], w[2], w[3]);
    }
  }
  __syncthreads();
}

template <bool Q8, bool F8OUT = false>
__device__ __forceinline__ void rmsnorm_rows(const float* __restrict__ x, const float* __restrict__ gain, u16* __restrict__ out,
                                             unsigned char* __restrict__ q8, float* __restrict__ qs) {
  const int lane = TIDX & 63, wave = TIDX >> 6;
  float4 g[4];
#pragma unroll
  for (int i = 0; i < 4; ++i) g[i] = ((const float4*)gain)[lane + 64 * i];
  for (int row = blockIdx.x * 8 + wave; row < MTOK; row += gridDim.x * 8) {
    const float4* xr = (const float4*)(x + (size_t)row * DM);
    float4 v[4];
    float ss = 0.f;
#pragma unroll
    for (int i = 0; i < 4; ++i) {
      v[i] = xr[lane + 64 * i];
      ss += v[i].x * v[i].x + v[i].y * v[i].y + v[i].z * v[i].z + v[i].w * v[i].w;
    }
    ss = wave_sum_dpp(ss);
    float r = rsqrtf(ss * (1.f / DM) + EPS);
    float amax = 0.f;
#pragma unroll
    for (int i = 0; i < 4; ++i) {
      v[i].x *= r * g[i].x; v[i].y *= r * g[i].y; v[i].z *= r * g[i].z; v[i].w *= r * g[i].w;
      if (F8OUT) {
        *(u32*)((unsigned char*)out + (size_t)row * DM + 4 * (lane + 64 * i)) = fp8x4(2.f * v[i].x, 2.f * v[i].y, 2.f * v[i].z, 2.f * v[i].w);
      } else {
        uint2 o;
        o.x = pack2(v[i].x, v[i].y);
        o.y = pack2(v[i].z, v[i].w);
        *(uint2*)(out + (size_t)row * DM + 4 * (lane + 64 * i)) = o;
      }
      if (Q8) amax = fmaxf(amax, fmaxf(fmaxf(fabsf(v[i].x), fabsf(v[i].y)), fmaxf(fabsf(v[i].z), fabsf(v[i].w))));
    }
    if (Q8) {
      amax = wave_max_dpp(amax);
      const float inv = amax > 0.f ? 127.f / amax : 0.f;
#pragma unroll
      for (int i = 0; i < 4; ++i) {
        const int q0 = (int)rintf(v[i].x * inv), q1 = (int)rintf(v[i].y * inv), q2 = (int)rintf(v[i].z * inv), q3 = (int)rintf(v[i].w * inv);
        *(u32*)(q8 + (size_t)row * DM + 4 * (lane + 64 * i)) =
            (u32)(q0 & 0xff) | ((u32)(q1 & 0xff) << 8) | ((u32)(q2 & 0xff) << 16) | ((u32)(q3 & 0xff) << 24);
      }
      if (lane == 0) qs[row] = amax * (1.f / 127.f);
    }
  }
}

__device__ __forceinline__ void phase0(const Params& p, unsigned char* smem) {
  float* tile = (float*)smem;
  unsigned char* ws = p.ws;
  const int n_in = 16 * 88, n_a = 8 * 16, n_b = 8 * 16, n_o = 16 * 16, n_q = 16 * 32;
  const int total = n_in + n_a + n_b + n_o + n_q;
  for (int t = blockIdx.x; t < total; t += gridDim.x) {
    int i = t;
    if (i < n_in) { transpose_tile(p.in[2], 5456, (u16*)(ws + OFF_WTIN), 1024, (i / 88) * 64, (i % 88) * 64, true, true, tile, 32.f); continue; }
    i -= n_in;
    if (i < n_a) { transpose_tile(p.in[9], 1024, (u16*)(ws + OFF_WTA), 512, (i / 16) * 64, (i % 16) * 64, false, true, tile); continue; }
    i -= n_a;
    if (i < n_b) { transpose_tile(p.in[10], 1024, (u16*)(ws + OFF_WTB), 512, (i / 16) * 64, (i % 16) * 64, false, true, tile); continue; }
    i -= n_b;
    if (i < n_o) { transpose_tile(p.in[11], 1024, (u16*)(ws + OFF_WTO), 1024, (i / 16) * 64, (i % 16) * 64, false, true, tile); continue; }
    i -= n_o;
    transpose_tile(p.in[13], 2048, (u16*)(ws + OFF_WTQ), 1024, (i / 32) * 64, (i % 32) * 64, false, true, tile);
  }
  {
    const float* sk = p.in[14];
    u16* skb = (u16*)(ws + OFF_SKB);
    for (int i = blockIdx.x * NTHREADS + TIDX; i < 16 * 128 * 128; i += gridDim.x * NTHREADS) skb[i] = f2bf(sk[i]);
  }
  rmsnorm_rows<false, true>(p.in[0], p.in[1], (u16*)(ws + OFF_H), nullptr, nullptr);
}

constexpr int G_BM = 256, G_BN = 128, G_BK = 64;
constexpr int G_ABYTES = G_BM * 128;

template <int MI>
__device__ __forceinline__ void gemm_mainloop_t(const u16* __restrict__ A, int lda, const u16* __restrict__ Bt, int ldb, int K,
                                                int m0, int n0, unsigned char* smem, f32x4 (&acc)[MI][4]) {
  constexpr int BN = (MI == 4) ? 128 : 256;
  constexpr int NRB = BN / 64;
  constexpr int STAGE = G_ABYTES + BN * 128;
  const int tid = TIDX, lane = tid & 63, wave = tid >> 6;
  const int wm = (MI == 4) ? (wave >> 1) : (wave >> 2), wn = (MI == 4) ? (wave & 1) : (wave & 3);
#pragma unroll
  for (int i = 0; i < MI; ++i)
#pragma unroll
    for (int j = 0; j < 4; ++j) acc[i][j] = (f32x4){0.f, 0.f, 0.f, 0.f};
  const int kc = tid & 7;
  const int arow = tid >> 3;
  u32x4 ra[4], rb[NRB];
  const u16* ap = A + (size_t)(m0 + arow) * lda + kc * 8;
  const u16* bp = Bt + (size_t)(n0 + arow) * ldb + kc * 8;
  const int nk = K / G_BK;
  const int fr = lane & 15, fg = lane >> 4;
#define G_LOAD(kt_)                                                                       \
  {                                                                                       \
    const u16* ap2_ = ap + (size_t)(kt_) * G_BK;                                          \
    const u16* bp2_ = bp + (size_t)(kt_) * G_BK;                                          \
    _Pragma("unroll") for (int i = 0; i < 4; ++i) ra[i] = *(const u32x4*)(ap2_ + (size_t)(64 * i) * lda); \
    _Pragma("unroll") for (int i = 0; i < NRB; ++i) rb[i] = *(const u32x4*)(bp2_ + (size_t)(64 * i) * ldb); \
  }
#define G_STORE(st_)                                                                      \
  {                                                                                       \
    unsigned char* sa_ = smem + (st_) * STAGE;                                            \
    unsigned char* sb_ = sa_ + G_ABYTES;                                                  \
    _Pragma("unroll") for (int i = 0; i < 4; ++i) { int r = arow + 64 * i; *(u32x4*)(sa_ + r * 128 + ((kc ^ (r & 7)) << 4)) = ra[i]; } \
    _Pragma("unroll") for (int i = 0; i < NRB; ++i) { int r = arow + 64 * i; *(u32x4*)(sb_ + r * 128 + ((kc ^ (r & 7)) << 4)) = rb[i]; } \
  }
  G_LOAD(0)
  __syncthreads();
  G_STORE(0)
  if (nk > 1) G_LOAD(1)
  __syncthreads();
  for (int kt = 0; kt < nk; ++kt) {
    if (kt + 1 < nk) G_STORE((kt + 1) & 1)
    if (kt + 2 < nk) G_LOAD(kt + 2)
    __builtin_amdgcn_sched_barrier(0);
    const unsigned char* sa = smem + (kt & 1) * STAGE;
    const unsigned char* sb = sa + G_ABYTES;
#pragma unroll
    for (int kk = 0; kk < 2; ++kk) {
      bf16x8 bfr[4];
#pragma unroll
      for (int j = 0; j < 4; ++j) {
        int r = wn * 64 + j * 16 + fr;
        bfr[j] = *(const bf16x8*)(sb + r * 128 + (((kk * 4 + fg) ^ (r & 7)) << 4));
      }
#pragma unroll
      for (int ih = 0; ih < MI; ih += 4) {
        bf16x8 af[4];
#pragma unroll
        for (int i = 0; i < 4; ++i) {
          int r = wm * (MI * 16) + (ih + i) * 16 + fr;
          af[i] = *(const bf16x8*)(sa + r * 128 + (((kk * 4 + fg) ^ (r & 7)) << 4));
        }
#pragma unroll
        for (int i = 0; i < 4; ++i)
#pragma unroll
          for (int j = 0; j < 4; ++j) acc[ih + i][j] = __builtin_amdgcn_mfma_f32_16x16x32_bf16(af[i], bfr[j], acc[ih + i][j], 0, 0, 0);
        if (MI == 8 && ih == 0) __builtin_amdgcn_sched_barrier(0);
      }
    }
    __syncthreads();
  }
#undef G_LOAD
#undef G_STORE
}
__device__ __forceinline__ void gemm_mainloop(const u16* __restrict__ A, int lda, const u16* __restrict__ Bt, int ldb, int K,
                                              int m0, int n0, unsigned char* smem, f32x4 (&acc)[4][4]) {
  gemm_mainloop_t<4>(A, lda, Bt, ldb, K, m0, n0, smem, acc);
}

__device__ __forceinline__ int g8_lds_byte(int r, int c) {
  int st = (r >> 4) * 2 + (c >> 5), rr = r & 15, cc = c & 31, ob = rr * 64 + cc * 2;
  return st * 1024 + (ob ^ (((ob >> 9) & 1) << 5));
}
__device__ __forceinline__ void g8_stage_rc(int b, int& R, int& C) {
  int st = b / 1024, sb = b % 1024, swz = sb ^ (((sb >> 9) & 1) << 5);
  R = (st >> 1) * 16 + swz / 64; C = (st & 1) * 32 + (swz % 64) / 2;
}
typedef __attribute__((address_space(3))) unsigned int lds_u32;
template <int F8 = 0, int SC = 127>
__device__ __forceinline__ void gemm8_tile(const u16* __restrict__ A, const u16* __restrict__ Bt, int K, int brow, int bcol,
                                           unsigned char* smem, f32x4 (&acc)[2][2][4][2]) {
  typedef int i32x8_ __attribute__((ext_vector_type(8)));
  typedef int i32x4_ __attribute__((ext_vector_type(4)));
  constexpr int HTB = 16384;
  const int tid = TIDX;
  const int wid = tid >> 6, lane = tid & 63, wr = wid >> 2, wc = wid & 3, fr = lane & 15, fq = lane >> 4;
#define SA(b, h) (smem + ((b) * 2 + (h)) * HTB)
#define SB(b, h) (smem + (4 + (b) * 2 + (h)) * HTB)
  u32 soff0;
  { int _r, _c; g8_stage_rc(tid * 16, _r, _c); soff0 = (u32)(_r * K + _c) * 2u; }
  const int wbase = __builtin_amdgcn_readfirstlane(wid) * 1024;
#define STAGE(P, BASE, br, kt) do { \
    unsigned long long _uv0 = (unsigned long long)(BASE) + (unsigned long long)(((long)(br) * K + (long)(kt) * 64) * 2); \
    unsigned long long _uv1 = _uv0 + (unsigned long long)(64 * K * 2); \
    asm volatile("" : "+s"(_uv0), "+s"(_uv1), "+v"(soff0)); \
    __builtin_amdgcn_global_load_lds((const unsigned int*)((const unsigned char*)_uv0 + soff0), (lds_u32*)((P) + wbase), 16, 0, 0); \
    __builtin_amdgcn_global_load_lds((const unsigned int*)((const unsigned char*)_uv1 + soff0), (lds_u32*)((P) + wbase + 8192), 16, 0, 0); } while (0)
#define LDA(dst, b, h) _Pragma("unroll") for (int m = 0; m < 4; ++m) _Pragma("unroll") for (int k = 0; k < 2; ++k) \
    dst[m][k] = *(const bf16x8*)(SA(b, h) + g8_lds_byte(wr * 64 + m * 16 + fr, k * 32 + fq * 8))
#define LDB(dst, b, h) _Pragma("unroll") for (int n = 0; n < 2; ++n) _Pragma("unroll") for (int k = 0; k < 2; ++k) \
    dst[n][k] = *(const bf16x8*)(SB(b, h) + g8_lds_byte(wc * 32 + n * 16 + fr, k * 32 + fq * 8))
#define MMA(ai, bj, At_, Bt_) do { __builtin_amdgcn_s_setprio(1); \
    if (F8) { \
      _Pragma("unroll") for (int m = 0; m < 4; ++m) _Pragma("unroll") for (int n = 0; n < 2; ++n) \
          \
        asm volatile("v_mfma_scale_f32_16x16x128_f8f6f4 %0, %1, %2, %0, %3, %3 op_sel_hi:[0,0,0]" \
            : "+v"(acc[ai][bj][m][n]) \
            : "v"(__builtin_shufflevector((i32x4_)At_[m][0], (i32x4_)At_[m][1], 0, 1, 2, 3, 4, 5, 6, 7)), \
              "v"(__builtin_shufflevector((i32x4_)Bt_[n][0], (i32x4_)Bt_[n][1], 0, 1, 2, 3, 4, 5, 6, 7)), "v"(scv)); \
    } else { \
    _Pragma("unroll") for (int m = 0; m < 4; ++m) _Pragma("unroll") for (int n = 0; n < 2; ++n) _Pragma("unroll") for (int k = 0; k < 2; ++k) \
      acc[ai][bj][m][n] = __builtin_amdgcn_mfma_f32_16x16x32_bf16(At_[m][k], Bt_[n][k], acc[ai][bj][m][n], 0, 0, 0); \
    } \
    __builtin_amdgcn_s_setprio(0); } while (0)
#define WAIT_V(n) asm volatile("s_waitcnt vmcnt(" #n ")" ::: "memory")
#define WAIT_L(n) asm volatile("s_waitcnt lgkmcnt(" #n ")" ::: "memory")
#define BAR __builtin_amdgcn_s_barrier()
#define SCHED __builtin_amdgcn_sched_barrier(0)
#pragma unroll
  for (int a = 0; a < 2; ++a)
#pragma unroll
    for (int b2 = 0; b2 < 2; ++b2)
#pragma unroll
      for (int m = 0; m < 4; ++m)
#pragma unroll
        for (int n = 0; n < 2; ++n) acc[a][b2][m][n] = (f32x4){0.f, 0.f, 0.f, 0.f};
  bf16x8 At[4][2], B0[2][2], B1[2][2];
  const int scv = SC * 0x01010101;
  const int nt = K / 64;
  constexpr int HALF = 128;
  __syncthreads();
  STAGE(SB(0, 0), Bt, bcol, 0); STAGE(SA(0, 0), A, brow, 0);
  STAGE(SB(0, 1), Bt, bcol + HALF, 0); STAGE(SA(0, 1), A, brow + HALF, 0);
  if (wr == 1) BAR;
  WAIT_V(4); BAR;
  STAGE(SB(1, 0), Bt, bcol, 1); STAGE(SA(1, 0), A, brow, 1); STAGE(SB(1, 1), Bt, bcol + HALF, 1);
  WAIT_V(6); BAR;
#pragma unroll 1
  for (int t = 0; t < nt - 2; t += 2) {
    LDB(B0, 0, 0); SCHED; LDA(At, 0, 0); STAGE(SA(1, 1), A, brow + HALF, t + 1);
    WAIT_L(8); BAR; WAIT_L(0); MMA(0, 0, At, B0); BAR; SCHED;
    LDB(B1, 0, 1); STAGE(SB(0, 0), Bt, bcol, t + 2);
    BAR; WAIT_L(0); MMA(0, 1, At, B1); BAR;
    LDA(At, 0, 1); STAGE(SA(0, 0), A, brow, t + 2);
    BAR; WAIT_L(0); MMA(1, 0, At, B0); BAR; SCHED;
    STAGE(SB(0, 1), Bt, bcol + HALF, t + 2);
    WAIT_V(6); BAR; MMA(1, 1, At, B1); BAR;
    LDB(B0, 1, 0); SCHED; LDA(At, 1, 0); STAGE(SA(0, 1), A, brow + HALF, t + 2);
    WAIT_L(8); BAR; WAIT_L(0); MMA(0, 0, At, B0); BAR; SCHED;
    LDB(B1, 1, 1); STAGE(SB(1, 0), Bt, bcol, t + 3);
    BAR; WAIT_L(0); MMA(0, 1, At, B1); BAR;
    LDA(At, 1, 1); STAGE(SA(1, 0), A, brow, t + 3);
    BAR; WAIT_L(0); MMA(1, 0, At, B0); BAR; SCHED;
    STAGE(SB(1, 1), Bt, bcol + HALF, t + 3);
    WAIT_V(6); BAR; MMA(1, 1, At, B1); BAR;
  }
#define ACC_PIN() _Pragma("unroll") for (int a = 0; a < 2; ++a) _Pragma("unroll") for (int b2 = 0; b2 < 2; ++b2) \
      asm volatile("" : "+v"(acc[a][b2][0][0]), "+v"(acc[a][b2][0][1]), "+v"(acc[a][b2][1][0]), "+v"(acc[a][b2][1][1]), \
                        "+v"(acc[a][b2][2][0]), "+v"(acc[a][b2][2][1]), "+v"(acc[a][b2][3][0]), "+v"(acc[a][b2][3][1]))
  ACC_PIN();
  { LDB(B0, 0, 0); LDA(At, 0, 0); STAGE(SA(1, 1), A, brow + HALF, nt - 1);
    BAR; WAIT_L(0); MMA(0, 0, At, B0); BAR; SCHED;
    LDB(B1, 0, 1); BAR; WAIT_L(0); MMA(0, 1, At, B1); BAR; SCHED;
    LDA(At, 0, 1); WAIT_V(4); BAR; WAIT_L(0); MMA(1, 0, At, B0); SCHED; MMA(1, 1, At, B1); BAR; SCHED; }
  { LDB(B0, 1, 0); LDA(At, 1, 0); WAIT_V(2); BAR; WAIT_L(0); MMA(0, 0, At, B0); BAR; SCHED;
    LDB(B1, 1, 1); WAIT_V(0); BAR; WAIT_L(0); MMA(0, 1, At, B1); BAR; SCHED;
    LDA(At, 1, 1); BAR; WAIT_L(0); MMA(1, 0, At, B0); SCHED; MMA(1, 1, At, B1); BAR; SCHED; }
  ACC_PIN();
#undef ACC_PIN
  if (wr == 0) BAR;
#undef SA
#undef SB
#undef STAGE
#undef LDA
#undef LDB
#undef MMA
#undef WAIT_V
#undef WAIT_L
#undef BAR
#undef SCHED
}

template <int LD, bool NORM>
__device__ __forceinline__ void ep_store(u16* __restrict__ dst, u32 ob, const f32x4 (&acc)[2][2][4][2], const float* __restrict__ gain,
                                         float extra, unsigned char* smem, int wave, int lane_in) {
  int lane = lane_in;
  asm volatile("" : "+v"(lane));
  const int fr = lane & 15, fq = lane >> 4;
  unsigned char* reg = smem + wave * 16384;
  float gj[4] = {1.f, 1.f, 1.f, 1.f};
  if (NORM) {
#pragma unroll
    for (int j = 0; j < 4; ++j) gj[j] = gain[j * 16 + fr] * extra;
  }
  const int lrot = (fr >> 3) + 2 * fq;
  unsigned char* wbase = reg + (4 * fq) * 128 + (fr & 7) * 2;
#pragma unroll
  for (int ai = 0; ai < 2; ++ai)
#pragma unroll
    for (int m = 0; m < 4; ++m) {
#pragma unroll
      for (int r = 0; r < 4; ++r) {
        float rs = 1.f;
        if (NORM) {
          float sq = 0.f;
#pragma unroll
          for (int bj = 0; bj < 2; ++bj)
#pragma unroll
            for (int n = 0; n < 2; ++n) sq += acc[ai][bj][m][n][r] * acc[ai][bj][m][n][r];
          sq += DPPF(sq, 0xb1); sq += DPPF(sq, 0x4e); sq += DPPF(sq, 0x141); sq += DPPF(sq, 0x140);
          rs = rsqrtf(sq * (1.f / 64.f) + EPS);
        }
#pragma unroll
        for (int bj = 0; bj < 2; ++bj)
#pragma unroll
          for (int n = 0; n < 2; ++n) {
            const float v = acc[ai][bj][m][n][r];
            const int ch = ((bj * 2 + n) * 2 + lrot) & 7;
            *(u16*)(wbase + (ai * 64 + m * 16 + r) * 128 + (ch << 4)) = f2bf(NORM ? v * rs * gj[bj * 2 + n] : v);
          }
      }
      __builtin_amdgcn_sched_barrier(0);
    }
  WAVE_LDS_SYNC();
  const int c16 = lane & 7, r8 = lane >> 3;
#pragma unroll
  for (int it = 0; it < 16; ++it) {
    const int rw = it * 8 + r8;
    const u32x4 v = *(const u32x4*)(reg + rw * 128 + (((c16 + 2 * ((rw >> 2) & 3)) & 7) << 4));
    const int grow = (it >> 3) * 128 + (it & 7) * 8 + r8;
    *(u32x4*)(dst + ob + (u32)(grow * LD + c16 * 8)) = v;
    if ((it & 3) == 3) __builtin_amdgcn_sched_barrier(0);
  }
}

template <bool NORM>
__device__ __forceinline__ void ep_store8(unsigned char* __restrict__ dst, u32 ob, const f32x4 (&acc)[2][2][4][2],
                                          const float* __restrict__ gain, unsigned char* smem, int wave, int lane_in) {
  int lane = lane_in;
  asm volatile("" : "+v"(lane));
  const int fr = lane & 15, fq = lane >> 4;
  unsigned char* reg = smem + wave * 16384;
  float gj[4] = {1.f, 1.f, 1.f, 1.f};
  if (NORM) {
#pragma unroll
    for (int j = 0; j < 4; ++j) gj[j] = gain[j * 16 + fr];
  }
#pragma unroll
  for (int ai = 0; ai < 2; ++ai)
#pragma unroll
    for (int m = 0; m < 4; ++m) {
#pragma unroll
      for (int r = 0; r < 4; ++r) {
        float rs = 1.f;
        if (NORM) {
          float sq = 0.f;
#pragma unroll
          for (int bj = 0; bj < 2; ++bj)
#pragma unroll
            for (int n = 0; n < 2; ++n) sq += acc[ai][bj][m][n][r] * acc[ai][bj][m][n][r];
          sq += DPPF(sq, 0xb1); sq += DPPF(sq, 0x4e); sq += DPPF(sq, 0x141); sq += DPPF(sq, 0x140);
          rs = rsqrtf(sq * (1.f / 64.f) + EPS);
        }
        const int rw = ai * 64 + m * 16 + 4 * fq + r;
#pragma unroll
        for (int bj = 0; bj < 2; ++bj)
#pragma unroll
          for (int n = 0; n < 2; ++n) {
            const float v = NORM ? acc[ai][bj][m][n][r] * rs * gj[bj * 2 + n] : acc[ai][bj][m][n][r];
            reg[rw * 64 + ((((bj * 2 + n) + (rw >> 2)) & 3) << 4) + fr] =
                (unsigned char)(__builtin_amdgcn_cvt_pk_fp8_f32(v, v, 0, false) & 0xff);
          }
      }
      __builtin_amdgcn_sched_barrier(0);
    }
  WAVE_LDS_SYNC();
  const int c4 = lane & 3, r16 = lane >> 2;
#pragma unroll
  for (int it = 0; it < 8; ++it) {
    const int rw = it * 16 + r16;
    const u32x4 v = *(const u32x4*)(reg + rw * 64 + (((c4 + (rw >> 2)) & 3) << 4));
    const int grow = (rw >> 6) * 128 + (rw & 63);
    *(u32x4*)(dst + ob + (u32)(grow * 256 + c4 * 16)) = v;
  }
}

__device__ __forceinline__ void phase1(const Params& p, unsigned char* smem) {
  const u16* H = (const u16*)(p.ws + OFF_H);
  const u16* WT = (const u16*)(p.ws + OFF_WTIN);
  u16* PROJ = (u16*)(p.ws + OFF_PROJ);
  u16* KVC = (u16*)(p.ws + OFF_KVC);
  u16* IKC = (u16*)(p.ws + OFF_IKC);
  float* SMALL = (float*)(p.ws + OFF_SMALL);
  const int ntn = NPADW / 256;
  const int ntiles = (MTOK / 256) * ntn;
  for (int t = blockIdx.x; t < ntiles; t += gridDim.x) {
    const int m0 = (t / ntn) * 256, n0 = (t % ntn) * 256;
    f32x4 acc[2][2][4][2];
    gemm8_tile<1, 124>(H, WT, DM / 2, m0, n0, smem, acc);
    const int tid_e = TIDX, lane = tid_e & 63, wave = tid_e >> 6;
    const int wr = wave >> 2, wc = wave & 3, fr = lane & 15, fq = lane >> 4;
    const int cbase = n0 + wc * 64;
    const u32 rbase = (u32)(m0 + wr * 64);
    if (cbase < C_IQ) {
      ep_store<LDP, true>(PROJ, rbase * LDP + (u32)cbase, acc, p.in[3], 0.125f, smem, wave, lane);
    } else if (cbase < LDP) {
      ep_store<LDP, false>(PROJ, rbase * LDP + (u32)cbase, acc, nullptr, 1.f, smem, wave, lane);
    } else if (cbase < N_AV) {
      ep_store8<true>(p.ws + OFF_KVC, rbase * 256 + (u32)(cbase - N_AK), acc, p.in[4], smem, wave, lane);
    } else if (cbase < N_IK) {
      ep_store8<false>(p.ws + OFF_KVC, rbase * 256 + (u32)(cbase - N_AV + 128), acc, nullptr, smem, wave, lane);
    } else if (cbase < N_SM) {
      ep_store<64, false>(IKC, rbase * 64, acc, nullptr, 1.f, smem, wave, lane);
    } else if (cbase == N_SM) {
      const u32 sb0 = (rbase + 4 * fq) * 16 + (u32)fr;
#pragma unroll
      for (int ai = 0; ai < 2; ++ai)
#pragma unroll
        for (int m = 0; m < 4; ++m)
#pragma unroll
          for (int r = 0; r < 4; ++r) SMALL[sb0 + (u32)((ai * 128 + m * 16 + r) * 16)] = acc[ai][0][m][0][r];
    }
  }
}

constexpr int IDX_RS = 8208;

__device__ __forceinline__ u32 f2key(float x) {
  _Float16 h = (_Float16)x;
  u32 b = (u32) * (u16*)&h;
  return (b & 0x8000u) ? ((~b) & 0xffffu) : (b | 0x8000u);
}
__device__ __forceinline__ int count_ge_wave(const u32 (&kreg)[32], u32 mid, int ndw) {
  const u32 m1 = (mid - 1u) * 0x00010001u;
  const u32 one = 0x00010001u;
  u32 acc0 = 0u, acc1 = 0u;
#pragma unroll
  for (int c4 = 0; c4 < 8; ++c4) {
    if (c4 * 4 < ndw) {
#pragma unroll
      for (int i = c4 * 4; i < c4 * 4 + 4; i += 2) {
        u32 t0, t1;
        asm("v_pk_sub_u16 %0, %1, %2 clamp" : "=v"(t0) : "v"(kreg[i]), "s"(m1));
        asm("v_pk_sub_u16 %0, %1, %2 clamp" : "=v"(t1) : "v"(kreg[i + 1]), "s"(m1));
        asm("v_pk_min_u16 %0, %1, %2" : "=v"(t0) : "v"(t0), "s"(one));
        asm("v_pk_min_u16 %0, %1, %2" : "=v"(t1) : "v"(t1), "s"(one));
        asm("v_pk_add_u16 %0, %1, %2" : "=v"(acc0) : "v"(acc0), "v"(t0));
        asm("v_pk_add_u16 %0, %1, %2" : "=v"(acc1) : "v"(acc1), "v"(t1));
      }
    }
  }
  int c = (int)((acc0 & 0xffffu) + (acc0 >> 16) + (acc1 & 0xffffu) + (acc1 >> 16));
  return wave_sum_i_dpp(c);
}

__device__ __forceinline__ void idx_item(const Params& p, unsigned char* smem, int b, int tq) {
  const u16* PROJ = (const u16*)(p.ws + OFF_PROJ);
  const float* SMALL = (const float*)(p.ws + OFF_SMALL);
  u16* SEL = (u16*)(p.ws + OFF_SEL);
  const int tid = TIDX, lane = tid & 63, wave = tid >> 6;
  const int t0 = tq * 16;
  const size_t tokb = (size_t)b * SEQ;
  if (tq < 16) {
    for (int rr = 0; rr < 2; ++rr) {
      int row = 2 * wave + rr, t = t0 + row;
      u16* out = SEL + (tokb + t) * 256;
      for (int i = lane; i < 256; i += 64) out[i] = (i <= t) ? (u16)i : (u16)0xFFFF;
    }
    return;
  }
  const int q = lane & 15, g = lane >> 4;
  __syncthreads();
  {
    const u16* iqrow = PROJ + (tokb + t0 + q) * LDP + C_IQ;
    bf16x8 bq[8][2];
    float wq[8];
#pragma unroll
    for (int h = 0; h < 8; ++h) {
      bq[h][0] = *(const bf16x8*)(iqrow + h * 64 + g * 8);
      bq[h][1] = *(const bf16x8*)(iqrow + h * 64 + 32 + g * 8);
      wq[h] = SMALL[(tokb + t0 + q) * 16 + h];
    }
    const int nkb = tq + 1;
    const int niter = (nkb > wave) ? ((nkb - wave + 7) >> 3) : 0;
    const u16* ikbase = (const u16*)(p.ws + OFF_IKC) + (tokb + q) * 64 + g * 8;
    bf16x8 ca[3][2];
#pragma unroll
    for (int j = 0; j < 3; ++j)
      if (j < niter) {
        const u16* ikrow = ikbase + (size_t)((wave + 8 * j) * 16) * 64;
        ca[j][0] = *(const bf16x8*)(ikrow); ca[j][1] = *(const bf16x8*)(ikrow + 32);
      }
    for (int i0 = 0; i0 < ((p.flags & 8) ? 0 : niter); i0 += 3) {
#pragma unroll
      for (int j = 0; j < 3; ++j) {
        if (i0 + j < niter) {
          const int s0 = (wave + 8 * (i0 + j)) * 16;
          f32x4 tot = {0.f, 0.f, 0.f, 0.f};
#pragma unroll
          for (int h = 0; h < 8; ++h) {
            f32x4 acc = {0.f, 0.f, 0.f, 0.f};
            acc = __builtin_amdgcn_mfma_f32_16x16x32_bf16(ca[j][0], bq[h][0], acc, 0, 0, 0);
            acc = __builtin_amdgcn_mfma_f32_16x16x32_bf16(ca[j][1], bq[h][1], acc, 0, 0, 0);
#pragma unroll
            for (int r = 0; r < 4; ++r) tot[r] += wq[h] * fmaxf(acc[r], 0.f);
          }
          if (i0 + 3 + j < niter) {
            const u16* ikrow = ikbase + (size_t)((wave + 8 * (i0 + 3 + j)) * 16) * 64;
            ca[j][0] = *(const bf16x8*)(ikrow); ca[j][1] = *(const bf16x8*)(ikrow + 32);
          }
          u32 k[4];
#pragma unroll
          for (int r = 0; r < 4; ++r) {
            int sidx = s0 + 4 * g + r;
            k[r] = (sidx <= t0 + q) ? f2key(tot[r]) : 0u;
          }
          u32x2 w2 = {k[0] | (k[1] << 16), k[2] | (k[3] << 16)};
          *(u32x2*)(smem + q * IDX_RS + (s0 + 4 * g) * 2) = w2;
        }
        __builtin_amdgcn_sched_barrier(0);
      }
    }
    const int nk = t0 + 16, nk64 = (nk + 511) & ~511;
    for (int i = tid; i < 16 * (nk64 - nk); i += NTHREADS) {
      int row = i / (nk64 - nk), c = nk + i % (nk64 - nk);
      *(u16*)(smem + row * IDX_RS + c * 2) = 0;
    }
  }
  __syncthreads();
  const int ndw = ((t0 + 16 + 511) >> 9) << 2;
  for (int rr = 0; rr < ((p.flags & 16) ? 0 : 2); ++rr) {
    const int row = 2 * wave + rr, t = t0 + row;
    u16* out = SEL + (tokb + t) * 256;
    u32 kreg[32];
    {
      const u32* src = (const u32*)(smem + row * IDX_RS) + lane;
#pragma unroll
      for (int c4 = 0; c4 < 8; ++c4)
        if (c4 * 4 < ndw) {
#pragma unroll
          for (int i = c4 * 4; i < c4 * 4 + 4; ++i) kreg[i] = src[i * 64];
        }
    }
    WAVE_LDS_SYNC();
    u32 lo = 1u, hi = 65535u;
    while (lo < hi) {
      u32 mid = (lo + hi + 1u) >> 1;
      int c = count_ge_wave(kreg, mid, ndw);
      if (c >= 256) lo = mid; else hi = mid - 1u;
    }
    const u32 tau = lo;
    int gt = 0, eq = 0;
#pragma unroll
    for (int c4 = 0; c4 < 8; ++c4)
      if (c4 * 4 < ndw) {
#pragma unroll
        for (int i = c4 * 4; i < c4 * 4 + 4; ++i) {
          u32 a = kreg[i] & 0xffffu, c2 = kreg[i] >> 16;
          gt += (a > tau) ? 1 : 0; gt += (c2 > tau) ? 1 : 0;
          eq += (a == tau) ? 1 : 0; eq += (c2 == tau) ? 1 : 0;
        }
      }
    int packed = gt | (eq << 16);
    int incl = packed;
#pragma unroll
    for (int o = 1; o < 64; o <<= 1) {
      int v = __shfl_up(incl, o);
      if (lane >= o) incl += v;
    }
    const int excl = incl - packed;
    const int total = __shfl(incl, 63);
    const int need = 256 - (total & 0xffff);
    const int pg = excl & 0xffff, pe = excl >> 16;
    int pos = pg + min(pe, need);
    int eqseen = pe;
    u16* lrow = (u16*)(smem + row * IDX_RS);
#pragma unroll
    for (int c4 = 0; c4 < 8; ++c4)
      if (c4 * 4 < ndw) {
#pragma unroll
        for (int i = c4 * 4; i < c4 * 4 + 4; ++i) {
#pragma unroll
          for (int hh = 0; hh < 2; ++hh) {
            u32 kv = hh ? (kreg[i] >> 16) : (kreg[i] & 0xffffu);
            int idx = 128 * i + 2 * lane + hh;
            bool take = false;
            if (kv > tau) take = true;
            else if (kv == tau) { take = (eqseen < need); ++eqseen; }
            if (take) { lrow[pos] = (u16)idx; ++pos; }
          }
        }
      }
    WAVE_LDS_SYNC();
    *(u32x2*)(out + lane * 4) = *(const u32x2*)(lrow + lane * 4);
    WAVE_LDS_SYNC();
  }
}

constexpr int DNP = 68;
constexpr int DL_KT = 0;
constexpr int DL_V = DL_KT + 128 * DNP * 4;
constexpr int DL_QB = DL_V + 64 * 128 * 4;
constexpr int DL_KB = DL_QB + 64 * 272;
constexpr int DL_SM = DL_KB + 64 * 272;
constexpr int DL_RAW = DL_SM + 2048;
static_assert(DL_RAW + 3 * 67 * 272 <= SMEM_BYTES && 16384 + 64 * 144 + 2048 <= 3 * 67 * 272, "dn_local LDS");
__device__ __forceinline__ void dn_local_item(const Params& p, unsigned char* smem, int item) {
  const int h = item & 3, n = (item >> 2) & 63, b = item >> 8;
  const u16* PROJ = (const u16*)(p.ws + OFF_PROJ);
  const float* SMALL = (const float*)(p.ws + OFF_SMALL);
  u16* Ug = (u16*)((unsigned char*)p.out + DO_U);
  u16* Wg = (u16*)((unsigned char*)p.out + DO_W);
  u16* QNg = (u16*)((unsigned char*)p.out + DO_QN);
  u16* KNTg = (u16*)((unsigned char*)p.out + DO_KNT);
  u16* ATTg = (u16*)(p.ws + OFF_ATT);
  float* GCg = (float*)(p.ws + OFF_GC);
  const float* convw = p.in[5];
  const int tid = TIDX, lane = tid & 63, wave = tid >> 6;
  const int c0 = n * 64;
  const size_t tok0 = (size_t)b * SEQ + c0;
  float* Kt = (float*)(smem + DL_KT);
  float* V = (float*)(smem + DL_V);
  unsigned char* Qb = smem + DL_QB;
  unsigned char* Kb = smem + DL_KB;
  float* gc = (float*)(smem + DL_SM);
  float* beta = gc + 64;
  float* ssp = beta + 64;
  unsigned char* RAW = smem + DL_RAW;
  float* AmT = (float*)(smem + DL_RAW);
  __syncthreads();
  {
    u32x4 rg[7];
#pragma unroll
    for (int k = 0; k < 7; ++k) {
      const int ci = tid + 512 * k;
      rg[k] = (u32x4){0u, 0u, 0u, 0u};
      if (ci < 3216) {
        const int arr = ci / 1072, rem = ci - arr * 1072, row = rem >> 4, ch = rem & 15;
        const int trel = c0 - 3 + row;
        if (trel >= 0)
          rg[k] = *(const u32x4*)(PROJ + ((size_t)b * SEQ + trel) * LDP + (C_DQ + arr * 512) + h * 128 + ch * 8);
      }
    }
#pragma unroll
    for (int k = 0; k < 7; ++k) {
      const int ci = tid + 512 * k;
      if (ci < 3216) {
        const int arr = ci / 1072, rem = ci - arr * 1072, row = rem >> 4, ch = rem & 15;
        *(u32x4*)(RAW + (arr * 67 + row) * 272 + ch * 16) = rg[k];
      }
    }
  }
  if (tid < 64) {
    float da = SMALL[(tok0 + tid) * 16 + 8 + h], db = SMALL[(tok0 + tid) * 16 + 12 + h];
    float xx = da + p.in[7][h];
    float sp = fmaxf(xx, 0.f) + log1pf(__expf(-fabsf(xx)));
    float gr = -__expf(p.in[6][h]) * sp;
    float incl = gr;
#pragma unroll
    for (int o = 1; o < 64; o <<= 1) {
      float v = __shfl_up(incl, o);
      if (lane >= o) incl += v;
    }
    gc[tid] = incl;
    beta[tid] = sigmoidf_(db);
    GCg[(tok0 + tid) * 4 + h] = incl;
  }
  __syncthreads();
  {
    const int c = tid & 127, tg = tid >> 7;
    float qv[16], kv[16];
#pragma unroll
    for (int arr = 0; arr < 3; ++arr) {
      const float w0 = convw[0 * 1536 + arr * 512 + h * 128 + c], w1 = convw[1 * 1536 + arr * 512 + h * 128 + c],
                  w2 = convw[2 * 1536 + arr * 512 + h * 128 + c], w3 = convw[3 * 1536 + arr * 512 + h * 128 + c];
      const unsigned char* rp = RAW + (arr * 67 + tg * 16) * 272 + c * 2;
      float x0 = bf2f(*(const u16*)(rp)), x1 = bf2f(*(const u16*)(rp + 272)), x2 = bf2f(*(const u16*)(rp + 2 * 272));
#pragma unroll
      for (int ii = 0; ii < 16; ++ii) {
        const float x3 = bf2f(*(const u16*)(rp + (ii + 3) * 272));
        const float y = w0 * x0 + w1 * x1 + w2 * x2 + w3 * x3;
        const float sv = y * sigmoidf_(y);
        if (arr == 0) qv[ii] = sv;
        else if (arr == 1) kv[ii] = sv;
        else V[(tg * 16 + ii) * 128 + c] = sv;
        x0 = x1; x1 = x2; x2 = x3;
      }
    }
#pragma unroll
    for (int ii = 0; ii < 16; ++ii) {
      const float sq = wave_sum_dpp(qv[ii] * qv[ii]);
      const float sk = wave_sum_dpp(kv[ii] * kv[ii]);
      if (lane == 0) {
        ssp[((tg * 16 + ii) * 2) + (wave & 1)] = sq;
        ssp[128 + ((tg * 16 + ii) * 2) + (wave & 1)] = sk;
      }
    }
    __syncthreads();
#pragma unroll
    for (int ii = 0; ii < 16; ++ii) {
      const int i = tg * 16 + ii;
      const float qsc = rsqrtf(ssp[i * 2] + ssp[i * 2 + 1] + EPS) * 0.08838834764831845f;
      const float ksc = rsqrtf(ssp[128 + i * 2] + ssp[128 + i * 2 + 1] + EPS);
      const float qn = qv[ii] * qsc, kn = kv[ii] * ksc;
      *(u16*)(Qb + i * 272 + c * 2) = f2bf(qn);
      *(u16*)(Kb + i * 272 + c * 2) = f2bf(kn);
      Kt[c * DNP + i] = kn;
    }
  }
  __syncthreads();
#pragma unroll
  for (int k = 0; k < 4; ++k) {
    const int gi = tid + 512 * k;
    {
      const int i = gi >> 5, d4 = (gi & 31) * 4;
      const u32x2 v = *(const u32x2*)(Qb + i * 272 + d4 * 2);
      *(u32x2*)(QNg + (tok0 + i) * 512 + h * 128 + perm32(d4)) = v;
    }
    {
      const int d = gi >> 4, t4 = (gi & 15) * 4;
      const f32x4 v = *(const f32x4*)(Kt + d * DNP + t4);
      u32x2 o = {pack2(v[0], v[1]), pack2(v[2], v[3])};
      *(u32x2*)(KNTg + (size_t)item * 8192 + d * 64 + perm32(t4)) = o;
    }
  }
  {
    const int mat = wave >> 2, it = wave & 3;
    const int fr = lane & 15, fg = lane >> 4;
    const unsigned char* Ab = mat ? Qb : Kb;
    bf16x8 af[4];
#pragma unroll
    for (int kk = 0; kk < 4; ++kk) af[kk] = *(const bf16x8*)(Ab + (it * 16 + fr) * 272 + kk * 64 + fg * 16);
    f32x4 gi4 = *(const f32x4*)(gc + it * 16 + 4 * fg);
    f32x4 bi4 = *(const f32x4*)(beta + it * 16 + 4 * fg);
#pragma unroll
    for (int jt = 0; jt < 4; ++jt) {
      f32x4 acc = {0.f, 0.f, 0.f, 0.f};
      if (jt <= it) {
#pragma unroll
        for (int kk = 0; kk < 4; ++kk) {
          bf16x8 bfg = *(const bf16x8*)(Kb + (jt * 16 + fr) * 272 + kk * 64 + fg * 16);
          acc = __builtin_amdgcn_mfma_f32_16x16x32_bf16(af[kk], bfg, acc, 0, 0, 0);
        }
      }
      const int j = jt * 16 + fr;
      const float gj = gc[j];
#pragma unroll
      for (int r = 0; r < 4; ++r) {
        const int i = it * 16 + 4 * fg + r;
        const float dec = __expf(fminf(gi4[r] - gj, 0.f));
        if (mat == 0) { if (jt <= it) AmT[j * 64 + i] = (i > j) ? bi4[r] * acc[r] * dec : 0.f; }
        else ATTg[(size_t)item * 4096 + i * 64 + perm32(j)] = f2bf((i >= j) ? acc[r] * dec : 0.f);
      }
    }
  }
  __syncthreads();
  u16* nA = (u16*)(smem + DL_RAW + 16384);
  u16* Nb = (u16*)(smem + DL_RAW + 16384 + 64 * 144);
  {
#pragma unroll
    for (int k = 0; k < 8; ++k) {
      const int e = tid + 512 * k;
      const int i = e >> 6, j = e & 63;
      const float v = ((j >> 4) < (i >> 4)) ? -AmT[j * 64 + i] : 0.f;
      nA[i * 72 + j] = f2bf(v);
    }
    if (tid < 64) {
      const int bb = tid >> 4, j = tid & 15;
      float nn[16];
#pragma unroll
      for (int i = 0; i < 16; ++i) {
        float sacc = 0.f;
#pragma unroll
        for (int k = 0; k < i; ++k) sacc += AmT[(bb * 16 + k) * 64 + bb * 16 + i] * nn[k];
        nn[i] = (i == j) ? 1.f : ((i > j) ? -sacc : 0.f);
      }
#pragma unroll
      for (int i = 0; i < 16; ++i) Nb[bb * 256 + i * 16 + j] = f2bf(nn[i]);
    }
  }
  __syncthreads();
  {
    const int fr = lane & 15, fg = lane >> 4;
    f32x4 X[2][4];
#pragma unroll
    for (int ct2 = 0; ct2 < 2; ++ct2) {
      const int c = (wave * 2 + ct2) * 16 + fr;
      const bool isu = c < 128;
      const int cc = c & 127;
#pragma unroll
      for (int bb = 0; bb < 4; ++bb) {
        f32x4 acc;
#pragma unroll
        for (int r = 0; r < 4; ++r) {
          const int i = bb * 16 + 4 * fg + r;
          acc[r] = isu ? V[i * 128 + cc] * beta[i] : Kt[cc * DNP + i] * beta[i] * __expf(gc[i]);
        }
        if (bb >= 1) {
          union { u32 w[4]; bf16x8 v; } af, bf;
          const u32x2 a0 = *(const u32x2*)(nA + (bb * 16 + fr) * 72 + 4 * fg);
          af.w[0] = a0[0]; af.w[1] = a0[1];
          bf.w[0] = pack2(X[ct2][0][0], X[ct2][0][1]); bf.w[1] = pack2(X[ct2][0][2], X[ct2][0][3]);
          if (bb >= 2) {
            const u32x2 a1 = *(const u32x2*)(nA + (bb * 16 + fr) * 72 + 16 + 4 * fg);
            af.w[2] = a1[0]; af.w[3] = a1[1];
            bf.w[2] = pack2(X[ct2][1][0], X[ct2][1][1]); bf.w[3] = pack2(X[ct2][1][2], X[ct2][1][3]);
          } else { af.w[2] = 0u; af.w[3] = 0u; bf.w[2] = 0u; bf.w[3] = 0u; }
          acc = __builtin_amdgcn_mfma_f32_16x16x32_bf16(af.v, bf.v, acc, 0, 0, 0);
          if (bb == 3) {
            const u32x2 a2 = *(const u32x2*)(nA + (bb * 16 + fr) * 72 + 32 + 4 * fg);
            af.w[0] = a2[0]; af.w[1] = a2[1]; af.w[2] = 0u; af.w[3] = 0u;
            bf.w[0] = pack2(X[ct2][2][0], X[ct2][2][1]); bf.w[1] = pack2(X[ct2][2][2], X[ct2][2][3]); bf.w[2] = 0u; bf.w[3] = 0u;
            acc = __builtin_amdgcn_mfma_f32_16x16x32_bf16(af.v, bf.v, acc, 0, 0, 0);
          }
        }
        {
          union { u32 w[4]; bf16x8 v; } af, bf;
          const u32x2 d0 = *(const u32x2*)(Nb + bb * 256 + fr * 16 + 4 * fg);
          af.w[0] = d0[0]; af.w[1] = d0[1]; af.w[2] = 0u; af.w[3] = 0u;
          bf.w[0] = pack2(acc[0], acc[1]); bf.w[1] = pack2(acc[2], acc[3]); bf.w[2] = 0u; bf.w[3] = 0u;
          const f32x4 z4 = {0.f, 0.f, 0.f, 0.f};
          X[ct2][bb] = __builtin_amdgcn_mfma_f32_16x16x32_bf16(af.v, bf.v, z4, 0, 0, 0);
        }
#pragma unroll
        for (int r = 0; r < 4; ++r) {
          const int i = bb * 16 + 4 * fg + r;
          if (isu) Ug[(tok0 + i) * 512 + h * 128 + cc] = f2bf(X[ct2][bb][r]);
          else Wg[(tok0 + i) * 512 + h * 128 + perm32(cc)] = f2bf(X[ct2][bb][r]);
        }
      }
    }
  }
}

__device__ __forceinline__ void phase2(const Params& p, unsigned char* smem) {
#ifndef NO_IDX
  for (int i = blockIdx.x; i < 2048; i += gridDim.x) idx_item(p, smem, i & 7, 255 - (i >> 3));
#endif
#ifndef NO_DNL
  if (!(p.flags & 1))
    for (int i = blockIdx.x; i < 2048; i += gridDim.x) dn_local_item(p, smem, i);
#endif
}

constexpr int SC_WP = 272, SC_KP = 144;
constexpr int SC_W = 0, SC_Q = 64 * SC_WP, SC_KT = 2 * 64 * SC_WP, SC_AT = SC_KT + 128 * SC_KP, SC_U = SC_AT + 64 * SC_KP,
              SC_BUF = SC_U + 64 * SC_WP;
constexpr int SC_GC = 2 * SC_BUF;
static_assert(SC_GC + 2 * 64 * 4 <= SMEM_BYTES, "scan LDS");

__device__ __forceinline__ void dn_scan_item(const Params& p, unsigned char* smem, int bh) {
  const int h = bh & 3, b = bh >> 2;
  const u16* Ug = (const u16*)((const unsigned char*)p.out + DO_U);
  const u16* Wg = (const u16*)((const unsigned char*)p.out + DO_W);
  const u16* QNg = (const u16*)((const unsigned char*)p.out + DO_QN);
  const u16* KNTg = (const u16*)((const unsigned char*)p.out + DO_KNT);
  const u16* ATTg = (const u16*)(p.ws + OFF_ATT);
  const float* GCg = (const float*)(p.ws + OFF_GC);
  const u16* PROJ = (const u16*)(p.ws + OFF_PROJ);
  u16* YDN = (u16*)(p.ws + OFF_YDN);
  const float* ogain = p.in[8];
  const int tid = TIDX, lane = tid & 63, wave = tid >> 6;
  const int fr = lane & 15, fg = lane >> 4;
  const int ecol = wave * 16 + fr;
  float* gcs = (float*)(smem + SC_GC);
  f32x4 S[8];
#pragma unroll
  for (int d = 0; d < 8; ++d) S[d] = (f32x4){0.f, 0.f, 0.f, 0.f};
  u32x4 st[9];
  float gcr = 0.f;
  const int r16 = tid >> 4, c16 = tid & 15;
  const int r8 = tid >> 3, c8 = tid & 7;
#define SCAN_LOAD(n_)                                                                                      \
  {                                                                                                        \
    const size_t tk0 = (size_t)b * SEQ + (size_t)(n_) * 64;                                                \
    const size_t it_ = (size_t)((b * 64 + (n_)) * 4 + h);                                                  \
    st[0] = *(const u32x4*)(Wg + (tk0 + r16) * 512 + h * 128 + c16 * 8);                                   \
    st[1] = *(const u32x4*)(Wg + (tk0 + r16 + 32) * 512 + h * 128 + c16 * 8);                              \
    st[2] = *(const u32x4*)(QNg + (tk0 + r16) * 512 + h * 128 + c16 * 8);                                  \
    st[3] = *(const u32x4*)(QNg + (tk0 + r16 + 32) * 512 + h * 128 + c16 * 8);                             \
    st[4] = *(const u32x4*)(KNTg + it_ * 8192 + (size_t)tid * 8);                                          \
    st[5] = *(const u32x4*)(KNTg + it_ * 8192 + (size_t)(tid + 512) * 8);                                  \
    st[6] = *(const u32x4*)(ATTg + it_ * 4096 + (size_t)tid * 8);                                          \
    st[7] = *(const u32x4*)(Ug + (tk0 + r16) * 512 + h * 128 + c16 * 8);                                   \
    st[8] = *(const u32x4*)(Ug + (tk0 + r16 + 32) * 512 + h * 128 + c16 * 8);                              \
    if (tid < 64) gcr = GCg[(tk0 + tid) * 4 + h];                                                          \
  }
#define SCAN_STORE(buf_)                                                                                   \
  {                                                                                                        \
    unsigned char* bs_ = smem + (buf_) * SC_BUF;                                                           \
    *(u32x4*)(bs_ + SC_W + r16 * SC_WP + c16 * 16) = st[0];                                                \
    *(u32x4*)(bs_ + SC_W + (r16 + 32) * SC_WP + c16 * 16) = st[1];                                         \
    *(u32x4*)(bs_ + SC_Q + r16 * SC_WP + c16 * 16) = st[2];                                                \
    *(u32x4*)(bs_ + SC_Q + (r16 + 32) * SC_WP + c16 * 16) = st[3];                                         \
    *(u32x4*)(bs_ + SC_KT + r8 * SC_KP + c8 * 16) = st[4];                                                 \
    *(u32x4*)(bs_ + SC_KT + (r8 + 64) * SC_KP + c8 * 16) = st[5];                                          \
    *(u32x4*)(bs_ + SC_AT + r8 * SC_KP + c8 * 16) = st[6];                                                 \
    *(u32x4*)(bs_ + SC_U + r16 * SC_WP + c16 * 16) = st[7];                                                \
    *(u32x4*)(bs_ + SC_U + (r16 + 32) * SC_WP + c16 * 16) = st[8];                                         \
    if (tid < 64) gcs[(buf_) * 64 + tid] = gcr;                                                            \
  }
  __syncthreads();
  SCAN_LOAD(0)
  SCAN_STORE(0)
  if (1 < 64) SCAN_LOAD(1)
  __syncthreads();
  for (int n = 0; n < 64; ++n) {
    const int buf = n & 1;
    const size_t tok0 = (size_t)b * SEQ + n * 64;
    if (n + 1 < 64) SCAN_STORE(buf ^ 1)
    if (n + 2 < 64) SCAN_LOAD(n + 2)
    __builtin_amdgcn_sched_barrier(0);
    const unsigned char* base = smem + buf * SC_BUF;
    const u32 ub0 = (u32)(tok0 + 4 * fg) * 512 + (u32)(h * 128 + ecol);
    const float* gcb = gcs + buf * 64 + 4 * fg;
    const float glast = gcs[buf * 64 + 63];
    bf16x8 Sb[4];
#pragma unroll
    for (int kk = 0; kk < 4; ++kk) {
      union { u32 w[4]; bf16x8 v; } cv;
      cv.w[0] = pack2(S[2 * kk][0], S[2 * kk][1]); cv.w[1] = pack2(S[2 * kk][2], S[2 * kk][3]);
      cv.w[2] = pack2(S[2 * kk + 1][0], S[2 * kk + 1][1]); cv.w[3] = pack2(S[2 * kk + 1][2], S[2 * kk + 1][3]);
      Sb[kk] = cv.v;
    }
    f32x4 vnew[4], ov[4];
#pragma unroll
    for (int m = 0; m < 4; ++m) {
      f32x4 aw = {0.f, 0.f, 0.f, 0.f}, aq = {0.f, 0.f, 0.f, 0.f};
#pragma unroll
      for (int kk = 0; kk < 4; ++kk) {
        bf16x8 wf = *(const bf16x8*)(base + SC_W + (m * 16 + fr) * SC_WP + kk * 64 + fg * 16);
        bf16x8 qf = *(const bf16x8*)(base + SC_Q + (m * 16 + fr) * SC_WP + kk * 64 + fg * 16);
        aw = __builtin_amdgcn_mfma_f32_16x16x32_bf16(wf, Sb[kk], aw, 0, 0, 0);
        aq = __builtin_amdgcn_mfma_f32_16x16x32_bf16(qf, Sb[kk], aq, 0, 0, 0);
      }
      f32x4 g4 = *(const f32x4*)(gcb + m * 16);
#pragma unroll
      for (int r = 0; r < 4; ++r) {
        float uv = bf2f(*(const u16*)(base + SC_U + (m * 16 + 4 * fg + r) * SC_WP + ecol * 2));
        vnew[m][r] = uv - aw[r];
        ov[m][r] = aq[r] * __expf(g4[r]);
      }
    }
    bf16x8 vb[2], vsb[2];
#pragma unroll
    for (int k2 = 0; k2 < 2; ++k2) {
      union { u32 w[4]; bf16x8 v; } c1, c2;
      const int ma = 2 * k2, mb = 2 * k2 + 1;
      c1.w[0] = pack2(vnew[ma][0], vnew[ma][1]); c1.w[1] = pack2(vnew[ma][2], vnew[ma][3]);
      c1.w[2] = pack2(vnew[mb][0], vnew[mb][1]); c1.w[3] = pack2(vnew[mb][2], vnew[mb][3]);
      f32x4 ga4 = *(const f32x4*)(gcb + ma * 16), gb4 = *(const f32x4*)(gcb + mb * 16);
      float sa[4], sb2[4];
#pragma unroll
      for (int r = 0; r < 4; ++r) { sa[r] = vnew[ma][r] * __expf(glast - ga4[r]); sb2[r] = vnew[mb][r] * __expf(glast - gb4[r]); }
      c2.w[0] = pack2(sa[0], sa[1]); c2.w[1] = pack2(sa[2], sa[3]);
      c2.w[2] = pack2(sb2[0], sb2[1]); c2.w[3] = pack2(sb2[2], sb2[3]);
      vb[k2] = c1.v; vsb[k2] = c2.v;
    }
    const float egl = __expf(glast);
#pragma unroll
    for (int d = 0; d < 8; ++d) {
      f32x4 a = S[d] * egl;
#pragma unroll
      for (int k2 = 0; k2 < 2; ++k2) {
        bf16x8 kf = *(const bf16x8*)(base + SC_KT + (d * 16 + fr) * SC_KP + k2 * 64 + fg * 16);
        a = __builtin_amdgcn_mfma_f32_16x16x32_bf16(kf, vsb[k2], a, 0, 0, 0);
      }
      S[d] = a;
    }
#pragma unroll
    for (int m = 0; m < 4; ++m) {
      f32x4 ao = ov[m];
#pragma unroll
      for (int k2 = 0; k2 < 2; ++k2) {
        bf16x8 af = *(const bf16x8*)(base + SC_AT + (m * 16 + fr) * SC_KP + k2 * 64 + fg * 16);
        ao = __builtin_amdgcn_mfma_f32_16x16x32_bf16(af, vb[k2], ao, 0, 0, 0);
      }
#pragma unroll
      for (int r = 0; r < 4; ++r) YDN[ub0 + (u32)((m * 16 + r) * 512)] = f2bf(ao[r]);
    }
    __syncthreads();
  }
#undef SCAN_LOAD
#undef SCAN_STORE
  asm volatile("s_waitcnt vmcnt(0)" ::: "memory");
  __syncthreads();
  {
    const int sub = lane >> 4, l16 = lane & 15;
    float gn8[8];
#pragma unroll
    for (int e = 0; e < 8; ++e) gn8[e] = ogain[l16 * 8 + e];
    for (int t = wave * 4 + sub; t < SEQ; t += 32) {
      const size_t tok = (size_t)b * SEQ + t;
      u16* yp = YDN + tok * 512 + h * 128 + l16 * 8;
      const u32x4 ov4 = *(const u32x4*)yp;
      const u32x4 zv4 = *(const u32x4*)(PROJ + tok * LDP + C_DZ + h * 128 + l16 * 8);
      float o8[8], z8[8];
#pragma unroll
      for (int c = 0; c < 4; ++c) { o8[2 * c] = bflo(ov4[c]); o8[2 * c + 1] = bfhi(ov4[c]); z8[2 * c] = bflo(zv4[c]); z8[2 * c + 1] = bfhi(zv4[c]); }
      float sq = 0.f;
#pragma unroll
      for (int e = 0; e < 8; ++e) sq += o8[e] * o8[e];
      sq += DPPF(sq, 0xb1); sq += DPPF(sq, 0x4e); sq += DPPF(sq, 0x141); sq += DPPF(sq, 0x140);
      const float rstd = rsqrtf(sq * (1.f / 128.f) + EPS);
      u32 w[4];
#pragma unroll
      for (int c = 0; c < 4; ++c) {
        const float y0 = o8[2 * c] * rstd * gn8[2 * c] * z8[2 * c] * sigmoidf_(z8[2 * c]);
        const float y1 = o8[2 * c + 1] * rstd * gn8[2 * c + 1] * z8[2 * c + 1] * sigmoidf_(z8[2 * c + 1]);
        w[c] = pack2(y0, y1);
      }
      *(u32x4*)yp = (u32x4){w[0], w[1], w[2], w[3]};
    }
  }
}

constexpr int AT_WAVE_BYTES = 8192 + 512 + 8192;
__device__ __forceinline__ float xor16_sum(float v) {
  auto r = __builtin_amdgcn_permlane16_swap(__float_as_uint(v), __float_as_uint(v), false, false);
  return __uint_as_float(r[0]) + __uint_as_float(r[1]);
}
__device__ __forceinline__ float xor32_sum(float v) {
  auto r = __builtin_amdgcn_permlane32_swap(__float_as_uint(v), __float_as_uint(v), false, false);
  return __uint_as_float(r[0]) + __uint_as_float(r[1]);
}
__device__ __forceinline__ void attn_query(const Params& p, unsigned char* wsm, int b, int t) {
  typedef long i64;
  typedef int i32x2 __attribute__((ext_vector_type(2)));
  typedef __attribute__((address_space(3))) i32x2 lds_i32x2;
  const u16* PROJ = (const u16*)(p.ws + OFF_PROJ);
  const u16* SEL = (const u16*)(p.ws + OFF_SEL);
  const unsigned char* KVC8 = p.ws + OFF_KVC;
  u16* YATT = (u16*)(p.ws + OFF_YATT);
  const int lane = TIDX & 63;
  const int fr = lane & 15, fg = lane >> 4;
  float* P = (float*)wsm;
  u16* sl = (u16*)(wsm + 8192);
  const size_t tokb = (size_t)b * SEQ;
  const size_t tok = tokb + t;
  const int nsel = min(256, t + 1);
  i64 qb[2][2];
  {
    const u16* qrow = PROJ + tok * LDP + C_AQ + (fr & 3) * 64 + fg * 8;
#pragma unroll
    for (int g = 0; g < 2; ++g)
#pragma unroll
      for (int kk = 0; kk < 2; ++kk) {
        const u32x4 v = *(const u32x4*)(qrow + g * 256 + kk * 32);
        const u32 lo = fp8x4(bflo(v[0]) * 16.f, bfhi(v[0]) * 16.f, bflo(v[1]) * 16.f, bfhi(v[1]) * 16.f);
        const u32 hi = fp8x4(bflo(v[2]) * 16.f, bfhi(v[2]) * 16.f, bflo(v[3]) * 16.f, bfhi(v[3]) * 16.f);
        const i64 w = (i64)(((unsigned long long)hi << 32) | (unsigned long long)lo);
        qb[g][kk] = (fr < 4) ? w : (i64)0;
      }
    const u16* sr = SEL + tok * 256;
#pragma unroll
    for (int i = 0; i < 4; ++i) sl[lane + 64 * i] = sr[lane + 64 * i];
  }
  WAVE_LDS_SYNC();
  const int ngrp = (nsel + 15) >> 4;
  const int nbq = (ngrp + 1) >> 1;
  unsigned char* KST = wsm + 8192 + 512;
  const int kq = lane >> 3, kch = lane & 7;
  u32x4 kA[2][2], kB[2][2];
#define QK_LOAD(buf_, bi_)                                                                       \
  _Pragma("unroll") for (int j = 0; j < 2; ++j)                                                  \
    _Pragma("unroll") for (int hf = 0; hf < 2; ++hf) {                                           \
      const int ki_ = min(((bi_) * 2 + j) * 16 + hf * 8 + kq, 255);                              \
      const int s_ = (int)sl[ki_] & 4095;                                                        \
      buf_[j][hf] = *(const u32x4*)(KVC8 + (tokb + s_) * 256 + kch * 16);                        \
    }
#define QK_COMPUTE(buf_, bi_)                                                                    \
  {                                                                                              \
    _Pragma("unroll") for (int j = 0; j < 2; ++j)                                                \
      _Pragma("unroll") for (int hf = 0; hf < 2; ++hf) {                                         \
        const int row_ = hf * 8 + kq;                                                            \
        *(u32x4*)(KST + j * 2048 + row_ * 128 + ((kch ^ (row_ & 7)) << 4)) = buf_[j][hf];        \
      }                                                                                          \
    WAVE_LDS_SYNC();                                                                             \
    _Pragma("unroll") for (int j = 0; j < 2; ++j) {                                              \
      const unsigned char* kr_ = KST + j * 2048 + fr * 128 + 8 * (fg & 1);                       \
      const int sw_ = fr & 7, ch_ = fg >> 1;                                                     \
      const i64 a00_ = *(const i64*)(kr_ + (((0 + ch_) ^ sw_) << 4));                            \
      const i64 a01_ = *(const i64*)(kr_ + (((2 + ch_) ^ sw_) << 4));                            \
      const i64 a10_ = *(const i64*)(kr_ + (((4 + ch_) ^ sw_) << 4));                            \
      const i64 a11_ = *(const i64*)(kr_ + (((6 + ch_) ^ sw_) << 4));                            \
      f32x4 c0_ = {0.f, 0.f, 0.f, 0.f}, c1_ = {0.f, 0.f, 0.f, 0.f};                              \
      c0_ = __builtin_amdgcn_mfma_f32_16x16x32_fp8_fp8(a00_, qb[0][0], c0_, 0, 0, 0);            \
      c0_ = __builtin_amdgcn_mfma_f32_16x16x32_fp8_fp8(a01_, qb[0][1], c0_, 0, 0, 0);            \
      c1_ = __builtin_amdgcn_mfma_f32_16x16x32_fp8_fp8(a10_, qb[1][0], c1_, 0, 0, 0);            \
      c1_ = __builtin_amdgcn_mfma_f32_16x16x32_fp8_fp8(a11_, qb[1][1], c1_, 0, 0, 0);            \
      if (fr < 4) {                                                                              \
        _Pragma("unroll") for (int r = 0; r < 4; ++r) {                                          \
          const int kk2_ = ((bi_) * 2 + j) * 16 + 4 * fg + r;                                    \
          if (kk2_ < 256) {                                                                      \
            const bool v_ = kk2_ < nsel;                                                         \
            P[kk2_ * 8 + fr] = v_ ? c0_[r] * 0.0625f : -1e30f;                                   \
            P[kk2_ * 8 + 4 + fr] = v_ ? c1_[r] * 0.0625f : -1e30f;                               \
          }                                                                                      \
        }                                                                                        \
      }                                                                                          \
    }                                                                                            \
    WAVE_LDS_SYNC();                                                                             \
  }
  QK_LOAD(kA, 0)
  for (int bi = 0; bi < nbq; bi += 2) {
    if (bi + 1 < nbq) { QK_LOAD(kB, bi + 1) }
    QK_COMPUTE(kA, bi)
    if (bi + 2 < nbq) { QK_LOAD(kA, bi + 2) }
    if (bi + 1 < nbq) { QK_COMPUTE(kB, bi + 1) }
  }
#undef QK_LOAD
#undef QK_COMPUTE
  for (int ki = nbq * 32 + lane; ki < 256; ki += 64) {
    *(f32x4*)(P + ki * 8) = (f32x4){-1e30f, -1e30f, -1e30f, -1e30f};
    *(f32x4*)(P + ki * 8 + 4) = (f32x4){-1e30f, -1e30f, -1e30f, -1e30f};
  }
  WAVE_LDS_SYNC();
  float inv8[8];
  {
    float lg[4][8];
#pragma unroll
    for (int i = 0; i < 4; ++i) {
      f32x4 x0 = *(const f32x4*)(P + (lane + 64 * i) * 8), x1 = *(const f32x4*)(P + (lane + 64 * i) * 8 + 4);
      lg[i][0] = x0[0]; lg[i][1] = x0[1]; lg[i][2] = x0[2]; lg[i][3] = x0[3];
      lg[i][4] = x1[0]; lg[i][5] = x1[1]; lg[i][6] = x1[2]; lg[i][7] = x1[3];
    }
    WAVE_LDS_SYNC();
    unsigned char* PT8 = (unsigned char*)P;
#pragma unroll
    for (int hh = 0; hh < 8; ++hh) {
      float m = fmaxf(fmaxf(lg[0][hh], lg[1][hh]), fmaxf(lg[2][hh], lg[3][hh]));
      m = wave_max_dpp(m);
      float e[4], sum = 0.f;
#pragma unroll
      for (int i = 0; i < 4; ++i) { e[i] = __expf(lg[i][hh] - m); sum += e[i]; }
      sum = wave_sum_dpp(sum);
      inv8[hh] = __builtin_amdgcn_rcpf(sum) * (1.f / 256.f);
      const u32 w = fp8x4(e[0] * 256.f, e[1] * 256.f, e[2] * 256.f, e[3] * 256.f);
#pragma unroll
      for (int i = 0; i < 4; ++i) PT8[hh * 256 + lane + 64 * i] = (unsigned char)((w >> (8 * i)) & 0xffu);
    }
  }
  WAVE_LDS_SYNC();
  {
    const unsigned char* PT8 = (const unsigned char*)P;
    unsigned char* VST = wsm + 8192 + 512;
    const int trow = (lane & 15) >> 1, thalf = lane & 1;
    f32x4 oacc[2][4];
#pragma unroll
    for (int g = 0; g < 2; ++g)
#pragma unroll
      for (int c = 0; c < 4; ++c) oacc[g][c] = (f32x4){0.f, 0.f, 0.f, 0.f};
    const int nks = (nsel + 31) >> 5;
    u32x4 vA[4], vB[4];
#define PV_LOAD(buf_, ks_)                                                                       \
  _Pragma("unroll") for (int i = 0; i < 4; ++i) {                                                \
    const int ki_ = min((ks_) * 32 + i * 8 + kq, 255);                                           \
    const int s_ = (int)sl[ki_] & 4095;                                                          \
    buf_[i] = *(const u32x4*)(KVC8 + (tokb + s_) * 256 + 128 + kch * 16);                        \
  }
#define PV_COMPUTE(buf_, ks_)                                                                    \
  {                                                                                              \
    _Pragma("unroll") for (int i = 0; i < 4; ++i) {                                              \
      const int key_ = i * 8 + kq;                                                               \
      *(u32x4*)(VST + key_ * 128 + ((kch ^ (key_ & 7)) << 4)) = buf_[i];                         \
    }                                                                                            \
    WAVE_LDS_SYNC();                                                                             \
    i64 pa_[2];                                                                                  \
    _Pragma("unroll") for (int g = 0; g < 2; ++g) {                                              \
      const i64 t_ = *(const i64*)(PT8 + (g * 4 + (fr & 3)) * 256 + (ks_) * 32 + 8 * fg);        \
      pa_[g] = (fr < 4) ? t_ : (i64)0;                                                           \
    }                                                                                            \
    const int r1_ = 8 * fg + trow;                                                               \
    _Pragma("unroll") for (int g = 0; g < 2; ++g)                                                \
      _Pragma("unroll") for (int c = 0; c < 4; ++c) {                                            \
        const i32x2 tv_ = __builtin_amdgcn_ds_read_tr8_b64_v2i32((lds_i32x2*)(VST + r1_ * 128 + (((g * 4 + c) ^ (r1_ & 7)) << 4) + 8 * thalf)); \
        const i64 vb_ = (i64)(((unsigned long long)(u32)tv_[1] << 32) | (unsigned long long)(u32)tv_[0]); \
        oacc[g][c] = __builtin_amdgcn_mfma_f32_16x16x32_fp8_fp8(pa_[g], vb_, oacc[g][c], 0, 0, 0); \
      }                                                                                          \
    WAVE_LDS_SYNC();                                                                             \
  }
    PV_LOAD(vA, 0)
    for (int ks = 0; ks < nks; ks += 2) {
      if (ks + 1 < nks) { PV_LOAD(vB, ks + 1) }
      PV_COMPUTE(vA, ks)
      if (ks + 2 < nks) { PV_LOAD(vA, ks + 2) }
      if (ks + 1 < nks) { PV_COMPUTE(vB, ks + 1) }
    }
#undef PV_LOAD
#undef PV_COMPUTE
    if (lane < 16) {
#pragma unroll
      for (int g = 0; g < 2; ++g)
#pragma unroll
        for (int c = 0; c < 4; ++c)
#pragma unroll
          for (int r = 0; r < 4; ++r)
            YATT[tok * 512 + (g * 4 + r) * 64 + 16 * c + fr] = f2bf(oacc[g][c][r] * inv8[g * 4 + r]);
    }
  }
  WAVE_LDS_SYNC();
}

__device__ __forceinline__ void phase3(const Params& p, unsigned char* smem) {
  const int wave = TIDX >> 6;
#ifndef NO_SCAN
  if (blockIdx.x < 32) {
    if (!(p.flags & 2)) dn_scan_item(p, smem, blockIdx.x);
    __syncthreads();
  }
#endif
#ifdef NO_ATTN
  return;
#endif
  if (p.flags & 4) return;
  unsigned* qctr = (unsigned*)(p.ws + 1024 + ((p.flags & 128) ? 4096 : 0));
  const unsigned xcc = (unsigned)__builtin_amdgcn_s_getreg((3 << 11) | 20) & 7u;
  unsigned char* wsm = smem + wave * AT_WAVE_BYTES;
  for (unsigned db = 0; db < 8; ++db) {
    const int bb = (int)((xcc + db) & 7u);
    for (;;) {
      unsigned qi = 0;
      if ((TIDX & 63) == 0) qi = __hip_atomic_fetch_add(qctr + bb * 16, 1u, __ATOMIC_RELAXED, __HIP_MEMORY_SCOPE_AGENT);
      qi = (unsigned)__builtin_amdgcn_readfirstlane((int)qi);
      if (qi >= (unsigned)SEQ) break;
      attn_query(p, wsm, bb, SEQ - 1 - (int)qi);
    }
  }
}

__device__ __forceinline__ void hblk_load(unsigned char* reg, const u16* __restrict__ src, u32 ob, u32 ld, int lane) {
  const int c16 = lane & 7, r8 = lane >> 3;
#pragma unroll
  for (int it = 0; it < 8; ++it) {
    const int rl = it * 8 + r8;
    const u32x4 v = *(const u32x4*)(src + ob + (u32)rl * ld + (u32)(c16 * 8));
    *(u32x4*)(reg + rl * 128 + (((c16 + 2 * ((rl >> 2) & 3)) & 7) << 4)) = v;
    if ((it & 3) == 3) __builtin_amdgcn_sched_barrier(0);
  }
}
__device__ __forceinline__ void hblk_store(const unsigned char* reg, u16* __restrict__ dst, u32 ob, u32 ld, int lane) {
  const int c16 = lane & 7, r8 = lane >> 3;
#pragma unroll
  for (int it = 0; it < 8; ++it) {
    const int rl = it * 8 + r8;
    const u32x4 v = *(const u32x4*)(reg + rl * 128 + (((c16 + 2 * ((rl >> 2) & 3)) & 7) << 4));
    *(u32x4*)(dst + ob + (u32)rl * ld + (u32)(c16 * 8)) = v;
  }
}
__device__ __forceinline__ void phase4(const Params& p, unsigned char* smem) {
  const u16* YATT = (const u16*)(p.ws + OFF_YATT);
  const u16* YDN = (const u16*)(p.ws + OFF_YDN);
  const u16* WTA = (const u16*)(p.ws + OFF_WTA);
  const u16* WTB = (const u16*)(p.ws + OFF_WTB);
  const u16* PROJ = (const u16*)(p.ws + OFF_PROJ);
  u16* MG = (u16*)(p.ws + OFF_MERGED);
  const int ntn = DM / 256, ntiles = (MTOK / 256) * ntn;
  for (int t = blockIdx.x; t < ntiles; t += gridDim.x) {
    const int m0 = (t / ntn) * 256, n0 = (t % ntn) * 256;
    f32x4 acc[2][2][4][2];
#pragma unroll
    for (int pass = 0; pass < 2; ++pass) {
      gemm8_tile(pass ? YDN : YATT, pass ? WTB : WTA, 512, m0, n0, smem, acc);
      int lane = TIDX & 63;
      asm volatile("" : "+v"(lane));
      const int wave = TIDX >> 6, wr = wave >> 2, wc = wave & 3, fr = lane & 15, fq = lane >> 4;
      unsigned char* regG = smem + wave * 16384;
      unsigned char* regT = regG + 8192;
      const int lrot = (fr >> 3) + 2 * fq;
      int off4[4];
#pragma unroll
      for (int jj = 0; jj < 4; ++jj) off4[jj] = (4 * fq) * 128 + (fr & 7) * 2 + (((jj * 2 + lrot) & 7) << 4);
#pragma unroll
      for (int ai = 0; ai < 2; ++ai) {
        const u32 gb0 = (u32)(m0 + ai * 128 + wr * 64) * LDP + (u32)(n0 + wc * 64) + (u32)(pass ? C_GB : C_GA);
        const u32 ob0 = (u32)(m0 + ai * 128 + wr * 64) * DM + (u32)(n0 + wc * 64);
        hblk_load(regG, PROJ, gb0, LDP, lane);
        if (pass == 1) hblk_load(regT, MG, ob0, DM, lane);
        WAVE_LDS_SYNC();
#pragma unroll
        for (int m = 0; m < 4; ++m)
#pragma unroll
          for (int r = 0; r < 4; ++r)
#pragma unroll
            for (int bj = 0; bj < 2; ++bj)
#pragma unroll
              for (int n = 0; n < 2; ++n) {
                const int o = off4[bj * 2 + n] + (m * 16 + r) * 128;
                float v = sigmoidf_(bf2f(*(const u16*)(regG + o))) * acc[ai][bj][m][n][r];
                if (pass == 1) v += bf2f(*(const u16*)(regT + o));
                *(u16*)(regT + o) = f2bf(v);
              }
        WAVE_LDS_SYNC();
        hblk_store(regT, MG, ob0, DM, lane);
        WAVE_LDS_SYNC();
      }
      asm volatile("s_waitcnt vmcnt(0)" ::: "memory");
    }
  }
}

__device__ __forceinline__ void phase5(const Params& p, unsigned char* smem) {
  const u16* MG = (const u16*)(p.ws + OFF_MERGED);
  const u16* WTO = (const u16*)(p.ws + OFF_WTO);
  const float* x = p.in[0];
  const int lane = TIDX & 63, wave = TIDX >> 6;
  const int wr = wave >> 2, wc = wave & 3, fr = lane & 15, fq = lane >> 4;
  const int ntn = DM / 256, ntiles = (MTOK / 256) * ntn;
  for (int t = blockIdx.x; t < ntiles; t += gridDim.x) {
    const int m0 = (t / ntn) * 256, n0 = (t % ntn) * 256;
    f32x4 acc[2][2][4][2];
    gemm8_tile(MG, WTO, DM, m0, n0, smem, acc);
    const u32 ob0 = (u32)(m0 + wr * 64 + 4 * fq) * DM + (u32)(n0 + wc * 64 + fr);
    float* outp = p.out;
#pragma unroll
    for (int ai = 0; ai < 2; ++ai)
#pragma unroll
      for (int m = 0; m < 4; ++m) {
#pragma unroll
        for (int bj = 0; bj < 2; ++bj)
#pragma unroll
          for (int n = 0; n < 2; ++n)
#pragma unroll
            for (int j = 0; j < 4; ++j) {
              u32 o = ob0 + (u32)((ai * 128 + m * 16 + j) * DM + (bj * 2 + n) * 16);
              outp[o] = x[o] + acc[ai][bj][m][n][j];
            }
        __builtin_amdgcn_sched_barrier(0);
      }
  }
}

__device__ __forceinline__ void phase6(const Params& p, unsigned char* smem) {
  const u16* H2 = (const u16*)(p.ws + OFF_H2);
  const u16* WTQ = (const u16*)(p.ws + OFF_WTQ);
  u16* QP = (u16*)(p.ws + OFF_QP);
  const int ntn = 2048 / 256, ntiles = (MTOK / 256) * ntn;
  for (int t = blockIdx.x; t < ntiles; t += gridDim.x) {
    const int m0 = (t / ntn) * 256, n0 = (t % ntn) * 256;
    f32x4 acc[2][2][4][2];
    gemm8_tile(H2, WTQ, DM, m0, n0, smem, acc);
    const int tid_e = TIDX, lane = tid_e & 63, wave = tid_e >> 6;
    const int wr = wave >> 2, wc = wave & 3;
    ep_store<2048, false>(QP, (u32)(m0 + wr * 64) * 2048 + (u32)(n0 + wc * 64), acc, nullptr, 1.f, smem, wave, lane);
  }
}

__device__ __forceinline__ int mono_key(float v) { int b = __float_as_int(v); return b ^ ((b >> 31) & 0x7fffffff); }
__device__ __forceinline__ float unmono_key(int k) { return __int_as_float(k ^ ((k >> 31) & 0x7fffffff)); }
__device__ __forceinline__ void chain16(int (&k)[16], int x) {
#pragma unroll
  for (int j = 0; j < 16; ++j) { int hi = max(k[j], x); x = min(k[j], x); k[j] = hi; }
}

#define CE_DESC(a, b) { const int hi_ = max(a, b), lo_ = min(a, b); a = hi_; b = lo_; }
__device__ __forceinline__ void sort16_desc(int (&k)[16]) {
#pragma unroll
  for (int size = 2; size <= 16; size <<= 1) {
#pragma unroll
    for (int stride = size >> 1; stride > 0; stride >>= 1) {
#pragma unroll
      for (int i = 0; i < 16; ++i) {
        const int l = i ^ stride;
        if (l > i) {
          if ((i & size) == 0) CE_DESC(k[i], k[l]) else CE_DESC(k[l], k[i])
        }
      }
    }
  }
}
__device__ __forceinline__ void merge_top16(int (&a)[16], const int (&b)[16]) {
#pragma unroll
  for (int i = 0; i < 16; ++i) a[i] = max(a[i], b[15 - i]);
#pragma unroll
  for (int stride = 8; stride > 0; stride >>= 1) {
#pragma unroll
    for (int i = 0; i < 16; ++i) {
      const int l = i ^ stride;
      if (l > i) CE_DESC(a[i], a[l])
    }
  }
}

constexpr int P7_LD = 132;
__device__ __forceinline__ void phase7(const Params& p, unsigned char* smem) {
  const u16* QP = (const u16*)(p.ws + OFF_QP);
  const u16* SKB = (const u16*)(p.ws + OFF_SKB);
  float* TOPS = (float*)(p.ws + OFF_TOPS);
  u8* TOPI = (u8*)(p.ws + OFF_TOPI);
  const int tid = TIDX, lane = tid & 63, wave = tid >> 6;
  const int wm = wave >> 1, wn = wave & 1, fr = lane & 15, fg = lane >> 4;
  const int ntiles = (MTOK / G_BM) * 16;
  float* tile = (float*)smem;
  for (int t = blockIdx.x; t < ntiles; t += gridDim.x) {
    const int m0 = (t >> 4) * G_BM, hp = t & 15;
    f32x4 acc[4][4];
    gemm_mainloop(QP + hp * 128, 2048, SKB + (size_t)hp * 128 * 128, 128, 128, m0, 0, smem, acc);
#pragma unroll
    for (int i = 0; i < 4; ++i)
#pragma unroll
      for (int j = 0; j < 4; ++j)
#pragma unroll
        for (int r = 0; r < 4; ++r) {
          int row = wm * 64 + i * 16 + 4 * fg + r, col = wn * 64 + j * 16 + fr;
          tile[row * P7_LD + col] = acc[i][j][r];
        }
    __syncthreads();
    {
      const int row = tid >> 1, half = tid & 1;
      int k[16];
      const float* rowp = tile + row * P7_LD + half * 64;
#pragma unroll
      for (int grp = 0; grp < 4; ++grp) {
        int gk[16];
#pragma unroll
        for (int c = 0; c < 16; c += 4) {
          f32x4 v = *(const f32x4*)(rowp + grp * 16 + c);
          const int ib = 127 - (half * 64 + grp * 16 + c);
          gk[c] = (mono_key(v[0]) & ~127) | ib;
          gk[c + 1] = (mono_key(v[1]) & ~127) | (ib - 1);
          gk[c + 2] = (mono_key(v[2]) & ~127) | (ib - 2);
          gk[c + 3] = (mono_key(v[3]) & ~127) | (ib - 3);
        }
        sort16_desc(gk);
        if (grp == 0) {
#pragma unroll
          for (int j = 0; j < 16; ++j) k[j] = gk[j];
        } else merge_top16(k, gk);
      }
      {
        int other[16];
#pragma unroll
        for (int j = 0; j < 16; ++j) other[j] = DPPI(k[j], 0xb1);
        merge_top16(k, other);
      }
      if (half == 0) {
        size_t o = ((size_t)(m0 + row) * 16 + hp) * 16;
        float vals[16]; int idx[16];
#pragma unroll
        for (int j = 0; j < 16; ++j) { idx[j] = 127 - (k[j] & 127); vals[j] = tile[row * P7_LD + idx[j]]; }
#pragma unroll
        for (int j = 0; j < 16; j += 4) *(f32x4*)(TOPS + o + j) = (f32x4){vals[j], vals[j + 1], vals[j + 2], vals[j + 3]};
#pragma unroll
        for (int j = 0; j < 16; j += 4)
          *(u32*)(TOPI + o + j) = (u32)idx[j] | ((u32)idx[j + 1] << 8) | ((u32)idx[j + 2] << 16) | ((u32)idx[j + 3] << 24);
      }
    }
    __syncthreads();
  }
}

__device__ __forceinline__ void phase7b(const Params& p) {
  const float* TOPS = (const float*)(p.ws + OFF_TOPS);
  const u8* TOPI = (const u8*)(p.ws + OFF_TOPI);
  int* EXPERT = (int*)(p.ws + OFF_EXPERT);
  float* GATE = (float*)(p.ws + OFF_GATE);
  for (int w = blockIdx.x * NTHREADS + TIDX; w < MTOK * 8; w += gridDim.x * NTHREADS) {
    const size_t o = (size_t)w * 32;
    float sa[16], sb[16];
#pragma unroll
    for (int k = 0; k < 16; k += 4) {
      float4 v = *(const float4*)(TOPS + o + k); sa[k] = v.x; sa[k + 1] = v.y; sa[k + 2] = v.z; sa[k + 3] = v.w;
      float4 u = *(const float4*)(TOPS + o + 16 + k); sb[k] = u.x; sb[k + 1] = u.y; sb[k + 2] = u.z; sb[k + 3] = u.w;
    }
    int cand[64];
#pragma unroll
    for (int k = 0; k < 64; ++k) cand[k] = (int)0x80000000;
    {
      int cnt = 0;
#pragma unroll
      for (int a = 0; a < 16; ++a)
#pragma unroll
        for (int bb = 0; bb < 16; ++bb)
          if ((a + 1) * (bb + 1) <= 16) { cand[cnt] = (mono_key(sa[a] + sb[bb]) & ~255) | (255 - (a * 16 + bb)); ++cnt; }
    }
    int kk[16];
#pragma unroll
    for (int grp = 0; grp < 4; ++grp) {
      int gk[16];
#pragma unroll
      for (int j = 0; j < 16; ++j) gk[j] = cand[grp * 16 + j];
      sort16_desc(gk);
      if (grp == 0) {
#pragma unroll
        for (int j = 0; j < 16; ++j) kk[j] = gk[j];
      } else merge_top16(kk, gk);
    }
    float vals[16];
#pragma unroll
    for (int k = 0; k < 16; ++k) vals[k] = unmono_key(kk[k] & ~255);
    float m = vals[0], s = 0.f, e[16];
#pragma unroll
    for (int k = 0; k < 16; ++k) { e[k] = __expf(vals[k] - m); s += e[k]; }
    float inv = 1.f / s;
#pragma unroll
    for (int k = 0; k < 16; ++k) {
      const int ci = 255 - (kk[k] & 255);
      int a = ci >> 4, bb = ci & 15;
      int ex = (int)TOPI[o + a] * 128 + (int)TOPI[o + 16 + bb];
      EXPERT[(size_t)w * 16 + k] = ex;
      GATE[(size_t)w * 16 + k] = e[k] * inv;
    }
  }
  {
    const int lane = TIDX & 63, wave = TIDX >> 6;
    for (int row = blockIdx.x * 8 + wave; row < 2 * 16384; row += gridDim.x * 8) {
      const int tbl = row >> 14, r = row & 16383;
      const f32x4* src = (const f32x4*)((tbl ? p.in[16] : p.in[15]) + (size_t)r * DM) + 4 * lane;
      f32x4 x[4];
      float amax = 0.f;
#pragma unroll
      for (int i = 0; i < 4; ++i) {
        x[i] = src[i];
        amax = fmaxf(amax, fmaxf(fmaxf(fabsf(x[i][0]), fabsf(x[i][1])), fmaxf(fabsf(x[i][2]), fabsf(x[i][3]))));
      }
      amax = wave_max_dpp(amax);
      const float inv = amax > 0.f ? 127.f / amax : 0.f;
      const int bias = 0;
      u32x4 o;
#pragma unroll
      for (int i = 0; i < 4; ++i) {
        int q0 = (int)rintf(x[i][0] * inv) + bias, q1 = (int)rintf(x[i][1] * inv) + bias;
        int q2 = (int)rintf(x[i][2] * inv) + bias, q3 = (int)rintf(x[i][3] * inv) + bias;
        o[i] = (u32)(q0 & 0xff) | ((u32)(q1 & 0xff) << 8) | ((u32)(q2 & 0xff) << 16) | ((u32)(q3 & 0xff) << 24);
      }
      *(u32x4*)(p.ws + (tbl ? OFF_VQ : OFF_UQ) + ((size_t)(lane >> 3) * 16384 + r) * 128 + (lane & 7) * 16) = o;
      if (lane == 0) ((float*)(p.ws + (tbl ? OFF_VS : OFF_US)))[r] = amax * (1.f / 127.f);
    }
  }
}

__device__ __forceinline__ void phase8a(const Params& p) {
  const int* EXPERT = (const int*)(p.ws + OFF_EXPERT);
  const unsigned char* UQS = p.ws + OFF_UQ;
  const unsigned char* H2Q = p.ws + OFF_H2Q;
  int* PD = (int*)(p.ws + OFF_PD);
  unsigned* ctr = (unsigned*)(p.ws + 2048 + ((p.flags & 128) ? 4096 : 0));
  const unsigned xcc = (unsigned)__builtin_amdgcn_s_getreg((3 << 11) | 20) & 7u;
  const int lane = TIDX & 63, g8 = lane >> 3, l8 = lane & 7;
  for (unsigned db = 0; db < 8; ++db) {
    const int x = (int)((xcc + db) & 7u);
    for (;;) {
      unsigned ci = 0;
      if (lane == 0) ci = __hip_atomic_fetch_add(ctr + x * 16, 1u, __ATOMIC_RELAXED, __HIP_MEMORY_SCOPE_AGENT);
      ci = (unsigned)__builtin_amdgcn_readfirstlane((int)ci);
      if (ci >= (unsigned)(MTOK / 16)) break;
#pragma unroll 1
      for (int tt = 0; tt < 16; ++tt) {
        const int tok = (int)ci * 16 + tt;
        const int e0 = EXPERT[(size_t)tok * 128 + lane], e1 = EXPERT[(size_t)tok * 128 + 64 + lane];
        const u32x4 hq = *(const u32x4*)(H2Q + (size_t)tok * DM + x * 128 + l8 * 16);
        u32x4 ua[16];
#pragma unroll
        for (int i = 0; i < 16; ++i) {
          const int k = i * 8 + g8;
          const int ek = __shfl(i < 8 ? e0 : e1, k & 63);
          ua[i] = *(const u32x4*)(UQS + ((size_t)(x * 16384 + ek)) * 128 + l8 * 16);
        }
        int keep0 = 0, keep1 = 0;
#pragma unroll
        for (int i = 0; i < 16; ++i) {
          int sd = 0;
#pragma unroll
          for (int c = 0; c < 4; ++c) sd = __builtin_amdgcn_sdot4((int)ua[i][c], (int)hq[c], sd, false);
          sd += DPPI(sd, 0xb1); sd += DPPI(sd, 0x4e); sd += DPPI(sd, 0x141);
          if (i < 8) keep0 = (l8 == (i & 7)) ? sd : keep0; else keep1 = (l8 == (i & 7)) ? sd : keep1;
        }
        int* pd = PD + ((size_t)x * MTOK + tok) * 128 + l8 * 8 + g8;
        pd[0] = keep0; pd[64] = keep1;
      }
    }
  }
}

__device__ __forceinline__ void phase8c(const Params& p) {
  const int* EXPERT = (const int*)(p.ws + OFF_EXPERT);
  const float* GATE = (const float*)(p.ws + OFF_GATE);
  const float* US = (const float*)(p.ws + OFF_US);
  const float* VS = (const float*)(p.ws + OFF_VS);
  const float* HS = (const float*)(p.ws + OFF_HS);
  const int* PD = (const int*)(p.ws + OFF_PD);
  unsigned char* CQ8 = p.ws + OFF_CQ8;
  float* QSC = (float*)(p.ws + OFF_QSC);
  const int lane = TIDX & 63, wave = TIDX >> 6;
  for (int tok = blockIdx.x * 8 + wave; tok < MTOK; tok += gridDim.x * 8) {
    const int e0 = EXPERT[(size_t)tok * 128 + lane], e1 = EXPERT[(size_t)tok * 128 + 64 + lane];
    const float g0 = GATE[(size_t)tok * 128 + lane], g1 = GATE[(size_t)tok * 128 + 64 + lane];
    int s0 = 0, s1 = 0;
#pragma unroll
    for (int xx = 0; xx < 8; ++xx) {
      s0 += PD[((size_t)xx * MTOK + tok) * 128 + lane];
      s1 += PD[((size_t)xx * MTOK + tok) * 128 + 64 + lane];
    }
    const float hs = HS[tok];
    const float d0 = (float)s0 * US[e0] * hs, d1 = (float)s1 * US[e1] * hs;
    const float cf0 = g0 * 0.5f * d0 * (1.f + erff(d0 * 0.70710678118654752f)) * VS[e0];
    const float cf1 = g1 * 0.5f * d1 * (1.f + erff(d1 * 0.70710678118654752f)) * VS[e1];
    const float cmax = wave_max_dpp(fmaxf(fabsf(cf0), fabsf(cf1)));
    const float qinv = cmax > 0.f ? 32639.f / cmax : 0.f;
    const int c0 = (int)rintf(cf0 * qinv), c1 = (int)rintf(cf1 * qinv);
    const int h0 = (c0 + 128) >> 8, h1 = (c1 + 128) >> 8;
    unsigned char* cq = CQ8 + (size_t)tok * 256;
    cq[lane] = (unsigned char)(h0 & 0xff); cq[64 + lane] = (unsigned char)(h1 & 0xff);
    cq[128 + lane] = (unsigned char)((c0 - 256 * h0) & 0xff); cq[192 + lane] = (unsigned char)((c1 - 256 * h1) & 0xff);
    if (lane == 0) QSC[tok] = cmax * (1.f / 32639.f);
  }
}

#ifndef TR8_VARIANT
#define TR8_VARIANT 0
#endif
__device__ __forceinline__ void phase8b(const Params& p, unsigned char* smem) {
  typedef int i32x4 __attribute__((ext_vector_type(4)));
  typedef int i32x2 __attribute__((ext_vector_type(2)));
  typedef __attribute__((address_space(3))) i32x2 lds_i32x2;
  const int* EXPERT = (const int*)(p.ws + OFF_EXPERT);
  const unsigned char* VQS = p.ws + OFF_VQ;
  const unsigned char* CQ8 = p.ws + OFF_CQ8;
  const float* QSC = (const float*)(p.ws + OFF_QSC);
  unsigned* ctr = (unsigned*)(p.ws + 3072 + ((p.flags & 128) ? 4096 : 0));
  const unsigned xcc = (unsigned)__builtin_amdgcn_s_getreg((3 << 11) | 20) & 7u;
  const int lane = TIDX & 63, wave = TIDX >> 6, g8 = lane >> 3, l8 = lane & 7;
  const int fr = lane & 15, fg = lane >> 4;
  unsigned char* VST = smem + wave * 16384;
#if TR8_VARIANT == 0
  const int trow = (lane & 15) >> 1, thalf = lane & 1;
#else
  const int trow = lane & 7, thalf = (lane & 15) >> 3;
#endif
  __syncthreads();
  for (unsigned db = 0; db < 8; ++db) {
    const int x = (int)((xcc + db) & 7u);
    for (;;) {
      unsigned ci = 0;
      if (lane == 0) ci = __hip_atomic_fetch_add(ctr + x * 16, 1u, __ATOMIC_RELAXED, __HIP_MEMORY_SCOPE_AGENT);
      ci = (unsigned)__builtin_amdgcn_readfirstlane((int)ci);
      if (ci >= (unsigned)(MTOK / 16)) break;
#pragma unroll 1
      for (int tt = 0; tt < 16; ++tt) {
        const int tok = (int)ci * 16 + tt;
        const int e0 = EXPERT[(size_t)tok * 128 + lane], e1 = EXPERT[(size_t)tok * 128 + 64 + lane];
        u32x4 va[16];
#pragma unroll
        for (int i = 0; i < 16; ++i) {
          const int k = i * 8 + g8;
          const int ek = __shfl(i < 8 ? e0 : e1, k & 63);
          va[i] = *(const u32x4*)(VQS + ((size_t)(x * 16384 + ek)) * 128 + l8 * 16);
        }
        i32x4 af[2];
#pragma unroll
        for (int sx = 0; sx < 2; ++sx) {
          af[sx] = *(const i32x4*)(CQ8 + (size_t)tok * 256 + (fr & 1) * 128 + sx * 64 + fg * 16);
          if (fr >= 2) af[sx] = (i32x4){0, 0, 0, 0};
        }
        const float qsc = QSC[tok];
#pragma unroll
        for (int i = 0; i < 16; ++i) {
          const int k = i * 8 + g8;
          *(u32x4*)(VST + k * 128 + ((l8 ^ g8) << 4)) = va[i];
        }
        WAVE_LDS_SYNC();
        i32x4 acc[8];
#pragma unroll
        for (int c = 0; c < 8; ++c) acc[c] = (i32x4){0, 0, 0, 0};
#pragma unroll
        for (int sx = 0; sx < 2; ++sx) {
          const int r1 = sx * 64 + fg * 16 + trow, r2 = r1 + 8;
#pragma unroll
          for (int c = 0; c < 8; ++c) {
            const i32x2 lo = __builtin_amdgcn_ds_read_tr8_b64_v2i32((lds_i32x2*)(VST + r1 * 128 + ((c ^ (r1 & 7)) << 4) + 8 * thalf));
            const i32x2 hi = __builtin_amdgcn_ds_read_tr8_b64_v2i32((lds_i32x2*)(VST + r2 * 128 + ((c ^ (r2 & 7)) << 4) + 8 * thalf));
            const i32x4 bf = {lo[0], lo[1], hi[0], hi[1]};
            acc[c] = __builtin_amdgcn_mfma_i32_16x16x64_i8(af[sx], bf, acc[c], 0, 0, 0);
          }
        }
        WAVE_LDS_SYNC();
        if (lane < 16 && !(p.flags & 32)) {
          float* op = p.out + (size_t)tok * DM + x * 128 + fr;
#pragma unroll
          for (int c = 0; c < 8; ++c) op[16 * c] += ((float)acc[c][0] * 256.f + (float)acc[c][1]) * qsc;
        }
      }
    }
  }
}

__device__ __forceinline__ void grid_barrier(unsigned* ctr, unsigned nb) {
  asm volatile("s_waitcnt vmcnt(0)" ::: "memory");
  __syncthreads();
  if (TIDX == 0) {
    const unsigned ng = (gridDim.x & 7u) ? 1u : 8u, gsize = gridDim.x / ng;
    __builtin_amdgcn_fence(__ATOMIC_RELEASE, "agent");
    asm volatile("s_waitcnt vmcnt(0)" ::: "memory");
    unsigned* gctr = ctr + 32 + (blockIdx.x & (ng - 1u)) * 16;
    const unsigned old = __hip_atomic_fetch_add(gctr, 1u, __ATOMIC_RELAXED, __HIP_MEMORY_SCOPE_AGENT);
    if (old + 1u == gsize * nb) __hip_atomic_fetch_add(ctr, 1u, __ATOMIC_RELAXED, __HIP_MEMORY_SCOPE_AGENT);
    while (__hip_atomic_load(ctr, __ATOMIC_RELAXED, __HIP_MEMORY_SCOPE_AGENT) < ng * nb) __builtin_amdgcn_s_sleep(1);
    __builtin_amdgcn_fence(__ATOMIC_ACQUIRE, "agent");
    asm volatile("s_waitcnt vmcnt(0)" ::: "memory");
  }
  __syncthreads();
}

__global__ void __launch_bounds__(NTHREADS, 2) mk_fwd(Params p) {
  cg::grid_group grid = cg::this_grid();
  __shared__ __attribute__((aligned(16))) unsigned char smem[SMEM_BYTES];
  const int lo = p.ph_lo, hi = p.ph_hi;
#define RUN(k, call) if (lo <= (k) && (k) < hi) { call; if ((k) + 1 < hi) { if ((k) == 0) grid.sync(); else grid_barrier((unsigned*)p.ws, (unsigned)(lo == 0 ? (k) : (k) - lo + 1)); } }
  RUN(0, phase0(p, smem))
  RUN(1, phase1(p, smem))
  RUN(2, phase2(p, smem))
  RUN(3, phase3(p, smem))
  RUN(4, phase4(p, smem))
  RUN(5, phase5(p, smem))
  RUN(6, rmsnorm_rows<true>(p.out, p.in[12], (u16*)(p.ws + OFF_H2), p.ws + OFF_H2Q, (float*)(p.ws + OFF_HS)))
  RUN(7, phase6(p, smem))
  RUN(8, phase7(p, smem))
  RUN(9, phase7b(p))
  RUN(10, phase8a(p))
  RUN(11, phase8c(p))
  RUN(12, phase8b(p, smem))
#undef RUN
}

extern "C" void kernel_launch(void* const* d_in, const int* in_sizes, int n_in,
                              void* d_out, int out_size, void* d_ws, size_t ws_size,
                              hipStream_t stream) {
  static int grid_blocks = 0;
  if (!grid_blocks) {
    int dev = 0, cus = 0, per_cu = 0;
    (void)hipGetDevice(&dev);
    (void)hipDeviceGetAttribute(&cus, hipDeviceAttributeMultiprocessorCount, dev);
    (void)hipOccupancyMaxActiveBlocksPerMultiprocessor(&per_cu, mk_fwd, NTHREADS, 0);
    if (per_cu < 1) per_cu = 1;
    if (per_cu > 1) per_cu = 1;
    grid_blocks = cus * per_cu;
    fprintf(stderr, "mk_fwd: cus=%d per_cu=%d grid=%d ws=%zu\n", cus, per_cu, grid_blocks, ws_size);
  }
  Params p{};
  for (int i = 0; i < 17 && i < n_in; ++i) p.in[i] = (const float*)d_in[i];
  p.out = (float*)d_out;
  p.ws = (unsigned char*)d_ws;
  p.ph_lo = 0; p.ph_hi = 13;
  (void)hipMemsetAsync(d_ws, 0, 8192, stream);
  void* args[] = {&p};
  hipError_t e = hipLaunchCooperativeKernel((void*)mk_fwd, dim3(grid_blocks), dim3(NTHREADS), args, 0, stream);
  if (e != hipSuccess) fprintf(stderr, "cooperative launch failed: %s (grid %d)\n", hipGetErrorString(e), grid_blocks);
#ifdef EXTRA_LO
  {
    Params p2 = p;
    p2.ph_lo = EXTRA_LO; p2.ph_hi = EXTRA_HI; p2.flags = EXTRA_FLAGS;
    void* args2[] = {&p2};
    (void)hipLaunchCooperativeKernel((void*)mk_fwd, dim3(grid_blocks), dim3(NTHREADS), args2, 0, stream);
  }
#endif
}
```

```cpp
#include <hip/hip_runtime.h>
#include <hip/hip_bf16.h>
#include <hip/hip_cooperative_groups.h>
#include <cstdio>
#include <cstdint>
namespace cg = cooperative_groups;

typedef unsigned short u16;
typedef unsigned int u32;
typedef unsigned char u8;
typedef short bf16x8 __attribute__((ext_vector_type(8)));
typedef float f32x4 __attribute__((ext_vector_type(4)));
typedef unsigned int u32x4 __attribute__((ext_vector_type(4)));
typedef unsigned int u32x2 __attribute__((ext_vector_type(2)));

constexpr int NTHREADS = 512;
constexpr int BATCH = 8, SEQ = 4096, DM = 1024, MTOK = BATCH * SEQ;
constexpr int LDP = 5120;
constexpr int NPADW = 5632;
constexpr int C_AQ = 0, C_IQ = 512, C_DQ = 1024, C_DK = 1536, C_DV = 2048, C_DZ = 2560, C_GA = 3072, C_GB = 4096;
constexpr int N_AK = 5120, N_AV = 5248, N_IK = 5376, N_SM = 5440;
constexpr size_t MiB = 1ull << 20;
constexpr size_t OFF_WTIN = 1 * MiB, OFF_WTA = 12 * MiB, OFF_WTB = 13 * MiB, OFF_WTO = 14 * MiB, OFF_WTQ = 16 * MiB,
                 OFF_SKB = 20 * MiB, OFF_SMALL = 21 * MiB, OFF_H = 23 * MiB, OFF_ATT = 23 * MiB, OFF_GC = 39 * MiB,
                 OFF_MERGED = 23 * MiB, OFF_PROJ = 87 * MiB, OFF_KVC = 407 * MiB, OFF_IKC = 423 * MiB, OFF_SEL = 427 * MiB, OFF_YATT = 443 * MiB,
                 OFF_YDN = 475 * MiB;
constexpr size_t OFF_H2 = OFF_PROJ, OFF_QP = OFF_PROJ + 64 * MiB, OFF_TOPS = OFF_PROJ + 192 * MiB,
                 OFF_TOPI = OFF_PROJ + 224 * MiB, OFF_EXPERT = OFF_PROJ + 232 * MiB, OFF_GATE = OFF_PROJ + 248 * MiB;
constexpr size_t OFF_UQ = OFF_PROJ + 264 * MiB, OFF_VQ = OFF_PROJ + 280 * MiB, OFF_US = OFF_PROJ + 296 * MiB, OFF_VS = OFF_PROJ + 297 * MiB;
constexpr size_t OFF_CQ8 = 56 * MiB, OFF_QSC = 64 * MiB;
constexpr size_t OFF_H2Q = 23 * MiB, OFF_HS = 55 * MiB, OFF_PD = OFF_PROJ + 64 * MiB;
constexpr size_t DO_U = 0, DO_W = 32 * MiB, DO_QN = 64 * MiB, DO_KNT = 96 * MiB;

constexpr int SMEM_BYTES = 162816;
constexpr float EPS = 1e-6f;

struct Params {
  const float* in[17];
  float* out;
  unsigned char* ws;
  int ph_lo, ph_hi;
  int flags, pad;
};

typedef __bf16 bf16x2_t __attribute__((ext_vector_type(2)));
typedef float f32x2_t __attribute__((ext_vector_type(2)));
__device__ __forceinline__ u32 pack2(float a, float b) {
  f32x2_t f = {a, b};
  return __builtin_bit_cast(u32, __builtin_convertvector(f, bf16x2_t));
}
__device__ __forceinline__ u16 f2bf(float f) { return (u16)(pack2(f, f) & 0xffffu); }
__device__ __forceinline__ float bf2f(u16 h) { return __uint_as_float(((u32)h) << 16); }
__device__ __forceinline__ float bflo(u32 w) { return __uint_as_float(w << 16); }
__device__ __forceinline__ float bfhi(u32 w) { return __uint_as_float(w & 0xffff0000u); }
__device__ __forceinline__ float wave_sum(float v) {
#pragma unroll
  for (int o = 32; o > 0; o >>= 1) v += __shfl_xor(v, o);
  return v;
}
__device__ __forceinline__ float wave_max(float v) {
#pragma unroll
  for (int o = 32; o > 0; o >>= 1) v = fmaxf(v, __shfl_xor(v, o));
  return v;
}
__device__ __forceinline__ float dot2bf(u32 a, u32 b, float acc) {
  return __builtin_amdgcn_fdot2_f32_bf16(__builtin_bit_cast(bf16x2_t, a), __builtin_bit_cast(bf16x2_t, b), acc, false);
}
#define DPPF(v, ctrl) __int_as_float(__builtin_amdgcn_update_dpp(0, __float_as_int(v), ctrl, 0xf, 0xf, true))
__device__ __forceinline__ float wave_sum_dpp(float v) {
  v += DPPF(v, 0xb1);
  v += DPPF(v, 0x4e);
  v += DPPF(v, 0x124);
  v += DPPF(v, 0x128);
  float r0 = __int_as_float(__builtin_amdgcn_readlane(__float_as_int(v), 0));
  float r1 = __int_as_float(__builtin_amdgcn_readlane(__float_as_int(v), 16));
  float r2 = __int_as_float(__builtin_amdgcn_readlane(__float_as_int(v), 32));
  float r3 = __int_as_float(__builtin_amdgcn_readlane(__float_as_int(v), 48));
  return (r0 + r1) + (r2 + r3);
}
__device__ __forceinline__ int opaque_tid() { int t = threadIdx.x; asm volatile("" : "+v"(t)); return t; }
#define TIDX opaque_tid()
#define DPPI(v, ctrl) __builtin_amdgcn_update_dpp(0, (v), ctrl, 0xf, 0xf, true)
__device__ __forceinline__ int wave_sum_i_dpp(int v) {
  v += DPPI(v, 0xb1);
  v += DPPI(v, 0x4e);
  v += DPPI(v, 0x124);
  v += DPPI(v, 0x128);
  return (__builtin_amdgcn_readlane(v, 0) + __builtin_amdgcn_readlane(v, 16)) +
         (__builtin_amdgcn_readlane(v, 32) + __builtin_amdgcn_readlane(v, 48));
}
__device__ __forceinline__ float wave_max_dpp(float v) {
  v = fmaxf(v, DPPF(v, 0xb1));
  v = fmaxf(v, DPPF(v, 0x4e));
  v = fmaxf(v, DPPF(v, 0x124));
  v = fmaxf(v, DPPF(v, 0x128));
  float r0 = __int_as_float(__builtin_amdgcn_readlane(__float_as_int(v), 0));
  float r1 = __int_as_float(__builtin_amdgcn_readlane(__float_as_int(v), 16));
  float r2 = __int_as_float(__builtin_amdgcn_readlane(__float_as_int(v), 32));
  float r3 = __int_as_float(__builtin_amdgcn_readlane(__float_as_int(v), 48));
  return fmaxf(fmaxf(r0, r1), fmaxf(r2, r3));
}
#define WAVE_LDS_SYNC() asm volatile("s_waitcnt lgkmcnt(0)" ::: "memory")
__device__ __forceinline__ float sigmoidf_(float x) { return __builtin_amdgcn_rcpf(1.f + __expf(-x)); }
__device__ __forceinline__ int perm32(int k) {
  int blk = k & ~31, r = k & 31;
  int p = (r < 16) ? (8 * (r >> 2) + (r & 3)) : (8 * ((r - 16) >> 2) + 4 + (r & 3));
  return blk + p;
}

__device__ __forceinline__ u32 fp8x4(float a, float b, float c, float d) {
  int w = __builtin_amdgcn_cvt_pk_fp8_f32(a, b, 0, false);
  w = __builtin_amdgcn_cvt_pk_fp8_f32(c, d, w, true);
  return (u32)w;
}
__device__ __forceinline__ int g8_logical_col(int t) { return ((t & 127) >> 5) * 64 + (t >> 7) * 32 + (t & 31); }
__device__ __forceinline__ int win_map(int n) {
  if (n < 512) return n;
  if (n < 1024) return 768 + (n - 512);
  if (n < 3072) return 1352 + (n - 1024);
  if (n < 5120) return 3408 + (n - 3072);
  if (n < 5248) return 512 + (n - 5120);
  if (n < 5376) return 640 + (n - 5248);
  if (n < 5440) return 1280 + (n - 5376);
  if (n < 5448) return 1344 + (n - 5440);
  if (n < 5452) return 3400 + (n - 5448);
  if (n < 5456) return 3404 + (n - 5452);
  return -1;
}
__device__ __forceinline__ void transpose_tile(const float* __restrict__ src, int Nsrc, u16* __restrict__ dst, int K, int k0, int n0,
                               bool mapped, bool perm8, float* tile  , float f8scale = 0.f) {
  const int tid = TIDX;
  {
    const int tx = tid & 63, ty = tid >> 6;
    int n = n0 + tx;
    if (perm8) n = (n & ~255) + g8_logical_col(n & 255);
    int sc = mapped ? win_map(n) : n;
#pragma unroll
    for (int i = 0; i < 8; ++i) {
      int k = ty + 8 * i;
      float v = (sc >= 0) ? src[(size_t)(k0 + k) * Nsrc + sc] : 0.f;
      tile[k * 65 + tx] = v;
    }
  }
  __syncthreads();
  {
    const int n = tid >> 3, kc = (tid & 7) * 8;
    if (f8scale != 0.f) {
      u32 w[2];
#pragma unroll
      for (int j = 0; j < 2; ++j)
        w[j] = fp8x4(tile[(kc + 4 * j) * 65 + n] * f8scale, tile[(kc + 4 * j + 1) * 65 + n] * f8scale,
                     tile[(kc + 4 * j + 2) * 65 + n] * f8scale, tile[(kc + 4 * j + 3) * 65 + n] * f8scale);
      *(uint2*)((unsigned char*)dst + (size_t)(n0 + n) * K + k0 + kc) = make_uint2(w[0], w[1]);
    } else {
    u32 w[4];
#pragma unroll
    for (int j = 0; j < 4; ++j) w[j] = pack2(tile[(kc + 2 * j) * 65 + n], tile[(kc + 2 * j + 1) * 65 + n]);
    *(uint4*)(dst + (size_t)(n0 + n) * K + k0 + kc) = make_uint4(w[0], w[1], w[2], w[3]);
    }
  }
  __syncthreads();
}

template <bool Q8, bool F8OUT = false>
__device__ __forceinline__ void rmsnorm_rows(const float* __restrict__ x, const float* __restrict__ gain, u16* __restrict__ out,
                                             unsigned char* __restrict__ q8, float* __restrict__ qs) {
  const int lane = TIDX & 63, wave = TIDX >> 6;
  float4 g[4];
#pragma unroll
  for (int i = 0; i < 4; ++i) g[i] = ((const float4*)gain)[lane + 64 * i];
  for (int row = blockIdx.x * 8 + wave; row < MTOK; row += gridDim.x * 8) {
    const float4* xr = (const float4*)(x + (size_t)row * DM);
    float4 v[4];
    float ss = 0.f;
#pragma unroll
    for (int i = 0; i < 4; ++i) {
      v[i] = xr[lane + 64 * i];
      ss += v[i].x * v[i].x + v[i].y * v[i].y + v[i].z * v[i].z + v[i].w * v[i].w;
    }
    ss = wave_sum_dpp(ss);
    float r = rsqrtf(ss * (1.f / DM) + EPS);
    float amax = 0.f;
#pragma unroll
    for (int i = 0; i < 4; ++i) {
      v[i].x *= r * g[i].x; v[i].y *= r * g[i].y; v[i].z *= r * g[i].z; v[i].w *= r * g[i].w;
      if (F8OUT) {
        *(u32*)((unsigned char*)out + (size_t)row * DM + 4 * (lane + 64 * i)) = fp8x4(2.f * v[i].x, 2.f * v[i].y, 2.f * v[i].z, 2.f * v[i].w);
      } else {
        uint2 o;
        o.x = pack2(v[i].x, v[i].y);
        o.y = pack2(v[i].z, v[i].w);
        *(uint2*)(out + (size_t)row * DM + 4 * (lane + 64 * i)) = o;
      }
      if (Q8) amax = fmaxf(amax, fmaxf(fmaxf(fabsf(v[i].x), fabsf(v[i].y)), fmaxf(fabsf(v[i].z), fabsf(v[i].w))));
    }
    if (Q8) {
      amax = wave_max_dpp(amax);
      const float inv = amax > 0.f ? 127.f / amax : 0.f;
#pragma unroll
      for (int i = 0; i < 4; ++i) {
        const int q0 = (int)rintf(v[i].x * inv), q1 = (int)rintf(v[i].y * inv), q2 = (int)rintf(v[i].z * inv), q3 = (int)rintf(v[i].w * inv);
        *(u32*)(q8 + (size_t)row * DM + 4 * (lane + 64 * i)) =
            (u32)(q0 & 0xff) | ((u32)(q1 & 0xff) << 8) | ((u32)(q2 & 0xff) << 16) | ((u32)(q3 & 0xff) << 24);
      }
      if (lane == 0) qs[row] = amax * (1.f / 127.f);
    }
  }
}

__device__ __forceinline__ void phase0(const Params& p, unsigned char* smem) {
  float* tile = (float*)smem;
  unsigned char* ws = p.ws;
  const int n_in = 16 * 88, n_a = 8 * 16, n_b = 8 * 16, n_o = 16 * 16, n_q = 16 * 32;
  const int total = n_in + n_a + n_b + n_o + n_q;
  for (int t = blockIdx.x; t < total; t += gridDim.x) {
    int i = t;
    if (i < n_in) { transpose_tile(p.in[2], 5456, (u16*)(ws + OFF_WTIN), 1024, (i / 88) * 64, (i % 88) * 64, true, true, tile, 32.f); continue; }
    i -= n_in;
    if (i < n_a) { transpose_tile(p.in[9], 1024, (u16*)(ws + OFF_WTA), 512, (i / 16) * 64, (i % 16) * 64, false, true, tile); continue; }
    i -= n_a;
    if (i < n_b) { transpose_tile(p.in[10], 1024, (u16*)(ws + OFF_WTB), 512, (i / 16) * 64, (i % 16) * 64, false, true, tile); continue; }
    i -= n_b;
    if (i < n_o) { transpose_tile(p.in[11], 1024, (u16*)(ws + OFF_WTO), 1024, (i / 16) * 64, (i % 16) * 64, false, true, tile); continue; }
    i -= n_o;
    transpose_tile(p.in[13], 2048, (u16*)(ws + OFF_WTQ), 1024, (i / 32) * 64, (i % 32) * 64, false, true, tile);
  }
  {
    const float* sk = p.in[14];
    u16* skb = (u16*)(ws + OFF_SKB);
    for (int i = blockIdx.x * NTHREADS + TIDX; i < 16 * 128 * 128; i += gridDim.x * NTHREADS) skb[i] = f2bf(sk[i]);
  }
  rmsnorm_rows<false, true>(p.in[0], p.in[1], (u16*)(ws + OFF_H), nullptr, nullptr);
}

constexpr int G_BM = 256, G_BN = 128, G_BK = 64;
constexpr int G_ABYTES = G_BM * 128;

template <int MI>
__device__ __forceinline__ void gemm_mainloop_t(const u16* __restrict__ A, int lda, const u16* __restrict__ Bt, int ldb, int K,
                                                int m0, int n0, unsigned char* smem, f32x4 (&acc)[MI][4]) {
  constexpr int BN = (MI == 4) ? 128 : 256;
  constexpr int NRB = BN / 64;
  constexpr int STAGE = G_ABYTES + BN * 128;
  const int tid = TIDX, lane = tid & 63, wave = tid >> 6;
  const int wm = (MI == 4) ? (wave >> 1) : (wave >> 2), wn = (MI == 4) ? (wave & 1) : (wave & 3);
#pragma unroll
  for (int i = 0; i < MI; ++i)
#pragma unroll
    for (int j = 0; j < 4; ++j) acc[i][j] = (f32x4){0.f, 0.f, 0.f, 0.f};
  const int kc = tid & 7;
  const int arow = tid >> 3;
  u32x4 ra[4], rb[NRB];
  const u16* ap = A + (size_t)(m0 + arow) * lda + kc * 8;
  const u16* bp = Bt + (size_t)(n0 + arow) * ldb + kc * 8;
  const int nk = K / G_BK;
  const int fr = lane & 15, fg = lane >> 4;
#define G_LOAD(kt_)                                                                       \
  {                                                                                       \
    const u16* ap2_ = ap + (size_t)(kt_) * G_BK;                                          \
    const u16* bp2_ = bp + (size_t)(kt_) * G_BK;                                          \
    _Pragma("unroll") for (int i = 0; i < 4; ++i) ra[i] = *(const u32x4*)(ap2_ + (size_t)(64 * i) * lda); \
    _Pragma("unroll") for (int i = 0; i < NRB; ++i) rb[i] = *(const u32x4*)(bp2_ + (size_t)(64 * i) * ldb); \
  }
#define G_STORE(st_)                                                                      \
  {                                                                                       \
    unsigned char* sa_ = smem + (st_) * STAGE;                                            \
    unsigned char* sb_ = sa_ + G_ABYTES;                                                  \
    _Pragma("unroll") for (int i = 0; i < 4; ++i) { int r = arow + 64 * i; *(u32x4*)(sa_ + r * 128 + ((kc ^ (r & 7)) << 4)) = ra[i]; } \
    _Pragma("unroll") for (int i = 0; i < NRB; ++i) { int r = arow + 64 * i; *(u32x4*)(sb_ + r * 128 + ((kc ^ (r & 7)) << 4)) = rb[i]; } \
  }
  G_LOAD(0)
  __syncthreads();
  G_STORE(0)
  if (nk > 1) G_LOAD(1)
  __syncthreads();
  for (int kt = 0; kt < nk; ++kt) {
    if (kt + 1 < nk) G_STORE((kt + 1) & 1)
    if (kt + 2 < nk) G_LOAD(kt + 2)
    __builtin_amdgcn_sched_barrier(0);
    const unsigned char* sa = smem + (kt & 1) * STAGE;
    const unsigned char* sb = sa + G_ABYTES;
#pragma unroll
    for (int kk = 0; kk < 2; ++kk) {
      bf16x8 bfr[4];
#pragma unroll
      for (int j = 0; j < 4; ++j) {
        int r = wn * 64 + j * 16 + fr;
        bfr[j] = *(const bf16x8*)(sb + r * 128 + (((kk * 4 + fg) ^ (r & 7)) << 4));
      }
#pragma unroll
      for (int ih = 0; ih < MI; ih += 4) {
        bf16x8 af[4];
#pragma unroll
        for (int i = 0; i < 4; ++i) {
          int r = wm * (MI * 16) + (ih + i) * 16 + fr;
          af[i] = *(const bf16x8*)(sa + r * 128 + (((kk * 4 + fg) ^ (r & 7)) << 4));
        }
#pragma unroll
        for (int i = 0; i < 4; ++i)
#pragma unroll
          for (int j = 0; j < 4; ++j) acc[ih + i][j] = __builtin_amdgcn_mfma_f32_16x16x32_bf16(af[i], bfr[j], acc[ih + i][j], 0, 0, 0);
        if (MI == 8 && ih == 0) __builtin_amdgcn_sched_barrier(0);
      }
    }
    __syncthreads();
  }
#undef G_LOAD
#undef G_STORE
}
__device__ __forceinline__ void gemm_mainloop(const u16* __restrict__ A, int lda, const u16* __restrict__ Bt, int ldb, int K,
                                              int m0, int n0, unsigned char* smem, f32x4 (&acc)[4][4]) {
  gemm_mainloop_t<4>(A, lda, Bt, ldb, K, m0, n0, smem, acc);
}

__device__ __forceinline__ int g8_lds_byte(int r, int c) {
  int st = (r >> 4) * 2 + (c >> 5), rr = r & 15, cc = c & 31, ob = rr * 64 + cc * 2;
  return st * 1024 + (ob ^ (((ob >> 9) & 1) << 5));
}
__device__ __forceinline__ void g8_stage_rc(int b, int& R, int& C) {
  int st = b / 1024, sb = b % 1024, swz = sb ^ (((sb >> 9) & 1) << 5);
  R = (st >> 1) * 16 + swz / 64; C = (st & 1) * 32 + (swz % 64) / 2;
}
typedef __attribute__((address_space(3))) unsigned int lds_u32;
template <int F8 = 0, int SC = 127>
__device__ __forceinline__ void gemm8_tile(const u16* __restrict__ A, const u16* __restrict__ Bt, int K, int brow, int bcol,
                                           unsigned char* smem, f32x4 (&acc)[2][2][4][2]) {
  typedef int i32x8_ __attribute__((ext_vector_type(8)));
  typedef int i32x4_ __attribute__((ext_vector_type(4)));
  constexpr int HTB = 16384;
  const int tid = TIDX;
  const int wid = tid >> 6, lane = tid & 63, wr = wid >> 2, wc = wid & 3, fr = lane & 15, fq = lane >> 4;
#define SA(b, h) (smem + ((b) * 2 + (h)) * HTB)
#define SB(b, h) (smem + (4 + (b) * 2 + (h)) * HTB)
  u32 soff0;
  { int _r, _c; g8_stage_rc(tid * 16, _r, _c); soff0 = (u32)(_r * K + _c) * 2u; }
  const int wbase = __builtin_amdgcn_readfirstlane(wid) * 1024;
#define STAGE(P, BASE, br, kt) do { \
    unsigned long long _uv0 = (unsigned long long)(BASE) + (unsigned long long)(((long)(br) * K + (long)(kt) * 64) * 2); \
    unsigned long long _uv1 = _uv0 + (unsigned long long)(64 * K * 2); \
    asm volatile("" : "+s"(_uv0), "+s"(_uv1), "+v"(soff0)); \
    __builtin_amdgcn_global_load_lds((const unsigned int*)((const unsigned char*)_uv0 + soff0), (lds_u32*)((P) + wbase), 16, 0, 0); \
    __builtin_amdgcn_global_load_lds((const unsigned int*)((const unsigned char*)_uv1 + soff0), (lds_u32*)((P) + wbase + 8192), 16, 0, 0); } while (0)
#define LDA(dst, b, h) _Pragma("unroll") for (int m = 0; m < 4; ++m) _Pragma("unroll") for (int k = 0; k < 2; ++k) \
    dst[m][k] = *(const bf16x8*)(SA(b, h) + g8_lds_byte(wr * 64 + m * 16 + fr, k * 32 + fq * 8))
#define LDB(dst, b, h) _Pragma("unroll") for (int n = 0; n < 2; ++n) _Pragma("unroll") for (int k = 0; k < 2; ++k) \
    dst[n][k] = *(const bf16x8*)(SB(b, h) + g8_lds_byte(wc * 32 + n * 16 + fr, k * 32 + fq * 8))
#define MMA(ai, bj, At_, Bt_) do { __builtin_amdgcn_s_setprio(1); \
    if (F8) { \
      _Pragma("unroll") for (int m = 0; m < 4; ++m) _Pragma("unroll") for (int n = 0; n < 2; ++n) \
          \
        asm volatile("v_mfma_scale_f32_16x16x128_f8f6f4 %0, %1, %2, %0, %3, %3 op_sel_hi:[0,0,0]" \
            : "+v"(acc[ai][bj][m][n]) \
            : "v"(__builtin_shufflevector((i32x4_)At_[m][0], (i32x4_)At_[m][1], 0, 1, 2, 3, 4, 5, 6, 7)), \
              "v"(__builtin_shufflevector((i32x4_)Bt_[n][0], (i32x4_)Bt_[n][1], 0, 1, 2, 3, 4, 5, 6, 7)), "v"(scv)); \
    } else { \
    _Pragma("unroll") for (int m = 0; m < 4; ++m) _Pragma("unroll") for (int n = 0; n < 2; ++n) _Pragma("unroll") for (int k = 0; k < 2; ++k) \
      acc[ai][bj][m][n] = __builtin_amdgcn_mfma_f32_16x16x32_bf16(At_[m][k], Bt_[n][k], acc[ai][bj][m][n], 0, 0, 0); \
    } \
    __builtin_amdgcn_s_setprio(0); } while (0)
#define WAIT_V(n) asm volatile("s_waitcnt vmcnt(" #n ")" ::: "memory")
#define WAIT_L(n) asm volatile("s_waitcnt lgkmcnt(" #n ")" ::: "memory")
#define BAR __builtin_amdgcn_s_barrier()
#define SCHED __builtin_amdgcn_sched_barrier(0)
#pragma unroll
  for (int a = 0; a < 2; ++a)
#pragma unroll
    for (int b2 = 0; b2 < 2; ++b2)
#pragma unroll
      for (int m = 0; m < 4; ++m)
#pragma unroll
        for (int n = 0; n < 2; ++n) acc[a][b2][m][n] = (f32x4){0.f, 0.f, 0.f, 0.f};
  bf16x8 At[4][2], B0[2][2], B1[2][2];
  const int scv = SC * 0x01010101;
  const int nt = K / 64;
  constexpr int HALF = 128;
  __syncthreads();
  STAGE(SB(0, 0), Bt, bcol, 0); STAGE(SA(0, 0), A, brow, 0);
  STAGE(SB(0, 1), Bt, bcol + HALF, 0); STAGE(SA(0, 1), A, brow + HALF, 0);
  if (wr == 1) BAR;
  WAIT_V(4); BAR;
  STAGE(SB(1, 0), Bt, bcol, 1); STAGE(SA(1, 0), A, brow, 1); STAGE(SB(1, 1), Bt, bcol + HALF, 1);
  WAIT_V(6); BAR;
#pragma unroll 1
  for (int t = 0; t < nt - 2; t += 2) {
    LDB(B0, 0, 0); SCHED; LDA(At, 0, 0); STAGE(SA(1, 1), A, brow + HALF, t + 1);
    WAIT_L(8); BAR; WAIT_L(0); MMA(0, 0, At, B0); BAR; SCHED;
    LDB(B1, 0, 1); STAGE(SB(0, 0), Bt, bcol, t + 2);
    BAR; WAIT_L(0); MMA(0, 1, At, B1); BAR;
    LDA(At, 0, 1); STAGE(SA(0, 0), A, brow, t + 2);
    BAR; WAIT_L(0); MMA(1, 0, At, B0); BAR; SCHED;
    STAGE(SB(0, 1), Bt, bcol + HALF, t + 2);
    WAIT_V(6); BAR; MMA(1, 1, At, B1); BAR;
    LDB(B0, 1, 0); SCHED; LDA(At, 1, 0); STAGE(SA(0, 1), A, brow + HALF, t + 2);
    WAIT_L(8); BAR; WAIT_L(0); MMA(0, 0, At, B0); BAR; SCHED;
    LDB(B1, 1, 1); STAGE(SB(1, 0), Bt, bcol, t + 3);
    BAR; WAIT_L(0); MMA(0, 1, At, B1); BAR;
    LDA(At, 1, 1); STAGE(SA(1, 0), A, brow, t + 3);
    BAR; WAIT_L(0); MMA(1, 0, At, B0); BAR; SCHED;
    STAGE(SB(1, 1), Bt, bcol + HALF, t + 3);
    WAIT_V(6); BAR; MMA(1, 1, At, B1); BAR;
  }
#define ACC_PIN() _Pragma("unroll") for (int a = 0; a < 2; ++a) _Pragma("unroll") for (int b2 = 0; b2 < 2; ++b2) \
      asm volatile("" : "+v"(acc[a][b2][0][0]), "+v"(acc[a][b2][0][1]), "+v"(acc[a][b2][1][0]), "+v"(acc[a][b2][1][1]), \
                        "+v"(acc[a][b2][2][0]), "+v"(acc[a][b2][2][1]), "+v"(acc[a][b2][3][0]), "+v"(acc[a][b2][3][1]))
  ACC_PIN();
  { LDB(B0, 0, 0); LDA(At, 0, 0); STAGE(SA(1, 1), A, brow + HALF, nt - 1);
    BAR; WAIT_L(0); MMA(0, 0, At, B0); BAR; SCHED;
    LDB(B1, 0, 1); BAR; WAIT_L(0); MMA(0, 1, At, B1); BAR; SCHED;
    LDA(At, 0, 1); WAIT_V(4); BAR; WAIT_L(0); MMA(1, 0, At, B0); SCHED; MMA(1, 1, At, B1); BAR; SCHED; }
  { LDB(B0, 1, 0); LDA(At, 1, 0); WAIT_V(2); BAR; WAIT_L(0); MMA(0, 0, At, B0); BAR; SCHED;
    LDB(B1, 1, 1); WAIT_V(0); BAR; WAIT_L(0); MMA(0, 1, At, B1); BAR; SCHED;
    LDA(At, 1, 1); BAR; WAIT_L(0); MMA(1, 0, At, B0); SCHED; MMA(1, 1, At, B1); BAR; SCHED; }
  ACC_PIN();
#undef ACC_PIN
  if (wr == 0) BAR;
#undef SA
#undef SB
#undef STAGE
#undef LDA
#undef LDB
#undef MMA
#undef WAIT_V
#undef WAIT_L
#undef BAR
#undef SCHED
}

template <int LD, bool NORM>
__device__ __forceinline__ void ep_store(u16* __restrict__ dst, u32 ob, const f32x4 (&acc)[2][2][4][2], const float* __restrict__ gain,
                                         float extra, unsigned char* smem, int wave, int lane_in) {
  int lane = lane_in;
  asm volatile("" : "+v"(lane));
  const int fr = lane & 15, fq = lane >> 4;
  unsigned char* reg = smem + wave * 16384;
  float gj[4] = {1.f, 1.f, 1.f, 1.f};
  if (NORM) {
#pragma unroll
    for (int j = 0; j < 4; ++j) gj[j] = gain[j * 16 + fr] * extra;
  }
  const int lrot = (fr >> 3) + 2 * fq;
  unsigned char* wbase = reg + (4 * fq) * 128 + (fr & 7) * 2;
#pragma unroll
  for (int ai = 0; ai < 2; ++ai)
#pragma unroll
    for (int m = 0; m < 4; ++m) {
#pragma unroll
      for (int r = 0; r < 4; ++r) {
        float rs = 1.f;
        if (NORM) {
          float sq = 0.f;
#pragma unroll
          for (int bj = 0; bj < 2; ++bj)
#pragma unroll
            for (int n = 0; n < 2; ++n) sq += acc[ai][bj][m][n][r] * acc[ai][bj][m][n][r];
          sq += DPPF(sq, 0xb1); sq += DPPF(sq, 0x4e); sq += DPPF(sq, 0x141); sq += DPPF(sq, 0x140);
          rs = rsqrtf(sq * (1.f / 64.f) + EPS);
        }
#pragma unroll
        for (int bj = 0; bj < 2; ++bj)
#pragma unroll
          for (int n = 0; n < 2; ++n) {
            const float v = acc[ai][bj][m][n][r];
            const int ch = ((bj * 2 + n) * 2 + lrot) & 7;
            *(u16*)(wbase + (ai * 64 + m * 16 + r) * 128 + (ch << 4)) = f2bf(NORM ? v * rs * gj[bj * 2 + n] : v);
          }
      }
      __builtin_amdgcn_sched_barrier(0);
    }
  WAVE_LDS_SYNC();
  const int c16 = lane & 7, r8 = lane >> 3;
#pragma unroll
  for (int it = 0; it < 16; ++it) {
    const int rw = it * 8 + r8;
    const u32x4 v = *(const u32x4*)(reg + rw * 128 + (((c16 + 2 * ((rw >> 2) & 3)) & 7) << 4));
    const int grow = (it >> 3) * 128 + (it & 7) * 8 + r8;
    *(u32x4*)(dst + ob + (u32)(grow * LD + c16 * 8)) = v;
    if ((it & 3) == 3) __builtin_amdgcn_sched_barrier(0);
  }
}

template <bool NORM>
__device__ __forceinline__ void ep_store8(unsigned char* __restrict__ dst, u32 ob, const f32x4 (&acc)[2][2][4][2],
                                          const float* __restrict__ gain, unsigned char* smem, int wave, int lane_in) {
  int lane = lane_in;
  asm volatile("" : "+v"(lane));
  const int fr = lane & 15, fq = lane >> 4;
  unsigned char* reg = smem + wave * 16384;
  float gj[4] = {1.f, 1.f, 1.f, 1.f};
  if (NORM) {
#pragma unroll
    for (int j = 0; j < 4; ++j) gj[j] = gain[j * 16 + fr];
  }
#pragma unroll
  for (int ai = 0; ai < 2; ++ai)
#pragma unroll
    for (int m = 0; m < 4; ++m) {
#pragma unroll
      for (int r = 0; r < 4; ++r) {
        float rs = 1.f;
        if (NORM) {
          float sq = 0.f;
#pragma unroll
          for (int bj = 0; bj < 2; ++bj)
#pragma unroll
            for (int n = 0; n < 2; ++n) sq += acc[ai][bj][m][n][r] * acc[ai][bj][m][n][r];
          sq += DPPF(sq, 0xb1); sq += DPPF(sq, 0x4e); sq += DPPF(sq, 0x141); sq += DPPF(sq, 0x140);
          rs = rsqrtf(sq * (1.f / 64.f) + EPS);
        }
        const int rw = ai * 64 + m * 16 + 4 * fq + r;
#pragma unroll
        for (int bj = 0; bj < 2; ++bj)
#pragma unroll
          for (int n = 0; n < 2; ++n) {
            const float v = NORM ? acc[ai][bj][m][n][r] * rs * gj[bj * 2 + n] : acc[ai][bj][m][n][r];
            reg[rw * 64 + ((((bj * 2 + n) + (rw >> 2)) & 3) << 4) + fr] =
                (unsigned char)(__builtin_amdgcn_cvt_pk_fp8_f32(v, v, 0, false) & 0xff);
          }
      }
      __builtin_amdgcn_sched_barrier(0);
    }
  WAVE_LDS_SYNC();
  const int c4 = lane & 3, r16 = lane >> 2;
#pragma unroll
  for (int it = 0; it < 8; ++it) {
    const int rw = it * 16 + r16;
    const u32x4 v = *(const u32x4*)(reg + rw * 64 + (((c4 + (rw >> 2)) & 3) << 4));
    const int grow = (rw >> 6) * 128 + (rw & 63);
    *(u32x4*)(dst + ob + (u32)(grow * 256 + c4 * 16)) = v;
  }
}

__device__ __forceinline__ void phase1(const Params& p, unsigned char* smem) {
  const u16* H = (const u16*)(p.ws + OFF_H);
  const u16* WT = (const u16*)(p.ws + OFF_WTIN);
  u16* PROJ = (u16*)(p.ws + OFF_PROJ);
  u16* KVC = (u16*)(p.ws + OFF_KVC);
  u16* IKC = (u16*)(p.ws + OFF_IKC);
  float* SMALL = (float*)(p.ws + OFF_SMALL);
  const int ntn = NPADW / 256;
  const int ntiles = (MTOK / 256) * ntn;
  for (int t = blockIdx.x; t < ntiles; t += gridDim.x) {
    const int m0 = (t / ntn) * 256, n0 = (t % ntn) * 256;
    f32x4 acc[2][2][4][2];
    gemm8_tile<1, 124>(H, WT, DM / 2, m0, n0, smem, acc);
    const int tid_e = TIDX, lane = tid_e & 63, wave = tid_e >> 6;
    const int wr = wave >> 2, wc = wave & 3, fr = lane & 15, fq = lane >> 4;
    const int cbase = n0 + wc * 64;
    const u32 rbase = (u32)(m0 + wr * 64);
    if (cbase < C_IQ) {
      ep_store<LDP, true>(PROJ, rbase * LDP + (u32)cbase, acc, p.in[3], 0.125f, smem, wave, lane);
    } else if (cbase < LDP) {
      ep_store<LDP, false>(PROJ, rbase * LDP + (u32)cbase, acc, nullptr, 1.f, smem, wave, lane);
    } else if (cbase < N_AV) {
      ep_store8<true>(p.ws + OFF_KVC, rbase * 256 + (u32)(cbase - N_AK), acc, p.in[4], smem, wave, lane);
    } else if (cbase < N_IK) {
      ep_store8<false>(p.ws + OFF_KVC, rbase * 256 + (u32)(cbase - N_AV + 128), acc, nullptr, smem, wave, lane);
    } else if (cbase < N_SM) {
      ep_store<64, false>(IKC, rbase * 64, acc, nullptr, 1.f, smem, wave, lane);
    } else if (cbase == N_SM) {
      const u32 sb0 = (rbase + 4 * fq) * 16 + (u32)fr;
#pragma unroll
      for (int ai = 0; ai < 2; ++ai)
#pragma unroll
        for (int m = 0; m < 4; ++m)
#pragma unroll
          for (int r = 0; r < 4; ++r) SMALL[sb0 + (u32)((ai * 128 + m * 16 + r) * 16)] = acc[ai][0][m][0][r];
    }
  }
}

constexpr int IDX_RS = 8208;

__device__ __forceinline__ u32 f2key(float x) {
  _Float16 h = (_Float16)x;
  u32 b = (u32) * (u16*)&h;
  return (b & 0x8000u) ? ((~b) & 0xffffu) : (b | 0x8000u);
}
__device__ __forceinline__ int count_ge_wave(const u32 (&kreg)[32], u32 mid, int ndw) {
  const u32 m1 = (mid - 1u) * 0x00010001u;
  const u32 one = 0x00010001u;
  u32 acc0 = 0u, acc1 = 0u;
#pragma unroll
  for (int c4 = 0; c4 < 8; ++c4) {
    if (c4 * 4 < ndw) {
#pragma unroll
      for (int i = c4 * 4; i < c4 * 4 + 4; i += 2) {
        u32 t0, t1;
        asm("v_pk_sub_u16 %0, %1, %2 clamp" : "=v"(t0) : "v"(kreg[i]), "s"(m1));
        asm("v_pk_sub_u16 %0, %1, %2 clamp" : "=v"(t1) : "v"(kreg[i + 1]), "s"(m1));
        asm("v_pk_min_u16 %0, %1, %2" : "=v"(t0) : "v"(t0), "s"(one));
        asm("v_pk_min_u16 %0, %1, %2" : "=v"(t1) : "v"(t1), "s"(one));
        asm("v_pk_add_u16 %0, %1, %2" : "=v"(acc0) : "v"(acc0), "v"(t0));
        asm("v_pk_add_u16 %0, %1, %2" : "=v"(acc1) : "v"(acc1), "v"(t1));
      }
    }
  }
  int c = (int)((acc0 & 0xffffu) + (acc0 >> 16) + (acc1 & 0xffffu) + (acc1 >> 16));
  return wave_sum_i_dpp(c);
}

__device__ __forceinline__ void idx_item(const Params& p, unsigned char* smem, int b, int tq) {
  const u16* PROJ = (const u16*)(p.ws + OFF_PROJ);
  const float* SMALL = (const float*)(p.ws + OFF_SMALL);
  u16* SEL = (u16*)(p.ws + OFF_SEL);
  const int tid = TIDX, lane = tid & 63, wave = tid >> 6;
  const int t0 = tq * 16;
  const size_t tokb = (size_t)b * SEQ;
  if (tq < 16) {
    for (int rr = 0; rr < 2; ++rr) {
      int row = 2 * wave + rr, t = t0 + row;
      u16* out = SEL + (tokb + t) * 256;
      for (int i = lane; i < 256; i += 64) out[i] = (i <= t) ? (u16)i : (u16)0xFFFF;
    }
    return;
  }
  const int q = lane & 15, g = lane >> 4;
  __syncthreads();
  {
    const u16* iqrow = PROJ + (tokb + t0 + q) * LDP + C_IQ;
    bf16x8 bq[8][2];
    float wq[8];
#pragma unroll
    for (int h = 0; h < 8; ++h) {
      bq[h][0] = *(const bf16x8*)(iqrow + h * 64 + g * 8);
      bq[h][1] = *(const bf16x8*)(iqrow + h * 64 + 32 + g * 8);
      wq[h] = SMALL[(tokb + t0 + q) * 16 + h];
    }
    bf16x8 bqs[2];
    {
      typedef u32 u32x4_ __attribute__((ext_vector_type(4)));
#pragma unroll
      for (int kk = 0; kk < 2; ++kk) {
        float s8[8];
#pragma unroll
        for (int e = 0; e < 8; ++e) s8[e] = 0.f;
#pragma unroll
        for (int h = 0; h < 8; ++h) {
          const u32x4_ w4 = (u32x4_)bq[h][kk];
#pragma unroll
          for (int c = 0; c < 4; ++c) { s8[2 * c] = fmaf(wq[h], bflo(w4[c]), s8[2 * c]); s8[2 * c + 1] = fmaf(wq[h], bfhi(w4[c]), s8[2 * c + 1]); }
        }
        u32x4_ o4;
#pragma unroll
        for (int c = 0; c < 4; ++c) o4[c] = pack2(s8[2 * c], s8[2 * c + 1]);
        bqs[kk] = (bf16x8)o4;
      }
    }
    const int nkb = tq + 1;
    const int niter = (nkb > wave) ? ((nkb - wave + 7) >> 3) : 0;
    const u16* ikbase = (const u16*)(p.ws + OFF_IKC) + (tokb + q) * 64 + g * 8;
    bf16x8 ca[3][2];
#pragma unroll
    for (int j = 0; j < 3; ++j)
      if (j < niter) {
        const u16* ikrow = ikbase + (size_t)((wave + 8 * j) * 16) * 64;
        ca[j][0] = *(const bf16x8*)(ikrow); ca[j][1] = *(const bf16x8*)(ikrow + 32);
      }
    for (int i0 = 0; i0 < ((p.flags & 8) ? 0 : niter); i0 += 3) {
#pragma unroll
      for (int j = 0; j < 3; ++j) {
        if (i0 + j < niter) {
          const int s0 = (wave + 8 * (i0 + j)) * 16;
          f32x4 tot = {0.f, 0.f, 0.f, 0.f};
          tot = __builtin_amdgcn_mfma_f32_16x16x32_bf16(ca[j][0], bqs[0], tot, 0, 0, 0);
          tot = __builtin_amdgcn_mfma_f32_16x16x32_bf16(ca[j][1], bqs[1], tot, 0, 0, 0);
#pragma unroll
          for (int h = 0; h < 8; ++h) {
            f32x4 acc = {0.f, 0.f, 0.f, 0.f};
            acc = __builtin_amdgcn_mfma_f32_16x16x32_bf16(ca[j][0], bq[h][0], acc, 0, 0, 0);
            acc = __builtin_amdgcn_mfma_f32_16x16x32_bf16(ca[j][1], bq[h][1], acc, 0, 0, 0);
#pragma unroll
            for (int r = 0; r < 4; ++r) tot[r] = fmaf(fabsf(acc[r]), wq[h], tot[r]);
          }
          if (i0 + 3 + j < niter) {
            const u16* ikrow = ikbase + (size_t)((wave + 8 * (i0 + 3 + j)) * 16) * 64;
            ca[j][0] = *(const bf16x8*)(ikrow); ca[j][1] = *(const bf16x8*)(ikrow + 32);
          }
          typedef short s16x2_ __attribute__((ext_vector_type(2)));
          u32x2 w2;
#pragma unroll
          for (int c = 0; c < 2; ++c) {
            const u32 pk = __builtin_bit_cast(u32, __builtin_amdgcn_cvt_pkrtz(tot[2 * c], tot[2 * c + 1]));
            const u32 sm = __builtin_bit_cast(u32, __builtin_bit_cast(s16x2_, pk) >> (s16x2_){15, 15});
            w2[c] = pk ^ (sm | 0x80008000u);
          }
          if (s0 == t0) {
#pragma unroll
            for (int c = 0; c < 2; ++c) {
              const int sidx = s0 + 4 * g + 2 * c;
              w2[c] = (sidx <= t0 + q ? (w2[c] & 0xffffu) : 0u) | (sidx + 1 <= t0 + q ? (w2[c] & 0xffff0000u) : 0u);
            }
          }
          *(u32x2*)(smem + q * IDX_RS + (s0 + 4 * g) * 2) = w2;
        }
        __builtin_amdgcn_sched_barrier(0);
      }
    }
    const int nk = t0 + 16, nk64 = (nk + 511) & ~511;
#pragma unroll
    for (int rr = 0; rr < 2; ++rr) {
      const int cb = nk * 2 + lane * 16;
      if (cb < nk64 * 2) *(u32x4*)(smem + (2 * wave + rr) * IDX_RS + cb) = (u32x4){0u, 0u, 0u, 0u};
    }
  }
  __syncthreads();
  const int ndw = ((t0 + 16 + 511) >> 9) << 2;
  for (int rr = 0; rr < ((p.flags & 16) ? 0 : 2); ++rr) {
    const int row = 2 * wave + rr, t = t0 + row;
    u16* out = SEL + (tokb + t) * 256;
    u32 kreg[32];
    {
      const u32* src = (const u32*)(smem + row * IDX_RS) + lane;
#pragma unroll
      for (int c4 = 0; c4 < 8; ++c4)
        if (c4 * 4 < ndw) {
#pragma unroll
          for (int i = c4 * 4; i < c4 * 4 + 4; ++i) kreg[i] = src[i * 64];
        }
    }
    WAVE_LDS_SYNC();
    u32 lo = 1u, hi = 65535u;
    while (lo < hi) {
      u32 mid = (lo + hi + 1u) >> 1;
      int c = count_ge_wave(kreg, mid, ndw);
      if (c >= 256) lo = mid; else hi = mid - 1u;
    }
    const u32 tau = lo;
    int gt = 0, eq = 0;
#pragma unroll
    for (int c4 = 0; c4 < 8; ++c4)
      if (c4 * 4 < ndw) {
#pragma unroll
        for (int i = c4 * 4; i < c4 * 4 + 4; ++i) {
          u32 a = kreg[i] & 0xffffu, c2 = kreg[i] >> 16;
          gt += (a > tau) ? 1 : 0; gt += (c2 > tau) ? 1 : 0;
          eq += (a == tau) ? 1 : 0; eq += (c2 == tau) ? 1 : 0;
        }
      }
    int packed = gt | (eq << 16);
    int incl = packed;
#pragma unroll
    for (int o = 1; o < 64; o <<= 1) {
      int v = __shfl_up(incl, o);
      if (lane >= o) incl += v;
    }
    const int excl = incl - packed;
    const int total = __shfl(incl, 63);
    const int need = 256 - (total & 0xffff);
    const int pg = excl & 0xffff, pe = excl >> 16;
    int pos = pg + min(pe, need);
    int eqseen = pe;
    u16* lrow = (u16*)(smem + row * IDX_RS);
#pragma unroll
    for (int c4 = 0; c4 < 8; ++c4)
      if (c4 * 4 < ndw) {
#pragma unroll
        for (int i = c4 * 4; i < c4 * 4 + 4; ++i) {
#pragma unroll
          for (int hh = 0; hh < 2; ++hh) {
            u32 kv = hh ? (kreg[i] >> 16) : (kreg[i] & 0xffffu);
            int idx = 128 * i + 2 * lane + hh;
            bool take = false;
            if (kv > tau) take = true;
            else if (kv == tau) { take = (eqseen < need); ++eqseen; }
            if (take) { lrow[pos] = (u16)idx; ++pos; }
          }
        }
      }
    WAVE_LDS_SYNC();
    *(u32x2*)(out + lane * 4) = *(const u32x2*)(lrow + lane * 4);
    WAVE_LDS_SYNC();
  }
}

constexpr int DNP = 68;
constexpr int DL_KT = 0;
constexpr int DL_V = DL_KT + 128 * DNP * 4;
constexpr int DL_QB = DL_V + 64 * 128 * 4;
constexpr int DL_KB = DL_QB + 64 * 272;
constexpr int DL_SM = DL_KB + 64 * 272;
constexpr int DL_RAW = DL_SM + 2048;
static_assert(DL_RAW + 3 * 67 * 272 <= SMEM_BYTES && 16384 + 64 * 144 + 2048 <= 3 * 67 * 272, "dn_local LDS");
__device__ __forceinline__ void dn_local_item(const Params& p, unsigned char* smem, int item) {
  const int h = item & 3, n = (item >> 2) & 63, b = item >> 8;
  const u16* PROJ = (const u16*)(p.ws + OFF_PROJ);
  const float* SMALL = (const float*)(p.ws + OFF_SMALL);
  u16* Ug = (u16*)((unsigned char*)p.out + DO_U);
  u16* Wg = (u16*)((unsigned char*)p.out + DO_W);
  u16* QNg = (u16*)((unsigned char*)p.out + DO_QN);
  u16* KNTg = (u16*)((unsigned char*)p.out + DO_KNT);
  u16* ATTg = (u16*)(p.ws + OFF_ATT);
  float* GCg = (float*)(p.ws + OFF_GC);
  const float* convw = p.in[5];
  const int tid = TIDX, lane = tid & 63, wave = tid >> 6;
  const int c0 = n * 64;
  const size_t tok0 = (size_t)b * SEQ + c0;
  float* Kt = (float*)(smem + DL_KT);
  float* V = (float*)(smem + DL_V);
  unsigned char* Qb = smem + DL_QB;
  unsigned char* Kb = smem + DL_KB;
  float* gc = (float*)(smem + DL_SM);
  float* beta = gc + 64;
  float* ssp = beta + 64;
  unsigned char* RAW = smem + DL_RAW;
  float* AmT = (float*)(smem + DL_RAW);
  __syncthreads();
  {
    u32x4 rg[7];
#pragma unroll
    for (int k = 0; k < 7; ++k) {
      const int ci = tid + 512 * k;
      rg[k] = (u32x4){0u, 0u, 0u, 0u};
      if (ci < 3216) {
        const int arr = ci / 1072, rem = ci - arr * 1072, row = rem >> 4, ch = rem & 15;
        const int trel = c0 - 3 + row;
        if (trel >= 0)
          rg[k] = *(const u32x4*)(PROJ + ((size_t)b * SEQ + trel) * LDP + (C_DQ + arr * 512) + h * 128 + ch * 8);
      }
    }
#pragma unroll
    for (int k = 0; k < 7; ++k) {
      const int ci = tid + 512 * k;
      if (ci < 3216) {
        const int arr = ci / 1072, rem = ci - arr * 1072, row = rem >> 4, ch = rem & 15;
        *(u32x4*)(RAW + (arr * 67 + row) * 272 + ch * 16) = rg[k];
      }
    }
  }
  if (tid < 64) {
    float da = SMALL[(tok0 + tid) * 16 + 8 + h], db = SMALL[(tok0 + tid) * 16 + 12 + h];
    float xx = da + p.in[7][h];
    float sp = fmaxf(xx, 0.f) + log1pf(__expf(-fabsf(xx)));
    float gr = -__expf(p.in[6][h]) * sp;
    float incl = gr;
#pragma unroll
    for (int o = 1; o < 64; o <<= 1) {
      float v = __shfl_up(incl, o);
      if (lane >= o) incl += v;
    }
    gc[tid] = incl;
    beta[tid] = sigmoidf_(db);
    GCg[(tok0 + tid) * 4 + h] = incl;
  }
  __syncthreads();
  {
    const int c = tid & 127, tg = tid >> 7;
    float qv[16], kv[16];
#pragma unroll
    for (int arr = 0; arr < 3; ++arr) {
      const float w0 = convw[0 * 1536 + arr * 512 + h * 128 + c], w1 = convw[1 * 1536 + arr * 512 + h * 128 + c],
                  w2 = convw[2 * 1536 + arr * 512 + h * 128 + c], w3 = convw[3 * 1536 + arr * 512 + h * 128 + c];
      const unsigned char* rp = RAW + (arr * 67 + tg * 16) * 272 + c * 2;
      float x0 = bf2f(*(const u16*)(rp)), x1 = bf2f(*(const u16*)(rp + 272)), x2 = bf2f(*(const u16*)(rp + 2 * 272));
#pragma unroll
      for (int ii = 0; ii < 16; ++ii) {
        const float x3 = bf2f(*(const u16*)(rp + (ii + 3) * 272));
        const float y = w0 * x0 + w1 * x1 + w2 * x2 + w3 * x3;
        const float sv = y * sigmoidf_(y);
        if (arr == 0) qv[ii] = sv;
        else if (arr == 1) kv[ii] = sv;
        else V[(tg * 16 + ii) * 128 + c] = sv;
        x0 = x1; x1 = x2; x2 = x3;
      }
    }
#pragma unroll
    for (int ii = 0; ii < 16; ++ii) {
      const float sq = wave_sum_dpp(qv[ii] * qv[ii]);
      const float sk = wave_sum_dpp(kv[ii] * kv[ii]);
      if (lane == 0) {
        ssp[((tg * 16 + ii) * 2) + (wave & 1)] = sq;
        ssp[128 + ((tg * 16 + ii) * 2) + (wave & 1)] = sk;
      }
    }
    __syncthreads();
#pragma unroll
    for (int ii = 0; ii < 16; ++ii) {
      const int i = tg * 16 + ii;
      const float qsc = rsqrtf(ssp[i * 2] + ssp[i * 2 + 1] + EPS) * 0.08838834764831845f;
      const float ksc = rsqrtf(ssp[128 + i * 2] + ssp[128 + i * 2 + 1] + EPS);
      const float qn = qv[ii] * qsc, kn = kv[ii] * ksc;
      *(u16*)(Qb + i * 272 + c * 2) = f2bf(qn);
      *(u16*)(Kb + i * 272 + c * 2) = f2bf(kn);
      Kt[c * DNP + i] = kn;
    }
  }
  __syncthreads();
#pragma unroll
  for (int k = 0; k < 4; ++k) {
    const int gi = tid + 512 * k;
    {
      const int i = gi >> 5, d4 = (gi & 31) * 4;
      const u32x2 v = *(const u32x2*)(Qb + i * 272 + d4 * 2);
      *(u32x2*)(QNg + (tok0 + i) * 512 + h * 128 + perm32(d4)) = v;
    }
    {
      const int d = gi >> 4, t4 = (gi & 15) * 4;
      const f32x4 v = *(const f32x4*)(Kt + d * DNP + t4);
      u32x2 o = {pack2(v[0], v[1]), pack2(v[2], v[3])};
      *(u32x2*)(KNTg + (size_t)item * 8192 + d * 64 + perm32(t4)) = o;
    }
  }
  {
    const int mat = wave >> 2, it = wave & 3;
    const int fr = lane & 15, fg = lane >> 4;
    const unsigned char* Ab = mat ? Qb : Kb;
    bf16x8 af[4];
#pragma unroll
    for (int kk = 0; kk < 4; ++kk) af[kk] = *(const bf16x8*)(Ab + (it * 16 + fr) * 272 + kk * 64 + fg * 16);
    f32x4 gi4 = *(const f32x4*)(gc + it * 16 + 4 * fg);
    f32x4 bi4 = *(const f32x4*)(beta + it * 16 + 4 * fg);
#pragma unroll
    for (int jt = 0; jt < 4; ++jt) {
      f32x4 acc = {0.f, 0.f, 0.f, 0.f};
      if (jt <= it) {
#pragma unroll
        for (int kk = 0; kk < 4; ++kk) {
          bf16x8 bfg = *(const bf16x8*)(Kb + (jt * 16 + fr) * 272 + kk * 64 + fg * 16);
          acc = __builtin_amdgcn_mfma_f32_16x16x32_bf16(af[kk], bfg, acc, 0, 0, 0);
        }
      }
      const int j = jt * 16 + fr;
      const float gj = gc[j];
#pragma unroll
      for (int r = 0; r < 4; ++r) {
        const int i = it * 16 + 4 * fg + r;
        const float dec = __expf(fminf(gi4[r] - gj, 0.f));
        if (mat == 0) { if (jt <= it) AmT[j * 64 + i] = (i > j) ? bi4[r] * acc[r] * dec : 0.f; }
        else ATTg[(size_t)item * 4096 + i * 64 + perm32(j)] = f2bf((i >= j) ? acc[r] * dec : 0.f);
      }
    }
  }
  __syncthreads();
  u16* nA = (u16*)(smem + DL_RAW + 16384);
  u16* Nb = (u16*)(smem + DL_RAW + 16384 + 64 * 144);
  {
#pragma unroll
    for (int k = 0; k < 8; ++k) {
      const int e = tid + 512 * k;
      const int i = e >> 6, j = e & 63;
      const float v = ((j >> 4) < (i >> 4)) ? -AmT[j * 64 + i] : 0.f;
      nA[i * 72 + j] = f2bf(v);
    }
    if (tid < 64) {
      const int bb = tid >> 4, j = tid & 15;
      float nn[16];
#pragma unroll
      for (int i = 0; i < 16; ++i) {
        float sacc = 0.f;
#pragma unroll
        for (int k = 0; k < i; ++k) sacc += AmT[(bb * 16 + k) * 64 + bb * 16 + i] * nn[k];
        nn[i] = (i == j) ? 1.f : ((i > j) ? -sacc : 0.f);
      }
#pragma unroll
      for (int i = 0; i < 16; ++i) Nb[bb * 256 + i * 16 + j] = f2bf(nn[i]);
    }
  }
  __syncthreads();
  {
    const int fr = lane & 15, fg = lane >> 4;
    f32x4 X[2][4];
#pragma unroll
    for (int ct2 = 0; ct2 < 2; ++ct2) {
      const int c = (wave * 2 + ct2) * 16 + fr;
      const bool isu = c < 128;
      const int cc = c & 127;
#pragma unroll
      for (int bb = 0; bb < 4; ++bb) {
        f32x4 acc;
#pragma unroll
        for (int r = 0; r < 4; ++r) {
          const int i = bb * 16 + 4 * fg + r;
          acc[r] = isu ? V[i * 128 + cc] * beta[i] : Kt[cc * DNP + i] * beta[i] * __expf(gc[i]);
        }
        if (bb >= 1) {
          union { u32 w[4]; bf16x8 v; } af, bf;
          const u32x2 a0 = *(const u32x2*)(nA + (bb * 16 + fr) * 72 + 4 * fg);
          af.w[0] = a0[0]; af.w[1] = a0[1];
          bf.w[0] = pack2(X[ct2][0][0], X[ct2][0][1]); bf.w[1] = pack2(X[ct2][0][2], X[ct2][0][3]);
          if (bb >= 2) {
            const u32x2 a1 = *(const u32x2*)(nA + (bb * 16 + fr) * 72 + 16 + 4 * fg);
            af.w[2] = a1[0]; af.w[3] = a1[1];
            bf.w[2] = pack2(X[ct2][1][0], X[ct2][1][1]); bf.w[3] = pack2(X[ct2][1][2], X[ct2][1][3]);
          } else { af.w[2] = 0u; af.w[3] = 0u; bf.w[2] = 0u; bf.w[3] = 0u; }
          acc = __builtin_amdgcn_mfma_f32_16x16x32_bf16(af.v, bf.v, acc, 0, 0, 0);
          if (bb == 3) {
            const u32x2 a2 = *(const u32x2*)(nA + (bb * 16 + fr) * 72 + 32 + 4 * fg);
            af.w[0] = a2[0]; af.w[1] = a2[1]; af.w[2] = 0u; af.w[3] = 0u;
            bf.w[0] = pack2(X[ct2][2][0], X[ct2][2][1]); bf.w[1] = pack2(X[ct2][2][2], X[ct2][2][3]); bf.w[2] = 0u; bf.w[3] = 0u;
            acc = __builtin_amdgcn_mfma_f32_16x16x32_bf16(af.v, bf.v, acc, 0, 0, 0);
          }
        }
        {
          union { u32 w[4]; bf16x8 v; } af, bf;
          const u32x2 d0 = *(const u32x2*)(Nb + bb * 256 + fr * 16 + 4 * fg);
          af.w[0] = d0[0]; af.w[1] = d0[1]; af.w[2] = 0u; af.w[3] = 0u;
          bf.w[0] = pack2(acc[0], acc[1]); bf.w[1] = pack2(acc[2], acc[3]); bf.w[2] = 0u; bf.w[3] = 0u;
          const f32x4 z4 = {0.f, 0.f, 0.f, 0.f};
          X[ct2][bb] = __builtin_amdgcn_mfma_f32_16x16x32_bf16(af.v, bf.v, z4, 0, 0, 0);
        }
#pragma unroll
        for (int r = 0; r < 4; ++r) {
          const int i = bb * 16 + 4 * fg + r;
          if (isu) Ug[(tok0 + i) * 512 + h * 128 + cc] = f2bf(X[ct2][bb][r]);
          else Wg[(tok0 + i) * 512 + h * 128 + perm32(cc)] = f2bf(X[ct2][bb][r]);
        }
      }
    }
  }
}

__device__ __forceinline__ void phase2(const Params& p, unsigned char* smem) {
#ifndef NO_IDX
  for (int i = blockIdx.x; i < 2048; i += gridDim.x) idx_item(p, smem, i & 7, 255 - (i >> 3));
#endif
#ifndef NO_DNL
  if (!(p.flags & 1))
    for (int i = blockIdx.x; i < 2048; i += gridDim.x) dn_local_item(p, smem, i);
#endif
}

constexpr int SC_WP = 272, SC_KP = 144;
constexpr int SC_W = 0, SC_Q = 64 * SC_WP, SC_KT = 2 * 64 * SC_WP, SC_AT = SC_KT + 128 * SC_KP, SC_U = SC_AT + 64 * SC_KP,
              SC_BUF = SC_U + 64 * SC_WP;
constexpr int SC_GC = 2 * SC_BUF;
static_assert(SC_GC + 2 * 64 * 4 <= SMEM_BYTES, "scan LDS");

__device__ __forceinline__ void dn_scan_item(const Params& p, unsigned char* smem, int bh) {
  const int h = bh & 3, b = bh >> 2;
  const u16* Ug = (const u16*)((const unsigned char*)p.out + DO_U);
  const u16* Wg = (const u16*)((const unsigned char*)p.out + DO_W);
  const u16* QNg = (const u16*)((const unsigned char*)p.out + DO_QN);
  const u16* KNTg = (const u16*)((const unsigned char*)p.out + DO_KNT);
  const u16* ATTg = (const u16*)(p.ws + OFF_ATT);
  const float* GCg = (const float*)(p.ws + OFF_GC);
  const u16* PROJ = (const u16*)(p.ws + OFF_PROJ);
  u16* YDN = (u16*)(p.ws + OFF_YDN);
  const float* ogain = p.in[8];
  const int tid = TIDX, lane = tid & 63, wave = tid >> 6;
  const int fr = lane & 15, fg = lane >> 4;
  const int ecol = wave * 16 + fr;
  float* gcs = (float*)(smem + SC_GC);
  f32x4 S[8];
#pragma unroll
  for (int d = 0; d < 8; ++d) S[d] = (f32x4){0.f, 0.f, 0.f, 0.f};
  u32x4 st[9];
  float gcr = 0.f;
  const int r16 = tid >> 4, c16 = tid & 15;
  const int r8 = tid >> 3, c8 = tid & 7;
#define SCAN_LOAD(n_)                                                                                      \
  {                                                                                                        \
    const size_t tk0 = (size_t)b * SEQ + (size_t)(n_) * 64;                                                \
    const size_t it_ = (size_t)((b * 64 + (n_)) * 4 + h);                                                  \
    st[0] = *(const u32x4*)(Wg + (tk0 + r16) * 512 + h * 128 + c16 * 8);                                   \
    st[1] = *(const u32x4*)(Wg + (tk0 + r16 + 32) * 512 + h * 128 + c16 * 8);                              \
    st[2] = *(const u32x4*)(QNg + (tk0 + r16) * 512 + h * 128 + c16 * 8);                                  \
    st[3] = *(const u32x4*)(QNg + (tk0 + r16 + 32) * 512 + h * 128 + c16 * 8);                             \
    st[4] = *(const u32x4*)(KNTg + it_ * 8192 + (size_t)tid * 8);                                          \
    st[5] = *(const u32x4*)(KNTg + it_ * 8192 + (size_t)(tid + 512) * 8);                                  \
    st[6] = *(const u32x4*)(ATTg + it_ * 4096 + (size_t)tid * 8);                                          \
    st[7] = *(const u32x4*)(Ug + (tk0 + r16) * 512 + h * 128 + c16 * 8);                                   \
    st[8] = *(const u32x4*)(Ug + (tk0 + r16 + 32) * 512 + h * 128 + c16 * 8);                              \
    if (tid < 64) gcr = GCg[(tk0 + tid) * 4 + h];                                                          \
  }
#define SCAN_STORE(buf_)                                                                                   \
  {                                                                                                        \
    unsigned char* bs_ = smem + (buf_) * SC_BUF;                                                           \
    *(u32x4*)(bs_ + SC_W + r16 * SC_WP + c16 * 16) = st[0];                                                \
    *(u32x4*)(bs_ + SC_W + (r16 + 32) * SC_WP + c16 * 16) = st[1];                                         \
    *(u32x4*)(bs_ + SC_Q + r16 * SC_WP + c16 * 16) = st[2];                                                \
    *(u32x4*)(bs_ + SC_Q + (r16 + 32) * SC_WP + c16 * 16) = st[3];                                         \
    *(u32x4*)(bs_ + SC_KT + r8 * SC_KP + c8 * 16) = st[4];                                                 \
    *(u32x4*)(bs_ + SC_KT + (r8 + 64) * SC_KP + c8 * 16) = st[5];                                          \
    *(u32x4*)(bs_ + SC_AT + r8 * SC_KP + c8 * 16) = st[6];                                                 \
    *(u32x4*)(bs_ + SC_U + r16 * SC_WP + c16 * 16) = st[7];                                                \
    *(u32x4*)(bs_ + SC_U + (r16 + 32) * SC_WP + c16 * 16) = st[8];                                         \
    if (tid < 64) gcs[(buf_) * 64 + tid] = gcr;                                                            \
  }
  __syncthreads();
  SCAN_LOAD(0)
  SCAN_STORE(0)
  if (1 < 64) SCAN_LOAD(1)
  __syncthreads();
  for (int n = 0; n < 64; ++n) {
    const int buf = n & 1;
    const size_t tok0 = (size_t)b * SEQ + n * 64;
    if (n + 1 < 64) SCAN_STORE(buf ^ 1)
    if (n + 2 < 64) SCAN_LOAD(n + 2)
    __builtin_amdgcn_sched_barrier(0);
    const unsigned char* base = smem + buf * SC_BUF;
    const u32 ub0 = (u32)(tok0 + 4 * fg) * 512 + (u32)(h * 128 + ecol);
    const float* gcb = gcs + buf * 64 + 4 * fg;
    const float glast = gcs[buf * 64 + 63];
    bf16x8 Sb[4];
#pragma unroll
    for (int kk = 0; kk < 4; ++kk) {
      union { u32 w[4]; bf16x8 v; } cv;
      cv.w[0] = pack2(S[2 * kk][0], S[2 * kk][1]); cv.w[1] = pack2(S[2 * kk][2], S[2 * kk][3]);
      cv.w[2] = pack2(S[2 * kk + 1][0], S[2 * kk + 1][1]); cv.w[3] = pack2(S[2 * kk + 1][2], S[2 * kk + 1][3]);
      Sb[kk] = cv.v;
    }
    f32x4 vnew[4], ov[4];
#pragma unroll
    for (int m = 0; m < 4; ++m) {
      f32x4 aw = {0.f, 0.f, 0.f, 0.f}, aq = {0.f, 0.f, 0.f, 0.f};
#pragma unroll
      for (int kk = 0; kk < 4; ++kk) {
        bf16x8 wf = *(const bf16x8*)(base + SC_W + (m * 16 + fr) * SC_WP + kk * 64 + fg * 16);
        bf16x8 qf = *(const bf16x8*)(base + SC_Q + (m * 16 + fr) * SC_WP + kk * 64 + fg * 16);
        aw = __builtin_amdgcn_mfma_f32_16x16x32_bf16(wf, Sb[kk], aw, 0, 0, 0);
        aq = __builtin_amdgcn_mfma_f32_16x16x32_bf16(qf, Sb[kk], aq, 0, 0, 0);
      }
      f32x4 g4 = *(const f32x4*)(gcb + m * 16);
#pragma unroll
      for (int r = 0; r < 4; ++r) {
        float uv = bf2f(*(const u16*)(base + SC_U + (m * 16 + 4 * fg + r) * SC_WP + ecol * 2));
        vnew[m][r] = uv - aw[r];
        ov[m][r] = aq[r] * __expf(g4[r]);
      }
    }
    bf16x8 vb[2], vsb[2];
#pragma unroll
    for (int k2 = 0; k2 < 2; ++k2) {
      union { u32 w[4]; bf16x8 v; } c1, c2;
      const int ma = 2 * k2, mb = 2 * k2 + 1;
      c1.w[0] = pack2(vnew[ma][0], vnew[ma][1]); c1.w[1] = pack2(vnew[ma][2], vnew[ma][3]);
      c1.w[2] = pack2(vnew[mb][0], vnew[mb][1]); c1.w[3] = pack2(vnew[mb][2], vnew[mb][3]);
      f32x4 ga4 = *(const f32x4*)(gcb + ma * 16), gb4 = *(const f32x4*)(gcb + mb * 16);
      float sa[4], sb2[4];
#pragma unroll
      for (int r = 0; r < 4; ++r) { sa[r] = vnew[ma][r] * __expf(glast - ga4[r]); sb2[r] = vnew[mb][r] * __expf(glast - gb4[r]); }
      c2.w[0] = pack2(sa[0], sa[1]); c2.w[1] = pack2(sa[2], sa[3]);
      c2.w[2] = pack2(sb2[0], sb2[1]); c2.w[3] = pack2(sb2[2], sb2[3]);
      vb[k2] = c1.v; vsb[k2] = c2.v;
    }
    const float egl = __expf(glast);
#pragma unroll
    for (int d = 0; d < 8; ++d) {
      f32x4 a = S[d] * egl;
#pragma unroll
      for (int k2 = 0; k2 < 2; ++k2) {
        bf16x8 kf = *(const bf16x8*)(base + SC_KT + (d * 16 + fr) * SC_KP + k2 * 64 + fg * 16);
        a = __builtin_amdgcn_mfma_f32_16x16x32_bf16(kf, vsb[k2], a, 0, 0, 0);
      }
      S[d] = a;
    }
#pragma unroll
    for (int m = 0; m < 4; ++m) {
      f32x4 ao = ov[m];
#pragma unroll
      for (int k2 = 0; k2 < 2; ++k2) {
        bf16x8 af = *(const bf16x8*)(base + SC_AT + (m * 16 + fr) * SC_KP + k2 * 64 + fg * 16);
        ao = __builtin_amdgcn_mfma_f32_16x16x32_bf16(af, vb[k2], ao, 0, 0, 0);
      }
#pragma unroll
      for (int r = 0; r < 4; ++r) YDN[ub0 + (u32)((m * 16 + r) * 512)] = f2bf(ao[r]);
    }
    __syncthreads();
  }
#undef SCAN_LOAD
#undef SCAN_STORE
  asm volatile("s_waitcnt vmcnt(0)" ::: "memory");
  __syncthreads();
  {
    const int sub = lane >> 4, l16 = lane & 15;
    float gn8[8];
#pragma unroll
    for (int e = 0; e < 8; ++e) gn8[e] = ogain[l16 * 8 + e];
    for (int t = wave * 4 + sub; t < SEQ; t += 32) {
      const size_t tok = (size_t)b * SEQ + t;
      u16* yp = YDN + tok * 512 + h * 128 + l16 * 8;
      const u32x4 ov4 = *(const u32x4*)yp;
      const u32x4 zv4 = *(const u32x4*)(PROJ + tok * LDP + C_DZ + h * 128 + l16 * 8);
      float o8[8], z8[8];
#pragma unroll
      for (int c = 0; c < 4; ++c) { o8[2 * c] = bflo(ov4[c]); o8[2 * c + 1] = bfhi(ov4[c]); z8[2 * c] = bflo(zv4[c]); z8[2 * c + 1] = bfhi(zv4[c]); }
      float sq = 0.f;
#pragma unroll
      for (int e = 0; e < 8; ++e) sq += o8[e] * o8[e];
      sq += DPPF(sq, 0xb1); sq += DPPF(sq, 0x4e); sq += DPPF(sq, 0x141); sq += DPPF(sq, 0x140);
      const float rstd = rsqrtf(sq * (1.f / 128.f) + EPS);
      u32 w[4];
#pragma unroll
      for (int c = 0; c < 4; ++c) {
        const float y0 = o8[2 * c] * rstd * gn8[2 * c] * z8[2 * c] * sigmoidf_(z8[2 * c]);
        const float y1 = o8[2 * c + 1] * rstd * gn8[2 * c + 1] * z8[2 * c + 1] * sigmoidf_(z8[2 * c + 1]);
        w[c] = pack2(y0, y1);
      }
      *(u32x4*)yp = (u32x4){w[0], w[1], w[2], w[3]};
    }
  }
}

constexpr int AT_WAVE_BYTES = 8192 + 512 + 8192;
__device__ __forceinline__ float xor16_sum(float v) {
  auto r = __builtin_amdgcn_permlane16_swap(__float_as_uint(v), __float_as_uint(v), false, false);
  return __uint_as_float(r[0]) + __uint_as_float(r[1]);
}
__device__ __forceinline__ float xor32_sum(float v) {
  auto r = __builtin_amdgcn_permlane32_swap(__float_as_uint(v), __float_as_uint(v), false, false);
  return __uint_as_float(r[0]) + __uint_as_float(r[1]);
}
__device__ __forceinline__ void attn_query(const Params& p, unsigned char* wsm, int b, int t) {
  typedef long i64;
  typedef int i32x2 __attribute__((ext_vector_type(2)));
  typedef __attribute__((address_space(3))) i32x2 lds_i32x2;
  const u16* PROJ = (const u16*)(p.ws + OFF_PROJ);
  const u16* SEL = (const u16*)(p.ws + OFF_SEL);
  const unsigned char* KVC8 = p.ws + OFF_KVC;
  u16* YATT = (u16*)(p.ws + OFF_YATT);
  const int lane = TIDX & 63;
  const int fr = lane & 15, fg = lane >> 4;
  float* P = (float*)wsm;
  u16* sl = (u16*)(wsm + 8192);
  const size_t tokb = (size_t)b * SEQ;
  const size_t tok = tokb + t;
  const int nsel = min(256, t + 1);
  i64 qb[2][2];
  {
    const u16* qrow = PROJ + tok * LDP + C_AQ + (fr & 3) * 64 + fg * 8;
#pragma unroll
    for (int g = 0; g < 2; ++g)
#pragma unroll
      for (int kk = 0; kk < 2; ++kk) {
        const u32x4 v = *(const u32x4*)(qrow + g * 256 + kk * 32);
        const u32 lo = fp8x4(bflo(v[0]) * 16.f, bfhi(v[0]) * 16.f, bflo(v[1]) * 16.f, bfhi(v[1]) * 16.f);
        const u32 hi = fp8x4(bflo(v[2]) * 16.f, bfhi(v[2]) * 16.f, bflo(v[3]) * 16.f, bfhi(v[3]) * 16.f);
        const i64 w = (i64)(((unsigned long long)hi << 32) | (unsigned long long)lo);
        qb[g][kk] = (fr < 4) ? w : (i64)0;
      }
    const u16* sr = SEL + tok * 256;
#pragma unroll
    for (int i = 0; i < 4; ++i) sl[lane + 64 * i] = sr[lane + 64 * i];
  }
  WAVE_LDS_SYNC();
  const int ngrp = (nsel + 15) >> 4;
  const int nbq = (ngrp + 1) >> 1;
  unsigned char* KST = wsm + 8192 + 512;
  const int kq = lane >> 3, kch = lane & 7;
  u32x4 kA[2][2], kB[2][2];
#define QK_LOAD(buf_, bi_)                                                                       \
  _Pragma("unroll") for (int j = 0; j < 2; ++j)                                                  \
    _Pragma("unroll") for (int hf = 0; hf < 2; ++hf) {                                           \
      const int ki_ = min(((bi_) * 2 + j) * 16 + hf * 8 + kq, 255);                              \
      const int s_ = (int)sl[ki_] & 4095;                                                        \
      buf_[j][hf] = *(const u32x4*)(KVC8 + (tokb + s_) * 256 + kch * 16);                        \
    }
#define QK_COMPUTE(buf_, bi_)                                                                    \
  {                                                                                              \
    _Pragma("unroll") for (int j = 0; j < 2; ++j)                                                \
      _Pragma("unroll") for (int hf = 0; hf < 2; ++hf) {                                         \
        const int row_ = hf * 8 + kq;                                                            \
        *(u32x4*)(KST + j * 2048 + row_ * 128 + ((kch ^ (row_ & 7)) << 4)) = buf_[j][hf];        \
      }                                                                                          \
    WAVE_LDS_SYNC();                                                                             \
    _Pragma("unroll") for (int j = 0; j < 2; ++j) {                                              \
      const unsigned char* kr_ = KST + j * 2048 + fr * 128 + 8 * (fg & 1);                       \
      const int sw_ = fr & 7, ch_ = fg >> 1;                                                     \
      const i64 a00_ = *(const i64*)(kr_ + (((0 + ch_) ^ sw_) << 4));                            \
      const i64 a01_ = *(const i64*)(kr_ + (((2 + ch_) ^ sw_) << 4));                            \
      const i64 a10_ = *(const i64*)(kr_ + (((4 + ch_) ^ sw_) << 4));                            \
      const i64 a11_ = *(const i64*)(kr_ + (((6 + ch_) ^ sw_) << 4));                            \
      f32x4 c0_ = {0.f, 0.f, 0.f, 0.f}, c1_ = {0.f, 0.f, 0.f, 0.f};                              \
      c0_ = __builtin_amdgcn_mfma_f32_16x16x32_fp8_fp8(a00_, qb[0][0], c0_, 0, 0, 0);            \
      c0_ = __builtin_amdgcn_mfma_f32_16x16x32_fp8_fp8(a01_, qb[0][1], c0_, 0, 0, 0);            \
      c1_ = __builtin_amdgcn_mfma_f32_16x16x32_fp8_fp8(a10_, qb[1][0], c1_, 0, 0, 0);            \
      c1_ = __builtin_amdgcn_mfma_f32_16x16x32_fp8_fp8(a11_, qb[1][1], c1_, 0, 0, 0);            \
      if (fr < 4) {                                                                              \
        _Pragma("unroll") for (int r = 0; r < 4; ++r) {                                          \
          const int kk2_ = ((bi_) * 2 + j) * 16 + 4 * fg + r;                                    \
          if (kk2_ < 256) {                                                                      \
            const bool v_ = kk2_ < nsel;                                                         \
            P[kk2_ * 8 + fr] = v_ ? c0_[r] * 0.0625f : -1e30f;                                   \
            P[kk2_ * 8 + 4 + fr] = v_ ? c1_[r] * 0.0625f : -1e30f;                               \
          }                                                                                      \
        }                                                                                        \
      }                                                                                          \
    }                                                                                            \
    WAVE_LDS_SYNC();                                                                             \
  }
  QK_LOAD(kA, 0)
  for (int bi = 0; bi < nbq; bi += 2) {
    if (bi + 1 < nbq) { QK_LOAD(kB, bi + 1) }
    QK_COMPUTE(kA, bi)
    if (bi + 2 < nbq) { QK_LOAD(kA, bi + 2) }
    if (bi + 1 < nbq) { QK_COMPUTE(kB, bi + 1) }
  }
#undef QK_LOAD
#undef QK_COMPUTE
  for (int ki = nbq * 32 + lane; ki < 256; ki += 64) {
    *(f32x4*)(P + ki * 8) = (f32x4){-1e30f, -1e30f, -1e30f, -1e30f};
    *(f32x4*)(P + ki * 8 + 4) = (f32x4){-1e30f, -1e30f, -1e30f, -1e30f};
  }
  WAVE_LDS_SYNC();
  float inv8[8];
  {
    float lg[4][8];
#pragma unroll
    for (int i = 0; i < 4; ++i) {
      f32x4 x0 = *(const f32x4*)(P + (lane + 64 * i) * 8), x1 = *(const f32x4*)(P + (lane + 64 * i) * 8 + 4);
      lg[i][0] = x0[0]; lg[i][1] = x0[1]; lg[i][2] = x0[2]; lg[i][3] = x0[3];
      lg[i][4] = x1[0]; lg[i][5] = x1[1]; lg[i][6] = x1[2]; lg[i][7] = x1[3];
    }
    WAVE_LDS_SYNC();
    unsigned char* PT8 = (unsigned char*)P;
#pragma unroll
    for (int hh = 0; hh < 8; ++hh) {
      float m = fmaxf(fmaxf(lg[0][hh], lg[1][hh]), fmaxf(lg[2][hh], lg[3][hh]));
      m = wave_max_dpp(m);
      float e[4], sum = 0.f;
#pragma unroll
      for (int i = 0; i < 4; ++i) { e[i] = __expf(lg[i][hh] - m); sum += e[i]; }
      sum = wave_sum_dpp(sum);
      inv8[hh] = __builtin_amdgcn_rcpf(sum) * (1.f / 256.f);
      const u32 w = fp8x4(e[0] * 256.f, e[1] * 256.f, e[2] * 256.f, e[3] * 256.f);
#pragma unroll
      for (int i = 0; i < 4; ++i) PT8[hh * 256 + lane + 64 * i] = (unsigned char)((w >> (8 * i)) & 0xffu);
    }
  }
  WAVE_LDS_SYNC();
  {
    const unsigned char* PT8 = (const unsigned char*)P;
    unsigned char* VST = wsm + 8192 + 512;
    const int trow = (lane & 15) >> 1, thalf = lane & 1;
    f32x4 oacc[2][4];
#pragma unroll
    for (int g = 0; g < 2; ++g)
#pragma unroll
      for (int c = 0; c < 4; ++c) oacc[g][c] = (f32x4){0.f, 0.f, 0.f, 0.f};
    const int nks = (nsel + 31) >> 5;
    u32x4 vA[4], vB[4];
#define PV_LOAD(buf_, ks_)                                                                       \
  _Pragma("unroll") for (int i = 0; i < 4; ++i) {                                                \
    const int ki_ = min((ks_) * 32 + i * 8 + kq, 255);                                           \
    const int s_ = (int)sl[ki_] & 4095;                                                          \
    buf_[i] = *(const u32x4*)(KVC8 + (tokb + s_) * 256 + 128 + kch * 16);                        \
  }
#define PV_COMPUTE(buf_, ks_)                                                                    \
  {                                                                                              \
    _Pragma("unroll") for (int i = 0; i < 4; ++i) {                                              \
      const int key_ = i * 8 + kq;                                                               \
      *(u32x4*)(VST + key_ * 128 + ((kch ^ (key_ & 7)) << 4)) = buf_[i];                         \
    }                                                                                            \
    WAVE_LDS_SYNC();                                                                             \
    i64 pa_[2];                                                                                  \
    _Pragma("unroll") for (int g = 0; g < 2; ++g) {                                              \
      const i64 t_ = *(const i64*)(PT8 + (g * 4 + (fr & 3)) * 256 + (ks_) * 32 + 8 * fg);        \
      pa_[g] = (fr < 4) ? t_ : (i64)0;                                                           \
    }                                                                                            \
    const int r1_ = 8 * fg + trow;                                                               \
    _Pragma("unroll") for (int g = 0; g < 2; ++g)                                                \
      _Pragma("unroll") for (int c = 0; c < 4; ++c) {                                            \
        const i32x2 tv_ = __builtin_amdgcn_ds_read_tr8_b64_v2i32((lds_i32x2*)(VST + r1_ * 128 + (((g * 4 + c) ^ (r1_ & 7)) << 4) + 8 * thalf)); \
        const i64 vb_ = (i64)(((unsigned long long)(u32)tv_[1] << 32) | (unsigned long long)(u32)tv_[0]); \
        oacc[g][c] = __builtin_amdgcn_mfma_f32_16x16x32_fp8_fp8(pa_[g], vb_, oacc[g][c], 0, 0, 0); \
      }                                                                                          \
    WAVE_LDS_SYNC();                                                                             \
  }
    PV_LOAD(vA, 0)
    for (int ks = 0; ks < nks; ks += 2) {
      if (ks + 1 < nks) { PV_LOAD(vB, ks + 1) }
      PV_COMPUTE(vA, ks)
      if (ks + 2 < nks) { PV_LOAD(vA, ks + 2) }
      if (ks + 1 < nks) { PV_COMPUTE(vB, ks + 1) }
    }
#undef PV_LOAD
#undef PV_COMPUTE
    if (lane < 16) {
#pragma unroll
      for (int g = 0; g < 2; ++g)
#pragma unroll
        for (int c = 0; c < 4; ++c)
#pragma unroll
          for (int r = 0; r < 4; ++r)
            YATT[tok * 512 + (g * 4 + r) * 64 + 16 * c + fr] = f2bf(oacc[g][c][r] * inv8[g * 4 + r]);
    }
  }
  WAVE_LDS_SYNC();
}

__device__ __forceinline__ void phase3(const Params& p, unsigned char* smem) {
  const int wave = TIDX >> 6;
#ifndef NO_SCAN
  if (blockIdx.x < 32) {
    if (!(p.flags & 2)) dn_scan_item(p, smem, blockIdx.x);
    __syncthreads();
  }
#endif
#ifdef NO_ATTN
  return;
#endif
  if (p.flags & 4) return;
  unsigned* qctr = (unsigned*)(p.ws + 1024 + ((p.flags & 128) ? 4096 : 0));
  const unsigned xcc = (unsigned)__builtin_amdgcn_s_getreg((3 << 11) | 20) & 7u;
  unsigned char* wsm = smem + wave * AT_WAVE_BYTES;
  for (unsigned db = 0; db < 8; ++db) {
    const int bb = (int)((xcc + db) & 7u);
    for (;;) {
      unsigned qi = 0;
      if ((TIDX & 63) == 0) qi = __hip_atomic_fetch_add(qctr + bb * 16, 1u, __ATOMIC_RELAXED, __HIP_MEMORY_SCOPE_AGENT);
      qi = (unsigned)__builtin_amdgcn_readfirstlane((int)qi);
      if (qi >= (unsigned)SEQ) break;
      attn_query(p, wsm, bb, SEQ - 1 - (int)qi);
    }
  }
}

__device__ __forceinline__ void hblk_load(unsigned char* reg, const u16* __restrict__ src, u32 ob, u32 ld, int lane) {
  const int c16 = lane & 7, r8 = lane >> 3;
#pragma unroll
  for (int it = 0; it < 8; ++it) {
    const int rl = it * 8 + r8;
    const u32x4 v = *(const u32x4*)(src + ob + (u32)rl * ld + (u32)(c16 * 8));
    *(u32x4*)(reg + rl * 128 + (((c16 + 2 * ((rl >> 2) & 3)) & 7) << 4)) = v;
    if ((it & 3) == 3) __builtin_amdgcn_sched_barrier(0);
  }
}
__device__ __forceinline__ void hblk_store(const unsigned char* reg, u16* __restrict__ dst, u32 ob, u32 ld, int lane) {
  const int c16 = lane & 7, r8 = lane >> 3;
#pragma unroll
  for (int it = 0; it < 8; ++it) {
    const int rl = it * 8 + r8;
    const u32x4 v = *(const u32x4*)(reg + rl * 128 + (((c16 + 2 * ((rl >> 2) & 3)) & 7) << 4));
    *(u32x4*)(dst + ob + (u32)rl * ld + (u32)(c16 * 8)) = v;
  }
}
__device__ __forceinline__ void phase4(const Params& p, unsigned char* smem) {
  const u16* YATT = (const u16*)(p.ws + OFF_YATT);
  const u16* YDN = (const u16*)(p.ws + OFF_YDN);
  const u16* WTA = (const u16*)(p.ws + OFF_WTA);
  const u16* WTB = (const u16*)(p.ws + OFF_WTB);
  const u16* PROJ = (const u16*)(p.ws + OFF_PROJ);
  u16* MG = (u16*)(p.ws + OFF_MERGED);
  const int ntn = DM / 256, ntiles = (MTOK / 256) * ntn;
  for (int t = blockIdx.x; t < ntiles; t += gridDim.x) {
    const int m0 = (t / ntn) * 256, n0 = (t % ntn) * 256;
    f32x4 acc[2][2][4][2];
#pragma unroll
    for (int pass = 0; pass < 2; ++pass) {
      gemm8_tile(pass ? YDN : YATT, pass ? WTB : WTA, 512, m0, n0, smem, acc);
      int lane = TIDX & 63;
      asm volatile("" : "+v"(lane));
      const int wave = TIDX >> 6, wr = wave >> 2, wc = wave & 3, fr = lane & 15, fq = lane >> 4;
      unsigned char* regG = smem + wave * 16384;
      unsigned char* regT = regG + 8192;
      const int lrot = (fr >> 3) + 2 * fq;
      int off4[4];
#pragma unroll
      for (int jj = 0; jj < 4; ++jj) off4[jj] = (4 * fq) * 128 + (fr & 7) * 2 + (((jj * 2 + lrot) & 7) << 4);
#pragma unroll
      for (int ai = 0; ai < 2; ++ai) {
        const u32 gb0 = (u32)(m0 + ai * 128 + wr * 64) * LDP + (u32)(n0 + wc * 64) + (u32)(pass ? C_GB : C_GA);
        const u32 ob0 = (u32)(m0 + ai * 128 + wr * 64) * DM + (u32)(n0 + wc * 64);
        hblk_load(regG, PROJ, gb0, LDP, lane);
        if (pass == 1) hblk_load(regT, MG, ob0, DM, lane);
        WAVE_LDS_SYNC();
#pragma unroll
        for (int m = 0; m < 4; ++m)
#pragma unroll
          for (int r = 0; r < 4; ++r)
#pragma unroll
            for (int bj = 0; bj < 2; ++bj)
#pragma unroll
              for (int n = 0; n < 2; ++n) {
                const int o = off4[bj * 2 + n] + (m * 16 + r) * 128;
                float v = sigmoidf_(bf2f(*(const u16*)(regG + o))) * acc[ai][bj][m][n][r];
                if (pass == 1) v += bf2f(*(const u16*)(regT + o));
                *(u16*)(regT + o) = f2bf(v);
              }
        WAVE_LDS_SYNC();
        hblk_store(regT, MG, ob0, DM, lane);
        WAVE_LDS_SYNC();
      }
      asm volatile("s_waitcnt vmcnt(0)" ::: "memory");
    }
  }
}

__device__ __forceinline__ void phase5(const Params& p, unsigned char* smem) {
  const u16* MG = (const u16*)(p.ws + OFF_MERGED);
  const u16* WTO = (const u16*)(p.ws + OFF_WTO);
  const float* x = p.in[0];
  const int ntn = DM / 256, ntiles = (MTOK / 256) * ntn;
  for (int t = blockIdx.x; t < ntiles; t += gridDim.x) {
    const int m0 = (t / ntn) * 256, n0 = (t % ntn) * 256;
    f32x4 acc[2][2][4][2];
    gemm8_tile(MG, WTO, DM, m0, n0, smem, acc);
    const int tid_e = TIDX, lane = tid_e & 63, wave = tid_e >> 6;
    const int wr = wave >> 2, wc = wave & 3, fr = lane & 15, fq = lane >> 4;
    unsigned char* reg = smem + wave * 16384;
    const int c16 = lane & 15, r4 = lane >> 4;
    float* outp = p.out;
#pragma unroll
    for (int ai = 0; ai < 2; ++ai) {
#pragma unroll
      for (int m = 0; m < 4; ++m)
#pragma unroll
        for (int r = 0; r < 4; ++r)
#pragma unroll
          for (int bj = 0; bj < 2; ++bj)
#pragma unroll
            for (int n = 0; n < 2; ++n) {
              const int col = (bj * 2 + n) * 16 + fr, row = m * 16 + 4 * fq + r;
              *(float*)(reg + row * 256 + ((((col >> 2) + 4 * fq) & 15) << 4) + (col & 3) * 4) = acc[ai][bj][m][n][r];
            }
      WAVE_LDS_SYNC();
      const u32 ob = (u32)(m0 + ai * 128 + wr * 64) * DM + (u32)(n0 + wc * 64 + c16 * 4);
#pragma unroll
      for (int i4 = 0; i4 < 4; ++i4) {
        f32x4 xv[4];
#pragma unroll
        for (int k = 0; k < 4; ++k) xv[k] = *(const f32x4*)(x + ob + (u32)(((i4 * 4 + k) * 4 + r4) * DM));
#pragma unroll
        for (int k = 0; k < 4; ++k) {
          const int rw = (i4 * 4 + k) * 4 + r4;
          const f32x4 v = *(const f32x4*)(reg + rw * 256 + (((c16 + 4 * ((rw >> 2) & 3)) & 15) << 4));
          *(f32x4*)(outp + ob + (u32)(rw * DM)) = xv[k] + v;
        }
        __builtin_amdgcn_sched_barrier(0);
      }
      WAVE_LDS_SYNC();
    }
  }
}

__device__ __forceinline__ void phase6(const Params& p, unsigned char* smem) {
  const u16* H2 = (const u16*)(p.ws + OFF_H2);
  const u16* WTQ = (const u16*)(p.ws + OFF_WTQ);
  u16* QP = (u16*)(p.ws + OFF_QP);
  const int ntn = 2048 / 256, ntiles = (MTOK / 256) * ntn;
  for (int t = blockIdx.x; t < ntiles; t += gridDim.x) {
    const int m0 = (t / ntn) * 256, n0 = (t % ntn) * 256;
    f32x4 acc[2][2][4][2];
    gemm8_tile(H2, WTQ, DM, m0, n0, smem, acc);
    const int tid_e = TIDX, lane = tid_e & 63, wave = tid_e >> 6;
    const int wr = wave >> 2, wc = wave & 3;
    ep_store<2048, false>(QP, (u32)(m0 + wr * 64) * 2048 + (u32)(n0 + wc * 64), acc, nullptr, 1.f, smem, wave, lane);
  }
}

__device__ __forceinline__ int mono_key(float v) { int b = __float_as_int(v); return b ^ ((b >> 31) & 0x7fffffff); }
__device__ __forceinline__ float unmono_key(int k) { return __int_as_float(k ^ ((k >> 31) & 0x7fffffff)); }
__device__ __forceinline__ void chain16(int (&k)[16], int x) {
#pragma unroll
  for (int j = 0; j < 16; ++j) { int hi = max(k[j], x); x = min(k[j], x); k[j] = hi; }
}

#define CE_DESC(a, b) { const int hi_ = max(a, b), lo_ = min(a, b); a = hi_; b = lo_; }
__device__ __forceinline__ void sort16_desc(int (&k)[16]) {
#pragma unroll
  for (int size = 2; size <= 16; size <<= 1) {
#pragma unroll
    for (int stride = size >> 1; stride > 0; stride >>= 1) {
#pragma unroll
      for (int i = 0; i < 16; ++i) {
        const int l = i ^ stride;
        if (l > i) {
          if ((i & size) == 0) CE_DESC(k[i], k[l]) else CE_DESC(k[l], k[i])
        }
      }
    }
  }
}
__device__ __forceinline__ void merge_top16(int (&a)[16], const int (&b)[16]) {
#pragma unroll
  for (int i = 0; i < 16; ++i) a[i] = max(a[i], b[15 - i]);
#pragma unroll
  for (int stride = 8; stride > 0; stride >>= 1) {
#pragma unroll
    for (int i = 0; i < 16; ++i) {
      const int l = i ^ stride;
      if (l > i) CE_DESC(a[i], a[l])
    }
  }
}

constexpr int P7_LD = 132;
__device__ __forceinline__ void phase7(const Params& p, unsigned char* smem) {
  const u16* QP = (const u16*)(p.ws + OFF_QP);
  const u16* SKB = (const u16*)(p.ws + OFF_SKB);
  float* TOPS = (float*)(p.ws + OFF_TOPS);
  u8* TOPI = (u8*)(p.ws + OFF_TOPI);
  const int tid = TIDX, lane = tid & 63, wave = tid >> 6;
  const int wm = wave >> 1, wn = wave & 1, fr = lane & 15, fg = lane >> 4;
  const int ntiles = (MTOK / G_BM) * 16;
  float* tile = (float*)smem;
  for (int t = blockIdx.x; t < ntiles; t += gridDim.x) {
    const int m0 = (t >> 4) * G_BM, hp = t & 15;
    f32x4 acc[4][4];
    gemm_mainloop(QP + hp * 128, 2048, SKB + (size_t)hp * 128 * 128, 128, 128, m0, 0, smem, acc);
#pragma unroll
    for (int i = 0; i < 4; ++i)
#pragma unroll
      for (int j = 0; j < 4; ++j)
#pragma unroll
        for (int r = 0; r < 4; ++r) {
          int row = wm * 64 + i * 16 + 4 * fg + r, col = wn * 64 + j * 16 + fr;
          tile[row * P7_LD + col] = acc[i][j][r];
        }
    __syncthreads();
    {
      const int row = tid >> 1, half = tid & 1;
      int k[16];
      const float* rowp = tile + row * P7_LD + half * 64;
#pragma unroll
      for (int grp = 0; grp < 4; ++grp) {
        int gk[16];
#pragma unroll
        for (int c = 0; c < 16; c += 4) {
          f32x4 v = *(const f32x4*)(rowp + grp * 16 + c);
          const int ib = 127 - (half * 64 + grp * 16 + c);
          gk[c] = (mono_key(v[0]) & ~127) | ib;
          gk[c + 1] = (mono_key(v[1]) & ~127) | (ib - 1);
          gk[c + 2] = (mono_key(v[2]) & ~127) | (ib - 2);
          gk[c + 3] = (mono_key(v[3]) & ~127) | (ib - 3);
        }
        sort16_desc(gk);
        if (grp == 0) {
#pragma unroll
          for (int j = 0; j < 16; ++j) k[j] = gk[j];
        } else merge_top16(k, gk);
      }
      {
        int other[16];
#pragma unroll
        for (int j = 0; j < 16; ++j) other[j] = DPPI(k[j], 0xb1);
        merge_top16(k, other);
      }
      if (half == 0) {
        size_t o = ((size_t)(m0 + row) * 16 + hp) * 16;
        float vals[16]; int idx[16];
#pragma unroll
        for (int j = 0; j < 16; ++j) { idx[j] = 127 - (k[j] & 127); vals[j] = tile[row * P7_LD + idx[j]]; }
#pragma unroll
        for (int j = 0; j < 16; j += 4) *(f32x4*)(TOPS + o + j) = (f32x4){vals[j], vals[j + 1], vals[j + 2], vals[j + 3]};
#pragma unroll
        for (int j = 0; j < 16; j += 4)
          *(u32*)(TOPI + o + j) = (u32)idx[j] | ((u32)idx[j + 1] << 8) | ((u32)idx[j + 2] << 16) | ((u32)idx[j + 3] << 24);
      }
    }
    __syncthreads();
  }
}

__device__ __forceinline__ void phase7b(const Params& p) {
  const float* TOPS = (const float*)(p.ws + OFF_TOPS);
  const u8* TOPI = (const u8*)(p.ws + OFF_TOPI);
  int* EXPERT = (int*)(p.ws + OFF_EXPERT);
  float* GATE = (float*)(p.ws + OFF_GATE);
  for (int w = blockIdx.x * NTHREADS + TIDX; w < MTOK * 8; w += gridDim.x * NTHREADS) {
    const size_t o = (size_t)w * 32;
    float sa[16], sb[16];
#pragma unroll
    for (int k = 0; k < 16; k += 4) {
      float4 v = *(const float4*)(TOPS + o + k); sa[k] = v.x; sa[k + 1] = v.y; sa[k + 2] = v.z; sa[k + 3] = v.w;
      float4 u = *(const float4*)(TOPS + o + 16 + k); sb[k] = u.x; sb[k + 1] = u.y; sb[k + 2] = u.z; sb[k + 3] = u.w;
    }
    int cand[64];
#pragma unroll
    for (int k = 0; k < 64; ++k) cand[k] = (int)0x80000000;
    {
      int cnt = 0;
#pragma unroll
      for (int a = 0; a < 16; ++a)
#pragma unroll
        for (int bb = 0; bb < 16; ++bb)
          if ((a + 1) * (bb + 1) <= 16) { cand[cnt] = (mono_key(sa[a] + sb[bb]) & ~255) | (255 - (a * 16 + bb)); ++cnt; }
    }
    int kk[16];
#pragma unroll
    for (int grp = 0; grp < 4; ++grp) {
      int gk[16];
#pragma unroll
      for (int j = 0; j < 16; ++j) gk[j] = cand[grp * 16 + j];
      sort16_desc(gk);
      if (grp == 0) {
#pragma unroll
        for (int j = 0; j < 16; ++j) kk[j] = gk[j];
      } else merge_top16(kk, gk);
    }
    float vals[16];
#pragma unroll
    for (int k = 0; k < 16; ++k) vals[k] = unmono_key(kk[k] & ~255);
    float m = vals[0], s = 0.f, e[16];
#pragma unroll
    for (int k = 0; k < 16; ++k) { e[k] = __expf(vals[k] - m); s += e[k]; }
    float inv = 1.f / s;
#pragma unroll
    for (int k = 0; k < 16; ++k) {
      const int ci = 255 - (kk[k] & 255);
      int a = ci >> 4, bb = ci & 15;
      int ex = (int)TOPI[o + a] * 128 + (int)TOPI[o + 16 + bb];
      EXPERT[(size_t)w * 16 + k] = ex;
      GATE[(size_t)w * 16 + k] = e[k] * inv;
    }
  }
  {
    const int lane = TIDX & 63, wave = TIDX >> 6;
    for (int row = blockIdx.x * 8 + wave; row < 2 * 16384; row += gridDim.x * 8) {
      const int tbl = row >> 14, r = row & 16383;
      const f32x4* src = (const f32x4*)((tbl ? p.in[16] : p.in[15]) + (size_t)r * DM) + 4 * lane;
      f32x4 x[4];
      float amax = 0.f;
#pragma unroll
      for (int i = 0; i < 4; ++i) {
        x[i] = src[i];
        amax = fmaxf(amax, fmaxf(fmaxf(fabsf(x[i][0]), fabsf(x[i][1])), fmaxf(fabsf(x[i][2]), fabsf(x[i][3]))));
      }
      amax = wave_max_dpp(amax);
      const float inv = amax > 0.f ? 127.f / amax : 0.f;
      const int bias = 0;
      u32x4 o;
#pragma unroll
      for (int i = 0; i < 4; ++i) {
        int q0 = (int)rintf(x[i][0] * inv) + bias, q1 = (int)rintf(x[i][1] * inv) + bias;
        int q2 = (int)rintf(x[i][2] * inv) + bias, q3 = (int)rintf(x[i][3] * inv) + bias;
        o[i] = (u32)(q0 & 0xff) | ((u32)(q1 & 0xff) << 8) | ((u32)(q2 & 0xff) << 16) | ((u32)(q3 & 0xff) << 24);
      }
      *(u32x4*)(p.ws + (tbl ? OFF_VQ : OFF_UQ) + ((size_t)(lane >> 3) * 16384 + r) * 128 + (lane & 7) * 16) = o;
      if (lane == 0) ((float*)(p.ws + (tbl ? OFF_VS : OFF_US)))[r] = amax * (1.f / 127.f);
    }
  }
}

__device__ __forceinline__ void phase8a(const Params& p) {
  const int* EXPERT = (const int*)(p.ws + OFF_EXPERT);
  const unsigned char* UQS = p.ws + OFF_UQ;
  const unsigned char* H2Q = p.ws + OFF_H2Q;
  int* PD = (int*)(p.ws + OFF_PD);
  unsigned* ctr = (unsigned*)(p.ws + 2048 + ((p.flags & 128) ? 4096 : 0));
  const unsigned xcc = (unsigned)__builtin_amdgcn_s_getreg((3 << 11) | 20) & 7u;
  const int lane = TIDX & 63, g8 = lane >> 3, l8 = lane & 7;
  for (unsigned db = 0; db < 8; ++db) {
    const int x = (int)((xcc + db) & 7u);
    for (;;) {
      unsigned ci = 0;
      if (lane == 0) ci = __hip_atomic_fetch_add(ctr + x * 16, 1u, __ATOMIC_RELAXED, __HIP_MEMORY_SCOPE_AGENT);
      ci = (unsigned)__builtin_amdgcn_readfirstlane((int)ci);
      if (ci >= (unsigned)(MTOK / 16)) break;
#pragma unroll 1
      for (int tt = 0; tt < 16; ++tt) {
        const int tok = (int)ci * 16 + tt;
        const int e0 = EXPERT[(size_t)tok * 128 + lane], e1 = EXPERT[(size_t)tok * 128 + 64 + lane];
        const u32x4 hq = *(const u32x4*)(H2Q + (size_t)tok * DM + x * 128 + l8 * 16);
        u32x4 ua[16];
#pragma unroll
        for (int i = 0; i < 16; ++i) {
          const int k = i * 8 + g8;
          const int ek = __shfl(i < 8 ? e0 : e1, k & 63);
          ua[i] = *(const u32x4*)(UQS + ((size_t)(x * 16384 + ek)) * 128 + l8 * 16);
        }
        int keep0 = 0, keep1 = 0;
#pragma unroll
        for (int i = 0; i < 16; ++i) {
          int sd = 0;
#pragma unroll
          for (int c = 0; c < 4; ++c) sd = __builtin_amdgcn_sdot4((int)ua[i][c], (int)hq[c], sd, false);
          sd += DPPI(sd, 0xb1); sd += DPPI(sd, 0x4e); sd += DPPI(sd, 0x141);
          if (i < 8) keep0 = (l8 == (i & 7)) ? sd : keep0; else keep1 = (l8 == (i & 7)) ? sd : keep1;
        }
        int* pd = PD + ((size_t)x * MTOK + tok) * 128 + l8 * 8 + g8;
        pd[0] = keep0; pd[64] = keep1;
      }
    }
  }
}

__device__ __forceinline__ void phase8c(const Params& p) {
  const int* EXPERT = (const int*)(p.ws + OFF_EXPERT);
  const float* GATE = (const float*)(p.ws + OFF_GATE);
  const float* US = (const float*)(p.ws + OFF_US);
  const float* VS = (const float*)(p.ws + OFF_VS);
  const float* HS = (const float*)(p.ws + OFF_HS);
  const int* PD = (const int*)(p.ws + OFF_PD);
  unsigned char* CQ8 = p.ws + OFF_CQ8;
  float* QSC = (float*)(p.ws + OFF_QSC);
  const int lane = TIDX & 63, wave = TIDX >> 6;
  for (int tok = blockIdx.x * 8 + wave; tok < MTOK; tok += gridDim.x * 8) {
    const int e0 = EXPERT[(size_t)tok * 128 + lane], e1 = EXPERT[(size_t)tok * 128 + 64 + lane];
    const float g0 = GATE[(size_t)tok * 128 + lane], g1 = GATE[(size_t)tok * 128 + 64 + lane];
    int s0 = 0, s1 = 0;
#pragma unroll
    for (int xx = 0; xx < 8; ++xx) {
      s0 += PD[((size_t)xx * MTOK + tok) * 128 + lane];
      s1 += PD[((size_t)xx * MTOK + tok) * 128 + 64 + lane];
    }
    const float hs = HS[tok];
    const float d0 = (float)s0 * US[e0] * hs, d1 = (float)s1 * US[e1] * hs;
    const float cf0 = g0 * 0.5f * d0 * (1.f + erff(d0 * 0.70710678118654752f)) * VS[e0];
    const float cf1 = g1 * 0.5f * d1 * (1.f + erff(d1 * 0.70710678118654752f)) * VS[e1];
    const float cmax = wave_max_dpp(fmaxf(fabsf(cf0), fabsf(cf1)));
    const float qinv = cmax > 0.f ? 32639.f / cmax : 0.f;
    const int c0 = (int)rintf(cf0 * qinv), c1 = (int)rintf(cf1 * qinv);
    const int h0 = (c0 + 128) >> 8, h1 = (c1 + 128) >> 8;
    unsigned char* cq = CQ8 + (size_t)tok * 256;
    cq[lane] = (unsigned char)(h0 & 0xff); cq[64 + lane] = (unsigned char)(h1 & 0xff);
    cq[128 + lane] = (unsigned char)((c0 - 256 * h0) & 0xff); cq[192 + lane] = (unsigned char)((c1 - 256 * h1) & 0xff);
    if (lane == 0) QSC[tok] = cmax * (1.f / 32639.f);
  }
}

#ifndef TR8_VARIANT
#define TR8_VARIANT 0
#endif
__device__ __forceinline__ void phase8b(const Params& p, unsigned char* smem) {
  typedef int i32x4 __attribute__((ext_vector_type(4)));
  typedef int i32x2 __attribute__((ext_vector_type(2)));
  typedef __attribute__((address_space(3))) i32x2 lds_i32x2;
  const int* EXPERT = (const int*)(p.ws + OFF_EXPERT);
  const unsigned char* VQS = p.ws + OFF_VQ;
  const unsigned char* CQ8 = p.ws + OFF_CQ8;
  const float* QSC = (const float*)(p.ws + OFF_QSC);
  unsigned* ctr = (unsigned*)(p.ws + 3072 + ((p.flags & 128) ? 4096 : 0));
  const unsigned xcc = (unsigned)__builtin_amdgcn_s_getreg((3 << 11) | 20) & 7u;
  const int lane = TIDX & 63, wave = TIDX >> 6, g8 = lane >> 3, l8 = lane & 7;
  const int fr = lane & 15, fg = lane >> 4;
  unsigned char* VST = smem + wave * 16384;
#if TR8_VARIANT == 0
  const int trow = (lane & 15) >> 1, thalf = lane & 1;
#else
  const int trow = lane & 7, thalf = (lane & 15) >> 3;
#endif
  __syncthreads();
  for (unsigned db = 0; db < 8; ++db) {
    const int x = (int)((xcc + db) & 7u);
    for (;;) {
      unsigned ci = 0;
      if (lane == 0) ci = __hip_atomic_fetch_add(ctr + x * 16, 1u, __ATOMIC_RELAXED, __HIP_MEMORY_SCOPE_AGENT);
      ci = (unsigned)__builtin_amdgcn_readfirstlane((int)ci);
      if (ci >= (unsigned)(MTOK / 16)) break;
#pragma unroll 1
      for (int tt = 0; tt < 16; ++tt) {
        const int tok = (int)ci * 16 + tt;
        const int e0 = EXPERT[(size_t)tok * 128 + lane], e1 = EXPERT[(size_t)tok * 128 + 64 + lane];
        u32x4 va[16];
#pragma unroll
        for (int i = 0; i < 16; ++i) {
          const int k = i * 8 + g8;
          const int ek = __shfl(i < 8 ? e0 : e1, k & 63);
          va[i] = *(const u32x4*)(VQS + ((size_t)(x * 16384 + ek)) * 128 + l8 * 16);
        }
        i32x4 af[2];
#pragma unroll
        for (int sx = 0; sx < 2; ++sx) {
          af[sx] = *(const i32x4*)(CQ8 + (size_t)tok * 256 + (fr & 1) * 128 + sx * 64 + fg * 16);
          if (fr >= 2) af[sx] = (i32x4){0, 0, 0, 0};
        }
        const float qsc = QSC[tok];
#pragma unroll
        for (int i = 0; i < 16; ++i) {
          const int k = i * 8 + g8;
          *(u32x4*)(VST + k * 128 + ((l8 ^ g8) << 4)) = va[i];
        }
        WAVE_LDS_SYNC();
        i32x4 acc[8];
#pragma unroll
        for (int c = 0; c < 8; ++c) acc[c] = (i32x4){0, 0, 0, 0};
#pragma unroll
        for (int sx = 0; sx < 2; ++sx) {
          const int r1 = sx * 64 + fg * 16 + trow, r2 = r1 + 8;
#pragma unroll
          for (int c = 0; c < 8; ++c) {
            const i32x2 lo = __builtin_amdgcn_ds_read_tr8_b64_v2i32((lds_i32x2*)(VST + r1 * 128 + ((c ^ (r1 & 7)) << 4) + 8 * thalf));
            const i32x2 hi = __builtin_amdgcn_ds_read_tr8_b64_v2i32((lds_i32x2*)(VST + r2 * 128 + ((c ^ (r2 & 7)) << 4) + 8 * thalf));
            const i32x4 bf = {lo[0], lo[1], hi[0], hi[1]};
            acc[c] = __builtin_amdgcn_mfma_i32_16x16x64_i8(af[sx], bf, acc[c], 0, 0, 0);
          }
        }
        WAVE_LDS_SYNC();
        if (lane < 16 && !(p.flags & 32)) {
          float* op = p.out + (size_t)tok * DM + x * 128 + fr;
#pragma unroll
          for (int c = 0; c < 8; ++c) op[16 * c] += ((float)acc[c][0] * 256.f + (float)acc[c][1]) * qsc;
        }
      }
    }
  }
}

__device__ __forceinline__ void grid_barrier(unsigned* ctr, unsigned nb) {
  asm volatile("s_waitcnt vmcnt(0)" ::: "memory");
  __syncthreads();
  if (TIDX == 0) {
    const unsigned ng = (gridDim.x & 7u) ? 1u : 8u, gsize = gridDim.x / ng;
    __builtin_amdgcn_fence(__ATOMIC_RELEASE, "agent");
    asm volatile("s_waitcnt vmcnt(0)" ::: "memory");
    unsigned* gctr = ctr + 32 + (blockIdx.x & (ng - 1u)) * 16;
    const unsigned old = __hip_atomic_fetch_add(gctr, 1u, __ATOMIC_RELAXED, __HIP_MEMORY_SCOPE_AGENT);
    if (old + 1u == gsize * nb) __hip_atomic_fetch_add(ctr, 1u, __ATOMIC_RELAXED, __HIP_MEMORY_SCOPE_AGENT);
    while (__hip_atomic_load(ctr, __ATOMIC_RELAXED, __HIP_MEMORY_SCOPE_AGENT) < ng * nb) __builtin_amdgcn_s_sleep(1);
    __builtin_amdgcn_fence(__ATOMIC_ACQUIRE, "agent");
    asm volatile("s_waitcnt vmcnt(0)" ::: "memory");
  }
  __syncthreads();
}

__global__ void __launch_bounds__(NTHREADS, 2) mk_fwd(Params p) {
  cg::grid_group grid = cg::this_grid();
  __shared__ __attribute__((aligned(16))) unsigned char smem[SMEM_BYTES];
  const int lo = p.ph_lo, hi = p.ph_hi;
#define RUN(k, call) if (lo <= (k) && (k) < hi) { call; if ((k) + 1 < hi) { if ((k) == 0) grid.sync(); else grid_barrier((unsigned*)p.ws, (unsigned)(lo == 0 ? (k) : (k) - lo + 1)); } }
  RUN(0, phase0(p, smem))
  RUN(1, phase1(p, smem))
  RUN(2, phase2(p, smem))
  RUN(3, phase3(p, smem))
  RUN(4, phase4(p, smem))
  RUN(5, phase5(p, smem))
  RUN(6, rmsnorm_rows<true>(p.out, p.in[12], (u16*)(p.ws + OFF_H2), p.ws + OFF_H2Q, (float*)(p.ws + OFF_HS)))
  RUN(7, phase6(p, smem))
  RUN(8, phase7(p, smem))
  RUN(9, phase7b(p))
  RUN(10, phase8a(p))
  RUN(11, phase8c(p))
  RUN(12, phase8b(p, smem))
#undef RUN
}

extern "C" void kernel_launch(void* const* d_in, const int* in_sizes, int n_in,
                              void* d_out, int out_size, void* d_ws, size_t ws_size,
                              hipStream_t stream) {
  static int grid_blocks = 0;
  if (!grid_blocks) {
    int dev = 0, cus = 0, per_cu = 0;
    (void)hipGetDevice(&dev);
    (void)hipDeviceGetAttribute(&cus, hipDeviceAttributeMultiprocessorCount, dev);
    (void)hipOccupancyMaxActiveBlocksPerMultiprocessor(&per_cu, mk_fwd, NTHREADS, 0);
    if (per_cu < 1) per_cu = 1;
    if (per_cu > 1) per_cu = 1;
    grid_blocks = cus * per_cu;
    fprintf(stderr, "mk_fwd: cus=%d per_cu=%d grid=%d ws=%zu\n", cus, per_cu, grid_blocks, ws_size);
  }
  Params p{};
  for (int i = 0; i < 17 && i < n_in; ++i) p.in[i] = (const float*)d_in[i];
  p.out = (float*)d_out;
  p.ws = (unsigned char*)d_ws;
  p.ph_lo = 0; p.ph_hi = 13;
  (void)hipMemsetAsync(d_ws, 0, 8192, stream);
  void* args[] = {&p};
  hipError_t e = hipLaunchCooperativeKernel((void*)mk_fwd, dim3(grid_blocks), dim3(NTHREADS), args, 0, stream);
  if (e != hipSuccess) fprintf(stderr, "cooperative launch failed: %s (grid %d)\n", hipGetErrorString(e), grid_blocks);
#ifdef EXTRA_LO
  {
    Params p2 = p;
    p2.ph_lo = EXTRA_LO; p2.ph_hi = EXTRA_HI; p2.flags = EXTRA_FLAGS;
    void* args2[] = {&p2};
    (void)hipLaunchCooperativeKernel((void*)mk_fwd, dim3(grid_blocks), dim3(NTHREADS), args2, 0, stream);
  }
#endif
}
```

```cpp
#include <hip/hip_runtime.h>
#include <hip/hip_bf16.h>
#include <hip/hip_cooperative_groups.h>
#include <cstdio>
#include <cstdint>
namespace cg = cooperative_groups;

typedef unsigned short u16;
typedef unsigned int u32;
typedef unsigned char u8;
typedef short bf16x8 __attribute__((ext_vector_type(8)));
typedef float f32x4 __attribute__((ext_vector_type(4)));
typedef unsigned int u32x4 __attribute__((ext_vector_type(4)));
typedef unsigned int u32x2 __attribute__((ext_vector_type(2)));

constexpr int NTHREADS = 512;
constexpr int BATCH = 8, SEQ = 4096, DM = 1024, MTOK = BATCH * SEQ;
constexpr int LDP = 5120;
constexpr int NPADW = 5632;
constexpr int C_AQ = 0, C_IQ = 512, C_DQ = 1024, C_DK = 1536, C_DV = 2048, C_DZ = 2560, C_GA = 3072, C_GB = 4096;
constexpr int N_AK = 5120, N_AV = 5248, N_IK = 5376, N_SM = 5440;
constexpr size_t MiB = 1ull << 20;
constexpr size_t OFF_WTIN = 1 * MiB, OFF_WTA = 12 * MiB, OFF_WTB = 13 * MiB, OFF_WTO = 14 * MiB, OFF_WTQ = 16 * MiB,
                 OFF_SKB = 20 * MiB, OFF_SMALL = 21 * MiB, OFF_H = 23 * MiB, OFF_ATT = 23 * MiB, OFF_GC = 39 * MiB,
                 OFF_MERGED = 23 * MiB, OFF_PROJ = 87 * MiB, OFF_KVC = 407 * MiB, OFF_IKC = 423 * MiB, OFF_SEL = 427 * MiB, OFF_YATT = 443 * MiB,
                 OFF_YDN = 475 * MiB;
constexpr size_t OFF_H2 = OFF_PROJ, OFF_QP = OFF_PROJ + 64 * MiB, OFF_TOPS = OFF_PROJ + 192 * MiB,
                 OFF_TOPI = OFF_PROJ + 224 * MiB, OFF_EXPERT = OFF_PROJ + 232 * MiB, OFF_GATE = OFF_PROJ + 248 * MiB;
constexpr size_t OFF_UQ = OFF_PROJ + 264 * MiB, OFF_VQ = OFF_PROJ + 280 * MiB, OFF_US = OFF_PROJ + 296 * MiB, OFF_VS = OFF_PROJ + 297 * MiB;
constexpr size_t OFF_CQ8 = 56 * MiB, OFF_QSC = 64 * MiB;
constexpr size_t OFF_H2Q = 23 * MiB, OFF_HS = 55 * MiB, OFF_PD = OFF_PROJ + 64 * MiB;
constexpr size_t DO_U = 0, DO_W = 32 * MiB, DO_QN = 64 * MiB, DO_KNT = 96 * MiB;

constexpr int SMEM_BYTES = 162816;
constexpr float EPS = 1e-6f;

struct Params {
  const float* in[17];
  float* out;
  unsigned char* ws;
  int ph_lo, ph_hi;
  int flags, pad;
};

typedef __bf16 bf16x2_t __attribute__((ext_vector_type(2)));
typedef float f32x2_t __attribute__((ext_vector_type(2)));
__device__ __forceinline__ u32 pack2(float a, float b) {
  f32x2_t f = {a, b};
  return __builtin_bit_cast(u32, __builtin_convertvector(f, bf16x2_t));
}
__device__ __forceinline__ u16 f2bf(float f) { return (u16)(pack2(f, f) & 0xffffu); }
__device__ __forceinline__ float bf2f(u16 h) { return __uint_as_float(((u32)h) << 16); }
__device__ __forceinline__ float bflo(u32 w) { return __uint_as_float(w << 16); }
__device__ __forceinline__ float bfhi(u32 w) { return __uint_as_float(w & 0xffff0000u); }
__device__ __forceinline__ float wave_sum(float v) {
#pragma unroll
  for (int o = 32; o > 0; o >>= 1) v += __shfl_xor(v, o);
  return v;
}
__device__ __forceinline__ float wave_max(float v) {
#pragma unroll
  for (int o = 32; o > 0; o >>= 1) v = fmaxf(v, __shfl_xor(v, o));
  return v;
}
__device__ __forceinline__ float dot2bf(u32 a, u32 b, float acc) {
  return __builtin_amdgcn_fdot2_f32_bf16(__builtin_bit_cast(bf16x2_t, a), __builtin_bit_cast(bf16x2_t, b), acc, false);
}
#define DPPF(v, ctrl) __int_as_float(__builtin_amdgcn_update_dpp(0, __float_as_int(v), ctrl, 0xf, 0xf, true))
__device__ __forceinline__ float wave_sum_dpp(float v) {
  v += DPPF(v, 0xb1);
  v += DPPF(v, 0x4e);
  v += DPPF(v, 0x124);
  v += DPPF(v, 0x128);
  float r0 = __int_as_float(__builtin_amdgcn_readlane(__float_as_int(v), 0));
  float r1 = __int_as_float(__builtin_amdgcn_readlane(__float_as_int(v), 16));
  float r2 = __int_as_float(__builtin_amdgcn_readlane(__float_as_int(v), 32));
  float r3 = __int_as_float(__builtin_amdgcn_readlane(__float_as_int(v), 48));
  return (r0 + r1) + (r2 + r3);
}
__device__ __forceinline__ int opaque_tid() { int t = threadIdx.x; asm volatile("" : "+v"(t)); return t; }
#define TIDX opaque_tid()
#define DPPI(v, ctrl) __builtin_amdgcn_update_dpp(0, (v), ctrl, 0xf, 0xf, true)
__device__ __forceinline__ int wave_sum_i_dpp(int v) {
  v += DPPI(v, 0xb1);
  v += DPPI(v, 0x4e);
  v += DPPI(v, 0x124);
  v += DPPI(v, 0x128);
  return (__builtin_amdgcn_readlane(v, 0) + __builtin_amdgcn_readlane(v, 16)) +
         (__builtin_amdgcn_readlane(v, 32) + __builtin_amdgcn_readlane(v, 48));
}
__device__ __forceinline__ float wave_max_dpp(float v) {
  v = fmaxf(v, DPPF(v, 0xb1));
  v = fmaxf(v, DPPF(v, 0x4e));
  v = fmaxf(v, DPPF(v, 0x124));
  v = fmaxf(v, DPPF(v, 0x128));
  float r0 = __int_as_float(__builtin_amdgcn_readlane(__float_as_int(v), 0));
  float r1 = __int_as_float(__builtin_amdgcn_readlane(__float_as_int(v), 16));
  float r2 = __int_as_float(__builtin_amdgcn_readlane(__float_as_int(v), 32));
  float r3 = __int_as_float(__builtin_amdgcn_readlane(__float_as_int(v), 48));
  return fmaxf(fmaxf(r0, r1), fmaxf(r2, r3));
}
#define WAVE_LDS_SYNC() asm volatile("s_waitcnt lgkmcnt(0)" ::: "memory")
__device__ __forceinline__ float sigmoidf_(float x) { return __builtin_amdgcn_rcpf(1.f + __expf(-x)); }
__device__ __forceinline__ int perm32(int k) {
  int blk = k & ~31, r = k & 31;
  int p = (r < 16) ? (8 * (r >> 2) + (r & 3)) : (8 * ((r - 16) >> 2) + 4 + (r & 3));
  return blk + p;
}

__device__ __forceinline__ u32 fp8x4(float a, float b, float c, float d) {
  int w = __builtin_amdgcn_cvt_pk_fp8_f32(a, b, 0, false);
  w = __builtin_amdgcn_cvt_pk_fp8_f32(c, d, w, true);
  return (u32)w;
}
__device__ __forceinline__ int g8_logical_col(int t) { return ((t & 127) >> 5) * 64 + (t >> 7) * 32 + (t & 31); }
__device__ __forceinline__ int win_map(int n) {
  if (n < 512) return n;
  if (n < 1024) return 768 + (n - 512);
  if (n < 3072) return 1352 + (n - 1024);
  if (n < 5120) return 3408 + (n - 3072);
  if (n < 5248) return 512 + (n - 5120);
  if (n < 5376) return 640 + (n - 5248);
  if (n < 5440) return 1280 + (n - 5376);
  if (n < 5448) return 1344 + (n - 5440);
  if (n < 5452) return 3400 + (n - 5448);
  if (n < 5456) return 3404 + (n - 5452);
  return -1;
}
__device__ __forceinline__ void transpose_tile(const float* __restrict__ src, int Nsrc, u16* __restrict__ dst, int K, int k0, int n0,
                               bool mapped, bool perm8, float* tile  , float f8scale = 0.f) {
  const int tid = TIDX;
  {
    const int tx = tid & 63, ty = tid >> 6;
    int n = n0 + tx;
    if (perm8) n = (n & ~255) + g8_logical_col(n & 255);
    int sc = mapped ? win_map(n) : n;
#pragma unroll
    for (int i = 0; i < 8; ++i) {
      int k = ty + 8 * i;
      float v = (sc >= 0) ? src[(size_t)(k0 + k) * Nsrc + sc] : 0.f;
      tile[k * 65 + tx] = v;
    }
  }
  __syncthreads();
  {
    const int n = tid >> 3, kc = (tid & 7) * 8;
    if (f8scale != 0.f) {
      u32 w[2];
#pragma unroll
      for (int j = 0; j < 2; ++j)
        w[j] = fp8x4(tile[(kc + 4 * j) * 65 + n] * f8scale, tile[(kc + 4 * j + 1) * 65 + n] * f8scale,
                     tile[(kc + 4 * j + 2) * 65 + n] * f8scale, tile[(kc + 4 * j + 3) * 65 + n] * f8scale);
      *(uint2*)((unsigned char*)dst + (size_t)(n0 + n) * K + k0 + kc) = make_uint2(w[0], w[1]);
    } else {
    u32 w[4];
#pragma unroll
    for (int j = 0; j < 4; ++j) w[j] = pack2(tile[(kc + 2 * j) * 65 + n], tile[(kc + 2 * j + 1) * 65 + n]);
    *(uint4*)(dst + (size_t)(n0 + n) * K + k0 + kc) = make_uint4(w[0], w[1], w[2], w[3]);
    }
  }
  __syncthreads();
}

template <bool Q8, bool F8OUT = false>
__device__ __forceinline__ void rmsnorm_rows(const float* __restrict__ x, const float* __restrict__ gain, u16* __restrict__ out,
                                             unsigned char* __restrict__ q8, float* __restrict__ qs) {
  const int lane = TIDX & 63, wave = TIDX >> 6;
  float4 g[4];
#pragma unroll
  for (int i = 0; i < 4; ++i) g[i] = ((const float4*)gain)[lane + 64 * i];
  for (int row = blockIdx.x * 8 + wave; row < MTOK; row += gridDim.x * 8) {
    const float4* xr = (const float4*)(x + (size_t)row * DM);
    float4 v[4];
    float ss = 0.f;
#pragma unroll
    for (int i = 0; i < 4; ++i) {
      v[i] = xr[lane + 64 * i];
      ss += v[i].x * v[i].x + v[i].y * v[i].y + v[i].z * v[i].z + v[i].w * v[i].w;
    }
    ss = wave_sum_dpp(ss);
    float r = rsqrtf(ss * (1.f / DM) + EPS);
    float amax = 0.f;
#pragma unroll
    for (int i = 0; i < 4; ++i) {
      v[i].x *= r * g[i].x; v[i].y *= r * g[i].y; v[i].z *= r * g[i].z; v[i].w *= r * g[i].w;
      if (F8OUT) {
        *(u32*)((unsigned char*)out + (size_t)row * DM + 4 * (lane + 64 * i)) = fp8x4(2.f * v[i].x, 2.f * v[i].y, 2.f * v[i].z, 2.f * v[i].w);
      } else {
        uint2 o;
        o.x = pack2(v[i].x, v[i].y);
        o.y = pack2(v[i].z, v[i].w);
        *(uint2*)(out + (size_t)row * DM + 4 * (lane + 64 * i)) = o;
      }
      if (Q8) amax = fmaxf(amax, fmaxf(fmaxf(fabsf(v[i].x), fabsf(v[i].y)), fmaxf(fabsf(v[i].z), fabsf(v[i].w))));
    }
    if (Q8) {
      amax = wave_max_dpp(amax);
      const float inv = amax > 0.f ? 127.f / amax : 0.f;
#pragma unroll
      for (int i = 0; i < 4; ++i) {
        const int q0 = (int)rintf(v[i].x * inv), q1 = (int)rintf(v[i].y * inv), q2 = (int)rintf(v[i].z * inv), q3 = (int)rintf(v[i].w * inv);
        *(u32*)(q8 + (size_t)row * DM + 4 * (lane + 64 * i)) =
            (u32)(q0 & 0xff) | ((u32)(q1 & 0xff) << 8) | ((u32)(q2 & 0xff) << 16) | ((u32)(q3 & 0xff) << 24);
      }
      if (lane == 0) qs[row] = amax * (1.f / 127.f);
    }
  }
}

__device__ __forceinline__ void phase0(const Params& p, unsigned char* smem) {
  float* tile = (float*)smem;
  unsigned char* ws = p.ws;
  const int n_in = 16 * 88, n_a = 8 * 16, n_b = 8 * 16, n_o = 16 * 16, n_q = 16 * 32;
  const int total = n_in + n_a + n_b + n_o + n_q;
  for (int t = blockIdx.x; t < total; t += gridDim.x) {
    int i = t;
    if (i < n_in) { transpose_tile(p.in[2], 5456, (u16*)(ws + OFF_WTIN), 1024, (i / 88) * 64, (i % 88) * 64, true, true, tile, 32.f); continue; }
    i -= n_in;
    if (i < n_a) { transpose_tile(p.in[9], 1024, (u16*)(ws + OFF_WTA), 512, (i / 16) * 64, (i % 16) * 64, false, true, tile); continue; }
    i -= n_a;
    if (i < n_b) { transpose_tile(p.in[10], 1024, (u16*)(ws + OFF_WTB), 512, (i / 16) * 64, (i % 16) * 64, false, true, tile); continue; }
    i -= n_b;
    if (i < n_o) { transpose_tile(p.in[11], 1024, (u16*)(ws + OFF_WTO), 1024, (i / 16) * 64, (i % 16) * 64, false, true, tile); continue; }
    i -= n_o;
    transpose_tile(p.in[13], 2048, (u16*)(ws + OFF_WTQ), 1024, (i / 32) * 64, (i % 32) * 64, false, true, tile);
  }
  {
    const float* sk = p.in[14];
    u16* skb = (u16*)(ws + OFF_SKB);
    for (int i = blockIdx.x * NTHREADS + TIDX; i < 16 * 128 * 128; i += gridDim.x * NTHREADS) skb[i] = f2bf(sk[i]);
  }
  rmsnorm_rows<false, true>(p.in[0], p.in[1], (u16*)(ws + OFF_H), nullptr, nullptr);
}

constexpr int G_BM = 256, G_BN = 128, G_BK = 64;
constexpr int G_ABYTES = G_BM * 128;

template <int MI>
__device__ __forceinline__ void gemm_mainloop_t(const u16* __restrict__ A, int lda, const u16* __restrict__ Bt, int ldb, int K,
                                                int m0, int n0, unsigned char* smem, f32x4 (&acc)[MI][4]) {
  constexpr int BN = (MI == 4) ? 128 : 256;
  constexpr int NRB = BN / 64;
  constexpr int STAGE = G_ABYTES + BN * 128;
  const int tid = TIDX, lane = tid & 63, wave = tid >> 6;
  const int wm = (MI == 4) ? (wave >> 1) : (wave >> 2), wn = (MI == 4) ? (wave & 1) : (wave & 3);
#pragma unroll
  for (int i = 0; i < MI; ++i)
#pragma unroll
    for (int j = 0; j < 4; ++j) acc[i][j] = (f32x4){0.f, 0.f, 0.f, 0.f};
  const int kc = tid & 7;
  const int arow = tid >> 3;
  u32x4 ra[4], rb[NRB];
  const u16* ap = A + (size_t)(m0 + arow) * lda + kc * 8;
  const u16* bp = Bt + (size_t)(n0 + arow) * ldb + kc * 8;
  const int nk = K / G_BK;
  const int fr = lane & 15, fg = lane >> 4;
#define G_LOAD(kt_)                                                                       \
  {                                                                                       \
    const u16* ap2_ = ap + (size_t)(kt_) * G_BK;                                          \
    const u16* bp2_ = bp + (size_t)(kt_) * G_BK;                                          \
    _Pragma("unroll") for (int i = 0; i < 4; ++i) ra[i] = *(const u32x4*)(ap2_ + (size_t)(64 * i) * lda); \
    _Pragma("unroll") for (int i = 0; i < NRB; ++i) rb[i] = *(const u32x4*)(bp2_ + (size_t)(64 * i) * ldb); \
  }
#define G_STORE(st_)                                                                      \
  {                                                                                       \
    unsigned char* sa_ = smem + (st_) * STAGE;                                            \
    unsigned char* sb_ = sa_ + G_ABYTES;                                                  \
    _Pragma("unroll") for (int i = 0; i < 4; ++i) { int r = arow + 64 * i; *(u32x4*)(sa_ + r * 128 + ((kc ^ (r & 7)) << 4)) = ra[i]; } \
    _Pragma("unroll") for (int i = 0; i < NRB; ++i) { int r = arow + 64 * i; *(u32x4*)(sb_ + r * 128 + ((kc ^ (r & 7)) << 4)) = rb[i]; } \
  }
  G_LOAD(0)
  __syncthreads();
  G_STORE(0)
  if (nk > 1) G_LOAD(1)
  __syncthreads();
  for (int kt = 0; kt < nk; ++kt) {
    if (kt + 1 < nk) G_STORE((kt + 1) & 1)
    if (kt + 2 < nk) G_LOAD(kt + 2)
    __builtin_amdgcn_sched_barrier(0);
    const unsigned char* sa = smem + (kt & 1) * STAGE;
    const unsigned char* sb = sa + G_ABYTES;
#pragma unroll
    for (int kk = 0; kk < 2; ++kk) {
      bf16x8 bfr[4];
#pragma unroll
      for (int j = 0; j < 4; ++j) {
        int r = wn * 64 + j * 16 + fr;
        bfr[j] = *(const bf16x8*)(sb + r * 128 + (((kk * 4 + fg) ^ (r & 7)) << 4));
      }
#pragma unroll
      for (int ih = 0; ih < MI; ih += 4) {
        bf16x8 af[4];
#pragma unroll
        for (int i = 0; i < 4; ++i) {
          int r = wm * (MI * 16) + (ih + i) * 16 + fr;
          af[i] = *(const bf16x8*)(sa + r * 128 + (((kk * 4 + fg) ^ (r & 7)) << 4));
        }
#pragma unroll
        for (int i = 0; i < 4; ++i)
#pragma unroll
          for (int j = 0; j < 4; ++j) acc[ih + i][j] = __builtin_amdgcn_mfma_f32_16x16x32_bf16(af[i], bfr[j], acc[ih + i][j], 0, 0, 0);
        if (MI == 8 && ih == 0) __builtin_amdgcn_sched_barrier(0);
      }
    }
    __syncthreads();
  }
#undef G_LOAD
#undef G_STORE
}
__device__ __forceinline__ void gemm_mainloop(const u16* __restrict__ A, int lda, const u16* __restrict__ Bt, int ldb, int K,
                                              int m0, int n0, unsigned char* smem, f32x4 (&acc)[4][4]) {
  gemm_mainloop_t<4>(A, lda, Bt, ldb, K, m0, n0, smem, acc);
}

__device__ __forceinline__ int g8_lds_byte(int r, int c) {
  int st = (r >> 4) * 2 + (c >> 5), rr = r & 15, cc = c & 31, ob = rr * 64 + cc * 2;
  return st * 1024 + (ob ^ (((ob >> 9) & 1) << 5));
}
__device__ __forceinline__ void g8_stage_rc(int b, int& R, int& C) {
  int st = b / 1024, sb = b % 1024, swz = sb ^ (((sb >> 9) & 1) << 5);
  R = (st >> 1) * 16 + swz / 64; C = (st & 1) * 32 + (swz % 64) / 2;
}
typedef __attribute__((address_space(3))) unsigned int lds_u32;
template <int F8 = 0, int SC = 127>
__device__ __forceinline__ void gemm8_tile(const u16* __restrict__ A, const u16* __restrict__ Bt, int K, int brow, int bcol,
                                           unsigned char* smem, f32x4 (&acc)[2][2][4][2]) {
  typedef int i32x8_ __attribute__((ext_vector_type(8)));
  typedef int i32x4_ __attribute__((ext_vector_type(4)));
  constexpr int HTB = 16384;
  const int tid = TIDX;
  const int wid = tid >> 6, lane = tid & 63, wr = wid >> 2, wc = wid & 3, fr = lane & 15, fq = lane >> 4;
#define SA(b, h) (smem + ((b) * 2 + (h)) * HTB)
#define SB(b, h) (smem + (4 + (b) * 2 + (h)) * HTB)
  u32 soff0;
  { int _r, _c; g8_stage_rc(tid * 16, _r, _c); soff0 = (u32)(_r * K + _c) * 2u; }
  const int wbase = __builtin_amdgcn_readfirstlane(wid) * 1024;
#define STAGE(P, BASE, br, kt) do { \
    unsigned long long _uv0 = (unsigned long long)(BASE) + (unsigned long long)(((long)(br) * K + (long)(kt) * 64) * 2); \
    unsigned long long _uv1 = _uv0 + (unsigned long long)(64 * K * 2); \
    asm volatile("" : "+s"(_uv0), "+s"(_uv1), "+v"(soff0)); \
    __builtin_amdgcn_global_load_lds((const unsigned int*)((const unsigned char*)_uv0 + soff0), (lds_u32*)((P) + wbase), 16, 0, 0); \
    __builtin_amdgcn_global_load_lds((const unsigned int*)((const unsigned char*)_uv1 + soff0), (lds_u32*)((P) + wbase + 8192), 16, 0, 0); } while (0)
#define LDA(dst, b, h) _Pragma("unroll") for (int m = 0; m < 4; ++m) _Pragma("unroll") for (int k = 0; k < 2; ++k) \
    dst[m][k] = *(const bf16x8*)(SA(b, h) + g8_lds_byte(wr * 64 + m * 16 + fr, k * 32 + fq * 8))
#define LDB(dst, b, h) _Pragma("unroll") for (int n = 0; n < 2; ++n) _Pragma("unroll") for (int k = 0; k < 2; ++k) \
    dst[n][k] = *(const bf16x8*)(SB(b, h) + g8_lds_byte(wc * 32 + n * 16 + fr, k * 32 + fq * 8))
#define MMA(ai, bj, At_, Bt_) do { __builtin_amdgcn_s_setprio(1); \
    if (F8) { \
      _Pragma("unroll") for (int m = 0; m < 4; ++m) _Pragma("unroll") for (int n = 0; n < 2; ++n) \
          \
        asm volatile("v_mfma_scale_f32_16x16x128_f8f6f4 %0, %1, %2, %0, %3, %3 op_sel_hi:[0,0,0]" \
            : "+v"(acc[ai][bj][m][n]) \
            : "v"(__builtin_shufflevector((i32x4_)At_[m][0], (i32x4_)At_[m][1], 0, 1, 2, 3, 4, 5, 6, 7)), \
              "v"(__builtin_shufflevector((i32x4_)Bt_[n][0], (i32x4_)Bt_[n][1], 0, 1, 2, 3, 4, 5, 6, 7)), "v"(scv)); \
    } else { \
    _Pragma("unroll") for (int m = 0; m < 4; ++m) _Pragma("unroll") for (int n = 0; n < 2; ++n) _Pragma("unroll") for (int k = 0; k < 2; ++k) \
      acc[ai][bj][m][n] = __builtin_amdgcn_mfma_f32_16x16x32_bf16(At_[m][k], Bt_[n][k], acc[ai][bj][m][n], 0, 0, 0); \
    } \
    __builtin_amdgcn_s_setprio(0); } while (0)
#define WAIT_V(n) asm volatile("s_waitcnt vmcnt(" #n ")" ::: "memory")
#define WAIT_L(n) asm volatile("s_waitcnt lgkmcnt(" #n ")" ::: "memory")
#define BAR __builtin_amdgcn_s_barrier()
#define SCHED __builtin_amdgcn_sched_barrier(0)
#pragma unroll
  for (int a = 0; a < 2; ++a)
#pragma unroll
    for (int b2 = 0; b2 < 2; ++b2)
#pragma unroll
      for (int m = 0; m < 4; ++m)
#pragma unroll
        for (int n = 0; n < 2; ++n) acc[a][b2][m][n] = (f32x4){0.f, 0.f, 0.f, 0.f};
  bf16x8 At[4][2], B0[2][2], B1[2][2];
  const int scv = SC * 0x01010101;
  const int nt = K / 64;
  constexpr int HALF = 128;
  __syncthreads();
  STAGE(SB(0, 0), Bt, bcol, 0); STAGE(SA(0, 0), A, brow, 0);
  STAGE(SB(0, 1), Bt, bcol + HALF, 0); STAGE(SA(0, 1), A, brow + HALF, 0);
  if (wr == 1) BAR;
  WAIT_V(4); BAR;
  STAGE(SB(1, 0), Bt, bcol, 1); STAGE(SA(1, 0), A, brow, 1); STAGE(SB(1, 1), Bt, bcol + HALF, 1);
  WAIT_V(6); BAR;
#pragma unroll 1
  for (int t = 0; t < nt - 2; t += 2) {
    LDB(B0, 0, 0); SCHED; LDA(At, 0, 0); STAGE(SA(1, 1), A, brow + HALF, t + 1);
    WAIT_L(8); BAR; WAIT_L(0); MMA(0, 0, At, B0); BAR; SCHED;
    LDB(B1, 0, 1); STAGE(SB(0, 0), Bt, bcol, t + 2);
    BAR; WAIT_L(0); MMA(0, 1, At, B1); BAR;
    LDA(At, 0, 1); STAGE(SA(0, 0), A, brow, t + 2);
    BAR; WAIT_L(0); MMA(1, 0, At, B0); BAR; SCHED;
    STAGE(SB(0, 1), Bt, bcol + HALF, t + 2);
    WAIT_V(6); BAR; MMA(1, 1, At, B1); BAR;
    LDB(B0, 1, 0); SCHED; LDA(At, 1, 0); STAGE(SA(0, 1), A, brow + HALF, t + 2);
    WAIT_L(8); BAR; WAIT_L(0); MMA(0, 0, At, B0); BAR; SCHED;
    LDB(B1, 1, 1); STAGE(SB(1, 0), Bt, bcol, t + 3);
    BAR; WAIT_L(0); MMA(0, 1, At, B1); BAR;
    LDA(At, 1, 1); STAGE(SA(1, 0), A, brow, t + 3);
    BAR; WAIT_L(0); MMA(1, 0, At, B0); BAR; SCHED;
    STAGE(SB(1, 1), Bt, bcol + HALF, t + 3);
    WAIT_V(6); BAR; MMA(1, 1, At, B1); BAR;
  }
#define ACC_PIN() _Pragma("unroll") for (int a = 0; a < 2; ++a) _Pragma("unroll") for (int b2 = 0; b2 < 2; ++b2) \
      asm volatile("" : "+v"(acc[a][b2][0][0]), "+v"(acc[a][b2][0][1]), "+v"(acc[a][b2][1][0]), "+v"(acc[a][b2][1][1]), \
                        "+v"(acc[a][b2][2][0]), "+v"(acc[a][b2][2][1]), "+v"(acc[a][b2][3][0]), "+v"(acc[a][b2][3][1]))
  ACC_PIN();
  { LDB(B0, 0, 0); LDA(At, 0, 0); STAGE(SA(1, 1), A, brow + HALF, nt - 1);
    BAR; WAIT_L(0); MMA(0, 0, At, B0); BAR; SCHED;
    LDB(B1, 0, 1); BAR; WAIT_L(0); MMA(0, 1, At, B1); BAR; SCHED;
    LDA(At, 0, 1); WAIT_V(4); BAR; WAIT_L(0); MMA(1, 0, At, B0); SCHED; MMA(1, 1, At, B1); BAR; SCHED; }
  { LDB(B0, 1, 0); LDA(At, 1, 0); WAIT_V(2); BAR; WAIT_L(0); MMA(0, 0, At, B0); BAR; SCHED;
    LDB(B1, 1, 1); WAIT_V(0); BAR; WAIT_L(0); MMA(0, 1, At, B1); BAR; SCHED;
    LDA(At, 1, 1); BAR; WAIT_L(0); MMA(1, 0, At, B0); SCHED; MMA(1, 1, At, B1); BAR; SCHED; }
  ACC_PIN();
#undef ACC_PIN
  if (wr == 0) BAR;
#undef SA
#undef SB
#undef STAGE
#undef LDA
#undef LDB
#undef MMA
#undef WAIT_V
#undef WAIT_L
#undef BAR
#undef SCHED
}

template <int LD, bool NORM>
__device__ __forceinline__ void ep_store(u16* __restrict__ dst, u32 ob, const f32x4 (&acc)[2][2][4][2], const float* __restrict__ gain,
                                         float extra, unsigned char* smem, int wave, int lane_in) {
  int lane = lane_in;
  asm volatile("" : "+v"(lane));
  const int fr = lane & 15, fq = lane >> 4;
  unsigned char* reg = smem + wave * 16384;
  float gj[4] = {1.f, 1.f, 1.f, 1.f};
  if (NORM) {
#pragma unroll
    for (int j = 0; j < 4; ++j) gj[j] = gain[j * 16 + fr] * extra;
  }
  const int lrot = (fr >> 3) + 2 * fq;
  unsigned char* wbase = reg + (4 * fq) * 128 + (fr & 7) * 2;
#pragma unroll
  for (int ai = 0; ai < 2; ++ai)
#pragma unroll
    for (int m = 0; m < 4; ++m) {
#pragma unroll
      for (int r = 0; r < 4; ++r) {
        float rs = 1.f;
        if (NORM) {
          float sq = 0.f;
#pragma unroll
          for (int bj = 0; bj < 2; ++bj)
#pragma unroll
            for (int n = 0; n < 2; ++n) sq += acc[ai][bj][m][n][r] * acc[ai][bj][m][n][r];
          sq += DPPF(sq, 0xb1); sq += DPPF(sq, 0x4e); sq += DPPF(sq, 0x141); sq += DPPF(sq, 0x140);
          rs = rsqrtf(sq * (1.f / 64.f) + EPS);
        }
#pragma unroll
        for (int bj = 0; bj < 2; ++bj)
#pragma unroll
          for (int n = 0; n < 2; ++n) {
            const float v = acc[ai][bj][m][n][r];
            const int ch = ((bj * 2 + n) * 2 + lrot) & 7;
            *(u16*)(wbase + (ai * 64 + m * 16 + r) * 128 + (ch << 4)) = f2bf(NORM ? v * rs * gj[bj * 2 + n] : v);
          }
      }
      __builtin_amdgcn_sched_barrier(0);
    }
  WAVE_LDS_SYNC();
  const int c16 = lane & 7, r8 = lane >> 3;
#pragma unroll
  for (int it = 0; it < 16; ++it) {
    const int rw = it * 8 + r8;
    const u32x4 v = *(const u32x4*)(reg + rw * 128 + (((c16 + 2 * ((rw >> 2) & 3)) & 7) << 4));
    const int grow = (it >> 3) * 128 + (it & 7) * 8 + r8;
    *(u32x4*)(dst + ob + (u32)(grow * LD + c16 * 8)) = v;
    if ((it & 3) == 3) __builtin_amdgcn_sched_barrier(0);
  }
}

template <bool NORM>
__device__ __forceinline__ void ep_store8(unsigned char* __restrict__ dst, u32 ob, const f32x4 (&acc)[2][2][4][2],
                                          const float* __restrict__ gain, unsigned char* smem, int wave, int lane_in) {
  int lane = lane_in;
  asm volatile("" : "+v"(lane));
  const int fr = lane & 15, fq = lane >> 4;
  unsigned char* reg = smem + wave * 16384;
  float gj[4] = {1.f, 1.f, 1.f, 1.f};
  if (NORM) {
#pragma unroll
    for (int j = 0; j < 4; ++j) gj[j] = gain[j * 16 + fr];
  }
#pragma unroll
  for (int ai = 0; ai < 2; ++ai)
#pragma unroll
    for (int m = 0; m < 4; ++m) {
#pragma unroll
      for (int r = 0; r < 4; ++r) {
        float rs = 1.f;
        if (NORM) {
          float sq = 0.f;
#pragma unroll
          for (int bj = 0; bj < 2; ++bj)
#pragma unroll
            for (int n = 0; n < 2; ++n) sq += acc[ai][bj][m][n][r] * acc[ai][bj][m][n][r];
          sq += DPPF(sq, 0xb1); sq += DPPF(sq, 0x4e); sq += DPPF(sq, 0x141); sq += DPPF(sq, 0x140);
          rs = rsqrtf(sq * (1.f / 64.f) + EPS);
        }
        const int rw = ai * 64 + m * 16 + 4 * fq + r;
#pragma unroll
        for (int bj = 0; bj < 2; ++bj)
#pragma unroll
          for (int n = 0; n < 2; ++n) {
            const float v = NORM ? acc[ai][bj][m][n][r] * rs * gj[bj * 2 + n] : acc[ai][bj][m][n][r];
            reg[rw * 64 + ((((bj * 2 + n) + (rw >> 2)) & 3) << 4) + fr] =
                (unsigned char)(__builtin_amdgcn_cvt_pk_fp8_f32(v, v, 0, false) & 0xff);
          }
      }
      __builtin_amdgcn_sched_barrier(0);
    }
  WAVE_LDS_SYNC();
  const int c4 = lane & 3, r16 = lane >> 2;
#pragma unroll
  for (int it = 0; it < 8; ++it) {
    const int rw = it * 16 + r16;
    const u32x4 v = *(const u32x4*)(reg + rw * 64 + (((c4 + (rw >> 2)) & 3) << 4));
    const int grow = (rw >> 6) * 128 + (rw & 63);
    *(u32x4*)(dst + ob + (u32)(grow * 256 + c4 * 16)) = v;
  }
}

__device__ __forceinline__ void phase1(const Params& p, unsigned char* smem) {
  const u16* H = (const u16*)(p.ws + OFF_H);
  const u16* WT = (const u16*)(p.ws + OFF_WTIN);
  u16* PROJ = (u16*)(p.ws + OFF_PROJ);
  u16* KVC = (u16*)(p.ws + OFF_KVC);
  u16* IKC = (u16*)(p.ws + OFF_IKC);
  float* SMALL = (float*)(p.ws + OFF_SMALL);
  const int ntn = NPADW / 256;
  const int ntiles = (MTOK / 256) * ntn;
  for (int t = blockIdx.x; t < ntiles; t += gridDim.x) {
    const int m0 = (t / ntn) * 256, n0 = (t % ntn) * 256;
    f32x4 acc[2][2][4][2];
    gemm8_tile<1, 124>(H, WT, DM / 2, m0, n0, smem, acc);
    const int tid_e = TIDX, lane = tid_e & 63, wave = tid_e >> 6;
    const int wr = wave >> 2, wc = wave & 3, fr = lane & 15, fq = lane >> 4;
    const int cbase = n0 + wc * 64;
    const u32 rbase = (u32)(m0 + wr * 64);
    if (cbase < C_IQ) {
      ep_store<LDP, true>(PROJ, rbase * LDP + (u32)cbase, acc, p.in[3], 0.125f, smem, wave, lane);
    } else if (cbase < LDP) {
      ep_store<LDP, false>(PROJ, rbase * LDP + (u32)cbase, acc, nullptr, 1.f, smem, wave, lane);
    } else if (cbase < N_AV) {
      ep_store8<true>(p.ws + OFF_KVC, rbase * 256 + (u32)(cbase - N_AK), acc, p.in[4], smem, wave, lane);
    } else if (cbase < N_IK) {
      ep_store8<false>(p.ws + OFF_KVC, rbase * 256 + (u32)(cbase - N_AV + 128), acc, nullptr, smem, wave, lane);
    } else if (cbase < N_SM) {
      ep_store<64, false>(IKC, rbase * 64, acc, nullptr, 1.f, smem, wave, lane);
    } else if (cbase == N_SM) {
      const u32 sb0 = (rbase + 4 * fq) * 16 + (u32)fr;
#pragma unroll
      for (int ai = 0; ai < 2; ++ai)
#pragma unroll
        for (int m = 0; m < 4; ++m)
#pragma unroll
          for (int r = 0; r < 4; ++r) SMALL[sb0 + (u32)((ai * 128 + m * 16 + r) * 16)] = acc[ai][0][m][0][r];
    }
  }
}

constexpr int IDX_RS = 8208;

__device__ __forceinline__ u32 f2key(float x) {
  _Float16 h = (_Float16)x;
  u32 b = (u32) * (u16*)&h;
  return (b & 0x8000u) ? ((~b) & 0xffffu) : (b | 0x8000u);
}
__device__ __forceinline__ int count_ge_wave(const u32 (&kreg)[32], u32 mid, int ndw) {
  const u32 m1 = (mid - 1u) * 0x00010001u;
  const u32 one = 0x00010001u;
  u32 acc0 = 0u, acc1 = 0u;
#pragma unroll
  for (int c4 = 0; c4 < 8; ++c4) {
    if (c4 * 4 < ndw) {
#pragma unroll
      for (int i = c4 * 4; i < c4 * 4 + 4; i += 2) {
        u32 t0, t1;
        asm("v_pk_sub_u16 %0, %1, %2 clamp" : "=v"(t0) : "v"(kreg[i]), "s"(m1));
        asm("v_pk_sub_u16 %0, %1, %2 clamp" : "=v"(t1) : "v"(kreg[i + 1]), "s"(m1));
        asm("v_pk_min_u16 %0, %1, %2" : "=v"(t0) : "v"(t0), "s"(one));
        asm("v_pk_min_u16 %0, %1, %2" : "=v"(t1) : "v"(t1), "s"(one));
        asm("v_pk_add_u16 %0, %1, %2" : "=v"(acc0) : "v"(acc0), "v"(t0));
        asm("v_pk_add_u16 %0, %1, %2" : "=v"(acc1) : "v"(acc1), "v"(t1));
      }
    }
  }
  int c = (int)((acc0 & 0xffffu) + (acc0 >> 16) + (acc1 & 0xffffu) + (acc1 >> 16));
  return wave_sum_i_dpp(c);
}

__device__ __forceinline__ void idx_item(const Params& p, unsigned char* smem, int b, int tq) {
  const u16* PROJ = (const u16*)(p.ws + OFF_PROJ);
  const float* SMALL = (const float*)(p.ws + OFF_SMALL);
  u16* SEL = (u16*)(p.ws + OFF_SEL);
  const int tid = TIDX, lane = tid & 63, wave = tid >> 6;
  const int t0 = tq * 16;
  const size_t tokb = (size_t)b * SEQ;
  if (tq < 16) {
    for (int rr = 0; rr < 2; ++rr) {
      int row = 2 * wave + rr, t = t0 + row;
      u16* out = SEL + (tokb + t) * 256;
      for (int i = lane; i < 256; i += 64) out[i] = (i <= t) ? (u16)i : (u16)0xFFFF;
    }
    return;
  }
  const int q = lane & 15, g = lane >> 4;
  __syncthreads();
  {
    const u16* iqrow = PROJ + (tokb + t0 + q) * LDP + C_IQ;
    bf16x8 bq[8][2];
    float wq[8];
#pragma unroll
    for (int h = 0; h < 8; ++h) {
      bq[h][0] = *(const bf16x8*)(iqrow + h * 64 + g * 8);
      bq[h][1] = *(const bf16x8*)(iqrow + h * 64 + 32 + g * 8);
      wq[h] = SMALL[(tokb + t0 + q) * 16 + h];
    }
    bf16x8 bqs[2];
    {
      typedef u32 u32x4_ __attribute__((ext_vector_type(4)));
#pragma unroll
      for (int kk = 0; kk < 2; ++kk) {
        float s8[8];
#pragma unroll
        for (int e = 0; e < 8; ++e) s8[e] = 0.f;
#pragma unroll
        for (int h = 0; h < 8; ++h) {
          const u32x4_ w4 = (u32x4_)bq[h][kk];
#pragma unroll
          for (int c = 0; c < 4; ++c) { s8[2 * c] = fmaf(wq[h], bflo(w4[c]), s8[2 * c]); s8[2 * c + 1] = fmaf(wq[h], bfhi(w4[c]), s8[2 * c + 1]); }
        }
        u32x4_ o4;
#pragma unroll
        for (int c = 0; c < 4; ++c) o4[c] = pack2(s8[2 * c], s8[2 * c + 1]);
        bqs[kk] = (bf16x8)o4;
      }
    }
    const int nkb = tq + 1;
    const int niter = (nkb > wave) ? ((nkb - wave + 7) >> 3) : 0;
    const u16* ikbase = (const u16*)(p.ws + OFF_IKC) + (tokb + q) * 64 + g * 8;
    bf16x8 ca[3][2];
#pragma unroll
    for (int j = 0; j < 3; ++j)
      if (j < niter) {
        const u16* ikrow = ikbase + (size_t)((wave + 8 * j) * 16) * 64;
        ca[j][0] = *(const bf16x8*)(ikrow); ca[j][1] = *(const bf16x8*)(ikrow + 32);
      }
    for (int i0 = 0; i0 < ((p.flags & 8) ? 0 : niter); i0 += 3) {
#pragma unroll
      for (int j = 0; j < 3; ++j) {
        if (i0 + j < niter) {
          const int s0 = (wave + 8 * (i0 + j)) * 16;
          f32x4 tot = {0.f, 0.f, 0.f, 0.f};
          tot = __builtin_amdgcn_mfma_f32_16x16x32_bf16(ca[j][0], bqs[0], tot, 0, 0, 0);
          tot = __builtin_amdgcn_mfma_f32_16x16x32_bf16(ca[j][1], bqs[1], tot, 0, 0, 0);
#pragma unroll
          for (int h = 0; h < 8; ++h) {
            f32x4 acc = {0.f, 0.f, 0.f, 0.f};
            acc = __builtin_amdgcn_mfma_f32_16x16x32_bf16(ca[j][0], bq[h][0], acc, 0, 0, 0);
            acc = __builtin_amdgcn_mfma_f32_16x16x32_bf16(ca[j][1], bq[h][1], acc, 0, 0, 0);
#pragma unroll
            for (int r = 0; r < 4; ++r) tot[r] = fmaf(fabsf(acc[r]), wq[h], tot[r]);
          }
          if (i0 + 3 + j < niter) {
            const u16* ikrow = ikbase + (size_t)((wave + 8 * (i0 + 3 + j)) * 16) * 64;
            ca[j][0] = *(const bf16x8*)(ikrow); ca[j][1] = *(const bf16x8*)(ikrow + 32);
          }
          typedef short s16x2_ __attribute__((ext_vector_type(2)));
          u32x2 w2;
#pragma unroll
          for (int c = 0; c < 2; ++c) {
            const u32 pk = __builtin_bit_cast(u32, __builtin_amdgcn_cvt_pkrtz(tot[2 * c], tot[2 * c + 1]));
            const u32 sm = __builtin_bit_cast(u32, __builtin_bit_cast(s16x2_, pk) >> (s16x2_){15, 15});
            w2[c] = pk ^ (sm | 0x80008000u);
          }
          if (s0 == t0) {
#pragma unroll
            for (int c = 0; c < 2; ++c) {
              const int sidx = s0 + 4 * g + 2 * c;
              w2[c] = (sidx <= t0 + q ? (w2[c] & 0xffffu) : 0u) | (sidx + 1 <= t0 + q ? (w2[c] & 0xffff0000u) : 0u);
            }
          }
          *(u32x2*)(smem + q * IDX_RS + (s0 + 4 * g) * 2) = w2;
        }
        __builtin_amdgcn_sched_barrier(0);
      }
    }
    const int nk = t0 + 16, nk64 = (nk + 511) & ~511;
#pragma unroll
    for (int rr = 0; rr < 2; ++rr) {
      const int cb = nk * 2 + lane * 16;
      if (cb < nk64 * 2) *(u32x4*)(smem + (2 * wave + rr) * IDX_RS + cb) = (u32x4){0u, 0u, 0u, 0u};
    }
  }
  __syncthreads();
  const int ndw = ((t0 + 16 + 511) >> 9) << 2;
  for (int rr = 0; rr < ((p.flags & 16) ? 0 : 2); ++rr) {
    const int row = 2 * wave + rr, t = t0 + row;
    u16* out = SEL + (tokb + t) * 256;
    u32 kreg[32];
    {
      const u32* src = (const u32*)(smem + row * IDX_RS) + lane;
#pragma unroll
      for (int c4 = 0; c4 < 8; ++c4)
        if (c4 * 4 < ndw) {
#pragma unroll
          for (int i = c4 * 4; i < c4 * 4 + 4; ++i) kreg[i] = src[i * 64];
        }
    }
    WAVE_LDS_SYNC();
    u32 lo = 1u, hi = 65535u;
    while (lo < hi) {
      u32 mid = (lo + hi + 1u) >> 1;
      int c = count_ge_wave(kreg, mid, ndw);
      if (c >= 256) lo = mid; else hi = mid - 1u;
    }
    const u32 tau = lo;
    int gt = 0, eq = 0;
#pragma unroll
    for (int c4 = 0; c4 < 8; ++c4)
      if (c4 * 4 < ndw) {
#pragma unroll
        for (int i = c4 * 4; i < c4 * 4 + 4; ++i) {
          u32 a = kreg[i] & 0xffffu, c2 = kreg[i] >> 16;
          gt += (a > tau) ? 1 : 0; gt += (c2 > tau) ? 1 : 0;
          eq += (a == tau) ? 1 : 0; eq += (c2 == tau) ? 1 : 0;
        }
      }
    int packed = gt | (eq << 16);
    int incl = packed;
#pragma unroll
    for (int o = 1; o < 64; o <<= 1) {
      int v = __shfl_up(incl, o);
      if (lane >= o) incl += v;
    }
    const int excl = incl - packed;
    const int total = __shfl(incl, 63);
    const int need = 256 - (total & 0xffff);
    const int pg = excl & 0xffff, pe = excl >> 16;
    int pos = pg + min(pe, need);
    int eqseen = pe;
    u16* lrow = (u16*)(smem + row * IDX_RS);
#pragma unroll
    for (int c4 = 0; c4 < 8; ++c4)
      if (c4 * 4 < ndw) {
#pragma unroll
        for (int i = c4 * 4; i < c4 * 4 + 4; ++i) {
#pragma unroll
          for (int hh = 0; hh < 2; ++hh) {
            u32 kv = hh ? (kreg[i] >> 16) : (kreg[i] & 0xffffu);
            int idx = 128 * i + 2 * lane + hh;
            bool take = false;
            if (kv > tau) take = true;
            else if (kv == tau) { take = (eqseen < need); ++eqseen; }
            if (take) { lrow[pos] = (u16)idx; ++pos; }
          }
        }
      }
    WAVE_LDS_SYNC();
    *(u32x2*)(out + lane * 4) = *(const u32x2*)(lrow + lane * 4);
    WAVE_LDS_SYNC();
  }
}

constexpr int DNP = 68;
constexpr int DL_KT = 0;
constexpr int DL_V = DL_KT + 128 * DNP * 4;
constexpr int DL_QB = DL_V + 64 * 128 * 4;
constexpr int DL_KB = DL_QB + 64 * 272;
constexpr int DL_SM = DL_KB + 64 * 272;
constexpr int DL_RAW = DL_SM + 2048;
static_assert(DL_RAW + 3 * 67 * 272 <= SMEM_BYTES && 16384 + 64 * 144 + 2048 <= 3 * 67 * 272, "dn_local LDS");
__device__ __forceinline__ void dn_local_item(const Params& p, unsigned char* smem, int item) {
  const int h = item & 3, n = (item >> 2) & 63, b = item >> 8;
  const u16* PROJ = (const u16*)(p.ws + OFF_PROJ);
  const float* SMALL = (const float*)(p.ws + OFF_SMALL);
  u16* Ug = (u16*)((unsigned char*)p.out + DO_U);
  u16* Wg = (u16*)((unsigned char*)p.out + DO_W);
  u16* QNg = (u16*)((unsigned char*)p.out + DO_QN);
  u16* KNTg = (u16*)((unsigned char*)p.out + DO_KNT);
  u16* ATTg = (u16*)(p.ws + OFF_ATT);
  float* GCg = (float*)(p.ws + OFF_GC);
  const float* convw = p.in[5];
  const int tid = TIDX, lane = tid & 63, wave = tid >> 6;
  const int c0 = n * 64;
  const size_t tok0 = (size_t)b * SEQ + c0;
  float* Kt = (float*)(smem + DL_KT);
  float* V = (float*)(smem + DL_V);
  unsigned char* Qb = smem + DL_QB;
  unsigned char* Kb = smem + DL_KB;
  float* gc = (float*)(smem + DL_SM);
  float* beta = gc + 64;
  float* ssp = beta + 64;
  unsigned char* RAW = smem + DL_RAW;
  float* AmT = (float*)(smem + DL_RAW);
  __syncthreads();
  {
    u32x4 rg[7];
#pragma unroll
    for (int k = 0; k < 7; ++k) {
      const int ci = tid + 512 * k;
      rg[k] = (u32x4){0u, 0u, 0u, 0u};
      if (ci < 3216) {
        const int arr = ci / 1072, rem = ci - arr * 1072, row = rem >> 4, ch = rem & 15;
        const int trel = c0 - 3 + row;
        if (trel >= 0)
          rg[k] = *(const u32x4*)(PROJ + ((size_t)b * SEQ + trel) * LDP + (C_DQ + arr * 512) + h * 128 + ch * 8);
      }
    }
#pragma unroll
    for (int k = 0; k < 7; ++k) {
      const int ci = tid + 512 * k;
      if (ci < 3216) {
        const int arr = ci / 1072, rem = ci - arr * 1072, row = rem >> 4, ch = rem & 15;
        *(u32x4*)(RAW + (arr * 67 + row) * 272 + ch * 16) = rg[k];
      }
    }
  }
  if (tid < 64) {
    float da = SMALL[(tok0 + tid) * 16 + 8 + h], db = SMALL[(tok0 + tid) * 16 + 12 + h];
    float xx = da + p.in[7][h];
    float sp = fmaxf(xx, 0.f) + log1pf(__expf(-fabsf(xx)));
    float gr = -__expf(p.in[6][h]) * sp;
    float incl = gr;
#pragma unroll
    for (int o = 1; o < 64; o <<= 1) {
      float v = __shfl_up(incl, o);
      if (lane >= o) incl += v;
    }
    gc[tid] = incl;
    beta[tid] = sigmoidf_(db);
    GCg[(tok0 + tid) * 4 + h] = incl;
  }
  __syncthreads();
  {
    const int c = tid & 127, tg = tid >> 7;
    float qv[16], kv[16];
#pragma unroll
    for (int arr = 0; arr < 3; ++arr) {
      const float w0 = convw[0 * 1536 + arr * 512 + h * 128 + c], w1 = convw[1 * 1536 + arr * 512 + h * 128 + c],
                  w2 = convw[2 * 1536 + arr * 512 + h * 128 + c], w3 = convw[3 * 1536 + arr * 512 + h * 128 + c];
      const unsigned char* rp = RAW + (arr * 67 + tg * 16) * 272 + c * 2;
      float x0 = bf2f(*(const u16*)(rp)), x1 = bf2f(*(const u16*)(rp + 272)), x2 = bf2f(*(const u16*)(rp + 2 * 272));
#pragma unroll
      for (int ii = 0; ii < 16; ++ii) {
        const float x3 = bf2f(*(const u16*)(rp + (ii + 3) * 272));
        const float y = w0 * x0 + w1 * x1 + w2 * x2 + w3 * x3;
        const float sv = y * sigmoidf_(y);
        if (arr == 0) qv[ii] = sv;
        else if (arr == 1) kv[ii] = sv;
        else V[(tg * 16 + ii) * 128 + c] = sv;
        x0 = x1; x1 = x2; x2 = x3;
      }
    }
#pragma unroll
    for (int ii = 0; ii < 16; ++ii) {
      const float sq = wave_sum_dpp(qv[ii] * qv[ii]);
      const float sk = wave_sum_dpp(kv[ii] * kv[ii]);
      if (lane == 0) {
        ssp[((tg * 16 + ii) * 2) + (wave & 1)] = sq;
        ssp[128 + ((tg * 16 + ii) * 2) + (wave & 1)] = sk;
      }
    }
    __syncthreads();
#pragma unroll
    for (int ii = 0; ii < 16; ++ii) {
      const int i = tg * 16 + ii;
      const float qsc = rsqrtf(ssp[i * 2] + ssp[i * 2 + 1] + EPS) * 0.08838834764831845f;
      const float ksc = rsqrtf(ssp[128 + i * 2] + ssp[128 + i * 2 + 1] + EPS);
      const float qn = qv[ii] * qsc, kn = kv[ii] * ksc;
      *(u16*)(Qb + i * 272 + c * 2) = f2bf(qn);
      *(u16*)(Kb + i * 272 + c * 2) = f2bf(kn);
      Kt[c * DNP + i] = kn;
    }
  }
  __syncthreads();
#pragma unroll
  for (int k = 0; k < 4; ++k) {
    const int gi = tid + 512 * k;
    {
      const int i = gi >> 5, d4 = (gi & 31) * 4;
      const u32x2 v = *(const u32x2*)(Qb + i * 272 + d4 * 2);
      *(u32x2*)(QNg + (tok0 + i) * 512 + h * 128 + perm32(d4)) = v;
    }
    {
      const int d = gi >> 4, t4 = (gi & 15) * 4;
      const f32x4 v = *(const f32x4*)(Kt + d * DNP + t4);
      u32x2 o = {pack2(v[0], v[1]), pack2(v[2], v[3])};
      *(u32x2*)(KNTg + (size_t)item * 8192 + d * 64 + perm32(t4)) = o;
    }
  }
  {
    const int mat = wave >> 2, it = wave & 3;
    const int fr = lane & 15, fg = lane >> 4;
    const unsigned char* Ab = mat ? Qb : Kb;
    bf16x8 af[4];
#pragma unroll
    for (int kk = 0; kk < 4; ++kk) af[kk] = *(const bf16x8*)(Ab + (it * 16 + fr) * 272 + kk * 64 + fg * 16);
    f32x4 gi4 = *(const f32x4*)(gc + it * 16 + 4 * fg);
    f32x4 bi4 = *(const f32x4*)(beta + it * 16 + 4 * fg);
#pragma unroll
    for (int jt = 0; jt < 4; ++jt) {
      f32x4 acc = {0.f, 0.f, 0.f, 0.f};
      if (jt <= it) {
#pragma unroll
        for (int kk = 0; kk < 4; ++kk) {
          bf16x8 bfg = *(const bf16x8*)(Kb + (jt * 16 + fr) * 272 + kk * 64 + fg * 16);
          acc = __builtin_amdgcn_mfma_f32_16x16x32_bf16(af[kk], bfg, acc, 0, 0, 0);
        }
      }
      const int j = jt * 16 + fr;
      const float gj = gc[j];
#pragma unroll
      for (int r = 0; r < 4; ++r) {
        const int i = it * 16 + 4 * fg + r;
        const float dec = __expf(fminf(gi4[r] - gj, 0.f));
        if (mat == 0) { if (jt <= it) AmT[j * 64 + i] = (i > j) ? bi4[r] * acc[r] * dec : 0.f; }
        else ATTg[(size_t)item * 4096 + i * 64 + perm32(j)] = f2bf((i >= j) ? acc[r] * dec : 0.f);
      }
    }
  }
  __syncthreads();
  u16* nA = (u16*)(smem + DL_RAW + 16384);
  u16* Nb = (u16*)(smem + DL_RAW + 16384 + 64 * 144);
  {
#pragma unroll
    for (int k = 0; k < 8; ++k) {
      const int e = tid + 512 * k;
      const int i = e >> 6, j = e & 63;
      const float v = ((j >> 4) < (i >> 4)) ? -AmT[j * 64 + i] : 0.f;
      nA[i * 72 + j] = f2bf(v);
    }
    if (tid < 64) {
      const int bb = tid >> 4, j = tid & 15;
      float nn[16];
#pragma unroll
      for (int i = 0; i < 16; ++i) {
        float sacc = 0.f;
#pragma unroll
        for (int k = 0; k < i; ++k) sacc += AmT[(bb * 16 + k) * 64 + bb * 16 + i] * nn[k];
        nn[i] = (i == j) ? 1.f : ((i > j) ? -sacc : 0.f);
      }
#pragma unroll
      for (int i = 0; i < 16; ++i) Nb[bb * 256 + i * 16 + j] = f2bf(nn[i]);
    }
  }
  __syncthreads();
  {
    const int fr = lane & 15, fg = lane >> 4;
    f32x4 X[2][4];
#pragma unroll
    for (int ct2 = 0; ct2 < 2; ++ct2) {
      const int c = (wave * 2 + ct2) * 16 + fr;
      const bool isu = c < 128;
      const int cc = c & 127;
#pragma unroll
      for (int bb = 0; bb < 4; ++bb) {
        f32x4 acc;
#pragma unroll
        for (int r = 0; r < 4; ++r) {
          const int i = bb * 16 + 4 * fg + r;
          acc[r] = isu ? V[i * 128 + cc] * beta[i] : Kt[cc * DNP + i] * beta[i] * __expf(gc[i]);
        }
        if (bb >= 1) {
          union { u32 w[4]; bf16x8 v; } af, bf;
          const u32x2 a0 = *(const u32x2*)(nA + (bb * 16 + fr) * 72 + 4 * fg);
          af.w[0] = a0[0]; af.w[1] = a0[1];
          bf.w[0] = pack2(X[ct2][0][0], X[ct2][0][1]); bf.w[1] = pack2(X[ct2][0][2], X[ct2][0][3]);
          if (bb >= 2) {
            const u32x2 a1 = *(const u32x2*)(nA + (bb * 16 + fr) * 72 + 16 + 4 * fg);
            af.w[2] = a1[0]; af.w[3] = a1[1];
            bf.w[2] = pack2(X[ct2][1][0], X[ct2][1][1]); bf.w[3] = pack2(X[ct2][1][2], X[ct2][1][3]);
          } else { af.w[2] = 0u; af.w[3] = 0u; bf.w[2] = 0u; bf.w[3] = 0u; }
          acc = __builtin_amdgcn_mfma_f32_16x16x32_bf16(af.v, bf.v, acc, 0, 0, 0);
          if (bb == 3) {
            const u32x2 a2 = *(const u32x2*)(nA + (bb * 16 + fr) * 72 + 32 + 4 * fg);
            af.w[0] = a2[0]; af.w[1] = a2[1]; af.w[2] = 0u; af.w[3] = 0u;
            bf.w[0] = pack2(X[ct2][2][0], X[ct2][2][1]); bf.w[1] = pack2(X[ct2][2][2], X[ct2][2][3]); bf.w[2] = 0u; bf.w[3] = 0u;
            acc = __builtin_amdgcn_mfma_f32_16x16x32_bf16(af.v, bf.v, acc, 0, 0, 0);
          }
        }
        {
          union { u32 w[4]; bf16x8 v; } af, bf;
          const u32x2 d0 = *(const u32x2*)(Nb + bb * 256 + fr * 16 + 4 * fg);
          af.w[0] = d0[0]; af.w[1] = d0[1]; af.w[2] = 0u; af.w[3] = 0u;
          bf.w[0] = pack2(acc[0], acc[1]); bf.w[1] = pack2(acc[2], acc[3]); bf.w[2] = 0u; bf.w[3] = 0u;
          const f32x4 z4 = {0.f, 0.f, 0.f, 0.f};
          X[ct2][bb] = __builtin_amdgcn_mfma_f32_16x16x32_bf16(af.v, bf.v, z4, 0, 0, 0);
        }
#pragma unroll
        for (int r = 0; r < 4; ++r) {
          const int i = bb * 16 + 4 * fg + r;
          if (isu) Ug[(tok0 + i) * 512 + h * 128 + cc] = f2bf(X[ct2][bb][r]);
          else Wg[(tok0 + i) * 512 + h * 128 + perm32(cc)] = f2bf(X[ct2][bb][r]);
        }
      }
    }
  }
}

__device__ __forceinline__ void phase2(const Params& p, unsigned char* smem) {
#ifndef NO_IDX
  for (int i = blockIdx.x; i < 2048; i += gridDim.x) idx_item(p, smem, i & 7, 255 - (i >> 3));
#endif
#ifndef NO_DNL
  if (!(p.flags & 1))
    for (int i = blockIdx.x; i < 2048; i += gridDim.x) dn_local_item(p, smem, i);
#endif
}

constexpr int SC_WP = 272, SC_KP = 144;
constexpr int SC_W = 0, SC_Q = 64 * SC_WP, SC_KT = 2 * 64 * SC_WP, SC_AT = SC_KT + 128 * SC_KP, SC_U = SC_AT + 64 * SC_KP,
              SC_BUF = SC_U + 64 * SC_WP;
constexpr int SC_GC = 2 * SC_BUF;
static_assert(SC_GC + 2 * 64 * 4 <= SMEM_BYTES, "scan LDS");

__device__ __forceinline__ void dn_scan_item(const Params& p, unsigned char* smem, int bh) {
  const int h = bh & 3, b = bh >> 2;
  const u16* Ug = (const u16*)((const unsigned char*)p.out + DO_U);
  const u16* Wg = (const u16*)((const unsigned char*)p.out + DO_W);
  const u16* QNg = (const u16*)((const unsigned char*)p.out + DO_QN);
  const u16* KNTg = (const u16*)((const unsigned char*)p.out + DO_KNT);
  const u16* ATTg = (const u16*)(p.ws + OFF_ATT);
  const float* GCg = (const float*)(p.ws + OFF_GC);
  const u16* PROJ = (const u16*)(p.ws + OFF_PROJ);
  u16* YDN = (u16*)(p.ws + OFF_YDN);
  const float* ogain = p.in[8];
  const int tid = TIDX, lane = tid & 63, wave = tid >> 6;
  const int fr = lane & 15, fg = lane >> 4;
  const int ecol = wave * 16 + fr;
  float* gcs = (float*)(smem + SC_GC);
  f32x4 S[8];
#pragma unroll
  for (int d = 0; d < 8; ++d) S[d] = (f32x4){0.f, 0.f, 0.f, 0.f};
  u32x4 st[9];
  float gcr = 0.f;
  const int r16 = tid >> 4, c16 = tid & 15;
  const int r8 = tid >> 3, c8 = tid & 7;
#define SCAN_LOAD(n_)                                                                                      \
  {                                                                                                        \
    const size_t tk0 = (size_t)b * SEQ + (size_t)(n_) * 64;                                                \
    const size_t it_ = (size_t)((b * 64 + (n_)) * 4 + h);                                                  \
    st[0] = *(const u32x4*)(Wg + (tk0 + r16) * 512 + h * 128 + c16 * 8);                                   \
    st[1] = *(const u32x4*)(Wg + (tk0 + r16 + 32) * 512 + h * 128 + c16 * 8);                              \
    st[2] = *(const u32x4*)(QNg + (tk0 + r16) * 512 + h * 128 + c16 * 8);                                  \
    st[3] = *(const u32x4*)(QNg + (tk0 + r16 + 32) * 512 + h * 128 + c16 * 8);                             \
    st[4] = *(const u32x4*)(KNTg + it_ * 8192 + (size_t)tid * 8);                                          \
    st[5] = *(const u32x4*)(KNTg + it_ * 8192 + (size_t)(tid + 512) * 8);                                  \
    st[6] = *(const u32x4*)(ATTg + it_ * 4096 + (size_t)tid * 8);                                          \
    st[7] = *(const u32x4*)(Ug + (tk0 + r16) * 512 + h * 128 + c16 * 8);                                   \
    st[8] = *(const u32x4*)(Ug + (tk0 + r16 + 32) * 512 + h * 128 + c16 * 8);                              \
    if (tid < 64) gcr = GCg[(tk0 + tid) * 4 + h];                                                          \
  }
#define SCAN_STORE(buf_)                                                                                   \
  {                                                                                                        \
    unsigned char* bs_ = smem + (buf_) * SC_BUF;                                                           \
    *(u32x4*)(bs_ + SC_W + r16 * SC_WP + c16 * 16) = st[0];                                                \
    *(u32x4*)(bs_ + SC_W + (r16 + 32) * SC_WP + c16 * 16) = st[1];                                         \
    *(u32x4*)(bs_ + SC_Q + r16 * SC_WP + c16 * 16) = st[2];                                                \
    *(u32x4*)(bs_ + SC_Q + (r16 + 32) * SC_WP + c16 * 16) = st[3];                                         \
    *(u32x4*)(bs_ + SC_KT + r8 * SC_KP + c8 * 16) = st[4];                                                 \
    *(u32x4*)(bs_ + SC_KT + (r8 + 64) * SC_KP + c8 * 16) = st[5];                                          \
    *(u32x4*)(bs_ + SC_AT + r8 * SC_KP + c8 * 16) = st[6];                                                 \
    *(u32x4*)(bs_ + SC_U + r16 * SC_WP + c16 * 16) = st[7];                                                \
    *(u32x4*)(bs_ + SC_U + (r16 + 32) * SC_WP + c16 * 16) = st[8];                                         \
    if (tid < 64) gcs[(buf_) * 64 + tid] = gcr;                                                            \
  }
  __syncthreads();
  SCAN_LOAD(0)
  SCAN_STORE(0)
  if (1 < 64) SCAN_LOAD(1)
  __syncthreads();
  for (int n = 0; n < 64; ++n) {
    const int buf = n & 1;
    const size_t tok0 = (size_t)b * SEQ + n * 64;
    if (n + 1 < 64) SCAN_STORE(buf ^ 1)
    if (n + 2 < 64) SCAN_LOAD(n + 2)
    __builtin_amdgcn_sched_barrier(0);
    const unsigned char* base = smem + buf * SC_BUF;
    const u32 ub0 = (u32)(tok0 + 4 * fg) * 512 + (u32)(h * 128 + ecol);
    const float* gcb = gcs + buf * 64 + 4 * fg;
    const float glast = gcs[buf * 64 + 63];
    bf16x8 Sb[4];
#pragma unroll
    for (int kk = 0; kk < 4; ++kk) {
      union { u32 w[4]; bf16x8 v; } cv;
      cv.w[0] = pack2(S[2 * kk][0], S[2 * kk][1]); cv.w[1] = pack2(S[2 * kk][2], S[2 * kk][3]);
      cv.w[2] = pack2(S[2 * kk + 1][0], S[2 * kk + 1][1]); cv.w[3] = pack2(S[2 * kk + 1][2], S[2 * kk + 1][3]);
      Sb[kk] = cv.v;
    }
    f32x4 vnew[4], ov[4];
#pragma unroll
    for (int m = 0; m < 4; ++m) {
      f32x4 aw = {0.f, 0.f, 0.f, 0.f}, aq = {0.f, 0.f, 0.f, 0.f};
#pragma unroll
      for (int kk = 0; kk < 4; ++kk) {
        bf16x8 wf = *(const bf16x8*)(base + SC_W + (m * 16 + fr) * SC_WP + kk * 64 + fg * 16);
        bf16x8 qf = *(const bf16x8*)(base + SC_Q + (m * 16 + fr) * SC_WP + kk * 64 + fg * 16);
        aw = __builtin_amdgcn_mfma_f32_16x16x32_bf16(wf, Sb[kk], aw, 0, 0, 0);
        aq = __builtin_amdgcn_mfma_f32_16x16x32_bf16(qf, Sb[kk], aq, 0, 0, 0);
      }
      f32x4 g4 = *(const f32x4*)(gcb + m * 16);
#pragma unroll
      for (int r = 0; r < 4; ++r) {
        float uv = bf2f(*(const u16*)(base + SC_U + (m * 16 + 4 * fg + r) * SC_WP + ecol * 2));
        vnew[m][r] = uv - aw[r];
        ov[m][r] = aq[r] * __expf(g4[r]);
      }
    }
    bf16x8 vb[2], vsb[2];
#pragma unroll
    for (int k2 = 0; k2 < 2; ++k2) {
      union { u32 w[4]; bf16x8 v; } c1, c2;
      const int ma = 2 * k2, mb = 2 * k2 + 1;
      c1.w[0] = pack2(vnew[ma][0], vnew[ma][1]); c1.w[1] = pack2(vnew[ma][2], vnew[ma][3]);
      c1.w[2] = pack2(vnew[mb][0], vnew[mb][1]); c1.w[3] = pack2(vnew[mb][2], vnew[mb][3]);
      f32x4 ga4 = *(const f32x4*)(gcb + ma * 16), gb4 = *(const f32x4*)(gcb + mb * 16);
      float sa[4], sb2[4];
#pragma unroll
      for (int r = 0; r < 4; ++r) { sa[r] = vnew[ma][r] * __expf(glast - ga4[r]); sb2[r] = vnew[mb][r] * __expf(glast - gb4[r]); }
      c2.w[0] = pack2(sa[0], sa[1]); c2.w[1] = pack2(sa[2], sa[3]);
      c2.w[2] = pack2(sb2[0], sb2[1]); c2.w[3] = pack2(sb2[2], sb2[3]);
      vb[k2] = c1.v; vsb[k2] = c2.v;
    }
    const float egl = __expf(glast);
#pragma unroll
    for (int d = 0; d < 8; ++d) {
      f32x4 a = S[d] * egl;
#pragma unroll
      for (int k2 = 0; k2 < 2; ++k2) {
        bf16x8 kf = *(const bf16x8*)(base + SC_KT + (d * 16 + fr) * SC_KP + k2 * 64 + fg * 16);
        a = __builtin_amdgcn_mfma_f32_16x16x32_bf16(kf, vsb[k2], a, 0, 0, 0);
      }
      S[d] = a;
    }
#pragma unroll
    for (int m = 0; m < 4; ++m) {
      f32x4 ao = ov[m];
#pragma unroll
      for (int k2 = 0; k2 < 2; ++k2) {
        bf16x8 af = *(const bf16x8*)(base + SC_AT + (m * 16 + fr) * SC_KP + k2 * 64 + fg * 16);
        ao = __builtin_amdgcn_mfma_f32_16x16x32_bf16(af, vb[k2], ao, 0, 0, 0);
      }
#pragma unroll
      for (int r = 0; r < 4; ++r) YDN[ub0 + (u32)((m * 16 + r) * 512)] = f2bf(ao[r]);
    }
    __syncthreads();
  }
#undef SCAN_LOAD
#undef SCAN_STORE
  asm volatile("s_waitcnt vmcnt(0)" ::: "memory");
  __syncthreads();
  {
    const int sub = lane >> 4, l16 = lane & 15;
    float gn8[8];
#pragma unroll
    for (int e = 0; e < 8; ++e) gn8[e] = ogain[l16 * 8 + e];
    for (int t = wave * 4 + sub; t < SEQ; t += 32) {
      const size_t tok = (size_t)b * SEQ + t;
      u16* yp = YDN + tok * 512 + h * 128 + l16 * 8;
      const u32x4 ov4 = *(const u32x4*)yp;
      const u32x4 zv4 = *(const u32x4*)(PROJ + tok * LDP + C_DZ + h * 128 + l16 * 8);
      float o8[8], z8[8];
#pragma unroll
      for (int c = 0; c < 4; ++c) { o8[2 * c] = bflo(ov4[c]); o8[2 * c + 1] = bfhi(ov4[c]); z8[2 * c] = bflo(zv4[c]); z8[2 * c + 1] = bfhi(zv4[c]); }
      float sq = 0.f;
#pragma unroll
      for (int e = 0; e < 8; ++e) sq += o8[e] * o8[e];
      sq += DPPF(sq, 0xb1); sq += DPPF(sq, 0x4e); sq += DPPF(sq, 0x141); sq += DPPF(sq, 0x140);
      const float rstd = rsqrtf(sq * (1.f / 128.f) + EPS);
      u32 w[4];
#pragma unroll
      for (int c = 0; c < 4; ++c) {
        const float y0 = o8[2 * c] * rstd * gn8[2 * c] * z8[2 * c] * sigmoidf_(z8[2 * c]);
        const float y1 = o8[2 * c + 1] * rstd * gn8[2 * c + 1] * z8[2 * c + 1] * sigmoidf_(z8[2 * c + 1]);
        w[c] = pack2(y0, y1);
      }
      *(u32x4*)yp = (u32x4){w[0], w[1], w[2], w[3]};
    }
  }
}

constexpr int AT_WAVE_BYTES = 8192 + 512 + 8192;
__device__ __forceinline__ float xor16_sum(float v) {
  auto r = __builtin_amdgcn_permlane16_swap(__float_as_uint(v), __float_as_uint(v), false, false);
  return __uint_as_float(r[0]) + __uint_as_float(r[1]);
}
__device__ __forceinline__ float xor32_sum(float v) {
  auto r = __builtin_amdgcn_permlane32_swap(__float_as_uint(v), __float_as_uint(v), false, false);
  return __uint_as_float(r[0]) + __uint_as_float(r[1]);
}
__device__ __forceinline__ void attn_query(const Params& p, unsigned char* wsm, int b, int t) {
  typedef long i64;
  typedef int i32x2 __attribute__((ext_vector_type(2)));
  typedef __attribute__((address_space(3))) i32x2 lds_i32x2;
  const u16* PROJ = (const u16*)(p.ws + OFF_PROJ);
  const u16* SEL = (const u16*)(p.ws + OFF_SEL);
  const unsigned char* KVC8 = p.ws + OFF_KVC;
  u16* YATT = (u16*)(p.ws + OFF_YATT);
  const int lane = TIDX & 63;
  const int fr = lane & 15, fg = lane >> 4;
  float* P = (float*)wsm;
  u16* sl = (u16*)(wsm + 8192);
  const size_t tokb = (size_t)b * SEQ;
  const size_t tok = tokb + t;
  const int nsel = min(256, t + 1);
  i64 qb[2][2];
  {
    const u16* qrow = PROJ + tok * LDP + C_AQ + (fr & 3) * 64 + fg * 8;
#pragma unroll
    for (int g = 0; g < 2; ++g)
#pragma unroll
      for (int kk = 0; kk < 2; ++kk) {
        const u32x4 v = *(const u32x4*)(qrow + g * 256 + kk * 32);
        const u32 lo = fp8x4(bflo(v[0]) * 16.f, bfhi(v[0]) * 16.f, bflo(v[1]) * 16.f, bfhi(v[1]) * 16.f);
        const u32 hi = fp8x4(bflo(v[2]) * 16.f, bfhi(v[2]) * 16.f, bflo(v[3]) * 16.f, bfhi(v[3]) * 16.f);
        const i64 w = (i64)(((unsigned long long)hi << 32) | (unsigned long long)lo);
        qb[g][kk] = (fr < 4) ? w : (i64)0;
      }
    const u16* sr = SEL + tok * 256;
#pragma unroll
    for (int i = 0; i < 4; ++i) sl[lane + 64 * i] = sr[lane + 64 * i];
  }
  WAVE_LDS_SYNC();
  const int ngrp = (nsel + 15) >> 4;
  const int nbq = (ngrp + 1) >> 1;
  unsigned char* KST = wsm + 8192 + 512;
  const int kq = lane >> 3, kch = lane & 7;
  u32x4 kA[2][2], kB[2][2];
#define QK_LOAD(buf_, bi_)                                                                       \
  _Pragma("unroll") for (int j = 0; j < 2; ++j)                                                  \
    _Pragma("unroll") for (int hf = 0; hf < 2; ++hf) {                                           \
      const int ki_ = min(((bi_) * 2 + j) * 16 + hf * 8 + kq, 255);                              \
      const int s_ = (int)sl[ki_] & 4095;                                                        \
      buf_[j][hf] = *(const u32x4*)(KVC8 + (tokb + s_) * 256 + kch * 16);                        \
    }
#define QK_COMPUTE(buf_, bi_)                                                                    \
  {                                                                                              \
    _Pragma("unroll") for (int j = 0; j < 2; ++j)                                                \
      _Pragma("unroll") for (int hf = 0; hf < 2; ++hf) {                                         \
        const int row_ = hf * 8 + kq;                                                            \
        *(u32x4*)(KST + j * 2048 + row_ * 128 + ((kch ^ (row_ & 7)) << 4)) = buf_[j][hf];        \
      }                                                                                          \
    WAVE_LDS_SYNC();                                                                             \
    _Pragma("unroll") for (int j = 0; j < 2; ++j) {                                              \
      const unsigned char* kr_ = KST + j * 2048 + fr * 128 + 8 * (fg & 1);                       \
      const int sw_ = fr & 7, ch_ = fg >> 1;                                                     \
      const i64 a00_ = *(const i64*)(kr_ + (((0 + ch_) ^ sw_) << 4));                            \
      const i64 a01_ = *(const i64*)(kr_ + (((2 + ch_) ^ sw_) << 4));                            \
      const i64 a10_ = *(const i64*)(kr_ + (((4 + ch_) ^ sw_) << 4));                            \
      const i64 a11_ = *(const i64*)(kr_ + (((6 + ch_) ^ sw_) << 4));                            \
      f32x4 c0_ = {0.f, 0.f, 0.f, 0.f}, c1_ = {0.f, 0.f, 0.f, 0.f};                              \
      c0_ = __builtin_amdgcn_mfma_f32_16x16x32_fp8_fp8(a00_, qb[0][0], c0_, 0, 0, 0);            \
      c0_ = __builtin_amdgcn_mfma_f32_16x16x32_fp8_fp8(a01_, qb[0][1], c0_, 0, 0, 0);            \
      c1_ = __builtin_amdgcn_mfma_f32_16x16x32_fp8_fp8(a10_, qb[1][0], c1_, 0, 0, 0);            \
      c1_ = __builtin_amdgcn_mfma_f32_16x16x32_fp8_fp8(a11_, qb[1][1], c1_, 0, 0, 0);            \
      if (fr < 4) {                                                                              \
        _Pragma("unroll") for (int r = 0; r < 4; ++r) {                                          \
          const int kk2_ = ((bi_) * 2 + j) * 16 + 4 * fg + r;                                    \
          if (kk2_ < 256) {                                                                      \
            const bool v_ = kk2_ < nsel;                                                         \
            P[kk2_ * 8 + fr] = v_ ? c0_[r] * 0.0625f : -1e30f;                                   \
            P[kk2_ * 8 + 4 + fr] = v_ ? c1_[r] * 0.0625f : -1e30f;                               \
          }                                                                                      \
        }                                                                                        \
      }                                                                                          \
    }                                                                                            \
    WAVE_LDS_SYNC();                                                                             \
  }
  QK_LOAD(kA, 0)
  for (int bi = 0; bi < nbq; bi += 2) {
    if (bi + 1 < nbq) { QK_LOAD(kB, bi + 1) }
    QK_COMPUTE(kA, bi)
    if (bi + 2 < nbq) { QK_LOAD(kA, bi + 2) }
    if (bi + 1 < nbq) { QK_COMPUTE(kB, bi + 1) }
  }
#undef QK_LOAD
#undef QK_COMPUTE
  for (int ki = nbq * 32 + lane; ki < 256; ki += 64) {
    *(f32x4*)(P + ki * 8) = (f32x4){-1e30f, -1e30f, -1e30f, -1e30f};
    *(f32x4*)(P + ki * 8 + 4) = (f32x4){-1e30f, -1e30f, -1e30f, -1e30f};
  }
  WAVE_LDS_SYNC();
  float inv8[8];
  {
    float lg[4][8];
#pragma unroll
    for (int i = 0; i < 4; ++i) {
      f32x4 x0 = *(const f32x4*)(P + (lane + 64 * i) * 8), x1 = *(const f32x4*)(P + (lane + 64 * i) * 8 + 4);
      lg[i][0] = x0[0]; lg[i][1] = x0[1]; lg[i][2] = x0[2]; lg[i][3] = x0[3];
      lg[i][4] = x1[0]; lg[i][5] = x1[1]; lg[i][6] = x1[2]; lg[i][7] = x1[3];
    }
    WAVE_LDS_SYNC();
    unsigned char* PT8 = (unsigned char*)P;
#pragma unroll
    for (int hh = 0; hh < 8; ++hh) {
      float m = fmaxf(fmaxf(lg[0][hh], lg[1][hh]), fmaxf(lg[2][hh], lg[3][hh]));
      m = wave_max_dpp(m);
      float e[4], sum = 0.f;
#pragma unroll
      for (int i = 0; i < 4; ++i) { e[i] = __expf(lg[i][hh] - m); sum += e[i]; }
      sum = wave_sum_dpp(sum);
      inv8[hh] = __builtin_amdgcn_rcpf(sum) * (1.f / 256.f);
      const u32 w = fp8x4(e[0] * 256.f, e[1] * 256.f, e[2] * 256.f, e[3] * 256.f);
#pragma unroll
      for (int i = 0; i < 4; ++i) PT8[hh * 256 + lane + 64 * i] = (unsigned char)((w >> (8 * i)) & 0xffu);
    }
  }
  WAVE_LDS_SYNC();
  {
    const unsigned char* PT8 = (const unsigned char*)P;
    unsigned char* VST = wsm + 8192 + 512;
    const int trow = (lane & 15) >> 1, thalf = lane & 1;
    f32x4 oacc[2][4];
#pragma unroll
    for (int g = 0; g < 2; ++g)
#pragma unroll
      for (int c = 0; c < 4; ++c) oacc[g][c] = (f32x4){0.f, 0.f, 0.f, 0.f};
    const int nks = (nsel + 31) >> 5;
    u32x4 vA[4], vB[4];
#define PV_LOAD(buf_, ks_)                                                                       \
  _Pragma("unroll") for (int i = 0; i < 4; ++i) {                                                \
    const int ki_ = min((ks_) * 32 + i * 8 + kq, 255);                                           \
    const int s_ = (int)sl[ki_] & 4095;                                                          \
    buf_[i] = *(const u32x4*)(KVC8 + (tokb + s_) * 256 + 128 + kch * 16);                        \
  }
#define PV_COMPUTE(buf_, ks_)                                                                    \
  {                                                                                              \
    _Pragma("unroll") for (int i = 0; i < 4; ++i) {                                              \
      const int key_ = i * 8 + kq;                                                               \
      *(u32x4*)(VST + key_ * 128 + ((kch ^ (key_ & 7)) << 4)) = buf_[i];                         \
    }                                                                                            \
    WAVE_LDS_SYNC();                                                                             \
    i64 pa_[2];                                                                                  \
    _Pragma("unroll") for (int g = 0; g < 2; ++g) {                                              \
      const i64 t_ = *(const i64*)(PT8 + (g * 4 + (fr & 3)) * 256 + (ks_) * 32 + 8 * fg);        \
      pa_[g] = (fr < 4) ? t_ : (i64)0;                                                           \
    }                                                                                            \
    const int r1_ = 8 * fg + trow;                                                               \
    _Pragma("unroll") for (int g = 0; g < 2; ++g)                                                \
      _Pragma("unroll") for (int c = 0; c < 4; ++c) {                                            \
        const i32x2 tv_ = __builtin_amdgcn_ds_read_tr8_b64_v2i32((lds_i32x2*)(VST + r1_ * 128 + (((g * 4 + c) ^ (r1_ & 7)) << 4) + 8 * thalf)); \
        const i64 vb_ = (i64)(((unsigned long long)(u32)tv_[1] << 32) | (unsigned long long)(u32)tv_[0]); \
        oacc[g][c] = __builtin_amdgcn_mfma_f32_16x16x32_fp8_fp8(pa_[g], vb_, oacc[g][c], 0, 0, 0); \
      }                                                                                          \
    WAVE_LDS_SYNC();                                                                             \
  }
    PV_LOAD(vA, 0)
    for (int ks = 0; ks < nks; ks += 2) {
      if (ks + 1 < nks) { PV_LOAD(vB, ks + 1) }
      PV_COMPUTE(vA, ks)
      if (ks + 2 < nks) { PV_LOAD(vA, ks + 2) }
      if (ks + 1 < nks) { PV_COMPUTE(vB, ks + 1) }
    }
#undef PV_LOAD
#undef PV_COMPUTE
    if (lane < 16) {
#pragma unroll
      for (int g = 0; g < 2; ++g)
#pragma unroll
        for (int c = 0; c < 4; ++c)
#pragma unroll
          for (int r = 0; r < 4; ++r)
            YATT[tok * 512 + (g * 4 + r) * 64 + 16 * c + fr] = f2bf(oacc[g][c][r] * inv8[g * 4 + r]);
    }
  }
  WAVE_LDS_SYNC();
}

__device__ __forceinline__ void phase3(const Params& p, unsigned char* smem) {
  const int wave = TIDX >> 6;
#ifndef NO_SCAN
  if (blockIdx.x < 32) {
    if (!(p.flags & 2)) dn_scan_item(p, smem, blockIdx.x);
    __syncthreads();
  }
#endif
#ifdef NO_ATTN
  return;
#endif
  if (p.flags & 4) return;
  unsigned* qctr = (unsigned*)(p.ws + 1024 + ((p.flags & 128) ? 4096 : 0));
  const unsigned xcc = (unsigned)__builtin_amdgcn_s_getreg((3 << 11) | 20) & 7u;
  unsigned char* wsm = smem + wave * AT_WAVE_BYTES;
  for (unsigned db = 0; db < 8; ++db) {
    const int bb = (int)((xcc + db) & 7u);
    for (;;) {
      unsigned qi = 0;
      if ((TIDX & 63) == 0) qi = __hip_atomic_fetch_add(qctr + bb * 16, 1u, __ATOMIC_RELAXED, __HIP_MEMORY_SCOPE_AGENT);
      qi = (unsigned)__builtin_amdgcn_readfirstlane((int)qi);
      if (qi >= (unsigned)SEQ) break;
      attn_query(p, wsm, bb, SEQ - 1 - (int)qi);
    }
  }
}

__device__ __forceinline__ void hblk_load(unsigned char* reg, const u16* __restrict__ src, u32 ob, u32 ld, int lane) {
  const int c16 = lane & 7, r8 = lane >> 3;
#pragma unroll
  for (int it = 0; it < 8; ++it) {
    const int rl = it * 8 + r8;
    const u32x4 v = *(const u32x4*)(src + ob + (u32)rl * ld + (u32)(c16 * 8));
    *(u32x4*)(reg + rl * 128 + (((c16 + 2 * ((rl >> 2) & 3)) & 7) << 4)) = v;
    if ((it & 3) == 3) __builtin_amdgcn_sched_barrier(0);
  }
}
__device__ __forceinline__ void hblk_store(const unsigned char* reg, u16* __restrict__ dst, u32 ob, u32 ld, int lane) {
  const int c16 = lane & 7, r8 = lane >> 3;
#pragma unroll
  for (int it = 0; it < 8; ++it) {
    const int rl = it * 8 + r8;
    const u32x4 v = *(const u32x4*)(reg + rl * 128 + (((c16 + 2 * ((rl >> 2) & 3)) & 7) << 4));
    *(u32x4*)(dst + ob + (u32)rl * ld + (u32)(c16 * 8)) = v;
  }
}
__device__ __forceinline__ void phase4(const Params& p, unsigned char* smem) {
  const u16* YATT = (const u16*)(p.ws + OFF_YATT);
  const u16* YDN = (const u16*)(p.ws + OFF_YDN);
  const u16* WTA = (const u16*)(p.ws + OFF_WTA);
  const u16* WTB = (const u16*)(p.ws + OFF_WTB);
  const u16* PROJ = (const u16*)(p.ws + OFF_PROJ);
  u16* MG = (u16*)(p.ws + OFF_MERGED);
  const int ntn = DM / 256, ntiles = (MTOK / 256) * ntn;
  for (int t = blockIdx.x; t < ntiles; t += gridDim.x) {
    const int m0 = (t / ntn) * 256, n0 = (t % ntn) * 256;
    f32x4 acc[2][2][4][2];
#pragma unroll
    for (int pass = 0; pass < 2; ++pass) {
      gemm8_tile(pass ? YDN : YATT, pass ? WTB : WTA, 512, m0, n0, smem, acc);
      int lane = TIDX & 63;
      asm volatile("" : "+v"(lane));
      const int wave = TIDX >> 6, wr = wave >> 2, wc = wave & 3, fr = lane & 15, fq = lane >> 4;
      unsigned char* regG = smem + wave * 16384;
      unsigned char* regT = regG + 8192;
      const int lrot = (fr >> 3) + 2 * fq;
      int off4[4];
#pragma unroll
      for (int jj = 0; jj < 4; ++jj) off4[jj] = (4 * fq) * 128 + (fr & 7) * 2 + (((jj * 2 + lrot) & 7) << 4);
#pragma unroll
      for (int ai = 0; ai < 2; ++ai) {
        const u32 gb0 = (u32)(m0 + ai * 128 + wr * 64) * LDP + (u32)(n0 + wc * 64) + (u32)(pass ? C_GB : C_GA);
        const u32 ob0 = (u32)(m0 + ai * 128 + wr * 64) * DM + (u32)(n0 + wc * 64);
        hblk_load(regG, PROJ, gb0, LDP, lane);
        if (pass == 1) hblk_load(regT, MG, ob0, DM, lane);
        WAVE_LDS_SYNC();
#pragma unroll
        for (int m = 0; m < 4; ++m)
#pragma unroll
          for (int r = 0; r < 4; ++r)
#pragma unroll
            for (int bj = 0; bj < 2; ++bj)
#pragma unroll
              for (int n = 0; n < 2; ++n) {
                const int o = off4[bj * 2 + n] + (m * 16 + r) * 128;
                float v = sigmoidf_(bf2f(*(const u16*)(regG + o))) * acc[ai][bj][m][n][r];
                if (pass == 1) v += bf2f(*(const u16*)(regT + o));
                *(u16*)(regT + o) = f2bf(v);
              }
        WAVE_LDS_SYNC();
        hblk_store(regT, MG, ob0, DM, lane);
        WAVE_LDS_SYNC();
      }
      asm volatile("s_waitcnt vmcnt(0)" ::: "memory");
    }
  }
}

__device__ __forceinline__ void phase5(const Params& p, unsigned char* smem) {
  const u16* MG = (const u16*)(p.ws + OFF_MERGED);
  const u16* WTO = (const u16*)(p.ws + OFF_WTO);
  const float* x = p.in[0];
  const int ntn = DM / 256, ntiles = (MTOK / 256) * ntn;
  for (int t = blockIdx.x; t < ntiles; t += gridDim.x) {
    const int m0 = (t / ntn) * 256, n0 = (t % ntn) * 256;
    f32x4 acc[2][2][4][2];
    gemm8_tile(MG, WTO, DM, m0, n0, smem, acc);
    const int tid_e = TIDX, lane = tid_e & 63, wave = tid_e >> 6;
    const int wr = wave >> 2, wc = wave & 3, fr = lane & 15, fq = lane >> 4;
    unsigned char* reg = smem + wave * 16384;
    const int c16 = lane & 15, r4 = lane >> 4;
    float* outp = p.out;
#pragma unroll
    for (int ai = 0; ai < 2; ++ai) {
#pragma unroll
      for (int m = 0; m < 4; ++m)
#pragma unroll
        for (int r = 0; r < 4; ++r)
#pragma unroll
          for (int bj = 0; bj < 2; ++bj)
#pragma unroll
            for (int n = 0; n < 2; ++n) {
              const int col = (bj * 2 + n) * 16 + fr, row = m * 16 + 4 * fq + r;
              *(float*)(reg + row * 256 + ((((col >> 2) + 4 * fq) & 15) << 4) + (col & 3) * 4) = acc[ai][bj][m][n][r];
            }
      WAVE_LDS_SYNC();
      const u32 ob = (u32)(m0 + ai * 128 + wr * 64) * DM + (u32)(n0 + wc * 64 + c16 * 4);
#pragma unroll
      for (int i4 = 0; i4 < 4; ++i4) {
        f32x4 xv[4];
#pragma unroll
        for (int k = 0; k < 4; ++k) xv[k] = *(const f32x4*)(x + ob + (u32)(((i4 * 4 + k) * 4 + r4) * DM));
#pragma unroll
        for (int k = 0; k < 4; ++k) {
          const int rw = (i4 * 4 + k) * 4 + r4;
          const f32x4 v = *(const f32x4*)(reg + rw * 256 + (((c16 + 4 * ((rw >> 2) & 3)) & 15) << 4));
          *(f32x4*)(outp + ob + (u32)(rw * DM)) = xv[k] + v;
        }
        __builtin_amdgcn_sched_barrier(0);
      }
      WAVE_LDS_SYNC();
    }
  }
}

__device__ __forceinline__ void phase6(const Params& p, unsigned char* smem) {
  const u16* H2 = (const u16*)(p.ws + OFF_H2);
  const u16* WTQ = (const u16*)(p.ws + OFF_WTQ);
  u16* QP = (u16*)(p.ws + OFF_QP);
  const int ntn = 2048 / 256, ntiles = (MTOK / 256) * ntn;
  for (int t = blockIdx.x; t < ntiles; t += gridDim.x) {
    const int m0 = (t / ntn) * 256, n0 = (t % ntn) * 256;
    f32x4 acc[2][2][4][2];
    gemm8_tile(H2, WTQ, DM, m0, n0, smem, acc);
    const int tid_e = TIDX, lane = tid_e & 63, wave = tid_e >> 6;
    const int wr = wave >> 2, wc = wave & 3;
    ep_store<2048, false>(QP, (u32)(m0 + wr * 64) * 2048 + (u32)(n0 + wc * 64), acc, nullptr, 1.f, smem, wave, lane);
  }
}

__device__ __forceinline__ int mono_key(float v) { int b = __float_as_int(v); return b ^ ((b >> 31) & 0x7fffffff); }
__device__ __forceinline__ float unmono_key(int k) { return __int_as_float(k ^ ((k >> 31) & 0x7fffffff)); }
__device__ __forceinline__ void chain16(int (&k)[16], int x) {
#pragma unroll
  for (int j = 0; j < 16; ++j) { int hi = max(k[j], x); x = min(k[j], x); k[j] = hi; }
}

#define CE_DESC(a, b) { const int hi_ = max(a, b), lo_ = min(a, b); a = hi_; b = lo_; }
__device__ __forceinline__ void sort16_desc(int (&k)[16]) {
#pragma unroll
  for (int size = 2; size <= 16; size <<= 1) {
#pragma unroll
    for (int stride = size >> 1; stride > 0; stride >>= 1) {
#pragma unroll
      for (int i = 0; i < 16; ++i) {
        const int l = i ^ stride;
        if (l > i) {
          if ((i & size) == 0) CE_DESC(k[i], k[l]) else CE_DESC(k[l], k[i])
        }
      }
    }
  }
}
__device__ __forceinline__ void merge_top16(int (&a)[16], const int (&b)[16]) {
#pragma unroll
  for (int i = 0; i < 16; ++i) a[i] = max(a[i], b[15 - i]);
#pragma unroll
  for (int stride = 8; stride > 0; stride >>= 1) {
#pragma unroll
    for (int i = 0; i < 16; ++i) {
      const int l = i ^ stride;
      if (l > i) CE_DESC(a[i], a[l])
    }
  }
}

constexpr int P7_LD = 132;
__device__ __forceinline__ void phase7(const Params& p, unsigned char* smem) {
  const u16* QP = (const u16*)(p.ws + OFF_QP);
  const u16* SKB = (const u16*)(p.ws + OFF_SKB);
  float* TOPS = (float*)(p.ws + OFF_TOPS);
  u8* TOPI = (u8*)(p.ws + OFF_TOPI);
  const int tid = TIDX, lane = tid & 63, wave = tid >> 6;
  const int wm = wave >> 1, wn = wave & 1, fr = lane & 15, fg = lane >> 4;
  const int ntiles = (MTOK / G_BM) * 16;
  float* tile = (float*)smem;
  for (int t = blockIdx.x; t < ntiles; t += gridDim.x) {
    const int m0 = (t >> 4) * G_BM, hp = t & 15;
    f32x4 acc[4][4];
    gemm_mainloop(QP + hp * 128, 2048, SKB + (size_t)hp * 128 * 128, 128, 128, m0, 0, smem, acc);
#pragma unroll
    for (int i = 0; i < 4; ++i)
#pragma unroll
      for (int j = 0; j < 4; ++j)
#pragma unroll
        for (int r = 0; r < 4; ++r) {
          int row = wm * 64 + i * 16 + 4 * fg + r, col = wn * 64 + j * 16 + fr;
          tile[row * P7_LD + col] = acc[i][j][r];
        }
    __syncthreads();
    {
      const int row = tid >> 1, half = tid & 1;
      int k[16];
      const float* rowp = tile + row * P7_LD + half * 64;
#pragma unroll
      for (int grp = 0; grp < 4; ++grp) {
        int gk[16];
#pragma unroll
        for (int c = 0; c < 16; c += 4) {
          f32x4 v = *(const f32x4*)(rowp + grp * 16 + c);
          const int ib = 127 - (half * 64 + grp * 16 + c);
          gk[c] = (mono_key(v[0]) & ~127) | ib;
          gk[c + 1] = (mono_key(v[1]) & ~127) | (ib - 1);
          gk[c + 2] = (mono_key(v[2]) & ~127) | (ib - 2);
          gk[c + 3] = (mono_key(v[3]) & ~127) | (ib - 3);
        }
        sort16_desc(gk);
        if (grp == 0) {
#pragma unroll
          for (int j = 0; j < 16; ++j) k[j] = gk[j];
        } else merge_top16(k, gk);
      }
      {
        int other[16];
#pragma unroll
        for (int j = 0; j < 16; ++j) other[j] = DPPI(k[j], 0xb1);
        merge_top16(k, other);
      }
      if (half == 0) {
        size_t o = ((size_t)(m0 + row) * 16 + hp) * 16;
        float vals[16]; int idx[16];
#pragma unroll
        for (int j = 0; j < 16; ++j) { idx[j] = 127 - (k[j] & 127); vals[j] = tile[row * P7_LD + idx[j]]; }
#pragma unroll
        for (int j = 0; j < 16; j += 4) *(f32x4*)(TOPS + o + j) = (f32x4){vals[j], vals[j + 1], vals[j + 2], vals[j + 3]};
#pragma unroll
        for (int j = 0; j < 16; j += 4)
          *(u32*)(TOPI + o + j) = (u32)idx[j] | ((u32)idx[j + 1] << 8) | ((u32)idx[j + 2] << 16) | ((u32)idx[j + 3] << 24);
      }
    }
    __syncthreads();
  }
}

__device__ __forceinline__ void phase7b(const Params& p) {
  const float* TOPS = (const float*)(p.ws + OFF_TOPS);
  const u8* TOPI = (const u8*)(p.ws + OFF_TOPI);
  int* EXPERT = (int*)(p.ws + OFF_EXPERT);
  float* GATE = (float*)(p.ws + OFF_GATE);
  for (int w = blockIdx.x * NTHREADS + TIDX; w < MTOK * 8; w += gridDim.x * NTHREADS) {
    const size_t o = (size_t)w * 32;
    float sa[16], sb[16];
#pragma unroll
    for (int k = 0; k < 16; k += 4) {
      float4 v = *(const float4*)(TOPS + o + k); sa[k] = v.x; sa[k + 1] = v.y; sa[k + 2] = v.z; sa[k + 3] = v.w;
      float4 u = *(const float4*)(TOPS + o + 16 + k); sb[k] = u.x; sb[k + 1] = u.y; sb[k + 2] = u.z; sb[k + 3] = u.w;
    }
    int cand[64];
#pragma unroll
    for (int k = 0; k < 64; ++k) cand[k] = (int)0x80000000;
    {
      int cnt = 0;
#pragma unroll
      for (int a = 0; a < 16; ++a)
#pragma unroll
        for (int bb = 0; bb < 16; ++bb)
          if ((a + 1) * (bb + 1) <= 16) { cand[cnt] = (mono_key(sa[a] + sb[bb]) & ~255) | (255 - (a * 16 + bb)); ++cnt; }
    }
    int kk[16];
#pragma unroll
    for (int grp = 0; grp < 4; ++grp) {
      int gk[16];
#pragma unroll
      for (int j = 0; j < 16; ++j) gk[j] = cand[grp * 16 + j];
      sort16_desc(gk);
      if (grp == 0) {
#pragma unroll
        for (int j = 0; j < 16; ++j) kk[j] = gk[j];
      } else merge_top16(kk, gk);
    }
    float vals[16];
#pragma unroll
    for (int k = 0; k < 16; ++k) vals[k] = unmono_key(kk[k] & ~255);
    float m = vals[0], s = 0.f, e[16];
#pragma unroll
    for (int k = 0; k < 16; ++k) { e[k] = __expf(vals[k] - m); s += e[k]; }
    float inv = 1.f / s;
    const u32x4 ia = *(const u32x4*)(TOPI + o), ib = *(const u32x4*)(TOPI + o + 16);
    int exv[16];
#pragma unroll
    for (int k = 0; k < 16; ++k) {
      const int ci = 255 - (kk[k] & 255);
      const int a = ci >> 4, bb = ci & 15;
      const u32 wa = (a < 8) ? ((a < 4) ? ia[0] : ia[1]) : ((a < 12) ? ia[2] : ia[3]);
      const u32 wb = (bb < 8) ? ((bb < 4) ? ib[0] : ib[1]) : ((bb < 12) ? ib[2] : ib[3]);
      exv[k] = (int)((wa >> ((a & 3) * 8)) & 255u) * 128 + (int)((wb >> ((bb & 3) * 8)) & 255u);
    }
#pragma unroll
    for (int k = 0; k < 16; k += 4) {
      *(u32x4*)(EXPERT + (size_t)w * 16 + k) = (u32x4){(u32)exv[k], (u32)exv[k + 1], (u32)exv[k + 2], (u32)exv[k + 3]};
      *(f32x4*)(GATE + (size_t)w * 16 + k) = (f32x4){e[k] * inv, e[k + 1] * inv, e[k + 2] * inv, e[k + 3] * inv};
    }
  }
  {
    const int lane = TIDX & 63, wave = TIDX >> 6;
    for (int row = blockIdx.x * 8 + wave; row < 2 * 16384; row += gridDim.x * 8) {
      const int tbl = row >> 14, r = row & 16383;
      const f32x4* src = (const f32x4*)((tbl ? p.in[16] : p.in[15]) + (size_t)r * DM) + lane;
      f32x4 x[4];
      float amax = 0.f;
#pragma unroll
      for (int i = 0; i < 4; ++i) {
        x[i] = src[64 * i];
        amax = fmaxf(amax, fmaxf(fmaxf(fabsf(x[i][0]), fabsf(x[i][1])), fmaxf(fabsf(x[i][2]), fabsf(x[i][3]))));
      }
      amax = wave_max_dpp(amax);
      const float inv = amax > 0.f ? 127.f / amax : 0.f;
      const int bias = 0;
      u32x4 o;
#pragma unroll
      for (int i = 0; i < 4; ++i) {
        int q0 = (int)rintf(x[i][0] * inv) + bias, q1 = (int)rintf(x[i][1] * inv) + bias;
        int q2 = (int)rintf(x[i][2] * inv) + bias, q3 = (int)rintf(x[i][3] * inv) + bias;
        o[i] = (u32)(q0 & 0xff) | ((u32)(q1 & 0xff) << 8) | ((u32)(q2 & 0xff) << 16) | ((u32)(q3 & 0xff) << 24);
      }
#pragma unroll
      for (int i = 0; i < 4; ++i)
        *(u32*)(p.ws + (tbl ? OFF_VQ : OFF_UQ) + ((size_t)(2 * i + (lane >> 5)) * 16384 + r) * 128 + (lane & 31) * 4) = o[i];
      if (lane == 0) ((float*)(p.ws + (tbl ? OFF_VS : OFF_US)))[r] = amax * (1.f / 127.f);
    }
  }
}

__device__ __forceinline__ void phase8a(const Params& p) {
  const int* EXPERT = (const int*)(p.ws + OFF_EXPERT);
  const unsigned char* UQS = p.ws + OFF_UQ;
  const unsigned char* H2Q = p.ws + OFF_H2Q;
  int* PD = (int*)(p.ws + OFF_PD);
  unsigned* ctr = (unsigned*)(p.ws + 2048 + ((p.flags & 128) ? 4096 : 0));
  const unsigned xcc = (unsigned)__builtin_amdgcn_s_getreg((3 << 11) | 20) & 7u;
  const int lane = TIDX & 63, g8 = lane >> 3, l8 = lane & 7;
  for (unsigned db = 0; db < 8; ++db) {
    const int x = (int)((xcc + db) & 7u);
    for (;;) {
      unsigned ci = 0;
      if (lane == 0) ci = __hip_atomic_fetch_add(ctr + x * 16, 1u, __ATOMIC_RELAXED, __HIP_MEMORY_SCOPE_AGENT);
      ci = (unsigned)__builtin_amdgcn_readfirstlane((int)ci);
      if (ci >= (unsigned)(MTOK / 16)) break;
#pragma unroll 1
      for (int tt = 0; tt < 16; ++tt) {
        const int tok = (int)ci * 16 + tt;
        const int e0 = EXPERT[(size_t)tok * 128 + lane], e1 = EXPERT[(size_t)tok * 128 + 64 + lane];
        const u32x4 hq = *(const u32x4*)(H2Q + (size_t)tok * DM + x * 128 + l8 * 16);
        u32x4 ua[16];
#pragma unroll
        for (int i = 0; i < 16; ++i) {
          const int k = i * 8 + g8;
          const int ek = __shfl(i < 8 ? e0 : e1, k & 63);
          ua[i] = *(const u32x4*)(UQS + ((size_t)(x * 16384 + ek)) * 128 + l8 * 16);
        }
        int keep0 = 0, keep1 = 0;
#pragma unroll
        for (int i = 0; i < 16; ++i) {
          int sd = 0;
#pragma unroll
          for (int c = 0; c < 4; ++c) sd = __builtin_amdgcn_sdot4((int)ua[i][c], (int)hq[c], sd, false);
          sd += DPPI(sd, 0xb1); sd += DPPI(sd, 0x4e); sd += DPPI(sd, 0x141);
          if (i < 8) keep0 = (l8 == (i & 7)) ? sd : keep0; else keep1 = (l8 == (i & 7)) ? sd : keep1;
        }
        int* pd = PD + ((size_t)x * MTOK + tok) * 128 + l8 * 8 + g8;
        pd[0] = keep0; pd[64] = keep1;
      }
    }
  }
}

__device__ __forceinline__ void phase8c(const Params& p) {
  const int* EXPERT = (const int*)(p.ws + OFF_EXPERT);
  const float* GATE = (const float*)(p.ws + OFF_GATE);
  const float* US = (const float*)(p.ws + OFF_US);
  const float* VS = (const float*)(p.ws + OFF_VS);
  const float* HS = (const float*)(p.ws + OFF_HS);
  const int* PD = (const int*)(p.ws + OFF_PD);
  unsigned char* CQ8 = p.ws + OFF_CQ8;
  float* QSC = (float*)(p.ws + OFF_QSC);
  const int lane = TIDX & 63, wave = TIDX >> 6;
  for (int tok = blockIdx.x * 8 + wave; tok < MTOK; tok += gridDim.x * 8) {
    const int e0 = EXPERT[(size_t)tok * 128 + lane], e1 = EXPERT[(size_t)tok * 128 + 64 + lane];
    const float g0 = GATE[(size_t)tok * 128 + lane], g1 = GATE[(size_t)tok * 128 + 64 + lane];
    int s0 = 0, s1 = 0;
#pragma unroll
    for (int xx = 0; xx < 8; ++xx) {
      s0 += PD[((size_t)xx * MTOK + tok) * 128 + lane];
      s1 += PD[((size_t)xx * MTOK + tok) * 128 + 64 + lane];
    }
    const float hs = HS[tok];
    const float d0 = (float)s0 * US[e0] * hs, d1 = (float)s1 * US[e1] * hs;
    const float cf0 = g0 * 0.5f * d0 * (1.f + erff(d0 * 0.70710678118654752f)) * VS[e0];
    const float cf1 = g1 * 0.5f * d1 * (1.f + erff(d1 * 0.70710678118654752f)) * VS[e1];
    const float cmax = wave_max_dpp(fmaxf(fabsf(cf0), fabsf(cf1)));
    const float qinv = cmax > 0.f ? 32639.f / cmax : 0.f;
    const int c0 = (int)rintf(cf0 * qinv), c1 = (int)rintf(cf1 * qinv);
    const int h0 = (c0 + 128) >> 8, h1 = (c1 + 128) >> 8;
    unsigned char* cq = CQ8 + (size_t)tok * 256;
    cq[lane] = (unsigned char)(h0 & 0xff); cq[64 + lane] = (unsigned char)(h1 & 0xff);
    cq[128 + lane] = (unsigned char)((c0 - 256 * h0) & 0xff); cq[192 + lane] = (unsigned char)((c1 - 256 * h1) & 0xff);
    if (lane == 0) QSC[tok] = cmax * (1.f / 32639.f);
  }
}

#ifndef TR8_VARIANT
#define TR8_VARIANT 0
#endif
__device__ __forceinline__ void phase8b(const Params& p, unsigned char* smem) {
  typedef int i32x4 __attribute__((ext_vector_type(4)));
  typedef int i32x2 __attribute__((ext_vector_type(2)));
  typedef __attribute__((address_space(3))) i32x2 lds_i32x2;
  const int* EXPERT = (const int*)(p.ws + OFF_EXPERT);
  const unsigned char* VQS = p.ws + OFF_VQ;
  const unsigned char* CQ8 = p.ws + OFF_CQ8;
  const float* QSC = (const float*)(p.ws + OFF_QSC);
  unsigned* ctr = (unsigned*)(p.ws + 3072 + ((p.flags & 128) ? 4096 : 0));
  const unsigned xcc = (unsigned)__builtin_amdgcn_s_getreg((3 << 11) | 20) & 7u;
  const int lane = TIDX & 63, wave = TIDX >> 6, g8 = lane >> 3, l8 = lane & 7;
  const int fr = lane & 15, fg = lane >> 4;
  unsigned char* VST = smem + wave * 16384;
#if TR8_VARIANT == 0
  const int trow = (lane & 15) >> 1, thalf = lane & 1;
#else
  const int trow = lane & 7, thalf = (lane & 15) >> 3;
#endif
  __syncthreads();
  for (unsigned db = 0; db < 8; ++db) {
    const int x = (int)((xcc + db) & 7u);
    for (;;) {
      unsigned ci = 0;
      if (lane == 0) ci = __hip_atomic_fetch_add(ctr + x * 16, 1u, __ATOMIC_RELAXED, __HIP_MEMORY_SCOPE_AGENT);
      ci = (unsigned)__builtin_amdgcn_readfirstlane((int)ci);
      if (ci >= (unsigned)(MTOK / 16)) break;
#pragma unroll 1
      for (int tt = 0; tt < 16; ++tt) {
        const int tok = (int)ci * 16 + tt;
        const int e0 = EXPERT[(size_t)tok * 128 + lane], e1 = EXPERT[(size_t)tok * 128 + 64 + lane];
        u32x4 va[16];
#pragma unroll
        for (int i = 0; i < 16; ++i) {
          const int k = i * 8 + g8;
          const int ek = __shfl(i < 8 ? e0 : e1, k & 63);
          va[i] = *(const u32x4*)(VQS + ((size_t)(x * 16384 + ek)) * 128 + l8 * 16);
        }
        i32x4 af[2];
#pragma unroll
        for (int sx = 0; sx < 2; ++sx) {
          af[sx] = *(const i32x4*)(CQ8 + (size_t)tok * 256 + (fr & 1) * 128 + sx * 64 + fg * 16);
          if (fr >= 2) af[sx] = (i32x4){0, 0, 0, 0};
        }
        const float qsc = QSC[tok];
#pragma unroll
        for (int i = 0; i < 16; ++i) {
          const int k = i * 8 + g8;
          *(u32x4*)(VST + k * 128 + ((l8 ^ g8) << 4)) = va[i];
        }
        WAVE_LDS_SYNC();
        i32x4 acc[8];
#pragma unroll
        for (int c = 0; c < 8; ++c) acc[c] = (i32x4){0, 0, 0, 0};
#pragma unroll
        for (int sx = 0; sx < 2; ++sx) {
          const int r1 = sx * 64 + fg * 16 + trow, r2 = r1 + 8;
#pragma unroll
          for (int c = 0; c < 8; ++c) {
            const i32x2 lo = __builtin_amdgcn_ds_read_tr8_b64_v2i32((lds_i32x2*)(VST + r1 * 128 + ((c ^ (r1 & 7)) << 4) + 8 * thalf));
            const i32x2 hi = __builtin_amdgcn_ds_read_tr8_b64_v2i32((lds_i32x2*)(VST + r2 * 128 + ((c ^ (r2 & 7)) << 4) + 8 * thalf));
            const i32x4 bf = {lo[0], lo[1], hi[0], hi[1]};
            acc[c] = __builtin_amdgcn_mfma_i32_16x16x64_i8(af[sx], bf, acc[c], 0, 0, 0);
          }
        }
        WAVE_LDS_SYNC();
        if (lane < 16 && !(p.flags & 32)) {
          float* op = p.out + (size_t)tok * DM + x * 128 + fr;
#pragma unroll
          for (int c = 0; c < 8; ++c) op[16 * c] += ((float)acc[c][0] * 256.f + (float)acc[c][1]) * qsc;
        }
      }
    }
  }
}

__device__ __forceinline__ void grid_barrier(unsigned* ctr, unsigned nb) {
  asm volatile("s_waitcnt vmcnt(0)" ::: "memory");
  __syncthreads();
  if (TIDX == 0) {
    const unsigned ng = (gridDim.x & 7u) ? 1u : 8u, gsize = gridDim.x / ng;
    __builtin_amdgcn_fence(__ATOMIC_RELEASE, "agent");
    asm volatile("s_waitcnt vmcnt(0)" ::: "memory");
    unsigned* gctr = ctr + 32 + (blockIdx.x & (ng - 1u)) * 16;
    const unsigned old = __hip_atomic_fetch_add(gctr, 1u, __ATOMIC_RELAXED, __HIP_MEMORY_SCOPE_AGENT);
    if (old + 1u == gsize * nb) __hip_atomic_fetch_add(ctr, 1u, __ATOMIC_RELAXED, __HIP_MEMORY_SCOPE_AGENT);
    while (__hip_atomic_load(ctr, __ATOMIC_RELAXED, __HIP_MEMORY_SCOPE_AGENT) < ng * nb) __builtin_amdgcn_s_sleep(1);
    __builtin_amdgcn_fence(__ATOMIC_ACQUIRE, "agent");
    asm volatile("s_waitcnt vmcnt(0)" ::: "memory");
  }
  __syncthreads();
}

__global__ void __launch_bounds__(NTHREADS, 2) mk_fwd(Params p) {
  cg::grid_group grid = cg::this_grid();
  __shared__ __attribute__((aligned(16))) unsigned char smem[SMEM_BYTES];
  const int lo = p.ph_lo, hi = p.ph_hi;
#define RUN(k, call) if (lo <= (k) && (k) < hi) { call; if ((k) + 1 < hi) { if ((k) == 0) grid.sync(); else grid_barrier((unsigned*)p.ws, (unsigned)(lo == 0 ? (k) : (k) - lo + 1)); } }
  RUN(0, phase0(p, smem))
  RUN(1, phase1(p, smem))
  RUN(2, phase2(p, smem))
  RUN(3, phase3(p, smem))
  RUN(4, phase4(p, smem))
  RUN(5, phase5(p, smem))
  RUN(6, rmsnorm_rows<true>(p.out, p.in[12], (u16*)(p.ws + OFF_H2), p.ws + OFF_H2Q, (float*)(p.ws + OFF_HS)))
  RUN(7, phase6(p, smem))
  RUN(8, phase7(p, smem))
  RUN(9, phase7b(p))
  RUN(10, phase8a(p))
  RUN(11, phase8c(p))
  RUN(12, phase8b(p, smem))
#undef RUN
}

extern "C" void kernel_launch(void* const* d_in, const int* in_sizes, int n_in,
                              void* d_out, int out_size, void* d_ws, size_t ws_size,
                              hipStream_t stream) {
  static int grid_blocks = 0;
  if (!grid_blocks) {
    int dev = 0, cus = 0, per_cu = 0;
    (void)hipGetDevice(&dev);
    (void)hipDeviceGetAttribute(&cus, hipDeviceAttributeMultiprocessorCount, dev);
    (void)hipOccupancyMaxActiveBlocksPerMultiprocessor(&per_cu, mk_fwd, NTHREADS, 0);
    if (per_cu < 1) per_cu = 1;
    if (per_cu > 1) per_cu = 1;
    grid_blocks = cus * per_cu;
    fprintf(stderr, "mk_fwd: cus=%d per_cu=%d grid=%d ws=%zu\n", cus, per_cu, grid_blocks, ws_size);
  }
  Params p{};
  for (int i = 0; i < 17 && i < n_in; ++i) p.in[i] = (const float*)d_in[i];
  p.out = (float*)d_out;
  p.ws = (unsigned char*)d_ws;
  p.ph_lo = 0; p.ph_hi = 13;
  (void)hipMemsetAsync(d_ws, 0, 8192, stream);
  void* args[] = {&p};
  hipError_t e = hipLaunchCooperativeKernel((void*)mk_fwd, dim3(grid_blocks), dim3(NTHREADS), args, 0, stream);
  if (e != hipSuccess) fprintf(stderr, "cooperative launch failed: %s (grid %d)\n", hipGetErrorString(e), grid_blocks);
#ifdef EXTRA_LO
  {
    Params p2 = p;
    p2.ph_lo = EXTRA_LO; p2.ph_hi = EXTRA_HI; p2.flags = EXTRA_FLAGS;
    void* args2[] = {&p2};
    (void)hipLaunchCooperativeKernel((void*)mk_fwd, dim3(grid_blocks), dim3(NTHREADS), args2, 0, stream);
  }
#endif
}
```

```cpp
#include <hip/hip_runtime.h>
#include <hip/hip_bf16.h>
#include <hip/hip_cooperative_groups.h>
#include <cstdio>
#include <cstdint>
namespace cg = cooperative_groups;

typedef unsigned short u16;
typedef unsigned int u32;
typedef unsigned char u8;
typedef short bf16x8 __attribute__((ext_vector_type(8)));
typedef float f32x4 __attribute__((ext_vector_type(4)));
typedef unsigned int u32x4 __attribute__((ext_vector_type(4)));
typedef unsigned int u32x2 __attribute__((ext_vector_type(2)));

constexpr int NTHREADS = 512;
constexpr int BATCH = 8, SEQ = 4096, DM = 1024, MTOK = BATCH * SEQ;
constexpr int LDP = 5120;
constexpr int NPADW = 5632;
constexpr int C_AQ = 0, C_IQ = 512, C_DQ = 1024, C_DK = 1536, C_DV = 2048, C_DZ = 2560, C_GA = 3072, C_GB = 4096;
constexpr int N_AK = 5120, N_AV = 5248, N_IK = 5376, N_SM = 5440;
constexpr size_t MiB = 1ull << 20;
constexpr size_t OFF_WTIN = 1 * MiB, OFF_WTA = 12 * MiB, OFF_WTB = 13 * MiB, OFF_WTO = 14 * MiB, OFF_WTQ = 16 * MiB,
                 OFF_SKB = 20 * MiB, OFF_SMALL = 21 * MiB, OFF_H = 23 * MiB, OFF_ATT = 23 * MiB, OFF_GC = 39 * MiB,
                 OFF_MERGED = 23 * MiB, OFF_PROJ = 87 * MiB, OFF_KVC = 407 * MiB, OFF_IKC = 423 * MiB, OFF_SEL = 427 * MiB, OFF_YATT = 443 * MiB,
                 OFF_YDN = 475 * MiB;
constexpr size_t OFF_H2 = OFF_PROJ, OFF_QP = OFF_PROJ + 64 * MiB, OFF_TOPS = OFF_PROJ + 192 * MiB,
                 OFF_TOPI = OFF_PROJ + 224 * MiB, OFF_EXPERT = OFF_PROJ + 232 * MiB, OFF_GATE = OFF_PROJ + 248 * MiB;
constexpr size_t OFF_UQ = OFF_PROJ + 264 * MiB, OFF_VQ = OFF_PROJ + 280 * MiB, OFF_US = OFF_PROJ + 296 * MiB, OFF_VS = OFF_PROJ + 297 * MiB;
constexpr size_t OFF_CQ8 = 56 * MiB, OFF_QSC = 64 * MiB;
constexpr size_t OFF_H2Q = 23 * MiB, OFF_HS = 55 * MiB, OFF_PD = OFF_PROJ + 64 * MiB;
constexpr size_t DO_U = 0, DO_W = 32 * MiB, DO_QN = 64 * MiB, DO_KNT = 96 * MiB;

constexpr int SMEM_BYTES = 162816;
constexpr float EPS = 1e-6f;

struct Params {
  const float* in[17];
  float* out;
  unsigned char* ws;
  int ph_lo, ph_hi;
  int flags, pad;
};

typedef __bf16 bf16x2_t __attribute__((ext_vector_type(2)));
typedef float f32x2_t __attribute__((ext_vector_type(2)));
__device__ __forceinline__ u32 pack2(float a, float b) {
  f32x2_t f = {a, b};
  return __builtin_bit_cast(u32, __builtin_convertvector(f, bf16x2_t));
}
__device__ __forceinline__ u16 f2bf(float f) { return (u16)(pack2(f, f) & 0xffffu); }
__device__ __forceinline__ float bf2f(u16 h) { return __uint_as_float(((u32)h) << 16); }
__device__ __forceinline__ float bflo(u32 w) { return __uint_as_float(w << 16); }
__device__ __forceinline__ float bfhi(u32 w) { return __uint_as_float(w & 0xffff0000u); }
__device__ __forceinline__ float wave_sum(float v) {
#pragma unroll
  for (int o = 32; o > 0; o >>= 1) v += __shfl_xor(v, o);
  return v;
}
__device__ __forceinline__ float wave_max(float v) {
#pragma unroll
  for (int o = 32; o > 0; o >>= 1) v = fmaxf(v, __shfl_xor(v, o));
  return v;
}
__device__ __forceinline__ float dot2bf(u32 a, u32 b, float acc) {
  return __builtin_amdgcn_fdot2_f32_bf16(__builtin_bit_cast(bf16x2_t, a), __builtin_bit_cast(bf16x2_t, b), acc, false);
}
#define DPPF(v, ctrl) __int_as_float(__builtin_amdgcn_update_dpp(0, __float_as_int(v), ctrl, 0xf, 0xf, true))
__device__ __forceinline__ float wave_sum_dpp(float v) {
  v += DPPF(v, 0xb1);
  v += DPPF(v, 0x4e);
  v += DPPF(v, 0x124);
  v += DPPF(v, 0x128);
  float r0 = __int_as_float(__builtin_amdgcn_readlane(__float_as_int(v), 0));
  float r1 = __int_as_float(__builtin_amdgcn_readlane(__float_as_int(v), 16));
  float r2 = __int_as_float(__builtin_amdgcn_readlane(__float_as_int(v), 32));
  float r3 = __int_as_float(__builtin_amdgcn_readlane(__float_as_int(v), 48));
  return (r0 + r1) + (r2 + r3);
}
__device__ __forceinline__ int opaque_tid() { int t = threadIdx.x; asm volatile("" : "+v"(t)); return t; }
#define TIDX opaque_tid()
#define DPPI(v, ctrl) __builtin_amdgcn_update_dpp(0, (v), ctrl, 0xf, 0xf, true)
__device__ __forceinline__ int wave_sum_i_dpp(int v) {
  v += DPPI(v, 0xb1);
  v += DPPI(v, 0x4e);
  v += DPPI(v, 0x124);
  v += DPPI(v, 0x128);
  return (__builtin_amdgcn_readlane(v, 0) + __builtin_amdgcn_readlane(v, 16)) +
         (__builtin_amdgcn_readlane(v, 32) + __builtin_amdgcn_readlane(v, 48));
}
__device__ __forceinline__ float wave_max_dpp(float v) {
  v = fmaxf(v, DPPF(v, 0xb1));
  v = fmaxf(v, DPPF(v, 0x4e));
  v = fmaxf(v, DPPF(v, 0x124));
  v = fmaxf(v, DPPF(v, 0x128));
  float r0 = __int_as_float(__builtin_amdgcn_readlane(__float_as_int(v), 0));
  float r1 = __int_as_float(__builtin_amdgcn_readlane(__float_as_int(v), 16));
  float r2 = __int_as_float(__builtin_amdgcn_readlane(__float_as_int(v), 32));
  float r3 = __int_as_float(__builtin_amdgcn_readlane(__float_as_int(v), 48));
  return fmaxf(fmaxf(r0, r1), fmaxf(r2, r3));
}
#define WAVE_LDS_SYNC() asm volatile("s_waitcnt lgkmcnt(0)" ::: "memory")
__device__ __forceinline__ float sigmoidf_(float x) { return __builtin_amdgcn_rcpf(1.f + __expf(-x)); }
__device__ __forceinline__ int perm32(int k) {
  int blk = k & ~31, r = k & 31;
  int p = (r < 16) ? (8 * (r >> 2) + (r & 3)) : (8 * ((r - 16) >> 2) + 4 + (r & 3));
  return blk + p;
}

__device__ __forceinline__ u32 fp8x4(float a, float b, float c, float d) {
  int w = __builtin_amdgcn_cvt_pk_fp8_f32(a, b, 0, false);
  w = __builtin_amdgcn_cvt_pk_fp8_f32(c, d, w, true);
  return (u32)w;
}
__device__ __forceinline__ int g8_logical_col(int t) { return ((t & 127) >> 5) * 64 + (t >> 7) * 32 + (t & 31); }
__device__ __forceinline__ int win_map(int n) {
  if (n < 512) return n;
  if (n < 1024) return 768 + (n - 512);
  if (n < 3072) return 1352 + (n - 1024);
  if (n < 5120) return 3408 + (n - 3072);
  if (n < 5248) return 512 + (n - 5120);
  if (n < 5376) return 640 + (n - 5248);
  if (n < 5440) return 1280 + (n - 5376);
  if (n < 5448) return 1344 + (n - 5440);
  if (n < 5452) return 3400 + (n - 5448);
  if (n < 5456) return 3404 + (n - 5452);
  return -1;
}
__device__ __forceinline__ void transpose_tile(const float* __restrict__ src, int Nsrc, u16* __restrict__ dst, int K, int k0, int n0,
                               bool mapped, bool perm8, float* tile  , float f8scale = 0.f) {
  const int tid = TIDX;
  {
    const int tx = tid & 63, ty = tid >> 6;
    int n = n0 + tx;
    if (perm8) n = (n & ~255) + g8_logical_col(n & 255);
    int sc = mapped ? win_map(n) : n;
#pragma unroll
    for (int i = 0; i < 8; ++i) {
      int k = ty + 8 * i;
      float v = (sc >= 0) ? src[(size_t)(k0 + k) * Nsrc + sc] : 0.f;
      tile[k * 65 + tx] = v;
    }
  }
  __syncthreads();
  {
    const int n = tid >> 3, kc = (tid & 7) * 8;
    if (f8scale != 0.f) {
      u32 w[2];
#pragma unroll
      for (int j = 0; j < 2; ++j)
        w[j] = fp8x4(tile[(kc + 4 * j) * 65 + n] * f8scale, tile[(kc + 4 * j + 1) * 65 + n] * f8scale,
                     tile[(kc + 4 * j + 2) * 65 + n] * f8scale, tile[(kc + 4 * j + 3) * 65 + n] * f8scale);
      *(uint2*)((unsigned char*)dst + (size_t)(n0 + n) * K + k0 + kc) = make_uint2(w[0], w[1]);
    } else {
    u32 w[4];
#pragma unroll
    for (int j = 0; j < 4; ++j) w[j] = pack2(tile[(kc + 2 * j) * 65 + n], tile[(kc + 2 * j + 1) * 65 + n]);
    *(uint4*)(dst + (size_t)(n0 + n) * K + k0 + kc) = make_uint4(w[0], w[1], w[2], w[3]);
    }
  }
  __syncthreads();
}

template <bool Q8, bool F8OUT = false>
__device__ __forceinline__ void rmsnorm_rows(const float* __restrict__ x, const float* __restrict__ gain, u16* __restrict__ out,
                                             unsigned char* __restrict__ q8, float* __restrict__ qs) {
  const int lane = TIDX & 63, wave = TIDX >> 6;
  float4 g[4];
#pragma unroll
  for (int i = 0; i < 4; ++i) g[i] = ((const float4*)gain)[lane + 64 * i];
  for (int row = blockIdx.x * 8 + wave; row < MTOK; row += gridDim.x * 8) {
    const float4* xr = (const float4*)(x + (size_t)row * DM);
    float4 v[4];
    float ss = 0.f;
#pragma unroll
    for (int i = 0; i < 4; ++i) {
      v[i] = xr[lane + 64 * i];
      ss += v[i].x * v[i].x + v[i].y * v[i].y + v[i].z * v[i].z + v[i].w * v[i].w;
    }
    ss = wave_sum_dpp(ss);
    float r = rsqrtf(ss * (1.f / DM) + EPS);
    float amax = 0.f;
#pragma unroll
    for (int i = 0; i < 4; ++i) {
      v[i].x *= r * g[i].x; v[i].y *= r * g[i].y; v[i].z *= r * g[i].z; v[i].w *= r * g[i].w;
      if (F8OUT) {
        *(u32*)((unsigned char*)out + (size_t)row * DM + 4 * (lane + 64 * i)) = fp8x4(2.f * v[i].x, 2.f * v[i].y, 2.f * v[i].z, 2.f * v[i].w);
      } else {
        uint2 o;
        o.x = pack2(v[i].x, v[i].y);
        o.y = pack2(v[i].z, v[i].w);
        *(uint2*)(out + (size_t)row * DM + 4 * (lane + 64 * i)) = o;
      }
      if (Q8) amax = fmaxf(amax, fmaxf(fmaxf(fabsf(v[i].x), fabsf(v[i].y)), fmaxf(fabsf(v[i].z), fabsf(v[i].w))));
    }
    if (Q8) {
      amax = wave_max_dpp(amax);
      const float inv = amax > 0.f ? 127.f / amax : 0.f;
#pragma unroll
      for (int i = 0; i < 4; ++i) {
        const int q0 = (int)rintf(v[i].x * inv), q1 = (int)rintf(v[i].y * inv), q2 = (int)rintf(v[i].z * inv), q3 = (int)rintf(v[i].w * inv);
        *(u32*)(q8 + (size_t)row * DM + 4 * (lane + 64 * i)) =
            (u32)(q0 & 0xff) | ((u32)(q1 & 0xff) << 8) | ((u32)(q2 & 0xff) << 16) | ((u32)(q3 & 0xff) << 24);
      }
      if (lane == 0) qs[row] = amax * (1.f / 127.f);
    }
  }
}

__device__ __forceinline__ void phase0(const Params& p, unsigned char* smem) {
  float* tile = (float*)smem;
  unsigned char* ws = p.ws;
  const int n_in = 16 * 88, n_a = 8 * 16, n_b = 8 * 16, n_o = 16 * 16, n_q = 16 * 32;
  const int total = n_in + n_a + n_b + n_o + n_q;
  for (int t = blockIdx.x; t < total; t += gridDim.x) {
    int i = t;
    if (i < n_in) { transpose_tile(p.in[2], 5456, (u16*)(ws + OFF_WTIN), 1024, (i / 88) * 64, (i % 88) * 64, true, true, tile, 32.f); continue; }
    i -= n_in;
    if (i < n_a) { transpose_tile(p.in[9], 1024, (u16*)(ws + OFF_WTA), 512, (i / 16) * 64, (i % 16) * 64, false, true, tile); continue; }
    i -= n_a;
    if (i < n_b) { transpose_tile(p.in[10], 1024, (u16*)(ws + OFF_WTB), 512, (i / 16) * 64, (i % 16) * 64, false, true, tile); continue; }
    i -= n_b;
    if (i < n_o) { transpose_tile(p.in[11], 1024, (u16*)(ws + OFF_WTO), 1024, (i / 16) * 64, (i % 16) * 64, false, true, tile); continue; }
    i -= n_o;
    transpose_tile(p.in[13], 2048, (u16*)(ws + OFF_WTQ), 1024, (i / 32) * 64, (i % 32) * 64, false, true, tile);
  }
  {
    const float* sk = p.in[14];
    u16* skb = (u16*)(ws + OFF_SKB);
    for (int i = blockIdx.x * NTHREADS + TIDX; i < 16 * 128 * 128; i += gridDim.x * NTHREADS) skb[i] = f2bf(sk[i]);
  }
  rmsnorm_rows<false, true>(p.in[0], p.in[1], (u16*)(ws + OFF_H), nullptr, nullptr);
}

constexpr int G_BM = 256, G_BN = 128, G_BK = 64;
constexpr int G_ABYTES = G_BM * 128;

template <int MI>
__device__ __forceinline__ void gemm_mainloop_t(const u16* __restrict__ A, int lda, const u16* __restrict__ Bt, int ldb, int K,
                                                int m0, int n0, unsigned char* smem, f32x4 (&acc)[MI][4]) {
  constexpr int BN = (MI == 4) ? 128 : 256;
  constexpr int NRB = BN / 64;
  constexpr int STAGE = G_ABYTES + BN * 128;
  const int tid = TIDX, lane = tid & 63, wave = tid >> 6;
  const int wm = (MI == 4) ? (wave >> 1) : (wave >> 2), wn = (MI == 4) ? (wave & 1) : (wave & 3);
#pragma unroll
  for (int i = 0; i < MI; ++i)
#pragma unroll
    for (int j = 0; j < 4; ++j) acc[i][j] = (f32x4){0.f, 0.f, 0.f, 0.f};
  const int kc = tid & 7;
  const int arow = tid >> 3;
  u32x4 ra[4], rb[NRB];
  const u16* ap = A + (size_t)(m0 + arow) * lda + kc * 8;
  const u16* bp = Bt + (size_t)(n0 + arow) * ldb + kc * 8;
  const int nk = K / G_BK;
  const int fr = lane & 15, fg = lane >> 4;
#define G_LOAD(kt_)                                                                       \
  {                                                                                       \
    const u16* ap2_ = ap + (size_t)(kt_) * G_BK;                                          \
    const u16* bp2_ = bp + (size_t)(kt_) * G_BK;                                          \
    _Pragma("unroll") for (int i = 0; i < 4; ++i) ra[i] = *(const u32x4*)(ap2_ + (size_t)(64 * i) * lda); \
    _Pragma("unroll") for (int i = 0; i < NRB; ++i) rb[i] = *(const u32x4*)(bp2_ + (size_t)(64 * i) * ldb); \
  }
#define G_STORE(st_)                                                                      \
  {                                                                                       \
    unsigned char* sa_ = smem + (st_) * STAGE;                                            \
    unsigned char* sb_ = sa_ + G_ABYTES;                                                  \
    _Pragma("unroll") for (int i = 0; i < 4; ++i) { int r = arow + 64 * i; *(u32x4*)(sa_ + r * 128 + ((kc ^ (r & 7)) << 4)) = ra[i]; } \
    _Pragma("unroll") for (int i = 0; i < NRB; ++i) { int r = arow + 64 * i; *(u32x4*)(sb_ + r * 128 + ((kc ^ (r & 7)) << 4)) = rb[i]; } \
  }
  G_LOAD(0)
  __syncthreads();
  G_STORE(0)
  if (nk > 1) G_LOAD(1)
  __syncthreads();
  for (int kt = 0; kt < nk; ++kt) {
    if (kt + 1 < nk) G_STORE((kt + 1) & 1)
    if (kt + 2 < nk) G_LOAD(kt + 2)
    __builtin_amdgcn_sched_barrier(0);
    const unsigned char* sa = smem + (kt & 1) * STAGE;
    const unsigned char* sb = sa + G_ABYTES;
#pragma unroll
    for (int kk = 0; kk < 2; ++kk) {
      bf16x8 bfr[4];
#pragma unroll
      for (int j = 0; j < 4; ++j) {
        int r = wn * 64 + j * 16 + fr;
        bfr[j] = *(const bf16x8*)(sb + r * 128 + (((kk * 4 + fg) ^ (r & 7)) << 4));
      }
#pragma unroll
      for (int ih = 0; ih < MI; ih += 4) {
        bf16x8 af[4];
#pragma unroll
        for (int i = 0; i < 4; ++i) {
          int r = wm * (MI * 16) + (ih + i) * 16 + fr;
          af[i] = *(const bf16x8*)(sa + r * 128 + (((kk * 4 + fg) ^ (r & 7)) << 4));
        }
#pragma unroll
        for (int i = 0; i < 4; ++i)
#pragma unroll
          for (int j = 0; j < 4; ++j) acc[ih + i][j] = __builtin_amdgcn_mfma_f32_16x16x32_bf16(af[i], bfr[j], acc[ih + i][j], 0, 0, 0);
        if (MI == 8 && ih == 0) __builtin_amdgcn_sched_barrier(0);
      }
    }
    __syncthreads();
  }
#undef G_LOAD
#undef G_STORE
}
__device__ __forceinline__ void gemm_mainloop(const u16* __restrict__ A, int lda, const u16* __restrict__ Bt, int ldb, int K,
                                              int m0, int n0, unsigned char* smem, f32x4 (&acc)[4][4]) {
  gemm_mainloop_t<4>(A, lda, Bt, ldb, K, m0, n0, smem, acc);
}

__device__ __forceinline__ int g8_lds_byte(int r, int c) {
  int st = (r >> 4) * 2 + (c >> 5), rr = r & 15, cc = c & 31, ob = rr * 64 + cc * 2;
  return st * 1024 + (ob ^ (((ob >> 9) & 1) << 5));
}
__device__ __forceinline__ void g8_stage_rc(int b, int& R, int& C) {
  int st = b / 1024, sb = b % 1024, swz = sb ^ (((sb >> 9) & 1) << 5);
  R = (st >> 1) * 16 + swz / 64; C = (st & 1) * 32 + (swz % 64) / 2;
}
typedef __attribute__((address_space(3))) unsigned int lds_u32;
template <int F8 = 0, int SC = 127>
__device__ __forceinline__ void gemm8_tile(const u16* __restrict__ A, const u16* __restrict__ Bt, int K, int brow, int bcol,
                                           unsigned char* smem, f32x4 (&acc)[2][2][4][2]) {
  typedef int i32x8_ __attribute__((ext_vector_type(8)));
  typedef int i32x4_ __attribute__((ext_vector_type(4)));
  constexpr int HTB = 16384;
  const int tid = TIDX;
  const int wid = tid >> 6, lane = tid & 63, wr = wid >> 2, wc = wid & 3, fr = lane & 15, fq = lane >> 4;
#define SA(b, h) (smem + ((b) * 2 + (h)) * HTB)
#define SB(b, h) (smem + (4 + (b) * 2 + (h)) * HTB)
  u32 soff0;
  { int _r, _c; g8_stage_rc(tid * 16, _r, _c); soff0 = (u32)(_r * K + _c) * 2u; }
  const int wbase = __builtin_amdgcn_readfirstlane(wid) * 1024;
#define STAGE(P, BASE, br, kt) do { \
    unsigned long long _uv0 = (unsigned long long)(BASE) + (unsigned long long)(((long)(br) * K + (long)(kt) * 64) * 2); \
    unsigned long long _uv1 = _uv0 + (unsigned long long)(64 * K * 2); \
    asm volatile("" : "+s"(_uv0), "+s"(_uv1), "+v"(soff0)); \
    __builtin_amdgcn_global_load_lds((const unsigned int*)((const unsigned char*)_uv0 + soff0), (lds_u32*)((P) + wbase), 16, 0, 0); \
    __builtin_amdgcn_global_load_lds((const unsigned int*)((const unsigned char*)_uv1 + soff0), (lds_u32*)((P) + wbase + 8192), 16, 0, 0); } while (0)
#define LDA(dst, b, h) _Pragma("unroll") for (int m = 0; m < 4; ++m) _Pragma("unroll") for (int k = 0; k < 2; ++k) \
    dst[m][k] = *(const bf16x8*)(SA(b, h) + g8_lds_byte(wr * 64 + m * 16 + fr, k * 32 + fq * 8))
#define LDB(dst, b, h) _Pragma("unroll") for (int n = 0; n < 2; ++n) _Pragma("unroll") for (int k = 0; k < 2; ++k) \
    dst[n][k] = *(const bf16x8*)(SB(b, h) + g8_lds_byte(wc * 32 + n * 16 + fr, k * 32 + fq * 8))
#define MMA(ai, bj, At_, Bt_) do { __builtin_amdgcn_s_setprio(1); \
    if (F8) { \
      _Pragma("unroll") for (int m = 0; m < 4; ++m) _Pragma("unroll") for (int n = 0; n < 2; ++n) \
          \
        asm volatile("v_mfma_scale_f32_16x16x128_f8f6f4 %0, %1, %2, %0, %3, %3 op_sel_hi:[0,0,0]" \
            : "+v"(acc[ai][bj][m][n]) \
            : "v"(__builtin_shufflevector((i32x4_)At_[m][0], (i32x4_)At_[m][1], 0, 1, 2, 3, 4, 5, 6, 7)), \
              "v"(__builtin_shufflevector((i32x4_)Bt_[n][0], (i32x4_)Bt_[n][1], 0, 1, 2, 3, 4, 5, 6, 7)), "v"(scv)); \
    } else { \
    _Pragma("unroll") for (int m = 0; m < 4; ++m) _Pragma("unroll") for (int n = 0; n < 2; ++n) _Pragma("unroll") for (int k = 0; k < 2; ++k) \
      acc[ai][bj][m][n] = __builtin_amdgcn_mfma_f32_16x16x32_bf16(At_[m][k], Bt_[n][k], acc[ai][bj][m][n], 0, 0, 0); \
    } \
    __builtin_amdgcn_s_setprio(0); } while (0)
#define WAIT_V(n) asm volatile("s_waitcnt vmcnt(" #n ")" ::: "memory")
#define WAIT_L(n) asm volatile("s_waitcnt lgkmcnt(" #n ")" ::: "memory")
#define BAR __builtin_amdgcn_s_barrier()
#define SCHED __builtin_amdgcn_sched_barrier(0)
#pragma unroll
  for (int a = 0; a < 2; ++a)
#pragma unroll
    for (int b2 = 0; b2 < 2; ++b2)
#pragma unroll
      for (int m = 0; m < 4; ++m)
#pragma unroll
        for (int n = 0; n < 2; ++n) acc[a][b2][m][n] = (f32x4){0.f, 0.f, 0.f, 0.f};
  bf16x8 At[4][2], B0[2][2], B1[2][2];
  const int scv = SC * 0x01010101;
  const int nt = K / 64;
  constexpr int HALF = 128;
  __syncthreads();
  STAGE(SB(0, 0), Bt, bcol, 0); STAGE(SA(0, 0), A, brow, 0);
  STAGE(SB(0, 1), Bt, bcol + HALF, 0); STAGE(SA(0, 1), A, brow + HALF, 0);
  if (wr == 1) BAR;
  WAIT_V(4); BAR;
  STAGE(SB(1, 0), Bt, bcol, 1); STAGE(SA(1, 0), A, brow, 1); STAGE(SB(1, 1), Bt, bcol + HALF, 1);
  WAIT_V(6); BAR;
#pragma unroll 1
  for (int t = 0; t < nt - 2; t += 2) {
    LDB(B0, 0, 0); SCHED; LDA(At, 0, 0); STAGE(SA(1, 1), A, brow + HALF, t + 1);
    WAIT_L(8); BAR; WAIT_L(0); MMA(0, 0, At, B0); BAR; SCHED;
    LDB(B1, 0, 1); STAGE(SB(0, 0), Bt, bcol, t + 2);
    BAR; WAIT_L(0); MMA(0, 1, At, B1); BAR;
    LDA(At, 0, 1); STAGE(SA(0, 0), A, brow, t + 2);
    BAR; WAIT_L(0); MMA(1, 0, At, B0); BAR; SCHED;
    STAGE(SB(0, 1), Bt, bcol + HALF, t + 2);
    WAIT_V(6); BAR; MMA(1, 1, At, B1); BAR;
    LDB(B0, 1, 0); SCHED; LDA(At, 1, 0); STAGE(SA(0, 1), A, brow + HALF, t + 2);
    WAIT_L(8); BAR; WAIT_L(0); MMA(0, 0, At, B0); BAR; SCHED;
    LDB(B1, 1, 1); STAGE(SB(1, 0), Bt, bcol, t + 3);
    BAR; WAIT_L(0); MMA(0, 1, At, B1); BAR;
    LDA(At, 1, 1); STAGE(SA(1, 0), A, brow, t + 3);
    BAR; WAIT_L(0); MMA(1, 0, At, B0); BAR; SCHED;
    STAGE(SB(1, 1), Bt, bcol + HALF, t + 3);
    WAIT_V(6); BAR; MMA(1, 1, At, B1); BAR;
  }
#define ACC_PIN() _Pragma("unroll") for (int a = 0; a < 2; ++a) _Pragma("unroll") for (int b2 = 0; b2 < 2; ++b2) \
      asm volatile("" : "+v"(acc[a][b2][0][0]), "+v"(acc[a][b2][0][1]), "+v"(acc[a][b2][1][0]), "+v"(acc[a][b2][1][1]), \
                        "+v"(acc[a][b2][2][0]), "+v"(acc[a][b2][2][1]), "+v"(acc[a][b2][3][0]), "+v"(acc[a][b2][3][1]))
  ACC_PIN();
  { LDB(B0, 0, 0); LDA(At, 0, 0); STAGE(SA(1, 1), A, brow + HALF, nt - 1);
    BAR; WAIT_L(0); MMA(0, 0, At, B0); BAR; SCHED;
    LDB(B1, 0, 1); BAR; WAIT_L(0); MMA(0, 1, At, B1); BAR; SCHED;
    LDA(At, 0, 1); WAIT_V(4); BAR; WAIT_L(0); MMA(1, 0, At, B0); SCHED; MMA(1, 1, At, B1); BAR; SCHED; }
  { LDB(B0, 1, 0); LDA(At, 1, 0); WAIT_V(2); BAR; WAIT_L(0); MMA(0, 0, At, B0); BAR; SCHED;
    LDB(B1, 1, 1); WAIT_V(0); BAR; WAIT_L(0); MMA(0, 1, At, B1); BAR; SCHED;
    LDA(At, 1, 1); BAR; WAIT_L(0); MMA(1, 0, At, B0); SCHED; MMA(1, 1, At, B1); BAR; SCHED; }
  ACC_PIN();
#undef ACC_PIN
  if (wr == 0) BAR;
#undef SA
#undef SB
#undef STAGE
#undef LDA
#undef LDB
#undef MMA
#undef WAIT_V
#undef WAIT_L
#undef BAR
#undef SCHED
}

template <int LD, bool NORM>
__device__ __forceinline__ void ep_store(u16* __restrict__ dst, u32 ob, const f32x4 (&acc)[2][2][4][2], const float* __restrict__ gain,
                                         float extra, unsigned char* smem, int wave, int lane_in) {
  int lane = lane_in;
  asm volatile("" : "+v"(lane));
  const int fr = lane & 15, fq = lane >> 4;
  unsigned char* reg = smem + wave * 16384;
  float gj[4] = {1.f, 1.f, 1.f, 1.f};
  if (NORM) {
#pragma unroll
    for (int j = 0; j < 4; ++j) gj[j] = gain[j * 16 + fr] * extra;
  }
  const int lrot = (fr >> 3) + 2 * fq;
  unsigned char* wbase = reg + (4 * fq) * 128 + (fr & 7) * 2;
#pragma unroll
  for (int ai = 0; ai < 2; ++ai)
#pragma unroll
    for (int m = 0; m < 4; ++m) {
#pragma unroll
      for (int r = 0; r < 4; ++r) {
        float rs = 1.f;
        if (NORM) {
          float sq = 0.f;
#pragma unroll
          for (int bj = 0; bj < 2; ++bj)
#pragma unroll
            for (int n = 0; n < 2; ++n) sq += acc[ai][bj][m][n][r] * acc[ai][bj][m][n][r];
          sq += DPPF(sq, 0xb1); sq += DPPF(sq, 0x4e); sq += DPPF(sq, 0x141); sq += DPPF(sq, 0x140);
          rs = rsqrtf(sq * (1.f / 64.f) + EPS);
        }
#pragma unroll
        for (int bj = 0; bj < 2; ++bj)
#pragma unroll
          for (int n = 0; n < 2; ++n) {
            const float v = acc[ai][bj][m][n][r];
            const int ch = ((bj * 2 + n) * 2 + lrot) & 7;
            *(u16*)(wbase + (ai * 64 + m * 16 + r) * 128 + (ch << 4)) = f2bf(NORM ? v * rs * gj[bj * 2 + n] : v);
          }
      }
      __builtin_amdgcn_sched_barrier(0);
    }
  WAVE_LDS_SYNC();
  const int c16 = lane & 7, r8 = lane >> 3;
#pragma unroll
  for (int it = 0; it < 16; ++it) {
    const int rw = it * 8 + r8;
    const u32x4 v = *(const u32x4*)(reg + rw * 128 + (((c16 + 2 * ((rw >> 2) & 3)) & 7) << 4));
    const int grow = (it >> 3) * 128 + (it & 7) * 8 + r8;
    *(u32x4*)(dst + ob + (u32)(grow * LD + c16 * 8)) = v;
    if ((it & 3) == 3) __builtin_amdgcn_sched_barrier(0);
  }
}

template <bool NORM>
__device__ __forceinline__ void ep_store8(unsigned char* __restrict__ dst, u32 ob, const f32x4 (&acc)[2][2][4][2],
                                          const float* __restrict__ gain, unsigned char* smem, int wave, int lane_in) {
  int lane = lane_in;
  asm volatile("" : "+v"(lane));
  const int fr = lane & 15, fq = lane >> 4;
  unsigned char* reg = smem + wave * 16384;
  float gj[4] = {1.f, 1.f, 1.f, 1.f};
  if (NORM) {
#pragma unroll
    for (int j = 0; j < 4; ++j) gj[j] = gain[j * 16 + fr];
  }
#pragma unroll
  for (int ai = 0; ai < 2; ++ai)
#pragma unroll
    for (int m = 0; m < 4; ++m) {
#pragma unroll
      for (int r = 0; r < 4; ++r) {
        float rs = 1.f;
        if (NORM) {
          float sq = 0.f;
#pragma unroll
          for (int bj = 0; bj < 2; ++bj)
#pragma unroll
            for (int n = 0; n < 2; ++n) sq += acc[ai][bj][m][n][r] * acc[ai][bj][m][n][r];
          sq += DPPF(sq, 0xb1); sq += DPPF(sq, 0x4e); sq += DPPF(sq, 0x141); sq += DPPF(sq, 0x140);
          rs = rsqrtf(sq * (1.f / 64.f) + EPS);
        }
        const int rw = ai * 64 + m * 16 + 4 * fq + r;
#pragma unroll
        for (int bj = 0; bj < 2; ++bj)
#pragma unroll
          for (int n = 0; n < 2; ++n) {
            const float v = NORM ? acc[ai][bj][m][n][r] * rs * gj[bj * 2 + n] : acc[ai][bj][m][n][r];
            reg[rw * 64 + ((((bj * 2 + n) + (rw >> 2)) & 3) << 4) + fr] =
                (unsigned char)(__builtin_amdgcn_cvt_pk_fp8_f32(v, v, 0, false) & 0xff);
          }
      }
      __builtin_amdgcn_sched_barrier(0);
    }
  WAVE_LDS_SYNC();
  const int c4 = lane & 3, r16 = lane >> 2;
#pragma unroll
  for (int it = 0; it < 8; ++it) {
    const int rw = it * 16 + r16;
    const u32x4 v = *(const u32x4*)(reg + rw * 64 + (((c4 + (rw >> 2)) & 3) << 4));
    const int grow = (rw >> 6) * 128 + (rw & 63);
    *(u32x4*)(dst + ob + (u32)(grow * 256 + c4 * 16)) = v;
  }
}

__device__ __forceinline__ void phase1(const Params& p, unsigned char* smem) {
  const u16* H = (const u16*)(p.ws + OFF_H);
  const u16* WT = (const u16*)(p.ws + OFF_WTIN);
  u16* PROJ = (u16*)(p.ws + OFF_PROJ);
  u16* KVC = (u16*)(p.ws + OFF_KVC);
  u16* IKC = (u16*)(p.ws + OFF_IKC);
  float* SMALL = (float*)(p.ws + OFF_SMALL);
  const int ntn = NPADW / 256;
  const int ntiles = (MTOK / 256) * ntn;
  for (int t = blockIdx.x; t < ntiles; t += gridDim.x) {
    const int m0 = (t / ntn) * 256, n0 = (t % ntn) * 256;
    f32x4 acc[2][2][4][2];
    gemm8_tile<1, 124>(H, WT, DM / 2, m0, n0, smem, acc);
    const int tid_e = TIDX, lane = tid_e & 63, wave = tid_e >> 6;
    const int wr = wave >> 2, wc = wave & 3, fr = lane & 15, fq = lane >> 4;
    const int cbase = n0 + wc * 64;
    const u32 rbase = (u32)(m0 + wr * 64);
    if (cbase < C_IQ) {
      ep_store<LDP, true>(PROJ, rbase * LDP + (u32)cbase, acc, p.in[3], 0.125f, smem, wave, lane);
    } else if (cbase < LDP) {
      ep_store<LDP, false>(PROJ, rbase * LDP + (u32)cbase, acc, nullptr, 1.f, smem, wave, lane);
    } else if (cbase < N_AV) {
      ep_store8<true>(p.ws + OFF_KVC, rbase * 256 + (u32)(cbase - N_AK), acc, p.in[4], smem, wave, lane);
    } else if (cbase < N_IK) {
      ep_store8<false>(p.ws + OFF_KVC, rbase * 256 + (u32)(cbase - N_AV + 128), acc, nullptr, smem, wave, lane);
    } else if (cbase < N_SM) {
      ep_store<64, false>(IKC, rbase * 64, acc, nullptr, 1.f, smem, wave, lane);
    } else if (cbase == N_SM) {
      const u32 sb0 = (rbase + 4 * fq) * 16 + (u32)fr;
#pragma unroll
      for (int ai = 0; ai < 2; ++ai)
#pragma unroll
        for (int m = 0; m < 4; ++m)
#pragma unroll
          for (int r = 0; r < 4; ++r) SMALL[sb0 + (u32)((ai * 128 + m * 16 + r) * 16)] = acc[ai][0][m][0][r];
    }
  }
}

constexpr int IDX_RS = 8208;

__device__ __forceinline__ u32 f2key(float x) {
  _Float16 h = (_Float16)x;
  u32 b = (u32) * (u16*)&h;
  return (b & 0x8000u) ? ((~b) & 0xffffu) : (b | 0x8000u);
}
__device__ __forceinline__ int count_ge_wave(const u32 (&kreg)[32], u32 mid, int ndw) {
  const u32 m1 = (mid - 1u) * 0x00010001u;
  const u32 one = 0x00010001u;
  u32 acc0 = 0u, acc1 = 0u;
#pragma unroll
  for (int c4 = 0; c4 < 8; ++c4) {
    if (c4 * 4 < ndw) {
#pragma unroll
      for (int i = c4 * 4; i < c4 * 4 + 4; i += 2) {
        u32 t0, t1;
        asm("v_pk_sub_u16 %0, %1, %2 clamp" : "=v"(t0) : "v"(kreg[i]), "s"(m1));
        asm("v_pk_sub_u16 %0, %1, %2 clamp" : "=v"(t1) : "v"(kreg[i + 1]), "s"(m1));
        asm("v_pk_min_u16 %0, %1, %2" : "=v"(t0) : "v"(t0), "s"(one));
        asm("v_pk_min_u16 %0, %1, %2" : "=v"(t1) : "v"(t1), "s"(one));
        asm("v_pk_add_u16 %0, %1, %2" : "=v"(acc0) : "v"(acc0), "v"(t0));
        asm("v_pk_add_u16 %0, %1, %2" : "=v"(acc1) : "v"(acc1), "v"(t1));
      }
    }
  }
  int c = (int)((acc0 & 0xffffu) + (acc0 >> 16) + (acc1 & 0xffffu) + (acc1 >> 16));
  return wave_sum_i_dpp(c);
}

__device__ __forceinline__ void idx_item(const Params& p, unsigned char* smem, int b, int tq) {
  const u16* PROJ = (const u16*)(p.ws + OFF_PROJ);
  const float* SMALL = (const float*)(p.ws + OFF_SMALL);
  u16* SEL = (u16*)(p.ws + OFF_SEL);
  const int tid = TIDX, lane = tid & 63, wave = tid >> 6;
  const int t0 = tq * 16;
  const size_t tokb = (size_t)b * SEQ;
  if (tq < 16) {
    for (int rr = 0; rr < 2; ++rr) {
      int row = 2 * wave + rr, t = t0 + row;
      u16* out = SEL + (tokb + t) * 256;
      for (int i = lane; i < 256; i += 64) out[i] = (i <= t) ? (u16)i : (u16)0xFFFF;
    }
    return;
  }
  const int q = lane & 15, g = lane >> 4;
  __syncthreads();
  {
    const u16* iqrow = PROJ + (tokb + t0 + q) * LDP + C_IQ;
    bf16x8 bq[8][2];
    float wq[8];
#pragma unroll
    for (int h = 0; h < 8; ++h) {
      bq[h][0] = *(const bf16x8*)(iqrow + h * 64 + g * 8);
      bq[h][1] = *(const bf16x8*)(iqrow + h * 64 + 32 + g * 8);
      wq[h] = SMALL[(tokb + t0 + q) * 16 + h];
    }
    bf16x8 bqs[2];
    {
      typedef u32 u32x4_ __attribute__((ext_vector_type(4)));
#pragma unroll
      for (int kk = 0; kk < 2; ++kk) {
        float s8[8];
#pragma unroll
        for (int e = 0; e < 8; ++e) s8[e] = 0.f;
#pragma unroll
        for (int h = 0; h < 8; ++h) {
          const u32x4_ w4 = (u32x4_)bq[h][kk];
#pragma unroll
          for (int c = 0; c < 4; ++c) { s8[2 * c] = fmaf(wq[h], bflo(w4[c]), s8[2 * c]); s8[2 * c + 1] = fmaf(wq[h], bfhi(w4[c]), s8[2 * c + 1]); }
        }
        u32x4_ o4;
#pragma unroll
        for (int c = 0; c < 4; ++c) o4[c] = pack2(s8[2 * c], s8[2 * c + 1]);
        bqs[kk] = (bf16x8)o4;
      }
    }
    const int nkb = tq + 1;
    const int niter = (nkb > wave) ? ((nkb - wave + 7) >> 3) : 0;
    const u16* ikbase = (const u16*)(p.ws + OFF_IKC) + (tokb + q) * 64 + g * 8;
    bf16x8 ca[3][2];
#pragma unroll
    for (int j = 0; j < 3; ++j)
      if (j < niter) {
        const u16* ikrow = ikbase + (size_t)((wave + 8 * j) * 16) * 64;
        ca[j][0] = *(const bf16x8*)(ikrow); ca[j][1] = *(const bf16x8*)(ikrow + 32);
      }
    for (int i0 = 0; i0 < ((p.flags & 8) ? 0 : niter); i0 += 3) {
#pragma unroll
      for (int j = 0; j < 3; ++j) {
        if (i0 + j < niter) {
          const int s0 = (wave + 8 * (i0 + j)) * 16;
          f32x4 tot = {0.f, 0.f, 0.f, 0.f};
          tot = __builtin_amdgcn_mfma_f32_16x16x32_bf16(ca[j][0], bqs[0], tot, 0, 0, 0);
          tot = __builtin_amdgcn_mfma_f32_16x16x32_bf16(ca[j][1], bqs[1], tot, 0, 0, 0);
#pragma unroll
          for (int h = 0; h < 8; ++h) {
            f32x4 acc = {0.f, 0.f, 0.f, 0.f};
            acc = __builtin_amdgcn_mfma_f32_16x16x32_bf16(ca[j][0], bq[h][0], acc, 0, 0, 0);
            acc = __builtin_amdgcn_mfma_f32_16x16x32_bf16(ca[j][1], bq[h][1], acc, 0, 0, 0);
#pragma unroll
            for (int r = 0; r < 4; ++r) tot[r] = fmaf(fabsf(acc[r]), wq[h], tot[r]);
          }
          if (i0 + 3 + j < niter) {
            const u16* ikrow = ikbase + (size_t)((wave + 8 * (i0 + 3 + j)) * 16) * 64;
            ca[j][0] = *(const bf16x8*)(ikrow); ca[j][1] = *(const bf16x8*)(ikrow + 32);
          }
          typedef short s16x2_ __attribute__((ext_vector_type(2)));
          u32x2 w2;
#pragma unroll
          for (int c = 0; c < 2; ++c) {
            const u32 pk = __builtin_bit_cast(u32, __builtin_amdgcn_cvt_pkrtz(tot[2 * c], tot[2 * c + 1]));
            const u32 sm = __builtin_bit_cast(u32, __builtin_bit_cast(s16x2_, pk) >> (s16x2_){15, 15});
            w2[c] = pk ^ (sm | 0x80008000u);
          }
          if (s0 == t0) {
#pragma unroll
            for (int c = 0; c < 2; ++c) {
              const int sidx = s0 + 4 * g + 2 * c;
              w2[c] = (sidx <= t0 + q ? (w2[c] & 0xffffu) : 0u) | (sidx + 1 <= t0 + q ? (w2[c] & 0xffff0000u) : 0u);
            }
          }
          *(u32x2*)(smem + q * IDX_RS + (s0 + 4 * g) * 2) = w2;
        }
        __builtin_amdgcn_sched_barrier(0);
      }
    }
    const int nk = t0 + 16, nk64 = (nk + 511) & ~511;
#pragma unroll
    for (int rr = 0; rr < 2; ++rr) {
      const int cb = nk * 2 + lane * 16;
      if (cb < nk64 * 2) *(u32x4*)(smem + (2 * wave + rr) * IDX_RS + cb) = (u32x4){0u, 0u, 0u, 0u};
    }
  }
  __syncthreads();
  const int ndw = ((t0 + 16 + 511) >> 9) << 2;
  for (int rr = 0; rr < ((p.flags & 16) ? 0 : 2); ++rr) {
    const int row = 2 * wave + rr, t = t0 + row;
    u16* out = SEL + (tokb + t) * 256;
    u32 kreg[32];
    {
      const u32* src = (const u32*)(smem + row * IDX_RS) + lane;
#pragma unroll
      for (int c4 = 0; c4 < 8; ++c4)
        if (c4 * 4 < ndw) {
#pragma unroll
          for (int i = c4 * 4; i < c4 * 4 + 4; ++i) kreg[i] = src[i * 64];
        }
    }
    WAVE_LDS_SYNC();
    u32 lo = 1u, hi = 65535u;
    while (lo < hi) {
      u32 mid = (lo + hi + 1u) >> 1;
      int c = count_ge_wave(kreg, mid, ndw);
      if (c >= 256) lo = mid; else hi = mid - 1u;
    }
    const u32 tau = lo;
    int gt = 0, eq = 0;
#pragma unroll
    for (int c4 = 0; c4 < 8; ++c4)
      if (c4 * 4 < ndw) {
#pragma unroll
        for (int i = c4 * 4; i < c4 * 4 + 4; ++i) {
          u32 a = kreg[i] & 0xffffu, c2 = kreg[i] >> 16;
          gt += (a > tau) ? 1 : 0; gt += (c2 > tau) ? 1 : 0;
          eq += (a == tau) ? 1 : 0; eq += (c2 == tau) ? 1 : 0;
        }
      }
    int packed = gt | (eq << 16);
    int incl = packed;
#pragma unroll
    for (int o = 1; o < 64; o <<= 1) {
      int v = __shfl_up(incl, o);
      if (lane >= o) incl += v;
    }
    const int excl = incl - packed;
    const int total = __shfl(incl, 63);
    const int need = 256 - (total & 0xffff);
    const int pg = excl & 0xffff, pe = excl >> 16;
    int pos = pg + min(pe, need);
    int eqseen = pe;
    u16* lrow = (u16*)(smem + row * IDX_RS);
#pragma unroll
    for (int c4 = 0; c4 < 8; ++c4)
      if (c4 * 4 < ndw) {
#pragma unroll
        for (int i = c4 * 4; i < c4 * 4 + 4; ++i) {
#pragma unroll
          for (int hh = 0; hh < 2; ++hh) {
            u32 kv = hh ? (kreg[i] >> 16) : (kreg[i] & 0xffffu);
            int idx = 128 * i + 2 * lane + hh;
            bool take = false;
            if (kv > tau) take = true;
            else if (kv == tau) { take = (eqseen < need); ++eqseen; }
            if (take) { lrow[pos] = (u16)idx; ++pos; }
          }
        }
      }
    WAVE_LDS_SYNC();
    *(u32x2*)(out + lane * 4) = *(const u32x2*)(lrow + lane * 4);
    WAVE_LDS_SYNC();
  }
}

constexpr int DNP = 68;
constexpr int DL_KT = 0;
constexpr int DL_V = DL_KT + 128 * DNP * 4;
constexpr int DL_QB = DL_V + 64 * 128 * 4;
constexpr int DL_KB = DL_QB + 64 * 272;
constexpr int DL_SM = DL_KB + 64 * 272;
constexpr int DL_RAW = DL_SM + 2048;
static_assert(DL_RAW + 3 * 67 * 272 <= SMEM_BYTES && 16384 + 64 * 144 + 2048 <= 3 * 67 * 272, "dn_local LDS");
__device__ __forceinline__ void dn_local_item(const Params& p, unsigned char* smem, int item) {
  const int h = item & 3, n = (item >> 2) & 63, b = item >> 8;
  const u16* PROJ = (const u16*)(p.ws + OFF_PROJ);
  const float* SMALL = (const float*)(p.ws + OFF_SMALL);
  u16* Ug = (u16*)((unsigned char*)p.out + DO_U);
  u16* Wg = (u16*)((unsigned char*)p.out + DO_W);
  u16* QNg = (u16*)((unsigned char*)p.out + DO_QN);
  u16* KNTg = (u16*)((unsigned char*)p.out + DO_KNT);
  u16* ATTg = (u16*)(p.ws + OFF_ATT);
  float* GCg = (float*)(p.ws + OFF_GC);
  const float* convw = p.in[5];
  const int tid = TIDX, lane = tid & 63, wave = tid >> 6;
  const int c0 = n * 64;
  const size_t tok0 = (size_t)b * SEQ + c0;
  float* Kt = (float*)(smem + DL_KT);
  float* V = (float*)(smem + DL_V);
  unsigned char* Qb = smem + DL_QB;
  unsigned char* Kb = smem + DL_KB;
  float* gc = (float*)(smem + DL_SM);
  float* beta = gc + 64;
  float* ssp = beta + 64;
  unsigned char* RAW = smem + DL_RAW;
  float* AmT = (float*)(smem + DL_RAW);
  __syncthreads();
  {
    u32x4 rg[7];
#pragma unroll
    for (int k = 0; k < 7; ++k) {
      const int ci = tid + 512 * k;
      rg[k] = (u32x4){0u, 0u, 0u, 0u};
      if (ci < 3216) {
        const int arr = ci / 1072, rem = ci - arr * 1072, row = rem >> 4, ch = rem & 15;
        const int trel = c0 - 3 + row;
        if (trel >= 0)
          rg[k] = *(const u32x4*)(PROJ + ((size_t)b * SEQ + trel) * LDP + (C_DQ + arr * 512) + h * 128 + ch * 8);
      }
    }
#pragma unroll
    for (int k = 0; k < 7; ++k) {
      const int ci = tid + 512 * k;
      if (ci < 3216) {
        const int arr = ci / 1072, rem = ci - arr * 1072, row = rem >> 4, ch = rem & 15;
        *(u32x4*)(RAW + (arr * 67 + row) * 272 + ch * 16) = rg[k];
      }
    }
  }
  if (tid < 64) {
    float da = SMALL[(tok0 + tid) * 16 + 8 + h], db = SMALL[(tok0 + tid) * 16 + 12 + h];
    float xx = da + p.in[7][h];
    float sp = fmaxf(xx, 0.f) + log1pf(__expf(-fabsf(xx)));
    float gr = -__expf(p.in[6][h]) * sp;
    float incl = gr;
#pragma unroll
    for (int o = 1; o < 64; o <<= 1) {
      float v = __shfl_up(incl, o);
      if (lane >= o) incl += v;
    }
    gc[tid] = incl;
    beta[tid] = sigmoidf_(db);
    GCg[(tok0 + tid) * 4 + h] = incl;
  }
  __syncthreads();
  {
    const int c = tid & 127, tg = tid >> 7;
    float qv[16], kv[16];
#pragma unroll
    for (int arr = 0; arr < 3; ++arr) {
      const float w0 = convw[0 * 1536 + arr * 512 + h * 128 + c], w1 = convw[1 * 1536 + arr * 512 + h * 128 + c],
                  w2 = convw[2 * 1536 + arr * 512 + h * 128 + c], w3 = convw[3 * 1536 + arr * 512 + h * 128 + c];
      const unsigned char* rp = RAW + (arr * 67 + tg * 16) * 272 + c * 2;
      float x0 = bf2f(*(const u16*)(rp)), x1 = bf2f(*(const u16*)(rp + 272)), x2 = bf2f(*(const u16*)(rp + 2 * 272));
#pragma unroll
      for (int ii = 0; ii < 16; ++ii) {
        const float x3 = bf2f(*(const u16*)(rp + (ii + 3) * 272));
        const float y = w0 * x0 + w1 * x1 + w2 * x2 + w3 * x3;
        const float sv = y * sigmoidf_(y);
        if (arr == 0) qv[ii] = sv;
        else if (arr == 1) kv[ii] = sv;
        else V[(tg * 16 + ii) * 128 + c] = sv;
        x0 = x1; x1 = x2; x2 = x3;
      }
    }
#pragma unroll
    for (int ii = 0; ii < 16; ++ii) {
      const float sq = wave_sum_dpp(qv[ii] * qv[ii]);
      const float sk = wave_sum_dpp(kv[ii] * kv[ii]);
      if (lane == 0) {
        ssp[((tg * 16 + ii) * 2) + (wave & 1)] = sq;
        ssp[128 + ((tg * 16 + ii) * 2) + (wave & 1)] = sk;
      }
    }
    __syncthreads();
#pragma unroll
    for (int ii = 0; ii < 16; ++ii) {
      const int i = tg * 16 + ii;
      const float qsc = rsqrtf(ssp[i * 2] + ssp[i * 2 + 1] + EPS) * 0.08838834764831845f;
      const float ksc = rsqrtf(ssp[128 + i * 2] + ssp[128 + i * 2 + 1] + EPS);
      const float qn = qv[ii] * qsc, kn = kv[ii] * ksc;
      *(u16*)(Qb + i * 272 + c * 2) = f2bf(qn);
      *(u16*)(Kb + i * 272 + c * 2) = f2bf(kn);
      Kt[c * DNP + i] = kn;
    }
  }
  __syncthreads();
#pragma unroll
  for (int k = 0; k < 4; ++k) {
    const int gi = tid + 512 * k;
    {
      const int i = gi >> 5, d4 = (gi & 31) * 4;
      const u32x2 v = *(const u32x2*)(Qb + i * 272 + d4 * 2);
      *(u32x2*)(QNg + (tok0 + i) * 512 + h * 128 + perm32(d4)) = v;
    }
    {
      const int d = gi >> 4, t4 = (gi & 15) * 4;
      const f32x4 v = *(const f32x4*)(Kt + d * DNP + t4);
      u32x2 o = {pack2(v[0], v[1]), pack2(v[2], v[3])};
      *(u32x2*)(KNTg + (size_t)item * 8192 + d * 64 + perm32(t4)) = o;
    }
  }
  {
    const int mat = wave >> 2, it = wave & 3;
    const int fr = lane & 15, fg = lane >> 4;
    const unsigned char* Ab = mat ? Qb : Kb;
    bf16x8 af[4];
#pragma unroll
    for (int kk = 0; kk < 4; ++kk) af[kk] = *(const bf16x8*)(Ab + (it * 16 + fr) * 272 + kk * 64 + fg * 16);
    f32x4 gi4 = *(const f32x4*)(gc + it * 16 + 4 * fg);
    f32x4 bi4 = *(const f32x4*)(beta + it * 16 + 4 * fg);
#pragma unroll
    for (int jt = 0; jt < 4; ++jt) {
      f32x4 acc = {0.f, 0.f, 0.f, 0.f};
      if (jt <= it) {
#pragma unroll
        for (int kk = 0; kk < 4; ++kk) {
          bf16x8 bfg = *(const bf16x8*)(Kb + (jt * 16 + fr) * 272 + kk * 64 + fg * 16);
          acc = __builtin_amdgcn_mfma_f32_16x16x32_bf16(af[kk], bfg, acc, 0, 0, 0);
        }
      }
      const int j = jt * 16 + fr;
      const float gj = gc[j];
#pragma unroll
      for (int r = 0; r < 4; ++r) {
        const int i = it * 16 + 4 * fg + r;
        const float dec = __expf(fminf(gi4[r] - gj, 0.f));
        if (mat == 0) { if (jt <= it) AmT[j * 64 + i] = (i > j) ? bi4[r] * acc[r] * dec : 0.f; }
        else ATTg[(size_t)item * 4096 + i * 64 + perm32(j)] = f2bf((i >= j) ? acc[r] * dec : 0.f);
      }
    }
  }
  __syncthreads();
  u16* nA = (u16*)(smem + DL_RAW + 16384);
  u16* Nb = (u16*)(smem + DL_RAW + 16384 + 64 * 144);
  {
#pragma unroll
    for (int k = 0; k < 8; ++k) {
      const int e = tid + 512 * k;
      const int i = e >> 6, j = e & 63;
      const float v = ((j >> 4) < (i >> 4)) ? -AmT[j * 64 + i] : 0.f;
      nA[i * 72 + j] = f2bf(v);
    }
    if (tid < 64) {
      const int bb = tid >> 4, j = tid & 15;
      float nn[16];
#pragma unroll
      for (int i = 0; i < 16; ++i) {
        float sacc = 0.f;
#pragma unroll
        for (int k = 0; k < i; ++k) sacc += AmT[(bb * 16 + k) * 64 + bb * 16 + i] * nn[k];
        nn[i] = (i == j) ? 1.f : ((i > j) ? -sacc : 0.f);
      }
#pragma unroll
      for (int i = 0; i < 16; ++i) Nb[bb * 256 + i * 16 + j] = f2bf(nn[i]);
    }
  }
  __syncthreads();
  {
    const int fr = lane & 15, fg = lane >> 4;
    f32x4 X[2][4];
#pragma unroll
    for (int ct2 = 0; ct2 < 2; ++ct2) {
      const int c = (wave * 2 + ct2) * 16 + fr;
      const bool isu = c < 128;
      const int cc = c & 127;
#pragma unroll
      for (int bb = 0; bb < 4; ++bb) {
        f32x4 acc;
#pragma unroll
        for (int r = 0; r < 4; ++r) {
          const int i = bb * 16 + 4 * fg + r;
          acc[r] = isu ? V[i * 128 + cc] * beta[i] : Kt[cc * DNP + i] * beta[i] * __expf(gc[i]);
        }
        if (bb >= 1) {
          union { u32 w[4]; bf16x8 v; } af, bf;
          const u32x2 a0 = *(const u32x2*)(nA + (bb * 16 + fr) * 72 + 4 * fg);
          af.w[0] = a0[0]; af.w[1] = a0[1];
          bf.w[0] = pack2(X[ct2][0][0], X[ct2][0][1]); bf.w[1] = pack2(X[ct2][0][2], X[ct2][0][3]);
          if (bb >= 2) {
            const u32x2 a1 = *(const u32x2*)(nA + (bb * 16 + fr) * 72 + 16 + 4 * fg);
            af.w[2] = a1[0]; af.w[3] = a1[1];
            bf.w[2] = pack2(X[ct2][1][0], X[ct2][1][1]); bf.w[3] = pack2(X[ct2][1][2], X[ct2][1][3]);
          } else { af.w[2] = 0u; af.w[3] = 0u; bf.w[2] = 0u; bf.w[3] = 0u; }
          acc = __builtin_amdgcn_mfma_f32_16x16x32_bf16(af.v, bf.v, acc, 0, 0, 0);
          if (bb == 3) {
            const u32x2 a2 = *(const u32x2*)(nA + (bb * 16 + fr) * 72 + 32 + 4 * fg);
            af.w[0] = a2[0]; af.w[1] = a2[1]; af.w[2] = 0u; af.w[3] = 0u;
            bf.w[0] = pack2(X[ct2][2][0], X[ct2][2][1]); bf.w[1] = pack2(X[ct2][2][2], X[ct2][2][3]); bf.w[2] = 0u; bf.w[3] = 0u;
            acc = __builtin_amdgcn_mfma_f32_16x16x32_bf16(af.v, bf.v, acc, 0, 0, 0);
          }
        }
        {
          union { u32 w[4]; bf16x8 v; } af, bf;
          const u32x2 d0 = *(const u32x2*)(Nb + bb * 256 + fr * 16 + 4 * fg);
          af.w[0] = d0[0]; af.w[1] = d0[1]; af.w[2] = 0u; af.w[3] = 0u;
          bf.w[0] = pack2(acc[0], acc[1]); bf.w[1] = pack2(acc[2], acc[3]); bf.w[2] = 0u; bf.w[3] = 0u;
          const f32x4 z4 = {0.f, 0.f, 0.f, 0.f};
          X[ct2][bb] = __builtin_amdgcn_mfma_f32_16x16x32_bf16(af.v, bf.v, z4, 0, 0, 0);
        }
#pragma unroll
        for (int r = 0; r < 4; ++r) {
          const int i = bb * 16 + 4 * fg + r;
          if (isu) Ug[(tok0 + i) * 512 + h * 128 + cc] = f2bf(X[ct2][bb][r]);
          else Wg[(tok0 + i) * 512 + h * 128 + perm32(cc)] = f2bf(X[ct2][bb][r]);
        }
      }
    }
  }
}

__device__ __forceinline__ void phase2(const Params& p, unsigned char* smem) {
#ifndef NO_IDX
  for (int i = blockIdx.x; i < 2048; i += gridDim.x) idx_item(p, smem, i & 7, 255 - (i >> 3));
#endif
#ifndef NO_DNL
  if (!(p.flags & 1))
    for (int i = blockIdx.x; i < 2048; i += gridDim.x) dn_local_item(p, smem, i);
#endif
}

constexpr int SC_WP = 272, SC_KP = 144;
constexpr int SC_W = 0, SC_Q = 64 * SC_WP, SC_KT = 2 * 64 * SC_WP, SC_AT = SC_KT + 128 * SC_KP, SC_U = SC_AT + 64 * SC_KP,
              SC_BUF = SC_U + 64 * SC_WP;
constexpr int SC_GC = 2 * SC_BUF;
static_assert(SC_GC + 2 * 64 * 4 <= SMEM_BYTES, "scan LDS");

__device__ __forceinline__ void dn_scan_item(const Params& p, unsigned char* smem, int bh) {
  const int h = bh & 3, b = bh >> 2;
  const u16* Ug = (const u16*)((const unsigned char*)p.out + DO_U);
  const u16* Wg = (const u16*)((const unsigned char*)p.out + DO_W);
  const u16* QNg = (const u16*)((const unsigned char*)p.out + DO_QN);
  const u16* KNTg = (const u16*)((const unsigned char*)p.out + DO_KNT);
  const u16* ATTg = (const u16*)(p.ws + OFF_ATT);
  const float* GCg = (const float*)(p.ws + OFF_GC);
  const u16* PROJ = (const u16*)(p.ws + OFF_PROJ);
  u16* YDN = (u16*)(p.ws + OFF_YDN);
  const float* ogain = p.in[8];
  const int tid = TIDX, lane = tid & 63, wave = tid >> 6;
  const int fr = lane & 15, fg = lane >> 4;
  const int ecol = wave * 16 + fr;
  float* gcs = (float*)(smem + SC_GC);
  f32x4 S[8];
#pragma unroll
  for (int d = 0; d < 8; ++d) S[d] = (f32x4){0.f, 0.f, 0.f, 0.f};
  u32x4 st[9];
  float gcr = 0.f;
  const int r16 = tid >> 4, c16 = tid & 15;
  const int r8 = tid >> 3, c8 = tid & 7;
#define SCAN_LOAD(n_)                                                                                      \
  {                                                                                                        \
    const size_t tk0 = (size_t)b * SEQ + (size_t)(n_) * 64;                                                \
    const size_t it_ = (size_t)((b * 64 + (n_)) * 4 + h);                                                  \
    st[0] = *(const u32x4*)(Wg + (tk0 + r16) * 512 + h * 128 + c16 * 8);                                   \
    st[1] = *(const u32x4*)(Wg + (tk0 + r16 + 32) * 512 + h * 128 + c16 * 8);                              \
    st[2] = *(const u32x4*)(QNg + (tk0 + r16) * 512 + h * 128 + c16 * 8);                                  \
    st[3] = *(const u32x4*)(QNg + (tk0 + r16 + 32) * 512 + h * 128 + c16 * 8);                             \
    st[4] = *(const u32x4*)(KNTg + it_ * 8192 + (size_t)tid * 8);                                          \
    st[5] = *(const u32x4*)(KNTg + it_ * 8192 + (size_t)(tid + 512) * 8);                                  \
    st[6] = *(const u32x4*)(ATTg + it_ * 4096 + (size_t)tid * 8);                                          \
    st[7] = *(const u32x4*)(Ug + (tk0 + r16) * 512 + h * 128 + c16 * 8);                                   \
    st[8] = *(const u32x4*)(Ug + (tk0 + r16 + 32) * 512 + h * 128 + c16 * 8);                              \
    if (tid < 64) gcr = GCg[(tk0 + tid) * 4 + h];                                                          \
  }
#define SCAN_STORE(buf_)                                                                                   \
  {                                                                                                        \
    unsigned char* bs_ = smem + (buf_) * SC_BUF;                                                           \
    *(u32x4*)(bs_ + SC_W + r16 * SC_WP + c16 * 16) = st[0];                                                \
    *(u32x4*)(bs_ + SC_W + (r16 + 32) * SC_WP + c16 * 16) = st[1];                                         \
    *(u32x4*)(bs_ + SC_Q + r16 * SC_WP + c16 * 16) = st[2];                                                \
    *(u32x4*)(bs_ + SC_Q + (r16 + 32) * SC_WP + c16 * 16) = st[3];                                         \
    *(u32x4*)(bs_ + SC_KT + r8 * SC_KP + c8 * 16) = st[4];                                                 \
    *(u32x4*)(bs_ + SC_KT + (r8 + 64) * SC_KP + c8 * 16) = st[5];                                          \
    *(u32x4*)(bs_ + SC_AT + r8 * SC_KP + c8 * 16) = st[6];                                                 \
    *(u32x4*)(bs_ + SC_U + r16 * SC_WP + c16 * 16) = st[7];                                                \
    *(u32x4*)(bs_ + SC_U + (r16 + 32) * SC_WP + c16 * 16) = st[8];                                         \
    if (tid < 64) gcs[(buf_) * 64 + tid] = gcr;                                                            \
  }
  __syncthreads();
  SCAN_LOAD(0)
  SCAN_STORE(0)
  if (1 < 64) SCAN_LOAD(1)
  __syncthreads();
  for (int n = 0; n < 64; ++n) {
    const int buf = n & 1;
    const size_t tok0 = (size_t)b * SEQ + n * 64;
    if (n + 1 < 64) SCAN_STORE(buf ^ 1)
    if (n + 2 < 64) SCAN_LOAD(n + 2)
    __builtin_amdgcn_sched_barrier(0);
    const unsigned char* base = smem + buf * SC_BUF;
    const u32 ub0 = (u32)(tok0 + 4 * fg) * 512 + (u32)(h * 128 + ecol);
    const float* gcb = gcs + buf * 64 + 4 * fg;
    const float glast = gcs[buf * 64 + 63];
    bf16x8 Sb[4];
#pragma unroll
    for (int kk = 0; kk < 4; ++kk) {
      union { u32 w[4]; bf16x8 v; } cv;
      cv.w[0] = pack2(S[2 * kk][0], S[2 * kk][1]); cv.w[1] = pack2(S[2 * kk][2], S[2 * kk][3]);
      cv.w[2] = pack2(S[2 * kk + 1][0], S[2 * kk + 1][1]); cv.w[3] = pack2(S[2 * kk + 1][2], S[2 * kk + 1][3]);
      Sb[kk] = cv.v;
    }
    f32x4 vnew[4], ov[4];
#pragma unroll
    for (int m = 0; m < 4; ++m) {
      f32x4 aw = {0.f, 0.f, 0.f, 0.f}, aq = {0.f, 0.f, 0.f, 0.f};
#pragma unroll
      for (int kk = 0; kk < 4; ++kk) {
        bf16x8 wf = *(const bf16x8*)(base + SC_W + (m * 16 + fr) * SC_WP + kk * 64 + fg * 16);
        bf16x8 qf = *(const bf16x8*)(base + SC_Q + (m * 16 + fr) * SC_WP + kk * 64 + fg * 16);
        aw = __builtin_amdgcn_mfma_f32_16x16x32_bf16(wf, Sb[kk], aw, 0, 0, 0);
        aq = __builtin_amdgcn_mfma_f32_16x16x32_bf16(qf, Sb[kk], aq, 0, 0, 0);
      }
      f32x4 g4 = *(const f32x4*)(gcb + m * 16);
#pragma unroll
      for (int r = 0; r < 4; ++r) {
        float uv = bf2f(*(const u16*)(base + SC_U + (m * 16 + 4 * fg + r) * SC_WP + ecol * 2));
        vnew[m][r] = uv - aw[r];
        ov[m][r] = aq[r] * __expf(g4[r]);
      }
    }
    bf16x8 vb[2], vsb[2];
#pragma unroll
    for (int k2 = 0; k2 < 2; ++k2) {
      union { u32 w[4]; bf16x8 v; } c1, c2;
      const int ma = 2 * k2, mb = 2 * k2 + 1;
      c1.w[0] = pack2(vnew[ma][0], vnew[ma][1]); c1.w[1] = pack2(vnew[ma][2], vnew[ma][3]);
      c1.w[2] = pack2(vnew[mb][0], vnew[mb][1]); c1.w[3] = pack2(vnew[mb][2], vnew[mb][3]);
      f32x4 ga4 = *(const f32x4*)(gcb + ma * 16), gb4 = *(const f32x4*)(gcb + mb * 16);
      float sa[4], sb2[4];
#pragma unroll
      for (int r = 0; r < 4; ++r) { sa[r] = vnew[ma][r] * __expf(glast - ga4[r]); sb2[r] = vnew[mb][r] * __expf(glast - gb4[r]); }
      c2.w[0] = pack2(sa[0], sa[1]); c2.w[1] = pack2(sa[2], sa[3]);
      c2.w[2] = pack2(sb2[0], sb2[1]); c2.w[3] = pack2(sb2[2], sb2[3]);
      vb[k2] = c1.v; vsb[k2] = c2.v;
    }
    const float egl = __expf(glast);
#pragma unroll
    for (int d = 0; d < 8; ++d) {
      f32x4 a = S[d] * egl;
#pragma unroll
      for (int k2 = 0; k2 < 2; ++k2) {
        bf16x8 kf = *(const bf16x8*)(base + SC_KT + (d * 16 + fr) * SC_KP + k2 * 64 + fg * 16);
        a = __builtin_amdgcn_mfma_f32_16x16x32_bf16(kf, vsb[k2], a, 0, 0, 0);
      }
      S[d] = a;
    }
#pragma unroll
    for (int m = 0; m < 4; ++m) {
      f32x4 ao = ov[m];
#pragma unroll
      for (int k2 = 0; k2 < 2; ++k2) {
        bf16x8 af = *(const bf16x8*)(base + SC_AT + (m * 16 + fr) * SC_KP + k2 * 64 + fg * 16);
        ao = __builtin_amdgcn_mfma_f32_16x16x32_bf16(af, vb[k2], ao, 0, 0, 0);
      }
#pragma unroll
      for (int r = 0; r < 4; ++r) YDN[ub0 + (u32)((m * 16 + r) * 512)] = f2bf(ao[r]);
    }
    __syncthreads();
  }
#undef SCAN_LOAD
#undef SCAN_STORE
  asm volatile("s_waitcnt vmcnt(0)" ::: "memory");
  __syncthreads();
  {
    const int sub = lane >> 4, l16 = lane & 15;
    float gn8[8];
#pragma unroll
    for (int e = 0; e < 8; ++e) gn8[e] = ogain[l16 * 8 + e];
    for (int t = wave * 4 + sub; t < SEQ; t += 32) {
      const size_t tok = (size_t)b * SEQ + t;
      u16* yp = YDN + tok * 512 + h * 128 + l16 * 8;
      const u32x4 ov4 = *(const u32x4*)yp;
      const u32x4 zv4 = *(const u32x4*)(PROJ + tok * LDP + C_DZ + h * 128 + l16 * 8);
      float o8[8], z8[8];
#pragma unroll
      for (int c = 0; c < 4; ++c) { o8[2 * c] = bflo(ov4[c]); o8[2 * c + 1] = bfhi(ov4[c]); z8[2 * c] = bflo(zv4[c]); z8[2 * c + 1] = bfhi(zv4[c]); }
      float sq = 0.f;
#pragma unroll
      for (int e = 0; e < 8; ++e) sq += o8[e] * o8[e];
      sq += DPPF(sq, 0xb1); sq += DPPF(sq, 0x4e); sq += DPPF(sq, 0x141); sq += DPPF(sq, 0x140);
      const float rstd = rsqrtf(sq * (1.f / 128.f) + EPS);
      u32 w[4];
#pragma unroll
      for (int c = 0; c < 4; ++c) {
        const float y0 = o8[2 * c] * rstd * gn8[2 * c] * z8[2 * c] * sigmoidf_(z8[2 * c]);
        const float y1 = o8[2 * c + 1] * rstd * gn8[2 * c + 1] * z8[2 * c + 1] * sigmoidf_(z8[2 * c + 1]);
        w[c] = pack2(y0, y1);
      }
      *(u32x4*)yp = (u32x4){w[0], w[1], w[2], w[3]};
    }
  }
}

constexpr int AT_WAVE_BYTES = 8192 + 512 + 8192;
__device__ __forceinline__ float xor16_sum(float v) {
  auto r = __builtin_amdgcn_permlane16_swap(__float_as_uint(v), __float_as_uint(v), false, false);
  return __uint_as_float(r[0]) + __uint_as_float(r[1]);
}
__device__ __forceinline__ float xor32_sum(float v) {
  auto r = __builtin_amdgcn_permlane32_swap(__float_as_uint(v), __float_as_uint(v), false, false);
  return __uint_as_float(r[0]) + __uint_as_float(r[1]);
}
__device__ __forceinline__ void attn_query(const Params& p, unsigned char* wsm, int b, int t) {
  typedef long i64;
  typedef int i32x2 __attribute__((ext_vector_type(2)));
  typedef __attribute__((address_space(3))) i32x2 lds_i32x2;
  const u16* PROJ = (const u16*)(p.ws + OFF_PROJ);
  const u16* SEL = (const u16*)(p.ws + OFF_SEL);
  const unsigned char* KVC8 = p.ws + OFF_KVC;
  u16* YATT = (u16*)(p.ws + OFF_YATT);
  const int lane = TIDX & 63;
  const int fr = lane & 15, fg = lane >> 4;
  float* P = (float*)wsm;
  u16* sl = (u16*)(wsm + 8192);
  const size_t tokb = (size_t)b * SEQ;
  const size_t tok = tokb + t;
  const int nsel = min(256, t + 1);
  i64 qb[2][2];
  {
    const u16* qrow = PROJ + tok * LDP + C_AQ + (fr & 3) * 64 + fg * 8;
#pragma unroll
    for (int g = 0; g < 2; ++g)
#pragma unroll
      for (int kk = 0; kk < 2; ++kk) {
        const u32x4 v = *(const u32x4*)(qrow + g * 256 + kk * 32);
        const u32 lo = fp8x4(bflo(v[0]) * 16.f, bfhi(v[0]) * 16.f, bflo(v[1]) * 16.f, bfhi(v[1]) * 16.f);
        const u32 hi = fp8x4(bflo(v[2]) * 16.f, bfhi(v[2]) * 16.f, bflo(v[3]) * 16.f, bfhi(v[3]) * 16.f);
        const i64 w = (i64)(((unsigned long long)hi << 32) | (unsigned long long)lo);
        qb[g][kk] = (fr < 4) ? w : (i64)0;
      }
    const u16* sr = SEL + tok * 256;
#pragma unroll
    for (int i = 0; i < 4; ++i) sl[lane + 64 * i] = sr[lane + 64 * i];
  }
  WAVE_LDS_SYNC();
  const int ngrp = (nsel + 15) >> 4;
  const int nbq = (ngrp + 1) >> 1;
  unsigned char* KST = wsm + 8192 + 512;
  const int kq = lane >> 3, kch = lane & 7;
  u32x4 kA[2][2], kB[2][2];
#define QK_LOAD(buf_, bi_)                                                                       \
  _Pragma("unroll") for (int j = 0; j < 2; ++j)                                                  \
    _Pragma("unroll") for (int hf = 0; hf < 2; ++hf) {                                           \
      const int ki_ = min(((bi_) * 2 + j) * 16 + hf * 8 + kq, 255);                              \
      const int s_ = (int)sl[ki_] & 4095;                                                        \
      buf_[j][hf] = *(const u32x4*)(KVC8 + (tokb + s_) * 256 + kch * 16);                        \
    }
#define QK_COMPUTE(buf_, bi_)                                                                    \
  {                                                                                              \
    _Pragma("unroll") for (int j = 0; j < 2; ++j)                                                \
      _Pragma("unroll") for (int hf = 0; hf < 2; ++hf) {                                         \
        const int row_ = hf * 8 + kq;                                                            \
        *(u32x4*)(KST + j * 2048 + row_ * 128 + ((kch ^ (row_ & 7)) << 4)) = buf_[j][hf];        \
      }                                                                                          \
    WAVE_LDS_SYNC();                                                                             \
    _Pragma("unroll") for (int j = 0; j < 2; ++j) {                                              \
      const unsigned char* kr_ = KST + j * 2048 + fr * 128 + 8 * (fg & 1);                       \
      const int sw_ = fr & 7, ch_ = fg >> 1;                                                     \
      const i64 a00_ = *(const i64*)(kr_ + (((0 + ch_) ^ sw_) << 4));                            \
      const i64 a01_ = *(const i64*)(kr_ + (((2 + ch_) ^ sw_) << 4));                            \
      const i64 a10_ = *(const i64*)(kr_ + (((4 + ch_) ^ sw_) << 4));                            \
      const i64 a11_ = *(const i64*)(kr_ + (((6 + ch_) ^ sw_) << 4));                            \
      f32x4 c0_ = {0.f, 0.f, 0.f, 0.f}, c1_ = {0.f, 0.f, 0.f, 0.f};                              \
      c0_ = __builtin_amdgcn_mfma_f32_16x16x32_fp8_fp8(a00_, qb[0][0], c0_, 0, 0, 0);            \
      c0_ = __builtin_amdgcn_mfma_f32_16x16x32_fp8_fp8(a01_, qb[0][1], c0_, 0, 0, 0);            \
      c1_ = __builtin_amdgcn_mfma_f32_16x16x32_fp8_fp8(a10_, qb[1][0], c1_, 0, 0, 0);            \
      c1_ = __builtin_amdgcn_mfma_f32_16x16x32_fp8_fp8(a11_, qb[1][1], c1_, 0, 0, 0);            \
      if (fr < 4) {                                                                              \
        _Pragma("unroll") for (int r = 0; r < 4; ++r) {                                          \
          const int kk2_ = ((bi_) * 2 + j) * 16 + 4 * fg + r;                                    \
          if (kk2_ < 256) {                                                                      \
            const bool v_ = kk2_ < nsel;                                                         \
            P[kk2_ * 8 + fr] = v_ ? c0_[r] * 0.0625f : -1e30f;                                   \
            P[kk2_ * 8 + 4 + fr] = v_ ? c1_[r] * 0.0625f : -1e30f;                               \
          }                                                                                      \
        }                                                                                        \
      }                                                                                          \
    }                                                                                            \
    WAVE_LDS_SYNC();                                                                             \
  }
  QK_LOAD(kA, 0)
  for (int bi = 0; bi < nbq; bi += 2) {
    if (bi + 1 < nbq) { QK_LOAD(kB, bi + 1) }
    QK_COMPUTE(kA, bi)
    if (bi + 2 < nbq) { QK_LOAD(kA, bi + 2) }
    if (bi + 1 < nbq) { QK_COMPUTE(kB, bi + 1) }
  }
#undef QK_LOAD
#undef QK_COMPUTE
  for (int ki = nbq * 32 + lane; ki < 256; ki += 64) {
    *(f32x4*)(P + ki * 8) = (f32x4){-1e30f, -1e30f, -1e30f, -1e30f};
    *(f32x4*)(P + ki * 8 + 4) = (f32x4){-1e30f, -1e30f, -1e30f, -1e30f};
  }
  WAVE_LDS_SYNC();
  float inv8[8];
  {
    float lg[4][8];
#pragma unroll
    for (int i = 0; i < 4; ++i) {
      f32x4 x0 = *(const f32x4*)(P + (lane + 64 * i) * 8), x1 = *(const f32x4*)(P + (lane + 64 * i) * 8 + 4);
      lg[i][0] = x0[0]; lg[i][1] = x0[1]; lg[i][2] = x0[2]; lg[i][3] = x0[3];
      lg[i][4] = x1[0]; lg[i][5] = x1[1]; lg[i][6] = x1[2]; lg[i][7] = x1[3];
    }
    WAVE_LDS_SYNC();
    unsigned char* PT8 = (unsigned char*)P;
#pragma unroll
    for (int hh = 0; hh < 8; ++hh) {
      float m = fmaxf(fmaxf(lg[0][hh], lg[1][hh]), fmaxf(lg[2][hh], lg[3][hh]));
      m = wave_max_dpp(m);
      float e[4], sum = 0.f;
#pragma unroll
      for (int i = 0; i < 4; ++i) { e[i] = __expf(lg[i][hh] - m); sum += e[i]; }
      sum = wave_sum_dpp(sum);
      inv8[hh] = __builtin_amdgcn_rcpf(sum) * (1.f / 256.f);
      const u32 w = fp8x4(e[0] * 256.f, e[1] * 256.f, e[2] * 256.f, e[3] * 256.f);
#pragma unroll
      for (int i = 0; i < 4; ++i) PT8[hh * 256 + lane + 64 * i] = (unsigned char)((w >> (8 * i)) & 0xffu);
    }
  }
  WAVE_LDS_SYNC();
  {
    const unsigned char* PT8 = (const unsigned char*)P;
    unsigned char* VST = wsm + 8192 + 512;
    const int trow = (lane & 15) >> 1, thalf = lane & 1;
    f32x4 oacc[2][4];
#pragma unroll
    for (int g = 0; g < 2; ++g)
#pragma unroll
      for (int c = 0; c < 4; ++c) oacc[g][c] = (f32x4){0.f, 0.f, 0.f, 0.f};
    const int nks = (nsel + 31) >> 5;
    u32x4 vA[4], vB[4];
#define PV_LOAD(buf_, ks_)                                                                       \
  _Pragma("unroll") for (int i = 0; i < 4; ++i) {                                                \
    const int ki_ = min((ks_) * 32 + i * 8 + kq, 255);                                           \
    const int s_ = (int)sl[ki_] & 4095;                                                          \
    buf_[i] = *(const u32x4*)(KVC8 + (tokb + s_) * 256 + 128 + kch * 16);                        \
  }
#define PV_COMPUTE(buf_, ks_)                                                                    \
  {                                                                                              \
    _Pragma("unroll") for (int i = 0; i < 4; ++i) {                                              \
      const int key_ = i * 8 + kq;                                                               \
      *(u32x4*)(VST + key_ * 128 + ((kch ^ (key_ & 7)) << 4)) = buf_[i];                         \
    }                                                                                            \
    WAVE_LDS_SYNC();                                                                             \
    i64 pa_[2];                                                                                  \
    _Pragma("unroll") for (int g = 0; g < 2; ++g) {                                              \
      const i64 t_ = *(const i64*)(PT8 + (g * 4 + (fr & 3)) * 256 + (ks_) * 32 + 8 * fg);        \
      pa_[g] = (fr < 4) ? t_ : (i64)0;                                                           \
    }                                                                                            \
    const int r1_ = 8 * fg + trow;                                                               \
    _Pragma("unroll") for (int g = 0; g < 2; ++g)                                                \
      _Pragma("unroll") for (int c = 0; c < 4; ++c) {                                            \
        const i32x2 tv_ = __builtin_amdgcn_ds_read_tr8_b64_v2i32((lds_i32x2*)(VST + r1_ * 128 + (((g * 4 + c) ^ (r1_ & 7)) << 4) + 8 * thalf)); \
        const i64 vb_ = (i64)(((unsigned long long)(u32)tv_[1] << 32) | (unsigned long long)(u32)tv_[0]); \
        oacc[g][c] = __builtin_amdgcn_mfma_f32_16x16x32_fp8_fp8(pa_[g], vb_, oacc[g][c], 0, 0, 0); \
      }                                                                                          \
    WAVE_LDS_SYNC();                                                                             \
  }
    PV_LOAD(vA, 0)
    for (int ks = 0; ks < nks; ks += 2) {
      if (ks + 1 < nks) { PV_LOAD(vB, ks + 1) }
      PV_COMPUTE(vA, ks)
      if (ks + 2 < nks) { PV_LOAD(vA, ks + 2) }
      if (ks + 1 < nks) { PV_COMPUTE(vB, ks + 1) }
    }
#undef PV_LOAD
#undef PV_COMPUTE
    if (lane < 16) {
#pragma unroll
      for (int g = 0; g < 2; ++g)
#pragma unroll
        for (int c = 0; c < 4; ++c)
#pragma unroll
          for (int r = 0; r < 4; ++r)
            YATT[tok * 512 + (g * 4 + r) * 64 + 16 * c + fr] = f2bf(oacc[g][c][r] * inv8[g * 4 + r]);
    }
  }
  WAVE_LDS_SYNC();
}

__device__ __forceinline__ void phase3(const Params& p, unsigned char* smem) {
  const int wave = TIDX >> 6;
#ifndef NO_SCAN
  if (blockIdx.x < 32) {
    if (!(p.flags & 2)) dn_scan_item(p, smem, blockIdx.x);
    __syncthreads();
  }
#endif
#ifdef NO_ATTN
  return;
#endif
  if (p.flags & 4) return;
  unsigned* qctr = (unsigned*)(p.ws + 1024 + ((p.flags & 128) ? 4096 : 0));
  const unsigned xcc = (unsigned)__builtin_amdgcn_s_getreg((3 << 11) | 20) & 7u;
  unsigned char* wsm = smem + wave * AT_WAVE_BYTES;
  for (unsigned db = 0; db < 8; ++db) {
    const int bb = (int)((xcc + db) & 7u);
    for (;;) {
      unsigned qi = 0;
      if ((TIDX & 63) == 0) qi = __hip_atomic_fetch_add(qctr + bb * 16, 1u, __ATOMIC_RELAXED, __HIP_MEMORY_SCOPE_AGENT);
      qi = (unsigned)__builtin_amdgcn_readfirstlane((int)qi);
      if (qi >= (unsigned)SEQ) break;
      attn_query(p, wsm, bb, SEQ - 1 - (int)qi);
    }
  }
}

__device__ __forceinline__ void hblk_load(unsigned char* reg, const u16* __restrict__ src, u32 ob, u32 ld, int lane) {
  const int c16 = lane & 7, r8 = lane >> 3;
#pragma unroll
  for (int it = 0; it < 8; ++it) {
    const int rl = it * 8 + r8;
    const u32x4 v = *(const u32x4*)(src + ob + (u32)rl * ld + (u32)(c16 * 8));
    *(u32x4*)(reg + rl * 128 + (((c16 + 2 * ((rl >> 2) & 3)) & 7) << 4)) = v;
    if ((it & 3) == 3) __builtin_amdgcn_sched_barrier(0);
  }
}
__device__ __forceinline__ void hblk_store(const unsigned char* reg, u16* __restrict__ dst, u32 ob, u32 ld, int lane) {
  const int c16 = lane & 7, r8 = lane >> 3;
#pragma unroll
  for (int it = 0; it < 8; ++it) {
    const int rl = it * 8 + r8;
    const u32x4 v = *(const u32x4*)(reg + rl * 128 + (((c16 + 2 * ((rl >> 2) & 3)) & 7) << 4));
    *(u32x4*)(dst + ob + (u32)rl * ld + (u32)(c16 * 8)) = v;
  }
}
__device__ __forceinline__ void phase4(const Params& p, unsigned char* smem) {
  const u16* YATT = (const u16*)(p.ws + OFF_YATT);
  const u16* YDN = (const u16*)(p.ws + OFF_YDN);
  const u16* WTA = (const u16*)(p.ws + OFF_WTA);
  const u16* WTB = (const u16*)(p.ws + OFF_WTB);
  const u16* PROJ = (const u16*)(p.ws + OFF_PROJ);
  u16* MG = (u16*)(p.ws + OFF_MERGED);
  const int ntn = DM / 256, ntiles = (MTOK / 256) * ntn;
  for (int t = blockIdx.x; t < ntiles; t += gridDim.x) {
    const int m0 = (t / ntn) * 256, n0 = (t % ntn) * 256;
    f32x4 acc[2][2][4][2];
#pragma unroll
    for (int pass = 0; pass < 2; ++pass) {
      gemm8_tile(pass ? YDN : YATT, pass ? WTB : WTA, 512, m0, n0, smem, acc);
      int lane = TIDX & 63;
      asm volatile("" : "+v"(lane));
      const int wave = TIDX >> 6, wr = wave >> 2, wc = wave & 3, fr = lane & 15, fq = lane >> 4;
      unsigned char* regG = smem + wave * 16384;
      unsigned char* regT = regG + 8192;
      const int lrot = (fr >> 3) + 2 * fq;
      int off4[4];
#pragma unroll
      for (int jj = 0; jj < 4; ++jj) off4[jj] = (4 * fq) * 128 + (fr & 7) * 2 + (((jj * 2 + lrot) & 7) << 4);
#pragma unroll
      for (int ai = 0; ai < 2; ++ai) {
        const u32 gb0 = (u32)(m0 + ai * 128 + wr * 64) * LDP + (u32)(n0 + wc * 64) + (u32)(pass ? C_GB : C_GA);
        const u32 ob0 = (u32)(m0 + ai * 128 + wr * 64) * DM + (u32)(n0 + wc * 64);
        hblk_load(regG, PROJ, gb0, LDP, lane);
        if (pass == 1) hblk_load(regT, MG, ob0, DM, lane);
        WAVE_LDS_SYNC();
#pragma unroll
        for (int m = 0; m < 4; ++m)
#pragma unroll
          for (int r = 0; r < 4; ++r)
#pragma unroll
            for (int bj = 0; bj < 2; ++bj)
#pragma unroll
              for (int n = 0; n < 2; ++n) {
                const int o = off4[bj * 2 + n] + (m * 16 + r) * 128;
                float v = sigmoidf_(bf2f(*(const u16*)(regG + o))) * acc[ai][bj][m][n][r];
                if (pass == 1) v += bf2f(*(const u16*)(regT + o));
                *(u16*)(regT + o) = f2bf(v);
              }
        WAVE_LDS_SYNC();
        hblk_store(regT, MG, ob0, DM, lane);
        WAVE_LDS_SYNC();
      }
      asm volatile("s_waitcnt vmcnt(0)" ::: "memory");
    }
  }
}

__device__ __forceinline__ void phase5(const Params& p, unsigned char* smem) {
  const u16* MG = (const u16*)(p.ws + OFF_MERGED);
  const u16* WTO = (const u16*)(p.ws + OFF_WTO);
  const float* x = p.in[0];
  const int ntn = DM / 256, ntiles = (MTOK / 256) * ntn;
  for (int t = blockIdx.x; t < ntiles; t += gridDim.x) {
    const int m0 = (t / ntn) * 256, n0 = (t % ntn) * 256;
    f32x4 acc[2][2][4][2];
    gemm8_tile(MG, WTO, DM, m0, n0, smem, acc);
    const int tid_e = TIDX, lane = tid_e & 63, wave = tid_e >> 6;
    const int wr = wave >> 2, wc = wave & 3, fr = lane & 15, fq = lane >> 4;
    unsigned char* reg = smem + wave * 16384;
    const int c16 = lane & 15, r4 = lane >> 4;
    float* outp = p.out;
#pragma unroll
    for (int ai = 0; ai < 2; ++ai) {
#pragma unroll
      for (int m = 0; m < 4; ++m)
#pragma unroll
        for (int r = 0; r < 4; ++r)
#pragma unroll
          for (int bj = 0; bj < 2; ++bj)
#pragma unroll
            for (int n = 0; n < 2; ++n) {
              const int col = (bj * 2 + n) * 16 + fr, row = m * 16 + 4 * fq + r;
              *(float*)(reg + row * 256 + ((((col >> 2) + 4 * fq) & 15) << 4) + (col & 3) * 4) = acc[ai][bj][m][n][r];
            }
      WAVE_LDS_SYNC();
      const u32 ob = (u32)(m0 + ai * 128 + wr * 64) * DM + (u32)(n0 + wc * 64 + c16 * 4);
#pragma unroll
      for (int i4 = 0; i4 < 4; ++i4) {
        f32x4 xv[4];
#pragma unroll
        for (int k = 0; k < 4; ++k) xv[k] = *(const f32x4*)(x + ob + (u32)(((i4 * 4 + k) * 4 + r4) * DM));
#pragma unroll
        for (int k = 0; k < 4; ++k) {
          const int rw = (i4 * 4 + k) * 4 + r4;
          const f32x4 v = *(const f32x4*)(reg + rw * 256 + (((c16 + 4 * ((rw >> 2) & 3)) & 15) << 4));
          *(f32x4*)(outp + ob + (u32)(rw * DM)) = xv[k] + v;
        }
        __builtin_amdgcn_sched_barrier(0);
      }
      WAVE_LDS_SYNC();
    }
  }
}

__device__ __forceinline__ void phase6(const Params& p, unsigned char* smem) {
  const u16* H2 = (const u16*)(p.ws + OFF_H2);
  const u16* WTQ = (const u16*)(p.ws + OFF_WTQ);
  u16* QP = (u16*)(p.ws + OFF_QP);
  const int ntn = 2048 / 256, ntiles = (MTOK / 256) * ntn;
  for (int t = blockIdx.x; t < ntiles; t += gridDim.x) {
    const int m0 = (t / ntn) * 256, n0 = (t % ntn) * 256;
    f32x4 acc[2][2][4][2];
    gemm8_tile(H2, WTQ, DM, m0, n0, smem, acc);
    const int tid_e = TIDX, lane = tid_e & 63, wave = tid_e >> 6;
    const int wr = wave >> 2, wc = wave & 3;
    ep_store<2048, false>(QP, (u32)(m0 + wr * 64) * 2048 + (u32)(n0 + wc * 64), acc, nullptr, 1.f, smem, wave, lane);
  }
}

__device__ __forceinline__ int mono_key(float v) { int b = __float_as_int(v); return b ^ ((b >> 31) & 0x7fffffff); }
__device__ __forceinline__ float unmono_key(int k) { return __int_as_float(k ^ ((k >> 31) & 0x7fffffff)); }
__device__ __forceinline__ void chain16(int (&k)[16], int x) {
#pragma unroll
  for (int j = 0; j < 16; ++j) { int hi = max(k[j], x); x = min(k[j], x); k[j] = hi; }
}

#define CE_DESC(a, b) { const int hi_ = max(a, b), lo_ = min(a, b); a = hi_; b = lo_; }
__device__ __forceinline__ void sort16_desc(int (&k)[16]) {
#pragma unroll
  for (int size = 2; size <= 16; size <<= 1) {
#pragma unroll
    for (int stride = size >> 1; stride > 0; stride >>= 1) {
#pragma unroll
      for (int i = 0; i < 16; ++i) {
        const int l = i ^ stride;
        if (l > i) {
          if ((i & size) == 0) CE_DESC(k[i], k[l]) else CE_DESC(k[l], k[i])
        }
      }
    }
  }
}
__device__ __forceinline__ void merge_top16(int (&a)[16], const int (&b)[16]) {
#pragma unroll
  for (int i = 0; i < 16; ++i) a[i] = max(a[i], b[15 - i]);
#pragma unroll
  for (int stride = 8; stride > 0; stride >>= 1) {
#pragma unroll
    for (int i = 0; i < 16; ++i) {
      const int l = i ^ stride;
      if (l > i) CE_DESC(a[i], a[l])
    }
  }
}

constexpr int P7_LD = 132;
__device__ __forceinline__ void phase7(const Params& p, unsigned char* smem) {
  const u16* QP = (const u16*)(p.ws + OFF_QP);
  const u16* SKB = (const u16*)(p.ws + OFF_SKB);
  float* TOPS = (float*)(p.ws + OFF_TOPS);
  u8* TOPI = (u8*)(p.ws + OFF_TOPI);
  const int tid = TIDX, lane = tid & 63, wave = tid >> 6;
  const int wm = wave >> 1, wn = wave & 1, fr = lane & 15, fg = lane >> 4;
  const int ntiles = (MTOK / G_BM) * 16;
  float* tile = (float*)smem;
  for (int t = blockIdx.x; t < ntiles; t += gridDim.x) {
    const int m0 = (t >> 4) * G_BM, hp = t & 15;
    f32x4 acc[4][4];
    gemm_mainloop(QP + hp * 128, 2048, SKB + (size_t)hp * 128 * 128, 128, 128, m0, 0, smem, acc);
#pragma unroll
    for (int i = 0; i < 4; ++i)
#pragma unroll
      for (int j = 0; j < 4; ++j)
#pragma unroll
        for (int r = 0; r < 4; ++r) {
          int row = wm * 64 + i * 16 + 4 * fg + r, col = wn * 64 + j * 16 + fr;
          tile[row * P7_LD + col] = acc[i][j][r];
        }
    __syncthreads();
    {
      const int row = tid >> 1, half = tid & 1;
      int k[16];
      const float* rowp = tile + row * P7_LD + half * 64;
#pragma unroll
      for (int grp = 0; grp < 4; ++grp) {
        int gk[16];
#pragma unroll
        for (int c = 0; c < 16; c += 4) {
          f32x4 v = *(const f32x4*)(rowp + grp * 16 + c);
          const int ib = 127 - (half * 64 + grp * 16 + c);
          gk[c] = (mono_key(v[0]) & ~127) | ib;
          gk[c + 1] = (mono_key(v[1]) & ~127) | (ib - 1);
          gk[c + 2] = (mono_key(v[2]) & ~127) | (ib - 2);
          gk[c + 3] = (mono_key(v[3]) & ~127) | (ib - 3);
        }
        sort16_desc(gk);
        if (grp == 0) {
#pragma unroll
          for (int j = 0; j < 16; ++j) k[j] = gk[j];
        } else merge_top16(k, gk);
      }
      {
        int other[16];
#pragma unroll
        for (int j = 0; j < 16; ++j) other[j] = DPPI(k[j], 0xb1);
        merge_top16(k, other);
      }
      if (half == 0) {
        size_t o = ((size_t)(m0 + row) * 16 + hp) * 16;
        float vals[16]; int idx[16];
#pragma unroll
        for (int j = 0; j < 16; ++j) { idx[j] = 127 - (k[j] & 127); vals[j] = tile[row * P7_LD + idx[j]]; }
#pragma unroll
        for (int j = 0; j < 16; j += 4) *(f32x4*)(TOPS + o + j) = (f32x4){vals[j], vals[j + 1], vals[j + 2], vals[j + 3]};
#pragma unroll
        for (int j = 0; j < 16; j += 4)
          *(u32*)(TOPI + o + j) = (u32)idx[j] | ((u32)idx[j + 1] << 8) | ((u32)idx[j + 2] << 16) | ((u32)idx[j + 3] << 24);
      }
    }
    __syncthreads();
  }
}

__device__ __forceinline__ void phase7b(const Params& p) {
  const float* TOPS = (const float*)(p.ws + OFF_TOPS);
  const u8* TOPI = (const u8*)(p.ws + OFF_TOPI);
  int* EXPERT = (int*)(p.ws + OFF_EXPERT);
  float* GATE = (float*)(p.ws + OFF_GATE);
  for (int w = blockIdx.x * NTHREADS + TIDX; w < MTOK * 8; w += gridDim.x * NTHREADS) {
    const size_t o = (size_t)w * 32;
    float sa[16], sb[16];
#pragma unroll
    for (int k = 0; k < 16; k += 4) {
      float4 v = *(const float4*)(TOPS + o + k); sa[k] = v.x; sa[k + 1] = v.y; sa[k + 2] = v.z; sa[k + 3] = v.w;
      float4 u = *(const float4*)(TOPS + o + 16 + k); sb[k] = u.x; sb[k + 1] = u.y; sb[k + 2] = u.z; sb[k + 3] = u.w;
    }
    int cand[64];
#pragma unroll
    for (int k = 0; k < 64; ++k) cand[k] = (int)0x80000000;
    {
      int cnt = 0;
#pragma unroll
      for (int a = 0; a < 16; ++a)
#pragma unroll
        for (int bb = 0; bb < 16; ++bb)
          if ((a + 1) * (bb + 1) <= 16) { cand[cnt] = (mono_key(sa[a] + sb[bb]) & ~255) | (255 - (a * 16 + bb)); ++cnt; }
    }
    int kk[16];
#pragma unroll
    for (int grp = 0; grp < 4; ++grp) {
      int gk[16];
#pragma unroll
      for (int j = 0; j < 16; ++j) gk[j] = cand[grp * 16 + j];
      sort16_desc(gk);
      if (grp == 0) {
#pragma unroll
        for (int j = 0; j < 16; ++j) kk[j] = gk[j];
      } else merge_top16(kk, gk);
    }
    float vals[16];
#pragma unroll
    for (int k = 0; k < 16; ++k) vals[k] = unmono_key(kk[k] & ~255);
    float m = vals[0], s = 0.f, e[16];
#pragma unroll
    for (int k = 0; k < 16; ++k) { e[k] = __expf(vals[k] - m); s += e[k]; }
    float inv = 1.f / s;
    const u32x4 ia = *(const u32x4*)(TOPI + o), ib = *(const u32x4*)(TOPI + o + 16);
    int exv[16];
#pragma unroll
    for (int k = 0; k < 16; ++k) {
      const int ci = 255 - (kk[k] & 255);
      const int a = ci >> 4, bb = ci & 15;
      const u32 wa = (a < 8) ? ((a < 4) ? ia[0] : ia[1]) : ((a < 12) ? ia[2] : ia[3]);
      const u32 wb = (bb < 8) ? ((bb < 4) ? ib[0] : ib[1]) : ((bb < 12) ? ib[2] : ib[3]);
      exv[k] = (int)((wa >> ((a & 3) * 8)) & 255u) * 128 + (int)((wb >> ((bb & 3) * 8)) & 255u);
    }
#pragma unroll
    for (int k = 0; k < 16; k += 4) {
      *(u32x4*)(EXPERT + (size_t)w * 16 + k) = (u32x4){(u32)exv[k], (u32)exv[k + 1], (u32)exv[k + 2], (u32)exv[k + 3]};
      *(f32x4*)(GATE + (size_t)w * 16 + k) = (f32x4){e[k] * inv, e[k + 1] * inv, e[k + 2] * inv, e[k + 3] * inv};
    }
  }
  {
    const int lane = TIDX & 63, wave = TIDX >> 6;
    for (int row = blockIdx.x * 8 + wave; row < 2 * 16384; row += gridDim.x * 8) {
      const int tbl = row >> 14, r = row & 16383;
      const f32x4* src = (const f32x4*)((tbl ? p.in[16] : p.in[15]) + (size_t)r * DM) + lane;
      f32x4 x[4];
      float amax = 0.f;
#pragma unroll
      for (int i = 0; i < 4; ++i) {
        x[i] = src[64 * i];
        amax = fmaxf(amax, fmaxf(fmaxf(fabsf(x[i][0]), fabsf(x[i][1])), fmaxf(fabsf(x[i][2]), fabsf(x[i][3]))));
      }
      amax = wave_max_dpp(amax);
      const float inv = amax > 0.f ? 127.f / amax : 0.f;
      const int bias = 0;
      u32x4 o;
#pragma unroll
      for (int i = 0; i < 4; ++i) {
        int q0 = (int)rintf(x[i][0] * inv) + bias, q1 = (int)rintf(x[i][1] * inv) + bias;
        int q2 = (int)rintf(x[i][2] * inv) + bias, q3 = (int)rintf(x[i][3] * inv) + bias;
        o[i] = (u32)(q0 & 0xff) | ((u32)(q1 & 0xff) << 8) | ((u32)(q2 & 0xff) << 16) | ((u32)(q3 & 0xff) << 24);
      }
#pragma unroll
      for (int i = 0; i < 4; ++i)
        *(u32*)(p.ws + (tbl ? OFF_VQ : OFF_UQ) + ((size_t)(2 * i + (lane >> 5)) * 16384 + r) * 128 + (lane & 31) * 4) = o[i];
      if (lane == 0) ((float*)(p.ws + (tbl ? OFF_VS : OFF_US)))[r] = amax * (1.f / 127.f);
    }
  }
}

__device__ __forceinline__ void phase8a(const Params& p) {
  const int* EXPERT = (const int*)(p.ws + OFF_EXPERT);
  const unsigned char* UQS = p.ws + OFF_UQ;
  const unsigned char* H2Q = p.ws + OFF_H2Q;
  int* PD = (int*)(p.ws + OFF_PD);
  unsigned* ctr = (unsigned*)(p.ws + 2048 + ((p.flags & 128) ? 4096 : 0));
  const unsigned xcc = (unsigned)__builtin_amdgcn_s_getreg((3 << 11) | 20) & 7u;
  const int lane = TIDX & 63, g8 = lane >> 3, l8 = lane & 7;
  for (unsigned db = 0; db < 8; ++db) {
    const int x = (int)((xcc + db) & 7u);
    for (;;) {
      unsigned ci = 0;
      if (lane == 0) ci = __hip_atomic_fetch_add(ctr + x * 16, 1u, __ATOMIC_RELAXED, __HIP_MEMORY_SCOPE_AGENT);
      ci = (unsigned)__builtin_amdgcn_readfirstlane((int)ci);
      if (ci >= (unsigned)(MTOK / 16)) break;
#pragma unroll 1
      for (int tt = 0; tt < 16; ++tt) {
        const int tok = (int)ci * 16 + tt;
        const int e0 = EXPERT[(size_t)tok * 128 + lane], e1 = EXPERT[(size_t)tok * 128 + 64 + lane];
        const u32x4 hq = *(const u32x4*)(H2Q + (size_t)tok * DM + x * 128 + l8 * 16);
        u32x4 ua[16];
#pragma unroll
        for (int i = 0; i < 16; ++i) {
          const int k = i * 8 + g8;
          const int ek = __shfl(i < 8 ? e0 : e1, k & 63);
          ua[i] = *(const u32x4*)(UQS + ((size_t)(x * 16384 + ek)) * 128 + l8 * 16);
        }
        int keep0 = 0, keep1 = 0;
#pragma unroll
        for (int i = 0; i < 16; ++i) {
          int sd = 0;
#pragma unroll
          for (int c = 0; c < 4; ++c) sd = __builtin_amdgcn_sdot4((int)ua[i][c], (int)hq[c], sd, false);
          sd += DPPI(sd, 0xb1); sd += DPPI(sd, 0x4e); sd += DPPI(sd, 0x141);
          if (i < 8) keep0 = (l8 == (i & 7)) ? sd : keep0; else keep1 = (l8 == (i & 7)) ? sd : keep1;
        }
        int* pd = PD + ((size_t)x * MTOK + tok) * 128 + l8 * 8 + g8;
        pd[0] = keep0; pd[64] = keep1;
      }
    }
  }
}

__device__ __forceinline__ void phase8c(const Params& p) {
  const int* EXPERT = (const int*)(p.ws + OFF_EXPERT);
  const float* GATE = (const float*)(p.ws + OFF_GATE);
  const float* US = (const float*)(p.ws + OFF_US);
  const float* VS = (const float*)(p.ws + OFF_VS);
  const float* HS = (const float*)(p.ws + OFF_HS);
  const int* PD = (const int*)(p.ws + OFF_PD);
  unsigned char* CQ8 = p.ws + OFF_CQ8;
  float* QSC = (float*)(p.ws + OFF_QSC);
  const int lane = TIDX & 63, wave = TIDX >> 6;
  for (int tok = blockIdx.x * 8 + wave; tok < MTOK; tok += gridDim.x * 8) {
    const int e0 = EXPERT[(size_t)tok * 128 + lane], e1 = EXPERT[(size_t)tok * 128 + 64 + lane];
    const float g0 = GATE[(size_t)tok * 128 + lane], g1 = GATE[(size_t)tok * 128 + 64 + lane];
    int s0 = 0, s1 = 0;
#pragma unroll
    for (int xx = 0; xx < 8; ++xx) {
      s0 += PD[((size_t)xx * MTOK + tok) * 128 + lane];
      s1 += PD[((size_t)xx * MTOK + tok) * 128 + 64 + lane];
    }
    const float hs = HS[tok];
    const float d0 = (float)s0 * US[e0] * hs, d1 = (float)s1 * US[e1] * hs;
    const float cf0 = g0 * 0.5f * d0 * (1.f + erff(d0 * 0.70710678118654752f)) * VS[e0];
    const float cf1 = g1 * 0.5f * d1 * (1.f + erff(d1 * 0.70710678118654752f)) * VS[e1];
    const float cmax = wave_max_dpp(fmaxf(fabsf(cf0), fabsf(cf1)));
    const float qinv = cmax > 0.f ? 32639.f / cmax : 0.f;
    const int c0 = (int)rintf(cf0 * qinv), c1 = (int)rintf(cf1 * qinv);
    const int h0 = (c0 + 128) >> 8, h1 = (c1 + 128) >> 8;
    unsigned char* cq = CQ8 + (size_t)tok * 256;
    cq[lane] = (unsigned char)(h0 & 0xff); cq[64 + lane] = (unsigned char)(h1 & 0xff);
    cq[128 + lane] = (unsigned char)((c0 - 256 * h0) & 0xff); cq[192 + lane] = (unsigned char)((c1 - 256 * h1) & 0xff);
    if (lane == 0) QSC[tok] = cmax * (1.f / 32639.f);
  }
}

#ifndef TR8_VARIANT
#define TR8_VARIANT 0
#endif
__device__ __forceinline__ void phase8b(const Params& p, unsigned char* smem) {
  typedef int i32x4 __attribute__((ext_vector_type(4)));
  typedef int i32x2 __attribute__((ext_vector_type(2)));
  typedef __attribute__((address_space(3))) i32x2 lds_i32x2;
  const int* EXPERT = (const int*)(p.ws + OFF_EXPERT);
  const unsigned char* VQS = p.ws + OFF_VQ;
  const unsigned char* CQ8 = p.ws + OFF_CQ8;
  const float* QSC = (const float*)(p.ws + OFF_QSC);
  unsigned* ctr = (unsigned*)(p.ws + 3072 + ((p.flags & 128) ? 4096 : 0));
  const unsigned xcc = (unsigned)__builtin_amdgcn_s_getreg((3 << 11) | 20) & 7u;
  const int lane = TIDX & 63, wave = TIDX >> 6, g8 = lane >> 3, l8 = lane & 7;
  const int fr = lane & 15, fg = lane >> 4;
  unsigned char* VST = smem + wave * 16384;
#if TR8_VARIANT == 0
  const int trow = (lane & 15) >> 1, thalf = lane & 1;
#else
  const int trow = lane & 7, thalf = (lane & 15) >> 3;
#endif
  __syncthreads();
  for (unsigned db = 0; db < 8; ++db) {
    const int x = (int)((xcc + db) & 7u);
    for (;;) {
      unsigned ci = 0;
      if (lane == 0) ci = __hip_atomic_fetch_add(ctr + x * 16, 1u, __ATOMIC_RELAXED, __HIP_MEMORY_SCOPE_AGENT);
      ci = (unsigned)__builtin_amdgcn_readfirstlane((int)ci);
      if (ci >= (unsigned)(MTOK / 16)) break;
#pragma unroll 1
      for (int tt = 0; tt < 16; ++tt) {
        const int tok = (int)ci * 16 + tt;
        const int e0 = EXPERT[(size_t)tok * 128 + lane], e1 = EXPERT[(size_t)tok * 128 + 64 + lane];
        f32x4 oldv = {0.f, 0.f, 0.f, 0.f};
        if (lane < 32) oldv = *(const f32x4*)(p.out + (size_t)tok * DM + x * 128 + lane * 4);
        u32x4 va[16];
#pragma unroll
        for (int i = 0; i < 16; ++i) {
          const int k = i * 8 + g8;
          const int ek = __shfl(i < 8 ? e0 : e1, k & 63);
          va[i] = *(const u32x4*)(VQS + ((size_t)(x * 16384 + ek)) * 128 + l8 * 16);
        }
        i32x4 af[2];
#pragma unroll
        for (int sx = 0; sx < 2; ++sx) {
          af[sx] = *(const i32x4*)(CQ8 + (size_t)tok * 256 + (fr & 1) * 128 + sx * 64 + fg * 16);
          if (fr >= 2) af[sx] = (i32x4){0, 0, 0, 0};
        }
        const float qsc = QSC[tok];
#pragma unroll
        for (int i = 0; i < 16; ++i) {
          const int k = i * 8 + g8;
          *(u32x4*)(VST + k * 128 + ((l8 ^ g8) << 4)) = va[i];
        }
        WAVE_LDS_SYNC();
        i32x4 acc[8];
#pragma unroll
        for (int c = 0; c < 8; ++c) acc[c] = (i32x4){0, 0, 0, 0};
#pragma unroll
        for (int sx = 0; sx < 2; ++sx) {
          const int r1 = sx * 64 + fg * 16 + trow, r2 = r1 + 8;
#pragma unroll
          for (int c = 0; c < 8; ++c) {
            const i32x2 lo = __builtin_amdgcn_ds_read_tr8_b64_v2i32((lds_i32x2*)(VST + r1 * 128 + ((c ^ (r1 & 7)) << 4) + 8 * thalf));
            const i32x2 hi = __builtin_amdgcn_ds_read_tr8_b64_v2i32((lds_i32x2*)(VST + r2 * 128 + ((c ^ (r2 & 7)) << 4) + 8 * thalf));
            const i32x4 bf = {lo[0], lo[1], hi[0], hi[1]};
            acc[c] = __builtin_amdgcn_mfma_i32_16x16x64_i8(af[sx], bf, acc[c], 0, 0, 0);
          }
        }
        WAVE_LDS_SYNC();
        float* ost = (float*)VST;
        if (lane < 16) {
#pragma unroll
          for (int c = 0; c < 8; ++c) ost[16 * c + fr] = ((float)acc[c][0] * 256.f + (float)acc[c][1]) * qsc;
        }
        WAVE_LDS_SYNC();
        if (lane < 32 && !(p.flags & 32))
          *(f32x4*)(p.out + (size_t)tok * DM + x * 128 + lane * 4) = oldv + *(const f32x4*)(ost + lane * 4);
        WAVE_LDS_SYNC();
      }
    }
  }
}

__device__ __forceinline__ void grid_barrier(unsigned* ctr, unsigned nb) {
  asm volatile("s_waitcnt vmcnt(0)" ::: "memory");
  __syncthreads();
  if (TIDX == 0) {
    const unsigned ng = (gridDim.x & 7u) ? 1u : 8u, gsize = gridDim.x / ng;
    __builtin_amdgcn_fence(__ATOMIC_RELEASE, "agent");
    asm volatile("s_waitcnt vmcnt(0)" ::: "memory");
    unsigned* gctr = ctr + 32 + (blockIdx.x & (ng - 1u)) * 16;
    const unsigned old = __hip_atomic_fetch_add(gctr, 1u, __ATOMIC_RELAXED, __HIP_MEMORY_SCOPE_AGENT);
    if (old + 1u == gsize * nb) __hip_atomic_fetch_add(ctr, 1u, __ATOMIC_RELAXED, __HIP_MEMORY_SCOPE_AGENT);
    while (__hip_atomic_load(ctr, __ATOMIC_RELAXED, __HIP_MEMORY_SCOPE_AGENT) < ng * nb) __builtin_amdgcn_s_sleep(1);
    __builtin_amdgcn_fence(__ATOMIC_ACQUIRE, "agent");
    asm volatile("s_waitcnt vmcnt(0)" ::: "memory");
  }
  __syncthreads();
}

__global__ void __launch_bounds__(NTHREADS, 2) mk_fwd(Params p) {
  cg::grid_group grid = cg::this_grid();
  __shared__ __attribute__((aligned(16))) unsigned char smem[SMEM_BYTES];
  const int lo = p.ph_lo, hi = p.ph_hi;
#define RUN(k, call) if (lo <= (k) && (k) < hi) { call; if ((k) + 1 < hi) { if ((k) == 0) grid.sync(); else grid_barrier((unsigned*)p.ws, (unsigned)(lo == 0 ? (k) : (k) - lo + 1)); } }
  RUN(0, phase0(p, smem))
  RUN(1, phase1(p, smem))
  RUN(2, phase2(p, smem))
  RUN(3, phase3(p, smem))
  RUN(4, phase4(p, smem))
  RUN(5, phase5(p, smem))
  RUN(6, rmsnorm_rows<true>(p.out, p.in[12], (u16*)(p.ws + OFF_H2), p.ws + OFF_H2Q, (float*)(p.ws + OFF_HS)))
  RUN(7, phase6(p, smem))
  RUN(8, phase7(p, smem))
  RUN(9, phase7b(p))
  RUN(10, phase8a(p))
  RUN(11, phase8c(p))
  RUN(12, phase8b(p, smem))
#undef RUN
}

extern "C" void kernel_launch(void* const* d_in, const int* in_sizes, int n_in,
                              void* d_out, int out_size, void* d_ws, size_t ws_size,
                              hipStream_t stream) {
  static int grid_blocks = 0;
  if (!grid_blocks) {
    int dev = 0, cus = 0, per_cu = 0;
    (void)hipGetDevice(&dev);
    (void)hipDeviceGetAttribute(&cus, hipDeviceAttributeMultiprocessorCount, dev);
    (void)hipOccupancyMaxActiveBlocksPerMultiprocessor(&per_cu, mk_fwd, NTHREADS, 0);
    if (per_cu < 1) per_cu = 1;
    if (per_cu > 1) per_cu = 1;
    grid_blocks = cus * per_cu;
    fprintf(stderr, "mk_fwd: cus=%d per_cu=%d grid=%d ws=%zu\n", cus, per_cu, grid_blocks, ws_size);
  }
  Params p{};
  for (int i = 0; i < 17 && i < n_in; ++i) p.in[i] = (const float*)d_in[i];
  p.out = (float*)d_out;
  p.ws = (unsigned char*)d_ws;
  p.ph_lo = 0; p.ph_hi = 13;
  (void)hipMemsetAsync(d_ws, 0, 8192, stream);
  void* args[] = {&p};
  hipError_t e = hipLaunchCooperativeKernel((void*)mk_fwd, dim3(grid_blocks), dim3(NTHREADS), args, 0, stream);
  if (e != hipSuccess) fprintf(stderr, "cooperative launch failed: %s (grid %d)\n", hipGetErrorString(e), grid_blocks);
#ifdef EXTRA_LO
  {
    Params p2 = p;
    p2.ph_lo = EXTRA_LO; p2.ph_hi = EXTRA_HI; p2.flags = EXTRA_FLAGS;
    void* args2[] = {&p2};
    (void)hipLaunchCooperativeKernel((void*)mk_fwd, dim3(grid_blocks), dim3(NTHREADS), args2, 0, stream);
  }
#endif
}
```

```cpp
#include <hip/hip_runtime.h>
#include <hip/hip_bf16.h>
#include <hip/hip_cooperative_groups.h>
#include <cstdio>
#include <cstdint>
namespace cg = cooperative_groups;

typedef unsigned short u16;
typedef unsigned int u32;
typedef unsigned char u8;
typedef short bf16x8 __attribute__((ext_vector_type(8)));
typedef float f32x4 __attribute__((ext_vector_type(4)));
typedef unsigned int u32x4 __attribute__((ext_vector_type(4)));
typedef unsigned int u32x2 __attribute__((ext_vector_type(2)));

constexpr int NTHREADS = 512;
constexpr int BATCH = 8, SEQ = 4096, DM = 1024, MTOK = BATCH * SEQ;
constexpr int LDP = 3072;
constexpr int NPROJ = 5120;
constexpr int NPADW = 5632;
constexpr int C_AQ = 0, C_IQ = 512, C_DQ = 1024, C_DK = 1536, C_DV = 2048, C_DZ = 2560, C_GA = 3072, C_GB = 4096;
constexpr int N_AK = 5120, N_AV = 5248, N_IK = 5376, N_SM = 5440;
constexpr size_t MiB = 1ull << 20;
constexpr size_t OFF_WTIN = 1 * MiB, OFF_WTA = 12 * MiB, OFF_WTB = 13 * MiB, OFF_WTO = 14 * MiB, OFF_WTQ = 16 * MiB,
                 OFF_SKB = 20 * MiB, OFF_SMALL = 21 * MiB, OFF_H = 23 * MiB, OFF_ATT = 23 * MiB, OFF_GC = 39 * MiB,
                 OFF_MERGED = 23 * MiB, OFF_PROJ = 87 * MiB, OFF_KVC = 407 * MiB, OFF_IKC = 423 * MiB, OFF_SEL = 427 * MiB, OFF_YATT = 443 * MiB,
                 OFF_YDN = 475 * MiB;
constexpr size_t OFF_H2 = OFF_PROJ, OFF_QP = OFF_PROJ + 64 * MiB, OFF_TOPS = OFF_PROJ + 192 * MiB,
                 OFF_TOPI = OFF_PROJ + 224 * MiB, OFF_EXPERT = OFF_PROJ + 232 * MiB, OFF_GATE = OFF_PROJ + 248 * MiB;
constexpr size_t OFF_UQ = OFF_PROJ + 264 * MiB, OFF_VQ = OFF_PROJ + 280 * MiB, OFF_US = OFF_PROJ + 296 * MiB, OFF_VS = OFF_PROJ + 297 * MiB;
constexpr size_t OFF_CQ8 = 56 * MiB, OFF_QSC = 64 * MiB;
constexpr size_t OFF_H2Q = 23 * MiB, OFF_HS = 55 * MiB, OFF_PD = OFF_PROJ + 64 * MiB;
constexpr size_t OFF_YATT8 = OFF_YATT, OFF_YDN8 = OFF_YATT + 16 * MiB;
constexpr size_t OFF_GATE8 = OFF_PROJ + 192 * MiB;
constexpr size_t OFF_IQF = 55 * MiB;
constexpr size_t OFF_PART8 = OFF_KVC;
constexpr size_t DO_U = 0, DO_W = 32 * MiB, DO_QN = 64 * MiB, DO_KNT = 96 * MiB;

constexpr int SMEM_BYTES = 162816;
constexpr float EPS = 1e-6f;

struct Params {
  const float* in[17];
  float* out;
  unsigned char* ws;
  int ph_lo, ph_hi;
  int flags, pad;
};

typedef __bf16 bf16x2_t __attribute__((ext_vector_type(2)));
typedef float f32x2_t __attribute__((ext_vector_type(2)));
__device__ __forceinline__ u32 pack2(float a, float b) {
  f32x2_t f = {a, b};
  return __builtin_bit_cast(u32, __builtin_convertvector(f, bf16x2_t));
}
__device__ __forceinline__ u16 f2bf(float f) { return (u16)(pack2(f, f) & 0xffffu); }
__device__ __forceinline__ float bf2f(u16 h) { return __uint_as_float(((u32)h) << 16); }
__device__ __forceinline__ float bflo(u32 w) { return __uint_as_float(w << 16); }
__device__ __forceinline__ float bfhi(u32 w) { return __uint_as_float(w & 0xffff0000u); }
__device__ __forceinline__ float wave_sum(float v) {
#pragma unroll
  for (int o = 32; o > 0; o >>= 1) v += __shfl_xor(v, o);
  return v;
}
__device__ __forceinline__ float wave_max(float v) {
#pragma unroll
  for (int o = 32; o > 0; o >>= 1) v = fmaxf(v, __shfl_xor(v, o));
  return v;
}
__device__ __forceinline__ float dot2bf(u32 a, u32 b, float acc) {
  return __builtin_amdgcn_fdot2_f32_bf16(__builtin_bit_cast(bf16x2_t, a), __builtin_bit_cast(bf16x2_t, b), acc, false);
}
#define DPPF(v, ctrl) __int_as_float(__builtin_amdgcn_update_dpp(0, __float_as_int(v), ctrl, 0xf, 0xf, true))
__device__ __forceinline__ float wave_sum_dpp(float v) {
  v += DPPF(v, 0xb1);
  v += DPPF(v, 0x4e);
  v += DPPF(v, 0x124);
  v += DPPF(v, 0x128);
  float r0 = __int_as_float(__builtin_amdgcn_readlane(__float_as_int(v), 0));
  float r1 = __int_as_float(__builtin_amdgcn_readlane(__float_as_int(v), 16));
  float r2 = __int_as_float(__builtin_amdgcn_readlane(__float_as_int(v), 32));
  float r3 = __int_as_float(__builtin_amdgcn_readlane(__float_as_int(v), 48));
  return (r0 + r1) + (r2 + r3);
}
__device__ __forceinline__ int opaque_tid() { int t = threadIdx.x; asm volatile("" : "+v"(t)); return t; }
#define TIDX opaque_tid()
#define DPPI(v, ctrl) __builtin_amdgcn_update_dpp(0, (v), ctrl, 0xf, 0xf, true)
__device__ __forceinline__ int wave_sum_i_dpp(int v) {
  v += DPPI(v, 0xb1);
  v += DPPI(v, 0x4e);
  v += DPPI(v, 0x124);
  v += DPPI(v, 0x128);
  return (__builtin_amdgcn_readlane(v, 0) + __builtin_amdgcn_readlane(v, 16)) +
         (__builtin_amdgcn_readlane(v, 32) + __builtin_amdgcn_readlane(v, 48));
}
__device__ __forceinline__ float wave_max_dpp(float v) {
  v = fmaxf(v, DPPF(v, 0xb1));
  v = fmaxf(v, DPPF(v, 0x4e));
  v = fmaxf(v, DPPF(v, 0x124));
  v = fmaxf(v, DPPF(v, 0x128));
  float r0 = __int_as_float(__builtin_amdgcn_readlane(__float_as_int(v), 0));
  float r1 = __int_as_float(__builtin_amdgcn_readlane(__float_as_int(v), 16));
  float r2 = __int_as_float(__builtin_amdgcn_readlane(__float_as_int(v), 32));
  float r3 = __int_as_float(__builtin_amdgcn_readlane(__float_as_int(v), 48));
  return fmaxf(fmaxf(r0, r1), fmaxf(r2, r3));
}
#define WAVE_LDS_SYNC() asm volatile("s_waitcnt lgkmcnt(0)" ::: "memory")
__device__ __forceinline__ float sigmoidf_(float x) { return __builtin_amdgcn_rcpf(1.f + __expf(-x)); }
__device__ __forceinline__ int perm32(int k) {
  int blk = k & ~31, r = k & 31;
  int p = (r < 16) ? (8 * (r >> 2) + (r & 3)) : (8 * ((r - 16) >> 2) + 4 + (r & 3));
  return blk + p;
}

__device__ __forceinline__ u32 fp8x4(float a, float b, float c, float d) {
  int w = __builtin_amdgcn_cvt_pk_fp8_f32(a, b, 0, false);
  w = __builtin_amdgcn_cvt_pk_fp8_f32(c, d, w, true);
  return (u32)w;
}
__device__ __forceinline__ int g8_logical_col(int t) { return ((t & 127) >> 5) * 64 + (t & 15) * 4 + (t >> 7) * 2 + ((t >> 4) & 1); }
__device__ __forceinline__ int win_map(int n) {
  if (n < 512) return n;
  if (n < 1024) return 768 + (n - 512);
  if (n < 3072) return 1352 + (n - 1024);
  if (n < 5120) return 3408 + (n - 3072);
  if (n < 5248) return 512 + (n - 5120);
  if (n < 5376) return 640 + (n - 5248);
  if (n < 5440) return 1280 + (n - 5376);
  if (n < 5448) return 1344 + (n - 5440);
  if (n < 5452) return 3400 + (n - 5448);
  if (n < 5456) return 3404 + (n - 5452);
  return -1;
}
__device__ __forceinline__ void transpose_tile(const float* __restrict__ src, int Nsrc, u16* __restrict__ dst, int K, int k0, int n0,
                               bool mapped, bool perm8, float* tile  , float f8scale = 0.f) {
  const int tid = TIDX;
  {
    const int tx = tid & 63, ty = tid >> 6;
    int n = n0 + tx;
    if (perm8) n = (n & ~255) + g8_logical_col(n & 255);
    int sc = mapped ? win_map(n) : n;
#pragma unroll
    for (int i = 0; i < 8; ++i) {
      int k = ty + 8 * i;
      float v = (sc >= 0) ? src[(size_t)(k0 + k) * Nsrc + sc] : 0.f;
      tile[k * 65 + tx] = v;
    }
  }
  __syncthreads();
  {
    const int n = tid >> 3, kc = (tid & 7) * 8;
    if (f8scale != 0.f) {
      u32 w[2];
#pragma unroll
      for (int j = 0; j < 2; ++j)
        w[j] = fp8x4(tile[(kc + 4 * j) * 65 + n] * f8scale, tile[(kc + 4 * j + 1) * 65 + n] * f8scale,
                     tile[(kc + 4 * j + 2) * 65 + n] * f8scale, tile[(kc + 4 * j + 3) * 65 + n] * f8scale);
      *(uint2*)((unsigned char*)dst + (size_t)(n0 + n) * K + k0 + kc) = make_uint2(w[0], w[1]);
    } else {
    u32 w[4];
#pragma unroll
    for (int j = 0; j < 4; ++j) w[j] = pack2(tile[(kc + 2 * j) * 65 + n], tile[(kc + 2 * j + 1) * 65 + n]);
    *(uint4*)(dst + (size_t)(n0 + n) * K + k0 + kc) = make_uint4(w[0], w[1], w[2], w[3]);
    }
  }
  __syncthreads();
}

template <bool Q8, bool F8OUT = false>
__device__ __forceinline__ void rmsnorm_rows(const float* __restrict__ x, const float* __restrict__ gain, u16* __restrict__ out,
                                             unsigned char* __restrict__ q8, float* __restrict__ qs) {
  const int lane = TIDX & 63, wave = TIDX >> 6;
  float4 g[4];
#pragma unroll
  for (int i = 0; i < 4; ++i) g[i] = ((const float4*)gain)[lane + 64 * i];
  for (int row = blockIdx.x * 8 + wave; row < MTOK; row += gridDim.x * 8) {
    const float4* xr = (const float4*)(x + (size_t)row * DM);
    float4 v[4];
    float ss = 0.f;
#pragma unroll
    for (int i = 0; i < 4; ++i) {
      v[i] = xr[lane + 64 * i];
      ss += v[i].x * v[i].x + v[i].y * v[i].y + v[i].z * v[i].z + v[i].w * v[i].w;
    }
    ss = wave_sum_dpp(ss);
    float r = rsqrtf(ss * (1.f / DM) + EPS);
    float amax = 0.f;
#pragma unroll
    for (int i = 0; i < 4; ++i) {
      v[i].x *= r * g[i].x; v[i].y *= r * g[i].y; v[i].z *= r * g[i].z; v[i].w *= r * g[i].w;
      if (F8OUT) {
        *(u32*)((unsigned char*)out + (size_t)row * DM + 4 * (lane + 64 * i)) = fp8x4(2.f * v[i].x, 2.f * v[i].y, 2.f * v[i].z, 2.f * v[i].w);
      } else {
        uint2 o;
        o.x = pack2(v[i].x, v[i].y);
        o.y = pack2(v[i].z, v[i].w);
        *(uint2*)(out + (size_t)row * DM + 4 * (lane + 64 * i)) = o;
      }
      if (Q8) amax = fmaxf(amax, fmaxf(fmaxf(fabsf(v[i].x), fabsf(v[i].y)), fmaxf(fabsf(v[i].z), fabsf(v[i].w))));
    }
    if (Q8) {
      amax = wave_max_dpp(amax);
      const float inv = amax > 0.f ? 127.f / amax : 0.f;
#pragma unroll
      for (int i = 0; i < 4; ++i) {
        const int q0 = (int)rintf(v[i].x * inv), q1 = (int)rintf(v[i].y * inv), q2 = (int)rintf(v[i].z * inv), q3 = (int)rintf(v[i].w * inv);
        *(u32*)(q8 + (size_t)row * DM + 4 * (lane + 64 * i)) =
            (u32)(q0 & 0xff) | ((u32)(q1 & 0xff) << 8) | ((u32)(q2 & 0xff) << 16) | ((u32)(q3 & 0xff) << 24);
      }
      if (lane == 0) qs[row] = amax * (1.f / 127.f);
    }
  }
}

__device__ __forceinline__ void phase0(const Params& p, unsigned char* smem) {
  float* tile = (float*)smem;
  unsigned char* ws = p.ws;
  const int n_in = 16 * 88, n_a = 8 * 16, n_b = 8 * 16, n_o = 16 * 16, n_q = 16 * 32;
  const int total = n_in + n_a + n_b + n_o + n_q;
  for (int t = blockIdx.x; t < total; t += gridDim.x) {
    int i = t;
    if (i < n_in) { transpose_tile(p.in[2], 5456, (u16*)(ws + OFF_WTIN), 1024, (i / 88) * 64, (i % 88) * 64, true, true, tile, 32.f); continue; }
    i -= n_in;
    if (i < n_a) { transpose_tile(p.in[9], 1024, (u16*)(ws + OFF_WTA), 512, (i / 16) * 64, (i % 16) * 64, false, true, tile, 32.f); continue; }
    i -= n_a;
    if (i < n_b) { transpose_tile(p.in[10], 1024, (u16*)(ws + OFF_WTB), 512, (i / 16) * 64, (i % 16) * 64, false, true, tile, 32.f); continue; }
    i -= n_b;
    if (i < n_o) { transpose_tile(p.in[11], 1024, (u16*)(ws + OFF_WTO), 1024, (i / 16) * 64, (i % 16) * 64, false, true, tile, 32.f); continue; }
    i -= n_o;
    transpose_tile(p.in[13], 2048, (u16*)(ws + OFF_WTQ), 1024, (i / 32) * 64, (i % 32) * 64, false, true, tile);
  }
  {
    const float* sk = p.in[14];
    u16* skb = (u16*)(ws + OFF_SKB);
    for (int i = blockIdx.x * NTHREADS + TIDX; i < 16 * 128 * 128; i += gridDim.x * NTHREADS) skb[i] = f2bf(sk[i]);
  }
  rmsnorm_rows<false, true>(p.in[0], p.in[1], (u16*)(ws + OFF_H), nullptr, nullptr);
}

constexpr int G_BM = 256, G_BN = 128, G_BK = 64;
constexpr int G_ABYTES = G_BM * 128;

template <int MI>
__device__ __forceinline__ void gemm_mainloop_t(const u16* __restrict__ A, int lda, const u16* __restrict__ Bt, int ldb, int K,
                                                int m0, int n0, unsigned char* smem, f32x4 (&acc)[MI][4]) {
  constexpr int BN = (MI == 4) ? 128 : 256;
  constexpr int NRB = BN / 64;
  constexpr int STAGE = G_ABYTES + BN * 128;
  const int tid = TIDX, lane = tid & 63, wave = tid >> 6;
  const int wm = (MI == 4) ? (wave >> 1) : (wave >> 2), wn = (MI == 4) ? (wave & 1) : (wave & 3);
#pragma unroll
  for (int i = 0; i < MI; ++i)
#pragma unroll
    for (int j = 0; j < 4; ++j) acc[i][j] = (f32x4){0.f, 0.f, 0.f, 0.f};
  const int kc = tid & 7;
  const int arow = tid >> 3;
  u32x4 ra[4], rb[NRB];
  const u16* ap = A + (size_t)(m0 + arow) * lda + kc * 8;
  const u16* bp = Bt + (size_t)(n0 + arow) * ldb + kc * 8;
  const int nk = K / G_BK;
  const int fr = lane & 15, fg = lane >> 4;
#define G_LOAD(kt_)                                                                       \
  {                                                                                       \
    const u16* ap2_ = ap + (size_t)(kt_) * G_BK;                                          \
    const u16* bp2_ = bp + (size_t)(kt_) * G_BK;                                          \
    _Pragma("unroll") for (int i = 0; i < 4; ++i) ra[i] = *(const u32x4*)(ap2_ + (size_t)(64 * i) * lda); \
    _Pragma("unroll") for (int i = 0; i < NRB; ++i) rb[i] = *(const u32x4*)(bp2_ + (size_t)(64 * i) * ldb); \
  }
#define G_STORE(st_)                                                                      \
  {                                                                                       \
    unsigned char* sa_ = smem + (st_) * STAGE;                                            \
    unsigned char* sb_ = sa_ + G_ABYTES;                                                  \
    _Pragma("unroll") for (int i = 0; i < 4; ++i) { int r = arow + 64 * i; *(u32x4*)(sa_ + r * 128 + ((kc ^ (r & 7)) << 4)) = ra[i]; } \
    _Pragma("unroll") for (int i = 0; i < NRB; ++i) { int r = arow + 64 * i; *(u32x4*)(sb_ + r * 128 + ((kc ^ (r & 7)) << 4)) = rb[i]; } \
  }
  G_LOAD(0)
  __syncthreads();
  G_STORE(0)
  if (nk > 1) G_LOAD(1)
  __syncthreads();
  for (int kt = 0; kt < nk; ++kt) {
    if (kt + 1 < nk) G_STORE((kt + 1) & 1)
    if (kt + 2 < nk) G_LOAD(kt + 2)
    __builtin_amdgcn_sched_barrier(0);
    const unsigned char* sa = smem + (kt & 1) * STAGE;
    const unsigned char* sb = sa + G_ABYTES;
#pragma unroll
    for (int kk = 0; kk < 2; ++kk) {
      bf16x8 bfr[4];
#pragma unroll
      for (int j = 0; j < 4; ++j) {
        int r = wn * 64 + j * 16 + fr;
        bfr[j] = *(const bf16x8*)(sb + r * 128 + (((kk * 4 + fg) ^ (r & 7)) << 4));
      }
#pragma unroll
      for (int ih = 0; ih < MI; ih += 4) {
        bf16x8 af[4];
#pragma unroll
        for (int i = 0; i < 4; ++i) {
          int r = wm * (MI * 16) + (ih + i) * 16 + fr;
          af[i] = *(const bf16x8*)(sa + r * 128 + (((kk * 4 + fg) ^ (r & 7)) << 4));
        }
#pragma unroll
        for (int i = 0; i < 4; ++i)
#pragma unroll
          for (int j = 0; j < 4; ++j) acc[ih + i][j] = __builtin_amdgcn_mfma_f32_16x16x32_bf16(af[i], bfr[j], acc[ih + i][j], 0, 0, 0);
        if (MI == 8 && ih == 0) __builtin_amdgcn_sched_barrier(0);
      }
    }
    __syncthreads();
  }
#undef G_LOAD
#undef G_STORE
}
__device__ __forceinline__ void gemm_mainloop(const u16* __restrict__ A, int lda, const u16* __restrict__ Bt, int ldb, int K,
                                              int m0, int n0, unsigned char* smem, f32x4 (&acc)[4][4]) {
  gemm_mainloop_t<4>(A, lda, Bt, ldb, K, m0, n0, smem, acc);
}

__device__ __forceinline__ int g8_lds_byte(int r, int c) {
  int st = (r >> 4) * 2 + (c >> 5), rr = r & 15, cc = c & 31, ob = rr * 64 + cc * 2;
  return st * 1024 + (ob ^ (((ob >> 9) & 1) << 5));
}
__device__ __forceinline__ void g8_stage_rc(int b, int& R, int& C) {
  int st = b / 1024, sb = b % 1024, swz = sb ^ (((sb >> 9) & 1) << 5);
  R = (st >> 1) * 16 + swz / 64; C = (st & 1) * 32 + (swz % 64) / 2;
}
typedef __attribute__((address_space(3))) unsigned int lds_u32;
template <int F8 = 0, int SC = 127>
__device__ __forceinline__ void gemm8_tile(const u16* __restrict__ A, const u16* __restrict__ Bt, int K, int brow, int bcol,
                                           unsigned char* smem, f32x4 (&acc)[2][2][4][2]) {
  typedef int i32x8_ __attribute__((ext_vector_type(8)));
  typedef int i32x4_ __attribute__((ext_vector_type(4)));
  constexpr int HTB = 16384;
  const int tid = TIDX;
  const int wid = tid >> 6, lane = tid & 63, wr = wid >> 2, wc = wid & 3, fr = lane & 15, fq = lane >> 4;
#define SA(b, h) (smem + ((b) * 2 + (h)) * HTB)
#define SB(b, h) (smem + (4 + (b) * 2 + (h)) * HTB)
  u32 soff0;
  { int _r, _c; g8_stage_rc(tid * 16, _r, _c); soff0 = (u32)(_r * K + _c) * 2u; }
  const int wbase = __builtin_amdgcn_readfirstlane(wid) * 1024;
#define STAGE(P, BASE, br, kt) do { \
    unsigned long long _uv0 = (unsigned long long)(BASE) + (unsigned long long)(((long)(br) * K + (long)(kt) * 64) * 2); \
    unsigned long long _uv1 = _uv0 + (unsigned long long)(64 * K * 2); \
    asm volatile("" : "+s"(_uv0), "+s"(_uv1), "+v"(soff0)); \
    __builtin_amdgcn_global_load_lds((const unsigned int*)((const unsigned char*)_uv0 + soff0), (lds_u32*)((P) + wbase), 16, 0, 0); \
    __builtin_amdgcn_global_load_lds((const unsigned int*)((const unsigned char*)_uv1 + soff0), (lds_u32*)((P) + wbase + 8192), 16, 0, 0); } while (0)
#define LDA(dst, b, h) _Pragma("unroll") for (int m = 0; m < 4; ++m) _Pragma("unroll") for (int k = 0; k < 2; ++k) \
    dst[m][k] = *(const bf16x8*)(SA(b, h) + g8_lds_byte(wr * 64 + m * 16 + fr, k * 32 + fq * 8))
#define LDB(dst, b, h) _Pragma("unroll") for (int n = 0; n < 2; ++n) _Pragma("unroll") for (int k = 0; k < 2; ++k) \
    dst[n][k] = *(const bf16x8*)(SB(b, h) + g8_lds_byte(wc * 32 + n * 16 + fr, k * 32 + fq * 8))
#define MMA(ai, bj, At_, Bt_) do { __builtin_amdgcn_s_setprio(1); \
    if (F8) { \
      _Pragma("unroll") for (int m = 0; m < 4; ++m) _Pragma("unroll") for (int n = 0; n < 2; ++n) \
          \
        asm volatile("v_mfma_scale_f32_16x16x128_f8f6f4 %0, %1, %2, %0, %3, %3 op_sel_hi:[0,0,0]" \
            : "+v"(acc[ai][bj][m][n]) \
            : "v"(__builtin_shufflevector((i32x4_)At_[m][0], (i32x4_)At_[m][1], 0, 1, 2, 3, 4, 5, 6, 7)), \
              "v"(__builtin_shufflevector((i32x4_)Bt_[n][0], (i32x4_)Bt_[n][1], 0, 1, 2, 3, 4, 5, 6, 7)), "v"(scv)); \
    } else { \
    _Pragma("unroll") for (int m = 0; m < 4; ++m) _Pragma("unroll") for (int n = 0; n < 2; ++n) _Pragma("unroll") for (int k = 0; k < 2; ++k) \
      acc[ai][bj][m][n] = __builtin_amdgcn_mfma_f32_16x16x32_bf16(At_[m][k], Bt_[n][k], acc[ai][bj][m][n], 0, 0, 0); \
    } \
    __builtin_amdgcn_s_setprio(0); } while (0)
#define WAIT_V(n) asm volatile("s_waitcnt vmcnt(" #n ")" ::: "memory")
#define WAIT_L(n) asm volatile("s_waitcnt lgkmcnt(" #n ")" ::: "memory")
#define BAR __builtin_amdgcn_s_barrier()
#define SCHED __builtin_amdgcn_sched_barrier(0)
#pragma unroll
  for (int a = 0; a < 2; ++a)
#pragma unroll
    for (int b2 = 0; b2 < 2; ++b2)
#pragma unroll
      for (int m = 0; m < 4; ++m)
#pragma unroll
        for (int n = 0; n < 2; ++n) acc[a][b2][m][n] = (f32x4){0.f, 0.f, 0.f, 0.f};
  bf16x8 At[4][2], B0[2][2], B1[2][2];
  const int scv = SC * 0x01010101;
  const int nt = K / 64;
  constexpr int HALF = 128;
  __syncthreads();
  STAGE(SB(0, 0), Bt, bcol, 0); STAGE(SA(0, 0), A, brow, 0);
  STAGE(SB(0, 1), Bt, bcol + HALF, 0); STAGE(SA(0, 1), A, brow + HALF, 0);
  if (wr == 1) BAR;
  WAIT_V(4); BAR;
  STAGE(SB(1, 0), Bt, bcol, 1); STAGE(SA(1, 0), A, brow, 1); STAGE(SB(1, 1), Bt, bcol + HALF, 1);
  WAIT_V(6); BAR;
#pragma unroll 1
  for (int t = 0; t < nt - 2; t += 2) {
    LDB(B0, 0, 0); SCHED; LDA(At, 0, 0); STAGE(SA(1, 1), A, brow + HALF, t + 1);
    WAIT_L(8); BAR; WAIT_L(0); MMA(0, 0, At, B0); BAR; SCHED;
    LDB(B1, 0, 1); STAGE(SB(0, 0), Bt, bcol, t + 2);
    BAR; WAIT_L(0); MMA(0, 1, At, B1); BAR;
    LDA(At, 0, 1); STAGE(SA(0, 0), A, brow, t + 2);
    BAR; WAIT_L(0); MMA(1, 0, At, B0); BAR; SCHED;
    STAGE(SB(0, 1), Bt, bcol + HALF, t + 2);
    WAIT_V(6); BAR; MMA(1, 1, At, B1); BAR;
    LDB(B0, 1, 0); SCHED; LDA(At, 1, 0); STAGE(SA(0, 1), A, brow + HALF, t + 2);
    WAIT_L(8); BAR; WAIT_L(0); MMA(0, 0, At, B0); BAR; SCHED;
    LDB(B1, 1, 1); STAGE(SB(1, 0), Bt, bcol, t + 3);
    BAR; WAIT_L(0); MMA(0, 1, At, B1); BAR;
    LDA(At, 1, 1); STAGE(SA(1, 0), A, brow, t + 3);
    BAR; WAIT_L(0); MMA(1, 0, At, B0); BAR; SCHED;
    STAGE(SB(1, 1), Bt, bcol + HALF, t + 3);
    WAIT_V(6); BAR; MMA(1, 1, At, B1); BAR;
  }
#define ACC_PIN() _Pragma("unroll") for (int a = 0; a < 2; ++a) _Pragma("unroll") for (int b2 = 0; b2 < 2; ++b2) \
      asm volatile("" : "+v"(acc[a][b2][0][0]), "+v"(acc[a][b2][0][1]), "+v"(acc[a][b2][1][0]), "+v"(acc[a][b2][1][1]), \
                        "+v"(acc[a][b2][2][0]), "+v"(acc[a][b2][2][1]), "+v"(acc[a][b2][3][0]), "+v"(acc[a][b2][3][1]))
  ACC_PIN();
  { LDB(B0, 0, 0); LDA(At, 0, 0); STAGE(SA(1, 1), A, brow + HALF, nt - 1);
    BAR; WAIT_L(0); MMA(0, 0, At, B0); BAR; SCHED;
    LDB(B1, 0, 1); BAR; WAIT_L(0); MMA(0, 1, At, B1); BAR; SCHED;
    LDA(At, 0, 1); WAIT_V(4); BAR; WAIT_L(0); MMA(1, 0, At, B0); SCHED; MMA(1, 1, At, B1); BAR; SCHED; }
  { LDB(B0, 1, 0); LDA(At, 1, 0); WAIT_V(2); BAR; WAIT_L(0); MMA(0, 0, At, B0); BAR; SCHED;
    LDB(B1, 1, 1); WAIT_V(0); BAR; WAIT_L(0); MMA(0, 1, At, B1); BAR; SCHED;
    LDA(At, 1, 1); BAR; WAIT_L(0); MMA(1, 0, At, B0); SCHED; MMA(1, 1, At, B1); BAR; SCHED; }
  ACC_PIN();
#undef ACC_PIN
  if (wr == 0) BAR;
#undef SA
#undef SB
#undef STAGE
#undef LDA
#undef LDB
#undef MMA
#undef WAIT_V
#undef WAIT_L
#undef BAR
#undef SCHED
}

template <int LD, bool NORM, bool FRAG = false, int FRAGH = 1>
__device__ __forceinline__ void ep_store(u16* __restrict__ dst, u32 ob, const f32x4 (&acc)[2][2][4][2], const float* __restrict__ gain,
                                         float extra, unsigned char* smem, int wave, int lane_in) {
  int lane = lane_in;
  asm volatile("" : "+v"(lane));
  const int fr = lane & 15, fq = lane >> 4;
  unsigned char* reg = smem + wave * 16384;
  float gj[4] = {1.f, 1.f, 1.f, 1.f};
  if (NORM) {
#pragma unroll
    for (int j = 0; j < 4; ++j) gj[j] = gain[fr * 4 + j] * extra;
  }
  unsigned char* wbase = reg + (4 * fq) * 128 + (fr & 1) * 8;
#pragma unroll
  for (int ai = 0; ai < 2; ++ai)
#pragma unroll
    for (int m = 0; m < 4; ++m) {
#pragma unroll
      for (int r = 0; r < 4; ++r) {
        float rs = 1.f;
        if (NORM) {
          float sq = 0.f;
#pragma unroll
          for (int bj = 0; bj < 2; ++bj)
#pragma unroll
            for (int n = 0; n < 2; ++n) sq += acc[ai][bj][m][n][r] * acc[ai][bj][m][n][r];
          sq += DPPF(sq, 0xb1); sq += DPPF(sq, 0x4e); sq += DPPF(sq, 0x141); sq += DPPF(sq, 0x140);
          rs = rsqrtf(sq * (1.f / 64.f) + EPS);
        }
        {
          const float v0 = acc[ai][0][m][0][r], v1 = acc[ai][0][m][1][r], v2 = acc[ai][1][m][0][r], v3 = acc[ai][1][m][1][r];
          const int ch = ((fr >> 1) + 2 * fq) & 7;
          u32x2 w;
          w[0] = NORM ? pack2(v0 * rs * gj[0], v1 * rs * gj[1]) : pack2(v0, v1);
          w[1] = NORM ? pack2(v2 * rs * gj[2], v3 * rs * gj[3]) : pack2(v2, v3);
          *(u32x2*)(wbase + (ai * 64 + m * 16 + r) * 128 + (ch << 4)) = w;
        }
      }
      __builtin_amdgcn_sched_barrier(0);
    }
  WAVE_LDS_SYNC();
  const int c16 = lane & 7, r8 = lane >> 3;
#pragma unroll
  for (int it = 0; it < 16; ++it) {
    const int rw = it * 8 + r8;
    const u32x4 v = *(const u32x4*)(reg + rw * 128 + (((c16 + 2 * ((rw >> 2) & 3)) & 7) << 4));
    const int grow = (it >> 3) * 128 + (it & 7) * 8 + r8;
    if (FRAG) {
      const u32 stok = ob / 64u + (u32)grow;
      *(u32x4*)(dst + ((stok >> 4) * FRAGH + (ob & 63u)) * 1024u + (u32)((c16 >> 2) * 512 + (((c16 & 3) * 16 + (int)(stok & 15u)) * 8))) = v;
    } else
    *(u32x4*)(dst + ob + (u32)(grow * LD + c16 * 8)) = v;
    if ((it & 3) == 3) __builtin_amdgcn_sched_barrier(0);
  }
}

template <bool NORM, int PITCH = 256, bool SIG = false, int HALFSTRIDE = 128 * PITCH>
__device__ __forceinline__ void ep_store8(unsigned char* __restrict__ dst, u32 ob, const f32x4 (&acc)[2][2][4][2],
                                          const float* __restrict__ gain, unsigned char* smem, int wave, int lane_in) {
  int lane = lane_in;
  asm volatile("" : "+v"(lane));
  const int fr = lane & 15, fq = lane >> 4;
  unsigned char* reg = smem + wave * 16384;
  float gj[4] = {1.f, 1.f, 1.f, 1.f};
  if (NORM) {
#pragma unroll
    for (int j = 0; j < 4; ++j) gj[j] = gain[fr * 4 + j];
  }
#pragma unroll
  for (int ai = 0; ai < 2; ++ai)
#pragma unroll
    for (int m = 0; m < 4; ++m) {
#pragma unroll
      for (int r = 0; r < 4; ++r) {
        float rs = 1.f;
        if (NORM) {
          float sq = 0.f;
#pragma unroll
          for (int bj = 0; bj < 2; ++bj)
#pragma unroll
            for (int n = 0; n < 2; ++n) sq += acc[ai][bj][m][n][r] * acc[ai][bj][m][n][r];
          sq += DPPF(sq, 0xb1); sq += DPPF(sq, 0x4e); sq += DPPF(sq, 0x141); sq += DPPF(sq, 0x140);
          rs = rsqrtf(sq * (1.f / 64.f) + EPS);
        }
        const int rw = ai * 64 + m * 16 + 4 * fq + r;
        {
          float v0 = acc[ai][0][m][0][r], v1 = acc[ai][0][m][1][r], v2 = acc[ai][1][m][0][r], v3 = acc[ai][1][m][1][r];
          if (NORM) { v0 *= rs * gj[0]; v1 *= rs * gj[1]; v2 *= rs * gj[2]; v3 *= rs * gj[3]; }
          if (SIG) { v0 = sigmoidf_(v0); v1 = sigmoidf_(v1); v2 = sigmoidf_(v2); v3 = sigmoidf_(v3); }
          *(u32*)(reg + rw * 64 + ((((fr >> 2) + (rw >> 2)) & 3) << 4) + (fr & 3) * 4) = fp8x4(v0, v1, v2, v3);
        }
      }
      __builtin_amdgcn_sched_barrier(0);
    }
  WAVE_LDS_SYNC();
  const int c4 = lane & 3, r16 = lane >> 2;
#pragma unroll
  for (int it = 0; it < 8; ++it) {
    const int rw = it * 16 + r16;
    const u32x4 v = *(const u32x4*)(reg + rw * 64 + (((c4 + (rw >> 2)) & 3) << 4));
    *(u32x4*)(dst + ob + (u32)((rw >> 6) * HALFSTRIDE + (rw & 63) * PITCH + c4 * 16)) = v;
  }
}

__device__ __forceinline__ void phase1(const Params& p, unsigned char* smem) {
  const u16* H = (const u16*)(p.ws + OFF_H);
  const u16* WT = (const u16*)(p.ws + OFF_WTIN);
  u16* PROJ = (u16*)(p.ws + OFF_PROJ);
  u16* KVC = (u16*)(p.ws + OFF_KVC);
  u16* IKC = (u16*)(p.ws + OFF_IKC);
  float* SMALL = (float*)(p.ws + OFF_SMALL);
  const int ntn = NPADW / 256;
  const int ntiles = (MTOK / 256) * ntn;
  for (int t = blockIdx.x; t < ntiles; t += gridDim.x) {
    const int m0 = (t / ntn) * 256, n0 = (t % ntn) * 256;
    f32x4 acc[2][2][4][2];
    gemm8_tile<1, 124>(H, WT, DM / 2, m0, n0, smem, acc);
    const int tid_e = TIDX, lane = tid_e & 63, wave = tid_e >> 6;
    const int wr = wave >> 2, wc = wave & 3, fr = lane & 15, fq = lane >> 4;
    const int cbase = n0 + wc * 64;
    const u32 rbase = (u32)(m0 + wr * 64);
    if (cbase < C_IQ) {
      ep_store<LDP, true>(PROJ, rbase * LDP + (u32)cbase, acc, p.in[3], 0.125f, smem, wave, lane);
    } else if (cbase < C_DQ) {
      ep_store<64, false, true, 8>((u16*)(p.ws + OFF_IQF), rbase * 64 + (u32)((cbase - C_IQ) >> 6), acc, nullptr, 1.f, smem, wave, lane);
    } else if (cbase < C_GA) {
      ep_store<LDP, false>(PROJ, rbase * LDP + (u32)cbase, acc, nullptr, 1.f, smem, wave, lane);
    } else if (cbase < NPROJ) {
      ep_store8<false, 64, true, 2 * 32 * 4096>(p.ws + OFF_GATE8, (u32)(((rbase >> 6) * 32 + ((cbase - C_GA) >> 6)) * 4096), acc, nullptr, smem, wave, lane);
    } else if (cbase < N_AV) {
      ep_store8<true>(p.ws + OFF_KVC, rbase * 256 + (u32)(cbase - N_AK), acc, p.in[4], smem, wave, lane);
    } else if (cbase < N_IK) {
      ep_store8<false>(p.ws + OFF_KVC, rbase * 256 + (u32)(cbase - N_AV + 128), acc, nullptr, smem, wave, lane);
    } else if (cbase < N_SM) {
      ep_store<64, false, true>(IKC, rbase * 64, acc, nullptr, 1.f, smem, wave, lane);
    } else if (cbase == N_SM) {
      const u32 sb0 = (rbase + 4 * fq) * 16 + (u32)(fr * 4);
      if (fr < 4) {
#pragma unroll
        for (int ai = 0; ai < 2; ++ai)
#pragma unroll
          for (int m = 0; m < 4; ++m)
#pragma unroll
            for (int r = 0; r < 4; ++r)
              *(f32x4*)(SMALL + sb0 + (u32)((ai * 128 + m * 16 + r) * 16)) =
                  (f32x4){acc[ai][0][m][0][r], acc[ai][0][m][1][r], acc[ai][1][m][0][r], acc[ai][1][m][1][r]};
      }
    }
  }
}

constexpr int IDX_RS = 8208;

__device__ __forceinline__ u32 f2key(float x) {
  _Float16 h = (_Float16)x;
  u32 b = (u32) * (u16*)&h;
  return (b & 0x8000u) ? ((~b) & 0xffffu) : (b | 0x8000u);
}
__device__ __forceinline__ int count_ge_wave(const u32 (&kreg)[32], u32 mid, int ndw) {
  const u32 m1 = (mid - 1u) * 0x00010001u;
  const u32 one = 0x00010001u;
  u32 acc0 = 0u, acc1 = 0u;
#pragma unroll
  for (int c4 = 0; c4 < 8; ++c4) {
    if (c4 * 4 < ndw) {
#pragma unroll
      for (int i = c4 * 4; i < c4 * 4 + 4; i += 2) {
        u32 t0, t1;
        asm("v_pk_sub_u16 %0, %1, %2 clamp" : "=v"(t0) : "v"(kreg[i]), "s"(m1));
        asm("v_pk_sub_u16 %0, %1, %2 clamp" : "=v"(t1) : "v"(kreg[i + 1]), "s"(m1));
        asm("v_pk_min_u16 %0, %1, %2" : "=v"(t0) : "v"(t0), "s"(one));
        asm("v_pk_min_u16 %0, %1, %2" : "=v"(t1) : "v"(t1), "s"(one));
        asm("v_pk_add_u16 %0, %1, %2" : "=v"(acc0) : "v"(acc0), "v"(t0));
        asm("v_pk_add_u16 %0, %1, %2" : "=v"(acc1) : "v"(acc1), "v"(t1));
      }
    }
  }
  int c = (int)((acc0 & 0xffffu) + (acc0 >> 16) + (acc1 & 0xffffu) + (acc1 >> 16));
  return wave_sum_i_dpp(c);
}

__device__ __forceinline__ void idx_item(const Params& p, unsigned char* smem, int b, int tq) {
  const u16* PROJ = (const u16*)(p.ws + OFF_PROJ);
  const float* SMALL = (const float*)(p.ws + OFF_SMALL);
  u16* SEL = (u16*)(p.ws + OFF_SEL);
  const int tid = TIDX, lane = tid & 63, wave = tid >> 6;
  const int t0 = tq * 16;
  const size_t tokb = (size_t)b * SEQ;
  if (tq < 16) {
    for (int rr = 0; rr < 2; ++rr) {
      int row = 2 * wave + rr, t = t0 + row;
      u16* out = SEL + (tokb + t) * 256;
      for (int i = lane; i < 256; i += 64) out[i] = (i <= t) ? (u16)i : (u16)0xFFFF;
    }
    return;
  }
  const int q = lane & 15, g = lane >> 4;
  __syncthreads();
  {
    const u16* iqf = (const u16*)(p.ws + OFF_IQF) + ((tokb + t0) >> 4) * 8 * 1024 + lane * 8;
    bf16x8 bq[8][2];
    float wq[8];
#pragma unroll
    for (int h = 0; h < 8; ++h) {
      bq[h][0] = *(const bf16x8*)(iqf + h * 1024);
      bq[h][1] = *(const bf16x8*)(iqf + h * 1024 + 512);
    }
    {
      const f32x4 w0 = *(const f32x4*)(SMALL + (tokb + t0 + q) * 16), w1 = *(const f32x4*)(SMALL + (tokb + t0 + q) * 16 + 4);
      wq[0] = w0[0]; wq[1] = w0[1]; wq[2] = w0[2]; wq[3] = w0[3]; wq[4] = w1[0]; wq[5] = w1[1]; wq[6] = w1[2]; wq[7] = w1[3];
    }
    bf16x8 bqs[2];
    {
      typedef u32 u32x4_ __attribute__((ext_vector_type(4)));
#pragma unroll
      for (int kk = 0; kk < 2; ++kk) {
        float s8[8];
#pragma unroll
        for (int e = 0; e < 8; ++e) s8[e] = 0.f;
#pragma unroll
        for (int h = 0; h < 8; ++h) {
          const u32x4_ w4 = (u32x4_)bq[h][kk];
#pragma unroll
          for (int c = 0; c < 4; ++c) { s8[2 * c] = fmaf(wq[h], bflo(w4[c]), s8[2 * c]); s8[2 * c + 1] = fmaf(wq[h], bfhi(w4[c]), s8[2 * c + 1]); }
        }
        u32x4_ o4;
#pragma unroll
        for (int c = 0; c < 4; ++c) o4[c] = pack2(s8[2 * c], s8[2 * c + 1]);
        bqs[kk] = (bf16x8)o4;
      }
    }
    const int nkb = tq + 1;
    const int niter = (nkb > wave) ? ((nkb - wave + 7) >> 3) : 0;
    const u16* ikbase = (const u16*)(p.ws + OFF_IKC) + (tokb >> 4) * 1024 + lane * 8;
    bf16x8 ca[3][2];
#pragma unroll
    for (int j = 0; j < 3; ++j)
      if (j < niter) {
        const u16* ikrow = ikbase + (size_t)(wave + 8 * j) * 1024;
        ca[j][0] = *(const bf16x8*)(ikrow); ca[j][1] = *(const bf16x8*)(ikrow + 512);
      }
    for (int i0 = 0; i0 < ((p.flags & 8) ? 0 : niter); i0 += 3) {
#pragma unroll
      for (int j = 0; j < 3; ++j) {
        if (i0 + j < niter) {
          const int s0 = (wave + 8 * (i0 + j)) * 16;
          f32x4 tot = {0.f, 0.f, 0.f, 0.f};
          tot = __builtin_amdgcn_mfma_f32_16x16x32_bf16(ca[j][0], bqs[0], tot, 0, 0, 0);
          tot = __builtin_amdgcn_mfma_f32_16x16x32_bf16(ca[j][1], bqs[1], tot, 0, 0, 0);
#pragma unroll
          for (int h = 0; h < 8; ++h) {
            f32x4 acc = {0.f, 0.f, 0.f, 0.f};
            acc = __builtin_amdgcn_mfma_f32_16x16x32_bf16(ca[j][0], bq[h][0], acc, 0, 0, 0);
            acc = __builtin_amdgcn_mfma_f32_16x16x32_bf16(ca[j][1], bq[h][1], acc, 0, 0, 0);
#pragma unroll
            for (int r = 0; r < 4; ++r) tot[r] = fmaf(fabsf(acc[r]), wq[h], tot[r]);
          }
          if (i0 + 3 + j < niter) {
            const u16* ikrow = ikbase + (size_t)(wave + 8 * (i0 + 3 + j)) * 1024;
            ca[j][0] = *(const bf16x8*)(ikrow); ca[j][1] = *(const bf16x8*)(ikrow + 512);
          }
          typedef short s16x2_ __attribute__((ext_vector_type(2)));
          u32x2 w2;
#pragma unroll
          for (int c = 0; c < 2; ++c) {
            const u32 pk = __builtin_bit_cast(u32, __builtin_amdgcn_cvt_pkrtz(tot[2 * c], tot[2 * c + 1]));
            const u32 sm = __builtin_bit_cast(u32, __builtin_bit_cast(s16x2_, pk) >> (s16x2_){15, 15});
            w2[c] = (pk ^ (sm | 0x80008000u)) & 0xffc0ffc0u;
          }
          if (s0 == t0) {
#pragma unroll
            for (int c = 0; c < 2; ++c) {
              const int sidx = s0 + 4 * g + 2 * c;
              w2[c] = (sidx <= t0 + q ? (w2[c] & 0xffffu) : 0u) | (sidx + 1 <= t0 + q ? (w2[c] & 0xffff0000u) : 0u);
            }
          }
          *(u32x2*)(smem + q * IDX_RS + (s0 + 4 * g) * 2) = w2;
        }
        __builtin_amdgcn_sched_barrier(0);
      }
    }
    const int nk = t0 + 16, nk64 = (nk + 511) & ~511;
#pragma unroll
    for (int rr = 0; rr < 2; ++rr) {
      const int cb = nk * 2 + lane * 16;
      if (cb < nk64 * 2) *(u32x4*)(smem + (2 * wave + rr) * IDX_RS + cb) = (u32x4){0u, 0u, 0u, 0u};
    }
  }
  __syncthreads();
  const int ndw = ((t0 + 16 + 511) >> 9) << 2;
  for (int rr = 0; rr < ((p.flags & 16) ? 0 : 2); ++rr) {
    const int row = 2 * wave + rr, t = t0 + row;
    u16* out = SEL + (tokb + t) * 256;
    u32 kreg[32];
    {
      const u32* src = (const u32*)(smem + row * IDX_RS) + lane;
#pragma unroll
      for (int c4 = 0; c4 < 8; ++c4)
        if (c4 * 4 < ndw) {
#pragma unroll
          for (int i = c4 * 4; i < c4 * 4 + 4; ++i) kreg[i] = src[i * 64];
        }
    }
    WAVE_LDS_SYNC();
    u32 lo = 0u, hi = 1023u;
    while (lo < hi) {
      u32 mid = (lo + hi + 1u) >> 1;
      int c = count_ge_wave(kreg, mid << 6, ndw);
      if (c >= 256) lo = mid; else hi = mid - 1u;
    }
    const u32 tau = lo << 6;
    const u32 tauP = (u32)__builtin_amdgcn_readfirstlane((int)(tau * 0x00010001u));
    const u32 tau1P = (u32)__builtin_amdgcn_readfirstlane((int)((tau - 1u) * 0x00010001u));
    const u32 oneP = 0x00010001u;
    u32 gA = 0u, gB = 0u, eA = 0u, eB = 0u;
#pragma unroll
    for (int c4 = 0; c4 < 8; ++c4)
      if (c4 * 4 < ndw) {
#pragma unroll
        for (int i = c4 * 4; i < c4 * 4 + 4; ++i) {
          u32 g, e;
          asm("v_pk_sub_u16 %0, %1, %2 clamp" : "=v"(g) : "v"(kreg[i]), "s"(tauP));
          asm("v_pk_sub_u16 %0, %1, %2 clamp" : "=v"(e) : "v"(kreg[i]), "s"(tau1P));
          asm("v_pk_min_u16 %0, %1, %2" : "=v"(g) : "v"(g), "s"(oneP));
          asm("v_pk_min_u16 %0, %1, %2" : "=v"(e) : "v"(e), "s"(oneP));
          if (i < 16) { gA |= g << i; eA |= e << i; } else { gB |= g << (i - 16); eB |= e << (i - 16); }
        }
      }
    eA &= ~gA; eB &= ~gB;
    const int gt = __builtin_popcount(gA) + __builtin_popcount(gB);
    int eq = __builtin_popcount(eA) + __builtin_popcount(eB);
    int packed = gt | (eq << 16);
    int incl = packed;
#pragma unroll
    for (int o = 1; o < 64; o <<= 1) {
      int v = __shfl_up(incl, o);
      if (lane >= o) incl += v;
    }
    const int excl = incl - packed;
    const int total = __shfl(incl, 63);
    const int need = 256 - (total & 0xffff);
    const int pg = excl & 0xffff, pe = excl >> 16;
    int pos = pg + min(pe, need);
    const int keq = min(max(need - pe, 0), eq);
    while (eq > keq) {
      if (eB) eB &= ~(0x80000000u >> __builtin_clz(eB)); else eA &= ~(0x80000000u >> __builtin_clz(eA));
      --eq;
    }
    u32 tA = gA | eA, tB = gB | eB;
    u16* lrow = (u16*)(smem + row * IDX_RS);
    while (tA) {
      const int bpos = __builtin_ctz(tA);
      tA &= tA - 1u;
      lrow[pos] = (u16)(128 * (bpos & 15) + 2 * lane + (bpos >> 4));
      ++pos;
    }
    while (tB) {
      const int bpos = __builtin_ctz(tB);
      tB &= tB - 1u;
      lrow[pos] = (u16)(128 * (16 + (bpos & 15)) + 2 * lane + (bpos >> 4));
      ++pos;
    }
    WAVE_LDS_SYNC();
    *(u32x2*)(out + lane * 4) = *(const u32x2*)(lrow + lane * 4);
    WAVE_LDS_SYNC();
  }
}

constexpr int DNP = 68;
constexpr int DL_KT = 0;
constexpr int DL_V = DL_KT + 128 * DNP * 4;
constexpr int DL_QB = DL_V + 64 * 128 * 4;
constexpr int DL_KB = DL_QB + 64 * 272;
constexpr int DL_SM = DL_KB + 64 * 272;
constexpr int DL_RAW = DL_SM + 2048;
static_assert(DL_RAW + 3 * 67 * 272 <= SMEM_BYTES && 16384 + 64 * 144 + 2048 <= 3 * 67 * 272, "dn_local LDS");
__device__ __forceinline__ void dn_local_item(const Params& p, unsigned char* smem, int item) {
  const int h = item & 3, n = (item >> 2) & 63, b = item >> 8;
  const u16* PROJ = (const u16*)(p.ws + OFF_PROJ);
  const float* SMALL = (const float*)(p.ws + OFF_SMALL);
  u16* Ug = (u16*)((unsigned char*)p.out + DO_U);
  u16* Wg = (u16*)((unsigned char*)p.out + DO_W);
  u16* QNg = (u16*)((unsigned char*)p.out + DO_QN);
  u16* KNTg = (u16*)((unsigned char*)p.out + DO_KNT);
  u16* ATTg = (u16*)(p.ws + OFF_ATT);
  float* GCg = (float*)(p.ws + OFF_GC);
  const float* convw = p.in[5];
  const int tid = TIDX, lane = tid & 63, wave = tid >> 6;
  const int c0 = n * 64;
  const size_t tok0 = (size_t)b * SEQ + c0;
  float* Kt = (float*)(smem + DL_KT);
  float* V = (float*)(smem + DL_V);
  unsigned char* Qb = smem + DL_QB;
  unsigned char* Kb = smem + DL_KB;
  float* gc = (float*)(smem + DL_SM);
  float* beta = gc + 64;
  float* ssp = beta + 64;
  unsigned char* RAW = smem + DL_RAW;
  float* AmT = (float*)(smem + DL_RAW);
  __syncthreads();
  {
    u32x4 rg[7];
#pragma unroll
    for (int k = 0; k < 7; ++k) {
      const int ci = tid + 512 * k;
      rg[k] = (u32x4){0u, 0u, 0u, 0u};
      if (ci < 3216) {
        const int arr = ci / 1072, rem = ci - arr * 1072, row = rem >> 4, ch = rem & 15;
        const int trel = c0 - 3 + row;
        if (trel >= 0)
          rg[k] = *(const u32x4*)(PROJ + ((size_t)b * SEQ + trel) * LDP + (C_DQ + arr * 512) + h * 128 + ch * 8);
      }
    }
#pragma unroll
    for (int k = 0; k < 7; ++k) {
      const int ci = tid + 512 * k;
      if (ci < 3216) {
        const int arr = ci / 1072, rem = ci - arr * 1072, row = rem >> 4, ch = rem & 15;
        *(u32x4*)(RAW + (arr * 67 + row) * 272 + ch * 16) = rg[k];
      }
    }
  }
  if (tid < 64) {
    float da = SMALL[(tok0 + tid) * 16 + 8 + h], db = SMALL[(tok0 + tid) * 16 + 12 + h];
    float xx = da + p.in[7][h];
    float sp = fmaxf(xx, 0.f) + log1pf(__expf(-fabsf(xx)));
    float gr = -__expf(p.in[6][h]) * sp;
    float incl = gr;
#pragma unroll
    for (int o = 1; o < 64; o <<= 1) {
      float v = __shfl_up(incl, o);
      if (lane >= o) incl += v;
    }
    gc[tid] = incl;
    beta[tid] = sigmoidf_(db);
    GCg[(tok0 + tid) * 4 + h] = incl;
  }
  __syncthreads();
  {
    const int c = tid & 127, tg = tid >> 7;
    float qv[16], kv[16];
#pragma unroll
    for (int arr = 0; arr < 3; ++arr) {
      const float w0 = convw[0 * 1536 + arr * 512 + h * 128 + c], w1 = convw[1 * 1536 + arr * 512 + h * 128 + c],
                  w2 = convw[2 * 1536 + arr * 512 + h * 128 + c], w3 = convw[3 * 1536 + arr * 512 + h * 128 + c];
      const unsigned char* rp = RAW + (arr * 67 + tg * 16) * 272 + c * 2;
      float x0 = bf2f(*(const u16*)(rp)), x1 = bf2f(*(const u16*)(rp + 272)), x2 = bf2f(*(const u16*)(rp + 2 * 272));
#pragma unroll
      for (int ii = 0; ii < 16; ++ii) {
        const float x3 = bf2f(*(const u16*)(rp + (ii + 3) * 272));
        const float y = w0 * x0 + w1 * x1 + w2 * x2 + w3 * x3;
        const float sv = y * sigmoidf_(y);
        if (arr == 0) qv[ii] = sv;
        else if (arr == 1) kv[ii] = sv;
        else V[(tg * 16 + ii) * 128 + c] = sv;
        x0 = x1; x1 = x2; x2 = x3;
      }
    }
#pragma unroll
    for (int ii = 0; ii < 16; ++ii) {
      const float sq = wave_sum_dpp(qv[ii] * qv[ii]);
      const float sk = wave_sum_dpp(kv[ii] * kv[ii]);
      if (lane == 0) {
        ssp[((tg * 16 + ii) * 2) + (wave & 1)] = sq;
        ssp[128 + ((tg * 16 + ii) * 2) + (wave & 1)] = sk;
      }
    }
    __syncthreads();
#pragma unroll
    for (int ii = 0; ii < 16; ++ii) {
      const int i = tg * 16 + ii;
      const float qsc = rsqrtf(ssp[i * 2] + ssp[i * 2 + 1] + EPS) * 0.08838834764831845f;
      const float ksc = rsqrtf(ssp[128 + i * 2] + ssp[128 + i * 2 + 1] + EPS);
      const float qn = qv[ii] * qsc, kn = kv[ii] * ksc;
      *(u16*)(Qb + i * 272 + c * 2) = f2bf(qn);
      *(u16*)(Kb + i * 272 + c * 2) = f2bf(kn);
      Kt[c * DNP + i] = kn;
    }
  }
  __syncthreads();
#pragma unroll
  for (int k = 0; k < 4; ++k) {
    const int gi = tid + 512 * k;
    {
      const int i = gi >> 5, d4 = (gi & 31) * 4;
      const u32x2 v = *(const u32x2*)(Qb + i * 272 + d4 * 2);
      *(u32x2*)(QNg + (tok0 + i) * 512 + h * 128 + perm32(d4)) = v;
    }
    {
      const int d = gi >> 4, t4 = (gi & 15) * 4;
      const f32x4 v = *(const f32x4*)(Kt + d * DNP + t4);
      u32x2 o = {pack2(v[0], v[1]), pack2(v[2], v[3])};
      *(u32x2*)(KNTg + (size_t)item * 8192 + d * 64 + perm32(t4)) = o;
    }
  }
  {
    const int mat = wave >> 2, it = wave & 3;
    const int fr = lane & 15, fg = lane >> 4;
    const unsigned char* Ab = mat ? Qb : Kb;
    bf16x8 af[4];
#pragma unroll
    for (int kk = 0; kk < 4; ++kk) af[kk] = *(const bf16x8*)(Ab + (it * 16 + fr) * 272 + kk * 64 + fg * 16);
    f32x4 gi4 = *(const f32x4*)(gc + it * 16 + 4 * fg);
    f32x4 bi4 = *(const f32x4*)(beta + it * 16 + 4 * fg);
#pragma unroll
    for (int jt = 0; jt < 4; ++jt) {
      f32x4 acc = {0.f, 0.f, 0.f, 0.f};
      if (jt <= it) {
#pragma unroll
        for (int kk = 0; kk < 4; ++kk) {
          bf16x8 bfg = *(const bf16x8*)(Kb + (jt * 16 + fr) * 272 + kk * 64 + fg * 16);
          acc = __builtin_amdgcn_mfma_f32_16x16x32_bf16(af[kk], bfg, acc, 0, 0, 0);
        }
      }
      const int j = jt * 16 + fr;
      const float gj = gc[j];
#pragma unroll
      for (int r = 0; r < 4; ++r) {
        const int i = it * 16 + 4 * fg + r;
        const float dec = __expf(fminf(gi4[r] - gj, 0.f));
        if (mat == 0) { if (jt <= it) AmT[j * 64 + i] = (i > j) ? bi4[r] * acc[r] * dec : 0.f; }
        else ATTg[(size_t)item * 4096 + i * 64 + perm32(j)] = f2bf((i >= j) ? acc[r] * dec : 0.f);
      }
    }
  }
  __syncthreads();
  u16* nA = (u16*)(smem + DL_RAW + 16384);
  u16* Nb = (u16*)(smem + DL_RAW + 16384 + 64 * 144);
  {
#pragma unroll
    for (int k = 0; k < 8; ++k) {
      const int e = tid + 512 * k;
      const int i = e >> 6, j = e & 63;
      const float v = ((j >> 4) < (i >> 4)) ? -AmT[j * 64 + i] : 0.f;
      nA[i * 72 + j] = f2bf(v);
    }
    if (tid < 64) {
      const int bb = tid >> 4, j = tid & 15;
      float nn[16];
#pragma unroll
      for (int i = 0; i < 16; ++i) {
        float sacc = 0.f;
#pragma unroll
        for (int k = 0; k < i; ++k) sacc += AmT[(bb * 16 + k) * 64 + bb * 16 + i] * nn[k];
        nn[i] = (i == j) ? 1.f : ((i > j) ? -sacc : 0.f);
      }
#pragma unroll
      for (int i = 0; i < 16; ++i) Nb[bb * 256 + i * 16 + j] = f2bf(nn[i]);
    }
  }
  __syncthreads();
  {
    const int fr = lane & 15, fg = lane >> 4;
    f32x4 X[2][4];
#pragma unroll
    for (int ct2 = 0; ct2 < 2; ++ct2) {
      const int c = (wave * 2 + ct2) * 16 + fr;
      const bool isu = c < 128;
      const int cc = c & 127;
#pragma unroll
      for (int bb = 0; bb < 4; ++bb) {
        f32x4 acc;
#pragma unroll
        for (int r = 0; r < 4; ++r) {
          const int i = bb * 16 + 4 * fg + r;
          acc[r] = isu ? V[i * 128 + cc] * beta[i] : Kt[cc * DNP + i] * beta[i] * __expf(gc[i]);
        }
        if (bb >= 1) {
          union { u32 w[4]; bf16x8 v; } af, bf;
          const u32x2 a0 = *(const u32x2*)(nA + (bb * 16 + fr) * 72 + 4 * fg);
          af.w[0] = a0[0]; af.w[1] = a0[1];
          bf.w[0] = pack2(X[ct2][0][0], X[ct2][0][1]); bf.w[1] = pack2(X[ct2][0][2], X[ct2][0][3]);
          if (bb >= 2) {
            const u32x2 a1 = *(const u32x2*)(nA + (bb * 16 + fr) * 72 + 16 + 4 * fg);
            af.w[2] = a1[0]; af.w[3] = a1[1];
            bf.w[2] = pack2(X[ct2][1][0], X[ct2][1][1]); bf.w[3] = pack2(X[ct2][1][2], X[ct2][1][3]);
          } else { af.w[2] = 0u; af.w[3] = 0u; bf.w[2] = 0u; bf.w[3] = 0u; }
          acc = __builtin_amdgcn_mfma_f32_16x16x32_bf16(af.v, bf.v, acc, 0, 0, 0);
          if (bb == 3) {
            const u32x2 a2 = *(const u32x2*)(nA + (bb * 16 + fr) * 72 + 32 + 4 * fg);
            af.w[0] = a2[0]; af.w[1] = a2[1]; af.w[2] = 0u; af.w[3] = 0u;
            bf.w[0] = pack2(X[ct2][2][0], X[ct2][2][1]); bf.w[1] = pack2(X[ct2][2][2], X[ct2][2][3]); bf.w[2] = 0u; bf.w[3] = 0u;
            acc = __builtin_amdgcn_mfma_f32_16x16x32_bf16(af.v, bf.v, acc, 0, 0, 0);
          }
        }
        {
          union { u32 w[4]; bf16x8 v; } af, bf;
          const u32x2 d0 = *(const u32x2*)(Nb + bb * 256 + fr * 16 + 4 * fg);
          af.w[0] = d0[0]; af.w[1] = d0[1]; af.w[2] = 0u; af.w[3] = 0u;
          bf.w[0] = pack2(acc[0], acc[1]); bf.w[1] = pack2(acc[2], acc[3]); bf.w[2] = 0u; bf.w[3] = 0u;
          const f32x4 z4 = {0.f, 0.f, 0.f, 0.f};
          X[ct2][bb] = __builtin_amdgcn_mfma_f32_16x16x32_bf16(af.v, bf.v, z4, 0, 0, 0);
        }
#pragma unroll
        for (int r = 0; r < 4; ++r) {
          const int i = bb * 16 + 4 * fg + r;
          if (isu) Ug[(tok0 + i) * 512 + h * 128 + cc] = f2bf(X[ct2][bb][r]);
          else Wg[(tok0 + i) * 512 + h * 128 + perm32(cc)] = f2bf(X[ct2][bb][r]);
        }
      }
    }
  }
}

__device__ __forceinline__ void phase2(const Params& p, unsigned char* smem) {
#ifndef NO_IDX
  for (int i = blockIdx.x; i < 2048; i += gridDim.x) idx_item(p, smem, i & 7, 255 - (i >> 3));
#endif
#ifndef NO_DNL
  if (!(p.flags & 1))
    for (int i = blockIdx.x; i < 2048; i += gridDim.x) dn_local_item(p, smem, i);
#endif
}

constexpr int SC_WP = 272, SC_KP = 144;
constexpr int SC_W = 0, SC_Q = 64 * SC_WP, SC_KT = 2 * 64 * SC_WP, SC_AT = SC_KT + 128 * SC_KP, SC_U = SC_AT + 64 * SC_KP,
              SC_BUF = SC_U + 64 * SC_WP;
constexpr int SC_GC = 2 * SC_BUF;
static_assert(SC_GC + 2 * 64 * 4 <= SMEM_BYTES, "scan LDS");

__device__ __forceinline__ void dn_scan_item(const Params& p, unsigned char* smem, int bh) {
  const int h = bh & 3, b = bh >> 2;
  const u16* Ug = (const u16*)((const unsigned char*)p.out + DO_U);
  const u16* Wg = (const u16*)((const unsigned char*)p.out + DO_W);
  const u16* QNg = (const u16*)((const unsigned char*)p.out + DO_QN);
  const u16* KNTg = (const u16*)((const unsigned char*)p.out + DO_KNT);
  const u16* ATTg = (const u16*)(p.ws + OFF_ATT);
  const float* GCg = (const float*)(p.ws + OFF_GC);
  const u16* PROJ = (const u16*)(p.ws + OFF_PROJ);
  u16* YDN = (u16*)(p.ws + OFF_YDN);
  const float* ogain = p.in[8];
  const int tid = TIDX, lane = tid & 63, wave = tid >> 6;
  const int fr = lane & 15, fg = lane >> 4;
  const int ecol = wave * 16 + fr;
  float* gcs = (float*)(smem + SC_GC);
  f32x4 S[8];
#pragma unroll
  for (int d = 0; d < 8; ++d) S[d] = (f32x4){0.f, 0.f, 0.f, 0.f};
  u32x4 st[9];
  float gcr = 0.f;
  const int r16 = tid >> 4, c16 = tid & 15;
  const int r8 = tid >> 3, c8 = tid & 7;
#define SCAN_LOAD(n_)                                                                                      \
  {                                                                                                        \
    const size_t tk0 = (size_t)b * SEQ + (size_t)(n_) * 64;                                                \
    const size_t it_ = (size_t)((b * 64 + (n_)) * 4 + h);                                                  \
    st[0] = *(const u32x4*)(Wg + (tk0 + r16) * 512 + h * 128 + c16 * 8);                                   \
    st[1] = *(const u32x4*)(Wg + (tk0 + r16 + 32) * 512 + h * 128 + c16 * 8);                              \
    st[2] = *(const u32x4*)(QNg + (tk0 + r16) * 512 + h * 128 + c16 * 8);                                  \
    st[3] = *(const u32x4*)(QNg + (tk0 + r16 + 32) * 512 + h * 128 + c16 * 8);                             \
    st[4] = *(const u32x4*)(KNTg + it_ * 8192 + (size_t)tid * 8);                                          \
    st[5] = *(const u32x4*)(KNTg + it_ * 8192 + (size_t)(tid + 512) * 8);                                  \
    st[6] = *(const u32x4*)(ATTg + it_ * 4096 + (size_t)tid * 8);                                          \
    st[7] = *(const u32x4*)(Ug + (tk0 + r16) * 512 + h * 128 + c16 * 8);                                   \
    st[8] = *(const u32x4*)(Ug + (tk0 + r16 + 32) * 512 + h * 128 + c16 * 8);                              \
    if (tid < 64) gcr = GCg[(tk0 + tid) * 4 + h];                                                          \
  }
#define SCAN_STORE(buf_)                                                                                   \
  {                                                                                                        \
    unsigned char* bs_ = smem + (buf_) * SC_BUF;                                                           \
    *(u32x4*)(bs_ + SC_W + r16 * SC_WP + c16 * 16) = st[0];                                                \
    *(u32x4*)(bs_ + SC_W + (r16 + 32) * SC_WP + c16 * 16) = st[1];                                         \
    *(u32x4*)(bs_ + SC_Q + r16 * SC_WP + c16 * 16) = st[2];                                                \
    *(u32x4*)(bs_ + SC_Q + (r16 + 32) * SC_WP + c16 * 16) = st[3];                                         \
    *(u32x4*)(bs_ + SC_KT + r8 * SC_KP + c8 * 16) = st[4];                                                 \
    *(u32x4*)(bs_ + SC_KT + (r8 + 64) * SC_KP + c8 * 16) = st[5];                                          \
    *(u32x4*)(bs_ + SC_AT + r8 * SC_KP + c8 * 16) = st[6];                                                 \
    *(u32x4*)(bs_ + SC_U + r16 * SC_WP + c16 * 16) = st[7];                                                \
    *(u32x4*)(bs_ + SC_U + (r16 + 32) * SC_WP + c16 * 16) = st[8];                                         \
    if (tid < 64) gcs[(buf_) * 64 + tid] = gcr;                                                            \
  }
  __syncthreads();
  SCAN_LOAD(0)
  SCAN_STORE(0)
  if (1 < 64) SCAN_LOAD(1)
  __syncthreads();
  for (int n = 0; n < 64; ++n) {
    const int buf = n & 1;
    const size_t tok0 = (size_t)b * SEQ + n * 64;
    if (n + 1 < 64) SCAN_STORE(buf ^ 1)
    if (n + 2 < 64) SCAN_LOAD(n + 2)
    __builtin_amdgcn_sched_barrier(0);
    const unsigned char* base = smem + buf * SC_BUF;
    const u32 ub0 = (u32)(tok0 + 4 * fg) * 512 + (u32)(h * 128 + ecol);
    const float* gcb = gcs + buf * 64 + 4 * fg;
    const float glast = gcs[buf * 64 + 63];
    bf16x8 Sb[4];
#pragma unroll
    for (int kk = 0; kk < 4; ++kk) {
      union { u32 w[4]; bf16x8 v; } cv;
      cv.w[0] = pack2(S[2 * kk][0], S[2 * kk][1]); cv.w[1] = pack2(S[2 * kk][2], S[2 * kk][3]);
      cv.w[2] = pack2(S[2 * kk + 1][0], S[2 * kk + 1][1]); cv.w[3] = pack2(S[2 * kk + 1][2], S[2 * kk + 1][3]);
      Sb[kk] = cv.v;
    }
    f32x4 vnew[4], ov[4];
#pragma unroll
    for (int m = 0; m < 4; ++m) {
      f32x4 aw = {0.f, 0.f, 0.f, 0.f}, aq = {0.f, 0.f, 0.f, 0.f};
#pragma unroll
      for (int kk = 0; kk < 4; ++kk) {
        bf16x8 wf = *(const bf16x8*)(base + SC_W + (m * 16 + fr) * SC_WP + kk * 64 + fg * 16);
        bf16x8 qf = *(const bf16x8*)(base + SC_Q + (m * 16 + fr) * SC_WP + kk * 64 + fg * 16);
        aw = __builtin_amdgcn_mfma_f32_16x16x32_bf16(wf, Sb[kk], aw, 0, 0, 0);
        aq = __builtin_amdgcn_mfma_f32_16x16x32_bf16(qf, Sb[kk], aq, 0, 0, 0);
      }
      f32x4 g4 = *(const f32x4*)(gcb + m * 16);
#pragma unroll
      for (int r = 0; r < 4; ++r) {
        float uv = bf2f(*(const u16*)(base + SC_U + (m * 16 + 4 * fg + r) * SC_WP + ecol * 2));
        vnew[m][r] = uv - aw[r];
        ov[m][r] = aq[r] * __expf(g4[r]);
      }
    }
    bf16x8 vb[2], vsb[2];
#pragma unroll
    for (int k2 = 0; k2 < 2; ++k2) {
      union { u32 w[4]; bf16x8 v; } c1, c2;
      const int ma = 2 * k2, mb = 2 * k2 + 1;
      c1.w[0] = pack2(vnew[ma][0], vnew[ma][1]); c1.w[1] = pack2(vnew[ma][2], vnew[ma][3]);
      c1.w[2] = pack2(vnew[mb][0], vnew[mb][1]); c1.w[3] = pack2(vnew[mb][2], vnew[mb][3]);
      f32x4 ga4 = *(const f32x4*)(gcb + ma * 16), gb4 = *(const f32x4*)(gcb + mb * 16);
      float sa[4], sb2[4];
#pragma unroll
      for (int r = 0; r < 4; ++r) { sa[r] = vnew[ma][r] * __expf(glast - ga4[r]); sb2[r] = vnew[mb][r] * __expf(glast - gb4[r]); }
      c2.w[0] = pack2(sa[0], sa[1]); c2.w[1] = pack2(sa[2], sa[3]);
      c2.w[2] = pack2(sb2[0], sb2[1]); c2.w[3] = pack2(sb2[2], sb2[3]);
      vb[k2] = c1.v; vsb[k2] = c2.v;
    }
    const float egl = __expf(glast);
#pragma unroll
    for (int d = 0; d < 8; ++d) {
      f32x4 a = S[d] * egl;
#pragma unroll
      for (int k2 = 0; k2 < 2; ++k2) {
        bf16x8 kf = *(const bf16x8*)(base + SC_KT + (d * 16 + fr) * SC_KP + k2 * 64 + fg * 16);
        a = __builtin_amdgcn_mfma_f32_16x16x32_bf16(kf, vsb[k2], a, 0, 0, 0);
      }
      S[d] = a;
    }
#pragma unroll
    for (int m = 0; m < 4; ++m) {
      f32x4 ao = ov[m];
#pragma unroll
      for (int k2 = 0; k2 < 2; ++k2) {
        bf16x8 af = *(const bf16x8*)(base + SC_AT + (m * 16 + fr) * SC_KP + k2 * 64 + fg * 16);
        ao = __builtin_amdgcn_mfma_f32_16x16x32_bf16(af, vb[k2], ao, 0, 0, 0);
      }
#pragma unroll
      for (int r = 0; r < 4; ++r) YDN[ub0 + (u32)((m * 16 + r) * 512)] = f2bf(ao[r]);
    }
    __syncthreads();
  }
#undef SCAN_LOAD
#undef SCAN_STORE
}

__device__ __forceinline__ void ydn_norm(const Params& p) {
  const u16* PROJ = (const u16*)(p.ws + OFF_PROJ);
  u16* YDN = (u16*)(p.ws + OFF_YDN);
  const float* ogain = p.in[8];
  const int lane = TIDX & 63, wave = TIDX >> 6;
  const int sub = lane >> 4, l16 = lane & 15;
  float gn8[8];
#pragma unroll
  for (int e = 0; e < 8; ++e) gn8[e] = ogain[l16 * 8 + e];
  for (int tok = blockIdx.x * 8 + wave; tok < MTOK; tok += gridDim.x * 8) {
    u16* yp = YDN + (size_t)tok * 512 + sub * 128 + l16 * 8;
    const u32x4 ov4 = *(const u32x4*)yp;
    const u32x4 zv4 = *(const u32x4*)(PROJ + (size_t)tok * LDP + C_DZ + sub * 128 + l16 * 8);
    float o8[8], z8[8];
#pragma unroll
    for (int c = 0; c < 4; ++c) { o8[2 * c] = bflo(ov4[c]); o8[2 * c + 1] = bfhi(ov4[c]); z8[2 * c] = bflo(zv4[c]); z8[2 * c + 1] = bfhi(zv4[c]); }
    float sq = 0.f;
#pragma unroll
    for (int e = 0; e < 8; ++e) sq += o8[e] * o8[e];
    sq += DPPF(sq, 0xb1); sq += DPPF(sq, 0x4e); sq += DPPF(sq, 0x141); sq += DPPF(sq, 0x140);
    const float rstd = rsqrtf(sq * (1.f / 128.f) + EPS);
    float y8[8];
#pragma unroll
    for (int e = 0; e < 8; ++e) y8[e] = fminf(fmaxf(o8[e] * (rstd * 8.f) * gn8[e] * z8[e] * sigmoidf_(z8[e]), -440.f), 440.f);
    *(uint2*)(p.ws + OFF_YDN8 + (size_t)tok * 512 + sub * 128 + l16 * 8) =
        make_uint2(fp8x4(y8[0], y8[1], y8[2], y8[3]), fp8x4(y8[4], y8[5], y8[6], y8[7]));
  }
}

constexpr int AT_PH = 1040;
constexpr int AT_SL = 8 * AT_PH, AT_ST = AT_SL + 512;
constexpr int AT_WAVE_BYTES = AT_ST + 8192;
__device__ __forceinline__ float xor16_sum(float v) {
  auto r = __builtin_amdgcn_permlane16_swap(__float_as_uint(v), __float_as_uint(v), false, false);
  return __uint_as_float(r[0]) + __uint_as_float(r[1]);
}
__device__ __forceinline__ float xor32_sum(float v) {
  auto r = __builtin_amdgcn_permlane32_swap(__float_as_uint(v), __float_as_uint(v), false, false);
  return __uint_as_float(r[0]) + __uint_as_float(r[1]);
}
__device__ __forceinline__ void attn_query(const Params& p, unsigned char* wsm, int b, int t, unsigned& qnext) {
  typedef long i64;
  typedef int i32x2 __attribute__((ext_vector_type(2)));
  typedef __attribute__((address_space(3))) i32x2 lds_i32x2;
  const u16* PROJ = (const u16*)(p.ws + OFF_PROJ);
  const u16* SEL = (const u16*)(p.ws + OFF_SEL);
  const unsigned char* KVC8 = p.ws + OFF_KVC;
  u16* YATT = (u16*)(p.ws + OFF_YATT);
  const int lane = TIDX & 63;
  const int fr = lane & 15, fg = lane >> 4;
  unsigned char* P = wsm;
  u16* sl = (u16*)(wsm + AT_SL);
  const size_t tokb = (size_t)b * SEQ;
  const size_t tok = tokb + t;
  const int nsel = min(256, t + 1);
  i64 qb[2][2];
  {
    const u16* qrow = PROJ + tok * LDP + C_AQ + (fr & 3) * 64 + fg * 8;
#pragma unroll
    for (int g = 0; g < 2; ++g)
#pragma unroll
      for (int kk = 0; kk < 2; ++kk) {
        const u32x4 v = *(const u32x4*)(qrow + g * 256 + kk * 32);
        const u32 lo = fp8x4(bflo(v[0]) * 16.f, bfhi(v[0]) * 16.f, bflo(v[1]) * 16.f, bfhi(v[1]) * 16.f);
        const u32 hi = fp8x4(bflo(v[2]) * 16.f, bfhi(v[2]) * 16.f, bflo(v[3]) * 16.f, bfhi(v[3]) * 16.f);
        const i64 w = (i64)(((unsigned long long)hi << 32) | (unsigned long long)lo);
        qb[g][kk] = (fr < 4) ? w : (i64)0;
      }
    const u16* sr = SEL + tok * 256;
#pragma unroll
    for (int i = 0; i < 4; ++i) sl[lane + 64 * i] = sr[lane + 64 * i];
  }
  WAVE_LDS_SYNC();
  asm volatile("" : "+v"(qnext));
  const int ngrp = (nsel + 15) >> 4;
  const int nbq = (ngrp + 1) >> 1;
  unsigned char* KST = wsm + AT_ST;
  const int kq = lane >> 3, kch = lane & 7;
  u32x4 kbuf[8][4], vbuf[8][4];
  const unsigned char* kvb = KVC8 + tokb * 256;
  u32 goff[8][4];
#define QK_LOAD(buf_, bi_)                                                                       \
  _Pragma("unroll") for (int j = 0; j < 2; ++j)                                                  \
    _Pragma("unroll") for (int hf = 0; hf < 2; ++hf) {                                           \
      const int ki_ = ((bi_) * 2 + j) * 16 + hf * 8 + kq;                                        \
      goff[bi_][j * 2 + hf] = (((u32)sl[ki_] & 4095u) << 8) | (u32)(kch * 16);                   \
      buf_[j * 2 + hf] = *(const u32x4*)(kvb + goff[bi_][j * 2 + hf]);                           \
    }
#define PV_LOAD(buf_, ks_)                                                                       \
  _Pragma("unroll") for (int i = 0; i < 4; ++i) buf_[i] = *(const u32x4*)(kvb + goff[ks_][i] + 128);
#define QK_COMPUTE(buf_, bi_)                                                                    \
  {                                                                                              \
    _Pragma("unroll") for (int j = 0; j < 2; ++j)                                                \
      _Pragma("unroll") for (int hf = 0; hf < 2; ++hf) {                                         \
        const int row_ = hf * 8 + kq;                                                            \
        *(u32x4*)(KST + j * 2048 + row_ * 128 + ((kch ^ (row_ & 7)) << 4)) = buf_[j * 2 + hf];   \
      }                                                                                          \
    WAVE_LDS_SYNC();                                                                             \
    _Pragma("unroll") for (int j = 0; j < 2; ++j) {                                              \
      const unsigned char* kr_ = KST + j * 2048 + fr * 128 + 8 * (fg & 1);                       \
      const int sw_ = fr & 7, ch_ = fg >> 1;                                                     \
      const i64 a00_ = *(const i64*)(kr_ + (((0 + ch_) ^ sw_) << 4));                            \
      const i64 a01_ = *(const i64*)(kr_ + (((2 + ch_) ^ sw_) << 4));                            \
      const i64 a10_ = *(const i64*)(kr_ + (((4 + ch_) ^ sw_) << 4));                            \
      const i64 a11_ = *(const i64*)(kr_ + (((6 + ch_) ^ sw_) << 4));                            \
      f32x4 c0_ = {0.f, 0.f, 0.f, 0.f}, c1_ = {0.f, 0.f, 0.f, 0.f};                              \
      c0_ = __builtin_amdgcn_mfma_f32_16x16x32_fp8_fp8(a00_, qb[0][0], c0_, 0, 0, 0);            \
      c0_ = __builtin_amdgcn_mfma_f32_16x16x32_fp8_fp8(a01_, qb[0][1], c0_, 0, 0, 0);            \
      c1_ = __builtin_amdgcn_mfma_f32_16x16x32_fp8_fp8(a10_, qb[1][0], c1_, 0, 0, 0);            \
      c1_ = __builtin_amdgcn_mfma_f32_16x16x32_fp8_fp8(a11_, qb[1][1], c1_, 0, 0, 0);            \
      if (fr < 4) {     \
        const int kb_ = ((bi_) * 2 + j) * 16 + 4 * fg;                                           \
        if (nsel != 256) {           \
          _Pragma("unroll") for (int r = 0; r < 4; ++r) {                                        \
            const bool v_ = kb_ + r < nsel;                                                      \
            c0_[r] = v_ ? c0_[r] : -1e30f; c1_[r] = v_ ? c1_[r] : -1e30f;                        \
          }                                                                                      \
        }                                                                                        \
        *(f32x4*)(P + fr * AT_PH + kb_ * 4) = c0_;                                               \
        *(f32x4*)(P + (4 + fr) * AT_PH + kb_ * 4) = c1_;                                         \
      }                                                                                          \
    }                                                                                            \
    WAVE_LDS_SYNC();                                                                             \
  }
#pragma unroll
  for (int bi = 0; bi < 8; ++bi) { QK_LOAD(kbuf[bi], bi) }
#pragma unroll
  for (int bi = 0; bi < 8; ++bi) {
    QK_COMPUTE(kbuf[bi], bi)
    PV_LOAD(vbuf[bi], bi)
  }
#undef QK_LOAD
#undef QK_COMPUTE
#undef PV_LOAD
  float inv8[8];
  {
    float lg[4][8];
#pragma unroll
    for (int hh = 0; hh < 8; ++hh) {
      const f32x4 x = *(const f32x4*)(P + hh * AT_PH + lane * 16);
      lg[0][hh] = x[0]; lg[1][hh] = x[1]; lg[2][hh] = x[2]; lg[3][hh] = x[3];
    }
    WAVE_LDS_SYNC();
    unsigned char* PT8 = P;
#pragma unroll
    for (int hh = 0; hh < 8; ++hh) {
      float m = fmaxf(fmaxf(lg[0][hh], lg[1][hh]), fmaxf(lg[2][hh], lg[3][hh]));
      m = wave_max_dpp(m);
      float e[4], sum = 0.f;
#pragma unroll
      for (int i = 0; i < 4; ++i) { e[i] = __expf((lg[i][hh] - m) * 0.0625f); sum += e[i]; }
      sum = wave_sum_dpp(sum);
      inv8[hh] = __builtin_amdgcn_rcpf(sum) * (1.f / 256.f);
      const u32 w = fp8x4(e[0] * 256.f, e[1] * 256.f, e[2] * 256.f, e[3] * 256.f);
      *(u32*)(PT8 + hh * 256 + lane * 4) = w;
    }
  }
  WAVE_LDS_SYNC();
  {
    const unsigned char* PT8 = P;
    unsigned char* VST = wsm + AT_ST;
    const int trow = (lane & 15) >> 1, thalf = lane & 1;
    f32x4 oacc[2][4];
#pragma unroll
    for (int g = 0; g < 2; ++g)
#pragma unroll
      for (int c = 0; c < 4; ++c) oacc[g][c] = (f32x4){0.f, 0.f, 0.f, 0.f};
    const int nks = (nsel + 31) >> 5;
#define PV_COMPUTE(buf_, ks_)                                                                    \
  {                                                                                              \
    _Pragma("unroll") for (int i = 0; i < 4; ++i) {                                              \
      const int key_ = i * 8 + kq;                                                               \
      *(u32x4*)(VST + key_ * 128 + ((kch ^ (key_ & 7)) << 4)) = buf_[i];                         \
    }                                                                                            \
    WAVE_LDS_SYNC();                                                                             \
    i64 pa_[2];                                                                                  \
    _Pragma("unroll") for (int g = 0; g < 2; ++g) {                                              \
      const i64 t_ = *(const i64*)(PT8 + (g * 4 + (fr & 3)) * 256 + (ks_) * 32 + 8 * fg);        \
      pa_[g] = (fr < 4) ? t_ : (i64)0;                                                           \
    }                                                                                            \
    const int r1_ = 8 * fg + trow;                                                               \
    _Pragma("unroll") for (int g = 0; g < 2; ++g)                                                \
      _Pragma("unroll") for (int c = 0; c < 4; ++c) {                                            \
        const i32x2 tv_ = __builtin_amdgcn_ds_read_tr8_b64_v2i32((lds_i32x2*)(VST + r1_ * 128 + (((g * 4 + c) ^ (r1_ & 7)) << 4) + 8 * thalf)); \
        const i64 vb_ = (i64)(((unsigned long long)(u32)tv_[1] << 32) | (unsigned long long)(u32)tv_[0]); \
        oacc[g][c] = __builtin_amdgcn_mfma_f32_16x16x32_fp8_fp8(pa_[g], vb_, oacc[g][c], 0, 0, 0); \
      }                                                                                          \
    WAVE_LDS_SYNC();                                                                             \
  }
#pragma unroll
    for (int ks = 0; ks < 8; ++ks) {
      if (ks < nks) { PV_COMPUTE(vbuf[ks], ks) }
    }
#undef PV_COMPUTE
    unsigned char* ost = wsm + AT_ST;
    if (lane < 16) {
#pragma unroll
      for (int g = 0; g < 2; ++g)
#pragma unroll
        for (int c = 0; c < 4; ++c)
#pragma unroll
          for (int r = 0; r < 4; ++r) {
            const float v = oacc[g][c][r] * (inv8[g * 4 + r] * 8.f);
            ost[(g * 4 + r) * 64 + 16 * c + fr] = (unsigned char)(__builtin_amdgcn_cvt_pk_fp8_f32(v, v, 0, false) & 0xff);
          }
    }
    WAVE_LDS_SYNC();
    if (lane < 32) __builtin_nontemporal_store(*(const u32x4*)(ost + lane * 16), (u32x4*)(p.ws + OFF_YATT8 + tok * 512 + lane * 16));
  }
  WAVE_LDS_SYNC();
}

__device__ __forceinline__ void tq_load(const Params& p, int row, int lane, f32x4 (&x)[4]) {
  row = row < 2 * 16384 ? row : 2 * 16384 - 1;
  const int tbl = row >> 14, r = row & 16383;
  const f32x4* src = (const f32x4*)((tbl ? p.in[16] : p.in[15]) + (size_t)r * DM) + lane;
#pragma unroll
  for (int i = 0; i < 4; ++i) x[i] = __builtin_nontemporal_load(src + 64 * i);
}
__device__ __forceinline__ void tq_finish(const Params& p, int row, int lane, const f32x4 (&x)[4]) {
  if (row >= 2 * 16384) return;
  const int tbl = row >> 14, r = row & 16383;
  float amax = 0.f;
#pragma unroll
  for (int i = 0; i < 4; ++i)
    amax = fmaxf(amax, fmaxf(fmaxf(fabsf(x[i][0]), fabsf(x[i][1])), fmaxf(fabsf(x[i][2]), fabsf(x[i][3]))));
  amax = wave_max_dpp(amax);
  const float inv = amax > 0.f ? 127.f / amax : 0.f;
  u32x4 o;
#pragma unroll
  for (int i = 0; i < 4; ++i) {
    int q0 = (int)rintf(x[i][0] * inv), q1 = (int)rintf(x[i][1] * inv);
    int q2 = (int)rintf(x[i][2] * inv), q3 = (int)rintf(x[i][3] * inv);
    o[i] = (u32)(q0 & 0xff) | ((u32)(q1 & 0xff) << 8) | ((u32)(q2 & 0xff) << 16) | ((u32)(q3 & 0xff) << 24);
  }
#pragma unroll
  for (int i = 0; i < 4; ++i)
    __builtin_nontemporal_store(o[i], (u32*)(p.ws + (tbl ? OFF_VQ : OFF_UQ) + ((size_t)(2 * i + (lane >> 5)) * 16384 + r) * 128 + (lane & 31) * 4));
  if (lane == 0) ((float*)(p.ws + OFF_US))[2 * r + tbl] = amax * (1.f / 127.f);
}

__device__ __forceinline__ unsigned tq_draw(const Params& p) {
  unsigned g = 0;
  if ((TIDX & 63) == 0) g = __hip_atomic_fetch_add((unsigned*)(p.ws + 4096), 1u, __ATOMIC_RELAXED, __HIP_MEMORY_SCOPE_AGENT);
  return g;
}
__device__ __forceinline__ bool tq_rows(const Params& p, unsigned graw) {
  const unsigned g = (unsigned)__builtin_amdgcn_readfirstlane((int)graw);
  if (g >= (unsigned)(2 * 16384 / 4)) return false;
  const int lane = TIDX & 63, r0 = (int)g * 4;
  f32x4 xa[4], xb[4], xc[4], xd[4];
  tq_load(p, r0 + 0, lane, xa);
  tq_load(p, r0 + 1, lane, xb);
  tq_load(p, r0 + 2, lane, xc);
  tq_load(p, r0 + 3, lane, xd);
  tq_finish(p, r0 + 0, lane, xa);
  tq_finish(p, r0 + 1, lane, xb);
  tq_finish(p, r0 + 2, lane, xc);
  tq_finish(p, r0 + 3, lane, xd);
  return true;
}

__device__ __forceinline__ void phase3(const Params& p, unsigned char* smem) {
  const int wave = TIDX >> 6;
#ifndef NO_SCAN
  if (blockIdx.x < 32) {
    if (!(p.flags & 2)) dn_scan_item(p, smem, blockIdx.x);
    __syncthreads();
  }
#endif
#ifdef NO_ATTN
  return;
#endif
  if (p.flags & 4) return;
  unsigned* qctr = (unsigned*)(p.ws + 1024 + ((p.flags & 128) ? 4096 : 0));
  const unsigned xcc = (unsigned)__builtin_amdgcn_s_getreg((3 << 11) | 20) & 7u;
  unsigned char* wsm = smem + wave * AT_WAVE_BYTES;
  int nq = 0;
  for (unsigned db = 0; db < 8; ++db) {
    const int bb = (int)((xcc + db) & 7u);
    unsigned qraw = 0;
    if ((TIDX & 63) == 0) qraw = __hip_atomic_fetch_add(qctr + bb * 16, 1u, __ATOMIC_RELAXED, __HIP_MEMORY_SCOPE_AGENT);
    for (;;) {
      const unsigned qi = (unsigned)__builtin_amdgcn_readfirstlane((int)qraw);
      if (qi >= (unsigned)SEQ) break;
      qraw = 0;
      if ((TIDX & 63) == 0) qraw = __hip_atomic_fetch_add(qctr + bb * 16, 1u, __ATOMIC_RELAXED, __HIP_MEMORY_SCOPE_AGENT);
      const bool trig = (nq++ & 3) == 3;
      unsigned graw = 0;
      if (trig) graw = tq_draw(p);
      attn_query(p, wsm, bb, SEQ - 1 - (int)qi, qraw);
      if (trig) (void)tq_rows(p, graw);
    }
  }
  while (tq_rows(p, tq_draw(p))) {}
}

__device__ __forceinline__ void hblk_load(unsigned char* reg, const u16* __restrict__ src, u32 ob, u32 ld, int lane) {
  const int c16 = lane & 7, r8 = lane >> 3;
#pragma unroll
  for (int it = 0; it < 8; ++it) {
    const int rl = it * 8 + r8;
    const u32x4 v = *(const u32x4*)(src + ob + (u32)rl * ld + (u32)(c16 * 8));
    *(u32x4*)(reg + rl * 128 + (((c16 + 2 * ((rl >> 2) & 3)) & 7) << 4)) = v;
    if ((it & 3) == 3) __builtin_amdgcn_sched_barrier(0);
  }
}
__device__ __forceinline__ void hblk_load8(unsigned char* reg, const unsigned char* __restrict__ src, u32 ob, u32 pitch, int lane) {
  const int c4 = lane & 3, r16 = lane >> 2;
#pragma unroll
  for (int it = 0; it < 4; ++it) {
    const int rl = it * 16 + r16;
    const u32x4 v = *(const u32x4*)(src + ob + (u32)rl * pitch + (u32)(c4 * 16));
    *(u32x4*)(reg + rl * 64 + (((c4 + (rl >> 2)) & 3) << 4)) = v;
  }
}
__device__ __forceinline__ void hblk_store(const unsigned char* reg, u16* __restrict__ dst, u32 ob, u32 ld, int lane) {
  const int c16 = lane & 7, r8 = lane >> 3;
#pragma unroll
  for (int it = 0; it < 8; ++it) {
    const int rl = it * 8 + r8;
    const u32x4 v = *(const u32x4*)(reg + rl * 128 + (((c16 + 2 * ((rl >> 2) & 3)) & 7) << 4));
    *(u32x4*)(dst + ob + (u32)rl * ld + (u32)(c16 * 8)) = v;
  }
}
template <int PASS>
__device__ __forceinline__ void phase4(const Params& p, unsigned char* smem) {
  const u16* YATT = (const u16*)(p.ws + OFF_YATT);
  const u16* YDN = (const u16*)(p.ws + OFF_YDN);
  const u16* WTA = (const u16*)(p.ws + OFF_WTA);
  const u16* WTB = (const u16*)(p.ws + OFF_WTB);
  const u16* PROJ = (const u16*)(p.ws + OFF_PROJ);
  u16* MG = (u16*)(p.ws + OFF_MERGED);
  const int ntn = DM / 256, ntiles = (MTOK / 256) * ntn;
  for (int t = blockIdx.x; t < ntiles; t += gridDim.x) {
    const int m0 = (t / ntn) * 256, n0 = (t % ntn) * 256;
    f32x4 acc[2][2][4][2];
    {
      constexpr int pass = PASS;
      gemm8_tile<1, 123>((const u16*)(p.ws + (pass ? OFF_YDN8 : OFF_YATT8)), pass ? WTB : WTA, 512 / 2, m0, n0, smem, acc);
      const int tid_e = TIDX, lane = tid_e & 63, wave = tid_e >> 6;
      const int wr = wave >> 2, wc = wave & 3, fr = lane & 15, fq = lane >> 4;
      unsigned char* reg = smem + wave * 16384;
      const int c16 = lane & 15, r4 = lane >> 4;
      const unsigned char* gbase = p.ws + OFF_GATE8;
#pragma unroll
      for (int ai = 0; ai < 2; ++ai) {
        const u32 row0 = (u32)(m0 + ai * 128 + wr * 64);
        const u32 gb0 = (u32)(((row0 >> 6) * 32 + (((pass ? 1024 : 0) + n0 + wc * 64) >> 6)) * 4096 + c16 * 4);
        const u32 ob0 = row0 * DM + (u32)(n0 + wc * 64 + c16 * 4);
        u32 g4[2][8];
        u32 pp[2][8];
        const u32 pb0 = (u32)(((row0 >> 6) * 16 + ((n0 + wc * 64) >> 6)) * 4096 + c16 * 4);
#define P4_LOADS(hb_)                                                                                   \
        _Pragma("unroll") for (int i8 = 0; i8 < 8; ++i8) {                                              \
          const u32 rw = (u32)(((hb_) * 8 + i8) * 4 + r4);                                              \
          g4[hb_][i8] = *(const u32*)(gbase + gb0 + rw * 64u);                                          \
          if (pass == 1) pp[hb_][i8] = *(const u32*)(p.ws + OFF_PART8 + pb0 + rw * 64u);                \
        }
#define P4_ROWS(hb_)                                                                                    \
        _Pragma("unroll") for (int i8 = 0; i8 < 8; ++i8) {                                              \
          const int rw = ((hb_) * 8 + i8) * 4 + r4;                                                     \
          const f32x4 v = *(const f32x4*)(reg + rw * 256 + (((c16 + 4 * ((rw >> 2) & 3)) & 15) << 4));  \
          const int gw = (int)g4[hb_][i8];                                                              \
          float o0 = __builtin_amdgcn_cvt_f32_fp8(gw, 0) * v[0], o1 = __builtin_amdgcn_cvt_f32_fp8(gw, 1) * v[1]; \
          float o2 = __builtin_amdgcn_cvt_f32_fp8(gw, 2) * v[2], o3 = __builtin_amdgcn_cvt_f32_fp8(gw, 3) * v[3]; \
          if (pass == 1) {                                                                              \
            const int pw = (int)pp[hb_][i8];                                                            \
            o0 += __builtin_amdgcn_cvt_f32_fp8(pw, 0) * 0.0625f; o1 += __builtin_amdgcn_cvt_f32_fp8(pw, 1) * 0.0625f; \
            o2 += __builtin_amdgcn_cvt_f32_fp8(pw, 2) * 0.0625f; o3 += __builtin_amdgcn_cvt_f32_fp8(pw, 3) * 0.0625f; \
            *(u32*)((unsigned char*)MG + ob0 + (u32)rw * DM) = fp8x4(o0 * 8.f, o1 * 8.f, o2 * 8.f, o3 * 8.f);     \
          } else {                \
            *(u32*)(p.ws + OFF_PART8 + pb0 + (u32)rw * 64u) = fp8x4(o0 * 16.f, o1 * 16.f, o2 * 16.f, o3 * 16.f); \
          }                                                                                             \
        }
        P4_LOADS(0)
#pragma unroll
        for (int m = 0; m < 4; ++m)
#pragma unroll
          for (int r = 0; r < 4; ++r) {
            const int row = m * 16 + 4 * fq + r;
            *(f32x4*)(reg + row * 256 + (((fr + 4 * fq) & 15) << 4)) =
                (f32x4){acc[ai][0][m][0][r], acc[ai][0][m][1][r], acc[ai][1][m][0][r], acc[ai][1][m][1][r]};
          }
        WAVE_LDS_SYNC();
        P4_LOADS(1)
        P4_ROWS(0)
        P4_ROWS(1)
#undef P4_LOADS
#undef P4_ROWS
        WAVE_LDS_SYNC();
      }
    }
  }
}

__device__ __forceinline__ void phase5(const Params& p, unsigned char* smem) {
  const u16* MG = (const u16*)(p.ws + OFF_MERGED);
  const u16* WTO = (const u16*)(p.ws + OFF_WTO);
  const float* x = p.in[0];
  const int ntn = DM / 256, ntiles = (MTOK / 256) * ntn;
  for (int t = blockIdx.x; t < ntiles; t += gridDim.x) {
    const int m0 = (t / ntn) * 256, n0 = (t % ntn) * 256;
    f32x4 acc[2][2][4][2];
    gemm8_tile<1, 123>(MG, WTO, DM / 2, m0, n0, smem, acc);
    const int tid_e = TIDX, lane = tid_e & 63, wave = tid_e >> 6;
    const int wr = wave >> 2, wc = wave & 3, fr = lane & 15, fq = lane >> 4;
    unsigned char* reg = smem + wave * 16384;
    const int c16 = lane & 15, r4 = lane >> 4;
    float* outp = p.out;
#pragma unroll
    for (int ai = 0; ai < 2; ++ai) {
#pragma unroll
      for (int m = 0; m < 4; ++m)
#pragma unroll
        for (int r = 0; r < 4; ++r) {
          const int row = m * 16 + 4 * fq + r;
          *(f32x4*)(reg + row * 256 + (((fr + 4 * fq) & 15) << 4)) =
              (f32x4){acc[ai][0][m][0][r], acc[ai][0][m][1][r], acc[ai][1][m][0][r], acc[ai][1][m][1][r]};
        }
      WAVE_LDS_SYNC();
      const u32 ob = (u32)(m0 + ai * 128 + wr * 64) * DM + (u32)(n0 + wc * 64 + c16 * 4);
#pragma unroll
      for (int i4 = 0; i4 < 4; ++i4) {
        f32x4 xv[4];
#pragma unroll
        for (int k = 0; k < 4; ++k) xv[k] = *(const f32x4*)(x + ob + (u32)(((i4 * 4 + k) * 4 + r4) * DM));
#pragma unroll
        for (int k = 0; k < 4; ++k) {
          const int rw = (i4 * 4 + k) * 4 + r4;
          const f32x4 v = *(const f32x4*)(reg + rw * 256 + (((c16 + 4 * ((rw >> 2) & 3)) & 15) << 4));
          *(f32x4*)(outp + ob + (u32)(rw * DM)) = xv[k] + v;
        }
        __builtin_amdgcn_sched_barrier(0);
      }
      WAVE_LDS_SYNC();
    }
  }
}

__device__ __forceinline__ void phase6(const Params& p, unsigned char* smem) {
  const u16* H2 = (const u16*)(p.ws + OFF_H2);
  const u16* WTQ = (const u16*)(p.ws + OFF_WTQ);
  u16* QP = (u16*)(p.ws + OFF_QP);
  const int ntn = 2048 / 256, ntiles = (MTOK / 256) * ntn;
  for (int t = blockIdx.x; t < ntiles; t += gridDim.x) {
    const int m0 = (t / ntn) * 256, n0 = (t % ntn) * 256;
    f32x4 acc[2][2][4][2];
    gemm8_tile(H2, WTQ, DM, m0, n0, smem, acc);
    const int tid_e = TIDX, lane = tid_e & 63, wave = tid_e >> 6;
    const int wr = wave >> 2, wc = wave & 3;
    ep_store<2048, false>(QP, (u32)(m0 + wr * 64) * 2048 + (u32)(n0 + wc * 64), acc, nullptr, 1.f, smem, wave, lane);
  }
}

__device__ __forceinline__ int mono_key(float v) { int b = __float_as_int(v); return b ^ ((b >> 31) & 0x7fffffff); }
__device__ __forceinline__ float unmono_key(int k) { return __int_as_float(k ^ ((k >> 31) & 0x7fffffff)); }
__device__ __forceinline__ void chain16(int (&k)[16], int x) {
#pragma unroll
  for (int j = 0; j < 16; ++j) { int hi = max(k[j], x); x = min(k[j], x); k[j] = hi; }
}

#define CE_DESC(a, b) { const int hi_ = max(a, b), lo_ = min(a, b); a = hi_; b = lo_; }
__device__ __forceinline__ void sort16_desc(int (&k)[16]) {
#pragma unroll
  for (int size = 2; size <= 16; size <<= 1) {
#pragma unroll
    for (int stride = size >> 1; stride > 0; stride >>= 1) {
#pragma unroll
      for (int i = 0; i < 16; ++i) {
        const int l = i ^ stride;
        if (l > i) {
          if ((i & size) == 0) CE_DESC(k[i], k[l]) else CE_DESC(k[l], k[i])
        }
      }
    }
  }
}
__device__ __forceinline__ void merge_top16(int (&a)[16], const int (&b)[16]) {
#pragma unroll
  for (int i = 0; i < 16; ++i) a[i] = max(a[i], b[15 - i]);
#pragma unroll
  for (int stride = 8; stride > 0; stride >>= 1) {
#pragma unroll
    for (int i = 0; i < 16; ++i) {
      const int l = i ^ stride;
      if (l > i) CE_DESC(a[i], a[l])
    }
  }
}

constexpr int P7_LD = 132;
__device__ __forceinline__ void phase7_tile(const Params& p, unsigned char* smem, const int m0, const int hp) {
  const u16* QP = (const u16*)(p.ws + OFF_QP);
  const u16* SKB = (const u16*)(p.ws + OFF_SKB);
  float* TOPS = (float*)(p.ws + OFF_TOPS);
  u8* TOPI = (u8*)(p.ws + OFF_TOPI);
  const int tid = TIDX, lane = tid & 63, wave = tid >> 6;
  const int wm = wave >> 1, wn = wave & 1, fr = lane & 15, fg = lane >> 4;
  float* tile = (float*)smem;
  unsigned char* stv = smem + 256 * P7_LD * 4;
  unsigned char* sti = stv + 256 * 64;
  {
    f32x4 acc[4][4];
    gemm_mainloop(QP + hp * 128, 2048, SKB + (size_t)hp * 128 * 128, 128, 128, m0, 0, smem, acc);
#pragma unroll
    for (int i = 0; i < 4; ++i)
#pragma unroll
      for (int j = 0; j < 4; ++j)
#pragma unroll
        for (int r = 0; r < 4; ++r) {
          int row = wm * 64 + i * 16 + 4 * fg + r, col = wn * 64 + j * 16 + fr;
          tile[row * P7_LD + col] = acc[i][j][r];
        }
    __syncthreads();
    {
      const int row = tid >> 1, half = tid & 1;
      int k[16];
      const float* rowp = tile + row * P7_LD + half * 64;
#pragma unroll
      for (int grp = 0; grp < 4; ++grp) {
        int gk[16];
#pragma unroll
        for (int c = 0; c < 16; c += 4) {
          f32x4 v = *(const f32x4*)(rowp + grp * 16 + c);
          const int ib = 127 - (half * 64 + grp * 16 + c);
          gk[c] = (mono_key(v[0]) & ~127) | ib;
          gk[c + 1] = (mono_key(v[1]) & ~127) | (ib - 1);
          gk[c + 2] = (mono_key(v[2]) & ~127) | (ib - 2);
          gk[c + 3] = (mono_key(v[3]) & ~127) | (ib - 3);
        }
        sort16_desc(gk);
        if (grp == 0) {
#pragma unroll
          for (int j = 0; j < 16; ++j) k[j] = gk[j];
        } else merge_top16(k, gk);
      }
      {
        int other[16];
#pragma unroll
        for (int j = 0; j < 16; ++j) other[j] = DPPI(k[j], 0xb1);
        merge_top16(k, other);
      }
      if (half == 0) {
        float vals[16]; int idx[16];
#pragma unroll
        for (int j = 0; j < 16; ++j) { idx[j] = 127 - (k[j] & 127); vals[j] = tile[row * P7_LD + idx[j]]; }
#pragma unroll
        for (int j = 0; j < 16; j += 4) *(f32x4*)(stv + row * 64 + j * 4) = (f32x4){vals[j], vals[j + 1], vals[j + 2], vals[j + 3]};
        u32x4 iw;
#pragma unroll
        for (int j = 0; j < 16; j += 4)
          iw[j >> 2] = (u32)idx[j] | ((u32)idx[j + 1] << 8) | ((u32)idx[j + 2] << 16) | ((u32)idx[j + 3] << 24);
        *(u32x4*)(sti + row * 16) = iw;
      }
    }
    __syncthreads();
    {
#pragma unroll
      for (int k2 = 0; k2 < 2; ++k2) {
        const int pc = tid + 512 * k2, prow = pc >> 2, c = pc & 3;
        *(u32x4*)((unsigned char*)TOPS + (((size_t)(m0 + prow) * 16 + hp) * 16) * 4 + c * 16) = *(const u32x4*)(stv + prow * 64 + c * 16);
      }
      if (tid < 256) *(u32x4*)(TOPI + ((size_t)(m0 + tid) * 16 + hp) * 16) = *(const u32x4*)(sti + tid * 16);
    }
    __syncthreads();
  }
}

__device__ __forceinline__ void phase6f(const Params& p, unsigned char* smem) {
  const u16* H2 = (const u16*)(p.ws + OFF_H2);
  const u16* WTQ = (const u16*)(p.ws + OFF_WTQ);
  u16* QP = (u16*)(p.ws + OFF_QP);
  const int ntn = 2048 / 256, ntiles = (MTOK / 256) * ntn;
  for (int t = blockIdx.x; t < ntiles; t += gridDim.x) {
    const int m0 = (t / ntn) * 256, n0 = (t % ntn) * 256;
    {
      f32x4 acc[2][2][4][2];
      gemm8_tile(H2, WTQ, DM, m0, n0, smem, acc);
      const int tid_e = TIDX, lane = tid_e & 63, wave = tid_e >> 6;
      const int wr = wave >> 2, wc = wave & 3;
      ep_store<2048, false>(QP, (u32)(m0 + wr * 64) * 2048 + (u32)(n0 + wc * 64), acc, nullptr, 1.f, smem, wave, lane);
    }
    asm volatile("s_waitcnt vmcnt(0)" ::: "memory");
    __syncthreads();
    phase7_tile(p, smem, m0, (n0 >> 8) * 2);
    phase7_tile(p, smem, m0, (n0 >> 8) * 2 + 1);
  }
}

__device__ __forceinline__ void phase7b(const Params& p) {
  const float* TOPS = (const float*)(p.ws + OFF_TOPS);
  const u8* TOPI = (const u8*)(p.ws + OFF_TOPI);
  int* EXPERT = (int*)(p.ws + OFF_EXPERT);
  float* GATE = (float*)(p.ws + OFF_GATE);
  for (int w = blockIdx.x * NTHREADS + TIDX; w < MTOK * 8; w += gridDim.x * NTHREADS) {
    const size_t o = (size_t)w * 32;
    float sa[16], sb[16];
#pragma unroll
    for (int k = 0; k < 16; k += 4) {
      float4 v = *(const float4*)(TOPS + o + k); sa[k] = v.x; sa[k + 1] = v.y; sa[k + 2] = v.z; sa[k + 3] = v.w;
      float4 u = *(const float4*)(TOPS + o + 16 + k); sb[k] = u.x; sb[k + 1] = u.y; sb[k + 2] = u.z; sb[k + 3] = u.w;
    }
    int cand[64];
#pragma unroll
    for (int k = 0; k < 64; ++k) cand[k] = (int)0x80000000;
    {
      int cnt = 0;
#pragma unroll
      for (int a = 0; a < 16; ++a)
#pragma unroll
        for (int bb = 0; bb < 16; ++bb)
          if ((a + 1) * (bb + 1) <= 16) { cand[cnt] = (mono_key(sa[a] + sb[bb]) & ~255) | (255 - (a * 16 + bb)); ++cnt; }
    }
    int kk[16];
#pragma unroll
    for (int grp = 0; grp < 4; ++grp) {
      int gk[16];
#pragma unroll
      for (int j = 0; j < 16; ++j) gk[j] = cand[grp * 16 + j];
      sort16_desc(gk);
      if (grp == 0) {
#pragma unroll
        for (int j = 0; j < 16; ++j) kk[j] = gk[j];
      } else merge_top16(kk, gk);
    }
    float vals[16];
#pragma unroll
    for (int k = 0; k < 16; ++k) vals[k] = unmono_key(kk[k] & ~255);
    float m = vals[0], s = 0.f, e[16];
#pragma unroll
    for (int k = 0; k < 16; ++k) { e[k] = __expf(vals[k] - m); s += e[k]; }
    float inv = 1.f / s;
    const u32x4 ia = *(const u32x4*)(TOPI + o), ib = *(const u32x4*)(TOPI + o + 16);
    int exv[16];
#pragma unroll
    for (int k = 0; k < 16; ++k) {
      const int ci = 255 - (kk[k] & 255);
      const int a = ci >> 4, bb = ci & 15;
      const u32 wa = (a < 8) ? ((a < 4) ? ia[0] : ia[1]) : ((a < 12) ? ia[2] : ia[3]);
      const u32 wb = (bb < 8) ? ((bb < 4) ? ib[0] : ib[1]) : ((bb < 12) ? ib[2] : ib[3]);
      exv[k] = (int)((wa >> ((a & 3) * 8)) & 255u) * 128 + (int)((wb >> ((bb & 3) * 8)) & 255u);
    }
#pragma unroll
    for (int k = 0; k < 16; k += 4) {
      *(f32x4*)(GATE + (size_t)w * 16 + k) = (f32x4){e[k] * inv, e[k + 1] * inv, e[k + 2] * inv, e[k + 3] * inv};
    }
#pragma unroll
    for (int k = 0; k < 16; k += 8)
      *(u32x4*)((u16*)EXPERT + (size_t)w * 16 + k) =
          (u32x4){(u32)exv[k] | ((u32)exv[k + 1] << 16), (u32)exv[k + 2] | ((u32)exv[k + 3] << 16),
                  (u32)exv[k + 4] | ((u32)exv[k + 5] << 16), (u32)exv[k + 6] | ((u32)exv[k + 7] << 16)};
  }
}

__device__ __forceinline__ void phase8a(const Params& p) {
  const int* EXPERT = (const int*)(p.ws + OFF_EXPERT);
  const unsigned char* UQS = p.ws + OFF_UQ;
  const unsigned char* H2Q = p.ws + OFF_H2Q;
  int* PD = (int*)(p.ws + OFF_PD);
  unsigned* ctr = (unsigned*)(p.ws + 2048 + ((p.flags & 128) ? 4096 : 0));
  const unsigned xcc = (unsigned)__builtin_amdgcn_s_getreg((3 << 11) | 20) & 7u;
  const int lane = TIDX & 63, g8 = lane >> 3, l8 = lane & 7;
  for (unsigned db = 0; db < 8; ++db) {
    const int x = (int)((xcc + db) & 7u);
    for (;;) {
      unsigned ci = 0;
      if (lane == 0) ci = __hip_atomic_fetch_add(ctr + x * 16, 1u, __ATOMIC_RELAXED, __HIP_MEMORY_SCOPE_AGENT);
      ci = (unsigned)__builtin_amdgcn_readfirstlane((int)ci);
      if (ci >= (unsigned)(MTOK / 16)) break;
#pragma unroll 1
      for (int tt = 0; tt < 16; ++tt) {
        const int tok = (int)ci * 16 + tt;
        const int e0 = (int)((const u16*)EXPERT)[(size_t)tok * 128 + lane], e1 = (int)((const u16*)EXPERT)[(size_t)tok * 128 + 64 + lane];
        const u32x4 hq = *(const u32x4*)(H2Q + (size_t)tok * DM + x * 128 + l8 * 16);
        u32x4 ua[16];
#pragma unroll
        for (int i = 0; i < 16; ++i) {
          const int k = i * 8 + g8;
          const int ek = __shfl(i < 8 ? e0 : e1, k & 63);
          ua[i] = *(const u32x4*)(UQS + ((size_t)(x * 16384 + ek)) * 128 + l8 * 16);
        }
        int keep0 = 0, keep1 = 0;
#pragma unroll
        for (int i = 0; i < 16; ++i) {
          int sd = 0;
#pragma unroll
          for (int c = 0; c < 4; ++c) sd = __builtin_amdgcn_sdot4((int)ua[i][c], (int)hq[c], sd, false);
          sd += DPPI(sd, 0xb1); sd += DPPI(sd, 0x4e); sd += DPPI(sd, 0x141);
          if (i < 8) keep0 = (l8 == (i & 7)) ? sd : keep0; else keep1 = (l8 == (i & 7)) ? sd : keep1;
        }
        _Float16* pd = (_Float16*)PD + ((size_t)x * MTOK + tok) * 128 + l8 * 8 + g8;
        pd[0] = (_Float16)((float)keep0 * 0.015625f); pd[64] = (_Float16)((float)keep1 * 0.015625f);
      }
    }
  }
}

__device__ __forceinline__ void phase8c(const Params& p) {
  const int* EXPERT = (const int*)(p.ws + OFF_EXPERT);
  const float* GATE = (const float*)(p.ws + OFF_GATE);
  const float* US = (const float*)(p.ws + OFF_US);
  const float* VS = (const float*)(p.ws + OFF_VS);
  const float* HS = (const float*)(p.ws + OFF_HS);
  const int* PD = (const int*)(p.ws + OFF_PD);
  unsigned char* CQ8 = p.ws + OFF_CQ8;
  float* QSC = (float*)(p.ws + OFF_QSC);
  const int lane = TIDX & 63, wave = TIDX >> 6;
  for (int tok = blockIdx.x * 8 + wave; tok < MTOK; tok += gridDim.x * 8) {
    const int e0 = (int)((const u16*)EXPERT)[(size_t)tok * 128 + lane], e1 = (int)((const u16*)EXPERT)[(size_t)tok * 128 + 64 + lane];
    const float g0 = GATE[(size_t)tok * 128 + lane], g1 = GATE[(size_t)tok * 128 + 64 + lane];
    float s0 = 0.f, s1 = 0.f;
    const _Float16* PDH = (const _Float16*)PD;
#pragma unroll
    for (int xx = 0; xx < 8; ++xx) {
      s0 += (float)PDH[((size_t)xx * MTOK + tok) * 128 + lane];
      s1 += (float)PDH[((size_t)xx * MTOK + tok) * 128 + 64 + lane];
    }
    const float hs = HS[tok] * 64.f;
    const float2 sc0 = ((const float2*)US)[e0], sc1 = ((const float2*)US)[e1];
    const float d0 = s0 * sc0.x * hs, d1 = s1 * sc1.x * hs;
    const float cf0 = g0 * 0.5f * d0 * (1.f + erff(d0 * 0.70710678118654752f)) * sc0.y;
    const float cf1 = g1 * 0.5f * d1 * (1.f + erff(d1 * 0.70710678118654752f)) * sc1.y;
    const float cmax = wave_max_dpp(fmaxf(fabsf(cf0), fabsf(cf1)));
    const float qinv = cmax > 0.f ? 32639.f / cmax : 0.f;
    const int c0 = (int)rintf(cf0 * qinv), c1 = (int)rintf(cf1 * qinv);
    const int h0 = (c0 + 128) >> 8, h1 = (c1 + 128) >> 8;
    unsigned char* cq = CQ8 + (size_t)tok * 256;
    cq[lane] = (unsigned char)(h0 & 0xff); cq[64 + lane] = (unsigned char)(h1 & 0xff);
    cq[128 + lane] = (unsigned char)((c0 - 256 * h0) & 0xff); cq[192 + lane] = (unsigned char)((c1 - 256 * h1) & 0xff);
    if (lane == 0) QSC[tok] = cmax * (1.f / 32639.f);
  }
}

#ifndef TR8_VARIANT
#define TR8_VARIANT 0
#endif
__device__ __forceinline__ void phase8b(const Params& p, unsigned char* smem) {
  typedef int i32x4 __attribute__((ext_vector_type(4)));
  typedef int i32x2 __attribute__((ext_vector_type(2)));
  typedef __attribute__((address_space(3))) i32x2 lds_i32x2;
  const int* EXPERT = (const int*)(p.ws + OFF_EXPERT);
  const unsigned char* VQS = p.ws + OFF_VQ;
  const unsigned char* CQ8 = p.ws + OFF_CQ8;
  const float* QSC = (const float*)(p.ws + OFF_QSC);
  unsigned* ctr = (unsigned*)(p.ws + 3072 + ((p.flags & 128) ? 4096 : 0));
  const unsigned xcc = (unsigned)__builtin_amdgcn_s_getreg((3 << 11) | 20) & 7u;
  const int lane = TIDX & 63, wave = TIDX >> 6, g8 = lane >> 3, l8 = lane & 7;
  const int fr = lane & 15, fg = lane >> 4;
  unsigned char* VST = smem + wave * 16384;
#if TR8_VARIANT == 0
  const int trow = (lane & 15) >> 1, thalf = lane & 1;
#else
  const int trow = lane & 7, thalf = (lane & 15) >> 3;
#endif
  __syncthreads();
  for (unsigned db = 0; db < 8; ++db) {
    const int x = (int)((xcc + db) & 7u);
    for (;;) {
      unsigned ci = 0;
      if (lane == 0) ci = __hip_atomic_fetch_add(ctr + x * 16, 1u, __ATOMIC_RELAXED, __HIP_MEMORY_SCOPE_AGENT);
      ci = (unsigned)__builtin_amdgcn_readfirstlane((int)ci);
      if (ci >= (unsigned)(MTOK / 16)) break;
#pragma unroll 1
      for (int tt = 0; tt < 16; ++tt) {
        const int tok = (int)ci * 16 + tt;
        const int e0 = (int)((const u16*)EXPERT)[(size_t)tok * 128 + lane], e1 = (int)((const u16*)EXPERT)[(size_t)tok * 128 + 64 + lane];
        f32x4 oldv = {0.f, 0.f, 0.f, 0.f};
        if (lane < 32) oldv = *(const f32x4*)(p.out + (size_t)tok * DM + x * 128 + lane * 4);
        u32x4 va[16];
#pragma unroll
        for (int i = 0; i < 16; ++i) {
          const int k = i * 8 + g8;
          const int ek = __shfl(i < 8 ? e0 : e1, k & 63);
          va[i] = *(const u32x4*)(VQS + ((size_t)(x * 16384 + ek)) * 128 + l8 * 16);
        }
        i32x4 af[2];
#pragma unroll
        for (int sx = 0; sx < 2; ++sx) {
          af[sx] = *(const i32x4*)(CQ8 + (size_t)tok * 256 + (fr & 1) * 128 + sx * 64 + fg * 16);
          if (fr >= 2) af[sx] = (i32x4){0, 0, 0, 0};
        }
        const float qsc = QSC[tok];
#pragma unroll
        for (int i = 0; i < 16; ++i) {
          const int k = i * 8 + g8;
          *(u32x4*)(VST + k * 128 + ((l8 ^ g8) << 4)) = va[i];
        }
        WAVE_LDS_SYNC();
        i32x4 acc[8];
#pragma unroll
        for (int c = 0; c < 8; ++c) acc[c] = (i32x4){0, 0, 0, 0};
#pragma unroll
        for (int sx = 0; sx < 2; ++sx) {
          const int r1 = sx * 64 + fg * 16 + trow, r2 = r1 + 8;
#pragma unroll
          for (int c = 0; c < 8; ++c) {
            const i32x2 lo = __builtin_amdgcn_ds_read_tr8_b64_v2i32((lds_i32x2*)(VST + r1 * 128 + ((c ^ (r1 & 7)) << 4) + 8 * thalf));
            const i32x2 hi = __builtin_amdgcn_ds_read_tr8_b64_v2i32((lds_i32x2*)(VST + r2 * 128 + ((c ^ (r2 & 7)) << 4) + 8 * thalf));
            const i32x4 bf = {lo[0], lo[1], hi[0], hi[1]};
            acc[c] = __builtin_amdgcn_mfma_i32_16x16x64_i8(af[sx], bf, acc[c], 0, 0, 0);
          }
        }
        WAVE_LDS_SYNC();
        float* ost = (float*)VST;
        if (lane < 16) {
#pragma unroll
          for (int c = 0; c < 8; ++c) ost[16 * c + fr] = ((float)acc[c][0] * 256.f + (float)acc[c][1]) * qsc;
        }
        WAVE_LDS_SYNC();
        if (lane < 32 && !(p.flags & 32))
          *(f32x4*)(p.out + (size_t)tok * DM + x * 128 + lane * 4) = oldv + *(const f32x4*)(ost + lane * 4);
        WAVE_LDS_SYNC();
      }
    }
  }
}

__device__ __forceinline__ void grid_barrier(unsigned* ctr, unsigned nb) {
  asm volatile("s_waitcnt vmcnt(0)" ::: "memory");
  __syncthreads();
  if (TIDX == 0) {
    const unsigned ng = (gridDim.x & 7u) ? 1u : 8u, gsize = gridDim.x / ng;
    __builtin_amdgcn_fence(__ATOMIC_RELEASE, "agent");
    asm volatile("s_waitcnt vmcnt(0)" ::: "memory");
    unsigned* gctr = ctr + 32 + (blockIdx.x & (ng - 1u)) * 16;
    const unsigned old = __hip_atomic_fetch_add(gctr, 1u, __ATOMIC_RELAXED, __HIP_MEMORY_SCOPE_AGENT);
    if (old + 1u == gsize * nb) __hip_atomic_fetch_add(ctr, 1u, __ATOMIC_RELAXED, __HIP_MEMORY_SCOPE_AGENT);
    while (__hip_atomic_load(ctr, __ATOMIC_RELAXED, __HIP_MEMORY_SCOPE_AGENT) < ng * nb) __builtin_amdgcn_s_sleep(1);
    __builtin_amdgcn_fence(__ATOMIC_ACQUIRE, "agent");
    asm volatile("s_waitcnt vmcnt(0)" ::: "memory");
  }
  __syncthreads();
}

__global__ void __launch_bounds__(NTHREADS, 2) mk_fwd(Params p) {
  cg::grid_group grid = cg::this_grid();
  __shared__ __attribute__((aligned(16))) unsigned char smem[SMEM_BYTES];
  const int lo = p.ph_lo, hi = p.ph_hi;
#define RUN(k, call) if (lo <= (k) && (k) < hi) { call; if ((k) + 1 < hi) { if ((k) == 0) grid.sync(); else grid_barrier((unsigned*)p.ws, (unsigned)(lo == 0 ? (k) : (k) - lo + 1)); } }
  if (lo == 0 && blockIdx.x == 0) ((u32x4*)p.ws)[TIDX] = u32x4{0u, 0u, 0u, 0u};
  RUN(0, phase0(p, smem))
  RUN(1, phase1(p, smem))
  RUN(2, phase2(p, smem))
  RUN(3, phase3(p, smem))
  RUN(4, (ydn_norm(p), phase4<0>(p, smem)))
  RUN(5, phase4<1>(p, smem))
  RUN(6, phase5(p, smem))
  RUN(7, rmsnorm_rows<true>(p.out, p.in[12], (u16*)(p.ws + OFF_H2), p.ws + OFF_H2Q, (float*)(p.ws + OFF_HS)))
  RUN(8, phase6f(p, smem))
  RUN(9, phase7b(p))
  RUN(10, phase8a(p))
  RUN(11, phase8c(p))
  RUN(12, phase8b(p, smem))
#undef RUN
}

extern "C" void kernel_launch(void* const* d_in, const int* in_sizes, int n_in,
                              void* d_out, int out_size, void* d_ws, size_t ws_size,
                              hipStream_t stream) {
  static int grid_blocks = 0;
  if (!grid_blocks) {
    int dev = 0, cus = 0, per_cu = 0;
    (void)hipGetDevice(&dev);
    (void)hipDeviceGetAttribute(&cus, hipDeviceAttributeMultiprocessorCount, dev);
    (void)hipOccupancyMaxActiveBlocksPerMultiprocessor(&per_cu, mk_fwd, NTHREADS, 0);
    if (per_cu < 1) per_cu = 1;
    if (per_cu > 1) per_cu = 1;
    grid_blocks = cus * per_cu;
    fprintf(stderr, "mk_fwd: cus=%d per_cu=%d grid=%d ws=%zu\n", cus, per_cu, grid_blocks, ws_size);
  }
  Params p{};
  for (int i = 0; i < 17 && i < n_in; ++i) p.in[i] = (const float*)d_in[i];
  p.out = (float*)d_out;
  p.ws = (unsigned char*)d_ws;
  p.ph_lo = 0; p.ph_hi = 13;
#ifdef EXTRA_LO
  (void)hipMemsetAsync(d_ws, 0, 8192, stream);
#endif
  void* args[] = {&p};
  hipError_t e = hipLaunchCooperativeKernel((void*)mk_fwd, dim3(grid_blocks), dim3(NTHREADS), args, 0, stream);
  if (e != hipSuccess) fprintf(stderr, "cooperative launch failed: %s (grid %d)\n", hipGetErrorString(e), grid_blocks);
#ifdef EXTRA_LO
  {
    Params p2 = p;
    p2.ph_lo = EXTRA_LO; p2.ph_hi = EXTRA_HI; p2.flags = EXTRA_FLAGS;
    void* args2[] = {&p2};
    (void)hipLaunchCooperativeKernel((void*)mk_fwd, dim3(grid_blocks), dim3(NTHREADS), args2, 0, stream);
  }
#endif
}
```
